# Optimizing an MI355X kernel written in HIP

```python
import math
import numpy as np
import jax
import jax.numpy as jnp
from jax import lax

D_MODEL = 1024
BATCH = 4
SEQ = 4096
DEPTH = 1

SSD_WIDTH = D_MODEL
ATTN_WIDTH = D_MODEL
MIX_WIDTH = SSD_WIDTH + ATTN_WIDTH
SSD_HEAD_DIM = 64
SSD_HEADS = SSD_WIDTH // SSD_HEAD_DIM
SSD_GROUPS = 2
SSD_HEADS_PER_GROUP = SSD_HEADS // SSD_GROUPS
SSD_STATE = 128
SSD_CONV = 4
SSD_CHUNK = 128
SSD_CONV_DIM = SSD_WIDTH + 2 * SSD_GROUPS * SSD_STATE
ATTN_HEAD_DIM = 64
ATTN_HEADS = ATTN_WIDTH // ATTN_HEAD_DIM
KV_HEADS = 4
Q_PER_KV = ATTN_HEADS // KV_HEADS
KV_WIDTH = KV_HEADS * ATTN_HEAD_DIM
CMP_BLOCK = 32
CMP_STRIDE = 16
CMP_HIDDEN = 256
SLC_BLOCK = 64
SLC_TOPK = 16
WINDOW = 512
Q_BLOCK = 64
ROPE_THETA = 10000.0
N_GATES = 3
PEER_HEADS = 8
PEER_KEYS = 128
PEER_EXPERTS = PEER_KEYS * PEER_KEYS
PEER_KEY_DIM = 256
PEER_TOPK = 16
PEER_TOKEN_BLOCK = 128
DN_ALPHA = (2 * DEPTH) ** 0.25
DN_BETA = (8 * DEPTH) ** -0.25
LN_EPS = 1e-5
RMS_EPS = 1e-5
NEG_INF = -1e30
BIG = 1e30

SPLIT_SIZES = (SSD_WIDTH, SSD_CONV_DIM, SSD_HEADS, ATTN_WIDTH, 6 * KV_WIDTH, ATTN_HEADS * N_GATES)
IN_PROJ_DIM = sum(SPLIT_SIZES)
SPLIT_POINTS = tuple(int(v) for v in np.cumsum(SPLIT_SIZES)[:-1])

kernel_name = "hymba_ssd_nsa_peer_deepnorm"


def layer_norm(x, g, b):
    xf = x.astype(jnp.float32)
    mu = jnp.mean(xf, -1, keepdims=True)
    var = jnp.mean(jnp.square(xf - mu), -1, keepdims=True)
    return ((xf - mu) * lax.rsqrt(var + LN_EPS) * g + b).astype(x.dtype)


def rms_norm(x, g):
    xf = x.astype(jnp.float32)
    return xf * lax.rsqrt(jnp.mean(xf * xf, -1, keepdims=True) + RMS_EPS) * g


def rope_angles(pos):
    inv = ROPE_THETA ** (-jnp.arange(0, ATTN_HEAD_DIM, 2, dtype=jnp.float32) / ATTN_HEAD_DIM)
    ang = pos.astype(jnp.float32)[:, None] * inv[None, :]
    return jnp.cos(ang), jnp.sin(ang)


def apply_rope(x, cos, sin):
    x1, x2 = jnp.split(x.astype(jnp.float32), 2, axis=-1)
    c = cos[:, None, :]
    s = sin[:, None, :]
    return jnp.concatenate([x1 * c - x2 * s, x1 * s + x2 * c], -1).astype(x.dtype)


def causal_dwconv(x, w, b):
    y = lax.conv_general_dilated(
        x, w[:, None, :].astype(x.dtype), window_strides=(1,), padding=[(w.shape[0] - 1, 0)],
        dimension_numbers=("NWC", "WIO", "NWC"), feature_group_count=x.shape[-1])
    return y + b


def segsum(a):
    cs = jnp.cumsum(a, -1)
    T = a.shape[-1]
    diff = cs[..., :, None] - cs[..., None, :]
    return jnp.where(jnp.tril(jnp.ones((T, T), dtype=bool)), diff, -jnp.inf)


def ssd_chunked(xh, dt, A, Bm, Cm):
    b, L, G, K, P = xh.shape
    N = Bm.shape[-1]
    c, l = L // SSD_CHUNK, SSD_CHUNK
    xdt = (xh.astype(jnp.float32) * dt[..., None]).reshape(b, c, l, G, K, P)
    a = (dt * A).reshape(b, c, l, G, K).transpose(0, 3, 4, 1, 2)
    Bc = Bm.astype(jnp.float32).reshape(b, c, l, G, N)
    Cc = Cm.astype(jnp.float32).reshape(b, c, l, G, N)
    a_cs = jnp.cumsum(a, -1)
    Lmat = jnp.exp(segsum(a))
    CB = jnp.einsum('bclgn,bcsgn->bgcls', Cc, Bc)
    scores = CB[:, :, None] * Lmat
    y_diag = jnp.einsum('bgkcls,bcsgkp->bclgkp', scores, xdt)
    decay_states = jnp.exp(a_cs[..., -1:] - a_cs).transpose(0, 3, 4, 1, 2)
    states = jnp.einsum('bclgn,bclgkp->bcgkpn', Bc, xdt * decay_states[..., None])
    states = jnp.concatenate([jnp.zeros_like(states[:, :1]), states], axis=1)
    last = jnp.pad(a_cs[..., -1], ((0, 0), (0, 0), (0, 0), (1, 0)))
    chunk_decay = jnp.exp(segsum(last))
    new_states = jnp.einsum('bgkzc,bcgkpn->bzgkpn', chunk_decay, states)
    prev_states = new_states[:, :-1]
    out_decay = jnp.exp(a_cs).transpose(0, 3, 4, 1, 2)
    y_off = jnp.einsum('bclgn,bcgkpn->bclgkp', Cc, prev_states) * out_decay[..., None]
    return (y_diag + y_off).reshape(b, L, G, K, P)


def ssd_mixer(z, xbc, dt_raw, conv_w, conv_b, dt_bias, a_log, d_skip, norm_w):
    b, L, _ = z.shape
    xbc = jax.nn.silu(causal_dwconv(xbc, conv_w, conv_b))
    xs, Bm, Cm = jnp.split(xbc, [SSD_WIDTH, SSD_WIDTH + SSD_GROUPS * SSD_STATE], axis=-1)
    xh = xs.reshape(b, L, SSD_GROUPS, SSD_HEADS_PER_GROUP, SSD_HEAD_DIM)
    Bm = Bm.reshape(b, L, SSD_GROUPS, SSD_STATE)
    Cm = Cm.reshape(b, L, SSD_GROUPS, SSD_STATE)
    dt = jax.nn.softplus(dt_raw.astype(jnp.float32) + dt_bias.astype(jnp.float32))
    dt = dt.reshape(b, L, SSD_GROUPS, SSD_HEADS_PER_GROUP)
    A = -jnp.exp(a_log.astype(jnp.float32)).reshape(SSD_GROUPS, SSD_HEADS_PER_GROUP)
    y = ssd_chunked(xh, dt, A, Bm, Cm)
    y = y + d_skip.astype(jnp.float32).reshape(SSD_GROUPS, SSD_HEADS_PER_GROUP)[..., None] * xh.astype(jnp.float32)
    gw = SSD_HEADS_PER_GROUP * SSD_HEAD_DIM
    y = y.reshape(b, L, SSD_GROUPS, gw) * jax.nn.silu(z.astype(jnp.float32)).reshape(b, L, SSD_GROUPS, gw)
    y = rms_norm(y, norm_w.reshape(SSD_GROUPS, gw))
    return y.reshape(b, L, SSD_WIDTH)


def compress_blocks(k, cmp_idx, pos_emb, w1, w2):
    b, _, hk, dh = k.shape
    n = cmp_idx.shape[0]
    blocks = k[:, cmp_idx] + pos_emb[:, None, :]
    flat = blocks.transpose(0, 1, 3, 2, 4).reshape(b, n, hk, CMP_BLOCK * dh)
    return jax.nn.gelu(flat @ w1, approximate=False) @ w2


def nsa_mixer(q, k_cmp, v_cmp, k_slc, v_slc, k_win, v_win, gate_raw,
              cmp_pos_k, cmp_w1_k, cmp_w2_k, cmp_pos_v, cmp_w1_v, cmp_w2_v):
    b, L, _ = q.shape
    n_cmp = (L - CMP_BLOCK) // CMP_STRIDE + 1
    n_slc = L // SLC_BLOCK
    n_sel = min(SLC_TOPK, n_slc)
    n_qb = L // Q_BLOCK
    kv = lambda t: t.reshape(b, L, KV_HEADS, ATTN_HEAD_DIM)

    cos, sin = rope_angles(jnp.arange(L))
    qh = apply_rope(q.reshape(b, L, ATTN_HEADS, ATTN_HEAD_DIM), cos, sin) * (ATTN_HEAD_DIM ** -0.5)
    qh = qh.reshape(b, L, KV_HEADS, Q_PER_KV, ATTN_HEAD_DIM)
    gates = jax.nn.sigmoid(gate_raw.astype(jnp.float32)).reshape(b, L, KV_HEADS, Q_PER_KV, N_GATES)

    cmp_idx = np.arange(n_cmp)[:, None] * CMP_STRIDE + np.arange(CMP_BLOCK)[None, :]
    cmp_end_np = cmp_idx[:, -1]
    ccos, csin = rope_angles(jnp.asarray(cmp_end_np))
    kc = apply_rope(compress_blocks(kv(k_cmp), cmp_idx, cmp_pos_k, cmp_w1_k, cmp_w2_k), ccos, csin)
    vc = compress_blocks(kv(v_cmp), cmp_idx, cmp_pos_v, cmp_w1_v, cmp_w2_v)
    cmp_end = jnp.asarray(cmp_end_np)
    cs = np.arange(n_cmp) * CMP_STRIDE
    ss = np.arange(n_slc) * SLC_BLOCK
    overlap = jnp.asarray(((cs[:, None] < ss[None, :] + SLC_BLOCK) &
                           (cs[:, None] + CMP_BLOCK > ss[None, :])).astype(np.float32))

    ks = apply_rope(kv(k_slc), cos, sin)
    ks_blk = ks.reshape(b, n_slc, SLC_BLOCK, KV_HEADS, ATTN_HEAD_DIM).transpose(0, 3, 1, 2, 4)
    vs_blk = kv(v_slc).reshape(b, n_slc, SLC_BLOCK, KV_HEADS, ATTN_HEAD_DIM).transpose(0, 3, 1, 2, 4)
    gather_blocks = jax.vmap(jax.vmap(lambda kb, ii: kb[ii]))

    pad = ((0, 0), (WINDOW, 0), (0, 0), (0, 0))
    kw_pad = jnp.pad(apply_rope(kv(k_win), cos, sin), pad)
    vw_pad = jnp.pad(kv(v_win), pad)
    blk = jnp.arange(n_slc)

    def block(qi):
        start = qi * Q_BLOCK
        t = start + jnp.arange(Q_BLOCK)
        qb = lax.dynamic_slice_in_dim(qh, start, Q_BLOCK, axis=1)
        gb = lax.dynamic_slice_in_dim(gates, start, Q_BLOCK, axis=1)

        s_c = jnp.einsum('bqhgd,bnhd->bhgqn', qb, kc).astype(jnp.float32)
        valid_c = cmp_end[None, :] <= t[:, None]
        p_c = jnp.where(valid_c, jax.nn.softmax(jnp.where(valid_c, s_c, NEG_INF), -1), 0.0)
        o_c = jnp.einsum('bhgqn,bnhd->bqhgd', p_c, vc.astype(jnp.float32))

        imp = jnp.einsum('bhgqn,nj->bhqj', p_c, overlap)
        tb = t // SLC_BLOCK
        causal_b = blk[None, :] * SLC_BLOCK <= t[:, None]
        forced = (blk[None, :] == 0) | (blk[None, :] == tb[:, None]) | (blk[None, :] == tb[:, None] - 1)
        imp = jnp.where(causal_b, jnp.where(forced, BIG, imp), NEG_INF)
        top_s, top_i = lax.top_k(imp, n_sel)
        blk_ok = top_s > 0.5 * NEG_INF
        kg = gather_blocks(ks_blk, top_i)
        vg = gather_blocks(vs_blk, top_i)
        s_s = jnp.einsum('bqhgd,bhqjld->bhgqjl', qb, kg).astype(jnp.float32)
        key_pos = top_i[..., None] * SLC_BLOCK + jnp.arange(SLC_BLOCK)
        mask_s = blk_ok[..., None] & (key_pos <= t[None, None, :, None, None])
        s_s = jnp.where(mask_s[:, :, None], s_s, NEG_INF)
        sh = s_s.shape
        p_s = jax.nn.softmax(s_s.reshape(sh[:4] + (n_sel * SLC_BLOCK,)), -1).reshape(sh)
        o_s = jnp.einsum('bhgqjl,bhqjld->bqhgd', p_s, vg.astype(jnp.float32))

        kw_b = lax.dynamic_slice_in_dim(kw_pad, start, Q_BLOCK + WINDOW, axis=1)
        vw_b = lax.dynamic_slice_in_dim(vw_pad, start, Q_BLOCK + WINDOW, axis=1)
        kpos = start - WINDOW + jnp.arange(Q_BLOCK + WINDOW)
        mask_w = (kpos[None, :] <= t[:, None]) & (kpos[None, :] > t[:, None] - WINDOW) & (kpos[None, :] >= 0)
        s_w = jnp.einsum('bqhgd,bkhd->bhgqk', qb, kw_b).astype(jnp.float32)
        p_w = jax.nn.softmax(jnp.where(mask_w, s_w, NEG_INF), -1)
        o_w = jnp.einsum('bhgqk,bkhd->bqhgd', p_w, vw_b.astype(jnp.float32))

        return gb[..., 0:1] * o_c + gb[..., 1:2] * o_s + gb[..., 2:3] * o_w

    out = lax.map(block, jnp.arange(n_qb))
    return out.transpose(1, 0, 2, 3, 4, 5).reshape(b, L, ATTN_WIDTH)


def peer_ffn(x, w_query, sub_keys, expert_u, expert_v):
    b, L, D = x.shape
    T = b * L
    xt = x.reshape(T, D)
    q = (xt @ w_query).reshape(T, PEER_HEADS, 2, PEER_KEY_DIM // 2)
    s = jnp.einsum('thcd,hckd->thck', q, sub_keys).astype(jnp.float32)
    s_top, i_top = lax.top_k(s, PEER_TOPK)
    cand = (s_top[:, :, 0, :, None] + s_top[:, :, 1, None, :]).reshape(T, PEER_HEADS, PEER_TOPK * PEER_TOPK)
    cand_idx = (i_top[:, :, 0, :, None] * PEER_KEYS + i_top[:, :, 1, None, :]).reshape(T, PEER_HEADS, PEER_TOPK * PEER_TOPK)
    g_s, g_pos = lax.top_k(cand, PEER_TOPK)
    e_idx = jnp.take_along_axis(cand_idx, g_pos, axis=-1)
    g = jax.nn.softmax(g_s, -1)
    nb = T // PEER_TOKEN_BLOCK

    def block(args):
        xb, eb, gb = args
        u = expert_u[eb]
        h = jax.nn.gelu(jnp.einsum('td,thkd->thk', xb, u).astype(jnp.float32), approximate=False)
        v = expert_v[eb]
        return jnp.einsum('thk,thkd->td', (gb * h).astype(v.dtype), v)

    y = lax.map(block, (xt.reshape(nb, PEER_TOKEN_BLOCK, D),
                        e_idx.reshape(nb, PEER_TOKEN_BLOCK, PEER_HEADS, PEER_TOPK),
                        g.reshape(nb, PEER_TOKEN_BLOCK, PEER_HEADS, PEER_TOPK)))
    return y.reshape(b, L, D).astype(x.dtype)


def setup_inputs(seed: int = 0) -> dict:
    key = jax.random.key(seed)
    ks = jax.random.split(key, 24)
    f32 = jnp.float32
    nl = DEPTH

    def nrm(k, shape, scale):
        return jax.random.normal(k, shape, f32) * scale

    x = nrm(ks[0], (BATCH, SEQ, D_MODEL), 1.0)
    w_in = nrm(ks[1], (nl, D_MODEL, IN_PROJ_DIM), D_MODEL ** -0.5)
    conv_w = nrm(ks[2], (nl, SSD_CONV, SSD_CONV_DIM), SSD_CONV ** -0.5)
    conv_b = nrm(ks[3], (nl, SSD_CONV_DIM), 0.01)
    dt0 = jnp.exp(jax.random.uniform(ks[4], (nl, SSD_HEADS), f32, math.log(1e-3), math.log(1e-1)))
    dt_bias = dt0 + jnp.log(-jnp.expm1(-dt0))
    a_log = jnp.log(jax.random.uniform(ks[5], (nl, SSD_HEADS), f32, 1.0, 16.0))
    d_skip = 1.0 + nrm(ks[6], (nl, SSD_HEADS), 0.1)
    ssd_norm_w = 1.0 + nrm(ks[7], (nl, SSD_WIDTH), 0.02)
    cmp_in = CMP_BLOCK * ATTN_HEAD_DIM
    cmp_pos_k = nrm(ks[8], (nl, CMP_BLOCK, ATTN_HEAD_DIM), 0.02)
    cmp_w1_k = nrm(ks[9], (nl, cmp_in, CMP_HIDDEN), cmp_in ** -0.5)
    cmp_w2_k = nrm(ks[10], (nl, CMP_HIDDEN, ATTN_HEAD_DIM), CMP_HIDDEN ** -0.5)
    cmp_pos_v = nrm(ks[11], (nl, CMP_BLOCK, ATTN_HEAD_DIM), 0.02)
    cmp_w1_v = nrm(ks[12], (nl, cmp_in, CMP_HIDDEN), cmp_in ** -0.5)
    cmp_w2_v = nrm(ks[13], (nl, CMP_HIDDEN, ATTN_HEAD_DIM), CMP_HIDDEN ** -0.5)
    attn_norm_w = 1.0 + nrm(ks[14], (nl, ATTN_WIDTH), 0.02)
    w_out = nrm(ks[15], (nl, MIX_WIDTH, D_MODEL), (MIX_WIDTH ** -0.5) * DN_BETA)
    ln1_g = 1.0 + nrm(ks[16], (nl, D_MODEL), 0.02)
    ln1_b = nrm(ks[17], (nl, D_MODEL), 0.01)
    peer_w_query = nrm(ks[18], (nl, D_MODEL, PEER_HEADS * PEER_KEY_DIM), D_MODEL ** -0.5)
    peer_sub_keys = nrm(ks[19], (nl, PEER_HEADS, 2, PEER_KEYS, PEER_KEY_DIM // 2), (PEER_KEY_DIM // 2) ** -0.5)
    peer_u = nrm(ks[20], (nl, PEER_EXPERTS, D_MODEL), D_MODEL ** -0.5)
    peer_v = nrm(ks[21], (nl, PEER_EXPERTS, D_MODEL), DN_BETA)
    ln2_g = 1.0 + nrm(ks[22], (nl, D_MODEL), 0.02)
    ln2_b = nrm(ks[23], (nl, D_MODEL), 0.01)
    return {"x": x, "w_in": w_in, "conv_w": conv_w, "conv_b": conv_b, "dt_bias": dt_bias,
            "a_log": a_log, "d_skip": d_skip, "ssd_norm_w": ssd_norm_w,
            "cmp_pos_k": cmp_pos_k, "cmp_w1_k": cmp_w1_k, "cmp_w2_k": cmp_w2_k,
            "cmp_pos_v": cmp_pos_v, "cmp_w1_v": cmp_w1_v, "cmp_w2_v": cmp_w2_v,
            "attn_norm_w": attn_norm_w, "w_out": w_out, "ln1_g": ln1_g, "ln1_b": ln1_b,
            "peer_w_query": peer_w_query, "peer_sub_keys": peer_sub_keys,
            "peer_u": peer_u, "peer_v": peer_v, "ln2_g": ln2_g, "ln2_b": ln2_b}


def reference(x, w_in, conv_w, conv_b, dt_bias, a_log, d_skip, ssd_norm_w,
              cmp_pos_k, cmp_w1_k, cmp_w2_k, cmp_pos_v, cmp_w1_v, cmp_w2_v,
              attn_norm_w, w_out, ln1_g, ln1_b, peer_w_query, peer_sub_keys,
              peer_u, peer_v, ln2_g, ln2_b):
    h = x
    for i in range(DEPTH):
        proj = h @ w_in[i]
        z, xbc, dt_raw, q, kvs, gate_raw = jnp.split(proj, SPLIT_POINTS, axis=-1)
        k_cmp, v_cmp, k_slc, v_slc, k_win, v_win = jnp.split(kvs, 6, axis=-1)
        y_ssd = ssd_mixer(z, xbc, dt_raw, conv_w[i], conv_b[i], dt_bias[i], a_log[i], d_skip[i], ssd_norm_w[i])
        y_att = nsa_mixer(q, k_cmp, v_cmp, k_slc, v_slc, k_win, v_win, gate_raw,
                          cmp_pos_k[i], cmp_w1_k[i], cmp_w2_k[i], cmp_pos_v[i], cmp_w1_v[i], cmp_w2_v[i])
        y_att = rms_norm(y_att, attn_norm_w[i])
        mix = jnp.concatenate([y_ssd, y_att], axis=-1).astype(h.dtype) @ w_out[i]
        h = layer_norm(DN_ALPHA * h + mix, ln1_g[i], ln1_b[i])
        ffn = peer_ffn(h, peer_w_query[i], peer_sub_keys[i], peer_u[i], peer_v[i])
        h = layer_norm(DN_ALPHA * h + ffn, ln2_g[i], ln2_b[i])
    return h
```

```cpp
#include <hip/hip_runtime.h>
#include <hip/hip_cooperative_groups.h>
#include <cstdio>
#include <cstdint>
namespace cg = cooperative_groups;

typedef unsigned short bf16;
typedef short bf16x8 __attribute__((ext_vector_type(8)));
typedef float f32x4 __attribute__((ext_vector_type(4)));
typedef unsigned long long u64;

constexpr int T = 16384, L = 4096, NBATCH = 4, D = 1024;
constexpr int NPROJ = 5184, NPROJ_PAD = 5376;
constexpr int NTHREADS = 512, NWAVES = 8;
constexpr float LN_EPS = 1e-5f, RMS_EPS = 1e-5f;
constexpr float DN_ALPHA = 1.189207115002721f;
constexpr float NEG_INF = -1e30f, BIG = 1e30f;

constexpr size_t MiB = 1u << 20;
constexpr size_t OFF_SSQ = 0;
constexpr size_t OFF_WOUT = 1 * MiB, OFF_WQ = 5 * MiB, OFF_W1K = 9 * MiB, OFF_W1V = 10 * MiB;
constexpr size_t OFF_W2K = 11 * MiB, OFF_W2V = 11 * MiB + 65536, OFF_B1K = 11 * MiB + 131072, OFF_B1V = 11 * MiB + 131072 + 4096;
constexpr size_t OFF_KEYS = 12 * MiB, OFF_ROPE = 13 * MiB, OFF_DT = 14 * MiB, OFF_ACS = 15 * MiB, OFF_GATE = 16 * MiB, OFF_MASK = 19 * MiB;
constexpr size_t OFF_HID = 20 * MiB, OFF_KC = 24 * MiB, OFF_VC = 24 * MiB + 524288;
constexpr size_t OFF_Z = 26 * MiB, OFF_Q = 58 * MiB, OFF_KVS = 90 * MiB, OFF_XBC = 138 * MiB, OFF_XSBC = 186 * MiB, OFF_BT = 234 * MiB, OFF_DTG = 242 * MiB;
constexpr size_t OFF_XB = 186 * MiB, OFF_WIN = 218 * MiB;
constexpr size_t OFF_H1B = 90 * MiB, OFF_QP = 138 * MiB, OFF_EIDX = 202 * MiB, OFF_GW = 210 * MiB;
constexpr int LDS_BYTES = 147456;

struct Params {
    const float *x, *w_in, *conv_w, *conv_b, *dt_bias, *a_log, *d_skip, *ssd_norm_w;
    const float *cmp_pos_k, *cmp_w1_k, *cmp_w2_k, *cmp_pos_v, *cmp_w1_v, *cmp_w2_v;
    const float *attn_norm_w, *w_out, *ln1_g, *ln1_b, *peer_wq, *peer_keys, *peer_u, *peer_v, *ln2_g, *ln2_b;
    float* out; unsigned char* ws;
};

__device__ __forceinline__ float bf2f(bf16 v) { return __uint_as_float((unsigned)v << 16); }
__device__ __forceinline__ bf16 f2bf(float f) { unsigned u = __float_as_uint(f); return (bf16)((u + 0x7fffu + ((u >> 16) & 1u)) >> 16); }
__device__ __forceinline__ float wave_sum(float v) {
#pragma unroll
    for (int o = 1; o < 64; o <<= 1) v += __shfl_xor(v, o);
    return v;
}
__device__ __forceinline__ float wave_max(float v) {
#pragma unroll
    for (int o = 1; o < 64; o <<= 1) v = fmaxf(v, __shfl_xor(v, o));
    return v;
}
__device__ __forceinline__ float gelu_exact(float v) { return 0.5f * v * (1.0f + erff(v * 0.7071067811865476f)); }
__device__ __forceinline__ float sigmoidf(float v) { return 1.0f / (1.0f + __expf(-v)); }

template <class AP, class BP, class EP>
__device__ __forceinline__ void gemm_wave32(int Mt, int Nt, int K, const AP& ap, const BP& bp, const EP& ep, int gwave, int nwaves) {
    const int lane = threadIdx.x & 63, r = lane & 15, q = lane >> 4;
    for (int tile = gwave; tile < Mt * Nt; tile += nwaves) {
        const int tm = tile / Nt, tn = tile % Nt, row0 = tm * 32, col0 = tn * 32;
        f32x4 acc[2][2];
#pragma unroll
        for (int i = 0; i < 2; ++i)
#pragma unroll
            for (int j = 0; j < 2; ++j) acc[i][j] = (f32x4){0.f, 0.f, 0.f, 0.f};
        for (int k0 = 0; k0 < K; k0 += 32) {
            const bf16x8 a0 = ap(row0 + r, k0 + 8 * q), a1 = ap(row0 + 16 + r, k0 + 8 * q);
            const bf16x8 b0 = bp(col0 + r, k0 + 8 * q), b1 = bp(col0 + 16 + r, k0 + 8 * q);
            acc[0][0] = __builtin_amdgcn_mfma_f32_16x16x32_bf16(a0, b0, acc[0][0], 0, 0, 0);
            acc[0][1] = __builtin_amdgcn_mfma_f32_16x16x32_bf16(a0, b1, acc[0][1], 0, 0, 0);
            acc[1][0] = __builtin_amdgcn_mfma_f32_16x16x32_bf16(a1, b0, acc[1][0], 0, 0, 0);
            acc[1][1] = __builtin_amdgcn_mfma_f32_16x16x32_bf16(a1, b1, acc[1][1], 0, 0, 0);
        }
#pragma unroll
        for (int i = 0; i < 2; ++i)
#pragma unroll
            for (int j = 0; j < 2; ++j)
#pragma unroll
                for (int e = 0; e < 4; ++e) ep(row0 + 16 * i + 4 * q + e, col0 + 16 * j + r, acc[i][j][e]);
    }
}
struct RowMajorBf16 { const bf16* p; int ld; __device__ __forceinline__ bf16x8 operator()(int row, int k) const { return *(const bf16x8*)(p + (size_t)row * ld + k); } };

__device__ __forceinline__ int winmap(int n) { return n < 2560 ? n : (n < 5120 ? n + 16 : (n < 5136 ? 2560 + (n - 5120) : n)); }
__device__ void ph_prep(const Params& p, int gtid, int gn, int gwave, int nwaves) {
    unsigned char* ws = p.ws; const int lane = threadIdx.x & 63;
    bf16* xb = (bf16*)(ws + OFF_XB);
    for (size_t i = gtid; i < (size_t)T * D / 4; i += gn) { const float4 v = ((const float4*)p.x)[i]; ushort4 o; o.x = f2bf(v.x); o.y = f2bf(v.y); o.z = f2bf(v.z); o.w = f2bf(v.w); ((ushort4*)xb)[i] = o; }
    bf16* winT = (bf16*)(ws + OFF_WIN);
    for (int i = gtid; i < NPROJ_PAD * 1024; i += gn) { const int n = i >> 10, k = i & 1023; winT[i] = n < NPROJ ? f2bf(p.w_in[(size_t)k * NPROJ + winmap(n)]) : (bf16)0; }
    bf16* woutT = (bf16*)(ws + OFF_WOUT);
    for (int i = gtid; i < 1024 * 2048; i += gn) { const int n = i >> 11, kk = i & 2047; const float w = kk < 1024 ? p.w_out[(size_t)(1024 + kk) * 1024 + n] * p.attn_norm_w[kk] : p.w_out[(size_t)(kk - 1024) * 1024 + n]; woutT[i] = f2bf(w); }
    bf16* wqT = (bf16*)(ws + OFF_WQ);
    for (int i = gtid; i < 2048 * 1024; i += gn) { const int n = i >> 10, k = i & 1023; wqT[i] = f2bf(p.peer_wq[(size_t)k * 2048 + n]); }
    bf16* w1kT = (bf16*)(ws + OFF_W1K); bf16* w1vT = (bf16*)(ws + OFF_W1V);
    for (int i = gtid; i < 256 * 2048; i += gn) { const int n = i >> 11, k = i & 2047; w1kT[i] = f2bf(p.cmp_w1_k[(size_t)k * 256 + n]); w1vT[i] = f2bf(p.cmp_w1_v[(size_t)k * 256 + n]); }
    bf16* w2kT = (bf16*)(ws + OFF_W2K); bf16* w2vT = (bf16*)(ws + OFF_W2V);
    for (int i = gtid; i < 64 * 256; i += gn) { const int n = i >> 8, k = i & 255; w2kT[i] = f2bf(p.cmp_w2_k[(size_t)k * 64 + n]); w2vT[i] = f2bf(p.cmp_w2_v[(size_t)k * 64 + n]); }
    bf16* keys = (bf16*)(ws + OFF_KEYS);
    for (int i = gtid; i < 8 * 2 * 128 * 128; i += gn) keys[i] = f2bf(p.peer_keys[i]);
    float* rc = (float*)(ws + OFF_ROPE); float* rs = rc + 4096 * 32;
    for (int i = gtid; i < 4096 * 32; i += gn) {
        const int pos = i >> 5, j = i & 31;
        const float inv = powf(10000.0f, -(float)(2 * j) / 64.0f); const float angf = (float)pos * inv;
        double xr = (double)angf * 0.15915494309189535; xr -= rint(xr); const double rr = xr * 6.283185307179586, r2 = rr * rr;
        double s = 0.0, c = 0.0, ts = rr, tc = 1.0;
        for (int k = 0; k < 14; ++k) { s += ts; c += tc; tc = -tc * r2 / (double)((2 * k + 1) * (2 * k + 2)); ts = -ts * r2 / (double)((2 * k + 2) * (2 * k + 3)); }
        rc[i] = (float)c; rs[i] = (float)s;
    }
    float* b1k = (float*)(ws + OFF_B1K); float* b1v = (float*)(ws + OFF_B1V);
    for (int o = gwave; o < 512; o += nwaves) {
        const int j = o & 255; const float* pos = o < 256 ? p.cmp_pos_k : p.cmp_pos_v; const float* w1 = o < 256 ? p.cmp_w1_k : p.cmp_w1_v;
        float s = 0.f; for (int k = lane; k < 2048; k += 64) s += pos[k] * w1[(size_t)k * 256 + j];
        s = wave_sum(s); if (lane == 0) (o < 256 ? b1k : b1v)[j] = s;
    }
    float* ssq = (float*)(ws + OFF_SSQ);
    for (int i = gtid; i < T; i += gn) ssq[i] = 0.f;
}

struct EpiInProj {
    bf16 *z, *xbc, *q, *kvs, *dtg;
    __device__ __forceinline__ void operator()(int row, int c, float v) const {
        const bf16 b = f2bf(v);
        if (c < 1024) z[(size_t)row * 1024 + c] = b;
        else if (c < 2560) xbc[(size_t)row * 1536 + (c - 1024)] = b;
        else if (c < 3584) q[(size_t)row * 1024 + (c - 2560)] = b;
        else if (c < 5120) kvs[(size_t)row * 1536 + (c - 3584)] = b;
        else if (c < 5184) dtg[(size_t)row * 64 + (c - 5120)] = b;
    }
};

__device__ void ph_tokprep(const Params& p, int gtid, int gn) {
    unsigned char* ws = p.ws;
    const bf16* xbc = (const bf16*)(ws + OFF_XBC); bf16* xsbc = (bf16*)(ws + OFF_XSBC);
    for (size_t i = gtid; i < (size_t)T * 1536; i += gn) {
        const int t = (int)(i / 1536), ch = (int)(i % 1536), l = t & (L - 1);
        float y = p.conv_b[ch];
#pragma unroll
        for (int j = 0; j < 4; ++j) { const int ll = l - 3 + j; if (ll >= 0) y += p.conv_w[j * 1536 + ch] * bf2f(xbc[(size_t)(t - 3 + j) * 1536 + ch]); }
        xsbc[i] = f2bf(y * sigmoidf(y));
    }
    const bf16* dtg = (const bf16*)(ws + OFF_DTG); float* dt = (float*)(ws + OFF_DT); float* gate = (float*)(ws + OFF_GATE);
    for (int i = gtid; i < T * 64; i += gn) {
        const int t = i >> 6, c = i & 63; const float v = bf2f(dtg[i]);
        if (c < 16) { const float xx = v + p.dt_bias[c]; dt[t * 16 + c] = xx > 20.f ? xx : log1pf(__expf(xx)); }
        else gate[t * 48 + (c - 16)] = sigmoidf(v);
    }
    const float* rc = (const float*)(ws + OFF_ROPE); const float* rs = rc + 4096 * 32;
    bf16* q = (bf16*)(ws + OFF_Q); bf16* kvs = (bf16*)(ws + OFF_KVS);
    for (size_t i = gtid; i < (size_t)T * 16 * 32; i += gn) {
        const int j = (int)(i & 31), h = (int)((i >> 5) & 15), t = (int)(i >> 9), l = t & (L - 1);
        const float c = rc[l * 32 + j], s = rs[l * 32 + j];
        bf16* pp = q + (size_t)t * 1024 + h * 64 + j; const float x1 = bf2f(pp[0]), x2 = bf2f(pp[32]);
        pp[0] = f2bf((x1 * c - x2 * s) * 0.125f); pp[32] = f2bf((x1 * s + x2 * c) * 0.125f);
    }
    for (size_t i = gtid; i < (size_t)T * 8 * 32; i += gn) {
        const int j = (int)(i & 31), hh = (int)((i >> 5) & 7), t = (int)(i >> 8), l = t & (L - 1);
        const float c = rc[l * 32 + j], s = rs[l * 32 + j];
        bf16* pp = kvs + (size_t)t * 1536 + (hh < 4 ? 512 + hh * 64 : 1024 + (hh - 4) * 64) + j; const float x1 = bf2f(pp[0]), x2 = bf2f(pp[32]);
        pp[0] = f2bf(x1 * c - x2 * s); pp[32] = f2bf(x1 * s + x2 * c);
    }
}

__device__ void ph_ssd_seq(const Params& p, int gwave, int nwaves) {
    unsigned char* ws = p.ws; const int lane = threadIdx.x & 63;
    const bf16* xsbc = (const bf16*)(ws + OFF_XSBC); const float* dt = (const float*)(ws + OFF_DT); float* ys = p.out;
    for (int task = gwave; task < NBATCH * 16 * 64; task += nwaves) {
        const int pp = task & 63, h = (task >> 6) & 15, b = task >> 10, g = h >> 3;
        const float A = -__expf(p.a_log[h]), Dh = p.d_skip[h];
        float h0 = 0.f, h1 = 0.f;
        for (int l = 0; l < L; l += 4) {
            float dtv[4], xv[4], B0[4], B1[4], C0[4], C1[4];
#pragma unroll
            for (int u = 0; u < 4; ++u) {
                const size_t t = (size_t)b * L + l + u; const bf16* row = xsbc + t * 1536;
                dtv[u] = dt[t * 16 + h]; xv[u] = bf2f(row[h * 64 + pp]);
                B0[u] = bf2f(row[1024 + g * 128 + lane]); B1[u] = bf2f(row[1024 + g * 128 + 64 + lane]);
                C0[u] = bf2f(row[1280 + g * 128 + lane]); C1[u] = bf2f(row[1280 + g * 128 + 64 + lane]);
            }
#pragma unroll
            for (int u = 0; u < 4; ++u) {
                const float dA = __expf(dtv[u] * A), xdt = xv[u] * dtv[u];
                h0 = dA * h0 + xdt * B0[u]; h1 = dA * h1 + xdt * B1[u];
                const float y = wave_sum(C0[u] * h0 + C1[u] * h1) + Dh * xv[u];
                if (lane == 0) ys[((size_t)b * L + l + u) * 1024 + h * 64 + pp] = y;
            }
        }
    }
}
__device__ void ph_ssd_gate(const Params& p, int gwave, int nwaves) {
    unsigned char* ws = p.ws; const int lane = threadIdx.x & 63;
    bf16* z = (bf16*)(ws + OFF_Z); const float* ys = p.out;
    for (int task = gwave; task < T * 2; task += nwaves) {
        const int t = task >> 1, g = task & 1; const size_t base = (size_t)t * 1024 + g * 512 + lane * 8;
        float y[8]; float ss = 0.f;
#pragma unroll
        for (int i = 0; i < 8; ++i) { const float zz = bf2f(z[base + i]); y[i] = ys[base + i] * (zz * sigmoidf(zz)); ss += y[i] * y[i]; }
        ss = wave_sum(ss); const float r = rsqrtf(ss * (1.0f / 512.0f) + RMS_EPS);
#pragma unroll
        for (int i = 0; i < 8; ++i) z[base + i] = f2bf(y[i] * r * p.ssd_norm_w[g * 512 + lane * 8 + i]);
    }
}

struct ACmp {
    const bf16* kvs; int coff;
    __device__ __forceinline__ bf16x8 operator()(int m, int k) const {
        const int hk = m & 3, n = (m >> 2) & 255, b = m >> 10, l = k >> 6, d = k & 63;
        if (n == 255) return (bf16x8){0, 0, 0, 0, 0, 0, 0, 0};
        return *(const bf16x8*)(kvs + (size_t)(b * L + 16 * n + l) * 1536 + coff + hk * 64 + d);
    }
};
struct EpiHid { bf16* hid; const float* bias; __device__ __forceinline__ void operator()(int row, int c, float v) const { hid[(size_t)row * 256 + c] = f2bf(gelu_exact(v + bias[c])); } };
struct EpiKc {
    bf16* dst; __device__ __forceinline__ void operator()(int m, int c, float v) const { const int hk = m & 3, n = (m >> 2) & 255, b = m >> 10; dst[((size_t)(b * 4 + hk) * 256 + n) * 64 + c] = (n == 255) ? (bf16)0 : f2bf(v); } };
__device__ void ph_kc_rope(const Params& p, int gtid, int gn) {
    unsigned char* ws = p.ws; bf16* kc = (bf16*)(ws + OFF_KC); const float* rc = (const float*)(ws + OFF_ROPE); const float* rs = rc + 4096 * 32;
    for (int i = gtid; i < 16 * 256 * 32; i += gn) {
        const int j = i & 31, n = (i >> 5) & 255, bh = i >> 13; const int pos = 16 * n + 31; if (n == 255) continue;
        const float c = rc[pos * 32 + j], s = rs[pos * 32 + j];
        bf16* pp = kc + ((size_t)bh * 256 + n) * 64 + j; const float x1 = bf2f(pp[0]), x2 = bf2f(pp[32]);
        pp[0] = f2bf(x1 * c - x2 * s); pp[32] = f2bf(x1 * s + x2 * c);
    }
}

__device__ void ph_nsa_naive(const Params& p, unsigned char* lds, int gwave, int nwaves) {
    unsigned char* ws = p.ws; const int lane = threadIdx.x & 63, wave = threadIdx.x >> 6;
    float* qs = (float*)(lds + wave * 17408); float* sbuf = qs + 256;
    bf16* q = (bf16*)(ws + OFF_Q); const bf16* kvs = (const bf16*)(ws + OFF_KVS);
    const bf16* kc = (const bf16*)(ws + OFF_KC); const bf16* vc = (const bf16*)(ws + OFF_VC);
    const float* gate = (const float*)(ws + OFF_GATE); float* ssq = (float*)(ws + OFF_SSQ);
    for (int task = gwave; task < T * 4; task += nwaves) {
        const int hk = task & 3, t = task >> 2, b = t >> 12, l = t & (L - 1), tb = l >> 6;
        bf16* qrow = q + (size_t)t * 1024 + hk * 256;
        __builtin_amdgcn_s_waitcnt(0);
#pragma unroll
        for (int g = 0; g < 4; ++g) qs[g * 64 + lane] = bf2f(qrow[g * 64 + lane]);
        float outv[4] = {0.f, 0.f, 0.f, 0.f};
        const bf16* kcb = kc + (size_t)(b * 4 + hk) * 256 * 64; const bf16* vcb = vc + (size_t)(b * 4 + hk) * 256 * 64;
        float m4[4] = {NEG_INF, NEG_INF, NEG_INF, NEG_INF};
#pragma unroll 1
        for (int c = 0; c < 4; ++c) {
            const int n = c * 64 + lane; const bool valid = (n < 255) && (16 * n + 31 <= l);
            float s[4] = {0.f, 0.f, 0.f, 0.f};
            const bf16* kr = kcb + (size_t)n * 64;
#pragma unroll 4
            for (int d = 0; d < 64; ++d) { const float kv = bf2f(kr[d]);
#pragma unroll
                for (int g = 0; g < 4; ++g) s[g] += qs[g * 64 + d] * kv; }
#pragma unroll
            for (int g = 0; g < 4; ++g) { const float sv = valid ? s[g] : NEG_INF; sbuf[g * 1024 + n] = sv; m4[g] = fmaxf(m4[g], sv); }
        }
        const bool anyvalid = (l >= 31);
        float sum4[4];
#pragma unroll
        for (int g = 0; g < 4; ++g) { m4[g] = wave_max(m4[g]); sum4[g] = 0.f; }
#pragma unroll 1
        for (int c = 0; c < 4; ++c) { const int n = c * 64 + lane;
#pragma unroll
            for (int g = 0; g < 4; ++g) { const float sv = sbuf[g * 1024 + n]; const float e = (sv > 0.5f * NEG_INF) ? __expf(sv - m4[g]) : 0.f; sbuf[g * 1024 + n] = e; sum4[g] += e; } }
#pragma unroll
        for (int g = 0; g < 4; ++g) { sum4[g] = wave_sum(sum4[g]); sum4[g] = anyvalid ? 1.0f / sum4[g] : 0.f; }
#pragma unroll 1
        for (int c = 0; c < 4; ++c) { const int n = c * 64 + lane;
#pragma unroll
            for (int g = 0; g < 4; ++g) sbuf[g * 1024 + n] *= sum4[g]; }
        __builtin_amdgcn_s_waitcnt(0);
        float imp = 0.f;
        { const int j = lane;
          for (int n = 4 * j - 1; n <= 4 * j + 3; ++n) if (n >= 0 && n < 255) { imp += sbuf[n] + sbuf[1024 + n] + sbuf[2048 + n] + sbuf[3072 + n]; }
          const bool causal = (j <= tb), forced = (j == 0) || (j == tb) || (j == tb - 1);
          imp = causal ? (forced ? BIG : imp) : NEG_INF; }
        int rank = 0;
#pragma unroll 1
        for (int jj = 0; jj < 64; ++jj) { const float v = __shfl(imp, jj); rank += (v > imp || (v == imp && jj < lane)) ? 1 : 0; }
        const bool sel = (rank < 16) && (lane <= tb);
        const u64 selmask = __ballot(sel);
        { float oc[4] = {0.f, 0.f, 0.f, 0.f};
          if (anyvalid) { const int nmax = (l - 31) / 16;
            for (int n = 0; n <= nmax; ++n) { const float vv = bf2f(vcb[(size_t)n * 64 + lane]);
#pragma unroll
                for (int g = 0; g < 4; ++g) oc[g] += sbuf[g * 1024 + n] * vv; } }
#pragma unroll
          for (int g = 0; g < 4; ++g) outv[g] += gate[(size_t)t * 48 + (hk * 4 + g) * 3 + 0] * oc[g]; }
        __builtin_amdgcn_s_waitcnt(0);
        {
            const bf16* ksb = kvs + (size_t)b * L * 1536 + 512 + hk * 64; const bf16* vsb = kvs + (size_t)b * L * 1536 + 768 + hk * 64;
            float mx[4] = {NEG_INF, NEG_INF, NEG_INF, NEG_INF}; int cnt = 0;
            for (u64 mm = selmask; mm; mm &= mm - 1, ++cnt) {
                const int j = __builtin_ctzll(mm); const int kp = j * 64 + lane; const bool ok = kp <= l;
                const bf16* kr = ksb + (size_t)kp * 1536; float s[4] = {0.f, 0.f, 0.f, 0.f};
#pragma unroll 4
                for (int d = 0; d < 64; ++d) { const float kv = bf2f(kr[d]);
#pragma unroll
                    for (int g = 0; g < 4; ++g) s[g] += qs[g * 64 + d] * kv; }
#pragma unroll
                for (int g = 0; g < 4; ++g) { const float sv = ok ? s[g] : NEG_INF; sbuf[g * 1024 + cnt * 64 + lane] = sv; mx[g] = fmaxf(mx[g], sv); }
            }
            float sm[4];
#pragma unroll
            for (int g = 0; g < 4; ++g) { mx[g] = wave_max(mx[g]); sm[g] = 0.f; }
            for (int c = 0; c < cnt; ++c)
#pragma unroll
                for (int g = 0; g < 4; ++g) { const float sv = sbuf[g * 1024 + c * 64 + lane]; const float e = (sv > 0.5f * NEG_INF) ? __expf(sv - mx[g]) : 0.f; sbuf[g * 1024 + c * 64 + lane] = e; sm[g] += e; }
#pragma unroll
            for (int g = 0; g < 4; ++g) sm[g] = 1.0f / wave_sum(sm[g]);
            __builtin_amdgcn_s_waitcnt(0);
            float os[4] = {0.f, 0.f, 0.f, 0.f}; int c = 0;
            for (u64 mm = selmask; mm; mm &= mm - 1, ++c) {
                const int j = __builtin_ctzll(mm); const int kmax = min(63, l - j * 64);
                for (int kk = 0; kk <= kmax; ++kk) { const float vv = bf2f(vsb[(size_t)(j * 64 + kk) * 1536 + lane]);
#pragma unroll
                    for (int g = 0; g < 4; ++g) os[g] += sbuf[g * 1024 + c * 64 + kk] * vv; }
            }
#pragma unroll
            for (int g = 0; g < 4; ++g) outv[g] += gate[(size_t)t * 48 + (hk * 4 + g) * 3 + 1] * os[g] * sm[g];
        }
        __builtin_amdgcn_s_waitcnt(0);
        {
            const bf16* kwb = kvs + (size_t)b * L * 1536 + 1024 + hk * 64; const bf16* vwb = kvs + (size_t)b * L * 1536 + 1280 + hk * 64;
            const int k0 = l - 511; float mx[4] = {NEG_INF, NEG_INF, NEG_INF, NEG_INF};
#pragma unroll 1
            for (int c = 0; c < 8; ++c) {
                const int kp = k0 + c * 64 + lane; const bool ok = kp >= 0; float s[4] = {0.f, 0.f, 0.f, 0.f};
                if (ok) { const bf16* kr = kwb + (size_t)kp * 1536;
#pragma unroll 4
                    for (int d = 0; d < 64; ++d) { const float kv = bf2f(kr[d]);
#pragma unroll
                        for (int g = 0; g < 4; ++g) s[g] += qs[g * 64 + d] * kv; } }
#pragma unroll
                for (int g = 0; g < 4; ++g) { const float sv = ok ? s[g] : NEG_INF; sbuf[g * 1024 + c * 64 + lane] = sv; mx[g] = fmaxf(mx[g], sv); }
            }
            float sm[4];
#pragma unroll
            for (int g = 0; g < 4; ++g) { mx[g] = wave_max(mx[g]); sm[g] = 0.f; }
#pragma unroll 1
            for (int c = 0; c < 8; ++c)
#pragma unroll
                for (int g = 0; g < 4; ++g) { const float sv = sbuf[g * 1024 + c * 64 + lane]; const float e = (sv > 0.5f * NEG_INF) ? __expf(sv - mx[g]) : 0.f; sbuf[g * 1024 + c * 64 + lane] = e; sm[g] += e; }
#pragma unroll
            for (int g = 0; g < 4; ++g) sm[g] = 1.0f / wave_sum(sm[g]);
            __builtin_amdgcn_s_waitcnt(0);
            float ow[4] = {0.f, 0.f, 0.f, 0.f};
            for (int i = (k0 < 0 ? -k0 : 0); i < 512; ++i) { const float vv = bf2f(vwb[(size_t)(k0 + i) * 1536 + lane]);
#pragma unroll
                for (int g = 0; g < 4; ++g) ow[g] += sbuf[g * 1024 + i] * vv; }
#pragma unroll
            for (int g = 0; g < 4; ++g) outv[g] += gate[(size_t)t * 48 + (hk * 4 + g) * 3 + 2] * ow[g] * sm[g];
        }
        float ss = 0.f;
#pragma unroll
        for (int g = 0; g < 4; ++g) { qrow[g * 64 + lane] = f2bf(outv[g]); ss += outv[g] * outv[g]; }
        ss = wave_sum(ss); if (lane == 0) atomicAdd(&ssq[t], ss);
    }
}

__device__ void ph_outproj_naive(const Params& p, int gwave, int nwaves) {
    unsigned char* ws = p.ws; const int lane = threadIdx.x & 63, r = lane & 15, q = lane >> 4;
    const bf16* yatt = (const bf16*)(ws + OFF_Q); const bf16* yssd = (const bf16*)(ws + OFF_Z); const bf16* wT = (const bf16*)(ws + OFF_WOUT);
    const float* ssq = (const float*)(ws + OFF_SSQ);
    const int Mt = T / 32, Nt = D / 32;
    for (int tile = gwave; tile < Mt * Nt; tile += nwaves) {
        const int tm = tile / Nt, tn = tile % Nt, row0 = tm * 32, col0 = tn * 32;
        f32x4 acc[2][2];
#pragma unroll
        for (int i = 0; i < 2; ++i)
#pragma unroll
            for (int j = 0; j < 2; ++j) acc[i][j] = (f32x4){0.f, 0.f, 0.f, 0.f};
        for (int half = 0; half < 2; ++half) {
            const bf16* A = half == 0 ? yatt : yssd;
            for (int k0 = 0; k0 < 1024; k0 += 32) {
                const bf16x8 a0 = *(const bf16x8*)(A + (size_t)(row0 + r) * 1024 + k0 + 8 * q), a1 = *(const bf16x8*)(A + (size_t)(row0 + 16 + r) * 1024 + k0 + 8 * q);
                const bf16x8 b0 = *(const bf16x8*)(wT + (size_t)(col0 + r) * 2048 + half * 1024 + k0 + 8 * q), b1 = *(const bf16x8*)(wT + (size_t)(col0 + 16 + r) * 2048 + half * 1024 + k0 + 8 * q);
                acc[0][0] = __builtin_amdgcn_mfma_f32_16x16x32_bf16(a0, b0, acc[0][0], 0, 0, 0);
                acc[0][1] = __builtin_amdgcn_mfma_f32_16x16x32_bf16(a0, b1, acc[0][1], 0, 0, 0);
                acc[1][0] = __builtin_amdgcn_mfma_f32_16x16x32_bf16(a1, b0, acc[1][0], 0, 0, 0);
                acc[1][1] = __builtin_amdgcn_mfma_f32_16x16x32_bf16(a1, b1, acc[1][1], 0, 0, 0);
            }
            if (half == 0) {
#pragma unroll
                for (int i = 0; i < 2; ++i)
#pragma unroll
                    for (int e = 0; e < 4; ++e) { const float rt = rsqrtf(ssq[row0 + 16 * i + 4 * q + e] * (1.0f / 1024.0f) + RMS_EPS); acc[i][0][e] *= rt; acc[i][1][e] *= rt; }
            }
        }
#pragma unroll
        for (int i = 0; i < 2; ++i)
#pragma unroll
            for (int j = 0; j < 2; ++j)
#pragma unroll
                for (int e = 0; e < 4; ++e) { const size_t o = (size_t)(row0 + 16 * i + 4 * q + e) * 1024 + col0 + 16 * j + r; p.out[o] = DN_ALPHA * p.x[o] + acc[i][j][e]; }
    }
}
__device__ void ph_ln1(const Params& p, int gwave, int nwaves) {
    unsigned char* ws = p.ws; const int lane = threadIdx.x & 63; bf16* h1b = (bf16*)(ws + OFF_H1B);
    for (int t = gwave; t < T; t += nwaves) {
        float v[16]; float s = 0.f; float* row = p.out + (size_t)t * 1024;
#pragma unroll
        for (int i = 0; i < 16; ++i) { v[i] = row[i * 64 + lane]; s += v[i]; }
        const float mu = wave_sum(s) * (1.0f / 1024.0f); float s2 = 0.f;
#pragma unroll
        for (int i = 0; i < 16; ++i) { v[i] -= mu; s2 += v[i] * v[i]; }
        const float rstd = rsqrtf(wave_sum(s2) * (1.0f / 1024.0f) + LN_EPS);
#pragma unroll
        for (int i = 0; i < 16; ++i) { const int c = i * 64 + lane; const float o = v[i] * rstd * p.ln1_g[c] + p.ln1_b[c]; row[c] = o; h1b[(size_t)t * 1024 + c] = f2bf(o); }
    }
}

__device__ void ph_peer_topk(const Params& p, unsigned char* lds, int gwave, int nwaves) {
    unsigned char* ws = p.ws; const int lane = threadIdx.x & 63, wave = threadIdx.x >> 6;
    float* qv = (float*)(lds + wave * 4608); float* sv = qv + 256; float* stop = sv + 256; int* itop = (int*)(stop + 32); float* cand = (float*)(itop + 32); int* cidx = (int*)(cand + 256);
    const bf16* qp = (const bf16*)(ws + OFF_QP); const bf16* keys = (const bf16*)(ws + OFF_KEYS);
    int* eidx = (int*)(ws + OFF_EIDX); float* gw = (float*)(ws + OFF_GW);
    for (int task = gwave; task < T * 8; task += nwaves) {
        const int h = task & 7, t = task >> 3;
        __builtin_amdgcn_s_waitcnt(0);
#pragma unroll
        for (int i = 0; i < 4; ++i) qv[i * 64 + lane] = bf2f(qp[(size_t)t * 2048 + h * 256 + i * 64 + lane]);
        __builtin_amdgcn_s_waitcnt(0);
        float sc[4];
#pragma unroll
        for (int i = 0; i < 4; ++i) { const int e = lane + 64 * i, c = e >> 7, k = e & 127; const bf16* kr = keys + ((size_t)(h * 2 + c) * 128 + k) * 128; float s = 0.f;
            for (int d = 0; d < 128; ++d) s += qv[c * 128 + d] * bf2f(kr[d]);
            sc[i] = s; sv[e] = s; }
        __builtin_amdgcn_s_waitcnt(0);
#pragma unroll
        for (int i = 0; i < 4; ++i) { const int e = lane + 64 * i, c = e >> 7, k = e & 127; int rank = 0;
            for (int kk = 0; kk < 128; ++kk) { const float v = sv[c * 128 + kk]; rank += (v > sc[i] || (v == sc[i] && kk < k)) ? 1 : 0; }
            if (rank < 16) { stop[c * 16 + rank] = sc[i]; itop[c * 16 + rank] = k; } }
        __builtin_amdgcn_s_waitcnt(0);
        float cv[4];
#pragma unroll
        for (int i = 0; i < 4; ++i) { const int e = lane + 64 * i, a = e >> 4, bb = e & 15; cv[i] = stop[a] + stop[16 + bb]; cand[e] = cv[i]; cidx[e] = itop[a] * 128 + itop[16 + bb]; }
        __builtin_amdgcn_s_waitcnt(0);
        float* gs = sv; int* ge = (int*)(sv + 16);
#pragma unroll
        for (int i = 0; i < 4; ++i) { const int e = lane + 64 * i; int rank = 0;
            for (int kk = 0; kk < 256; ++kk) { const float v = cand[kk]; rank += (v > cv[i] || (v == cv[i] && kk < e)) ? 1 : 0; }
            if (rank < 16) { gs[rank] = cv[i]; ge[rank] = cidx[e]; } }
        __builtin_amdgcn_s_waitcnt(0);
        if (lane < 16) { const float m = gs[0]; float den = 0.f; for (int i = 0; i < 16; ++i) den += __expf(gs[i] - m);
            gw[(size_t)t * 128 + h * 16 + lane] = __expf(gs[lane] - m) / den; eidx[(size_t)t * 128 + h * 16 + lane] = ge[lane]; }
    }
}
__device__ void ph_peer_gather(const Params& p, int gwave, int nwaves) {
    unsigned char* ws = p.ws; const int lane = threadIdx.x & 63;
    const bf16* h1b = (const bf16*)(ws + OFF_H1B); const int* eidx = (const int*)(ws + OFF_EIDX); const float* gw = (const float*)(ws + OFF_GW);
    for (int t = gwave; t < T; t += nwaves) {
        float xv[16], y[16];
#pragma unroll
        for (int i = 0; i < 4; ++i) { const ushort4 v = *(const ushort4*)(h1b + (size_t)t * 1024 + i * 256 + lane * 4); xv[4 * i] = bf2f(v.x); xv[4 * i + 1] = bf2f(v.y); xv[4 * i + 2] = bf2f(v.z); xv[4 * i + 3] = bf2f(v.w); }
#pragma unroll
        for (int i = 0; i < 16; ++i) y[i] = 0.f;
        for (int e0 = 0; e0 < 128; e0 += 2) {
            const int ea = eidx[(size_t)t * 128 + e0], eb = eidx[(size_t)t * 128 + e0 + 1]; const float ga = gw[(size_t)t * 128 + e0], gb = gw[(size_t)t * 128 + e0 + 1];
            float4 ua[4], ub[4], va[4], vb[4];
#pragma unroll
            for (int i = 0; i < 4; ++i) { ua[i] = *(const float4*)(p.peer_u + (size_t)ea * 1024 + i * 256 + lane * 4); ub[i] = *(const float4*)(p.peer_u + (size_t)eb * 1024 + i * 256 + lane * 4);
                va[i] = *(const float4*)(p.peer_v + (size_t)ea * 1024 + i * 256 + lane * 4); vb[i] = *(const float4*)(p.peer_v + (size_t)eb * 1024 + i * 256 + lane * 4); }
            float da = 0.f, db = 0.f;
#pragma unroll
            for (int i = 0; i < 4; ++i) { da += xv[4 * i] * ua[i].x + xv[4 * i + 1] * ua[i].y + xv[4 * i + 2] * ua[i].z + xv[4 * i + 3] * ua[i].w; db += xv[4 * i] * ub[i].x + xv[4 * i + 1] * ub[i].y + xv[4 * i + 2] * ub[i].z + xv[4 * i + 3] * ub[i].w; }
            da = wave_sum(da); db = wave_sum(db);
            const float ca = ga * gelu_exact(da), cb = gb * gelu_exact(db);
#pragma unroll
            for (int i = 0; i < 4; ++i) { y[4 * i] += ca * va[i].x + cb * vb[i].x; y[4 * i + 1] += ca * va[i].y + cb * vb[i].y; y[4 * i + 2] += ca * va[i].z + cb * vb[i].z; y[4 * i + 3] += ca * va[i].w + cb * vb[i].w; }
        }
        float* row = p.out + (size_t)t * 1024; float s = 0.f;
#pragma unroll
        for (int i = 0; i < 4; ++i) { const float4 hv = *(const float4*)(row + i * 256 + lane * 4); y[4 * i] += DN_ALPHA * hv.x; y[4 * i + 1] += DN_ALPHA * hv.y; y[4 * i + 2] += DN_ALPHA * hv.z; y[4 * i + 3] += DN_ALPHA * hv.w; }
#pragma unroll
        for (int i = 0; i < 16; ++i) s += y[i];
        const float mu = wave_sum(s) * (1.0f / 1024.0f); float s2 = 0.f;
#pragma unroll
        for (int i = 0; i < 16; ++i) { y[i] -= mu; s2 += y[i] * y[i]; }
        const float rstd = rsqrtf(wave_sum(s2) * (1.0f / 1024.0f) + LN_EPS);
#pragma unroll
        for (int i = 0; i < 4; ++i) { const int c = i * 256 + lane * 4; float4 o; o.x = y[4 * i] * rstd * p.ln2_g[c] + p.ln2_b[c]; o.y = y[4 * i + 1] * rstd * p.ln2_g[c + 1] + p.ln2_b[c + 1]; o.z = y[4 * i + 2] * rstd * p.ln2_g[c + 2] + p.ln2_b[c + 2]; o.w = y[4 * i + 3] * rstd * p.ln2_g[c + 3] + p.ln2_b[c + 3]; *(float4*)(row + c) = o; }
    }
}

__global__ void __launch_bounds__(NTHREADS) fwd_megakernel(Params p) {
    extern __shared__ __attribute__((aligned(16))) unsigned char lds[];
    cg::grid_group grid = cg::this_grid();
    const int nb = gridDim.x, bid = blockIdx.x, gtid = bid * NTHREADS + threadIdx.x, gn = nb * NTHREADS;
    const int gwave = bid * NWAVES + (threadIdx.x >> 6), nwaves = nb * NWAVES;
    unsigned char* ws = p.ws;

    ph_prep(p, gtid, gn, gwave, nwaves);
    grid.sync();
    {
        RowMajorBf16 ap{(const bf16*)(ws + OFF_XB), 1024}, bp{(const bf16*)(ws + OFF_WIN), 1024};
        EpiInProj ep{(bf16*)(ws + OFF_Z), (bf16*)(ws + OFF_XBC), (bf16*)(ws + OFF_Q), (bf16*)(ws + OFF_KVS), (bf16*)(ws + OFF_DTG)};
        gemm_wave32(T / 32, NPROJ_PAD / 32, 1024, ap, bp, ep, gwave, nwaves);
    }
    grid.sync();
    ph_tokprep(p, gtid, gn);
    grid.sync();
    {
        ACmp ak{(const bf16*)(ws + OFF_KVS), 0}, av{(const bf16*)(ws + OFF_KVS), 256};
        RowMajorBf16 bk{(const bf16*)(ws + OFF_W1K), 2048}, bv{(const bf16*)(ws + OFF_W1V), 2048};
        EpiHid ek{(bf16*)(ws + OFF_HID), (const float*)(ws + OFF_B1K)}, ev{(bf16*)(ws + OFF_HID + 2 * MiB), (const float*)(ws + OFF_B1V)};
        gemm_wave32(4096 / 32, 256 / 32, 2048, ak, bk, ek, gwave, nwaves);
        gemm_wave32(4096 / 32, 256 / 32, 2048, av, bv, ev, gwave, nwaves);
    }
    ph_ssd_seq(p, gwave, nwaves);
    grid.sync();
    {
        RowMajorBf16 ak{(const bf16*)(ws + OFF_HID), 256}, av{(const bf16*)(ws + OFF_HID + 2 * MiB), 256};
        RowMajorBf16 bk{(const bf16*)(ws + OFF_W2K), 256}, bv{(const bf16*)(ws + OFF_W2V), 256};
        EpiKc ek{(bf16*)(ws + OFF_KC)}, ev{(bf16*)(ws + OFF_VC)};
        gemm_wave32(4096 / 32, 64 / 32, 256, ak, bk, ek, gwave, nwaves);
        gemm_wave32(4096 / 32, 64 / 32, 256, av, bv, ev, gwave, nwaves);
    }
    ph_ssd_gate(p, gwave, nwaves);
    grid.sync();
    ph_kc_rope(p, gtid, gn);
    grid.sync();
    ph_nsa_naive(p, lds, gwave, nwaves);
    grid.sync();
    ph_outproj_naive(p, gwave, nwaves);
    grid.sync();
    ph_ln1(p, gwave, nwaves);
    grid.sync();
    {
        RowMajorBf16 ap{(const bf16*)(ws + OFF_H1B), 1024}, bp{(const bf16*)(ws + OFF_WQ), 1024};
        bf16* qp = (bf16*)(ws + OFF_QP);
        auto ep = [qp](int row, int c, float v) { qp[(size_t)row * 2048 + c] = f2bf(v); };
        gemm_wave32(T / 32, 2048 / 32, 1024, ap, bp, ep, gwave, nwaves);
    }
    grid.sync();
    ph_peer_topk(p, lds, gwave, nwaves);
    grid.sync();
    ph_peer_gather(p, gwave, nwaves);
}

extern "C" void kernel_launch(void* const* d_in, const int* in_sizes, int n_in, void* d_out, int out_size, void* d_ws, size_t ws_size, hipStream_t stream) {
    static int grid_blocks = 0;
    if (!grid_blocks) {
        int dev = 0, cus = 0, per_cu = 0;
        hipGetDevice(&dev);
        hipDeviceGetAttribute(&cus, hipDeviceAttributeMultiprocessorCount, dev);
        hipFuncSetAttribute((const void*)fwd_megakernel, hipFuncAttributeMaxDynamicSharedMemorySize, LDS_BYTES);
        hipOccupancyMaxActiveBlocksPerMultiprocessor(&per_cu, fwd_megakernel, NTHREADS, LDS_BYTES);
        if (per_cu < 1) per_cu = 1;
        if (per_cu > 1) per_cu = 1;
        grid_blocks = cus * per_cu;
        if (ws_size < 244 * MiB) fprintf(stderr, "kernel_launch: workspace too small: %zu\n", ws_size);
    }
    Params p{};
    const float** pp = (const float**)&p;
    for (int i = 0; i < 24; ++i) pp[i] = (const float*)d_in[i];
    p.out = (float*)d_out; p.ws = (unsigned char*)d_ws;
    void* args[] = {&p};
    hipError_t e = hipLaunchCooperativeKernel((void*)fwd_megakernel, dim3(grid_blocks), dim3(NTHREADS), args, LDS_BYTES, stream);
    if (e != hipSuccess) fprintf(stderr, "cooperative launch failed: %s (grid %d)\n", hipGetErrorString(e), grid_blocks);
}
```

```cpp
#include <hip/hip_runtime.h>
#include <hip/hip_cooperative_groups.h>
#include <cstdio>
#include <cstdint>
namespace cg = cooperative_groups;

typedef unsigned short bf16;
typedef short bf16x8 __attribute__((ext_vector_type(8)));
typedef float f32x4 __attribute__((ext_vector_type(4)));
typedef unsigned long long u64;

constexpr int T = 16384, L = 4096, NBATCH = 4, D = 1024;
constexpr int NPROJ = 5184, NPROJ_PAD = 5376;
constexpr int NTHREADS = 512, NWAVES = 8;
constexpr float LN_EPS = 1e-5f, RMS_EPS = 1e-5f;
constexpr float DN_ALPHA = 1.189207115002721f;
constexpr float NEG_INF = -1e30f, BIG = 1e30f;

constexpr size_t MiB = 1u << 20;
constexpr size_t OFF_SSQ = 0;
constexpr size_t OFF_WOUT = 1 * MiB, OFF_WQ = 5 * MiB, OFF_W1K = 9 * MiB, OFF_W1V = 10 * MiB;
constexpr size_t OFF_W2K = 11 * MiB, OFF_W2V = 11 * MiB + 65536, OFF_B1K = 11 * MiB + 131072, OFF_B1V = 11 * MiB + 131072 + 4096;
constexpr size_t OFF_KEYS = 12 * MiB, OFF_ROPE = 13 * MiB, OFF_DT = 14 * MiB, OFF_ACS = 15 * MiB, OFF_GATE = 16 * MiB, OFF_MASK = 19 * MiB;
constexpr size_t OFF_HID = 20 * MiB, OFF_KC = 24 * MiB, OFF_VC = 24 * MiB + 524288;
constexpr size_t OFF_Z = 26 * MiB, OFF_Q = 58 * MiB, OFF_KVS = 90 * MiB, OFF_XBC = 138 * MiB, OFF_XSBC = 186 * MiB, OFF_BT = 234 * MiB, OFF_DTG = 242 * MiB;
constexpr size_t OFF_VST = 138 * MiB, OFF_VWT = 146 * MiB, OFF_VCT = 154 * MiB;
constexpr size_t OFF_XB = 186 * MiB, OFF_WIN = 218 * MiB;
constexpr size_t OFF_H1B = 90 * MiB, OFF_QP = 138 * MiB, OFF_EIDX = 202 * MiB, OFF_GW = 210 * MiB;
constexpr int LDS_BYTES = 147456;

struct Params {
    const float *x, *w_in, *conv_w, *conv_b, *dt_bias, *a_log, *d_skip, *ssd_norm_w;
    const float *cmp_pos_k, *cmp_w1_k, *cmp_w2_k, *cmp_pos_v, *cmp_w1_v, *cmp_w2_v;
    const float *attn_norm_w, *w_out, *ln1_g, *ln1_b, *peer_wq, *peer_keys, *peer_u, *peer_v, *ln2_g, *ln2_b;
    float* out; unsigned char* ws;
};

__device__ __forceinline__ float bf2f(bf16 v) { return __uint_as_float((unsigned)v << 16); }
__device__ __forceinline__ bf16 f2bf(float f) { unsigned u = __float_as_uint(f); return (bf16)((u + 0x7fffu + ((u >> 16) & 1u)) >> 16); }
__device__ __forceinline__ int lane_id() { int l = (int)__builtin_amdgcn_mbcnt_hi(~0u, __builtin_amdgcn_mbcnt_lo(~0u, 0u)); asm volatile("" : "+v"(l)); return l; }
#define PH_IDS() const int lane = lane_id(); const int tid = (wv << 6) | lane; const int bid = blockIdx.x, nb = gridDim.x; const int gtid = bid * NTHREADS + tid, gn = nb * NTHREADS; const int gwave = bid * NWAVES + wv, nwaves = nb * NWAVES; (void)gtid; (void)gn; (void)gwave; (void)nwaves;
__device__ __forceinline__ float wave_sum(float v) {
#pragma unroll
    for (int o = 1; o < 64; o <<= 1) v += __shfl_xor(v, o);
    return v;
}
__device__ __forceinline__ float wave_max(float v) {
#pragma unroll
    for (int o = 1; o < 64; o <<= 1) v = fmaxf(v, __shfl_xor(v, o));
    return v;
}
__device__ __forceinline__ float gelu_exact(float v) { return 0.5f * v * (1.0f + erff(v * 0.7071067811865476f)); }
__device__ __forceinline__ float sigmoidf(float v) { return 1.0f / (1.0f + __expf(-v)); }

template <class AP, class BP, class EP>
__device__ __forceinline__ void gemm_wave32(int wv, int Mt, int Nt, int K, const AP& ap, const BP& bp, const EP& ep) {
    PH_IDS(); const int r = lane & 15, q = lane >> 4;
    for (int tile = gwave; tile < Mt * Nt; tile += nwaves) {
        const int tm = tile / Nt, tn = tile % Nt, row0 = tm * 32, col0 = tn * 32;
        f32x4 acc[2][2];
#pragma unroll
        for (int i = 0; i < 2; ++i)
#pragma unroll
            for (int j = 0; j < 2; ++j) acc[i][j] = (f32x4){0.f, 0.f, 0.f, 0.f};
        for (int k0 = 0; k0 < K; k0 += 32) {
            const bf16x8 a0 = ap(row0 + r, k0 + 8 * q), a1 = ap(row0 + 16 + r, k0 + 8 * q);
            const bf16x8 b0 = bp(col0 + r, k0 + 8 * q), b1 = bp(col0 + 16 + r, k0 + 8 * q);
            acc[0][0] = __builtin_amdgcn_mfma_f32_16x16x32_bf16(a0, b0, acc[0][0], 0, 0, 0);
            acc[0][1] = __builtin_amdgcn_mfma_f32_16x16x32_bf16(a0, b1, acc[0][1], 0, 0, 0);
            acc[1][0] = __builtin_amdgcn_mfma_f32_16x16x32_bf16(a1, b0, acc[1][0], 0, 0, 0);
            acc[1][1] = __builtin_amdgcn_mfma_f32_16x16x32_bf16(a1, b1, acc[1][1], 0, 0, 0);
        }
#pragma unroll
        for (int i = 0; i < 2; ++i)
#pragma unroll
            for (int j = 0; j < 2; ++j)
#pragma unroll
                for (int e = 0; e < 4; ++e) ep(row0 + 16 * i + 4 * q + e, col0 + 16 * j + r, acc[i][j][e]);
    }
}
struct RowMajorBf16 { const bf16* p; int ld; __device__ __forceinline__ bf16x8 operator()(int row, int k) const { return *(const bf16x8*)(p + (size_t)row * ld + k); } };

namespace pg8 {
#define PG8_LAS __attribute__((address_space(3)))
typedef unsigned short bf16_t;
typedef short bf16x8 __attribute__((ext_vector_type(8)));
typedef float f32x4 __attribute__((ext_vector_type(4)));
typedef unsigned u32x4 __attribute__((ext_vector_type(4)));
constexpr int BM = 256, BK = 64, HALF = 128, HTB = HALF * BK * 2  , STAGE_BYTES = 8 * HTB, NXCD = 8, WGM = 8;

__host__ __device__ __forceinline__ int lds_byte(int r, int c) { const int st = (r >> 4) * 2 + (c >> 5), rr = r & 15, cc = c & 31, ob = rr * 64 + cc * 2; return st * 1024 + (ob ^ (((ob >> 9) & 1) << 5)); }
__host__ __device__ __forceinline__ void stage_rc(int b, int& R, int& C) { const int st = b / 1024, sb = b % 1024, swz = sb ^ (((sb >> 9) & 1) << 5); R = (st >> 1) * 16 + swz / 64; C = (st & 1) * 32 + (swz % 64) / 2; }
__host__ __device__ __forceinline__ int perm32(int rho) { const int n = rho >> 4, i = rho & 15; return 8 * (i >> 2) + 4 * n + (i & 3); }

struct Unit { int pm, pn; };
struct Gemm { const bf16_t* A; const bf16_t* Bt; int M, N, K; int lda; int amode; int ksplit; long kdelta; };

struct StaticOrder {
    int nM, nN, nwg, G, c;
    __host__ __device__ void init(int M, int N, int G_, int c_) { nM = M / BM; nN = N / BM; nwg = nM * nN; G = G_; c = c_; }
    __host__ __device__ bool next(int i, Unit& u) const {
        const long L = (long)i * G + c; if (L >= nwg) return false;
        int wgid = (int)L; { const int q = nwg / NXCD, r = nwg % NXCD, xcd = wgid % NXCD, off = wgid / NXCD; wgid = (xcd < r ? xcd * (q + 1) : r * (q + 1) + (xcd - r) * q) + off; }
        const int nig = WGM * nN, gid = wgid / nig, fm = gid * WGM, gsz = (nM - fm) < WGM ? (nM - fm) : WGM;
        u.pm = fm + ((wgid % nig) % gsz); u.pn = (wgid % nig) / gsz; return true;
    }
    __device__ __forceinline__ void a_ready(const Unit&) const {}
    __device__ __forceinline__ void done(const Unit&) const {}
};


__device__ __forceinline__ unsigned cvt_pk_bf16(float lo, float hi) { unsigned r; asm volatile("v_cvt_pk_bf16_f32 %0, %1, %2" : "=v"(r) : "v"(lo), "v"(hi)); return r; }
typedef float f32x2 __attribute__((ext_vector_type(2)));
__device__ __forceinline__ f32x2 gelu_pk(f32x2 v) {
    const f32x2 av = __builtin_elementwise_abs(v), d = av * 0.2316418882f + 1.0f;
    f32x2 t; t.x = __builtin_amdgcn_rcpf(d.x); t.y = __builtin_amdgcn_rcpf(d.y);
    f32x2 q = t * 0.5307027145f + (-0.7265760135f); q = q * t + 0.7107068705f; q = q * t + (-0.142248368f); q = q * t + 0.127414796f; q = q * t;
    const f32x2 s = (v * v) * (-0.72134752044f);
    f32x2 e; e.x = __builtin_amdgcn_exp2f(s.x); e.y = __builtin_amdgcn_exp2f(s.y);
    const f32x2 m = v * (q * e), r = v - m;
    f32x2 o; o.x = v.x < 0.f ? m.x : r.x; o.y = v.y < 0.f ? m.y : r.y; return o;
}

template <int ACT  > struct EpiBf16 {
    static constexpr bool PERM = true, AFTER_DRAIN = false; static_assert(ACT == 0 || ACT == 1, "EpiBf16: ACT is 0 (none) or 1 (gelu_pk)");
    bf16_t* O; int ldc; const float* bias; int split_cols; size_t split_stride; float scale0;
    __device__ __forceinline__ void operator()(const f32x4 (&acc)[2][2][4][2], const Unit& u, int wr, int wc, int fr, int fq) const {
        const int row0 = u.pm * BM + wr * 64 + fr; int colt = u.pn * BM; bf16_t* base = O;
        float sc = 1.f; if (split_cols) { const int t = colt / split_cols; base += (size_t)t * split_stride; colt -= t * split_cols; if (t == 0) sc = scale0; }
        const int col0 = colt + wc * 32 + 8 * fq, bcol0 = u.pn * BM + wc * 32 + 8 * fq;
        f32x4 bv[2][2];
#pragma unroll
        for (int bj = 0; bj < 2; ++bj)
#pragma unroll
            for (int n = 0; n < 2; ++n) bv[bj][n] = bias ? *(const f32x4*)(bias + bcol0 + bj * HALF + 4 * n) : (f32x4){0.f, 0.f, 0.f, 0.f};
#pragma unroll
        for (int ai = 0; ai < 2; ++ai)
#pragma unroll
            for (int m = 0; m < 4; ++m) { bf16_t* rowp = base + (size_t)(row0 + ai * HALF + m * 16) * ldc + col0;
#pragma unroll
                for (int bj = 0; bj < 2; ++bj) { f32x4 v0 = acc[ai][bj][m][0] + bv[bj][0], v1 = acc[ai][bj][m][1] + bv[bj][1];
                    if (ACT == 1) { f32x2 a = gelu_pk((f32x2){v0[0], v0[1]}), b = gelu_pk((f32x2){v0[2], v0[3]}), c = gelu_pk((f32x2){v1[0], v1[1]}), d = gelu_pk((f32x2){v1[2], v1[3]});
                        v0 = (f32x4){a.x, a.y, b.x, b.y}; v1 = (f32x4){c.x, c.y, d.x, d.y}; }
                    v0 = v0 * sc; v1 = v1 * sc; u32x4 w; w.x = cvt_pk_bf16(v0[0], v0[1]); w.y = cvt_pk_bf16(v0[2], v0[3]); w.z = cvt_pk_bf16(v1[0], v1[1]); w.w = cvt_pk_bf16(v1[2], v1[3]);
                    *(u32x4*)(rowp + bj * HALF) = w; } }
    }
};

struct EpiInProjPg { static constexpr bool PERM = true, AFTER_DRAIN = false;
    bf16_t *z, *xbc, *q, *kvs, *dtg;
    __device__ __forceinline__ void operator()(const f32x4 (&acc)[2][2][4][2], const Unit& u, int wr, int wc, int fr, int fq) const {
        bf16_t* base; int ldc, colt; const int pn = u.pn;
        if (pn < 4) { base = z; ldc = 1024; colt = pn * 256; } else if (pn < 10) { base = xbc; ldc = 1536; colt = (pn - 4) * 256; }
        else if (pn < 14) { base = q; ldc = 1024; colt = (pn - 10) * 256; } else if (pn < 20) { base = kvs; ldc = 1536; colt = (pn - 14) * 256; }
        else { base = dtg; ldc = 64; colt = 0; }
        const int row0 = u.pm * BM + wr * 64 + fr, col0 = colt + wc * 32 + 8 * fq;
#pragma unroll
        for (int ai = 0; ai < 2; ++ai)
#pragma unroll
            for (int m = 0; m < 4; ++m) { bf16_t* rowp = base + (size_t)(row0 + ai * HALF + m * 16) * ldc + col0;
#pragma unroll
                for (int bj = 0; bj < 2; ++bj) { const f32x4 v0 = acc[ai][bj][m][0], v1 = acc[ai][bj][m][1];
                    u32x4 w; w.x = cvt_pk_bf16(v0[0], v0[1]); w.y = cvt_pk_bf16(v0[2], v0[3]); w.z = cvt_pk_bf16(v1[0], v1[1]); w.w = cvt_pk_bf16(v1[2], v1[3]);
                    if (pn < 20 || (bj == 0 && wc < 2)) *(u32x4*)(rowp + bj * HALF) = w; } }
    }
};
struct RmsFactors { const float* ssq; const float* ssq2; float eps;
    __device__ __forceinline__ void get(int row, float& ra, float& r0, float& r1) const {
        ra = rsqrtf(ssq[row] * (1.0f / 1024.0f) + eps); r0 = rsqrtf(ssq2[2 * row] * (1.0f / 512.0f) + eps); r1 = rsqrtf(ssq2[2 * row + 1] * (1.0f / 512.0f) + eps); } };
struct EpiOutProj { static constexpr bool PERM = false, AFTER_DRAIN = false;
    const float* x; float* out; float alpha; RmsFactors rf;
    __device__ __forceinline__ void operator()(const f32x4 (&acc)[2][2][4][2], const Unit& u, int wr, int wc, int fr, int fq) const {
        const int col0 = u.pn * BM + wc * 32 + 4 * fq;
#pragma unroll
        for (int ai = 0; ai < 2; ++ai)
#pragma unroll
            for (int m = 0; m < 4; ++m) { const int row = u.pm * BM + ai * HALF + wr * 64 + m * 16 + fr; const size_t off = (size_t)row * 1024 + col0;
                float ra, r0, r1; rf.get(row, ra, r0, r1);
#pragma unroll
                for (int bj = 0; bj < 2; ++bj)
#pragma unroll
                    for (int n = 0; n < 2; ++n) { const size_t o = off + bj * HALF + n * 16; const f32x4 xv = *(const f32x4*)(x + o); *(f32x4*)(out + o) = xv * alpha + acc[ai][bj][m][n] * r1; } }
    }
};
struct MidRmsScale { static constexpr bool ENABLED = true; RmsFactors rf;
    __device__ __forceinline__ void operator()(f32x4 (&acc)[2][2][4][2], const Unit& u, int t, int wr, int wc, int fr, int fq) const {
        if (t != 16 && t != 24) return;
        int rowb = u.pm * BM + wr * 64 + fr; asm volatile("" : "+v"(rowb));
#pragma unroll
        for (int ai = 0; ai < 2; ++ai)
#pragma unroll
            for (int m = 0; m < 4; ++m) { float ra, r0, r1; rf.get(rowb + ai * HALF + m * 16, ra, r0, r1);
                const float sc = (t == 16) ? ra / r0 : r0 / r1;
#pragma unroll
                for (int bj = 0; bj < 2; ++bj)
#pragma unroll
                    for (int n = 0; n < 2; ++n) acc[ai][bj][m][n] = acc[ai][bj][m][n] * sc; }
    }
};
struct NoMid { static constexpr bool ENABLED = false; template <class ACC> __device__ __forceinline__ void operator()(ACC&, const Unit&, int, int, int, int, int) const {} };
template <class Epi, class Sched, class Mid, bool ALIGN_EPI = false, bool SP2 = false>
__device__ __forceinline__ void gemm_phase(int wv, PG8_LAS unsigned char* lds, const Gemm g, const Sched& S, const Epi& E, const Mid& MH) {
    int lane_ = (int)__builtin_amdgcn_mbcnt_hi(~0u, __builtin_amdgcn_mbcnt_lo(~0u, 0u)); asm volatile("" : "+v"(lane_));
    const int lane = lane_, wid = wv, tid = (wv << 6) | lane, wr = wid >> 2, wc = wid & 3, fr = lane & 15, fq = lane >> 4;
    const int K = g.K, nt = K / BK;
    unsigned voffA[2], voffB[2];
#pragma unroll
    for (int i = 0; i < 2; ++i) { int R, C; stage_rc(tid * 16 + i * 8192, R, C); const int Rb = Epi::PERM ? ((R & ~31) + perm32(R & 31)) : R;
        voffA[i] = g.amode == 0 ? (unsigned)(R * g.lda + C) * 2u : (unsigned)((R >> 2) * 49152 + (R & 3) * 128 + C * 2); voffB[i] = (unsigned)(Rb * K + C) * 2u; }
    const size_t kstep = (size_t)(BK * 2);
    const size_t hstep = (size_t)HALF * K * 2;
    const size_t tstep = 2 * hstep;
    const size_t kstepA = g.amode == 0 ? (size_t)(BK * 2) : (size_t)3072;
    const size_t hstepA = g.amode == 0 ? (size_t)HALF * g.lda * 2 : (size_t)32 * 49152;
    const size_t tstepA = 2 * hstepA;
#define PG8_AK(base, t) ((base) + (size_t)(t) * kstepA + (((t) >= g.ksplit) ? g.kdelta : 0l))
    const unsigned ldsw = (unsigned)wid * 1024u;
    const int aoff = lds_byte(wr * 64 + fr, fq * 8), boff = lds_byte(wc * 32 + fr, fq * 8);
#define PG8_SA(b, h) (((b) * 2 + (h)) * HTB)
#define PG8_SB(b, h) ((4 + (b) * 2 + (h)) * HTB)
#define PG8_STAGE(bufoff, gbase, voff) do { _Pragma("unroll") for (int _i = 0; _i < 2; ++_i) \
        __builtin_amdgcn_global_load_lds((const unsigned*)((const char*)(gbase) + (voff)[_i]), (PG8_LAS unsigned*)(lds + (bufoff) + ldsw + _i * 8192), 16, 0, 0); } while (0)
#define PG8_LDA(dst, b, h) do { _Pragma("unroll") for (int m = 0; m < 4; ++m) _Pragma("unroll") for (int k = 0; k < 2; ++k) dst[m][k] = *(const PG8_LAS bf16x8*)(lds + PG8_SA(b, h) + aoff + m * 2048 + k * 1024); } while (0)
#define PG8_LDB(dst, b, h) do { _Pragma("unroll") for (int n = 0; n < 2; ++n) _Pragma("unroll") for (int k = 0; k < 2; ++k) dst[n][k] = *(const PG8_LAS bf16x8*)(lds + PG8_SB(b, h) + boff + n * 2048 + k * 1024); } while (0)
#define PG8_MMA(ai, bj, At, Bt) do { __builtin_amdgcn_s_setprio(1); _Pragma("unroll") for (int m = 0; m < 4; ++m) _Pragma("unroll") for (int n = 0; n < 2; ++n) _Pragma("unroll") for (int k = 0; k < 2; ++k) \
        acc[ai][bj][m][n] = __builtin_amdgcn_mfma_f32_16x16x32_bf16(Bt[n][k], At[m][k], acc[ai][bj][m][n], 0, 0, 0); __builtin_amdgcn_s_setprio(0); } while (0)
#define PG8_WAIT_V(n) asm volatile("s_waitcnt vmcnt(" #n ")" ::: "memory")
#define PG8_WAIT_L(n) asm volatile("s_waitcnt lgkmcnt(" #n ")" ::: "memory")
#define PG8_BAR __builtin_amdgcn_s_barrier()
#define PG8_SCHED __builtin_amdgcn_sched_barrier(0)
    Unit cur, nxt; int ui = 0;
    if (!S.next(0, cur)) return;
    f32x4 acc[2][2][4][2];
#pragma unroll
    for (int a = 0; a < 2; ++a)
#pragma unroll
        for (int b = 0; b < 2; ++b)
#pragma unroll
            for (int m = 0; m < 4; ++m)
#pragma unroll
                for (int n = 0; n < 2; ++n) acc[a][b][m][n] = (f32x4){0.f, 0.f, 0.f, 0.f};
    bf16x8 At[4][2], B0[2][2], B1[2][2];
    const char* cA = (const char*)g.A + (size_t)cur.pm * tstepA; const char* cB = (const char*)g.Bt + (size_t)cur.pn * tstep;
    S.a_ready(cur);
    if constexpr (SP2) {
        PG8_STAGE(PG8_SB(0, 0), cB, voffB); PG8_STAGE(PG8_SB(0, 1), cB + hstep, voffB); PG8_STAGE(PG8_SA(0, 0), cA, voffA); PG8_STAGE(PG8_SA(0, 1), cA + hstepA, voffA);
        if (wr == 1) PG8_BAR;
        PG8_WAIT_V(2); PG8_BAR;
        PG8_STAGE(PG8_SB(1, 0), cB + kstep, voffB); PG8_STAGE(PG8_SA(1, 0), PG8_AK(cA, 1), voffA); PG8_STAGE(PG8_SB(1, 1), cB + hstep + kstep, voffB);
        PG8_WAIT_V(6); PG8_BAR;
    } else {
        PG8_STAGE(PG8_SB(0, 0), cB, voffB); PG8_STAGE(PG8_SA(0, 0), cA, voffA); PG8_STAGE(PG8_SB(0, 1), cB + hstep, voffB); PG8_STAGE(PG8_SA(0, 1), cA + hstepA, voffA);
        if (wr == 1) PG8_BAR;
        PG8_WAIT_V(4); PG8_BAR;
        PG8_STAGE(PG8_SB(1, 0), cB + kstep, voffB); PG8_STAGE(PG8_SA(1, 0), PG8_AK(cA, 1), voffA); PG8_STAGE(PG8_SB(1, 1), cB + hstep + kstep, voffB);
        PG8_WAIT_V(6); PG8_BAR;
    }
    for (;;) {
        const bool has_next = S.next(ui + 1, nxt);
        const char* nA = has_next ? (const char*)g.A + (size_t)nxt.pm * tstepA : cA; const char* nB = has_next ? (const char*)g.Bt + (size_t)nxt.pn * tstep : cB;
        for (int t = 0; t < nt; t += 2) {
            const bool last = (t == nt - 2);
            if (Mid::ENABLED) MH(acc, cur, t, wr, wc, fr, fq);
            const char* a1 = PG8_AK(cA, t + 1);
            const char* a2 = last ? nA : PG8_AK(cA, t + 2); const char* b2 = last ? nB : cB + (size_t)(t + 2) * kstep;
            const char* a3 = a2 + kstepA; const char* b3 = b2 + kstep;
            if (last && has_next) S.a_ready(nxt);
            if constexpr (SP2) {
            PG8_LDB(B0, 0, 0); PG8_LDB(B1, 0, 1); PG8_SCHED; PG8_LDA(At, 0, 0); PG8_STAGE(PG8_SA(1, 1), a1 + hstepA, voffA);
            PG8_WAIT_V(8); PG8_WAIT_L(0); PG8_BAR; PG8_MMA(0, 0, At, B0); PG8_MMA(0, 1, At, B1); PG8_BAR; PG8_SCHED;
            PG8_LDA(At, 0, 1); PG8_STAGE(PG8_SB(0, 0), b2, voffB); PG8_STAGE(PG8_SB(0, 1), b2 + hstep, voffB); PG8_STAGE(PG8_SA(0, 0), a2, voffA);
            PG8_WAIT_V(8); PG8_WAIT_L(0); PG8_BAR; PG8_MMA(1, 0, At, B0); PG8_MMA(1, 1, At, B1); PG8_BAR; PG8_SCHED;
            PG8_LDB(B0, 1, 0); PG8_LDB(B1, 1, 1); PG8_SCHED; PG8_LDA(At, 1, 0); PG8_STAGE(PG8_SA(0, 1), a2 + hstepA, voffA);
            PG8_WAIT_V(8); PG8_WAIT_L(0); PG8_BAR; PG8_MMA(0, 0, At, B0); PG8_MMA(0, 1, At, B1); PG8_BAR; PG8_SCHED;
            PG8_LDA(At, 1, 1); PG8_STAGE(PG8_SB(1, 0), b3, voffB); PG8_STAGE(PG8_SB(1, 1), b3 + hstep, voffB); PG8_STAGE(PG8_SA(1, 0), a3, voffA);
            PG8_WAIT_V(8); PG8_WAIT_L(0); PG8_BAR; PG8_MMA(1, 0, At, B0); PG8_MMA(1, 1, At, B1); PG8_BAR; PG8_SCHED;
            } else {
            PG8_LDB(B0, 0, 0); PG8_SCHED; PG8_LDA(At, 0, 0); PG8_STAGE(PG8_SA(1, 1), a1 + hstepA, voffA);
            PG8_WAIT_L(8); PG8_BAR; PG8_WAIT_L(0); PG8_MMA(0, 0, At, B0); PG8_BAR; PG8_SCHED;
            PG8_LDB(B1, 0, 1); PG8_STAGE(PG8_SB(0, 0), b2, voffB);
            PG8_BAR; PG8_WAIT_L(0); PG8_MMA(0, 1, At, B1); PG8_BAR;
            PG8_LDA(At, 0, 1); PG8_STAGE(PG8_SA(0, 0), a2, voffA);
            PG8_BAR; PG8_WAIT_L(0); PG8_MMA(1, 0, At, B0); PG8_BAR; PG8_SCHED;
            PG8_STAGE(PG8_SB(0, 1), b2 + hstep, voffB);
            PG8_WAIT_V(6); PG8_BAR; PG8_MMA(1, 1, At, B1); PG8_BAR;
            PG8_LDB(B0, 1, 0); PG8_SCHED; PG8_LDA(At, 1, 0); PG8_STAGE(PG8_SA(0, 1), a2 + hstepA, voffA);
            PG8_WAIT_L(8); PG8_BAR; PG8_WAIT_L(0); PG8_MMA(0, 0, At, B0); PG8_BAR; PG8_SCHED;
            PG8_LDB(B1, 1, 1); PG8_STAGE(PG8_SB(1, 0), b3, voffB);
            PG8_BAR; PG8_WAIT_L(0); PG8_MMA(0, 1, At, B1); PG8_BAR;
            PG8_LDA(At, 1, 1); PG8_STAGE(PG8_SA(1, 0), a3, voffA);
            PG8_BAR; PG8_WAIT_L(0); PG8_MMA(1, 0, At, B0); PG8_BAR; PG8_SCHED;
            PG8_STAGE(PG8_SB(1, 1), b3 + hstep, voffB);
            PG8_WAIT_V(6); PG8_BAR; PG8_MMA(1, 1, At, B1); PG8_BAR;
            }
        }
        if constexpr (ALIGN_EPI) { if (wr == 0) PG8_BAR; }
        if constexpr (!Epi::AFTER_DRAIN) { E(acc, cur, wr, wc, fr, fq); S.done(cur); }
        if (!has_next) break;
#pragma unroll
        for (int a = 0; a < 2; ++a)
#pragma unroll
            for (int b = 0; b < 2; ++b)
#pragma unroll
                for (int m = 0; m < 4; ++m)
#pragma unroll
                    for (int n = 0; n < 2; ++n) acc[a][b][m][n] = (f32x4){0.f, 0.f, 0.f, 0.f};
        cur = nxt; cA = nA; cB = nB; ++ui;
        if constexpr (ALIGN_EPI) { if (wr == 1) PG8_BAR; }
    }
    PG8_WAIT_V(0);
    if constexpr (!ALIGN_EPI) { if (wr == 0) PG8_BAR; }
    PG8_BAR;
    if constexpr (Epi::AFTER_DRAIN) { E.fused(acc, cur, wr, wc, fr, fq, lds, wid, lane); S.done(cur); }
#undef PG8_AK
#undef PG8_SA
#undef PG8_SB
#undef PG8_STAGE
#undef PG8_LDA
#undef PG8_LDB
#undef PG8_MMA
#undef PG8_WAIT_V
#undef PG8_WAIT_L
#undef PG8_BAR
#undef PG8_SCHED
}
}

__device__ __forceinline__ int winmap(int n) { return n < 2560 ? n : (n < 5120 ? n + 16 : (n < 5136 ? 2560 + (n - 5120) : n)); }
__device__ __forceinline__ void ph_prep(const Params& p, int wv) {
    PH_IDS(); unsigned char* ws = p.ws;
    bf16* xb = (bf16*)(ws + OFF_XB);
    for (size_t i = gtid; i < (size_t)T * D / 4; i += gn) { const float4 v = ((const float4*)p.x)[i]; ushort4 o; o.x = f2bf(v.x); o.y = f2bf(v.y); o.z = f2bf(v.z); o.w = f2bf(v.w); ((ushort4*)xb)[i] = o; }
    bf16* winT = (bf16*)(ws + OFF_WIN);
    for (int i = gtid; i < NPROJ_PAD * 1024; i += gn) { const int n = i >> 10, k = i & 1023; winT[i] = n < NPROJ ? f2bf(p.w_in[(size_t)k * NPROJ + winmap(n)]) : (bf16)0; }
    bf16* woutT = (bf16*)(ws + OFF_WOUT);
    for (int i = gtid; i < 1024 * 2048; i += gn) { const int n = i >> 11, kk = i & 2047; const float w = kk < 1024 ? p.w_out[(size_t)(1024 + kk) * 1024 + n] * p.attn_norm_w[kk] : p.w_out[(size_t)(kk - 1024) * 1024 + n] * p.ssd_norm_w[kk - 1024]; woutT[i] = f2bf(w); }
    bf16* wqT = (bf16*)(ws + OFF_WQ);
    for (int i = gtid; i < 2048 * 1024; i += gn) { const int n = i >> 10, k = i & 1023; wqT[i] = f2bf(p.peer_wq[(size_t)k * 2048 + n]); }
    bf16* w1kT = (bf16*)(ws + OFF_W1K); bf16* w1vT = (bf16*)(ws + OFF_W1V);
    for (int i = gtid; i < 256 * 2048; i += gn) { const int n = i >> 11, k = i & 2047; w1kT[i] = f2bf(p.cmp_w1_k[(size_t)k * 256 + n]); w1vT[i] = f2bf(p.cmp_w1_v[(size_t)k * 256 + n]); }
    bf16* w2kT = (bf16*)(ws + OFF_W2K); bf16* w2vT = (bf16*)(ws + OFF_W2V);
    for (int i = gtid; i < 64 * 256; i += gn) { const int n = i >> 8, k = i & 255; w2kT[i] = f2bf(p.cmp_w2_k[(size_t)k * 64 + n]); w2vT[i] = f2bf(p.cmp_w2_v[(size_t)k * 64 + n]); }
    bf16* keys = (bf16*)(ws + OFF_KEYS);
    for (int i = gtid; i < 8 * 2 * 128 * 128; i += gn) keys[i] = f2bf(p.peer_keys[i]);
    float* rc = (float*)(ws + OFF_ROPE); float* rs = rc + 4096 * 32;
    for (int i = gtid; i < 4096 * 32; i += gn) {
        const int pos = i >> 5, j = i & 31;
        const float inv = powf(10000.0f, -(float)(2 * j) / 64.0f); const float angf = (float)pos * inv;
        double xr = (double)angf * 0.15915494309189535; xr -= rint(xr); const double rr = xr * 6.283185307179586, r2 = rr * rr;
        double s = 0.0, c = 0.0, ts = rr, tc = 1.0;
        for (int k = 0; k < 14; ++k) { s += ts; c += tc; tc = -tc * r2 / (double)((2 * k + 1) * (2 * k + 2)); ts = -ts * r2 / (double)((2 * k + 2) * (2 * k + 3)); }
        rc[i] = (float)c; rs[i] = (float)s;
    }
    float* b1k = (float*)(ws + OFF_B1K); float* b1v = (float*)(ws + OFF_B1V);
    for (int o = gwave; o < 512; o += nwaves) {
        const int j = o & 255; const float* pos = o < 256 ? p.cmp_pos_k : p.cmp_pos_v; const float* w1 = o < 256 ? p.cmp_w1_k : p.cmp_w1_v;
        float s = 0.f; for (int k = lane; k < 2048; k += 64) s += pos[k] * w1[(size_t)k * 256 + j];
        s = wave_sum(s); if (lane == 0) (o < 256 ? b1k : b1v)[j] = s;
    }
    float* ssq = (float*)(ws + OFF_SSQ);
    for (int i = gtid; i < 3 * T; i += gn) ssq[i] = 0.f;
}

struct EpiInProj {
    bf16 *z, *xbc, *q, *kvs, *dtg;
    __device__ __forceinline__ void operator()(int row, int c, float v) const {
        const bf16 b = f2bf(v);
        if (c < 1024) z[(size_t)row * 1024 + c] = b;
        else if (c < 2560) xbc[(size_t)row * 1536 + (c - 1024)] = b;
        else if (c < 3584) q[(size_t)row * 1024 + (c - 2560)] = b;
        else if (c < 5120) kvs[(size_t)row * 1536 + (c - 3584)] = b;
        else if (c < 5184) dtg[(size_t)row * 64 + (c - 5120)] = b;
    }
};

__device__ __forceinline__ void ph_tokprep(const Params& p, int wv) {
    PH_IDS(); unsigned char* ws = p.ws;
    const bf16* xbc = (const bf16*)(ws + OFF_XBC); bf16* xsbc = (bf16*)(ws + OFF_XSBC);
    for (size_t i = gtid; i < (size_t)T * 1536; i += gn) {
        const int t = (int)(i / 1536), ch = (int)(i % 1536), l = t & (L - 1);
        float y = p.conv_b[ch];
#pragma unroll
        for (int j = 0; j < 4; ++j) { const int ll = l - 3 + j; if (ll >= 0) y += p.conv_w[j * 1536 + ch] * bf2f(xbc[(size_t)(t - 3 + j) * 1536 + ch]); }
        xsbc[i] = f2bf(y * sigmoidf(y));
    }
    const bf16* dtg = (const bf16*)(ws + OFF_DTG); float* dt = (float*)(ws + OFF_DT); float* gate = (float*)(ws + OFF_GATE);
    for (int i = gtid; i < T * 64; i += gn) {
        const int t = i >> 6, c = i & 63; const float v = bf2f(dtg[i]);
        if (c < 16) { const float xx = v + p.dt_bias[c]; dt[t * 16 + c] = xx > 20.f ? xx : log1pf(__expf(xx)); }
        else gate[t * 48 + (c - 16)] = sigmoidf(v);
    }
    const float* rc = (const float*)(ws + OFF_ROPE); const float* rs = rc + 4096 * 32;
    bf16* q = (bf16*)(ws + OFF_Q); bf16* kvs = (bf16*)(ws + OFF_KVS);
    for (size_t i = gtid; i < (size_t)T * 16 * 32; i += gn) {
        const int j = (int)(i & 31), h = (int)((i >> 5) & 15), t = (int)(i >> 9), l = t & (L - 1);
        const float c = rc[l * 32 + j], s = rs[l * 32 + j];
        bf16* pp = q + (size_t)t * 1024 + h * 64 + j; const float x1 = bf2f(pp[0]), x2 = bf2f(pp[32]);
        pp[0] = f2bf((x1 * c - x2 * s) * 0.125f); pp[32] = f2bf((x1 * s + x2 * c) * 0.125f);
    }
    for (size_t i = gtid; i < (size_t)T * 8 * 32; i += gn) {
        const int j = (int)(i & 31), hh = (int)((i >> 5) & 7), t = (int)(i >> 8), l = t & (L - 1);
        const float c = rc[l * 32 + j], s = rs[l * 32 + j];
        bf16* pp = kvs + (size_t)t * 1536 + (hh < 4 ? 512 + hh * 64 : 1024 + (hh - 4) * 64) + j; const float x1 = bf2f(pp[0]), x2 = bf2f(pp[32]);
        pp[0] = f2bf(x1 * c - x2 * s); pp[32] = f2bf(x1 * s + x2 * c);
    }
}

__device__ __forceinline__ void ph_ssd_prep2(const Params& p, int wv, unsigned char* lds) {
    PH_IDS(); unsigned char* ws = p.ws;
    const bf16* xsbc = (const bf16*)(ws + OFF_XSBC); const float* dt = (const float*)(ws + OFF_DT);
    bf16* XdT = (bf16*)p.out; bf16* BT = (bf16*)(ws + OFF_BT); float* acsT = (float*)(ws + OFF_ACS);
    float* sdt = (float*)lds; float* swave = sdt + 128;
    for (int unit = bid; unit < 2048 + 256; unit += nb) {
        __syncthreads();
        if (unit < 2048) {
            const int h = unit & 15, bc = unit >> 4; const size_t t0 = (size_t)bc * 128;
            const float A = -__expf(p.a_log[h]);
            if (tid < 128) { const float dv = dt[(t0 + tid) * 16 + h]; sdt[tid] = dv; float a = dv * A;
#pragma unroll
                for (int o = 1; o < 64; o <<= 1) { const float v = __shfl_up(a, o); if (lane >= o) a += v; }
                if (lane == 63) swave[tid >> 6] = a;
                sdt[128 + 8 + tid] = a; }
            __syncthreads();
            if (tid < 128) { float a = sdt[128 + 8 + tid]; if (tid >= 64) a += swave[0]; acsT[(size_t)unit * 128 + tid] = a; }
            const int pp = tid & 63, lg = tid >> 6; const bf16* src = xsbc + (t0 + lg * 16) * 1536 + h * 64 + pp;
            unsigned w[8];
#pragma unroll
            for (int i = 0; i < 8; ++i) { const float v0 = bf2f(src[(size_t)(2 * i) * 1536]) * sdt[lg * 16 + 2 * i], v1 = bf2f(src[(size_t)(2 * i + 1) * 1536]) * sdt[lg * 16 + 2 * i + 1]; w[i] = (unsigned)f2bf(v0) | ((unsigned)f2bf(v1) << 16); }
            uint4* dst = (uint4*)(XdT + (size_t)unit * 8192 + pp * 128 + lg * 16);
            dst[0] = make_uint4(w[0], w[1], w[2], w[3]); dst[1] = make_uint4(w[4], w[5], w[6], w[7]);
        } else {
            const int u2 = unit - 2048, g = u2 & 1, bc = u2 >> 1; const size_t t0 = (size_t)bc * 128;
            const int n = tid & 127, lg = tid >> 7; const bf16* src = xsbc + (t0 + lg * 32) * 1536 + 1024 + g * 128 + n;
            uint4* dst = (uint4*)(BT + (size_t)u2 * 16384 + n * 128 + lg * 32);
#pragma unroll
            for (int k = 0; k < 4; ++k) { unsigned w[4];
#pragma unroll
                for (int i = 0; i < 4; ++i) w[i] = (unsigned)src[(size_t)(8 * k + 2 * i) * 1536] | ((unsigned)src[(size_t)(8 * k + 2 * i + 1) * 1536] << 16);
                dst[k] = make_uint4(w[0], w[1], w[2], w[3]); }
        }
    }
}
__device__ __forceinline__ bf16x8 scale_frag(bf16x8 a, const float* s) {
    bf16x8 o;
#pragma unroll
    for (int j = 0; j < 8; ++j) o[j] = (short)f2bf(bf2f((bf16)a[j]) * s[j]);
    return o;
}
__device__ __forceinline__ void ph_ssd_states(const Params& p, int wv) {
    PH_IDS(); unsigned char* ws = p.ws; const int r = lane & 15, q = lane >> 4;
    const bf16* XdT = (const bf16*)p.out; bf16* S = (bf16*)((unsigned char*)p.out + 32 * MiB); const bf16* BT = (const bf16*)(ws + OFF_BT); const float* acsT = (const float*)(ws + OFF_ACS);
    for (int task = gwave; task < 8192; task += nwaves) {
        const int pt = task & 3, unit = task >> 2, h = unit & 15, bc = unit >> 4, g = h >> 3;
        const float* ac = acsT + (size_t)unit * 128; const float alast = ac[127];
        const bf16* xrow = XdT + (size_t)unit * 8192 + (pt * 16 + r) * 128; const bf16* bt = BT + (size_t)(bc * 2 + g) * 16384 + r * 128;
        f32x4 acc[8];
#pragma unroll
        for (int i = 0; i < 8; ++i) acc[i] = (f32x4){0.f, 0.f, 0.f, 0.f};
#pragma unroll
        for (int ks = 0; ks < 4; ++ks) {
            const int l0 = ks * 32 + 8 * q; float dec[8];
#pragma unroll
            for (int j = 0; j < 8; ++j) dec[j] = __expf(alast - ac[l0 + j]);
            const bf16x8 af = scale_frag(*(const bf16x8*)(xrow + l0), dec);
#pragma unroll
            for (int nt = 0; nt < 8; ++nt) acc[nt] = __builtin_amdgcn_mfma_f32_16x16x32_bf16(af, *(const bf16x8*)(bt + (size_t)nt * 2048 + l0), acc[nt], 0, 0, 0);
        }
        bf16* so = S + (size_t)unit * 8192 + (pt * 16 + 4 * q) * 128 + r;
#pragma unroll
        for (int nt = 0; nt < 8; ++nt)
#pragma unroll
            for (int e = 0; e < 4; ++e) so[e * 128 + nt * 16] = f2bf(acc[nt][e]);
    }
}
__device__ __forceinline__ void ph_ssd_scan(const Params& p, int wv) {
    PH_IDS();
    unsigned* S = (unsigned*)((unsigned char*)p.out + 32 * MiB); const float* acsT = (const float*)(p.ws + OFF_ACS);
    for (int e = gtid; e < NBATCH * 16 * 4096; e += gn) {
        const int pn = e & 4095, h = (e >> 12) & 15, b = e >> 16; float r0 = 0.f, r1 = 0.f;
        for (int c = 0; c < 32; c += 4) {
            unsigned v[4]; float d[4];
#pragma unroll
            for (int u = 0; u < 4; ++u) { const int unit = (b * 32 + c + u) * 16 + h; v[u] = S[(size_t)unit * 4096 + pn]; d[u] = __expf(acsT[(size_t)unit * 128 + 127]); }
#pragma unroll
            for (int u = 0; u < 4; ++u) { const int unit = (b * 32 + c + u) * 16 + h; S[(size_t)unit * 4096 + pn] = (unsigned)f2bf(r0) | ((unsigned)f2bf(r1) << 16);
                r0 = r0 * d[u] + bf2f((bf16)(v[u] & 0xffffu)); r1 = r1 * d[u] + bf2f((bf16)(v[u] >> 16)); }
        }
    }
}
__device__ __forceinline__ void ph_ssd_out(const Params& p, int wv) {
    PH_IDS(); unsigned char* ws = p.ws; const int r = lane & 15, q = lane >> 4;
    const bf16* XdT = (const bf16*)p.out; const bf16* S = (const bf16*)((unsigned char*)p.out + 32 * MiB); const bf16* xsbc = (const bf16*)(ws + OFF_XSBC);
    const float* acsT = (const float*)(ws + OFF_ACS); bf16* z = (bf16*)(ws + OFF_Z); float* ssq2 = (float*)(ws + OFF_SSQ) + T;
    for (int task = gwave; task < 16384; task += nwaves) {
        const int lt = 7 - (task & 7), unit = task >> 3, h = unit & 15, bc = unit >> 4, g = h >> 3; const size_t t0 = (size_t)bc * 128;
        const float* ac = acsT + (size_t)unit * 128; const float Dh = p.d_skip[h];
        bf16x8 Cf[4];
#pragma unroll
        for (int ks = 0; ks < 4; ++ks) Cf[ks] = *(const bf16x8*)(xsbc + (t0 + lt * 16 + r) * 1536 + 1280 + g * 128 + ks * 32 + 8 * q);
        const float acl = ac[lt * 16 + r]; const int lrow = lt * 16 + r;
        f32x4 acc[4];
#pragma unroll
        for (int i = 0; i < 4; ++i) acc[i] = (f32x4){0.f, 0.f, 0.f, 0.f};
        const bf16* xd = XdT + (size_t)unit * 8192 + r * 128;
        for (int kk = 0; kk <= (lt >> 1); ++kk) {
            bf16x8 mf;
#pragma unroll
            for (int half = 0; half < 2; ++half) {
                const int st = 2 * kk + half; f32x4 cb = (f32x4){0.f, 0.f, 0.f, 0.f};
                if (st <= lt) {
                    const bf16* brow = xsbc + (t0 + st * 16 + r) * 1536 + 1024 + g * 128 + 8 * q;
#pragma unroll
                    for (int ks = 0; ks < 4; ++ks) cb = __builtin_amdgcn_mfma_f32_16x16x32_bf16(*(const bf16x8*)(brow + ks * 32), Cf[ks], cb, 0, 0, 0);
                    const f32x4 as4 = *(const f32x4*)(ac + st * 16 + 4 * q);
#pragma unroll
                    for (int e = 0; e < 4; ++e) { const int s = st * 16 + 4 * q + e; cb[e] = (lrow >= s) ? cb[e] * __expf(acl - as4[e]) : 0.f; }
                }
#pragma unroll
                for (int e = 0; e < 4; ++e) mf[half * 4 + e] = (short)f2bf(cb[e]);
            }
#pragma unroll
            for (int pt = 0; pt < 4; ++pt) {
                const uint2 lo = *(const uint2*)(xd + (size_t)pt * 2048 + 32 * kk + 4 * q), hi = *(const uint2*)(xd + (size_t)pt * 2048 + 32 * kk + 16 + 4 * q);
                union { uint4 u; bf16x8 v; } xf; xf.u = make_uint4(lo.x, lo.y, hi.x, hi.y);
                acc[pt] = __builtin_amdgcn_mfma_f32_16x16x32_bf16(mf, xf.v, acc[pt], 0, 0, 0);
            }
        }
        f32x4 acc2[4];
#pragma unroll
        for (int i = 0; i < 4; ++i) acc2[i] = (f32x4){0.f, 0.f, 0.f, 0.f};
        const bf16* sin = S + (size_t)unit * 8192 + r * 128 + 8 * q;
#pragma unroll
        for (int ks = 0; ks < 4; ++ks)
#pragma unroll
            for (int pt = 0; pt < 4; ++pt) acc2[pt] = __builtin_amdgcn_mfma_f32_16x16x32_bf16(Cf[ks], *(const bf16x8*)(sin + (size_t)pt * 2048 + ks * 32), acc2[pt], 0, 0, 0);
#pragma unroll
        for (int e = 0; e < 4; ++e) {
            const int l = lt * 16 + 4 * q + e; const size_t t = t0 + l; const float od = __expf(ac[l]); float ss = 0.f;
#pragma unroll
            for (int pt = 0; pt < 4; ++pt) { const int col = h * 64 + pt * 16 + r; const float xv = bf2f(xsbc[t * 1536 + col]);
                const float y = acc[pt][e] + od * acc2[pt][e] + Dh * xv; const float zz = bf2f(z[t * 1024 + col]); const float v = y * (zz * sigmoidf(zz));
                z[t * 1024 + col] = f2bf(v); ss += v * v; }
            ss += __shfl_xor(ss, 1); ss += __shfl_xor(ss, 2); ss += __shfl_xor(ss, 4); ss += __shfl_xor(ss, 8);
            if (r == 0) atomicAdd(&ssq2[t * 2 + g], ss);
        }
    }
}

struct ACmp {
    const bf16* kvs; int coff;
    __device__ __forceinline__ bf16x8 operator()(int m, int k) const {
        const int hk = m & 3, n = (m >> 2) & 255, b = m >> 10, l = k >> 6, d = k & 63;
        if (n == 255) return (bf16x8){0, 0, 0, 0, 0, 0, 0, 0};
        return *(const bf16x8*)(kvs + (size_t)(b * L + 16 * n + l) * 1536 + coff + hk * 64 + d);
    }
};
struct EpiHid { bf16* hid; const float* bias; __device__ __forceinline__ void operator()(int row, int c, float v) const { hid[(size_t)row * 256 + c] = f2bf(gelu_exact(v + bias[c])); } };
struct EpiKc {
    bf16* dst; bool tr; __device__ __forceinline__ void operator()(int m, int c, float v) const { const int hk = m & 3, n = (m >> 2) & 255, b = m >> 10; const bf16 o = (n == 255) ? (bf16)0 : f2bf(v);
        if (tr) dst[((size_t)(b * 4 + hk) * 64 + c) * 256 + n] = o; else dst[((size_t)(b * 4 + hk) * 256 + n) * 64 + c] = o; } };
__device__ __forceinline__ void ph_kc_rope(const Params& p, int wv) {
    PH_IDS(); unsigned char* ws = p.ws; bf16* kc = (bf16*)(ws + OFF_KC); const float* rc = (const float*)(ws + OFF_ROPE); const float* rs = rc + 4096 * 32;
    for (int i = gtid; i < 16 * 256 * 32; i += gn) {
        const int j = i & 31, n = (i >> 5) & 255, bh = i >> 13; const int pos = 16 * n + 31; if (n == 255) continue;
        const float c = rc[pos * 32 + j], s = rs[pos * 32 + j];
        bf16* pp = kc + ((size_t)bh * 256 + n) * 64 + j; const float x1 = bf2f(pp[0]), x2 = bf2f(pp[32]);
        pp[0] = f2bf(x1 * c - x2 * s); pp[32] = f2bf(x1 * s + x2 * c);
    }
}


__device__ __forceinline__ void ph_vt_prep(const Params& p, int wv) {
    PH_IDS(); unsigned char* ws = p.ws; const bf16* kvs = (const bf16*)(ws + OFF_KVS);
    for (int unit = bid; unit < 2 * 16 * 64; unit += nb) {
        const int br = unit & 1, tl = (unit >> 1) & 63, bh = unit >> 7, b = bh >> 2, hk = bh & 3;
        const int d = tid & 63, grp = tid >> 6; const int l0 = tl * 64 + grp * 8;
        const bf16* src = kvs + ((size_t)b * L + l0) * 1536 + (br ? 1280 : 768) + hk * 64 + d;
        unsigned w[4];
#pragma unroll
        for (int i = 0; i < 4; ++i) w[i] = (unsigned)src[(size_t)(2 * i) * 1536] | ((unsigned)src[(size_t)(2 * i + 1) * 1536] << 16);
        bf16* dst = (bf16*)(ws + (br ? OFF_VWT : OFF_VST)) + ((size_t)bh * 64 + d) * L + l0;
        *(uint4*)dst = make_uint4(w[0], w[1], w[2], w[3]);
    }
}

typedef float f32x16 __attribute__((ext_vector_type(16)));
typedef float f32x2v __attribute__((ext_vector_type(2)));
typedef __bf16 bf16x2v __attribute__((ext_vector_type(2)));
__device__ __forceinline__ unsigned pk2bf(float lo, float hi) { f32x2v v = {lo, hi}; bf16x2v b = __builtin_convertvector(v, bf16x2v); return __builtin_bit_cast(unsigned, b); }
__device__ __forceinline__ int crow(int r, int hi) { return (r & 3) + 8 * (r >> 2) + 4 * hi; }
constexpr int NSA_KROW = 144, NSA_VROW = 136, NSA_KBUF = 64 * NSA_KROW, NSA_VBUF = 64 * NSA_VROW;
constexpr int NSA_OFF_K = 0, NSA_OFF_V = 2 * NSA_KBUF, NSA_OFF_IMPA = NSA_OFF_V + 2 * NSA_VBUF, NSA_IMPS = 65, NSA_OFF_IMPB = NSA_OFF_IMPA + 64 * NSA_IMPS * 4, NSA_OFF_SEL = NSA_OFF_IMPB + 64 * NSA_IMPS * 4;
struct NsaSrc { const bf16* K; size_t kstride; const bf16* VT; size_t ldv; };
__device__ __forceinline__ void nsa_gload(const NsaSrc& s, int k0, int tid, uint4& kr, uint4& vr) {
    const int row = tid >> 3, ch = tid & 7;
    kr = *(const uint4*)(s.K + (size_t)(k0 + row) * s.kstride + ch * 8);
    vr = *(const uint4*)(s.VT + (size_t)row * s.ldv + k0 + ch * 8);
}
__device__ __forceinline__ void nsa_lstore(unsigned char* kb, unsigned char* vb, int tid, const uint4& kr, const uint4& vr) {
    const int row = tid >> 3, ch = tid & 7;
    *(uint4*)(kb + row * NSA_KROW + ch * 16) = kr;
    uint2* vp = (uint2*)(vb + row * NSA_VROW + ch * 16); vp[0] = make_uint2(vr.x, vr.y); vp[1] = make_uint2(vr.z, vr.w);
}
__device__ __forceinline__ void nsa_qk(const unsigned char* kb, const bf16x8 (&qf)[4], int rr, int hi, f32x16& p0, f32x16& p1) {
#pragma unroll
    for (int i = 0; i < 16; ++i) { p0[i] = 0.f; p1[i] = 0.f; }
#pragma unroll
    for (int ds = 0; ds < 4; ++ds) {
        const bf16x8 a0 = *(const bf16x8*)(kb + rr * NSA_KROW + ds * 32 + hi * 16), a1 = *(const bf16x8*)(kb + (rr + 32) * NSA_KROW + ds * 32 + hi * 16);
        p0 = __builtin_amdgcn_mfma_f32_32x32x16_bf16(a0, qf[ds], p0, 0, 0, 0); p1 = __builtin_amdgcn_mfma_f32_32x32x16_bf16(a1, qf[ds], p1, 0, 0, 0);
    }
}
__device__ __forceinline__ void nsa_pv(const unsigned char* vb, int rr, int hi, const f32x16& p0, const f32x16& p1, f32x16 (&O)[2]) {
#pragma unroll
    for (int s = 0; s < 4; ++s) {
        const int eb = 8 * (s & 1), kbase = 32 * (s >> 1) + 16 * (s & 1);
        union { uint4 u; bf16x8 v; } pf;
        if (s < 2) pf.u = make_uint4(pk2bf(p0[eb], p0[eb + 1]), pk2bf(p0[eb + 2], p0[eb + 3]), pk2bf(p0[eb + 4], p0[eb + 5]), pk2bf(p0[eb + 6], p0[eb + 7]));
        else       pf.u = make_uint4(pk2bf(p1[eb], p1[eb + 1]), pk2bf(p1[eb + 2], p1[eb + 3]), pk2bf(p1[eb + 4], p1[eb + 5]), pk2bf(p1[eb + 6], p1[eb + 7]));
#pragma unroll
        for (int dsub = 0; dsub < 2; ++dsub) {
            const unsigned char* vp = vb + (dsub * 32 + rr) * NSA_VROW + (kbase + 4 * hi) * 2;
            const uint2 lo = *(const uint2*)vp, hh = *(const uint2*)(vp + 16);
            union { uint4 u; bf16x8 v; } vf; vf.u = make_uint4(lo.x, lo.y, hh.x, hh.y);
            O[dsub] = __builtin_amdgcn_mfma_f32_32x32x16_bf16(vf.v, pf.v, O[dsub], 0, 0, 0);
        }
    }
}
template <int MODE>
__device__ __forceinline__ void nsa_branch(unsigned char* lds, const NsaSrc& src, int jt0, int jt1, int tid, int rr, int hi, const bf16x8 (&qf)[4], int lpos, int qi, int tokblk,
                                           u64 selm, u64 wsel, float& m, float& lsum, float inv_l, f32x16 (&O)[2]) {
    if (jt0 >= jt1) return;
    asm volatile("" : "+v"(tid), "+v"(rr));
    float* impA = (float*)(lds + NSA_OFF_IMPA); float* impB = (float*)(lds + NSA_OFF_IMPB);
    uint4 kr, vr;
    nsa_gload(src, jt0 * 64, tid, kr, vr);
    nsa_lstore(lds + NSA_OFF_K, lds + NSA_OFF_V, tid, kr, vr);
    __syncthreads();
    for (int jt = jt0; jt < jt1; ++jt) {
        const int cur = (jt - jt0) & 1; const bool more = (jt + 1 < jt1);
        if (more) nsa_gload(src, (jt + 1) * 64, tid, kr, vr);
        const unsigned char* kb = lds + NSA_OFF_K + cur * NSA_KBUF; const unsigned char* vb = lds + NSA_OFF_V + cur * NSA_VBUF;
        const bool active = (MODE != 2) || ((wsel >> jt) & 1ull);
        if (active) {
            f32x16 p0, p1; nsa_qk(kb, qf, rr, hi, p0, p1);
            const int k0 = jt * 64;
            const bool tile_on = (MODE != 2) || ((selm >> jt) & 1ull);
            float mx = NEG_INF;
#pragma unroll
            for (int e = 0; e < 16; ++e) {
                const int ka = k0 + crow(e, hi), kb2 = ka + 32; bool oa, ob;
                if (MODE <= 1) { oa = (16 * ka + 31 <= lpos); ob = (16 * kb2 + 31 <= lpos); }
                else if (MODE == 2) { oa = tile_on && (ka <= lpos); ob = tile_on && (kb2 <= lpos); }
                else { oa = (ka <= lpos) && (ka > lpos - 512); ob = (kb2 <= lpos) && (kb2 > lpos - 512); }
                p0[e] = oa ? p0[e] : NEG_INF; p1[e] = ob ? p1[e] : NEG_INF; mx = fmaxf(mx, fmaxf(p0[e], p1[e]));
            }
            if (MODE != 1) {
                mx = fmaxf(mx, __shfl_xor(mx, 32));
                const float mnew = fmaxf(m, mx), alpha = __expf(m - mnew); m = mnew; float rs = 0.f;
#pragma unroll
                for (int e = 0; e < 16; ++e) { p0[e] = (p0[e] > 0.5f * NEG_INF) ? __expf(p0[e] - mnew) : 0.f; p1[e] = (p1[e] > 0.5f * NEG_INF) ? __expf(p1[e] - mnew) : 0.f; rs += p0[e] + p1[e]; }
                lsum = lsum * alpha + rs;
                if (MODE != 0) {
#pragma unroll
                    for (int e = 0; e < 16; ++e) { O[0][e] *= alpha; O[1][e] *= alpha; }
                    nsa_pv(vb, rr, hi, p0, p1, O);
                }
            } else {
#pragma unroll
                for (int e = 0; e < 16; ++e) { p0[e] = (p0[e] > 0.5f * NEG_INF) ? __expf(p0[e] - m) * inv_l : 0.f; p1[e] = (p1[e] > 0.5f * NEG_INF) ? __expf(p1[e] - m) * inv_l : 0.f; }
                nsa_pv(vb, rr, hi, p0, p1, O);
#pragma unroll
                for (int sub = 0; sub < 2; ++sub)
#pragma unroll
                    for (int a = 0; a < 4; ++a) {
                        float G, last;
                        if (sub == 0) { G = (p0[4 * a] + p0[4 * a + 1]) + (p0[4 * a + 2] + p0[4 * a + 3]); last = p0[4 * a + 3]; } else { G = (p1[4 * a] + p1[4 * a + 1]) + (p1[4 * a + 2] + p1[4 * a + 3]); last = p1[4 * a + 3]; }
                        G += __shfl_xor(G, 1); G += __shfl_xor(G, 2); last += __shfl_xor(last, 1); last += __shfl_xor(last, 2);
                        const int jj = (k0 >> 2) + 8 * sub + 2 * a + hi;
                        if ((rr & 3) == 0) { impA[tokblk * NSA_IMPS + jj] = G; if (jj + 1 < 64) impB[tokblk * NSA_IMPS + jj + 1] = last; }
                    }
            }
        }
        if (more) nsa_lstore(lds + NSA_OFF_K + (cur ^ 1) * NSA_KBUF, lds + NSA_OFF_V + (cur ^ 1) * NSA_VBUF, tid, kr, vr);
        __syncthreads();
    }
}
__device__ __forceinline__ void ph_nsa(const Params& p, int wv, unsigned char* lds) {
    PH_IDS(); unsigned char* ws = p.ws; const int wave = wv, rr = lane & 31, hi = lane >> 5;
    bf16* q = (bf16*)(ws + OFF_Q); const bf16* kvs = (const bf16*)(ws + OFF_KVS);
    const float* gate = (const float*)(ws + OFF_GATE); float* ssq = (float*)(ws + OFF_SSQ);
    float* impA = (float*)(lds + NSA_OFF_IMPA); float* impB = (float*)(lds + NSA_OFF_IMPB); u64* selw = (u64*)(lds + NSA_OFF_SEL);
    const int nunits = 1024;
    for (int it = 0; ; ++it) {
        int bh, qi;
        if (nb == 256) { if (it >= 4) break; bh = bid & 15; const int x = bid >> 4; qi = (it == 0) ? 63 - x : (it == 1) ? 32 + x : (it == 2) ? 31 - x : x; }
        else { const int u = bid + it * nb; if (u >= nunits) break; bh = u & 15; qi = 63 - (u >> 4); }
        const int b = bh >> 2, hk = bh & 3; const int tokblk = wave * 8 + (rr >> 2), g = rr & 3; const int lpos = qi * 64 + tokblk; const size_t t = (size_t)b * L + lpos;
        bf16* qrow = q + t * 1024 + (hk * 4 + g) * 64;
        bf16x8 qf[4];
#pragma unroll
        for (int ds = 0; ds < 4; ++ds) qf[ds] = *(const bf16x8*)(qrow + ds * 16 + hi * 8);
        for (int i = tid; i < 64 * NSA_IMPS; i += NTHREADS) { impA[i] = 0.f; impB[i] = 0.f; }
        __syncthreads();
        f32x16 outacc[2]; f32x16 O[2];
#pragma unroll
        for (int e = 0; e < 16; ++e) { outacc[0][e] = 0.f; outacc[1][e] = 0.f; }
        const float g0 = gate[t * 48 + (hk * 4 + g) * 3 + 0], g1 = gate[t * 48 + (hk * 4 + g) * 3 + 1], g2 = gate[t * 48 + (hk * 4 + g) * 3 + 2];
        {
            NsaSrc s{(const bf16*)(ws + OFF_KC) + (size_t)bh * 256 * 64, 64, (const bf16*)(ws + OFF_VCT) + (size_t)bh * 64 * 256, 256};
            const int nct = (4 * qi + 3 + 63) >> 6;
            float m = NEG_INF, lsum = 0.f;
            nsa_branch<0>(lds, s, 0, nct, tid, rr, hi, qf, lpos, qi, tokblk, 0ull, 0ull, m, lsum, 0.f, O);
            lsum += __shfl_xor(lsum, 32);
            const float inv_l = lsum > 0.f ? 1.0f / lsum : 0.f;
#pragma unroll
            for (int e = 0; e < 16; ++e) { O[0][e] = 0.f; O[1][e] = 0.f; }
            nsa_branch<1>(lds, s, 0, nct, tid, rr, hi, qf, lpos, qi, tokblk, 0ull, 0ull, m, lsum, inv_l, O);
#pragma unroll
            for (int e = 0; e < 16; ++e) { outacc[0][e] += g0 * O[0][e]; outacc[1][e] += g0 * O[1][e]; }
        }
        {
            const int tk = tid >> 3, jg = tid & 7; float v[8];
#pragma unroll
            for (int i = 0; i < 8; ++i) { const int j = jg * 8 + i; const float raw = impA[tk * NSA_IMPS + j] + impB[tk * NSA_IMPS + j];
                const bool causal = (j <= qi), forced = (j == 0) || (j == qi) || (j == qi - 1); v[i] = causal ? (forced ? BIG : raw) : NEG_INF; }
            __syncthreads();
#pragma unroll
            for (int i = 0; i < 8; ++i) impA[tk * NSA_IMPS + jg * 8 + i] = v[i];
            __syncthreads();
            int rank[8];
#pragma unroll
            for (int i = 0; i < 8; ++i) rank[i] = 0;
            for (int jj = 0; jj < 64; ++jj) { const float x = impA[tk * NSA_IMPS + jj];
#pragma unroll
                for (int i = 0; i < 8; ++i) rank[i] += (x > v[i] || (x == v[i] && jj < jg * 8 + i)) ? 1 : 0; }
            unsigned b8 = 0u;
#pragma unroll
            for (int i = 0; i < 8; ++i) b8 |= (rank[i] < 16 && jg * 8 + i <= qi) ? (1u << i) : 0u;
            const u64 full = (u64)b8 << (jg * 8); unsigned blo = (unsigned)full, bhi = (unsigned)(full >> 32);
            blo |= __shfl_xor(blo, 1); bhi |= __shfl_xor(bhi, 1); blo |= __shfl_xor(blo, 2); bhi |= __shfl_xor(bhi, 2); blo |= __shfl_xor(blo, 4); bhi |= __shfl_xor(bhi, 4);
            if (jg == 0) selw[tk] = (u64)blo | ((u64)bhi << 32);
            __syncthreads();
        }
        const u64 selm = selw[tokblk];
        u64 wsel = selm;
        { unsigned lo = (unsigned)wsel, h2 = (unsigned)(wsel >> 32);
          lo |= __shfl_xor(lo, 4); h2 |= __shfl_xor(h2, 4); lo |= __shfl_xor(lo, 8); h2 |= __shfl_xor(h2, 8); lo |= __shfl_xor(lo, 16); h2 |= __shfl_xor(h2, 16);
          wsel = (u64)lo | ((u64)h2 << 32); }
        {
            NsaSrc s{kvs + (size_t)b * L * 1536 + 512 + hk * 64, 1536, (const bf16*)(ws + OFF_VST) + (size_t)bh * 64 * L, (size_t)L};
            float m = NEG_INF, lsum = 0.f;
#pragma unroll
            for (int e = 0; e < 16; ++e) { O[0][e] = 0.f; O[1][e] = 0.f; }
            nsa_branch<2>(lds, s, 0, qi + 1, tid, rr, hi, qf, lpos, qi, tokblk, selm, wsel, m, lsum, 0.f, O);
            lsum += __shfl_xor(lsum, 32); const float sc = g1 / lsum;
#pragma unroll
            for (int e = 0; e < 16; ++e) { outacc[0][e] += sc * O[0][e]; outacc[1][e] += sc * O[1][e]; }
        }
        {
            NsaSrc s{kvs + (size_t)b * L * 1536 + 1024 + hk * 64, 1536, (const bf16*)(ws + OFF_VWT) + (size_t)bh * 64 * L, (size_t)L};
            float m = NEG_INF, lsum = 0.f;
#pragma unroll
            for (int e = 0; e < 16; ++e) { O[0][e] = 0.f; O[1][e] = 0.f; }
            nsa_branch<3>(lds, s, qi >= 8 ? qi - 8 : 0, qi + 1, tid, rr, hi, qf, lpos, qi, tokblk, 0ull, 0ull, m, lsum, 0.f, O);
            lsum += __shfl_xor(lsum, 32); const float sc = g2 / lsum;
#pragma unroll
            for (int e = 0; e < 16; ++e) { outacc[0][e] += sc * O[0][e]; outacc[1][e] += sc * O[1][e]; }
        }
        float ss = 0.f;
#pragma unroll
        for (int dsub = 0; dsub < 2; ++dsub)
#pragma unroll
            for (int a = 0; a < 4; ++a) {
                const float v0 = outacc[dsub][4 * a], v1 = outacc[dsub][4 * a + 1], v2 = outacc[dsub][4 * a + 2], v3 = outacc[dsub][4 * a + 3];
                ss += (v0 * v0 + v1 * v1) + (v2 * v2 + v3 * v3);
                *(uint2*)(qrow + dsub * 32 + 8 * a + 4 * hi) = make_uint2(pk2bf(v0, v1), pk2bf(v2, v3));
            }
        ss += __shfl_xor(ss, 32); ss += __shfl_xor(ss, 1); ss += __shfl_xor(ss, 2);
        if (hi == 0 && g == 0) atomicAdd(&ssq[t], ss);
        __syncthreads();
    }
}

__device__ __forceinline__ void ph_nsa_naive(const Params& p, int wv, unsigned char* lds) {
    PH_IDS(); unsigned char* ws = p.ws; const int wave = wv;
    float* qs = (float*)(lds + wave * 17408); float* sbuf = qs + 256;
    bf16* q = (bf16*)(ws + OFF_Q); const bf16* kvs = (const bf16*)(ws + OFF_KVS);
    const bf16* kc = (const bf16*)(ws + OFF_KC); const bf16* vc = (const bf16*)(ws + OFF_VC);
    const float* gate = (const float*)(ws + OFF_GATE); float* ssq = (float*)(ws + OFF_SSQ);
    for (int task = gwave; task < T * 4; task += nwaves) {
        const int hk = task & 3, t = task >> 2, b = t >> 12, l = t & (L - 1), tb = l >> 6;
        bf16* qrow = q + (size_t)t * 1024 + hk * 256;
        __builtin_amdgcn_s_waitcnt(0);
#pragma unroll
        for (int g = 0; g < 4; ++g) qs[g * 64 + lane] = bf2f(qrow[g * 64 + lane]);
        float outv[4] = {0.f, 0.f, 0.f, 0.f};
        const bf16* kcb = kc + (size_t)(b * 4 + hk) * 256 * 64; const bf16* vcb = vc + (size_t)(b * 4 + hk) * 256 * 64;
        float m4[4] = {NEG_INF, NEG_INF, NEG_INF, NEG_INF};
#pragma unroll 1
        for (int c = 0; c < 4; ++c) {
            const int n = c * 64 + lane; const bool valid = (n < 255) && (16 * n + 31 <= l);
            float s[4] = {0.f, 0.f, 0.f, 0.f};
            const bf16* kr = kcb + (size_t)n * 64;
#pragma unroll 4
            for (int d = 0; d < 64; ++d) { const float kv = bf2f(kr[d]);
#pragma unroll
                for (int g = 0; g < 4; ++g) s[g] += qs[g * 64 + d] * kv; }
#pragma unroll
            for (int g = 0; g < 4; ++g) { const float sv = valid ? s[g] : NEG_INF; sbuf[g * 1024 + n] = sv; m4[g] = fmaxf(m4[g], sv); }
        }
        const bool anyvalid = (l >= 31);
        float sum4[4];
#pragma unroll
        for (int g = 0; g < 4; ++g) { m4[g] = wave_max(m4[g]); sum4[g] = 0.f; }
#pragma unroll 1
        for (int c = 0; c < 4; ++c) { const int n = c * 64 + lane;
#pragma unroll
            for (int g = 0; g < 4; ++g) { const float sv = sbuf[g * 1024 + n]; const float e = (sv > 0.5f * NEG_INF) ? __expf(sv - m4[g]) : 0.f; sbuf[g * 1024 + n] = e; sum4[g] += e; } }
#pragma unroll
        for (int g = 0; g < 4; ++g) { sum4[g] = wave_sum(sum4[g]); sum4[g] = anyvalid ? 1.0f / sum4[g] : 0.f; }
#pragma unroll 1
        for (int c = 0; c < 4; ++c) { const int n = c * 64 + lane;
#pragma unroll
            for (int g = 0; g < 4; ++g) sbuf[g * 1024 + n] *= sum4[g]; }
        __builtin_amdgcn_s_waitcnt(0);
        float imp = 0.f;
        { const int j = lane;
          for (int n = 4 * j - 1; n <= 4 * j + 3; ++n) if (n >= 0 && n < 255) { imp += sbuf[n] + sbuf[1024 + n] + sbuf[2048 + n] + sbuf[3072 + n]; }
          const bool causal = (j <= tb), forced = (j == 0) || (j == tb) || (j == tb - 1);
          imp = causal ? (forced ? BIG : imp) : NEG_INF; }
        int rank = 0;
#pragma unroll 1
        for (int jj = 0; jj < 64; ++jj) { const float v = __shfl(imp, jj); rank += (v > imp || (v == imp && jj < lane)) ? 1 : 0; }
        const bool sel = (rank < 16) && (lane <= tb);
        const u64 selmask = __ballot(sel);
        { float oc[4] = {0.f, 0.f, 0.f, 0.f};
          if (anyvalid) { const int nmax = (l - 31) / 16;
            for (int n = 0; n <= nmax; ++n) { const float vv = bf2f(vcb[(size_t)n * 64 + lane]);
#pragma unroll
                for (int g = 0; g < 4; ++g) oc[g] += sbuf[g * 1024 + n] * vv; } }
#pragma unroll
          for (int g = 0; g < 4; ++g) outv[g] += gate[(size_t)t * 48 + (hk * 4 + g) * 3 + 0] * oc[g]; }
        __builtin_amdgcn_s_waitcnt(0);
        {
            const bf16* ksb = kvs + (size_t)b * L * 1536 + 512 + hk * 64; const bf16* vsb = kvs + (size_t)b * L * 1536 + 768 + hk * 64;
            float mx[4] = {NEG_INF, NEG_INF, NEG_INF, NEG_INF}; int cnt = 0;
            for (u64 mm = selmask; mm; mm &= mm - 1, ++cnt) {
                const int j = __builtin_ctzll(mm); const int kp = j * 64 + lane; const bool ok = kp <= l;
                const bf16* kr = ksb + (size_t)kp * 1536; float s[4] = {0.f, 0.f, 0.f, 0.f};
#pragma unroll 4
                for (int d = 0; d < 64; ++d) { const float kv = bf2f(kr[d]);
#pragma unroll
                    for (int g = 0; g < 4; ++g) s[g] += qs[g * 64 + d] * kv; }
#pragma unroll
                for (int g = 0; g < 4; ++g) { const float sv = ok ? s[g] : NEG_INF; sbuf[g * 1024 + cnt * 64 + lane] = sv; mx[g] = fmaxf(mx[g], sv); }
            }
            float sm[4];
#pragma unroll
            for (int g = 0; g < 4; ++g) { mx[g] = wave_max(mx[g]); sm[g] = 0.f; }
            for (int c = 0; c < cnt; ++c)
#pragma unroll
                for (int g = 0; g < 4; ++g) { const float sv = sbuf[g * 1024 + c * 64 + lane]; const float e = (sv > 0.5f * NEG_INF) ? __expf(sv - mx[g]) : 0.f; sbuf[g * 1024 + c * 64 + lane] = e; sm[g] += e; }
#pragma unroll
            for (int g = 0; g < 4; ++g) sm[g] = 1.0f / wave_sum(sm[g]);
            __builtin_amdgcn_s_waitcnt(0);
            float os[4] = {0.f, 0.f, 0.f, 0.f}; int c = 0;
            for (u64 mm = selmask; mm; mm &= mm - 1, ++c) {
                const int j = __builtin_ctzll(mm); const int kmax = min(63, l - j * 64);
                for (int kk = 0; kk <= kmax; ++kk) { const float vv = bf2f(vsb[(size_t)(j * 64 + kk) * 1536 + lane]);
#pragma unroll
                    for (int g = 0; g < 4; ++g) os[g] += sbuf[g * 1024 + c * 64 + kk] * vv; }
            }
#pragma unroll
            for (int g = 0; g < 4; ++g) outv[g] += gate[(size_t)t * 48 + (hk * 4 + g) * 3 + 1] * os[g] * sm[g];
        }
        __builtin_amdgcn_s_waitcnt(0);
        {
            const bf16* kwb = kvs + (size_t)b * L * 1536 + 1024 + hk * 64; const bf16* vwb = kvs + (size_t)b * L * 1536 + 1280 + hk * 64;
            const int k0 = l - 511; float mx[4] = {NEG_INF, NEG_INF, NEG_INF, NEG_INF};
#pragma unroll 1
            for (int c = 0; c < 8; ++c) {
                const int kp = k0 + c * 64 + lane; const bool ok = kp >= 0; float s[4] = {0.f, 0.f, 0.f, 0.f};
                if (ok) { const bf16* kr = kwb + (size_t)kp * 1536;
#pragma unroll 4
                    for (int d = 0; d < 64; ++d) { const float kv = bf2f(kr[d]);
#pragma unroll
                        for (int g = 0; g < 4; ++g) s[g] += qs[g * 64 + d] * kv; } }
#pragma unroll
                for (int g = 0; g < 4; ++g) { const float sv = ok ? s[g] : NEG_INF; sbuf[g * 1024 + c * 64 + lane] = sv; mx[g] = fmaxf(mx[g], sv); }
            }
            float sm[4];
#pragma unroll
            for (int g = 0; g < 4; ++g) { mx[g] = wave_max(mx[g]); sm[g] = 0.f; }
#pragma unroll 1
            for (int c = 0; c < 8; ++c)
#pragma unroll
                for (int g = 0; g < 4; ++g) { const float sv = sbuf[g * 1024 + c * 64 + lane]; const float e = (sv > 0.5f * NEG_INF) ? __expf(sv - mx[g]) : 0.f; sbuf[g * 1024 + c * 64 + lane] = e; sm[g] += e; }
#pragma unroll
            for (int g = 0; g < 4; ++g) sm[g] = 1.0f / wave_sum(sm[g]);
            __builtin_amdgcn_s_waitcnt(0);
            float ow[4] = {0.f, 0.f, 0.f, 0.f};
            for (int i = (k0 < 0 ? -k0 : 0); i < 512; ++i) { const float vv = bf2f(vwb[(size_t)(k0 + i) * 1536 + lane]);
#pragma unroll
                for (int g = 0; g < 4; ++g) ow[g] += sbuf[g * 1024 + i] * vv; }
#pragma unroll
            for (int g = 0; g < 4; ++g) outv[g] += gate[(size_t)t * 48 + (hk * 4 + g) * 3 + 2] * ow[g] * sm[g];
        }
        float ss = 0.f;
#pragma unroll
        for (int g = 0; g < 4; ++g) { qrow[g * 64 + lane] = f2bf(outv[g]); ss += outv[g] * outv[g]; }
        ss = wave_sum(ss); if (lane == 0) atomicAdd(&ssq[t], ss);
    }
}

__device__ __forceinline__ void ph_ln1(const Params& p, int wv) {
    PH_IDS(); unsigned char* ws = p.ws; bf16* h1b = (bf16*)(ws + OFF_H1B);
    for (int t = gwave; t < T; t += nwaves) {
        float v[16]; float s = 0.f; float* row = p.out + (size_t)t * 1024;
#pragma unroll
        for (int i = 0; i < 16; ++i) { v[i] = row[i * 64 + lane]; s += v[i]; }
        const float mu = wave_sum(s) * (1.0f / 1024.0f); float s2 = 0.f;
#pragma unroll
        for (int i = 0; i < 16; ++i) { v[i] -= mu; s2 += v[i] * v[i]; }
        const float rstd = rsqrtf(wave_sum(s2) * (1.0f / 1024.0f) + LN_EPS);
#pragma unroll
        for (int i = 0; i < 16; ++i) { const int c = i * 64 + lane; const float o = v[i] * rstd * p.ln1_g[c] + p.ln1_b[c]; row[c] = o; h1b[(size_t)t * 1024 + c] = f2bf(o); }
    }
}

__device__ __forceinline__ void ph_peer_topk(const Params& p, int wv, unsigned char* lds) {
    PH_IDS(); unsigned char* ws = p.ws; const int wave = wv;
    float* qv = (float*)(lds + wave * 4608); float* sv = qv + 256; float* stop = sv + 256; int* itop = (int*)(stop + 32); float* cand = (float*)(itop + 32); int* cidx = (int*)(cand + 256);
    const bf16* qp = (const bf16*)(ws + OFF_QP); const bf16* keys = (const bf16*)(ws + OFF_KEYS);
    int* eidx = (int*)(ws + OFF_EIDX); float* gw = (float*)(ws + OFF_GW);
    for (int task = gwave; task < T * 8; task += nwaves) {
        const int h = task & 7, t = task >> 3;
        __builtin_amdgcn_s_waitcnt(0);
#pragma unroll
        for (int i = 0; i < 4; ++i) qv[i * 64 + lane] = bf2f(qp[(size_t)t * 2048 + h * 256 + i * 64 + lane]);
        __builtin_amdgcn_s_waitcnt(0);
        float sc[4];
#pragma unroll
        for (int i = 0; i < 4; ++i) { const int e = lane + 64 * i, c = e >> 7, k = e & 127; const bf16* kr = keys + ((size_t)(h * 2 + c) * 128 + k) * 128; float s = 0.f;
            for (int d = 0; d < 128; ++d) s += qv[c * 128 + d] * bf2f(kr[d]);
            sc[i] = s; sv[e] = s; }
        __builtin_amdgcn_s_waitcnt(0);
#pragma unroll
        for (int i = 0; i < 4; ++i) { const int e = lane + 64 * i, c = e >> 7, k = e & 127; int rank = 0;
            for (int kk = 0; kk < 128; ++kk) { const float v = sv[c * 128 + kk]; rank += (v > sc[i] || (v == sc[i] && kk < k)) ? 1 : 0; }
            if (rank < 16) { stop[c * 16 + rank] = sc[i]; itop[c * 16 + rank] = k; } }
        __builtin_amdgcn_s_waitcnt(0);
        float cv[4];
#pragma unroll
        for (int i = 0; i < 4; ++i) { const int e = lane + 64 * i, a = e >> 4, bb = e & 15; cv[i] = stop[a] + stop[16 + bb]; cand[e] = cv[i]; cidx[e] = itop[a] * 128 + itop[16 + bb]; }
        __builtin_amdgcn_s_waitcnt(0);
        float* gs = sv; int* ge = (int*)(sv + 16);
#pragma unroll
        for (int i = 0; i < 4; ++i) { const int e = lane + 64 * i; int rank = 0;
            for (int kk = 0; kk < 256; ++kk) { const float v = cand[kk]; rank += (v > cv[i] || (v == cv[i] && kk < e)) ? 1 : 0; }
            if (rank < 16) { gs[rank] = cv[i]; ge[rank] = cidx[e]; } }
        __builtin_amdgcn_s_waitcnt(0);
        if (lane < 16) { const float m = gs[0]; float den = 0.f; for (int i = 0; i < 16; ++i) den += __expf(gs[i] - m);
            gw[(size_t)t * 128 + h * 16 + lane] = __expf(gs[lane] - m) / den; eidx[(size_t)t * 128 + h * 16 + lane] = ge[lane]; }
    }
}
__device__ __forceinline__ void ph_peer_gather(const Params& p, int wv) {
    PH_IDS(); unsigned char* ws = p.ws;
    const bf16* h1b = (const bf16*)(ws + OFF_H1B); const int* eidx = (const int*)(ws + OFF_EIDX); const float* gw = (const float*)(ws + OFF_GW);
    for (int t = gwave; t < T; t += nwaves) {
        float xv[16], y[16];
#pragma unroll
        for (int i = 0; i < 4; ++i) { const ushort4 v = *(const ushort4*)(h1b + (size_t)t * 1024 + i * 256 + lane * 4); xv[4 * i] = bf2f(v.x); xv[4 * i + 1] = bf2f(v.y); xv[4 * i + 2] = bf2f(v.z); xv[4 * i + 3] = bf2f(v.w); }
#pragma unroll
        for (int i = 0; i < 16; ++i) y[i] = 0.f;
        for (int e0 = 0; e0 < 128; e0 += 2) {
            const int ea = eidx[(size_t)t * 128 + e0], eb = eidx[(size_t)t * 128 + e0 + 1]; const float ga = gw[(size_t)t * 128 + e0], gb = gw[(size_t)t * 128 + e0 + 1];
            float4 ua[4], ub[4], va[4], vb[4];
#pragma unroll
            for (int i = 0; i < 4; ++i) { ua[i] = *(const float4*)(p.peer_u + (size_t)ea * 1024 + i * 256 + lane * 4); ub[i] = *(const float4*)(p.peer_u + (size_t)eb * 1024 + i * 256 + lane * 4);
                va[i] = *(const float4*)(p.peer_v + (size_t)ea * 1024 + i * 256 + lane * 4); vb[i] = *(const float4*)(p.peer_v + (size_t)eb * 1024 + i * 256 + lane * 4); }
            float da = 0.f, db = 0.f;
#pragma unroll
            for (int i = 0; i < 4; ++i) { da += xv[4 * i] * ua[i].x + xv[4 * i + 1] * ua[i].y + xv[4 * i + 2] * ua[i].z + xv[4 * i + 3] * ua[i].w; db += xv[4 * i] * ub[i].x + xv[4 * i + 1] * ub[i].y + xv[4 * i + 2] * ub[i].z + xv[4 * i + 3] * ub[i].w; }
            da = wave_sum(da); db = wave_sum(db);
            const float ca = ga * gelu_exact(da), cb = gb * gelu_exact(db);
#pragma unroll
            for (int i = 0; i < 4; ++i) { y[4 * i] += ca * va[i].x + cb * vb[i].x; y[4 * i + 1] += ca * va[i].y + cb * vb[i].y; y[4 * i + 2] += ca * va[i].z + cb * vb[i].z; y[4 * i + 3] += ca * va[i].w + cb * vb[i].w; }
        }
        float* row = p.out + (size_t)t * 1024; float s = 0.f;
#pragma unroll
        for (int i = 0; i < 4; ++i) { const float4 hv = *(const float4*)(row + i * 256 + lane * 4); y[4 * i] += DN_ALPHA * hv.x; y[4 * i + 1] += DN_ALPHA * hv.y; y[4 * i + 2] += DN_ALPHA * hv.z; y[4 * i + 3] += DN_ALPHA * hv.w; }
#pragma unroll
        for (int i = 0; i < 16; ++i) s += y[i];
        const float mu = wave_sum(s) * (1.0f / 1024.0f); float s2 = 0.f;
#pragma unroll
        for (int i = 0; i < 16; ++i) { y[i] -= mu; s2 += y[i] * y[i]; }
        const float rstd = rsqrtf(wave_sum(s2) * (1.0f / 1024.0f) + LN_EPS);
#pragma unroll
        for (int i = 0; i < 4; ++i) { const int c = i * 256 + lane * 4; float4 o; o.x = y[4 * i] * rstd * p.ln2_g[c] + p.ln2_b[c]; o.y = y[4 * i + 1] * rstd * p.ln2_g[c + 1] + p.ln2_b[c + 1]; o.z = y[4 * i + 2] * rstd * p.ln2_g[c + 2] + p.ln2_b[c + 2]; o.w = y[4 * i + 3] * rstd * p.ln2_g[c + 3] + p.ln2_b[c + 3]; *(float4*)(row + c) = o; }
    }
}

__global__ void __launch_bounds__(NTHREADS) fwd_megakernel(Params p) {
    extern __shared__ __attribute__((aligned(16))) unsigned char lds[];
    cg::grid_group grid = cg::this_grid();
    const int nb = gridDim.x, bid = blockIdx.x;
    const int wv = __builtin_amdgcn_readfirstlane(threadIdx.x >> 6);
    unsigned char* ws = p.ws;
    PG8_LAS unsigned char* ldsp = (PG8_LAS unsigned char*)lds;

    ph_prep(p, wv);
    grid.sync();
    {
        pg8::Gemm g{(const bf16*)(ws + OFF_XB), (const bf16*)(ws + OFF_WIN), T, NPROJ_PAD, 1024, 1024, 0, 1 << 30, 0l};
        pg8::StaticOrder S; S.init(T, NPROJ_PAD, nb, bid);
        pg8::EpiInProjPg E{(bf16*)(ws + OFF_Z), (bf16*)(ws + OFF_XBC), (bf16*)(ws + OFF_Q), (bf16*)(ws + OFF_KVS), (bf16*)(ws + OFF_DTG)};
        pg8::gemm_phase<pg8::EpiInProjPg, pg8::StaticOrder, pg8::NoMid, true, true>(wv, ldsp, g, S, E, pg8::NoMid{});
    }
    grid.sync();
    ph_tokprep(p, wv);
    grid.sync();
    if (bid < 32) {
        const bool isv = bid >= 16;
        pg8::Gemm g{(const bf16*)(ws + OFF_KVS) + (isv ? 256 : 0), (const bf16*)(ws + (isv ? OFF_W1V : OFF_W1K)), 4096, 256, 2048, 0, 1, 1 << 30, 0l};
        pg8::StaticOrder S; S.init(4096, 256, 16, isv ? bid - 16 : bid);
        pg8::EpiBf16<1> E{(bf16*)(ws + OFF_HID + (isv ? 2 * MiB : 0)), 256, (const float*)(ws + (isv ? OFF_B1V : OFF_B1K)), 0, 0, 1.f};
        pg8::gemm_phase<pg8::EpiBf16<1>, pg8::StaticOrder, pg8::NoMid, true, true>(wv, ldsp, g, S, E, pg8::NoMid{});
    }
    ph_ssd_prep2(p, wv, lds);
    ph_vt_prep(p, wv);
    grid.sync();
    {
        RowMajorBf16 ak{(const bf16*)(ws + OFF_HID), 256}, av{(const bf16*)(ws + OFF_HID + 2 * MiB), 256};
        RowMajorBf16 bk{(const bf16*)(ws + OFF_W2K), 256}, bv{(const bf16*)(ws + OFF_W2V), 256};
        EpiKc ek{(bf16*)(ws + OFF_KC), false}, ev{(bf16*)(ws + OFF_VCT), true};
        gemm_wave32(wv, 4096 / 32, 64 / 32, 256, ak, bk, ek);
        gemm_wave32(wv, 4096 / 32, 64 / 32, 256, av, bv, ev);
    }
    ph_ssd_states(p, wv);
    grid.sync();
    ph_kc_rope(p, wv);
    ph_ssd_scan(p, wv);
    grid.sync();
    ph_ssd_out(p, wv);
    ph_nsa(p, wv, lds);
    grid.sync();
    {
        pg8::Gemm g{(const bf16*)(ws + OFF_Q), (const bf16*)(ws + OFF_WOUT), T, 1024, 2048, 1024, 0, 16, (long)OFF_Z - (long)OFF_Q - 16l * 128l};
        pg8::StaticOrder S; S.init(T, 1024, nb, bid);
        pg8::RmsFactors rf{(const float*)(ws + OFF_SSQ), (const float*)(ws + OFF_SSQ) + T, RMS_EPS};
        pg8::EpiOutProj E{p.x, p.out, DN_ALPHA, rf}; pg8::MidRmsScale MH{rf};
        pg8::gemm_phase<pg8::EpiOutProj, pg8::StaticOrder, pg8::MidRmsScale, true, true>(wv, ldsp, g, S, E, MH);
    }
    grid.sync();
    ph_ln1(p, wv);
    grid.sync();
    {
        pg8::Gemm g{(const bf16*)(ws + OFF_H1B), (const bf16*)(ws + OFF_WQ), T, 2048, 1024, 1024, 0, 1 << 30, 0l};
        pg8::StaticOrder S; S.init(T, 2048, nb, bid);
        pg8::EpiBf16<0> E{(bf16*)(ws + OFF_QP), 2048, nullptr, 0, 0, 1.f};
        pg8::gemm_phase<pg8::EpiBf16<0>, pg8::StaticOrder, pg8::NoMid, true, true>(wv, ldsp, g, S, E, pg8::NoMid{});
    }
    grid.sync();
    ph_peer_topk(p, wv, lds);
    grid.sync();
    ph_peer_gather(p, wv);
}

extern "C" void kernel_launch(void* const* d_in, const int* in_sizes, int n_in, void* d_out, int out_size, void* d_ws, size_t ws_size, hipStream_t stream) {
    static int grid_blocks = 0;
    if (!grid_blocks) {
        int dev = 0, cus = 0, per_cu = 0;
        hipGetDevice(&dev);
        hipDeviceGetAttribute(&cus, hipDeviceAttributeMultiprocessorCount, dev);
        hipFuncSetAttribute((const void*)fwd_megakernel, hipFuncAttributeMaxDynamicSharedMemorySize, LDS_BYTES);
        hipOccupancyMaxActiveBlocksPerMultiprocessor(&per_cu, fwd_megakernel, NTHREADS, LDS_BYTES);
        if (per_cu < 1) per_cu = 1;
        if (per_cu > 1) per_cu = 1;
        grid_blocks = cus * per_cu;
        if (ws_size < 244 * MiB) fprintf(stderr, "kernel_launch: workspace too small: %zu\n", ws_size);
    }
    Params p{};
    const float** pp = (const float**)&p;
    for (int i = 0; i < 24; ++i) pp[i] = (const float*)d_in[i];
    p.out = (float*)d_out; p.ws = (unsigned char*)d_ws;
    void* args[] = {&p};
    hipError_t e = hipLaunchCooperativeKernel((void*)fwd_megakernel, dim3(grid_blocks), dim3(NTHREADS), args, LDS_BYTES, stream);
    if (e != hipSuccess) fprintf(stderr, "cooperative launch failed: %s (grid %d)\n", hipGetErrorString(e), grid_blocks);
}
```

```cpp
#include <hip/hip_runtime.h>
#include <hip/hip_cooperative_groups.h>
#include <cstdio>
#include <cstdint>
namespace cg = cooperative_groups;

typedef unsigned short bf16;
typedef short bf16x8 __attribute__((ext_vector_type(8)));
typedef float f32x4 __attribute__((ext_vector_type(4)));
typedef unsigned long long u64;

constexpr int T = 16384, L = 4096, NBATCH = 4, D = 1024;
constexpr int NPROJ = 5184, NPROJ_PAD = 5376;
constexpr int NTHREADS = 512, NWAVES = 8;
constexpr float LN_EPS = 1e-5f, RMS_EPS = 1e-5f;
constexpr float DN_ALPHA = 1.189207115002721f;
constexpr float NEG_INF = -1e30f, BIG = 1e30f;

constexpr size_t MiB = 1u << 20;
constexpr size_t OFF_SSQ = 0;
constexpr size_t OFF_WOUT = 1 * MiB, OFF_WQ = 5 * MiB, OFF_W1K = 9 * MiB, OFF_W1V = 10 * MiB;
constexpr size_t OFF_W2K = 11 * MiB, OFF_W2V = 11 * MiB + 65536, OFF_B1K = 11 * MiB + 131072, OFF_B1V = 11 * MiB + 131072 + 4096;
constexpr size_t OFF_KEYS = 12 * MiB, OFF_ROPE = 13 * MiB, OFF_DT = 14 * MiB, OFF_ACS = 15 * MiB, OFF_GATE = 16 * MiB, OFF_MASK = 19 * MiB;
constexpr size_t OFF_HID = 20 * MiB, OFF_KC = 24 * MiB, OFF_VC = 24 * MiB + 524288;
constexpr size_t OFF_Z = 26 * MiB, OFF_Q = 58 * MiB, OFF_KVS = 90 * MiB, OFF_XBC = 138 * MiB, OFF_XSBC = 186 * MiB, OFF_BT = 234 * MiB, OFF_DTG = 242 * MiB;
constexpr size_t OFF_VST = 138 * MiB, OFF_VWT = 146 * MiB, OFF_VCT = 154 * MiB;
constexpr size_t OFF_XB = 186 * MiB, OFF_WIN = 218 * MiB;
constexpr size_t OFF_H1B = 90 * MiB, OFF_QP = 138 * MiB, OFF_EIDX = 202 * MiB, OFF_GW = 210 * MiB;
constexpr size_t OFF_PU = 26 * MiB, OFF_PV = 58 * MiB;
constexpr int LDS_BYTES = 147456;

struct Params {
    const float *x, *w_in, *conv_w, *conv_b, *dt_bias, *a_log, *d_skip, *ssd_norm_w;
    const float *cmp_pos_k, *cmp_w1_k, *cmp_w2_k, *cmp_pos_v, *cmp_w1_v, *cmp_w2_v;
    const float *attn_norm_w, *w_out, *ln1_g, *ln1_b, *peer_wq, *peer_keys, *peer_u, *peer_v, *ln2_g, *ln2_b;
    float* out; unsigned char* ws;
};

__device__ __forceinline__ float bf2f(bf16 v) { return __uint_as_float((unsigned)v << 16); }
__device__ __forceinline__ bf16 f2bf(float f) { unsigned u = __float_as_uint(f); return (bf16)((u + 0x7fffu + ((u >> 16) & 1u)) >> 16); }
__device__ __forceinline__ int lane_id() { int l = (int)__builtin_amdgcn_mbcnt_hi(~0u, __builtin_amdgcn_mbcnt_lo(~0u, 0u)); asm volatile("" : "+v"(l)); return l; }
#define PH_IDS() const int lane = lane_id(); const int tid = (wv << 6) | lane; const int bid = blockIdx.x, nb = gridDim.x; const int gtid = bid * NTHREADS + tid, gn = nb * NTHREADS; const int gwave = bid * NWAVES + wv, nwaves = nb * NWAVES; (void)gtid; (void)gn; (void)gwave; (void)nwaves;
__device__ __forceinline__ float wave_sum(float v) {
#pragma unroll
    for (int o = 1; o < 64; o <<= 1) v += __shfl_xor(v, o);
    return v;
}
__device__ __forceinline__ float wave_max(float v) {
#pragma unroll
    for (int o = 1; o < 64; o <<= 1) v = fmaxf(v, __shfl_xor(v, o));
    return v;
}
__device__ __forceinline__ float gelu_exact(float v) { return 0.5f * v * (1.0f + erff(v * 0.7071067811865476f)); }
__device__ __forceinline__ float sigmoidf(float v) { return 1.0f / (1.0f + __expf(-v)); }

template <class AP, class BP, class EP>
__device__ __forceinline__ void gemm_wave32(int wv, int Mt, int Nt, int K, const AP& ap, const BP& bp, const EP& ep) {
    PH_IDS(); const int r = lane & 15, q = lane >> 4;
    for (int tile = gwave; tile < Mt * Nt; tile += nwaves) {
        const int tm = tile / Nt, tn = tile % Nt, row0 = tm * 32, col0 = tn * 32;
        f32x4 acc[2][2];
#pragma unroll
        for (int i = 0; i < 2; ++i)
#pragma unroll
            for (int j = 0; j < 2; ++j) acc[i][j] = (f32x4){0.f, 0.f, 0.f, 0.f};
        for (int k0 = 0; k0 < K; k0 += 32) {
            const bf16x8 a0 = ap(row0 + r, k0 + 8 * q), a1 = ap(row0 + 16 + r, k0 + 8 * q);
            const bf16x8 b0 = bp(col0 + r, k0 + 8 * q), b1 = bp(col0 + 16 + r, k0 + 8 * q);
            acc[0][0] = __builtin_amdgcn_mfma_f32_16x16x32_bf16(a0, b0, acc[0][0], 0, 0, 0);
            acc[0][1] = __builtin_amdgcn_mfma_f32_16x16x32_bf16(a0, b1, acc[0][1], 0, 0, 0);
            acc[1][0] = __builtin_amdgcn_mfma_f32_16x16x32_bf16(a1, b0, acc[1][0], 0, 0, 0);
            acc[1][1] = __builtin_amdgcn_mfma_f32_16x16x32_bf16(a1, b1, acc[1][1], 0, 0, 0);
        }
#pragma unroll
        for (int i = 0; i < 2; ++i)
#pragma unroll
            for (int j = 0; j < 2; ++j)
#pragma unroll
                for (int e = 0; e < 4; ++e) ep(row0 + 16 * i + 4 * q + e, col0 + 16 * j + r, acc[i][j][e]);
    }
}
struct RowMajorBf16 { const bf16* p; int ld; __device__ __forceinline__ bf16x8 operator()(int row, int k) const { return *(const bf16x8*)(p + (size_t)row * ld + k); } };

namespace pg8 {
#define PG8_LAS __attribute__((address_space(3)))
typedef unsigned short bf16_t;
typedef short bf16x8 __attribute__((ext_vector_type(8)));
typedef float f32x4 __attribute__((ext_vector_type(4)));
typedef unsigned u32x4 __attribute__((ext_vector_type(4)));
constexpr int BM = 256, BK = 64, HALF = 128, HTB = HALF * BK * 2  , STAGE_BYTES = 8 * HTB, NXCD = 8, WGM = 8;

__host__ __device__ __forceinline__ int lds_byte(int r, int c) { const int st = (r >> 4) * 2 + (c >> 5), rr = r & 15, cc = c & 31, ob = rr * 64 + cc * 2; return st * 1024 + (ob ^ (((ob >> 9) & 1) << 5)); }
__host__ __device__ __forceinline__ void stage_rc(int b, int& R, int& C) { const int st = b / 1024, sb = b % 1024, swz = sb ^ (((sb >> 9) & 1) << 5); R = (st >> 1) * 16 + swz / 64; C = (st & 1) * 32 + (swz % 64) / 2; }
__host__ __device__ __forceinline__ int perm32(int rho) { const int n = rho >> 4, i = rho & 15; return 8 * (i >> 2) + 4 * n + (i & 3); }

struct Unit { int pm, pn; };
struct Gemm { const bf16_t* A; const bf16_t* Bt; int M, N, K; int lda; int amode; int ksplit; long kdelta; };

struct StaticOrder {
    int nM, nN, nwg, G, c;
    __host__ __device__ void init(int M, int N, int G_, int c_) { nM = M / BM; nN = N / BM; nwg = nM * nN; G = G_; c = c_; }
    __host__ __device__ bool next(int i, Unit& u) const {
        const long L = (long)i * G + c; if (L >= nwg) return false;
        int wgid = (int)L; { const int q = nwg / NXCD, r = nwg % NXCD, xcd = wgid % NXCD, off = wgid / NXCD; wgid = (xcd < r ? xcd * (q + 1) : r * (q + 1) + (xcd - r) * q) + off; }
        const int nig = WGM * nN, gid = wgid / nig, fm = gid * WGM, gsz = (nM - fm) < WGM ? (nM - fm) : WGM;
        u.pm = fm + ((wgid % nig) % gsz); u.pn = (wgid % nig) / gsz; return true;
    }
    __device__ __forceinline__ void a_ready(const Unit&) const {}
    __device__ __forceinline__ void done(const Unit&) const {}
};


__device__ __forceinline__ unsigned cvt_pk_bf16(float lo, float hi) { unsigned r; asm volatile("v_cvt_pk_bf16_f32 %0, %1, %2" : "=v"(r) : "v"(lo), "v"(hi)); return r; }
typedef float f32x2 __attribute__((ext_vector_type(2)));
__device__ __forceinline__ f32x2 gelu_pk(f32x2 v) {
    const f32x2 av = __builtin_elementwise_abs(v), d = av * 0.2316418882f + 1.0f;
    f32x2 t; t.x = __builtin_amdgcn_rcpf(d.x); t.y = __builtin_amdgcn_rcpf(d.y);
    f32x2 q = t * 0.5307027145f + (-0.7265760135f); q = q * t + 0.7107068705f; q = q * t + (-0.142248368f); q = q * t + 0.127414796f; q = q * t;
    const f32x2 s = (v * v) * (-0.72134752044f);
    f32x2 e; e.x = __builtin_amdgcn_exp2f(s.x); e.y = __builtin_amdgcn_exp2f(s.y);
    const f32x2 m = v * (q * e), r = v - m;
    f32x2 o; o.x = v.x < 0.f ? m.x : r.x; o.y = v.y < 0.f ? m.y : r.y; return o;
}

template <int ACT  > struct EpiBf16 {
    static constexpr bool PERM = true, AFTER_DRAIN = false; static_assert(ACT == 0 || ACT == 1, "EpiBf16: ACT is 0 (none) or 1 (gelu_pk)");
    bf16_t* O; int ldc; const float* bias; int split_cols; size_t split_stride; float scale0;
    __device__ __forceinline__ void operator()(const f32x4 (&acc)[2][2][4][2], const Unit& u, int wr, int wc, int fr, int fq) const {
        const int row0 = u.pm * BM + wr * 64 + fr; int colt = u.pn * BM; bf16_t* base = O;
        float sc = 1.f; if (split_cols) { const int t = colt / split_cols; base += (size_t)t * split_stride; colt -= t * split_cols; if (t == 0) sc = scale0; }
        const int col0 = colt + wc * 32 + 8 * fq, bcol0 = u.pn * BM + wc * 32 + 8 * fq;
        f32x4 bv[2][2];
#pragma unroll
        for (int bj = 0; bj < 2; ++bj)
#pragma unroll
            for (int n = 0; n < 2; ++n) bv[bj][n] = bias ? *(const f32x4*)(bias + bcol0 + bj * HALF + 4 * n) : (f32x4){0.f, 0.f, 0.f, 0.f};
#pragma unroll
        for (int ai = 0; ai < 2; ++ai)
#pragma unroll
            for (int m = 0; m < 4; ++m) { bf16_t* rowp = base + (size_t)(row0 + ai * HALF + m * 16) * ldc + col0;
#pragma unroll
                for (int bj = 0; bj < 2; ++bj) { f32x4 v0 = acc[ai][bj][m][0] + bv[bj][0], v1 = acc[ai][bj][m][1] + bv[bj][1];
                    if (ACT == 1) { f32x2 a = gelu_pk((f32x2){v0[0], v0[1]}), b = gelu_pk((f32x2){v0[2], v0[3]}), c = gelu_pk((f32x2){v1[0], v1[1]}), d = gelu_pk((f32x2){v1[2], v1[3]});
                        v0 = (f32x4){a.x, a.y, b.x, b.y}; v1 = (f32x4){c.x, c.y, d.x, d.y}; }
                    v0 = v0 * sc; v1 = v1 * sc; u32x4 w; w.x = cvt_pk_bf16(v0[0], v0[1]); w.y = cvt_pk_bf16(v0[2], v0[3]); w.z = cvt_pk_bf16(v1[0], v1[1]); w.w = cvt_pk_bf16(v1[2], v1[3]);
                    *(u32x4*)(rowp + bj * HALF) = w; } }
    }
};

struct EpiInProjPg { static constexpr bool PERM = true, AFTER_DRAIN = false;
    bf16_t *z, *xbc, *q, *kvs, *dtg;
    __device__ __forceinline__ void operator()(const f32x4 (&acc)[2][2][4][2], const Unit& u, int wr, int wc, int fr, int fq) const {
        bf16_t* base; int ldc, colt; const int pn = u.pn;
        if (pn < 4) { base = z; ldc = 1024; colt = pn * 256; } else if (pn < 10) { base = xbc; ldc = 1536; colt = (pn - 4) * 256; }
        else if (pn < 14) { base = q; ldc = 1024; colt = (pn - 10) * 256; } else if (pn < 20) { base = kvs; ldc = 1536; colt = (pn - 14) * 256; }
        else { base = dtg; ldc = 64; colt = 0; }
        const int row0 = u.pm * BM + wr * 64 + fr, col0 = colt + wc * 32 + 8 * fq;
#pragma unroll
        for (int ai = 0; ai < 2; ++ai)
#pragma unroll
            for (int m = 0; m < 4; ++m) { bf16_t* rowp = base + (size_t)(row0 + ai * HALF + m * 16) * ldc + col0;
#pragma unroll
                for (int bj = 0; bj < 2; ++bj) { const f32x4 v0 = acc[ai][bj][m][0], v1 = acc[ai][bj][m][1];
                    u32x4 w; w.x = cvt_pk_bf16(v0[0], v0[1]); w.y = cvt_pk_bf16(v0[2], v0[3]); w.z = cvt_pk_bf16(v1[0], v1[1]); w.w = cvt_pk_bf16(v1[2], v1[3]);
                    if (pn < 20 || (bj == 0 && wc < 2)) *(u32x4*)(rowp + bj * HALF) = w; } }
    }
};
struct RmsFactors { const float* ssq; const float* ssq2; float eps;
    __device__ __forceinline__ void get(int row, float& ra, float& r0, float& r1) const {
        ra = rsqrtf(ssq[row] * (1.0f / 1024.0f) + eps); r0 = rsqrtf(ssq2[2 * row] * (1.0f / 512.0f) + eps); r1 = rsqrtf(ssq2[2 * row + 1] * (1.0f / 512.0f) + eps); } };
struct EpiOutProj { static constexpr bool PERM = false, AFTER_DRAIN = false;
    const float* x; float* out; float alpha; RmsFactors rf;
    __device__ __forceinline__ void operator()(const f32x4 (&acc)[2][2][4][2], const Unit& u, int wr, int wc, int fr, int fq) const {
        const int col0 = u.pn * BM + wc * 32 + 4 * fq;
#pragma unroll
        for (int ai = 0; ai < 2; ++ai)
#pragma unroll
            for (int m = 0; m < 4; ++m) { const int row = u.pm * BM + ai * HALF + wr * 64 + m * 16 + fr; const size_t off = (size_t)row * 1024 + col0;
                float ra, r0, r1; rf.get(row, ra, r0, r1);
#pragma unroll
                for (int bj = 0; bj < 2; ++bj)
#pragma unroll
                    for (int n = 0; n < 2; ++n) { const size_t o = off + bj * HALF + n * 16; const f32x4 xv = *(const f32x4*)(x + o); *(f32x4*)(out + o) = xv * alpha + acc[ai][bj][m][n] * r1; } }
    }
};
struct MidRmsScale { static constexpr bool ENABLED = true; RmsFactors rf;
    __device__ __forceinline__ void operator()(f32x4 (&acc)[2][2][4][2], const Unit& u, int t, int wr, int wc, int fr, int fq) const {
        if (t != 16 && t != 24) return;
        int rowb = u.pm * BM + wr * 64 + fr; asm volatile("" : "+v"(rowb));
#pragma unroll
        for (int ai = 0; ai < 2; ++ai)
#pragma unroll
            for (int m = 0; m < 4; ++m) { float ra, r0, r1; rf.get(rowb + ai * HALF + m * 16, ra, r0, r1);
                const float sc = (t == 16) ? ra / r0 : r0 / r1;
#pragma unroll
                for (int bj = 0; bj < 2; ++bj)
#pragma unroll
                    for (int n = 0; n < 2; ++n) acc[ai][bj][m][n] = acc[ai][bj][m][n] * sc; }
    }
};
struct NoMid { static constexpr bool ENABLED = false; template <class ACC> __device__ __forceinline__ void operator()(ACC&, const Unit&, int, int, int, int, int) const {} };
template <class Epi, class Sched, class Mid, bool ALIGN_EPI = false, bool SP2 = false>
__device__ __forceinline__ void gemm_phase(int wv, PG8_LAS unsigned char* lds, const Gemm g, const Sched& S, const Epi& E, const Mid& MH) {
    int lane_ = (int)__builtin_amdgcn_mbcnt_hi(~0u, __builtin_amdgcn_mbcnt_lo(~0u, 0u)); asm volatile("" : "+v"(lane_));
    const int lane = lane_, wid = wv, tid = (wv << 6) | lane, wr = wid >> 2, wc = wid & 3, fr = lane & 15, fq = lane >> 4;
    const int K = g.K, nt = K / BK;
    unsigned voffA[2], voffB[2];
#pragma unroll
    for (int i = 0; i < 2; ++i) { int R, C; stage_rc(tid * 16 + i * 8192, R, C); const int Rb = Epi::PERM ? ((R & ~31) + perm32(R & 31)) : R;
        voffA[i] = g.amode == 0 ? (unsigned)(R * g.lda + C) * 2u : (unsigned)((R >> 2) * 49152 + (R & 3) * 128 + C * 2); voffB[i] = (unsigned)(Rb * K + C) * 2u; }
    const size_t kstep = (size_t)(BK * 2);
    const size_t hstep = (size_t)HALF * K * 2;
    const size_t tstep = 2 * hstep;
    const size_t kstepA = g.amode == 0 ? (size_t)(BK * 2) : (size_t)3072;
    const size_t hstepA = g.amode == 0 ? (size_t)HALF * g.lda * 2 : (size_t)32 * 49152;
    const size_t tstepA = 2 * hstepA;
#define PG8_AK(base, t) ((base) + (size_t)(t) * kstepA + (((t) >= g.ksplit) ? g.kdelta : 0l))
    const unsigned ldsw = (unsigned)wid * 1024u;
    const int aoff = lds_byte(wr * 64 + fr, fq * 8), boff = lds_byte(wc * 32 + fr, fq * 8);
#define PG8_SA(b, h) (((b) * 2 + (h)) * HTB)
#define PG8_SB(b, h) ((4 + (b) * 2 + (h)) * HTB)
#define PG8_STAGE(bufoff, gbase, voff) do { _Pragma("unroll") for (int _i = 0; _i < 2; ++_i) \
        __builtin_amdgcn_global_load_lds((const unsigned*)((const char*)(gbase) + (voff)[_i]), (PG8_LAS unsigned*)(lds + (bufoff) + ldsw + _i * 8192), 16, 0, 0); } while (0)
#define PG8_LDA(dst, b, h) do { _Pragma("unroll") for (int m = 0; m < 4; ++m) _Pragma("unroll") for (int k = 0; k < 2; ++k) dst[m][k] = *(const PG8_LAS bf16x8*)(lds + PG8_SA(b, h) + aoff + m * 2048 + k * 1024); } while (0)
#define PG8_LDB(dst, b, h) do { _Pragma("unroll") for (int n = 0; n < 2; ++n) _Pragma("unroll") for (int k = 0; k < 2; ++k) dst[n][k] = *(const PG8_LAS bf16x8*)(lds + PG8_SB(b, h) + boff + n * 2048 + k * 1024); } while (0)
#define PG8_MMA(ai, bj, At, Bt) do { __builtin_amdgcn_s_setprio(1); _Pragma("unroll") for (int m = 0; m < 4; ++m) _Pragma("unroll") for (int n = 0; n < 2; ++n) _Pragma("unroll") for (int k = 0; k < 2; ++k) \
        acc[ai][bj][m][n] = __builtin_amdgcn_mfma_f32_16x16x32_bf16(Bt[n][k], At[m][k], acc[ai][bj][m][n], 0, 0, 0); __builtin_amdgcn_s_setprio(0); } while (0)
#define PG8_WAIT_V(n) asm volatile("s_waitcnt vmcnt(" #n ")" ::: "memory")
#define PG8_WAIT_L(n) asm volatile("s_waitcnt lgkmcnt(" #n ")" ::: "memory")
#define PG8_BAR __builtin_amdgcn_s_barrier()
#define PG8_SCHED __builtin_amdgcn_sched_barrier(0)
    Unit cur, nxt; int ui = 0;
    if (!S.next(0, cur)) return;
    f32x4 acc[2][2][4][2];
#pragma unroll
    for (int a = 0; a < 2; ++a)
#pragma unroll
        for (int b = 0; b < 2; ++b)
#pragma unroll
            for (int m = 0; m < 4; ++m)
#pragma unroll
                for (int n = 0; n < 2; ++n) acc[a][b][m][n] = (f32x4){0.f, 0.f, 0.f, 0.f};
    bf16x8 At[4][2], B0[2][2], B1[2][2];
    const char* cA = (const char*)g.A + (size_t)cur.pm * tstepA; const char* cB = (const char*)g.Bt + (size_t)cur.pn * tstep;
    S.a_ready(cur);
    if constexpr (SP2) {
        PG8_STAGE(PG8_SB(0, 0), cB, voffB); PG8_STAGE(PG8_SB(0, 1), cB + hstep, voffB); PG8_STAGE(PG8_SA(0, 0), cA, voffA); PG8_STAGE(PG8_SA(0, 1), cA + hstepA, voffA);
        if (wr == 1) PG8_BAR;
        PG8_WAIT_V(2); PG8_BAR;
        PG8_STAGE(PG8_SB(1, 0), cB + kstep, voffB); PG8_STAGE(PG8_SA(1, 0), PG8_AK(cA, 1), voffA); PG8_STAGE(PG8_SB(1, 1), cB + hstep + kstep, voffB);
        PG8_WAIT_V(6); PG8_BAR;
    } else {
        PG8_STAGE(PG8_SB(0, 0), cB, voffB); PG8_STAGE(PG8_SA(0, 0), cA, voffA); PG8_STAGE(PG8_SB(0, 1), cB + hstep, voffB); PG8_STAGE(PG8_SA(0, 1), cA + hstepA, voffA);
        if (wr == 1) PG8_BAR;
        PG8_WAIT_V(4); PG8_BAR;
        PG8_STAGE(PG8_SB(1, 0), cB + kstep, voffB); PG8_STAGE(PG8_SA(1, 0), PG8_AK(cA, 1), voffA); PG8_STAGE(PG8_SB(1, 1), cB + hstep + kstep, voffB);
        PG8_WAIT_V(6); PG8_BAR;
    }
    for (;;) {
        const bool has_next = S.next(ui + 1, nxt);
        const char* nA = has_next ? (const char*)g.A + (size_t)nxt.pm * tstepA : cA; const char* nB = has_next ? (const char*)g.Bt + (size_t)nxt.pn * tstep : cB;
        for (int t = 0; t < nt; t += 2) {
            const bool last = (t == nt - 2);
            if (Mid::ENABLED) MH(acc, cur, t, wr, wc, fr, fq);
            const char* a1 = PG8_AK(cA, t + 1);
            const char* a2 = last ? nA : PG8_AK(cA, t + 2); const char* b2 = last ? nB : cB + (size_t)(t + 2) * kstep;
            const char* a3 = a2 + kstepA; const char* b3 = b2 + kstep;
            if (last && has_next) S.a_ready(nxt);
            if constexpr (SP2) {
            PG8_LDB(B0, 0, 0); PG8_LDB(B1, 0, 1); PG8_SCHED; PG8_LDA(At, 0, 0); PG8_STAGE(PG8_SA(1, 1), a1 + hstepA, voffA);
            PG8_WAIT_V(8); PG8_WAIT_L(0); PG8_BAR; PG8_MMA(0, 0, At, B0); PG8_MMA(0, 1, At, B1); PG8_BAR; PG8_SCHED;
            PG8_LDA(At, 0, 1); PG8_STAGE(PG8_SB(0, 0), b2, voffB); PG8_STAGE(PG8_SB(0, 1), b2 + hstep, voffB); PG8_STAGE(PG8_SA(0, 0), a2, voffA);
            PG8_WAIT_V(8); PG8_WAIT_L(0); PG8_BAR; PG8_MMA(1, 0, At, B0); PG8_MMA(1, 1, At, B1); PG8_BAR; PG8_SCHED;
            PG8_LDB(B0, 1, 0); PG8_LDB(B1, 1, 1); PG8_SCHED; PG8_LDA(At, 1, 0); PG8_STAGE(PG8_SA(0, 1), a2 + hstepA, voffA);
            PG8_WAIT_V(8); PG8_WAIT_L(0); PG8_BAR; PG8_MMA(0, 0, At, B0); PG8_MMA(0, 1, At, B1); PG8_BAR; PG8_SCHED;
            PG8_LDA(At, 1, 1); PG8_STAGE(PG8_SB(1, 0), b3, voffB); PG8_STAGE(PG8_SB(1, 1), b3 + hstep, voffB); PG8_STAGE(PG8_SA(1, 0), a3, voffA);
            PG8_WAIT_V(8); PG8_WAIT_L(0); PG8_BAR; PG8_MMA(1, 0, At, B0); PG8_MMA(1, 1, At, B1); PG8_BAR; PG8_SCHED;
            } else {
            PG8_LDB(B0, 0, 0); PG8_SCHED; PG8_LDA(At, 0, 0); PG8_STAGE(PG8_SA(1, 1), a1 + hstepA, voffA);
            PG8_WAIT_L(8); PG8_BAR; PG8_WAIT_L(0); PG8_MMA(0, 0, At, B0); PG8_BAR; PG8_SCHED;
            PG8_LDB(B1, 0, 1); PG8_STAGE(PG8_SB(0, 0), b2, voffB);
            PG8_BAR; PG8_WAIT_L(0); PG8_MMA(0, 1, At, B1); PG8_BAR;
            PG8_LDA(At, 0, 1); PG8_STAGE(PG8_SA(0, 0), a2, voffA);
            PG8_BAR; PG8_WAIT_L(0); PG8_MMA(1, 0, At, B0); PG8_BAR; PG8_SCHED;
            PG8_STAGE(PG8_SB(0, 1), b2 + hstep, voffB);
            PG8_WAIT_V(6); PG8_BAR; PG8_MMA(1, 1, At, B1); PG8_BAR;
            PG8_LDB(B0, 1, 0); PG8_SCHED; PG8_LDA(At, 1, 0); PG8_STAGE(PG8_SA(0, 1), a2 + hstepA, voffA);
            PG8_WAIT_L(8); PG8_BAR; PG8_WAIT_L(0); PG8_MMA(0, 0, At, B0); PG8_BAR; PG8_SCHED;
            PG8_LDB(B1, 1, 1); PG8_STAGE(PG8_SB(1, 0), b3, voffB);
            PG8_BAR; PG8_WAIT_L(0); PG8_MMA(0, 1, At, B1); PG8_BAR;
            PG8_LDA(At, 1, 1); PG8_STAGE(PG8_SA(1, 0), a3, voffA);
            PG8_BAR; PG8_WAIT_L(0); PG8_MMA(1, 0, At, B0); PG8_BAR; PG8_SCHED;
            PG8_STAGE(PG8_SB(1, 1), b3 + hstep, voffB);
            PG8_WAIT_V(6); PG8_BAR; PG8_MMA(1, 1, At, B1); PG8_BAR;
            }
        }
        if constexpr (ALIGN_EPI) { if (wr == 0) PG8_BAR; }
        if constexpr (!Epi::AFTER_DRAIN) { E(acc, cur, wr, wc, fr, fq); S.done(cur); }
        if (!has_next) break;
#pragma unroll
        for (int a = 0; a < 2; ++a)
#pragma unroll
            for (int b = 0; b < 2; ++b)
#pragma unroll
                for (int m = 0; m < 4; ++m)
#pragma unroll
                    for (int n = 0; n < 2; ++n) acc[a][b][m][n] = (f32x4){0.f, 0.f, 0.f, 0.f};
        cur = nxt; cA = nA; cB = nB; ++ui;
        if constexpr (ALIGN_EPI) { if (wr == 1) PG8_BAR; }
    }
    PG8_WAIT_V(0);
    if constexpr (!ALIGN_EPI) { if (wr == 0) PG8_BAR; }
    PG8_BAR;
    if constexpr (Epi::AFTER_DRAIN) { E.fused(acc, cur, wr, wc, fr, fq, lds, wid, lane); S.done(cur); }
#undef PG8_AK
#undef PG8_SA
#undef PG8_SB
#undef PG8_STAGE
#undef PG8_LDA
#undef PG8_LDB
#undef PG8_MMA
#undef PG8_WAIT_V
#undef PG8_WAIT_L
#undef PG8_BAR
#undef PG8_SCHED
}
}

__device__ __forceinline__ int winmap(int n) { return n < 2560 ? n : (n < 5120 ? n + 16 : (n < 5136 ? 2560 + (n - 5120) : n)); }
__device__ __forceinline__ void ph_prep(const Params& p, int wv) {
    PH_IDS(); unsigned char* ws = p.ws;
    bf16* xb = (bf16*)(ws + OFF_XB);
    for (size_t i = gtid; i < (size_t)T * D / 4; i += gn) { const float4 v = ((const float4*)p.x)[i]; ushort4 o; o.x = f2bf(v.x); o.y = f2bf(v.y); o.z = f2bf(v.z); o.w = f2bf(v.w); ((ushort4*)xb)[i] = o; }
    bf16* winT = (bf16*)(ws + OFF_WIN);
    for (int i = gtid; i < NPROJ_PAD * 1024; i += gn) { const int n = i >> 10, k = i & 1023; winT[i] = n < NPROJ ? f2bf(p.w_in[(size_t)k * NPROJ + winmap(n)]) : (bf16)0; }
    bf16* woutT = (bf16*)(ws + OFF_WOUT);
    for (int i = gtid; i < 1024 * 2048; i += gn) { const int n = i >> 11, kk = i & 2047; const float w = kk < 1024 ? p.w_out[(size_t)(1024 + kk) * 1024 + n] * p.attn_norm_w[kk] : p.w_out[(size_t)(kk - 1024) * 1024 + n] * p.ssd_norm_w[kk - 1024]; woutT[i] = f2bf(w); }
    bf16* wqT = (bf16*)(ws + OFF_WQ);
    for (int i = gtid; i < 2048 * 1024; i += gn) { const int n = i >> 10, k = i & 1023; wqT[i] = f2bf(p.peer_wq[(size_t)k * 2048 + n]); }
    bf16* w1kT = (bf16*)(ws + OFF_W1K); bf16* w1vT = (bf16*)(ws + OFF_W1V);
    for (int i = gtid; i < 256 * 2048; i += gn) { const int n = i >> 11, k = i & 2047; w1kT[i] = f2bf(p.cmp_w1_k[(size_t)k * 256 + n]); w1vT[i] = f2bf(p.cmp_w1_v[(size_t)k * 256 + n]); }
    bf16* w2kT = (bf16*)(ws + OFF_W2K); bf16* w2vT = (bf16*)(ws + OFF_W2V);
    for (int i = gtid; i < 64 * 256; i += gn) { const int n = i >> 8, k = i & 255; w2kT[i] = f2bf(p.cmp_w2_k[(size_t)k * 64 + n]); w2vT[i] = f2bf(p.cmp_w2_v[(size_t)k * 64 + n]); }
    bf16* keys = (bf16*)(ws + OFF_KEYS);
    for (int i = gtid; i < 8 * 2 * 128 * 128; i += gn) keys[i] = f2bf(p.peer_keys[i]);
    float* rc = (float*)(ws + OFF_ROPE); float* rs = rc + 4096 * 32;
    for (int i = gtid; i < 4096 * 32; i += gn) {
        const int pos = i >> 5, j = i & 31;
        const float inv = powf(10000.0f, -(float)(2 * j) / 64.0f); const float angf = (float)pos * inv;
        double xr = (double)angf * 0.15915494309189535; xr -= rint(xr); const double rr = xr * 6.283185307179586, r2 = rr * rr;
        double s = 0.0, c = 0.0, ts = rr, tc = 1.0;
        for (int k = 0; k < 14; ++k) { s += ts; c += tc; tc = -tc * r2 / (double)((2 * k + 1) * (2 * k + 2)); ts = -ts * r2 / (double)((2 * k + 2) * (2 * k + 3)); }
        rc[i] = (float)c; rs[i] = (float)s;
    }
    float* b1k = (float*)(ws + OFF_B1K); float* b1v = (float*)(ws + OFF_B1V);
    for (int o = gwave; o < 512; o += nwaves) {
        const int j = o & 255; const float* pos = o < 256 ? p.cmp_pos_k : p.cmp_pos_v; const float* w1 = o < 256 ? p.cmp_w1_k : p.cmp_w1_v;
        float s = 0.f; for (int k = lane; k < 2048; k += 64) s += pos[k] * w1[(size_t)k * 256 + j];
        s = wave_sum(s); if (lane == 0) (o < 256 ? b1k : b1v)[j] = s;
    }
    float* ssq = (float*)(ws + OFF_SSQ);
    for (int i = gtid; i < 3 * T; i += gn) ssq[i] = 0.f;
}

struct EpiInProj {
    bf16 *z, *xbc, *q, *kvs, *dtg;
    __device__ __forceinline__ void operator()(int row, int c, float v) const {
        const bf16 b = f2bf(v);
        if (c < 1024) z[(size_t)row * 1024 + c] = b;
        else if (c < 2560) xbc[(size_t)row * 1536 + (c - 1024)] = b;
        else if (c < 3584) q[(size_t)row * 1024 + (c - 2560)] = b;
        else if (c < 5120) kvs[(size_t)row * 1536 + (c - 3584)] = b;
        else if (c < 5184) dtg[(size_t)row * 64 + (c - 5120)] = b;
    }
};

__device__ __forceinline__ void ph_tokprep(const Params& p, int wv) {
    PH_IDS(); unsigned char* ws = p.ws;
    const bf16* xbc = (const bf16*)(ws + OFF_XBC); bf16* xsbc = (bf16*)(ws + OFF_XSBC);
    for (size_t i = gtid; i < (size_t)T * 1536; i += gn) {
        const int t = (int)(i / 1536), ch = (int)(i % 1536), l = t & (L - 1);
        float y = p.conv_b[ch];
#pragma unroll
        for (int j = 0; j < 4; ++j) { const int ll = l - 3 + j; if (ll >= 0) y += p.conv_w[j * 1536 + ch] * bf2f(xbc[(size_t)(t - 3 + j) * 1536 + ch]); }
        xsbc[i] = f2bf(y * sigmoidf(y));
    }
    const bf16* dtg = (const bf16*)(ws + OFF_DTG); float* dt = (float*)(ws + OFF_DT); float* gate = (float*)(ws + OFF_GATE);
    for (int i = gtid; i < T * 64; i += gn) {
        const int t = i >> 6, c = i & 63; const float v = bf2f(dtg[i]);
        if (c < 16) { const float xx = v + p.dt_bias[c]; dt[t * 16 + c] = xx > 20.f ? xx : log1pf(__expf(xx)); }
        else gate[t * 48 + (c - 16)] = sigmoidf(v);
    }
    const float* rc = (const float*)(ws + OFF_ROPE); const float* rs = rc + 4096 * 32;
    bf16* q = (bf16*)(ws + OFF_Q); bf16* kvs = (bf16*)(ws + OFF_KVS);
    for (size_t i = gtid; i < (size_t)T * 16 * 32; i += gn) {
        const int j = (int)(i & 31), h = (int)((i >> 5) & 15), t = (int)(i >> 9), l = t & (L - 1);
        const float c = rc[l * 32 + j], s = rs[l * 32 + j];
        bf16* pp = q + (size_t)t * 1024 + h * 64 + j; const float x1 = bf2f(pp[0]), x2 = bf2f(pp[32]);
        pp[0] = f2bf((x1 * c - x2 * s) * 0.125f); pp[32] = f2bf((x1 * s + x2 * c) * 0.125f);
    }
    for (size_t i = gtid; i < (size_t)T * 8 * 32; i += gn) {
        const int j = (int)(i & 31), hh = (int)((i >> 5) & 7), t = (int)(i >> 8), l = t & (L - 1);
        const float c = rc[l * 32 + j], s = rs[l * 32 + j];
        bf16* pp = kvs + (size_t)t * 1536 + (hh < 4 ? 512 + hh * 64 : 1024 + (hh - 4) * 64) + j; const float x1 = bf2f(pp[0]), x2 = bf2f(pp[32]);
        pp[0] = f2bf(x1 * c - x2 * s); pp[32] = f2bf(x1 * s + x2 * c);
    }
}

__device__ __forceinline__ void ph_ssd_prep2(const Params& p, int wv, unsigned char* lds) {
    PH_IDS(); unsigned char* ws = p.ws;
    const bf16* xsbc = (const bf16*)(ws + OFF_XSBC); const float* dt = (const float*)(ws + OFF_DT);
    bf16* XdT = (bf16*)p.out; bf16* BT = (bf16*)(ws + OFF_BT); float* acsT = (float*)(ws + OFF_ACS);
    float* sdt = (float*)lds; float* swave = sdt + 128;
    for (int unit = bid; unit < 2048 + 256; unit += nb) {
        __syncthreads();
        if (unit < 2048) {
            const int h = unit & 15, bc = unit >> 4; const size_t t0 = (size_t)bc * 128;
            const float A = -__expf(p.a_log[h]);
            if (tid < 128) { const float dv = dt[(t0 + tid) * 16 + h]; sdt[tid] = dv; float a = dv * A;
#pragma unroll
                for (int o = 1; o < 64; o <<= 1) { const float v = __shfl_up(a, o); if (lane >= o) a += v; }
                if (lane == 63) swave[tid >> 6] = a;
                sdt[128 + 8 + tid] = a; }
            __syncthreads();
            if (tid < 128) { float a = sdt[128 + 8 + tid]; if (tid >= 64) a += swave[0]; acsT[(size_t)unit * 128 + tid] = a; }
            const int pp = tid & 63, lg = tid >> 6; const bf16* src = xsbc + (t0 + lg * 16) * 1536 + h * 64 + pp;
            unsigned w[8];
#pragma unroll
            for (int i = 0; i < 8; ++i) { const float v0 = bf2f(src[(size_t)(2 * i) * 1536]) * sdt[lg * 16 + 2 * i], v1 = bf2f(src[(size_t)(2 * i + 1) * 1536]) * sdt[lg * 16 + 2 * i + 1]; w[i] = (unsigned)f2bf(v0) | ((unsigned)f2bf(v1) << 16); }
            uint4* dst = (uint4*)(XdT + (size_t)unit * 8192 + pp * 128 + lg * 16);
            dst[0] = make_uint4(w[0], w[1], w[2], w[3]); dst[1] = make_uint4(w[4], w[5], w[6], w[7]);
        } else {
            const int u2 = unit - 2048, g = u2 & 1, bc = u2 >> 1; const size_t t0 = (size_t)bc * 128;
            const int n = tid & 127, lg = tid >> 7; const bf16* src = xsbc + (t0 + lg * 32) * 1536 + 1024 + g * 128 + n;
            uint4* dst = (uint4*)(BT + (size_t)u2 * 16384 + n * 128 + lg * 32);
#pragma unroll
            for (int k = 0; k < 4; ++k) { unsigned w[4];
#pragma unroll
                for (int i = 0; i < 4; ++i) w[i] = (unsigned)src[(size_t)(8 * k + 2 * i) * 1536] | ((unsigned)src[(size_t)(8 * k + 2 * i + 1) * 1536] << 16);
                dst[k] = make_uint4(w[0], w[1], w[2], w[3]); }
        }
    }
}
__device__ __forceinline__ bf16x8 scale_frag(bf16x8 a, const float* s) {
    bf16x8 o;
#pragma unroll
    for (int j = 0; j < 8; ++j) o[j] = (short)f2bf(bf2f((bf16)a[j]) * s[j]);
    return o;
}
__device__ __forceinline__ void ph_ssd_states(const Params& p, int wv) {
    PH_IDS(); unsigned char* ws = p.ws; const int r = lane & 15, q = lane >> 4;
    const bf16* XdT = (const bf16*)p.out; bf16* S = (bf16*)((unsigned char*)p.out + 32 * MiB); const bf16* BT = (const bf16*)(ws + OFF_BT); const float* acsT = (const float*)(ws + OFF_ACS);
    for (int task = gwave; task < 8192; task += nwaves) {
        const int pt = task & 3, unit = task >> 2, h = unit & 15, bc = unit >> 4, g = h >> 3;
        const float* ac = acsT + (size_t)unit * 128; const float alast = ac[127];
        const bf16* xrow = XdT + (size_t)unit * 8192 + (pt * 16 + r) * 128; const bf16* bt = BT + (size_t)(bc * 2 + g) * 16384 + r * 128;
        f32x4 acc[8];
#pragma unroll
        for (int i = 0; i < 8; ++i) acc[i] = (f32x4){0.f, 0.f, 0.f, 0.f};
#pragma unroll
        for (int ks = 0; ks < 4; ++ks) {
            const int l0 = ks * 32 + 8 * q; float dec[8];
#pragma unroll
            for (int j = 0; j < 8; ++j) dec[j] = __expf(alast - ac[l0 + j]);
            const bf16x8 af = scale_frag(*(const bf16x8*)(xrow + l0), dec);
#pragma unroll
            for (int nt = 0; nt < 8; ++nt) acc[nt] = __builtin_amdgcn_mfma_f32_16x16x32_bf16(af, *(const bf16x8*)(bt + (size_t)nt * 2048 + l0), acc[nt], 0, 0, 0);
        }
        bf16* so = S + (size_t)unit * 8192 + (pt * 16 + 4 * q) * 128 + r;
#pragma unroll
        for (int nt = 0; nt < 8; ++nt)
#pragma unroll
            for (int e = 0; e < 4; ++e) so[e * 128 + nt * 16] = f2bf(acc[nt][e]);
    }
}
__device__ __forceinline__ void ph_ssd_scan(const Params& p, int wv) {
    PH_IDS();
    unsigned* S = (unsigned*)((unsigned char*)p.out + 32 * MiB); const float* acsT = (const float*)(p.ws + OFF_ACS);
    for (int e = gtid; e < NBATCH * 16 * 4096; e += gn) {
        const int pn = e & 4095, h = (e >> 12) & 15, b = e >> 16; float r0 = 0.f, r1 = 0.f;
        for (int c = 0; c < 32; c += 4) {
            unsigned v[4]; float d[4];
#pragma unroll
            for (int u = 0; u < 4; ++u) { const int unit = (b * 32 + c + u) * 16 + h; v[u] = S[(size_t)unit * 4096 + pn]; d[u] = __expf(acsT[(size_t)unit * 128 + 127]); }
#pragma unroll
            for (int u = 0; u < 4; ++u) { const int unit = (b * 32 + c + u) * 16 + h; S[(size_t)unit * 4096 + pn] = (unsigned)f2bf(r0) | ((unsigned)f2bf(r1) << 16);
                r0 = r0 * d[u] + bf2f((bf16)(v[u] & 0xffffu)); r1 = r1 * d[u] + bf2f((bf16)(v[u] >> 16)); }
        }
    }
}
__device__ __forceinline__ void ph_ssd_out(const Params& p, int wv) {
    PH_IDS(); unsigned char* ws = p.ws; const int r = lane & 15, q = lane >> 4;
    const bf16* XdT = (const bf16*)p.out; const bf16* S = (const bf16*)((unsigned char*)p.out + 32 * MiB); const bf16* xsbc = (const bf16*)(ws + OFF_XSBC);
    const float* acsT = (const float*)(ws + OFF_ACS); bf16* z = (bf16*)(ws + OFF_Z); float* ssq2 = (float*)(ws + OFF_SSQ) + T;
    for (int task = gwave; task < 16384; task += nwaves) {
        const int lt = 7 - (task & 7), unit = task >> 3, h = unit & 15, bc = unit >> 4, g = h >> 3; const size_t t0 = (size_t)bc * 128;
        const float* ac = acsT + (size_t)unit * 128; const float Dh = p.d_skip[h];
        bf16x8 Cf[4];
#pragma unroll
        for (int ks = 0; ks < 4; ++ks) Cf[ks] = *(const bf16x8*)(xsbc + (t0 + lt * 16 + r) * 1536 + 1280 + g * 128 + ks * 32 + 8 * q);
        const float acl = ac[lt * 16 + r]; const int lrow = lt * 16 + r;
        f32x4 acc[4];
#pragma unroll
        for (int i = 0; i < 4; ++i) acc[i] = (f32x4){0.f, 0.f, 0.f, 0.f};
        const bf16* xd = XdT + (size_t)unit * 8192 + r * 128;
        for (int kk = 0; kk <= (lt >> 1); ++kk) {
            bf16x8 mf;
#pragma unroll
            for (int half = 0; half < 2; ++half) {
                const int st = 2 * kk + half; f32x4 cb = (f32x4){0.f, 0.f, 0.f, 0.f};
                if (st <= lt) {
                    const bf16* brow = xsbc + (t0 + st * 16 + r) * 1536 + 1024 + g * 128 + 8 * q;
#pragma unroll
                    for (int ks = 0; ks < 4; ++ks) cb = __builtin_amdgcn_mfma_f32_16x16x32_bf16(*(const bf16x8*)(brow + ks * 32), Cf[ks], cb, 0, 0, 0);
                    const f32x4 as4 = *(const f32x4*)(ac + st * 16 + 4 * q);
#pragma unroll
                    for (int e = 0; e < 4; ++e) { const int s = st * 16 + 4 * q + e; cb[e] = (lrow >= s) ? cb[e] * __expf(acl - as4[e]) : 0.f; }
                }
#pragma unroll
                for (int e = 0; e < 4; ++e) mf[half * 4 + e] = (short)f2bf(cb[e]);
            }
#pragma unroll
            for (int pt = 0; pt < 4; ++pt) {
                const uint2 lo = *(const uint2*)(xd + (size_t)pt * 2048 + 32 * kk + 4 * q), hi = *(const uint2*)(xd + (size_t)pt * 2048 + 32 * kk + 16 + 4 * q);
                union { uint4 u; bf16x8 v; } xf; xf.u = make_uint4(lo.x, lo.y, hi.x, hi.y);
                acc[pt] = __builtin_amdgcn_mfma_f32_16x16x32_bf16(mf, xf.v, acc[pt], 0, 0, 0);
            }
        }
        f32x4 acc2[4];
#pragma unroll
        for (int i = 0; i < 4; ++i) acc2[i] = (f32x4){0.f, 0.f, 0.f, 0.f};
        const bf16* sin = S + (size_t)unit * 8192 + r * 128 + 8 * q;
#pragma unroll
        for (int ks = 0; ks < 4; ++ks)
#pragma unroll
            for (int pt = 0; pt < 4; ++pt) acc2[pt] = __builtin_amdgcn_mfma_f32_16x16x32_bf16(Cf[ks], *(const bf16x8*)(sin + (size_t)pt * 2048 + ks * 32), acc2[pt], 0, 0, 0);
#pragma unroll
        for (int e = 0; e < 4; ++e) {
            const int l = lt * 16 + 4 * q + e; const size_t t = t0 + l; const float od = __expf(ac[l]); float ss = 0.f;
#pragma unroll
            for (int pt = 0; pt < 4; ++pt) { const int col = h * 64 + pt * 16 + r; const float xv = bf2f(xsbc[t * 1536 + col]);
                const float y = acc[pt][e] + od * acc2[pt][e] + Dh * xv; const float zz = bf2f(z[t * 1024 + col]); const float v = y * (zz * sigmoidf(zz));
                z[t * 1024 + col] = f2bf(v); ss += v * v; }
            ss += __shfl_xor(ss, 1); ss += __shfl_xor(ss, 2); ss += __shfl_xor(ss, 4); ss += __shfl_xor(ss, 8);
            if (r == 0) atomicAdd(&ssq2[t * 2 + g], ss);
        }
    }
}

struct ACmp {
    const bf16* kvs; int coff;
    __device__ __forceinline__ bf16x8 operator()(int m, int k) const {
        const int hk = m & 3, n = (m >> 2) & 255, b = m >> 10, l = k >> 6, d = k & 63;
        if (n == 255) return (bf16x8){0, 0, 0, 0, 0, 0, 0, 0};
        return *(const bf16x8*)(kvs + (size_t)(b * L + 16 * n + l) * 1536 + coff + hk * 64 + d);
    }
};
struct EpiHid { bf16* hid; const float* bias; __device__ __forceinline__ void operator()(int row, int c, float v) const { hid[(size_t)row * 256 + c] = f2bf(gelu_exact(v + bias[c])); } };
struct EpiKc {
    bf16* dst; bool tr; __device__ __forceinline__ void operator()(int m, int c, float v) const { const int hk = m & 3, n = (m >> 2) & 255, b = m >> 10; const bf16 o = (n == 255) ? (bf16)0 : f2bf(v);
        if (tr) dst[((size_t)(b * 4 + hk) * 64 + c) * 256 + n] = o; else dst[((size_t)(b * 4 + hk) * 256 + n) * 64 + c] = o; } };
__device__ __forceinline__ void ph_kc_rope(const Params& p, int wv) {
    PH_IDS(); unsigned char* ws = p.ws; bf16* kc = (bf16*)(ws + OFF_KC); const float* rc = (const float*)(ws + OFF_ROPE); const float* rs = rc + 4096 * 32;
    for (int i = gtid; i < 16 * 256 * 32; i += gn) {
        const int j = i & 31, n = (i >> 5) & 255, bh = i >> 13; const int pos = 16 * n + 31; if (n == 255) continue;
        const float c = rc[pos * 32 + j], s = rs[pos * 32 + j];
        bf16* pp = kc + ((size_t)bh * 256 + n) * 64 + j; const float x1 = bf2f(pp[0]), x2 = bf2f(pp[32]);
        pp[0] = f2bf(x1 * c - x2 * s); pp[32] = f2bf(x1 * s + x2 * c);
    }
}


__device__ __forceinline__ void ph_vt_prep(const Params& p, int wv) {
    PH_IDS(); unsigned char* ws = p.ws; const bf16* kvs = (const bf16*)(ws + OFF_KVS);
    for (int unit = bid; unit < 2 * 16 * 64; unit += nb) {
        const int br = unit & 1, tl = (unit >> 1) & 63, bh = unit >> 7, b = bh >> 2, hk = bh & 3;
        const int d = tid & 63, grp = tid >> 6; const int l0 = tl * 64 + grp * 8;
        const bf16* src = kvs + ((size_t)b * L + l0) * 1536 + (br ? 1280 : 768) + hk * 64 + d;
        unsigned w[4];
#pragma unroll
        for (int i = 0; i < 4; ++i) w[i] = (unsigned)src[(size_t)(2 * i) * 1536] | ((unsigned)src[(size_t)(2 * i + 1) * 1536] << 16);
        bf16* dst = (bf16*)(ws + (br ? OFF_VWT : OFF_VST)) + ((size_t)bh * 64 + d) * L + l0;
        *(uint4*)dst = make_uint4(w[0], w[1], w[2], w[3]);
    }
}

typedef float f32x16 __attribute__((ext_vector_type(16)));
typedef float f32x2v __attribute__((ext_vector_type(2)));
typedef __bf16 bf16x2v __attribute__((ext_vector_type(2)));
__device__ __forceinline__ unsigned pk2bf(float lo, float hi) { f32x2v v = {lo, hi}; bf16x2v b = __builtin_convertvector(v, bf16x2v); return __builtin_bit_cast(unsigned, b); }
__device__ __forceinline__ int crow(int r, int hi) { return (r & 3) + 8 * (r >> 2) + 4 * hi; }
constexpr int NSA_KROW = 144, NSA_VROW = 136, NSA_KBUF = 64 * NSA_KROW, NSA_VBUF = 64 * NSA_VROW;
constexpr int NSA_OFF_K = 0, NSA_OFF_V = 2 * NSA_KBUF, NSA_OFF_IMPA = NSA_OFF_V + 2 * NSA_VBUF, NSA_IMPS = 65, NSA_OFF_IMPB = NSA_OFF_IMPA + 64 * NSA_IMPS * 4, NSA_OFF_SEL = NSA_OFF_IMPB + 64 * NSA_IMPS * 4;
struct NsaSrc { const bf16* K; size_t kstride; const bf16* VT; size_t ldv; };
__device__ __forceinline__ void nsa_gload(const NsaSrc& s, int k0, int tid, uint4& kr, uint4& vr) {
    const int row = tid >> 3, ch = tid & 7;
    kr = *(const uint4*)(s.K + (size_t)(k0 + row) * s.kstride + ch * 8);
    vr = *(const uint4*)(s.VT + (size_t)row * s.ldv + k0 + ch * 8);
}
__device__ __forceinline__ void nsa_lstore(unsigned char* kb, unsigned char* vb, int tid, const uint4& kr, const uint4& vr) {
    const int row = tid >> 3, ch = tid & 7;
    *(uint4*)(kb + row * NSA_KROW + ch * 16) = kr;
    uint2* vp = (uint2*)(vb + row * NSA_VROW + ch * 16); vp[0] = make_uint2(vr.x, vr.y); vp[1] = make_uint2(vr.z, vr.w);
}
__device__ __forceinline__ void nsa_qk(const unsigned char* kb, const bf16x8 (&qf)[4], int rr, int hi, f32x16& p0, f32x16& p1) {
#pragma unroll
    for (int i = 0; i < 16; ++i) { p0[i] = 0.f; p1[i] = 0.f; }
#pragma unroll
    for (int ds = 0; ds < 4; ++ds) {
        const bf16x8 a0 = *(const bf16x8*)(kb + rr * NSA_KROW + ds * 32 + hi * 16), a1 = *(const bf16x8*)(kb + (rr + 32) * NSA_KROW + ds * 32 + hi * 16);
        p0 = __builtin_amdgcn_mfma_f32_32x32x16_bf16(a0, qf[ds], p0, 0, 0, 0); p1 = __builtin_amdgcn_mfma_f32_32x32x16_bf16(a1, qf[ds], p1, 0, 0, 0);
    }
}
__device__ __forceinline__ void nsa_pv(const unsigned char* vb, int rr, int hi, const f32x16& p0, const f32x16& p1, f32x16 (&O)[2]) {
#pragma unroll
    for (int s = 0; s < 4; ++s) {
        const int eb = 8 * (s & 1), kbase = 32 * (s >> 1) + 16 * (s & 1);
        union { uint4 u; bf16x8 v; } pf;
        if (s < 2) pf.u = make_uint4(pk2bf(p0[eb], p0[eb + 1]), pk2bf(p0[eb + 2], p0[eb + 3]), pk2bf(p0[eb + 4], p0[eb + 5]), pk2bf(p0[eb + 6], p0[eb + 7]));
        else       pf.u = make_uint4(pk2bf(p1[eb], p1[eb + 1]), pk2bf(p1[eb + 2], p1[eb + 3]), pk2bf(p1[eb + 4], p1[eb + 5]), pk2bf(p1[eb + 6], p1[eb + 7]));
#pragma unroll
        for (int dsub = 0; dsub < 2; ++dsub) {
            const unsigned char* vp = vb + (dsub * 32 + rr) * NSA_VROW + (kbase + 4 * hi) * 2;
            const uint2 lo = *(const uint2*)vp, hh = *(const uint2*)(vp + 16);
            union { uint4 u; bf16x8 v; } vf; vf.u = make_uint4(lo.x, lo.y, hh.x, hh.y);
            O[dsub] = __builtin_amdgcn_mfma_f32_32x32x16_bf16(vf.v, pf.v, O[dsub], 0, 0, 0);
        }
    }
}
template <int MODE>
__device__ __forceinline__ void nsa_branch(unsigned char* lds, const NsaSrc& src, int jt0, int jt1, int tid, int rr, int hi, const bf16x8 (&qf)[4], int lpos, int qi, int tokblk,
                                           u64 selm, u64 wsel, float& m, float& lsum, float inv_l, f32x16 (&O)[2]) {
    if (jt0 >= jt1) return;
    asm volatile("" : "+v"(tid), "+v"(rr));
    float* impA = (float*)(lds + NSA_OFF_IMPA); float* impB = (float*)(lds + NSA_OFF_IMPB);
    uint4 kr, vr;
    nsa_gload(src, jt0 * 64, tid, kr, vr);
    nsa_lstore(lds + NSA_OFF_K, lds + NSA_OFF_V, tid, kr, vr);
    __syncthreads();
    for (int jt = jt0; jt < jt1; ++jt) {
        const int cur = (jt - jt0) & 1; const bool more = (jt + 1 < jt1);
        if (more) nsa_gload(src, (jt + 1) * 64, tid, kr, vr);
        const unsigned char* kb = lds + NSA_OFF_K + cur * NSA_KBUF; const unsigned char* vb = lds + NSA_OFF_V + cur * NSA_VBUF;
        const bool active = (MODE != 2) || ((wsel >> jt) & 1ull);
        if (active) {
            f32x16 p0, p1; nsa_qk(kb, qf, rr, hi, p0, p1);
            const int k0 = jt * 64;
            const bool tile_on = (MODE != 2) || ((selm >> jt) & 1ull);
            float mx = NEG_INF;
#pragma unroll
            for (int e = 0; e < 16; ++e) {
                const int ka = k0 + crow(e, hi), kb2 = ka + 32; bool oa, ob;
                if (MODE <= 1) { oa = (16 * ka + 31 <= lpos); ob = (16 * kb2 + 31 <= lpos); }
                else if (MODE == 2) { oa = tile_on && (ka <= lpos); ob = tile_on && (kb2 <= lpos); }
                else { oa = (ka <= lpos) && (ka > lpos - 512); ob = (kb2 <= lpos) && (kb2 > lpos - 512); }
                p0[e] = oa ? p0[e] : NEG_INF; p1[e] = ob ? p1[e] : NEG_INF; mx = fmaxf(mx, fmaxf(p0[e], p1[e]));
            }
            if (MODE != 1) {
                mx = fmaxf(mx, __shfl_xor(mx, 32));
                const float mnew = fmaxf(m, mx), alpha = __expf(m - mnew); m = mnew; float rs = 0.f;
#pragma unroll
                for (int e = 0; e < 16; ++e) { p0[e] = (p0[e] > 0.5f * NEG_INF) ? __expf(p0[e] - mnew) : 0.f; p1[e] = (p1[e] > 0.5f * NEG_INF) ? __expf(p1[e] - mnew) : 0.f; rs += p0[e] + p1[e]; }
                lsum = lsum * alpha + rs;
                if (MODE != 0) {
#pragma unroll
                    for (int e = 0; e < 16; ++e) { O[0][e] *= alpha; O[1][e] *= alpha; }
                    nsa_pv(vb, rr, hi, p0, p1, O);
                }
            } else {
#pragma unroll
                for (int e = 0; e < 16; ++e) { p0[e] = (p0[e] > 0.5f * NEG_INF) ? __expf(p0[e] - m) * inv_l : 0.f; p1[e] = (p1[e] > 0.5f * NEG_INF) ? __expf(p1[e] - m) * inv_l : 0.f; }
                nsa_pv(vb, rr, hi, p0, p1, O);
#pragma unroll
                for (int sub = 0; sub < 2; ++sub)
#pragma unroll
                    for (int a = 0; a < 4; ++a) {
                        float G, last;
                        if (sub == 0) { G = (p0[4 * a] + p0[4 * a + 1]) + (p0[4 * a + 2] + p0[4 * a + 3]); last = p0[4 * a + 3]; } else { G = (p1[4 * a] + p1[4 * a + 1]) + (p1[4 * a + 2] + p1[4 * a + 3]); last = p1[4 * a + 3]; }
                        G += __shfl_xor(G, 1); G += __shfl_xor(G, 2); last += __shfl_xor(last, 1); last += __shfl_xor(last, 2);
                        const int jj = (k0 >> 2) + 8 * sub + 2 * a + hi;
                        if ((rr & 3) == 0) { impA[tokblk * NSA_IMPS + jj] = G; if (jj + 1 < 64) impB[tokblk * NSA_IMPS + jj + 1] = last; }
                    }
            }
        }
        if (more) nsa_lstore(lds + NSA_OFF_K + (cur ^ 1) * NSA_KBUF, lds + NSA_OFF_V + (cur ^ 1) * NSA_VBUF, tid, kr, vr);
        __syncthreads();
    }
}
__device__ __forceinline__ void ph_nsa(const Params& p, int wv, unsigned char* lds) {
    PH_IDS(); unsigned char* ws = p.ws; const int wave = wv, rr = lane & 31, hi = lane >> 5;
    bf16* q = (bf16*)(ws + OFF_Q); const bf16* kvs = (const bf16*)(ws + OFF_KVS);
    const float* gate = (const float*)(ws + OFF_GATE); float* ssq = (float*)(ws + OFF_SSQ);
    float* impA = (float*)(lds + NSA_OFF_IMPA); float* impB = (float*)(lds + NSA_OFF_IMPB); u64* selw = (u64*)(lds + NSA_OFF_SEL);
    const int nunits = 1024;
    for (int it = 0; ; ++it) {
        int bh, qi;
        if (nb == 256) { if (it >= 4) break; bh = bid & 15; const int x = bid >> 4; qi = (it == 0) ? 63 - x : (it == 1) ? 32 + x : (it == 2) ? 31 - x : x; }
        else { const int u = bid + it * nb; if (u >= nunits) break; bh = u & 15; qi = 63 - (u >> 4); }
        const int b = bh >> 2, hk = bh & 3; const int tokblk = wave * 8 + (rr >> 2), g = rr & 3; const int lpos = qi * 64 + tokblk; const size_t t = (size_t)b * L + lpos;
        bf16* qrow = q + t * 1024 + (hk * 4 + g) * 64;
        bf16x8 qf[4];
#pragma unroll
        for (int ds = 0; ds < 4; ++ds) qf[ds] = *(const bf16x8*)(qrow + ds * 16 + hi * 8);
        for (int i = tid; i < 64 * NSA_IMPS; i += NTHREADS) { impA[i] = 0.f; impB[i] = 0.f; }
        __syncthreads();
        f32x16 outacc[2]; f32x16 O[2];
#pragma unroll
        for (int e = 0; e < 16; ++e) { outacc[0][e] = 0.f; outacc[1][e] = 0.f; }
        const float g0 = gate[t * 48 + (hk * 4 + g) * 3 + 0], g1 = gate[t * 48 + (hk * 4 + g) * 3 + 1], g2 = gate[t * 48 + (hk * 4 + g) * 3 + 2];
        {
            NsaSrc s{(const bf16*)(ws + OFF_KC) + (size_t)bh * 256 * 64, 64, (const bf16*)(ws + OFF_VCT) + (size_t)bh * 64 * 256, 256};
            const int nct = (4 * qi + 3 + 63) >> 6;
            float m = NEG_INF, lsum = 0.f;
            nsa_branch<0>(lds, s, 0, nct, tid, rr, hi, qf, lpos, qi, tokblk, 0ull, 0ull, m, lsum, 0.f, O);
            lsum += __shfl_xor(lsum, 32);
            const float inv_l = lsum > 0.f ? 1.0f / lsum : 0.f;
#pragma unroll
            for (int e = 0; e < 16; ++e) { O[0][e] = 0.f; O[1][e] = 0.f; }
            nsa_branch<1>(lds, s, 0, nct, tid, rr, hi, qf, lpos, qi, tokblk, 0ull, 0ull, m, lsum, inv_l, O);
#pragma unroll
            for (int e = 0; e < 16; ++e) { outacc[0][e] += g0 * O[0][e]; outacc[1][e] += g0 * O[1][e]; }
        }
        {
            const int tk = tid >> 3, jg = tid & 7; float v[8];
#pragma unroll
            for (int i = 0; i < 8; ++i) { const int j = jg * 8 + i; const float raw = impA[tk * NSA_IMPS + j] + impB[tk * NSA_IMPS + j];
                const bool causal = (j <= qi), forced = (j == 0) || (j == qi) || (j == qi - 1); v[i] = causal ? (forced ? BIG : raw) : NEG_INF; }
            __syncthreads();
#pragma unroll
            for (int i = 0; i < 8; ++i) impA[tk * NSA_IMPS + jg * 8 + i] = v[i];
            __syncthreads();
            int rank[8];
#pragma unroll
            for (int i = 0; i < 8; ++i) rank[i] = 0;
            for (int jj = 0; jj < 64; ++jj) { const float x = impA[tk * NSA_IMPS + jj];
#pragma unroll
                for (int i = 0; i < 8; ++i) rank[i] += (x > v[i] || (x == v[i] && jj < jg * 8 + i)) ? 1 : 0; }
            unsigned b8 = 0u;
#pragma unroll
            for (int i = 0; i < 8; ++i) b8 |= (rank[i] < 16 && jg * 8 + i <= qi) ? (1u << i) : 0u;
            const u64 full = (u64)b8 << (jg * 8); unsigned blo = (unsigned)full, bhi = (unsigned)(full >> 32);
            blo |= __shfl_xor(blo, 1); bhi |= __shfl_xor(bhi, 1); blo |= __shfl_xor(blo, 2); bhi |= __shfl_xor(bhi, 2); blo |= __shfl_xor(blo, 4); bhi |= __shfl_xor(bhi, 4);
            if (jg == 0) selw[tk] = (u64)blo | ((u64)bhi << 32);
            __syncthreads();
        }
        const u64 selm = selw[tokblk];
        u64 wsel = selm;
        { unsigned lo = (unsigned)wsel, h2 = (unsigned)(wsel >> 32);
          lo |= __shfl_xor(lo, 4); h2 |= __shfl_xor(h2, 4); lo |= __shfl_xor(lo, 8); h2 |= __shfl_xor(h2, 8); lo |= __shfl_xor(lo, 16); h2 |= __shfl_xor(h2, 16);
          wsel = (u64)lo | ((u64)h2 << 32); }
        {
            NsaSrc s{kvs + (size_t)b * L * 1536 + 512 + hk * 64, 1536, (const bf16*)(ws + OFF_VST) + (size_t)bh * 64 * L, (size_t)L};
            float m = NEG_INF, lsum = 0.f;
#pragma unroll
            for (int e = 0; e < 16; ++e) { O[0][e] = 0.f; O[1][e] = 0.f; }
            nsa_branch<2>(lds, s, 0, qi + 1, tid, rr, hi, qf, lpos, qi, tokblk, selm, wsel, m, lsum, 0.f, O);
            lsum += __shfl_xor(lsum, 32); const float sc = g1 / lsum;
#pragma unroll
            for (int e = 0; e < 16; ++e) { outacc[0][e] += sc * O[0][e]; outacc[1][e] += sc * O[1][e]; }
        }
        {
            NsaSrc s{kvs + (size_t)b * L * 1536 + 1024 + hk * 64, 1536, (const bf16*)(ws + OFF_VWT) + (size_t)bh * 64 * L, (size_t)L};
            float m = NEG_INF, lsum = 0.f;
#pragma unroll
            for (int e = 0; e < 16; ++e) { O[0][e] = 0.f; O[1][e] = 0.f; }
            nsa_branch<3>(lds, s, qi >= 8 ? qi - 8 : 0, qi + 1, tid, rr, hi, qf, lpos, qi, tokblk, 0ull, 0ull, m, lsum, 0.f, O);
            lsum += __shfl_xor(lsum, 32); const float sc = g2 / lsum;
#pragma unroll
            for (int e = 0; e < 16; ++e) { outacc[0][e] += sc * O[0][e]; outacc[1][e] += sc * O[1][e]; }
        }
        float ss = 0.f;
#pragma unroll
        for (int dsub = 0; dsub < 2; ++dsub)
#pragma unroll
            for (int a = 0; a < 4; ++a) {
                const float v0 = outacc[dsub][4 * a], v1 = outacc[dsub][4 * a + 1], v2 = outacc[dsub][4 * a + 2], v3 = outacc[dsub][4 * a + 3];
                ss += (v0 * v0 + v1 * v1) + (v2 * v2 + v3 * v3);
                *(uint2*)(qrow + dsub * 32 + 8 * a + 4 * hi) = make_uint2(pk2bf(v0, v1), pk2bf(v2, v3));
            }
        ss += __shfl_xor(ss, 32); ss += __shfl_xor(ss, 1); ss += __shfl_xor(ss, 2);
        if (hi == 0 && g == 0) atomicAdd(&ssq[t], ss);
        __syncthreads();
    }
}

__device__ __forceinline__ void ph_nsa_naive(const Params& p, int wv, unsigned char* lds) {
    PH_IDS(); unsigned char* ws = p.ws; const int wave = wv;
    float* qs = (float*)(lds + wave * 17408); float* sbuf = qs + 256;
    bf16* q = (bf16*)(ws + OFF_Q); const bf16* kvs = (const bf16*)(ws + OFF_KVS);
    const bf16* kc = (const bf16*)(ws + OFF_KC); const bf16* vc = (const bf16*)(ws + OFF_VC);
    const float* gate = (const float*)(ws + OFF_GATE); float* ssq = (float*)(ws + OFF_SSQ);
    for (int task = gwave; task < T * 4; task += nwaves) {
        const int hk = task & 3, t = task >> 2, b = t >> 12, l = t & (L - 1), tb = l >> 6;
        bf16* qrow = q + (size_t)t * 1024 + hk * 256;
        __builtin_amdgcn_s_waitcnt(0);
#pragma unroll
        for (int g = 0; g < 4; ++g) qs[g * 64 + lane] = bf2f(qrow[g * 64 + lane]);
        float outv[4] = {0.f, 0.f, 0.f, 0.f};
        const bf16* kcb = kc + (size_t)(b * 4 + hk) * 256 * 64; const bf16* vcb = vc + (size_t)(b * 4 + hk) * 256 * 64;
        float m4[4] = {NEG_INF, NEG_INF, NEG_INF, NEG_INF};
#pragma unroll 1
        for (int c = 0; c < 4; ++c) {
            const int n = c * 64 + lane; const bool valid = (n < 255) && (16 * n + 31 <= l);
            float s[4] = {0.f, 0.f, 0.f, 0.f};
            const bf16* kr = kcb + (size_t)n * 64;
#pragma unroll 4
            for (int d = 0; d < 64; ++d) { const float kv = bf2f(kr[d]);
#pragma unroll
                for (int g = 0; g < 4; ++g) s[g] += qs[g * 64 + d] * kv; }
#pragma unroll
            for (int g = 0; g < 4; ++g) { const float sv = valid ? s[g] : NEG_INF; sbuf[g * 1024 + n] = sv; m4[g] = fmaxf(m4[g], sv); }
        }
        const bool anyvalid = (l >= 31);
        float sum4[4];
#pragma unroll
        for (int g = 0; g < 4; ++g) { m4[g] = wave_max(m4[g]); sum4[g] = 0.f; }
#pragma unroll 1
        for (int c = 0; c < 4; ++c) { const int n = c * 64 + lane;
#pragma unroll
            for (int g = 0; g < 4; ++g) { const float sv = sbuf[g * 1024 + n]; const float e = (sv > 0.5f * NEG_INF) ? __expf(sv - m4[g]) : 0.f; sbuf[g * 1024 + n] = e; sum4[g] += e; } }
#pragma unroll
        for (int g = 0; g < 4; ++g) { sum4[g] = wave_sum(sum4[g]); sum4[g] = anyvalid ? 1.0f / sum4[g] : 0.f; }
#pragma unroll 1
        for (int c = 0; c < 4; ++c) { const int n = c * 64 + lane;
#pragma unroll
            for (int g = 0; g < 4; ++g) sbuf[g * 1024 + n] *= sum4[g]; }
        __builtin_amdgcn_s_waitcnt(0);
        float imp = 0.f;
        { const int j = lane;
          for (int n = 4 * j - 1; n <= 4 * j + 3; ++n) if (n >= 0 && n < 255) { imp += sbuf[n] + sbuf[1024 + n] + sbuf[2048 + n] + sbuf[3072 + n]; }
          const bool causal = (j <= tb), forced = (j == 0) || (j == tb) || (j == tb - 1);
          imp = causal ? (forced ? BIG : imp) : NEG_INF; }
        int rank = 0;
#pragma unroll 1
        for (int jj = 0; jj < 64; ++jj) { const float v = __shfl(imp, jj); rank += (v > imp || (v == imp && jj < lane)) ? 1 : 0; }
        const bool sel = (rank < 16) && (lane <= tb);
        const u64 selmask = __ballot(sel);
        { float oc[4] = {0.f, 0.f, 0.f, 0.f};
          if (anyvalid) { const int nmax = (l - 31) / 16;
            for (int n = 0; n <= nmax; ++n) { const float vv = bf2f(vcb[(size_t)n * 64 + lane]);
#pragma unroll
                for (int g = 0; g < 4; ++g) oc[g] += sbuf[g * 1024 + n] * vv; } }
#pragma unroll
          for (int g = 0; g < 4; ++g) outv[g] += gate[(size_t)t * 48 + (hk * 4 + g) * 3 + 0] * oc[g]; }
        __builtin_amdgcn_s_waitcnt(0);
        {
            const bf16* ksb = kvs + (size_t)b * L * 1536 + 512 + hk * 64; const bf16* vsb = kvs + (size_t)b * L * 1536 + 768 + hk * 64;
            float mx[4] = {NEG_INF, NEG_INF, NEG_INF, NEG_INF}; int cnt = 0;
            for (u64 mm = selmask; mm; mm &= mm - 1, ++cnt) {
                const int j = __builtin_ctzll(mm); const int kp = j * 64 + lane; const bool ok = kp <= l;
                const bf16* kr = ksb + (size_t)kp * 1536; float s[4] = {0.f, 0.f, 0.f, 0.f};
#pragma unroll 4
                for (int d = 0; d < 64; ++d) { const float kv = bf2f(kr[d]);
#pragma unroll
                    for (int g = 0; g < 4; ++g) s[g] += qs[g * 64 + d] * kv; }
#pragma unroll
                for (int g = 0; g < 4; ++g) { const float sv = ok ? s[g] : NEG_INF; sbuf[g * 1024 + cnt * 64 + lane] = sv; mx[g] = fmaxf(mx[g], sv); }
            }
            float sm[4];
#pragma unroll
            for (int g = 0; g < 4; ++g) { mx[g] = wave_max(mx[g]); sm[g] = 0.f; }
            for (int c = 0; c < cnt; ++c)
#pragma unroll
                for (int g = 0; g < 4; ++g) { const float sv = sbuf[g * 1024 + c * 64 + lane]; const float e = (sv > 0.5f * NEG_INF) ? __expf(sv - mx[g]) : 0.f; sbuf[g * 1024 + c * 64 + lane] = e; sm[g] += e; }
#pragma unroll
            for (int g = 0; g < 4; ++g) sm[g] = 1.0f / wave_sum(sm[g]);
            __builtin_amdgcn_s_waitcnt(0);
            float os[4] = {0.f, 0.f, 0.f, 0.f}; int c = 0;
            for (u64 mm = selmask; mm; mm &= mm - 1, ++c) {
                const int j = __builtin_ctzll(mm); const int kmax = min(63, l - j * 64);
                for (int kk = 0; kk <= kmax; ++kk) { const float vv = bf2f(vsb[(size_t)(j * 64 + kk) * 1536 + lane]);
#pragma unroll
                    for (int g = 0; g < 4; ++g) os[g] += sbuf[g * 1024 + c * 64 + kk] * vv; }
            }
#pragma unroll
            for (int g = 0; g < 4; ++g) outv[g] += gate[(size_t)t * 48 + (hk * 4 + g) * 3 + 1] * os[g] * sm[g];
        }
        __builtin_amdgcn_s_waitcnt(0);
        {
            const bf16* kwb = kvs + (size_t)b * L * 1536 + 1024 + hk * 64; const bf16* vwb = kvs + (size_t)b * L * 1536 + 1280 + hk * 64;
            const int k0 = l - 511; float mx[4] = {NEG_INF, NEG_INF, NEG_INF, NEG_INF};
#pragma unroll 1
            for (int c = 0; c < 8; ++c) {
                const int kp = k0 + c * 64 + lane; const bool ok = kp >= 0; float s[4] = {0.f, 0.f, 0.f, 0.f};
                if (ok) { const bf16* kr = kwb + (size_t)kp * 1536;
#pragma unroll 4
                    for (int d = 0; d < 64; ++d) { const float kv = bf2f(kr[d]);
#pragma unroll
                        for (int g = 0; g < 4; ++g) s[g] += qs[g * 64 + d] * kv; } }
#pragma unroll
                for (int g = 0; g < 4; ++g) { const float sv = ok ? s[g] : NEG_INF; sbuf[g * 1024 + c * 64 + lane] = sv; mx[g] = fmaxf(mx[g], sv); }
            }
            float sm[4];
#pragma unroll
            for (int g = 0; g < 4; ++g) { mx[g] = wave_max(mx[g]); sm[g] = 0.f; }
#pragma unroll 1
            for (int c = 0; c < 8; ++c)
#pragma unroll
                for (int g = 0; g < 4; ++g) { const float sv = sbuf[g * 1024 + c * 64 + lane]; const float e = (sv > 0.5f * NEG_INF) ? __expf(sv - mx[g]) : 0.f; sbuf[g * 1024 + c * 64 + lane] = e; sm[g] += e; }
#pragma unroll
            for (int g = 0; g < 4; ++g) sm[g] = 1.0f / wave_sum(sm[g]);
            __builtin_amdgcn_s_waitcnt(0);
            float ow[4] = {0.f, 0.f, 0.f, 0.f};
            for (int i = (k0 < 0 ? -k0 : 0); i < 512; ++i) { const float vv = bf2f(vwb[(size_t)(k0 + i) * 1536 + lane]);
#pragma unroll
                for (int g = 0; g < 4; ++g) ow[g] += sbuf[g * 1024 + i] * vv; }
#pragma unroll
            for (int g = 0; g < 4; ++g) outv[g] += gate[(size_t)t * 48 + (hk * 4 + g) * 3 + 2] * ow[g] * sm[g];
        }
        float ss = 0.f;
#pragma unroll
        for (int g = 0; g < 4; ++g) { qrow[g * 64 + lane] = f2bf(outv[g]); ss += outv[g] * outv[g]; }
        ss = wave_sum(ss); if (lane == 0) atomicAdd(&ssq[t], ss);
    }
}

__device__ __forceinline__ void ph_ln1(const Params& p, int wv) {
    PH_IDS(); unsigned char* ws = p.ws; bf16* h1b = (bf16*)(ws + OFF_H1B);
    for (int t = gwave; t < T; t += nwaves) {
        float v[16]; float s = 0.f; float* row = p.out + (size_t)t * 1024;
#pragma unroll
        for (int i = 0; i < 16; ++i) { v[i] = row[i * 64 + lane]; s += v[i]; }
        const float mu = wave_sum(s) * (1.0f / 1024.0f); float s2 = 0.f;
#pragma unroll
        for (int i = 0; i < 16; ++i) { v[i] -= mu; s2 += v[i] * v[i]; }
        const float rstd = rsqrtf(wave_sum(s2) * (1.0f / 1024.0f) + LN_EPS);
#pragma unroll
        for (int i = 0; i < 16; ++i) { const int c = i * 64 + lane; const float o = v[i] * rstd * p.ln1_g[c] + p.ln1_b[c]; row[c] = o; h1b[(size_t)t * 1024 + c] = f2bf(o); }
    }
}

__device__ __forceinline__ void ph_peer_topk(const Params& p, int wv, unsigned char* lds) {
    PH_IDS(); unsigned char* ws = p.ws; const int rr = lane & 31, hi = lane >> 5;
    float* sv = (float*)(lds + wv * 12288); int* si = (int*)(sv + 1024); float* gv = (float*)(si + 1024); int* ge = (int*)(gv + 512);
    const bf16* qp = (const bf16*)(ws + OFF_QP); const bf16* keys = (const bf16*)(ws + OFF_KEYS);
    int* eidx = (int*)(ws + OFF_EIDX); float* gw = (float*)(ws + OFF_GW);
    const float NEGB = -3.0e38f;
    for (int task = gwave; task < 512 * 8; task += nwaves) {
        const int h = task & 7, t0 = (task >> 3) * 32;
#pragma unroll 1
        for (int c = 0; c < 2; ++c) {
            bf16x8 qf[8];
#pragma unroll
            for (int ks = 0; ks < 8; ++ks) qf[ks] = *(const bf16x8*)(qp + (size_t)(t0 + rr) * 2048 + h * 256 + c * 128 + ks * 16 + 8 * hi);
            f32x16 acc[4];
#pragma unroll
            for (int kt = 0; kt < 4; ++kt) {
#pragma unroll
                for (int e = 0; e < 16; ++e) acc[kt][e] = 0.f;
                const bf16* kr = keys + ((size_t)(h * 2 + c) * 128 + kt * 32 + rr) * 128 + 8 * hi;
#pragma unroll
                for (int ks = 0; ks < 8; ++ks) acc[kt] = __builtin_amdgcn_mfma_f32_32x32x16_bf16(*(const bf16x8*)(kr + ks * 16), qf[ks], acc[kt], 0, 0, 0);
            }
#pragma unroll 1
            for (int r = 0; r < 16; ++r) {
                float m = NEGB;
#pragma unroll
                for (int kt = 0; kt < 4; ++kt)
#pragma unroll
                    for (int e = 0; e < 16; ++e) m = fmaxf(m, acc[kt][e]);
                const float gm = fmaxf(m, __shfl_xor(m, 32));
                int idx = 255; bool found = false;
#pragma unroll
                for (int kt = 0; kt < 4; ++kt)
#pragma unroll
                    for (int e = 0; e < 16; ++e) { const bool hit = (acc[kt][e] == gm) && !found; idx = hit ? (kt * 32 + (e & 3) + 8 * (e >> 2) + 4 * hi) : idx; found = found || hit; }
                const int widx = min(idx, __shfl_xor(idx, 32)); const int wloc = widx - 4 * hi;
#pragma unroll
                for (int kt = 0; kt < 4; ++kt)
#pragma unroll
                    for (int e = 0; e < 16; ++e) acc[kt][e] = (wloc == kt * 32 + (e & 3) + 8 * (e >> 2)) ? NEGB : acc[kt][e];
                if (hi == 0) { sv[(c * 16 + r) * 32 + rr] = gm; si[(c * 16 + r) * 32 + rr] = widx; }
            }
        }
        float s0[16], s1[16]; int i0[16], i1[16];
#pragma unroll
        for (int i = 0; i < 16; ++i) { s0[i] = sv[i * 32 + rr]; s1[i] = sv[(16 + i) * 32 + rr]; i0[i] = si[i * 32 + rr]; i1[i] = si[(16 + i) * 32 + rr]; }
        float cv[16][16];
#pragma unroll
        for (int i = 0; i < 16; ++i)
#pragma unroll
            for (int j = 0; j < 16; ++j) if ((i + 1) * (j + 1) <= 16) cv[i][j] = s0[i] + s1[j];
#pragma unroll 1
        for (int r = 0; r < 16; ++r) {
            float gm = NEGB;
#pragma unroll
            for (int i = 0; i < 16; ++i)
#pragma unroll
                for (int j = 0; j < 16; ++j) if ((i + 1) * (j + 1) <= 16) gm = fmaxf(gm, cv[i][j]);
            int es = 0; bool found = false;
#pragma unroll
            for (int i = 0; i < 16; ++i)
#pragma unroll
                for (int j = 0; j < 16; ++j) if ((i + 1) * (j + 1) <= 16) { const bool hit = (cv[i][j] == gm) && !found; es = hit ? (i0[i] * 128 + i1[j]) : es; cv[i][j] = hit ? NEGB : cv[i][j]; found = found || hit; }
            if (hi == 0) { gv[r * 32 + rr] = gm; ge[r * 32 + rr] = es; }
        }
        float e16[16]; float den = 0.f; const float g0 = gv[rr];
#pragma unroll
        for (int r = 0; r < 16; ++r) { e16[r] = __expf(gv[r * 32 + rr] - g0); den += e16[r]; }
        const float inv = 1.0f / den; const size_t ob = (size_t)(t0 + rr) * 128 + h * 16 + hi * 8;
        float4 wa, wb; int4 ea, eb;
        wa.x = (hi ? e16[8] : e16[0]) * inv; wa.y = (hi ? e16[9] : e16[1]) * inv; wa.z = (hi ? e16[10] : e16[2]) * inv; wa.w = (hi ? e16[11] : e16[3]) * inv;
        wb.x = (hi ? e16[12] : e16[4]) * inv; wb.y = (hi ? e16[13] : e16[5]) * inv; wb.z = (hi ? e16[14] : e16[6]) * inv; wb.w = (hi ? e16[15] : e16[7]) * inv;
        ea.x = ge[(hi * 8 + 0) * 32 + rr]; ea.y = ge[(hi * 8 + 1) * 32 + rr]; ea.z = ge[(hi * 8 + 2) * 32 + rr]; ea.w = ge[(hi * 8 + 3) * 32 + rr];
        eb.x = ge[(hi * 8 + 4) * 32 + rr]; eb.y = ge[(hi * 8 + 5) * 32 + rr]; eb.z = ge[(hi * 8 + 6) * 32 + rr]; eb.w = ge[(hi * 8 + 7) * 32 + rr];
        *(float4*)(gw + ob) = wa; *(float4*)(gw + ob + 4) = wb; *(int4*)(eidx + ob) = ea; *(int4*)(eidx + ob + 4) = eb;
    }
}
__device__ __forceinline__ unsigned pk4fp8(float a, float b, float c, float d) { unsigned w = 0u; w = __builtin_amdgcn_cvt_pk_fp8_f32(a, b, w, false); w = __builtin_amdgcn_cvt_pk_fp8_f32(c, d, w, true); return w; }
__device__ __forceinline__ void ph_peer_cvt(const Params& p, int wv) {
    PH_IDS(); unsigned char* ws = p.ws; uint4* pu = (uint4*)(ws + OFF_PU); uint4* pv = (uint4*)(ws + OFF_PV);
    for (size_t i = gtid; i < (size_t)16384 * 1024 / 16; i += gn) {
        const float4* su = (const float4*)p.peer_u + 4 * i; const float4* sv = (const float4*)p.peer_v + 4 * i;
        const float4 a = su[0], b = su[1], c = su[2], d = su[3], e = sv[0], f = sv[1], g = sv[2], h = sv[3];
        pu[i] = make_uint4(pk4fp8(a.x * 32.f, a.y * 32.f, a.z * 32.f, a.w * 32.f), pk4fp8(b.x * 32.f, b.y * 32.f, b.z * 32.f, b.w * 32.f), pk4fp8(c.x * 32.f, c.y * 32.f, c.z * 32.f, c.w * 32.f), pk4fp8(d.x * 32.f, d.y * 32.f, d.z * 32.f, d.w * 32.f));
        pv[i] = make_uint4(pk4fp8(e.x, e.y, e.z, e.w), pk4fp8(f.x, f.y, f.z, f.w), pk4fp8(g.x, g.y, g.z, g.w), pk4fp8(h.x, h.y, h.z, h.w));
    }
}
__device__ __forceinline__ float bflo(unsigned w) { return __uint_as_float(w << 16); }
__device__ __forceinline__ float bfhi(unsigned w) { return __uint_as_float(w & 0xffff0000u); }
__device__ __forceinline__ float dot4f8(unsigned w, const float* x) { const f32x2v lo = __builtin_amdgcn_cvt_pk_f32_fp8(w, false), hi = __builtin_amdgcn_cvt_pk_f32_fp8(w, true); return (lo.x * x[0] + lo.y * x[1]) + (hi.x * x[2] + hi.y * x[3]); }
__device__ __forceinline__ float dot16f8(const uint4& w, const float* x) { return (dot4f8(w.x, x) + dot4f8(w.y, x + 4)) + (dot4f8(w.z, x + 8) + dot4f8(w.w, x + 12)); }
__device__ __forceinline__ void axpy4f8(unsigned w, float c, float* y) { const f32x2v lo = __builtin_amdgcn_cvt_pk_f32_fp8(w, false), hi = __builtin_amdgcn_cvt_pk_f32_fp8(w, true); y[0] += c * lo.x; y[1] += c * lo.y; y[2] += c * hi.x; y[3] += c * hi.y; }
__device__ __forceinline__ void axpy16f8(const uint4& w, float c, float* y) { axpy4f8(w.x, c, y); axpy4f8(w.y, c, y + 4); axpy4f8(w.z, c, y + 8); axpy4f8(w.w, c, y + 12); }
#define PG_LOAD(U, V, base) do { _Pragma("unroll") for (int k = 0; k < 8; ++k) { const int ei = (base) + k; const int ex = ei < 64 ? __builtin_amdgcn_readlane(e_lo, ei & 63) : __builtin_amdgcn_readlane(e_hi, ei & 63); \
        U[k] = *(const uint4*)(PU + (size_t)ex * 1024 + lane * 16); V[k] = *(const uint4*)(PV + (size_t)ex * 1024 + lane * 16); } } while (0)
#define PG_COMPUTE(U, V, base) do { float d[8]; _Pragma("unroll") for (int k = 0; k < 8; ++k) d[k] = dot16f8(U[k], xv); \
        const bool b5 = (lane & 32) != 0, b4 = (lane & 16) != 0, b3 = (lane & 8) != 0; float a4[4], a2[2], a1; \
        _Pragma("unroll") for (int k = 0; k < 4; ++k) { const float give = b5 ? d[k] : d[4 + k]; a4[k] = (b5 ? d[4 + k] : d[k]) + __shfl_xor(give, 32); } \
        _Pragma("unroll") for (int k = 0; k < 2; ++k) { const float give = b4 ? a4[k] : a4[2 + k]; a2[k] = (b4 ? a4[2 + k] : a4[k]) + __shfl_xor(give, 16); } \
        { const float give = b3 ? a2[0] : a2[1]; a1 = (b3 ? a2[1] : a2[0]) + __shfl_xor(give, 8); } \
        a1 += __shfl_xor(a1, 4); a1 += __shfl_xor(a1, 2); a1 += __shfl_xor(a1, 1); \
        const float ge = gelu_exact(a1 * (1.0f / 32.0f)); \
        _Pragma("unroll") for (int k = 0; k < 8; ++k) { const int ei = (base) + k; const float gx = __uint_as_float(ei < 64 ? __builtin_amdgcn_readlane(__float_as_uint(g_lo), ei & 63) : __builtin_amdgcn_readlane(__float_as_uint(g_hi), ei & 63)); \
            const float cf = gx * __uint_as_float(__builtin_amdgcn_readlane(__float_as_uint(ge), ((k >> 2) & 1) * 32 + ((k >> 1) & 1) * 16 + (k & 1) * 8)); axpy16f8(V[k], cf, y); } } while (0)
__device__ __forceinline__ void ph_peer_gather(const Params& p, int wv) {
    PH_IDS(); unsigned char* ws = p.ws;
    const bf16* h1b = (const bf16*)(ws + OFF_H1B); const int* eidx = (const int*)(ws + OFF_EIDX); const float* gw = (const float*)(ws + OFF_GW);
    const unsigned char* PU = ws + OFF_PU; const unsigned char* PV = ws + OFF_PV;
    for (int t = gwave; t < T; t += nwaves) {
        float xv[16], y[16];
        { const uint4 a = *(const uint4*)(h1b + (size_t)t * 1024 + lane * 16), b = *(const uint4*)(h1b + (size_t)t * 1024 + lane * 16 + 8);
          xv[0] = bflo(a.x); xv[1] = bfhi(a.x); xv[2] = bflo(a.y); xv[3] = bfhi(a.y); xv[4] = bflo(a.z); xv[5] = bfhi(a.z); xv[6] = bflo(a.w); xv[7] = bfhi(a.w);
          xv[8] = bflo(b.x); xv[9] = bfhi(b.x); xv[10] = bflo(b.y); xv[11] = bfhi(b.y); xv[12] = bflo(b.z); xv[13] = bfhi(b.z); xv[14] = bflo(b.w); xv[15] = bfhi(b.w); }
#pragma unroll
        for (int i = 0; i < 16; ++i) y[i] = 0.f;
        const int e_lo = eidx[(size_t)t * 128 + lane], e_hi = eidx[(size_t)t * 128 + 64 + lane]; const float g_lo = gw[(size_t)t * 128 + lane], g_hi = gw[(size_t)t * 128 + 64 + lane];
        uint4 uA[8], vA[8], uB[8], vB[8];
        PG_LOAD(uA, vA, 0);
#pragma unroll 1
        for (int e0 = 0; e0 < 128; e0 += 16) {
            PG_LOAD(uB, vB, e0 + 8);
            PG_COMPUTE(uA, vA, e0);
            if (e0 + 16 < 128) PG_LOAD(uA, vA, e0 + 16);
            PG_COMPUTE(uB, vB, e0 + 8);
        }
        float* row = p.out + (size_t)t * 1024 + lane * 16; float s = 0.f;
#pragma unroll
        for (int i = 0; i < 4; ++i) { const float4 a = *(const float4*)(row + 4 * i); y[4 * i] += DN_ALPHA * a.x; y[4 * i + 1] += DN_ALPHA * a.y; y[4 * i + 2] += DN_ALPHA * a.z; y[4 * i + 3] += DN_ALPHA * a.w; }
#pragma unroll
        for (int i = 0; i < 16; ++i) s += y[i];
        const float mu = wave_sum(s) * (1.0f / 1024.0f); float s2 = 0.f;
#pragma unroll
        for (int i = 0; i < 16; ++i) { y[i] -= mu; s2 += y[i] * y[i]; }
        const float rstd = rsqrtf(wave_sum(s2) * (1.0f / 1024.0f) + LN_EPS);
#pragma unroll
        for (int i = 0; i < 4; ++i) { const int c = lane * 16 + 4 * i; const float4 ga = *(const float4*)(p.ln2_g + c), ba = *(const float4*)(p.ln2_b + c);
            float4 o; o.x = y[4 * i] * rstd * ga.x + ba.x; o.y = y[4 * i + 1] * rstd * ga.y + ba.y; o.z = y[4 * i + 2] * rstd * ga.z + ba.z; o.w = y[4 * i + 3] * rstd * ga.w + ba.w;
            *(float4*)(row + 4 * i) = o; }
    }
}

#ifndef TIMING_BOUNDARY
#define TIMING_BOUNDARY -1
#endif
#define TPROBE(k) do { if (TIMING_BOUNDARY == (k) && blockIdx.x == 0 && wv == 0) { const unsigned long long t1_ = __builtin_amdgcn_s_memrealtime(); while (__builtin_amdgcn_s_memrealtime() - t1_ < t1_ - tstart_) __builtin_amdgcn_s_sleep(8); } } while (0)
__global__ void __launch_bounds__(NTHREADS) fwd_megakernel(Params p) {
    extern __shared__ __attribute__((aligned(16))) unsigned char lds[];
    cg::grid_group grid = cg::this_grid();
    const int nb = gridDim.x, bid = blockIdx.x;
    const int wv = __builtin_amdgcn_readfirstlane(threadIdx.x >> 6);
    unsigned char* ws = p.ws;
    const unsigned long long tstart_ = (TIMING_BOUNDARY >= 0) ? __builtin_amdgcn_s_memrealtime() : 0ull; (void)tstart_;
    PG8_LAS unsigned char* ldsp = (PG8_LAS unsigned char*)lds;

    ph_prep(p, wv);
    TPROBE(0);
    grid.sync();
    {
        pg8::Gemm g{(const bf16*)(ws + OFF_XB), (const bf16*)(ws + OFF_WIN), T, NPROJ_PAD, 1024, 1024, 0, 1 << 30, 0l};
        pg8::StaticOrder S; S.init(T, NPROJ_PAD, nb, bid);
        pg8::EpiInProjPg E{(bf16*)(ws + OFF_Z), (bf16*)(ws + OFF_XBC), (bf16*)(ws + OFF_Q), (bf16*)(ws + OFF_KVS), (bf16*)(ws + OFF_DTG)};
        pg8::gemm_phase<pg8::EpiInProjPg, pg8::StaticOrder, pg8::NoMid, true, true>(wv, ldsp, g, S, E, pg8::NoMid{});
    }
    TPROBE(1);
    grid.sync();
    ph_tokprep(p, wv);
    TPROBE(2);
    grid.sync();
    if (bid < 32) {
        const bool isv = bid >= 16;
        pg8::Gemm g{(const bf16*)(ws + OFF_KVS) + (isv ? 256 : 0), (const bf16*)(ws + (isv ? OFF_W1V : OFF_W1K)), 4096, 256, 2048, 0, 1, 1 << 30, 0l};
        pg8::StaticOrder S; S.init(4096, 256, 16, isv ? bid - 16 : bid);
        pg8::EpiBf16<1> E{(bf16*)(ws + OFF_HID + (isv ? 2 * MiB : 0)), 256, (const float*)(ws + (isv ? OFF_B1V : OFF_B1K)), 0, 0, 1.f};
        pg8::gemm_phase<pg8::EpiBf16<1>, pg8::StaticOrder, pg8::NoMid, true, true>(wv, ldsp, g, S, E, pg8::NoMid{});
    }
    ph_ssd_prep2(p, wv, lds);
    ph_vt_prep(p, wv);
    TPROBE(3);
    grid.sync();
    {
        RowMajorBf16 ak{(const bf16*)(ws + OFF_HID), 256}, av{(const bf16*)(ws + OFF_HID + 2 * MiB), 256};
        RowMajorBf16 bk{(const bf16*)(ws + OFF_W2K), 256}, bv{(const bf16*)(ws + OFF_W2V), 256};
        EpiKc ek{(bf16*)(ws + OFF_KC), false}, ev{(bf16*)(ws + OFF_VCT), true};
        gemm_wave32(wv, 4096 / 32, 64 / 32, 256, ak, bk, ek);
        gemm_wave32(wv, 4096 / 32, 64 / 32, 256, av, bv, ev);
    }
    ph_ssd_states(p, wv);
    TPROBE(4);
    grid.sync();
    ph_kc_rope(p, wv);
    ph_ssd_scan(p, wv);
    TPROBE(5);
    grid.sync();
    ph_ssd_out(p, wv);
    ph_nsa(p, wv, lds);
    TPROBE(6);
    grid.sync();
    {
        pg8::Gemm g{(const bf16*)(ws + OFF_Q), (const bf16*)(ws + OFF_WOUT), T, 1024, 2048, 1024, 0, 16, (long)OFF_Z - (long)OFF_Q - 16l * 128l};
        pg8::StaticOrder S; S.init(T, 1024, nb, bid);
        pg8::RmsFactors rf{(const float*)(ws + OFF_SSQ), (const float*)(ws + OFF_SSQ) + T, RMS_EPS};
        pg8::EpiOutProj E{p.x, p.out, DN_ALPHA, rf}; pg8::MidRmsScale MH{rf};
        pg8::gemm_phase<pg8::EpiOutProj, pg8::StaticOrder, pg8::MidRmsScale, true, true>(wv, ldsp, g, S, E, MH);
    }
    TPROBE(7);
    grid.sync();
    ph_ln1(p, wv);
    ph_peer_cvt(p, wv);
    TPROBE(8);
    grid.sync();
    {
        pg8::Gemm g{(const bf16*)(ws + OFF_H1B), (const bf16*)(ws + OFF_WQ), T, 2048, 1024, 1024, 0, 1 << 30, 0l};
        pg8::StaticOrder S; S.init(T, 2048, nb, bid);
        pg8::EpiBf16<0> E{(bf16*)(ws + OFF_QP), 2048, nullptr, 0, 0, 1.f};
        pg8::gemm_phase<pg8::EpiBf16<0>, pg8::StaticOrder, pg8::NoMid, true, true>(wv, ldsp, g, S, E, pg8::NoMid{});
    }
    TPROBE(9);
    grid.sync();
    ph_peer_topk(p, wv, lds);
    TPROBE(10);
    grid.sync();
    ph_peer_gather(p, wv);
}

extern "C" void kernel_launch(void* const* d_in, const int* in_sizes, int n_in, void* d_out, int out_size, void* d_ws, size_t ws_size, hipStream_t stream) {
    static int grid_blocks = 0;
    if (!grid_blocks) {
        int dev = 0, cus = 0, per_cu = 0;
        hipGetDevice(&dev);
        hipDeviceGetAttribute(&cus, hipDeviceAttributeMultiprocessorCount, dev);
        hipFuncSetAttribute((const void*)fwd_megakernel, hipFuncAttributeMaxDynamicSharedMemorySize, LDS_BYTES);
        hipOccupancyMaxActiveBlocksPerMultiprocessor(&per_cu, fwd_megakernel, NTHREADS, LDS_BYTES);
        if (per_cu < 1) per_cu = 1;
        if (per_cu > 1) per_cu = 1;
        grid_blocks = cus * per_cu;
        if (ws_size < 244 * MiB) fprintf(stderr, "kernel_launch: workspace too small: %zu\n", ws_size);
    }
    Params p{};
    const float** pp = (const float**)&p;
    for (int i = 0; i < 24; ++i) pp[i] = (const float*)d_in[i];
    p.out = (float*)d_out; p.ws = (unsigned char*)d_ws;
    void* args[] = {&p};
    hipError_t e = hipLaunchCooperativeKernel((void*)fwd_megakernel, dim3(grid_blocks), dim3(NTHREADS), args, LDS_BYTES, stream);
    if (e != hipSuccess) fprintf(stderr, "cooperative launch failed: %s (grid %d)\n", hipGetErrorString(e), grid_blocks);
}
```

```cpp
#include <hip/hip_runtime.h>
#include <hip/hip_cooperative_groups.h>
#include <cstdio>
#include <cstdint>
namespace cg = cooperative_groups;

typedef unsigned short bf16;
typedef short bf16x8 __attribute__((ext_vector_type(8)));
typedef float f32x4 __attribute__((ext_vector_type(4)));
typedef unsigned long long u64;

constexpr int T = 16384, L = 4096, NBATCH = 4, D = 1024;
constexpr int NPROJ = 5184, NPROJ_PAD = 5376;
constexpr int NTHREADS = 512, NWAVES = 8;
constexpr float LN_EPS = 1e-5f, RMS_EPS = 1e-5f;
constexpr float DN_ALPHA = 1.189207115002721f;
constexpr float NEG_INF = -1e30f, BIG = 1e30f;

constexpr size_t MiB = 1u << 20;
constexpr size_t OFF_SSQ = 0, OFF_BAR = 512 * 1024, BAR_BYTES = 16384;
constexpr size_t OFF_WOUT = 1 * MiB, OFF_WQ = 5 * MiB, OFF_W1K = 9 * MiB, OFF_W1V = 10 * MiB;
constexpr size_t OFF_W2K = 11 * MiB, OFF_W2V = 11 * MiB + 65536, OFF_B1K = 11 * MiB + 131072, OFF_B1V = 11 * MiB + 131072 + 4096;
constexpr size_t OFF_KEYS = 12 * MiB, OFF_ROPE = 13 * MiB, OFF_DT = 14 * MiB, OFF_ACS = 15 * MiB, OFF_GATE = 16 * MiB, OFF_MASK = 19 * MiB;
constexpr size_t OFF_HID = 20 * MiB, OFF_KC = 24 * MiB, OFF_VC = 24 * MiB + 524288;
constexpr size_t OFF_Z = 26 * MiB, OFF_Q = 58 * MiB, OFF_KVS = 90 * MiB, OFF_XBC = 138 * MiB, OFF_XSBC = 186 * MiB, OFF_BT = 234 * MiB, OFF_DTG = 242 * MiB;
constexpr size_t OFF_VST = 138 * MiB, OFF_VWT = 146 * MiB, OFF_VCT = 154 * MiB;
constexpr size_t OFF_XB = 186 * MiB, OFF_WIN = 218 * MiB;
constexpr size_t OFF_H1B = 90 * MiB, OFF_QP = 138 * MiB, OFF_EIDX = 202 * MiB, OFF_GW = 210 * MiB;
constexpr size_t OFF_PU = 26 * MiB, OFF_PV = 58 * MiB;
constexpr int LDS_BYTES = 147456;

struct Params {
    const float *x, *w_in, *conv_w, *conv_b, *dt_bias, *a_log, *d_skip, *ssd_norm_w;
    const float *cmp_pos_k, *cmp_w1_k, *cmp_w2_k, *cmp_pos_v, *cmp_w1_v, *cmp_w2_v;
    const float *attn_norm_w, *w_out, *ln1_g, *ln1_b, *peer_wq, *peer_keys, *peer_u, *peer_v, *ln2_g, *ln2_b;
    float* out; unsigned char* ws;
};

__device__ __forceinline__ float bf2f(bf16 v) { return __uint_as_float((unsigned)v << 16); }
__device__ __forceinline__ bf16 f2bf(float f) { unsigned u = __float_as_uint(f); return (bf16)((u + 0x7fffu + ((u >> 16) & 1u)) >> 16); }
__device__ __forceinline__ int lane_id() { int l = (int)__builtin_amdgcn_mbcnt_hi(~0u, __builtin_amdgcn_mbcnt_lo(~0u, 0u)); asm volatile("" : "+v"(l)); return l; }
#define PH_IDS() const int lane = lane_id(); const int tid = (wv << 6) | lane; const int bid = blockIdx.x, nb = gridDim.x; const int gtid = bid * NTHREADS + tid, gn = nb * NTHREADS; const int gwave = bid * NWAVES + wv, nwaves = nb * NWAVES; (void)gtid; (void)gn; (void)gwave; (void)nwaves;
typedef float f32x2v __attribute__((ext_vector_type(2)));
typedef __bf16 bf16x2v __attribute__((ext_vector_type(2)));
__device__ __forceinline__ unsigned pk2bf(float lo, float hi) { f32x2v v = {lo, hi}; bf16x2v b = __builtin_convertvector(v, bf16x2v); return __builtin_bit_cast(unsigned, b); }
__device__ __forceinline__ float wave_sum(float v) {
#pragma unroll
    for (int o = 1; o < 64; o <<= 1) v += __shfl_xor(v, o);
    return v;
}
__device__ __forceinline__ float wave_max(float v) {
#pragma unroll
    for (int o = 1; o < 64; o <<= 1) v = fmaxf(v, __shfl_xor(v, o));
    return v;
}
__device__ __forceinline__ float gelu_exact(float v) { return 0.5f * v * (1.0f + erff(v * 0.7071067811865476f)); }
__device__ __forceinline__ float sigmoidf(float v) { return 1.0f / (1.0f + __expf(-v)); }

template <class AP, class BP, class EP>
__device__ __forceinline__ void gemm_wave32(int wv, int Mt, int Nt, int K, const AP& ap, const BP& bp, const EP& ep) {
    PH_IDS(); const int r = lane & 15, q = lane >> 4;
    for (int tile = gwave; tile < Mt * Nt; tile += nwaves) {
        const int tm = tile / Nt, tn = tile % Nt, row0 = tm * 32, col0 = tn * 32;
        f32x4 acc[2][2];
#pragma unroll
        for (int i = 0; i < 2; ++i)
#pragma unroll
            for (int j = 0; j < 2; ++j) acc[i][j] = (f32x4){0.f, 0.f, 0.f, 0.f};
        for (int k0 = 0; k0 < K; k0 += 32) {
            const bf16x8 a0 = ap(row0 + r, k0 + 8 * q), a1 = ap(row0 + 16 + r, k0 + 8 * q);
            const bf16x8 b0 = bp(col0 + r, k0 + 8 * q), b1 = bp(col0 + 16 + r, k0 + 8 * q);
            acc[0][0] = __builtin_amdgcn_mfma_f32_16x16x32_bf16(a0, b0, acc[0][0], 0, 0, 0);
            acc[0][1] = __builtin_amdgcn_mfma_f32_16x16x32_bf16(a0, b1, acc[0][1], 0, 0, 0);
            acc[1][0] = __builtin_amdgcn_mfma_f32_16x16x32_bf16(a1, b0, acc[1][0], 0, 0, 0);
            acc[1][1] = __builtin_amdgcn_mfma_f32_16x16x32_bf16(a1, b1, acc[1][1], 0, 0, 0);
        }
#pragma unroll
        for (int i = 0; i < 2; ++i)
#pragma unroll
            for (int j = 0; j < 2; ++j)
#pragma unroll
                for (int e = 0; e < 4; ++e) ep(row0 + 16 * i + 4 * q + e, col0 + 16 * j + r, acc[i][j][e]);
    }
}
struct RowMajorBf16 { const bf16* p; int ld; __device__ __forceinline__ bf16x8 operator()(int row, int k) const { return *(const bf16x8*)(p + (size_t)row * ld + k); } };

namespace pg8 {
#define PG8_LAS __attribute__((address_space(3)))
typedef unsigned short bf16_t;
typedef short bf16x8 __attribute__((ext_vector_type(8)));
typedef float f32x4 __attribute__((ext_vector_type(4)));
typedef unsigned u32x4 __attribute__((ext_vector_type(4)));
constexpr int BM = 256, BK = 64, HALF = 128, HTB = HALF * BK * 2  , STAGE_BYTES = 8 * HTB, NXCD = 8, WGM = 8;

__host__ __device__ __forceinline__ int lds_byte(int r, int c) { const int st = (r >> 4) * 2 + (c >> 5), rr = r & 15, cc = c & 31, ob = rr * 64 + cc * 2; return st * 1024 + (ob ^ (((ob >> 9) & 1) << 5)); }
__host__ __device__ __forceinline__ void stage_rc(int b, int& R, int& C) { const int st = b / 1024, sb = b % 1024, swz = sb ^ (((sb >> 9) & 1) << 5); R = (st >> 1) * 16 + swz / 64; C = (st & 1) * 32 + (swz % 64) / 2; }
__host__ __device__ __forceinline__ int perm32(int rho) { const int n = rho >> 4, i = rho & 15; return 8 * (i >> 2) + 4 * n + (i & 3); }

struct Unit { int pm, pn; };
struct Gemm { const bf16_t* A; const bf16_t* Bt; int M, N, K; int lda; int amode; int ksplit; long kdelta; };

struct StaticOrder {
    int nM, nN, nwg, G, c;
    __host__ __device__ void init(int M, int N, int G_, int c_) { nM = M / BM; nN = N / BM; nwg = nM * nN; G = G_; c = c_; }
    __host__ __device__ bool next(int i, Unit& u) const {
        const long L = (long)i * G + c; if (L >= nwg) return false;
        int wgid = (int)L; { const int q = nwg / NXCD, r = nwg % NXCD, xcd = wgid % NXCD, off = wgid / NXCD; wgid = (xcd < r ? xcd * (q + 1) : r * (q + 1) + (xcd - r) * q) + off; }
        const int nig = WGM * nN, gid = wgid / nig, fm = gid * WGM, gsz = (nM - fm) < WGM ? (nM - fm) : WGM;
        u.pm = fm + ((wgid % nig) % gsz); u.pn = (wgid % nig) / gsz; return true;
    }
    __device__ __forceinline__ void a_ready(const Unit&) const {}
    __device__ __forceinline__ void done(const Unit&) const {}
};


__device__ __forceinline__ unsigned cvt_pk_bf16(float lo, float hi) { unsigned r; asm volatile("v_cvt_pk_bf16_f32 %0, %1, %2" : "=v"(r) : "v"(lo), "v"(hi)); return r; }
typedef float f32x2 __attribute__((ext_vector_type(2)));
__device__ __forceinline__ f32x2 gelu_pk(f32x2 v) {
    const f32x2 av = __builtin_elementwise_abs(v), d = av * 0.2316418882f + 1.0f;
    f32x2 t; t.x = __builtin_amdgcn_rcpf(d.x); t.y = __builtin_amdgcn_rcpf(d.y);
    f32x2 q = t * 0.5307027145f + (-0.7265760135f); q = q * t + 0.7107068705f; q = q * t + (-0.142248368f); q = q * t + 0.127414796f; q = q * t;
    const f32x2 s = (v * v) * (-0.72134752044f);
    f32x2 e; e.x = __builtin_amdgcn_exp2f(s.x); e.y = __builtin_amdgcn_exp2f(s.y);
    const f32x2 m = v * (q * e), r = v - m;
    f32x2 o; o.x = v.x < 0.f ? m.x : r.x; o.y = v.y < 0.f ? m.y : r.y; return o;
}

template <int ACT  > struct EpiBf16 {
    static constexpr bool PERM = true, AFTER_DRAIN = false; static_assert(ACT == 0 || ACT == 1, "EpiBf16: ACT is 0 (none) or 1 (gelu_pk)");
    bf16_t* O; int ldc; const float* bias; int split_cols; size_t split_stride; float scale0;
    __device__ __forceinline__ void operator()(const f32x4 (&acc)[2][2][4][2], const Unit& u, int wr, int wc, int fr, int fq) const {
        const int row0 = u.pm * BM + wr * 64 + fr; int colt = u.pn * BM; bf16_t* base = O;
        float sc = 1.f; if (split_cols) { const int t = colt / split_cols; base += (size_t)t * split_stride; colt -= t * split_cols; if (t == 0) sc = scale0; }
        const int col0 = colt + wc * 32 + 8 * fq, bcol0 = u.pn * BM + wc * 32 + 8 * fq;
        f32x4 bv[2][2];
#pragma unroll
        for (int bj = 0; bj < 2; ++bj)
#pragma unroll
            for (int n = 0; n < 2; ++n) bv[bj][n] = bias ? *(const f32x4*)(bias + bcol0 + bj * HALF + 4 * n) : (f32x4){0.f, 0.f, 0.f, 0.f};
#pragma unroll
        for (int ai = 0; ai < 2; ++ai)
#pragma unroll
            for (int m = 0; m < 4; ++m) { bf16_t* rowp = base + (size_t)(row0 + ai * HALF + m * 16) * ldc + col0;
#pragma unroll
                for (int bj = 0; bj < 2; ++bj) { f32x4 v0 = acc[ai][bj][m][0] + bv[bj][0], v1 = acc[ai][bj][m][1] + bv[bj][1];
                    if (ACT == 1) { f32x2 a = gelu_pk((f32x2){v0[0], v0[1]}), b = gelu_pk((f32x2){v0[2], v0[3]}), c = gelu_pk((f32x2){v1[0], v1[1]}), d = gelu_pk((f32x2){v1[2], v1[3]});
                        v0 = (f32x4){a.x, a.y, b.x, b.y}; v1 = (f32x4){c.x, c.y, d.x, d.y}; }
                    v0 = v0 * sc; v1 = v1 * sc; u32x4 w; w.x = cvt_pk_bf16(v0[0], v0[1]); w.y = cvt_pk_bf16(v0[2], v0[3]); w.z = cvt_pk_bf16(v1[0], v1[1]); w.w = cvt_pk_bf16(v1[2], v1[3]);
                    *(u32x4*)(rowp + bj * HALF) = w; } }
    }
};

struct EpiInProjPg { static constexpr bool PERM = true, AFTER_DRAIN = false;
    bf16_t *z, *xbc, *q, *kvs, *dtg;
    __device__ __forceinline__ void operator()(const f32x4 (&acc)[2][2][4][2], const Unit& u, int wr, int wc, int fr, int fq) const {
        bf16_t* base; int ldc, colt; const int pn = u.pn;
        if (pn < 4) { base = z; ldc = 1024; colt = pn * 256; } else if (pn < 10) { base = xbc; ldc = 1536; colt = (pn - 4) * 256; }
        else if (pn < 14) { base = q; ldc = 1024; colt = (pn - 10) * 256; } else if (pn < 20) { base = kvs; ldc = 1536; colt = (pn - 14) * 256; }
        else { base = dtg; ldc = 64; colt = 0; }
        const int row0 = u.pm * BM + wr * 64 + fr, col0 = colt + wc * 32 + 8 * fq;
#pragma unroll
        for (int ai = 0; ai < 2; ++ai)
#pragma unroll
            for (int m = 0; m < 4; ++m) { bf16_t* rowp = base + (size_t)(row0 + ai * HALF + m * 16) * ldc + col0;
#pragma unroll
                for (int bj = 0; bj < 2; ++bj) { const f32x4 v0 = acc[ai][bj][m][0], v1 = acc[ai][bj][m][1];
                    u32x4 w; w.x = cvt_pk_bf16(v0[0], v0[1]); w.y = cvt_pk_bf16(v0[2], v0[3]); w.z = cvt_pk_bf16(v1[0], v1[1]); w.w = cvt_pk_bf16(v1[2], v1[3]);
                    if (pn < 20 || (bj == 0 && wc < 2)) *(u32x4*)(rowp + bj * HALF) = w; } }
    }
};
struct RmsFactors { const float* ssq; const float* ssq2; float eps;
    __device__ __forceinline__ void get(int row, float& ra, float& r0, float& r1) const {
        ra = rsqrtf(ssq[row] * (1.0f / 1024.0f) + eps); r0 = rsqrtf(ssq2[2 * row] * (1.0f / 512.0f) + eps); r1 = rsqrtf(ssq2[2 * row + 1] * (1.0f / 512.0f) + eps); } };
struct EpiOutProj { static constexpr bool PERM = false, AFTER_DRAIN = false;
    const float* x; float* out; float alpha; RmsFactors rf;
    __device__ __forceinline__ void operator()(const f32x4 (&acc)[2][2][4][2], const Unit& u, int wr, int wc, int fr, int fq) const {
        const int col0 = u.pn * BM + wc * 32 + 4 * fq;
#pragma unroll
        for (int ai = 0; ai < 2; ++ai)
#pragma unroll
            for (int m = 0; m < 4; ++m) { const int row = u.pm * BM + ai * HALF + wr * 64 + m * 16 + fr; const size_t off = (size_t)row * 1024 + col0;
                float ra, r0, r1; rf.get(row, ra, r0, r1);
#pragma unroll
                for (int bj = 0; bj < 2; ++bj)
#pragma unroll
                    for (int n = 0; n < 2; ++n) { const size_t o = off + bj * HALF + n * 16; const f32x4 xv = *(const f32x4*)(x + o); *(f32x4*)(out + o) = xv * alpha + acc[ai][bj][m][n] * r1; } }
    }
};
struct MidRmsScale { static constexpr bool ENABLED = true; RmsFactors rf;
    __device__ __forceinline__ void operator()(f32x4 (&acc)[2][2][4][2], const Unit& u, int t, int wr, int wc, int fr, int fq) const {
        if (t != 16 && t != 24) return;
        int rowb = u.pm * BM + wr * 64 + fr; asm volatile("" : "+v"(rowb));
#pragma unroll
        for (int ai = 0; ai < 2; ++ai)
#pragma unroll
            for (int m = 0; m < 4; ++m) { float ra, r0, r1; rf.get(rowb + ai * HALF + m * 16, ra, r0, r1);
                const float sc = (t == 16) ? ra / r0 : r0 / r1;
#pragma unroll
                for (int bj = 0; bj < 2; ++bj)
#pragma unroll
                    for (int n = 0; n < 2; ++n) acc[ai][bj][m][n] = acc[ai][bj][m][n] * sc; }
    }
};
struct NoMid { static constexpr bool ENABLED = false; template <class ACC> __device__ __forceinline__ void operator()(ACC&, const Unit&, int, int, int, int, int) const {} };
template <class Epi, class Sched, class Mid, bool ALIGN_EPI = false, bool SP2 = false>
__device__ __forceinline__ void gemm_phase(int wv, PG8_LAS unsigned char* lds, const Gemm g, const Sched& S, const Epi& E, const Mid& MH) {
    int lane_ = (int)__builtin_amdgcn_mbcnt_hi(~0u, __builtin_amdgcn_mbcnt_lo(~0u, 0u)); asm volatile("" : "+v"(lane_));
    const int lane = lane_, wid = wv, tid = (wv << 6) | lane, wr = wid >> 2, wc = wid & 3, fr = lane & 15, fq = lane >> 4;
    const int K = g.K, nt = K / BK;
    unsigned voffA[2], voffB[2];
#pragma unroll
    for (int i = 0; i < 2; ++i) { int R, C; stage_rc(tid * 16 + i * 8192, R, C); const int Rb = Epi::PERM ? ((R & ~31) + perm32(R & 31)) : R;
        voffA[i] = g.amode == 0 ? (unsigned)(R * g.lda + C) * 2u : (unsigned)((R >> 2) * 49152 + (R & 3) * 128 + C * 2); voffB[i] = (unsigned)(Rb * K + C) * 2u; }
    const size_t kstep = (size_t)(BK * 2);
    const size_t hstep = (size_t)HALF * K * 2;
    const size_t tstep = 2 * hstep;
    const size_t kstepA = g.amode == 0 ? (size_t)(BK * 2) : (size_t)3072;
    const size_t hstepA = g.amode == 0 ? (size_t)HALF * g.lda * 2 : (size_t)32 * 49152;
    const size_t tstepA = 2 * hstepA;
#define PG8_AK(base, t) ((base) + (size_t)(t) * kstepA + (((t) >= g.ksplit) ? g.kdelta : 0l))
    const unsigned ldsw = (unsigned)wid * 1024u;
    const int aoff = lds_byte(wr * 64 + fr, fq * 8), boff = lds_byte(wc * 32 + fr, fq * 8);
#define PG8_SA(b, h) (((b) * 2 + (h)) * HTB)
#define PG8_SB(b, h) ((4 + (b) * 2 + (h)) * HTB)
#define PG8_STAGE(bufoff, gbase, voff) do { _Pragma("unroll") for (int _i = 0; _i < 2; ++_i) \
        __builtin_amdgcn_global_load_lds((const unsigned*)((const char*)(gbase) + (voff)[_i]), (PG8_LAS unsigned*)(lds + (bufoff) + ldsw + _i * 8192), 16, 0, 0); } while (0)
#define PG8_LDA(dst, b, h) do { _Pragma("unroll") for (int m = 0; m < 4; ++m) _Pragma("unroll") for (int k = 0; k < 2; ++k) dst[m][k] = *(const PG8_LAS bf16x8*)(lds + PG8_SA(b, h) + aoff + m * 2048 + k * 1024); } while (0)
#define PG8_LDB(dst, b, h) do { _Pragma("unroll") for (int n = 0; n < 2; ++n) _Pragma("unroll") for (int k = 0; k < 2; ++k) dst[n][k] = *(const PG8_LAS bf16x8*)(lds + PG8_SB(b, h) + boff + n * 2048 + k * 1024); } while (0)
#define PG8_MMA(ai, bj, At, Bt) do { __builtin_amdgcn_s_setprio(1); _Pragma("unroll") for (int m = 0; m < 4; ++m) _Pragma("unroll") for (int n = 0; n < 2; ++n) _Pragma("unroll") for (int k = 0; k < 2; ++k) \
        acc[ai][bj][m][n] = __builtin_amdgcn_mfma_f32_16x16x32_bf16(Bt[n][k], At[m][k], acc[ai][bj][m][n], 0, 0, 0); __builtin_amdgcn_s_setprio(0); } while (0)
#define PG8_WAIT_V(n) asm volatile("s_waitcnt vmcnt(" #n ")" ::: "memory")
#define PG8_WAIT_L(n) asm volatile("s_waitcnt lgkmcnt(" #n ")" ::: "memory")
#define PG8_BAR __builtin_amdgcn_s_barrier()
#define PG8_SCHED __builtin_amdgcn_sched_barrier(0)
    Unit cur, nxt; int ui = 0;
    if (!S.next(0, cur)) return;
    f32x4 acc[2][2][4][2];
#pragma unroll
    for (int a = 0; a < 2; ++a)
#pragma unroll
        for (int b = 0; b < 2; ++b)
#pragma unroll
            for (int m = 0; m < 4; ++m)
#pragma unroll
                for (int n = 0; n < 2; ++n) acc[a][b][m][n] = (f32x4){0.f, 0.f, 0.f, 0.f};
    bf16x8 At[4][2], B0[2][2], B1[2][2];
    const char* cA = (const char*)g.A + (size_t)cur.pm * tstepA; const char* cB = (const char*)g.Bt + (size_t)cur.pn * tstep;
    S.a_ready(cur);
    if constexpr (SP2) {
        PG8_STAGE(PG8_SB(0, 0), cB, voffB); PG8_STAGE(PG8_SB(0, 1), cB + hstep, voffB); PG8_STAGE(PG8_SA(0, 0), cA, voffA); PG8_STAGE(PG8_SA(0, 1), cA + hstepA, voffA);
        if (wr == 1) PG8_BAR;
        PG8_WAIT_V(2); PG8_BAR;
        PG8_STAGE(PG8_SB(1, 0), cB + kstep, voffB); PG8_STAGE(PG8_SA(1, 0), PG8_AK(cA, 1), voffA); PG8_STAGE(PG8_SB(1, 1), cB + hstep + kstep, voffB);
        PG8_WAIT_V(6); PG8_BAR;
    } else {
        PG8_STAGE(PG8_SB(0, 0), cB, voffB); PG8_STAGE(PG8_SA(0, 0), cA, voffA); PG8_STAGE(PG8_SB(0, 1), cB + hstep, voffB); PG8_STAGE(PG8_SA(0, 1), cA + hstepA, voffA);
        if (wr == 1) PG8_BAR;
        PG8_WAIT_V(4); PG8_BAR;
        PG8_STAGE(PG8_SB(1, 0), cB + kstep, voffB); PG8_STAGE(PG8_SA(1, 0), PG8_AK(cA, 1), voffA); PG8_STAGE(PG8_SB(1, 1), cB + hstep + kstep, voffB);
        PG8_WAIT_V(6); PG8_BAR;
    }
    for (;;) {
        const bool has_next = S.next(ui + 1, nxt);
        const char* nA = has_next ? (const char*)g.A + (size_t)nxt.pm * tstepA : cA; const char* nB = has_next ? (const char*)g.Bt + (size_t)nxt.pn * tstep : cB;
        for (int t = 0; t < nt; t += 2) {
            const bool last = (t == nt - 2);
            if (Mid::ENABLED) MH(acc, cur, t, wr, wc, fr, fq);
            const char* a1 = PG8_AK(cA, t + 1);
            const char* a2 = last ? nA : PG8_AK(cA, t + 2); const char* b2 = last ? nB : cB + (size_t)(t + 2) * kstep;
            const char* a3 = a2 + kstepA; const char* b3 = b2 + kstep;
            if (last && has_next) S.a_ready(nxt);
            if constexpr (SP2) {
            PG8_LDB(B0, 0, 0); PG8_LDB(B1, 0, 1); PG8_SCHED; PG8_LDA(At, 0, 0); PG8_STAGE(PG8_SA(1, 1), a1 + hstepA, voffA);
            PG8_WAIT_V(8); PG8_WAIT_L(0); PG8_BAR; PG8_MMA(0, 0, At, B0); PG8_MMA(0, 1, At, B1); PG8_BAR; PG8_SCHED;
            PG8_LDA(At, 0, 1); PG8_STAGE(PG8_SB(0, 0), b2, voffB); PG8_STAGE(PG8_SB(0, 1), b2 + hstep, voffB); PG8_STAGE(PG8_SA(0, 0), a2, voffA);
            PG8_WAIT_V(8); PG8_WAIT_L(0); PG8_BAR; PG8_MMA(1, 0, At, B0); PG8_MMA(1, 1, At, B1); PG8_BAR; PG8_SCHED;
            PG8_LDB(B0, 1, 0); PG8_LDB(B1, 1, 1); PG8_SCHED; PG8_LDA(At, 1, 0); PG8_STAGE(PG8_SA(0, 1), a2 + hstepA, voffA);
            PG8_WAIT_V(8); PG8_WAIT_L(0); PG8_BAR; PG8_MMA(0, 0, At, B0); PG8_MMA(0, 1, At, B1); PG8_BAR; PG8_SCHED;
            PG8_LDA(At, 1, 1); PG8_STAGE(PG8_SB(1, 0), b3, voffB); PG8_STAGE(PG8_SB(1, 1), b3 + hstep, voffB); PG8_STAGE(PG8_SA(1, 0), a3, voffA);
            PG8_WAIT_V(8); PG8_WAIT_L(0); PG8_BAR; PG8_MMA(1, 0, At, B0); PG8_MMA(1, 1, At, B1); PG8_BAR; PG8_SCHED;
            } else {
            PG8_LDB(B0, 0, 0); PG8_SCHED; PG8_LDA(At, 0, 0); PG8_STAGE(PG8_SA(1, 1), a1 + hstepA, voffA);
            PG8_WAIT_L(8); PG8_BAR; PG8_WAIT_L(0); PG8_MMA(0, 0, At, B0); PG8_BAR; PG8_SCHED;
            PG8_LDB(B1, 0, 1); PG8_STAGE(PG8_SB(0, 0), b2, voffB);
            PG8_BAR; PG8_WAIT_L(0); PG8_MMA(0, 1, At, B1); PG8_BAR;
            PG8_LDA(At, 0, 1); PG8_STAGE(PG8_SA(0, 0), a2, voffA);
            PG8_BAR; PG8_WAIT_L(0); PG8_MMA(1, 0, At, B0); PG8_BAR; PG8_SCHED;
            PG8_STAGE(PG8_SB(0, 1), b2 + hstep, voffB);
            PG8_WAIT_V(6); PG8_BAR; PG8_MMA(1, 1, At, B1); PG8_BAR;
            PG8_LDB(B0, 1, 0); PG8_SCHED; PG8_LDA(At, 1, 0); PG8_STAGE(PG8_SA(0, 1), a2 + hstepA, voffA);
            PG8_WAIT_L(8); PG8_BAR; PG8_WAIT_L(0); PG8_MMA(0, 0, At, B0); PG8_BAR; PG8_SCHED;
            PG8_LDB(B1, 1, 1); PG8_STAGE(PG8_SB(1, 0), b3, voffB);
            PG8_BAR; PG8_WAIT_L(0); PG8_MMA(0, 1, At, B1); PG8_BAR;
            PG8_LDA(At, 1, 1); PG8_STAGE(PG8_SA(1, 0), a3, voffA);
            PG8_BAR; PG8_WAIT_L(0); PG8_MMA(1, 0, At, B0); PG8_BAR; PG8_SCHED;
            PG8_STAGE(PG8_SB(1, 1), b3 + hstep, voffB);
            PG8_WAIT_V(6); PG8_BAR; PG8_MMA(1, 1, At, B1); PG8_BAR;
            }
        }
        if constexpr (ALIGN_EPI) { if (wr == 0) PG8_BAR; }
        if constexpr (!Epi::AFTER_DRAIN) { E(acc, cur, wr, wc, fr, fq); S.done(cur); }
        if (!has_next) break;
#pragma unroll
        for (int a = 0; a < 2; ++a)
#pragma unroll
            for (int b = 0; b < 2; ++b)
#pragma unroll
                for (int m = 0; m < 4; ++m)
#pragma unroll
                    for (int n = 0; n < 2; ++n) acc[a][b][m][n] = (f32x4){0.f, 0.f, 0.f, 0.f};
        cur = nxt; cA = nA; cB = nB; ++ui;
        if constexpr (ALIGN_EPI) { if (wr == 1) PG8_BAR; }
    }
    PG8_WAIT_V(0);
    if constexpr (!ALIGN_EPI) { if (wr == 0) PG8_BAR; }
    PG8_BAR;
    if constexpr (Epi::AFTER_DRAIN) { E.fused(acc, cur, wr, wc, fr, fq, lds, wid, lane); S.done(cur); }
#undef PG8_AK
#undef PG8_SA
#undef PG8_SB
#undef PG8_STAGE
#undef PG8_LDA
#undef PG8_LDB
#undef PG8_MMA
#undef PG8_WAIT_V
#undef PG8_WAIT_L
#undef PG8_BAR
#undef PG8_SCHED
}
}

__device__ __forceinline__ int winmap(int n) { return n < 2560 ? n : (n < 5120 ? n + 16 : (n < 5136 ? 2560 + (n - 5120) : n)); }
template <class Map>
__device__ __forceinline__ void transpose_item(const float* W, int ldw, bf16* WT, int K, int item, int nblk, float* scr, int lane, const Map& mp) {
    const int kb = item / nblk, nbk = item % nblk, k0 = 64 * kb, n0 = 32 * nbk;
    const int col = mp.scol(n0 + (lane & 31));
#pragma unroll 8
    for (int i = 0; i < 32; ++i) { const int kk = 2 * i + (lane >> 5); scr[kk * 33 + (lane & 31)] = col >= 0 ? W[(size_t)mp.srow(k0 + kk) * ldw + col] * mp.scale(k0 + kk) : 0.f; }
    const int c = lane & 7;
#pragma unroll
    for (int j = 0; j < 4; ++j) { const int n = (lane >> 3) + 8 * j; const float* s = scr + (8 * c) * 33 + n;
        *(uint4*)(WT + (size_t)(n0 + n) * K + k0 + 8 * c) = make_uint4(pk2bf(s[0], s[33]), pk2bf(s[66], s[99]), pk2bf(s[132], s[165]), pk2bf(s[198], s[231])); }
}
struct MapPlain { __device__ __forceinline__ int srow(int k) const { return k; } __device__ __forceinline__ int scol(int n) const { return n; } __device__ __forceinline__ float scale(int) const { return 1.f; } };
struct MapWin { __device__ __forceinline__ int srow(int k) const { return k; } __device__ __forceinline__ int scol(int n) const { return n < NPROJ ? winmap(n) : -1; } __device__ __forceinline__ float scale(int) const { return 1.f; } };
struct MapWout { const float* an; const float* sn;
    __device__ __forceinline__ int srow(int k) const { return (k + 1024) & 2047; } __device__ __forceinline__ int scol(int n) const { return n; } __device__ __forceinline__ float scale(int k) const { return k < 1024 ? an[k] : sn[k - 1024]; } };
__device__ __forceinline__ void ph_prep(const Params& p, int wv, unsigned char* lds) {
    PH_IDS(); unsigned char* ws = p.ws;
    bf16* xb = (bf16*)(ws + OFF_XB);
    for (size_t i = gtid; i < (size_t)T * D / 8; i += gn) { const float4 v = ((const float4*)p.x)[2 * i], w = ((const float4*)p.x)[2 * i + 1]; ((uint4*)xb)[i] = make_uint4(pk2bf(v.x, v.y), pk2bf(v.z, v.w), pk2bf(w.x, w.y), pk2bf(w.z, w.w)); }
    {
        float* scr = (float*)(lds + wv * 8448);
        constexpr int I_WIN = 16 * 168, I_WOUT = 32 * 32, I_WQ = 16 * 64, I_W1 = 32 * 8, I_W2 = 4 * 2;
        constexpr int NIT = I_WIN + I_WOUT + I_WQ + 2 * I_W1 + 2 * I_W2;
        for (int it = gwave; it < NIT; it += nwaves) {
            int r = it;
            if (r < I_WIN) { transpose_item(p.w_in, NPROJ, (bf16*)(ws + OFF_WIN), 1024, r, 168, scr, lane, MapWin{}); continue; } r -= I_WIN;
            if (r < I_WOUT) { transpose_item(p.w_out, 1024, (bf16*)(ws + OFF_WOUT), 2048, r, 32, scr, lane, MapWout{p.attn_norm_w, p.ssd_norm_w}); continue; } r -= I_WOUT;
            if (r < I_WQ) { transpose_item(p.peer_wq, 2048, (bf16*)(ws + OFF_WQ), 1024, r, 64, scr, lane, MapPlain{}); continue; } r -= I_WQ;
            if (r < I_W1) { transpose_item(p.cmp_w1_k, 256, (bf16*)(ws + OFF_W1K), 2048, r, 8, scr, lane, MapPlain{}); continue; } r -= I_W1;
            if (r < I_W1) { transpose_item(p.cmp_w1_v, 256, (bf16*)(ws + OFF_W1V), 2048, r, 8, scr, lane, MapPlain{}); continue; } r -= I_W1;
            if (r < I_W2) { transpose_item(p.cmp_w2_k, 64, (bf16*)(ws + OFF_W2K), 256, r, 2, scr, lane, MapPlain{}); continue; } r -= I_W2;
            transpose_item(p.cmp_w2_v, 64, (bf16*)(ws + OFF_W2V), 256, r, 2, scr, lane, MapPlain{});
        }
    }
    bf16* keys = (bf16*)(ws + OFF_KEYS);
    for (int i = gtid; i < 8 * 2 * 128 * 128; i += gn) keys[i] = f2bf(p.peer_keys[i]);
    float* rc = (float*)(ws + OFF_ROPE); float* rs = rc + 4096 * 32;
    for (int i = gtid; i < 4096 * 32; i += gn) {
        const int pos = i >> 5, j = i & 31;
        const float inv = powf(10000.0f, -(float)(2 * j) / 64.0f); const float angf = (float)pos * inv;
        double xr = (double)angf * 0.15915494309189535; xr -= rint(xr); const double rr = xr * 6.283185307179586, r2 = rr * rr;
        double s = 0.0, c = 0.0, ts = rr, tc = 1.0;
        for (int k = 0; k < 14; ++k) { s += ts; c += tc; tc = -tc * r2 / (double)((2 * k + 1) * (2 * k + 2)); ts = -ts * r2 / (double)((2 * k + 2) * (2 * k + 3)); }
        rc[i] = (float)c; rs[i] = (float)s;
    }
    float* b1k = (float*)(ws + OFF_B1K); float* b1v = (float*)(ws + OFF_B1V);
    for (int o = gwave; o < 512; o += nwaves) {
        const int j = o & 255; const float* pos = o < 256 ? p.cmp_pos_k : p.cmp_pos_v; const float* w1 = o < 256 ? p.cmp_w1_k : p.cmp_w1_v;
        float s = 0.f; for (int k = lane; k < 2048; k += 64) s += pos[k] * w1[(size_t)k * 256 + j];
        s = wave_sum(s); if (lane == 0) (o < 256 ? b1k : b1v)[j] = s;
    }
    float* ssq = (float*)(ws + OFF_SSQ);
    for (int i = gtid; i < 3 * T; i += gn) ssq[i] = 0.f;
}

struct EpiInProj {
    bf16 *z, *xbc, *q, *kvs, *dtg;
    __device__ __forceinline__ void operator()(int row, int c, float v) const {
        const bf16 b = f2bf(v);
        if (c < 1024) z[(size_t)row * 1024 + c] = b;
        else if (c < 2560) xbc[(size_t)row * 1536 + (c - 1024)] = b;
        else if (c < 3584) q[(size_t)row * 1024 + (c - 2560)] = b;
        else if (c < 5120) kvs[(size_t)row * 1536 + (c - 3584)] = b;
        else if (c < 5184) dtg[(size_t)row * 64 + (c - 5120)] = b;
    }
};

__device__ __forceinline__ void unpack8(const uint4& w, float* f) { f[0] = __uint_as_float(w.x << 16); f[1] = __uint_as_float(w.x & 0xffff0000u); f[2] = __uint_as_float(w.y << 16); f[3] = __uint_as_float(w.y & 0xffff0000u);
    f[4] = __uint_as_float(w.z << 16); f[5] = __uint_as_float(w.z & 0xffff0000u); f[6] = __uint_as_float(w.w << 16); f[7] = __uint_as_float(w.w & 0xffff0000u); }
__device__ __forceinline__ uint4 pack8(const float* f) { return make_uint4(pk2bf(f[0], f[1]), pk2bf(f[2], f[3]), pk2bf(f[4], f[5]), pk2bf(f[6], f[7])); }
__device__ __forceinline__ void ph_tokprep(const Params& p, int wv) {
    PH_IDS(); unsigned char* ws = p.ws;
    const bf16* xbc = (const bf16*)(ws + OFF_XBC); bf16* xsbc = (bf16*)(ws + OFF_XSBC);
    for (int it = gtid; it < (T / 16) * 192; it += gn) {
        const int cg = it % 192, tg = it / 192, ch = cg * 8, t0 = tg * 16, l0 = t0 & (L - 1);
        float w[4][8], bias[8];
#pragma unroll
        for (int j = 0; j < 4; ++j) { const float4 a = *(const float4*)(p.conv_w + j * 1536 + ch), b2 = *(const float4*)(p.conv_w + j * 1536 + ch + 4); w[j][0] = a.x; w[j][1] = a.y; w[j][2] = a.z; w[j][3] = a.w; w[j][4] = b2.x; w[j][5] = b2.y; w[j][6] = b2.z; w[j][7] = b2.w; }
        { const float4 a = *(const float4*)(p.conv_b + ch), b2 = *(const float4*)(p.conv_b + ch + 4); bias[0] = a.x; bias[1] = a.y; bias[2] = a.z; bias[3] = a.w; bias[4] = b2.x; bias[5] = b2.y; bias[6] = b2.z; bias[7] = b2.w; }
        float x0[8], x1[8], x2[8], x3[8];
        { uint4 h0 = make_uint4(0u, 0u, 0u, 0u), h1 = h0, h2 = h0;
          if (l0 != 0) { h0 = *(const uint4*)(xbc + (size_t)(t0 - 3) * 1536 + ch); h1 = *(const uint4*)(xbc + (size_t)(t0 - 2) * 1536 + ch); h2 = *(const uint4*)(xbc + (size_t)(t0 - 1) * 1536 + ch); }
          unpack8(h0, x0); unpack8(h1, x1); unpack8(h2, x2); }
#pragma unroll
        for (int u = 0; u < 16; ++u) {
            unpack8(*(const uint4*)(xbc + (size_t)(t0 + u) * 1536 + ch), x3);
            float y[8];
#pragma unroll
            for (int i = 0; i < 8; ++i) { const float v = bias[i] + w[0][i] * x0[i] + w[1][i] * x1[i] + w[2][i] * x2[i] + w[3][i] * x3[i]; y[i] = v * sigmoidf(v); x0[i] = x1[i]; x1[i] = x2[i]; x2[i] = x3[i]; }
            *(uint4*)(xsbc + (size_t)(t0 + u) * 1536 + ch) = pack8(y);
        }
    }
    const bf16* dtg = (const bf16*)(ws + OFF_DTG); float* dt = (float*)(ws + OFF_DT); float* gate = (float*)(ws + OFF_GATE);
    for (int i = gtid; i < T * 64; i += gn) {
        const int t = i >> 6, c = i & 63; const float v = bf2f(dtg[i]);
        if (c < 16) { const float xx = v + p.dt_bias[c]; dt[t * 16 + c] = xx > 20.f ? xx : log1pf(__expf(xx)); }
        else gate[t * 48 + (c - 16)] = sigmoidf(v);
    }
    const float* rc = (const float*)(ws + OFF_ROPE); const float* rs = rc + 4096 * 32;
    bf16* q = (bf16*)(ws + OFF_Q); bf16* kvs = (bf16*)(ws + OFF_KVS);
    for (int it = gtid; it < T * 24 * 4; it += gn) {
        const int j0 = (it & 3) * 8, hh = (it >> 2) % 24, t = it / 96, l = t & (L - 1);
        bf16* pp; float sc;
        if (hh < 16) { pp = q + (size_t)t * 1024 + hh * 64 + j0; sc = 0.125f; } else if (hh < 20) { pp = kvs + (size_t)t * 1536 + 512 + (hh - 16) * 64 + j0; sc = 1.f; } else { pp = kvs + (size_t)t * 1536 + 1024 + (hh - 20) * 64 + j0; sc = 1.f; }
        float x1[8], x2[8], c[8], s[8], o1[8], o2[8];
        unpack8(*(const uint4*)pp, x1); unpack8(*(const uint4*)(pp + 32), x2);
        { const float4 a = *(const float4*)(rc + l * 32 + j0), b2 = *(const float4*)(rc + l * 32 + j0 + 4), d = *(const float4*)(rs + l * 32 + j0), e = *(const float4*)(rs + l * 32 + j0 + 4);
          c[0] = a.x; c[1] = a.y; c[2] = a.z; c[3] = a.w; c[4] = b2.x; c[5] = b2.y; c[6] = b2.z; c[7] = b2.w; s[0] = d.x; s[1] = d.y; s[2] = d.z; s[3] = d.w; s[4] = e.x; s[5] = e.y; s[6] = e.z; s[7] = e.w; }
#pragma unroll
        for (int i = 0; i < 8; ++i) { o1[i] = (x1[i] * c[i] - x2[i] * s[i]) * sc; o2[i] = (x1[i] * s[i] + x2[i] * c[i]) * sc; }
        *(uint4*)pp = pack8(o1); *(uint4*)(pp + 32) = pack8(o2);
    }
}

__device__ __forceinline__ void ph_ssd_prep2(const Params& p, int wv, unsigned char* lds) {
    PH_IDS(); unsigned char* ws = p.ws;
    const bf16* xsbc = (const bf16*)(ws + OFF_XSBC); const float* dt = (const float*)(ws + OFF_DT);
    bf16* XdT = (bf16*)p.out; bf16* BT = (bf16*)(ws + OFF_BT); float* acsT = (float*)(ws + OFF_ACS);
    float* sdt = (float*)lds; float* swave = sdt + 128;
    const int bide = nb > 64 ? bid - 32 : bid, nbe = nb > 64 ? nb - 32 : nb; if (bide < 0) return;
    for (int unit = bide; unit < 2048 + 256; unit += nbe) {
        __syncthreads();
        if (unit < 2048) {
            const int h = unit & 15, bc = unit >> 4; const size_t t0 = (size_t)bc * 128;
            const float A = -__expf(p.a_log[h]);
            if (tid < 128) { const float dv = dt[(t0 + tid) * 16 + h]; sdt[tid] = dv; float a = dv * A;
#pragma unroll
                for (int o = 1; o < 64; o <<= 1) { const float v = __shfl_up(a, o); if (lane >= o) a += v; }
                if (lane == 63) swave[tid >> 6] = a;
                sdt[128 + 8 + tid] = a; }
            __syncthreads();
            if (tid < 128) { float a = sdt[128 + 8 + tid]; if (tid >= 64) a += swave[0]; acsT[(size_t)unit * 128 + tid] = a; }
            const int pp = tid & 63, lg = tid >> 6; const bf16* src = xsbc + (t0 + lg * 16) * 1536 + h * 64 + pp;
            unsigned w[8];
#pragma unroll
            for (int i = 0; i < 8; ++i) { const float v0 = bf2f(src[(size_t)(2 * i) * 1536]) * sdt[lg * 16 + 2 * i], v1 = bf2f(src[(size_t)(2 * i + 1) * 1536]) * sdt[lg * 16 + 2 * i + 1]; w[i] = (unsigned)f2bf(v0) | ((unsigned)f2bf(v1) << 16); }
            uint4* dst = (uint4*)(XdT + (size_t)unit * 8192 + pp * 128 + lg * 16);
            dst[0] = make_uint4(w[0], w[1], w[2], w[3]); dst[1] = make_uint4(w[4], w[5], w[6], w[7]);
        } else {
            const int u2 = unit - 2048, g = u2 & 1, bc = u2 >> 1; const size_t t0 = (size_t)bc * 128;
            const int n = tid & 127, lg = tid >> 7; const bf16* src = xsbc + (t0 + lg * 32) * 1536 + 1024 + g * 128 + n;
            uint4* dst = (uint4*)(BT + (size_t)u2 * 16384 + n * 128 + lg * 32);
#pragma unroll
            for (int k = 0; k < 4; ++k) { unsigned w[4];
#pragma unroll
                for (int i = 0; i < 4; ++i) w[i] = (unsigned)src[(size_t)(8 * k + 2 * i) * 1536] | ((unsigned)src[(size_t)(8 * k + 2 * i + 1) * 1536] << 16);
                dst[k] = make_uint4(w[0], w[1], w[2], w[3]); }
        }
    }
}
__device__ __forceinline__ bf16x8 scale_frag(bf16x8 a, const float* s) {
    bf16x8 o;
#pragma unroll
    for (int j = 0; j < 8; ++j) o[j] = (short)f2bf(bf2f((bf16)a[j]) * s[j]);
    return o;
}
__device__ __forceinline__ void ph_ssd_states(const Params& p, int wv) {
    PH_IDS(); unsigned char* ws = p.ws; const int r = lane & 15, q = lane >> 4;
    const bf16* XdT = (const bf16*)p.out; bf16* S = (bf16*)((unsigned char*)p.out + 32 * MiB); const bf16* BT = (const bf16*)(ws + OFF_BT); const float* acsT = (const float*)(ws + OFF_ACS);
    for (int task = gwave; task < 8192; task += nwaves) {
        const int pt = task & 3, unit = task >> 2, h = unit & 15, bc = unit >> 4, g = h >> 3;
        const float* ac = acsT + (size_t)unit * 128; const float alast = ac[127];
        const bf16* xrow = XdT + (size_t)unit * 8192 + (pt * 16 + r) * 128; const bf16* bt = BT + (size_t)(bc * 2 + g) * 16384 + r * 128;
        f32x4 acc[8];
#pragma unroll
        for (int i = 0; i < 8; ++i) acc[i] = (f32x4){0.f, 0.f, 0.f, 0.f};
#pragma unroll
        for (int ks = 0; ks < 4; ++ks) {
            const int l0 = ks * 32 + 8 * q; float dec[8];
#pragma unroll
            for (int j = 0; j < 8; ++j) dec[j] = __expf(alast - ac[l0 + j]);
            const bf16x8 af = scale_frag(*(const bf16x8*)(xrow + l0), dec);
#pragma unroll
            for (int nt = 0; nt < 8; ++nt) acc[nt] = __builtin_amdgcn_mfma_f32_16x16x32_bf16(af, *(const bf16x8*)(bt + (size_t)nt * 2048 + l0), acc[nt], 0, 0, 0);
        }
        bf16* so = S + (size_t)unit * 8192 + (pt * 16 + 4 * q) * 128 + r;
#pragma unroll
        for (int nt = 0; nt < 8; ++nt)
#pragma unroll
            for (int e = 0; e < 4; ++e) so[e * 128 + nt * 16] = f2bf(acc[nt][e]);
    }
}
__device__ __forceinline__ void ph_ssd_scan(const Params& p, int wv) {
    PH_IDS();
    unsigned* S = (unsigned*)((unsigned char*)p.out + 32 * MiB); const float* acsT = (const float*)(p.ws + OFF_ACS);
    for (int e = gtid; e < NBATCH * 16 * 4096; e += gn) {
        const int pn = e & 4095, h = (e >> 12) & 15, b = e >> 16; float r0 = 0.f, r1 = 0.f;
        for (int c = 0; c < 32; c += 4) {
            unsigned v[4]; float d[4];
#pragma unroll
            for (int u = 0; u < 4; ++u) { const int unit = (b * 32 + c + u) * 16 + h; v[u] = S[(size_t)unit * 4096 + pn]; d[u] = __expf(acsT[(size_t)unit * 128 + 127]); }
#pragma unroll
            for (int u = 0; u < 4; ++u) { const int unit = (b * 32 + c + u) * 16 + h; S[(size_t)unit * 4096 + pn] = (unsigned)f2bf(r0) | ((unsigned)f2bf(r1) << 16);
                r0 = r0 * d[u] + bf2f((bf16)(v[u] & 0xffffu)); r1 = r1 * d[u] + bf2f((bf16)(v[u] >> 16)); }
        }
    }
}
__device__ __forceinline__ void ph_ssd_out(const Params& p, int wv) {
    PH_IDS(); unsigned char* ws = p.ws; const int r = lane & 15, q = lane >> 4;
    const bf16* XdT = (const bf16*)p.out; const bf16* S = (const bf16*)((unsigned char*)p.out + 32 * MiB); const bf16* xsbc = (const bf16*)(ws + OFF_XSBC);
    const float* acsT = (const float*)(ws + OFF_ACS); bf16* z = (bf16*)(ws + OFF_Z); float* ssq2 = (float*)(ws + OFF_SSQ) + T;
    for (int task = gwave; task < 16384; task += nwaves) {
        const int lt = 7 - (task & 7), unit = task >> 3, h = unit & 15, bc = unit >> 4, g = h >> 3; const size_t t0 = (size_t)bc * 128;
        const float* ac = acsT + (size_t)unit * 128; const float Dh = p.d_skip[h];
        bf16x8 Cf[4];
#pragma unroll
        for (int ks = 0; ks < 4; ++ks) Cf[ks] = *(const bf16x8*)(xsbc + (t0 + lt * 16 + r) * 1536 + 1280 + g * 128 + ks * 32 + 8 * q);
        const float acl = ac[lt * 16 + r]; const int lrow = lt * 16 + r;
        f32x4 acc[4];
#pragma unroll
        for (int i = 0; i < 4; ++i) acc[i] = (f32x4){0.f, 0.f, 0.f, 0.f};
        const bf16* xd = XdT + (size_t)unit * 8192 + r * 128;
        for (int kk = 0; kk <= (lt >> 1); ++kk) {
            bf16x8 mf;
#pragma unroll
            for (int half = 0; half < 2; ++half) {
                const int st = 2 * kk + half; f32x4 cb = (f32x4){0.f, 0.f, 0.f, 0.f};
                if (st <= lt) {
                    const bf16* brow = xsbc + (t0 + st * 16 + r) * 1536 + 1024 + g * 128 + 8 * q;
#pragma unroll
                    for (int ks = 0; ks < 4; ++ks) cb = __builtin_amdgcn_mfma_f32_16x16x32_bf16(*(const bf16x8*)(brow + ks * 32), Cf[ks], cb, 0, 0, 0);
                    const f32x4 as4 = *(const f32x4*)(ac + st * 16 + 4 * q);
#pragma unroll
                    for (int e = 0; e < 4; ++e) { const int s = st * 16 + 4 * q + e; cb[e] = (lrow >= s) ? cb[e] * __expf(acl - as4[e]) : 0.f; }
                }
#pragma unroll
                for (int e = 0; e < 4; ++e) mf[half * 4 + e] = (short)f2bf(cb[e]);
            }
#pragma unroll
            for (int pt = 0; pt < 4; ++pt) {
                const uint2 lo = *(const uint2*)(xd + (size_t)pt * 2048 + 32 * kk + 4 * q), hi = *(const uint2*)(xd + (size_t)pt * 2048 + 32 * kk + 16 + 4 * q);
                union { uint4 u; bf16x8 v; } xf; xf.u = make_uint4(lo.x, lo.y, hi.x, hi.y);
                acc[pt] = __builtin_amdgcn_mfma_f32_16x16x32_bf16(mf, xf.v, acc[pt], 0, 0, 0);
            }
        }
        f32x4 acc2[4];
#pragma unroll
        for (int i = 0; i < 4; ++i) acc2[i] = (f32x4){0.f, 0.f, 0.f, 0.f};
        const bf16* sin = S + (size_t)unit * 8192 + r * 128 + 8 * q;
#pragma unroll
        for (int ks = 0; ks < 4; ++ks)
#pragma unroll
            for (int pt = 0; pt < 4; ++pt) acc2[pt] = __builtin_amdgcn_mfma_f32_16x16x32_bf16(Cf[ks], *(const bf16x8*)(sin + (size_t)pt * 2048 + ks * 32), acc2[pt], 0, 0, 0);
#pragma unroll
        for (int e = 0; e < 4; ++e) {
            const int l = lt * 16 + 4 * q + e; const size_t t = t0 + l; const float od = __expf(ac[l]); float ss = 0.f;
#pragma unroll
            for (int pt = 0; pt < 4; ++pt) { const int col = h * 64 + pt * 16 + r; const float xv = bf2f(xsbc[t * 1536 + col]);
                const float y = acc[pt][e] + od * acc2[pt][e] + Dh * xv; const float zz = bf2f(z[t * 1024 + col]); const float v = y * (zz * sigmoidf(zz));
                z[t * 1024 + col] = f2bf(v); ss += v * v; }
            ss += __shfl_xor(ss, 1); ss += __shfl_xor(ss, 2); ss += __shfl_xor(ss, 4); ss += __shfl_xor(ss, 8);
            if (r == 0) atomicAdd(&ssq2[t * 2 + g], ss);
        }
    }
}

struct ACmp {
    const bf16* kvs; int coff;
    __device__ __forceinline__ bf16x8 operator()(int m, int k) const {
        const int hk = m & 3, n = (m >> 2) & 255, b = m >> 10, l = k >> 6, d = k & 63;
        if (n == 255) return (bf16x8){0, 0, 0, 0, 0, 0, 0, 0};
        return *(const bf16x8*)(kvs + (size_t)(b * L + 16 * n + l) * 1536 + coff + hk * 64 + d);
    }
};
struct EpiHid { bf16* hid; const float* bias; __device__ __forceinline__ void operator()(int row, int c, float v) const { hid[(size_t)row * 256 + c] = f2bf(gelu_exact(v + bias[c])); } };
struct EpiKc {
    bf16* dst; bool tr; __device__ __forceinline__ void operator()(int m, int c, float v) const { const int hk = m & 3, n = (m >> 2) & 255, b = m >> 10; const bf16 o = (n == 255) ? (bf16)0 : f2bf(v);
        if (tr) dst[((size_t)(b * 4 + hk) * 64 + c) * 256 + n] = o; else dst[((size_t)(b * 4 + hk) * 256 + n) * 64 + c] = o; } };
__device__ __forceinline__ void ph_kc_rope(const Params& p, int wv) {
    PH_IDS(); unsigned char* ws = p.ws; bf16* kc = (bf16*)(ws + OFF_KC); const float* rc = (const float*)(ws + OFF_ROPE); const float* rs = rc + 4096 * 32;
    for (int i = gtid; i < 16 * 256 * 32; i += gn) {
        const int j = i & 31, n = (i >> 5) & 255, bh = i >> 13; const int pos = 16 * n + 31; if (n == 255) continue;
        const float c = rc[pos * 32 + j], s = rs[pos * 32 + j];
        bf16* pp = kc + ((size_t)bh * 256 + n) * 64 + j; const float x1 = bf2f(pp[0]), x2 = bf2f(pp[32]);
        pp[0] = f2bf(x1 * c - x2 * s); pp[32] = f2bf(x1 * s + x2 * c);
    }
}


__device__ __forceinline__ void ph_vt_prep(const Params& p, int wv) {
    PH_IDS(); unsigned char* ws = p.ws; const bf16* kvs = (const bf16*)(ws + OFF_KVS);
    const int bide = nb > 64 ? bid - 32 : bid, nbe = nb > 64 ? nb - 32 : nb; if (bide < 0) return;
    for (int unit = bide; unit < 2 * 16 * 64; unit += nbe) {
        const int br = unit & 1, tl = (unit >> 1) & 63, bh = unit >> 7, b = bh >> 2, hk = bh & 3;
        const int d = tid & 63, grp = tid >> 6; const int l0 = tl * 64 + grp * 8;
        const bf16* src = kvs + ((size_t)b * L + l0) * 1536 + (br ? 1280 : 768) + hk * 64 + d;
        unsigned w[4];
#pragma unroll
        for (int i = 0; i < 4; ++i) w[i] = (unsigned)src[(size_t)(2 * i) * 1536] | ((unsigned)src[(size_t)(2 * i + 1) * 1536] << 16);
        bf16* dst = (bf16*)(ws + (br ? OFF_VWT : OFF_VST)) + ((size_t)bh * 64 + d) * L + l0;
        *(uint4*)dst = make_uint4(w[0], w[1], w[2], w[3]);
    }
}

typedef float f32x16 __attribute__((ext_vector_type(16)));
__device__ __forceinline__ int crow(int r, int hi) { return (r & 3) + 8 * (r >> 2) + 4 * hi; }
constexpr int NSA_KROW = 144, NSA_VROW = 136, NSA_KBUF = 64 * NSA_KROW, NSA_VBUF = 64 * NSA_VROW;
constexpr int NSA_OFF_K = 0, NSA_OFF_V = 2 * NSA_KBUF, NSA_OFF_IMPA = NSA_OFF_V + 2 * NSA_VBUF, NSA_IMPS = 65, NSA_OFF_IMPB = NSA_OFF_IMPA + 64 * NSA_IMPS * 4, NSA_OFF_SEL = NSA_OFF_IMPB + 64 * NSA_IMPS * 4;
struct NsaSrc { const bf16* K; size_t kstride; const bf16* VT; size_t ldv; };
__device__ __forceinline__ void nsa_gload(const NsaSrc& s, int k0, int tid, uint4& kr, uint4& vr) {
    const int row = tid >> 3, ch = tid & 7;
    kr = *(const uint4*)(s.K + (size_t)(k0 + row) * s.kstride + ch * 8);
    vr = *(const uint4*)(s.VT + (size_t)row * s.ldv + k0 + ch * 8);
}
__device__ __forceinline__ void nsa_lstore(unsigned char* kb, unsigned char* vb, int tid, const uint4& kr, const uint4& vr) {
    const int row = tid >> 3, ch = tid & 7;
    *(uint4*)(kb + row * NSA_KROW + ch * 16) = kr;
    uint2* vp = (uint2*)(vb + row * NSA_VROW + ch * 16); vp[0] = make_uint2(vr.x, vr.y); vp[1] = make_uint2(vr.z, vr.w);
}
__device__ __forceinline__ void nsa_qk(const unsigned char* kb, const bf16x8 (&qf)[4], int rr, int hi, f32x16& p0, f32x16& p1) {
#pragma unroll
    for (int i = 0; i < 16; ++i) { p0[i] = 0.f; p1[i] = 0.f; }
#pragma unroll
    for (int ds = 0; ds < 4; ++ds) {
        const bf16x8 a0 = *(const bf16x8*)(kb + rr * NSA_KROW + ds * 32 + hi * 16), a1 = *(const bf16x8*)(kb + (rr + 32) * NSA_KROW + ds * 32 + hi * 16);
        p0 = __builtin_amdgcn_mfma_f32_32x32x16_bf16(a0, qf[ds], p0, 0, 0, 0); p1 = __builtin_amdgcn_mfma_f32_32x32x16_bf16(a1, qf[ds], p1, 0, 0, 0);
    }
}
__device__ __forceinline__ void nsa_pv(const unsigned char* vb, int rr, int hi, const f32x16& p0, const f32x16& p1, f32x16 (&O)[2]) {
#pragma unroll
    for (int s = 0; s < 4; ++s) {
        const int eb = 8 * (s & 1), kbase = 32 * (s >> 1) + 16 * (s & 1);
        union { uint4 u; bf16x8 v; } pf;
        if (s < 2) pf.u = make_uint4(pk2bf(p0[eb], p0[eb + 1]), pk2bf(p0[eb + 2], p0[eb + 3]), pk2bf(p0[eb + 4], p0[eb + 5]), pk2bf(p0[eb + 6], p0[eb + 7]));
        else       pf.u = make_uint4(pk2bf(p1[eb], p1[eb + 1]), pk2bf(p1[eb + 2], p1[eb + 3]), pk2bf(p1[eb + 4], p1[eb + 5]), pk2bf(p1[eb + 6], p1[eb + 7]));
#pragma unroll
        for (int dsub = 0; dsub < 2; ++dsub) {
            const unsigned char* vp = vb + (dsub * 32 + rr) * NSA_VROW + (kbase + 4 * hi) * 2;
            const uint2 lo = *(const uint2*)vp, hh = *(const uint2*)(vp + 16);
            union { uint4 u; bf16x8 v; } vf; vf.u = make_uint4(lo.x, lo.y, hh.x, hh.y);
            O[dsub] = __builtin_amdgcn_mfma_f32_32x32x16_bf16(vf.v, pf.v, O[dsub], 0, 0, 0);
        }
    }
}
template <int MODE>
__device__ __forceinline__ void nsa_branch(unsigned char* lds, const NsaSrc& src, int jt0, int jt1, int tid, int rr, int hi, const bf16x8 (&qf)[4], int lpos, int qi, int tokblk,
                                           u64 selm, u64 wsel, float& m, float& lsum, float inv_l, f32x16 (&O)[2]) {
    if (jt0 >= jt1) return;
    asm volatile("" : "+v"(tid), "+v"(rr));
    float* impA = (float*)(lds + NSA_OFF_IMPA); float* impB = (float*)(lds + NSA_OFF_IMPB);
    uint4 kr, vr;
    nsa_gload(src, jt0 * 64, tid, kr, vr);
    nsa_lstore(lds + NSA_OFF_K, lds + NSA_OFF_V, tid, kr, vr);
    __syncthreads();
    for (int jt = jt0; jt < jt1; ++jt) {
        const int cur = (jt - jt0) & 1; const bool more = (jt + 1 < jt1);
        if (more) nsa_gload(src, (jt + 1) * 64, tid, kr, vr);
        const unsigned char* kb = lds + NSA_OFF_K + cur * NSA_KBUF; const unsigned char* vb = lds + NSA_OFF_V + cur * NSA_VBUF;
        const bool active = (MODE != 2) || ((wsel >> jt) & 1ull);
        if (active) {
            f32x16 p0, p1; nsa_qk(kb, qf, rr, hi, p0, p1);
            const int k0 = jt * 64;
            const bool tile_on = (MODE != 2) || ((selm >> jt) & 1ull);
            float mx = NEG_INF;
#pragma unroll
            for (int e = 0; e < 16; ++e) {
                const int ka = k0 + crow(e, hi), kb2 = ka + 32; bool oa, ob;
                if (MODE <= 1) { oa = (16 * ka + 31 <= lpos); ob = (16 * kb2 + 31 <= lpos); }
                else if (MODE == 2) { oa = tile_on && (ka <= lpos); ob = tile_on && (kb2 <= lpos); }
                else { oa = (ka <= lpos) && (ka > lpos - 512); ob = (kb2 <= lpos) && (kb2 > lpos - 512); }
                p0[e] = oa ? p0[e] : NEG_INF; p1[e] = ob ? p1[e] : NEG_INF; mx = fmaxf(mx, fmaxf(p0[e], p1[e]));
            }
            if (MODE != 1) {
                mx = fmaxf(mx, __shfl_xor(mx, 32));
                const float mnew = fmaxf(m, mx), alpha = __expf(m - mnew); m = mnew; float rs = 0.f;
#pragma unroll
                for (int e = 0; e < 16; ++e) { p0[e] = (p0[e] > 0.5f * NEG_INF) ? __expf(p0[e] - mnew) : 0.f; p1[e] = (p1[e] > 0.5f * NEG_INF) ? __expf(p1[e] - mnew) : 0.f; rs += p0[e] + p1[e]; }
                lsum = lsum * alpha + rs;
                if (MODE != 0) {
#pragma unroll
                    for (int e = 0; e < 16; ++e) { O[0][e] *= alpha; O[1][e] *= alpha; }
                    nsa_pv(vb, rr, hi, p0, p1, O);
                }
            } else {
#pragma unroll
                for (int e = 0; e < 16; ++e) { p0[e] = (p0[e] > 0.5f * NEG_INF) ? __expf(p0[e] - m) * inv_l : 0.f; p1[e] = (p1[e] > 0.5f * NEG_INF) ? __expf(p1[e] - m) * inv_l : 0.f; }
                nsa_pv(vb, rr, hi, p0, p1, O);
#pragma unroll
                for (int sub = 0; sub < 2; ++sub)
#pragma unroll
                    for (int a = 0; a < 4; ++a) {
                        float G, last;
                        if (sub == 0) { G = (p0[4 * a] + p0[4 * a + 1]) + (p0[4 * a + 2] + p0[4 * a + 3]); last = p0[4 * a + 3]; } else { G = (p1[4 * a] + p1[4 * a + 1]) + (p1[4 * a + 2] + p1[4 * a + 3]); last = p1[4 * a + 3]; }
                        G += __shfl_xor(G, 1); G += __shfl_xor(G, 2); last += __shfl_xor(last, 1); last += __shfl_xor(last, 2);
                        const int jj = (k0 >> 2) + 8 * sub + 2 * a + hi;
                        if ((rr & 3) == 0) { impA[tokblk * NSA_IMPS + jj] = G; if (jj + 1 < 64) impB[tokblk * NSA_IMPS + jj + 1] = last; }
                    }
            }
        }
        if (more) nsa_lstore(lds + NSA_OFF_K + (cur ^ 1) * NSA_KBUF, lds + NSA_OFF_V + (cur ^ 1) * NSA_VBUF, tid, kr, vr);
        __syncthreads();
    }
}
__device__ __forceinline__ void ph_nsa(const Params& p, int wv, unsigned char* lds) {
    PH_IDS(); unsigned char* ws = p.ws; const int wave = wv, rr = lane & 31, hi = lane >> 5;
    bf16* q = (bf16*)(ws + OFF_Q); const bf16* kvs = (const bf16*)(ws + OFF_KVS);
    const float* gate = (const float*)(ws + OFF_GATE); float* ssq = (float*)(ws + OFF_SSQ);
    float* impA = (float*)(lds + NSA_OFF_IMPA); float* impB = (float*)(lds + NSA_OFF_IMPB); u64* selw = (u64*)(lds + NSA_OFF_SEL);
    const int nunits = 1024;
    for (int it = 0; ; ++it) {
        int bh, qi;
        if (nb == 256) { if (it >= 4) break; bh = bid & 15; const int x = bid >> 4; qi = (it == 0) ? 63 - x : (it == 1) ? 32 + x : (it == 2) ? 31 - x : x; }
        else { const int u = bid + it * nb; if (u >= nunits) break; bh = u & 15; qi = 63 - (u >> 4); }
        const int b = bh >> 2, hk = bh & 3; const int tokblk = wave * 8 + (rr >> 2), g = rr & 3; const int lpos = qi * 64 + tokblk; const size_t t = (size_t)b * L + lpos;
        bf16* qrow = q + t * 1024 + (hk * 4 + g) * 64;
        bf16x8 qf[4];
#pragma unroll
        for (int ds = 0; ds < 4; ++ds) qf[ds] = *(const bf16x8*)(qrow + ds * 16 + hi * 8);
        for (int i = tid; i < 64 * NSA_IMPS; i += NTHREADS) { impA[i] = 0.f; impB[i] = 0.f; }
        __syncthreads();
        f32x16 outacc[2]; f32x16 O[2];
#pragma unroll
        for (int e = 0; e < 16; ++e) { outacc[0][e] = 0.f; outacc[1][e] = 0.f; }
        const float g0 = gate[t * 48 + (hk * 4 + g) * 3 + 0], g1 = gate[t * 48 + (hk * 4 + g) * 3 + 1], g2 = gate[t * 48 + (hk * 4 + g) * 3 + 2];
        {
            NsaSrc s{(const bf16*)(ws + OFF_KC) + (size_t)bh * 256 * 64, 64, (const bf16*)(ws + OFF_VCT) + (size_t)bh * 64 * 256, 256};
            const int nct = (4 * qi + 3 + 63) >> 6;
            float m = NEG_INF, lsum = 0.f;
            nsa_branch<0>(lds, s, 0, nct, tid, rr, hi, qf, lpos, qi, tokblk, 0ull, 0ull, m, lsum, 0.f, O);
            lsum += __shfl_xor(lsum, 32);
            const float inv_l = lsum > 0.f ? 1.0f / lsum : 0.f;
#pragma unroll
            for (int e = 0; e < 16; ++e) { O[0][e] = 0.f; O[1][e] = 0.f; }
            nsa_branch<1>(lds, s, 0, nct, tid, rr, hi, qf, lpos, qi, tokblk, 0ull, 0ull, m, lsum, inv_l, O);
#pragma unroll
            for (int e = 0; e < 16; ++e) { outacc[0][e] += g0 * O[0][e]; outacc[1][e] += g0 * O[1][e]; }
        }
        {
            const int tk = tid >> 3, jg = tid & 7; float v[8];
#pragma unroll
            for (int i = 0; i < 8; ++i) { const int j = jg * 8 + i; const float raw = impA[tk * NSA_IMPS + j] + impB[tk * NSA_IMPS + j];
                const bool causal = (j <= qi), forced = (j == 0) || (j == qi) || (j == qi - 1); v[i] = causal ? (forced ? BIG : raw) : NEG_INF; }
            __syncthreads();
#pragma unroll
            for (int i = 0; i < 8; ++i) impA[tk * NSA_IMPS + jg * 8 + i] = v[i];
            __syncthreads();
            int rank[8];
#pragma unroll
            for (int i = 0; i < 8; ++i) rank[i] = 0;
            for (int jj = 0; jj < 64; ++jj) { const float x = impA[tk * NSA_IMPS + jj];
#pragma unroll
                for (int i = 0; i < 8; ++i) rank[i] += (x > v[i] || (x == v[i] && jj < jg * 8 + i)) ? 1 : 0; }
            unsigned b8 = 0u;
#pragma unroll
            for (int i = 0; i < 8; ++i) b8 |= (rank[i] < 16 && jg * 8 + i <= qi) ? (1u << i) : 0u;
            const u64 full = (u64)b8 << (jg * 8); unsigned blo = (unsigned)full, bhi = (unsigned)(full >> 32);
            blo |= __shfl_xor(blo, 1); bhi |= __shfl_xor(bhi, 1); blo |= __shfl_xor(blo, 2); bhi |= __shfl_xor(bhi, 2); blo |= __shfl_xor(blo, 4); bhi |= __shfl_xor(bhi, 4);
            if (jg == 0) selw[tk] = (u64)blo | ((u64)bhi << 32);
            __syncthreads();
        }
        const u64 selm = selw[tokblk];
        u64 wsel = selm;
        { unsigned lo = (unsigned)wsel, h2 = (unsigned)(wsel >> 32);
          lo |= __shfl_xor(lo, 4); h2 |= __shfl_xor(h2, 4); lo |= __shfl_xor(lo, 8); h2 |= __shfl_xor(h2, 8); lo |= __shfl_xor(lo, 16); h2 |= __shfl_xor(h2, 16);
          wsel = (u64)lo | ((u64)h2 << 32); }
        {
            NsaSrc s{kvs + (size_t)b * L * 1536 + 512 + hk * 64, 1536, (const bf16*)(ws + OFF_VST) + (size_t)bh * 64 * L, (size_t)L};
            float m = NEG_INF, lsum = 0.f;
#pragma unroll
            for (int e = 0; e < 16; ++e) { O[0][e] = 0.f; O[1][e] = 0.f; }
            nsa_branch<2>(lds, s, 0, qi + 1, tid, rr, hi, qf, lpos, qi, tokblk, selm, wsel, m, lsum, 0.f, O);
            lsum += __shfl_xor(lsum, 32); const float sc = g1 / lsum;
#pragma unroll
            for (int e = 0; e < 16; ++e) { outacc[0][e] += sc * O[0][e]; outacc[1][e] += sc * O[1][e]; }
        }
        {
            NsaSrc s{kvs + (size_t)b * L * 1536 + 1024 + hk * 64, 1536, (const bf16*)(ws + OFF_VWT) + (size_t)bh * 64 * L, (size_t)L};
            float m = NEG_INF, lsum = 0.f;
#pragma unroll
            for (int e = 0; e < 16; ++e) { O[0][e] = 0.f; O[1][e] = 0.f; }
            nsa_branch<3>(lds, s, qi >= 8 ? qi - 8 : 0, qi + 1, tid, rr, hi, qf, lpos, qi, tokblk, 0ull, 0ull, m, lsum, 0.f, O);
            lsum += __shfl_xor(lsum, 32); const float sc = g2 / lsum;
#pragma unroll
            for (int e = 0; e < 16; ++e) { outacc[0][e] += sc * O[0][e]; outacc[1][e] += sc * O[1][e]; }
        }
        float ss = 0.f;
#pragma unroll
        for (int dsub = 0; dsub < 2; ++dsub)
#pragma unroll
            for (int a = 0; a < 4; ++a) {
                const float v0 = outacc[dsub][4 * a], v1 = outacc[dsub][4 * a + 1], v2 = outacc[dsub][4 * a + 2], v3 = outacc[dsub][4 * a + 3];
                ss += (v0 * v0 + v1 * v1) + (v2 * v2 + v3 * v3);
                *(uint2*)(qrow + dsub * 32 + 8 * a + 4 * hi) = make_uint2(pk2bf(v0, v1), pk2bf(v2, v3));
            }
        ss += __shfl_xor(ss, 32); ss += __shfl_xor(ss, 1); ss += __shfl_xor(ss, 2);
        if (hi == 0 && g == 0) atomicAdd(&ssq[t], ss);
        __syncthreads();
    }
}

__device__ __forceinline__ void ph_nsa_naive(const Params& p, int wv, unsigned char* lds) {
    PH_IDS(); unsigned char* ws = p.ws; const int wave = wv;
    float* qs = (float*)(lds + wave * 17408); float* sbuf = qs + 256;
    bf16* q = (bf16*)(ws + OFF_Q); const bf16* kvs = (const bf16*)(ws + OFF_KVS);
    const bf16* kc = (const bf16*)(ws + OFF_KC); const bf16* vc = (const bf16*)(ws + OFF_VC);
    const float* gate = (const float*)(ws + OFF_GATE); float* ssq = (float*)(ws + OFF_SSQ);
    for (int task = gwave; task < T * 4; task += nwaves) {
        const int hk = task & 3, t = task >> 2, b = t >> 12, l = t & (L - 1), tb = l >> 6;
        bf16* qrow = q + (size_t)t * 1024 + hk * 256;
        __builtin_amdgcn_s_waitcnt(0);
#pragma unroll
        for (int g = 0; g < 4; ++g) qs[g * 64 + lane] = bf2f(qrow[g * 64 + lane]);
        float outv[4] = {0.f, 0.f, 0.f, 0.f};
        const bf16* kcb = kc + (size_t)(b * 4 + hk) * 256 * 64; const bf16* vcb = vc + (size_t)(b * 4 + hk) * 256 * 64;
        float m4[4] = {NEG_INF, NEG_INF, NEG_INF, NEG_INF};
#pragma unroll 1
        for (int c = 0; c < 4; ++c) {
            const int n = c * 64 + lane; const bool valid = (n < 255) && (16 * n + 31 <= l);
            float s[4] = {0.f, 0.f, 0.f, 0.f};
            const bf16* kr = kcb + (size_t)n * 64;
#pragma unroll 4
            for (int d = 0; d < 64; ++d) { const float kv = bf2f(kr[d]);
#pragma unroll
                for (int g = 0; g < 4; ++g) s[g] += qs[g * 64 + d] * kv; }
#pragma unroll
            for (int g = 0; g < 4; ++g) { const float sv = valid ? s[g] : NEG_INF; sbuf[g * 1024 + n] = sv; m4[g] = fmaxf(m4[g], sv); }
        }
        const bool anyvalid = (l >= 31);
        float sum4[4];
#pragma unroll
        for (int g = 0; g < 4; ++g) { m4[g] = wave_max(m4[g]); sum4[g] = 0.f; }
#pragma unroll 1
        for (int c = 0; c < 4; ++c) { const int n = c * 64 + lane;
#pragma unroll
            for (int g = 0; g < 4; ++g) { const float sv = sbuf[g * 1024 + n]; const float e = (sv > 0.5f * NEG_INF) ? __expf(sv - m4[g]) : 0.f; sbuf[g * 1024 + n] = e; sum4[g] += e; } }
#pragma unroll
        for (int g = 0; g < 4; ++g) { sum4[g] = wave_sum(sum4[g]); sum4[g] = anyvalid ? 1.0f / sum4[g] : 0.f; }
#pragma unroll 1
        for (int c = 0; c < 4; ++c) { const int n = c * 64 + lane;
#pragma unroll
            for (int g = 0; g < 4; ++g) sbuf[g * 1024 + n] *= sum4[g]; }
        __builtin_amdgcn_s_waitcnt(0);
        float imp = 0.f;
        { const int j = lane;
          for (int n = 4 * j - 1; n <= 4 * j + 3; ++n) if (n >= 0 && n < 255) { imp += sbuf[n] + sbuf[1024 + n] + sbuf[2048 + n] + sbuf[3072 + n]; }
          const bool causal = (j <= tb), forced = (j == 0) || (j == tb) || (j == tb - 1);
          imp = causal ? (forced ? BIG : imp) : NEG_INF; }
        int rank = 0;
#pragma unroll 1
        for (int jj = 0; jj < 64; ++jj) { const float v = __shfl(imp, jj); rank += (v > imp || (v == imp && jj < lane)) ? 1 : 0; }
        const bool sel = (rank < 16) && (lane <= tb);
        const u64 selmask = __ballot(sel);
        { float oc[4] = {0.f, 0.f, 0.f, 0.f};
          if (anyvalid) { const int nmax = (l - 31) / 16;
            for (int n = 0; n <= nmax; ++n) { const float vv = bf2f(vcb[(size_t)n * 64 + lane]);
#pragma unroll
                for (int g = 0; g < 4; ++g) oc[g] += sbuf[g * 1024 + n] * vv; } }
#pragma unroll
          for (int g = 0; g < 4; ++g) outv[g] += gate[(size_t)t * 48 + (hk * 4 + g) * 3 + 0] * oc[g]; }
        __builtin_amdgcn_s_waitcnt(0);
        {
            const bf16* ksb = kvs + (size_t)b * L * 1536 + 512 + hk * 64; const bf16* vsb = kvs + (size_t)b * L * 1536 + 768 + hk * 64;
            float mx[4] = {NEG_INF, NEG_INF, NEG_INF, NEG_INF}; int cnt = 0;
            for (u64 mm = selmask; mm; mm &= mm - 1, ++cnt) {
                const int j = __builtin_ctzll(mm); const int kp = j * 64 + lane; const bool ok = kp <= l;
                const bf16* kr = ksb + (size_t)kp * 1536; float s[4] = {0.f, 0.f, 0.f, 0.f};
#pragma unroll 4
                for (int d = 0; d < 64; ++d) { const float kv = bf2f(kr[d]);
#pragma unroll
                    for (int g = 0; g < 4; ++g) s[g] += qs[g * 64 + d] * kv; }
#pragma unroll
                for (int g = 0; g < 4; ++g) { const float sv = ok ? s[g] : NEG_INF; sbuf[g * 1024 + cnt * 64 + lane] = sv; mx[g] = fmaxf(mx[g], sv); }
            }
            float sm[4];
#pragma unroll
            for (int g = 0; g < 4; ++g) { mx[g] = wave_max(mx[g]); sm[g] = 0.f; }
            for (int c = 0; c < cnt; ++c)
#pragma unroll
                for (int g = 0; g < 4; ++g) { const float sv = sbuf[g * 1024 + c * 64 + lane]; const float e = (sv > 0.5f * NEG_INF) ? __expf(sv - mx[g]) : 0.f; sbuf[g * 1024 + c * 64 + lane] = e; sm[g] += e; }
#pragma unroll
            for (int g = 0; g < 4; ++g) sm[g] = 1.0f / wave_sum(sm[g]);
            __builtin_amdgcn_s_waitcnt(0);
            float os[4] = {0.f, 0.f, 0.f, 0.f}; int c = 0;
            for (u64 mm = selmask; mm; mm &= mm - 1, ++c) {
                const int j = __builtin_ctzll(mm); const int kmax = min(63, l - j * 64);
                for (int kk = 0; kk <= kmax; ++kk) { const float vv = bf2f(vsb[(size_t)(j * 64 + kk) * 1536 + lane]);
#pragma unroll
                    for (int g = 0; g < 4; ++g) os[g] += sbuf[g * 1024 + c * 64 + kk] * vv; }
            }
#pragma unroll
            for (int g = 0; g < 4; ++g) outv[g] += gate[(size_t)t * 48 + (hk * 4 + g) * 3 + 1] * os[g] * sm[g];
        }
        __builtin_amdgcn_s_waitcnt(0);
        {
            const bf16* kwb = kvs + (size_t)b * L * 1536 + 1024 + hk * 64; const bf16* vwb = kvs + (size_t)b * L * 1536 + 1280 + hk * 64;
            const int k0 = l - 511; float mx[4] = {NEG_INF, NEG_INF, NEG_INF, NEG_INF};
#pragma unroll 1
            for (int c = 0; c < 8; ++c) {
                const int kp = k0 + c * 64 + lane; const bool ok = kp >= 0; float s[4] = {0.f, 0.f, 0.f, 0.f};
                if (ok) { const bf16* kr = kwb + (size_t)kp * 1536;
#pragma unroll 4
                    for (int d = 0; d < 64; ++d) { const float kv = bf2f(kr[d]);
#pragma unroll
                        for (int g = 0; g < 4; ++g) s[g] += qs[g * 64 + d] * kv; } }
#pragma unroll
                for (int g = 0; g < 4; ++g) { const float sv = ok ? s[g] : NEG_INF; sbuf[g * 1024 + c * 64 + lane] = sv; mx[g] = fmaxf(mx[g], sv); }
            }
            float sm[4];
#pragma unroll
            for (int g = 0; g < 4; ++g) { mx[g] = wave_max(mx[g]); sm[g] = 0.f; }
#pragma unroll 1
            for (int c = 0; c < 8; ++c)
#pragma unroll
                for (int g = 0; g < 4; ++g) { const float sv = sbuf[g * 1024 + c * 64 + lane]; const float e = (sv > 0.5f * NEG_INF) ? __expf(sv - mx[g]) : 0.f; sbuf[g * 1024 + c * 64 + lane] = e; sm[g] += e; }
#pragma unroll
            for (int g = 0; g < 4; ++g) sm[g] = 1.0f / wave_sum(sm[g]);
            __builtin_amdgcn_s_waitcnt(0);
            float ow[4] = {0.f, 0.f, 0.f, 0.f};
            for (int i = (k0 < 0 ? -k0 : 0); i < 512; ++i) { const float vv = bf2f(vwb[(size_t)(k0 + i) * 1536 + lane]);
#pragma unroll
                for (int g = 0; g < 4; ++g) ow[g] += sbuf[g * 1024 + i] * vv; }
#pragma unroll
            for (int g = 0; g < 4; ++g) outv[g] += gate[(size_t)t * 48 + (hk * 4 + g) * 3 + 2] * ow[g] * sm[g];
        }
        float ss = 0.f;
#pragma unroll
        for (int g = 0; g < 4; ++g) { qrow[g * 64 + lane] = f2bf(outv[g]); ss += outv[g] * outv[g]; }
        ss = wave_sum(ss); if (lane == 0) atomicAdd(&ssq[t], ss);
    }
}

__device__ __forceinline__ void ph_ln1(const Params& p, int wv) {
    PH_IDS(); unsigned char* ws = p.ws; bf16* h1b = (bf16*)(ws + OFF_H1B);
    for (int t = gwave; t < T; t += nwaves) {
        float v[16]; float s = 0.f; float* row = p.out + (size_t)t * 1024;
#pragma unroll
        for (int i = 0; i < 16; ++i) { v[i] = row[i * 64 + lane]; s += v[i]; }
        const float mu = wave_sum(s) * (1.0f / 1024.0f); float s2 = 0.f;
#pragma unroll
        for (int i = 0; i < 16; ++i) { v[i] -= mu; s2 += v[i] * v[i]; }
        const float rstd = rsqrtf(wave_sum(s2) * (1.0f / 1024.0f) + LN_EPS);
#pragma unroll
        for (int i = 0; i < 16; ++i) { const int c = i * 64 + lane; const float o = v[i] * rstd * p.ln1_g[c] + p.ln1_b[c]; row[c] = o; h1b[(size_t)t * 1024 + c] = f2bf(o); }
    }
}

__device__ __forceinline__ void ph_peer_topk(const Params& p, int wv, unsigned char* lds) {
    PH_IDS(); unsigned char* ws = p.ws; const int rr = lane & 31, hi = lane >> 5;
    float* sv = (float*)(lds + wv * 12288); int* si = (int*)(sv + 1024); float* gv = (float*)(si + 1024); int* ge = (int*)(gv + 512);
    const bf16* qp = (const bf16*)(ws + OFF_QP); const bf16* keys = (const bf16*)(ws + OFF_KEYS);
    int* eidx = (int*)(ws + OFF_EIDX); float* gw = (float*)(ws + OFF_GW);
    const float NEGB = -3.0e38f;
    for (int task = gwave; task < 512 * 8; task += nwaves) {
        const int h = task & 7, t0 = (task >> 3) * 32;
#pragma unroll 1
        for (int c = 0; c < 2; ++c) {
            bf16x8 qf[8];
#pragma unroll
            for (int ks = 0; ks < 8; ++ks) qf[ks] = *(const bf16x8*)(qp + (size_t)(t0 + rr) * 2048 + h * 256 + c * 128 + ks * 16 + 8 * hi);
            f32x16 acc[4];
#pragma unroll
            for (int kt = 0; kt < 4; ++kt) {
#pragma unroll
                for (int e = 0; e < 16; ++e) acc[kt][e] = 0.f;
                const bf16* kr = keys + ((size_t)(h * 2 + c) * 128 + kt * 32 + rr) * 128 + 8 * hi;
#pragma unroll
                for (int ks = 0; ks < 8; ++ks) acc[kt] = __builtin_amdgcn_mfma_f32_32x32x16_bf16(*(const bf16x8*)(kr + ks * 16), qf[ks], acc[kt], 0, 0, 0);
            }
#pragma unroll 1
            for (int r = 0; r < 16; ++r) {
                float m = NEGB;
#pragma unroll
                for (int kt = 0; kt < 4; ++kt)
#pragma unroll
                    for (int e = 0; e < 16; ++e) m = fmaxf(m, acc[kt][e]);
                const float gm = fmaxf(m, __shfl_xor(m, 32));
                int idx = 255; bool found = false;
#pragma unroll
                for (int kt = 0; kt < 4; ++kt)
#pragma unroll
                    for (int e = 0; e < 16; ++e) { const bool hit = (acc[kt][e] == gm) && !found; idx = hit ? (kt * 32 + (e & 3) + 8 * (e >> 2) + 4 * hi) : idx; found = found || hit; }
                const int widx = min(idx, __shfl_xor(idx, 32)); const int wloc = widx - 4 * hi;
#pragma unroll
                for (int kt = 0; kt < 4; ++kt)
#pragma unroll
                    for (int e = 0; e < 16; ++e) acc[kt][e] = (wloc == kt * 32 + (e & 3) + 8 * (e >> 2)) ? NEGB : acc[kt][e];
                if (hi == 0) { sv[(c * 16 + r) * 32 + rr] = gm; si[(c * 16 + r) * 32 + rr] = widx; }
            }
        }
        float s0[16], s1[16]; int i0[16], i1[16];
#pragma unroll
        for (int i = 0; i < 16; ++i) { s0[i] = sv[i * 32 + rr]; s1[i] = sv[(16 + i) * 32 + rr]; i0[i] = si[i * 32 + rr]; i1[i] = si[(16 + i) * 32 + rr]; }
        float cv[16][16];
#pragma unroll
        for (int i = 0; i < 16; ++i)
#pragma unroll
            for (int j = 0; j < 16; ++j) if ((i + 1) * (j + 1) <= 16) cv[i][j] = s0[i] + s1[j];
#pragma unroll 1
        for (int r = 0; r < 16; ++r) {
            float gm = NEGB;
#pragma unroll
            for (int i = 0; i < 16; ++i)
#pragma unroll
                for (int j = 0; j < 16; ++j) if ((i + 1) * (j + 1) <= 16) gm = fmaxf(gm, cv[i][j]);
            int es = 0; bool found = false;
#pragma unroll
            for (int i = 0; i < 16; ++i)
#pragma unroll
                for (int j = 0; j < 16; ++j) if ((i + 1) * (j + 1) <= 16) { const bool hit = (cv[i][j] == gm) && !found; es = hit ? (i0[i] * 128 + i1[j]) : es; cv[i][j] = hit ? NEGB : cv[i][j]; found = found || hit; }
            if (hi == 0) { gv[r * 32 + rr] = gm; ge[r * 32 + rr] = es; }
        }
        float e16[16]; float den = 0.f; const float g0 = gv[rr];
#pragma unroll
        for (int r = 0; r < 16; ++r) { e16[r] = __expf(gv[r * 32 + rr] - g0); den += e16[r]; }
        const float inv = 1.0f / den; const size_t ob = (size_t)(t0 + rr) * 128 + h * 16 + hi * 8;
        float4 wa, wb; int4 ea, eb;
        wa.x = (hi ? e16[8] : e16[0]) * inv; wa.y = (hi ? e16[9] : e16[1]) * inv; wa.z = (hi ? e16[10] : e16[2]) * inv; wa.w = (hi ? e16[11] : e16[3]) * inv;
        wb.x = (hi ? e16[12] : e16[4]) * inv; wb.y = (hi ? e16[13] : e16[5]) * inv; wb.z = (hi ? e16[14] : e16[6]) * inv; wb.w = (hi ? e16[15] : e16[7]) * inv;
        ea.x = ge[(hi * 8 + 0) * 32 + rr]; ea.y = ge[(hi * 8 + 1) * 32 + rr]; ea.z = ge[(hi * 8 + 2) * 32 + rr]; ea.w = ge[(hi * 8 + 3) * 32 + rr];
        eb.x = ge[(hi * 8 + 4) * 32 + rr]; eb.y = ge[(hi * 8 + 5) * 32 + rr]; eb.z = ge[(hi * 8 + 6) * 32 + rr]; eb.w = ge[(hi * 8 + 7) * 32 + rr];
        *(float4*)(gw + ob) = wa; *(float4*)(gw + ob + 4) = wb; *(int4*)(eidx + ob) = ea; *(int4*)(eidx + ob + 4) = eb;
    }
}
__device__ __forceinline__ unsigned pk4fp8(float a, float b, float c, float d) { unsigned w = 0u; w = __builtin_amdgcn_cvt_pk_fp8_f32(a, b, w, false); w = __builtin_amdgcn_cvt_pk_fp8_f32(c, d, w, true); return w; }
__device__ __forceinline__ void ph_peer_cvt(const Params& p, int wv) {
    PH_IDS(); unsigned char* ws = p.ws; uint4* pu = (uint4*)(ws + OFF_PU); uint4* pv = (uint4*)(ws + OFF_PV);
    for (size_t i = gtid; i < (size_t)16384 * 1024 / 16; i += gn) {
        const float4* su = (const float4*)p.peer_u + 4 * i; const float4* sv = (const float4*)p.peer_v + 4 * i;
        const float4 a = su[0], b = su[1], c = su[2], d = su[3], e = sv[0], f = sv[1], g = sv[2], h = sv[3];
        pu[i] = make_uint4(pk4fp8(a.x * 32.f, a.y * 32.f, a.z * 32.f, a.w * 32.f), pk4fp8(b.x * 32.f, b.y * 32.f, b.z * 32.f, b.w * 32.f), pk4fp8(c.x * 32.f, c.y * 32.f, c.z * 32.f, c.w * 32.f), pk4fp8(d.x * 32.f, d.y * 32.f, d.z * 32.f, d.w * 32.f));
        pv[i] = make_uint4(pk4fp8(e.x, e.y, e.z, e.w), pk4fp8(f.x, f.y, f.z, f.w), pk4fp8(g.x, g.y, g.z, g.w), pk4fp8(h.x, h.y, h.z, h.w));
    }
}
__device__ __forceinline__ float bflo(unsigned w) { return __uint_as_float(w << 16); }
__device__ __forceinline__ float bfhi(unsigned w) { return __uint_as_float(w & 0xffff0000u); }
__device__ __forceinline__ float dot4f8(unsigned w, const float* x) { const f32x2v lo = __builtin_amdgcn_cvt_pk_f32_fp8(w, false), hi = __builtin_amdgcn_cvt_pk_f32_fp8(w, true); return (lo.x * x[0] + lo.y * x[1]) + (hi.x * x[2] + hi.y * x[3]); }
__device__ __forceinline__ float dot16f8(const uint4& w, const float* x) { return (dot4f8(w.x, x) + dot4f8(w.y, x + 4)) + (dot4f8(w.z, x + 8) + dot4f8(w.w, x + 12)); }
__device__ __forceinline__ void axpy4f8(unsigned w, float c, float* y) { const f32x2v lo = __builtin_amdgcn_cvt_pk_f32_fp8(w, false), hi = __builtin_amdgcn_cvt_pk_f32_fp8(w, true); y[0] += c * lo.x; y[1] += c * lo.y; y[2] += c * hi.x; y[3] += c * hi.y; }
__device__ __forceinline__ void axpy16f8(const uint4& w, float c, float* y) { axpy4f8(w.x, c, y); axpy4f8(w.y, c, y + 4); axpy4f8(w.z, c, y + 8); axpy4f8(w.w, c, y + 12); }
#define PG_LOAD(U, V, base) do { _Pragma("unroll") for (int k = 0; k < 8; ++k) { const int ei = (base) + k; const int ex = ei < 64 ? __builtin_amdgcn_readlane(e_lo, ei & 63) : __builtin_amdgcn_readlane(e_hi, ei & 63); \
        U[k] = *(const uint4*)(PU + (size_t)ex * 1024 + lane * 16); V[k] = *(const uint4*)(PV + (size_t)ex * 1024 + lane * 16); } } while (0)
#define PG_COMPUTE(U, V, base) do { float d[8]; _Pragma("unroll") for (int k = 0; k < 8; ++k) d[k] = dot16f8(U[k], xv); \
        const bool b5 = (lane & 32) != 0, b4 = (lane & 16) != 0, b3 = (lane & 8) != 0; float a4[4], a2[2], a1; \
        _Pragma("unroll") for (int k = 0; k < 4; ++k) { const float give = b5 ? d[k] : d[4 + k]; a4[k] = (b5 ? d[4 + k] : d[k]) + __shfl_xor(give, 32); } \
        _Pragma("unroll") for (int k = 0; k < 2; ++k) { const float give = b4 ? a4[k] : a4[2 + k]; a2[k] = (b4 ? a4[2 + k] : a4[k]) + __shfl_xor(give, 16); } \
        { const float give = b3 ? a2[0] : a2[1]; a1 = (b3 ? a2[1] : a2[0]) + __shfl_xor(give, 8); } \
        a1 += __shfl_xor(a1, 4); a1 += __shfl_xor(a1, 2); a1 += __shfl_xor(a1, 1); \
        const float ge = gelu_exact(a1 * (1.0f / 32.0f)); \
        _Pragma("unroll") for (int k = 0; k < 8; ++k) { const int ei = (base) + k; const float gx = __uint_as_float(ei < 64 ? __builtin_amdgcn_readlane(__float_as_uint(g_lo), ei & 63) : __builtin_amdgcn_readlane(__float_as_uint(g_hi), ei & 63)); \
            const float cf = gx * __uint_as_float(__builtin_amdgcn_readlane(__float_as_uint(ge), ((k >> 2) & 1) * 32 + ((k >> 1) & 1) * 16 + (k & 1) * 8)); axpy16f8(V[k], cf, y); } } while (0)
__device__ __forceinline__ void ph_peer_gather(const Params& p, int wv) {
    PH_IDS(); unsigned char* ws = p.ws;
    const bf16* h1b = (const bf16*)(ws + OFF_H1B); const int* eidx = (const int*)(ws + OFF_EIDX); const float* gw = (const float*)(ws + OFF_GW);
    const unsigned char* PU = ws + OFF_PU; const unsigned char* PV = ws + OFF_PV;
    for (int t = gwave; t < T; t += nwaves) {
        float xv[16], y[16];
        { const uint4 a = *(const uint4*)(h1b + (size_t)t * 1024 + lane * 16), b = *(const uint4*)(h1b + (size_t)t * 1024 + lane * 16 + 8);
          xv[0] = bflo(a.x); xv[1] = bfhi(a.x); xv[2] = bflo(a.y); xv[3] = bfhi(a.y); xv[4] = bflo(a.z); xv[5] = bfhi(a.z); xv[6] = bflo(a.w); xv[7] = bfhi(a.w);
          xv[8] = bflo(b.x); xv[9] = bfhi(b.x); xv[10] = bflo(b.y); xv[11] = bfhi(b.y); xv[12] = bflo(b.z); xv[13] = bfhi(b.z); xv[14] = bflo(b.w); xv[15] = bfhi(b.w); }
#pragma unroll
        for (int i = 0; i < 16; ++i) y[i] = 0.f;
        const int e_lo = eidx[(size_t)t * 128 + lane], e_hi = eidx[(size_t)t * 128 + 64 + lane]; const float g_lo = gw[(size_t)t * 128 + lane], g_hi = gw[(size_t)t * 128 + 64 + lane];
        uint4 uA[8], vA[8], uB[8], vB[8];
        PG_LOAD(uA, vA, 0);
#pragma unroll 1
        for (int e0 = 0; e0 < 128; e0 += 16) {
            PG_LOAD(uB, vB, e0 + 8);
            PG_COMPUTE(uA, vA, e0);
            if (e0 + 16 < 128) PG_LOAD(uA, vA, e0 + 16);
            PG_COMPUTE(uB, vB, e0 + 8);
        }
        float* row = p.out + (size_t)t * 1024 + lane * 16; float s = 0.f;
#pragma unroll
        for (int i = 0; i < 4; ++i) { const float4 a = *(const float4*)(row + 4 * i); y[4 * i] += DN_ALPHA * a.x; y[4 * i + 1] += DN_ALPHA * a.y; y[4 * i + 2] += DN_ALPHA * a.z; y[4 * i + 3] += DN_ALPHA * a.w; }
#pragma unroll
        for (int i = 0; i < 16; ++i) s += y[i];
        const float mu = wave_sum(s) * (1.0f / 1024.0f); float s2 = 0.f;
#pragma unroll
        for (int i = 0; i < 16; ++i) { y[i] -= mu; s2 += y[i] * y[i]; }
        const float rstd = rsqrtf(wave_sum(s2) * (1.0f / 1024.0f) + LN_EPS);
#pragma unroll
        for (int i = 0; i < 4; ++i) { const int c = lane * 16 + 4 * i; const float4 ga = *(const float4*)(p.ln2_g + c), ba = *(const float4*)(p.ln2_b + c);
            float4 o; o.x = y[4 * i] * rstd * ga.x + ba.x; o.y = y[4 * i + 1] * rstd * ga.y + ba.y; o.z = y[4 * i + 2] * rstd * ga.z + ba.z; o.w = y[4 * i + 3] * rstd * ga.w + ba.w;
            *(float4*)(row + 4 * i) = o; }
    }
}

#define LAS __attribute__((address_space(3)))
#define XB_TMO      128
#define XB_XCNT(j)  (256  + 64 * (j))
#define XB_XSUB(j)  (1280 + 64 * (j))
#define XB_XGEN(j)  (2304 + 64 * (j))
#define XB_TOP      3328
#define XB_TOPGEN   3392
#define XCD_BAR_WORDS 3456
#define XB_SPIN_CAP (1u << 18)

__device__ __forceinline__ unsigned xb_ld(unsigned* p)              { return __hip_atomic_load(p, __ATOMIC_RELAXED, __HIP_MEMORY_SCOPE_AGENT); }
__device__ __forceinline__ unsigned xb_add(unsigned* p, unsigned v) { return __hip_atomic_fetch_add(p, v, __ATOMIC_RELAXED, __HIP_MEMORY_SCOPE_AGENT); }
__device__ __forceinline__ unsigned xb_xcc_id() { return (unsigned)__builtin_amdgcn_s_getreg((3 << 11) | 20) & 0xFu; }
#define XB_SPIN(cond, bar) do { unsigned _sp = 0; while (cond) { __builtin_amdgcn_s_sleep(1); \
    if ((++_sp & 255u) == 0u) { if (xb_ld(&(bar)[XB_TMO])) break; if (_sp > XB_SPIN_CAP) { atomicAdd(&(bar)[XB_TMO], 1u); break; } } } } while (0)

struct XcdBarrier {
    unsigned* bar; unsigned x;
    volatile LAS unsigned* st;
};

__device__ __forceinline__ XcdBarrier xcd_barrier_post(unsigned* bar, volatile LAS unsigned* st, bool leader) {
    XcdBarrier b; b.bar = bar; b.x = xb_xcc_id(); b.st = st;
    if (leader) (void)xb_add(&bar[XB_XCNT(b.x)], 1u);
    return b;
}
__device__ __forceinline__ void xcd_barrier_complete(unsigned* bar, unsigned x, unsigned& nloc, unsigned& nx) {
    const unsigned G = gridDim.x * gridDim.y * gridDim.z;
    unsigned sum, cnt, mine, sp = 0u;
    for (;;) {
        sum = 0u; cnt = 0u; mine = 0u;
#pragma unroll
        for (unsigned j = 0; j < 16; ++j) { const unsigned c = xb_ld(&bar[XB_XCNT(j)]); sum += c; cnt += (c > 0u) ? 1u : 0u; mine = (j == x) ? c : mine; }
        if (sum == G) break;
        __builtin_amdgcn_s_sleep(1);
        if ((++sp & 255u) == 0u) { if (xb_ld(&bar[XB_TMO])) break; if (sp > XB_SPIN_CAP) { atomicAdd(&bar[XB_TMO], 1u); break; } }
    }
    nloc = mine > 0u ? mine : 1u; nx = cnt > 0u ? cnt : 1u;
}

__device__ __forceinline__ void xcd_barrier(const XcdBarrier& b, bool leader) {
    asm volatile("s_waitcnt vmcnt(0)" ::: "memory");
    __syncthreads();
    if (leader) {
        unsigned* bar = b.bar;
        __builtin_amdgcn_s_waitcnt(0);
        unsigned nloc = b.st[0], nx = b.st[1];
        if (nloc == 0u) { xcd_barrier_complete(bar, b.x, nloc, nx); b.st[0] = nloc; b.st[1] = nx; }
        const unsigned old = xb_add(&bar[XB_XSUB(b.x)], 1u);
        const unsigned gen = old / nloc;
        if (old + 1u == (gen + 1u) * nloc) {
            __builtin_amdgcn_fence(__ATOMIC_RELEASE, "agent");
            asm volatile("s_waitcnt vmcnt(0)" ::: "memory");
            const unsigned og = xb_add(&bar[XB_TOP], 1u);
            const unsigned tg = og / nx;
            if (og + 1u == (tg + 1u) * nx) xb_add(&bar[XB_TOPGEN], 1u);
            else XB_SPIN(xb_ld(&bar[XB_TOPGEN]) == tg, bar);
            __builtin_amdgcn_fence(__ATOMIC_ACQUIRE, "agent");
            xb_add(&bar[XB_XGEN(b.x)], 1u);
            asm volatile("s_waitcnt vmcnt(0)" ::: "memory");
        } else {
            XB_SPIN(xb_ld(&bar[XB_XGEN(b.x)]) == gen, bar);
            __builtin_amdgcn_fence(__ATOMIC_ACQUIRE, "agent");
            asm volatile("s_waitcnt vmcnt(0)" ::: "memory");
        }
    }
    __syncthreads();
}

#ifndef TIMING_BOUNDARY
#define TIMING_BOUNDARY -1
#endif
#define TPROBE(k) do { if (TIMING_BOUNDARY == (k) && blockIdx.x == 0 && wv == 0) { const unsigned long long t1_ = __builtin_amdgcn_s_memrealtime(); while (__builtin_amdgcn_s_memrealtime() - t1_ < t1_ - tstart_) __builtin_amdgcn_s_sleep(8); } } while (0)
__global__ void __launch_bounds__(NTHREADS) fwd_megakernel(Params p) {
    extern __shared__ __attribute__((aligned(16))) unsigned char lds[];
    cg::grid_group grid = cg::this_grid();
    const int nb = gridDim.x, bid = blockIdx.x;
    const int wv = __builtin_amdgcn_readfirstlane(threadIdx.x >> 6);
    unsigned char* ws = p.ws;
    const unsigned long long tstart_ = (TIMING_BOUNDARY >= 0) ? __builtin_amdgcn_s_memrealtime() : 0ull; (void)tstart_;
    PG8_LAS unsigned char* ldsp = (PG8_LAS unsigned char*)lds;
    const bool leader = (wv == 0) && (lane_id() == 0);
    volatile LAS unsigned* bst = (volatile LAS unsigned*)(ldsp + LDS_BYTES - 64);
    if (leader) { bst[0] = 0u; bst[1] = 0u; }
    __syncthreads();
    const XcdBarrier xbar = xcd_barrier_post((unsigned*)(ws + OFF_BAR), bst, leader);

    ph_prep(p, wv, lds);
    TPROBE(0);
    grid.sync();
    {
        pg8::Gemm g{(const bf16*)(ws + OFF_XB), (const bf16*)(ws + OFF_WIN), T, NPROJ_PAD, 1024, 1024, 0, 1 << 30, 0l};
        pg8::StaticOrder S; S.init(T, NPROJ_PAD, nb, bid);
        pg8::EpiInProjPg E{(bf16*)(ws + OFF_Z), (bf16*)(ws + OFF_XBC), (bf16*)(ws + OFF_Q), (bf16*)(ws + OFF_KVS), (bf16*)(ws + OFF_DTG)};
        pg8::gemm_phase<pg8::EpiInProjPg, pg8::StaticOrder, pg8::NoMid, true, true>(wv, ldsp, g, S, E, pg8::NoMid{});
    }
    TPROBE(1);
    xcd_barrier(xbar, leader);
    ph_tokprep(p, wv);
    TPROBE(2);
    xcd_barrier(xbar, leader);
    if (bid < 32) {
        const bool isv = bid >= 16;
        pg8::Gemm g{(const bf16*)(ws + OFF_KVS) + (isv ? 256 : 0), (const bf16*)(ws + (isv ? OFF_W1V : OFF_W1K)), 4096, 256, 2048, 0, 1, 1 << 30, 0l};
        pg8::StaticOrder S; S.init(4096, 256, 16, isv ? bid - 16 : bid);
        pg8::EpiBf16<1> E{(bf16*)(ws + OFF_HID + (isv ? 2 * MiB : 0)), 256, (const float*)(ws + (isv ? OFF_B1V : OFF_B1K)), 0, 0, 1.f};
        pg8::gemm_phase<pg8::EpiBf16<1>, pg8::StaticOrder, pg8::NoMid, true, true>(wv, ldsp, g, S, E, pg8::NoMid{});
    }
    ph_ssd_prep2(p, wv, lds);
    ph_vt_prep(p, wv);
    TPROBE(3);
    xcd_barrier(xbar, leader);
    {
        RowMajorBf16 ak{(const bf16*)(ws + OFF_HID), 256}, av{(const bf16*)(ws + OFF_HID + 2 * MiB), 256};
        RowMajorBf16 bk{(const bf16*)(ws + OFF_W2K), 256}, bv{(const bf16*)(ws + OFF_W2V), 256};
        EpiKc ek{(bf16*)(ws + OFF_KC), false}, ev{(bf16*)(ws + OFF_VCT), true};
        gemm_wave32(wv, 4096 / 32, 64 / 32, 256, ak, bk, ek);
        gemm_wave32(wv, 4096 / 32, 64 / 32, 256, av, bv, ev);
    }
    ph_ssd_states(p, wv);
    TPROBE(4);
    xcd_barrier(xbar, leader);
    ph_kc_rope(p, wv);
    ph_ssd_scan(p, wv);
    TPROBE(5);
    xcd_barrier(xbar, leader);
    ph_ssd_out(p, wv);
    ph_nsa(p, wv, lds);
    TPROBE(6);
    xcd_barrier(xbar, leader);
    {
        pg8::Gemm g{(const bf16*)(ws + OFF_Q), (const bf16*)(ws + OFF_WOUT), T, 1024, 2048, 1024, 0, 16, (long)OFF_Z - (long)OFF_Q - 16l * 128l};
        pg8::StaticOrder S; S.init(T, 1024, nb, bid);
        pg8::RmsFactors rf{(const float*)(ws + OFF_SSQ), (const float*)(ws + OFF_SSQ) + T, RMS_EPS};
        pg8::EpiOutProj E{p.x, p.out, DN_ALPHA, rf}; pg8::MidRmsScale MH{rf};
        pg8::gemm_phase<pg8::EpiOutProj, pg8::StaticOrder, pg8::MidRmsScale, true, true>(wv, ldsp, g, S, E, MH);
    }
    TPROBE(7);
    xcd_barrier(xbar, leader);
    ph_ln1(p, wv);
    ph_peer_cvt(p, wv);
    TPROBE(8);
    xcd_barrier(xbar, leader);
    {
        pg8::Gemm g{(const bf16*)(ws + OFF_H1B), (const bf16*)(ws + OFF_WQ), T, 2048, 1024, 1024, 0, 1 << 30, 0l};
        pg8::StaticOrder S; S.init(T, 2048, nb, bid);
        pg8::EpiBf16<0> E{(bf16*)(ws + OFF_QP), 2048, nullptr, 0, 0, 1.f};
        pg8::gemm_phase<pg8::EpiBf16<0>, pg8::StaticOrder, pg8::NoMid, true, true>(wv, ldsp, g, S, E, pg8::NoMid{});
    }
    TPROBE(9);
    xcd_barrier(xbar, leader);
    ph_peer_topk(p, wv, lds);
    TPROBE(10);
    xcd_barrier(xbar, leader);
    ph_peer_gather(p, wv);
}

extern "C" void kernel_launch(void* const* d_in, const int* in_sizes, int n_in, void* d_out, int out_size, void* d_ws, size_t ws_size, hipStream_t stream) {
    static int grid_blocks = 0;
    if (!grid_blocks) {
        int dev = 0, cus = 0, per_cu = 0;
        hipGetDevice(&dev);
        hipDeviceGetAttribute(&cus, hipDeviceAttributeMultiprocessorCount, dev);
        hipFuncSetAttribute((const void*)fwd_megakernel, hipFuncAttributeMaxDynamicSharedMemorySize, LDS_BYTES);
        hipOccupancyMaxActiveBlocksPerMultiprocessor(&per_cu, fwd_megakernel, NTHREADS, LDS_BYTES);
        if (per_cu < 1) per_cu = 1;
        if (per_cu > 1) per_cu = 1;
        grid_blocks = cus * per_cu;
        if (ws_size < 244 * MiB) fprintf(stderr, "kernel_launch: workspace too small: %zu\n", ws_size);
    }
    Params p{};
    const float** pp = (const float**)&p;
    for (int i = 0; i < 24; ++i) pp[i] = (const float*)d_in[i];
    p.out = (float*)d_out; p.ws = (unsigned char*)d_ws;
    (void)hipMemsetAsync((unsigned char*)d_ws + OFF_BAR, 0, BAR_BYTES, stream);
    void* args[] = {&p};
    hipError_t e = hipLaunchCooperativeKernel((void*)fwd_megakernel, dim3(grid_blocks), dim3(NTHREADS), args, LDS_BYTES, stream);
    if (e != hipSuccess) fprintf(stderr, "cooperative launch failed: %s (grid %d)\n", hipGetErrorString(e), grid_blocks);
}
```

```cpp
#include <hip/hip_runtime.h>
#include <hip/hip_cooperative_groups.h>
#include <cstdio>
#include <cstdint>
namespace cg = cooperative_groups;

typedef unsigned short bf16;
typedef short bf16x8 __attribute__((ext_vector_type(8)));
typedef float f32x4 __attribute__((ext_vector_type(4)));
typedef unsigned long long u64;

constexpr int T = 16384, L = 4096, NBATCH = 4, D = 1024;
constexpr int NPROJ = 5184, NPROJ_PAD = 5376;
constexpr int NTHREADS = 512, NWAVES = 8;
constexpr float LN_EPS = 1e-5f, RMS_EPS = 1e-5f;
constexpr float DN_ALPHA = 1.189207115002721f;
constexpr float NEG_INF = -1e30f, BIG = 1e30f;

constexpr size_t MiB = 1u << 20;
constexpr size_t OFF_SSQ = 0, OFF_BAR = 512 * 1024, BAR_BYTES = 16384;
constexpr size_t OFF_WOUT = 1 * MiB, OFF_WQ = 5 * MiB, OFF_W1K = 9 * MiB, OFF_W1V = 10 * MiB;
constexpr size_t OFF_W2K = 11 * MiB, OFF_W2V = 11 * MiB + 65536, OFF_B1K = 11 * MiB + 131072, OFF_B1V = 11 * MiB + 131072 + 4096;
constexpr size_t OFF_KEYS = 12 * MiB, OFF_ROPE = 13 * MiB, OFF_DT = 14 * MiB, OFF_ACS = 15 * MiB, OFF_GATE = 16 * MiB, OFF_MASK = 19 * MiB;
constexpr size_t OFF_HID = 20 * MiB, OFF_KC = 24 * MiB, OFF_VC = 24 * MiB + 524288;
constexpr size_t OFF_Z = 26 * MiB, OFF_Q = 58 * MiB, OFF_KVS = 90 * MiB, OFF_XBC = 138 * MiB, OFF_XSBC = 186 * MiB, OFF_BT = 234 * MiB, OFF_DTG = 242 * MiB;
constexpr size_t OFF_VST = 138 * MiB, OFF_VWT = 146 * MiB, OFF_VCT = 154 * MiB;
constexpr size_t OFF_XB = 186 * MiB, OFF_WIN = 218 * MiB;
constexpr size_t OFF_H1B = 90 * MiB, OFF_QP = 138 * MiB, OFF_EIDX = 202 * MiB, OFF_GW = 210 * MiB;
constexpr size_t OFF_PU = 26 * MiB, OFF_PV = 58 * MiB;
constexpr int LDS_BYTES = 147456;

struct Params {
    const float *x, *w_in, *conv_w, *conv_b, *dt_bias, *a_log, *d_skip, *ssd_norm_w;
    const float *cmp_pos_k, *cmp_w1_k, *cmp_w2_k, *cmp_pos_v, *cmp_w1_v, *cmp_w2_v;
    const float *attn_norm_w, *w_out, *ln1_g, *ln1_b, *peer_wq, *peer_keys, *peer_u, *peer_v, *ln2_g, *ln2_b;
    float* out; unsigned char* ws;
};

__device__ __forceinline__ float bf2f(bf16 v) { return __uint_as_float((unsigned)v << 16); }
__device__ __forceinline__ bf16 f2bf(float f) { unsigned u = __float_as_uint(f); return (bf16)((u + 0x7fffu + ((u >> 16) & 1u)) >> 16); }
__device__ __forceinline__ int lane_id() { int l = (int)__builtin_amdgcn_mbcnt_hi(~0u, __builtin_amdgcn_mbcnt_lo(~0u, 0u)); asm volatile("" : "+v"(l)); return l; }
#define PH_IDS() const int lane = lane_id(); const int tid = (wv << 6) | lane; const int bid = blockIdx.x, nb = gridDim.x; const int gtid = bid * NTHREADS + tid, gn = nb * NTHREADS; const int gwave = bid * NWAVES + wv, nwaves = nb * NWAVES; (void)gtid; (void)gn; (void)gwave; (void)nwaves;
typedef float f32x2v __attribute__((ext_vector_type(2)));
typedef __bf16 bf16x2v __attribute__((ext_vector_type(2)));
__device__ __forceinline__ unsigned pk2bf(float lo, float hi) { f32x2v v = {lo, hi}; bf16x2v b = __builtin_convertvector(v, bf16x2v); return __builtin_bit_cast(unsigned, b); }
__device__ __forceinline__ float wave_sum(float v) {
#pragma unroll
    for (int o = 1; o < 64; o <<= 1) v += __shfl_xor(v, o);
    return v;
}
__device__ __forceinline__ float wave_max(float v) {
#pragma unroll
    for (int o = 1; o < 64; o <<= 1) v = fmaxf(v, __shfl_xor(v, o));
    return v;
}
__device__ __forceinline__ float gelu_exact(float v) { return 0.5f * v * (1.0f + erff(v * 0.7071067811865476f)); }
__device__ __forceinline__ float sigmoidf(float v) { return 1.0f / (1.0f + __expf(-v)); }

template <class AP, class BP, class EP>
__device__ __forceinline__ void gemm_wave32(int wv, int Mt, int Nt, int K, const AP& ap, const BP& bp, const EP& ep) {
    PH_IDS(); const int r = lane & 15, q = lane >> 4;
    for (int tile = gwave; tile < Mt * Nt; tile += nwaves) {
        const int tm = tile / Nt, tn = tile % Nt, row0 = tm * 32, col0 = tn * 32;
        f32x4 acc[2][2];
#pragma unroll
        for (int i = 0; i < 2; ++i)
#pragma unroll
            for (int j = 0; j < 2; ++j) acc[i][j] = (f32x4){0.f, 0.f, 0.f, 0.f};
        for (int k0 = 0; k0 < K; k0 += 32) {
            const bf16x8 a0 = ap(row0 + r, k0 + 8 * q), a1 = ap(row0 + 16 + r, k0 + 8 * q);
            const bf16x8 b0 = bp(col0 + r, k0 + 8 * q), b1 = bp(col0 + 16 + r, k0 + 8 * q);
            acc[0][0] = __builtin_amdgcn_mfma_f32_16x16x32_bf16(a0, b0, acc[0][0], 0, 0, 0);
            acc[0][1] = __builtin_amdgcn_mfma_f32_16x16x32_bf16(a0, b1, acc[0][1], 0, 0, 0);
            acc[1][0] = __builtin_amdgcn_mfma_f32_16x16x32_bf16(a1, b0, acc[1][0], 0, 0, 0);
            acc[1][1] = __builtin_amdgcn_mfma_f32_16x16x32_bf16(a1, b1, acc[1][1], 0, 0, 0);
        }
#pragma unroll
        for (int i = 0; i < 2; ++i)
#pragma unroll
            for (int j = 0; j < 2; ++j)
#pragma unroll
                for (int e = 0; e < 4; ++e) ep(row0 + 16 * i + 4 * q + e, col0 + 16 * j + r, acc[i][j][e]);
    }
}
struct RowMajorBf16 { const bf16* p; int ld; __device__ __forceinline__ bf16x8 operator()(int row, int k) const { return *(const bf16x8*)(p + (size_t)row * ld + k); } };

namespace pg8 {
#define PG8_LAS __attribute__((address_space(3)))
typedef unsigned short bf16_t;
typedef short bf16x8 __attribute__((ext_vector_type(8)));
typedef float f32x4 __attribute__((ext_vector_type(4)));
typedef unsigned u32x4 __attribute__((ext_vector_type(4)));
constexpr int BM = 256, BK = 64, HALF = 128, HTB = HALF * BK * 2  , STAGE_BYTES = 8 * HTB, NXCD = 8, WGM = 8;

__host__ __device__ __forceinline__ int lds_byte(int r, int c) { const int st = (r >> 4) * 2 + (c >> 5), rr = r & 15, cc = c & 31, ob = rr * 64 + cc * 2; return st * 1024 + (ob ^ (((ob >> 9) & 1) << 5)); }
__host__ __device__ __forceinline__ void stage_rc(int b, int& R, int& C) { const int st = b / 1024, sb = b % 1024, swz = sb ^ (((sb >> 9) & 1) << 5); R = (st >> 1) * 16 + swz / 64; C = (st & 1) * 32 + (swz % 64) / 2; }
__host__ __device__ __forceinline__ int perm32(int rho) { const int n = rho >> 4, i = rho & 15; return 8 * (i >> 2) + 4 * n + (i & 3); }

struct Unit { int pm, pn; };
struct Gemm { const bf16_t* A; const bf16_t* Bt; int M, N, K; int lda; int amode; int ksplit; long kdelta; };

struct StaticOrder {
    int nM, nN, nwg, G, c;
    __host__ __device__ void init(int M, int N, int G_, int c_) { nM = M / BM; nN = N / BM; nwg = nM * nN; G = G_; c = c_; }
    __host__ __device__ bool next(int i, Unit& u) const {
        const long L = (long)i * G + c; if (L >= nwg) return false;
        int wgid = (int)L; { const int q = nwg / NXCD, r = nwg % NXCD, xcd = wgid % NXCD, off = wgid / NXCD; wgid = (xcd < r ? xcd * (q + 1) : r * (q + 1) + (xcd - r) * q) + off; }
        const int nig = WGM * nN, gid = wgid / nig, fm = gid * WGM, gsz = (nM - fm) < WGM ? (nM - fm) : WGM;
        u.pm = fm + ((wgid % nig) % gsz); u.pn = (wgid % nig) / gsz; return true;
    }
    __device__ __forceinline__ void a_ready(const Unit&) const {}
    __device__ __forceinline__ void done(const Unit&) const {}
};


__device__ __forceinline__ unsigned cvt_pk_bf16(float lo, float hi) { unsigned r; asm volatile("v_cvt_pk_bf16_f32 %0, %1, %2" : "=v"(r) : "v"(lo), "v"(hi)); return r; }
typedef float f32x2 __attribute__((ext_vector_type(2)));
__device__ __forceinline__ f32x2 gelu_pk(f32x2 v) {
    const f32x2 av = __builtin_elementwise_abs(v), d = av * 0.2316418882f + 1.0f;
    f32x2 t; t.x = __builtin_amdgcn_rcpf(d.x); t.y = __builtin_amdgcn_rcpf(d.y);
    f32x2 q = t * 0.5307027145f + (-0.7265760135f); q = q * t + 0.7107068705f; q = q * t + (-0.142248368f); q = q * t + 0.127414796f; q = q * t;
    const f32x2 s = (v * v) * (-0.72134752044f);
    f32x2 e; e.x = __builtin_amdgcn_exp2f(s.x); e.y = __builtin_amdgcn_exp2f(s.y);
    const f32x2 m = v * (q * e), r = v - m;
    f32x2 o; o.x = v.x < 0.f ? m.x : r.x; o.y = v.y < 0.f ? m.y : r.y; return o;
}

template <int ACT  > struct EpiBf16 {
    static constexpr bool PERM = true, AFTER_DRAIN = false; static_assert(ACT == 0 || ACT == 1, "EpiBf16: ACT is 0 (none) or 1 (gelu_pk)");
    bf16_t* O; int ldc; const float* bias; int split_cols; size_t split_stride; float scale0;
    __device__ __forceinline__ void operator()(const f32x4 (&acc)[2][2][4][2], const Unit& u, int wr, int wc, int fr, int fq) const {
        const int row0 = u.pm * BM + wr * 64 + fr; int colt = u.pn * BM; bf16_t* base = O;
        float sc = 1.f; if (split_cols) { const int t = colt / split_cols; base += (size_t)t * split_stride; colt -= t * split_cols; if (t == 0) sc = scale0; }
        const int col0 = colt + wc * 32 + 8 * fq, bcol0 = u.pn * BM + wc * 32 + 8 * fq;
        f32x4 bv[2][2];
#pragma unroll
        for (int bj = 0; bj < 2; ++bj)
#pragma unroll
            for (int n = 0; n < 2; ++n) bv[bj][n] = bias ? *(const f32x4*)(bias + bcol0 + bj * HALF + 4 * n) : (f32x4){0.f, 0.f, 0.f, 0.f};
#pragma unroll
        for (int ai = 0; ai < 2; ++ai)
#pragma unroll
            for (int m = 0; m < 4; ++m) { bf16_t* rowp = base + (size_t)(row0 + ai * HALF + m * 16) * ldc + col0;
#pragma unroll
                for (int bj = 0; bj < 2; ++bj) { f32x4 v0 = acc[ai][bj][m][0] + bv[bj][0], v1 = acc[ai][bj][m][1] + bv[bj][1];
                    if (ACT == 1) { f32x2 a = gelu_pk((f32x2){v0[0], v0[1]}), b = gelu_pk((f32x2){v0[2], v0[3]}), c = gelu_pk((f32x2){v1[0], v1[1]}), d = gelu_pk((f32x2){v1[2], v1[3]});
                        v0 = (f32x4){a.x, a.y, b.x, b.y}; v1 = (f32x4){c.x, c.y, d.x, d.y}; }
                    v0 = v0 * sc; v1 = v1 * sc; u32x4 w; w.x = cvt_pk_bf16(v0[0], v0[1]); w.y = cvt_pk_bf16(v0[2], v0[3]); w.z = cvt_pk_bf16(v1[0], v1[1]); w.w = cvt_pk_bf16(v1[2], v1[3]);
                    *(u32x4*)(rowp + bj * HALF) = w; } }
    }
};

struct EpiInProjPg { static constexpr bool PERM = true, AFTER_DRAIN = false;
    bf16_t *z, *xbc, *q, *kvs, *dtg;
    __device__ __forceinline__ void operator()(const f32x4 (&acc)[2][2][4][2], const Unit& u, int wr, int wc, int fr, int fq) const {
        bf16_t* base; int ldc, colt; const int pn = u.pn;
        if (pn < 4) { base = z; ldc = 1024; colt = pn * 256; } else if (pn < 10) { base = xbc; ldc = 1536; colt = (pn - 4) * 256; }
        else if (pn < 14) { base = q; ldc = 1024; colt = (pn - 10) * 256; } else if (pn < 20) { base = kvs; ldc = 1536; colt = (pn - 14) * 256; }
        else { base = dtg; ldc = 64; colt = 0; }
        const int row0 = u.pm * BM + wr * 64 + fr, col0 = colt + wc * 32 + 8 * fq;
#pragma unroll
        for (int ai = 0; ai < 2; ++ai)
#pragma unroll
            for (int m = 0; m < 4; ++m) { bf16_t* rowp = base + (size_t)(row0 + ai * HALF + m * 16) * ldc + col0;
#pragma unroll
                for (int bj = 0; bj < 2; ++bj) { const f32x4 v0 = acc[ai][bj][m][0], v1 = acc[ai][bj][m][1];
                    u32x4 w; w.x = cvt_pk_bf16(v0[0], v0[1]); w.y = cvt_pk_bf16(v0[2], v0[3]); w.z = cvt_pk_bf16(v1[0], v1[1]); w.w = cvt_pk_bf16(v1[2], v1[3]);
                    if (pn < 20 || (bj == 0 && wc < 2)) *(u32x4*)(rowp + bj * HALF) = w; } }
    }
};
struct RmsFactors { const float* ssqp; const float* ssq2p; float eps;
    __device__ __forceinline__ void get(int row, float& ra, float& r0, float& r1) const {
        const f32x4 a = *(const f32x4*)(ssqp + 4 * row); const f32x4 b0 = *(const f32x4*)(ssq2p + 16 * row), b1 = *(const f32x4*)(ssq2p + 16 * row + 4), b2 = *(const f32x4*)(ssq2p + 16 * row + 8), b3 = *(const f32x4*)(ssq2p + 16 * row + 12);
        ra = rsqrtf(((a[0] + a[1]) + (a[2] + a[3])) * (1.0f / 1024.0f) + eps);
        r0 = rsqrtf((((b0[0] + b0[1]) + (b0[2] + b0[3])) + ((b1[0] + b1[1]) + (b1[2] + b1[3]))) * (1.0f / 512.0f) + eps);
        r1 = rsqrtf((((b2[0] + b2[1]) + (b2[2] + b2[3])) + ((b3[0] + b3[1]) + (b3[2] + b3[3]))) * (1.0f / 512.0f) + eps); } };
struct EpiOutProj { static constexpr bool PERM = false, AFTER_DRAIN = false;
    const float* x; float* out; float alpha; RmsFactors rf;
    __device__ __forceinline__ void operator()(const f32x4 (&acc)[2][2][4][2], const Unit& u, int wr, int wc, int fr, int fq) const {
        const int col0 = u.pn * BM + wc * 32 + 4 * fq;
#pragma unroll
        for (int ai = 0; ai < 2; ++ai)
#pragma unroll
            for (int m = 0; m < 4; ++m) { const int row = u.pm * BM + ai * HALF + wr * 64 + m * 16 + fr; const size_t off = (size_t)row * 1024 + col0;
                float ra, r0, r1; rf.get(row, ra, r0, r1);
#pragma unroll
                for (int bj = 0; bj < 2; ++bj)
#pragma unroll
                    for (int n = 0; n < 2; ++n) { const size_t o = off + bj * HALF + n * 16; const f32x4 xv = *(const f32x4*)(x + o); *(f32x4*)(out + o) = xv * alpha + acc[ai][bj][m][n] * r1; } }
    }
};
struct MidRmsScale { static constexpr bool ENABLED = true; RmsFactors rf;
    __device__ __forceinline__ void operator()(f32x4 (&acc)[2][2][4][2], const Unit& u, int t, int wr, int wc, int fr, int fq) const {
        if (t != 16 && t != 24) return;
        int rowb = u.pm * BM + wr * 64 + fr; asm volatile("" : "+v"(rowb));
#pragma unroll
        for (int ai = 0; ai < 2; ++ai)
#pragma unroll
            for (int m = 0; m < 4; ++m) { float ra, r0, r1; rf.get(rowb + ai * HALF + m * 16, ra, r0, r1);
                const float sc = (t == 16) ? ra / r0 : r0 / r1;
#pragma unroll
                for (int bj = 0; bj < 2; ++bj)
#pragma unroll
                    for (int n = 0; n < 2; ++n) acc[ai][bj][m][n] = acc[ai][bj][m][n] * sc; }
    }
};
struct NoMid { static constexpr bool ENABLED = false; template <class ACC> __device__ __forceinline__ void operator()(ACC&, const Unit&, int, int, int, int, int) const {} };
template <class Epi, class Sched, class Mid, bool ALIGN_EPI = false, bool SP2 = false>
__device__ __forceinline__ void gemm_phase(int wv, PG8_LAS unsigned char* lds, const Gemm g, const Sched& S, const Epi& E, const Mid& MH) {
    int lane_ = (int)__builtin_amdgcn_mbcnt_hi(~0u, __builtin_amdgcn_mbcnt_lo(~0u, 0u)); asm volatile("" : "+v"(lane_));
    const int lane = lane_, wid = wv, tid = (wv << 6) | lane, wr = wid >> 2, wc = wid & 3, fr = lane & 15, fq = lane >> 4;
    const int K = g.K, nt = K / BK;
    unsigned voffA[2], voffB[2];
#pragma unroll
    for (int i = 0; i < 2; ++i) { int R, C; stage_rc(tid * 16 + i * 8192, R, C); const int Rb = Epi::PERM ? ((R & ~31) + perm32(R & 31)) : R;
        voffA[i] = g.amode == 0 ? (unsigned)(R * g.lda + C) * 2u : (unsigned)((R >> 2) * 49152 + (R & 3) * 128 + C * 2); voffB[i] = (unsigned)(Rb * K + C) * 2u; }
    const size_t kstep = (size_t)(BK * 2);
    const size_t hstep = (size_t)HALF * K * 2;
    const size_t tstep = 2 * hstep;
    const size_t kstepA = g.amode == 0 ? (size_t)(BK * 2) : (size_t)3072;
    const size_t hstepA = g.amode == 0 ? (size_t)HALF * g.lda * 2 : (size_t)32 * 49152;
    const size_t tstepA = 2 * hstepA;
#define PG8_AK(base, t) ((base) + (size_t)(t) * kstepA + (((t) >= g.ksplit) ? g.kdelta : 0l))
    const unsigned ldsw = (unsigned)wid * 1024u;
    const int aoff = lds_byte(wr * 64 + fr, fq * 8), boff = lds_byte(wc * 32 + fr, fq * 8);
#define PG8_SA(b, h) (((b) * 2 + (h)) * HTB)
#define PG8_SB(b, h) ((4 + (b) * 2 + (h)) * HTB)
#define PG8_STAGE(bufoff, gbase, voff) do { _Pragma("unroll") for (int _i = 0; _i < 2; ++_i) \
        __builtin_amdgcn_global_load_lds((const unsigned*)((const char*)(gbase) + (voff)[_i]), (PG8_LAS unsigned*)(lds + (bufoff) + ldsw + _i * 8192), 16, 0, 0); } while (0)
#define PG8_LDA(dst, b, h) do { _Pragma("unroll") for (int m = 0; m < 4; ++m) _Pragma("unroll") for (int k = 0; k < 2; ++k) dst[m][k] = *(const PG8_LAS bf16x8*)(lds + PG8_SA(b, h) + aoff + m * 2048 + k * 1024); } while (0)
#define PG8_LDB(dst, b, h) do { _Pragma("unroll") for (int n = 0; n < 2; ++n) _Pragma("unroll") for (int k = 0; k < 2; ++k) dst[n][k] = *(const PG8_LAS bf16x8*)(lds + PG8_SB(b, h) + boff + n * 2048 + k * 1024); } while (0)
#define PG8_MMA(ai, bj, At, Bt) do { __builtin_amdgcn_s_setprio(1); _Pragma("unroll") for (int m = 0; m < 4; ++m) _Pragma("unroll") for (int n = 0; n < 2; ++n) _Pragma("unroll") for (int k = 0; k < 2; ++k) \
        acc[ai][bj][m][n] = __builtin_amdgcn_mfma_f32_16x16x32_bf16(Bt[n][k], At[m][k], acc[ai][bj][m][n], 0, 0, 0); __builtin_amdgcn_s_setprio(0); } while (0)
#define PG8_WAIT_V(n) asm volatile("s_waitcnt vmcnt(" #n ")" ::: "memory")
#define PG8_WAIT_L(n) asm volatile("s_waitcnt lgkmcnt(" #n ")" ::: "memory")
#define PG8_BAR __builtin_amdgcn_s_barrier()
#define PG8_SCHED __builtin_amdgcn_sched_barrier(0)
    Unit cur, nxt; int ui = 0;
    if (!S.next(0, cur)) return;
    f32x4 acc[2][2][4][2];
#pragma unroll
    for (int a = 0; a < 2; ++a)
#pragma unroll
        for (int b = 0; b < 2; ++b)
#pragma unroll
            for (int m = 0; m < 4; ++m)
#pragma unroll
                for (int n = 0; n < 2; ++n) acc[a][b][m][n] = (f32x4){0.f, 0.f, 0.f, 0.f};
    bf16x8 At[4][2], B0[2][2], B1[2][2];
    const char* cA = (const char*)g.A + (size_t)cur.pm * tstepA; const char* cB = (const char*)g.Bt + (size_t)cur.pn * tstep;
    S.a_ready(cur);
    if constexpr (SP2) {
        PG8_STAGE(PG8_SB(0, 0), cB, voffB); PG8_STAGE(PG8_SB(0, 1), cB + hstep, voffB); PG8_STAGE(PG8_SA(0, 0), cA, voffA); PG8_STAGE(PG8_SA(0, 1), cA + hstepA, voffA);
        if (wr == 1) PG8_BAR;
        PG8_WAIT_V(2); PG8_BAR;
        PG8_STAGE(PG8_SB(1, 0), cB + kstep, voffB); PG8_STAGE(PG8_SA(1, 0), PG8_AK(cA, 1), voffA); PG8_STAGE(PG8_SB(1, 1), cB + hstep + kstep, voffB);
        PG8_WAIT_V(6); PG8_BAR;
    } else {
        PG8_STAGE(PG8_SB(0, 0), cB, voffB); PG8_STAGE(PG8_SA(0, 0), cA, voffA); PG8_STAGE(PG8_SB(0, 1), cB + hstep, voffB); PG8_STAGE(PG8_SA(0, 1), cA + hstepA, voffA);
        if (wr == 1) PG8_BAR;
        PG8_WAIT_V(4); PG8_BAR;
        PG8_STAGE(PG8_SB(1, 0), cB + kstep, voffB); PG8_STAGE(PG8_SA(1, 0), PG8_AK(cA, 1), voffA); PG8_STAGE(PG8_SB(1, 1), cB + hstep + kstep, voffB);
        PG8_WAIT_V(6); PG8_BAR;
    }
    for (;;) {
        const bool has_next = S.next(ui + 1, nxt);
        const char* nA = has_next ? (const char*)g.A + (size_t)nxt.pm * tstepA : cA; const char* nB = has_next ? (const char*)g.Bt + (size_t)nxt.pn * tstep : cB;
        for (int t = 0; t < nt; t += 2) {
            const bool last = (t == nt - 2);
            if (Mid::ENABLED) MH(acc, cur, t, wr, wc, fr, fq);
            const char* a1 = PG8_AK(cA, t + 1);
            const char* a2 = last ? nA : PG8_AK(cA, t + 2); const char* b2 = last ? nB : cB + (size_t)(t + 2) * kstep;
            const char* a3 = a2 + kstepA; const char* b3 = b2 + kstep;
            if (last && has_next) S.a_ready(nxt);
            if constexpr (SP2) {
            PG8_LDB(B0, 0, 0); PG8_LDB(B1, 0, 1); PG8_SCHED; PG8_LDA(At, 0, 0); PG8_STAGE(PG8_SA(1, 1), a1 + hstepA, voffA);
            PG8_WAIT_V(8); PG8_WAIT_L(0); PG8_BAR; PG8_MMA(0, 0, At, B0); PG8_MMA(0, 1, At, B1); PG8_BAR; PG8_SCHED;
            PG8_LDA(At, 0, 1); PG8_STAGE(PG8_SB(0, 0), b2, voffB); PG8_STAGE(PG8_SB(0, 1), b2 + hstep, voffB); PG8_STAGE(PG8_SA(0, 0), a2, voffA);
            PG8_WAIT_V(8); PG8_WAIT_L(0); PG8_BAR; PG8_MMA(1, 0, At, B0); PG8_MMA(1, 1, At, B1); PG8_BAR; PG8_SCHED;
            PG8_LDB(B0, 1, 0); PG8_LDB(B1, 1, 1); PG8_SCHED; PG8_LDA(At, 1, 0); PG8_STAGE(PG8_SA(0, 1), a2 + hstepA, voffA);
            PG8_WAIT_V(8); PG8_WAIT_L(0); PG8_BAR; PG8_MMA(0, 0, At, B0); PG8_MMA(0, 1, At, B1); PG8_BAR; PG8_SCHED;
            PG8_LDA(At, 1, 1); PG8_STAGE(PG8_SB(1, 0), b3, voffB); PG8_STAGE(PG8_SB(1, 1), b3 + hstep, voffB); PG8_STAGE(PG8_SA(1, 0), a3, voffA);
            PG8_WAIT_V(8); PG8_WAIT_L(0); PG8_BAR; PG8_MMA(1, 0, At, B0); PG8_MMA(1, 1, At, B1); PG8_BAR; PG8_SCHED;
            } else {
            PG8_LDB(B0, 0, 0); PG8_SCHED; PG8_LDA(At, 0, 0); PG8_STAGE(PG8_SA(1, 1), a1 + hstepA, voffA);
            PG8_WAIT_L(8); PG8_BAR; PG8_WAIT_L(0); PG8_MMA(0, 0, At, B0); PG8_BAR; PG8_SCHED;
            PG8_LDB(B1, 0, 1); PG8_STAGE(PG8_SB(0, 0), b2, voffB);
            PG8_BAR; PG8_WAIT_L(0); PG8_MMA(0, 1, At, B1); PG8_BAR;
            PG8_LDA(At, 0, 1); PG8_STAGE(PG8_SA(0, 0), a2, voffA);
            PG8_BAR; PG8_WAIT_L(0); PG8_MMA(1, 0, At, B0); PG8_BAR; PG8_SCHED;
            PG8_STAGE(PG8_SB(0, 1), b2 + hstep, voffB);
            PG8_WAIT_V(6); PG8_BAR; PG8_MMA(1, 1, At, B1); PG8_BAR;
            PG8_LDB(B0, 1, 0); PG8_SCHED; PG8_LDA(At, 1, 0); PG8_STAGE(PG8_SA(0, 1), a2 + hstepA, voffA);
            PG8_WAIT_L(8); PG8_BAR; PG8_WAIT_L(0); PG8_MMA(0, 0, At, B0); PG8_BAR; PG8_SCHED;
            PG8_LDB(B1, 1, 1); PG8_STAGE(PG8_SB(1, 0), b3, voffB);
            PG8_BAR; PG8_WAIT_L(0); PG8_MMA(0, 1, At, B1); PG8_BAR;
            PG8_LDA(At, 1, 1); PG8_STAGE(PG8_SA(1, 0), a3, voffA);
            PG8_BAR; PG8_WAIT_L(0); PG8_MMA(1, 0, At, B0); PG8_BAR; PG8_SCHED;
            PG8_STAGE(PG8_SB(1, 1), b3 + hstep, voffB);
            PG8_WAIT_V(6); PG8_BAR; PG8_MMA(1, 1, At, B1); PG8_BAR;
            }
        }
        if constexpr (ALIGN_EPI) { if (wr == 0) PG8_BAR; }
        if constexpr (!Epi::AFTER_DRAIN) { E(acc, cur, wr, wc, fr, fq); S.done(cur); }
        if (!has_next) break;
#pragma unroll
        for (int a = 0; a < 2; ++a)
#pragma unroll
            for (int b = 0; b < 2; ++b)
#pragma unroll
                for (int m = 0; m < 4; ++m)
#pragma unroll
                    for (int n = 0; n < 2; ++n) acc[a][b][m][n] = (f32x4){0.f, 0.f, 0.f, 0.f};
        cur = nxt; cA = nA; cB = nB; ++ui;
        if constexpr (ALIGN_EPI) { if (wr == 1) PG8_BAR; }
    }
    PG8_WAIT_V(0);
    if constexpr (!ALIGN_EPI) { if (wr == 0) PG8_BAR; }
    PG8_BAR;
    if constexpr (Epi::AFTER_DRAIN) { E.fused(acc, cur, wr, wc, fr, fq, lds, wid, lane); S.done(cur); }
#undef PG8_AK
#undef PG8_SA
#undef PG8_SB
#undef PG8_STAGE
#undef PG8_LDA
#undef PG8_LDB
#undef PG8_MMA
#undef PG8_WAIT_V
#undef PG8_WAIT_L
#undef PG8_BAR
#undef PG8_SCHED
}
}

__device__ __forceinline__ int winmap(int n) { return n < 2560 ? n : (n < 5120 ? n + 16 : (n < 5136 ? 2560 + (n - 5120) : n)); }
template <class Map>
__device__ __forceinline__ void transpose_item(const float* W, int ldw, bf16* WT, int K, int item, int nblk, float* scr, int lane, const Map& mp) {
    const int kb = item / nblk, nbk = item % nblk, k0 = 64 * kb, n0 = 32 * nbk;
    const int col = mp.scol(n0 + (lane & 31));
#pragma unroll 8
    for (int i = 0; i < 32; ++i) { const int kk = 2 * i + (lane >> 5); scr[kk * 33 + (lane & 31)] = col >= 0 ? W[(size_t)mp.srow(k0 + kk) * ldw + col] * mp.scale(k0 + kk) : 0.f; }
    const int c = lane & 7;
#pragma unroll
    for (int j = 0; j < 4; ++j) { const int n = (lane >> 3) + 8 * j; const float* s = scr + (8 * c) * 33 + n;
        *(uint4*)(WT + (size_t)(n0 + n) * K + k0 + 8 * c) = make_uint4(pk2bf(s[0], s[33]), pk2bf(s[66], s[99]), pk2bf(s[132], s[165]), pk2bf(s[198], s[231])); }
}
struct MapPlain { __device__ __forceinline__ int srow(int k) const { return k; } __device__ __forceinline__ int scol(int n) const { return n; } __device__ __forceinline__ float scale(int) const { return 1.f; } };
struct MapWin { __device__ __forceinline__ int srow(int k) const { return k; } __device__ __forceinline__ int scol(int n) const { return n < NPROJ ? winmap(n) : -1; } __device__ __forceinline__ float scale(int) const { return 1.f; } };
struct MapWout { const float* an; const float* sn;
    __device__ __forceinline__ int srow(int k) const { return (k + 1024) & 2047; } __device__ __forceinline__ int scol(int n) const { return n; } __device__ __forceinline__ float scale(int k) const { return k < 1024 ? an[k] : sn[k - 1024]; } };
__device__ __forceinline__ void ph_prep(const Params& p, int wv, unsigned char* lds) {
    PH_IDS(); unsigned char* ws = p.ws;
    bf16* xb = (bf16*)(ws + OFF_XB);
    for (size_t i = gtid; i < (size_t)T * D / 8; i += gn) { const float4 v = ((const float4*)p.x)[2 * i], w = ((const float4*)p.x)[2 * i + 1]; ((uint4*)xb)[i] = make_uint4(pk2bf(v.x, v.y), pk2bf(v.z, v.w), pk2bf(w.x, w.y), pk2bf(w.z, w.w)); }
    {
        float* scr = (float*)(lds + wv * 8448);
        constexpr int I_WIN = 16 * 168, I_WOUT = 32 * 32, I_WQ = 16 * 64, I_W1 = 32 * 8, I_W2 = 4 * 2;
        constexpr int NIT = I_WIN + I_WOUT + I_WQ + 2 * I_W1 + 2 * I_W2;
        for (int it = gwave; it < NIT; it += nwaves) {
            int r = it;
            if (r < I_WIN) { transpose_item(p.w_in, NPROJ, (bf16*)(ws + OFF_WIN), 1024, r, 168, scr, lane, MapWin{}); continue; } r -= I_WIN;
            if (r < I_WOUT) { transpose_item(p.w_out, 1024, (bf16*)(ws + OFF_WOUT), 2048, r, 32, scr, lane, MapWout{p.attn_norm_w, p.ssd_norm_w}); continue; } r -= I_WOUT;
            if (r < I_WQ) { transpose_item(p.peer_wq, 2048, (bf16*)(ws + OFF_WQ), 1024, r, 64, scr, lane, MapPlain{}); continue; } r -= I_WQ;
            if (r < I_W1) { transpose_item(p.cmp_w1_k, 256, (bf16*)(ws + OFF_W1K), 2048, r, 8, scr, lane, MapPlain{}); continue; } r -= I_W1;
            if (r < I_W1) { transpose_item(p.cmp_w1_v, 256, (bf16*)(ws + OFF_W1V), 2048, r, 8, scr, lane, MapPlain{}); continue; } r -= I_W1;
            if (r < I_W2) { transpose_item(p.cmp_w2_k, 64, (bf16*)(ws + OFF_W2K), 256, r, 2, scr, lane, MapPlain{}); continue; } r -= I_W2;
            transpose_item(p.cmp_w2_v, 64, (bf16*)(ws + OFF_W2V), 256, r, 2, scr, lane, MapPlain{});
        }
    }
    bf16* keys = (bf16*)(ws + OFF_KEYS);
    for (int i = gtid; i < 8 * 2 * 128 * 128; i += gn) keys[i] = f2bf(p.peer_keys[i]);
    float* rc = (float*)(ws + OFF_ROPE); float* rs = rc + 4096 * 32;
    for (int i = gtid; i < 4096 * 32; i += gn) {
        const int pos = i >> 5, j = i & 31;
        const float inv = powf(10000.0f, -(float)(2 * j) / 64.0f); const float angf = (float)pos * inv;
        double xr = (double)angf * 0.15915494309189535; xr -= rint(xr); const double rr = xr * 6.283185307179586, r2 = rr * rr;
        double s = 0.0, c = 0.0, ts = rr, tc = 1.0;
        for (int k = 0; k < 14; ++k) { s += ts; c += tc; tc = -tc * r2 / (double)((2 * k + 1) * (2 * k + 2)); ts = -ts * r2 / (double)((2 * k + 2) * (2 * k + 3)); }
        rc[i] = (float)c; rs[i] = (float)s;
    }
    float* b1k = (float*)(ws + OFF_B1K); float* b1v = (float*)(ws + OFF_B1V);
    for (int o = gwave; o < 512; o += nwaves) {
        const int j = o & 255; const float* pos = o < 256 ? p.cmp_pos_k : p.cmp_pos_v; const float* w1 = o < 256 ? p.cmp_w1_k : p.cmp_w1_v;
        float s = 0.f; for (int k = lane; k < 2048; k += 64) s += pos[k] * w1[(size_t)k * 256 + j];
        s = wave_sum(s); if (lane == 0) (o < 256 ? b1k : b1v)[j] = s;
    }
}

struct EpiInProj {
    bf16 *z, *xbc, *q, *kvs, *dtg;
    __device__ __forceinline__ void operator()(int row, int c, float v) const {
        const bf16 b = f2bf(v);
        if (c < 1024) z[(size_t)row * 1024 + c] = b;
        else if (c < 2560) xbc[(size_t)row * 1536 + (c - 1024)] = b;
        else if (c < 3584) q[(size_t)row * 1024 + (c - 2560)] = b;
        else if (c < 5120) kvs[(size_t)row * 1536 + (c - 3584)] = b;
        else if (c < 5184) dtg[(size_t)row * 64 + (c - 5120)] = b;
    }
};

__device__ __forceinline__ void unpack8(const uint4& w, float* f) { f[0] = __uint_as_float(w.x << 16); f[1] = __uint_as_float(w.x & 0xffff0000u); f[2] = __uint_as_float(w.y << 16); f[3] = __uint_as_float(w.y & 0xffff0000u);
    f[4] = __uint_as_float(w.z << 16); f[5] = __uint_as_float(w.z & 0xffff0000u); f[6] = __uint_as_float(w.w << 16); f[7] = __uint_as_float(w.w & 0xffff0000u); }
__device__ __forceinline__ uint4 pack8(const float* f) { return make_uint4(pk2bf(f[0], f[1]), pk2bf(f[2], f[3]), pk2bf(f[4], f[5]), pk2bf(f[6], f[7])); }
__device__ __forceinline__ void ph_tokprep(const Params& p, int wv) {
    PH_IDS(); unsigned char* ws = p.ws;
    const bf16* xbc = (const bf16*)(ws + OFF_XBC); bf16* xsbc = (bf16*)(ws + OFF_XSBC);
    for (int it = gtid; it < (T / 16) * 192; it += gn) {
        const int cg = it % 192, tg = it / 192, ch = cg * 8, t0 = tg * 16, l0 = t0 & (L - 1);
        float w[4][8], bias[8];
#pragma unroll
        for (int j = 0; j < 4; ++j) { const float4 a = *(const float4*)(p.conv_w + j * 1536 + ch), b2 = *(const float4*)(p.conv_w + j * 1536 + ch + 4); w[j][0] = a.x; w[j][1] = a.y; w[j][2] = a.z; w[j][3] = a.w; w[j][4] = b2.x; w[j][5] = b2.y; w[j][6] = b2.z; w[j][7] = b2.w; }
        { const float4 a = *(const float4*)(p.conv_b + ch), b2 = *(const float4*)(p.conv_b + ch + 4); bias[0] = a.x; bias[1] = a.y; bias[2] = a.z; bias[3] = a.w; bias[4] = b2.x; bias[5] = b2.y; bias[6] = b2.z; bias[7] = b2.w; }
        float x0[8], x1[8], x2[8], x3[8];
        { uint4 h0 = make_uint4(0u, 0u, 0u, 0u), h1 = h0, h2 = h0;
          if (l0 != 0) { h0 = *(const uint4*)(xbc + (size_t)(t0 - 3) * 1536 + ch); h1 = *(const uint4*)(xbc + (size_t)(t0 - 2) * 1536 + ch); h2 = *(const uint4*)(xbc + (size_t)(t0 - 1) * 1536 + ch); }
          unpack8(h0, x0); unpack8(h1, x1); unpack8(h2, x2); }
#pragma unroll
        for (int u = 0; u < 16; ++u) {
            unpack8(*(const uint4*)(xbc + (size_t)(t0 + u) * 1536 + ch), x3);
            float y[8];
#pragma unroll
            for (int i = 0; i < 8; ++i) { const float v = bias[i] + w[0][i] * x0[i] + w[1][i] * x1[i] + w[2][i] * x2[i] + w[3][i] * x3[i]; y[i] = v * sigmoidf(v); x0[i] = x1[i]; x1[i] = x2[i]; x2[i] = x3[i]; }
            *(uint4*)(xsbc + (size_t)(t0 + u) * 1536 + ch) = pack8(y);
        }
    }
    const bf16* dtg = (const bf16*)(ws + OFF_DTG); float* dt = (float*)(ws + OFF_DT); float* gate = (float*)(ws + OFF_GATE);
    for (int i = gtid; i < T * 64; i += gn) {
        const int t = i >> 6, c = i & 63; const float v = bf2f(dtg[i]);
        if (c < 16) { const float xx = v + p.dt_bias[c]; dt[t * 16 + c] = xx > 20.f ? xx : log1pf(__expf(xx)); }
        else gate[t * 48 + (c - 16)] = sigmoidf(v);
    }
    const float* rc = (const float*)(ws + OFF_ROPE); const float* rs = rc + 4096 * 32;
    bf16* q = (bf16*)(ws + OFF_Q); bf16* kvs = (bf16*)(ws + OFF_KVS);
    for (int it = gtid; it < T * 24 * 4; it += gn) {
        const int j0 = (it & 3) * 8, hh = (it >> 2) % 24, t = it / 96, l = t & (L - 1);
        bf16* pp; float sc;
        if (hh < 16) { pp = q + (size_t)t * 1024 + hh * 64 + j0; sc = 0.125f * 1.4426950408889634f; } else if (hh < 20) { pp = kvs + (size_t)t * 1536 + 512 + (hh - 16) * 64 + j0; sc = 1.f; } else { pp = kvs + (size_t)t * 1536 + 1024 + (hh - 20) * 64 + j0; sc = 1.f; }
        float x1[8], x2[8], c[8], s[8], o1[8], o2[8];
        unpack8(*(const uint4*)pp, x1); unpack8(*(const uint4*)(pp + 32), x2);
        { const float4 a = *(const float4*)(rc + l * 32 + j0), b2 = *(const float4*)(rc + l * 32 + j0 + 4), d = *(const float4*)(rs + l * 32 + j0), e = *(const float4*)(rs + l * 32 + j0 + 4);
          c[0] = a.x; c[1] = a.y; c[2] = a.z; c[3] = a.w; c[4] = b2.x; c[5] = b2.y; c[6] = b2.z; c[7] = b2.w; s[0] = d.x; s[1] = d.y; s[2] = d.z; s[3] = d.w; s[4] = e.x; s[5] = e.y; s[6] = e.z; s[7] = e.w; }
#pragma unroll
        for (int i = 0; i < 8; ++i) { o1[i] = (x1[i] * c[i] - x2[i] * s[i]) * sc; o2[i] = (x1[i] * s[i] + x2[i] * c[i]) * sc; }
        *(uint4*)pp = pack8(o1); *(uint4*)(pp + 32) = pack8(o2);
    }
}

__device__ __forceinline__ void ph_ssd_prep2(const Params& p, int wv, unsigned char* lds) {
    PH_IDS(); unsigned char* ws = p.ws;
    const bf16* xsbc = (const bf16*)(ws + OFF_XSBC); const float* dt = (const float*)(ws + OFF_DT);
    bf16* XdT = (bf16*)p.out; bf16* BT = (bf16*)(ws + OFF_BT); float* acsT = (float*)(ws + OFF_ACS);
    float* sdt = (float*)lds; float* swave = sdt + 128;
    const int bide = nb > 64 ? bid - 32 : bid, nbe = nb > 64 ? nb - 32 : nb; if (bide < 0) return;
    for (int unit = bide; unit < 2048 + 256; unit += nbe) {
        __syncthreads();
        if (unit < 2048) {
            const int h = unit & 15, bc = unit >> 4; const size_t t0 = (size_t)bc * 128;
            const float A = -__expf(p.a_log[h]);
            if (tid < 128) { const float dv = dt[(t0 + tid) * 16 + h]; sdt[tid] = dv; float a = dv * A;
#pragma unroll
                for (int o = 1; o < 64; o <<= 1) { const float v = __shfl_up(a, o); if (lane >= o) a += v; }
                if (lane == 63) swave[tid >> 6] = a;
                sdt[128 + 8 + tid] = a; }
            __syncthreads();
            if (tid < 128) { float a = sdt[128 + 8 + tid]; if (tid >= 64) a += swave[0]; acsT[(size_t)unit * 128 + tid] = a; }
            const int pp = tid & 63, lg = tid >> 6; const bf16* src = xsbc + (t0 + lg * 16) * 1536 + h * 64 + pp;
            unsigned w[8];
#pragma unroll
            for (int i = 0; i < 8; ++i) { const float v0 = bf2f(src[(size_t)(2 * i) * 1536]) * sdt[lg * 16 + 2 * i], v1 = bf2f(src[(size_t)(2 * i + 1) * 1536]) * sdt[lg * 16 + 2 * i + 1]; w[i] = (unsigned)f2bf(v0) | ((unsigned)f2bf(v1) << 16); }
            uint4* dst = (uint4*)(XdT + (size_t)unit * 8192 + pp * 128 + lg * 16);
            dst[0] = make_uint4(w[0], w[1], w[2], w[3]); dst[1] = make_uint4(w[4], w[5], w[6], w[7]);
        } else {
            const int u2 = unit - 2048, g = u2 & 1, bc = u2 >> 1; const size_t t0 = (size_t)bc * 128;
            const int n = tid & 127, lg = tid >> 7; const bf16* src = xsbc + (t0 + lg * 32) * 1536 + 1024 + g * 128 + n;
            uint4* dst = (uint4*)(BT + (size_t)u2 * 16384 + n * 128 + lg * 32);
#pragma unroll
            for (int k = 0; k < 4; ++k) { unsigned w[4];
#pragma unroll
                for (int i = 0; i < 4; ++i) w[i] = (unsigned)src[(size_t)(8 * k + 2 * i) * 1536] | ((unsigned)src[(size_t)(8 * k + 2 * i + 1) * 1536] << 16);
                dst[k] = make_uint4(w[0], w[1], w[2], w[3]); }
        }
    }
}
__device__ __forceinline__ bf16x8 scale_frag(bf16x8 a, const float* s) {
    bf16x8 o;
#pragma unroll
    for (int j = 0; j < 8; ++j) o[j] = (short)f2bf(bf2f((bf16)a[j]) * s[j]);
    return o;
}
__device__ __forceinline__ void ph_ssd_states(const Params& p, int wv) {
    PH_IDS(); unsigned char* ws = p.ws; const int r = lane & 15, q = lane >> 4;
    const bf16* XdT = (const bf16*)p.out; bf16* S = (bf16*)((unsigned char*)p.out + 32 * MiB); const bf16* BT = (const bf16*)(ws + OFF_BT); const float* acsT = (const float*)(ws + OFF_ACS);
    for (int task = gwave; task < 8192; task += nwaves) {
        const int pt = task & 3, unit = task >> 2, h = unit & 15, bc = unit >> 4, g = h >> 3;
        const float* ac = acsT + (size_t)unit * 128; const float alast = ac[127];
        const bf16* xrow = XdT + (size_t)unit * 8192 + (pt * 16 + r) * 128; const bf16* bt = BT + (size_t)(bc * 2 + g) * 16384 + r * 128;
        f32x4 acc[8];
#pragma unroll
        for (int i = 0; i < 8; ++i) acc[i] = (f32x4){0.f, 0.f, 0.f, 0.f};
#pragma unroll
        for (int ks = 0; ks < 4; ++ks) {
            const int l0 = ks * 32 + 8 * q; float dec[8];
#pragma unroll
            for (int j = 0; j < 8; ++j) dec[j] = __expf(alast - ac[l0 + j]);
            const bf16x8 af = scale_frag(*(const bf16x8*)(xrow + l0), dec);
#pragma unroll
            for (int nt = 0; nt < 8; ++nt) acc[nt] = __builtin_amdgcn_mfma_f32_16x16x32_bf16(af, *(const bf16x8*)(bt + (size_t)nt * 2048 + l0), acc[nt], 0, 0, 0);
        }
        bf16* so = S + (size_t)unit * 8192 + (pt * 16 + 4 * q) * 128 + r;
#pragma unroll
        for (int nt = 0; nt < 8; ++nt)
#pragma unroll
            for (int e = 0; e < 4; ++e) so[e * 128 + nt * 16] = f2bf(acc[nt][e]);
    }
}
__device__ __forceinline__ void ph_ssd_scan(const Params& p, int wv) {
    PH_IDS();
    unsigned* S = (unsigned*)((unsigned char*)p.out + 32 * MiB); const float* acsT = (const float*)(p.ws + OFF_ACS);
    for (int e = gtid; e < NBATCH * 16 * 4096; e += gn) {
        const int pn = e & 4095, h = (e >> 12) & 15, b = e >> 16; float r0 = 0.f, r1 = 0.f;
        for (int c = 0; c < 32; c += 4) {
            unsigned v[4]; float d[4];
#pragma unroll
            for (int u = 0; u < 4; ++u) { const int unit = (b * 32 + c + u) * 16 + h; v[u] = S[(size_t)unit * 4096 + pn]; d[u] = __expf(acsT[(size_t)unit * 128 + 127]); }
#pragma unroll
            for (int u = 0; u < 4; ++u) { const int unit = (b * 32 + c + u) * 16 + h; S[(size_t)unit * 4096 + pn] = (unsigned)f2bf(r0) | ((unsigned)f2bf(r1) << 16);
                r0 = r0 * d[u] + bf2f((bf16)(v[u] & 0xffffu)); r1 = r1 * d[u] + bf2f((bf16)(v[u] >> 16)); }
        }
    }
}
__device__ __forceinline__ void ph_ssd_out(const Params& p, int wv) {
    PH_IDS(); unsigned char* ws = p.ws; const int r = lane & 15, q = lane >> 4;
    const bf16* XdT = (const bf16*)p.out; const bf16* S = (const bf16*)((unsigned char*)p.out + 32 * MiB); const bf16* xsbc = (const bf16*)(ws + OFF_XSBC);
    const float* acsT = (const float*)(ws + OFF_ACS); bf16* z = (bf16*)(ws + OFF_Z); float* ssq2p = (float*)(ws + OFF_HID);
    for (int task = gwave; task < 16384; task += nwaves) {
        const int lt = 7 - (task & 7), unit = task >> 3, h = unit & 15, bc = unit >> 4, g = h >> 3; const size_t t0 = (size_t)bc * 128;
        const float* ac = acsT + (size_t)unit * 128; const float Dh = p.d_skip[h];
        bf16x8 Cf[4];
#pragma unroll
        for (int ks = 0; ks < 4; ++ks) Cf[ks] = *(const bf16x8*)(xsbc + (t0 + lt * 16 + r) * 1536 + 1280 + g * 128 + ks * 32 + 8 * q);
        const float acl = ac[lt * 16 + r]; const int lrow = lt * 16 + r;
        f32x4 acc[4];
#pragma unroll
        for (int i = 0; i < 4; ++i) acc[i] = (f32x4){0.f, 0.f, 0.f, 0.f};
        const bf16* xd = XdT + (size_t)unit * 8192 + r * 128;
        for (int kk = 0; kk <= (lt >> 1); ++kk) {
            bf16x8 mf;
#pragma unroll
            for (int half = 0; half < 2; ++half) {
                const int st = 2 * kk + half; f32x4 cb = (f32x4){0.f, 0.f, 0.f, 0.f};
                if (st <= lt) {
                    const bf16* brow = xsbc + (t0 + st * 16 + r) * 1536 + 1024 + g * 128 + 8 * q;
#pragma unroll
                    for (int ks = 0; ks < 4; ++ks) cb = __builtin_amdgcn_mfma_f32_16x16x32_bf16(*(const bf16x8*)(brow + ks * 32), Cf[ks], cb, 0, 0, 0);
                    const f32x4 as4 = *(const f32x4*)(ac + st * 16 + 4 * q);
#pragma unroll
                    for (int e = 0; e < 4; ++e) { const int s = st * 16 + 4 * q + e; cb[e] = (lrow >= s) ? cb[e] * __expf(acl - as4[e]) : 0.f; }
                }
#pragma unroll
                for (int e = 0; e < 4; ++e) mf[half * 4 + e] = (short)f2bf(cb[e]);
            }
#pragma unroll
            for (int pt = 0; pt < 4; ++pt) {
                const uint2 lo = *(const uint2*)(xd + (size_t)pt * 2048 + 32 * kk + 4 * q), hi = *(const uint2*)(xd + (size_t)pt * 2048 + 32 * kk + 16 + 4 * q);
                union { uint4 u; bf16x8 v; } xf; xf.u = make_uint4(lo.x, lo.y, hi.x, hi.y);
                acc[pt] = __builtin_amdgcn_mfma_f32_16x16x32_bf16(mf, xf.v, acc[pt], 0, 0, 0);
            }
        }
        f32x4 acc2[4];
#pragma unroll
        for (int i = 0; i < 4; ++i) acc2[i] = (f32x4){0.f, 0.f, 0.f, 0.f};
        const bf16* sin = S + (size_t)unit * 8192 + r * 128 + 8 * q;
#pragma unroll
        for (int ks = 0; ks < 4; ++ks)
#pragma unroll
            for (int pt = 0; pt < 4; ++pt) acc2[pt] = __builtin_amdgcn_mfma_f32_16x16x32_bf16(Cf[ks], *(const bf16x8*)(sin + (size_t)pt * 2048 + ks * 32), acc2[pt], 0, 0, 0);
#pragma unroll
        for (int e = 0; e < 4; ++e) {
            const int l = lt * 16 + 4 * q + e; const size_t t = t0 + l; const float od = __expf(ac[l]); float ss = 0.f;
#pragma unroll
            for (int pt = 0; pt < 4; ++pt) { const int col = h * 64 + pt * 16 + r; const float xv = bf2f(xsbc[t * 1536 + col]);
                const float y = acc[pt][e] + od * acc2[pt][e] + Dh * xv; const float zz = bf2f(z[t * 1024 + col]); const float v = y * (zz * sigmoidf(zz));
                z[t * 1024 + col] = f2bf(v); ss += v * v; }
            ss += __shfl_xor(ss, 1); ss += __shfl_xor(ss, 2); ss += __shfl_xor(ss, 4); ss += __shfl_xor(ss, 8);
            if (r == 0) ssq2p[t * 16 + h] = ss;
        }
    }
}

struct ACmp {
    const bf16* kvs; int coff;
    __device__ __forceinline__ bf16x8 operator()(int m, int k) const {
        const int hk = m & 3, n = (m >> 2) & 255, b = m >> 10, l = k >> 6, d = k & 63;
        if (n == 255) return (bf16x8){0, 0, 0, 0, 0, 0, 0, 0};
        return *(const bf16x8*)(kvs + (size_t)(b * L + 16 * n + l) * 1536 + coff + hk * 64 + d);
    }
};
struct EpiHid { bf16* hid; const float* bias; __device__ __forceinline__ void operator()(int row, int c, float v) const { hid[(size_t)row * 256 + c] = f2bf(gelu_exact(v + bias[c])); } };
struct EpiKc {
    bf16* dst; bool tr; __device__ __forceinline__ void operator()(int m, int c, float v) const { const int hk = m & 3, n = (m >> 2) & 255, b = m >> 10; const bf16 o = (n == 255) ? (bf16)0 : f2bf(v);
        if (tr) dst[((size_t)(b * 4 + hk) * 64 + c) * 256 + n] = o; else dst[((size_t)(b * 4 + hk) * 256 + n) * 64 + c] = o; } };
__device__ __forceinline__ void ph_kc_rope(const Params& p, int wv) {
    PH_IDS(); unsigned char* ws = p.ws; bf16* kc = (bf16*)(ws + OFF_KC); const float* rc = (const float*)(ws + OFF_ROPE); const float* rs = rc + 4096 * 32;
    for (int i = gtid; i < 16 * 256 * 32; i += gn) {
        const int j = i & 31, n = (i >> 5) & 255, bh = i >> 13; const int pos = 16 * n + 31; if (n == 255) continue;
        const float c = rc[pos * 32 + j], s = rs[pos * 32 + j];
        bf16* pp = kc + ((size_t)bh * 256 + n) * 64 + j; const float x1 = bf2f(pp[0]), x2 = bf2f(pp[32]);
        pp[0] = f2bf(x1 * c - x2 * s); pp[32] = f2bf(x1 * s + x2 * c);
    }
}


__device__ __forceinline__ void ph_vt_prep(const Params& p, int wv) {
    PH_IDS(); unsigned char* ws = p.ws; const bf16* kvs = (const bf16*)(ws + OFF_KVS);
    const int bide = nb > 64 ? bid - 32 : bid, nbe = nb > 64 ? nb - 32 : nb; if (bide < 0) return;
    for (int unit = bide; unit < 2 * 16 * 64; unit += nbe) {
        const int br = unit & 1, tl = (unit >> 1) & 63, bh = unit >> 7, b = bh >> 2, hk = bh & 3;
        const int d = tid & 63, grp = tid >> 6; const int l0 = tl * 64 + grp * 8;
        const bf16* src = kvs + ((size_t)b * L + l0) * 1536 + (br ? 1280 : 768) + hk * 64 + d;
        unsigned w[4];
#pragma unroll
        for (int i = 0; i < 4; ++i) w[i] = (unsigned)src[(size_t)(2 * i) * 1536] | ((unsigned)src[(size_t)(2 * i + 1) * 1536] << 16);
        bf16* dst = (bf16*)(ws + (br ? OFF_VWT : OFF_VST)) + ((size_t)bh * 64 + d) * L + l0;
        *(uint4*)dst = make_uint4(w[0], w[1], w[2], w[3]);
    }
}

typedef float f32x16 __attribute__((ext_vector_type(16)));
__device__ __forceinline__ int crow(int r, int hi) { return (r & 3) + 8 * (r >> 2) + 4 * hi; }
constexpr int NSA_KROW = 144, NSA_VROW = 136, NSA_KBUF = 64 * NSA_KROW, NSA_VBUF = 64 * NSA_VROW;
constexpr int NSA_OFF_STASH = 73728;
constexpr int NSA_OFF_K = 0, NSA_OFF_V = 2 * NSA_KBUF, NSA_OFF_IMPA = NSA_OFF_V + 2 * NSA_VBUF, NSA_IMPS = 65, NSA_OFF_IMPB = NSA_OFF_IMPA + 64 * NSA_IMPS * 4, NSA_OFF_SEL = NSA_OFF_IMPB + 64 * NSA_IMPS * 4;
struct NsaSrc { const bf16* K; size_t kstride; const bf16* VT; size_t ldv; };
__device__ __forceinline__ void nsa_gload(const NsaSrc& s, int k0, int tid, uint4& kr, uint4& vr) {
    const int row = tid >> 3, ch = tid & 7;
    kr = *(const uint4*)(s.K + (size_t)(k0 + row) * s.kstride + ch * 8);
    vr = *(const uint4*)(s.VT + (size_t)row * s.ldv + k0 + ch * 8);
}
__device__ __forceinline__ void nsa_lstore(unsigned char* kb, unsigned char* vb, int tid, const uint4& kr, const uint4& vr) {
    const int row = tid >> 3, ch = tid & 7;
    *(uint4*)(kb + row * NSA_KROW + ch * 16) = kr;
    uint2* vp = (uint2*)(vb + row * NSA_VROW + ch * 16); vp[0] = make_uint2(vr.x, vr.y); vp[1] = make_uint2(vr.z, vr.w);
}
__device__ __forceinline__ void nsa_qk(const unsigned char* kb, const bf16x8 (&qf)[4], int rr, int hi, f32x16& p0, f32x16& p1) {
#pragma unroll
    for (int i = 0; i < 16; ++i) { p0[i] = 0.f; p1[i] = 0.f; }
#pragma unroll
    for (int ds = 0; ds < 4; ++ds) {
        const bf16x8 a0 = *(const bf16x8*)(kb + rr * NSA_KROW + ds * 32 + hi * 16), a1 = *(const bf16x8*)(kb + (rr + 32) * NSA_KROW + ds * 32 + hi * 16);
        p0 = __builtin_amdgcn_mfma_f32_32x32x16_bf16(a0, qf[ds], p0, 0, 0, 0); p1 = __builtin_amdgcn_mfma_f32_32x32x16_bf16(a1, qf[ds], p1, 0, 0, 0);
    }
}
__device__ __forceinline__ void nsa_pv(const unsigned char* vb, int rr, int hi, const f32x16& p0, const f32x16& p1, f32x16 (&O)[2]) {
#pragma unroll
    for (int s = 0; s < 4; ++s) {
        const int eb = 8 * (s & 1), kbase = 32 * (s >> 1) + 16 * (s & 1);
        union { uint4 u; bf16x8 v; } pf;
        if (s < 2) pf.u = make_uint4(pk2bf(p0[eb], p0[eb + 1]), pk2bf(p0[eb + 2], p0[eb + 3]), pk2bf(p0[eb + 4], p0[eb + 5]), pk2bf(p0[eb + 6], p0[eb + 7]));
        else       pf.u = make_uint4(pk2bf(p1[eb], p1[eb + 1]), pk2bf(p1[eb + 2], p1[eb + 3]), pk2bf(p1[eb + 4], p1[eb + 5]), pk2bf(p1[eb + 6], p1[eb + 7]));
#pragma unroll
        for (int dsub = 0; dsub < 2; ++dsub) {
            const unsigned char* vp = vb + (dsub * 32 + rr) * NSA_VROW + (kbase + 4 * hi) * 2;
            const uint2 lo = *(const uint2*)vp, hh = *(const uint2*)(vp + 16);
            union { uint4 u; bf16x8 v; } vf; vf.u = make_uint4(lo.x, lo.y, hh.x, hh.y);
            O[dsub] = __builtin_amdgcn_mfma_f32_32x32x16_bf16(vf.v, pf.v, O[dsub], 0, 0, 0);
        }
    }
}
template <int MODE>
__device__ __forceinline__ void nsa_branch(unsigned char* lds, const NsaSrc& src, int jt0, int jt1, int tid, int rr, int hi, const bf16x8 (&qf)[4], int lpos, int qi, int tokblk,
                                           u64 selm, u64 wsel, float& m, float& lsum, float inv_l, f32x16 (&O)[2]) {
    if (jt0 >= jt1) return;
    asm volatile("" : "+v"(tid), "+v"(rr));
    float* impA = (float*)(lds + NSA_OFF_IMPA); float* impB = (float*)(lds + NSA_OFF_IMPB);
    uint4 kr, vr;
    nsa_gload(src, jt0 * 64, tid, kr, vr);
    nsa_lstore(lds + NSA_OFF_K, lds + NSA_OFF_V, tid, kr, vr);
    __syncthreads();
    for (int jt = jt0; jt < jt1; ++jt) {
        const int cur = (jt - jt0) & 1; const bool more = (jt + 1 < jt1);
        if (more) nsa_gload(src, (jt + 1) * 64, tid, kr, vr);
        const unsigned char* kb = lds + NSA_OFF_K + cur * NSA_KBUF; const unsigned char* vb = lds + NSA_OFF_V + cur * NSA_VBUF;
        const bool active = (MODE != 2) || ((wsel >> jt) & 1ull);
        if (active) {
            f32x16 p0, p1; nsa_qk(kb, qf, rr, hi, p0, p1);
            const int k0 = jt * 64;
            const bool tile_on = (MODE != 2) || ((selm >> jt) & 1ull);
            bool full;
            if (MODE <= 1) full = (16 * (k0 + 63) + 31 <= qi * 64); else if (MODE == 2) full = (jt < qi); else full = (jt > qi - 8) && (jt < qi);
            float mx = NEG_INF;
            if (full) {
#pragma unroll
                for (int e = 0; e < 16; ++e) mx = fmaxf(mx, fmaxf(p0[e], p1[e]));
                if (MODE == 2 && !tile_on) mx = NEG_INF;
            } else {
                const int lim = (MODE <= 1) ? (lpos - 31 - 16 * k0 - 64 * hi) : (lpos - k0 - 4 * hi);
#pragma unroll
                for (int e = 0; e < 16; ++e) {
                    const int ca = (e & 3) + 8 * (e >> 2), cb = ca + 32; bool oa, ob;
                    if (MODE <= 1) { oa = (16 * ca <= lim); ob = (16 * cb <= lim); }
                    else if (MODE == 2) { oa = (ca <= lim); ob = (cb <= lim); }
                    else { oa = (ca <= lim) && (ca > lim - 512); ob = (cb <= lim) && (cb > lim - 512); }
                    p0[e] = oa ? p0[e] : NEG_INF; p1[e] = ob ? p1[e] : NEG_INF; mx = fmaxf(mx, fmaxf(p0[e], p1[e]));
                }
            }
            if (MODE != 1) {
                mx = fmaxf(mx, __shfl_xor(mx, 32));
                const float mnew = fmaxf(m, mx);
                if (__any((mnew - m) > 6.0f)) {
                    const float alpha = __builtin_amdgcn_exp2f(m - mnew); m = mnew; lsum *= alpha;
                    if (MODE != 0) {
#pragma unroll
                        for (int e = 0; e < 16; ++e) { O[0][e] *= alpha; O[1][e] *= alpha; }
                    }
                }
                const float meff = (MODE == 2 && full && !tile_on) ? BIG : ((m > 0.5f * NEG_INF) ? m : BIG);
                float rs = 0.f;
#pragma unroll
                for (int e = 0; e < 16; ++e) { p0[e] = __builtin_amdgcn_exp2f(p0[e] - meff); p1[e] = __builtin_amdgcn_exp2f(p1[e] - meff); rs += p0[e] + p1[e]; }
                lsum += rs;
                if (MODE != 0) nsa_pv(vb, rr, hi, p0, p1, O);
            } else {
#pragma unroll
                for (int e = 0; e < 16; ++e) { p0[e] = __builtin_amdgcn_exp2f(p0[e] - m) * inv_l; p1[e] = __builtin_amdgcn_exp2f(p1[e] - m) * inv_l; }
                nsa_pv(vb, rr, hi, p0, p1, O);
#pragma unroll
                for (int sub = 0; sub < 2; ++sub)
#pragma unroll
                    for (int a = 0; a < 4; ++a) {
                        float G, last;
                        if (sub == 0) { G = (p0[4 * a] + p0[4 * a + 1]) + (p0[4 * a + 2] + p0[4 * a + 3]); last = p0[4 * a + 3]; } else { G = (p1[4 * a] + p1[4 * a + 1]) + (p1[4 * a + 2] + p1[4 * a + 3]); last = p1[4 * a + 3]; }
                        G += __shfl_xor(G, 1); G += __shfl_xor(G, 2); last += __shfl_xor(last, 1); last += __shfl_xor(last, 2);
                        const int jj = (k0 >> 2) + 8 * sub + 2 * a + hi;
                        if ((rr & 3) == 0) { impA[tokblk * NSA_IMPS + jj] = G; if (jj + 1 < 64) impB[tokblk * NSA_IMPS + jj + 1] = last; }
                    }
            }
        }
        if (more) nsa_lstore(lds + NSA_OFF_K + (cur ^ 1) * NSA_KBUF, lds + NSA_OFF_V + (cur ^ 1) * NSA_VBUF, tid, kr, vr);
        __syncthreads();
    }
}
__device__ __forceinline__ void ph_nsa(const Params& p, int wv, unsigned char* lds) {
    PH_IDS(); unsigned char* ws = p.ws; const int wave = wv, rr = lane & 31, hi = lane >> 5;
    bf16* q = (bf16*)(ws + OFF_Q); const bf16* kvs = (const bf16*)(ws + OFF_KVS);
    const float* gate = (const float*)(ws + OFF_GATE); float* ssq = (float*)(ws + OFF_SSQ);
    float* impA = (float*)(lds + NSA_OFF_IMPA); float* impB = (float*)(lds + NSA_OFF_IMPB); u64* selw = (u64*)(lds + NSA_OFF_SEL);
    const int nunits = 1024;
    for (int it = 0; ; ++it) {
        int bh, qi;
        if (nb == 256) { if (it >= 4) break; bh = bid & 15; const int x = bid >> 4; qi = (it == 0) ? 63 - x : (it == 1) ? 32 + x : (it == 2) ? 31 - x : x; }
        else { const int u = bid + it * nb; if (u >= nunits) break; bh = u & 15; qi = 63 - (u >> 4); }
        const int b = bh >> 2, hk = bh & 3; const int tokblk = wave * 8 + (rr >> 2), g = rr & 3; const int lpos = qi * 64 + tokblk; const size_t t = (size_t)b * L + lpos;
        bf16* qrow = q + t * 1024 + (hk * 4 + g) * 64;
        bf16x8 qf[4];
#pragma unroll
        for (int ds = 0; ds < 4; ++ds) qf[ds] = *(const bf16x8*)(qrow + ds * 16 + hi * 8);
        for (int i = tid; i < 64 * NSA_IMPS; i += NTHREADS) { impA[i] = 0.f; impB[i] = 0.f; }
        __syncthreads();
        f32x16 O[2]; float* stash = (float*)(lds + NSA_OFF_STASH) + tid;
        const float g0 = gate[t * 48 + (hk * 4 + g) * 3 + 0], g1 = gate[t * 48 + (hk * 4 + g) * 3 + 1], g2 = gate[t * 48 + (hk * 4 + g) * 3 + 2];
        {
            NsaSrc s{(const bf16*)(ws + OFF_KC) + (size_t)bh * 256 * 64, 64, (const bf16*)(ws + OFF_VCT) + (size_t)bh * 64 * 256, 256};
            const int nct = (4 * qi + 3 + 63) >> 6;
            float m = NEG_INF, lsum = 0.f;
            nsa_branch<0>(lds, s, 0, nct, tid, rr, hi, qf, lpos, qi, tokblk, 0ull, 0ull, m, lsum, 0.f, O);
            lsum += __shfl_xor(lsum, 32);
            const float inv_l = lsum > 0.f ? 1.0f / lsum : 0.f;
#pragma unroll
            for (int e = 0; e < 16; ++e) { O[0][e] = 0.f; O[1][e] = 0.f; }
            nsa_branch<1>(lds, s, 0, nct, tid, rr, hi, qf, lpos, qi, tokblk, 0ull, 0ull, m, lsum, inv_l, O);
#pragma unroll
            for (int e = 0; e < 16; ++e) { stash[e * 512] = g0 * O[0][e]; stash[(16 + e) * 512] = g0 * O[1][e]; }
        }
        {
            const int tk = tid >> 3, jg = tid & 7; float v[8];
#pragma unroll
            for (int i = 0; i < 8; ++i) { const int j = jg * 8 + i; const float raw = impA[tk * NSA_IMPS + j] + impB[tk * NSA_IMPS + j];
                const bool causal = (j <= qi), forced = (j == 0) || (j == qi) || (j == qi - 1); v[i] = causal ? (forced ? BIG : raw) : NEG_INF; }
            __syncthreads();
#pragma unroll
            for (int i = 0; i < 8; ++i) impA[tk * NSA_IMPS + jg * 8 + i] = v[i];
            __syncthreads();
            int rank[8];
#pragma unroll
            for (int i = 0; i < 8; ++i) rank[i] = 0;
            for (int jj = 0; jj < 64; ++jj) { const float x = impA[tk * NSA_IMPS + jj];
#pragma unroll
                for (int i = 0; i < 8; ++i) rank[i] += (x > v[i] || (x == v[i] && jj < jg * 8 + i)) ? 1 : 0; }
            unsigned b8 = 0u;
#pragma unroll
            for (int i = 0; i < 8; ++i) b8 |= (rank[i] < 16 && jg * 8 + i <= qi) ? (1u << i) : 0u;
            const u64 full = (u64)b8 << (jg * 8); unsigned blo = (unsigned)full, bhi = (unsigned)(full >> 32);
            blo |= __shfl_xor(blo, 1); bhi |= __shfl_xor(bhi, 1); blo |= __shfl_xor(blo, 2); bhi |= __shfl_xor(bhi, 2); blo |= __shfl_xor(blo, 4); bhi |= __shfl_xor(bhi, 4);
            if (jg == 0) selw[tk] = (u64)blo | ((u64)bhi << 32);
            __syncthreads();
        }
        const u64 selm = selw[tokblk];
        u64 wsel = selm;
        { unsigned lo = (unsigned)wsel, h2 = (unsigned)(wsel >> 32);
          lo |= __shfl_xor(lo, 4); h2 |= __shfl_xor(h2, 4); lo |= __shfl_xor(lo, 8); h2 |= __shfl_xor(h2, 8); lo |= __shfl_xor(lo, 16); h2 |= __shfl_xor(h2, 16);
          wsel = (u64)lo | ((u64)h2 << 32); }
        {
            NsaSrc s{kvs + (size_t)b * L * 1536 + 512 + hk * 64, 1536, (const bf16*)(ws + OFF_VST) + (size_t)bh * 64 * L, (size_t)L};
            float m = NEG_INF, lsum = 0.f;
#pragma unroll
            for (int e = 0; e < 16; ++e) { O[0][e] = 0.f; O[1][e] = 0.f; }
            nsa_branch<2>(lds, s, 0, qi + 1, tid, rr, hi, qf, lpos, qi, tokblk, selm, wsel, m, lsum, 0.f, O);
            lsum += __shfl_xor(lsum, 32); const float sc = g1 / lsum;
#pragma unroll
            for (int e = 0; e < 16; ++e) { stash[e * 512] += sc * O[0][e]; stash[(16 + e) * 512] += sc * O[1][e]; }
        }
        {
            NsaSrc s{kvs + (size_t)b * L * 1536 + 1024 + hk * 64, 1536, (const bf16*)(ws + OFF_VWT) + (size_t)bh * 64 * L, (size_t)L};
            float m = NEG_INF, lsum = 0.f;
#pragma unroll
            for (int e = 0; e < 16; ++e) { O[0][e] = 0.f; O[1][e] = 0.f; }
            nsa_branch<3>(lds, s, qi >= 8 ? qi - 8 : 0, qi + 1, tid, rr, hi, qf, lpos, qi, tokblk, 0ull, 0ull, m, lsum, 0.f, O);
            lsum += __shfl_xor(lsum, 32); const float sc = g2 / lsum;
#pragma unroll
            for (int e = 0; e < 16; ++e) { O[0][e] = stash[e * 512] + sc * O[0][e]; O[1][e] = stash[(16 + e) * 512] + sc * O[1][e]; }
        }
        float ss = 0.f;
#pragma unroll
        for (int dsub = 0; dsub < 2; ++dsub)
#pragma unroll
            for (int a = 0; a < 4; ++a) {
                const float v0 = O[dsub][4 * a], v1 = O[dsub][4 * a + 1], v2 = O[dsub][4 * a + 2], v3 = O[dsub][4 * a + 3];
                ss += (v0 * v0 + v1 * v1) + (v2 * v2 + v3 * v3);
                *(uint2*)(qrow + dsub * 32 + 8 * a + 4 * hi) = make_uint2(pk2bf(v0, v1), pk2bf(v2, v3));
            }
        ss += __shfl_xor(ss, 32); ss += __shfl_xor(ss, 1); ss += __shfl_xor(ss, 2);
        if (hi == 0 && g == 0) ssq[t * 4 + hk] = ss;
        __syncthreads();
    }
}

__device__ __forceinline__ void ph_ln1(const Params& p, int wv) {
    PH_IDS(); unsigned char* ws = p.ws; bf16* h1b = (bf16*)(ws + OFF_H1B);
    for (int t = gwave; t < T; t += nwaves) {
        float v[16]; float s = 0.f; float* row = p.out + (size_t)t * 1024;
#pragma unroll
        for (int i = 0; i < 16; ++i) { v[i] = row[i * 64 + lane]; s += v[i]; }
        const float mu = wave_sum(s) * (1.0f / 1024.0f); float s2 = 0.f;
#pragma unroll
        for (int i = 0; i < 16; ++i) { v[i] -= mu; s2 += v[i] * v[i]; }
        const float rstd = rsqrtf(wave_sum(s2) * (1.0f / 1024.0f) + LN_EPS);
#pragma unroll
        for (int i = 0; i < 16; ++i) { const int c = i * 64 + lane; const float o = v[i] * rstd * p.ln1_g[c] + p.ln1_b[c]; row[c] = o; h1b[(size_t)t * 1024 + c] = f2bf(o); }
    }
}

__device__ __forceinline__ void ph_peer_topk(const Params& p, int wv, unsigned char* lds) {
    PH_IDS(); unsigned char* ws = p.ws; const int rr = lane & 31, hi = lane >> 5;
    float* sv = (float*)(lds + wv * 12288); int* si = (int*)(sv + 1024); float* gv = (float*)(si + 1024); int* ge = (int*)(gv + 512);
    const bf16* qp = (const bf16*)(ws + OFF_QP); const bf16* keys = (const bf16*)(ws + OFF_KEYS);
    int* eidx = (int*)(ws + OFF_EIDX); float* gw = (float*)(ws + OFF_GW);
    const float NEGB = -3.0e38f;
    for (int task = gwave; task < 512 * 8; task += nwaves) {
        const int h = task & 7, t0 = (task >> 3) * 32;
#pragma unroll 1
        for (int c = 0; c < 2; ++c) {
            bf16x8 qf[8];
#pragma unroll
            for (int ks = 0; ks < 8; ++ks) qf[ks] = *(const bf16x8*)(qp + (size_t)(t0 + rr) * 2048 + h * 256 + c * 128 + ks * 16 + 8 * hi);
            f32x16 acc[4];
#pragma unroll
            for (int kt = 0; kt < 4; ++kt) {
#pragma unroll
                for (int e = 0; e < 16; ++e) acc[kt][e] = 0.f;
                const bf16* kr = keys + ((size_t)(h * 2 + c) * 128 + kt * 32 + rr) * 128 + 8 * hi;
#pragma unroll
                for (int ks = 0; ks < 8; ++ks) acc[kt] = __builtin_amdgcn_mfma_f32_32x32x16_bf16(*(const bf16x8*)(kr + ks * 16), qf[ks], acc[kt], 0, 0, 0);
            }
#pragma unroll 1
            for (int r = 0; r < 16; ++r) {
                float m = NEGB;
#pragma unroll
                for (int kt = 0; kt < 4; ++kt)
#pragma unroll
                    for (int e = 0; e < 16; ++e) m = fmaxf(m, acc[kt][e]);
                const float gm = fmaxf(m, __shfl_xor(m, 32));
                int idx = 255; bool found = false;
#pragma unroll
                for (int kt = 0; kt < 4; ++kt)
#pragma unroll
                    for (int e = 0; e < 16; ++e) { const bool hit = (acc[kt][e] == gm) && !found; idx = hit ? (kt * 32 + (e & 3) + 8 * (e >> 2) + 4 * hi) : idx; found = found || hit; }
                const int widx = min(idx, __shfl_xor(idx, 32)); const int wloc = widx - 4 * hi;
#pragma unroll
                for (int kt = 0; kt < 4; ++kt)
#pragma unroll
                    for (int e = 0; e < 16; ++e) acc[kt][e] = (wloc == kt * 32 + (e & 3) + 8 * (e >> 2)) ? NEGB : acc[kt][e];
                if (hi == 0) { sv[(c * 16 + r) * 32 + rr] = gm; si[(c * 16 + r) * 32 + rr] = widx; }
            }
        }
        float s0[16], s1[16]; int i0[16], i1[16];
#pragma unroll
        for (int i = 0; i < 16; ++i) { s0[i] = sv[i * 32 + rr]; s1[i] = sv[(16 + i) * 32 + rr]; i0[i] = si[i * 32 + rr]; i1[i] = si[(16 + i) * 32 + rr]; }
        float cv[16][16];
#pragma unroll
        for (int i = 0; i < 16; ++i)
#pragma unroll
            for (int j = 0; j < 16; ++j) if ((i + 1) * (j + 1) <= 16) cv[i][j] = s0[i] + s1[j];
#pragma unroll 1
        for (int r = 0; r < 16; ++r) {
            float gm = NEGB;
#pragma unroll
            for (int i = 0; i < 16; ++i)
#pragma unroll
                for (int j = 0; j < 16; ++j) if ((i + 1) * (j + 1) <= 16) gm = fmaxf(gm, cv[i][j]);
            int es = 0; bool found = false;
#pragma unroll
            for (int i = 0; i < 16; ++i)
#pragma unroll
                for (int j = 0; j < 16; ++j) if ((i + 1) * (j + 1) <= 16) { const bool hit = (cv[i][j] == gm) && !found; es = hit ? (i0[i] * 128 + i1[j]) : es; cv[i][j] = hit ? NEGB : cv[i][j]; found = found || hit; }
            if (hi == 0) { gv[r * 32 + rr] = gm; ge[r * 32 + rr] = es; }
        }
        float e16[16]; float den = 0.f; const float g0 = gv[rr];
#pragma unroll
        for (int r = 0; r < 16; ++r) { e16[r] = __expf(gv[r * 32 + rr] - g0); den += e16[r]; }
        const float inv = 1.0f / den; const size_t ob = (size_t)(t0 + rr) * 128 + h * 16 + hi * 8;
        float4 wa, wb; int4 ea, eb;
        wa.x = (hi ? e16[8] : e16[0]) * inv; wa.y = (hi ? e16[9] : e16[1]) * inv; wa.z = (hi ? e16[10] : e16[2]) * inv; wa.w = (hi ? e16[11] : e16[3]) * inv;
        wb.x = (hi ? e16[12] : e16[4]) * inv; wb.y = (hi ? e16[13] : e16[5]) * inv; wb.z = (hi ? e16[14] : e16[6]) * inv; wb.w = (hi ? e16[15] : e16[7]) * inv;
        ea.x = ge[(hi * 8 + 0) * 32 + rr]; ea.y = ge[(hi * 8 + 1) * 32 + rr]; ea.z = ge[(hi * 8 + 2) * 32 + rr]; ea.w = ge[(hi * 8 + 3) * 32 + rr];
        eb.x = ge[(hi * 8 + 4) * 32 + rr]; eb.y = ge[(hi * 8 + 5) * 32 + rr]; eb.z = ge[(hi * 8 + 6) * 32 + rr]; eb.w = ge[(hi * 8 + 7) * 32 + rr];
        *(float4*)(gw + ob) = wa; *(float4*)(gw + ob + 4) = wb; *(int4*)(eidx + ob) = ea; *(int4*)(eidx + ob + 4) = eb;
    }
}
__device__ __forceinline__ unsigned pk4fp8(float a, float b, float c, float d) { unsigned w = 0u; w = __builtin_amdgcn_cvt_pk_fp8_f32(a, b, w, false); w = __builtin_amdgcn_cvt_pk_fp8_f32(c, d, w, true); return w; }
__device__ __forceinline__ void ph_peer_cvt(const Params& p, int wv) {
    PH_IDS(); unsigned char* ws = p.ws; uint4* pu = (uint4*)(ws + OFF_PU); uint4* pv = (uint4*)(ws + OFF_PV);
    for (size_t i = gtid; i < (size_t)16384 * 1024 / 16; i += gn) {
        const float4* su = (const float4*)p.peer_u + 4 * i; const float4* sv = (const float4*)p.peer_v + 4 * i;
        const float4 a = su[0], b = su[1], c = su[2], d = su[3], e = sv[0], f = sv[1], g = sv[2], h = sv[3];
        pu[i] = make_uint4(pk4fp8(a.x * 32.f, a.y * 32.f, a.z * 32.f, a.w * 32.f), pk4fp8(b.x * 32.f, b.y * 32.f, b.z * 32.f, b.w * 32.f), pk4fp8(c.x * 32.f, c.y * 32.f, c.z * 32.f, c.w * 32.f), pk4fp8(d.x * 32.f, d.y * 32.f, d.z * 32.f, d.w * 32.f));
        pv[i] = make_uint4(pk4fp8(e.x, e.y, e.z, e.w), pk4fp8(f.x, f.y, f.z, f.w), pk4fp8(g.x, g.y, g.z, g.w), pk4fp8(h.x, h.y, h.z, h.w));
    }
}
__device__ __forceinline__ float bflo(unsigned w) { return __uint_as_float(w << 16); }
__device__ __forceinline__ float bfhi(unsigned w) { return __uint_as_float(w & 0xffff0000u); }
__device__ __forceinline__ float dot4f8(unsigned w, const float* x) { const f32x2v lo = __builtin_amdgcn_cvt_pk_f32_fp8(w, false), hi = __builtin_amdgcn_cvt_pk_f32_fp8(w, true); return (lo.x * x[0] + lo.y * x[1]) + (hi.x * x[2] + hi.y * x[3]); }
__device__ __forceinline__ float dot16f8(const uint4& w, const float* x) { return (dot4f8(w.x, x) + dot4f8(w.y, x + 4)) + (dot4f8(w.z, x + 8) + dot4f8(w.w, x + 12)); }
__device__ __forceinline__ void axpy4f8(unsigned w, float c, float* y) { const f32x2v lo = __builtin_amdgcn_cvt_pk_f32_fp8(w, false), hi = __builtin_amdgcn_cvt_pk_f32_fp8(w, true); y[0] += c * lo.x; y[1] += c * lo.y; y[2] += c * hi.x; y[3] += c * hi.y; }
__device__ __forceinline__ void axpy16f8(const uint4& w, float c, float* y) { axpy4f8(w.x, c, y); axpy4f8(w.y, c, y + 4); axpy4f8(w.z, c, y + 8); axpy4f8(w.w, c, y + 12); }
#define PG_LOAD(U, V, base) do { _Pragma("unroll") for (int k = 0; k < 8; ++k) { const int ei = (base) + k; const int ex = ei < 64 ? __builtin_amdgcn_readlane(e_lo, ei & 63) : __builtin_amdgcn_readlane(e_hi, ei & 63); \
        U[k] = *(const uint4*)(PU + (size_t)ex * 1024 + lane * 16); V[k] = *(const uint4*)(PV + (size_t)ex * 1024 + lane * 16); } } while (0)
#define PG_COMPUTE(U, V, base) do { float d[8]; _Pragma("unroll") for (int k = 0; k < 8; ++k) d[k] = dot16f8(U[k], xv); \
        const bool b5 = (lane & 32) != 0, b4 = (lane & 16) != 0, b3 = (lane & 8) != 0; float a4[4], a2[2], a1; \
        _Pragma("unroll") for (int k = 0; k < 4; ++k) { const float give = b5 ? d[k] : d[4 + k]; a4[k] = (b5 ? d[4 + k] : d[k]) + __shfl_xor(give, 32); } \
        _Pragma("unroll") for (int k = 0; k < 2; ++k) { const float give = b4 ? a4[k] : a4[2 + k]; a2[k] = (b4 ? a4[2 + k] : a4[k]) + __shfl_xor(give, 16); } \
        { const float give = b3 ? a2[0] : a2[1]; a1 = (b3 ? a2[1] : a2[0]) + __shfl_xor(give, 8); } \
        a1 += __shfl_xor(a1, 4); a1 += __shfl_xor(a1, 2); a1 += __shfl_xor(a1, 1); \
        const float ge = gelu_exact(a1 * (1.0f / 32.0f)); \
        _Pragma("unroll") for (int k = 0; k < 8; ++k) { const int ei = (base) + k; const float gx = __uint_as_float(ei < 64 ? __builtin_amdgcn_readlane(__float_as_uint(g_lo), ei & 63) : __builtin_amdgcn_readlane(__float_as_uint(g_hi), ei & 63)); \
            const float cf = gx * __uint_as_float(__builtin_amdgcn_readlane(__float_as_uint(ge), ((k >> 2) & 1) * 32 + ((k >> 1) & 1) * 16 + (k & 1) * 8)); axpy16f8(V[k], cf, y); } } while (0)
__device__ __forceinline__ void ph_peer_gather(const Params& p, int wv) {
    PH_IDS(); unsigned char* ws = p.ws;
    const bf16* h1b = (const bf16*)(ws + OFF_H1B); const int* eidx = (const int*)(ws + OFF_EIDX); const float* gw = (const float*)(ws + OFF_GW);
    const unsigned char* PU = ws + OFF_PU; const unsigned char* PV = ws + OFF_PV;
    for (int t = gwave; t < T; t += nwaves) {
        float xv[16], y[16];
        { const uint4 a = *(const uint4*)(h1b + (size_t)t * 1024 + lane * 16), b = *(const uint4*)(h1b + (size_t)t * 1024 + lane * 16 + 8);
          xv[0] = bflo(a.x); xv[1] = bfhi(a.x); xv[2] = bflo(a.y); xv[3] = bfhi(a.y); xv[4] = bflo(a.z); xv[5] = bfhi(a.z); xv[6] = bflo(a.w); xv[7] = bfhi(a.w);
          xv[8] = bflo(b.x); xv[9] = bfhi(b.x); xv[10] = bflo(b.y); xv[11] = bfhi(b.y); xv[12] = bflo(b.z); xv[13] = bfhi(b.z); xv[14] = bflo(b.w); xv[15] = bfhi(b.w); }
#pragma unroll
        for (int i = 0; i < 16; ++i) y[i] = 0.f;
        const int e_lo = eidx[(size_t)t * 128 + lane], e_hi = eidx[(size_t)t * 128 + 64 + lane]; const float g_lo = gw[(size_t)t * 128 + lane], g_hi = gw[(size_t)t * 128 + 64 + lane];
        uint4 uA[8], vA[8], uB[8], vB[8];
        PG_LOAD(uA, vA, 0);
#pragma unroll 1
        for (int e0 = 0; e0 < 128; e0 += 16) {
            PG_LOAD(uB, vB, e0 + 8);
            PG_COMPUTE(uA, vA, e0);
            if (e0 + 16 < 128) PG_LOAD(uA, vA, e0 + 16);
            PG_COMPUTE(uB, vB, e0 + 8);
        }
        float* row = p.out + (size_t)t * 1024 + lane * 16; float s = 0.f;
#pragma unroll
        for (int i = 0; i < 4; ++i) { const float4 a = *(const float4*)(row + 4 * i); y[4 * i] += DN_ALPHA * a.x; y[4 * i + 1] += DN_ALPHA * a.y; y[4 * i + 2] += DN_ALPHA * a.z; y[4 * i + 3] += DN_ALPHA * a.w; }
#pragma unroll
        for (int i = 0; i < 16; ++i) s += y[i];
        const float mu = wave_sum(s) * (1.0f / 1024.0f); float s2 = 0.f;
#pragma unroll
        for (int i = 0; i < 16; ++i) { y[i] -= mu; s2 += y[i] * y[i]; }
        const float rstd = rsqrtf(wave_sum(s2) * (1.0f / 1024.0f) + LN_EPS);
#pragma unroll
        for (int i = 0; i < 4; ++i) { const int c = lane * 16 + 4 * i; const float4 ga = *(const float4*)(p.ln2_g + c), ba = *(const float4*)(p.ln2_b + c);
            float4 o; o.x = y[4 * i] * rstd * ga.x + ba.x; o.y = y[4 * i + 1] * rstd * ga.y + ba.y; o.z = y[4 * i + 2] * rstd * ga.z + ba.z; o.w = y[4 * i + 3] * rstd * ga.w + ba.w;
            *(float4*)(row + 4 * i) = o; }
    }
}

#define LAS __attribute__((address_space(3)))
#define XB_TMO      128
#define XB_XCNT(j)  (256  + 64 * (j))
#define XB_XSUB(j)  (1280 + 64 * (j))
#define XB_XGEN(j)  (2304 + 64 * (j))
#define XB_TOP      3328
#define XB_TOPGEN   3392
#define XCD_BAR_WORDS 3456
#define XB_SPIN_CAP (1u << 18)

__device__ __forceinline__ unsigned xb_ld(unsigned* p)              { return __hip_atomic_load(p, __ATOMIC_RELAXED, __HIP_MEMORY_SCOPE_AGENT); }
__device__ __forceinline__ unsigned xb_add(unsigned* p, unsigned v) { return __hip_atomic_fetch_add(p, v, __ATOMIC_RELAXED, __HIP_MEMORY_SCOPE_AGENT); }
__device__ __forceinline__ unsigned xb_xcc_id() { return (unsigned)__builtin_amdgcn_s_getreg((3 << 11) | 20) & 0xFu; }
#define XB_SPIN(cond, bar) do { unsigned _sp = 0; while (cond) { __builtin_amdgcn_s_sleep(1); \
    if ((++_sp & 255u) == 0u) { if (xb_ld(&(bar)[XB_TMO])) break; if (_sp > XB_SPIN_CAP) { atomicAdd(&(bar)[XB_TMO], 1u); break; } } } } while (0)

struct XcdBarrier {
    unsigned* bar; unsigned x;
    volatile LAS unsigned* st;
};

__device__ __forceinline__ XcdBarrier xcd_barrier_post(unsigned* bar, volatile LAS unsigned* st, bool leader) {
    XcdBarrier b; b.bar = bar; b.x = xb_xcc_id(); b.st = st;
    if (leader) (void)xb_add(&bar[XB_XCNT(b.x)], 1u);
    return b;
}
__device__ __forceinline__ void xcd_barrier_complete(unsigned* bar, unsigned x, unsigned& nloc, unsigned& nx) {
    const unsigned G = gridDim.x * gridDim.y * gridDim.z;
    unsigned sum, cnt, mine, sp = 0u;
    for (;;) {
        sum = 0u; cnt = 0u; mine = 0u;
#pragma unroll
        for (unsigned j = 0; j < 16; ++j) { const unsigned c = xb_ld(&bar[XB_XCNT(j)]); sum += c; cnt += (c > 0u) ? 1u : 0u; mine = (j == x) ? c : mine; }
        if (sum == G) break;
        __builtin_amdgcn_s_sleep(1);
        if ((++sp & 255u) == 0u) { if (xb_ld(&bar[XB_TMO])) break; if (sp > XB_SPIN_CAP) { atomicAdd(&bar[XB_TMO], 1u); break; } }
    }
    nloc = mine > 0u ? mine : 1u; nx = cnt > 0u ? cnt : 1u;
}

__device__ __forceinline__ void xcd_barrier(const XcdBarrier& b, bool leader) {
    asm volatile("s_waitcnt vmcnt(0)" ::: "memory");
    __syncthreads();
    if (leader) {
        unsigned* bar = b.bar;
        __builtin_amdgcn_s_waitcnt(0);
        unsigned nloc = b.st[0], nx = b.st[1];
        if (nloc == 0u) { xcd_barrier_complete(bar, b.x, nloc, nx); b.st[0] = nloc; b.st[1] = nx; }
        const unsigned old = xb_add(&bar[XB_XSUB(b.x)], 1u);
        const unsigned gen = old / nloc;
        if (old + 1u == (gen + 1u) * nloc) {
            __builtin_amdgcn_fence(__ATOMIC_RELEASE, "agent");
            asm volatile("s_waitcnt vmcnt(0)" ::: "memory");
            const unsigned og = xb_add(&bar[XB_TOP], 1u);
            const unsigned tg = og / nx;
            if (og + 1u == (tg + 1u) * nx) xb_add(&bar[XB_TOPGEN], 1u);
            else XB_SPIN(xb_ld(&bar[XB_TOPGEN]) == tg, bar);
            __builtin_amdgcn_fence(__ATOMIC_ACQUIRE, "agent");
            xb_add(&bar[XB_XGEN(b.x)], 1u);
            asm volatile("s_waitcnt vmcnt(0)" ::: "memory");
        } else {
            XB_SPIN(xb_ld(&bar[XB_XGEN(b.x)]) == gen, bar);
            __builtin_amdgcn_fence(__ATOMIC_ACQUIRE, "agent");
            asm volatile("s_waitcnt vmcnt(0)" ::: "memory");
        }
    }
    __syncthreads();
}

#ifndef TIMING_BOUNDARY
#define TIMING_BOUNDARY -1
#endif
#define TPROBE(k) do { if (TIMING_BOUNDARY == (k) && blockIdx.x == 0 && wv == 0) { const unsigned long long t1_ = __builtin_amdgcn_s_memrealtime(); while (__builtin_amdgcn_s_memrealtime() - t1_ < t1_ - tstart_) __builtin_amdgcn_s_sleep(8); } } while (0)
__global__ void __launch_bounds__(NTHREADS) fwd_megakernel(Params p) {
    extern __shared__ __attribute__((aligned(16))) unsigned char lds[];
    cg::grid_group grid = cg::this_grid();
    const int nb = gridDim.x, bid = blockIdx.x;
    const int wv = __builtin_amdgcn_readfirstlane(threadIdx.x >> 6);
    unsigned char* ws = p.ws;
    const unsigned long long tstart_ = (TIMING_BOUNDARY >= 0) ? __builtin_amdgcn_s_memrealtime() : 0ull; (void)tstart_;
    PG8_LAS unsigned char* ldsp = (PG8_LAS unsigned char*)lds;
    const bool leader = (wv == 0) && (lane_id() == 0);
    volatile LAS unsigned* bst = (volatile LAS unsigned*)(ldsp + LDS_BYTES - 64);
    if (leader) { bst[0] = 0u; bst[1] = 0u; }
    __syncthreads();
    const XcdBarrier xbar = xcd_barrier_post((unsigned*)(ws + OFF_BAR), bst, leader);

    ph_prep(p, wv, lds);
    TPROBE(0);
    grid.sync();
    {
        pg8::Gemm g{(const bf16*)(ws + OFF_XB), (const bf16*)(ws + OFF_WIN), T, NPROJ_PAD, 1024, 1024, 0, 1 << 30, 0l};
        pg8::StaticOrder S; S.init(T, NPROJ_PAD, nb, bid);
        pg8::EpiInProjPg E{(bf16*)(ws + OFF_Z), (bf16*)(ws + OFF_XBC), (bf16*)(ws + OFF_Q), (bf16*)(ws + OFF_KVS), (bf16*)(ws + OFF_DTG)};
        pg8::gemm_phase<pg8::EpiInProjPg, pg8::StaticOrder, pg8::NoMid, true, true>(wv, ldsp, g, S, E, pg8::NoMid{});
    }
    TPROBE(1);
    xcd_barrier(xbar, leader);
    ph_tokprep(p, wv);
    TPROBE(2);
    xcd_barrier(xbar, leader);
    if (bid < 32) {
        const bool isv = bid >= 16;
        pg8::Gemm g{(const bf16*)(ws + OFF_KVS) + (isv ? 256 : 0), (const bf16*)(ws + (isv ? OFF_W1V : OFF_W1K)), 4096, 256, 2048, 0, 1, 1 << 30, 0l};
        pg8::StaticOrder S; S.init(4096, 256, 16, isv ? bid - 16 : bid);
        pg8::EpiBf16<1> E{(bf16*)(ws + OFF_HID + (isv ? 2 * MiB : 0)), 256, (const float*)(ws + (isv ? OFF_B1V : OFF_B1K)), 0, 0, 1.f};
        pg8::gemm_phase<pg8::EpiBf16<1>, pg8::StaticOrder, pg8::NoMid, true, true>(wv, ldsp, g, S, E, pg8::NoMid{});
    }
    ph_ssd_prep2(p, wv, lds);
    ph_vt_prep(p, wv);
    TPROBE(3);
    xcd_barrier(xbar, leader);
    {
        RowMajorBf16 ak{(const bf16*)(ws + OFF_HID), 256}, av{(const bf16*)(ws + OFF_HID + 2 * MiB), 256};
        RowMajorBf16 bk{(const bf16*)(ws + OFF_W2K), 256}, bv{(const bf16*)(ws + OFF_W2V), 256};
        EpiKc ek{(bf16*)(ws + OFF_KC), false}, ev{(bf16*)(ws + OFF_VCT), true};
        gemm_wave32(wv, 4096 / 32, 64 / 32, 256, ak, bk, ek);
        gemm_wave32(wv, 4096 / 32, 64 / 32, 256, av, bv, ev);
    }
    ph_ssd_states(p, wv);
    TPROBE(4);
    xcd_barrier(xbar, leader);
    ph_kc_rope(p, wv);
    ph_ssd_scan(p, wv);
    TPROBE(5);
    xcd_barrier(xbar, leader);
    ph_ssd_out(p, wv);
    ph_nsa(p, wv, lds);
    TPROBE(6);
    xcd_barrier(xbar, leader);
    {
        pg8::Gemm g{(const bf16*)(ws + OFF_Q), (const bf16*)(ws + OFF_WOUT), T, 1024, 2048, 1024, 0, 16, (long)OFF_Z - (long)OFF_Q - 16l * 128l};
        pg8::StaticOrder S; S.init(T, 1024, nb, bid);
        pg8::RmsFactors rf{(const float*)(ws + OFF_SSQ), (const float*)(ws + OFF_HID), RMS_EPS};
        pg8::EpiOutProj E{p.x, p.out, DN_ALPHA, rf}; pg8::MidRmsScale MH{rf};
        pg8::gemm_phase<pg8::EpiOutProj, pg8::StaticOrder, pg8::MidRmsScale, true, true>(wv, ldsp, g, S, E, MH);
    }
    TPROBE(7);
    xcd_barrier(xbar, leader);
    ph_ln1(p, wv);
    ph_peer_cvt(p, wv);
    TPROBE(8);
    xcd_barrier(xbar, leader);
    {
        pg8::Gemm g{(const bf16*)(ws + OFF_H1B), (const bf16*)(ws + OFF_WQ), T, 2048, 1024, 1024, 0, 1 << 30, 0l};
        pg8::StaticOrder S; S.init(T, 2048, nb, bid);
        pg8::EpiBf16<0> E{(bf16*)(ws + OFF_QP), 2048, nullptr, 0, 0, 1.f};
        pg8::gemm_phase<pg8::EpiBf16<0>, pg8::StaticOrder, pg8::NoMid, true, true>(wv, ldsp, g, S, E, pg8::NoMid{});
    }
    TPROBE(9);
    xcd_barrier(xbar, leader);
    ph_peer_topk(p, wv, lds);
    TPROBE(10);
    xcd_barrier(xbar, leader);
    ph_peer_gather(p, wv);
}

extern "C" void kernel_launch(void* const* d_in, const int* in_sizes, int n_in, void* d_out, int out_size, void* d_ws, size_t ws_size, hipStream_t stream) {
    static int grid_blocks = 0;
    if (!grid_blocks) {
        int dev = 0, cus = 0, per_cu = 0;
        hipGetDevice(&dev);
        hipDeviceGetAttribute(&cus, hipDeviceAttributeMultiprocessorCount, dev);
        hipFuncSetAttribute((const void*)fwd_megakernel, hipFuncAttributeMaxDynamicSharedMemorySize, LDS_BYTES);
        hipOccupancyMaxActiveBlocksPerMultiprocessor(&per_cu, fwd_megakernel, NTHREADS, LDS_BYTES);
        if (per_cu < 1) per_cu = 1;
        if (per_cu > 1) per_cu = 1;
        grid_blocks = cus * per_cu;
        if (ws_size < 244 * MiB) fprintf(stderr, "kernel_launch: workspace too small: %zu\n", ws_size);
    }
    Params p{};
    const float** pp = (const float**)&p;
    for (int i = 0; i < 24; ++i) pp[i] = (const float*)d_in[i];
    p.out = (float*)d_out; p.ws = (unsigned char*)d_ws;
    (void)hipMemsetAsync((unsigned char*)d_ws + OFF_BAR, 0, BAR_BYTES, stream);
    void* args[] = {&p};
    hipError_t e = hipLaunchCooperativeKernel((void*)fwd_megakernel, dim3(grid_blocks), dim3(NTHREADS), args, LDS_BYTES, stream);
    if (e != hipSuccess) fprintf(stderr, "cooperative launch failed: %s (grid %d)\n", hipGetErrorString(e), grid_blocks);
}
```

```cpp
#include <hip/hip_runtime.h>
#include <hip/hip_cooperative_groups.h>
#include <cstdio>
#include <cstdint>
namespace cg = cooperative_groups;

typedef unsigned short bf16;
typedef short bf16x8 __attribute__((ext_vector_type(8)));
typedef float f32x4 __attribute__((ext_vector_type(4)));
typedef unsigned long long u64;

constexpr int T = 16384, L = 4096, NBATCH = 4, D = 1024;
constexpr int NPROJ = 5184, NPROJ_PAD = 5376;
constexpr int NTHREADS = 512, NWAVES = 8;
constexpr float LN_EPS = 1e-5f, RMS_EPS = 1e-5f;
constexpr float DN_ALPHA = 1.189207115002721f;
constexpr float NEG_INF = -1e30f, BIG = 1e30f;

constexpr size_t MiB = 1u << 20;
constexpr size_t OFF_SSQ = 0, OFF_BAR = 512 * 1024, BAR_BYTES = 16384;
constexpr size_t OFF_WOUT = 1 * MiB, OFF_WQ = 5 * MiB, OFF_W1K = 9 * MiB, OFF_W1V = 10 * MiB;
constexpr size_t OFF_W2K = 11 * MiB, OFF_W2V = 11 * MiB + 65536, OFF_B1K = 11 * MiB + 131072, OFF_B1V = 11 * MiB + 131072 + 4096;
constexpr size_t OFF_KEYS = 12 * MiB, OFF_ROPE = 13 * MiB, OFF_DT = 14 * MiB, OFF_ACS = 15 * MiB, OFF_GATE = 16 * MiB, OFF_MASK = 19 * MiB;
constexpr size_t OFF_HID = 20 * MiB, OFF_KC = 24 * MiB, OFF_VC = 24 * MiB + 524288;
constexpr size_t OFF_Z = 26 * MiB, OFF_Q = 58 * MiB, OFF_KVS = 90 * MiB, OFF_XBC = 138 * MiB, OFF_XSBC = 186 * MiB, OFF_BT = 234 * MiB, OFF_DTG = 242 * MiB;
constexpr size_t OFF_VST = 138 * MiB, OFF_VWT = 146 * MiB, OFF_VCT = 154 * MiB;
constexpr size_t OFF_XB = 186 * MiB, OFF_WIN = 218 * MiB;
constexpr size_t OFF_H1B = 90 * MiB, OFF_QP = 138 * MiB, OFF_EIDX = 202 * MiB, OFF_GW = 210 * MiB;
constexpr size_t OFF_PU = 26 * MiB, OFF_PV = 58 * MiB;
constexpr int LDS_BYTES = 147456;

struct Params {
    const float *x, *w_in, *conv_w, *conv_b, *dt_bias, *a_log, *d_skip, *ssd_norm_w;
    const float *cmp_pos_k, *cmp_w1_k, *cmp_w2_k, *cmp_pos_v, *cmp_w1_v, *cmp_w2_v;
    const float *attn_norm_w, *w_out, *ln1_g, *ln1_b, *peer_wq, *peer_keys, *peer_u, *peer_v, *ln2_g, *ln2_b;
    float* out; unsigned char* ws;
};

__device__ __forceinline__ float bf2f(bf16 v) { return __uint_as_float((unsigned)v << 16); }
__device__ __forceinline__ bf16 f2bf(float f) { unsigned u = __float_as_uint(f); return (bf16)((u + 0x7fffu + ((u >> 16) & 1u)) >> 16); }
__device__ __forceinline__ int lane_id() { int l = (int)__builtin_amdgcn_mbcnt_hi(~0u, __builtin_amdgcn_mbcnt_lo(~0u, 0u)); asm volatile("" : "+v"(l)); return l; }
#define PH_IDS() const int lane = lane_id(); const int tid = (wv << 6) | lane; const int bid = blockIdx.x, nb = gridDim.x; const int gtid = bid * NTHREADS + tid, gn = nb * NTHREADS; const int gwave = bid * NWAVES + wv, nwaves = nb * NWAVES; (void)gtid; (void)gn; (void)gwave; (void)nwaves;
typedef float f32x2v __attribute__((ext_vector_type(2)));
typedef __bf16 bf16x2v __attribute__((ext_vector_type(2)));
__device__ __forceinline__ unsigned pk2bf(float lo, float hi) { f32x2v v = {lo, hi}; bf16x2v b = __builtin_convertvector(v, bf16x2v); return __builtin_bit_cast(unsigned, b); }
__device__ __forceinline__ float wave_sum(float v) {
#pragma unroll
    for (int o = 1; o < 64; o <<= 1) v += __shfl_xor(v, o);
    return v;
}
__device__ __forceinline__ float wave_max(float v) {
#pragma unroll
    for (int o = 1; o < 64; o <<= 1) v = fmaxf(v, __shfl_xor(v, o));
    return v;
}
__device__ __forceinline__ float gelu_exact(float v) { return 0.5f * v * (1.0f + erff(v * 0.7071067811865476f)); }
__device__ __forceinline__ float sigmoidf(float v) { return 1.0f / (1.0f + __expf(-v)); }

template <class AP, class BP, class EP>
__device__ __forceinline__ void gemm_wave32(int wv, int Mt, int Nt, int K, const AP& ap, const BP& bp, const EP& ep) {
    PH_IDS(); const int r = lane & 15, q = lane >> 4;
    for (int tile = gwave; tile < Mt * Nt; tile += nwaves) {
        const int tm = tile / Nt, tn = tile % Nt, row0 = tm * 32, col0 = tn * 32;
        f32x4 acc[2][2];
#pragma unroll
        for (int i = 0; i < 2; ++i)
#pragma unroll
            for (int j = 0; j < 2; ++j) acc[i][j] = (f32x4){0.f, 0.f, 0.f, 0.f};
        for (int k0 = 0; k0 < K; k0 += 32) {
            const bf16x8 a0 = ap(row0 + r, k0 + 8 * q), a1 = ap(row0 + 16 + r, k0 + 8 * q);
            const bf16x8 b0 = bp(col0 + r, k0 + 8 * q), b1 = bp(col0 + 16 + r, k0 + 8 * q);
            acc[0][0] = __builtin_amdgcn_mfma_f32_16x16x32_bf16(a0, b0, acc[0][0], 0, 0, 0);
            acc[0][1] = __builtin_amdgcn_mfma_f32_16x16x32_bf16(a0, b1, acc[0][1], 0, 0, 0);
            acc[1][0] = __builtin_amdgcn_mfma_f32_16x16x32_bf16(a1, b0, acc[1][0], 0, 0, 0);
            acc[1][1] = __builtin_amdgcn_mfma_f32_16x16x32_bf16(a1, b1, acc[1][1], 0, 0, 0);
        }
#pragma unroll
        for (int i = 0; i < 2; ++i)
#pragma unroll
            for (int j = 0; j < 2; ++j)
#pragma unroll
                for (int e = 0; e < 4; ++e) ep(row0 + 16 * i + 4 * q + e, col0 + 16 * j + r, acc[i][j][e]);
    }
}
struct RowMajorBf16 { const bf16* p; int ld; __device__ __forceinline__ bf16x8 operator()(int row, int k) const { return *(const bf16x8*)(p + (size_t)row * ld + k); } };

namespace pg8 {
#define PG8_LAS __attribute__((address_space(3)))
typedef unsigned short bf16_t;
typedef short bf16x8 __attribute__((ext_vector_type(8)));
typedef float f32x4 __attribute__((ext_vector_type(4)));
typedef unsigned u32x4 __attribute__((ext_vector_type(4)));
constexpr int BM = 256, BK = 64, HALF = 128, HTB = HALF * BK * 2  , STAGE_BYTES = 8 * HTB, NXCD = 8, WGM = 8;

__host__ __device__ __forceinline__ int lds_byte(int r, int c) { const int st = (r >> 4) * 2 + (c >> 5), rr = r & 15, cc = c & 31, ob = rr * 64 + cc * 2; return st * 1024 + (ob ^ (((ob >> 9) & 1) << 5)); }
__host__ __device__ __forceinline__ void stage_rc(int b, int& R, int& C) { const int st = b / 1024, sb = b % 1024, swz = sb ^ (((sb >> 9) & 1) << 5); R = (st >> 1) * 16 + swz / 64; C = (st & 1) * 32 + (swz % 64) / 2; }
__host__ __device__ __forceinline__ int perm32(int rho) { const int n = rho >> 4, i = rho & 15; return 8 * (i >> 2) + 4 * n + (i & 3); }

struct Unit { int pm, pn; };
struct Gemm { const bf16_t* A; const bf16_t* Bt; int M, N, K; int lda; int amode; int ksplit; long kdelta; };

struct StaticOrder {
    int nM, nN, nwg, G, c;
    __host__ __device__ void init(int M, int N, int G_, int c_) { nM = M / BM; nN = N / BM; nwg = nM * nN; G = G_; c = c_; }
    __host__ __device__ bool next(int i, Unit& u) const {
        const long L = (long)i * G + c; if (L >= nwg) return false;
        int wgid = (int)L; { const int q = nwg / NXCD, r = nwg % NXCD, xcd = wgid % NXCD, off = wgid / NXCD; wgid = (xcd < r ? xcd * (q + 1) : r * (q + 1) + (xcd - r) * q) + off; }
        const int nig = WGM * nN, gid = wgid / nig, fm = gid * WGM, gsz = (nM - fm) < WGM ? (nM - fm) : WGM;
        u.pm = fm + ((wgid % nig) % gsz); u.pn = (wgid % nig) / gsz; return true;
    }
    __device__ __forceinline__ void a_ready(const Unit&) const {}
    __device__ __forceinline__ void done(const Unit&) const {}
};


__device__ __forceinline__ unsigned cvt_pk_bf16(float lo, float hi) { unsigned r; asm volatile("v_cvt_pk_bf16_f32 %0, %1, %2" : "=v"(r) : "v"(lo), "v"(hi)); return r; }
typedef float f32x2 __attribute__((ext_vector_type(2)));
__device__ __forceinline__ f32x2 gelu_pk(f32x2 v) {
    const f32x2 av = __builtin_elementwise_abs(v), d = av * 0.2316418882f + 1.0f;
    f32x2 t; t.x = __builtin_amdgcn_rcpf(d.x); t.y = __builtin_amdgcn_rcpf(d.y);
    f32x2 q = t * 0.5307027145f + (-0.7265760135f); q = q * t + 0.7107068705f; q = q * t + (-0.142248368f); q = q * t + 0.127414796f; q = q * t;
    const f32x2 s = (v * v) * (-0.72134752044f);
    f32x2 e; e.x = __builtin_amdgcn_exp2f(s.x); e.y = __builtin_amdgcn_exp2f(s.y);
    const f32x2 m = v * (q * e), r = v - m;
    f32x2 o; o.x = v.x < 0.f ? m.x : r.x; o.y = v.y < 0.f ? m.y : r.y; return o;
}

template <int ACT  > struct EpiBf16 {
    static constexpr bool PERM = true, AFTER_DRAIN = false; static_assert(ACT == 0 || ACT == 1, "EpiBf16: ACT is 0 (none) or 1 (gelu_pk)");
    bf16_t* O; int ldc; const float* bias; int split_cols; size_t split_stride; float scale0;
    __device__ __forceinline__ void operator()(const f32x4 (&acc)[2][2][4][2], const Unit& u, int wr, int wc, int fr, int fq) const {
        const int row0 = u.pm * BM + wr * 64 + fr; int colt = u.pn * BM; bf16_t* base = O;
        float sc = 1.f; if (split_cols) { const int t = colt / split_cols; base += (size_t)t * split_stride; colt -= t * split_cols; if (t == 0) sc = scale0; }
        const int col0 = colt + wc * 32 + 8 * fq, bcol0 = u.pn * BM + wc * 32 + 8 * fq;
        f32x4 bv[2][2];
#pragma unroll
        for (int bj = 0; bj < 2; ++bj)
#pragma unroll
            for (int n = 0; n < 2; ++n) bv[bj][n] = bias ? *(const f32x4*)(bias + bcol0 + bj * HALF + 4 * n) : (f32x4){0.f, 0.f, 0.f, 0.f};
#pragma unroll
        for (int ai = 0; ai < 2; ++ai)
#pragma unroll
            for (int m = 0; m < 4; ++m) { bf16_t* rowp = base + (size_t)(row0 + ai * HALF + m * 16) * ldc + col0;
#pragma unroll
                for (int bj = 0; bj < 2; ++bj) { f32x4 v0 = acc[ai][bj][m][0] + bv[bj][0], v1 = acc[ai][bj][m][1] + bv[bj][1];
                    if (ACT == 1) { f32x2 a = gelu_pk((f32x2){v0[0], v0[1]}), b = gelu_pk((f32x2){v0[2], v0[3]}), c = gelu_pk((f32x2){v1[0], v1[1]}), d = gelu_pk((f32x2){v1[2], v1[3]});
                        v0 = (f32x4){a.x, a.y, b.x, b.y}; v1 = (f32x4){c.x, c.y, d.x, d.y}; }
                    v0 = v0 * sc; v1 = v1 * sc; u32x4 w; w.x = cvt_pk_bf16(v0[0], v0[1]); w.y = cvt_pk_bf16(v0[2], v0[3]); w.z = cvt_pk_bf16(v1[0], v1[1]); w.w = cvt_pk_bf16(v1[2], v1[3]);
                    *(u32x4*)(rowp + bj * HALF) = w; } }
    }
};

struct EpiInProjPg { static constexpr bool PERM = true, AFTER_DRAIN = false;
    bf16_t *z, *xbc, *q, *kvs, *dtg;
    __device__ __forceinline__ void operator()(const f32x4 (&acc)[2][2][4][2], const Unit& u, int wr, int wc, int fr, int fq) const {
        bf16_t* base; int ldc, colt; const int pn = u.pn;
        if (pn < 4) { base = z; ldc = 1024; colt = pn * 256; } else if (pn < 10) { base = xbc; ldc = 1536; colt = (pn - 4) * 256; }
        else if (pn < 14) { base = q; ldc = 1024; colt = (pn - 10) * 256; } else if (pn < 20) { base = kvs; ldc = 1536; colt = (pn - 14) * 256; }
        else { base = dtg; ldc = 64; colt = 0; }
        const int row0 = u.pm * BM + wr * 64 + fr, col0 = colt + wc * 32 + 8 * fq;
#pragma unroll
        for (int ai = 0; ai < 2; ++ai)
#pragma unroll
            for (int m = 0; m < 4; ++m) { bf16_t* rowp = base + (size_t)(row0 + ai * HALF + m * 16) * ldc + col0;
#pragma unroll
                for (int bj = 0; bj < 2; ++bj) { const f32x4 v0 = acc[ai][bj][m][0], v1 = acc[ai][bj][m][1];
                    u32x4 w; w.x = cvt_pk_bf16(v0[0], v0[1]); w.y = cvt_pk_bf16(v0[2], v0[3]); w.z = cvt_pk_bf16(v1[0], v1[1]); w.w = cvt_pk_bf16(v1[2], v1[3]);
                    if (pn < 20 || (bj == 0 && wc < 2)) *(u32x4*)(rowp + bj * HALF) = w; } }
    }
};
struct RmsFactors { const float* ssqp; const float* ssq2p; float eps;
    __device__ __forceinline__ void get(int row, float& ra, float& r0, float& r1) const {
        const f32x4 a = *(const f32x4*)(ssqp + 4 * row); const f32x4 b0 = *(const f32x4*)(ssq2p + 16 * row), b1 = *(const f32x4*)(ssq2p + 16 * row + 4), b2 = *(const f32x4*)(ssq2p + 16 * row + 8), b3 = *(const f32x4*)(ssq2p + 16 * row + 12);
        ra = rsqrtf(((a[0] + a[1]) + (a[2] + a[3])) * (1.0f / 1024.0f) + eps);
        r0 = rsqrtf((((b0[0] + b0[1]) + (b0[2] + b0[3])) + ((b1[0] + b1[1]) + (b1[2] + b1[3]))) * (1.0f / 512.0f) + eps);
        r1 = rsqrtf((((b2[0] + b2[1]) + (b2[2] + b2[3])) + ((b3[0] + b3[1]) + (b3[2] + b3[3]))) * (1.0f / 512.0f) + eps); } };
struct EpiOutProj { static constexpr bool PERM = false, AFTER_DRAIN = false;
    const float* x; float* out; float alpha; RmsFactors rf;
    __device__ __forceinline__ void operator()(const f32x4 (&acc)[2][2][4][2], const Unit& u, int wr, int wc, int fr, int fq) const {
        const int col0 = u.pn * BM + wc * 32 + 4 * fq;
#pragma unroll
        for (int ai = 0; ai < 2; ++ai)
#pragma unroll
            for (int m = 0; m < 4; ++m) { const int row = u.pm * BM + ai * HALF + wr * 64 + m * 16 + fr; const size_t off = (size_t)row * 1024 + col0;
                float ra, r0, r1; rf.get(row, ra, r0, r1);
#pragma unroll
                for (int bj = 0; bj < 2; ++bj)
#pragma unroll
                    for (int n = 0; n < 2; ++n) { const size_t o = off + bj * HALF + n * 16; const f32x4 xv = *(const f32x4*)(x + o); *(f32x4*)(out + o) = xv * alpha + acc[ai][bj][m][n] * r1; } }
    }
};
struct MidRmsScale { static constexpr bool ENABLED = true; RmsFactors rf;
    __device__ __forceinline__ void operator()(f32x4 (&acc)[2][2][4][2], const Unit& u, int t, int wr, int wc, int fr, int fq) const {
        if (t != 16 && t != 24) return;
        int rowb = u.pm * BM + wr * 64 + fr; asm volatile("" : "+v"(rowb));
#pragma unroll
        for (int ai = 0; ai < 2; ++ai)
#pragma unroll
            for (int m = 0; m < 4; ++m) { float ra, r0, r1; rf.get(rowb + ai * HALF + m * 16, ra, r0, r1);
                const float sc = (t == 16) ? ra / r0 : r0 / r1;
#pragma unroll
                for (int bj = 0; bj < 2; ++bj)
#pragma unroll
                    for (int n = 0; n < 2; ++n) acc[ai][bj][m][n] = acc[ai][bj][m][n] * sc; }
    }
};
struct NoMid { static constexpr bool ENABLED = false; template <class ACC> __device__ __forceinline__ void operator()(ACC&, const Unit&, int, int, int, int, int) const {} };
template <class Epi, class Sched, class Mid, bool ALIGN_EPI = false, bool SP2 = false>
__device__ __forceinline__ void gemm_phase(int wv, PG8_LAS unsigned char* lds, const Gemm g, const Sched& S, const Epi& E, const Mid& MH) {
    int lane_ = (int)__builtin_amdgcn_mbcnt_hi(~0u, __builtin_amdgcn_mbcnt_lo(~0u, 0u)); asm volatile("" : "+v"(lane_));
    const int lane = lane_, wid = wv, tid = (wv << 6) | lane, wr = wid >> 2, wc = wid & 3, fr = lane & 15, fq = lane >> 4;
    const int K = g.K, nt = K / BK;
    unsigned voffA[2], voffB[2];
#pragma unroll
    for (int i = 0; i < 2; ++i) { int R, C; stage_rc(tid * 16 + i * 8192, R, C); const int Rb = Epi::PERM ? ((R & ~31) + perm32(R & 31)) : R;
        voffA[i] = g.amode == 0 ? (unsigned)(R * g.lda + C) * 2u : (unsigned)((R >> 2) * 49152 + (R & 3) * 128 + C * 2); voffB[i] = (unsigned)(Rb * K + C) * 2u; }
    const size_t kstep = (size_t)(BK * 2);
    const size_t hstep = (size_t)HALF * K * 2;
    const size_t tstep = 2 * hstep;
    const size_t kstepA = g.amode == 0 ? (size_t)(BK * 2) : (size_t)3072;
    const size_t hstepA = g.amode == 0 ? (size_t)HALF * g.lda * 2 : (size_t)32 * 49152;
    const size_t tstepA = 2 * hstepA;
#define PG8_AK(base, t) ((base) + (size_t)(t) * kstepA + (((t) >= g.ksplit) ? g.kdelta : 0l))
    const unsigned ldsw = (unsigned)wid * 1024u;
    const int aoff = lds_byte(wr * 64 + fr, fq * 8), boff = lds_byte(wc * 32 + fr, fq * 8);
#define PG8_SA(b, h) (((b) * 2 + (h)) * HTB)
#define PG8_SB(b, h) ((4 + (b) * 2 + (h)) * HTB)
#define PG8_STAGE(bufoff, gbase, voff) do { _Pragma("unroll") for (int _i = 0; _i < 2; ++_i) \
        __builtin_amdgcn_global_load_lds((const unsigned*)((const char*)(gbase) + (voff)[_i]), (PG8_LAS unsigned*)(lds + (bufoff) + ldsw + _i * 8192), 16, 0, 0); } while (0)
#define PG8_LDA(dst, b, h) do { _Pragma("unroll") for (int m = 0; m < 4; ++m) _Pragma("unroll") for (int k = 0; k < 2; ++k) dst[m][k] = *(const PG8_LAS bf16x8*)(lds + PG8_SA(b, h) + aoff + m * 2048 + k * 1024); } while (0)
#define PG8_LDB(dst, b, h) do { _Pragma("unroll") for (int n = 0; n < 2; ++n) _Pragma("unroll") for (int k = 0; k < 2; ++k) dst[n][k] = *(const PG8_LAS bf16x8*)(lds + PG8_SB(b, h) + boff + n * 2048 + k * 1024); } while (0)
#define PG8_MMA(ai, bj, At, Bt) do { __builtin_amdgcn_s_setprio(1); _Pragma("unroll") for (int m = 0; m < 4; ++m) _Pragma("unroll") for (int n = 0; n < 2; ++n) _Pragma("unroll") for (int k = 0; k < 2; ++k) \
        acc[ai][bj][m][n] = __builtin_amdgcn_mfma_f32_16x16x32_bf16(Bt[n][k], At[m][k], acc[ai][bj][m][n], 0, 0, 0); __builtin_amdgcn_s_setprio(0); } while (0)
#define PG8_WAIT_V(n) asm volatile("s_waitcnt vmcnt(" #n ")" ::: "memory")
#define PG8_WAIT_L(n) asm volatile("s_waitcnt lgkmcnt(" #n ")" ::: "memory")
#define PG8_BAR __builtin_amdgcn_s_barrier()
#define PG8_SCHED __builtin_amdgcn_sched_barrier(0)
    Unit cur, nxt; int ui = 0;
    if (!S.next(0, cur)) return;
    f32x4 acc[2][2][4][2];
#pragma unroll
    for (int a = 0; a < 2; ++a)
#pragma unroll
        for (int b = 0; b < 2; ++b)
#pragma unroll
            for (int m = 0; m < 4; ++m)
#pragma unroll
                for (int n = 0; n < 2; ++n) acc[a][b][m][n] = (f32x4){0.f, 0.f, 0.f, 0.f};
    bf16x8 At[4][2], B0[2][2], B1[2][2];
    const char* cA = (const char*)g.A + (size_t)cur.pm * tstepA; const char* cB = (const char*)g.Bt + (size_t)cur.pn * tstep;
    S.a_ready(cur);
    if constexpr (SP2) {
        PG8_STAGE(PG8_SB(0, 0), cB, voffB); PG8_STAGE(PG8_SB(0, 1), cB + hstep, voffB); PG8_STAGE(PG8_SA(0, 0), cA, voffA); PG8_STAGE(PG8_SA(0, 1), cA + hstepA, voffA);
        if (wr == 1) PG8_BAR;
        PG8_WAIT_V(2); PG8_BAR;
        PG8_STAGE(PG8_SB(1, 0), cB + kstep, voffB); PG8_STAGE(PG8_SA(1, 0), PG8_AK(cA, 1), voffA); PG8_STAGE(PG8_SB(1, 1), cB + hstep + kstep, voffB);
        PG8_WAIT_V(6); PG8_BAR;
    } else {
        PG8_STAGE(PG8_SB(0, 0), cB, voffB); PG8_STAGE(PG8_SA(0, 0), cA, voffA); PG8_STAGE(PG8_SB(0, 1), cB + hstep, voffB); PG8_STAGE(PG8_SA(0, 1), cA + hstepA, voffA);
        if (wr == 1) PG8_BAR;
        PG8_WAIT_V(4); PG8_BAR;
        PG8_STAGE(PG8_SB(1, 0), cB + kstep, voffB); PG8_STAGE(PG8_SA(1, 0), PG8_AK(cA, 1), voffA); PG8_STAGE(PG8_SB(1, 1), cB + hstep + kstep, voffB);
        PG8_WAIT_V(6); PG8_BAR;
    }
    for (;;) {
        const bool has_next = S.next(ui + 1, nxt);
        const char* nA = has_next ? (const char*)g.A + (size_t)nxt.pm * tstepA : cA; const char* nB = has_next ? (const char*)g.Bt + (size_t)nxt.pn * tstep : cB;
        for (int t = 0; t < nt; t += 2) {
            const bool last = (t == nt - 2);
            if (Mid::ENABLED) MH(acc, cur, t, wr, wc, fr, fq);
            const char* a1 = PG8_AK(cA, t + 1);
            const char* a2 = last ? nA : PG8_AK(cA, t + 2); const char* b2 = last ? nB : cB + (size_t)(t + 2) * kstep;
            const char* a3 = a2 + kstepA; const char* b3 = b2 + kstep;
            if (last && has_next) S.a_ready(nxt);
            if constexpr (SP2) {
            PG8_LDB(B0, 0, 0); PG8_LDB(B1, 0, 1); PG8_SCHED; PG8_LDA(At, 0, 0); PG8_STAGE(PG8_SA(1, 1), a1 + hstepA, voffA);
            PG8_WAIT_V(8); PG8_WAIT_L(0); PG8_BAR; PG8_MMA(0, 0, At, B0); PG8_MMA(0, 1, At, B1); PG8_BAR; PG8_SCHED;
            PG8_LDA(At, 0, 1); PG8_STAGE(PG8_SB(0, 0), b2, voffB); PG8_STAGE(PG8_SB(0, 1), b2 + hstep, voffB); PG8_STAGE(PG8_SA(0, 0), a2, voffA);
            PG8_WAIT_V(8); PG8_WAIT_L(0); PG8_BAR; PG8_MMA(1, 0, At, B0); PG8_MMA(1, 1, At, B1); PG8_BAR; PG8_SCHED;
            PG8_LDB(B0, 1, 0); PG8_LDB(B1, 1, 1); PG8_SCHED; PG8_LDA(At, 1, 0); PG8_STAGE(PG8_SA(0, 1), a2 + hstepA, voffA);
            PG8_WAIT_V(8); PG8_WAIT_L(0); PG8_BAR; PG8_MMA(0, 0, At, B0); PG8_MMA(0, 1, At, B1); PG8_BAR; PG8_SCHED;
            PG8_LDA(At, 1, 1); PG8_STAGE(PG8_SB(1, 0), b3, voffB); PG8_STAGE(PG8_SB(1, 1), b3 + hstep, voffB); PG8_STAGE(PG8_SA(1, 0), a3, voffA);
            PG8_WAIT_V(8); PG8_WAIT_L(0); PG8_BAR; PG8_MMA(1, 0, At, B0); PG8_MMA(1, 1, At, B1); PG8_BAR; PG8_SCHED;
            } else {
            PG8_LDB(B0, 0, 0); PG8_SCHED; PG8_LDA(At, 0, 0); PG8_STAGE(PG8_SA(1, 1), a1 + hstepA, voffA);
            PG8_WAIT_L(8); PG8_BAR; PG8_WAIT_L(0); PG8_MMA(0, 0, At, B0); PG8_BAR; PG8_SCHED;
            PG8_LDB(B1, 0, 1); PG8_STAGE(PG8_SB(0, 0), b2, voffB);
            PG8_BAR; PG8_WAIT_L(0); PG8_MMA(0, 1, At, B1); PG8_BAR;
            PG8_LDA(At, 0, 1); PG8_STAGE(PG8_SA(0, 0), a2, voffA);
            PG8_BAR; PG8_WAIT_L(0); PG8_MMA(1, 0, At, B0); PG8_BAR; PG8_SCHED;
            PG8_STAGE(PG8_SB(0, 1), b2 + hstep, voffB);
            PG8_WAIT_V(6); PG8_BAR; PG8_MMA(1, 1, At, B1); PG8_BAR;
            PG8_LDB(B0, 1, 0); PG8_SCHED; PG8_LDA(At, 1, 0); PG8_STAGE(PG8_SA(0, 1), a2 + hstepA, voffA);
            PG8_WAIT_L(8); PG8_BAR; PG8_WAIT_L(0); PG8_MMA(0, 0, At, B0); PG8_BAR; PG8_SCHED;
            PG8_LDB(B1, 1, 1); PG8_STAGE(PG8_SB(1, 0), b3, voffB);
            PG8_BAR; PG8_WAIT_L(0); PG8_MMA(0, 1, At, B1); PG8_BAR;
            PG8_LDA(At, 1, 1); PG8_STAGE(PG8_SA(1, 0), a3, voffA);
            PG8_BAR; PG8_WAIT_L(0); PG8_MMA(1, 0, At, B0); PG8_BAR; PG8_SCHED;
            PG8_STAGE(PG8_SB(1, 1), b3 + hstep, voffB);
            PG8_WAIT_V(6); PG8_BAR; PG8_MMA(1, 1, At, B1); PG8_BAR;
            }
        }
        if constexpr (ALIGN_EPI) { if (wr == 0) PG8_BAR; }
        if constexpr (!Epi::AFTER_DRAIN) { E(acc, cur, wr, wc, fr, fq); S.done(cur); }
        if (!has_next) break;
#pragma unroll
        for (int a = 0; a < 2; ++a)
#pragma unroll
            for (int b = 0; b < 2; ++b)
#pragma unroll
                for (int m = 0; m < 4; ++m)
#pragma unroll
                    for (int n = 0; n < 2; ++n) acc[a][b][m][n] = (f32x4){0.f, 0.f, 0.f, 0.f};
        cur = nxt; cA = nA; cB = nB; ++ui;
        if constexpr (ALIGN_EPI) { if (wr == 1) PG8_BAR; }
    }
    PG8_WAIT_V(0);
    if constexpr (!ALIGN_EPI) { if (wr == 0) PG8_BAR; }
    PG8_BAR;
    if constexpr (Epi::AFTER_DRAIN) { E.fused(acc, cur, wr, wc, fr, fq, lds, wid, lane); S.done(cur); }
#undef PG8_AK
#undef PG8_SA
#undef PG8_SB
#undef PG8_STAGE
#undef PG8_LDA
#undef PG8_LDB
#undef PG8_MMA
#undef PG8_WAIT_V
#undef PG8_WAIT_L
#undef PG8_BAR
#undef PG8_SCHED
}
}

__device__ __forceinline__ int winmap(int n) { return n < 2560 ? n : (n < 5120 ? n + 16 : (n < 5136 ? 2560 + (n - 5120) : n)); }
template <class Map>
__device__ __forceinline__ void transpose_item(const float* W, int ldw, bf16* WT, int K, int item, int nblk, float* scr, int lane, const Map& mp) {
    const int kb = item / nblk, nbk = item % nblk, k0 = 64 * kb, n0 = 32 * nbk;
    const int col = mp.scol(n0 + (lane & 31));
#pragma unroll 8
    for (int i = 0; i < 32; ++i) { const int kk = 2 * i + (lane >> 5); scr[kk * 33 + (lane & 31)] = col >= 0 ? W[(size_t)mp.srow(k0 + kk) * ldw + col] * mp.scale(k0 + kk) : 0.f; }
    const int c = lane & 7;
#pragma unroll
    for (int j = 0; j < 4; ++j) { const int n = (lane >> 3) + 8 * j; const float* s = scr + (8 * c) * 33 + n;
        *(uint4*)(WT + (size_t)(n0 + n) * K + k0 + 8 * c) = make_uint4(pk2bf(s[0], s[33]), pk2bf(s[66], s[99]), pk2bf(s[132], s[165]), pk2bf(s[198], s[231])); }
}
struct MapPlain { __device__ __forceinline__ int srow(int k) const { return k; } __device__ __forceinline__ int scol(int n) const { return n; } __device__ __forceinline__ float scale(int) const { return 1.f; } };
struct MapWin { __device__ __forceinline__ int srow(int k) const { return k; } __device__ __forceinline__ int scol(int n) const { return n < NPROJ ? winmap(n) : -1; } __device__ __forceinline__ float scale(int) const { return 1.f; } };
struct MapWout { const float* an; const float* sn;
    __device__ __forceinline__ int srow(int k) const { return (k + 1024) & 2047; } __device__ __forceinline__ int scol(int n) const { return n; } __device__ __forceinline__ float scale(int k) const { return k < 1024 ? an[k] : sn[k - 1024]; } };
__device__ __forceinline__ void ph_prep(const Params& p, int wv, unsigned char* lds) {
    PH_IDS(); unsigned char* ws = p.ws;
    bf16* xb = (bf16*)(ws + OFF_XB);
    for (size_t i = gtid; i < (size_t)T * D / 8; i += gn) { const float4 v = ((const float4*)p.x)[2 * i], w = ((const float4*)p.x)[2 * i + 1]; ((uint4*)xb)[i] = make_uint4(pk2bf(v.x, v.y), pk2bf(v.z, v.w), pk2bf(w.x, w.y), pk2bf(w.z, w.w)); }
    {
        float* scr = (float*)(lds + wv * 8448);
        constexpr int I_WIN = 16 * 168, I_WOUT = 32 * 32, I_WQ = 16 * 64, I_W1 = 32 * 8, I_W2 = 4 * 2;
        constexpr int NIT = I_WIN + I_WOUT + I_WQ + 2 * I_W1 + 2 * I_W2;
        for (int it = gwave; it < NIT; it += nwaves) {
            int r = it;
            if (r < I_WIN) { transpose_item(p.w_in, NPROJ, (bf16*)(ws + OFF_WIN), 1024, r, 168, scr, lane, MapWin{}); continue; } r -= I_WIN;
            if (r < I_WOUT) { transpose_item(p.w_out, 1024, (bf16*)(ws + OFF_WOUT), 2048, r, 32, scr, lane, MapWout{p.attn_norm_w, p.ssd_norm_w}); continue; } r -= I_WOUT;
            if (r < I_WQ) { transpose_item(p.peer_wq, 2048, (bf16*)(ws + OFF_WQ), 1024, r, 64, scr, lane, MapPlain{}); continue; } r -= I_WQ;
            if (r < I_W1) { transpose_item(p.cmp_w1_k, 256, (bf16*)(ws + OFF_W1K), 2048, r, 8, scr, lane, MapPlain{}); continue; } r -= I_W1;
            if (r < I_W1) { transpose_item(p.cmp_w1_v, 256, (bf16*)(ws + OFF_W1V), 2048, r, 8, scr, lane, MapPlain{}); continue; } r -= I_W1;
            if (r < I_W2) { transpose_item(p.cmp_w2_k, 64, (bf16*)(ws + OFF_W2K), 256, r, 2, scr, lane, MapPlain{}); continue; } r -= I_W2;
            transpose_item(p.cmp_w2_v, 64, (bf16*)(ws + OFF_W2V), 256, r, 2, scr, lane, MapPlain{});
        }
    }
    bf16* keys = (bf16*)(ws + OFF_KEYS);
    for (int i = gtid; i < 8 * 2 * 128 * 128; i += gn) keys[i] = f2bf(p.peer_keys[i]);
    float* rc = (float*)(ws + OFF_ROPE); float* rs = rc + 4096 * 32;
    for (int i = gtid; i < 4096 * 32; i += gn) {
        const int pos = i >> 5, j = i & 31;
        const float inv = powf(10000.0f, -(float)(2 * j) / 64.0f); const float angf = (float)pos * inv;
        double xr = (double)angf * 0.15915494309189535; xr -= rint(xr); const double rr = xr * 6.283185307179586, r2 = rr * rr;
        double s = 0.0, c = 0.0, ts = rr, tc = 1.0;
        for (int k = 0; k < 14; ++k) { s += ts; c += tc; tc = -tc * r2 / (double)((2 * k + 1) * (2 * k + 2)); ts = -ts * r2 / (double)((2 * k + 2) * (2 * k + 3)); }
        rc[i] = (float)c; rs[i] = (float)s;
    }
    float* b1k = (float*)(ws + OFF_B1K); float* b1v = (float*)(ws + OFF_B1V);
    for (int o = gwave; o < 512; o += nwaves) {
        const int j = o & 255; const float* pos = o < 256 ? p.cmp_pos_k : p.cmp_pos_v; const float* w1 = o < 256 ? p.cmp_w1_k : p.cmp_w1_v;
        float s = 0.f; for (int k = lane; k < 2048; k += 64) s += pos[k] * w1[(size_t)k * 256 + j];
        s = wave_sum(s); if (lane == 0) (o < 256 ? b1k : b1v)[j] = s;
    }
}

struct EpiInProj {
    bf16 *z, *xbc, *q, *kvs, *dtg;
    __device__ __forceinline__ void operator()(int row, int c, float v) const {
        const bf16 b = f2bf(v);
        if (c < 1024) z[(size_t)row * 1024 + c] = b;
        else if (c < 2560) xbc[(size_t)row * 1536 + (c - 1024)] = b;
        else if (c < 3584) q[(size_t)row * 1024 + (c - 2560)] = b;
        else if (c < 5120) kvs[(size_t)row * 1536 + (c - 3584)] = b;
        else if (c < 5184) dtg[(size_t)row * 64 + (c - 5120)] = b;
    }
};

__device__ __forceinline__ void unpack8(const uint4& w, float* f) { f[0] = __uint_as_float(w.x << 16); f[1] = __uint_as_float(w.x & 0xffff0000u); f[2] = __uint_as_float(w.y << 16); f[3] = __uint_as_float(w.y & 0xffff0000u);
    f[4] = __uint_as_float(w.z << 16); f[5] = __uint_as_float(w.z & 0xffff0000u); f[6] = __uint_as_float(w.w << 16); f[7] = __uint_as_float(w.w & 0xffff0000u); }
__device__ __forceinline__ uint4 pack8(const float* f) { return make_uint4(pk2bf(f[0], f[1]), pk2bf(f[2], f[3]), pk2bf(f[4], f[5]), pk2bf(f[6], f[7])); }
__device__ __forceinline__ void ph_tokprep(const Params& p, int wv) {
    PH_IDS(); unsigned char* ws = p.ws;
    const bf16* xbc = (const bf16*)(ws + OFF_XBC); bf16* xsbc = (bf16*)(ws + OFF_XSBC);
    for (int it = gtid; it < (T / 16) * 192; it += gn) {
        const int cg = it % 192, tg = it / 192, ch = cg * 8, t0 = tg * 16, l0 = t0 & (L - 1);
        float w[4][8], bias[8];
#pragma unroll
        for (int j = 0; j < 4; ++j) { const float4 a = *(const float4*)(p.conv_w + j * 1536 + ch), b2 = *(const float4*)(p.conv_w + j * 1536 + ch + 4); w[j][0] = a.x; w[j][1] = a.y; w[j][2] = a.z; w[j][3] = a.w; w[j][4] = b2.x; w[j][5] = b2.y; w[j][6] = b2.z; w[j][7] = b2.w; }
        { const float4 a = *(const float4*)(p.conv_b + ch), b2 = *(const float4*)(p.conv_b + ch + 4); bias[0] = a.x; bias[1] = a.y; bias[2] = a.z; bias[3] = a.w; bias[4] = b2.x; bias[5] = b2.y; bias[6] = b2.z; bias[7] = b2.w; }
        float x0[8], x1[8], x2[8], x3[8];
        { uint4 h0 = make_uint4(0u, 0u, 0u, 0u), h1 = h0, h2 = h0;
          if (l0 != 0) { h0 = *(const uint4*)(xbc + (size_t)(t0 - 3) * 1536 + ch); h1 = *(const uint4*)(xbc + (size_t)(t0 - 2) * 1536 + ch); h2 = *(const uint4*)(xbc + (size_t)(t0 - 1) * 1536 + ch); }
          unpack8(h0, x0); unpack8(h1, x1); unpack8(h2, x2); }
#pragma unroll
        for (int u = 0; u < 16; ++u) {
            unpack8(*(const uint4*)(xbc + (size_t)(t0 + u) * 1536 + ch), x3);
            float y[8];
#pragma unroll
            for (int i = 0; i < 8; ++i) { const float v = bias[i] + w[0][i] * x0[i] + w[1][i] * x1[i] + w[2][i] * x2[i] + w[3][i] * x3[i]; y[i] = v * sigmoidf(v); x0[i] = x1[i]; x1[i] = x2[i]; x2[i] = x3[i]; }
            *(uint4*)(xsbc + (size_t)(t0 + u) * 1536 + ch) = pack8(y);
        }
    }
    const bf16* dtg = (const bf16*)(ws + OFF_DTG); float* dt = (float*)(ws + OFF_DT); float* gate = (float*)(ws + OFF_GATE);
    for (int i = gtid; i < T * 64; i += gn) {
        const int t = i >> 6, c = i & 63; const float v = bf2f(dtg[i]);
        if (c < 16) { const float xx = v + p.dt_bias[c]; dt[t * 16 + c] = xx > 20.f ? xx : log1pf(__expf(xx)); }
        else gate[t * 48 + (c - 16)] = sigmoidf(v);
    }
    const float* rc = (const float*)(ws + OFF_ROPE); const float* rs = rc + 4096 * 32;
    bf16* q = (bf16*)(ws + OFF_Q); bf16* kvs = (bf16*)(ws + OFF_KVS);
    for (int it = gtid; it < T * 24 * 4; it += gn) {
        const int j0 = (it & 3) * 8, hh = (it >> 2) % 24, t = it / 96, l = t & (L - 1);
        bf16* pp; float sc;
        if (hh < 16) { pp = q + (size_t)t * 1024 + hh * 64 + j0; sc = 0.125f * 1.4426950408889634f; } else if (hh < 20) { pp = kvs + (size_t)t * 1536 + 512 + (hh - 16) * 64 + j0; sc = 1.f; } else { pp = kvs + (size_t)t * 1536 + 1024 + (hh - 20) * 64 + j0; sc = 1.f; }
        float x1[8], x2[8], c[8], s[8], o1[8], o2[8];
        unpack8(*(const uint4*)pp, x1); unpack8(*(const uint4*)(pp + 32), x2);
        { const float4 a = *(const float4*)(rc + l * 32 + j0), b2 = *(const float4*)(rc + l * 32 + j0 + 4), d = *(const float4*)(rs + l * 32 + j0), e = *(const float4*)(rs + l * 32 + j0 + 4);
          c[0] = a.x; c[1] = a.y; c[2] = a.z; c[3] = a.w; c[4] = b2.x; c[5] = b2.y; c[6] = b2.z; c[7] = b2.w; s[0] = d.x; s[1] = d.y; s[2] = d.z; s[3] = d.w; s[4] = e.x; s[5] = e.y; s[6] = e.z; s[7] = e.w; }
#pragma unroll
        for (int i = 0; i < 8; ++i) { o1[i] = (x1[i] * c[i] - x2[i] * s[i]) * sc; o2[i] = (x1[i] * s[i] + x2[i] * c[i]) * sc; }
        *(uint4*)pp = pack8(o1); *(uint4*)(pp + 32) = pack8(o2);
    }
}

__device__ __forceinline__ void ph_ssd_prep2(const Params& p, int wv, unsigned char* lds) {
    PH_IDS(); unsigned char* ws = p.ws;
    const bf16* xsbc = (const bf16*)(ws + OFF_XSBC); const float* dt = (const float*)(ws + OFF_DT);
    bf16* XdT = (bf16*)p.out; bf16* BT = (bf16*)(ws + OFF_BT); float* acsT = (float*)(ws + OFF_ACS);
    float* sdt = (float*)lds; float* swave = sdt + 128;
    const int bide = nb > 64 ? bid - 32 : bid, nbe = nb > 64 ? nb - 32 : nb; if (bide < 0) return;
    for (int unit = bide; unit < 2048 + 256; unit += nbe) {
        __syncthreads();
        if (unit < 2048) {
            const int h = unit & 15, bc = unit >> 4; const size_t t0 = (size_t)bc * 128;
            const float A = -__expf(p.a_log[h]);
            if (tid < 128) { const float dv = dt[(t0 + tid) * 16 + h]; sdt[tid] = dv; float a = dv * A;
#pragma unroll
                for (int o = 1; o < 64; o <<= 1) { const float v = __shfl_up(a, o); if (lane >= o) a += v; }
                if (lane == 63) swave[tid >> 6] = a;
                sdt[128 + 8 + tid] = a; }
            __syncthreads();
            if (tid < 128) { float a = sdt[128 + 8 + tid]; if (tid >= 64) a += swave[0]; acsT[(size_t)unit * 128 + tid] = a; }
            const int pp = tid & 63, lg = tid >> 6; const bf16* src = xsbc + (t0 + lg * 16) * 1536 + h * 64 + pp;
            unsigned w[8];
#pragma unroll
            for (int i = 0; i < 8; ++i) { const float v0 = bf2f(src[(size_t)(2 * i) * 1536]) * sdt[lg * 16 + 2 * i], v1 = bf2f(src[(size_t)(2 * i + 1) * 1536]) * sdt[lg * 16 + 2 * i + 1]; w[i] = (unsigned)f2bf(v0) | ((unsigned)f2bf(v1) << 16); }
            uint4* dst = (uint4*)(XdT + (size_t)unit * 8192 + pp * 128 + lg * 16);
            dst[0] = make_uint4(w[0], w[1], w[2], w[3]); dst[1] = make_uint4(w[4], w[5], w[6], w[7]);
        } else {
            const int u2 = unit - 2048, g = u2 & 1, bc = u2 >> 1; const size_t t0 = (size_t)bc * 128;
            const int n = tid & 127, lg = tid >> 7; const bf16* src = xsbc + (t0 + lg * 32) * 1536 + 1024 + g * 128 + n;
            uint4* dst = (uint4*)(BT + (size_t)u2 * 16384 + n * 128 + lg * 32);
#pragma unroll
            for (int k = 0; k < 4; ++k) { unsigned w[4];
#pragma unroll
                for (int i = 0; i < 4; ++i) w[i] = (unsigned)src[(size_t)(8 * k + 2 * i) * 1536] | ((unsigned)src[(size_t)(8 * k + 2 * i + 1) * 1536] << 16);
                dst[k] = make_uint4(w[0], w[1], w[2], w[3]); }
        }
    }
}
__device__ __forceinline__ bf16x8 scale_frag(bf16x8 a, const float* s) {
    bf16x8 o;
#pragma unroll
    for (int j = 0; j < 8; ++j) o[j] = (short)f2bf(bf2f((bf16)a[j]) * s[j]);
    return o;
}
__device__ __forceinline__ void ph_ssd_states(const Params& p, int wv) {
    PH_IDS(); unsigned char* ws = p.ws; const int r = lane & 15, q = lane >> 4;
    const bf16* XdT = (const bf16*)p.out; bf16* S = (bf16*)((unsigned char*)p.out + 32 * MiB); const bf16* BT = (const bf16*)(ws + OFF_BT); const float* acsT = (const float*)(ws + OFF_ACS);
    for (int task = gwave; task < 8192; task += nwaves) {
        const int pt = task & 3, unit = task >> 2, h = unit & 15, bc = unit >> 4, g = h >> 3;
        const float* ac = acsT + (size_t)unit * 128; const float alast = ac[127];
        const bf16* xrow = XdT + (size_t)unit * 8192 + (pt * 16 + r) * 128; const bf16* bt = BT + (size_t)(bc * 2 + g) * 16384 + r * 128;
        f32x4 acc[8];
#pragma unroll
        for (int i = 0; i < 8; ++i) acc[i] = (f32x4){0.f, 0.f, 0.f, 0.f};
#pragma unroll
        for (int ks = 0; ks < 4; ++ks) {
            const int l0 = ks * 32 + 8 * q; float dec[8];
#pragma unroll
            for (int j = 0; j < 8; ++j) dec[j] = __expf(alast - ac[l0 + j]);
            const bf16x8 af = scale_frag(*(const bf16x8*)(xrow + l0), dec);
#pragma unroll
            for (int nt = 0; nt < 8; ++nt) acc[nt] = __builtin_amdgcn_mfma_f32_16x16x32_bf16(af, *(const bf16x8*)(bt + (size_t)nt * 2048 + l0), acc[nt], 0, 0, 0);
        }
        bf16* so = S + (size_t)unit * 8192 + (pt * 16 + 4 * q) * 128 + r;
#pragma unroll
        for (int nt = 0; nt < 8; ++nt)
#pragma unroll
            for (int e = 0; e < 4; ++e) so[e * 128 + nt * 16] = f2bf(acc[nt][e]);
    }
}
__device__ __forceinline__ void ph_ssd_scan(const Params& p, int wv) {
    PH_IDS();
    unsigned* S = (unsigned*)((unsigned char*)p.out + 32 * MiB); const float* acsT = (const float*)(p.ws + OFF_ACS);
    for (int e = gtid; e < NBATCH * 16 * 4096; e += gn) {
        const int pn = e & 4095, h = (e >> 12) & 15, b = e >> 16; float r0 = 0.f, r1 = 0.f;
        for (int c = 0; c < 32; c += 4) {
            unsigned v[4]; float d[4];
#pragma unroll
            for (int u = 0; u < 4; ++u) { const int unit = (b * 32 + c + u) * 16 + h; v[u] = S[(size_t)unit * 4096 + pn]; d[u] = __expf(acsT[(size_t)unit * 128 + 127]); }
#pragma unroll
            for (int u = 0; u < 4; ++u) { const int unit = (b * 32 + c + u) * 16 + h; S[(size_t)unit * 4096 + pn] = (unsigned)f2bf(r0) | ((unsigned)f2bf(r1) << 16);
                r0 = r0 * d[u] + bf2f((bf16)(v[u] & 0xffffu)); r1 = r1 * d[u] + bf2f((bf16)(v[u] >> 16)); }
        }
    }
}
__device__ __forceinline__ void ph_ssd_out(const Params& p, int wv) {
    PH_IDS(); unsigned char* ws = p.ws; const int r = lane & 15, q = lane >> 4;
    const bf16* XdT = (const bf16*)p.out; const bf16* S = (const bf16*)((unsigned char*)p.out + 32 * MiB); const bf16* xsbc = (const bf16*)(ws + OFF_XSBC);
    const float* acsT = (const float*)(ws + OFF_ACS); bf16* z = (bf16*)(ws + OFF_Z); float* ssq2p = (float*)(ws + OFF_HID);
    for (int task = gwave; task < 16384; task += nwaves) {
        const int lt = 7 - (task & 7), unit = task >> 3, h = unit & 15, bc = unit >> 4, g = h >> 3; const size_t t0 = (size_t)bc * 128;
        const float* ac = acsT + (size_t)unit * 128; const float Dh = p.d_skip[h];
        bf16x8 Cf[4];
#pragma unroll
        for (int ks = 0; ks < 4; ++ks) Cf[ks] = *(const bf16x8*)(xsbc + (t0 + lt * 16 + r) * 1536 + 1280 + g * 128 + ks * 32 + 8 * q);
        const float acl = ac[lt * 16 + r]; const int lrow = lt * 16 + r;
        f32x4 acc[4];
#pragma unroll
        for (int i = 0; i < 4; ++i) acc[i] = (f32x4){0.f, 0.f, 0.f, 0.f};
        const bf16* xd = XdT + (size_t)unit * 8192 + r * 128;
        for (int kk = 0; kk <= (lt >> 1); ++kk) {
            bf16x8 mf;
#pragma unroll
            for (int half = 0; half < 2; ++half) {
                const int st = 2 * kk + half; f32x4 cb = (f32x4){0.f, 0.f, 0.f, 0.f};
                if (st <= lt) {
                    const bf16* brow = xsbc + (t0 + st * 16 + r) * 1536 + 1024 + g * 128 + 8 * q;
#pragma unroll
                    for (int ks = 0; ks < 4; ++ks) cb = __builtin_amdgcn_mfma_f32_16x16x32_bf16(*(const bf16x8*)(brow + ks * 32), Cf[ks], cb, 0, 0, 0);
                    const f32x4 as4 = *(const f32x4*)(ac + st * 16 + 4 * q);
#pragma unroll
                    for (int e = 0; e < 4; ++e) { const int s = st * 16 + 4 * q + e; cb[e] = (lrow >= s) ? cb[e] * __expf(acl - as4[e]) : 0.f; }
                }
#pragma unroll
                for (int e = 0; e < 4; ++e) mf[half * 4 + e] = (short)f2bf(cb[e]);
            }
#pragma unroll
            for (int pt = 0; pt < 4; ++pt) {
                const uint2 lo = *(const uint2*)(xd + (size_t)pt * 2048 + 32 * kk + 4 * q), hi = *(const uint2*)(xd + (size_t)pt * 2048 + 32 * kk + 16 + 4 * q);
                union { uint4 u; bf16x8 v; } xf; xf.u = make_uint4(lo.x, lo.y, hi.x, hi.y);
                acc[pt] = __builtin_amdgcn_mfma_f32_16x16x32_bf16(mf, xf.v, acc[pt], 0, 0, 0);
            }
        }
        f32x4 acc2[4];
#pragma unroll
        for (int i = 0; i < 4; ++i) acc2[i] = (f32x4){0.f, 0.f, 0.f, 0.f};
        const bf16* sin = S + (size_t)unit * 8192 + r * 128 + 8 * q;
#pragma unroll
        for (int ks = 0; ks < 4; ++ks)
#pragma unroll
            for (int pt = 0; pt < 4; ++pt) acc2[pt] = __builtin_amdgcn_mfma_f32_16x16x32_bf16(Cf[ks], *(const bf16x8*)(sin + (size_t)pt * 2048 + ks * 32), acc2[pt], 0, 0, 0);
#pragma unroll
        for (int e = 0; e < 4; ++e) {
            const int l = lt * 16 + 4 * q + e; const size_t t = t0 + l; const float od = __expf(ac[l]); float ss = 0.f;
#pragma unroll
            for (int pt = 0; pt < 4; ++pt) { const int col = h * 64 + pt * 16 + r; const float xv = bf2f(xsbc[t * 1536 + col]);
                const float y = acc[pt][e] + od * acc2[pt][e] + Dh * xv; const float zz = bf2f(z[t * 1024 + col]); const float v = y * (zz * sigmoidf(zz));
                z[t * 1024 + col] = f2bf(v); ss += v * v; }
            ss += __shfl_xor(ss, 1); ss += __shfl_xor(ss, 2); ss += __shfl_xor(ss, 4); ss += __shfl_xor(ss, 8);
            if (r == 0) ssq2p[t * 16 + h] = ss;
        }
    }
}

struct ACmp {
    const bf16* kvs; int coff;
    __device__ __forceinline__ bf16x8 operator()(int m, int k) const {
        const int hk = m & 3, n = (m >> 2) & 255, b = m >> 10, l = k >> 6, d = k & 63;
        if (n == 255) return (bf16x8){0, 0, 0, 0, 0, 0, 0, 0};
        return *(const bf16x8*)(kvs + (size_t)(b * L + 16 * n + l) * 1536 + coff + hk * 64 + d);
    }
};
struct EpiHid { bf16* hid; const float* bias; __device__ __forceinline__ void operator()(int row, int c, float v) const { hid[(size_t)row * 256 + c] = f2bf(gelu_exact(v + bias[c])); } };
struct EpiKc {
    bf16* dst; bool tr; __device__ __forceinline__ void operator()(int m, int c, float v) const { const int hk = m & 3, n = (m >> 2) & 255, b = m >> 10; const bf16 o = (n == 255) ? (bf16)0 : f2bf(v);
        if (tr) dst[((size_t)(b * 4 + hk) * 64 + c) * 256 + n] = o; else dst[((size_t)(b * 4 + hk) * 256 + n) * 64 + c] = o; } };
__device__ __forceinline__ void ph_kc_rope(const Params& p, int wv) {
    PH_IDS(); unsigned char* ws = p.ws; bf16* kc = (bf16*)(ws + OFF_KC); const float* rc = (const float*)(ws + OFF_ROPE); const float* rs = rc + 4096 * 32;
    for (int i = gtid; i < 16 * 256 * 32; i += gn) {
        const int j = i & 31, n = (i >> 5) & 255, bh = i >> 13; const int pos = 16 * n + 31; if (n == 255) continue;
        const float c = rc[pos * 32 + j], s = rs[pos * 32 + j];
        bf16* pp = kc + ((size_t)bh * 256 + n) * 64 + j; const float x1 = bf2f(pp[0]), x2 = bf2f(pp[32]);
        pp[0] = f2bf(x1 * c - x2 * s); pp[32] = f2bf(x1 * s + x2 * c);
    }
}


__device__ __forceinline__ void ph_vt_prep(const Params& p, int wv) {
    PH_IDS(); unsigned char* ws = p.ws; const bf16* kvs = (const bf16*)(ws + OFF_KVS);
    const int bide = nb > 64 ? bid - 32 : bid, nbe = nb > 64 ? nb - 32 : nb; if (bide < 0) return;
    for (int unit = bide; unit < 2 * 16 * 64; unit += nbe) {
        const int br = unit & 1, tl = (unit >> 1) & 63, bh = unit >> 7, b = bh >> 2, hk = bh & 3;
        const int d = tid & 63, grp = tid >> 6; const int l0 = tl * 64 + grp * 8;
        const bf16* src = kvs + ((size_t)b * L + l0) * 1536 + (br ? 1280 : 768) + hk * 64 + d;
        unsigned w[4];
#pragma unroll
        for (int i = 0; i < 4; ++i) w[i] = (unsigned)src[(size_t)(2 * i) * 1536] | ((unsigned)src[(size_t)(2 * i + 1) * 1536] << 16);
        bf16* dst = (bf16*)(ws + (br ? OFF_VWT : OFF_VST)) + ((size_t)bh * 64 + d) * L + l0;
        *(uint4*)dst = make_uint4(w[0], w[1], w[2], w[3]);
    }
}

typedef float f32x16 __attribute__((ext_vector_type(16)));
__device__ __forceinline__ int crow(int r, int hi) { return (r & 3) + 8 * (r >> 2) + 4 * hi; }
constexpr int NSA_KROW = 144, NSA_VROW = 136, NSA_KBUF = 64 * NSA_KROW, NSA_VBUF = 64 * NSA_VROW;
constexpr int NSA_OFF_STASH = 73728;
constexpr int NSA_OFF_K = 0, NSA_OFF_V = 2 * NSA_KBUF, NSA_OFF_IMPA = NSA_OFF_V + 2 * NSA_VBUF, NSA_IMPS = 65, NSA_OFF_IMPB = NSA_OFF_IMPA + 64 * NSA_IMPS * 4, NSA_OFF_SEL = NSA_OFF_IMPB + 64 * NSA_IMPS * 4;
struct NsaSrc { const bf16* K; size_t kstride; const bf16* VT; size_t ldv; };
__device__ __forceinline__ void nsa_gload(const NsaSrc& s, int k0, int tid, uint4& kr, uint4& vr) {
    const int row = tid >> 3, ch = tid & 7;
    kr = *(const uint4*)(s.K + (size_t)(k0 + row) * s.kstride + ch * 8);
    vr = *(const uint4*)(s.VT + (size_t)row * s.ldv + k0 + ch * 8);
}
__device__ __forceinline__ void nsa_lstore(unsigned char* kb, unsigned char* vb, int tid, const uint4& kr, const uint4& vr) {
    const int row = tid >> 3, ch = tid & 7;
    *(uint4*)(kb + row * NSA_KROW + ch * 16) = kr;
    uint2* vp = (uint2*)(vb + row * NSA_VROW + ch * 16); vp[0] = make_uint2(vr.x, vr.y); vp[1] = make_uint2(vr.z, vr.w);
}
__device__ __forceinline__ void nsa_qk(const unsigned char* kb, const bf16x8 (&qf)[4], int rr, int hi, f32x16& p0, f32x16& p1) {
#pragma unroll
    for (int i = 0; i < 16; ++i) { p0[i] = 0.f; p1[i] = 0.f; }
#pragma unroll
    for (int ds = 0; ds < 4; ++ds) {
        const bf16x8 a0 = *(const bf16x8*)(kb + rr * NSA_KROW + ds * 32 + hi * 16), a1 = *(const bf16x8*)(kb + (rr + 32) * NSA_KROW + ds * 32 + hi * 16);
        p0 = __builtin_amdgcn_mfma_f32_32x32x16_bf16(a0, qf[ds], p0, 0, 0, 0); p1 = __builtin_amdgcn_mfma_f32_32x32x16_bf16(a1, qf[ds], p1, 0, 0, 0);
    }
}
__device__ __forceinline__ void nsa_pv(const unsigned char* vb, int rr, int hi, const f32x16& p0, const f32x16& p1, f32x16 (&O)[2]) {
#pragma unroll
    for (int s = 0; s < 4; ++s) {
        const int eb = 8 * (s & 1), kbase = 32 * (s >> 1) + 16 * (s & 1);
        union { uint4 u; bf16x8 v; } pf;
        if (s < 2) pf.u = make_uint4(pk2bf(p0[eb], p0[eb + 1]), pk2bf(p0[eb + 2], p0[eb + 3]), pk2bf(p0[eb + 4], p0[eb + 5]), pk2bf(p0[eb + 6], p0[eb + 7]));
        else       pf.u = make_uint4(pk2bf(p1[eb], p1[eb + 1]), pk2bf(p1[eb + 2], p1[eb + 3]), pk2bf(p1[eb + 4], p1[eb + 5]), pk2bf(p1[eb + 6], p1[eb + 7]));
#pragma unroll
        for (int dsub = 0; dsub < 2; ++dsub) {
            const unsigned char* vp = vb + (dsub * 32 + rr) * NSA_VROW + (kbase + 4 * hi) * 2;
            const uint2 lo = *(const uint2*)vp, hh = *(const uint2*)(vp + 16);
            union { uint4 u; bf16x8 v; } vf; vf.u = make_uint4(lo.x, lo.y, hh.x, hh.y);
            O[dsub] = __builtin_amdgcn_mfma_f32_32x32x16_bf16(vf.v, pf.v, O[dsub], 0, 0, 0);
        }
    }
}
template <int MODE>
__device__ __forceinline__ void nsa_branch(unsigned char* lds, const NsaSrc& src, int jt0, int jt1, int tid, int rr, int hi, const bf16x8 (&qf)[4], int lpos, int qi, int tokblk,
                                           u64 selm, u64 wsel, float& m, float& lsum, float inv_l, f32x16 (&O)[2]) {
    if (jt0 >= jt1) return;
    asm volatile("" : "+v"(tid), "+v"(rr));
    float* impA = (float*)(lds + NSA_OFF_IMPA); float* impB = (float*)(lds + NSA_OFF_IMPB);
    uint4 kr, vr;
    nsa_gload(src, jt0 * 64, tid, kr, vr);
    nsa_lstore(lds + NSA_OFF_K, lds + NSA_OFF_V, tid, kr, vr);
    __syncthreads();
    for (int jt = jt0; jt < jt1; ++jt) {
        const int cur = (jt - jt0) & 1; const bool more = (jt + 1 < jt1);
        if (more) nsa_gload(src, (jt + 1) * 64, tid, kr, vr);
        const unsigned char* kb = lds + NSA_OFF_K + cur * NSA_KBUF; const unsigned char* vb = lds + NSA_OFF_V + cur * NSA_VBUF;
        const bool active = (MODE != 2) || ((wsel >> jt) & 1ull);
        if (active) {
            f32x16 p0, p1; nsa_qk(kb, qf, rr, hi, p0, p1);
            const int k0 = jt * 64;
            const bool tile_on = (MODE != 2) || ((selm >> jt) & 1ull);
            bool full;
            if (MODE <= 1) full = (16 * (k0 + 63) + 31 <= qi * 64); else if (MODE == 2) full = (jt < qi); else full = (jt > qi - 8) && (jt < qi);
            float mx = NEG_INF;
            if (full) {
#pragma unroll
                for (int e = 0; e < 16; ++e) mx = fmaxf(mx, fmaxf(p0[e], p1[e]));
                if (MODE == 2 && !tile_on) mx = NEG_INF;
            } else {
                const int lim = (MODE <= 1) ? (lpos - 31 - 16 * k0 - 64 * hi) : (lpos - k0 - 4 * hi);
#pragma unroll
                for (int e = 0; e < 16; ++e) {
                    const int ca = (e & 3) + 8 * (e >> 2), cb = ca + 32; bool oa, ob;
                    if (MODE <= 1) { oa = (16 * ca <= lim); ob = (16 * cb <= lim); }
                    else if (MODE == 2) { oa = (ca <= lim); ob = (cb <= lim); }
                    else { oa = (ca <= lim) && (ca > lim - 512); ob = (cb <= lim) && (cb > lim - 512); }
                    p0[e] = oa ? p0[e] : NEG_INF; p1[e] = ob ? p1[e] : NEG_INF; mx = fmaxf(mx, fmaxf(p0[e], p1[e]));
                }
            }
            if (MODE != 1) {
                mx = fmaxf(mx, __shfl_xor(mx, 32));
                const float mnew = fmaxf(m, mx);
                if (__any((mnew - m) > 6.0f)) {
                    const float alpha = __builtin_amdgcn_exp2f(m - mnew); m = mnew; lsum *= alpha;
                    if (MODE != 0) {
#pragma unroll
                        for (int e = 0; e < 16; ++e) { O[0][e] *= alpha; O[1][e] *= alpha; }
                    }
                }
                const float meff = (MODE == 2 && full && !tile_on) ? BIG : ((m > 0.5f * NEG_INF) ? m : BIG);
                float rs = 0.f;
#pragma unroll
                for (int e = 0; e < 16; ++e) { p0[e] = __builtin_amdgcn_exp2f(p0[e] - meff); p1[e] = __builtin_amdgcn_exp2f(p1[e] - meff); rs += p0[e] + p1[e]; }
                lsum += rs;
                if (MODE != 0) nsa_pv(vb, rr, hi, p0, p1, O);
            } else {
#pragma unroll
                for (int e = 0; e < 16; ++e) { p0[e] = __builtin_amdgcn_exp2f(p0[e] - m) * inv_l; p1[e] = __builtin_amdgcn_exp2f(p1[e] - m) * inv_l; }
                nsa_pv(vb, rr, hi, p0, p1, O);
#pragma unroll
                for (int sub = 0; sub < 2; ++sub)
#pragma unroll
                    for (int a = 0; a < 4; ++a) {
                        float G, last;
                        if (sub == 0) { G = (p0[4 * a] + p0[4 * a + 1]) + (p0[4 * a + 2] + p0[4 * a + 3]); last = p0[4 * a + 3]; } else { G = (p1[4 * a] + p1[4 * a + 1]) + (p1[4 * a + 2] + p1[4 * a + 3]); last = p1[4 * a + 3]; }
                        G += __shfl_xor(G, 1); G += __shfl_xor(G, 2); last += __shfl_xor(last, 1); last += __shfl_xor(last, 2);
                        const int jj = (k0 >> 2) + 8 * sub + 2 * a + hi;
                        if ((rr & 3) == 0) { impA[tokblk * NSA_IMPS + jj] = G; if (jj + 1 < 64) impB[tokblk * NSA_IMPS + jj + 1] = last; }
                    }
            }
        }
        if (more) nsa_lstore(lds + NSA_OFF_K + (cur ^ 1) * NSA_KBUF, lds + NSA_OFF_V + (cur ^ 1) * NSA_VBUF, tid, kr, vr);
        __syncthreads();
    }
}
__device__ __forceinline__ void ph_nsa(const Params& p, int wv, unsigned char* lds) {
    PH_IDS(); unsigned char* ws = p.ws; const int wave = wv, rr = lane & 31, hi = lane >> 5;
    bf16* q = (bf16*)(ws + OFF_Q); const bf16* kvs = (const bf16*)(ws + OFF_KVS);
    const float* gate = (const float*)(ws + OFF_GATE); float* ssq = (float*)(ws + OFF_SSQ);
    float* impA = (float*)(lds + NSA_OFF_IMPA); float* impB = (float*)(lds + NSA_OFF_IMPB); u64* selw = (u64*)(lds + NSA_OFF_SEL);
    const int nunits = 1024;
    for (int it = 0; ; ++it) {
        int bh, qi;
        if (nb == 256) { if (it >= 4) break; bh = bid & 15; const int x = bid >> 4; qi = (it == 0) ? 63 - x : (it == 1) ? 32 + x : (it == 2) ? 31 - x : x; }
        else { const int u = bid + it * nb; if (u >= nunits) break; bh = u & 15; qi = 63 - (u >> 4); }
        const int b = bh >> 2, hk = bh & 3; const int tokblk = wave * 8 + (rr >> 2), g = rr & 3; const int lpos = qi * 64 + tokblk; const size_t t = (size_t)b * L + lpos;
        bf16* qrow = q + t * 1024 + (hk * 4 + g) * 64;
        bf16x8 qf[4];
#pragma unroll
        for (int ds = 0; ds < 4; ++ds) qf[ds] = *(const bf16x8*)(qrow + ds * 16 + hi * 8);
        for (int i = tid; i < 64 * NSA_IMPS; i += NTHREADS) { impA[i] = 0.f; impB[i] = 0.f; }
        __syncthreads();
        f32x16 O[2]; float* stash = (float*)(lds + NSA_OFF_STASH) + tid;
        const float g0 = gate[t * 48 + (hk * 4 + g) * 3 + 0], g1 = gate[t * 48 + (hk * 4 + g) * 3 + 1], g2 = gate[t * 48 + (hk * 4 + g) * 3 + 2];
        {
            NsaSrc s{(const bf16*)(ws + OFF_KC) + (size_t)bh * 256 * 64, 64, (const bf16*)(ws + OFF_VCT) + (size_t)bh * 64 * 256, 256};
            const int nct = (4 * qi + 3 + 63) >> 6;
            float m = NEG_INF, lsum = 0.f;
            nsa_branch<0>(lds, s, 0, nct, tid, rr, hi, qf, lpos, qi, tokblk, 0ull, 0ull, m, lsum, 0.f, O);
            lsum += __shfl_xor(lsum, 32);
            const float inv_l = lsum > 0.f ? 1.0f / lsum : 0.f;
#pragma unroll
            for (int e = 0; e < 16; ++e) { O[0][e] = 0.f; O[1][e] = 0.f; }
            nsa_branch<1>(lds, s, 0, nct, tid, rr, hi, qf, lpos, qi, tokblk, 0ull, 0ull, m, lsum, inv_l, O);
#pragma unroll
            for (int e = 0; e < 16; ++e) { stash[e * 512] = g0 * O[0][e]; stash[(16 + e) * 512] = g0 * O[1][e]; }
        }
        {
            const int tk = tid >> 3, jg = tid & 7; float v[8];
#pragma unroll
            for (int i = 0; i < 8; ++i) { const int j = jg * 8 + i; const float raw = impA[tk * NSA_IMPS + j] + impB[tk * NSA_IMPS + j];
                const bool causal = (j <= qi), forced = (j == 0) || (j == qi) || (j == qi - 1); v[i] = causal ? (forced ? BIG : raw) : NEG_INF; }
            __syncthreads();
#pragma unroll
            for (int i = 0; i < 8; ++i) impA[tk * NSA_IMPS + jg * 8 + i] = v[i];
            __syncthreads();
            int rank[8];
#pragma unroll
            for (int i = 0; i < 8; ++i) rank[i] = 0;
            for (int jj = 0; jj < 64; ++jj) { const float x = impA[tk * NSA_IMPS + jj];
#pragma unroll
                for (int i = 0; i < 8; ++i) rank[i] += (x > v[i] || (x == v[i] && jj < jg * 8 + i)) ? 1 : 0; }
            unsigned b8 = 0u;
#pragma unroll
            for (int i = 0; i < 8; ++i) b8 |= (rank[i] < 16 && jg * 8 + i <= qi) ? (1u << i) : 0u;
            const u64 full = (u64)b8 << (jg * 8); unsigned blo = (unsigned)full, bhi = (unsigned)(full >> 32);
            blo |= __shfl_xor(blo, 1); bhi |= __shfl_xor(bhi, 1); blo |= __shfl_xor(blo, 2); bhi |= __shfl_xor(bhi, 2); blo |= __shfl_xor(blo, 4); bhi |= __shfl_xor(bhi, 4);
            if (jg == 0) selw[tk] = (u64)blo | ((u64)bhi << 32);
            __syncthreads();
        }
        const u64 selm = selw[tokblk];
        u64 wsel = selm;
        { unsigned lo = (unsigned)wsel, h2 = (unsigned)(wsel >> 32);
          lo |= __shfl_xor(lo, 4); h2 |= __shfl_xor(h2, 4); lo |= __shfl_xor(lo, 8); h2 |= __shfl_xor(h2, 8); lo |= __shfl_xor(lo, 16); h2 |= __shfl_xor(h2, 16);
          wsel = (u64)lo | ((u64)h2 << 32); }
        {
            NsaSrc s{kvs + (size_t)b * L * 1536 + 512 + hk * 64, 1536, (const bf16*)(ws + OFF_VST) + (size_t)bh * 64 * L, (size_t)L};
            float m = NEG_INF, lsum = 0.f;
#pragma unroll
            for (int e = 0; e < 16; ++e) { O[0][e] = 0.f; O[1][e] = 0.f; }
            nsa_branch<2>(lds, s, 0, qi + 1, tid, rr, hi, qf, lpos, qi, tokblk, selm, wsel, m, lsum, 0.f, O);
            lsum += __shfl_xor(lsum, 32); const float sc = g1 / lsum;
#pragma unroll
            for (int e = 0; e < 16; ++e) { stash[e * 512] += sc * O[0][e]; stash[(16 + e) * 512] += sc * O[1][e]; }
        }
        {
            NsaSrc s{kvs + (size_t)b * L * 1536 + 1024 + hk * 64, 1536, (const bf16*)(ws + OFF_VWT) + (size_t)bh * 64 * L, (size_t)L};
            float m = NEG_INF, lsum = 0.f;
#pragma unroll
            for (int e = 0; e < 16; ++e) { O[0][e] = 0.f; O[1][e] = 0.f; }
            nsa_branch<3>(lds, s, qi >= 8 ? qi - 8 : 0, qi + 1, tid, rr, hi, qf, lpos, qi, tokblk, 0ull, 0ull, m, lsum, 0.f, O);
            lsum += __shfl_xor(lsum, 32); const float sc = g2 / lsum;
#pragma unroll
            for (int e = 0; e < 16; ++e) { O[0][e] = stash[e * 512] + sc * O[0][e]; O[1][e] = stash[(16 + e) * 512] + sc * O[1][e]; }
        }
        float ss = 0.f;
#pragma unroll
        for (int dsub = 0; dsub < 2; ++dsub)
#pragma unroll
            for (int a = 0; a < 4; ++a) {
                const float v0 = O[dsub][4 * a], v1 = O[dsub][4 * a + 1], v2 = O[dsub][4 * a + 2], v3 = O[dsub][4 * a + 3];
                ss += (v0 * v0 + v1 * v1) + (v2 * v2 + v3 * v3);
                *(uint2*)(qrow + dsub * 32 + 8 * a + 4 * hi) = make_uint2(pk2bf(v0, v1), pk2bf(v2, v3));
            }
        ss += __shfl_xor(ss, 32); ss += __shfl_xor(ss, 1); ss += __shfl_xor(ss, 2);
        if (hi == 0 && g == 0) ssq[t * 4 + hk] = ss;
        __syncthreads();
    }
}

__device__ __forceinline__ void ph_ln1(const Params& p, int wv) {
    PH_IDS(); unsigned char* ws = p.ws; bf16* h1b = (bf16*)(ws + OFF_H1B);
    for (int t = gwave; t < T; t += nwaves) {
        float v[16]; float s = 0.f; float* row = p.out + (size_t)t * 1024;
#pragma unroll
        for (int i = 0; i < 16; ++i) { v[i] = row[i * 64 + lane]; s += v[i]; }
        const float mu = wave_sum(s) * (1.0f / 1024.0f); float s2 = 0.f;
#pragma unroll
        for (int i = 0; i < 16; ++i) { v[i] -= mu; s2 += v[i] * v[i]; }
        const float rstd = rsqrtf(wave_sum(s2) * (1.0f / 1024.0f) + LN_EPS);
#pragma unroll
        for (int i = 0; i < 16; ++i) { const int c = i * 64 + lane; const float o = v[i] * rstd * p.ln1_g[c] + p.ln1_b[c]; row[c] = o; h1b[(size_t)t * 1024 + c] = f2bf(o); }
    }
}

__device__ __forceinline__ unsigned umaxu(unsigned a, unsigned b) { return a > b ? a : b; }
__device__ __forceinline__ unsigned uminu(unsigned a, unsigned b) { return a < b ? a : b; }
__device__ __forceinline__ unsigned f2mono(float f) { const unsigned u = __float_as_uint(f); return (u & 0x80000000u) ? ~u : (u | 0x80000000u); }
__device__ __forceinline__ float mono2f(unsigned m) { return __uint_as_float((m & 0x80000000u) ? (m & 0x7fffffffu) : ~m); }
template <int N> __device__ __forceinline__ void bitonic_sort_desc(unsigned (&a)[N]) {
#pragma unroll
    for (int k = 2; k <= N; k <<= 1)
#pragma unroll
        for (int j = k >> 1; j > 0; j >>= 1)
#pragma unroll
            for (int i = 0; i < N; ++i) { const int l = i ^ j; if (l > i) { const bool desc = ((i & k) == 0); const unsigned x = a[i], y = a[l], mx = umaxu(x, y), mn = uminu(x, y); a[i] = desc ? mx : mn; a[l] = desc ? mn : mx; } }
}
__device__ __forceinline__ void merge_top16(unsigned (&a)[16], const unsigned (&b)[16]) {
#pragma unroll
    for (int i = 0; i < 16; ++i) a[i] = umaxu(a[i], b[15 - i]);
#pragma unroll
    for (int j = 8; j > 0; j >>= 1)
#pragma unroll
        for (int i = 0; i < 16; ++i) { const int l = i ^ j; if (l > i) { const unsigned x = a[i], y = a[l]; a[i] = umaxu(x, y); a[l] = uminu(x, y); } }
}
__device__ __forceinline__ void peer_stage1(const bf16* qrow, const bf16* krow, int hi, unsigned (&run)[16]) {
    bf16x8 qf[8];
#pragma unroll
    for (int ks = 0; ks < 8; ++ks) qf[ks] = *(const bf16x8*)(qrow + ks * 16);
#pragma unroll 1
    for (int kt = 0; kt < 4; ++kt) {
        f32x16 acc;
#pragma unroll
        for (int e = 0; e < 16; ++e) acc[e] = 0.f;
        const bf16* kr = krow + (size_t)kt * 32 * 128;
#pragma unroll
        for (int ks = 0; ks < 8; ++ks) acc = __builtin_amdgcn_mfma_f32_32x32x16_bf16(*(const bf16x8*)(kr + ks * 16), qf[ks], acc, 0, 0, 0);
        unsigned grp[16]; const unsigned ib = (unsigned)(127 - kt * 32 - 4 * hi);
#pragma unroll
        for (int e = 0; e < 16; ++e) grp[e] = (f2mono(acc[e]) & ~0x7fu) | (ib - (unsigned)((e & 3) + 8 * (e >> 2)));
        bitonic_sort_desc<16>(grp);
        if (kt == 0) {
#pragma unroll
            for (int i = 0; i < 16; ++i) run[i] = grp[i];
        } else merge_top16(run, grp);
    }
    unsigned oth[16];
#pragma unroll
    for (int i = 0; i < 16; ++i) oth[i] = __shfl_xor(run[i], 32);
    merge_top16(run, oth);
}
__device__ __forceinline__ void ph_peer_topk(const Params& p, int wv, unsigned char* lds) {
    PH_IDS(); unsigned char* ws = p.ws; const int rr = lane & 31, hi = lane >> 5;
    int* exl = (int*)(lds + wv * 6400);
    const bf16* qp = (const bf16*)(ws + OFF_QP); const bf16* keys = (const bf16*)(ws + OFF_KEYS);
    int* eidx = (int*)(ws + OFF_EIDX); float* gw = (float*)(ws + OFF_GW);
    for (int task = gwave; task < 512 * 8; task += nwaves) {
        const int h = task & 7, t0 = (task >> 3) * 32;
        unsigned top[2][16];
        peer_stage1(qp + (size_t)(t0 + rr) * 2048 + h * 256 + 8 * hi, keys + ((size_t)(h * 2) * 128 + rr) * 128 + 8 * hi, hi, top[0]);
        peer_stage1(qp + (size_t)(t0 + rr) * 2048 + h * 256 + 128 + 8 * hi, keys + ((size_t)(h * 2 + 1) * 128 + rr) * 128 + 8 * hi, hi, top[1]);
        unsigned g4[4][16];
#pragma unroll
        for (int k = 0; k < 4; ++k)
#pragma unroll
            for (int i = 0; i < 16; ++i) g4[k][i] = 0u;
#pragma unroll
        for (int i = 0; i < 16; ++i) {
            int off = 0;
#pragma unroll
            for (int k = 0; k < 16; ++k) if (k < i) off += 16 / (k + 1);
            const float s0 = mono2f(top[0][i] & ~0x7fu); const int e0 = (int)(127u - (top[0][i] & 0x7fu)) * 128;
#pragma unroll
            for (int j = 0; j < 16; ++j) if ((i + 1) * (j + 1) <= 16) {
                const int nc = off + j;
                const float sum = s0 + mono2f(top[1][j] & ~0x7fu);
                g4[nc >> 4][nc & 15] = (f2mono(sum) & ~0x3fu) | (unsigned)(63 - nc);
                if (hi == 0) exl[nc * 32 + rr] = e0 + (int)(127u - (top[1][j] & 0x7fu));
            }
        }
#pragma unroll
        for (int k = 0; k < 4; ++k) bitonic_sort_desc<16>(g4[k]);
        merge_top16(g4[0], g4[1]); merge_top16(g4[2], g4[3]); merge_top16(g4[0], g4[2]);
        float e16[16]; float den = 0.f; const float gmax = mono2f(g4[0][0] & ~0x3fu);
#pragma unroll
        for (int r = 0; r < 16; ++r) { e16[r] = __expf(mono2f(g4[0][r] & ~0x3fu) - gmax); den += e16[r]; }
        const float inv = 1.0f / den; const size_t ob = (size_t)(t0 + rr) * 128 + h * 16 + hi * 8;
        float wo[8]; int eo[8];
#pragma unroll
        for (int k = 0; k < 8; ++k) { const unsigned key = hi ? g4[0][8 + k] : g4[0][k]; wo[k] = (hi ? e16[8 + k] : e16[k]) * inv; eo[k] = exl[(63 - (int)(key & 0x3fu)) * 32 + rr]; }
        *(float4*)(gw + ob) = make_float4(wo[0], wo[1], wo[2], wo[3]); *(float4*)(gw + ob + 4) = make_float4(wo[4], wo[5], wo[6], wo[7]);
        *(int4*)(eidx + ob) = make_int4(eo[0], eo[1], eo[2], eo[3]); *(int4*)(eidx + ob + 4) = make_int4(eo[4], eo[5], eo[6], eo[7]);
    }
}
__device__ __forceinline__ unsigned pk4fp8(float a, float b, float c, float d) { unsigned w = 0u; w = __builtin_amdgcn_cvt_pk_fp8_f32(a, b, w, false); w = __builtin_amdgcn_cvt_pk_fp8_f32(c, d, w, true); return w; }
__device__ __forceinline__ void ph_peer_cvt(const Params& p, int wv) {
    PH_IDS(); unsigned char* ws = p.ws; uint4* pu = (uint4*)(ws + OFF_PU); uint4* pv = (uint4*)(ws + OFF_PV);
    for (size_t i = gtid; i < (size_t)16384 * 1024 / 16; i += gn) {
        const float4* su = (const float4*)p.peer_u + 4 * i; const float4* sv = (const float4*)p.peer_v + 4 * i;
        const float4 a = su[0], b = su[1], c = su[2], d = su[3], e = sv[0], f = sv[1], g = sv[2], h = sv[3];
        pu[i] = make_uint4(pk4fp8(a.x * 32.f, a.y * 32.f, a.z * 32.f, a.w * 32.f), pk4fp8(b.x * 32.f, b.y * 32.f, b.z * 32.f, b.w * 32.f), pk4fp8(c.x * 32.f, c.y * 32.f, c.z * 32.f, c.w * 32.f), pk4fp8(d.x * 32.f, d.y * 32.f, d.z * 32.f, d.w * 32.f));
        pv[i] = make_uint4(pk4fp8(e.x, e.y, e.z, e.w), pk4fp8(f.x, f.y, f.z, f.w), pk4fp8(g.x, g.y, g.z, g.w), pk4fp8(h.x, h.y, h.z, h.w));
    }
}
__device__ __forceinline__ float bflo(unsigned w) { return __uint_as_float(w << 16); }
__device__ __forceinline__ float bfhi(unsigned w) { return __uint_as_float(w & 0xffff0000u); }
__device__ __forceinline__ f32x2v pkfma(f32x2v a, f32x2v b, f32x2v c) { return __builtin_elementwise_fma(a, b, c); }
__device__ __forceinline__ float dot16f8(const uint4& w, const f32x2v* x) {
    f32x2v a = {0.f, 0.f}, b = {0.f, 0.f};
    a = pkfma(__builtin_amdgcn_cvt_pk_f32_fp8(w.x, false), x[0], a); b = pkfma(__builtin_amdgcn_cvt_pk_f32_fp8(w.x, true), x[1], b);
    a = pkfma(__builtin_amdgcn_cvt_pk_f32_fp8(w.y, false), x[2], a); b = pkfma(__builtin_amdgcn_cvt_pk_f32_fp8(w.y, true), x[3], b);
    a = pkfma(__builtin_amdgcn_cvt_pk_f32_fp8(w.z, false), x[4], a); b = pkfma(__builtin_amdgcn_cvt_pk_f32_fp8(w.z, true), x[5], b);
    a = pkfma(__builtin_amdgcn_cvt_pk_f32_fp8(w.w, false), x[6], a); b = pkfma(__builtin_amdgcn_cvt_pk_f32_fp8(w.w, true), x[7], b);
    a = a + b; return a.x + a.y;
}
__device__ __forceinline__ void axpy16f8(const uint4& w, float c, f32x2v* y) {
    const f32x2v c2 = {c, c};
    y[0] = pkfma(c2, __builtin_amdgcn_cvt_pk_f32_fp8(w.x, false), y[0]); y[1] = pkfma(c2, __builtin_amdgcn_cvt_pk_f32_fp8(w.x, true), y[1]);
    y[2] = pkfma(c2, __builtin_amdgcn_cvt_pk_f32_fp8(w.y, false), y[2]); y[3] = pkfma(c2, __builtin_amdgcn_cvt_pk_f32_fp8(w.y, true), y[3]);
    y[4] = pkfma(c2, __builtin_amdgcn_cvt_pk_f32_fp8(w.z, false), y[4]); y[5] = pkfma(c2, __builtin_amdgcn_cvt_pk_f32_fp8(w.z, true), y[5]);
    y[6] = pkfma(c2, __builtin_amdgcn_cvt_pk_f32_fp8(w.w, false), y[6]); y[7] = pkfma(c2, __builtin_amdgcn_cvt_pk_f32_fp8(w.w, true), y[7]);
}
constexpr size_t OFF_PART = 90 * MiB + 32 * MiB;
constexpr size_t OFF_COEF = 218 * MiB;
constexpr size_t OFF_Y = 122 * MiB;
static_assert(OFF_PART >= OFF_H1B + 32 * MiB && OFF_PART + 64 * MiB <= OFF_EIDX && OFF_COEF + 8 * MiB <= OFF_BT, "PEER scratch map");
#define PU_ISSUE(W, ESRC) do { _Pragma("unroll") for (int k = 0; k < 8; ++k) { const int e = __shfl(ESRC, k * 8 + g); W[k] = *(const uint4*)(PU + (size_t)e * 1024 + 128 * s + 16 * j); } } while (0)
#define PU_REDUCE(W, XV, PROW, B) do { float d[8], a4[4], a2[2], a1; \
        _Pragma("unroll") for (int k = 0; k < 8; ++k) d[k] = dot16f8(W[k], XV); \
        _Pragma("unroll") for (int k = 0; k < 4; ++k) { const float give = b2 ? d[k] : d[4 + k]; a4[k] = (b2 ? d[4 + k] : d[k]) + __shfl_xor(give, 4); } \
        _Pragma("unroll") for (int k = 0; k < 2; ++k) { const float give = b1 ? a4[k] : a4[2 + k]; a2[k] = (b1 ? a4[2 + k] : a4[k]) + __shfl_xor(give, 2); } \
        { const float give = b0 ? a2[0] : a2[1]; a1 = (b0 ? a2[1] : a2[0]) + __shfl_xor(give, 1); } \
        (PROW)[(B) * 64 + kk * 8 + g] = a1; } while (0)
__device__ __forceinline__ void ph_peer_u(const Params& p, int wv) {
    PH_IDS(); unsigned char* ws = p.ws; const int s = bid & 7, cu = bid >> 3, ncu = nb >> 3, g = lane >> 3, j = lane & 7;
    const bf16* h1b = (const bf16*)(ws + OFF_H1B); const int* eidx = (const int*)(ws + OFF_EIDX); const unsigned char* PU = ws + OFF_PU; float* part = (float*)(ws + OFF_PART);
    const bool b2 = (lane & 4) != 0, b1 = (lane & 2) != 0, b0 = (lane & 1) != 0; const int kk = (b2 ? 4 : 0) + (b1 ? 2 : 0) + (b0 ? 1 : 0);
    const int tstep = ncu * NWAVES; int t = cu * NWAVES + wv;
    if (t >= T) return;
    uint4 xa = *(const uint4*)(h1b + (size_t)t * 1024 + 128 * s + 16 * j), xb = *(const uint4*)(h1b + (size_t)t * 1024 + 128 * s + 16 * j + 8);
    int e_lo = eidx[(size_t)t * 128 + lane], e_hi = eidx[(size_t)t * 128 + 64 + lane];
    uint4 wA[8], wB[8];
    PU_ISSUE(wA, e_lo);
    for (;;) {
        const int tn = t + tstep; const bool hasn = tn < T; const int tq = hasn ? tn : t;
        const uint4 nxa = *(const uint4*)(h1b + (size_t)tq * 1024 + 128 * s + 16 * j), nxb = *(const uint4*)(h1b + (size_t)tq * 1024 + 128 * s + 16 * j + 8);
        const int ne_lo = eidx[(size_t)tq * 128 + lane], ne_hi = eidx[(size_t)tq * 128 + 64 + lane];
        PU_ISSUE(wB, e_hi);
        f32x2v xv[8];
        { float xf[16]; unpack8(xa, xf); unpack8(xb, xf + 8);
#pragma unroll
          for (int i = 0; i < 8; ++i) xv[i] = (f32x2v){xf[2 * i], xf[2 * i + 1]}; }
        float* prow = part + ((size_t)s * T + t) * 128;
        PU_REDUCE(wA, xv, prow, 0);
        if (hasn) PU_ISSUE(wA, ne_lo);
        PU_REDUCE(wB, xv, prow, 1);
        if (!hasn) break;
        t = tn; xa = nxa; xb = nxb; e_lo = ne_lo; e_hi = ne_hi;
    }
}
__device__ __forceinline__ void ph_peer_c(const Params& p, int wv) {
    PH_IDS(); unsigned char* ws = p.ws; const float* part = (const float*)(ws + OFF_PART); const float* gw = (const float*)(ws + OFF_GW); float* coef = (float*)(ws + OFF_COEF);
    for (int i = gtid; i < T * 128; i += gn) {
        float sacc = 0.f;
#pragma unroll
        for (int s = 0; s < 8; ++s) sacc += part[(size_t)s * T * 128 + i];
        coef[i] = gw[i] * gelu_exact(sacc * (1.0f / 32.0f));
    }
}
#define PV_ISSUE(W, CF, ESRC, CSRC) do { _Pragma("unroll") for (int k = 0; k < 8; ++k) { const int e = __shfl(ESRC, k * 8 + g); CF[k] = __shfl(CSRC, k * 8 + g); W[k] = *(const uint4*)(PV + (size_t)e * 1024 + 128 * s + 16 * j); } } while (0)
__device__ __forceinline__ void ph_peer_v(const Params& p, int wv) {
    PH_IDS(); unsigned char* ws = p.ws; const int s = bid & 7, cu = bid >> 3, ncu = nb >> 3, g = lane >> 3, j = lane & 7;
    const int* eidx = (const int*)(ws + OFF_EIDX); const float* coef = (const float*)(ws + OFF_COEF); const unsigned char* PV = ws + OFF_PV; float* Y = (float*)(ws + OFF_Y);
    const bool b5 = (lane & 32) != 0, b4 = (lane & 16) != 0, b3 = (lane & 8) != 0; const int c0 = (b5 ? 8 : 0) + (b4 ? 4 : 0) + (b3 ? 2 : 0);
    const int tstep = ncu * NWAVES; int t = cu * NWAVES + wv;
    if (t >= T) return;
    int e_lo = eidx[(size_t)t * 128 + lane], e_hi = eidx[(size_t)t * 128 + 64 + lane]; float c_lo = coef[(size_t)t * 128 + lane], c_hi = coef[(size_t)t * 128 + 64 + lane];
    uint4 wA[8], wB[8]; float cA[8], cB[8];
    PV_ISSUE(wA, cA, e_lo, c_lo);
    for (;;) {
        const int tn = t + tstep; const bool hasn = tn < T; const int tq = hasn ? tn : t;
        const int ne_lo = eidx[(size_t)tq * 128 + lane], ne_hi = eidx[(size_t)tq * 128 + 64 + lane]; const float nc_lo = coef[(size_t)tq * 128 + lane], nc_hi = coef[(size_t)tq * 128 + 64 + lane];
        PV_ISSUE(wB, cB, e_hi, c_hi);
        f32x2v yp[8];
#pragma unroll
        for (int i = 0; i < 8; ++i) yp[i] = (f32x2v){0.f, 0.f};
#pragma unroll
        for (int k = 0; k < 8; ++k) axpy16f8(wA[k], cA[k], yp);
        if (hasn) PV_ISSUE(wA, cA, ne_lo, nc_lo);
#pragma unroll
        for (int k = 0; k < 8; ++k) axpy16f8(wB[k], cB[k], yp);
        float y[16];
#pragma unroll
        for (int i = 0; i < 8; ++i) { y[2 * i] = yp[i].x; y[2 * i + 1] = yp[i].y; }
        float y8[8], y4[4], y2[2];
#pragma unroll
        for (int i = 0; i < 8; ++i) { const float give = b5 ? y[i] : y[8 + i]; y8[i] = (b5 ? y[8 + i] : y[i]) + __shfl_xor(give, 32); }
#pragma unroll
        for (int i = 0; i < 4; ++i) { const float give = b4 ? y8[i] : y8[4 + i]; y4[i] = (b4 ? y8[4 + i] : y8[i]) + __shfl_xor(give, 16); }
#pragma unroll
        for (int i = 0; i < 2; ++i) { const float give = b3 ? y4[i] : y4[2 + i]; y2[i] = (b3 ? y4[2 + i] : y4[i]) + __shfl_xor(give, 8); }
        *(float2*)(Y + (size_t)t * 1024 + 128 * s + 16 * j + c0) = make_float2(y2[0], y2[1]);
        if (!hasn) break;
        t = tn; e_lo = ne_lo; e_hi = ne_hi; c_lo = nc_lo; c_hi = nc_hi;
    }
}
__device__ __forceinline__ void ph_peer_ln2(const Params& p, int wv) {
    PH_IDS(); unsigned char* ws = p.ws; const float* Y = (const float*)(ws + OFF_Y);
    for (int t = gwave; t < T; t += nwaves) {
        float y[16]; float* row = p.out + (size_t)t * 1024 + lane * 16; const float* yr = Y + (size_t)t * 1024 + lane * 16; float s = 0.f;
#pragma unroll
        for (int i = 0; i < 4; ++i) { const float4 a = *(const float4*)(row + 4 * i), c = *(const float4*)(yr + 4 * i); y[4 * i] = c.x + DN_ALPHA * a.x; y[4 * i + 1] = c.y + DN_ALPHA * a.y; y[4 * i + 2] = c.z + DN_ALPHA * a.z; y[4 * i + 3] = c.w + DN_ALPHA * a.w; }
#pragma unroll
        for (int i = 0; i < 16; ++i) s += y[i];
        const float mu = wave_sum(s) * (1.0f / 1024.0f); float s2 = 0.f;
#pragma unroll
        for (int i = 0; i < 16; ++i) { y[i] -= mu; s2 += y[i] * y[i]; }
        const float rstd = rsqrtf(wave_sum(s2) * (1.0f / 1024.0f) + LN_EPS);
#pragma unroll
        for (int i = 0; i < 4; ++i) { const int c = lane * 16 + 4 * i; const float4 ga = *(const float4*)(p.ln2_g + c), ba = *(const float4*)(p.ln2_b + c);
            float4 o; o.x = y[4 * i] * rstd * ga.x + ba.x; o.y = y[4 * i + 1] * rstd * ga.y + ba.y; o.z = y[4 * i + 2] * rstd * ga.z + ba.z; o.w = y[4 * i + 3] * rstd * ga.w + ba.w;
            *(float4*)(row + 4 * i) = o; }
    }
}

#define LAS __attribute__((address_space(3)))
#define XB_TMO      128
#define XB_XCNT(j)  (256  + 64 * (j))
#define XB_XSUB(j)  (1280 + 64 * (j))
#define XB_XGEN(j)  (2304 + 64 * (j))
#define XB_TOP      3328
#define XB_TOPGEN   3392
#define XCD_BAR_WORDS 3456
#define XB_SPIN_CAP (1u << 18)

__device__ __forceinline__ unsigned xb_ld(unsigned* p)              { return __hip_atomic_load(p, __ATOMIC_RELAXED, __HIP_MEMORY_SCOPE_AGENT); }
__device__ __forceinline__ unsigned xb_add(unsigned* p, unsigned v) { return __hip_atomic_fetch_add(p, v, __ATOMIC_RELAXED, __HIP_MEMORY_SCOPE_AGENT); }
__device__ __forceinline__ unsigned xb_xcc_id() { return (unsigned)__builtin_amdgcn_s_getreg((3 << 11) | 20) & 0xFu; }
#define XB_SPIN(cond, bar) do { unsigned _sp = 0; while (cond) { __builtin_amdgcn_s_sleep(1); \
    if ((++_sp & 255u) == 0u) { if (xb_ld(&(bar)[XB_TMO])) break; if (_sp > XB_SPIN_CAP) { atomicAdd(&(bar)[XB_TMO], 1u); break; } } } } while (0)

struct XcdBarrier {
    unsigned* bar; unsigned x;
    volatile LAS unsigned* st;
};

__device__ __forceinline__ XcdBarrier xcd_barrier_post(unsigned* bar, volatile LAS unsigned* st, bool leader) {
    XcdBarrier b; b.bar = bar; b.x = xb_xcc_id(); b.st = st;
    if (leader) (void)xb_add(&bar[XB_XCNT(b.x)], 1u);
    return b;
}
__device__ __forceinline__ void xcd_barrier_complete(unsigned* bar, unsigned x, unsigned& nloc, unsigned& nx) {
    const unsigned G = gridDim.x * gridDim.y * gridDim.z;
    unsigned sum, cnt, mine, sp = 0u;
    for (;;) {
        sum = 0u; cnt = 0u; mine = 0u;
#pragma unroll
        for (unsigned j = 0; j < 16; ++j) { const unsigned c = xb_ld(&bar[XB_XCNT(j)]); sum += c; cnt += (c > 0u) ? 1u : 0u; mine = (j == x) ? c : mine; }
        if (sum == G) break;
        __builtin_amdgcn_s_sleep(1);
        if ((++sp & 255u) == 0u) { if (xb_ld(&bar[XB_TMO])) break; if (sp > XB_SPIN_CAP) { atomicAdd(&bar[XB_TMO], 1u); break; } }
    }
    nloc = mine > 0u ? mine : 1u; nx = cnt > 0u ? cnt : 1u;
}

__device__ __forceinline__ void xcd_barrier(const XcdBarrier& b, bool leader) {
    asm volatile("s_waitcnt vmcnt(0)" ::: "memory");
    __syncthreads();
    if (leader) {
        unsigned* bar = b.bar;
        __builtin_amdgcn_s_waitcnt(0);
        unsigned nloc = b.st[0], nx = b.st[1];
        if (nloc == 0u) { xcd_barrier_complete(bar, b.x, nloc, nx); b.st[0] = nloc; b.st[1] = nx; }
        const unsigned old = xb_add(&bar[XB_XSUB(b.x)], 1u);
        const unsigned gen = old / nloc;
        if (old + 1u == (gen + 1u) * nloc) {
            __builtin_amdgcn_fence(__ATOMIC_RELEASE, "agent");
            asm volatile("s_waitcnt vmcnt(0)" ::: "memory");
            const unsigned og = xb_add(&bar[XB_TOP], 1u);
            const unsigned tg = og / nx;
            if (og + 1u == (tg + 1u) * nx) xb_add(&bar[XB_TOPGEN], 1u);
            else XB_SPIN(xb_ld(&bar[XB_TOPGEN]) == tg, bar);
            __builtin_amdgcn_fence(__ATOMIC_ACQUIRE, "agent");
            xb_add(&bar[XB_XGEN(b.x)], 1u);
            asm volatile("s_waitcnt vmcnt(0)" ::: "memory");
        } else {
            XB_SPIN(xb_ld(&bar[XB_XGEN(b.x)]) == gen, bar);
            __builtin_amdgcn_fence(__ATOMIC_ACQUIRE, "agent");
            asm volatile("s_waitcnt vmcnt(0)" ::: "memory");
        }
    }
    __syncthreads();
}

#ifndef TIMING_BOUNDARY
#define TIMING_BOUNDARY -1
#endif
#define TPROBE(k) do { if (TIMING_BOUNDARY == (k) && blockIdx.x == 0 && wv == 0) { const unsigned long long t1_ = __builtin_amdgcn_s_memrealtime(); while (__builtin_amdgcn_s_memrealtime() - t1_ < t1_ - tstart_) __builtin_amdgcn_s_sleep(8); } } while (0)
__global__ void __launch_bounds__(NTHREADS) fwd_megakernel(Params p) {
    extern __shared__ __attribute__((aligned(16))) unsigned char lds[];
    cg::grid_group grid = cg::this_grid();
    const int nb = gridDim.x, bid = blockIdx.x;
    const int wv = __builtin_amdgcn_readfirstlane(threadIdx.x >> 6);
    unsigned char* ws = p.ws;
    const unsigned long long tstart_ = (TIMING_BOUNDARY >= 0) ? __builtin_amdgcn_s_memrealtime() : 0ull; (void)tstart_;
    PG8_LAS unsigned char* ldsp = (PG8_LAS unsigned char*)lds;
    const bool leader = (wv == 0) && (lane_id() == 0);
    volatile LAS unsigned* bst = (volatile LAS unsigned*)(ldsp + LDS_BYTES - 64);
    if (leader) { bst[0] = 0u; bst[1] = 0u; }
    __syncthreads();
    const XcdBarrier xbar = xcd_barrier_post((unsigned*)(ws + OFF_BAR), bst, leader);

    ph_prep(p, wv, lds);
    TPROBE(0);
    grid.sync();
    {
        pg8::Gemm g{(const bf16*)(ws + OFF_XB), (const bf16*)(ws + OFF_WIN), T, NPROJ_PAD, 1024, 1024, 0, 1 << 30, 0l};
        pg8::StaticOrder S; S.init(T, NPROJ_PAD, nb, bid);
        pg8::EpiInProjPg E{(bf16*)(ws + OFF_Z), (bf16*)(ws + OFF_XBC), (bf16*)(ws + OFF_Q), (bf16*)(ws + OFF_KVS), (bf16*)(ws + OFF_DTG)};
        pg8::gemm_phase<pg8::EpiInProjPg, pg8::StaticOrder, pg8::NoMid, true, true>(wv, ldsp, g, S, E, pg8::NoMid{});
    }
    TPROBE(1);
    xcd_barrier(xbar, leader);
    ph_tokprep(p, wv);
    TPROBE(2);
    xcd_barrier(xbar, leader);
    if (bid < 32) {
        const bool isv = bid >= 16;
        pg8::Gemm g{(const bf16*)(ws + OFF_KVS) + (isv ? 256 : 0), (const bf16*)(ws + (isv ? OFF_W1V : OFF_W1K)), 4096, 256, 2048, 0, 1, 1 << 30, 0l};
        pg8::StaticOrder S; S.init(4096, 256, 16, isv ? bid - 16 : bid);
        pg8::EpiBf16<1> E{(bf16*)(ws + OFF_HID + (isv ? 2 * MiB : 0)), 256, (const float*)(ws + (isv ? OFF_B1V : OFF_B1K)), 0, 0, 1.f};
        pg8::gemm_phase<pg8::EpiBf16<1>, pg8::StaticOrder, pg8::NoMid, true, true>(wv, ldsp, g, S, E, pg8::NoMid{});
    }
    ph_ssd_prep2(p, wv, lds);
    ph_vt_prep(p, wv);
    TPROBE(3);
    xcd_barrier(xbar, leader);
    {
        RowMajorBf16 ak{(const bf16*)(ws + OFF_HID), 256}, av{(const bf16*)(ws + OFF_HID + 2 * MiB), 256};
        RowMajorBf16 bk{(const bf16*)(ws + OFF_W2K), 256}, bv{(const bf16*)(ws + OFF_W2V), 256};
        EpiKc ek{(bf16*)(ws + OFF_KC), false}, ev{(bf16*)(ws + OFF_VCT), true};
        gemm_wave32(wv, 4096 / 32, 64 / 32, 256, ak, bk, ek);
        gemm_wave32(wv, 4096 / 32, 64 / 32, 256, av, bv, ev);
    }
    ph_ssd_states(p, wv);
    TPROBE(4);
    xcd_barrier(xbar, leader);
    ph_kc_rope(p, wv);
    ph_ssd_scan(p, wv);
    TPROBE(5);
    xcd_barrier(xbar, leader);
    ph_ssd_out(p, wv);
    ph_nsa(p, wv, lds);
    TPROBE(6);
    xcd_barrier(xbar, leader);
    {
        pg8::Gemm g{(const bf16*)(ws + OFF_Q), (const bf16*)(ws + OFF_WOUT), T, 1024, 2048, 1024, 0, 16, (long)OFF_Z - (long)OFF_Q - 16l * 128l};
        pg8::StaticOrder S; S.init(T, 1024, nb, bid);
        pg8::RmsFactors rf{(const float*)(ws + OFF_SSQ), (const float*)(ws + OFF_HID), RMS_EPS};
        pg8::EpiOutProj E{p.x, p.out, DN_ALPHA, rf}; pg8::MidRmsScale MH{rf};
        pg8::gemm_phase<pg8::EpiOutProj, pg8::StaticOrder, pg8::MidRmsScale, true, true>(wv, ldsp, g, S, E, MH);
    }
    TPROBE(7);
    xcd_barrier(xbar, leader);
    ph_ln1(p, wv);
    ph_peer_cvt(p, wv);
    TPROBE(8);
    xcd_barrier(xbar, leader);
    {
        pg8::Gemm g{(const bf16*)(ws + OFF_H1B), (const bf16*)(ws + OFF_WQ), T, 2048, 1024, 1024, 0, 1 << 30, 0l};
        pg8::StaticOrder S; S.init(T, 2048, nb, bid);
        pg8::EpiBf16<0> E{(bf16*)(ws + OFF_QP), 2048, nullptr, 0, 0, 1.f};
        pg8::gemm_phase<pg8::EpiBf16<0>, pg8::StaticOrder, pg8::NoMid, true, true>(wv, ldsp, g, S, E, pg8::NoMid{});
    }
    TPROBE(9);
    xcd_barrier(xbar, leader);
    ph_peer_topk(p, wv, lds);
    TPROBE(10);
    xcd_barrier(xbar, leader);
    ph_peer_u(p, wv);
    TPROBE(11);
    xcd_barrier(xbar, leader);
    ph_peer_c(p, wv);
    TPROBE(12);
    xcd_barrier(xbar, leader);
    ph_peer_v(p, wv);
    TPROBE(13);
    xcd_barrier(xbar, leader);
    ph_peer_ln2(p, wv);
}

extern "C" void kernel_launch(void* const* d_in, const int* in_sizes, int n_in, void* d_out, int out_size, void* d_ws, size_t ws_size, hipStream_t stream) {
    static int grid_blocks = 0;
    if (!grid_blocks) {
        int dev = 0, cus = 0, per_cu = 0;
        hipGetDevice(&dev);
        hipDeviceGetAttribute(&cus, hipDeviceAttributeMultiprocessorCount, dev);
        hipFuncSetAttribute((const void*)fwd_megakernel, hipFuncAttributeMaxDynamicSharedMemorySize, LDS_BYTES);
        hipOccupancyMaxActiveBlocksPerMultiprocessor(&per_cu, fwd_megakernel, NTHREADS, LDS_BYTES);
        if (per_cu < 1) per_cu = 1;
        if (per_cu > 1) per_cu = 1;
        grid_blocks = cus * per_cu;
        if (ws_size < 244 * MiB) fprintf(stderr, "kernel_launch: workspace too small: %zu\n", ws_size);
    }
    Params p{};
    const float** pp = (const float**)&p;
    for (int i = 0; i < 24; ++i) pp[i] = (const float*)d_in[i];
    p.out = (float*)d_out; p.ws = (unsigned char*)d_ws;
    (void)hipMemsetAsync((unsigned char*)d_ws + OFF_BAR, 0, BAR_BYTES, stream);
    void* args[] = {&p};
    hipError_t e = hipLaunchCooperativeKernel((void*)fwd_megakernel, dim3(grid_blocks), dim3(NTHREADS), args, LDS_BYTES, stream);
    if (e != hipSuccess) fprintf(stderr, "cooperative launch failed: %s (grid %d)\n", hipGetErrorString(e), grid_blocks);
}
```

```cpp
#include <hip/hip_runtime.h>
#include <hip/hip_cooperative_groups.h>
#include <cstdio>
#include <cstdint>
namespace cg = cooperative_groups;

typedef unsigned short bf16;
typedef short bf16x8 __attribute__((ext_vector_type(8)));
typedef float f32x4 __attribute__((ext_vector_type(4)));
typedef unsigned long long u64;

constexpr int T = 16384, L = 4096, NBATCH = 4, D = 1024;
constexpr int NPROJ = 5184, NPROJ_PAD = 5376;
constexpr int NTHREADS = 512, NWAVES = 8;
constexpr float LN_EPS = 1e-5f, RMS_EPS = 1e-5f;
constexpr float DN_ALPHA = 1.189207115002721f;
constexpr float NEG_INF = -1e30f, BIG = 1e30f;

constexpr size_t MiB = 1u << 20;
constexpr size_t OFF_SSQ = 0, OFF_BAR = 512 * 1024, BAR_BYTES = 16384;
constexpr size_t OFF_WOUT = 1 * MiB, OFF_WQ = 5 * MiB, OFF_W1K = 9 * MiB, OFF_W1V = 10 * MiB;
constexpr size_t OFF_W2K = 11 * MiB, OFF_W2V = 11 * MiB + 65536, OFF_B1K = 11 * MiB + 131072, OFF_B1V = 11 * MiB + 131072 + 4096;
constexpr size_t OFF_KEYS = 12 * MiB, OFF_ROPE = 13 * MiB, OFF_DT = 14 * MiB, OFF_ACS = 15 * MiB, OFF_GATE = 16 * MiB, OFF_MASK = 19 * MiB;
constexpr size_t OFF_HID = 20 * MiB, OFF_KC = 24 * MiB, OFF_VC = 24 * MiB + 524288;
constexpr size_t OFF_Z = 26 * MiB, OFF_Q = 58 * MiB, OFF_KVS = 90 * MiB, OFF_XBC = 138 * MiB, OFF_XSBC = 186 * MiB, OFF_BT = 234 * MiB, OFF_DTG = 242 * MiB;
constexpr size_t OFF_VST = 138 * MiB, OFF_VWT = 146 * MiB, OFF_VCT = 154 * MiB;
constexpr size_t OFF_XB = 186 * MiB, OFF_WIN = 218 * MiB;
constexpr size_t OFF_H1B = 90 * MiB, OFF_QP = 138 * MiB, OFF_EIDX = 202 * MiB, OFF_GW = 210 * MiB;
constexpr size_t OFF_PU = 26 * MiB, OFF_PV = 58 * MiB;
constexpr int LDS_BYTES = 147456;

struct Params {
    const float *x, *w_in, *conv_w, *conv_b, *dt_bias, *a_log, *d_skip, *ssd_norm_w;
    const float *cmp_pos_k, *cmp_w1_k, *cmp_w2_k, *cmp_pos_v, *cmp_w1_v, *cmp_w2_v;
    const float *attn_norm_w, *w_out, *ln1_g, *ln1_b, *peer_wq, *peer_keys, *peer_u, *peer_v, *ln2_g, *ln2_b;
    float* out; unsigned char* ws;
};

__device__ __forceinline__ float bf2f(bf16 v) { return __uint_as_float((unsigned)v << 16); }
__device__ __forceinline__ bf16 f2bf(float f) { unsigned u = __float_as_uint(f); return (bf16)((u + 0x7fffu + ((u >> 16) & 1u)) >> 16); }
__device__ __forceinline__ int lane_id() { int l = (int)__builtin_amdgcn_mbcnt_hi(~0u, __builtin_amdgcn_mbcnt_lo(~0u, 0u)); asm volatile("" : "+v"(l)); return l; }
#define PH_IDS() const int lane = lane_id(); const int tid = (wv << 6) | lane; const int bid = blockIdx.x, nb = gridDim.x; const int gtid = bid * NTHREADS + tid, gn = nb * NTHREADS; const int gwave = bid * NWAVES + wv, nwaves = nb * NWAVES; (void)gtid; (void)gn; (void)gwave; (void)nwaves;
typedef float f32x2v __attribute__((ext_vector_type(2)));
typedef __bf16 bf16x2v __attribute__((ext_vector_type(2)));
__device__ __forceinline__ unsigned pk2bf(float lo, float hi) { f32x2v v = {lo, hi}; bf16x2v b = __builtin_convertvector(v, bf16x2v); return __builtin_bit_cast(unsigned, b); }
__device__ __forceinline__ float wave_sum(float v) {
#pragma unroll
    for (int o = 1; o < 64; o <<= 1) v += __shfl_xor(v, o);
    return v;
}
__device__ __forceinline__ float wave_max(float v) {
#pragma unroll
    for (int o = 1; o < 64; o <<= 1) v = fmaxf(v, __shfl_xor(v, o));
    return v;
}
__device__ __forceinline__ float gelu_exact(float v) { return 0.5f * v * (1.0f + erff(v * 0.7071067811865476f)); }
__device__ __forceinline__ float sigmoidf(float v) { return 1.0f / (1.0f + __expf(-v)); }

template <class AP, class BP, class EP>
__device__ __forceinline__ void gemm_wave32(int wv, int Mt, int Nt, int K, const AP& ap, const BP& bp, const EP& ep) {
    PH_IDS(); const int r = lane & 15, q = lane >> 4;
    for (int tile = gwave; tile < Mt * Nt; tile += nwaves) {
        const int tm = tile / Nt, tn = tile % Nt, row0 = tm * 32, col0 = tn * 32;
        f32x4 acc[2][2];
#pragma unroll
        for (int i = 0; i < 2; ++i)
#pragma unroll
            for (int j = 0; j < 2; ++j) acc[i][j] = (f32x4){0.f, 0.f, 0.f, 0.f};
        for (int k0 = 0; k0 < K; k0 += 32) {
            const bf16x8 a0 = ap(row0 + r, k0 + 8 * q), a1 = ap(row0 + 16 + r, k0 + 8 * q);
            const bf16x8 b0 = bp(col0 + r, k0 + 8 * q), b1 = bp(col0 + 16 + r, k0 + 8 * q);
            acc[0][0] = __builtin_amdgcn_mfma_f32_16x16x32_bf16(a0, b0, acc[0][0], 0, 0, 0);
            acc[0][1] = __builtin_amdgcn_mfma_f32_16x16x32_bf16(a0, b1, acc[0][1], 0, 0, 0);
            acc[1][0] = __builtin_amdgcn_mfma_f32_16x16x32_bf16(a1, b0, acc[1][0], 0, 0, 0);
            acc[1][1] = __builtin_amdgcn_mfma_f32_16x16x32_bf16(a1, b1, acc[1][1], 0, 0, 0);
        }
#pragma unroll
        for (int i = 0; i < 2; ++i)
#pragma unroll
            for (int j = 0; j < 2; ++j)
#pragma unroll
                for (int e = 0; e < 4; ++e) ep(row0 + 16 * i + 4 * q + e, col0 + 16 * j + r, acc[i][j][e]);
    }
}
struct RowMajorBf16 { const bf16* p; int ld; __device__ __forceinline__ bf16x8 operator()(int row, int k) const { return *(const bf16x8*)(p + (size_t)row * ld + k); } };

namespace pg8 {
#define PG8_LAS __attribute__((address_space(3)))
typedef unsigned short bf16_t;
typedef short bf16x8 __attribute__((ext_vector_type(8)));
typedef float f32x4 __attribute__((ext_vector_type(4)));
typedef unsigned u32x4 __attribute__((ext_vector_type(4)));
constexpr int BM = 256, BK = 64, HALF = 128, HTB = HALF * BK * 2  , STAGE_BYTES = 8 * HTB, NXCD = 8, WGM = 8;

__host__ __device__ __forceinline__ int lds_byte(int r, int c) { const int st = (r >> 4) * 2 + (c >> 5), rr = r & 15, cc = c & 31, ob = rr * 64 + cc * 2; return st * 1024 + (ob ^ (((ob >> 9) & 1) << 5)); }
__host__ __device__ __forceinline__ void stage_rc(int b, int& R, int& C) { const int st = b / 1024, sb = b % 1024, swz = sb ^ (((sb >> 9) & 1) << 5); R = (st >> 1) * 16 + swz / 64; C = (st & 1) * 32 + (swz % 64) / 2; }
__host__ __device__ __forceinline__ int perm32(int rho) { const int n = rho >> 4, i = rho & 15; return 8 * (i >> 2) + 4 * n + (i & 3); }

struct Unit { int pm, pn; };
struct Gemm { const bf16_t* A; const bf16_t* Bt; int M, N, K; int lda; int amode; int ksplit; long kdelta; };

struct StaticOrder {
    int nM, nN, nwg, G, c;
    __host__ __device__ void init(int M, int N, int G_, int c_) { nM = M / BM; nN = N / BM; nwg = nM * nN; G = G_; c = c_; }
    __host__ __device__ bool next(int i, Unit& u) const {
        const long L = (long)i * G + c; if (L >= nwg) return false;
        int wgid = (int)L; { const int q = nwg / NXCD, r = nwg % NXCD, xcd = wgid % NXCD, off = wgid / NXCD; wgid = (xcd < r ? xcd * (q + 1) : r * (q + 1) + (xcd - r) * q) + off; }
        const int nig = WGM * nN, gid = wgid / nig, fm = gid * WGM, gsz = (nM - fm) < WGM ? (nM - fm) : WGM;
        u.pm = fm + ((wgid % nig) % gsz); u.pn = (wgid % nig) / gsz; return true;
    }
    __device__ __forceinline__ void a_ready(const Unit&) const {}
    __device__ __forceinline__ void done(const Unit&) const {}
};


__device__ __forceinline__ unsigned cvt_pk_bf16(float lo, float hi) { unsigned r; asm volatile("v_cvt_pk_bf16_f32 %0, %1, %2" : "=v"(r) : "v"(lo), "v"(hi)); return r; }
typedef float f32x2 __attribute__((ext_vector_type(2)));
__device__ __forceinline__ f32x2 gelu_pk(f32x2 v) {
    const f32x2 av = __builtin_elementwise_abs(v), d = av * 0.2316418882f + 1.0f;
    f32x2 t; t.x = __builtin_amdgcn_rcpf(d.x); t.y = __builtin_amdgcn_rcpf(d.y);
    f32x2 q = t * 0.5307027145f + (-0.7265760135f); q = q * t + 0.7107068705f; q = q * t + (-0.142248368f); q = q * t + 0.127414796f; q = q * t;
    const f32x2 s = (v * v) * (-0.72134752044f);
    f32x2 e; e.x = __builtin_amdgcn_exp2f(s.x); e.y = __builtin_amdgcn_exp2f(s.y);
    const f32x2 m = v * (q * e), r = v - m;
    f32x2 o; o.x = v.x < 0.f ? m.x : r.x; o.y = v.y < 0.f ? m.y : r.y; return o;
}

template <int ACT  > struct EpiBf16 {
    static constexpr bool PERM = true, AFTER_DRAIN = false; static_assert(ACT == 0 || ACT == 1, "EpiBf16: ACT is 0 (none) or 1 (gelu_pk)");
    bf16_t* O; int ldc; const float* bias; int split_cols; size_t split_stride; float scale0;
    __device__ __forceinline__ void operator()(const f32x4 (&acc)[2][2][4][2], const Unit& u, int wr, int wc, int fr, int fq) const {
        const int row0 = u.pm * BM + wr * 64 + fr; int colt = u.pn * BM; bf16_t* base = O;
        float sc = 1.f; if (split_cols) { const int t = colt / split_cols; base += (size_t)t * split_stride; colt -= t * split_cols; if (t == 0) sc = scale0; }
        const int col0 = colt + wc * 32 + 8 * fq, bcol0 = u.pn * BM + wc * 32 + 8 * fq;
        f32x4 bv[2][2];
#pragma unroll
        for (int bj = 0; bj < 2; ++bj)
#pragma unroll
            for (int n = 0; n < 2; ++n) bv[bj][n] = bias ? *(const f32x4*)(bias + bcol0 + bj * HALF + 4 * n) : (f32x4){0.f, 0.f, 0.f, 0.f};
#pragma unroll
        for (int ai = 0; ai < 2; ++ai)
#pragma unroll
            for (int m = 0; m < 4; ++m) { bf16_t* rowp = base + (size_t)(row0 + ai * HALF + m * 16) * ldc + col0;
#pragma unroll
                for (int bj = 0; bj < 2; ++bj) { f32x4 v0 = acc[ai][bj][m][0] + bv[bj][0], v1 = acc[ai][bj][m][1] + bv[bj][1];
                    if (ACT == 1) { f32x2 a = gelu_pk((f32x2){v0[0], v0[1]}), b = gelu_pk((f32x2){v0[2], v0[3]}), c = gelu_pk((f32x2){v1[0], v1[1]}), d = gelu_pk((f32x2){v1[2], v1[3]});
                        v0 = (f32x4){a.x, a.y, b.x, b.y}; v1 = (f32x4){c.x, c.y, d.x, d.y}; }
                    v0 = v0 * sc; v1 = v1 * sc; u32x4 w; w.x = cvt_pk_bf16(v0[0], v0[1]); w.y = cvt_pk_bf16(v0[2], v0[3]); w.z = cvt_pk_bf16(v1[0], v1[1]); w.w = cvt_pk_bf16(v1[2], v1[3]);
                    *(u32x4*)(rowp + bj * HALF) = w; } }
    }
};

struct EpiInProjPg { static constexpr bool PERM = true, AFTER_DRAIN = false;
    bf16_t *z, *xbc, *q, *kvs, *dtg;
    __device__ __forceinline__ void operator()(const f32x4 (&acc)[2][2][4][2], const Unit& u, int wr, int wc, int fr, int fq) const {
        bf16_t* base; int ldc, colt; const int pn = u.pn;
        if (pn < 4) { base = z; ldc = 1024; colt = pn * 256; } else if (pn < 10) { base = xbc; ldc = 1536; colt = (pn - 4) * 256; }
        else if (pn < 14) { base = q; ldc = 1024; colt = (pn - 10) * 256; } else if (pn < 20) { base = kvs; ldc = 1536; colt = (pn - 14) * 256; }
        else { base = dtg; ldc = 64; colt = 0; }
        const int row0 = u.pm * BM + wr * 64 + fr, col0 = colt + wc * 32 + 8 * fq;
#pragma unroll
        for (int ai = 0; ai < 2; ++ai)
#pragma unroll
            for (int m = 0; m < 4; ++m) { bf16_t* rowp = base + (size_t)(row0 + ai * HALF + m * 16) * ldc + col0;
#pragma unroll
                for (int bj = 0; bj < 2; ++bj) { const f32x4 v0 = acc[ai][bj][m][0], v1 = acc[ai][bj][m][1];
                    u32x4 w; w.x = cvt_pk_bf16(v0[0], v0[1]); w.y = cvt_pk_bf16(v0[2], v0[3]); w.z = cvt_pk_bf16(v1[0], v1[1]); w.w = cvt_pk_bf16(v1[2], v1[3]);
                    if (pn < 20 || (bj == 0 && wc < 2)) *(u32x4*)(rowp + bj * HALF) = w; } }
    }
};
struct RmsFactors { const float* ssqp; const float* ssq2p; float eps;
    __device__ __forceinline__ void get(int row, float& ra, float& r0, float& r1) const {
        const f32x4 a = *(const f32x4*)(ssqp + 4 * row); const f32x4 b0 = *(const f32x4*)(ssq2p + 16 * row), b1 = *(const f32x4*)(ssq2p + 16 * row + 4), b2 = *(const f32x4*)(ssq2p + 16 * row + 8), b3 = *(const f32x4*)(ssq2p + 16 * row + 12);
        ra = rsqrtf(((a[0] + a[1]) + (a[2] + a[3])) * (1.0f / 1024.0f) + eps);
        r0 = rsqrtf((((b0[0] + b0[1]) + (b0[2] + b0[3])) + ((b1[0] + b1[1]) + (b1[2] + b1[3]))) * (1.0f / 512.0f) + eps);
        r1 = rsqrtf((((b2[0] + b2[1]) + (b2[2] + b2[3])) + ((b3[0] + b3[1]) + (b3[2] + b3[3]))) * (1.0f / 512.0f) + eps); } };
struct EpiOutProj { static constexpr bool PERM = false, AFTER_DRAIN = false;
    const float* x; float* out; float alpha; RmsFactors rf;
    __device__ __forceinline__ void operator()(const f32x4 (&acc)[2][2][4][2], const Unit& u, int wr, int wc, int fr, int fq) const {
        const int col0 = u.pn * BM + wc * 32 + 4 * fq;
#pragma unroll
        for (int ai = 0; ai < 2; ++ai)
#pragma unroll
            for (int m = 0; m < 4; ++m) { const int row = u.pm * BM + ai * HALF + wr * 64 + m * 16 + fr; const size_t off = (size_t)row * 1024 + col0;
                float ra, r0, r1; rf.get(row, ra, r0, r1);
#pragma unroll
                for (int bj = 0; bj < 2; ++bj)
#pragma unroll
                    for (int n = 0; n < 2; ++n) { const size_t o = off + bj * HALF + n * 16; const f32x4 xv = *(const f32x4*)(x + o); *(f32x4*)(out + o) = xv * alpha + acc[ai][bj][m][n] * r1; } }
    }
};
struct MidRmsScale { static constexpr bool ENABLED = true; RmsFactors rf;
    __device__ __forceinline__ void operator()(f32x4 (&acc)[2][2][4][2], const Unit& u, int t, int wr, int wc, int fr, int fq) const {
        if (t != 16 && t != 24) return;
        int rowb = u.pm * BM + wr * 64 + fr; asm volatile("" : "+v"(rowb));
#pragma unroll
        for (int ai = 0; ai < 2; ++ai)
#pragma unroll
            for (int m = 0; m < 4; ++m) { float ra, r0, r1; rf.get(rowb + ai * HALF + m * 16, ra, r0, r1);
                const float sc = (t == 16) ? ra / r0 : r0 / r1;
#pragma unroll
                for (int bj = 0; bj < 2; ++bj)
#pragma unroll
                    for (int n = 0; n < 2; ++n) acc[ai][bj][m][n] = acc[ai][bj][m][n] * sc; }
    }
};
struct NoMid { static constexpr bool ENABLED = false; template <class ACC> __device__ __forceinline__ void operator()(ACC&, const Unit&, int, int, int, int, int) const {} };
template <class Epi, class Sched, class Mid, bool ALIGN_EPI = false, bool SP2 = false>
__device__ __forceinline__ void gemm_phase(int wv, PG8_LAS unsigned char* lds, const Gemm g, const Sched& S, const Epi& E, const Mid& MH) {
    int lane_ = (int)__builtin_amdgcn_mbcnt_hi(~0u, __builtin_amdgcn_mbcnt_lo(~0u, 0u)); asm volatile("" : "+v"(lane_));
    const int lane = lane_, wid = wv, tid = (wv << 6) | lane, wr = wid >> 2, wc = wid & 3, fr = lane & 15, fq = lane >> 4;
    const int K = g.K, nt = K / BK;
    unsigned voffA[2], voffB[2];
#pragma unroll
    for (int i = 0; i < 2; ++i) { int R, C; stage_rc(tid * 16 + i * 8192, R, C); const int Rb = Epi::PERM ? ((R & ~31) + perm32(R & 31)) : R;
        voffA[i] = g.amode == 0 ? (unsigned)(R * g.lda + C) * 2u : (unsigned)((R >> 2) * 49152 + (R & 3) * 128 + C * 2); voffB[i] = (unsigned)(Rb * K + C) * 2u; }
    const size_t kstep = (size_t)(BK * 2);
    const size_t hstep = (size_t)HALF * K * 2;
    const size_t tstep = 2 * hstep;
    const size_t kstepA = g.amode == 0 ? (size_t)(BK * 2) : (size_t)3072;
    const size_t hstepA = g.amode == 0 ? (size_t)HALF * g.lda * 2 : (size_t)32 * 49152;
    const size_t tstepA = 2 * hstepA;
#define PG8_AK(base, t) ((base) + (size_t)(t) * kstepA + (((t) >= g.ksplit) ? g.kdelta : 0l))
    const unsigned ldsw = (unsigned)wid * 1024u;
    const int aoff = lds_byte(wr * 64 + fr, fq * 8), boff = lds_byte(wc * 32 + fr, fq * 8);
#define PG8_SA(b, h) (((b) * 2 + (h)) * HTB)
#define PG8_SB(b, h) ((4 + (b) * 2 + (h)) * HTB)
#define PG8_STAGE(bufoff, gbase, voff) do { _Pragma("unroll") for (int _i = 0; _i < 2; ++_i) \
        __builtin_amdgcn_global_load_lds((const unsigned*)((const char*)(gbase) + (voff)[_i]), (PG8_LAS unsigned*)(lds + (bufoff) + ldsw + _i * 8192), 16, 0, 0); } while (0)
#define PG8_LDA(dst, b, h) do { _Pragma("unroll") for (int m = 0; m < 4; ++m) _Pragma("unroll") for (int k = 0; k < 2; ++k) dst[m][k] = *(const PG8_LAS bf16x8*)(lds + PG8_SA(b, h) + aoff + m * 2048 + k * 1024); } while (0)
#define PG8_LDB(dst, b, h) do { _Pragma("unroll") for (int n = 0; n < 2; ++n) _Pragma("unroll") for (int k = 0; k < 2; ++k) dst[n][k] = *(const PG8_LAS bf16x8*)(lds + PG8_SB(b, h) + boff + n * 2048 + k * 1024); } while (0)
#define PG8_MMA(ai, bj, At, Bt) do { __builtin_amdgcn_s_setprio(1); _Pragma("unroll") for (int m = 0; m < 4; ++m) _Pragma("unroll") for (int n = 0; n < 2; ++n) _Pragma("unroll") for (int k = 0; k < 2; ++k) \
        acc[ai][bj][m][n] = __builtin_amdgcn_mfma_f32_16x16x32_bf16(Bt[n][k], At[m][k], acc[ai][bj][m][n], 0, 0, 0); __builtin_amdgcn_s_setprio(0); } while (0)
#define PG8_WAIT_V(n) asm volatile("s_waitcnt vmcnt(" #n ")" ::: "memory")
#define PG8_WAIT_L(n) asm volatile("s_waitcnt lgkmcnt(" #n ")" ::: "memory")
#define PG8_BAR __builtin_amdgcn_s_barrier()
#define PG8_SCHED __builtin_amdgcn_sched_barrier(0)
    Unit cur, nxt; int ui = 0;
    if (!S.next(0, cur)) return;
    f32x4 acc[2][2][4][2];
#pragma unroll
    for (int a = 0; a < 2; ++a)
#pragma unroll
        for (int b = 0; b < 2; ++b)
#pragma unroll
            for (int m = 0; m < 4; ++m)
#pragma unroll
                for (int n = 0; n < 2; ++n) acc[a][b][m][n] = (f32x4){0.f, 0.f, 0.f, 0.f};
    bf16x8 At[4][2], B0[2][2], B1[2][2];
    const char* cA = (const char*)g.A + (size_t)cur.pm * tstepA; const char* cB = (const char*)g.Bt + (size_t)cur.pn * tstep;
    S.a_ready(cur);
    if constexpr (SP2) {
        PG8_STAGE(PG8_SB(0, 0), cB, voffB); PG8_STAGE(PG8_SB(0, 1), cB + hstep, voffB); PG8_STAGE(PG8_SA(0, 0), cA, voffA); PG8_STAGE(PG8_SA(0, 1), cA + hstepA, voffA);
        if (wr == 1) PG8_BAR;
        PG8_WAIT_V(2); PG8_BAR;
        PG8_STAGE(PG8_SB(1, 0), cB + kstep, voffB); PG8_STAGE(PG8_SA(1, 0), PG8_AK(cA, 1), voffA); PG8_STAGE(PG8_SB(1, 1), cB + hstep + kstep, voffB);
        PG8_WAIT_V(6); PG8_BAR;
    } else {
        PG8_STAGE(PG8_SB(0, 0), cB, voffB); PG8_STAGE(PG8_SA(0, 0), cA, voffA); PG8_STAGE(PG8_SB(0, 1), cB + hstep, voffB); PG8_STAGE(PG8_SA(0, 1), cA + hstepA, voffA);
        if (wr == 1) PG8_BAR;
        PG8_WAIT_V(4); PG8_BAR;
        PG8_STAGE(PG8_SB(1, 0), cB + kstep, voffB); PG8_STAGE(PG8_SA(1, 0), PG8_AK(cA, 1), voffA); PG8_STAGE(PG8_SB(1, 1), cB + hstep + kstep, voffB);
        PG8_WAIT_V(6); PG8_BAR;
    }
    for (;;) {
        const bool has_next = S.next(ui + 1, nxt);
        const char* nA = has_next ? (const char*)g.A + (size_t)nxt.pm * tstepA : cA; const char* nB = has_next ? (const char*)g.Bt + (size_t)nxt.pn * tstep : cB;
        for (int t = 0; t < nt; t += 2) {
            const bool last = (t == nt - 2);
            if (Mid::ENABLED) MH(acc, cur, t, wr, wc, fr, fq);
            const char* a1 = PG8_AK(cA, t + 1);
            const char* a2 = last ? nA : PG8_AK(cA, t + 2); const char* b2 = last ? nB : cB + (size_t)(t + 2) * kstep;
            const char* a3 = a2 + kstepA; const char* b3 = b2 + kstep;
            if (last && has_next) S.a_ready(nxt);
            if constexpr (SP2) {
            PG8_LDB(B0, 0, 0); PG8_LDB(B1, 0, 1); PG8_SCHED; PG8_LDA(At, 0, 0); PG8_STAGE(PG8_SA(1, 1), a1 + hstepA, voffA);
            PG8_WAIT_V(8); PG8_WAIT_L(0); PG8_BAR; PG8_MMA(0, 0, At, B0); PG8_MMA(0, 1, At, B1); PG8_BAR; PG8_SCHED;
            PG8_LDA(At, 0, 1); PG8_STAGE(PG8_SB(0, 0), b2, voffB); PG8_STAGE(PG8_SB(0, 1), b2 + hstep, voffB); PG8_STAGE(PG8_SA(0, 0), a2, voffA);
            PG8_WAIT_V(8); PG8_WAIT_L(0); PG8_BAR; PG8_MMA(1, 0, At, B0); PG8_MMA(1, 1, At, B1); PG8_BAR; PG8_SCHED;
            PG8_LDB(B0, 1, 0); PG8_LDB(B1, 1, 1); PG8_SCHED; PG8_LDA(At, 1, 0); PG8_STAGE(PG8_SA(0, 1), a2 + hstepA, voffA);
            PG8_WAIT_V(8); PG8_WAIT_L(0); PG8_BAR; PG8_MMA(0, 0, At, B0); PG8_MMA(0, 1, At, B1); PG8_BAR; PG8_SCHED;
            PG8_LDA(At, 1, 1); PG8_STAGE(PG8_SB(1, 0), b3, voffB); PG8_STAGE(PG8_SB(1, 1), b3 + hstep, voffB); PG8_STAGE(PG8_SA(1, 0), a3, voffA);
            PG8_WAIT_V(8); PG8_WAIT_L(0); PG8_BAR; PG8_MMA(1, 0, At, B0); PG8_MMA(1, 1, At, B1); PG8_BAR; PG8_SCHED;
            } else {
            PG8_LDB(B0, 0, 0); PG8_SCHED; PG8_LDA(At, 0, 0); PG8_STAGE(PG8_SA(1, 1), a1 + hstepA, voffA);
            PG8_WAIT_L(8); PG8_BAR; PG8_WAIT_L(0); PG8_MMA(0, 0, At, B0); PG8_BAR; PG8_SCHED;
            PG8_LDB(B1, 0, 1); PG8_STAGE(PG8_SB(0, 0), b2, voffB);
            PG8_BAR; PG8_WAIT_L(0); PG8_MMA(0, 1, At, B1); PG8_BAR;
            PG8_LDA(At, 0, 1); PG8_STAGE(PG8_SA(0, 0), a2, voffA);
            PG8_BAR; PG8_WAIT_L(0); PG8_MMA(1, 0, At, B0); PG8_BAR; PG8_SCHED;
            PG8_STAGE(PG8_SB(0, 1), b2 + hstep, voffB);
            PG8_WAIT_V(6); PG8_BAR; PG8_MMA(1, 1, At, B1); PG8_BAR;
            PG8_LDB(B0, 1, 0); PG8_SCHED; PG8_LDA(At, 1, 0); PG8_STAGE(PG8_SA(0, 1), a2 + hstepA, voffA);
            PG8_WAIT_L(8); PG8_BAR; PG8_WAIT_L(0); PG8_MMA(0, 0, At, B0); PG8_BAR; PG8_SCHED;
            PG8_LDB(B1, 1, 1); PG8_STAGE(PG8_SB(1, 0), b3, voffB);
            PG8_BAR; PG8_WAIT_L(0); PG8_MMA(0, 1, At, B1); PG8_BAR;
            PG8_LDA(At, 1, 1); PG8_STAGE(PG8_SA(1, 0), a3, voffA);
            PG8_BAR; PG8_WAIT_L(0); PG8_MMA(1, 0, At, B0); PG8_BAR; PG8_SCHED;
            PG8_STAGE(PG8_SB(1, 1), b3 + hstep, voffB);
            PG8_WAIT_V(6); PG8_BAR; PG8_MMA(1, 1, At, B1); PG8_BAR;
            }
        }
        if constexpr (ALIGN_EPI) { if (wr == 0) PG8_BAR; }
        if constexpr (!Epi::AFTER_DRAIN) { E(acc, cur, wr, wc, fr, fq); S.done(cur); }
        if (!has_next) break;
#pragma unroll
        for (int a = 0; a < 2; ++a)
#pragma unroll
            for (int b = 0; b < 2; ++b)
#pragma unroll
                for (int m = 0; m < 4; ++m)
#pragma unroll
                    for (int n = 0; n < 2; ++n) acc[a][b][m][n] = (f32x4){0.f, 0.f, 0.f, 0.f};
        cur = nxt; cA = nA; cB = nB; ++ui;
        if constexpr (ALIGN_EPI) { if (wr == 1) PG8_BAR; }
    }
    PG8_WAIT_V(0);
    if constexpr (!ALIGN_EPI) { if (wr == 0) PG8_BAR; }
    PG8_BAR;
    if constexpr (Epi::AFTER_DRAIN) { E.fused(acc, cur, wr, wc, fr, fq, lds, wid, lane); S.done(cur); }
#undef PG8_AK
#undef PG8_SA
#undef PG8_SB
#undef PG8_STAGE
#undef PG8_LDA
#undef PG8_LDB
#undef PG8_MMA
#undef PG8_WAIT_V
#undef PG8_WAIT_L
#undef PG8_BAR
#undef PG8_SCHED
}
}

__device__ __forceinline__ int winmap(int n) { return n < 2560 ? n : (n < 5120 ? n + 16 : (n < 5136 ? 2560 + (n - 5120) : n)); }
template <class Map>
__device__ __forceinline__ void transpose_item(const float* W, int ldw, bf16* WT, int K, int item, int nblk, float* scr, int lane, const Map& mp) {
    const int kb = item / nblk, nbk = item % nblk, k0 = 64 * kb, n0 = 32 * nbk;
    const int col = mp.scol(n0 + (lane & 31));
#pragma unroll 8
    for (int i = 0; i < 32; ++i) { const int kk = 2 * i + (lane >> 5); scr[kk * 33 + (lane & 31)] = col >= 0 ? W[(size_t)mp.srow(k0 + kk) * ldw + col] * mp.scale(k0 + kk) : 0.f; }
    const int c = lane & 7;
#pragma unroll
    for (int j = 0; j < 4; ++j) { const int n = (lane >> 3) + 8 * j; const float* s = scr + (8 * c) * 33 + n;
        *(uint4*)(WT + (size_t)(n0 + n) * K + k0 + 8 * c) = make_uint4(pk2bf(s[0], s[33]), pk2bf(s[66], s[99]), pk2bf(s[132], s[165]), pk2bf(s[198], s[231])); }
}
struct MapPlain { __device__ __forceinline__ int srow(int k) const { return k; } __device__ __forceinline__ int scol(int n) const { return n; } __device__ __forceinline__ float scale(int) const { return 1.f; } };
struct MapWin { __device__ __forceinline__ int srow(int k) const { return k; } __device__ __forceinline__ int scol(int n) const { return n < NPROJ ? winmap(n) : -1; } __device__ __forceinline__ float scale(int) const { return 1.f; } };
struct MapWout { const float* an; const float* sn;
    __device__ __forceinline__ int srow(int k) const { return (k + 1024) & 2047; } __device__ __forceinline__ int scol(int n) const { return n; } __device__ __forceinline__ float scale(int k) const { return k < 1024 ? an[k] : sn[k - 1024]; } };
__device__ __forceinline__ void ph_prep(const Params& p, int wv, unsigned char* lds) {
    PH_IDS(); unsigned char* ws = p.ws;
    bf16* xb = (bf16*)(ws + OFF_XB);
    for (size_t i = gtid; i < (size_t)T * D / 8; i += gn) { const float4 v = ((const float4*)p.x)[2 * i], w = ((const float4*)p.x)[2 * i + 1]; ((uint4*)xb)[i] = make_uint4(pk2bf(v.x, v.y), pk2bf(v.z, v.w), pk2bf(w.x, w.y), pk2bf(w.z, w.w)); }
    {
        float* scr = (float*)(lds + wv * 8448);
        constexpr int I_WIN = 16 * 168, I_WOUT = 32 * 32, I_WQ = 16 * 64, I_W1 = 32 * 8, I_W2 = 4 * 2;
        constexpr int NIT = I_WIN + I_WOUT + I_WQ + 2 * I_W1 + 2 * I_W2;
        for (int it = gwave; it < NIT; it += nwaves) {
            int r = it;
            if (r < I_WIN) { transpose_item(p.w_in, NPROJ, (bf16*)(ws + OFF_WIN), 1024, r, 168, scr, lane, MapWin{}); continue; } r -= I_WIN;
            if (r < I_WOUT) { transpose_item(p.w_out, 1024, (bf16*)(ws + OFF_WOUT), 2048, r, 32, scr, lane, MapWout{p.attn_norm_w, p.ssd_norm_w}); continue; } r -= I_WOUT;
            if (r < I_WQ) { transpose_item(p.peer_wq, 2048, (bf16*)(ws + OFF_WQ), 1024, r, 64, scr, lane, MapPlain{}); continue; } r -= I_WQ;
            if (r < I_W1) { transpose_item(p.cmp_w1_k, 256, (bf16*)(ws + OFF_W1K), 2048, r, 8, scr, lane, MapPlain{}); continue; } r -= I_W1;
            if (r < I_W1) { transpose_item(p.cmp_w1_v, 256, (bf16*)(ws + OFF_W1V), 2048, r, 8, scr, lane, MapPlain{}); continue; } r -= I_W1;
            if (r < I_W2) { transpose_item(p.cmp_w2_k, 64, (bf16*)(ws + OFF_W2K), 256, r, 2, scr, lane, MapPlain{}); continue; } r -= I_W2;
            transpose_item(p.cmp_w2_v, 64, (bf16*)(ws + OFF_W2V), 256, r, 2, scr, lane, MapPlain{});
        }
    }
    bf16* keys = (bf16*)(ws + OFF_KEYS);
    for (int i = gtid; i < 8 * 2 * 128 * 128; i += gn) keys[i] = f2bf(p.peer_keys[i]);
    float* rc = (float*)(ws + OFF_ROPE); float* rs = rc + 4096 * 32;
    for (int i = gtid; i < 4096 * 32; i += gn) {
        const int pos = i >> 5, j = i & 31;
        const float inv = powf(10000.0f, -(float)(2 * j) / 64.0f); const float angf = (float)pos * inv;
        double xr = (double)angf * 0.15915494309189535; xr -= rint(xr); const double rr = xr * 6.283185307179586, r2 = rr * rr;
        double s = 0.0, c = 0.0, ts = rr, tc = 1.0;
        for (int k = 0; k < 14; ++k) { s += ts; c += tc; tc = -tc * r2 / (double)((2 * k + 1) * (2 * k + 2)); ts = -ts * r2 / (double)((2 * k + 2) * (2 * k + 3)); }
        rc[i] = (float)c; rs[i] = (float)s;
    }
    float* b1k = (float*)(ws + OFF_B1K); float* b1v = (float*)(ws + OFF_B1V);
    for (int o = gwave; o < 512; o += nwaves) {
        const int j = o & 255; const float* pos = o < 256 ? p.cmp_pos_k : p.cmp_pos_v; const float* w1 = o < 256 ? p.cmp_w1_k : p.cmp_w1_v;
        float s = 0.f; for (int k = lane; k < 2048; k += 64) s += pos[k] * w1[(size_t)k * 256 + j];
        s = wave_sum(s); if (lane == 0) (o < 256 ? b1k : b1v)[j] = s;
    }
}

struct EpiInProj {
    bf16 *z, *xbc, *q, *kvs, *dtg;
    __device__ __forceinline__ void operator()(int row, int c, float v) const {
        const bf16 b = f2bf(v);
        if (c < 1024) z[(size_t)row * 1024 + c] = b;
        else if (c < 2560) xbc[(size_t)row * 1536 + (c - 1024)] = b;
        else if (c < 3584) q[(size_t)row * 1024 + (c - 2560)] = b;
        else if (c < 5120) kvs[(size_t)row * 1536 + (c - 3584)] = b;
        else if (c < 5184) dtg[(size_t)row * 64 + (c - 5120)] = b;
    }
};

__device__ __forceinline__ void unpack8(const uint4& w, float* f) { f[0] = __uint_as_float(w.x << 16); f[1] = __uint_as_float(w.x & 0xffff0000u); f[2] = __uint_as_float(w.y << 16); f[3] = __uint_as_float(w.y & 0xffff0000u);
    f[4] = __uint_as_float(w.z << 16); f[5] = __uint_as_float(w.z & 0xffff0000u); f[6] = __uint_as_float(w.w << 16); f[7] = __uint_as_float(w.w & 0xffff0000u); }
__device__ __forceinline__ uint4 pack8(const float* f) { return make_uint4(pk2bf(f[0], f[1]), pk2bf(f[2], f[3]), pk2bf(f[4], f[5]), pk2bf(f[6], f[7])); }
__device__ __forceinline__ void ph_tokprep(const Params& p, int wv) {
    PH_IDS(); unsigned char* ws = p.ws;
    const bf16* xbc = (const bf16*)(ws + OFF_XBC); bf16* xsbc = (bf16*)(ws + OFF_XSBC);
    for (int it = gtid; it < (T / 16) * 192; it += gn) {
        const int cg = it % 192, tg = it / 192, ch = cg * 8, t0 = tg * 16, l0 = t0 & (L - 1);
        float w[4][8], bias[8];
#pragma unroll
        for (int j = 0; j < 4; ++j) { const float4 a = *(const float4*)(p.conv_w + j * 1536 + ch), b2 = *(const float4*)(p.conv_w + j * 1536 + ch + 4); w[j][0] = a.x; w[j][1] = a.y; w[j][2] = a.z; w[j][3] = a.w; w[j][4] = b2.x; w[j][5] = b2.y; w[j][6] = b2.z; w[j][7] = b2.w; }
        { const float4 a = *(const float4*)(p.conv_b + ch), b2 = *(const float4*)(p.conv_b + ch + 4); bias[0] = a.x; bias[1] = a.y; bias[2] = a.z; bias[3] = a.w; bias[4] = b2.x; bias[5] = b2.y; bias[6] = b2.z; bias[7] = b2.w; }
        float x0[8], x1[8], x2[8], x3[8];
        { uint4 h0 = make_uint4(0u, 0u, 0u, 0u), h1 = h0, h2 = h0;
          if (l0 != 0) { h0 = *(const uint4*)(xbc + (size_t)(t0 - 3) * 1536 + ch); h1 = *(const uint4*)(xbc + (size_t)(t0 - 2) * 1536 + ch); h2 = *(const uint4*)(xbc + (size_t)(t0 - 1) * 1536 + ch); }
          unpack8(h0, x0); unpack8(h1, x1); unpack8(h2, x2); }
#pragma unroll
        for (int u = 0; u < 16; ++u) {
            unpack8(*(const uint4*)(xbc + (size_t)(t0 + u) * 1536 + ch), x3);
            float y[8];
#pragma unroll
            for (int i = 0; i < 8; ++i) { const float v = bias[i] + w[0][i] * x0[i] + w[1][i] * x1[i] + w[2][i] * x2[i] + w[3][i] * x3[i]; y[i] = v * sigmoidf(v); x0[i] = x1[i]; x1[i] = x2[i]; x2[i] = x3[i]; }
            *(uint4*)(xsbc + (size_t)(t0 + u) * 1536 + ch) = pack8(y);
        }
    }
    const bf16* dtg = (const bf16*)(ws + OFF_DTG); float* dt = (float*)(ws + OFF_DT); float* gate = (float*)(ws + OFF_GATE);
    for (int i = gtid; i < T * 64; i += gn) {
        const int t = i >> 6, c = i & 63; const float v = bf2f(dtg[i]);
        if (c < 16) { const float xx = v + p.dt_bias[c]; dt[t * 16 + c] = xx > 20.f ? xx : log1pf(__expf(xx)); }
        else gate[t * 48 + (c - 16)] = sigmoidf(v);
    }
    const float* rc = (const float*)(ws + OFF_ROPE); const float* rs = rc + 4096 * 32;
    bf16* q = (bf16*)(ws + OFF_Q); bf16* kvs = (bf16*)(ws + OFF_KVS);
    for (int it = gtid; it < T * 24 * 4; it += gn) {
        const int j0 = (it & 3) * 8, hh = (it >> 2) % 24, t = it / 96, l = t & (L - 1);
        bf16* pp; float sc;
        if (hh < 16) { pp = q + (size_t)t * 1024 + hh * 64 + j0; sc = 0.125f * 1.4426950408889634f; } else if (hh < 20) { pp = kvs + (size_t)t * 1536 + 512 + (hh - 16) * 64 + j0; sc = 1.f; } else { pp = kvs + (size_t)t * 1536 + 1024 + (hh - 20) * 64 + j0; sc = 1.f; }
        float x1[8], x2[8], c[8], s[8], o1[8], o2[8];
        unpack8(*(const uint4*)pp, x1); unpack8(*(const uint4*)(pp + 32), x2);
        { const float4 a = *(const float4*)(rc + l * 32 + j0), b2 = *(const float4*)(rc + l * 32 + j0 + 4), d = *(const float4*)(rs + l * 32 + j0), e = *(const float4*)(rs + l * 32 + j0 + 4);
          c[0] = a.x; c[1] = a.y; c[2] = a.z; c[3] = a.w; c[4] = b2.x; c[5] = b2.y; c[6] = b2.z; c[7] = b2.w; s[0] = d.x; s[1] = d.y; s[2] = d.z; s[3] = d.w; s[4] = e.x; s[5] = e.y; s[6] = e.z; s[7] = e.w; }
#pragma unroll
        for (int i = 0; i < 8; ++i) { o1[i] = (x1[i] * c[i] - x2[i] * s[i]) * sc; o2[i] = (x1[i] * s[i] + x2[i] * c[i]) * sc; }
        *(uint4*)pp = pack8(o1); *(uint4*)(pp + 32) = pack8(o2);
    }
}

__device__ __forceinline__ void ph_ssd_prep2(const Params& p, int wv, unsigned char* lds) {
    PH_IDS(); unsigned char* ws = p.ws;
    const bf16* xsbc = (const bf16*)(ws + OFF_XSBC); const float* dt = (const float*)(ws + OFF_DT);
    bf16* XdT = (bf16*)p.out; bf16* BT = (bf16*)(ws + OFF_BT); float* acsT = (float*)(ws + OFF_ACS);
    float* sdt = (float*)lds; float* swave = sdt + 128;
    const int bide = nb > 64 ? bid - 32 : bid, nbe = nb > 64 ? nb - 32 : nb; if (bide < 0) return;
    for (int unit = bide; unit < 2048 + 256; unit += nbe) {
        __syncthreads();
        if (unit < 2048) {
            const int h = unit & 15, bc = unit >> 4; const size_t t0 = (size_t)bc * 128;
            const float A = -__expf(p.a_log[h]);
            if (tid < 128) { const float dv = dt[(t0 + tid) * 16 + h]; sdt[tid] = dv; float a = dv * A;
#pragma unroll
                for (int o = 1; o < 64; o <<= 1) { const float v = __shfl_up(a, o); if (lane >= o) a += v; }
                if (lane == 63) swave[tid >> 6] = a;
                sdt[128 + 8 + tid] = a; }
            __syncthreads();
            if (tid < 128) { float a = sdt[128 + 8 + tid]; if (tid >= 64) a += swave[0]; acsT[(size_t)unit * 128 + tid] = a; }
            const int pp = tid & 63, lg = tid >> 6; const bf16* src = xsbc + (t0 + lg * 16) * 1536 + h * 64 + pp;
            unsigned w[8];
#pragma unroll
            for (int i = 0; i < 8; ++i) { const float v0 = bf2f(src[(size_t)(2 * i) * 1536]) * sdt[lg * 16 + 2 * i], v1 = bf2f(src[(size_t)(2 * i + 1) * 1536]) * sdt[lg * 16 + 2 * i + 1]; w[i] = (unsigned)f2bf(v0) | ((unsigned)f2bf(v1) << 16); }
            uint4* dst = (uint4*)(XdT + (size_t)unit * 8192 + pp * 128 + lg * 16);
            dst[0] = make_uint4(w[0], w[1], w[2], w[3]); dst[1] = make_uint4(w[4], w[5], w[6], w[7]);
        } else {
            const int u2 = unit - 2048, g = u2 & 1, bc = u2 >> 1; const size_t t0 = (size_t)bc * 128;
            const int n = tid & 127, lg = tid >> 7; const bf16* src = xsbc + (t0 + lg * 32) * 1536 + 1024 + g * 128 + n;
            uint4* dst = (uint4*)(BT + (size_t)u2 * 16384 + n * 128 + lg * 32);
#pragma unroll
            for (int k = 0; k < 4; ++k) { unsigned w[4];
#pragma unroll
                for (int i = 0; i < 4; ++i) w[i] = (unsigned)src[(size_t)(8 * k + 2 * i) * 1536] | ((unsigned)src[(size_t)(8 * k + 2 * i + 1) * 1536] << 16);
                dst[k] = make_uint4(w[0], w[1], w[2], w[3]); }
        }
    }
}
__device__ __forceinline__ bf16x8 scale_frag(bf16x8 a, const float* s) {
    bf16x8 o;
#pragma unroll
    for (int j = 0; j < 8; ++j) o[j] = (short)f2bf(bf2f((bf16)a[j]) * s[j]);
    return o;
}
__device__ __forceinline__ void ph_ssd_states(const Params& p, int wv) {
    PH_IDS(); unsigned char* ws = p.ws; const int r = lane & 15, q = lane >> 4;
    const bf16* XdT = (const bf16*)p.out; bf16* S = (bf16*)((unsigned char*)p.out + 32 * MiB); const bf16* BT = (const bf16*)(ws + OFF_BT); const float* acsT = (const float*)(ws + OFF_ACS);
    for (int task = gwave; task < 8192; task += nwaves) {
        const int pt = task & 3, unit = task >> 2, h = unit & 15, bc = unit >> 4, g = h >> 3;
        const float* ac = acsT + (size_t)unit * 128; const float alast = ac[127];
        const bf16* xrow = XdT + (size_t)unit * 8192 + (pt * 16 + r) * 128; const bf16* bt = BT + (size_t)(bc * 2 + g) * 16384 + r * 128;
        f32x4 acc[8];
#pragma unroll
        for (int i = 0; i < 8; ++i) acc[i] = (f32x4){0.f, 0.f, 0.f, 0.f};
#pragma unroll
        for (int ks = 0; ks < 4; ++ks) {
            const int l0 = ks * 32 + 8 * q; float dec[8];
#pragma unroll
            for (int j = 0; j < 8; ++j) dec[j] = __expf(alast - ac[l0 + j]);
            const bf16x8 af = scale_frag(*(const bf16x8*)(xrow + l0), dec);
#pragma unroll
            for (int nt = 0; nt < 8; ++nt) acc[nt] = __builtin_amdgcn_mfma_f32_16x16x32_bf16(af, *(const bf16x8*)(bt + (size_t)nt * 2048 + l0), acc[nt], 0, 0, 0);
        }
        bf16* so = S + (size_t)unit * 8192 + (pt * 16 + 4 * q) * 128 + r;
#pragma unroll
        for (int nt = 0; nt < 8; ++nt)
#pragma unroll
            for (int e = 0; e < 4; ++e) so[e * 128 + nt * 16] = f2bf(acc[nt][e]);
    }
}
__device__ __forceinline__ void ph_ssd_scan(const Params& p, int wv) {
    PH_IDS();
    unsigned* S = (unsigned*)((unsigned char*)p.out + 32 * MiB); const float* acsT = (const float*)(p.ws + OFF_ACS);
    for (int e = gtid; e < NBATCH * 16 * 4096; e += gn) {
        const int pn = e & 4095, h = (e >> 12) & 15, b = e >> 16; float r0 = 0.f, r1 = 0.f;
        for (int c = 0; c < 32; c += 4) {
            unsigned v[4]; float d[4];
#pragma unroll
            for (int u = 0; u < 4; ++u) { const int unit = (b * 32 + c + u) * 16 + h; v[u] = S[(size_t)unit * 4096 + pn]; d[u] = __expf(acsT[(size_t)unit * 128 + 127]); }
#pragma unroll
            for (int u = 0; u < 4; ++u) { const int unit = (b * 32 + c + u) * 16 + h; S[(size_t)unit * 4096 + pn] = (unsigned)f2bf(r0) | ((unsigned)f2bf(r1) << 16);
                r0 = r0 * d[u] + bf2f((bf16)(v[u] & 0xffffu)); r1 = r1 * d[u] + bf2f((bf16)(v[u] >> 16)); }
        }
    }
}
__device__ __forceinline__ void ph_ssd_out(const Params& p, int wv) {
    PH_IDS(); unsigned char* ws = p.ws; const int r = lane & 15, q = lane >> 4;
    const bf16* XdT = (const bf16*)p.out; const bf16* S = (const bf16*)((unsigned char*)p.out + 32 * MiB); const bf16* xsbc = (const bf16*)(ws + OFF_XSBC);
    const float* acsT = (const float*)(ws + OFF_ACS); bf16* z = (bf16*)(ws + OFF_Z); float* ssq2p = (float*)(ws + OFF_HID);
    for (int task = gwave; task < 16384; task += nwaves) {
        const int lt = 7 - (task & 7), unit = task >> 3, h = unit & 15, bc = unit >> 4, g = h >> 3; const size_t t0 = (size_t)bc * 128;
        const float* ac = acsT + (size_t)unit * 128; const float Dh = p.d_skip[h];
        bf16x8 Cf[4];
#pragma unroll
        for (int ks = 0; ks < 4; ++ks) Cf[ks] = *(const bf16x8*)(xsbc + (t0 + lt * 16 + r) * 1536 + 1280 + g * 128 + ks * 32 + 8 * q);
        const float acl = ac[lt * 16 + r]; const int lrow = lt * 16 + r;
        f32x4 acc[4];
#pragma unroll
        for (int i = 0; i < 4; ++i) acc[i] = (f32x4){0.f, 0.f, 0.f, 0.f};
        const bf16* xd = XdT + (size_t)unit * 8192 + r * 128;
        for (int kk = 0; kk <= (lt >> 1); ++kk) {
            bf16x8 mf;
#pragma unroll
            for (int half = 0; half < 2; ++half) {
                const int st = 2 * kk + half; f32x4 cb = (f32x4){0.f, 0.f, 0.f, 0.f};
                if (st <= lt) {
                    const bf16* brow = xsbc + (t0 + st * 16 + r) * 1536 + 1024 + g * 128 + 8 * q;
#pragma unroll
                    for (int ks = 0; ks < 4; ++ks) cb = __builtin_amdgcn_mfma_f32_16x16x32_bf16(*(const bf16x8*)(brow + ks * 32), Cf[ks], cb, 0, 0, 0);
                    const f32x4 as4 = *(const f32x4*)(ac + st * 16 + 4 * q);
#pragma unroll
                    for (int e = 0; e < 4; ++e) { const int s = st * 16 + 4 * q + e; cb[e] = (lrow >= s) ? cb[e] * __expf(acl - as4[e]) : 0.f; }
                }
#pragma unroll
                for (int e = 0; e < 4; ++e) mf[half * 4 + e] = (short)f2bf(cb[e]);
            }
#pragma unroll
            for (int pt = 0; pt < 4; ++pt) {
                const uint2 lo = *(const uint2*)(xd + (size_t)pt * 2048 + 32 * kk + 4 * q), hi = *(const uint2*)(xd + (size_t)pt * 2048 + 32 * kk + 16 + 4 * q);
                union { uint4 u; bf16x8 v; } xf; xf.u = make_uint4(lo.x, lo.y, hi.x, hi.y);
                acc[pt] = __builtin_amdgcn_mfma_f32_16x16x32_bf16(mf, xf.v, acc[pt], 0, 0, 0);
            }
        }
        f32x4 acc2[4];
#pragma unroll
        for (int i = 0; i < 4; ++i) acc2[i] = (f32x4){0.f, 0.f, 0.f, 0.f};
        const bf16* sin = S + (size_t)unit * 8192 + r * 128 + 8 * q;
#pragma unroll
        for (int ks = 0; ks < 4; ++ks)
#pragma unroll
            for (int pt = 0; pt < 4; ++pt) acc2[pt] = __builtin_amdgcn_mfma_f32_16x16x32_bf16(Cf[ks], *(const bf16x8*)(sin + (size_t)pt * 2048 + ks * 32), acc2[pt], 0, 0, 0);
#pragma unroll
        for (int e = 0; e < 4; ++e) {
            const int l = lt * 16 + 4 * q + e; const size_t t = t0 + l; const float od = __expf(ac[l]); float ss = 0.f;
#pragma unroll
            for (int pt = 0; pt < 4; ++pt) { const int col = h * 64 + pt * 16 + r; const float xv = bf2f(xsbc[t * 1536 + col]);
                const float y = acc[pt][e] + od * acc2[pt][e] + Dh * xv; const float zz = bf2f(z[t * 1024 + col]); const float v = y * (zz * sigmoidf(zz));
                z[t * 1024 + col] = f2bf(v); ss += v * v; }
            ss += __shfl_xor(ss, 1); ss += __shfl_xor(ss, 2); ss += __shfl_xor(ss, 4); ss += __shfl_xor(ss, 8);
            if (r == 0) ssq2p[t * 16 + h] = ss;
        }
    }
}

struct ACmp {
    const bf16* kvs; int coff;
    __device__ __forceinline__ bf16x8 operator()(int m, int k) const {
        const int hk = m & 3, n = (m >> 2) & 255, b = m >> 10, l = k >> 6, d = k & 63;
        if (n == 255) return (bf16x8){0, 0, 0, 0, 0, 0, 0, 0};
        return *(const bf16x8*)(kvs + (size_t)(b * L + 16 * n + l) * 1536 + coff + hk * 64 + d);
    }
};
struct EpiHid { bf16* hid; const float* bias; __device__ __forceinline__ void operator()(int row, int c, float v) const { hid[(size_t)row * 256 + c] = f2bf(gelu_exact(v + bias[c])); } };
struct EpiKc {
    bf16* dst; bool tr; __device__ __forceinline__ void operator()(int m, int c, float v) const { const int hk = m & 3, n = (m >> 2) & 255, b = m >> 10; const bf16 o = (n == 255) ? (bf16)0 : f2bf(v);
        if (tr) dst[((size_t)(b * 4 + hk) * 64 + c) * 256 + n] = o; else dst[((size_t)(b * 4 + hk) * 256 + n) * 64 + c] = o; } };
__device__ __forceinline__ void ph_kc_rope(const Params& p, int wv) {
    PH_IDS(); unsigned char* ws = p.ws; bf16* kc = (bf16*)(ws + OFF_KC); const float* rc = (const float*)(ws + OFF_ROPE); const float* rs = rc + 4096 * 32;
    for (int i = gtid; i < 16 * 256 * 32; i += gn) {
        const int j = i & 31, n = (i >> 5) & 255, bh = i >> 13; const int pos = 16 * n + 31; if (n == 255) continue;
        const float c = rc[pos * 32 + j], s = rs[pos * 32 + j];
        bf16* pp = kc + ((size_t)bh * 256 + n) * 64 + j; const float x1 = bf2f(pp[0]), x2 = bf2f(pp[32]);
        pp[0] = f2bf(x1 * c - x2 * s); pp[32] = f2bf(x1 * s + x2 * c);
    }
}


__device__ __forceinline__ void ph_vt_prep(const Params& p, int wv) {
    PH_IDS(); unsigned char* ws = p.ws; const bf16* kvs = (const bf16*)(ws + OFF_KVS);
    const int bide = nb > 64 ? bid - 32 : bid, nbe = nb > 64 ? nb - 32 : nb; if (bide < 0) return;
    for (int unit = bide; unit < 2 * 16 * 64; unit += nbe) {
        const int br = unit & 1, tl = (unit >> 1) & 63, bh = unit >> 7, b = bh >> 2, hk = bh & 3;
        const int d = tid & 63, grp = tid >> 6; const int l0 = tl * 64 + grp * 8;
        const bf16* src = kvs + ((size_t)b * L + l0) * 1536 + (br ? 1280 : 768) + hk * 64 + d;
        unsigned w[4];
#pragma unroll
        for (int i = 0; i < 4; ++i) w[i] = (unsigned)src[(size_t)(2 * i) * 1536] | ((unsigned)src[(size_t)(2 * i + 1) * 1536] << 16);
        bf16* dst = (bf16*)(ws + (br ? OFF_VWT : OFF_VST)) + ((size_t)bh * 64 + d) * L + l0;
        *(uint4*)dst = make_uint4(w[0], w[1], w[2], w[3]);
    }
}

typedef float f32x16 __attribute__((ext_vector_type(16)));
__device__ __forceinline__ int crow(int r, int hi) { return (r & 3) + 8 * (r >> 2) + 4 * hi; }
constexpr int NSA_KROW = 144, NSA_VROW = 136, NSA_KBUF = 64 * NSA_KROW, NSA_VBUF = 64 * NSA_VROW;
constexpr int NSA_OFF_STASH = 73728;
constexpr int NSA_OFF_K = 0, NSA_OFF_V = 2 * NSA_KBUF, NSA_OFF_IMPA = NSA_OFF_V + 2 * NSA_VBUF, NSA_IMPS = 65, NSA_OFF_IMPB = NSA_OFF_IMPA + 64 * NSA_IMPS * 4, NSA_OFF_SEL = NSA_OFF_IMPB + 64 * NSA_IMPS * 4;
struct NsaSrc { const bf16* K; size_t kstride; const bf16* VT; size_t ldv; };
__device__ __forceinline__ void nsa_gload(const NsaSrc& s, int k0, int tid, uint4& kr, uint4& vr) {
    const int row = tid >> 3, ch = tid & 7;
    kr = *(const uint4*)(s.K + (size_t)(k0 + row) * s.kstride + ch * 8);
    vr = *(const uint4*)(s.VT + (size_t)row * s.ldv + k0 + ch * 8);
}
__device__ __forceinline__ void nsa_lstore(unsigned char* kb, unsigned char* vb, int tid, const uint4& kr, const uint4& vr) {
    const int row = tid >> 3, ch = tid & 7;
    *(uint4*)(kb + row * NSA_KROW + ch * 16) = kr;
    uint2* vp = (uint2*)(vb + row * NSA_VROW + ch * 16); vp[0] = make_uint2(vr.x, vr.y); vp[1] = make_uint2(vr.z, vr.w);
}
__device__ __forceinline__ void nsa_qk(const unsigned char* kb, const bf16x8 (&qf)[4], int rr, int hi, f32x16& p0, f32x16& p1) {
#pragma unroll
    for (int i = 0; i < 16; ++i) { p0[i] = 0.f; p1[i] = 0.f; }
#pragma unroll
    for (int ds = 0; ds < 4; ++ds) {
        const bf16x8 a0 = *(const bf16x8*)(kb + rr * NSA_KROW + ds * 32 + hi * 16), a1 = *(const bf16x8*)(kb + (rr + 32) * NSA_KROW + ds * 32 + hi * 16);
        p0 = __builtin_amdgcn_mfma_f32_32x32x16_bf16(a0, qf[ds], p0, 0, 0, 0); p1 = __builtin_amdgcn_mfma_f32_32x32x16_bf16(a1, qf[ds], p1, 0, 0, 0);
    }
}
__device__ __forceinline__ void nsa_pv(const unsigned char* vb, int rr, int hi, const f32x16& p0, const f32x16& p1, f32x16 (&O)[2]) {
#pragma unroll
    for (int s = 0; s < 4; ++s) {
        const int eb = 8 * (s & 1), kbase = 32 * (s >> 1) + 16 * (s & 1);
        union { uint4 u; bf16x8 v; } pf;
        if (s < 2) pf.u = make_uint4(pk2bf(p0[eb], p0[eb + 1]), pk2bf(p0[eb + 2], p0[eb + 3]), pk2bf(p0[eb + 4], p0[eb + 5]), pk2bf(p0[eb + 6], p0[eb + 7]));
        else       pf.u = make_uint4(pk2bf(p1[eb], p1[eb + 1]), pk2bf(p1[eb + 2], p1[eb + 3]), pk2bf(p1[eb + 4], p1[eb + 5]), pk2bf(p1[eb + 6], p1[eb + 7]));
#pragma unroll
        for (int dsub = 0; dsub < 2; ++dsub) {
            const unsigned char* vp = vb + (dsub * 32 + rr) * NSA_VROW + (kbase + 4 * hi) * 2;
            const uint2 lo = *(const uint2*)vp, hh = *(const uint2*)(vp + 16);
            union { uint4 u; bf16x8 v; } vf; vf.u = make_uint4(lo.x, lo.y, hh.x, hh.y);
            O[dsub] = __builtin_amdgcn_mfma_f32_32x32x16_bf16(vf.v, pf.v, O[dsub], 0, 0, 0);
        }
    }
}
template <int MODE>
__device__ __forceinline__ void nsa_branch(unsigned char* lds, const NsaSrc& src, int jt0, int jt1, int tid, int rr, int hi, const bf16x8 (&qf)[4], int lpos, int qi, int tokblk,
                                           u64 selm, u64 wsel, float& m, float& lsum, float inv_l, f32x16 (&O)[2]) {
    if (jt0 >= jt1) return;
    asm volatile("" : "+v"(tid), "+v"(rr));
    float* impA = (float*)(lds + NSA_OFF_IMPA); float* impB = (float*)(lds + NSA_OFF_IMPB);
    uint4 kr, vr;
    nsa_gload(src, jt0 * 64, tid, kr, vr);
    nsa_lstore(lds + NSA_OFF_K, lds + NSA_OFF_V, tid, kr, vr);
    __syncthreads();
    for (int jt = jt0; jt < jt1; ++jt) {
        const int cur = (jt - jt0) & 1; const bool more = (jt + 1 < jt1);
        if (more) nsa_gload(src, (jt + 1) * 64, tid, kr, vr);
        const unsigned char* kb = lds + NSA_OFF_K + cur * NSA_KBUF; const unsigned char* vb = lds + NSA_OFF_V + cur * NSA_VBUF;
        const bool active = (MODE != 2) || ((wsel >> jt) & 1ull);
        if (active) {
            f32x16 p0, p1; nsa_qk(kb, qf, rr, hi, p0, p1);
            const int k0 = jt * 64;
            const bool tile_on = (MODE != 2) || ((selm >> jt) & 1ull);
            bool full;
            if (MODE <= 1) full = (16 * (k0 + 63) + 31 <= qi * 64); else if (MODE == 2) full = (jt < qi); else full = (jt > qi - 8) && (jt < qi);
            float mx = NEG_INF;
            if (full) {
#pragma unroll
                for (int e = 0; e < 16; ++e) mx = fmaxf(mx, fmaxf(p0[e], p1[e]));
                if (MODE == 2 && !tile_on) mx = NEG_INF;
            } else {
                const int lim = (MODE <= 1) ? (lpos - 31 - 16 * k0 - 64 * hi) : (lpos - k0 - 4 * hi);
#pragma unroll
                for (int e = 0; e < 16; ++e) {
                    const int ca = (e & 3) + 8 * (e >> 2), cb = ca + 32; bool oa, ob;
                    if (MODE <= 1) { oa = (16 * ca <= lim); ob = (16 * cb <= lim); }
                    else if (MODE == 2) { oa = (ca <= lim); ob = (cb <= lim); }
                    else { oa = (ca <= lim) && (ca > lim - 512); ob = (cb <= lim) && (cb > lim - 512); }
                    p0[e] = oa ? p0[e] : NEG_INF; p1[e] = ob ? p1[e] : NEG_INF; mx = fmaxf(mx, fmaxf(p0[e], p1[e]));
                }
            }
            if (MODE != 1) {
                mx = fmaxf(mx, __shfl_xor(mx, 32));
                const float mnew = fmaxf(m, mx);
                if (__any((mnew - m) > 6.0f)) {
                    const float alpha = __builtin_amdgcn_exp2f(m - mnew); m = mnew; lsum *= alpha;
                    if (MODE != 0) {
#pragma unroll
                        for (int e = 0; e < 16; ++e) { O[0][e] *= alpha; O[1][e] *= alpha; }
                    }
                }
                const float meff = (MODE == 2 && full && !tile_on) ? BIG : ((m > 0.5f * NEG_INF) ? m : BIG);
                float rs = 0.f;
#pragma unroll
                for (int e = 0; e < 16; ++e) { p0[e] = __builtin_amdgcn_exp2f(p0[e] - meff); p1[e] = __builtin_amdgcn_exp2f(p1[e] - meff); rs += p0[e] + p1[e]; }
                lsum += rs;
                if (MODE != 0) nsa_pv(vb, rr, hi, p0, p1, O);
            } else {
#pragma unroll
                for (int e = 0; e < 16; ++e) { p0[e] = __builtin_amdgcn_exp2f(p0[e] - m) * inv_l; p1[e] = __builtin_amdgcn_exp2f(p1[e] - m) * inv_l; }
                nsa_pv(vb, rr, hi, p0, p1, O);
#pragma unroll
                for (int sub = 0; sub < 2; ++sub)
#pragma unroll
                    for (int a = 0; a < 4; ++a) {
                        float G, last;
                        if (sub == 0) { G = (p0[4 * a] + p0[4 * a + 1]) + (p0[4 * a + 2] + p0[4 * a + 3]); last = p0[4 * a + 3]; } else { G = (p1[4 * a] + p1[4 * a + 1]) + (p1[4 * a + 2] + p1[4 * a + 3]); last = p1[4 * a + 3]; }
                        G += __shfl_xor(G, 1); G += __shfl_xor(G, 2); last += __shfl_xor(last, 1); last += __shfl_xor(last, 2);
                        const int jj = (k0 >> 2) + 8 * sub + 2 * a + hi;
                        if ((rr & 3) == 0) { impA[tokblk * NSA_IMPS + jj] = G; if (jj + 1 < 64) impB[tokblk * NSA_IMPS + jj + 1] = last; }
                    }
            }
        }
        if (more) nsa_lstore(lds + NSA_OFF_K + (cur ^ 1) * NSA_KBUF, lds + NSA_OFF_V + (cur ^ 1) * NSA_VBUF, tid, kr, vr);
        __syncthreads();
    }
}
__device__ __forceinline__ void ph_nsa(const Params& p, int wv, unsigned char* lds) {
    PH_IDS(); unsigned char* ws = p.ws; const int wave = wv, rr = lane & 31, hi = lane >> 5;
    bf16* q = (bf16*)(ws + OFF_Q); const bf16* kvs = (const bf16*)(ws + OFF_KVS);
    const float* gate = (const float*)(ws + OFF_GATE); float* ssq = (float*)(ws + OFF_SSQ);
    float* impA = (float*)(lds + NSA_OFF_IMPA); float* impB = (float*)(lds + NSA_OFF_IMPB); u64* selw = (u64*)(lds + NSA_OFF_SEL);
    unsigned* qctr = (unsigned*)(ws + OFF_BAR + 14336) + 64 * (bid & 7); volatile int* ucur = (volatile int*)(lds + NSA_OFF_SEL + 512);
    for (;;) {
        if (tid == 0) *ucur = (int)__hip_atomic_fetch_add(qctr, 1u, __ATOMIC_RELAXED, __HIP_MEMORY_SCOPE_AGENT);
        __syncthreads();
        const int u = *ucur;
        if (u >= 128) break;
        const int bh = (bid & 7) + 8 * (u & 1), qi = 63 - (u >> 1);
        const int b = bh >> 2, hk = bh & 3; const int tokblk = wave * 8 + (rr >> 2), g = rr & 3; const int lpos = qi * 64 + tokblk; const size_t t = (size_t)b * L + lpos;
        bf16* qrow = q + t * 1024 + (hk * 4 + g) * 64;
        bf16x8 qf[4];
#pragma unroll
        for (int ds = 0; ds < 4; ++ds) qf[ds] = *(const bf16x8*)(qrow + ds * 16 + hi * 8);
        for (int i = tid; i < 64 * NSA_IMPS; i += NTHREADS) { impA[i] = 0.f; impB[i] = 0.f; }
        __syncthreads();
        f32x16 O[2]; float* stash = (float*)(lds + NSA_OFF_STASH) + tid;
        const float g0 = gate[t * 48 + (hk * 4 + g) * 3 + 0], g1 = gate[t * 48 + (hk * 4 + g) * 3 + 1], g2 = gate[t * 48 + (hk * 4 + g) * 3 + 2];
        {
            NsaSrc s{(const bf16*)(ws + OFF_KC) + (size_t)bh * 256 * 64, 64, (const bf16*)(ws + OFF_VCT) + (size_t)bh * 64 * 256, 256};
            const int nct = (4 * qi + 3 + 63) >> 6;
            float m = NEG_INF, lsum = 0.f;
            nsa_branch<0>(lds, s, 0, nct, tid, rr, hi, qf, lpos, qi, tokblk, 0ull, 0ull, m, lsum, 0.f, O);
            lsum += __shfl_xor(lsum, 32);
            const float inv_l = lsum > 0.f ? 1.0f / lsum : 0.f;
#pragma unroll
            for (int e = 0; e < 16; ++e) { O[0][e] = 0.f; O[1][e] = 0.f; }
            nsa_branch<1>(lds, s, 0, nct, tid, rr, hi, qf, lpos, qi, tokblk, 0ull, 0ull, m, lsum, inv_l, O);
#pragma unroll
            for (int e = 0; e < 16; ++e) { stash[e * 512] = g0 * O[0][e]; stash[(16 + e) * 512] = g0 * O[1][e]; }
        }
        {
            const int tk = tid >> 3, jg = tid & 7; float v[8];
#pragma unroll
            for (int i = 0; i < 8; ++i) { const int j = jg * 8 + i; const float raw = impA[tk * NSA_IMPS + j] + impB[tk * NSA_IMPS + j];
                const bool causal = (j <= qi), forced = (j == 0) || (j == qi) || (j == qi - 1); v[i] = causal ? (forced ? BIG : raw) : NEG_INF; }
            __syncthreads();
#pragma unroll
            for (int i = 0; i < 8; ++i) impA[tk * NSA_IMPS + jg * 8 + i] = v[i];
            __syncthreads();
            int rank[8];
#pragma unroll
            for (int i = 0; i < 8; ++i) rank[i] = 0;
            for (int jj = 0; jj < 64; ++jj) { const float x = impA[tk * NSA_IMPS + jj];
#pragma unroll
                for (int i = 0; i < 8; ++i) rank[i] += (x > v[i] || (x == v[i] && jj < jg * 8 + i)) ? 1 : 0; }
            unsigned b8 = 0u;
#pragma unroll
            for (int i = 0; i < 8; ++i) b8 |= (rank[i] < 16 && jg * 8 + i <= qi) ? (1u << i) : 0u;
            const u64 full = (u64)b8 << (jg * 8); unsigned blo = (unsigned)full, bhi = (unsigned)(full >> 32);
            blo |= __shfl_xor(blo, 1); bhi |= __shfl_xor(bhi, 1); blo |= __shfl_xor(blo, 2); bhi |= __shfl_xor(bhi, 2); blo |= __shfl_xor(blo, 4); bhi |= __shfl_xor(bhi, 4);
            if (jg == 0) selw[tk] = (u64)blo | ((u64)bhi << 32);
            __syncthreads();
        }
        const u64 selm = selw[tokblk];
        u64 wsel = selm;
        { unsigned lo = (unsigned)wsel, h2 = (unsigned)(wsel >> 32);
          lo |= __shfl_xor(lo, 4); h2 |= __shfl_xor(h2, 4); lo |= __shfl_xor(lo, 8); h2 |= __shfl_xor(h2, 8); lo |= __shfl_xor(lo, 16); h2 |= __shfl_xor(h2, 16);
          wsel = (u64)lo | ((u64)h2 << 32); }
        {
            NsaSrc s{kvs + (size_t)b * L * 1536 + 512 + hk * 64, 1536, (const bf16*)(ws + OFF_VST) + (size_t)bh * 64 * L, (size_t)L};
            float m = NEG_INF, lsum = 0.f;
#pragma unroll
            for (int e = 0; e < 16; ++e) { O[0][e] = 0.f; O[1][e] = 0.f; }
            nsa_branch<2>(lds, s, 0, qi + 1, tid, rr, hi, qf, lpos, qi, tokblk, selm, wsel, m, lsum, 0.f, O);
            lsum += __shfl_xor(lsum, 32); const float sc = g1 / lsum;
#pragma unroll
            for (int e = 0; e < 16; ++e) { stash[e * 512] += sc * O[0][e]; stash[(16 + e) * 512] += sc * O[1][e]; }
        }
        {
            NsaSrc s{kvs + (size_t)b * L * 1536 + 1024 + hk * 64, 1536, (const bf16*)(ws + OFF_VWT) + (size_t)bh * 64 * L, (size_t)L};
            float m = NEG_INF, lsum = 0.f;
#pragma unroll
            for (int e = 0; e < 16; ++e) { O[0][e] = 0.f; O[1][e] = 0.f; }
            nsa_branch<3>(lds, s, qi >= 8 ? qi - 8 : 0, qi + 1, tid, rr, hi, qf, lpos, qi, tokblk, 0ull, 0ull, m, lsum, 0.f, O);
            lsum += __shfl_xor(lsum, 32); const float sc = g2 / lsum;
#pragma unroll
            for (int e = 0; e < 16; ++e) { O[0][e] = stash[e * 512] + sc * O[0][e]; O[1][e] = stash[(16 + e) * 512] + sc * O[1][e]; }
        }
        float ss = 0.f;
#pragma unroll
        for (int dsub = 0; dsub < 2; ++dsub)
#pragma unroll
            for (int a = 0; a < 4; ++a) {
                const float v0 = O[dsub][4 * a], v1 = O[dsub][4 * a + 1], v2 = O[dsub][4 * a + 2], v3 = O[dsub][4 * a + 3];
                ss += (v0 * v0 + v1 * v1) + (v2 * v2 + v3 * v3);
                *(uint2*)(qrow + dsub * 32 + 8 * a + 4 * hi) = make_uint2(pk2bf(v0, v1), pk2bf(v2, v3));
            }
        ss += __shfl_xor(ss, 32); ss += __shfl_xor(ss, 1); ss += __shfl_xor(ss, 2);
        if (hi == 0 && g == 0) ssq[t * 4 + hk] = ss;
        __syncthreads();
    }
}

constexpr size_t OFF_SU = 640 * 1024, OFF_SV = 704 * 1024, OFF_SX = 768 * 1024, OFF_SC = 832 * 1024;
constexpr size_t OFF_COEFQ = 218 * MiB, OFF_H1Q = 220 * MiB;
__device__ __forceinline__ unsigned pack4i8(float a, float b, float c, float d) {
    const int ia = (int)rintf(a), ib = (int)rintf(b), ic = (int)rintf(c), id = (int)rintf(d);
    return (unsigned)(ia & 0xff) | ((unsigned)(ib & 0xff) << 8) | ((unsigned)(ic & 0xff) << 16) | ((unsigned)(id & 0xff) << 24);
}
__device__ __forceinline__ void ph_ln1(const Params& p, int wv) {
    PH_IDS(); unsigned char* ws = p.ws; bf16* h1b = (bf16*)(ws + OFF_H1B); unsigned char* h1q = ws + OFF_H1Q; float* sx = (float*)(ws + OFF_SX);
    for (int t = gwave; t < T; t += nwaves) {
        float v[16]; float s = 0.f; float* row = p.out + (size_t)t * 1024 + lane * 16;
#pragma unroll
        for (int i = 0; i < 4; ++i) { const float4 a = *(const float4*)(row + 4 * i); v[4 * i] = a.x; v[4 * i + 1] = a.y; v[4 * i + 2] = a.z; v[4 * i + 3] = a.w; s += (a.x + a.y) + (a.z + a.w); }
        const float mu = wave_sum(s) * (1.0f / 1024.0f); float s2 = 0.f;
#pragma unroll
        for (int i = 0; i < 16; ++i) { v[i] -= mu; s2 += v[i] * v[i]; }
        const float rstd = rsqrtf(wave_sum(s2) * (1.0f / 1024.0f) + LN_EPS); float amax = 0.f;
#pragma unroll
        for (int i = 0; i < 4; ++i) { const int c = lane * 16 + 4 * i; const float4 ga = *(const float4*)(p.ln1_g + c), ba = *(const float4*)(p.ln1_b + c);
            v[4 * i] = v[4 * i] * rstd * ga.x + ba.x; v[4 * i + 1] = v[4 * i + 1] * rstd * ga.y + ba.y; v[4 * i + 2] = v[4 * i + 2] * rstd * ga.z + ba.z; v[4 * i + 3] = v[4 * i + 3] * rstd * ga.w + ba.w;
            *(float4*)(row + 4 * i) = make_float4(v[4 * i], v[4 * i + 1], v[4 * i + 2], v[4 * i + 3]); }
#pragma unroll
        for (int i = 0; i < 16; ++i) amax = fmaxf(amax, fabsf(v[i]));
        amax = fmaxf(wave_max(amax), 1e-20f); const float inv = 127.0f / amax;
        *(uint4*)(h1b + (size_t)t * 1024 + lane * 16) = pack8(v); *(uint4*)(h1b + (size_t)t * 1024 + lane * 16 + 8) = pack8(v + 8);
        *(uint4*)(h1q + (size_t)t * 1024 + lane * 16) = make_uint4(pack4i8(v[0] * inv, v[1] * inv, v[2] * inv, v[3] * inv), pack4i8(v[4] * inv, v[5] * inv, v[6] * inv, v[7] * inv),
                                                                 pack4i8(v[8] * inv, v[9] * inv, v[10] * inv, v[11] * inv), pack4i8(v[12] * inv, v[13] * inv, v[14] * inv, v[15] * inv));
        if (lane == 0) sx[t] = amax * (1.0f / 127.0f);
    }
}

__device__ __forceinline__ unsigned umaxu(unsigned a, unsigned b) { return a > b ? a : b; }
__device__ __forceinline__ unsigned uminu(unsigned a, unsigned b) { return a < b ? a : b; }
__device__ __forceinline__ unsigned f2mono(float f) { const unsigned u = __float_as_uint(f); return (u & 0x80000000u) ? ~u : (u | 0x80000000u); }
__device__ __forceinline__ float mono2f(unsigned m) { return __uint_as_float((m & 0x80000000u) ? (m & 0x7fffffffu) : ~m); }
template <int N> __device__ __forceinline__ void bitonic_sort_desc(unsigned (&a)[N]) {
#pragma unroll
    for (int k = 2; k <= N; k <<= 1)
#pragma unroll
        for (int j = k >> 1; j > 0; j >>= 1)
#pragma unroll
            for (int i = 0; i < N; ++i) { const int l = i ^ j; if (l > i) { const bool desc = ((i & k) == 0); const unsigned x = a[i], y = a[l], mx = umaxu(x, y), mn = uminu(x, y); a[i] = desc ? mx : mn; a[l] = desc ? mn : mx; } }
}
__device__ __forceinline__ void merge_top16(unsigned (&a)[16], const unsigned (&b)[16]) {
#pragma unroll
    for (int i = 0; i < 16; ++i) a[i] = umaxu(a[i], b[15 - i]);
#pragma unroll
    for (int j = 8; j > 0; j >>= 1)
#pragma unroll
        for (int i = 0; i < 16; ++i) { const int l = i ^ j; if (l > i) { const unsigned x = a[i], y = a[l]; a[i] = umaxu(x, y); a[l] = uminu(x, y); } }
}
__device__ __forceinline__ void peer_stage1(const bf16* qrow, const bf16* krow, int hi, unsigned (&run)[16]) {
    bf16x8 qf[8];
#pragma unroll
    for (int ks = 0; ks < 8; ++ks) qf[ks] = *(const bf16x8*)(qrow + ks * 16);
#pragma unroll 1
    for (int kt = 0; kt < 4; ++kt) {
        f32x16 acc;
#pragma unroll
        for (int e = 0; e < 16; ++e) acc[e] = 0.f;
        const bf16* kr = krow + (size_t)kt * 32 * 128;
#pragma unroll
        for (int ks = 0; ks < 8; ++ks) acc = __builtin_amdgcn_mfma_f32_32x32x16_bf16(*(const bf16x8*)(kr + ks * 16), qf[ks], acc, 0, 0, 0);
        unsigned grp[16]; const unsigned ib = (unsigned)(127 - kt * 32 - 4 * hi);
#pragma unroll
        for (int e = 0; e < 16; ++e) grp[e] = (f2mono(acc[e]) & ~0x7fu) | (ib - (unsigned)((e & 3) + 8 * (e >> 2)));
        bitonic_sort_desc<16>(grp);
        if (kt == 0) {
#pragma unroll
            for (int i = 0; i < 16; ++i) run[i] = grp[i];
        } else merge_top16(run, grp);
    }
    unsigned oth[16];
#pragma unroll
    for (int i = 0; i < 16; ++i) oth[i] = __shfl_xor(run[i], 32);
    merge_top16(run, oth);
}
__device__ __forceinline__ void ph_peer_topk(const Params& p, int wv, unsigned char* lds) {
    PH_IDS(); unsigned char* ws = p.ws; const int rr = lane & 31, hi = lane >> 5;
    int* exl = (int*)(lds + wv * 6400);
    const bf16* qp = (const bf16*)(ws + OFF_QP); const bf16* keys = (const bf16*)(ws + OFF_KEYS);
    int* eidx = (int*)(ws + OFF_EIDX); float* gw = (float*)(ws + OFF_GW);
    for (int task = gwave; task < 512 * 8; task += nwaves) {
        const int h = task & 7, t0 = (task >> 3) * 32;
        unsigned top[2][16];
        peer_stage1(qp + (size_t)(t0 + rr) * 2048 + h * 256 + 8 * hi, keys + ((size_t)(h * 2) * 128 + rr) * 128 + 8 * hi, hi, top[0]);
        peer_stage1(qp + (size_t)(t0 + rr) * 2048 + h * 256 + 128 + 8 * hi, keys + ((size_t)(h * 2 + 1) * 128 + rr) * 128 + 8 * hi, hi, top[1]);
        unsigned g4[4][16];
#pragma unroll
        for (int k = 0; k < 4; ++k)
#pragma unroll
            for (int i = 0; i < 16; ++i) g4[k][i] = 0u;
#pragma unroll
        for (int i = 0; i < 16; ++i) {
            int off = 0;
#pragma unroll
            for (int k = 0; k < 16; ++k) if (k < i) off += 16 / (k + 1);
            const float s0 = mono2f(top[0][i] & ~0x7fu); const int e0 = (int)(127u - (top[0][i] & 0x7fu)) * 128;
#pragma unroll
            for (int j = 0; j < 16; ++j) if ((i + 1) * (j + 1) <= 16) {
                const int nc = off + j;
                const float sum = s0 + mono2f(top[1][j] & ~0x7fu);
                g4[nc >> 4][nc & 15] = (f2mono(sum) & ~0x3fu) | (unsigned)(63 - nc);
                if (hi == 0) exl[nc * 32 + rr] = e0 + (int)(127u - (top[1][j] & 0x7fu));
            }
        }
#pragma unroll
        for (int k = 0; k < 4; ++k) bitonic_sort_desc<16>(g4[k]);
        merge_top16(g4[0], g4[1]); merge_top16(g4[2], g4[3]); merge_top16(g4[0], g4[2]);
        float e16[16]; float den = 0.f; const float gmax = mono2f(g4[0][0] & ~0x3fu);
#pragma unroll
        for (int r = 0; r < 16; ++r) { e16[r] = __expf(mono2f(g4[0][r] & ~0x3fu) - gmax); den += e16[r]; }
        const float inv = 1.0f / den; const size_t ob = (size_t)(t0 + rr) * 128 + h * 16 + hi * 8;
        float wo[8]; int eo[8];
#pragma unroll
        for (int k = 0; k < 8; ++k) { const unsigned key = hi ? g4[0][8 + k] : g4[0][k]; wo[k] = (hi ? e16[8 + k] : e16[k]) * inv; eo[k] = exl[(63 - (int)(key & 0x3fu)) * 32 + rr]; }
        *(float4*)(gw + ob) = make_float4(wo[0], wo[1], wo[2], wo[3]); *(float4*)(gw + ob + 4) = make_float4(wo[4], wo[5], wo[6], wo[7]);
        *(int4*)(eidx + ob) = make_int4(eo[0], eo[1], eo[2], eo[3]); *(int4*)(eidx + ob + 4) = make_int4(eo[4], eo[5], eo[6], eo[7]);
    }
}
__device__ __forceinline__ void ph_peer_cvt(const Params& p, int wv) {
    PH_IDS(); unsigned char* ws = p.ws;
    for (int r = gwave; r < 2 * 16384; r += nwaves) {
        const bool isv = r >= 16384; const int e = isv ? r - 16384 : r;
        const float* src = (isv ? p.peer_v : p.peer_u) + (size_t)e * 1024 + lane * 16; float v[16]; float amax = 0.f;
#pragma unroll
        for (int i = 0; i < 4; ++i) { const float4 a = *(const float4*)(src + 4 * i); v[4 * i] = a.x; v[4 * i + 1] = a.y; v[4 * i + 2] = a.z; v[4 * i + 3] = a.w; }
#pragma unroll
        for (int i = 0; i < 16; ++i) amax = fmaxf(amax, fabsf(v[i]));
        amax = fmaxf(wave_max(amax), 1e-30f); const float inv = 127.0f / amax;
        *(uint4*)(ws + (isv ? OFF_PV : OFF_PU) + (size_t)e * 1024 + lane * 16) = make_uint4(pack4i8(v[0] * inv, v[1] * inv, v[2] * inv, v[3] * inv), pack4i8(v[4] * inv, v[5] * inv, v[6] * inv, v[7] * inv),
                                                                                            pack4i8(v[8] * inv, v[9] * inv, v[10] * inv, v[11] * inv), pack4i8(v[12] * inv, v[13] * inv, v[14] * inv, v[15] * inv));
        if (lane == 0) ((float*)(ws + (isv ? OFF_SV : OFF_SU)))[e] = amax * (1.0f / 127.0f);
    }
}
__device__ __forceinline__ float bflo(unsigned w) { return __uint_as_float(w << 16); }
__device__ __forceinline__ float bfhi(unsigned w) { return __uint_as_float(w & 0xffff0000u); }
__device__ __forceinline__ f32x2v pkfma(f32x2v a, f32x2v b, f32x2v c) { return __builtin_elementwise_fma(a, b, c); }
__device__ __forceinline__ float dot16f8(const uint4& w, const f32x2v* x) {
    f32x2v a = {0.f, 0.f}, b = {0.f, 0.f};
    a = pkfma(__builtin_amdgcn_cvt_pk_f32_fp8(w.x, false), x[0], a); b = pkfma(__builtin_amdgcn_cvt_pk_f32_fp8(w.x, true), x[1], b);
    a = pkfma(__builtin_amdgcn_cvt_pk_f32_fp8(w.y, false), x[2], a); b = pkfma(__builtin_amdgcn_cvt_pk_f32_fp8(w.y, true), x[3], b);
    a = pkfma(__builtin_amdgcn_cvt_pk_f32_fp8(w.z, false), x[4], a); b = pkfma(__builtin_amdgcn_cvt_pk_f32_fp8(w.z, true), x[5], b);
    a = pkfma(__builtin_amdgcn_cvt_pk_f32_fp8(w.w, false), x[6], a); b = pkfma(__builtin_amdgcn_cvt_pk_f32_fp8(w.w, true), x[7], b);
    a = a + b; return a.x + a.y;
}
__device__ __forceinline__ void axpy16f8(const uint4& w, float c, f32x2v* y) {
    const f32x2v c2 = {c, c};
    y[0] = pkfma(c2, __builtin_amdgcn_cvt_pk_f32_fp8(w.x, false), y[0]); y[1] = pkfma(c2, __builtin_amdgcn_cvt_pk_f32_fp8(w.x, true), y[1]);
    y[2] = pkfma(c2, __builtin_amdgcn_cvt_pk_f32_fp8(w.y, false), y[2]); y[3] = pkfma(c2, __builtin_amdgcn_cvt_pk_f32_fp8(w.y, true), y[3]);
    y[4] = pkfma(c2, __builtin_amdgcn_cvt_pk_f32_fp8(w.z, false), y[4]); y[5] = pkfma(c2, __builtin_amdgcn_cvt_pk_f32_fp8(w.z, true), y[5]);
    y[6] = pkfma(c2, __builtin_amdgcn_cvt_pk_f32_fp8(w.w, false), y[6]); y[7] = pkfma(c2, __builtin_amdgcn_cvt_pk_f32_fp8(w.w, true), y[7]);
}
constexpr size_t OFF_PART = 90 * MiB + 32 * MiB;
constexpr size_t OFF_COEF = 218 * MiB;
constexpr size_t OFF_Y = 122 * MiB;
static_assert(OFF_PART >= OFF_H1B + 32 * MiB && OFF_PART + 64 * MiB <= OFF_EIDX && OFF_COEF + 8 * MiB <= OFF_BT, "PEER scratch map");
#define PU_ISSUE16(W, ELO, EHI) do { _Pragma("unroll") for (int k = 0; k < 8; ++k) { const int e0 = __shfl(ELO, k * 8 + g), e1 = __shfl(EHI, k * 8 + g); \
        W[k] = *(const uint4*)(PU + (size_t)e0 * 1024 + 128 * s + 16 * j); W[8 + k] = *(const uint4*)(PU + (size_t)e1 * 1024 + 128 * s + 16 * j); } } while (0)
#define PU_DOT16(W, X) __builtin_amdgcn_sdot4((int)(W).w, (int)(X).w, __builtin_amdgcn_sdot4((int)(W).z, (int)(X).z, __builtin_amdgcn_sdot4((int)(W).y, (int)(X).y, __builtin_amdgcn_sdot4((int)(W).x, (int)(X).x, 0, false), false), false), false)
#define PU_REDUCE8(W, O, XQ, PROW, B) do { int d[8], a4[4], a2[2], a1; \
        _Pragma("unroll") for (int k = 0; k < 8; ++k) d[k] = PU_DOT16(W[(O) + k], XQ); \
        _Pragma("unroll") for (int k = 0; k < 4; ++k) { const int give = b2 ? d[k] : d[4 + k]; a4[k] = (b2 ? d[4 + k] : d[k]) + __shfl_xor(give, 4); } \
        _Pragma("unroll") for (int k = 0; k < 2; ++k) { const int give = b1 ? a4[k] : a4[2 + k]; a2[k] = (b1 ? a4[2 + k] : a4[k]) + __shfl_xor(give, 2); } \
        { const int give = b0 ? a2[0] : a2[1]; a1 = (b0 ? a2[1] : a2[0]) + __shfl_xor(give, 1); } \
        (PROW)[(B) * 64 + kk * 8 + g] = a1; } while (0)
#define PU_META(T_, XQ, ELO, EHI) do { const int tq_ = (T_) < T ? (T_) : tlast; XQ = *(const uint4*)(h1q + (size_t)tq_ * 1024 + 128 * s + 16 * j); \
        ELO = eidx[(size_t)tq_ * 128 + lane]; EHI = eidx[(size_t)tq_ * 128 + 64 + lane]; } while (0)
#define PU_TOKEN(W, T_, XQ) do { int* prow = part + ((size_t)s * T + (T_)) * 128; PU_REDUCE8(W, 0, XQ, prow, 0); PU_REDUCE8(W, 8, XQ, prow, 1); } while (0)
__device__ __forceinline__ void ph_peer_u(const Params& p, int wv) {
    PH_IDS(); unsigned char* ws = p.ws; const int s = bid & 7, cu = bid >> 3, ncu = nb >> 3, g = lane >> 3, j = lane & 7;
    const unsigned char* h1q = ws + OFF_H1Q; const int* eidx = (const int*)(ws + OFF_EIDX); const unsigned char* PU = ws + OFF_PU; int* part = (int*)(ws + OFF_PART);
    const bool b2 = (lane & 4) != 0, b1 = (lane & 2) != 0, b0 = (lane & 1) != 0; const int kk = (b2 ? 4 : 0) + (b1 ? 2 : 0) + (b0 ? 1 : 0);
    const int tstep = ncu * NWAVES; int t = cu * NWAVES + wv;
    if (t >= T) return;
    const int tlast = t;
    uint4 xq0, xq1; int el0, eh0, el1, eh1;
    PU_META(t, xq0, el0, eh0); PU_META(t + tstep, xq1, el1, eh1);
    uint4 wA[16], wB[16];
    PU_ISSUE16(wA, el0, eh0);
    for (;;) {
        { const uint4 cx = xq0; PU_META(t + 2 * tstep, xq0, el0, eh0); PU_ISSUE16(wB, el1, eh1); PU_TOKEN(wA, t, cx); }
        t += tstep; if (t >= T) break;
        { const uint4 cx = xq1; PU_META(t + 2 * tstep, xq1, el1, eh1); PU_ISSUE16(wA, el0, eh0); PU_TOKEN(wB, t, cx); }
        t += tstep; if (t >= T) break;
    }
}
__device__ __forceinline__ void ph_peer_c(const Params& p, int wv) {
    PH_IDS(); unsigned char* ws = p.ws; const int* part = (const int*)(ws + OFF_PART); const float* gw = (const float*)(ws + OFF_GW); const int* eidx = (const int*)(ws + OFF_EIDX);
    const float* su = (const float*)(ws + OFF_SU); const float* sv = (const float*)(ws + OFF_SV); const float* sx = (const float*)(ws + OFF_SX); float* sc = (float*)(ws + OFF_SC); unsigned* coefq = (unsigned*)(ws + OFF_COEFQ);
    for (int t = gwave; t < T; t += nwaves) {
        float cp[2];
#pragma unroll
        for (int b = 0; b < 2; ++b) { const size_t i = (size_t)t * 128 + b * 64 + lane; int acc = 0;
#pragma unroll
            for (int s = 0; s < 8; ++s) acc += part[(size_t)s * T * 128 + i];
            const int e = eidx[i]; cp[b] = gw[i] * gelu_exact((float)acc * su[e] * sx[t]) * sv[e]; }
        const float amax = fmaxf(wave_max(fmaxf(fabsf(cp[0]), fabsf(cp[1]))), 1e-30f), inv = 127.0f / amax;
        const int q0 = (int)rintf(cp[0] * inv) & 0xff, q1 = (int)rintf(cp[1] * inv) & 0xff;
        const int gg = lane & 7, kq = (lane >> 3) & 1;
        unsigned w0 = 0u, w1 = 0u;
#pragma unroll
        for (int i = 0; i < 4; ++i) { const int srcl = (4 * kq + i) * 8 + gg; w0 |= (unsigned)__shfl(q0, srcl) << (8 * i); w1 |= (unsigned)__shfl(q1, srcl) << (8 * i); }
        if (lane < 16) { coefq[(size_t)t * 32 + lane] = w0; coefq[(size_t)t * 32 + 16 + lane] = w1; }
        if (lane == 0) sc[t] = amax * (1.0f / 127.0f);
    }
}
#define PV_ISSUE16(W, ELO, EHI) do { _Pragma("unroll") for (int k = 0; k < 8; ++k) { const int e0 = __shfl(ELO, k * 8 + g), e1 = __shfl(EHI, k * 8 + g); \
        W[k] = *(const uint4*)(PV + (size_t)e0 * 1024 + 128 * s + 16 * j); W[8 + k] = *(const uint4*)(PV + (size_t)e1 * 1024 + 128 * s + 16 * j); } } while (0)
#define PV_META(T_, ELO, EHI, CQ) do { const int tq_ = (T_) < T ? (T_) : tlast; ELO = eidx[(size_t)tq_ * 128 + lane]; EHI = eidx[(size_t)tq_ * 128 + 64 + lane]; \
        CQ[0] = coefq[(size_t)tq_ * 32 + g]; CQ[1] = coefq[(size_t)tq_ * 32 + 8 + g]; CQ[2] = coefq[(size_t)tq_ * 32 + 16 + g]; CQ[3] = coefq[(size_t)tq_ * 32 + 24 + g]; } while (0)
#define PV_BLK(W0, W1, W2, W3, CQW, A0, A1, A2, A3) do { \
        const unsigned l01 = __builtin_amdgcn_perm(W1, W0, 0x05010400u), h01 = __builtin_amdgcn_perm(W1, W0, 0x07030602u), l23 = __builtin_amdgcn_perm(W3, W2, 0x05010400u), h23 = __builtin_amdgcn_perm(W3, W2, 0x07030602u); \
        A0 = __builtin_amdgcn_sdot4((int)__builtin_amdgcn_perm(l23, l01, 0x05040100u), (int)(CQW), A0, false); A1 = __builtin_amdgcn_sdot4((int)__builtin_amdgcn_perm(l23, l01, 0x07060302u), (int)(CQW), A1, false); \
        A2 = __builtin_amdgcn_sdot4((int)__builtin_amdgcn_perm(h23, h01, 0x05040100u), (int)(CQW), A2, false); A3 = __builtin_amdgcn_sdot4((int)__builtin_amdgcn_perm(h23, h01, 0x07060302u), (int)(CQW), A3, false); } while (0)
#define PV_QUAD(W, O, CQW) do { PV_BLK(W[(O)].x, W[(O) + 1].x, W[(O) + 2].x, W[(O) + 3].x, CQW, acc[0], acc[1], acc[2], acc[3]); PV_BLK(W[(O)].y, W[(O) + 1].y, W[(O) + 2].y, W[(O) + 3].y, CQW, acc[4], acc[5], acc[6], acc[7]); \
        PV_BLK(W[(O)].z, W[(O) + 1].z, W[(O) + 2].z, W[(O) + 3].z, CQW, acc[8], acc[9], acc[10], acc[11]); PV_BLK(W[(O)].w, W[(O) + 1].w, W[(O) + 2].w, W[(O) + 3].w, CQW, acc[12], acc[13], acc[14], acc[15]); } while (0)
#define PV_TOKEN(W, CQ, T_) do { int acc[16]; _Pragma("unroll") for (int i = 0; i < 16; ++i) acc[i] = 0; \
        PV_QUAD(W, 0, CQ[0]); PV_QUAD(W, 4, CQ[1]); PV_QUAD(W, 8, CQ[2]); PV_QUAD(W, 12, CQ[3]); \
        int y8[8], y4[4], y2[2]; \
        _Pragma("unroll") for (int i = 0; i < 8; ++i) { const int give = b5 ? acc[i] : acc[8 + i]; y8[i] = (b5 ? acc[8 + i] : acc[i]) + __shfl_xor(give, 32); } \
        _Pragma("unroll") for (int i = 0; i < 4; ++i) { const int give = b4 ? y8[i] : y8[4 + i]; y4[i] = (b4 ? y8[4 + i] : y8[i]) + __shfl_xor(give, 16); } \
        _Pragma("unroll") for (int i = 0; i < 2; ++i) { const int give = b3 ? y4[i] : y4[2 + i]; y2[i] = (b3 ? y4[2 + i] : y4[i]) + __shfl_xor(give, 8); } \
        const float sct = sc[(T_)]; *(float2*)(Y + (size_t)(T_) * 1024 + 128 * s + 16 * j + c0) = make_float2((float)y2[0] * sct, (float)y2[1] * sct); } while (0)
__device__ __forceinline__ void ph_peer_v(const Params& p, int wv) {
    PH_IDS(); unsigned char* ws = p.ws; const int s = bid & 7, cu = bid >> 3, ncu = nb >> 3, g = lane >> 3, j = lane & 7;
    const int* eidx = (const int*)(ws + OFF_EIDX); const unsigned* coefq = (const unsigned*)(ws + OFF_COEFQ); const float* sc = (const float*)(ws + OFF_SC); const unsigned char* PV = ws + OFF_PV; float* Y = (float*)(ws + OFF_Y);
    const bool b5 = (lane & 32) != 0, b4 = (lane & 16) != 0, b3 = (lane & 8) != 0; const int c0 = (b5 ? 8 : 0) + (b4 ? 4 : 0) + (b3 ? 2 : 0);
    const int tstep = ncu * NWAVES; int t = cu * NWAVES + wv;
    if (t >= T) return;
    const int tlast = t;
    int el0, eh0, el1, eh1; unsigned cq0[4], cq1[4];
    PV_META(t, el0, eh0, cq0); PV_META(t + tstep, el1, eh1, cq1);
    uint4 wA[16], wB[16];
    PV_ISSUE16(wA, el0, eh0);
    for (;;) {
        { unsigned cc[4] = {cq0[0], cq0[1], cq0[2], cq0[3]}; PV_META(t + 2 * tstep, el0, eh0, cq0); PV_ISSUE16(wB, el1, eh1); PV_TOKEN(wA, cc, t); }
        t += tstep; if (t >= T) break;
        { unsigned cc[4] = {cq1[0], cq1[1], cq1[2], cq1[3]}; PV_META(t + 2 * tstep, el1, eh1, cq1); PV_ISSUE16(wA, el0, eh0); PV_TOKEN(wB, cc, t); }
        t += tstep; if (t >= T) break;
    }
}
__device__ __forceinline__ void ph_peer_ln2(const Params& p, int wv) {
    PH_IDS(); unsigned char* ws = p.ws; const float* Y = (const float*)(ws + OFF_Y);
    for (int t = gwave; t < T; t += nwaves) {
        float y[16]; float* row = p.out + (size_t)t * 1024 + lane * 16; const float* yr = Y + (size_t)t * 1024 + lane * 16; float s = 0.f;
#pragma unroll
        for (int i = 0; i < 4; ++i) { const float4 a = *(const float4*)(row + 4 * i), c = *(const float4*)(yr + 4 * i); y[4 * i] = c.x + DN_ALPHA * a.x; y[4 * i + 1] = c.y + DN_ALPHA * a.y; y[4 * i + 2] = c.z + DN_ALPHA * a.z; y[4 * i + 3] = c.w + DN_ALPHA * a.w; }
#pragma unroll
        for (int i = 0; i < 16; ++i) s += y[i];
        const float mu = wave_sum(s) * (1.0f / 1024.0f); float s2 = 0.f;
#pragma unroll
        for (int i = 0; i < 16; ++i) { y[i] -= mu; s2 += y[i] * y[i]; }
        const float rstd = rsqrtf(wave_sum(s2) * (1.0f / 1024.0f) + LN_EPS);
#pragma unroll
        for (int i = 0; i < 4; ++i) { const int c = lane * 16 + 4 * i; const float4 ga = *(const float4*)(p.ln2_g + c), ba = *(const float4*)(p.ln2_b + c);
            float4 o; o.x = y[4 * i] * rstd * ga.x + ba.x; o.y = y[4 * i + 1] * rstd * ga.y + ba.y; o.z = y[4 * i + 2] * rstd * ga.z + ba.z; o.w = y[4 * i + 3] * rstd * ga.w + ba.w;
            *(float4*)(row + 4 * i) = o; }
    }
}

#define LAS __attribute__((address_space(3)))
#define XB_TMO      128
#define XB_XCNT(j)  (256  + 64 * (j))
#define XB_XSUB(j)  (1280 + 64 * (j))
#define XB_XGEN(j)  (2304 + 64 * (j))
#define XB_TOP      3328
#define XB_TOPGEN   3392
#define XCD_BAR_WORDS 3456
#define XB_SPIN_CAP (1u << 18)

__device__ __forceinline__ unsigned xb_ld(unsigned* p)              { return __hip_atomic_load(p, __ATOMIC_RELAXED, __HIP_MEMORY_SCOPE_AGENT); }
__device__ __forceinline__ unsigned xb_add(unsigned* p, unsigned v) { return __hip_atomic_fetch_add(p, v, __ATOMIC_RELAXED, __HIP_MEMORY_SCOPE_AGENT); }
__device__ __forceinline__ unsigned xb_xcc_id() { return (unsigned)__builtin_amdgcn_s_getreg((3 << 11) | 20) & 0xFu; }
#define XB_SPIN(cond, bar) do { unsigned _sp = 0; while (cond) { __builtin_amdgcn_s_sleep(1); \
    if ((++_sp & 255u) == 0u) { if (xb_ld(&(bar)[XB_TMO])) break; if (_sp > XB_SPIN_CAP) { atomicAdd(&(bar)[XB_TMO], 1u); break; } } } } while (0)

struct XcdBarrier {
    unsigned* bar; unsigned x;
    volatile LAS unsigned* st;
};

__device__ __forceinline__ XcdBarrier xcd_barrier_post(unsigned* bar, volatile LAS unsigned* st, bool leader) {
    XcdBarrier b; b.bar = bar; b.x = xb_xcc_id(); b.st = st;
    if (leader) (void)xb_add(&bar[XB_XCNT(b.x)], 1u);
    return b;
}
__device__ __forceinline__ void xcd_barrier_complete(unsigned* bar, unsigned x, unsigned& nloc, unsigned& nx) {
    const unsigned G = gridDim.x * gridDim.y * gridDim.z;
    unsigned sum, cnt, mine, sp = 0u;
    for (;;) {
        sum = 0u; cnt = 0u; mine = 0u;
#pragma unroll
        for (unsigned j = 0; j < 16; ++j) { const unsigned c = xb_ld(&bar[XB_XCNT(j)]); sum += c; cnt += (c > 0u) ? 1u : 0u; mine = (j == x) ? c : mine; }
        if (sum == G) break;
        __builtin_amdgcn_s_sleep(1);
        if ((++sp & 255u) == 0u) { if (xb_ld(&bar[XB_TMO])) break; if (sp > XB_SPIN_CAP) { atomicAdd(&bar[XB_TMO], 1u); break; } }
    }
    nloc = mine > 0u ? mine : 1u; nx = cnt > 0u ? cnt : 1u;
}

__device__ __forceinline__ void xcd_barrier(const XcdBarrier& b, bool leader) {
    asm volatile("s_waitcnt vmcnt(0)" ::: "memory");
    __syncthreads();
    if (leader) {
        unsigned* bar = b.bar;
        __builtin_amdgcn_s_waitcnt(0);
        unsigned nloc = b.st[0], nx = b.st[1];
        if (nloc == 0u) { xcd_barrier_complete(bar, b.x, nloc, nx); b.st[0] = nloc; b.st[1] = nx; }
        const unsigned old = xb_add(&bar[XB_XSUB(b.x)], 1u);
        const unsigned gen = old / nloc;
        if (old + 1u == (gen + 1u) * nloc) {
            __builtin_amdgcn_fence(__ATOMIC_RELEASE, "agent");
            asm volatile("s_waitcnt vmcnt(0)" ::: "memory");
            const unsigned og = xb_add(&bar[XB_TOP], 1u);
            const unsigned tg = og / nx;
            if (og + 1u == (tg + 1u) * nx) xb_add(&bar[XB_TOPGEN], 1u);
            else XB_SPIN(xb_ld(&bar[XB_TOPGEN]) == tg, bar);
            __builtin_amdgcn_fence(__ATOMIC_ACQUIRE, "agent");
            xb_add(&bar[XB_XGEN(b.x)], 1u);
            asm volatile("s_waitcnt vmcnt(0)" ::: "memory");
        } else {
            XB_SPIN(xb_ld(&bar[XB_XGEN(b.x)]) == gen, bar);
            __builtin_amdgcn_fence(__ATOMIC_ACQUIRE, "agent");
            asm volatile("s_waitcnt vmcnt(0)" ::: "memory");
        }
    }
    __syncthreads();
}

#ifndef TIMING_BOUNDARY
#define TIMING_BOUNDARY -1
#endif
#define TPROBE(k) do { if (TIMING_BOUNDARY == (k)) { const unsigned long long t1_ = __builtin_amdgcn_s_memrealtime(); while (__builtin_amdgcn_s_memrealtime() - t1_ < t1_ - tstart_) __builtin_amdgcn_s_sleep(8); } } while (0)
__global__ void __launch_bounds__(NTHREADS) fwd_megakernel(Params p) {
    extern __shared__ __attribute__((aligned(16))) unsigned char lds[];
    cg::grid_group grid = cg::this_grid();
    const int nb = gridDim.x, bid = blockIdx.x;
    const int wv = __builtin_amdgcn_readfirstlane(threadIdx.x >> 6);
    unsigned char* ws = p.ws;
    const unsigned long long tstart_ = (TIMING_BOUNDARY >= 0) ? __builtin_amdgcn_s_memrealtime() : 0ull; (void)tstart_;
    PG8_LAS unsigned char* ldsp = (PG8_LAS unsigned char*)lds;
    const bool leader = (wv == 0) && (lane_id() == 0);
    volatile LAS unsigned* bst = (volatile LAS unsigned*)(ldsp + LDS_BYTES - 64);
    if (leader) { bst[0] = 0u; bst[1] = 0u; }
    __syncthreads();
    const XcdBarrier xbar = xcd_barrier_post((unsigned*)(ws + OFF_BAR), bst, leader);

    ph_prep(p, wv, lds);
    grid.sync();
    TPROBE(0);
    {
        pg8::Gemm g{(const bf16*)(ws + OFF_XB), (const bf16*)(ws + OFF_WIN), T, NPROJ_PAD, 1024, 1024, 0, 1 << 30, 0l};
        pg8::StaticOrder S; S.init(T, NPROJ_PAD, nb, bid);
        pg8::EpiInProjPg E{(bf16*)(ws + OFF_Z), (bf16*)(ws + OFF_XBC), (bf16*)(ws + OFF_Q), (bf16*)(ws + OFF_KVS), (bf16*)(ws + OFF_DTG)};
        pg8::gemm_phase<pg8::EpiInProjPg, pg8::StaticOrder, pg8::NoMid, true, true>(wv, ldsp, g, S, E, pg8::NoMid{});
    }
    xcd_barrier(xbar, leader);
    TPROBE(1);
    ph_tokprep(p, wv);
    xcd_barrier(xbar, leader);
    TPROBE(2);
    if (bid < 32) {
        const bool isv = bid >= 16;
        pg8::Gemm g{(const bf16*)(ws + OFF_KVS) + (isv ? 256 : 0), (const bf16*)(ws + (isv ? OFF_W1V : OFF_W1K)), 4096, 256, 2048, 0, 1, 1 << 30, 0l};
        pg8::StaticOrder S; S.init(4096, 256, 16, isv ? bid - 16 : bid);
        pg8::EpiBf16<1> E{(bf16*)(ws + OFF_HID + (isv ? 2 * MiB : 0)), 256, (const float*)(ws + (isv ? OFF_B1V : OFF_B1K)), 0, 0, 1.f};
        pg8::gemm_phase<pg8::EpiBf16<1>, pg8::StaticOrder, pg8::NoMid, true, true>(wv, ldsp, g, S, E, pg8::NoMid{});
    }
    ph_ssd_prep2(p, wv, lds);
    ph_vt_prep(p, wv);
    xcd_barrier(xbar, leader);
    TPROBE(3);
    {
        RowMajorBf16 ak{(const bf16*)(ws + OFF_HID), 256}, av{(const bf16*)(ws + OFF_HID + 2 * MiB), 256};
        RowMajorBf16 bk{(const bf16*)(ws + OFF_W2K), 256}, bv{(const bf16*)(ws + OFF_W2V), 256};
        EpiKc ek{(bf16*)(ws + OFF_KC), false}, ev{(bf16*)(ws + OFF_VCT), true};
        gemm_wave32(wv, 4096 / 32, 64 / 32, 256, ak, bk, ek);
        gemm_wave32(wv, 4096 / 32, 64 / 32, 256, av, bv, ev);
    }
    ph_ssd_states(p, wv);
    xcd_barrier(xbar, leader);
    TPROBE(4);
    ph_kc_rope(p, wv);
    ph_ssd_scan(p, wv);
    xcd_barrier(xbar, leader);
    TPROBE(5);
    ph_ssd_out(p, wv);
    ph_nsa(p, wv, lds);
    xcd_barrier(xbar, leader);
    TPROBE(6);
    {
        pg8::Gemm g{(const bf16*)(ws + OFF_Q), (const bf16*)(ws + OFF_WOUT), T, 1024, 2048, 1024, 0, 16, (long)OFF_Z - (long)OFF_Q - 16l * 128l};
        pg8::StaticOrder S; S.init(T, 1024, nb, bid);
        pg8::RmsFactors rf{(const float*)(ws + OFF_SSQ), (const float*)(ws + OFF_HID), RMS_EPS};
        pg8::EpiOutProj E{p.x, p.out, DN_ALPHA, rf}; pg8::MidRmsScale MH{rf};
        pg8::gemm_phase<pg8::EpiOutProj, pg8::StaticOrder, pg8::MidRmsScale, true, true>(wv, ldsp, g, S, E, MH);
    }
    xcd_barrier(xbar, leader);
    TPROBE(7);
    ph_ln1(p, wv);
    ph_peer_cvt(p, wv);
    xcd_barrier(xbar, leader);
    TPROBE(8);
    {
        pg8::Gemm g{(const bf16*)(ws + OFF_H1B), (const bf16*)(ws + OFF_WQ), T, 2048, 1024, 1024, 0, 1 << 30, 0l};
        pg8::StaticOrder S; S.init(T, 2048, nb, bid);
        pg8::EpiBf16<0> E{(bf16*)(ws + OFF_QP), 2048, nullptr, 0, 0, 1.f};
        pg8::gemm_phase<pg8::EpiBf16<0>, pg8::StaticOrder, pg8::NoMid, true, true>(wv, ldsp, g, S, E, pg8::NoMid{});
    }
    xcd_barrier(xbar, leader);
    TPROBE(9);
    ph_peer_topk(p, wv, lds);
    xcd_barrier(xbar, leader);
    TPROBE(10);
    ph_peer_u(p, wv);
    xcd_barrier(xbar, leader);
    TPROBE(11);
    ph_peer_c(p, wv);
    xcd_barrier(xbar, leader);
    TPROBE(12);
    ph_peer_v(p, wv);
    xcd_barrier(xbar, leader);
    TPROBE(13);
    ph_peer_ln2(p, wv);
}

extern "C" void kernel_launch(void* const* d_in, const int* in_sizes, int n_in, void* d_out, int out_size, void* d_ws, size_t ws_size, hipStream_t stream) {
    static int grid_blocks = 0;
    if (!grid_blocks) {
        int dev = 0, cus = 0, per_cu = 0;
        hipGetDevice(&dev);
        hipDeviceGetAttribute(&cus, hipDeviceAttributeMultiprocessorCount, dev);
        hipFuncSetAttribute((const void*)fwd_megakernel, hipFuncAttributeMaxDynamicSharedMemorySize, LDS_BYTES);
        hipOccupancyMaxActiveBlocksPerMultiprocessor(&per_cu, fwd_megakernel, NTHREADS, LDS_BYTES);
        if (per_cu < 1) per_cu = 1;
        if (per_cu > 1) per_cu = 1;
        grid_blocks = cus * per_cu;
        if (ws_size < 244 * MiB) fprintf(stderr, "kernel_launch: workspace too small: %zu\n", ws_size);
    }
    Params p{};
    const float** pp = (const float**)&p;
    for (int i = 0; i < 24; ++i) pp[i] = (const float*)d_in[i];
    p.out = (float*)d_out; p.ws = (unsigned char*)d_ws;
    (void)hipMemsetAsync((unsigned char*)d_ws + OFF_BAR, 0, BAR_BYTES, stream);
    void* args[] = {&p};
    hipError_t e = hipLaunchCooperativeKernel((void*)fwd_megakernel, dim3(grid_blocks), dim3(NTHREADS), args, LDS_BYTES, stream);
    if (e != hipSuccess) fprintf(stderr, "cooperative launch failed: %s (grid %d)\n", hipGetErrorString(e), grid_blocks);
}
```

```cpp
#include <hip/hip_runtime.h>
#include <hip/hip_cooperative_groups.h>
#include <cstdio>
#include <cstdint>
namespace cg = cooperative_groups;

typedef unsigned short bf16;
typedef short bf16x8 __attribute__((ext_vector_type(8)));
typedef float f32x4 __attribute__((ext_vector_type(4)));
typedef float f32x16 __attribute__((ext_vector_type(16)));
typedef unsigned long long u64;

constexpr int T = 16384, L = 4096, NBATCH = 4, D = 1024;
constexpr int NPROJ = 5184, NPROJ_PAD = 5376;
constexpr int NTHREADS = 512, NWAVES = 8;
constexpr float LN_EPS = 1e-5f, RMS_EPS = 1e-5f;
constexpr float DN_ALPHA = 1.189207115002721f;
constexpr float NEG_INF = -1e30f, BIG = 1e30f;

constexpr size_t MiB = 1u << 20;
constexpr size_t OFF_SSQ = 0, OFF_BAR = 512 * 1024, BAR_BYTES = 16384;
constexpr size_t OFF_WOUT = 1 * MiB, OFF_WQ = 5 * MiB, OFF_W1K = 9 * MiB, OFF_W1V = 10 * MiB;
constexpr size_t OFF_W2K = 11 * MiB, OFF_W2V = 11 * MiB + 65536, OFF_B1K = 11 * MiB + 131072, OFF_B1V = 11 * MiB + 131072 + 4096;
constexpr size_t OFF_KEYS = 12 * MiB, OFF_ROPE = 13 * MiB, OFF_DT = 14 * MiB, OFF_ACS = 15 * MiB, OFF_GATE = 16 * MiB, OFF_MASK = 19 * MiB;
constexpr size_t OFF_HID = 20 * MiB, OFF_KC = 24 * MiB, OFF_VC = 24 * MiB + 524288;
constexpr size_t OFF_Z = 26 * MiB, OFF_Q = 58 * MiB, OFF_KVS = 90 * MiB, OFF_XBC = 138 * MiB, OFF_XSBC = 186 * MiB, OFF_BT = 234 * MiB, OFF_DTG = 242 * MiB;
constexpr size_t OFF_VST = 138 * MiB, OFF_VWT = 146 * MiB, OFF_VCT = 154 * MiB;
constexpr size_t OFF_XB = 186 * MiB, OFF_WIN = 218 * MiB;
constexpr size_t OFF_H1B = 90 * MiB, OFF_QP = 138 * MiB, OFF_EIDX = 202 * MiB, OFF_GW = 210 * MiB;
constexpr size_t OFF_PU = 26 * MiB, OFF_PV = 58 * MiB;
constexpr int LDS_BYTES = 147456;

struct Params {
    const float *x, *w_in, *conv_w, *conv_b, *dt_bias, *a_log, *d_skip, *ssd_norm_w;
    const float *cmp_pos_k, *cmp_w1_k, *cmp_w2_k, *cmp_pos_v, *cmp_w1_v, *cmp_w2_v;
    const float *attn_norm_w, *w_out, *ln1_g, *ln1_b, *peer_wq, *peer_keys, *peer_u, *peer_v, *ln2_g, *ln2_b;
    float* out; unsigned char* ws;
};

__device__ __forceinline__ float bf2f(bf16 v) { return __uint_as_float((unsigned)v << 16); }
__device__ __forceinline__ bf16 f2bf(float f) { unsigned u = __float_as_uint(f); return (bf16)((u + 0x7fffu + ((u >> 16) & 1u)) >> 16); }
__device__ __forceinline__ int lane_id() { int l = (int)__builtin_amdgcn_mbcnt_hi(~0u, __builtin_amdgcn_mbcnt_lo(~0u, 0u)); asm volatile("" : "+v"(l)); return l; }
#define PH_IDS() const int lane = lane_id(); const int tid = (wv << 6) | lane; const int bid = blockIdx.x, nb = gridDim.x; const int gtid = bid * NTHREADS + tid, gn = nb * NTHREADS; const int gwave = bid * NWAVES + wv, nwaves = nb * NWAVES; (void)gtid; (void)gn; (void)gwave; (void)nwaves;
typedef float f32x2v __attribute__((ext_vector_type(2)));
typedef __bf16 bf16x2v __attribute__((ext_vector_type(2)));
__device__ __forceinline__ unsigned pk2bf(float lo, float hi) { f32x2v v = {lo, hi}; bf16x2v b = __builtin_convertvector(v, bf16x2v); return __builtin_bit_cast(unsigned, b); }
__device__ __forceinline__ float bflo(unsigned w) { return __uint_as_float(w << 16); }
__device__ __forceinline__ float bfhi(unsigned w) { return __uint_as_float(w & 0xffff0000u); }
__device__ __forceinline__ float wave_sum(float v) {
#pragma unroll
    for (int o = 1; o < 64; o <<= 1) v += __shfl_xor(v, o);
    return v;
}
__device__ __forceinline__ float wave_max(float v) {
#pragma unroll
    for (int o = 1; o < 64; o <<= 1) v = fmaxf(v, __shfl_xor(v, o));
    return v;
}
__device__ __forceinline__ float gelu_exact(float v) { return 0.5f * v * (1.0f + erff(v * 0.7071067811865476f)); }
__device__ __forceinline__ float sigmoidf(float v) { return 1.0f / (1.0f + __expf(-v)); }

template <class AP, class BP, class EP>
__device__ __forceinline__ void gemm_wave32(int wv, int Mt, int Nt, int K, const AP& ap, const BP& bp, const EP& ep) {
    PH_IDS(); const int r = lane & 15, q = lane >> 4;
    for (int tile = gwave; tile < Mt * Nt; tile += nwaves) {
        const int tm = tile / Nt, tn = tile % Nt, row0 = tm * 32, col0 = tn * 32;
        f32x4 acc[2][2];
#pragma unroll
        for (int i = 0; i < 2; ++i)
#pragma unroll
            for (int j = 0; j < 2; ++j) acc[i][j] = (f32x4){0.f, 0.f, 0.f, 0.f};
        for (int k0 = 0; k0 < K; k0 += 32) {
            const bf16x8 a0 = ap(row0 + r, k0 + 8 * q), a1 = ap(row0 + 16 + r, k0 + 8 * q);
            const bf16x8 b0 = bp(col0 + r, k0 + 8 * q), b1 = bp(col0 + 16 + r, k0 + 8 * q);
            acc[0][0] = __builtin_amdgcn_mfma_f32_16x16x32_bf16(a0, b0, acc[0][0], 0, 0, 0);
            acc[0][1] = __builtin_amdgcn_mfma_f32_16x16x32_bf16(a0, b1, acc[0][1], 0, 0, 0);
            acc[1][0] = __builtin_amdgcn_mfma_f32_16x16x32_bf16(a1, b0, acc[1][0], 0, 0, 0);
            acc[1][1] = __builtin_amdgcn_mfma_f32_16x16x32_bf16(a1, b1, acc[1][1], 0, 0, 0);
        }
#pragma unroll
        for (int i = 0; i < 2; ++i)
#pragma unroll
            for (int j = 0; j < 2; ++j)
#pragma unroll
                for (int e = 0; e < 4; ++e) ep(row0 + 16 * i + 4 * q + e, col0 + 16 * j + r, acc[i][j][e]);
    }
}
struct RowMajorBf16 { const bf16* p; int ld; __device__ __forceinline__ bf16x8 operator()(int row, int k) const { return *(const bf16x8*)(p + (size_t)row * ld + k); } };

namespace pg8 {
#define PG8_LAS __attribute__((address_space(3)))
typedef unsigned short bf16_t;
typedef short bf16x8 __attribute__((ext_vector_type(8)));
typedef float f32x4 __attribute__((ext_vector_type(4)));
typedef unsigned u32x4 __attribute__((ext_vector_type(4)));
constexpr int BM = 256, BK = 64, HALF = 128, HTB = HALF * BK * 2  , STAGE_BYTES = 8 * HTB, NXCD = 8, WGM = 8;

__host__ __device__ __forceinline__ int lds_byte(int r, int c) { const int st = (r >> 4) * 2 + (c >> 5), rr = r & 15, cc = c & 31, ob = rr * 64 + cc * 2; return st * 1024 + (ob ^ (((ob >> 9) & 1) << 5)); }
__host__ __device__ __forceinline__ void stage_rc(int b, int& R, int& C) { const int st = b / 1024, sb = b % 1024, swz = sb ^ (((sb >> 9) & 1) << 5); R = (st >> 1) * 16 + swz / 64; C = (st & 1) * 32 + (swz % 64) / 2; }
__host__ __device__ __forceinline__ int perm32(int rho) { const int n = rho >> 4, i = rho & 15; return 8 * (i >> 2) + 4 * n + (i & 3); }

struct Unit { int pm, pn; };
struct Gemm { const bf16_t* A; const bf16_t* Bt; int M, N, K; int lda; int amode; int ksplit; long kdelta; };

struct StaticOrder {
    int nM, nN, nwg, G, c;
    __host__ __device__ void init(int M, int N, int G_, int c_) { nM = M / BM; nN = N / BM; nwg = nM * nN; G = G_; c = c_; }
    __host__ __device__ bool next(int i, Unit& u) const {
        const long L = (long)i * G + c; if (L >= nwg) return false;
        int wgid = (int)L; { const int q = nwg / NXCD, r = nwg % NXCD, xcd = wgid % NXCD, off = wgid / NXCD; wgid = (xcd < r ? xcd * (q + 1) : r * (q + 1) + (xcd - r) * q) + off; }
        const int nig = WGM * nN, gid = wgid / nig, fm = gid * WGM, gsz = (nM - fm) < WGM ? (nM - fm) : WGM;
        u.pm = fm + ((wgid % nig) % gsz); u.pn = (wgid % nig) / gsz; return true;
    }
    __device__ __forceinline__ void a_ready(const Unit&) const {}
    __device__ __forceinline__ void done(const Unit&) const {}
};


__device__ __forceinline__ unsigned cvt_pk_bf16(float lo, float hi) { unsigned r; asm volatile("v_cvt_pk_bf16_f32 %0, %1, %2" : "=v"(r) : "v"(lo), "v"(hi)); return r; }
typedef float f32x2 __attribute__((ext_vector_type(2)));
__device__ __forceinline__ f32x2 gelu_pk(f32x2 v) {
    const f32x2 av = __builtin_elementwise_abs(v), d = av * 0.2316418882f + 1.0f;
    f32x2 t; t.x = __builtin_amdgcn_rcpf(d.x); t.y = __builtin_amdgcn_rcpf(d.y);
    f32x2 q = t * 0.5307027145f + (-0.7265760135f); q = q * t + 0.7107068705f; q = q * t + (-0.142248368f); q = q * t + 0.127414796f; q = q * t;
    const f32x2 s = (v * v) * (-0.72134752044f);
    f32x2 e; e.x = __builtin_amdgcn_exp2f(s.x); e.y = __builtin_amdgcn_exp2f(s.y);
    const f32x2 m = v * (q * e), r = v - m;
    f32x2 o; o.x = v.x < 0.f ? m.x : r.x; o.y = v.y < 0.f ? m.y : r.y; return o;
}

template <int ACT  > struct EpiBf16 {
    static constexpr bool PERM = true, AFTER_DRAIN = false; static_assert(ACT == 0 || ACT == 1, "EpiBf16: ACT is 0 (none) or 1 (gelu_pk)");
    bf16_t* O; int ldc; const float* bias; int split_cols; size_t split_stride; float scale0;
    __device__ __forceinline__ void operator()(const f32x4 (&acc)[2][2][4][2], const Unit& u, int wr, int wc, int fr, int fq) const {
        const int row0 = u.pm * BM + wr * 64 + fr; int colt = u.pn * BM; bf16_t* base = O;
        float sc = 1.f; if (split_cols) { const int t = colt / split_cols; base += (size_t)t * split_stride; colt -= t * split_cols; if (t == 0) sc = scale0; }
        const int col0 = colt + wc * 32 + 8 * fq, bcol0 = u.pn * BM + wc * 32 + 8 * fq;
        f32x4 bv[2][2];
#pragma unroll
        for (int bj = 0; bj < 2; ++bj)
#pragma unroll
            for (int n = 0; n < 2; ++n) bv[bj][n] = bias ? *(const f32x4*)(bias + bcol0 + bj * HALF + 4 * n) : (f32x4){0.f, 0.f, 0.f, 0.f};
#pragma unroll
        for (int ai = 0; ai < 2; ++ai)
#pragma unroll
            for (int m = 0; m < 4; ++m) { bf16_t* rowp = base + (size_t)(row0 + ai * HALF + m * 16) * ldc + col0;
#pragma unroll
                for (int bj = 0; bj < 2; ++bj) { f32x4 v0 = acc[ai][bj][m][0] + bv[bj][0], v1 = acc[ai][bj][m][1] + bv[bj][1];
                    if (ACT == 1) { f32x2 a = gelu_pk((f32x2){v0[0], v0[1]}), b = gelu_pk((f32x2){v0[2], v0[3]}), c = gelu_pk((f32x2){v1[0], v1[1]}), d = gelu_pk((f32x2){v1[2], v1[3]});
                        v0 = (f32x4){a.x, a.y, b.x, b.y}; v1 = (f32x4){c.x, c.y, d.x, d.y}; }
                    v0 = v0 * sc; v1 = v1 * sc; u32x4 w; w.x = cvt_pk_bf16(v0[0], v0[1]); w.y = cvt_pk_bf16(v0[2], v0[3]); w.z = cvt_pk_bf16(v1[0], v1[1]); w.w = cvt_pk_bf16(v1[2], v1[3]);
                    *(u32x4*)(rowp + bj * HALF) = w; } }
    }
};

struct EpiInProjPg { static constexpr bool PERM = true, AFTER_DRAIN = false;
    bf16_t *z, *xbc, *q, *kvs, *dtg;
    __device__ __forceinline__ void operator()(const f32x4 (&acc)[2][2][4][2], const Unit& u, int wr, int wc, int fr, int fq) const {
        bf16_t* base; int ldc, colt; const int pn = u.pn;
        if (pn < 4) { base = z; ldc = 1024; colt = pn * 256; } else if (pn < 10) { base = xbc; ldc = 1536; colt = (pn - 4) * 256; }
        else if (pn < 14) { base = q; ldc = 1024; colt = (pn - 10) * 256; } else if (pn < 20) { base = kvs; ldc = 1536; colt = (pn - 14) * 256; }
        else { base = dtg; ldc = 64; colt = 0; }
        const int row0 = u.pm * BM + wr * 64 + fr, col0 = colt + wc * 32 + 8 * fq;
#pragma unroll
        for (int ai = 0; ai < 2; ++ai)
#pragma unroll
            for (int m = 0; m < 4; ++m) { bf16_t* rowp = base + (size_t)(row0 + ai * HALF + m * 16) * ldc + col0;
#pragma unroll
                for (int bj = 0; bj < 2; ++bj) { const f32x4 v0 = acc[ai][bj][m][0], v1 = acc[ai][bj][m][1];
                    u32x4 w; w.x = cvt_pk_bf16(v0[0], v0[1]); w.y = cvt_pk_bf16(v0[2], v0[3]); w.z = cvt_pk_bf16(v1[0], v1[1]); w.w = cvt_pk_bf16(v1[2], v1[3]);
                    if (pn < 20 || (bj == 0 && wc < 2)) *(u32x4*)(rowp + bj * HALF) = w; } }
    }
};
struct RmsFactors { const float* ssqp; const float* ssq2p; float eps;
    __device__ __forceinline__ void get(int row, float& ra, float& r0, float& r1) const {
        const f32x4 a = *(const f32x4*)(ssqp + 4 * row); const f32x4 b0 = *(const f32x4*)(ssq2p + 16 * row), b1 = *(const f32x4*)(ssq2p + 16 * row + 4), b2 = *(const f32x4*)(ssq2p + 16 * row + 8), b3 = *(const f32x4*)(ssq2p + 16 * row + 12);
        ra = rsqrtf(((a[0] + a[1]) + (a[2] + a[3])) * (1.0f / 1024.0f) + eps);
        r0 = rsqrtf((((b0[0] + b0[1]) + (b0[2] + b0[3])) + ((b1[0] + b1[1]) + (b1[2] + b1[3]))) * (1.0f / 512.0f) + eps);
        r1 = rsqrtf((((b2[0] + b2[1]) + (b2[2] + b2[3])) + ((b3[0] + b3[1]) + (b3[2] + b3[3]))) * (1.0f / 512.0f) + eps); } };
struct EpiOutProj { static constexpr bool PERM = false, AFTER_DRAIN = false;
    const float* x; float* out; float alpha; RmsFactors rf;
    __device__ __forceinline__ void operator()(const f32x4 (&acc)[2][2][4][2], const Unit& u, int wr, int wc, int fr, int fq) const {
        const int col0 = u.pn * BM + wc * 32 + 4 * fq;
#pragma unroll
        for (int ai = 0; ai < 2; ++ai)
#pragma unroll
            for (int m = 0; m < 4; ++m) { const int row = u.pm * BM + ai * HALF + wr * 64 + m * 16 + fr; const size_t off = (size_t)row * 1024 + col0;
                float ra, r0, r1; rf.get(row, ra, r0, r1);
#pragma unroll
                for (int bj = 0; bj < 2; ++bj)
#pragma unroll
                    for (int n = 0; n < 2; ++n) { const size_t o = off + bj * HALF + n * 16; const f32x4 xv = *(const f32x4*)(x + o); *(f32x4*)(out + o) = xv * alpha + acc[ai][bj][m][n] * r1; } }
    }
};
struct MidRmsScale { static constexpr bool ENABLED = true; RmsFactors rf;
    __device__ __forceinline__ void operator()(f32x4 (&acc)[2][2][4][2], const Unit& u, int t, int wr, int wc, int fr, int fq) const {
        if (t != 16 && t != 24) return;
        int rowb = u.pm * BM + wr * 64 + fr; asm volatile("" : "+v"(rowb));
#pragma unroll
        for (int ai = 0; ai < 2; ++ai)
#pragma unroll
            for (int m = 0; m < 4; ++m) { float ra, r0, r1; rf.get(rowb + ai * HALF + m * 16, ra, r0, r1);
                const float sc = (t == 16) ? ra / r0 : r0 / r1;
#pragma unroll
                for (int bj = 0; bj < 2; ++bj)
#pragma unroll
                    for (int n = 0; n < 2; ++n) acc[ai][bj][m][n] = acc[ai][bj][m][n] * sc; }
    }
};
struct NoMid { static constexpr bool ENABLED = false; template <class ACC> __device__ __forceinline__ void operator()(ACC&, const Unit&, int, int, int, int, int) const {} };
template <class Epi, class Sched, class Mid, bool ALIGN_EPI = false, bool SP2 = false>
__device__ __forceinline__ void gemm_phase(int wv, PG8_LAS unsigned char* lds, const Gemm g, const Sched& S, const Epi& E, const Mid& MH) {
    int lane_ = (int)__builtin_amdgcn_mbcnt_hi(~0u, __builtin_amdgcn_mbcnt_lo(~0u, 0u)); asm volatile("" : "+v"(lane_));
    const int lane = lane_, wid = wv, tid = (wv << 6) | lane, wr = wid >> 2, wc = wid & 3, fr = lane & 15, fq = lane >> 4;
    const int K = g.K, nt = K / BK;
    unsigned voffA[2], voffB[2];
#pragma unroll
    for (int i = 0; i < 2; ++i) { int R, C; stage_rc(tid * 16 + i * 8192, R, C); const int Rb = Epi::PERM ? ((R & ~31) + perm32(R & 31)) : R;
        voffA[i] = g.amode == 0 ? (unsigned)(R * g.lda + C) * 2u : (unsigned)((R >> 2) * 49152 + (R & 3) * 128 + C * 2); voffB[i] = (unsigned)(Rb * K + C) * 2u; }
    const size_t kstep = (size_t)(BK * 2);
    const size_t hstep = (size_t)HALF * K * 2;
    const size_t tstep = 2 * hstep;
    const size_t kstepA = g.amode == 0 ? (size_t)(BK * 2) : (size_t)3072;
    const size_t hstepA = g.amode == 0 ? (size_t)HALF * g.lda * 2 : (size_t)32 * 49152;
    const size_t tstepA = 2 * hstepA;
#define PG8_AK(base, t) ((base) + (size_t)(t) * kstepA + (((t) >= g.ksplit) ? g.kdelta : 0l))
    const unsigned ldsw = (unsigned)wid * 1024u;
    const int aoff = lds_byte(wr * 64 + fr, fq * 8), boff = lds_byte(wc * 32 + fr, fq * 8);
#define PG8_SA(b, h) (((b) * 2 + (h)) * HTB)
#define PG8_SB(b, h) ((4 + (b) * 2 + (h)) * HTB)
#define PG8_STAGE(bufoff, gbase, voff) do { _Pragma("unroll") for (int _i = 0; _i < 2; ++_i) \
        __builtin_amdgcn_global_load_lds((const unsigned*)((const char*)(gbase) + (voff)[_i]), (PG8_LAS unsigned*)(lds + (bufoff) + ldsw + _i * 8192), 16, 0, 0); } while (0)
#define PG8_LDA(dst, b, h) do { _Pragma("unroll") for (int m = 0; m < 4; ++m) _Pragma("unroll") for (int k = 0; k < 2; ++k) dst[m][k] = *(const PG8_LAS bf16x8*)(lds + PG8_SA(b, h) + aoff + m * 2048 + k * 1024); } while (0)
#define PG8_LDB(dst, b, h) do { _Pragma("unroll") for (int n = 0; n < 2; ++n) _Pragma("unroll") for (int k = 0; k < 2; ++k) dst[n][k] = *(const PG8_LAS bf16x8*)(lds + PG8_SB(b, h) + boff + n * 2048 + k * 1024); } while (0)
#define PG8_MMA(ai, bj, At, Bt) do { __builtin_amdgcn_s_setprio(1); _Pragma("unroll") for (int m = 0; m < 4; ++m) _Pragma("unroll") for (int n = 0; n < 2; ++n) _Pragma("unroll") for (int k = 0; k < 2; ++k) \
        acc[ai][bj][m][n] = __builtin_amdgcn_mfma_f32_16x16x32_bf16(Bt[n][k], At[m][k], acc[ai][bj][m][n], 0, 0, 0); __builtin_amdgcn_s_setprio(0); } while (0)
#define PG8_WAIT_V(n) asm volatile("s_waitcnt vmcnt(" #n ")" ::: "memory")
#define PG8_WAIT_L(n) asm volatile("s_waitcnt lgkmcnt(" #n ")" ::: "memory")
#define PG8_BAR __builtin_amdgcn_s_barrier()
#define PG8_SCHED __builtin_amdgcn_sched_barrier(0)
    Unit cur, nxt; int ui = 0;
    if (!S.next(0, cur)) return;
    f32x4 acc[2][2][4][2];
#pragma unroll
    for (int a = 0; a < 2; ++a)
#pragma unroll
        for (int b = 0; b < 2; ++b)
#pragma unroll
            for (int m = 0; m < 4; ++m)
#pragma unroll
                for (int n = 0; n < 2; ++n) acc[a][b][m][n] = (f32x4){0.f, 0.f, 0.f, 0.f};
    bf16x8 At[4][2], B0[2][2], B1[2][2];
    const char* cA = (const char*)g.A + (size_t)cur.pm * tstepA; const char* cB = (const char*)g.Bt + (size_t)cur.pn * tstep;
    S.a_ready(cur);
    if constexpr (SP2) {
        PG8_STAGE(PG8_SB(0, 0), cB, voffB); PG8_STAGE(PG8_SB(0, 1), cB + hstep, voffB); PG8_STAGE(PG8_SA(0, 0), cA, voffA); PG8_STAGE(PG8_SA(0, 1), cA + hstepA, voffA);
        if (wr == 1) PG8_BAR;
        PG8_WAIT_V(2); PG8_BAR;
        PG8_STAGE(PG8_SB(1, 0), cB + kstep, voffB); PG8_STAGE(PG8_SA(1, 0), PG8_AK(cA, 1), voffA); PG8_STAGE(PG8_SB(1, 1), cB + hstep + kstep, voffB);
        PG8_WAIT_V(6); PG8_BAR;
    } else {
        PG8_STAGE(PG8_SB(0, 0), cB, voffB); PG8_STAGE(PG8_SA(0, 0), cA, voffA); PG8_STAGE(PG8_SB(0, 1), cB + hstep, voffB); PG8_STAGE(PG8_SA(0, 1), cA + hstepA, voffA);
        if (wr == 1) PG8_BAR;
        PG8_WAIT_V(4); PG8_BAR;
        PG8_STAGE(PG8_SB(1, 0), cB + kstep, voffB); PG8_STAGE(PG8_SA(1, 0), PG8_AK(cA, 1), voffA); PG8_STAGE(PG8_SB(1, 1), cB + hstep + kstep, voffB);
        PG8_WAIT_V(6); PG8_BAR;
    }
    for (;;) {
        const bool has_next = S.next(ui + 1, nxt);
        const char* nA = has_next ? (const char*)g.A + (size_t)nxt.pm * tstepA : cA; const char* nB = has_next ? (const char*)g.Bt + (size_t)nxt.pn * tstep : cB;
        for (int t = 0; t < nt; t += 2) {
            const bool last = (t == nt - 2);
            if (Mid::ENABLED) MH(acc, cur, t, wr, wc, fr, fq);
            const char* a1 = PG8_AK(cA, t + 1);
            const char* a2 = last ? nA : PG8_AK(cA, t + 2); const char* b2 = last ? nB : cB + (size_t)(t + 2) * kstep;
            const char* a3 = a2 + kstepA; const char* b3 = b2 + kstep;
            if (last && has_next) S.a_ready(nxt);
            if constexpr (SP2) {
            PG8_LDB(B0, 0, 0); PG8_LDB(B1, 0, 1); PG8_SCHED; PG8_LDA(At, 0, 0); PG8_STAGE(PG8_SA(1, 1), a1 + hstepA, voffA);
            PG8_WAIT_V(8); PG8_WAIT_L(0); PG8_BAR; PG8_MMA(0, 0, At, B0); PG8_MMA(0, 1, At, B1); PG8_BAR; PG8_SCHED;
            PG8_LDA(At, 0, 1); PG8_STAGE(PG8_SB(0, 0), b2, voffB); PG8_STAGE(PG8_SB(0, 1), b2 + hstep, voffB); PG8_STAGE(PG8_SA(0, 0), a2, voffA);
            PG8_WAIT_V(8); PG8_WAIT_L(0); PG8_BAR; PG8_MMA(1, 0, At, B0); PG8_MMA(1, 1, At, B1); PG8_BAR; PG8_SCHED;
            PG8_LDB(B0, 1, 0); PG8_LDB(B1, 1, 1); PG8_SCHED; PG8_LDA(At, 1, 0); PG8_STAGE(PG8_SA(0, 1), a2 + hstepA, voffA);
            PG8_WAIT_V(8); PG8_WAIT_L(0); PG8_BAR; PG8_MMA(0, 0, At, B0); PG8_MMA(0, 1, At, B1); PG8_BAR; PG8_SCHED;
            PG8_LDA(At, 1, 1); PG8_STAGE(PG8_SB(1, 0), b3, voffB); PG8_STAGE(PG8_SB(1, 1), b3 + hstep, voffB); PG8_STAGE(PG8_SA(1, 0), a3, voffA);
            PG8_WAIT_V(8); PG8_WAIT_L(0); PG8_BAR; PG8_MMA(1, 0, At, B0); PG8_MMA(1, 1, At, B1); PG8_BAR; PG8_SCHED;
            } else {
            PG8_LDB(B0, 0, 0); PG8_SCHED; PG8_LDA(At, 0, 0); PG8_STAGE(PG8_SA(1, 1), a1 + hstepA, voffA);
            PG8_WAIT_L(8); PG8_BAR; PG8_WAIT_L(0); PG8_MMA(0, 0, At, B0); PG8_BAR; PG8_SCHED;
            PG8_LDB(B1, 0, 1); PG8_STAGE(PG8_SB(0, 0), b2, voffB);
            PG8_BAR; PG8_WAIT_L(0); PG8_MMA(0, 1, At, B1); PG8_BAR;
            PG8_LDA(At, 0, 1); PG8_STAGE(PG8_SA(0, 0), a2, voffA);
            PG8_BAR; PG8_WAIT_L(0); PG8_MMA(1, 0, At, B0); PG8_BAR; PG8_SCHED;
            PG8_STAGE(PG8_SB(0, 1), b2 + hstep, voffB);
            PG8_WAIT_V(6); PG8_BAR; PG8_MMA(1, 1, At, B1); PG8_BAR;
            PG8_LDB(B0, 1, 0); PG8_SCHED; PG8_LDA(At, 1, 0); PG8_STAGE(PG8_SA(0, 1), a2 + hstepA, voffA);
            PG8_WAIT_L(8); PG8_BAR; PG8_WAIT_L(0); PG8_MMA(0, 0, At, B0); PG8_BAR; PG8_SCHED;
            PG8_LDB(B1, 1, 1); PG8_STAGE(PG8_SB(1, 0), b3, voffB);
            PG8_BAR; PG8_WAIT_L(0); PG8_MMA(0, 1, At, B1); PG8_BAR;
            PG8_LDA(At, 1, 1); PG8_STAGE(PG8_SA(1, 0), a3, voffA);
            PG8_BAR; PG8_WAIT_L(0); PG8_MMA(1, 0, At, B0); PG8_BAR; PG8_SCHED;
            PG8_STAGE(PG8_SB(1, 1), b3 + hstep, voffB);
            PG8_WAIT_V(6); PG8_BAR; PG8_MMA(1, 1, At, B1); PG8_BAR;
            }
        }
        if constexpr (ALIGN_EPI) { if (wr == 0) PG8_BAR; }
        if constexpr (!Epi::AFTER_DRAIN) { E(acc, cur, wr, wc, fr, fq); S.done(cur); }
        if (!has_next) break;
#pragma unroll
        for (int a = 0; a < 2; ++a)
#pragma unroll
            for (int b = 0; b < 2; ++b)
#pragma unroll
                for (int m = 0; m < 4; ++m)
#pragma unroll
                    for (int n = 0; n < 2; ++n) acc[a][b][m][n] = (f32x4){0.f, 0.f, 0.f, 0.f};
        cur = nxt; cA = nA; cB = nB; ++ui;
        if constexpr (ALIGN_EPI) { if (wr == 1) PG8_BAR; }
    }
    PG8_WAIT_V(0);
    if constexpr (!ALIGN_EPI) { if (wr == 0) PG8_BAR; }
    PG8_BAR;
    if constexpr (Epi::AFTER_DRAIN) { E.fused(acc, cur, wr, wc, fr, fq, lds, wid, lane); S.done(cur); }
#undef PG8_AK
#undef PG8_SA
#undef PG8_SB
#undef PG8_STAGE
#undef PG8_LDA
#undef PG8_LDB
#undef PG8_MMA
#undef PG8_WAIT_V
#undef PG8_WAIT_L
#undef PG8_BAR
#undef PG8_SCHED
}
}

__device__ __forceinline__ int winmap(int n) { return n < 2560 ? n : (n < 5120 ? n + 16 : (n < 5136 ? 2560 + (n - 5120) : n)); }
template <class Map>
__device__ __forceinline__ void transpose_item(const float* W, int ldw, bf16* WT, int K, int item, int nblk, float* scr, int lane, const Map& mp) {
    const int kb = item / nblk, nbk = item % nblk, k0 = 64 * kb, n0 = 32 * nbk;
    const int col = mp.scol(n0 + (lane & 31));
#pragma unroll 8
    for (int i = 0; i < 32; ++i) { const int kk = 2 * i + (lane >> 5); scr[kk * 33 + (lane & 31)] = col >= 0 ? W[(size_t)mp.srow(k0 + kk) * ldw + col] * mp.scale(k0 + kk) : 0.f; }
    const int c = lane & 7;
#pragma unroll
    for (int j = 0; j < 4; ++j) { const int n = (lane >> 3) + 8 * j; const float* s = scr + (8 * c) * 33 + n;
        *(uint4*)(WT + (size_t)(n0 + n) * K + k0 + 8 * c) = make_uint4(pk2bf(s[0], s[33]), pk2bf(s[66], s[99]), pk2bf(s[132], s[165]), pk2bf(s[198], s[231])); }
}
struct MapPlain { __device__ __forceinline__ int srow(int k) const { return k; } __device__ __forceinline__ int scol(int n) const { return n; } __device__ __forceinline__ float scale(int) const { return 1.f; } };
struct MapWin { __device__ __forceinline__ int srow(int k) const { return k; } __device__ __forceinline__ int scol(int n) const { return n < NPROJ ? winmap(n) : -1; } __device__ __forceinline__ float scale(int) const { return 1.f; } };
struct MapWout { const float* an; const float* sn;
    __device__ __forceinline__ int srow(int k) const { return (k + 1024) & 2047; } __device__ __forceinline__ int scol(int n) const { return n; } __device__ __forceinline__ float scale(int k) const { return k < 1024 ? an[k] : sn[k - 1024]; } };
__device__ __forceinline__ void ph_prep(const Params& p, int wv, unsigned char* lds) {
    PH_IDS(); unsigned char* ws = p.ws;
    bf16* xb = (bf16*)(ws + OFF_XB);
    for (size_t i = gtid; i < (size_t)T * D / 8; i += gn) { const float4 v = ((const float4*)p.x)[2 * i], w = ((const float4*)p.x)[2 * i + 1]; ((uint4*)xb)[i] = make_uint4(pk2bf(v.x, v.y), pk2bf(v.z, v.w), pk2bf(w.x, w.y), pk2bf(w.z, w.w)); }
    {
        float* scr = (float*)(lds + wv * 8448);
        constexpr int I_WIN = 16 * 168, I_WOUT = 32 * 32, I_WQ = 16 * 64, I_W1 = 32 * 8, I_W2 = 4 * 2;
        constexpr int NIT = I_WIN + I_WOUT + I_WQ + 2 * I_W1 + 2 * I_W2;
        for (int it = gwave; it < NIT; it += nwaves) {
            int r = it;
            if (r < I_WIN) { transpose_item(p.w_in, NPROJ, (bf16*)(ws + OFF_WIN), 1024, r, 168, scr, lane, MapWin{}); continue; } r -= I_WIN;
            if (r < I_WOUT) { transpose_item(p.w_out, 1024, (bf16*)(ws + OFF_WOUT), 2048, r, 32, scr, lane, MapWout{p.attn_norm_w, p.ssd_norm_w}); continue; } r -= I_WOUT;
            if (r < I_WQ) { transpose_item(p.peer_wq, 2048, (bf16*)(ws + OFF_WQ), 1024, r, 64, scr, lane, MapPlain{}); continue; } r -= I_WQ;
            if (r < I_W1) { transpose_item(p.cmp_w1_k, 256, (bf16*)(ws + OFF_W1K), 2048, r, 8, scr, lane, MapPlain{}); continue; } r -= I_W1;
            if (r < I_W1) { transpose_item(p.cmp_w1_v, 256, (bf16*)(ws + OFF_W1V), 2048, r, 8, scr, lane, MapPlain{}); continue; } r -= I_W1;
            if (r < I_W2) { transpose_item(p.cmp_w2_k, 64, (bf16*)(ws + OFF_W2K), 256, r, 2, scr, lane, MapPlain{}); continue; } r -= I_W2;
            transpose_item(p.cmp_w2_v, 64, (bf16*)(ws + OFF_W2V), 256, r, 2, scr, lane, MapPlain{});
        }
    }
    bf16* keys = (bf16*)(ws + OFF_KEYS);
    for (int i = gtid; i < 8 * 2 * 128 * 128; i += gn) keys[i] = f2bf(p.peer_keys[i]);
    float* rc = (float*)(ws + OFF_ROPE); float* rs = rc + 4096 * 32;
    for (int i = gtid; i < 4096 * 32; i += gn) {
        const int pos = i >> 5, j = i & 31;
        const float inv = powf(10000.0f, -(float)(2 * j) / 64.0f); const float angf = (float)pos * inv;
        double xr = (double)angf * 0.15915494309189535; xr -= rint(xr); const double rr = xr * 6.283185307179586, r2 = rr * rr;
        double s = 0.0, c = 0.0, ts = rr, tc = 1.0;
        for (int k = 0; k < 14; ++k) { s += ts; c += tc; tc = -tc * r2 / (double)((2 * k + 1) * (2 * k + 2)); ts = -ts * r2 / (double)((2 * k + 2) * (2 * k + 3)); }
        rc[i] = (float)c; rs[i] = (float)s;
    }
    float* b1k = (float*)(ws + OFF_B1K); float* b1v = (float*)(ws + OFF_B1V);
    for (int o = gwave; o < 512; o += nwaves) {
        const int j = o & 255; const float* pos = o < 256 ? p.cmp_pos_k : p.cmp_pos_v; const float* w1 = o < 256 ? p.cmp_w1_k : p.cmp_w1_v;
        float s = 0.f; for (int k = lane; k < 2048; k += 64) s += pos[k] * w1[(size_t)k * 256 + j];
        s = wave_sum(s); if (lane == 0) (o < 256 ? b1k : b1v)[j] = s;
    }
}

struct EpiInProj {
    bf16 *z, *xbc, *q, *kvs, *dtg;
    __device__ __forceinline__ void operator()(int row, int c, float v) const {
        const bf16 b = f2bf(v);
        if (c < 1024) z[(size_t)row * 1024 + c] = b;
        else if (c < 2560) xbc[(size_t)row * 1536 + (c - 1024)] = b;
        else if (c < 3584) q[(size_t)row * 1024 + (c - 2560)] = b;
        else if (c < 5120) kvs[(size_t)row * 1536 + (c - 3584)] = b;
        else if (c < 5184) dtg[(size_t)row * 64 + (c - 5120)] = b;
    }
};

__device__ __forceinline__ void unpack8(const uint4& w, float* f) { f[0] = __uint_as_float(w.x << 16); f[1] = __uint_as_float(w.x & 0xffff0000u); f[2] = __uint_as_float(w.y << 16); f[3] = __uint_as_float(w.y & 0xffff0000u);
    f[4] = __uint_as_float(w.z << 16); f[5] = __uint_as_float(w.z & 0xffff0000u); f[6] = __uint_as_float(w.w << 16); f[7] = __uint_as_float(w.w & 0xffff0000u); }
__device__ __forceinline__ uint4 pack8(const float* f) { return make_uint4(pk2bf(f[0], f[1]), pk2bf(f[2], f[3]), pk2bf(f[4], f[5]), pk2bf(f[6], f[7])); }
__device__ __forceinline__ void ph_tokprep(const Params& p, int wv) {
    PH_IDS(); unsigned char* ws = p.ws;
    const int gtid_ = (nb > 64 ? bid - 32 : bid) * NTHREADS + tid, gn_ = (nb > 64 ? nb - 32 : nb) * NTHREADS;
    const bf16* xbc = (const bf16*)(ws + OFF_XBC); bf16* xsbc = (bf16*)(ws + OFF_XSBC);
    for (int it = gtid_; it < (T / 16) * 192; it += gn_) {
        const int cg = it % 192, tg = it / 192, ch = cg * 8, t0 = tg * 16, l0 = t0 & (L - 1);
        float w[4][8], bias[8];
#pragma unroll
        for (int j = 0; j < 4; ++j) { const float4 a = *(const float4*)(p.conv_w + j * 1536 + ch), b2 = *(const float4*)(p.conv_w + j * 1536 + ch + 4); w[j][0] = a.x; w[j][1] = a.y; w[j][2] = a.z; w[j][3] = a.w; w[j][4] = b2.x; w[j][5] = b2.y; w[j][6] = b2.z; w[j][7] = b2.w; }
        { const float4 a = *(const float4*)(p.conv_b + ch), b2 = *(const float4*)(p.conv_b + ch + 4); bias[0] = a.x; bias[1] = a.y; bias[2] = a.z; bias[3] = a.w; bias[4] = b2.x; bias[5] = b2.y; bias[6] = b2.z; bias[7] = b2.w; }
        float x0[8], x1[8], x2[8], x3[8];
        { uint4 h0 = make_uint4(0u, 0u, 0u, 0u), h1 = h0, h2 = h0;
          if (l0 != 0) { h0 = *(const uint4*)(xbc + (size_t)(t0 - 3) * 1536 + ch); h1 = *(const uint4*)(xbc + (size_t)(t0 - 2) * 1536 + ch); h2 = *(const uint4*)(xbc + (size_t)(t0 - 1) * 1536 + ch); }
          unpack8(h0, x0); unpack8(h1, x1); unpack8(h2, x2); }
#pragma unroll
        for (int u = 0; u < 16; ++u) {
            unpack8(*(const uint4*)(xbc + (size_t)(t0 + u) * 1536 + ch), x3);
            float y[8];
#pragma unroll
            for (int i = 0; i < 8; ++i) { const float v = bias[i] + w[0][i] * x0[i] + w[1][i] * x1[i] + w[2][i] * x2[i] + w[3][i] * x3[i]; y[i] = v * sigmoidf(v); x0[i] = x1[i]; x1[i] = x2[i]; x2[i] = x3[i]; }
            *(uint4*)(xsbc + (size_t)(t0 + u) * 1536 + ch) = pack8(y);
        }
    }
    const bf16* dtg = (const bf16*)(ws + OFF_DTG); float* dt = (float*)(ws + OFF_DT); float* gate = (float*)(ws + OFF_GATE);
    for (int i = gtid_; i < T * 64; i += gn_) {
        const int t = i >> 6, c = i & 63; const float v = bf2f(dtg[i]);
        if (c < 16) { const float xx = v + p.dt_bias[c]; dt[t * 16 + c] = xx > 20.f ? xx : log1pf(__expf(xx)); }
        else gate[t * 48 + (c - 16)] = sigmoidf(v);
    }
    const float* rc = (const float*)(ws + OFF_ROPE); const float* rs = rc + 4096 * 32;
    bf16* q = (bf16*)(ws + OFF_Q); bf16* kvs = (bf16*)(ws + OFF_KVS);
    for (int it = gtid_; it < T * 24 * 4; it += gn_) {
        const int j0 = (it & 3) * 8, hh = (it >> 2) % 24, t = it / 96, l = t & (L - 1);
        bf16* pp; float sc;
        if (hh < 16) { pp = q + (size_t)t * 1024 + hh * 64 + j0; sc = 0.125f * 1.4426950408889634f; } else if (hh < 20) { pp = kvs + (size_t)t * 1536 + 512 + (hh - 16) * 64 + j0; sc = 1.f; } else { pp = kvs + (size_t)t * 1536 + 1024 + (hh - 20) * 64 + j0; sc = 1.f; }
        float x1[8], x2[8], c[8], s[8], o1[8], o2[8];
        unpack8(*(const uint4*)pp, x1); unpack8(*(const uint4*)(pp + 32), x2);
        { const float4 a = *(const float4*)(rc + l * 32 + j0), b2 = *(const float4*)(rc + l * 32 + j0 + 4), d = *(const float4*)(rs + l * 32 + j0), e = *(const float4*)(rs + l * 32 + j0 + 4);
          c[0] = a.x; c[1] = a.y; c[2] = a.z; c[3] = a.w; c[4] = b2.x; c[5] = b2.y; c[6] = b2.z; c[7] = b2.w; s[0] = d.x; s[1] = d.y; s[2] = d.z; s[3] = d.w; s[4] = e.x; s[5] = e.y; s[6] = e.z; s[7] = e.w; }
#pragma unroll
        for (int i = 0; i < 8; ++i) { o1[i] = (x1[i] * c[i] - x2[i] * s[i]) * sc; o2[i] = (x1[i] * s[i] + x2[i] * c[i]) * sc; }
        *(uint4*)pp = pack8(o1); *(uint4*)(pp + 32) = pack8(o2);
    }
}

__device__ __forceinline__ void ph_ssd_prep2(const Params& p, int wv, unsigned char* lds) {
    PH_IDS(); unsigned char* ws = p.ws;
    const bf16* xsbc = (const bf16*)(ws + OFF_XSBC); const float* dt = (const float*)(ws + OFF_DT);
    bf16* XdT = (bf16*)p.out; bf16* BT = (bf16*)(ws + OFF_BT); float* acsT = (float*)(ws + OFF_ACS);
    float* sdt = (float*)lds; float* swave = sdt + 128;
    const int bide = bid, nbe = nb;
    for (int unit = bide; unit < 2048 + 256; unit += nbe) {
        __syncthreads();
        if (unit < 2048) {
            const int h = unit & 15, bc = unit >> 4; const size_t t0 = (size_t)bc * 128;
            const float A = -__expf(p.a_log[h]);
            if (tid < 128) { const float dv = dt[(t0 + tid) * 16 + h]; sdt[tid] = dv; float a = dv * A;
#pragma unroll
                for (int o = 1; o < 64; o <<= 1) { const float v = __shfl_up(a, o); if (lane >= o) a += v; }
                if (lane == 63) swave[tid >> 6] = a;
                sdt[128 + 8 + tid] = a; }
            __syncthreads();
            if (tid < 128) { float a = sdt[128 + 8 + tid]; if (tid >= 64) a += swave[0]; acsT[(size_t)unit * 128 + tid] = a; }
            const int pp = tid & 63, lg = tid >> 6; const bf16* src = xsbc + (t0 + lg * 16) * 1536 + h * 64 + pp;
            unsigned w[8];
#pragma unroll
            for (int i = 0; i < 8; ++i) { const float v0 = bf2f(src[(size_t)(2 * i) * 1536]) * sdt[lg * 16 + 2 * i], v1 = bf2f(src[(size_t)(2 * i + 1) * 1536]) * sdt[lg * 16 + 2 * i + 1]; w[i] = (unsigned)f2bf(v0) | ((unsigned)f2bf(v1) << 16); }
            uint4* dst = (uint4*)(XdT + (size_t)unit * 8192 + pp * 128 + lg * 16);
            dst[0] = make_uint4(w[0], w[1], w[2], w[3]); dst[1] = make_uint4(w[4], w[5], w[6], w[7]);
        } else {
            const int u2 = unit - 2048, g = u2 & 1, bc = u2 >> 1; const size_t t0 = (size_t)bc * 128;
            const int n = tid & 127, lg = tid >> 7; const bf16* src = xsbc + (t0 + lg * 32) * 1536 + 1024 + g * 128 + n;
            uint4* dst = (uint4*)(BT + (size_t)u2 * 16384 + n * 128 + lg * 32);
#pragma unroll
            for (int k = 0; k < 4; ++k) { unsigned w[4];
#pragma unroll
                for (int i = 0; i < 4; ++i) w[i] = (unsigned)src[(size_t)(8 * k + 2 * i) * 1536] | ((unsigned)src[(size_t)(8 * k + 2 * i + 1) * 1536] << 16);
                dst[k] = make_uint4(w[0], w[1], w[2], w[3]); }
        }
    }
}
__device__ __forceinline__ bf16x8 scale_frag(bf16x8 a, const float* s) {
    bf16x8 o;
#pragma unroll
    for (int j = 0; j < 8; ++j) o[j] = (short)f2bf(bf2f((bf16)a[j]) * s[j]);
    return o;
}
__device__ __forceinline__ void ph_ssd_states(const Params& p, int wv) {
    PH_IDS(); unsigned char* ws = p.ws; const int r = lane & 15, q = lane >> 4;
    const bf16* XdT = (const bf16*)p.out; bf16* S = (bf16*)((unsigned char*)p.out + 32 * MiB); const bf16* BT = (const bf16*)(ws + OFF_BT); const float* acsT = (const float*)(ws + OFF_ACS);
    for (int task = gwave; task < 8192; task += nwaves) {
        const int pt = task & 3, unit = task >> 2, h = unit & 15, bc = unit >> 4, g = h >> 3;
        const float* ac = acsT + (size_t)unit * 128; const float alast = ac[127];
        const bf16* xrow = XdT + (size_t)unit * 8192 + (pt * 16 + r) * 128; const bf16* bt = BT + (size_t)(bc * 2 + g) * 16384 + r * 128;
        f32x4 acc[8];
#pragma unroll
        for (int i = 0; i < 8; ++i) acc[i] = (f32x4){0.f, 0.f, 0.f, 0.f};
#pragma unroll
        for (int ks = 0; ks < 4; ++ks) {
            const int l0 = ks * 32 + 8 * q; float dec[8];
#pragma unroll
            for (int j = 0; j < 8; ++j) dec[j] = __expf(alast - ac[l0 + j]);
            const bf16x8 af = scale_frag(*(const bf16x8*)(xrow + l0), dec);
#pragma unroll
            for (int nt = 0; nt < 8; ++nt) acc[nt] = __builtin_amdgcn_mfma_f32_16x16x32_bf16(af, *(const bf16x8*)(bt + (size_t)nt * 2048 + l0), acc[nt], 0, 0, 0);
        }
        bf16* so = S + (size_t)unit * 8192 + (pt * 16 + 4 * q) * 128 + r;
#pragma unroll
        for (int nt = 0; nt < 8; ++nt)
#pragma unroll
            for (int e = 0; e < 4; ++e) so[e * 128 + nt * 16] = f2bf(acc[nt][e]);
    }
}
__device__ __forceinline__ void ph_ssd_scan(const Params& p, int wv) {
    PH_IDS();
    unsigned* S = (unsigned*)((unsigned char*)p.out + 32 * MiB); const float* acsT = (const float*)(p.ws + OFF_ACS);
    for (int e = gtid; e < NBATCH * 16 * 4096; e += gn) {
        const int pn = e & 4095, h = (e >> 12) & 15, b = e >> 16; float r0 = 0.f, r1 = 0.f;
        for (int c = 0; c < 32; c += 4) {
            unsigned v[4]; float d[4];
#pragma unroll
            for (int u = 0; u < 4; ++u) { const int unit = (b * 32 + c + u) * 16 + h; v[u] = S[(size_t)unit * 4096 + pn]; d[u] = __expf(acsT[(size_t)unit * 128 + 127]); }
#pragma unroll
            for (int u = 0; u < 4; ++u) { const int unit = (b * 32 + c + u) * 16 + h; S[(size_t)unit * 4096 + pn] = (unsigned)f2bf(r0) | ((unsigned)f2bf(r1) << 16);
                r0 = r0 * d[u] + bf2f((bf16)(v[u] & 0xffffu)); r1 = r1 * d[u] + bf2f((bf16)(v[u] >> 16)); }
        }
    }
}
constexpr int SO_CBROW = 136;
__device__ __forceinline__ void ph_ssd_out(const Params& p, int wv, unsigned char* lds) {
    PH_IDS(); unsigned char* ws = p.ws; const int rr = lane & 31, hi = lane >> 5;
    const bf16* XdT = (const bf16*)p.out; const bf16* S = (const bf16*)((unsigned char*)p.out + 32 * MiB); const bf16* xsbc = (const bf16*)(ws + OFF_XSBC);
    const float* acsT = (const float*)(ws + OFF_ACS); bf16* z = (bf16*)(ws + OFF_Z); float* ssq2p = (float*)(ws + OFF_HID);
    bf16* CBl = (bf16*)lds;
    for (int unit = bid; unit < 256; unit += nb) {
        const int g = unit & 1, bc = unit >> 1; const size_t t0 = (size_t)bc * 128;
        __syncthreads();
        for (int ti = wv; ti < 10; ti += NWAVES) {
            int lt = 0, st = ti; if (st > 0) { st -= 1; lt = 1; if (st > 1) { st -= 2; lt = 2; if (st > 2) { st -= 3; lt = 3; } } }
            f32x16 acc;
#pragma unroll
            for (int e = 0; e < 16; ++e) acc[e] = 0.f;
            const bf16* arow = xsbc + (t0 + st * 32 + rr) * 1536 + 1024 + g * 128 + 8 * hi; const bf16* brow = xsbc + (t0 + lt * 32 + rr) * 1536 + 1280 + g * 128 + 8 * hi;
#pragma unroll
            for (int ks = 0; ks < 8; ++ks) acc = __builtin_amdgcn_mfma_f32_32x32x16_bf16(*(const bf16x8*)(arow + ks * 16), *(const bf16x8*)(brow + ks * 16), acc, 0, 0, 0);
            bf16* dst = CBl + (lt * 32 + rr) * SO_CBROW + st * 32 + 4 * hi;
#pragma unroll
            for (int a = 0; a < 4; ++a) *(uint2*)(dst + 8 * a) = make_uint2(pk2bf(acc[4 * a], acc[4 * a + 1]), pk2bf(acc[4 * a + 2], acc[4 * a + 3]));
        }
        __syncthreads();
        const int h = g * 8 + wv, uh = bc * 16 + h; const float* ac = acsT + (size_t)uh * 128; const float Dh = p.d_skip[h];
        const bf16* xd = XdT + (size_t)uh * 8192 + rr * 128 + 8 * hi; const bf16* sin = S + (size_t)uh * 8192 + rr * 128 + 8 * hi;
        f32x16 acc[2][4];
#pragma unroll
        for (int pt = 0; pt < 2; ++pt)
#pragma unroll
            for (int lt = 0; lt < 4; ++lt)
#pragma unroll
                for (int e = 0; e < 16; ++e) acc[pt][lt][e] = 0.f;
#pragma unroll
        for (int lt = 0; lt < 4; ++lt) {
            const int l = lt * 32 + rr; const float acl = ac[l]; const float eal = __expf(acl);
#pragma unroll
            for (int ks = 0; ks < 2 * lt + 2; ++ks) {
                const int s0 = ks * 16 + 8 * hi; float cb[8]; unpack8(*(const uint4*)(CBl + l * SO_CBROW + s0), cb);
                const f32x4 a0 = *(const f32x4*)(ac + s0), a1 = *(const f32x4*)(ac + s0 + 4);
#pragma unroll
                for (int jx = 0; jx < 8; ++jx) { const float as = jx < 4 ? a0[jx] : a1[jx - 4]; cb[jx] = (s0 + jx <= l) ? cb[jx] * __expf(acl - as) : 0.f; }
                union { uint4 u; bf16x8 v; } mf; mf.u = pack8(cb);
#pragma unroll
                for (int pt = 0; pt < 2; ++pt) acc[pt][lt] = __builtin_amdgcn_mfma_f32_32x32x16_bf16(*(const bf16x8*)(xd + (size_t)pt * 4096 + ks * 16), mf.v, acc[pt][lt], 0, 0, 0);
            }
            const bf16* crow_ = xsbc + (t0 + l) * 1536 + 1280 + g * 128 + 8 * hi;
#pragma unroll
            for (int ks = 0; ks < 8; ++ks) {
                float cf[8]; unpack8(*(const uint4*)(crow_ + ks * 16), cf);
#pragma unroll
                for (int jx = 0; jx < 8; ++jx) cf[jx] *= eal;
                union { uint4 u; bf16x8 v; } bf_; bf_.u = pack8(cf);
#pragma unroll
                for (int pt = 0; pt < 2; ++pt) acc[pt][lt] = __builtin_amdgcn_mfma_f32_32x32x16_bf16(*(const bf16x8*)(sin + (size_t)pt * 4096 + ks * 16), bf_.v, acc[pt][lt], 0, 0, 0);
            }
            const size_t t = t0 + l; float ss = 0.f;
#pragma unroll
            for (int pt = 0; pt < 2; ++pt)
#pragma unroll
                for (int a = 0; a < 4; ++a) {
                    const int col = h * 64 + pt * 32 + 8 * a + 4 * hi;
                    const uint2 xw = *(const uint2*)(xsbc + t * 1536 + col), zw = *(const uint2*)(z + t * 1024 + col);
                    const float xs0 = bflo(xw.x), xs1 = bfhi(xw.x), xs2 = bflo(xw.y), xs3 = bfhi(xw.y), z0 = bflo(zw.x), z1 = bfhi(zw.x), z2 = bflo(zw.y), z3 = bfhi(zw.y);
                    const float v0 = (acc[pt][lt][4 * a] + Dh * xs0) * (z0 * sigmoidf(z0)), v1 = (acc[pt][lt][4 * a + 1] + Dh * xs1) * (z1 * sigmoidf(z1));
                    const float v2 = (acc[pt][lt][4 * a + 2] + Dh * xs2) * (z2 * sigmoidf(z2)), v3 = (acc[pt][lt][4 * a + 3] + Dh * xs3) * (z3 * sigmoidf(z3));
                    ss += (v0 * v0 + v1 * v1) + (v2 * v2 + v3 * v3);
                    *(uint2*)(z + t * 1024 + col) = make_uint2(pk2bf(v0, v1), pk2bf(v2, v3));
                }
            ss += __shfl_xor(ss, 32);
            if (hi == 0) ssq2p[t * 16 + h] = ss;
        }
    }
}

struct ACmp {
    const bf16* kvs; int coff;
    __device__ __forceinline__ bf16x8 operator()(int m, int k) const {
        const int hk = m & 3, n = (m >> 2) & 255, b = m >> 10, l = k >> 6, d = k & 63;
        if (n == 255) return (bf16x8){0, 0, 0, 0, 0, 0, 0, 0};
        return *(const bf16x8*)(kvs + (size_t)(b * L + 16 * n + l) * 1536 + coff + hk * 64 + d);
    }
};
struct EpiHid { bf16* hid; const float* bias; __device__ __forceinline__ void operator()(int row, int c, float v) const { hid[(size_t)row * 256 + c] = f2bf(gelu_exact(v + bias[c])); } };
struct EpiKc {
    bf16* dst; bool tr; __device__ __forceinline__ void operator()(int m, int c, float v) const { const int hk = m & 3, n = (m >> 2) & 255, b = m >> 10; const bf16 o = (n == 255) ? (bf16)0 : f2bf(v);
        if (tr) dst[((size_t)(b * 4 + hk) * 64 + c) * 256 + n] = o; else dst[((size_t)(b * 4 + hk) * 256 + n) * 64 + c] = o; } };
__device__ __forceinline__ void ph_kc_rope(const Params& p, int wv) {
    PH_IDS(); unsigned char* ws = p.ws; bf16* kc = (bf16*)(ws + OFF_KC); const float* rc = (const float*)(ws + OFF_ROPE); const float* rs = rc + 4096 * 32;
    for (int i = gtid; i < 16 * 256 * 32; i += gn) {
        const int j = i & 31, n = (i >> 5) & 255, bh = i >> 13; const int pos = 16 * n + 31; if (n == 255) continue;
        const float c = rc[pos * 32 + j], s = rs[pos * 32 + j];
        bf16* pp = kc + ((size_t)bh * 256 + n) * 64 + j; const float x1 = bf2f(pp[0]), x2 = bf2f(pp[32]);
        pp[0] = f2bf(x1 * c - x2 * s); pp[32] = f2bf(x1 * s + x2 * c);
    }
}


__device__ __forceinline__ void ph_vt_prep(const Params& p, int wv) {
    PH_IDS(); unsigned char* ws = p.ws; const bf16* kvs = (const bf16*)(ws + OFF_KVS);
    const int bide = bid, nbe = nb;
    for (int unit = bide; unit < 2 * 16 * 64; unit += nbe) {
        const int br = unit & 1, tl = (unit >> 1) & 63, bh = unit >> 7, b = bh >> 2, hk = bh & 3;
        const int d = tid & 63, grp = tid >> 6; const int l0 = tl * 64 + grp * 8;
        const bf16* src = kvs + ((size_t)b * L + l0) * 1536 + (br ? 1280 : 768) + hk * 64 + d;
        unsigned w[4];
#pragma unroll
        for (int i = 0; i < 4; ++i) w[i] = (unsigned)src[(size_t)(2 * i) * 1536] | ((unsigned)src[(size_t)(2 * i + 1) * 1536] << 16);
        bf16* dst = (bf16*)(ws + (br ? OFF_VWT : OFF_VST)) + ((size_t)bh * 64 + d) * L + l0;
        *(uint4*)dst = make_uint4(w[0], w[1], w[2], w[3]);
    }
}

__device__ __forceinline__ int crow(int r, int hi) { return (r & 3) + 8 * (r >> 2) + 4 * hi; }
constexpr int NSA_KROW = 144, NSA_VROW = 136, NSA_KBUF = 64 * NSA_KROW, NSA_VBUF = 64 * NSA_VROW;
constexpr int NSA_OFF_STASH = 73728;
constexpr int NSA_OFF_K = 0, NSA_OFF_V = 2 * NSA_KBUF, NSA_OFF_IMPA = NSA_OFF_V + 2 * NSA_VBUF, NSA_IMPS = 65, NSA_OFF_IMPB = NSA_OFF_IMPA + 64 * NSA_IMPS * 4, NSA_OFF_SEL = NSA_OFF_IMPB + 64 * NSA_IMPS * 4;
struct NsaSrc { const bf16* K; size_t kstride; const bf16* VT; size_t ldv; };
__device__ __forceinline__ void nsa_gload(const NsaSrc& s, int k0, int tid, uint4& kr, uint4& vr) {
    const int row = tid >> 3, ch = tid & 7;
    kr = *(const uint4*)(s.K + (size_t)(k0 + row) * s.kstride + ch * 8);
    vr = *(const uint4*)(s.VT + (size_t)row * s.ldv + k0 + ch * 8);
}
__device__ __forceinline__ void nsa_lstore(unsigned char* kb, unsigned char* vb, int tid, const uint4& kr, const uint4& vr) {
    const int row = tid >> 3, ch = tid & 7;
    *(uint4*)(kb + row * NSA_KROW + ch * 16) = kr;
    uint2* vp = (uint2*)(vb + row * NSA_VROW + ch * 16); vp[0] = make_uint2(vr.x, vr.y); vp[1] = make_uint2(vr.z, vr.w);
}
__device__ __forceinline__ void nsa_qk(const unsigned char* kb, const bf16x8 (&qf)[4], int rr, int hi, f32x16& p0, f32x16& p1) {
#pragma unroll
    for (int i = 0; i < 16; ++i) { p0[i] = 0.f; p1[i] = 0.f; }
#pragma unroll
    for (int ds = 0; ds < 4; ++ds) {
        const bf16x8 a0 = *(const bf16x8*)(kb + rr * NSA_KROW + ds * 32 + hi * 16), a1 = *(const bf16x8*)(kb + (rr + 32) * NSA_KROW + ds * 32 + hi * 16);
        p0 = __builtin_amdgcn_mfma_f32_32x32x16_bf16(a0, qf[ds], p0, 0, 0, 0); p1 = __builtin_amdgcn_mfma_f32_32x32x16_bf16(a1, qf[ds], p1, 0, 0, 0);
    }
}
__device__ __forceinline__ void nsa_pv(const unsigned char* vb, int rr, int hi, const f32x16& p0, const f32x16& p1, f32x16 (&O)[2]) {
#pragma unroll
    for (int s = 0; s < 4; ++s) {
        const int eb = 8 * (s & 1), kbase = 32 * (s >> 1) + 16 * (s & 1);
        union { uint4 u; bf16x8 v; } pf;
        if (s < 2) pf.u = make_uint4(pk2bf(p0[eb], p0[eb + 1]), pk2bf(p0[eb + 2], p0[eb + 3]), pk2bf(p0[eb + 4], p0[eb + 5]), pk2bf(p0[eb + 6], p0[eb + 7]));
        else       pf.u = make_uint4(pk2bf(p1[eb], p1[eb + 1]), pk2bf(p1[eb + 2], p1[eb + 3]), pk2bf(p1[eb + 4], p1[eb + 5]), pk2bf(p1[eb + 6], p1[eb + 7]));
#pragma unroll
        for (int dsub = 0; dsub < 2; ++dsub) {
            const unsigned char* vp = vb + (dsub * 32 + rr) * NSA_VROW + (kbase + 4 * hi) * 2;
            const uint2 lo = *(const uint2*)vp, hh = *(const uint2*)(vp + 16);
            union { uint4 u; bf16x8 v; } vf; vf.u = make_uint4(lo.x, lo.y, hh.x, hh.y);
            O[dsub] = __builtin_amdgcn_mfma_f32_32x32x16_bf16(vf.v, pf.v, O[dsub], 0, 0, 0);
        }
    }
}
template <int MODE>
__device__ __forceinline__ void nsa_branch(unsigned char* lds, const NsaSrc& src, int jt0, int jt1, int tid, int rr, int hi, const bf16x8 (&qf)[4], int lpos, int qi, int tokblk,
                                           u64 selm, u64 wsel, float& m, float& lsum, float inv_l, f32x16 (&O)[2]) {
    if (jt0 >= jt1) return;
    asm volatile("" : "+v"(tid), "+v"(rr));
    float* impA = (float*)(lds + NSA_OFF_IMPA); float* impB = (float*)(lds + NSA_OFF_IMPB);
    uint4 kr, vr;
    nsa_gload(src, jt0 * 64, tid, kr, vr);
    nsa_lstore(lds + NSA_OFF_K, lds + NSA_OFF_V, tid, kr, vr);
    __syncthreads();
    for (int jt = jt0; jt < jt1; ++jt) {
        const int cur = (jt - jt0) & 1; const bool more = (jt + 1 < jt1);
        if (more) nsa_gload(src, (jt + 1) * 64, tid, kr, vr);
        const unsigned char* kb = lds + NSA_OFF_K + cur * NSA_KBUF; const unsigned char* vb = lds + NSA_OFF_V + cur * NSA_VBUF;
        const bool active = (MODE != 2) || ((wsel >> jt) & 1ull);
        if (active) {
            f32x16 p0, p1; nsa_qk(kb, qf, rr, hi, p0, p1);
            const int k0 = jt * 64;
            const bool tile_on = (MODE != 2) || ((selm >> jt) & 1ull);
            bool full;
            if (MODE <= 1) full = (16 * (k0 + 63) + 31 <= qi * 64); else if (MODE == 2) full = (jt < qi); else full = (jt > qi - 8) && (jt < qi);
            float mx = NEG_INF;
            if (full) {
#pragma unroll
                for (int e = 0; e < 16; ++e) mx = fmaxf(mx, fmaxf(p0[e], p1[e]));
                if (MODE == 2 && !tile_on) mx = NEG_INF;
            } else {
                const int lim = (MODE <= 1) ? (lpos - 31 - 16 * k0 - 64 * hi) : (lpos - k0 - 4 * hi);
#pragma unroll
                for (int e = 0; e < 16; ++e) {
                    const int ca = (e & 3) + 8 * (e >> 2), cb = ca + 32; bool oa, ob;
                    if (MODE <= 1) { oa = (16 * ca <= lim); ob = (16 * cb <= lim); }
                    else if (MODE == 2) { oa = (ca <= lim); ob = (cb <= lim); }
                    else { oa = (ca <= lim) && (ca > lim - 512); ob = (cb <= lim) && (cb > lim - 512); }
                    p0[e] = oa ? p0[e] : NEG_INF; p1[e] = ob ? p1[e] : NEG_INF; mx = fmaxf(mx, fmaxf(p0[e], p1[e]));
                }
            }
            if (MODE != 1) {
                mx = fmaxf(mx, __shfl_xor(mx, 32));
                const float mnew = fmaxf(m, mx);
                if (__any((mnew - m) > 6.0f)) {
                    const float alpha = __builtin_amdgcn_exp2f(m - mnew); m = mnew; lsum *= alpha;
                    if (MODE != 0) {
#pragma unroll
                        for (int e = 0; e < 16; ++e) { O[0][e] *= alpha; O[1][e] *= alpha; }
                    }
                }
                const float meff = (MODE == 2 && full && !tile_on) ? BIG : ((m > 0.5f * NEG_INF) ? m : BIG);
                float rs = 0.f;
#pragma unroll
                for (int e = 0; e < 16; ++e) { p0[e] = __builtin_amdgcn_exp2f(p0[e] - meff); p1[e] = __builtin_amdgcn_exp2f(p1[e] - meff); rs += p0[e] + p1[e]; }
                lsum += rs;
                if (MODE != 0) nsa_pv(vb, rr, hi, p0, p1, O);
            } else {
#pragma unroll
                for (int e = 0; e < 16; ++e) { p0[e] = __builtin_amdgcn_exp2f(p0[e] - m) * inv_l; p1[e] = __builtin_amdgcn_exp2f(p1[e] - m) * inv_l; }
                nsa_pv(vb, rr, hi, p0, p1, O);
#pragma unroll
                for (int sub = 0; sub < 2; ++sub)
#pragma unroll
                    for (int a = 0; a < 4; ++a) {
                        float G, last;
                        if (sub == 0) { G = (p0[4 * a] + p0[4 * a + 1]) + (p0[4 * a + 2] + p0[4 * a + 3]); last = p0[4 * a + 3]; } else { G = (p1[4 * a] + p1[4 * a + 1]) + (p1[4 * a + 2] + p1[4 * a + 3]); last = p1[4 * a + 3]; }
                        G += __shfl_xor(G, 1); G += __shfl_xor(G, 2); last += __shfl_xor(last, 1); last += __shfl_xor(last, 2);
                        const int jj = (k0 >> 2) + 8 * sub + 2 * a + hi;
                        if ((rr & 3) == 0) { impA[tokblk * NSA_IMPS + jj] = G; if (jj + 1 < 64) impB[tokblk * NSA_IMPS + jj + 1] = last; }
                    }
            }
        }
        if (more) nsa_lstore(lds + NSA_OFF_K + (cur ^ 1) * NSA_KBUF, lds + NSA_OFF_V + (cur ^ 1) * NSA_VBUF, tid, kr, vr);
        __syncthreads();
    }
}
__device__ __forceinline__ void ph_nsa(const Params& p, int wv, unsigned char* lds) {
    PH_IDS(); unsigned char* ws = p.ws; const int wave = wv, rr = lane & 31, hi = lane >> 5;
    bf16* q = (bf16*)(ws + OFF_Q); const bf16* kvs = (const bf16*)(ws + OFF_KVS);
    const float* gate = (const float*)(ws + OFF_GATE); float* ssq = (float*)(ws + OFF_SSQ);
    float* impA = (float*)(lds + NSA_OFF_IMPA); float* impB = (float*)(lds + NSA_OFF_IMPB); u64* selw = (u64*)(lds + NSA_OFF_SEL);
    unsigned* qctr = (unsigned*)(ws + OFF_BAR + 14336) + 64 * (bid & 7); volatile int* ucur = (volatile int*)(lds + NSA_OFF_SEL + 512);
    for (;;) {
        if (tid == 0) *ucur = (int)__hip_atomic_fetch_add(qctr, 1u, __ATOMIC_RELAXED, __HIP_MEMORY_SCOPE_AGENT);
        __syncthreads();
        const int u = *ucur;
        if (u >= 128) break;
        const int bh = (bid & 7) + 8 * (u & 1), qi = 63 - (u >> 1);
        const int b = bh >> 2, hk = bh & 3; const int tokblk = wave * 8 + (rr >> 2), g = rr & 3; const int lpos = qi * 64 + tokblk; const size_t t = (size_t)b * L + lpos;
        bf16* qrow = q + t * 1024 + (hk * 4 + g) * 64;
        bf16x8 qf[4];
#pragma unroll
        for (int ds = 0; ds < 4; ++ds) qf[ds] = *(const bf16x8*)(qrow + ds * 16 + hi * 8);
        for (int i = tid; i < 64 * NSA_IMPS; i += NTHREADS) { impA[i] = 0.f; impB[i] = 0.f; }
        __syncthreads();
        f32x16 O[2]; float* stash = (float*)(lds + NSA_OFF_STASH) + tid;
        const float g0 = gate[t * 48 + (hk * 4 + g) * 3 + 0], g1 = gate[t * 48 + (hk * 4 + g) * 3 + 1], g2 = gate[t * 48 + (hk * 4 + g) * 3 + 2];
        {
            NsaSrc s{(const bf16*)(ws + OFF_KC) + (size_t)bh * 256 * 64, 64, (const bf16*)(ws + OFF_VCT) + (size_t)bh * 64 * 256, 256};
            const int nct = (4 * qi + 3 + 63) >> 6;
            float m = NEG_INF, lsum = 0.f;
            nsa_branch<0>(lds, s, 0, nct, tid, rr, hi, qf, lpos, qi, tokblk, 0ull, 0ull, m, lsum, 0.f, O);
            lsum += __shfl_xor(lsum, 32);
            const float inv_l = lsum > 0.f ? 1.0f / lsum : 0.f;
#pragma unroll
            for (int e = 0; e < 16; ++e) { O[0][e] = 0.f; O[1][e] = 0.f; }
            nsa_branch<1>(lds, s, 0, nct, tid, rr, hi, qf, lpos, qi, tokblk, 0ull, 0ull, m, lsum, inv_l, O);
#pragma unroll
            for (int e = 0; e < 16; ++e) { stash[e * 512] = g0 * O[0][e]; stash[(16 + e) * 512] = g0 * O[1][e]; }
        }
        {
            const int tk = tid >> 3, jg = tid & 7; float v[8];
#pragma unroll
            for (int i = 0; i < 8; ++i) { const int j = jg * 8 + i; const float raw = impA[tk * NSA_IMPS + j] + impB[tk * NSA_IMPS + j];
                const bool causal = (j <= qi), forced = (j == 0) || (j == qi) || (j == qi - 1); v[i] = causal ? (forced ? BIG : raw) : NEG_INF; }
            __syncthreads();
#pragma unroll
            for (int i = 0; i < 8; ++i) impA[tk * NSA_IMPS + jg * 8 + i] = v[i];
            __syncthreads();
            int rank[8];
#pragma unroll
            for (int i = 0; i < 8; ++i) rank[i] = 0;
            for (int jj = 0; jj < 64; ++jj) { const float x = impA[tk * NSA_IMPS + jj];
#pragma unroll
                for (int i = 0; i < 8; ++i) rank[i] += (x > v[i] || (x == v[i] && jj < jg * 8 + i)) ? 1 : 0; }
            unsigned b8 = 0u;
#pragma unroll
            for (int i = 0; i < 8; ++i) b8 |= (rank[i] < 16 && jg * 8 + i <= qi) ? (1u << i) : 0u;
            const u64 full = (u64)b8 << (jg * 8); unsigned blo = (unsigned)full, bhi = (unsigned)(full >> 32);
            blo |= __shfl_xor(blo, 1); bhi |= __shfl_xor(bhi, 1); blo |= __shfl_xor(blo, 2); bhi |= __shfl_xor(bhi, 2); blo |= __shfl_xor(blo, 4); bhi |= __shfl_xor(bhi, 4);
            if (jg == 0) selw[tk] = (u64)blo | ((u64)bhi << 32);
            __syncthreads();
        }
        const u64 selm = selw[tokblk];
        u64 wsel = selm;
        { unsigned lo = (unsigned)wsel, h2 = (unsigned)(wsel >> 32);
          lo |= __shfl_xor(lo, 4); h2 |= __shfl_xor(h2, 4); lo |= __shfl_xor(lo, 8); h2 |= __shfl_xor(h2, 8); lo |= __shfl_xor(lo, 16); h2 |= __shfl_xor(h2, 16);
          wsel = (u64)lo | ((u64)h2 << 32); }
        {
            NsaSrc s{kvs + (size_t)b * L * 1536 + 512 + hk * 64, 1536, (const bf16*)(ws + OFF_VST) + (size_t)bh * 64 * L, (size_t)L};
            float m = NEG_INF, lsum = 0.f;
#pragma unroll
            for (int e = 0; e < 16; ++e) { O[0][e] = 0.f; O[1][e] = 0.f; }
            nsa_branch<2>(lds, s, 0, qi + 1, tid, rr, hi, qf, lpos, qi, tokblk, selm, wsel, m, lsum, 0.f, O);
            lsum += __shfl_xor(lsum, 32); const float sc = g1 / lsum;
#pragma unroll
            for (int e = 0; e < 16; ++e) { stash[e * 512] += sc * O[0][e]; stash[(16 + e) * 512] += sc * O[1][e]; }
        }
        {
            NsaSrc s{kvs + (size_t)b * L * 1536 + 1024 + hk * 64, 1536, (const bf16*)(ws + OFF_VWT) + (size_t)bh * 64 * L, (size_t)L};
            float m = NEG_INF, lsum = 0.f;
#pragma unroll
            for (int e = 0; e < 16; ++e) { O[0][e] = 0.f; O[1][e] = 0.f; }
            nsa_branch<3>(lds, s, qi >= 8 ? qi - 8 : 0, qi + 1, tid, rr, hi, qf, lpos, qi, tokblk, 0ull, 0ull, m, lsum, 0.f, O);
            lsum += __shfl_xor(lsum, 32); const float sc = g2 / lsum;
#pragma unroll
            for (int e = 0; e < 16; ++e) { O[0][e] = stash[e * 512] + sc * O[0][e]; O[1][e] = stash[(16 + e) * 512] + sc * O[1][e]; }
        }
        float ss = 0.f;
#pragma unroll
        for (int dsub = 0; dsub < 2; ++dsub)
#pragma unroll
            for (int a = 0; a < 4; ++a) {
                const float v0 = O[dsub][4 * a], v1 = O[dsub][4 * a + 1], v2 = O[dsub][4 * a + 2], v3 = O[dsub][4 * a + 3];
                ss += (v0 * v0 + v1 * v1) + (v2 * v2 + v3 * v3);
                *(uint2*)(qrow + dsub * 32 + 8 * a + 4 * hi) = make_uint2(pk2bf(v0, v1), pk2bf(v2, v3));
            }
        ss += __shfl_xor(ss, 32); ss += __shfl_xor(ss, 1); ss += __shfl_xor(ss, 2);
        if (hi == 0 && g == 0) ssq[t * 4 + hk] = ss;
        __syncthreads();
    }
}

constexpr size_t OFF_SU = 640 * 1024, OFF_SV = 704 * 1024, OFF_SX = 768 * 1024, OFF_SC = 832 * 1024;
constexpr size_t OFF_COEFQ = 218 * MiB, OFF_H1Q = 220 * MiB;
__device__ __forceinline__ unsigned pack4i8(float a, float b, float c, float d) {
    const int ia = (int)rintf(a), ib = (int)rintf(b), ic = (int)rintf(c), id = (int)rintf(d);
    return (unsigned)(ia & 0xff) | ((unsigned)(ib & 0xff) << 8) | ((unsigned)(ic & 0xff) << 16) | ((unsigned)(id & 0xff) << 24);
}
__device__ __forceinline__ void ph_ln1(const Params& p, int wv) {
    PH_IDS(); unsigned char* ws = p.ws; bf16* h1b = (bf16*)(ws + OFF_H1B); unsigned char* h1q = ws + OFF_H1Q; float* sx = (float*)(ws + OFF_SX);
    for (int t = gwave; t < T; t += nwaves) {
        float v[16]; float s = 0.f; float* row = p.out + (size_t)t * 1024 + lane * 16;
#pragma unroll
        for (int i = 0; i < 4; ++i) { const float4 a = *(const float4*)(row + 4 * i); v[4 * i] = a.x; v[4 * i + 1] = a.y; v[4 * i + 2] = a.z; v[4 * i + 3] = a.w; s += (a.x + a.y) + (a.z + a.w); }
        const float mu = wave_sum(s) * (1.0f / 1024.0f); float s2 = 0.f;
#pragma unroll
        for (int i = 0; i < 16; ++i) { v[i] -= mu; s2 += v[i] * v[i]; }
        const float rstd = rsqrtf(wave_sum(s2) * (1.0f / 1024.0f) + LN_EPS); float amax = 0.f;
#pragma unroll
        for (int i = 0; i < 4; ++i) { const int c = lane * 16 + 4 * i; const float4 ga = *(const float4*)(p.ln1_g + c), ba = *(const float4*)(p.ln1_b + c);
            v[4 * i] = v[4 * i] * rstd * ga.x + ba.x; v[4 * i + 1] = v[4 * i + 1] * rstd * ga.y + ba.y; v[4 * i + 2] = v[4 * i + 2] * rstd * ga.z + ba.z; v[4 * i + 3] = v[4 * i + 3] * rstd * ga.w + ba.w;
            *(float4*)(row + 4 * i) = make_float4(v[4 * i], v[4 * i + 1], v[4 * i + 2], v[4 * i + 3]); }
#pragma unroll
        for (int i = 0; i < 16; ++i) amax = fmaxf(amax, fabsf(v[i]));
        amax = fmaxf(wave_max(amax), 1e-20f); const float inv = 127.0f / amax;
        *(uint4*)(h1b + (size_t)t * 1024 + lane * 16) = pack8(v); *(uint4*)(h1b + (size_t)t * 1024 + lane * 16 + 8) = pack8(v + 8);
        *(uint4*)(h1q + (size_t)t * 1024 + lane * 16) = make_uint4(pack4i8(v[0] * inv, v[1] * inv, v[2] * inv, v[3] * inv), pack4i8(v[4] * inv, v[5] * inv, v[6] * inv, v[7] * inv),
                                                                 pack4i8(v[8] * inv, v[9] * inv, v[10] * inv, v[11] * inv), pack4i8(v[12] * inv, v[13] * inv, v[14] * inv, v[15] * inv));
        if (lane == 0) sx[t] = amax * (1.0f / 127.0f);
    }
}

__device__ __forceinline__ unsigned umaxu(unsigned a, unsigned b) { return a > b ? a : b; }
__device__ __forceinline__ unsigned uminu(unsigned a, unsigned b) { return a < b ? a : b; }
__device__ __forceinline__ unsigned f2mono(float f) { const unsigned u = __float_as_uint(f); return (u & 0x80000000u) ? ~u : (u | 0x80000000u); }
__device__ __forceinline__ float mono2f(unsigned m) { return __uint_as_float((m & 0x80000000u) ? (m & 0x7fffffffu) : ~m); }
template <int N> __device__ __forceinline__ void bitonic_sort_desc(unsigned (&a)[N]) {
#pragma unroll
    for (int k = 2; k <= N; k <<= 1)
#pragma unroll
        for (int j = k >> 1; j > 0; j >>= 1)
#pragma unroll
            for (int i = 0; i < N; ++i) { const int l = i ^ j; if (l > i) { const bool desc = ((i & k) == 0); const unsigned x = a[i], y = a[l], mx = umaxu(x, y), mn = uminu(x, y); a[i] = desc ? mx : mn; a[l] = desc ? mn : mx; } }
}
__device__ __forceinline__ void merge_top16(unsigned (&a)[16], const unsigned (&b)[16]) {
#pragma unroll
    for (int i = 0; i < 16; ++i) a[i] = umaxu(a[i], b[15 - i]);
#pragma unroll
    for (int j = 8; j > 0; j >>= 1)
#pragma unroll
        for (int i = 0; i < 16; ++i) { const int l = i ^ j; if (l > i) { const unsigned x = a[i], y = a[l]; a[i] = umaxu(x, y); a[l] = uminu(x, y); } }
}
__device__ __forceinline__ void peer_stage1(const bf16* qrow, const bf16* krow, int hi, unsigned (&run)[16]) {
    bf16x8 qf[8];
#pragma unroll
    for (int ks = 0; ks < 8; ++ks) qf[ks] = *(const bf16x8*)(qrow + ks * 16);
#pragma unroll 1
    for (int kt = 0; kt < 4; ++kt) {
        f32x16 acc;
#pragma unroll
        for (int e = 0; e < 16; ++e) acc[e] = 0.f;
        const bf16* kr = krow + (size_t)kt * 32 * 128;
#pragma unroll
        for (int ks = 0; ks < 8; ++ks) acc = __builtin_amdgcn_mfma_f32_32x32x16_bf16(*(const bf16x8*)(kr + ks * 16), qf[ks], acc, 0, 0, 0);
        unsigned grp[16]; const unsigned ib = (unsigned)(127 - kt * 32 - 4 * hi);
#pragma unroll
        for (int e = 0; e < 16; ++e) grp[e] = (f2mono(acc[e]) & ~0x7fu) | (ib - (unsigned)((e & 3) + 8 * (e >> 2)));
        bitonic_sort_desc<16>(grp);
        if (kt == 0) {
#pragma unroll
            for (int i = 0; i < 16; ++i) run[i] = grp[i];
        } else merge_top16(run, grp);
    }
    unsigned oth[16];
#pragma unroll
    for (int i = 0; i < 16; ++i) oth[i] = __shfl_xor(run[i], 32);
    merge_top16(run, oth);
}
__device__ __forceinline__ void ph_peer_topk(const Params& p, int wv, unsigned char* lds) {
    PH_IDS(); unsigned char* ws = p.ws; const int rr = lane & 31, hi = lane >> 5;
    int* exl = (int*)(lds + wv * 6400);
    const bf16* qp = (const bf16*)(ws + OFF_QP); const bf16* keys = (const bf16*)(ws + OFF_KEYS);
    int* eidx = (int*)(ws + OFF_EIDX); float* gw = (float*)(ws + OFF_GW);
    for (int task = gwave; task < 512 * 8; task += nwaves) {
        const int h = task & 7, t0 = (task >> 3) * 32;
        unsigned top[2][16];
        peer_stage1(qp + (size_t)(t0 + rr) * 2048 + h * 256 + 8 * hi, keys + ((size_t)(h * 2) * 128 + rr) * 128 + 8 * hi, hi, top[0]);
        peer_stage1(qp + (size_t)(t0 + rr) * 2048 + h * 256 + 128 + 8 * hi, keys + ((size_t)(h * 2 + 1) * 128 + rr) * 128 + 8 * hi, hi, top[1]);
        unsigned g4[4][16];
#pragma unroll
        for (int k = 0; k < 4; ++k)
#pragma unroll
            for (int i = 0; i < 16; ++i) g4[k][i] = 0u;
#pragma unroll
        for (int i = 0; i < 16; ++i) {
            int off = 0;
#pragma unroll
            for (int k = 0; k < 16; ++k) if (k < i) off += 16 / (k + 1);
            const float s0 = mono2f(top[0][i] & ~0x7fu); const int e0 = (int)(127u - (top[0][i] & 0x7fu)) * 128;
#pragma unroll
            for (int j = 0; j < 16; ++j) if ((i + 1) * (j + 1) <= 16) {
                const int nc = off + j;
                const float sum = s0 + mono2f(top[1][j] & ~0x7fu);
                g4[nc >> 4][nc & 15] = (f2mono(sum) & ~0x3fu) | (unsigned)(63 - nc);
                if (hi == 0) exl[nc * 32 + rr] = e0 + (int)(127u - (top[1][j] & 0x7fu));
            }
        }
#pragma unroll
        for (int k = 0; k < 4; ++k) bitonic_sort_desc<16>(g4[k]);
        merge_top16(g4[0], g4[1]); merge_top16(g4[2], g4[3]); merge_top16(g4[0], g4[2]);
        float e16[16]; float den = 0.f; const float gmax = mono2f(g4[0][0] & ~0x3fu);
#pragma unroll
        for (int r = 0; r < 16; ++r) { e16[r] = __expf(mono2f(g4[0][r] & ~0x3fu) - gmax); den += e16[r]; }
        const float inv = 1.0f / den; const size_t ob = (size_t)(t0 + rr) * 128 + h * 16 + hi * 8;
        float wo[8]; int eo[8];
#pragma unroll
        for (int k = 0; k < 8; ++k) { const unsigned key = hi ? g4[0][8 + k] : g4[0][k]; wo[k] = (hi ? e16[8 + k] : e16[k]) * inv; eo[k] = exl[(63 - (int)(key & 0x3fu)) * 32 + rr]; }
        *(float4*)(gw + ob) = make_float4(wo[0], wo[1], wo[2], wo[3]); *(float4*)(gw + ob + 4) = make_float4(wo[4], wo[5], wo[6], wo[7]);
        *(int4*)(eidx + ob) = make_int4(eo[0], eo[1], eo[2], eo[3]); *(int4*)(eidx + ob + 4) = make_int4(eo[4], eo[5], eo[6], eo[7]);
    }
}
__device__ __forceinline__ void ph_peer_cvt(const Params& p, int wv) {
    PH_IDS(); unsigned char* ws = p.ws;
    for (int r = gwave; r < 2 * 16384; r += nwaves) {
        const bool isv = r >= 16384; const int e = isv ? r - 16384 : r;
        const float* src = (isv ? p.peer_v : p.peer_u) + (size_t)e * 1024 + lane * 16; float v[16]; float amax = 0.f;
#pragma unroll
        for (int i = 0; i < 4; ++i) { const float4 a = *(const float4*)(src + 4 * i); v[4 * i] = a.x; v[4 * i + 1] = a.y; v[4 * i + 2] = a.z; v[4 * i + 3] = a.w; }
#pragma unroll
        for (int i = 0; i < 16; ++i) amax = fmaxf(amax, fabsf(v[i]));
        amax = fmaxf(wave_max(amax), 1e-30f); const float inv = 127.0f / amax;
        *(uint4*)(ws + (isv ? OFF_PV : OFF_PU) + (size_t)e * 1024 + lane * 16) = make_uint4(pack4i8(v[0] * inv, v[1] * inv, v[2] * inv, v[3] * inv), pack4i8(v[4] * inv, v[5] * inv, v[6] * inv, v[7] * inv),
                                                                                            pack4i8(v[8] * inv, v[9] * inv, v[10] * inv, v[11] * inv), pack4i8(v[12] * inv, v[13] * inv, v[14] * inv, v[15] * inv));
        if (lane == 0) ((float*)(ws + (isv ? OFF_SV : OFF_SU)))[e] = amax * (1.0f / 127.0f);
    }
}
__device__ __forceinline__ f32x2v pkfma(f32x2v a, f32x2v b, f32x2v c) { return __builtin_elementwise_fma(a, b, c); }
__device__ __forceinline__ float dot16f8(const uint4& w, const f32x2v* x) {
    f32x2v a = {0.f, 0.f}, b = {0.f, 0.f};
    a = pkfma(__builtin_amdgcn_cvt_pk_f32_fp8(w.x, false), x[0], a); b = pkfma(__builtin_amdgcn_cvt_pk_f32_fp8(w.x, true), x[1], b);
    a = pkfma(__builtin_amdgcn_cvt_pk_f32_fp8(w.y, false), x[2], a); b = pkfma(__builtin_amdgcn_cvt_pk_f32_fp8(w.y, true), x[3], b);
    a = pkfma(__builtin_amdgcn_cvt_pk_f32_fp8(w.z, false), x[4], a); b = pkfma(__builtin_amdgcn_cvt_pk_f32_fp8(w.z, true), x[5], b);
    a = pkfma(__builtin_amdgcn_cvt_pk_f32_fp8(w.w, false), x[6], a); b = pkfma(__builtin_amdgcn_cvt_pk_f32_fp8(w.w, true), x[7], b);
    a = a + b; return a.x + a.y;
}
__device__ __forceinline__ void axpy16f8(const uint4& w, float c, f32x2v* y) {
    const f32x2v c2 = {c, c};
    y[0] = pkfma(c2, __builtin_amdgcn_cvt_pk_f32_fp8(w.x, false), y[0]); y[1] = pkfma(c2, __builtin_amdgcn_cvt_pk_f32_fp8(w.x, true), y[1]);
    y[2] = pkfma(c2, __builtin_amdgcn_cvt_pk_f32_fp8(w.y, false), y[2]); y[3] = pkfma(c2, __builtin_amdgcn_cvt_pk_f32_fp8(w.y, true), y[3]);
    y[4] = pkfma(c2, __builtin_amdgcn_cvt_pk_f32_fp8(w.z, false), y[4]); y[5] = pkfma(c2, __builtin_amdgcn_cvt_pk_f32_fp8(w.z, true), y[5]);
    y[6] = pkfma(c2, __builtin_amdgcn_cvt_pk_f32_fp8(w.w, false), y[6]); y[7] = pkfma(c2, __builtin_amdgcn_cvt_pk_f32_fp8(w.w, true), y[7]);
}
constexpr size_t OFF_PART = 90 * MiB + 32 * MiB;
constexpr size_t OFF_COEF = 218 * MiB;
constexpr size_t OFF_Y = 122 * MiB;
static_assert(OFF_PART >= OFF_H1B + 32 * MiB && OFF_PART + 64 * MiB <= OFF_EIDX && OFF_COEF + 8 * MiB <= OFF_BT, "PEER scratch map");
#define PU_ISSUE16(W, ELO, EHI) do { _Pragma("unroll") for (int k = 0; k < 8; ++k) { const int e0 = __shfl(ELO, k * 8 + g), e1 = __shfl(EHI, k * 8 + g); \
        W[k] = *(const uint4*)(PU + (size_t)e0 * 1024 + 128 * s + 16 * j); W[8 + k] = *(const uint4*)(PU + (size_t)e1 * 1024 + 128 * s + 16 * j); } } while (0)
#define PU_DOT16(W, X) __builtin_amdgcn_sdot4((int)(W).w, (int)(X).w, __builtin_amdgcn_sdot4((int)(W).z, (int)(X).z, __builtin_amdgcn_sdot4((int)(W).y, (int)(X).y, __builtin_amdgcn_sdot4((int)(W).x, (int)(X).x, 0, false), false), false), false)
#define PU_REDUCE8(W, O, XQ, PROW, B) do { int d[8], a4[4], a2[2], a1; \
        _Pragma("unroll") for (int k = 0; k < 8; ++k) d[k] = PU_DOT16(W[(O) + k], XQ); \
        _Pragma("unroll") for (int k = 0; k < 4; ++k) { const int give = b2 ? d[k] : d[4 + k]; a4[k] = (b2 ? d[4 + k] : d[k]) + __shfl_xor(give, 4); } \
        _Pragma("unroll") for (int k = 0; k < 2; ++k) { const int give = b1 ? a4[k] : a4[2 + k]; a2[k] = (b1 ? a4[2 + k] : a4[k]) + __shfl_xor(give, 2); } \
        { const int give = b0 ? a2[0] : a2[1]; a1 = (b0 ? a2[1] : a2[0]) + __shfl_xor(give, 1); } \
        (PROW)[(B) * 64 + kk * 8 + g] = a1; } while (0)
#define PU_META(T_, XQ, ELO, EHI) do { const int tq_ = (T_) < T ? (T_) : tlast; XQ = *(const uint4*)(h1q + (size_t)tq_ * 1024 + 128 * s + 16 * j); \
        ELO = eidx[(size_t)tq_ * 128 + lane]; EHI = eidx[(size_t)tq_ * 128 + 64 + lane]; } while (0)
#define PU_TOKEN(W, T_, XQ) do { int* prow = part + ((size_t)s * T + (T_)) * 128; PU_REDUCE8(W, 0, XQ, prow, 0); PU_REDUCE8(W, 8, XQ, prow, 1); } while (0)
__device__ __forceinline__ void ph_peer_u(const Params& p, int wv) {
    PH_IDS(); unsigned char* ws = p.ws; const int s = bid & 7, cu = bid >> 3, ncu = nb >> 3, g = lane >> 3, j = lane & 7;
    const unsigned char* h1q = ws + OFF_H1Q; const int* eidx = (const int*)(ws + OFF_EIDX); const unsigned char* PU = ws + OFF_PU; int* part = (int*)(ws + OFF_PART);
    const bool b2 = (lane & 4) != 0, b1 = (lane & 2) != 0, b0 = (lane & 1) != 0; const int kk = (b2 ? 4 : 0) + (b1 ? 2 : 0) + (b0 ? 1 : 0);
    const int tstep = ncu * NWAVES; int t = cu * NWAVES + wv;
    if (t >= T) return;
    const int tlast = t;
    uint4 xq0, xq1; int el0, eh0, el1, eh1;
    PU_META(t, xq0, el0, eh0); PU_META(t + tstep, xq1, el1, eh1);
    uint4 wA[16], wB[16];
    PU_ISSUE16(wA, el0, eh0);
    for (;;) {
        { const uint4 cx = xq0; PU_META(t + 2 * tstep, xq0, el0, eh0); PU_ISSUE16(wB, el1, eh1); PU_TOKEN(wA, t, cx); }
        t += tstep; if (t >= T) break;
        { const uint4 cx = xq1; PU_META(t + 2 * tstep, xq1, el1, eh1); PU_ISSUE16(wA, el0, eh0); PU_TOKEN(wB, t, cx); }
        t += tstep; if (t >= T) break;
    }
}
__device__ __forceinline__ void ph_peer_c(const Params& p, int wv) {
    PH_IDS(); unsigned char* ws = p.ws; const int* part = (const int*)(ws + OFF_PART); const float* gw = (const float*)(ws + OFF_GW); const int* eidx = (const int*)(ws + OFF_EIDX);
    const float* su = (const float*)(ws + OFF_SU); const float* sv = (const float*)(ws + OFF_SV); const float* sx = (const float*)(ws + OFF_SX); float* sc = (float*)(ws + OFF_SC); unsigned* coefq = (unsigned*)(ws + OFF_COEFQ);
    for (int t = gwave; t < T; t += nwaves) {
        float cp[2];
#pragma unroll
        for (int b = 0; b < 2; ++b) { const size_t i = (size_t)t * 128 + b * 64 + lane; int acc = 0;
#pragma unroll
            for (int s = 0; s < 8; ++s) acc += part[(size_t)s * T * 128 + i];
            const int e = eidx[i]; cp[b] = gw[i] * gelu_exact((float)acc * su[e] * sx[t]) * sv[e]; }
        const float amax = fmaxf(wave_max(fmaxf(fabsf(cp[0]), fabsf(cp[1]))), 1e-30f), inv = 127.0f / amax;
        const int q0 = (int)rintf(cp[0] * inv) & 0xff, q1 = (int)rintf(cp[1] * inv) & 0xff;
        const int gg = lane & 7, kq = (lane >> 3) & 1;
        unsigned w0 = 0u, w1 = 0u;
#pragma unroll
        for (int i = 0; i < 4; ++i) { const int srcl = (4 * kq + i) * 8 + gg; w0 |= (unsigned)__shfl(q0, srcl) << (8 * i); w1 |= (unsigned)__shfl(q1, srcl) << (8 * i); }
        if (lane < 16) { coefq[(size_t)t * 32 + lane] = w0; coefq[(size_t)t * 32 + 16 + lane] = w1; }
        if (lane == 0) sc[t] = amax * (1.0f / 127.0f);
    }
}
#define PV_ISSUE16(W, ELO, EHI) do { _Pragma("unroll") for (int k = 0; k < 8; ++k) { const int e0 = __shfl(ELO, k * 8 + g), e1 = __shfl(EHI, k * 8 + g); \
        W[k] = *(const uint4*)(PV + (size_t)e0 * 1024 + 128 * s + 16 * j); W[8 + k] = *(const uint4*)(PV + (size_t)e1 * 1024 + 128 * s + 16 * j); } } while (0)
#define PV_META(T_, ELO, EHI, CQ) do { const int tq_ = (T_) < T ? (T_) : tlast; ELO = eidx[(size_t)tq_ * 128 + lane]; EHI = eidx[(size_t)tq_ * 128 + 64 + lane]; \
        CQ[0] = coefq[(size_t)tq_ * 32 + g]; CQ[1] = coefq[(size_t)tq_ * 32 + 8 + g]; CQ[2] = coefq[(size_t)tq_ * 32 + 16 + g]; CQ[3] = coefq[(size_t)tq_ * 32 + 24 + g]; } while (0)
#define PV_BLK(W0, W1, W2, W3, CQW, A0, A1, A2, A3) do { \
        const unsigned l01 = __builtin_amdgcn_perm(W1, W0, 0x05010400u), h01 = __builtin_amdgcn_perm(W1, W0, 0x07030602u), l23 = __builtin_amdgcn_perm(W3, W2, 0x05010400u), h23 = __builtin_amdgcn_perm(W3, W2, 0x07030602u); \
        A0 = __builtin_amdgcn_sdot4((int)__builtin_amdgcn_perm(l23, l01, 0x05040100u), (int)(CQW), A0, false); A1 = __builtin_amdgcn_sdot4((int)__builtin_amdgcn_perm(l23, l01, 0x07060302u), (int)(CQW), A1, false); \
        A2 = __builtin_amdgcn_sdot4((int)__builtin_amdgcn_perm(h23, h01, 0x05040100u), (int)(CQW), A2, false); A3 = __builtin_amdgcn_sdot4((int)__builtin_amdgcn_perm(h23, h01, 0x07060302u), (int)(CQW), A3, false); } while (0)
#define PV_QUAD(W, O, CQW) do { PV_BLK(W[(O)].x, W[(O) + 1].x, W[(O) + 2].x, W[(O) + 3].x, CQW, acc[0], acc[1], acc[2], acc[3]); PV_BLK(W[(O)].y, W[(O) + 1].y, W[(O) + 2].y, W[(O) + 3].y, CQW, acc[4], acc[5], acc[6], acc[7]); \
        PV_BLK(W[(O)].z, W[(O) + 1].z, W[(O) + 2].z, W[(O) + 3].z, CQW, acc[8], acc[9], acc[10], acc[11]); PV_BLK(W[(O)].w, W[(O) + 1].w, W[(O) + 2].w, W[(O) + 3].w, CQW, acc[12], acc[13], acc[14], acc[15]); } while (0)
#define PV_TOKEN(W, CQ, T_) do { int acc[16]; _Pragma("unroll") for (int i = 0; i < 16; ++i) acc[i] = 0; \
        PV_QUAD(W, 0, CQ[0]); PV_QUAD(W, 4, CQ[1]); PV_QUAD(W, 8, CQ[2]); PV_QUAD(W, 12, CQ[3]); \
        int y8[8], y4[4], y2[2]; \
        _Pragma("unroll") for (int i = 0; i < 8; ++i) { const int give = b5 ? acc[i] : acc[8 + i]; y8[i] = (b5 ? acc[8 + i] : acc[i]) + __shfl_xor(give, 32); } \
        _Pragma("unroll") for (int i = 0; i < 4; ++i) { const int give = b4 ? y8[i] : y8[4 + i]; y4[i] = (b4 ? y8[4 + i] : y8[i]) + __shfl_xor(give, 16); } \
        _Pragma("unroll") for (int i = 0; i < 2; ++i) { const int give = b3 ? y4[i] : y4[2 + i]; y2[i] = (b3 ? y4[2 + i] : y4[i]) + __shfl_xor(give, 8); } \
        const float sct = sc[(T_)]; *(float2*)(Y + (size_t)(T_) * 1024 + 128 * s + 16 * j + c0) = make_float2((float)y2[0] * sct, (float)y2[1] * sct); } while (0)
__device__ __forceinline__ void ph_peer_v(const Params& p, int wv) {
    PH_IDS(); unsigned char* ws = p.ws; const int s = bid & 7, cu = bid >> 3, ncu = nb >> 3, g = lane >> 3, j = lane & 7;
    const int* eidx = (const int*)(ws + OFF_EIDX); const unsigned* coefq = (const unsigned*)(ws + OFF_COEFQ); const float* sc = (const float*)(ws + OFF_SC); const unsigned char* PV = ws + OFF_PV; float* Y = (float*)(ws + OFF_Y);
    const bool b5 = (lane & 32) != 0, b4 = (lane & 16) != 0, b3 = (lane & 8) != 0; const int c0 = (b5 ? 8 : 0) + (b4 ? 4 : 0) + (b3 ? 2 : 0);
    const int tstep = ncu * NWAVES; int t = cu * NWAVES + wv;
    if (t >= T) return;
    const int tlast = t;
    int el0, eh0, el1, eh1; unsigned cq0[4], cq1[4];
    PV_META(t, el0, eh0, cq0); PV_META(t + tstep, el1, eh1, cq1);
    uint4 wA[16], wB[16];
    PV_ISSUE16(wA, el0, eh0);
    for (;;) {
        { unsigned cc[4] = {cq0[0], cq0[1], cq0[2], cq0[3]}; PV_META(t + 2 * tstep, el0, eh0, cq0); PV_ISSUE16(wB, el1, eh1); PV_TOKEN(wA, cc, t); }
        t += tstep; if (t >= T) break;
        { unsigned cc[4] = {cq1[0], cq1[1], cq1[2], cq1[3]}; PV_META(t + 2 * tstep, el1, eh1, cq1); PV_ISSUE16(wA, el0, eh0); PV_TOKEN(wB, cc, t); }
        t += tstep; if (t >= T) break;
    }
}
__device__ __forceinline__ void ph_peer_ln2(const Params& p, int wv) {
    PH_IDS(); unsigned char* ws = p.ws; const float* Y = (const float*)(ws + OFF_Y);
    for (int t = gwave; t < T; t += nwaves) {
        float y[16]; float* row = p.out + (size_t)t * 1024 + lane * 16; const float* yr = Y + (size_t)t * 1024 + lane * 16; float s = 0.f;
#pragma unroll
        for (int i = 0; i < 4; ++i) { const float4 a = *(const float4*)(row + 4 * i), c = *(const float4*)(yr + 4 * i); y[4 * i] = c.x + DN_ALPHA * a.x; y[4 * i + 1] = c.y + DN_ALPHA * a.y; y[4 * i + 2] = c.z + DN_ALPHA * a.z; y[4 * i + 3] = c.w + DN_ALPHA * a.w; }
#pragma unroll
        for (int i = 0; i < 16; ++i) s += y[i];
        const float mu = wave_sum(s) * (1.0f / 1024.0f); float s2 = 0.f;
#pragma unroll
        for (int i = 0; i < 16; ++i) { y[i] -= mu; s2 += y[i] * y[i]; }
        const float rstd = rsqrtf(wave_sum(s2) * (1.0f / 1024.0f) + LN_EPS);
#pragma unroll
        for (int i = 0; i < 4; ++i) { const int c = lane * 16 + 4 * i; const float4 ga = *(const float4*)(p.ln2_g + c), ba = *(const float4*)(p.ln2_b + c);
            float4 o; o.x = y[4 * i] * rstd * ga.x + ba.x; o.y = y[4 * i + 1] * rstd * ga.y + ba.y; o.z = y[4 * i + 2] * rstd * ga.z + ba.z; o.w = y[4 * i + 3] * rstd * ga.w + ba.w;
            *(float4*)(row + 4 * i) = o; }
    }
}

#define LAS __attribute__((address_space(3)))
#define XB_TMO      128
#define XB_XCNT(j)  (256  + 64 * (j))
#define XB_XSUB(j)  (1280 + 64 * (j))
#define XB_XGEN(j)  (2304 + 64 * (j))
#define XB_TOP      3328
#define XB_TOPGEN   3392
#define XCD_BAR_WORDS 3456
#define XB_SPIN_CAP (1u << 18)

__device__ __forceinline__ unsigned xb_ld(unsigned* p)              { return __hip_atomic_load(p, __ATOMIC_RELAXED, __HIP_MEMORY_SCOPE_AGENT); }
__device__ __forceinline__ unsigned xb_add(unsigned* p, unsigned v) { return __hip_atomic_fetch_add(p, v, __ATOMIC_RELAXED, __HIP_MEMORY_SCOPE_AGENT); }
__device__ __forceinline__ unsigned xb_xcc_id() { return (unsigned)__builtin_amdgcn_s_getreg((3 << 11) | 20) & 0xFu; }
#define XB_SPIN(cond, bar) do { unsigned _sp = 0; while (cond) { __builtin_amdgcn_s_sleep(1); \
    if ((++_sp & 255u) == 0u) { if (xb_ld(&(bar)[XB_TMO])) break; if (_sp > XB_SPIN_CAP) { atomicAdd(&(bar)[XB_TMO], 1u); break; } } } } while (0)

struct XcdBarrier {
    unsigned* bar; unsigned x;
    volatile LAS unsigned* st;
};

__device__ __forceinline__ XcdBarrier xcd_barrier_post(unsigned* bar, volatile LAS unsigned* st, bool leader) {
    XcdBarrier b; b.bar = bar; b.x = xb_xcc_id(); b.st = st;
    if (leader) (void)xb_add(&bar[XB_XCNT(b.x)], 1u);
    return b;
}
__device__ __forceinline__ void xcd_barrier_complete(unsigned* bar, unsigned x, unsigned& nloc, unsigned& nx) {
    const unsigned G = gridDim.x * gridDim.y * gridDim.z;
    unsigned sum, cnt, mine, sp = 0u;
    for (;;) {
        sum = 0u; cnt = 0u; mine = 0u;
#pragma unroll
        for (unsigned j = 0; j < 16; ++j) { const unsigned c = xb_ld(&bar[XB_XCNT(j)]); sum += c; cnt += (c > 0u) ? 1u : 0u; mine = (j == x) ? c : mine; }
        if (sum == G) break;
        __builtin_amdgcn_s_sleep(1);
        if ((++sp & 255u) == 0u) { if (xb_ld(&bar[XB_TMO])) break; if (sp > XB_SPIN_CAP) { atomicAdd(&bar[XB_TMO], 1u); break; } }
    }
    nloc = mine > 0u ? mine : 1u; nx = cnt > 0u ? cnt : 1u;
}

__device__ __forceinline__ void xcd_barrier(const XcdBarrier& b, bool leader) {
    asm volatile("s_waitcnt vmcnt(0)" ::: "memory");
    __syncthreads();
    if (leader) {
        unsigned* bar = b.bar;
        __builtin_amdgcn_s_waitcnt(0);
        unsigned nloc = b.st[0], nx = b.st[1];
        if (nloc == 0u) { xcd_barrier_complete(bar, b.x, nloc, nx); b.st[0] = nloc; b.st[1] = nx; }
        const unsigned old = xb_add(&bar[XB_XSUB(b.x)], 1u);
        const unsigned gen = old / nloc;
        if (old + 1u == (gen + 1u) * nloc) {
            __builtin_amdgcn_fence(__ATOMIC_RELEASE, "agent");
            asm volatile("s_waitcnt vmcnt(0)" ::: "memory");
            const unsigned og = xb_add(&bar[XB_TOP], 1u);
            const unsigned tg = og / nx;
            if (og + 1u == (tg + 1u) * nx) xb_add(&bar[XB_TOPGEN], 1u);
            else XB_SPIN(xb_ld(&bar[XB_TOPGEN]) == tg, bar);
            __builtin_amdgcn_fence(__ATOMIC_ACQUIRE, "agent");
            xb_add(&bar[XB_XGEN(b.x)], 1u);
            asm volatile("s_waitcnt vmcnt(0)" ::: "memory");
        } else {
            XB_SPIN(xb_ld(&bar[XB_XGEN(b.x)]) == gen, bar);
            __builtin_amdgcn_fence(__ATOMIC_ACQUIRE, "agent");
            asm volatile("s_waitcnt vmcnt(0)" ::: "memory");
        }
    }
    __syncthreads();
}

#ifndef TIMING_BOUNDARY
#define TIMING_BOUNDARY -1
#endif
#define TPROBE(k) do { if (TIMING_BOUNDARY == (k)) { const unsigned long long t1_ = __builtin_amdgcn_s_memrealtime(); while (__builtin_amdgcn_s_memrealtime() - t1_ < t1_ - tstart_) __builtin_amdgcn_s_sleep(8); } } while (0)
__global__ void __launch_bounds__(NTHREADS) fwd_megakernel(Params p) {
    extern __shared__ __attribute__((aligned(16))) unsigned char lds[];
    cg::grid_group grid = cg::this_grid();
    const int nb = gridDim.x, bid = blockIdx.x;
    const int wv = __builtin_amdgcn_readfirstlane(threadIdx.x >> 6);
    unsigned char* ws = p.ws;
    const unsigned long long tstart_ = (TIMING_BOUNDARY >= 0) ? __builtin_amdgcn_s_memrealtime() : 0ull; (void)tstart_;
    PG8_LAS unsigned char* ldsp = (PG8_LAS unsigned char*)lds;
    const bool leader = (wv == 0) && (lane_id() == 0);
    volatile LAS unsigned* bst = (volatile LAS unsigned*)(ldsp + LDS_BYTES - 64);
    if (leader) { bst[0] = 0u; bst[1] = 0u; }
    __syncthreads();
    const XcdBarrier xbar = xcd_barrier_post((unsigned*)(ws + OFF_BAR), bst, leader);

    ph_prep(p, wv, lds);
    if (p.ws == nullptr) grid.sync();
    xcd_barrier(xbar, leader);
    TPROBE(0);
    {
        pg8::Gemm g{(const bf16*)(ws + OFF_XB), (const bf16*)(ws + OFF_WIN), T, NPROJ_PAD, 1024, 1024, 0, 1 << 30, 0l};
        pg8::StaticOrder S; S.init(T, NPROJ_PAD, nb, bid);
        pg8::EpiInProjPg E{(bf16*)(ws + OFF_Z), (bf16*)(ws + OFF_XBC), (bf16*)(ws + OFF_Q), (bf16*)(ws + OFF_KVS), (bf16*)(ws + OFF_DTG)};
        pg8::gemm_phase<pg8::EpiInProjPg, pg8::StaticOrder, pg8::NoMid, true, true>(wv, ldsp, g, S, E, pg8::NoMid{});
    }
    xcd_barrier(xbar, leader);
    TPROBE(1);
    if (bid < 32) {
        const bool isv = bid >= 16;
        pg8::Gemm g{(const bf16*)(ws + OFF_KVS) + (isv ? 256 : 0), (const bf16*)(ws + (isv ? OFF_W1V : OFF_W1K)), 4096, 256, 2048, 0, 1, 1 << 30, 0l};
        pg8::StaticOrder S; S.init(4096, 256, 16, isv ? bid - 16 : bid);
        pg8::EpiBf16<1> E{(bf16*)(ws + OFF_HID + (isv ? 2 * MiB : 0)), 256, (const float*)(ws + (isv ? OFF_B1V : OFF_B1K)), 0, 0, 1.f};
        pg8::gemm_phase<pg8::EpiBf16<1>, pg8::StaticOrder, pg8::NoMid, true, true>(wv, ldsp, g, S, E, pg8::NoMid{});
    }
    else ph_tokprep(p, wv);
    xcd_barrier(xbar, leader);
    TPROBE(2);
    ph_ssd_prep2(p, wv, lds);
    ph_vt_prep(p, wv);
    xcd_barrier(xbar, leader);
    TPROBE(3);
    {
        RowMajorBf16 ak{(const bf16*)(ws + OFF_HID), 256}, av{(const bf16*)(ws + OFF_HID + 2 * MiB), 256};
        RowMajorBf16 bk{(const bf16*)(ws + OFF_W2K), 256}, bv{(const bf16*)(ws + OFF_W2V), 256};
        EpiKc ek{(bf16*)(ws + OFF_KC), false}, ev{(bf16*)(ws + OFF_VCT), true};
        gemm_wave32(wv, 4096 / 32, 64 / 32, 256, ak, bk, ek);
        gemm_wave32(wv, 4096 / 32, 64 / 32, 256, av, bv, ev);
    }
    ph_ssd_states(p, wv);
    xcd_barrier(xbar, leader);
    TPROBE(4);
    ph_kc_rope(p, wv);
    ph_ssd_scan(p, wv);
    xcd_barrier(xbar, leader);
    TPROBE(5);
    ph_ssd_out(p, wv, lds);
    ph_nsa(p, wv, lds);
    xcd_barrier(xbar, leader);
    TPROBE(6);
    {
        pg8::Gemm g{(const bf16*)(ws + OFF_Q), (const bf16*)(ws + OFF_WOUT), T, 1024, 2048, 1024, 0, 16, (long)OFF_Z - (long)OFF_Q - 16l * 128l};
        pg8::StaticOrder S; S.init(T, 1024, nb, bid);
        pg8::RmsFactors rf{(const float*)(ws + OFF_SSQ), (const float*)(ws + OFF_HID), RMS_EPS};
        pg8::EpiOutProj E{p.x, p.out, DN_ALPHA, rf}; pg8::MidRmsScale MH{rf};
        pg8::gemm_phase<pg8::EpiOutProj, pg8::StaticOrder, pg8::MidRmsScale, true, true>(wv, ldsp, g, S, E, MH);
    }
    xcd_barrier(xbar, leader);
    TPROBE(7);
    ph_ln1(p, wv);
    ph_peer_cvt(p, wv);
    xcd_barrier(xbar, leader);
    TPROBE(8);
    {
        pg8::Gemm g{(const bf16*)(ws + OFF_H1B), (const bf16*)(ws + OFF_WQ), T, 2048, 1024, 1024, 0, 1 << 30, 0l};
        pg8::StaticOrder S; S.init(T, 2048, nb, bid);
        pg8::EpiBf16<0> E{(bf16*)(ws + OFF_QP), 2048, nullptr, 0, 0, 1.f};
        pg8::gemm_phase<pg8::EpiBf16<0>, pg8::StaticOrder, pg8::NoMid, true, true>(wv, ldsp, g, S, E, pg8::NoMid{});
    }
    xcd_barrier(xbar, leader);
    TPROBE(9);
    ph_peer_topk(p, wv, lds);
    xcd_barrier(xbar, leader);
    TPROBE(10);
    ph_peer_u(p, wv);
    xcd_barrier(xbar, leader);
    TPROBE(11);
    ph_peer_c(p, wv);
    xcd_barrier(xbar, leader);
    TPROBE(12);
    ph_peer_v(p, wv);
    xcd_barrier(xbar, leader);
    TPROBE(13);
    ph_peer_ln2(p, wv);
}

extern "C" void kernel_launch(void* const* d_in, const int* in_sizes, int n_in, void* d_out, int out_size, void* d_ws, size_t ws_size, hipStream_t stream) {
    static int grid_blocks = 0;
    if (!grid_blocks) {
        int dev = 0, cus = 0, per_cu = 0;
        hipGetDevice(&dev);
        hipDeviceGetAttribute(&cus, hipDeviceAttributeMultiprocessorCount, dev);
        hipFuncSetAttribute((const void*)fwd_megakernel, hipFuncAttributeMaxDynamicSharedMemorySize, LDS_BYTES);
        hipOccupancyMaxActiveBlocksPerMultiprocessor(&per_cu, fwd_megakernel, NTHREADS, LDS_BYTES);
        if (per_cu < 1) per_cu = 1;
        if (per_cu > 1) per_cu = 1;
        grid_blocks = cus * per_cu;
        if (ws_size < 244 * MiB) fprintf(stderr, "kernel_launch: workspace too small: %zu\n", ws_size);
    }
    Params p{};
    const float** pp = (const float**)&p;
    for (int i = 0; i < 24; ++i) pp[i] = (const float*)d_in[i];
    p.out = (float*)d_out; p.ws = (unsigned char*)d_ws;
    (void)hipMemsetAsync((unsigned char*)d_ws + OFF_BAR, 0, BAR_BYTES, stream);
    void* args[] = {&p};
    hipError_t e = hipLaunchCooperativeKernel((void*)fwd_megakernel, dim3(grid_blocks), dim3(NTHREADS), args, LDS_BYTES, stream);
    if (e != hipSuccess) fprintf(stderr, "cooperative launch failed: %s (grid %d)\n", hipGetErrorString(e), grid_blocks);
}
```

```cpp
#include <hip/hip_runtime.h>
#include <hip/hip_cooperative_groups.h>
#include <cstdio>
#include <cstdint>
namespace cg = cooperative_groups;

typedef unsigned short bf16;
typedef short bf16x8 __attribute__((ext_vector_type(8)));
typedef float f32x4 __attribute__((ext_vector_type(4)));
typedef float f32x16 __attribute__((ext_vector_type(16)));
typedef unsigned long long u64;

constexpr int T = 16384, L = 4096, NBATCH = 4, D = 1024;
constexpr int NPROJ = 5184, NPROJ_PAD = 5376;
constexpr int NTHREADS = 512, NWAVES = 8;
constexpr float LN_EPS = 1e-5f, RMS_EPS = 1e-5f;
constexpr float DN_ALPHA = 1.189207115002721f;
constexpr float NEG_INF = -1e30f, BIG = 1e30f;

constexpr size_t MiB = 1u << 20;
constexpr size_t OFF_SSQ = 0, OFF_BAR = 512 * 1024, BAR_BYTES = 16384;
constexpr size_t OFF_WOUT = 1 * MiB, OFF_WQ = 5 * MiB, OFF_W1K = 9 * MiB, OFF_W1V = 10 * MiB;
constexpr size_t OFF_W2K = 11 * MiB, OFF_W2V = 11 * MiB + 65536, OFF_B1K = 11 * MiB + 131072, OFF_B1V = 11 * MiB + 131072 + 4096;
constexpr size_t OFF_KEYS = 12 * MiB, OFF_ROPE = 13 * MiB, OFF_DT = 14 * MiB, OFF_ACS = 15 * MiB, OFF_GATE = 16 * MiB, OFF_MASK = 19 * MiB;
constexpr size_t OFF_HID = 20 * MiB, OFF_KC = 24 * MiB, OFF_VC = 24 * MiB + 524288;
constexpr size_t OFF_Z = 26 * MiB, OFF_Q = 58 * MiB, OFF_KVS = 90 * MiB, OFF_XBC = 138 * MiB, OFF_XSBC = 186 * MiB, OFF_BT = 234 * MiB, OFF_DTG = 242 * MiB;
constexpr size_t OFF_VST = 138 * MiB, OFF_VWT = 146 * MiB, OFF_VCT = 19 * MiB;
constexpr size_t OFF_XB = 186 * MiB, OFF_WIN = 218 * MiB;
constexpr size_t OFF_H1B = 90 * MiB, OFF_QP = 26 * MiB, OFF_EIDX = 202 * MiB, OFF_GW = 210 * MiB;
constexpr size_t OFF_PU = 154 * MiB, OFF_PV = 170 * MiB;
constexpr int LDS_BYTES = 147456;

struct Params {
    const float *x, *w_in, *conv_w, *conv_b, *dt_bias, *a_log, *d_skip, *ssd_norm_w;
    const float *cmp_pos_k, *cmp_w1_k, *cmp_w2_k, *cmp_pos_v, *cmp_w1_v, *cmp_w2_v;
    const float *attn_norm_w, *w_out, *ln1_g, *ln1_b, *peer_wq, *peer_keys, *peer_u, *peer_v, *ln2_g, *ln2_b;
    float* out; unsigned char* ws;
};

__device__ __forceinline__ float bf2f(bf16 v) { return __uint_as_float((unsigned)v << 16); }
__device__ __forceinline__ bf16 f2bf(float f) { unsigned u = __float_as_uint(f); return (bf16)((u + 0x7fffu + ((u >> 16) & 1u)) >> 16); }
__device__ __forceinline__ int lane_id() { int l = (int)__builtin_amdgcn_mbcnt_hi(~0u, __builtin_amdgcn_mbcnt_lo(~0u, 0u)); asm volatile("" : "+v"(l)); return l; }
#define PH_IDS() const int lane = lane_id(); const int tid = (wv << 6) | lane; const int bid = blockIdx.x, nb = gridDim.x; const int gtid = bid * NTHREADS + tid, gn = nb * NTHREADS; const int gwave = bid * NWAVES + wv, nwaves = nb * NWAVES; (void)gtid; (void)gn; (void)gwave; (void)nwaves;
typedef float f32x2v __attribute__((ext_vector_type(2)));
typedef __bf16 bf16x2v __attribute__((ext_vector_type(2)));
__device__ __forceinline__ unsigned pk2bf(float lo, float hi) { f32x2v v = {lo, hi}; bf16x2v b = __builtin_convertvector(v, bf16x2v); return __builtin_bit_cast(unsigned, b); }
__device__ __forceinline__ float bflo(unsigned w) { return __uint_as_float(w << 16); }
__device__ __forceinline__ float bfhi(unsigned w) { return __uint_as_float(w & 0xffff0000u); }
__device__ __forceinline__ float wave_sum(float v) {
#pragma unroll
    for (int o = 1; o < 64; o <<= 1) v += __shfl_xor(v, o);
    return v;
}
__device__ __forceinline__ float wave_max(float v) {
#pragma unroll
    for (int o = 1; o < 64; o <<= 1) v = fmaxf(v, __shfl_xor(v, o));
    return v;
}
__device__ __forceinline__ float gelu_exact(float v) { return 0.5f * v * (1.0f + erff(v * 0.7071067811865476f)); }
__device__ __forceinline__ float sigmoidf(float v) { return 1.0f / (1.0f + __expf(-v)); }

template <class AP, class BP, class EP>
__device__ __forceinline__ void gemm_wave32(int wv, int Mt, int Nt, int K, const AP& ap, const BP& bp, const EP& ep) {
    PH_IDS(); const int r = lane & 15, q = lane >> 4;
    for (int tile = gwave; tile < Mt * Nt; tile += nwaves) {
        const int tm = tile / Nt, tn = tile % Nt, row0 = tm * 32, col0 = tn * 32;
        f32x4 acc[2][2];
#pragma unroll
        for (int i = 0; i < 2; ++i)
#pragma unroll
            for (int j = 0; j < 2; ++j) acc[i][j] = (f32x4){0.f, 0.f, 0.f, 0.f};
        for (int k0 = 0; k0 < K; k0 += 32) {
            const bf16x8 a0 = ap(row0 + r, k0 + 8 * q), a1 = ap(row0 + 16 + r, k0 + 8 * q);
            const bf16x8 b0 = bp(col0 + r, k0 + 8 * q), b1 = bp(col0 + 16 + r, k0 + 8 * q);
            acc[0][0] = __builtin_amdgcn_mfma_f32_16x16x32_bf16(a0, b0, acc[0][0], 0, 0, 0);
            acc[0][1] = __builtin_amdgcn_mfma_f32_16x16x32_bf16(a0, b1, acc[0][1], 0, 0, 0);
            acc[1][0] = __builtin_amdgcn_mfma_f32_16x16x32_bf16(a1, b0, acc[1][0], 0, 0, 0);
            acc[1][1] = __builtin_amdgcn_mfma_f32_16x16x32_bf16(a1, b1, acc[1][1], 0, 0, 0);
        }
#pragma unroll
        for (int i = 0; i < 2; ++i)
#pragma unroll
            for (int j = 0; j < 2; ++j)
#pragma unroll
                for (int e = 0; e < 4; ++e) ep(row0 + 16 * i + 4 * q + e, col0 + 16 * j + r, acc[i][j][e]);
    }
}
struct RowMajorBf16 { const bf16* p; int ld; __device__ __forceinline__ bf16x8 operator()(int row, int k) const { return *(const bf16x8*)(p + (size_t)row * ld + k); } };

namespace pg8 {
#define PG8_LAS __attribute__((address_space(3)))
typedef unsigned short bf16_t;
typedef short bf16x8 __attribute__((ext_vector_type(8)));
typedef float f32x4 __attribute__((ext_vector_type(4)));
typedef unsigned u32x4 __attribute__((ext_vector_type(4)));
constexpr int BM = 256, BK = 64, HALF = 128, HTB = HALF * BK * 2  , STAGE_BYTES = 8 * HTB, NXCD = 8, WGM = 8;

__host__ __device__ __forceinline__ int lds_byte(int r, int c) { const int st = (r >> 4) * 2 + (c >> 5), rr = r & 15, cc = c & 31, ob = rr * 64 + cc * 2; return st * 1024 + (ob ^ (((ob >> 9) & 1) << 5)); }
__host__ __device__ __forceinline__ void stage_rc(int b, int& R, int& C) { const int st = b / 1024, sb = b % 1024, swz = sb ^ (((sb >> 9) & 1) << 5); R = (st >> 1) * 16 + swz / 64; C = (st & 1) * 32 + (swz % 64) / 2; }
__host__ __device__ __forceinline__ int perm32(int rho) { const int n = rho >> 4, i = rho & 15; return 8 * (i >> 2) + 4 * n + (i & 3); }

struct Unit { int pm, pn; };
struct Gemm { const bf16_t* A; const bf16_t* Bt; int M, N, K; int lda; int amode; int ksplit; long kdelta; };

struct StaticOrder {
    int nM, nN, nwg, G, c;
    __host__ __device__ void init(int M, int N, int G_, int c_) { nM = M / BM; nN = N / BM; nwg = nM * nN; G = G_; c = c_; }
    __host__ __device__ bool next(int i, Unit& u) const {
        const long L = (long)i * G + c; if (L >= nwg) return false;
        int wgid = (int)L; { const int q = nwg / NXCD, r = nwg % NXCD, xcd = wgid % NXCD, off = wgid / NXCD; wgid = (xcd < r ? xcd * (q + 1) : r * (q + 1) + (xcd - r) * q) + off; }
        const int nig = WGM * nN, gid = wgid / nig, fm = gid * WGM, gsz = (nM - fm) < WGM ? (nM - fm) : WGM;
        u.pm = fm + ((wgid % nig) % gsz); u.pn = (wgid % nig) / gsz; return true;
    }
    __device__ __forceinline__ void a_ready(const Unit&) const {}
    __device__ __forceinline__ void done(const Unit&) const {}
};


__device__ __forceinline__ unsigned cvt_pk_bf16(float lo, float hi) { unsigned r; asm volatile("v_cvt_pk_bf16_f32 %0, %1, %2" : "=v"(r) : "v"(lo), "v"(hi)); return r; }
typedef float f32x2 __attribute__((ext_vector_type(2)));
__device__ __forceinline__ f32x2 gelu_pk(f32x2 v) {
    const f32x2 av = __builtin_elementwise_abs(v), d = av * 0.2316418882f + 1.0f;
    f32x2 t; t.x = __builtin_amdgcn_rcpf(d.x); t.y = __builtin_amdgcn_rcpf(d.y);
    f32x2 q = t * 0.5307027145f + (-0.7265760135f); q = q * t + 0.7107068705f; q = q * t + (-0.142248368f); q = q * t + 0.127414796f; q = q * t;
    const f32x2 s = (v * v) * (-0.72134752044f);
    f32x2 e; e.x = __builtin_amdgcn_exp2f(s.x); e.y = __builtin_amdgcn_exp2f(s.y);
    const f32x2 m = v * (q * e), r = v - m;
    f32x2 o; o.x = v.x < 0.f ? m.x : r.x; o.y = v.y < 0.f ? m.y : r.y; return o;
}

template <int ACT  > struct EpiBf16 {
    static constexpr bool PERM = true, AFTER_DRAIN = false; static_assert(ACT == 0 || ACT == 1, "EpiBf16: ACT is 0 (none) or 1 (gelu_pk)");
    bf16_t* O; int ldc; const float* bias; int split_cols; size_t split_stride; float scale0;
    __device__ __forceinline__ void operator()(const f32x4 (&acc)[2][2][4][2], const Unit& u, int wr, int wc, int fr, int fq) const {
        const int row0 = u.pm * BM + wr * 64 + fr; int colt = u.pn * BM; bf16_t* base = O;
        float sc = 1.f; if (split_cols) { const int t = colt / split_cols; base += (size_t)t * split_stride; colt -= t * split_cols; if (t == 0) sc = scale0; }
        const int col0 = colt + wc * 32 + 8 * fq, bcol0 = u.pn * BM + wc * 32 + 8 * fq;
        f32x4 bv[2][2];
#pragma unroll
        for (int bj = 0; bj < 2; ++bj)
#pragma unroll
            for (int n = 0; n < 2; ++n) bv[bj][n] = bias ? *(const f32x4*)(bias + bcol0 + bj * HALF + 4 * n) : (f32x4){0.f, 0.f, 0.f, 0.f};
#pragma unroll
        for (int ai = 0; ai < 2; ++ai)
#pragma unroll
            for (int m = 0; m < 4; ++m) { bf16_t* rowp = base + (size_t)(row0 + ai * HALF + m * 16) * ldc + col0;
#pragma unroll
                for (int bj = 0; bj < 2; ++bj) { f32x4 v0 = acc[ai][bj][m][0] + bv[bj][0], v1 = acc[ai][bj][m][1] + bv[bj][1];
                    if (ACT == 1) { f32x2 a = gelu_pk((f32x2){v0[0], v0[1]}), b = gelu_pk((f32x2){v0[2], v0[3]}), c = gelu_pk((f32x2){v1[0], v1[1]}), d = gelu_pk((f32x2){v1[2], v1[3]});
                        v0 = (f32x4){a.x, a.y, b.x, b.y}; v1 = (f32x4){c.x, c.y, d.x, d.y}; }
                    v0 = v0 * sc; v1 = v1 * sc; u32x4 w; w.x = cvt_pk_bf16(v0[0], v0[1]); w.y = cvt_pk_bf16(v0[2], v0[3]); w.z = cvt_pk_bf16(v1[0], v1[1]); w.w = cvt_pk_bf16(v1[2], v1[3]);
                    *(u32x4*)(rowp + bj * HALF) = w; } }
    }
};

struct EpiInProjPg { static constexpr bool PERM = true, AFTER_DRAIN = false;
    bf16_t *z, *xbc, *q, *kvs, *dtg;
    __device__ __forceinline__ void operator()(const f32x4 (&acc)[2][2][4][2], const Unit& u, int wr, int wc, int fr, int fq) const {
        bf16_t* base; int ldc, colt; const int pn = u.pn;
        if (pn < 4) { base = z; ldc = 1024; colt = pn * 256; } else if (pn < 10) { base = xbc; ldc = 1536; colt = (pn - 4) * 256; }
        else if (pn < 14) { base = q; ldc = 1024; colt = (pn - 10) * 256; } else if (pn < 20) { base = kvs; ldc = 1536; colt = (pn - 14) * 256; }
        else { base = dtg; ldc = 64; colt = 0; }
        const int row0 = u.pm * BM + wr * 64 + fr, col0 = colt + wc * 32 + 8 * fq;
#pragma unroll
        for (int ai = 0; ai < 2; ++ai)
#pragma unroll
            for (int m = 0; m < 4; ++m) { bf16_t* rowp = base + (size_t)(row0 + ai * HALF + m * 16) * ldc + col0;
#pragma unroll
                for (int bj = 0; bj < 2; ++bj) { const f32x4 v0 = acc[ai][bj][m][0], v1 = acc[ai][bj][m][1];
                    u32x4 w; w.x = cvt_pk_bf16(v0[0], v0[1]); w.y = cvt_pk_bf16(v0[2], v0[3]); w.z = cvt_pk_bf16(v1[0], v1[1]); w.w = cvt_pk_bf16(v1[2], v1[3]);
                    if (pn < 20 || (bj == 0 && wc < 2)) *(u32x4*)(rowp + bj * HALF) = w; } }
    }
};
struct RmsFactors { const float* ssqp; const float* ssq2p; float eps;
    __device__ __forceinline__ void get(int row, float& ra, float& r0, float& r1) const {
        const f32x4 a = *(const f32x4*)(ssqp + 4 * row); const f32x4 b0 = *(const f32x4*)(ssq2p + 16 * row), b1 = *(const f32x4*)(ssq2p + 16 * row + 4), b2 = *(const f32x4*)(ssq2p + 16 * row + 8), b3 = *(const f32x4*)(ssq2p + 16 * row + 12);
        ra = rsqrtf(((a[0] + a[1]) + (a[2] + a[3])) * (1.0f / 1024.0f) + eps);
        r0 = rsqrtf((((b0[0] + b0[1]) + (b0[2] + b0[3])) + ((b1[0] + b1[1]) + (b1[2] + b1[3]))) * (1.0f / 512.0f) + eps);
        r1 = rsqrtf((((b2[0] + b2[1]) + (b2[2] + b2[3])) + ((b3[0] + b3[1]) + (b3[2] + b3[3]))) * (1.0f / 512.0f) + eps); } };
struct EpiOutProj { static constexpr bool PERM = false, AFTER_DRAIN = false;
    const float* x; float* out; float alpha; RmsFactors rf;
    __device__ __forceinline__ void operator()(const f32x4 (&acc)[2][2][4][2], const Unit& u, int wr, int wc, int fr, int fq) const {
        const int col0 = u.pn * BM + wc * 32 + 4 * fq;
#pragma unroll
        for (int ai = 0; ai < 2; ++ai)
#pragma unroll
            for (int m = 0; m < 4; ++m) { const int row = u.pm * BM + ai * HALF + wr * 64 + m * 16 + fr; const size_t off = (size_t)row * 1024 + col0;
                float ra, r0, r1; rf.get(row, ra, r0, r1);
#pragma unroll
                for (int bj = 0; bj < 2; ++bj)
#pragma unroll
                    for (int n = 0; n < 2; ++n) { const size_t o = off + bj * HALF + n * 16; const f32x4 xv = *(const f32x4*)(x + o); *(f32x4*)(out + o) = xv * alpha + acc[ai][bj][m][n] * r1; } }
    }
};
struct MidRmsScale { static constexpr bool ENABLED = true; RmsFactors rf;
    __device__ __forceinline__ void operator()(f32x4 (&acc)[2][2][4][2], const Unit& u, int t, int wr, int wc, int fr, int fq) const {
        if (t != 16 && t != 24) return;
        int rowb = u.pm * BM + wr * 64 + fr; asm volatile("" : "+v"(rowb));
#pragma unroll
        for (int ai = 0; ai < 2; ++ai)
#pragma unroll
            for (int m = 0; m < 4; ++m) { float ra, r0, r1; rf.get(rowb + ai * HALF + m * 16, ra, r0, r1);
                const float sc = (t == 16) ? ra / r0 : r0 / r1;
#pragma unroll
                for (int bj = 0; bj < 2; ++bj)
#pragma unroll
                    for (int n = 0; n < 2; ++n) acc[ai][bj][m][n] = acc[ai][bj][m][n] * sc; }
    }
};
struct NoMid { static constexpr bool ENABLED = false; template <class ACC> __device__ __forceinline__ void operator()(ACC&, const Unit&, int, int, int, int, int) const {} };
template <class Epi, class Sched, class Mid, bool ALIGN_EPI = false, bool SP2 = false>
__device__ __forceinline__ void gemm_phase(int wv, PG8_LAS unsigned char* lds, const Gemm g, const Sched& S, const Epi& E, const Mid& MH) {
    int lane_ = (int)__builtin_amdgcn_mbcnt_hi(~0u, __builtin_amdgcn_mbcnt_lo(~0u, 0u)); asm volatile("" : "+v"(lane_));
    const int lane = lane_, wid = wv, tid = (wv << 6) | lane, wr = wid >> 2, wc = wid & 3, fr = lane & 15, fq = lane >> 4;
    const int K = g.K, nt = K / BK;
    unsigned voffA[2], voffB[2];
#pragma unroll
    for (int i = 0; i < 2; ++i) { int R, C; stage_rc(tid * 16 + i * 8192, R, C); const int Rb = Epi::PERM ? ((R & ~31) + perm32(R & 31)) : R;
        voffA[i] = g.amode == 0 ? (unsigned)(R * g.lda + C) * 2u : (unsigned)((R >> 2) * 49152 + (R & 3) * 128 + C * 2); voffB[i] = (unsigned)(Rb * K + C) * 2u; }
    const size_t kstep = (size_t)(BK * 2);
    const size_t hstep = (size_t)HALF * K * 2;
    const size_t tstep = 2 * hstep;
    const size_t kstepA = g.amode == 0 ? (size_t)(BK * 2) : (size_t)3072;
    const size_t hstepA = g.amode == 0 ? (size_t)HALF * g.lda * 2 : (size_t)32 * 49152;
    const size_t tstepA = 2 * hstepA;
#define PG8_AK(base, t) ((base) + (size_t)(t) * kstepA + (((t) >= g.ksplit) ? g.kdelta : 0l))
    const unsigned ldsw = (unsigned)wid * 1024u;
    const int aoff = lds_byte(wr * 64 + fr, fq * 8), boff = lds_byte(wc * 32 + fr, fq * 8);
#define PG8_SA(b, h) (((b) * 2 + (h)) * HTB)
#define PG8_SB(b, h) ((4 + (b) * 2 + (h)) * HTB)
#define PG8_STAGE(bufoff, gbase, voff) do { _Pragma("unroll") for (int _i = 0; _i < 2; ++_i) \
        __builtin_amdgcn_global_load_lds((const unsigned*)((const char*)(gbase) + (voff)[_i]), (PG8_LAS unsigned*)(lds + (bufoff) + ldsw + _i * 8192), 16, 0, 0); } while (0)
#define PG8_LDA(dst, b, h) do { _Pragma("unroll") for (int m = 0; m < 4; ++m) _Pragma("unroll") for (int k = 0; k < 2; ++k) dst[m][k] = *(const PG8_LAS bf16x8*)(lds + PG8_SA(b, h) + aoff + m * 2048 + k * 1024); } while (0)
#define PG8_LDB(dst, b, h) do { _Pragma("unroll") for (int n = 0; n < 2; ++n) _Pragma("unroll") for (int k = 0; k < 2; ++k) dst[n][k] = *(const PG8_LAS bf16x8*)(lds + PG8_SB(b, h) + boff + n * 2048 + k * 1024); } while (0)
#define PG8_MMA(ai, bj, At, Bt) do { __builtin_amdgcn_s_setprio(1); _Pragma("unroll") for (int m = 0; m < 4; ++m) _Pragma("unroll") for (int n = 0; n < 2; ++n) _Pragma("unroll") for (int k = 0; k < 2; ++k) \
        acc[ai][bj][m][n] = __builtin_amdgcn_mfma_f32_16x16x32_bf16(Bt[n][k], At[m][k], acc[ai][bj][m][n], 0, 0, 0); __builtin_amdgcn_s_setprio(0); } while (0)
#define PG8_WAIT_V(n) asm volatile("s_waitcnt vmcnt(" #n ")" ::: "memory")
#define PG8_WAIT_L(n) asm volatile("s_waitcnt lgkmcnt(" #n ")" ::: "memory")
#define PG8_BAR __builtin_amdgcn_s_barrier()
#define PG8_SCHED __builtin_amdgcn_sched_barrier(0)
    Unit cur, nxt; int ui = 0;
    if (!S.next(0, cur)) return;
    f32x4 acc[2][2][4][2];
#pragma unroll
    for (int a = 0; a < 2; ++a)
#pragma unroll
        for (int b = 0; b < 2; ++b)
#pragma unroll
            for (int m = 0; m < 4; ++m)
#pragma unroll
                for (int n = 0; n < 2; ++n) acc[a][b][m][n] = (f32x4){0.f, 0.f, 0.f, 0.f};
    bf16x8 At[4][2], B0[2][2], B1[2][2];
    const char* cA = (const char*)g.A + (size_t)cur.pm * tstepA; const char* cB = (const char*)g.Bt + (size_t)cur.pn * tstep;
    S.a_ready(cur);
    if constexpr (SP2) {
        PG8_STAGE(PG8_SB(0, 0), cB, voffB); PG8_STAGE(PG8_SB(0, 1), cB + hstep, voffB); PG8_STAGE(PG8_SA(0, 0), cA, voffA); PG8_STAGE(PG8_SA(0, 1), cA + hstepA, voffA);
        if (wr == 1) PG8_BAR;
        PG8_WAIT_V(2); PG8_BAR;
        PG8_STAGE(PG8_SB(1, 0), cB + kstep, voffB); PG8_STAGE(PG8_SA(1, 0), PG8_AK(cA, 1), voffA); PG8_STAGE(PG8_SB(1, 1), cB + hstep + kstep, voffB);
        PG8_WAIT_V(6); PG8_BAR;
    } else {
        PG8_STAGE(PG8_SB(0, 0), cB, voffB); PG8_STAGE(PG8_SA(0, 0), cA, voffA); PG8_STAGE(PG8_SB(0, 1), cB + hstep, voffB); PG8_STAGE(PG8_SA(0, 1), cA + hstepA, voffA);
        if (wr == 1) PG8_BAR;
        PG8_WAIT_V(4); PG8_BAR;
        PG8_STAGE(PG8_SB(1, 0), cB + kstep, voffB); PG8_STAGE(PG8_SA(1, 0), PG8_AK(cA, 1), voffA); PG8_STAGE(PG8_SB(1, 1), cB + hstep + kstep, voffB);
        PG8_WAIT_V(6); PG8_BAR;
    }
    for (;;) {
        const bool has_next = S.next(ui + 1, nxt);
        const char* nA = has_next ? (const char*)g.A + (size_t)nxt.pm * tstepA : cA; const char* nB = has_next ? (const char*)g.Bt + (size_t)nxt.pn * tstep : cB;
        for (int t = 0; t < nt; t += 2) {
            const bool last = (t == nt - 2);
            if (Mid::ENABLED) MH(acc, cur, t, wr, wc, fr, fq);
            const char* a1 = PG8_AK(cA, t + 1);
            const char* a2 = last ? nA : PG8_AK(cA, t + 2); const char* b2 = last ? nB : cB + (size_t)(t + 2) * kstep;
            const char* a3 = a2 + kstepA; const char* b3 = b2 + kstep;
            if (last && has_next) S.a_ready(nxt);
            if constexpr (SP2) {
            PG8_LDB(B0, 0, 0); PG8_LDB(B1, 0, 1); PG8_SCHED; PG8_LDA(At, 0, 0); PG8_STAGE(PG8_SA(1, 1), a1 + hstepA, voffA);
            PG8_WAIT_V(8); PG8_WAIT_L(0); PG8_BAR; PG8_MMA(0, 0, At, B0); PG8_MMA(0, 1, At, B1); PG8_BAR; PG8_SCHED;
            PG8_LDA(At, 0, 1); PG8_STAGE(PG8_SB(0, 0), b2, voffB); PG8_STAGE(PG8_SB(0, 1), b2 + hstep, voffB); PG8_STAGE(PG8_SA(0, 0), a2, voffA);
            PG8_WAIT_V(8); PG8_WAIT_L(0); PG8_BAR; PG8_MMA(1, 0, At, B0); PG8_MMA(1, 1, At, B1); PG8_BAR; PG8_SCHED;
            PG8_LDB(B0, 1, 0); PG8_LDB(B1, 1, 1); PG8_SCHED; PG8_LDA(At, 1, 0); PG8_STAGE(PG8_SA(0, 1), a2 + hstepA, voffA);
            PG8_WAIT_V(8); PG8_WAIT_L(0); PG8_BAR; PG8_MMA(0, 0, At, B0); PG8_MMA(0, 1, At, B1); PG8_BAR; PG8_SCHED;
            PG8_LDA(At, 1, 1); PG8_STAGE(PG8_SB(1, 0), b3, voffB); PG8_STAGE(PG8_SB(1, 1), b3 + hstep, voffB); PG8_STAGE(PG8_SA(1, 0), a3, voffA);
            PG8_WAIT_V(8); PG8_WAIT_L(0); PG8_BAR; PG8_MMA(1, 0, At, B0); PG8_MMA(1, 1, At, B1); PG8_BAR; PG8_SCHED;
            } else {
            PG8_LDB(B0, 0, 0); PG8_SCHED; PG8_LDA(At, 0, 0); PG8_STAGE(PG8_SA(1, 1), a1 + hstepA, voffA);
            PG8_WAIT_L(8); PG8_BAR; PG8_WAIT_L(0); PG8_MMA(0, 0, At, B0); PG8_BAR; PG8_SCHED;
            PG8_LDB(B1, 0, 1); PG8_STAGE(PG8_SB(0, 0), b2, voffB);
            PG8_BAR; PG8_WAIT_L(0); PG8_MMA(0, 1, At, B1); PG8_BAR;
            PG8_LDA(At, 0, 1); PG8_STAGE(PG8_SA(0, 0), a2, voffA);
            PG8_BAR; PG8_WAIT_L(0); PG8_MMA(1, 0, At, B0); PG8_BAR; PG8_SCHED;
            PG8_STAGE(PG8_SB(0, 1), b2 + hstep, voffB);
            PG8_WAIT_V(6); PG8_BAR; PG8_MMA(1, 1, At, B1); PG8_BAR;
            PG8_LDB(B0, 1, 0); PG8_SCHED; PG8_LDA(At, 1, 0); PG8_STAGE(PG8_SA(0, 1), a2 + hstepA, voffA);
            PG8_WAIT_L(8); PG8_BAR; PG8_WAIT_L(0); PG8_MMA(0, 0, At, B0); PG8_BAR; PG8_SCHED;
            PG8_LDB(B1, 1, 1); PG8_STAGE(PG8_SB(1, 0), b3, voffB);
            PG8_BAR; PG8_WAIT_L(0); PG8_MMA(0, 1, At, B1); PG8_BAR;
            PG8_LDA(At, 1, 1); PG8_STAGE(PG8_SA(1, 0), a3, voffA);
            PG8_BAR; PG8_WAIT_L(0); PG8_MMA(1, 0, At, B0); PG8_BAR; PG8_SCHED;
            PG8_STAGE(PG8_SB(1, 1), b3 + hstep, voffB);
            PG8_WAIT_V(6); PG8_BAR; PG8_MMA(1, 1, At, B1); PG8_BAR;
            }
        }
        if constexpr (ALIGN_EPI) { if (wr == 0) PG8_BAR; }
        if constexpr (!Epi::AFTER_DRAIN) { E(acc, cur, wr, wc, fr, fq); S.done(cur); }
        if (!has_next) break;
#pragma unroll
        for (int a = 0; a < 2; ++a)
#pragma unroll
            for (int b = 0; b < 2; ++b)
#pragma unroll
                for (int m = 0; m < 4; ++m)
#pragma unroll
                    for (int n = 0; n < 2; ++n) acc[a][b][m][n] = (f32x4){0.f, 0.f, 0.f, 0.f};
        cur = nxt; cA = nA; cB = nB; ++ui;
        if constexpr (ALIGN_EPI) { if (wr == 1) PG8_BAR; }
    }
    PG8_WAIT_V(0);
    if constexpr (!ALIGN_EPI) { if (wr == 0) PG8_BAR; }
    PG8_BAR;
    if constexpr (Epi::AFTER_DRAIN) { E.fused(acc, cur, wr, wc, fr, fq, lds, wid, lane); S.done(cur); }
#undef PG8_AK
#undef PG8_SA
#undef PG8_SB
#undef PG8_STAGE
#undef PG8_LDA
#undef PG8_LDB
#undef PG8_MMA
#undef PG8_WAIT_V
#undef PG8_WAIT_L
#undef PG8_BAR
#undef PG8_SCHED
}
}

__device__ __forceinline__ int winmap(int n) { return n < 2560 ? n : (n < 5120 ? n + 16 : (n < 5136 ? 2560 + (n - 5120) : n)); }
template <class Map>
__device__ __forceinline__ void transpose_item(const float* W, int ldw, bf16* WT, int K, int item, int nblk, float* scr, int lane, const Map& mp) {
    const int kb = item / nblk, nbk = item % nblk, k0 = 64 * kb, n0 = 32 * nbk;
    const int col = mp.scol(n0 + (lane & 31));
#pragma unroll 8
    for (int i = 0; i < 32; ++i) { const int kk = 2 * i + (lane >> 5); scr[kk * 33 + (lane & 31)] = col >= 0 ? W[(size_t)mp.srow(k0 + kk) * ldw + col] * mp.scale(k0 + kk) : 0.f; }
    const int c = lane & 7;
#pragma unroll
    for (int j = 0; j < 4; ++j) { const int n = (lane >> 3) + 8 * j; const float* s = scr + (8 * c) * 33 + n;
        *(uint4*)(WT + (size_t)(n0 + n) * K + k0 + 8 * c) = make_uint4(pk2bf(s[0], s[33]), pk2bf(s[66], s[99]), pk2bf(s[132], s[165]), pk2bf(s[198], s[231])); }
}
struct MapPlain { __device__ __forceinline__ int srow(int k) const { return k; } __device__ __forceinline__ int scol(int n) const { return n; } __device__ __forceinline__ float scale(int) const { return 1.f; } };
struct MapWin { __device__ __forceinline__ int srow(int k) const { return k; } __device__ __forceinline__ int scol(int n) const { return n < NPROJ ? winmap(n) : -1; } __device__ __forceinline__ float scale(int) const { return 1.f; } };
struct MapWout { const float* an; const float* sn;
    __device__ __forceinline__ int srow(int k) const { return (k + 1024) & 2047; } __device__ __forceinline__ int scol(int n) const { return n; } __device__ __forceinline__ float scale(int k) const { return k < 1024 ? an[k] : sn[k - 1024]; } };
__device__ __forceinline__ void ph_prep(const Params& p, int wv, unsigned char* lds) {
    PH_IDS(); unsigned char* ws = p.ws;
    bf16* xb = (bf16*)(ws + OFF_XB);
    for (size_t i = gtid; i < (size_t)T * D / 8; i += gn) { const float4 v = ((const float4*)p.x)[2 * i], w = ((const float4*)p.x)[2 * i + 1]; ((uint4*)xb)[i] = make_uint4(pk2bf(v.x, v.y), pk2bf(v.z, v.w), pk2bf(w.x, w.y), pk2bf(w.z, w.w)); }
    {
        float* scr = (float*)(lds + wv * 8448);
        constexpr int I_WIN = 16 * 168, I_WOUT = 32 * 32, I_WQ = 16 * 64, I_W1 = 32 * 8, I_W2 = 4 * 2;
        constexpr int NIT = I_WIN + I_WOUT + I_WQ + 2 * I_W1 + 2 * I_W2;
        for (int it = gwave; it < NIT; it += nwaves) {
            int r = it;
            if (r < I_WIN) { transpose_item(p.w_in, NPROJ, (bf16*)(ws + OFF_WIN), 1024, r, 168, scr, lane, MapWin{}); continue; } r -= I_WIN;
            if (r < I_WOUT) { transpose_item(p.w_out, 1024, (bf16*)(ws + OFF_WOUT), 2048, r, 32, scr, lane, MapWout{p.attn_norm_w, p.ssd_norm_w}); continue; } r -= I_WOUT;
            if (r < I_WQ) { transpose_item(p.peer_wq, 2048, (bf16*)(ws + OFF_WQ), 1024, r, 64, scr, lane, MapPlain{}); continue; } r -= I_WQ;
            if (r < I_W1) { transpose_item(p.cmp_w1_k, 256, (bf16*)(ws + OFF_W1K), 2048, r, 8, scr, lane, MapPlain{}); continue; } r -= I_W1;
            if (r < I_W1) { transpose_item(p.cmp_w1_v, 256, (bf16*)(ws + OFF_W1V), 2048, r, 8, scr, lane, MapPlain{}); continue; } r -= I_W1;
            if (r < I_W2) { transpose_item(p.cmp_w2_k, 64, (bf16*)(ws + OFF_W2K), 256, r, 2, scr, lane, MapPlain{}); continue; } r -= I_W2;
            transpose_item(p.cmp_w2_v, 64, (bf16*)(ws + OFF_W2V), 256, r, 2, scr, lane, MapPlain{});
        }
    }
    bf16* keys = (bf16*)(ws + OFF_KEYS);
    for (int i = gtid; i < 8 * 2 * 128 * 128; i += gn) keys[i] = f2bf(p.peer_keys[i]);
    float* rc = (float*)(ws + OFF_ROPE); float* rs = rc + 4096 * 32;
    for (int i = gtid; i < 4096 * 32; i += gn) {
        const int pos = i >> 5, j = i & 31;
        const float inv = powf(10000.0f, -(float)(2 * j) / 64.0f); const float angf = (float)pos * inv;
        double xr = (double)angf * 0.15915494309189535; xr -= rint(xr); const double rr = xr * 6.283185307179586, r2 = rr * rr;
        double s = 0.0, c = 0.0, ts = rr, tc = 1.0;
        for (int k = 0; k < 14; ++k) { s += ts; c += tc; tc = -tc * r2 / (double)((2 * k + 1) * (2 * k + 2)); ts = -ts * r2 / (double)((2 * k + 2) * (2 * k + 3)); }
        rc[i] = (float)c; rs[i] = (float)s;
    }
    float* b1k = (float*)(ws + OFF_B1K); float* b1v = (float*)(ws + OFF_B1V);
    for (int o = gwave; o < 512; o += nwaves) {
        const int j = o & 255; const float* pos = o < 256 ? p.cmp_pos_k : p.cmp_pos_v; const float* w1 = o < 256 ? p.cmp_w1_k : p.cmp_w1_v;
        float s = 0.f; for (int k = lane; k < 2048; k += 64) s += pos[k] * w1[(size_t)k * 256 + j];
        s = wave_sum(s); if (lane == 0) (o < 256 ? b1k : b1v)[j] = s;
    }
}

struct EpiInProj {
    bf16 *z, *xbc, *q, *kvs, *dtg;
    __device__ __forceinline__ void operator()(int row, int c, float v) const {
        const bf16 b = f2bf(v);
        if (c < 1024) z[(size_t)row * 1024 + c] = b;
        else if (c < 2560) xbc[(size_t)row * 1536 + (c - 1024)] = b;
        else if (c < 3584) q[(size_t)row * 1024 + (c - 2560)] = b;
        else if (c < 5120) kvs[(size_t)row * 1536 + (c - 3584)] = b;
        else if (c < 5184) dtg[(size_t)row * 64 + (c - 5120)] = b;
    }
};

__device__ __forceinline__ void unpack8(const uint4& w, float* f) { f[0] = __uint_as_float(w.x << 16); f[1] = __uint_as_float(w.x & 0xffff0000u); f[2] = __uint_as_float(w.y << 16); f[3] = __uint_as_float(w.y & 0xffff0000u);
    f[4] = __uint_as_float(w.z << 16); f[5] = __uint_as_float(w.z & 0xffff0000u); f[6] = __uint_as_float(w.w << 16); f[7] = __uint_as_float(w.w & 0xffff0000u); }
__device__ __forceinline__ uint4 pack8(const float* f) { return make_uint4(pk2bf(f[0], f[1]), pk2bf(f[2], f[3]), pk2bf(f[4], f[5]), pk2bf(f[6], f[7])); }
__device__ __forceinline__ void ph_tokprep(const Params& p, int wv) {
    PH_IDS(); unsigned char* ws = p.ws;
    const int gtid_ = (nb > 64 ? bid - 32 : bid) * NTHREADS + tid, gn_ = (nb > 64 ? nb - 32 : nb) * NTHREADS;
    const bf16* xbc = (const bf16*)(ws + OFF_XBC); bf16* xsbc = (bf16*)(ws + OFF_XSBC);
    for (int it = gtid_; it < (T / 16) * 192; it += gn_) {
        const int cg = it % 192, tg = it / 192, ch = cg * 8, t0 = tg * 16, l0 = t0 & (L - 1);
        float w[4][8], bias[8];
#pragma unroll
        for (int j = 0; j < 4; ++j) { const float4 a = *(const float4*)(p.conv_w + j * 1536 + ch), b2 = *(const float4*)(p.conv_w + j * 1536 + ch + 4); w[j][0] = a.x; w[j][1] = a.y; w[j][2] = a.z; w[j][3] = a.w; w[j][4] = b2.x; w[j][5] = b2.y; w[j][6] = b2.z; w[j][7] = b2.w; }
        { const float4 a = *(const float4*)(p.conv_b + ch), b2 = *(const float4*)(p.conv_b + ch + 4); bias[0] = a.x; bias[1] = a.y; bias[2] = a.z; bias[3] = a.w; bias[4] = b2.x; bias[5] = b2.y; bias[6] = b2.z; bias[7] = b2.w; }
        float x0[8], x1[8], x2[8], x3[8];
        { uint4 h0 = make_uint4(0u, 0u, 0u, 0u), h1 = h0, h2 = h0;
          if (l0 != 0) { h0 = *(const uint4*)(xbc + (size_t)(t0 - 3) * 1536 + ch); h1 = *(const uint4*)(xbc + (size_t)(t0 - 2) * 1536 + ch); h2 = *(const uint4*)(xbc + (size_t)(t0 - 1) * 1536 + ch); }
          unpack8(h0, x0); unpack8(h1, x1); unpack8(h2, x2); }
#pragma unroll
        for (int u = 0; u < 16; ++u) {
            unpack8(*(const uint4*)(xbc + (size_t)(t0 + u) * 1536 + ch), x3);
            float y[8];
#pragma unroll
            for (int i = 0; i < 8; ++i) { const float v = bias[i] + w[0][i] * x0[i] + w[1][i] * x1[i] + w[2][i] * x2[i] + w[3][i] * x3[i]; y[i] = v * sigmoidf(v); x0[i] = x1[i]; x1[i] = x2[i]; x2[i] = x3[i]; }
            *(uint4*)(xsbc + (size_t)(t0 + u) * 1536 + ch) = pack8(y);
        }
    }
    const bf16* dtg = (const bf16*)(ws + OFF_DTG); float* dt = (float*)(ws + OFF_DT); float* gate = (float*)(ws + OFF_GATE);
    for (int i = gtid_; i < T * 64; i += gn_) {
        const int t = i >> 6, c = i & 63; const float v = bf2f(dtg[i]);
        if (c < 16) { const float xx = v + p.dt_bias[c]; dt[t * 16 + c] = xx > 20.f ? xx : log1pf(__expf(xx)); }
        else gate[t * 48 + (c - 16)] = sigmoidf(v);
    }
    const float* rc = (const float*)(ws + OFF_ROPE); const float* rs = rc + 4096 * 32;
    bf16* q = (bf16*)(ws + OFF_Q); bf16* kvs = (bf16*)(ws + OFF_KVS);
    for (int it = gtid_; it < T * 24 * 4; it += gn_) {
        const int j0 = (it & 3) * 8, hh = (it >> 2) % 24, t = it / 96, l = t & (L - 1);
        bf16* pp; float sc;
        if (hh < 16) { pp = q + (size_t)t * 1024 + hh * 64 + j0; sc = 0.125f * 1.4426950408889634f; } else if (hh < 20) { pp = kvs + (size_t)t * 1536 + 512 + (hh - 16) * 64 + j0; sc = 1.f; } else { pp = kvs + (size_t)t * 1536 + 1024 + (hh - 20) * 64 + j0; sc = 1.f; }
        float x1[8], x2[8], c[8], s[8], o1[8], o2[8];
        unpack8(*(const uint4*)pp, x1); unpack8(*(const uint4*)(pp + 32), x2);
        { const float4 a = *(const float4*)(rc + l * 32 + j0), b2 = *(const float4*)(rc + l * 32 + j0 + 4), d = *(const float4*)(rs + l * 32 + j0), e = *(const float4*)(rs + l * 32 + j0 + 4);
          c[0] = a.x; c[1] = a.y; c[2] = a.z; c[3] = a.w; c[4] = b2.x; c[5] = b2.y; c[6] = b2.z; c[7] = b2.w; s[0] = d.x; s[1] = d.y; s[2] = d.z; s[3] = d.w; s[4] = e.x; s[5] = e.y; s[6] = e.z; s[7] = e.w; }
#pragma unroll
        for (int i = 0; i < 8; ++i) { o1[i] = (x1[i] * c[i] - x2[i] * s[i]) * sc; o2[i] = (x1[i] * s[i] + x2[i] * c[i]) * sc; }
        *(uint4*)pp = pack8(o1); *(uint4*)(pp + 32) = pack8(o2);
    }
}

__device__ __forceinline__ void ph_ssd_prep2(const Params& p, int wv, unsigned char* lds) {
    PH_IDS(); unsigned char* ws = p.ws;
    const bf16* xsbc = (const bf16*)(ws + OFF_XSBC); const float* dt = (const float*)(ws + OFF_DT);
    bf16* XdT = (bf16*)p.out; bf16* BT = (bf16*)(ws + OFF_BT); float* acsT = (float*)(ws + OFF_ACS);
    float* sdt = (float*)lds; float* swave = sdt + 128;
    const int bide = bid, nbe = nb;
    for (int unit = bide; unit < 2048 + 256; unit += nbe) {
        __syncthreads();
        if (unit < 2048) {
            const int h = unit & 15, bc = unit >> 4; const size_t t0 = (size_t)bc * 128;
            const float A = -__expf(p.a_log[h]);
            if (tid < 128) { const float dv = dt[(t0 + tid) * 16 + h]; sdt[tid] = dv; float a = dv * A;
#pragma unroll
                for (int o = 1; o < 64; o <<= 1) { const float v = __shfl_up(a, o); if (lane >= o) a += v; }
                if (lane == 63) swave[tid >> 6] = a;
                sdt[128 + 8 + tid] = a; }
            __syncthreads();
            if (tid < 128) { float a = sdt[128 + 8 + tid]; if (tid >= 64) a += swave[0]; acsT[(size_t)unit * 128 + tid] = a; }
            const int pp = tid & 63, lg = tid >> 6; const bf16* src = xsbc + (t0 + lg * 16) * 1536 + h * 64 + pp;
            unsigned w[8];
#pragma unroll
            for (int i = 0; i < 8; ++i) { const float v0 = bf2f(src[(size_t)(2 * i) * 1536]) * sdt[lg * 16 + 2 * i], v1 = bf2f(src[(size_t)(2 * i + 1) * 1536]) * sdt[lg * 16 + 2 * i + 1]; w[i] = (unsigned)f2bf(v0) | ((unsigned)f2bf(v1) << 16); }
            uint4* dst = (uint4*)(XdT + (size_t)unit * 8192 + pp * 128 + lg * 16);
            dst[0] = make_uint4(w[0], w[1], w[2], w[3]); dst[1] = make_uint4(w[4], w[5], w[6], w[7]);
        } else {
            const int u2 = unit - 2048, g = u2 & 1, bc = u2 >> 1; const size_t t0 = (size_t)bc * 128;
            const int n = tid & 127, lg = tid >> 7; const bf16* src = xsbc + (t0 + lg * 32) * 1536 + 1024 + g * 128 + n;
            uint4* dst = (uint4*)(BT + (size_t)u2 * 16384 + n * 128 + lg * 32);
#pragma unroll
            for (int k = 0; k < 4; ++k) { unsigned w[4];
#pragma unroll
                for (int i = 0; i < 4; ++i) w[i] = (unsigned)src[(size_t)(8 * k + 2 * i) * 1536] | ((unsigned)src[(size_t)(8 * k + 2 * i + 1) * 1536] << 16);
                dst[k] = make_uint4(w[0], w[1], w[2], w[3]); }
        }
    }
}
__device__ __forceinline__ bf16x8 scale_frag(bf16x8 a, const float* s) {
    bf16x8 o;
#pragma unroll
    for (int j = 0; j < 8; ++j) o[j] = (short)f2bf(bf2f((bf16)a[j]) * s[j]);
    return o;
}
__device__ __forceinline__ void ph_ssd_states(const Params& p, int wv) {
    PH_IDS(); unsigned char* ws = p.ws; const int rr = lane & 31, hi = lane >> 5;
    const bf16* XdT = (const bf16*)p.out; bf16* S = (bf16*)((unsigned char*)p.out + 32 * MiB); const bf16* BT = (const bf16*)(ws + OFF_BT); const float* acsT = (const float*)(ws + OFF_ACS);
    for (int unit = gwave; unit < 2048; unit += nwaves) {
        const int h = unit & 15, bc = unit >> 4, g = h >> 3;
        const float* ac = acsT + (size_t)unit * 128; const float alast = ac[127];
        const bf16* xrow = XdT + (size_t)unit * 8192 + rr * 128 + 8 * hi; const bf16* bt = BT + (size_t)(bc * 2 + g) * 16384 + rr * 128 + 8 * hi;
        f32x16 acc[4][2];
#pragma unroll
        for (int nt = 0; nt < 4; ++nt)
#pragma unroll
            for (int pt = 0; pt < 2; ++pt)
#pragma unroll
                for (int e = 0; e < 16; ++e) acc[nt][pt][e] = 0.f;
#pragma unroll 2
        for (int ks = 0; ks < 8; ++ks) {
            const int l0 = ks * 16 + 8 * hi; float dec[8];
            { const f32x4 a0 = *(const f32x4*)(ac + l0), a1 = *(const f32x4*)(ac + l0 + 4);
#pragma unroll
              for (int jx = 0; jx < 8; ++jx) dec[jx] = __expf(alast - (jx < 4 ? a0[jx] : a1[jx - 4])); }
            bf16x8 xf[2];
#pragma unroll
            for (int pt = 0; pt < 2; ++pt) { float f[8]; unpack8(*(const uint4*)(xrow + (size_t)pt * 4096 + ks * 16), f);
#pragma unroll
                for (int jx = 0; jx < 8; ++jx) f[jx] *= dec[jx];
                union { uint4 u; bf16x8 v; } cvu; cvu.u = pack8(f); xf[pt] = cvu.v; }
#pragma unroll
            for (int nt = 0; nt < 4; ++nt) { const bf16x8 bf_ = *(const bf16x8*)(bt + (size_t)nt * 4096 + ks * 16);
#pragma unroll
                for (int pt = 0; pt < 2; ++pt) acc[nt][pt] = __builtin_amdgcn_mfma_f32_32x32x16_bf16(bf_, xf[pt], acc[nt][pt], 0, 0, 0); }
        }
#pragma unroll
        for (int pt = 0; pt < 2; ++pt) { bf16* so = S + (size_t)unit * 8192 + (pt * 32 + rr) * 128 + 4 * hi;
#pragma unroll
            for (int nt = 0; nt < 4; ++nt)
#pragma unroll
                for (int a = 0; a < 4; ++a) *(uint2*)(so + nt * 32 + 8 * a) = make_uint2(pk2bf(acc[nt][pt][4 * a], acc[nt][pt][4 * a + 1]), pk2bf(acc[nt][pt][4 * a + 2], acc[nt][pt][4 * a + 3])); }
    }
}
__device__ __forceinline__ void ph_ssd_scan(const Params& p, int wv) {
    PH_IDS();
    unsigned* S = (unsigned*)((unsigned char*)p.out + 32 * MiB); const float* acsT = (const float*)(p.ws + OFF_ACS);
    for (int e = gtid; e < NBATCH * 16 * 4096; e += gn) {
        const int pn = e & 4095, h = (e >> 12) & 15, b = e >> 16; float r0 = 0.f, r1 = 0.f;
        for (int c = 0; c < 32; c += 4) {
            unsigned v[4]; float d[4];
#pragma unroll
            for (int u = 0; u < 4; ++u) { const int unit = (b * 32 + c + u) * 16 + h; v[u] = S[(size_t)unit * 4096 + pn]; d[u] = __expf(acsT[(size_t)unit * 128 + 127]); }
#pragma unroll
            for (int u = 0; u < 4; ++u) { const int unit = (b * 32 + c + u) * 16 + h; S[(size_t)unit * 4096 + pn] = (unsigned)f2bf(r0) | ((unsigned)f2bf(r1) << 16);
                r0 = r0 * d[u] + bf2f((bf16)(v[u] & 0xffffu)); r1 = r1 * d[u] + bf2f((bf16)(v[u] >> 16)); }
        }
    }
}
constexpr int SO_CBROW = 136;
__device__ __forceinline__ void ph_ssd_out(const Params& p, int wv, unsigned char* lds) {
    PH_IDS(); unsigned char* ws = p.ws; const int rr = lane & 31, hi = lane >> 5;
    const bf16* XdT = (const bf16*)p.out; const bf16* S = (const bf16*)((unsigned char*)p.out + 32 * MiB); const bf16* xsbc = (const bf16*)(ws + OFF_XSBC);
    const float* acsT = (const float*)(ws + OFF_ACS); bf16* z = (bf16*)(ws + OFF_Z); float* ssq2p = (float*)(ws + OFF_HID);
    bf16* CBl = (bf16*)lds;
    for (int unit = bid; unit < 256; unit += nb) {
        const int g = unit & 1, bc = unit >> 1; const size_t t0 = (size_t)bc * 128;
        __syncthreads();
        for (int ti = wv; ti < 10; ti += NWAVES) {
            int lt = 0, st = ti; if (st > 0) { st -= 1; lt = 1; if (st > 1) { st -= 2; lt = 2; if (st > 2) { st -= 3; lt = 3; } } }
            f32x16 acc;
#pragma unroll
            for (int e = 0; e < 16; ++e) acc[e] = 0.f;
            const bf16* arow = xsbc + (t0 + st * 32 + rr) * 1536 + 1024 + g * 128 + 8 * hi; const bf16* brow = xsbc + (t0 + lt * 32 + rr) * 1536 + 1280 + g * 128 + 8 * hi;
#pragma unroll
            for (int ks = 0; ks < 8; ++ks) acc = __builtin_amdgcn_mfma_f32_32x32x16_bf16(*(const bf16x8*)(arow + ks * 16), *(const bf16x8*)(brow + ks * 16), acc, 0, 0, 0);
            bf16* dst = CBl + (lt * 32 + rr) * SO_CBROW + st * 32 + 4 * hi;
#pragma unroll
            for (int a = 0; a < 4; ++a) *(uint2*)(dst + 8 * a) = make_uint2(pk2bf(acc[4 * a], acc[4 * a + 1]), pk2bf(acc[4 * a + 2], acc[4 * a + 3]));
        }
        __syncthreads();
        const int h = g * 8 + wv, uh = bc * 16 + h; const float* ac = acsT + (size_t)uh * 128; const float Dh = p.d_skip[h];
        const bf16* xd = XdT + (size_t)uh * 8192 + rr * 128 + 8 * hi; const bf16* sin = S + (size_t)uh * 8192 + rr * 128 + 8 * hi;
        f32x16 acc[2][4];
#pragma unroll
        for (int pt = 0; pt < 2; ++pt)
#pragma unroll
            for (int lt = 0; lt < 4; ++lt)
#pragma unroll
                for (int e = 0; e < 16; ++e) acc[pt][lt][e] = 0.f;
#pragma unroll
        for (int lt = 0; lt < 4; ++lt) {
            const int l = lt * 32 + rr; const float acl = ac[l]; const float eal = __expf(acl);
#pragma unroll
            for (int ks = 0; ks < 2 * lt + 2; ++ks) {
                const int s0 = ks * 16 + 8 * hi; float cb[8]; unpack8(*(const uint4*)(CBl + l * SO_CBROW + s0), cb);
                const f32x4 a0 = *(const f32x4*)(ac + s0), a1 = *(const f32x4*)(ac + s0 + 4);
#pragma unroll
                for (int jx = 0; jx < 8; ++jx) { const float as = jx < 4 ? a0[jx] : a1[jx - 4]; cb[jx] = (s0 + jx <= l) ? cb[jx] * __expf(acl - as) : 0.f; }
                union { uint4 u; bf16x8 v; } mf; mf.u = pack8(cb);
#pragma unroll
                for (int pt = 0; pt < 2; ++pt) acc[pt][lt] = __builtin_amdgcn_mfma_f32_32x32x16_bf16(*(const bf16x8*)(xd + (size_t)pt * 4096 + ks * 16), mf.v, acc[pt][lt], 0, 0, 0);
            }
            const bf16* crow_ = xsbc + (t0 + l) * 1536 + 1280 + g * 128 + 8 * hi;
#pragma unroll
            for (int ks = 0; ks < 8; ++ks) {
                float cf[8]; unpack8(*(const uint4*)(crow_ + ks * 16), cf);
#pragma unroll
                for (int jx = 0; jx < 8; ++jx) cf[jx] *= eal;
                union { uint4 u; bf16x8 v; } bf_; bf_.u = pack8(cf);
#pragma unroll
                for (int pt = 0; pt < 2; ++pt) acc[pt][lt] = __builtin_amdgcn_mfma_f32_32x32x16_bf16(*(const bf16x8*)(sin + (size_t)pt * 4096 + ks * 16), bf_.v, acc[pt][lt], 0, 0, 0);
            }
            const size_t t = t0 + l; float ss = 0.f;
#pragma unroll
            for (int pt = 0; pt < 2; ++pt)
#pragma unroll
                for (int a = 0; a < 4; ++a) {
                    const int col = h * 64 + pt * 32 + 8 * a + 4 * hi;
                    const uint2 xw = *(const uint2*)(xsbc + t * 1536 + col), zw = *(const uint2*)(z + t * 1024 + col);
                    const float xs0 = bflo(xw.x), xs1 = bfhi(xw.x), xs2 = bflo(xw.y), xs3 = bfhi(xw.y), z0 = bflo(zw.x), z1 = bfhi(zw.x), z2 = bflo(zw.y), z3 = bfhi(zw.y);
                    const float v0 = (acc[pt][lt][4 * a] + Dh * xs0) * (z0 * sigmoidf(z0)), v1 = (acc[pt][lt][4 * a + 1] + Dh * xs1) * (z1 * sigmoidf(z1));
                    const float v2 = (acc[pt][lt][4 * a + 2] + Dh * xs2) * (z2 * sigmoidf(z2)), v3 = (acc[pt][lt][4 * a + 3] + Dh * xs3) * (z3 * sigmoidf(z3));
                    ss += (v0 * v0 + v1 * v1) + (v2 * v2 + v3 * v3);
                    *(uint2*)(z + t * 1024 + col) = make_uint2(pk2bf(v0, v1), pk2bf(v2, v3));
                }
            ss += __shfl_xor(ss, 32);
            if (hi == 0) ssq2p[t * 16 + h] = ss;
        }
    }
}

struct ACmp {
    const bf16* kvs; int coff;
    __device__ __forceinline__ bf16x8 operator()(int m, int k) const {
        const int hk = m & 3, n = (m >> 2) & 255, b = m >> 10, l = k >> 6, d = k & 63;
        if (n == 255) return (bf16x8){0, 0, 0, 0, 0, 0, 0, 0};
        return *(const bf16x8*)(kvs + (size_t)(b * L + 16 * n + l) * 1536 + coff + hk * 64 + d);
    }
};
struct EpiHid { bf16* hid; const float* bias; __device__ __forceinline__ void operator()(int row, int c, float v) const { hid[(size_t)row * 256 + c] = f2bf(gelu_exact(v + bias[c])); } };
struct EpiKc {
    bf16* dst; bool tr; __device__ __forceinline__ void operator()(int m, int c, float v) const { const int hk = m & 3, n = (m >> 2) & 255, b = m >> 10; const bf16 o = (n == 255) ? (bf16)0 : f2bf(v);
        if (tr) dst[((size_t)(b * 4 + hk) * 64 + c) * 256 + n] = o; else dst[((size_t)(b * 4 + hk) * 256 + n) * 64 + c] = o; } };
__device__ __forceinline__ void ph_kc_rope(const Params& p, int wv) {
    PH_IDS(); unsigned char* ws = p.ws; bf16* kc = (bf16*)(ws + OFF_KC); const float* rc = (const float*)(ws + OFF_ROPE); const float* rs = rc + 4096 * 32;
    for (int i = gtid; i < 16 * 256 * 32; i += gn) {
        const int j = i & 31, n = (i >> 5) & 255, bh = i >> 13; const int pos = 16 * n + 31; if (n == 255) continue;
        const float c = rc[pos * 32 + j], s = rs[pos * 32 + j];
        bf16* pp = kc + ((size_t)bh * 256 + n) * 64 + j; const float x1 = bf2f(pp[0]), x2 = bf2f(pp[32]);
        pp[0] = f2bf(x1 * c - x2 * s); pp[32] = f2bf(x1 * s + x2 * c);
    }
}


__device__ __forceinline__ void ph_vt_prep(const Params& p, int wv) {
    PH_IDS(); unsigned char* ws = p.ws; const bf16* kvs = (const bf16*)(ws + OFF_KVS);
    const int bide = bid, nbe = nb;
    for (int unit = bide; unit < 2 * 16 * 64; unit += nbe) {
        const int br = unit & 1, tl = (unit >> 1) & 63, bh = unit >> 7, b = bh >> 2, hk = bh & 3;
        const int d = tid & 63, grp = tid >> 6; const int l0 = tl * 64 + grp * 8;
        const bf16* src = kvs + ((size_t)b * L + l0) * 1536 + (br ? 1280 : 768) + hk * 64 + d;
        unsigned w[4];
#pragma unroll
        for (int i = 0; i < 4; ++i) w[i] = (unsigned)src[(size_t)(2 * i) * 1536] | ((unsigned)src[(size_t)(2 * i + 1) * 1536] << 16);
        bf16* dst = (bf16*)(ws + (br ? OFF_VWT : OFF_VST)) + ((size_t)bh * 64 + d) * L + l0;
        *(uint4*)dst = make_uint4(w[0], w[1], w[2], w[3]);
    }
}

__device__ __forceinline__ float max3f(float a, float b, float c) { float r; asm("v_max3_f32 %0, %1, %2, %3" : "=v"(r) : "v"(a), "v"(b), "v"(c)); return r; }
__device__ __forceinline__ int crow(int r, int hi) { return (r & 3) + 8 * (r >> 2) + 4 * hi; }
constexpr int NSA_KROW = 144, NSA_VROW = 136, NSA_KBUF = 64 * NSA_KROW, NSA_VBUF = 64 * NSA_VROW;
constexpr int NSA_OFF_STASH = 73728;
constexpr int NSA_OFF_K = 0, NSA_OFF_V = 2 * NSA_KBUF, NSA_OFF_IMPA = NSA_OFF_V + 2 * NSA_VBUF, NSA_IMPS = 65, NSA_OFF_IMPB = NSA_OFF_IMPA + 64 * NSA_IMPS * 4, NSA_OFF_SEL = NSA_OFF_IMPB + 64 * NSA_IMPS * 4;
struct NsaSrc { const bf16* K; size_t kstride; const bf16* VT; size_t ldv; };
__device__ __forceinline__ void nsa_gload(const NsaSrc& s, int k0, int tid, uint4& kr, uint4& vr) {
    const int row = tid >> 3, ch = tid & 7;
    kr = *(const uint4*)(s.K + (size_t)(k0 + row) * s.kstride + ch * 8);
    vr = *(const uint4*)(s.VT + (size_t)row * s.ldv + k0 + ch * 8);
}
__device__ __forceinline__ void nsa_lstore(unsigned char* kb, unsigned char* vb, int tid, const uint4& kr, const uint4& vr) {
    const int row = tid >> 3, ch = tid & 7;
    *(uint4*)(kb + row * NSA_KROW + ch * 16) = kr;
    uint2* vp = (uint2*)(vb + row * NSA_VROW + ch * 16); vp[0] = make_uint2(vr.x, vr.y); vp[1] = make_uint2(vr.z, vr.w);
}
__device__ __forceinline__ void nsa_qk(const unsigned char* kb, const bf16x8 (&qf)[4], int rr, int hi, f32x16& p0, f32x16& p1) {
#pragma unroll
    for (int i = 0; i < 16; ++i) { p0[i] = 0.f; p1[i] = 0.f; }
    __builtin_amdgcn_s_setprio(1);
#pragma unroll
    for (int ds = 0; ds < 4; ++ds) {
        const bf16x8 a0 = *(const bf16x8*)(kb + rr * NSA_KROW + ds * 32 + hi * 16), a1 = *(const bf16x8*)(kb + (rr + 32) * NSA_KROW + ds * 32 + hi * 16);
        p0 = __builtin_amdgcn_mfma_f32_32x32x16_bf16(a0, qf[ds], p0, 0, 0, 0); p1 = __builtin_amdgcn_mfma_f32_32x32x16_bf16(a1, qf[ds], p1, 0, 0, 0);
    }
    __builtin_amdgcn_s_setprio(0);
}
__device__ __forceinline__ void nsa_pv(const unsigned char* vb, int rr, int hi, const f32x16& p0, const f32x16& p1, f32x16 (&O)[2]) {
    __builtin_amdgcn_s_setprio(1);
#pragma unroll
    for (int s = 0; s < 4; ++s) {
        const int eb = 8 * (s & 1), kbase = 32 * (s >> 1) + 16 * (s & 1);
        union { uint4 u; bf16x8 v; } pf;
        if (s < 2) pf.u = make_uint4(pk2bf(p0[eb], p0[eb + 1]), pk2bf(p0[eb + 2], p0[eb + 3]), pk2bf(p0[eb + 4], p0[eb + 5]), pk2bf(p0[eb + 6], p0[eb + 7]));
        else       pf.u = make_uint4(pk2bf(p1[eb], p1[eb + 1]), pk2bf(p1[eb + 2], p1[eb + 3]), pk2bf(p1[eb + 4], p1[eb + 5]), pk2bf(p1[eb + 6], p1[eb + 7]));
#pragma unroll
        for (int dsub = 0; dsub < 2; ++dsub) {
            const unsigned char* vp = vb + (dsub * 32 + rr) * NSA_VROW + (kbase + 4 * hi) * 2;
            const uint2 lo = *(const uint2*)vp, hh = *(const uint2*)(vp + 16);
            union { uint4 u; bf16x8 v; } vf; vf.u = make_uint4(lo.x, lo.y, hh.x, hh.y);
            O[dsub] = __builtin_amdgcn_mfma_f32_32x32x16_bf16(vf.v, pf.v, O[dsub], 0, 0, 0);
        }
    }
    __builtin_amdgcn_s_setprio(0);
}
template <int MODE>
__device__ __forceinline__ void nsa_branch(unsigned char* lds, const NsaSrc& src, int jt0, int jt1, int tid, int rr, int hi, const bf16x8 (&qf)[4], int lpos, int qi, int tokblk,
                                           u64 selm, u64 wsel, float& m, float& lsum, float inv_l, f32x16 (&O)[2]) {
    if (jt0 >= jt1) return;
    asm volatile("" : "+v"(tid), "+v"(rr));
    float* impA = (float*)(lds + NSA_OFF_IMPA); float* impB = (float*)(lds + NSA_OFF_IMPB);
    uint4 kr, vr;
    nsa_gload(src, jt0 * 64, tid, kr, vr);
    nsa_lstore(lds + NSA_OFF_K, lds + NSA_OFF_V, tid, kr, vr);
    __syncthreads();
    for (int jt = jt0; jt < jt1; ++jt) {
        const int cur = (jt - jt0) & 1; const bool more = (jt + 1 < jt1);
        if (more) nsa_gload(src, (jt + 1) * 64, tid, kr, vr);
        const unsigned char* kb = lds + NSA_OFF_K + cur * NSA_KBUF; const unsigned char* vb = lds + NSA_OFF_V + cur * NSA_VBUF;
        const bool active = (MODE != 2) || ((wsel >> jt) & 1ull);
        if (active) {
            f32x16 p0, p1; nsa_qk(kb, qf, rr, hi, p0, p1);
            asm volatile("s_nop 15\n\ts_nop 7" : "+v"(p0), "+v"(p1));
            const int k0 = jt * 64;
            const bool tile_on = (MODE != 2) || ((selm >> jt) & 1ull);
            bool full;
            if (MODE <= 1) full = (16 * (k0 + 63) + 31 <= qi * 64); else if (MODE == 2) full = (jt < qi); else full = (jt > qi - 8) && (jt < qi);
            float mx = NEG_INF, mx2 = NEG_INF;
            if (full) {
#pragma unroll
                for (int e = 0; e < 16; e += 2) { mx = max3f(mx, p0[e], p1[e]); mx2 = max3f(mx2, p0[e + 1], p1[e + 1]); }
                if (MODE == 2 && !tile_on) { mx = NEG_INF; mx2 = NEG_INF; }
            } else {
                const int lim = (MODE <= 1) ? (lpos - 31 - 16 * k0 - 64 * hi) : (lpos - k0 - 4 * hi);
#pragma unroll
                for (int e = 0; e < 16; ++e) {
                    const int ca = (e & 3) + 8 * (e >> 2), cb = ca + 32; bool oa, ob;
                    if (MODE <= 1) { oa = (16 * ca <= lim); ob = (16 * cb <= lim); }
                    else if (MODE == 2) { oa = (ca <= lim); ob = (cb <= lim); }
                    else { oa = (ca <= lim) && (ca > lim - 512); ob = (cb <= lim) && (cb > lim - 512); }
                    p0[e] = oa ? p0[e] : NEG_INF; p1[e] = ob ? p1[e] : NEG_INF; if (e & 1) mx2 = max3f(mx2, p0[e], p1[e]); else mx = max3f(mx, p0[e], p1[e]);
                }
            }
            if (MODE != 1) {
                mx = max3f(mx, mx2, NEG_INF); mx = max3f(mx, __shfl_xor(mx, 32), NEG_INF);
                const float mnew = fmaxf(m, mx);
                if (__any((mnew - m) > 6.0f)) {
                    const float alpha = __builtin_amdgcn_exp2f(m - mnew); m = mnew; lsum *= alpha;
                    if (MODE != 0) {
#pragma unroll
                        for (int e = 0; e < 16; ++e) { O[0][e] *= alpha; O[1][e] *= alpha; }
                    }
                }
                const float meff = (MODE == 2 && full && !tile_on) ? BIG : ((m > 0.5f * NEG_INF) ? m : BIG);
                float rs = 0.f;
#pragma unroll
                for (int e = 0; e < 16; ++e) { p0[e] = __builtin_amdgcn_exp2f(p0[e] - meff); p1[e] = __builtin_amdgcn_exp2f(p1[e] - meff); rs += p0[e] + p1[e]; }
                lsum += rs;
                if (MODE != 0) nsa_pv(vb, rr, hi, p0, p1, O);
            } else {
#pragma unroll
                for (int e = 0; e < 16; ++e) { p0[e] = __builtin_amdgcn_exp2f(p0[e] - m) * inv_l; p1[e] = __builtin_amdgcn_exp2f(p1[e] - m) * inv_l; }
                nsa_pv(vb, rr, hi, p0, p1, O);
#pragma unroll
                for (int sub = 0; sub < 2; ++sub)
#pragma unroll
                    for (int a = 0; a < 4; ++a) {
                        float G, last;
                        if (sub == 0) { G = (p0[4 * a] + p0[4 * a + 1]) + (p0[4 * a + 2] + p0[4 * a + 3]); last = p0[4 * a + 3]; } else { G = (p1[4 * a] + p1[4 * a + 1]) + (p1[4 * a + 2] + p1[4 * a + 3]); last = p1[4 * a + 3]; }
                        G += __shfl_xor(G, 1); G += __shfl_xor(G, 2); last += __shfl_xor(last, 1); last += __shfl_xor(last, 2);
                        const int jj = (k0 >> 2) + 8 * sub + 2 * a + hi;
                        if ((rr & 3) == 0) { impA[tokblk * NSA_IMPS + jj] = G; if (jj + 1 < 64) impB[tokblk * NSA_IMPS + jj + 1] = last; }
                    }
            }
        }
        if (more) nsa_lstore(lds + NSA_OFF_K + (cur ^ 1) * NSA_KBUF, lds + NSA_OFF_V + (cur ^ 1) * NSA_VBUF, tid, kr, vr);
        __syncthreads();
    }
}
__device__ __forceinline__ void ph_nsa(const Params& p, int wv, unsigned char* lds) {
    PH_IDS(); unsigned char* ws = p.ws; const int wave = wv, rr = lane & 31, hi = lane >> 5;
    bf16* q = (bf16*)(ws + OFF_Q); const bf16* kvs = (const bf16*)(ws + OFF_KVS);
    const float* gate = (const float*)(ws + OFF_GATE); float* ssq = (float*)(ws + OFF_SSQ);
    float* impA = (float*)(lds + NSA_OFF_IMPA); float* impB = (float*)(lds + NSA_OFF_IMPB); u64* selw = (u64*)(lds + NSA_OFF_SEL);
    unsigned* qctr = (unsigned*)(ws + OFF_BAR + 14336) + 64 * (bid & 7); volatile int* ucur = (volatile int*)(lds + NSA_OFF_SEL + 512);
    for (;;) {
        if (tid == 0) *ucur = (int)__hip_atomic_fetch_add(qctr, 1u, __ATOMIC_RELAXED, __HIP_MEMORY_SCOPE_AGENT);
        __syncthreads();
        const int u = *ucur;
        if (u >= 128) break;
        const int bh = (bid & 7) + 8 * (u & 1), qi = 63 - (u >> 1);
        const int b = bh >> 2, hk = bh & 3; const int tokblk = wave * 8 + (rr >> 2), g = rr & 3; const int lpos = qi * 64 + tokblk; const size_t t = (size_t)b * L + lpos;
        bf16* qrow = q + t * 1024 + (hk * 4 + g) * 64;
        bf16x8 qf[4];
#pragma unroll
        for (int ds = 0; ds < 4; ++ds) qf[ds] = *(const bf16x8*)(qrow + ds * 16 + hi * 8);
        for (int i = tid; i < 64 * NSA_IMPS; i += NTHREADS) { impA[i] = 0.f; impB[i] = 0.f; }
        __syncthreads();
        f32x16 O[2]; float* stash = (float*)(lds + NSA_OFF_STASH) + tid;
        const float g0 = gate[t * 48 + (hk * 4 + g) * 3 + 0], g1 = gate[t * 48 + (hk * 4 + g) * 3 + 1], g2 = gate[t * 48 + (hk * 4 + g) * 3 + 2];
        {
            NsaSrc s{(const bf16*)(ws + OFF_KC) + (size_t)bh * 256 * 64, 64, (const bf16*)(ws + OFF_VCT) + (size_t)bh * 64 * 256, 256};
            const int nct = (4 * qi + 3 + 63) >> 6;
            float m = NEG_INF, lsum = 0.f;
            nsa_branch<0>(lds, s, 0, nct, tid, rr, hi, qf, lpos, qi, tokblk, 0ull, 0ull, m, lsum, 0.f, O);
            lsum += __shfl_xor(lsum, 32);
            const float inv_l = lsum > 0.f ? 1.0f / lsum : 0.f;
#pragma unroll
            for (int e = 0; e < 16; ++e) { O[0][e] = 0.f; O[1][e] = 0.f; }
            nsa_branch<1>(lds, s, 0, nct, tid, rr, hi, qf, lpos, qi, tokblk, 0ull, 0ull, m, lsum, inv_l, O);
#pragma unroll
            for (int e = 0; e < 16; ++e) { stash[e * 512] = g0 * O[0][e]; stash[(16 + e) * 512] = g0 * O[1][e]; }
        }
        {
            const int tk = tid >> 3, jg = tid & 7; float v[8];
#pragma unroll
            for (int i = 0; i < 8; ++i) { const int j = jg * 8 + i; const float raw = impA[tk * NSA_IMPS + j] + impB[tk * NSA_IMPS + j];
                const bool causal = (j <= qi), forced = (j == 0) || (j == qi) || (j == qi - 1); v[i] = causal ? (forced ? BIG : raw) : NEG_INF; }
            __syncthreads();
#pragma unroll
            for (int i = 0; i < 8; ++i) impA[tk * NSA_IMPS + jg * 8 + i] = v[i];
            __syncthreads();
            int rank[8];
#pragma unroll
            for (int i = 0; i < 8; ++i) rank[i] = 0;
            for (int jj = 0; jj < 64; ++jj) { const float x = impA[tk * NSA_IMPS + jj];
#pragma unroll
                for (int i = 0; i < 8; ++i) rank[i] += (x > v[i] || (x == v[i] && jj < jg * 8 + i)) ? 1 : 0; }
            unsigned b8 = 0u;
#pragma unroll
            for (int i = 0; i < 8; ++i) b8 |= (rank[i] < 16 && jg * 8 + i <= qi) ? (1u << i) : 0u;
            const u64 full = (u64)b8 << (jg * 8); unsigned blo = (unsigned)full, bhi = (unsigned)(full >> 32);
            blo |= __shfl_xor(blo, 1); bhi |= __shfl_xor(bhi, 1); blo |= __shfl_xor(blo, 2); bhi |= __shfl_xor(bhi, 2); blo |= __shfl_xor(blo, 4); bhi |= __shfl_xor(bhi, 4);
            if (jg == 0) selw[tk] = (u64)blo | ((u64)bhi << 32);
            __syncthreads();
        }
        const u64 selm = selw[tokblk];
        u64 wsel = selm;
        { unsigned lo = (unsigned)wsel, h2 = (unsigned)(wsel >> 32);
          lo |= __shfl_xor(lo, 4); h2 |= __shfl_xor(h2, 4); lo |= __shfl_xor(lo, 8); h2 |= __shfl_xor(h2, 8); lo |= __shfl_xor(lo, 16); h2 |= __shfl_xor(h2, 16);
          wsel = (u64)lo | ((u64)h2 << 32); }
        {
            NsaSrc s{kvs + (size_t)b * L * 1536 + 512 + hk * 64, 1536, (const bf16*)(ws + OFF_VST) + (size_t)bh * 64 * L, (size_t)L};
            float m = NEG_INF, lsum = 0.f;
#pragma unroll
            for (int e = 0; e < 16; ++e) { O[0][e] = 0.f; O[1][e] = 0.f; }
            nsa_branch<2>(lds, s, 0, qi + 1, tid, rr, hi, qf, lpos, qi, tokblk, selm, wsel, m, lsum, 0.f, O);
            lsum += __shfl_xor(lsum, 32); const float sc = g1 / lsum;
#pragma unroll
            for (int e = 0; e < 16; ++e) { stash[e * 512] += sc * O[0][e]; stash[(16 + e) * 512] += sc * O[1][e]; }
        }
        {
            NsaSrc s{kvs + (size_t)b * L * 1536 + 1024 + hk * 64, 1536, (const bf16*)(ws + OFF_VWT) + (size_t)bh * 64 * L, (size_t)L};
            float m = NEG_INF, lsum = 0.f;
#pragma unroll
            for (int e = 0; e < 16; ++e) { O[0][e] = 0.f; O[1][e] = 0.f; }
            nsa_branch<3>(lds, s, qi >= 8 ? qi - 8 : 0, qi + 1, tid, rr, hi, qf, lpos, qi, tokblk, 0ull, 0ull, m, lsum, 0.f, O);
            lsum += __shfl_xor(lsum, 32); const float sc = g2 / lsum;
#pragma unroll
            for (int e = 0; e < 16; ++e) { O[0][e] = stash[e * 512] + sc * O[0][e]; O[1][e] = stash[(16 + e) * 512] + sc * O[1][e]; }
        }
        float ss = 0.f;
#pragma unroll
        for (int dsub = 0; dsub < 2; ++dsub)
#pragma unroll
            for (int a = 0; a < 4; ++a) {
                const float v0 = O[dsub][4 * a], v1 = O[dsub][4 * a + 1], v2 = O[dsub][4 * a + 2], v3 = O[dsub][4 * a + 3];
                ss += (v0 * v0 + v1 * v1) + (v2 * v2 + v3 * v3);
                *(uint2*)(qrow + dsub * 32 + 8 * a + 4 * hi) = make_uint2(pk2bf(v0, v1), pk2bf(v2, v3));
            }
        ss += __shfl_xor(ss, 32); ss += __shfl_xor(ss, 1); ss += __shfl_xor(ss, 2);
        if (hi == 0 && g == 0) ssq[t * 4 + hk] = ss;
        __syncthreads();
    }
}

constexpr size_t OFF_SU = 640 * 1024, OFF_SV = 704 * 1024, OFF_SX = 768 * 1024, OFF_SC = 832 * 1024;
constexpr size_t OFF_COEFQ = 218 * MiB, OFF_H1Q = 220 * MiB;
__device__ __forceinline__ unsigned pack4i8(float a, float b, float c, float d) {
    const int ia = (int)rintf(a), ib = (int)rintf(b), ic = (int)rintf(c), id = (int)rintf(d);
    return (unsigned)(ia & 0xff) | ((unsigned)(ib & 0xff) << 8) | ((unsigned)(ic & 0xff) << 16) | ((unsigned)(id & 0xff) << 24);
}
__device__ __forceinline__ void ph_ln1(const Params& p, int wv) {
    PH_IDS(); unsigned char* ws = p.ws; bf16* h1b = (bf16*)(ws + OFF_H1B); unsigned char* h1q = ws + OFF_H1Q; float* sx = (float*)(ws + OFF_SX);
    for (int t = gwave; t < T; t += nwaves) {
        float v[16]; float s = 0.f; float* row = p.out + (size_t)t * 1024 + lane * 16;
#pragma unroll
        for (int i = 0; i < 4; ++i) { const float4 a = *(const float4*)(row + 4 * i); v[4 * i] = a.x; v[4 * i + 1] = a.y; v[4 * i + 2] = a.z; v[4 * i + 3] = a.w; s += (a.x + a.y) + (a.z + a.w); }
        const float mu = wave_sum(s) * (1.0f / 1024.0f); float s2 = 0.f;
#pragma unroll
        for (int i = 0; i < 16; ++i) { v[i] -= mu; s2 += v[i] * v[i]; }
        const float rstd = rsqrtf(wave_sum(s2) * (1.0f / 1024.0f) + LN_EPS); float amax = 0.f;
#pragma unroll
        for (int i = 0; i < 4; ++i) { const int c = lane * 16 + 4 * i; const float4 ga = *(const float4*)(p.ln1_g + c), ba = *(const float4*)(p.ln1_b + c);
            v[4 * i] = v[4 * i] * rstd * ga.x + ba.x; v[4 * i + 1] = v[4 * i + 1] * rstd * ga.y + ba.y; v[4 * i + 2] = v[4 * i + 2] * rstd * ga.z + ba.z; v[4 * i + 3] = v[4 * i + 3] * rstd * ga.w + ba.w;
            *(float4*)(row + 4 * i) = make_float4(v[4 * i], v[4 * i + 1], v[4 * i + 2], v[4 * i + 3]); }
#pragma unroll
        for (int i = 0; i < 16; ++i) amax = fmaxf(amax, fabsf(v[i]));
        amax = fmaxf(wave_max(amax), 1e-20f); const float inv = 127.0f / amax;
        *(uint4*)(h1b + (size_t)t * 1024 + lane * 16) = pack8(v); *(uint4*)(h1b + (size_t)t * 1024 + lane * 16 + 8) = pack8(v + 8);
        *(uint4*)(h1q + (size_t)t * 1024 + lane * 16) = make_uint4(pack4i8(v[0] * inv, v[1] * inv, v[2] * inv, v[3] * inv), pack4i8(v[4] * inv, v[5] * inv, v[6] * inv, v[7] * inv),
                                                                 pack4i8(v[8] * inv, v[9] * inv, v[10] * inv, v[11] * inv), pack4i8(v[12] * inv, v[13] * inv, v[14] * inv, v[15] * inv));
        if (lane == 0) sx[t] = amax * (1.0f / 127.0f);
    }
}

__device__ __forceinline__ unsigned umaxu(unsigned a, unsigned b) { return a > b ? a : b; }
__device__ __forceinline__ unsigned uminu(unsigned a, unsigned b) { return a < b ? a : b; }
__device__ __forceinline__ unsigned f2mono(float f) { const unsigned u = __float_as_uint(f); return (u & 0x80000000u) ? ~u : (u | 0x80000000u); }
__device__ __forceinline__ float mono2f(unsigned m) { return __uint_as_float((m & 0x80000000u) ? (m & 0x7fffffffu) : ~m); }
template <int N> __device__ __forceinline__ void bitonic_sort_desc(unsigned (&a)[N]) {
#pragma unroll
    for (int k = 2; k <= N; k <<= 1)
#pragma unroll
        for (int j = k >> 1; j > 0; j >>= 1)
#pragma unroll
            for (int i = 0; i < N; ++i) { const int l = i ^ j; if (l > i) { const bool desc = ((i & k) == 0); const unsigned x = a[i], y = a[l], mx = umaxu(x, y), mn = uminu(x, y); a[i] = desc ? mx : mn; a[l] = desc ? mn : mx; } }
}
__device__ __forceinline__ void merge_top16(unsigned (&a)[16], const unsigned (&b)[16]) {
#pragma unroll
    for (int i = 0; i < 16; ++i) a[i] = umaxu(a[i], b[15 - i]);
#pragma unroll
    for (int j = 8; j > 0; j >>= 1)
#pragma unroll
        for (int i = 0; i < 16; ++i) { const int l = i ^ j; if (l > i) { const unsigned x = a[i], y = a[l]; a[i] = umaxu(x, y); a[l] = uminu(x, y); } }
}
__device__ __forceinline__ void peer_stage1(const bf16* qrow, const bf16* krow, int hi, unsigned (&run)[16]) {
    bf16x8 qf[8];
#pragma unroll
    for (int ks = 0; ks < 8; ++ks) qf[ks] = *(const bf16x8*)(qrow + ks * 16);
#pragma unroll 1
    for (int kt = 0; kt < 4; ++kt) {
        f32x16 acc;
#pragma unroll
        for (int e = 0; e < 16; ++e) acc[e] = 0.f;
        const bf16* kr = krow + (size_t)kt * 32 * 128;
#pragma unroll
        for (int ks = 0; ks < 8; ++ks) acc = __builtin_amdgcn_mfma_f32_32x32x16_bf16(*(const bf16x8*)(kr + ks * 16), qf[ks], acc, 0, 0, 0);
        unsigned grp[16]; const unsigned ib = (unsigned)(127 - kt * 32 - 4 * hi);
#pragma unroll
        for (int e = 0; e < 16; ++e) grp[e] = (f2mono(acc[e]) & ~0x7fu) | (ib - (unsigned)((e & 3) + 8 * (e >> 2)));
        bitonic_sort_desc<16>(grp);
        if (kt == 0) {
#pragma unroll
            for (int i = 0; i < 16; ++i) run[i] = grp[i];
        } else merge_top16(run, grp);
    }
    unsigned oth[16];
#pragma unroll
    for (int i = 0; i < 16; ++i) oth[i] = __shfl_xor(run[i], 32);
    merge_top16(run, oth);
}
__device__ __forceinline__ void ph_peer_topk(const Params& p, int wv, unsigned char* lds) {
    PH_IDS(); unsigned char* ws = p.ws; const int rr = lane & 31, hi = lane >> 5;
    int* exl = (int*)(lds + wv * 6400);
    const bf16* qp = (const bf16*)(ws + OFF_QP); const bf16* keys = (const bf16*)(ws + OFF_KEYS);
    int* eidx = (int*)(ws + OFF_EIDX); float* gw = (float*)(ws + OFF_GW);
    for (int task = gwave; task < 512 * 8; task += nwaves) {
        const int h = task & 7, t0 = (task >> 3) * 32;
        unsigned top[2][16];
        peer_stage1(qp + (size_t)(t0 + rr) * 2048 + h * 256 + 8 * hi, keys + ((size_t)(h * 2) * 128 + rr) * 128 + 8 * hi, hi, top[0]);
        peer_stage1(qp + (size_t)(t0 + rr) * 2048 + h * 256 + 128 + 8 * hi, keys + ((size_t)(h * 2 + 1) * 128 + rr) * 128 + 8 * hi, hi, top[1]);
        unsigned g4[4][16];
#pragma unroll
        for (int k = 0; k < 4; ++k)
#pragma unroll
            for (int i = 0; i < 16; ++i) g4[k][i] = 0u;
#pragma unroll
        for (int i = 0; i < 16; ++i) {
            int off = 0;
#pragma unroll
            for (int k = 0; k < 16; ++k) if (k < i) off += 16 / (k + 1);
            const float s0 = mono2f(top[0][i] & ~0x7fu); const int e0 = (int)(127u - (top[0][i] & 0x7fu)) * 128;
#pragma unroll
            for (int j = 0; j < 16; ++j) if ((i + 1) * (j + 1) <= 16) {
                const int nc = off + j;
                const float sum = s0 + mono2f(top[1][j] & ~0x7fu);
                g4[nc >> 4][nc & 15] = (f2mono(sum) & ~0x3fu) | (unsigned)(63 - nc);
                if (hi == 0) exl[nc * 32 + rr] = e0 + (int)(127u - (top[1][j] & 0x7fu));
            }
        }
#pragma unroll
        for (int k = 0; k < 4; ++k) bitonic_sort_desc<16>(g4[k]);
        merge_top16(g4[0], g4[1]); merge_top16(g4[2], g4[3]); merge_top16(g4[0], g4[2]);
        float e16[16]; float den = 0.f; const float gmax = mono2f(g4[0][0] & ~0x3fu);
#pragma unroll
        for (int r = 0; r < 16; ++r) { e16[r] = __expf(mono2f(g4[0][r] & ~0x3fu) - gmax); den += e16[r]; }
        const float inv = 1.0f / den; const size_t ob = (size_t)(t0 + rr) * 128 + h * 16 + hi * 8;
        float wo[8]; int eo[8];
#pragma unroll
        for (int k = 0; k < 8; ++k) { const unsigned key = hi ? g4[0][8 + k] : g4[0][k]; wo[k] = (hi ? e16[8 + k] : e16[k]) * inv; eo[k] = exl[(63 - (int)(key & 0x3fu)) * 32 + rr]; }
        *(float4*)(gw + ob) = make_float4(wo[0], wo[1], wo[2], wo[3]); *(float4*)(gw + ob + 4) = make_float4(wo[4], wo[5], wo[6], wo[7]);
        *(int4*)(eidx + ob) = make_int4(eo[0], eo[1], eo[2], eo[3]); *(int4*)(eidx + ob + 4) = make_int4(eo[4], eo[5], eo[6], eo[7]);
    }
}
__device__ __forceinline__ void ph_peer_cvt(const Params& p, int wv) {
    PH_IDS(); unsigned char* ws = p.ws;
    for (int r = gwave; r < 2 * 16384; r += nwaves) {
        const bool isv = r >= 16384; const int e = isv ? r - 16384 : r;
        const float* src = (isv ? p.peer_v : p.peer_u) + (size_t)e * 1024 + lane * 16; float v[16]; float amax = 0.f;
#pragma unroll
        for (int i = 0; i < 4; ++i) { const float4 a = *(const float4*)(src + 4 * i); v[4 * i] = a.x; v[4 * i + 1] = a.y; v[4 * i + 2] = a.z; v[4 * i + 3] = a.w; }
#pragma unroll
        for (int i = 0; i < 16; ++i) amax = fmaxf(amax, fabsf(v[i]));
        amax = fmaxf(wave_max(amax), 1e-30f); const float inv = 127.0f / amax;
        *(uint4*)(ws + (isv ? OFF_PV : OFF_PU) + (size_t)e * 1024 + lane * 16) = make_uint4(pack4i8(v[0] * inv, v[1] * inv, v[2] * inv, v[3] * inv), pack4i8(v[4] * inv, v[5] * inv, v[6] * inv, v[7] * inv),
                                                                                            pack4i8(v[8] * inv, v[9] * inv, v[10] * inv, v[11] * inv), pack4i8(v[12] * inv, v[13] * inv, v[14] * inv, v[15] * inv));
        if (lane == 0) ((float*)(ws + (isv ? OFF_SV : OFF_SU)))[e] = amax * (1.0f / 127.0f);
    }
}
__device__ __forceinline__ f32x2v pkfma(f32x2v a, f32x2v b, f32x2v c) { return __builtin_elementwise_fma(a, b, c); }
__device__ __forceinline__ float dot16f8(const uint4& w, const f32x2v* x) {
    f32x2v a = {0.f, 0.f}, b = {0.f, 0.f};
    a = pkfma(__builtin_amdgcn_cvt_pk_f32_fp8(w.x, false), x[0], a); b = pkfma(__builtin_amdgcn_cvt_pk_f32_fp8(w.x, true), x[1], b);
    a = pkfma(__builtin_amdgcn_cvt_pk_f32_fp8(w.y, false), x[2], a); b = pkfma(__builtin_amdgcn_cvt_pk_f32_fp8(w.y, true), x[3], b);
    a = pkfma(__builtin_amdgcn_cvt_pk_f32_fp8(w.z, false), x[4], a); b = pkfma(__builtin_amdgcn_cvt_pk_f32_fp8(w.z, true), x[5], b);
    a = pkfma(__builtin_amdgcn_cvt_pk_f32_fp8(w.w, false), x[6], a); b = pkfma(__builtin_amdgcn_cvt_pk_f32_fp8(w.w, true), x[7], b);
    a = a + b; return a.x + a.y;
}
__device__ __forceinline__ void axpy16f8(const uint4& w, float c, f32x2v* y) {
    const f32x2v c2 = {c, c};
    y[0] = pkfma(c2, __builtin_amdgcn_cvt_pk_f32_fp8(w.x, false), y[0]); y[1] = pkfma(c2, __builtin_amdgcn_cvt_pk_f32_fp8(w.x, true), y[1]);
    y[2] = pkfma(c2, __builtin_amdgcn_cvt_pk_f32_fp8(w.y, false), y[2]); y[3] = pkfma(c2, __builtin_amdgcn_cvt_pk_f32_fp8(w.y, true), y[3]);
    y[4] = pkfma(c2, __builtin_amdgcn_cvt_pk_f32_fp8(w.z, false), y[4]); y[5] = pkfma(c2, __builtin_amdgcn_cvt_pk_f32_fp8(w.z, true), y[5]);
    y[6] = pkfma(c2, __builtin_amdgcn_cvt_pk_f32_fp8(w.w, false), y[6]); y[7] = pkfma(c2, __builtin_amdgcn_cvt_pk_f32_fp8(w.w, true), y[7]);
}
constexpr size_t OFF_PART = 26 * MiB;
constexpr size_t OFF_COEF = 218 * MiB;
constexpr size_t OFF_Y = 26 * MiB;
static_assert(OFF_PART + 64 * MiB <= OFF_H1B && OFF_PV + 16 * MiB <= OFF_XSBC && OFF_VWT + 8 * MiB <= OFF_PU, "PEER scratch map");
#define PU_ISSUE16(W, ELO, EHI) do { _Pragma("unroll") for (int k = 0; k < 8; ++k) { const int e0 = __shfl(ELO, k * 8 + g), e1 = __shfl(EHI, k * 8 + g); \
        W[k] = *(const uint4*)(PU + (size_t)e0 * 1024 + 128 * s + 16 * j); W[8 + k] = *(const uint4*)(PU + (size_t)e1 * 1024 + 128 * s + 16 * j); } } while (0)
#define PU_DOT16(W, X) __builtin_amdgcn_sdot4((int)(W).w, (int)(X).w, __builtin_amdgcn_sdot4((int)(W).z, (int)(X).z, __builtin_amdgcn_sdot4((int)(W).y, (int)(X).y, __builtin_amdgcn_sdot4((int)(W).x, (int)(X).x, 0, false), false), false), false)
#define PU_REDUCE8(W, O, XQ, PROW, B) do { int d[8], a4[4], a2[2], a1; \
        _Pragma("unroll") for (int k = 0; k < 8; ++k) d[k] = PU_DOT16(W[(O) + k], XQ); \
        _Pragma("unroll") for (int k = 0; k < 4; ++k) { const int give = b2 ? d[k] : d[4 + k]; a4[k] = (b2 ? d[4 + k] : d[k]) + __shfl_xor(give, 4); } \
        _Pragma("unroll") for (int k = 0; k < 2; ++k) { const int give = b1 ? a4[k] : a4[2 + k]; a2[k] = (b1 ? a4[2 + k] : a4[k]) + __shfl_xor(give, 2); } \
        { const int give = b0 ? a2[0] : a2[1]; a1 = (b0 ? a2[1] : a2[0]) + __shfl_xor(give, 1); } \
        (PROW)[(B) * 64 + kk * 8 + g] = a1; } while (0)
#define PU_META(T_, XQ, ELO, EHI) do { const int tq_ = (T_) < T ? (T_) : tlast; XQ = *(const uint4*)(h1q + (size_t)tq_ * 1024 + 128 * s + 16 * j); \
        ELO = eidx[(size_t)tq_ * 128 + lane]; EHI = eidx[(size_t)tq_ * 128 + 64 + lane]; } while (0)
#define PU_TOKEN(W, T_, XQ) do { int* prow = part + ((size_t)s * T + (T_)) * 128; PU_REDUCE8(W, 0, XQ, prow, 0); PU_REDUCE8(W, 8, XQ, prow, 1); } while (0)
__device__ __forceinline__ void ph_peer_u(const Params& p, int wv) {
    PH_IDS(); unsigned char* ws = p.ws; const int s = bid & 7, cu = bid >> 3, ncu = nb >> 3, g = lane >> 3, j = lane & 7;
    const unsigned char* h1q = ws + OFF_H1Q; const int* eidx = (const int*)(ws + OFF_EIDX); const unsigned char* PU = ws + OFF_PU; int* part = (int*)(ws + OFF_PART);
    const bool b2 = (lane & 4) != 0, b1 = (lane & 2) != 0, b0 = (lane & 1) != 0; const int kk = (b2 ? 4 : 0) + (b1 ? 2 : 0) + (b0 ? 1 : 0);
    const int tstep = ncu * NWAVES; int t = cu * NWAVES + wv;
    if (t >= T) return;
    const int tlast = t;
    uint4 xq0, xq1; int el0, eh0, el1, eh1;
    PU_META(t, xq0, el0, eh0); PU_META(t + tstep, xq1, el1, eh1);
    uint4 wA[16], wB[16];
    PU_ISSUE16(wA, el0, eh0);
    for (;;) {
        { const uint4 cx = xq0; PU_META(t + 2 * tstep, xq0, el0, eh0); PU_ISSUE16(wB, el1, eh1); PU_TOKEN(wA, t, cx); }
        t += tstep; if (t >= T) break;
        { const uint4 cx = xq1; PU_META(t + 2 * tstep, xq1, el1, eh1); PU_ISSUE16(wA, el0, eh0); PU_TOKEN(wB, t, cx); }
        t += tstep; if (t >= T) break;
    }
}
__device__ __forceinline__ void ph_peer_c(const Params& p, int wv) {
    PH_IDS(); unsigned char* ws = p.ws; const int* part = (const int*)(ws + OFF_PART); const float* gw = (const float*)(ws + OFF_GW); const int* eidx = (const int*)(ws + OFF_EIDX);
    const float* su = (const float*)(ws + OFF_SU); const float* sv = (const float*)(ws + OFF_SV); const float* sx = (const float*)(ws + OFF_SX); float* sc = (float*)(ws + OFF_SC); unsigned* coefq = (unsigned*)(ws + OFF_COEFQ);
    for (int t = gwave; t < T; t += nwaves) {
        float cp[2];
#pragma unroll
        for (int b = 0; b < 2; ++b) { const size_t i = (size_t)t * 128 + b * 64 + lane; int acc = 0;
#pragma unroll
            for (int s = 0; s < 8; ++s) acc += part[(size_t)s * T * 128 + i];
            const int e = eidx[i]; cp[b] = gw[i] * gelu_exact((float)acc * su[e] * sx[t]) * sv[e]; }
        const float amax = fmaxf(wave_max(fmaxf(fabsf(cp[0]), fabsf(cp[1]))), 1e-30f), inv = 127.0f / amax;
        const int q0 = (int)rintf(cp[0] * inv) & 0xff, q1 = (int)rintf(cp[1] * inv) & 0xff;
        const int gg = lane & 7, kq = (lane >> 3) & 1;
        unsigned w0 = 0u, w1 = 0u;
#pragma unroll
        for (int i = 0; i < 4; ++i) { const int srcl = (4 * kq + i) * 8 + gg; w0 |= (unsigned)__shfl(q0, srcl) << (8 * i); w1 |= (unsigned)__shfl(q1, srcl) << (8 * i); }
        if (lane < 16) { coefq[(size_t)t * 32 + lane] = w0; coefq[(size_t)t * 32 + 16 + lane] = w1; }
        if (lane == 0) sc[t] = amax * (1.0f / 127.0f);
    }
}
#define PV_ISSUE16(W, ELO, EHI) do { _Pragma("unroll") for (int k = 0; k < 8; ++k) { const int e0 = __shfl(ELO, k * 8 + g), e1 = __shfl(EHI, k * 8 + g); \
        W[k] = *(const uint4*)(PV + (size_t)e0 * 1024 + 128 * s + 16 * j); W[8 + k] = *(const uint4*)(PV + (size_t)e1 * 1024 + 128 * s + 16 * j); } } while (0)
#define PV_META(T_, ELO, EHI, CQ) do { const int tq_ = (T_) < T ? (T_) : tlast; ELO = eidx[(size_t)tq_ * 128 + lane]; EHI = eidx[(size_t)tq_ * 128 + 64 + lane]; \
        CQ[0] = coefq[(size_t)tq_ * 32 + g]; CQ[1] = coefq[(size_t)tq_ * 32 + 8 + g]; CQ[2] = coefq[(size_t)tq_ * 32 + 16 + g]; CQ[3] = coefq[(size_t)tq_ * 32 + 24 + g]; } while (0)
#define PV_BLK(W0, W1, W2, W3, CQW, A0, A1, A2, A3) do { \
        const unsigned l01 = __builtin_amdgcn_perm(W1, W0, 0x05010400u), h01 = __builtin_amdgcn_perm(W1, W0, 0x07030602u), l23 = __builtin_amdgcn_perm(W3, W2, 0x05010400u), h23 = __builtin_amdgcn_perm(W3, W2, 0x07030602u); \
        A0 = __builtin_amdgcn_sdot4((int)__builtin_amdgcn_perm(l23, l01, 0x05040100u), (int)(CQW), A0, false); A1 = __builtin_amdgcn_sdot4((int)__builtin_amdgcn_perm(l23, l01, 0x07060302u), (int)(CQW), A1, false); \
        A2 = __builtin_amdgcn_sdot4((int)__builtin_amdgcn_perm(h23, h01, 0x05040100u), (int)(CQW), A2, false); A3 = __builtin_amdgcn_sdot4((int)__builtin_amdgcn_perm(h23, h01, 0x07060302u), (int)(CQW), A3, false); } while (0)
#define PV_QUAD(W, O, CQW) do { PV_BLK(W[(O)].x, W[(O) + 1].x, W[(O) + 2].x, W[(O) + 3].x, CQW, acc[0], acc[1], acc[2], acc[3]); PV_BLK(W[(O)].y, W[(O) + 1].y, W[(O) + 2].y, W[(O) + 3].y, CQW, acc[4], acc[5], acc[6], acc[7]); \
        PV_BLK(W[(O)].z, W[(O) + 1].z, W[(O) + 2].z, W[(O) + 3].z, CQW, acc[8], acc[9], acc[10], acc[11]); PV_BLK(W[(O)].w, W[(O) + 1].w, W[(O) + 2].w, W[(O) + 3].w, CQW, acc[12], acc[13], acc[14], acc[15]); } while (0)
#define PV_TOKEN(W, CQ, T_) do { int acc[16]; _Pragma("unroll") for (int i = 0; i < 16; ++i) acc[i] = 0; \
        PV_QUAD(W, 0, CQ[0]); PV_QUAD(W, 4, CQ[1]); PV_QUAD(W, 8, CQ[2]); PV_QUAD(W, 12, CQ[3]); \
        int y8[8], y4[4], y2[2]; \
        _Pragma("unroll") for (int i = 0; i < 8; ++i) { const int give = b5 ? acc[i] : acc[8 + i]; y8[i] = (b5 ? acc[8 + i] : acc[i]) + __shfl_xor(give, 32); } \
        _Pragma("unroll") for (int i = 0; i < 4; ++i) { const int give = b4 ? y8[i] : y8[4 + i]; y4[i] = (b4 ? y8[4 + i] : y8[i]) + __shfl_xor(give, 16); } \
        _Pragma("unroll") for (int i = 0; i < 2; ++i) { const int give = b3 ? y4[i] : y4[2 + i]; y2[i] = (b3 ? y4[2 + i] : y4[i]) + __shfl_xor(give, 8); } \
        const float sct = sc[(T_)]; *(float2*)(Y + (size_t)(T_) * 1024 + 128 * s + 16 * j + c0) = make_float2((float)y2[0] * sct, (float)y2[1] * sct); } while (0)
__device__ __forceinline__ void ph_peer_v(const Params& p, int wv) {
    PH_IDS(); unsigned char* ws = p.ws; const int s = bid & 7, cu = bid >> 3, ncu = nb >> 3, g = lane >> 3, j = lane & 7;
    const int* eidx = (const int*)(ws + OFF_EIDX); const unsigned* coefq = (const unsigned*)(ws + OFF_COEFQ); const float* sc = (const float*)(ws + OFF_SC); const unsigned char* PV = ws + OFF_PV; float* Y = (float*)(ws + OFF_Y);
    const bool b5 = (lane & 32) != 0, b4 = (lane & 16) != 0, b3 = (lane & 8) != 0; const int c0 = (b5 ? 8 : 0) + (b4 ? 4 : 0) + (b3 ? 2 : 0);
    const int tstep = ncu * NWAVES; int t = cu * NWAVES + wv;
    if (t >= T) return;
    const int tlast = t;
    int el0, eh0, el1, eh1; unsigned cq0[4], cq1[4];
    PV_META(t, el0, eh0, cq0); PV_META(t + tstep, el1, eh1, cq1);
    uint4 wA[16], wB[16];
    PV_ISSUE16(wA, el0, eh0);
    for (;;) {
        { unsigned cc[4] = {cq0[0], cq0[1], cq0[2], cq0[3]}; PV_META(t + 2 * tstep, el0, eh0, cq0); PV_ISSUE16(wB, el1, eh1); PV_TOKEN(wA, cc, t); }
        t += tstep; if (t >= T) break;
        { unsigned cc[4] = {cq1[0], cq1[1], cq1[2], cq1[3]}; PV_META(t + 2 * tstep, el1, eh1, cq1); PV_ISSUE16(wA, el0, eh0); PV_TOKEN(wB, cc, t); }
        t += tstep; if (t >= T) break;
    }
}
__device__ __forceinline__ void ph_peer_ln2(const Params& p, int wv) {
    PH_IDS(); unsigned char* ws = p.ws; const float* Y = (const float*)(ws + OFF_Y);
    for (int t = gwave; t < T; t += nwaves) {
        float y[16]; float* row = p.out + (size_t)t * 1024 + lane * 16; const float* yr = Y + (size_t)t * 1024 + lane * 16; float s = 0.f;
#pragma unroll
        for (int i = 0; i < 4; ++i) { const float4 a = *(const float4*)(row + 4 * i), c = *(const float4*)(yr + 4 * i); y[4 * i] = c.x + DN_ALPHA * a.x; y[4 * i + 1] = c.y + DN_ALPHA * a.y; y[4 * i + 2] = c.z + DN_ALPHA * a.z; y[4 * i + 3] = c.w + DN_ALPHA * a.w; }
#pragma unroll
        for (int i = 0; i < 16; ++i) s += y[i];
        const float mu = wave_sum(s) * (1.0f / 1024.0f); float s2 = 0.f;
#pragma unroll
        for (int i = 0; i < 16; ++i) { y[i] -= mu; s2 += y[i] * y[i]; }
        const float rstd = rsqrtf(wave_sum(s2) * (1.0f / 1024.0f) + LN_EPS);
#pragma unroll
        for (int i = 0; i < 4; ++i) { const int c = lane * 16 + 4 * i; const float4 ga = *(const float4*)(p.ln2_g + c), ba = *(const float4*)(p.ln2_b + c);
            float4 o; o.x = y[4 * i] * rstd * ga.x + ba.x; o.y = y[4 * i + 1] * rstd * ga.y + ba.y; o.z = y[4 * i + 2] * rstd * ga.z + ba.z; o.w = y[4 * i + 3] * rstd * ga.w + ba.w;
            *(float4*)(row + 4 * i) = o; }
    }
}

#define LAS __attribute__((address_space(3)))
#define XB_TMO      128
#define XB_XCNT(j)  (256  + 64 * (j))
#define XB_XSUB(j)  (1280 + 64 * (j))
#define XB_XGEN(j)  (2304 + 64 * (j))
#define XB_TOP      3328
#define XB_TOPGEN   3392
#define XCD_BAR_WORDS 3456
#define XB_SPIN_CAP (1u << 18)

__device__ __forceinline__ unsigned xb_ld(unsigned* p)              { return __hip_atomic_load(p, __ATOMIC_RELAXED, __HIP_MEMORY_SCOPE_AGENT); }
__device__ __forceinline__ unsigned xb_add(unsigned* p, unsigned v) { return __hip_atomic_fetch_add(p, v, __ATOMIC_RELAXED, __HIP_MEMORY_SCOPE_AGENT); }
__device__ __forceinline__ unsigned xb_xcc_id() { return (unsigned)__builtin_amdgcn_s_getreg((3 << 11) | 20) & 0xFu; }
#define XB_SPIN(cond, bar) do { unsigned _sp = 0; while (cond) { __builtin_amdgcn_s_sleep(1); \
    if ((++_sp & 255u) == 0u) { if (xb_ld(&(bar)[XB_TMO])) break; if (_sp > XB_SPIN_CAP) { atomicAdd(&(bar)[XB_TMO], 1u); break; } } } } while (0)

struct XcdBarrier {
    unsigned* bar; unsigned x;
    volatile LAS unsigned* st;
};

__device__ __forceinline__ XcdBarrier xcd_barrier_post(unsigned* bar, volatile LAS unsigned* st, bool leader) {
    XcdBarrier b; b.bar = bar; b.x = xb_xcc_id(); b.st = st;
    if (leader) (void)xb_add(&bar[XB_XCNT(b.x)], 1u);
    return b;
}
__device__ __forceinline__ void xcd_barrier_complete(unsigned* bar, unsigned x, unsigned& nloc, unsigned& nx) {
    const unsigned G = gridDim.x * gridDim.y * gridDim.z;
    unsigned sum, cnt, mine, sp = 0u;
    for (;;) {
        sum = 0u; cnt = 0u; mine = 0u;
#pragma unroll
        for (unsigned j = 0; j < 16; ++j) { const unsigned c = xb_ld(&bar[XB_XCNT(j)]); sum += c; cnt += (c > 0u) ? 1u : 0u; mine = (j == x) ? c : mine; }
        if (sum == G) break;
        __builtin_amdgcn_s_sleep(1);
        if ((++sp & 255u) == 0u) { if (xb_ld(&bar[XB_TMO])) break; if (sp > XB_SPIN_CAP) { atomicAdd(&bar[XB_TMO], 1u); break; } }
    }
    nloc = mine > 0u ? mine : 1u; nx = cnt > 0u ? cnt : 1u;
}

__device__ __forceinline__ void xcd_barrier(const XcdBarrier& b, bool leader) {
    asm volatile("s_waitcnt vmcnt(0)" ::: "memory");
    __syncthreads();
    if (leader) {
        unsigned* bar = b.bar;
        __builtin_amdgcn_s_waitcnt(0);
        unsigned nloc = b.st[0], nx = b.st[1];
        if (nloc == 0u) { xcd_barrier_complete(bar, b.x, nloc, nx); b.st[0] = nloc; b.st[1] = nx; }
        const unsigned old = xb_add(&bar[XB_XSUB(b.x)], 1u);
        const unsigned gen = old / nloc;
        if (old + 1u == (gen + 1u) * nloc) {
            __builtin_amdgcn_fence(__ATOMIC_RELEASE, "agent");
            asm volatile("s_waitcnt vmcnt(0)" ::: "memory");
            const unsigned og = xb_add(&bar[XB_TOP], 1u);
            const unsigned tg = og / nx;
            if (og + 1u == (tg + 1u) * nx) xb_add(&bar[XB_TOPGEN], 1u);
            else XB_SPIN(xb_ld(&bar[XB_TOPGEN]) == tg, bar);
            __builtin_amdgcn_fence(__ATOMIC_ACQUIRE, "agent");
            xb_add(&bar[XB_XGEN(b.x)], 1u);
            asm volatile("s_waitcnt vmcnt(0)" ::: "memory");
        } else {
            XB_SPIN(xb_ld(&bar[XB_XGEN(b.x)]) == gen, bar);
            __builtin_amdgcn_fence(__ATOMIC_ACQUIRE, "agent");
            asm volatile("s_waitcnt vmcnt(0)" ::: "memory");
        }
    }
    __syncthreads();
}

#ifndef TIMING_BOUNDARY
#define TIMING_BOUNDARY -1
#endif
#define TPROBE(k) do { if (TIMING_BOUNDARY == (k)) { const unsigned long long t1_ = __builtin_amdgcn_s_memrealtime(); while (__builtin_amdgcn_s_memrealtime() - t1_ < t1_ - tstart_) __builtin_amdgcn_s_sleep(8); } } while (0)
__global__ void __launch_bounds__(NTHREADS) fwd_megakernel(Params p) {
    extern __shared__ __attribute__((aligned(16))) unsigned char lds[];
    cg::grid_group grid = cg::this_grid();
    const int nb = gridDim.x, bid = blockIdx.x;
    const int wv = __builtin_amdgcn_readfirstlane(threadIdx.x >> 6);
    unsigned char* ws = p.ws;
    const unsigned long long tstart_ = (TIMING_BOUNDARY >= 0) ? __builtin_amdgcn_s_memrealtime() : 0ull; (void)tstart_;
    PG8_LAS unsigned char* ldsp = (PG8_LAS unsigned char*)lds;
    const bool leader = (wv == 0) && (lane_id() == 0);
    volatile LAS unsigned* bst = (volatile LAS unsigned*)(ldsp + LDS_BYTES - 64);
    if (leader) { bst[0] = 0u; bst[1] = 0u; }
    __syncthreads();
    const XcdBarrier xbar = xcd_barrier_post((unsigned*)(ws + OFF_BAR), bst, leader);

    ph_prep(p, wv, lds);
    if (p.ws == nullptr) grid.sync();
    xcd_barrier(xbar, leader);
    TPROBE(0);
    {
        pg8::Gemm g{(const bf16*)(ws + OFF_XB), (const bf16*)(ws + OFF_WIN), T, NPROJ_PAD, 1024, 1024, 0, 1 << 30, 0l};
        pg8::StaticOrder S; S.init(T, NPROJ_PAD, nb, bid);
        pg8::EpiInProjPg E{(bf16*)(ws + OFF_Z), (bf16*)(ws + OFF_XBC), (bf16*)(ws + OFF_Q), (bf16*)(ws + OFF_KVS), (bf16*)(ws + OFF_DTG)};
        pg8::gemm_phase<pg8::EpiInProjPg, pg8::StaticOrder, pg8::NoMid, true, true>(wv, ldsp, g, S, E, pg8::NoMid{});
    }
    xcd_barrier(xbar, leader);
    TPROBE(1);
    if (bid < 32) {
        const bool isv = bid >= 16;
        pg8::Gemm g{(const bf16*)(ws + OFF_KVS) + (isv ? 256 : 0), (const bf16*)(ws + (isv ? OFF_W1V : OFF_W1K)), 4096, 256, 2048, 0, 1, 1 << 30, 0l};
        pg8::StaticOrder S; S.init(4096, 256, 16, isv ? bid - 16 : bid);
        pg8::EpiBf16<1> E{(bf16*)(ws + OFF_HID + (isv ? 2 * MiB : 0)), 256, (const float*)(ws + (isv ? OFF_B1V : OFF_B1K)), 0, 0, 1.f};
        pg8::gemm_phase<pg8::EpiBf16<1>, pg8::StaticOrder, pg8::NoMid, true, true>(wv, ldsp, g, S, E, pg8::NoMid{});
    }
    else ph_tokprep(p, wv);
    xcd_barrier(xbar, leader);
    TPROBE(2);
    ph_ssd_prep2(p, wv, lds);
    ph_vt_prep(p, wv);
    xcd_barrier(xbar, leader);
    TPROBE(3);
    {
        RowMajorBf16 ak{(const bf16*)(ws + OFF_HID), 256}, av{(const bf16*)(ws + OFF_HID + 2 * MiB), 256};
        RowMajorBf16 bk{(const bf16*)(ws + OFF_W2K), 256}, bv{(const bf16*)(ws + OFF_W2V), 256};
        EpiKc ek{(bf16*)(ws + OFF_KC), false}, ev{(bf16*)(ws + OFF_VCT), true};
        gemm_wave32(wv, 4096 / 32, 64 / 32, 256, ak, bk, ek);
        gemm_wave32(wv, 4096 / 32, 64 / 32, 256, av, bv, ev);
    }
    ph_ssd_states(p, wv);
    xcd_barrier(xbar, leader);
    TPROBE(4);
    ph_kc_rope(p, wv);
    ph_ssd_scan(p, wv);
    ph_peer_cvt(p, wv);
    xcd_barrier(xbar, leader);
    TPROBE(5);
    ph_ssd_out(p, wv, lds);
    ph_nsa(p, wv, lds);
    xcd_barrier(xbar, leader);
    TPROBE(6);
    {
        pg8::Gemm g{(const bf16*)(ws + OFF_Q), (const bf16*)(ws + OFF_WOUT), T, 1024, 2048, 1024, 0, 16, (long)OFF_Z - (long)OFF_Q - 16l * 128l};
        pg8::StaticOrder S; S.init(T, 1024, nb, bid);
        pg8::RmsFactors rf{(const float*)(ws + OFF_SSQ), (const float*)(ws + OFF_HID), RMS_EPS};
        pg8::EpiOutProj E{p.x, p.out, DN_ALPHA, rf}; pg8::MidRmsScale MH{rf};
        pg8::gemm_phase<pg8::EpiOutProj, pg8::StaticOrder, pg8::MidRmsScale, true, true>(wv, ldsp, g, S, E, MH);
    }
    xcd_barrier(xbar, leader);
    TPROBE(7);
    ph_ln1(p, wv);
    xcd_barrier(xbar, leader);
    TPROBE(8);
    {
        pg8::Gemm g{(const bf16*)(ws + OFF_H1B), (const bf16*)(ws + OFF_WQ), T, 2048, 1024, 1024, 0, 1 << 30, 0l};
        pg8::StaticOrder S; S.init(T, 2048, nb, bid);
        pg8::EpiBf16<0> E{(bf16*)(ws + OFF_QP), 2048, nullptr, 0, 0, 1.f};
        pg8::gemm_phase<pg8::EpiBf16<0>, pg8::StaticOrder, pg8::NoMid, true, true>(wv, ldsp, g, S, E, pg8::NoMid{});
    }
    xcd_barrier(xbar, leader);
    TPROBE(9);
    ph_peer_topk(p, wv, lds);
    xcd_barrier(xbar, leader);
    TPROBE(10);
    ph_peer_u(p, wv);
    xcd_barrier(xbar, leader);
    TPROBE(11);
    ph_peer_c(p, wv);
    xcd_barrier(xbar, leader);
    TPROBE(12);
    ph_peer_v(p, wv);
    xcd_barrier(xbar, leader);
    TPROBE(13);
    ph_peer_ln2(p, wv);
}

extern "C" void kernel_launch(void* const* d_in, const int* in_sizes, int n_in, void* d_out, int out_size, void* d_ws, size_t ws_size, hipStream_t stream) {
    static int grid_blocks = 0;
    if (!grid_blocks) {
        int dev = 0, cus = 0, per_cu = 0;
        hipGetDevice(&dev);
        hipDeviceGetAttribute(&cus, hipDeviceAttributeMultiprocessorCount, dev);
        hipFuncSetAttribute((const void*)fwd_megakernel, hipFuncAttributeMaxDynamicSharedMemorySize, LDS_BYTES);
        hipOccupancyMaxActiveBlocksPerMultiprocessor(&per_cu, fwd_megakernel, NTHREADS, LDS_BYTES);
        if (per_cu < 1) per_cu = 1;
        if (per_cu > 1) per_cu = 1;
        grid_blocks = cus * per_cu;
        if (ws_size < 244 * MiB) fprintf(stderr, "kernel_launch: workspace too small: %zu\n", ws_size);
    }
    Params p{};
    const float** pp = (const float**)&p;
    for (int i = 0; i < 24; ++i) pp[i] = (const float*)d_in[i];
    p.out = (float*)d_out; p.ws = (unsigned char*)d_ws;
    (void)hipMemsetAsync((unsigned char*)d_ws + OFF_BAR, 0, BAR_BYTES, stream);
    void* args[] = {&p};
    hipError_t e = hipLaunchCooperativeKernel((void*)fwd_megakernel, dim3(grid_blocks), dim3(NTHREADS), args, LDS_BYTES, stream);
    if (e != hipSuccess) fprintf(stderr, "cooperative launch failed: %s (grid %d)\n", hipGetErrorString(e), grid_blocks);
}
```

```cpp
#include <hip/hip_runtime.h>
#include <hip/hip_cooperative_groups.h>
#include <cstdio>
#include <cstdint>
namespace cg = cooperative_groups;

typedef unsigned short bf16;
typedef short bf16x8 __attribute__((ext_vector_type(8)));
typedef float f32x4 __attribute__((ext_vector_type(4)));
typedef float f32x16 __attribute__((ext_vector_type(16)));
typedef unsigned long long u64;

constexpr int T = 16384, L = 4096, NBATCH = 4, D = 1024;
constexpr int NPROJ = 5184, NPROJ_PAD = 5376;
constexpr int NTHREADS = 512, NWAVES = 8;
constexpr float LN_EPS = 1e-5f, RMS_EPS = 1e-5f;
constexpr float DN_ALPHA = 1.189207115002721f;
constexpr float NEG_INF = -1e30f, BIG = 1e30f;

constexpr size_t MiB = 1u << 20;
constexpr size_t OFF_SSQ = 0, OFF_BAR = 512 * 1024, BAR_BYTES = 16384;
constexpr size_t OFF_WOUT = 1 * MiB, OFF_WQ = 5 * MiB, OFF_W1K = 9 * MiB, OFF_W1V = 10 * MiB;
constexpr size_t OFF_W2K = 11 * MiB, OFF_W2V = 11 * MiB + 65536, OFF_B1K = 11 * MiB + 131072, OFF_B1V = 11 * MiB + 131072 + 4096;
constexpr size_t OFF_KEYS = 12 * MiB, OFF_ROPE = 13 * MiB, OFF_DT = 14 * MiB, OFF_ACS = 15 * MiB, OFF_GATE = 16 * MiB;
constexpr size_t OFF_HID = 20 * MiB, OFF_KC = 24 * MiB;
constexpr size_t OFF_Z = 26 * MiB, OFF_Q = 58 * MiB, OFF_KVS = 90 * MiB, OFF_XBC = 138 * MiB, OFF_XSBC = 186 * MiB, OFF_BT = 234 * MiB, OFF_DTG = 242 * MiB;
constexpr size_t OFF_VST = 138 * MiB, OFF_VWT = 146 * MiB, OFF_VCT = 19 * MiB;
constexpr size_t OFF_XB = 186 * MiB, OFF_WIN = 218 * MiB;
constexpr size_t OFF_H1B = 90 * MiB, OFF_QP = 26 * MiB, OFF_EIDX = 202 * MiB, OFF_GW = 210 * MiB;
constexpr size_t OFF_PU = 154 * MiB, OFF_PV = 170 * MiB;
constexpr int LDS_BYTES = 147456;

struct Params {
    const float *x, *w_in, *conv_w, *conv_b, *dt_bias, *a_log, *d_skip, *ssd_norm_w;
    const float *cmp_pos_k, *cmp_w1_k, *cmp_w2_k, *cmp_pos_v, *cmp_w1_v, *cmp_w2_v;
    const float *attn_norm_w, *w_out, *ln1_g, *ln1_b, *peer_wq, *peer_keys, *peer_u, *peer_v, *ln2_g, *ln2_b;
    float* out; unsigned char* ws;
};

__device__ __forceinline__ float bf2f(bf16 v) { return __uint_as_float((unsigned)v << 16); }
__device__ __forceinline__ bf16 f2bf(float f) { unsigned u = __float_as_uint(f); return (bf16)((u + 0x7fffu + ((u >> 16) & 1u)) >> 16); }
__device__ __forceinline__ int lane_id() { int l = (int)__builtin_amdgcn_mbcnt_hi(~0u, __builtin_amdgcn_mbcnt_lo(~0u, 0u)); asm volatile("" : "+v"(l)); return l; }
#define PH_IDS() const int lane = lane_id(); const int tid = (wv << 6) | lane; const int bid = blockIdx.x, nb = gridDim.x; const int gtid = bid * NTHREADS + tid, gn = nb * NTHREADS; const int gwave = bid * NWAVES + wv, nwaves = nb * NWAVES; (void)gtid; (void)gn; (void)gwave; (void)nwaves;
typedef float f32x2v __attribute__((ext_vector_type(2)));
typedef __bf16 bf16x2v __attribute__((ext_vector_type(2)));
__device__ __forceinline__ unsigned pk2bf(float lo, float hi) { f32x2v v = {lo, hi}; bf16x2v b = __builtin_convertvector(v, bf16x2v); return __builtin_bit_cast(unsigned, b); }
__device__ __forceinline__ float bflo(unsigned w) { return __uint_as_float(w << 16); }
__device__ __forceinline__ float bfhi(unsigned w) { return __uint_as_float(w & 0xffff0000u); }
__device__ __forceinline__ float wave_sum(float v) {
#pragma unroll
    for (int o = 1; o < 64; o <<= 1) v += __shfl_xor(v, o);
    return v;
}
__device__ __forceinline__ float wave_max(float v) {
#pragma unroll
    for (int o = 1; o < 64; o <<= 1) v = fmaxf(v, __shfl_xor(v, o));
    return v;
}
__device__ __forceinline__ float gelu_exact(float v) { return 0.5f * v * (1.0f + erff(v * 0.7071067811865476f)); }
__device__ __forceinline__ float sigmoidf(float v) { return 1.0f / (1.0f + __expf(-v)); }

template <class AP, class BP, class EP>
__device__ __forceinline__ void gemm_wave32(int wv, int Mt, int Nt, int K, const AP& ap, const BP& bp, const EP& ep) {
    PH_IDS(); const int r = lane & 15, q = lane >> 4;
    for (int tile = gwave; tile < Mt * Nt; tile += nwaves) {
        const int tm = tile / Nt, tn = tile % Nt, row0 = tm * 32, col0 = tn * 32;
        f32x4 acc[2][2];
#pragma unroll
        for (int i = 0; i < 2; ++i)
#pragma unroll
            for (int j = 0; j < 2; ++j) acc[i][j] = (f32x4){0.f, 0.f, 0.f, 0.f};
        for (int k0 = 0; k0 < K; k0 += 32) {
            const bf16x8 a0 = ap(row0 + r, k0 + 8 * q), a1 = ap(row0 + 16 + r, k0 + 8 * q);
            const bf16x8 b0 = bp(col0 + r, k0 + 8 * q), b1 = bp(col0 + 16 + r, k0 + 8 * q);
            acc[0][0] = __builtin_amdgcn_mfma_f32_16x16x32_bf16(a0, b0, acc[0][0], 0, 0, 0);
            acc[0][1] = __builtin_amdgcn_mfma_f32_16x16x32_bf16(a0, b1, acc[0][1], 0, 0, 0);
            acc[1][0] = __builtin_amdgcn_mfma_f32_16x16x32_bf16(a1, b0, acc[1][0], 0, 0, 0);
            acc[1][1] = __builtin_amdgcn_mfma_f32_16x16x32_bf16(a1, b1, acc[1][1], 0, 0, 0);
        }
#pragma unroll
        for (int i = 0; i < 2; ++i)
#pragma unroll
            for (int j = 0; j < 2; ++j)
#pragma unroll
                for (int e = 0; e < 4; ++e) ep(row0 + 16 * i + 4 * q + e, col0 + 16 * j + r, acc[i][j][e]);
    }
}
struct RowMajorBf16 { const bf16* p; int ld; __device__ __forceinline__ bf16x8 operator()(int row, int k) const { return *(const bf16x8*)(p + (size_t)row * ld + k); } };

namespace pg8 {
#define PG8_LAS __attribute__((address_space(3)))
typedef unsigned short bf16_t;
typedef short bf16x8 __attribute__((ext_vector_type(8)));
typedef float f32x4 __attribute__((ext_vector_type(4)));
typedef unsigned u32x4 __attribute__((ext_vector_type(4)));
constexpr int BM = 256, BK = 64, HALF = 128, HTB = HALF * BK * 2  , STAGE_BYTES = 8 * HTB, NXCD = 8, WGM = 8;

__host__ __device__ __forceinline__ int lds_byte(int r, int c) { const int st = (r >> 4) * 2 + (c >> 5), rr = r & 15, cc = c & 31, ob = rr * 64 + cc * 2; return st * 1024 + (ob ^ (((ob >> 9) & 1) << 5)); }
__host__ __device__ __forceinline__ void stage_rc(int b, int& R, int& C) { const int st = b / 1024, sb = b % 1024, swz = sb ^ (((sb >> 9) & 1) << 5); R = (st >> 1) * 16 + swz / 64; C = (st & 1) * 32 + (swz % 64) / 2; }
__host__ __device__ __forceinline__ int perm32(int rho) { const int n = rho >> 4, i = rho & 15; return 8 * (i >> 2) + 4 * n + (i & 3); }

struct Unit { int pm, pn; };
struct Gemm { const bf16_t* A; const bf16_t* Bt; int M, N, K; int lda; int amode; int ksplit; long kdelta; };

struct StaticOrder {
    int nM, nN, nwg, G, c;
    __host__ __device__ void init(int M, int N, int G_, int c_) { nM = M / BM; nN = N / BM; nwg = nM * nN; G = G_; c = c_; }
    __host__ __device__ bool next(int i, Unit& u) const {
        const long L = (long)i * G + c; if (L >= nwg) return false;
        int wgid = (int)L; { const int q = nwg / NXCD, r = nwg % NXCD, xcd = wgid % NXCD, off = wgid / NXCD; wgid = (xcd < r ? xcd * (q + 1) : r * (q + 1) + (xcd - r) * q) + off; }
        const int nig = WGM * nN, gid = wgid / nig, fm = gid * WGM, gsz = (nM - fm) < WGM ? (nM - fm) : WGM;
        u.pm = fm + ((wgid % nig) % gsz); u.pn = (wgid % nig) / gsz; return true;
    }
    __device__ __forceinline__ void a_ready(const Unit&) const {}
    __device__ __forceinline__ void done(const Unit&) const {}
};


__device__ __forceinline__ unsigned cvt_pk_bf16(float lo, float hi) { unsigned r; asm volatile("v_cvt_pk_bf16_f32 %0, %1, %2" : "=v"(r) : "v"(lo), "v"(hi)); return r; }
typedef float f32x2 __attribute__((ext_vector_type(2)));
__device__ __forceinline__ f32x2 gelu_pk(f32x2 v) {
    const f32x2 av = __builtin_elementwise_abs(v), d = av * 0.2316418882f + 1.0f;
    f32x2 t; t.x = __builtin_amdgcn_rcpf(d.x); t.y = __builtin_amdgcn_rcpf(d.y);
    f32x2 q = t * 0.5307027145f + (-0.7265760135f); q = q * t + 0.7107068705f; q = q * t + (-0.142248368f); q = q * t + 0.127414796f; q = q * t;
    const f32x2 s = (v * v) * (-0.72134752044f);
    f32x2 e; e.x = __builtin_amdgcn_exp2f(s.x); e.y = __builtin_amdgcn_exp2f(s.y);
    const f32x2 m = v * (q * e), r = v - m;
    f32x2 o; o.x = v.x < 0.f ? m.x : r.x; o.y = v.y < 0.f ? m.y : r.y; return o;
}

template <int ACT  > struct EpiBf16 {
    static constexpr bool PERM = true, AFTER_DRAIN = false; static_assert(ACT == 0 || ACT == 1, "EpiBf16: ACT is 0 (none) or 1 (gelu_pk)");
    bf16_t* O; int ldc; const float* bias; int split_cols; size_t split_stride; float scale0;
    __device__ __forceinline__ void operator()(const f32x4 (&acc)[2][2][4][2], const Unit& u, int wr, int wc, int fr, int fq) const {
        const int row0 = u.pm * BM + wr * 64 + fr; int colt = u.pn * BM; bf16_t* base = O;
        float sc = 1.f; if (split_cols) { const int t = colt / split_cols; base += (size_t)t * split_stride; colt -= t * split_cols; if (t == 0) sc = scale0; }
        const int col0 = colt + wc * 32 + 8 * fq, bcol0 = u.pn * BM + wc * 32 + 8 * fq;
        f32x4 bv[2][2];
#pragma unroll
        for (int bj = 0; bj < 2; ++bj)
#pragma unroll
            for (int n = 0; n < 2; ++n) bv[bj][n] = bias ? *(const f32x4*)(bias + bcol0 + bj * HALF + 4 * n) : (f32x4){0.f, 0.f, 0.f, 0.f};
#pragma unroll
        for (int ai = 0; ai < 2; ++ai)
#pragma unroll
            for (int m = 0; m < 4; ++m) { bf16_t* rowp = base + (size_t)(row0 + ai * HALF + m * 16) * ldc + col0;
#pragma unroll
                for (int bj = 0; bj < 2; ++bj) { f32x4 v0 = acc[ai][bj][m][0] + bv[bj][0], v1 = acc[ai][bj][m][1] + bv[bj][1];
                    if (ACT == 1) { f32x2 a = gelu_pk((f32x2){v0[0], v0[1]}), b = gelu_pk((f32x2){v0[2], v0[3]}), c = gelu_pk((f32x2){v1[0], v1[1]}), d = gelu_pk((f32x2){v1[2], v1[3]});
                        v0 = (f32x4){a.x, a.y, b.x, b.y}; v1 = (f32x4){c.x, c.y, d.x, d.y}; }
                    v0 = v0 * sc; v1 = v1 * sc; u32x4 w; w.x = cvt_pk_bf16(v0[0], v0[1]); w.y = cvt_pk_bf16(v0[2], v0[3]); w.z = cvt_pk_bf16(v1[0], v1[1]); w.w = cvt_pk_bf16(v1[2], v1[3]);
                    *(u32x4*)(rowp + bj * HALF) = w; } }
    }
};

struct EpiInProjPg { static constexpr bool PERM = true, AFTER_DRAIN = false;
    bf16_t *z, *xbc, *q, *kvs, *dtg;
    __device__ __forceinline__ void operator()(const f32x4 (&acc)[2][2][4][2], const Unit& u, int wr, int wc, int fr, int fq) const {
        bf16_t* base; int ldc, colt; const int pn = u.pn;
        if (pn < 4) { base = z; ldc = 1024; colt = pn * 256; } else if (pn < 10) { base = xbc; ldc = 1536; colt = (pn - 4) * 256; }
        else if (pn < 14) { base = q; ldc = 1024; colt = (pn - 10) * 256; } else if (pn < 20) { base = kvs; ldc = 1536; colt = (pn - 14) * 256; }
        else { base = dtg; ldc = 64; colt = 0; }
        const int row0 = u.pm * BM + wr * 64 + fr, col0 = colt + wc * 32 + 8 * fq;
#pragma unroll
        for (int ai = 0; ai < 2; ++ai)
#pragma unroll
            for (int m = 0; m < 4; ++m) { bf16_t* rowp = base + (size_t)(row0 + ai * HALF + m * 16) * ldc + col0;
#pragma unroll
                for (int bj = 0; bj < 2; ++bj) { const f32x4 v0 = acc[ai][bj][m][0], v1 = acc[ai][bj][m][1];
                    u32x4 w; w.x = cvt_pk_bf16(v0[0], v0[1]); w.y = cvt_pk_bf16(v0[2], v0[3]); w.z = cvt_pk_bf16(v1[0], v1[1]); w.w = cvt_pk_bf16(v1[2], v1[3]);
                    if (pn < 20 || (bj == 0 && wc < 2)) *(u32x4*)(rowp + bj * HALF) = w; } }
    }
};
struct RmsFactors { const float* ssqp; const float* ssq2p; float eps;
    __device__ __forceinline__ void get(int row, float& ra, float& r0, float& r1) const {
        const f32x4 a = *(const f32x4*)(ssqp + 4 * row); const f32x4 b0 = *(const f32x4*)(ssq2p + 16 * row), b1 = *(const f32x4*)(ssq2p + 16 * row + 4), b2 = *(const f32x4*)(ssq2p + 16 * row + 8), b3 = *(const f32x4*)(ssq2p + 16 * row + 12);
        ra = rsqrtf(((a[0] + a[1]) + (a[2] + a[3])) * (1.0f / 1024.0f) + eps);
        r0 = rsqrtf((((b0[0] + b0[1]) + (b0[2] + b0[3])) + ((b1[0] + b1[1]) + (b1[2] + b1[3]))) * (1.0f / 512.0f) + eps);
        r1 = rsqrtf((((b2[0] + b2[1]) + (b2[2] + b2[3])) + ((b3[0] + b3[1]) + (b3[2] + b3[3]))) * (1.0f / 512.0f) + eps); } };
struct EpiOutProj { static constexpr bool PERM = false, AFTER_DRAIN = false;
    const float* x; float* out; float alpha; RmsFactors rf;
    __device__ __forceinline__ void operator()(const f32x4 (&acc)[2][2][4][2], const Unit& u, int wr, int wc, int fr, int fq) const {
        const int col0 = u.pn * BM + wc * 32 + 4 * fq;
#pragma unroll
        for (int ai = 0; ai < 2; ++ai)
#pragma unroll
            for (int m = 0; m < 4; ++m) { const int row = u.pm * BM + ai * HALF + wr * 64 + m * 16 + fr; const size_t off = (size_t)row * 1024 + col0;
                float ra, r0, r1; rf.get(row, ra, r0, r1);
#pragma unroll
                for (int bj = 0; bj < 2; ++bj)
#pragma unroll
                    for (int n = 0; n < 2; ++n) { const size_t o = off + bj * HALF + n * 16; const f32x4 xv = *(const f32x4*)(x + o); *(f32x4*)(out + o) = xv * alpha + acc[ai][bj][m][n] * r1; } }
    }
};
struct MidRmsScale { static constexpr bool ENABLED = true; RmsFactors rf;
    __device__ __forceinline__ void operator()(f32x4 (&acc)[2][2][4][2], const Unit& u, int t, int wr, int wc, int fr, int fq) const {
        if (t != 16 && t != 24) return;
        int rowb = u.pm * BM + wr * 64 + fr; asm volatile("" : "+v"(rowb));
#pragma unroll
        for (int ai = 0; ai < 2; ++ai)
#pragma unroll
            for (int m = 0; m < 4; ++m) { float ra, r0, r1; rf.get(rowb + ai * HALF + m * 16, ra, r0, r1);
                const float sc = (t == 16) ? ra / r0 : r0 / r1;
#pragma unroll
                for (int bj = 0; bj < 2; ++bj)
#pragma unroll
                    for (int n = 0; n < 2; ++n) acc[ai][bj][m][n] = acc[ai][bj][m][n] * sc; }
    }
};
struct NoMid { static constexpr bool ENABLED = false; template <class ACC> __device__ __forceinline__ void operator()(ACC&, const Unit&, int, int, int, int, int) const {} };
template <class Epi, class Sched, class Mid, bool ALIGN_EPI = false, bool SP2 = false>
__device__ __forceinline__ void gemm_phase(int wv, PG8_LAS unsigned char* lds, const Gemm g, const Sched& S, const Epi& E, const Mid& MH) {
    int lane_ = (int)__builtin_amdgcn_mbcnt_hi(~0u, __builtin_amdgcn_mbcnt_lo(~0u, 0u)); asm volatile("" : "+v"(lane_));
    const int lane = lane_, wid = wv, tid = (wv << 6) | lane, wr = wid >> 2, wc = wid & 3, fr = lane & 15, fq = lane >> 4;
    const int K = g.K, nt = K / BK;
    unsigned voffA[2], voffB[2];
#pragma unroll
    for (int i = 0; i < 2; ++i) { int R, C; stage_rc(tid * 16 + i * 8192, R, C); const int Rb = Epi::PERM ? ((R & ~31) + perm32(R & 31)) : R;
        voffA[i] = g.amode == 0 ? (unsigned)(R * g.lda + C) * 2u : (unsigned)((R >> 2) * 49152 + (R & 3) * 128 + C * 2); voffB[i] = (unsigned)(Rb * K + C) * 2u; }
    const size_t kstep = (size_t)(BK * 2);
    const size_t hstep = (size_t)HALF * K * 2;
    const size_t tstep = 2 * hstep;
    const size_t kstepA = g.amode == 0 ? (size_t)(BK * 2) : (size_t)3072;
    const size_t hstepA = g.amode == 0 ? (size_t)HALF * g.lda * 2 : (size_t)32 * 49152;
    const size_t tstepA = 2 * hstepA;
#define PG8_AK(base, t) ((base) + (size_t)(t) * kstepA + (((t) >= g.ksplit) ? g.kdelta : 0l))
    const unsigned ldsw = (unsigned)wid * 1024u;
    const int aoff = lds_byte(wr * 64 + fr, fq * 8), boff = lds_byte(wc * 32 + fr, fq * 8);
#define PG8_SA(b, h) (((b) * 2 + (h)) * HTB)
#define PG8_SB(b, h) ((4 + (b) * 2 + (h)) * HTB)
#define PG8_STAGE(bufoff, gbase, voff) do { _Pragma("unroll") for (int _i = 0; _i < 2; ++_i) \
        __builtin_amdgcn_global_load_lds((const unsigned*)((const char*)(gbase) + (voff)[_i]), (PG8_LAS unsigned*)(lds + (bufoff) + ldsw + _i * 8192), 16, 0, 0); } while (0)
#define PG8_LDA(dst, b, h) do { _Pragma("unroll") for (int m = 0; m < 4; ++m) _Pragma("unroll") for (int k = 0; k < 2; ++k) dst[m][k] = *(const PG8_LAS bf16x8*)(lds + PG8_SA(b, h) + aoff + m * 2048 + k * 1024); } while (0)
#define PG8_LDB(dst, b, h) do { _Pragma("unroll") for (int n = 0; n < 2; ++n) _Pragma("unroll") for (int k = 0; k < 2; ++k) dst[n][k] = *(const PG8_LAS bf16x8*)(lds + PG8_SB(b, h) + boff + n * 2048 + k * 1024); } while (0)
#define PG8_MMA(ai, bj, At, Bt) do { __builtin_amdgcn_s_setprio(1); _Pragma("unroll") for (int m = 0; m < 4; ++m) _Pragma("unroll") for (int n = 0; n < 2; ++n) _Pragma("unroll") for (int k = 0; k < 2; ++k) \
        acc[ai][bj][m][n] = __builtin_amdgcn_mfma_f32_16x16x32_bf16(Bt[n][k], At[m][k], acc[ai][bj][m][n], 0, 0, 0); __builtin_amdgcn_s_setprio(0); } while (0)
#define PG8_WAIT_V(n) asm volatile("s_waitcnt vmcnt(" #n ")" ::: "memory")
#define PG8_WAIT_L(n) asm volatile("s_waitcnt lgkmcnt(" #n ")" ::: "memory")
#define PG8_BAR __builtin_amdgcn_s_barrier()
#define PG8_SCHED __builtin_amdgcn_sched_barrier(0)
    Unit cur, nxt; int ui = 0;
    if (!S.next(0, cur)) return;
    f32x4 acc[2][2][4][2];
#pragma unroll
    for (int a = 0; a < 2; ++a)
#pragma unroll
        for (int b = 0; b < 2; ++b)
#pragma unroll
            for (int m = 0; m < 4; ++m)
#pragma unroll
                for (int n = 0; n < 2; ++n) acc[a][b][m][n] = (f32x4){0.f, 0.f, 0.f, 0.f};
    bf16x8 At[4][2], B0[2][2], B1[2][2];
    const char* cA = (const char*)g.A + (size_t)cur.pm * tstepA; const char* cB = (const char*)g.Bt + (size_t)cur.pn * tstep;
    S.a_ready(cur);
    if constexpr (SP2) {
        PG8_STAGE(PG8_SB(0, 0), cB, voffB); PG8_STAGE(PG8_SB(0, 1), cB + hstep, voffB); PG8_STAGE(PG8_SA(0, 0), cA, voffA); PG8_STAGE(PG8_SA(0, 1), cA + hstepA, voffA);
        if (wr == 1) PG8_BAR;
        PG8_WAIT_V(2); PG8_BAR;
        PG8_STAGE(PG8_SB(1, 0), cB + kstep, voffB); PG8_STAGE(PG8_SA(1, 0), PG8_AK(cA, 1), voffA); PG8_STAGE(PG8_SB(1, 1), cB + hstep + kstep, voffB);
        PG8_WAIT_V(6); PG8_BAR;
    } else {
        PG8_STAGE(PG8_SB(0, 0), cB, voffB); PG8_STAGE(PG8_SA(0, 0), cA, voffA); PG8_STAGE(PG8_SB(0, 1), cB + hstep, voffB); PG8_STAGE(PG8_SA(0, 1), cA + hstepA, voffA);
        if (wr == 1) PG8_BAR;
        PG8_WAIT_V(4); PG8_BAR;
        PG8_STAGE(PG8_SB(1, 0), cB + kstep, voffB); PG8_STAGE(PG8_SA(1, 0), PG8_AK(cA, 1), voffA); PG8_STAGE(PG8_SB(1, 1), cB + hstep + kstep, voffB);
        PG8_WAIT_V(6); PG8_BAR;
    }
    for (;;) {
        const bool has_next = S.next(ui + 1, nxt);
        const char* nA = has_next ? (const char*)g.A + (size_t)nxt.pm * tstepA : cA; const char* nB = has_next ? (const char*)g.Bt + (size_t)nxt.pn * tstep : cB;
        for (int t = 0; t < nt; t += 2) {
            const bool last = (t == nt - 2);
            if (Mid::ENABLED) MH(acc, cur, t, wr, wc, fr, fq);
            const char* a1 = PG8_AK(cA, t + 1);
            const char* a2 = last ? nA : PG8_AK(cA, t + 2); const char* b2 = last ? nB : cB + (size_t)(t + 2) * kstep;
            const char* a3 = a2 + kstepA; const char* b3 = b2 + kstep;
            if (last && has_next) S.a_ready(nxt);
            if constexpr (SP2) {
            PG8_LDB(B0, 0, 0); PG8_LDB(B1, 0, 1); PG8_SCHED; PG8_LDA(At, 0, 0); PG8_STAGE(PG8_SA(1, 1), a1 + hstepA, voffA);
            PG8_WAIT_V(8); PG8_WAIT_L(0); PG8_BAR; PG8_MMA(0, 0, At, B0); PG8_MMA(0, 1, At, B1); PG8_BAR; PG8_SCHED;
            PG8_LDA(At, 0, 1); PG8_STAGE(PG8_SB(0, 0), b2, voffB); PG8_STAGE(PG8_SB(0, 1), b2 + hstep, voffB); PG8_STAGE(PG8_SA(0, 0), a2, voffA);
            PG8_WAIT_V(8); PG8_WAIT_L(0); PG8_BAR; PG8_MMA(1, 0, At, B0); PG8_MMA(1, 1, At, B1); PG8_BAR; PG8_SCHED;
            PG8_LDB(B0, 1, 0); PG8_LDB(B1, 1, 1); PG8_SCHED; PG8_LDA(At, 1, 0); PG8_STAGE(PG8_SA(0, 1), a2 + hstepA, voffA);
            PG8_WAIT_V(8); PG8_WAIT_L(0); PG8_BAR; PG8_MMA(0, 0, At, B0); PG8_MMA(0, 1, At, B1); PG8_BAR; PG8_SCHED;
            PG8_LDA(At, 1, 1); PG8_STAGE(PG8_SB(1, 0), b3, voffB); PG8_STAGE(PG8_SB(1, 1), b3 + hstep, voffB); PG8_STAGE(PG8_SA(1, 0), a3, voffA);
            PG8_WAIT_V(8); PG8_WAIT_L(0); PG8_BAR; PG8_MMA(1, 0, At, B0); PG8_MMA(1, 1, At, B1); PG8_BAR; PG8_SCHED;
            } else {
            PG8_LDB(B0, 0, 0); PG8_SCHED; PG8_LDA(At, 0, 0); PG8_STAGE(PG8_SA(1, 1), a1 + hstepA, voffA);
            PG8_WAIT_L(8); PG8_BAR; PG8_WAIT_L(0); PG8_MMA(0, 0, At, B0); PG8_BAR; PG8_SCHED;
            PG8_LDB(B1, 0, 1); PG8_STAGE(PG8_SB(0, 0), b2, voffB);
            PG8_BAR; PG8_WAIT_L(0); PG8_MMA(0, 1, At, B1); PG8_BAR;
            PG8_LDA(At, 0, 1); PG8_STAGE(PG8_SA(0, 0), a2, voffA);
            PG8_BAR; PG8_WAIT_L(0); PG8_MMA(1, 0, At, B0); PG8_BAR; PG8_SCHED;
            PG8_STAGE(PG8_SB(0, 1), b2 + hstep, voffB);
            PG8_WAIT_V(6); PG8_BAR; PG8_MMA(1, 1, At, B1); PG8_BAR;
            PG8_LDB(B0, 1, 0); PG8_SCHED; PG8_LDA(At, 1, 0); PG8_STAGE(PG8_SA(0, 1), a2 + hstepA, voffA);
            PG8_WAIT_L(8); PG8_BAR; PG8_WAIT_L(0); PG8_MMA(0, 0, At, B0); PG8_BAR; PG8_SCHED;
            PG8_LDB(B1, 1, 1); PG8_STAGE(PG8_SB(1, 0), b3, voffB);
            PG8_BAR; PG8_WAIT_L(0); PG8_MMA(0, 1, At, B1); PG8_BAR;
            PG8_LDA(At, 1, 1); PG8_STAGE(PG8_SA(1, 0), a3, voffA);
            PG8_BAR; PG8_WAIT_L(0); PG8_MMA(1, 0, At, B0); PG8_BAR; PG8_SCHED;
            PG8_STAGE(PG8_SB(1, 1), b3 + hstep, voffB);
            PG8_WAIT_V(6); PG8_BAR; PG8_MMA(1, 1, At, B1); PG8_BAR;
            }
        }
        if constexpr (ALIGN_EPI) { if (wr == 0) PG8_BAR; }
        if constexpr (!Epi::AFTER_DRAIN) { E(acc, cur, wr, wc, fr, fq); S.done(cur); }
        if (!has_next) break;
#pragma unroll
        for (int a = 0; a < 2; ++a)
#pragma unroll
            for (int b = 0; b < 2; ++b)
#pragma unroll
                for (int m = 0; m < 4; ++m)
#pragma unroll
                    for (int n = 0; n < 2; ++n) acc[a][b][m][n] = (f32x4){0.f, 0.f, 0.f, 0.f};
        cur = nxt; cA = nA; cB = nB; ++ui;
        if constexpr (ALIGN_EPI) { if (wr == 1) PG8_BAR; }
    }
    PG8_WAIT_V(0);
    if constexpr (!ALIGN_EPI) { if (wr == 0) PG8_BAR; }
    PG8_BAR;
    if constexpr (Epi::AFTER_DRAIN) { E.fused(acc, cur, wr, wc, fr, fq, lds, wid, lane); S.done(cur); }
#undef PG8_AK
#undef PG8_SA
#undef PG8_SB
#undef PG8_STAGE
#undef PG8_LDA
#undef PG8_LDB
#undef PG8_MMA
#undef PG8_WAIT_V
#undef PG8_WAIT_L
#undef PG8_BAR
#undef PG8_SCHED
}
}

__device__ __forceinline__ int winmap(int n) { return n < 2560 ? n : (n < 5120 ? n + 16 : (n < 5136 ? 2560 + (n - 5120) : n)); }
template <class Map>
__device__ __forceinline__ void transpose_item(const float* W, int ldw, bf16* WT, int K, int item, int nblk, float* scr, int lane, const Map& mp) {
    const int kb = item / nblk, nbk = item % nblk, k0 = 64 * kb, n0 = 32 * nbk;
    const int col = mp.scol(n0 + (lane & 31));
#pragma unroll 8
    for (int i = 0; i < 32; ++i) { const int kk = 2 * i + (lane >> 5); scr[kk * 33 + (lane & 31)] = col >= 0 ? W[(size_t)mp.srow(k0 + kk) * ldw + col] * mp.scale(k0 + kk) : 0.f; }
    const int c = lane & 7;
#pragma unroll
    for (int j = 0; j < 4; ++j) { const int n = (lane >> 3) + 8 * j; const float* s = scr + (8 * c) * 33 + n;
        *(uint4*)(WT + (size_t)(n0 + n) * K + k0 + 8 * c) = make_uint4(pk2bf(s[0], s[33]), pk2bf(s[66], s[99]), pk2bf(s[132], s[165]), pk2bf(s[198], s[231])); }
}
struct MapPlain { __device__ __forceinline__ int srow(int k) const { return k; } __device__ __forceinline__ int scol(int n) const { return n; } __device__ __forceinline__ float scale(int) const { return 1.f; } };
struct MapWin { __device__ __forceinline__ int srow(int k) const { return k; } __device__ __forceinline__ int scol(int n) const { return n < NPROJ ? winmap(n) : -1; } __device__ __forceinline__ float scale(int) const { return 1.f; } };
struct MapWout { const float* an; const float* sn;
    __device__ __forceinline__ int srow(int k) const { return (k + 1024) & 2047; } __device__ __forceinline__ int scol(int n) const { return n; } __device__ __forceinline__ float scale(int k) const { return k < 1024 ? an[k] : sn[k - 1024]; } };
__device__ __forceinline__ void ph_prep(const Params& p, int wv, unsigned char* lds) {
    PH_IDS(); unsigned char* ws = p.ws;
    bf16* xb = (bf16*)(ws + OFF_XB);
    for (size_t i = gtid; i < (size_t)T * D / 8; i += gn) { const float4 v = ((const float4*)p.x)[2 * i], w = ((const float4*)p.x)[2 * i + 1]; ((uint4*)xb)[i] = make_uint4(pk2bf(v.x, v.y), pk2bf(v.z, v.w), pk2bf(w.x, w.y), pk2bf(w.z, w.w)); }
    {
        float* scr = (float*)(lds + wv * 8448);
        constexpr int I_WIN = 16 * 168, I_WOUT = 32 * 32, I_WQ = 16 * 64, I_W1 = 32 * 8, I_W2 = 4 * 2;
        constexpr int NIT = I_WIN + I_WOUT + I_WQ + 2 * I_W1 + 2 * I_W2;
        for (int it = gwave; it < NIT; it += nwaves) {
            int r = it;
            if (r < I_WIN) { transpose_item(p.w_in, NPROJ, (bf16*)(ws + OFF_WIN), 1024, r, 168, scr, lane, MapWin{}); continue; } r -= I_WIN;
            if (r < I_WOUT) { transpose_item(p.w_out, 1024, (bf16*)(ws + OFF_WOUT), 2048, r, 32, scr, lane, MapWout{p.attn_norm_w, p.ssd_norm_w}); continue; } r -= I_WOUT;
            if (r < I_WQ) { transpose_item(p.peer_wq, 2048, (bf16*)(ws + OFF_WQ), 1024, r, 64, scr, lane, MapPlain{}); continue; } r -= I_WQ;
            if (r < I_W1) { transpose_item(p.cmp_w1_k, 256, (bf16*)(ws + OFF_W1K), 2048, r, 8, scr, lane, MapPlain{}); continue; } r -= I_W1;
            if (r < I_W1) { transpose_item(p.cmp_w1_v, 256, (bf16*)(ws + OFF_W1V), 2048, r, 8, scr, lane, MapPlain{}); continue; } r -= I_W1;
            if (r < I_W2) { transpose_item(p.cmp_w2_k, 64, (bf16*)(ws + OFF_W2K), 256, r, 2, scr, lane, MapPlain{}); continue; } r -= I_W2;
            transpose_item(p.cmp_w2_v, 64, (bf16*)(ws + OFF_W2V), 256, r, 2, scr, lane, MapPlain{});
        }
    }
    bf16* keys = (bf16*)(ws + OFF_KEYS);
    for (int i = gtid; i < 8 * 2 * 128 * 128; i += gn) keys[i] = f2bf(p.peer_keys[i]);
    float* rc = (float*)(ws + OFF_ROPE); float* rs = rc + 4096 * 32;
    for (int i = gtid; i < 4096 * 32; i += gn) {
        const int pos = i >> 5, j = i & 31;
        const float inv = powf(10000.0f, -(float)(2 * j) / 64.0f); const float angf = (float)pos * inv;
        double xr = (double)angf * 0.15915494309189535; xr -= rint(xr); const double rr = xr * 6.283185307179586, r2 = rr * rr;
        double s = 0.0, c = 0.0, ts = rr, tc = 1.0;
        for (int k = 0; k < 14; ++k) { s += ts; c += tc; tc = -tc * r2 / (double)((2 * k + 1) * (2 * k + 2)); ts = -ts * r2 / (double)((2 * k + 2) * (2 * k + 3)); }
        rc[i] = (float)c; rs[i] = (float)s;
    }
    float* b1k = (float*)(ws + OFF_B1K); float* b1v = (float*)(ws + OFF_B1V);
    for (int o = gwave; o < 512; o += nwaves) {
        const int j = o & 255; const float* pos = o < 256 ? p.cmp_pos_k : p.cmp_pos_v; const float* w1 = o < 256 ? p.cmp_w1_k : p.cmp_w1_v;
        float s = 0.f; for (int k = lane; k < 2048; k += 64) s += pos[k] * w1[(size_t)k * 256 + j];
        s = wave_sum(s); if (lane == 0) (o < 256 ? b1k : b1v)[j] = s;
    }
}

__device__ __forceinline__ void unpack8(const uint4& w, float* f) { f[0] = __uint_as_float(w.x << 16); f[1] = __uint_as_float(w.x & 0xffff0000u); f[2] = __uint_as_float(w.y << 16); f[3] = __uint_as_float(w.y & 0xffff0000u);
    f[4] = __uint_as_float(w.z << 16); f[5] = __uint_as_float(w.z & 0xffff0000u); f[6] = __uint_as_float(w.w << 16); f[7] = __uint_as_float(w.w & 0xffff0000u); }
__device__ __forceinline__ uint4 pack8(const float* f) { return make_uint4(pk2bf(f[0], f[1]), pk2bf(f[2], f[3]), pk2bf(f[4], f[5]), pk2bf(f[6], f[7])); }
__device__ __forceinline__ void ph_tokprep(const Params& p, int wv) {
    PH_IDS(); unsigned char* ws = p.ws;
    const int gtid_ = (nb > 64 ? bid - 32 : bid) * NTHREADS + tid, gn_ = (nb > 64 ? nb - 32 : nb) * NTHREADS;
    const bf16* xbc = (const bf16*)(ws + OFF_XBC); bf16* xsbc = (bf16*)(ws + OFF_XSBC);
    for (int it = gtid_; it < (T / 16) * 192; it += gn_) {
        const int cg = it % 192, tg = it / 192, ch = cg * 8, t0 = tg * 16, l0 = t0 & (L - 1);
        float w[4][8], bias[8];
#pragma unroll
        for (int j = 0; j < 4; ++j) { const float4 a = *(const float4*)(p.conv_w + j * 1536 + ch), b2 = *(const float4*)(p.conv_w + j * 1536 + ch + 4); w[j][0] = a.x; w[j][1] = a.y; w[j][2] = a.z; w[j][3] = a.w; w[j][4] = b2.x; w[j][5] = b2.y; w[j][6] = b2.z; w[j][7] = b2.w; }
        { const float4 a = *(const float4*)(p.conv_b + ch), b2 = *(const float4*)(p.conv_b + ch + 4); bias[0] = a.x; bias[1] = a.y; bias[2] = a.z; bias[3] = a.w; bias[4] = b2.x; bias[5] = b2.y; bias[6] = b2.z; bias[7] = b2.w; }
        float x0[8], x1[8], x2[8], x3[8];
        { uint4 h0 = make_uint4(0u, 0u, 0u, 0u), h1 = h0, h2 = h0;
          if (l0 != 0) { h0 = *(const uint4*)(xbc + (size_t)(t0 - 3) * 1536 + ch); h1 = *(const uint4*)(xbc + (size_t)(t0 - 2) * 1536 + ch); h2 = *(const uint4*)(xbc + (size_t)(t0 - 1) * 1536 + ch); }
          unpack8(h0, x0); unpack8(h1, x1); unpack8(h2, x2); }
#pragma unroll
        for (int u = 0; u < 16; ++u) {
            unpack8(*(const uint4*)(xbc + (size_t)(t0 + u) * 1536 + ch), x3);
            float y[8];
#pragma unroll
            for (int i = 0; i < 8; ++i) { const float v = bias[i] + w[0][i] * x0[i] + w[1][i] * x1[i] + w[2][i] * x2[i] + w[3][i] * x3[i]; y[i] = v * sigmoidf(v); x0[i] = x1[i]; x1[i] = x2[i]; x2[i] = x3[i]; }
            *(uint4*)(xsbc + (size_t)(t0 + u) * 1536 + ch) = pack8(y);
        }
    }
    const bf16* dtg = (const bf16*)(ws + OFF_DTG); float* dt = (float*)(ws + OFF_DT); float* gate = (float*)(ws + OFF_GATE);
    for (int i = gtid_; i < T * 64; i += gn_) {
        const int t = i >> 6, c = i & 63; const float v = bf2f(dtg[i]);
        if (c < 16) { const float xx = v + p.dt_bias[c]; dt[t * 16 + c] = xx > 20.f ? xx : log1pf(__expf(xx)); }
        else gate[t * 48 + (c - 16)] = sigmoidf(v);
    }
    const float* rc = (const float*)(ws + OFF_ROPE); const float* rs = rc + 4096 * 32;
    bf16* q = (bf16*)(ws + OFF_Q); bf16* kvs = (bf16*)(ws + OFF_KVS);
    for (int it = gtid_; it < T * 24 * 4; it += gn_) {
        const int j0 = (it & 3) * 8, hh = (it >> 2) % 24, t = it / 96, l = t & (L - 1);
        bf16* pp; float sc;
        if (hh < 16) { pp = q + (size_t)t * 1024 + hh * 64 + j0; sc = 0.125f * 1.4426950408889634f; } else if (hh < 20) { pp = kvs + (size_t)t * 1536 + 512 + (hh - 16) * 64 + j0; sc = 1.f; } else { pp = kvs + (size_t)t * 1536 + 1024 + (hh - 20) * 64 + j0; sc = 1.f; }
        float x1[8], x2[8], c[8], s[8], o1[8], o2[8];
        unpack8(*(const uint4*)pp, x1); unpack8(*(const uint4*)(pp + 32), x2);
        { const float4 a = *(const float4*)(rc + l * 32 + j0), b2 = *(const float4*)(rc + l * 32 + j0 + 4), d = *(const float4*)(rs + l * 32 + j0), e = *(const float4*)(rs + l * 32 + j0 + 4);
          c[0] = a.x; c[1] = a.y; c[2] = a.z; c[3] = a.w; c[4] = b2.x; c[5] = b2.y; c[6] = b2.z; c[7] = b2.w; s[0] = d.x; s[1] = d.y; s[2] = d.z; s[3] = d.w; s[4] = e.x; s[5] = e.y; s[6] = e.z; s[7] = e.w; }
#pragma unroll
        for (int i = 0; i < 8; ++i) { o1[i] = (x1[i] * c[i] - x2[i] * s[i]) * sc; o2[i] = (x1[i] * s[i] + x2[i] * c[i]) * sc; }
        *(uint4*)pp = pack8(o1); *(uint4*)(pp + 32) = pack8(o2);
    }
}

__device__ __forceinline__ void ph_ssd_prep2(const Params& p, int wv, unsigned char* lds) {
    PH_IDS(); unsigned char* ws = p.ws;
    const bf16* xsbc = (const bf16*)(ws + OFF_XSBC); const float* dt = (const float*)(ws + OFF_DT);
    bf16* XdT = (bf16*)p.out; bf16* BT = (bf16*)(ws + OFF_BT); float* acsT = (float*)(ws + OFF_ACS);
    float* sdt = (float*)lds; float* swave = sdt + 128;
    const int bide = bid, nbe = nb;
    for (int unit = bide; unit < 2048 + 256; unit += nbe) {
        __syncthreads();
        if (unit < 2048) {
            const int h = unit & 15, bc = unit >> 4; const size_t t0 = (size_t)bc * 128;
            const float A = -__expf(p.a_log[h]);
            if (tid < 128) { const float dv = dt[(t0 + tid) * 16 + h]; sdt[tid] = dv; float a = dv * A;
#pragma unroll
                for (int o = 1; o < 64; o <<= 1) { const float v = __shfl_up(a, o); if (lane >= o) a += v; }
                if (lane == 63) swave[tid >> 6] = a;
                sdt[128 + 8 + tid] = a; }
            __syncthreads();
            if (tid < 128) { float a = sdt[128 + 8 + tid]; if (tid >= 64) a += swave[0]; acsT[(size_t)unit * 128 + tid] = a; }
            const int pp = tid & 63, lg = tid >> 6; const bf16* src = xsbc + (t0 + lg * 16) * 1536 + h * 64 + pp;
            unsigned w[8];
#pragma unroll
            for (int i = 0; i < 8; ++i) { const float v0 = bf2f(src[(size_t)(2 * i) * 1536]) * sdt[lg * 16 + 2 * i], v1 = bf2f(src[(size_t)(2 * i + 1) * 1536]) * sdt[lg * 16 + 2 * i + 1]; w[i] = (unsigned)f2bf(v0) | ((unsigned)f2bf(v1) << 16); }
            uint4* dst = (uint4*)(XdT + (size_t)unit * 8192 + pp * 128 + lg * 16);
            dst[0] = make_uint4(w[0], w[1], w[2], w[3]); dst[1] = make_uint4(w[4], w[5], w[6], w[7]);
        } else {
            const int u2 = unit - 2048, g = u2 & 1, bc = u2 >> 1; const size_t t0 = (size_t)bc * 128;
            const int n = tid & 127, lg = tid >> 7; const bf16* src = xsbc + (t0 + lg * 32) * 1536 + 1024 + g * 128 + n;
            uint4* dst = (uint4*)(BT + (size_t)u2 * 16384 + n * 128 + lg * 32);
#pragma unroll
            for (int k = 0; k < 4; ++k) { unsigned w[4];
#pragma unroll
                for (int i = 0; i < 4; ++i) w[i] = (unsigned)src[(size_t)(8 * k + 2 * i) * 1536] | ((unsigned)src[(size_t)(8 * k + 2 * i + 1) * 1536] << 16);
                dst[k] = make_uint4(w[0], w[1], w[2], w[3]); }
        }
    }
}
__device__ __forceinline__ void ph_ssd_states(const Params& p, int wv) {
    PH_IDS(); unsigned char* ws = p.ws; const int rr = lane & 31, hi = lane >> 5;
    const bf16* XdT = (const bf16*)p.out; bf16* S = (bf16*)((unsigned char*)p.out + 32 * MiB); const bf16* BT = (const bf16*)(ws + OFF_BT); const float* acsT = (const float*)(ws + OFF_ACS);
    for (int unit = gwave; unit < 2048; unit += nwaves) {
        const int h = unit & 15, bc = unit >> 4, g = h >> 3;
        const float* ac = acsT + (size_t)unit * 128; const float alast = ac[127];
        const bf16* xrow = XdT + (size_t)unit * 8192 + rr * 128 + 8 * hi; const bf16* bt = BT + (size_t)(bc * 2 + g) * 16384 + rr * 128 + 8 * hi;
        f32x16 acc[4][2];
#pragma unroll
        for (int nt = 0; nt < 4; ++nt)
#pragma unroll
            for (int pt = 0; pt < 2; ++pt)
#pragma unroll
                for (int e = 0; e < 16; ++e) acc[nt][pt][e] = 0.f;
#pragma unroll 2
        for (int ks = 0; ks < 8; ++ks) {
            const int l0 = ks * 16 + 8 * hi; float dec[8];
            { const f32x4 a0 = *(const f32x4*)(ac + l0), a1 = *(const f32x4*)(ac + l0 + 4);
#pragma unroll
              for (int jx = 0; jx < 8; ++jx) dec[jx] = __expf(alast - (jx < 4 ? a0[jx] : a1[jx - 4])); }
            bf16x8 xf[2];
#pragma unroll
            for (int pt = 0; pt < 2; ++pt) { float f[8]; unpack8(*(const uint4*)(xrow + (size_t)pt * 4096 + ks * 16), f);
#pragma unroll
                for (int jx = 0; jx < 8; ++jx) f[jx] *= dec[jx];
                union { uint4 u; bf16x8 v; } cvu; cvu.u = pack8(f); xf[pt] = cvu.v; }
#pragma unroll
            for (int nt = 0; nt < 4; ++nt) { const bf16x8 bf_ = *(const bf16x8*)(bt + (size_t)nt * 4096 + ks * 16);
#pragma unroll
                for (int pt = 0; pt < 2; ++pt) acc[nt][pt] = __builtin_amdgcn_mfma_f32_32x32x16_bf16(bf_, xf[pt], acc[nt][pt], 0, 0, 0); }
        }
#pragma unroll
        for (int pt = 0; pt < 2; ++pt) { bf16* so = S + (size_t)unit * 8192 + (pt * 32 + rr) * 128 + 4 * hi;
#pragma unroll
            for (int nt = 0; nt < 4; ++nt)
#pragma unroll
                for (int a = 0; a < 4; ++a) *(uint2*)(so + nt * 32 + 8 * a) = make_uint2(pk2bf(acc[nt][pt][4 * a], acc[nt][pt][4 * a + 1]), pk2bf(acc[nt][pt][4 * a + 2], acc[nt][pt][4 * a + 3])); }
    }
}
__device__ __forceinline__ void ph_ssd_scan(const Params& p, int wv) {
    PH_IDS();
    unsigned* S = (unsigned*)((unsigned char*)p.out + 32 * MiB); const float* acsT = (const float*)(p.ws + OFF_ACS);
    for (int e = gtid; e < NBATCH * 16 * 4096; e += gn) {
        const int pn = e & 4095, h = (e >> 12) & 15, b = e >> 16; float r0 = 0.f, r1 = 0.f;
        for (int c = 0; c < 32; c += 4) {
            unsigned v[4]; float d[4];
#pragma unroll
            for (int u = 0; u < 4; ++u) { const int unit = (b * 32 + c + u) * 16 + h; v[u] = S[(size_t)unit * 4096 + pn]; d[u] = __expf(acsT[(size_t)unit * 128 + 127]); }
#pragma unroll
            for (int u = 0; u < 4; ++u) { const int unit = (b * 32 + c + u) * 16 + h; S[(size_t)unit * 4096 + pn] = (unsigned)f2bf(r0) | ((unsigned)f2bf(r1) << 16);
                r0 = r0 * d[u] + bf2f((bf16)(v[u] & 0xffffu)); r1 = r1 * d[u] + bf2f((bf16)(v[u] >> 16)); }
        }
    }
}
constexpr int SO_CBROW = 136;
__device__ __forceinline__ void ph_ssd_out(const Params& p, int wv, unsigned char* lds) {
    PH_IDS(); unsigned char* ws = p.ws; const int rr = lane & 31, hi = lane >> 5;
    const bf16* XdT = (const bf16*)p.out; const bf16* S = (const bf16*)((unsigned char*)p.out + 32 * MiB); const bf16* xsbc = (const bf16*)(ws + OFF_XSBC);
    const float* acsT = (const float*)(ws + OFF_ACS); bf16* z = (bf16*)(ws + OFF_Z); float* ssq2p = (float*)(ws + OFF_HID);
    bf16* CBl = (bf16*)lds;
    for (int unit = bid; unit < 256; unit += nb) {
        const int g = unit & 1, bc = unit >> 1; const size_t t0 = (size_t)bc * 128;
        __syncthreads();
        for (int ti = wv; ti < 10; ti += NWAVES) {
            int lt = 0, st = ti; if (st > 0) { st -= 1; lt = 1; if (st > 1) { st -= 2; lt = 2; if (st > 2) { st -= 3; lt = 3; } } }
            f32x16 acc;
#pragma unroll
            for (int e = 0; e < 16; ++e) acc[e] = 0.f;
            const bf16* arow = xsbc + (t0 + st * 32 + rr) * 1536 + 1024 + g * 128 + 8 * hi; const bf16* brow = xsbc + (t0 + lt * 32 + rr) * 1536 + 1280 + g * 128 + 8 * hi;
#pragma unroll
            for (int ks = 0; ks < 8; ++ks) acc = __builtin_amdgcn_mfma_f32_32x32x16_bf16(*(const bf16x8*)(arow + ks * 16), *(const bf16x8*)(brow + ks * 16), acc, 0, 0, 0);
            bf16* dst = CBl + (lt * 32 + rr) * SO_CBROW + st * 32 + 4 * hi;
#pragma unroll
            for (int a = 0; a < 4; ++a) *(uint2*)(dst + 8 * a) = make_uint2(pk2bf(acc[4 * a], acc[4 * a + 1]), pk2bf(acc[4 * a + 2], acc[4 * a + 3]));
        }
        __syncthreads();
        const int h = g * 8 + wv, uh = bc * 16 + h; const float* ac = acsT + (size_t)uh * 128; const float Dh = p.d_skip[h];
        const bf16* xd = XdT + (size_t)uh * 8192 + rr * 128 + 8 * hi; const bf16* sin = S + (size_t)uh * 8192 + rr * 128 + 8 * hi;
        f32x16 acc[2][4];
#pragma unroll
        for (int pt = 0; pt < 2; ++pt)
#pragma unroll
            for (int lt = 0; lt < 4; ++lt)
#pragma unroll
                for (int e = 0; e < 16; ++e) acc[pt][lt][e] = 0.f;
#pragma unroll
        for (int lt = 0; lt < 4; ++lt) {
            const int l = lt * 32 + rr; const float acl = ac[l]; const float eal = __expf(acl);
#pragma unroll
            for (int ks = 0; ks < 2 * lt + 2; ++ks) {
                const int s0 = ks * 16 + 8 * hi; float cb[8]; unpack8(*(const uint4*)(CBl + l * SO_CBROW + s0), cb);
                const f32x4 a0 = *(const f32x4*)(ac + s0), a1 = *(const f32x4*)(ac + s0 + 4);
#pragma unroll
                for (int jx = 0; jx < 8; ++jx) { const float as = jx < 4 ? a0[jx] : a1[jx - 4]; cb[jx] = (s0 + jx <= l) ? cb[jx] * __expf(acl - as) : 0.f; }
                union { uint4 u; bf16x8 v; } mf; mf.u = pack8(cb);
#pragma unroll
                for (int pt = 0; pt < 2; ++pt) acc[pt][lt] = __builtin_amdgcn_mfma_f32_32x32x16_bf16(*(const bf16x8*)(xd + (size_t)pt * 4096 + ks * 16), mf.v, acc[pt][lt], 0, 0, 0);
            }
            const bf16* crow_ = xsbc + (t0 + l) * 1536 + 1280 + g * 128 + 8 * hi;
#pragma unroll
            for (int ks = 0; ks < 8; ++ks) {
                float cf[8]; unpack8(*(const uint4*)(crow_ + ks * 16), cf);
#pragma unroll
                for (int jx = 0; jx < 8; ++jx) cf[jx] *= eal;
                union { uint4 u; bf16x8 v; } bf_; bf_.u = pack8(cf);
#pragma unroll
                for (int pt = 0; pt < 2; ++pt) acc[pt][lt] = __builtin_amdgcn_mfma_f32_32x32x16_bf16(*(const bf16x8*)(sin + (size_t)pt * 4096 + ks * 16), bf_.v, acc[pt][lt], 0, 0, 0);
            }
            const size_t t = t0 + l; float ss = 0.f;
#pragma unroll
            for (int pt = 0; pt < 2; ++pt)
#pragma unroll
                for (int a = 0; a < 4; ++a) {
                    const int col = h * 64 + pt * 32 + 8 * a + 4 * hi;
                    const uint2 xw = *(const uint2*)(xsbc + t * 1536 + col), zw = *(const uint2*)(z + t * 1024 + col);
                    const float xs0 = bflo(xw.x), xs1 = bfhi(xw.x), xs2 = bflo(xw.y), xs3 = bfhi(xw.y), z0 = bflo(zw.x), z1 = bfhi(zw.x), z2 = bflo(zw.y), z3 = bfhi(zw.y);
                    const float v0 = (acc[pt][lt][4 * a] + Dh * xs0) * (z0 * sigmoidf(z0)), v1 = (acc[pt][lt][4 * a + 1] + Dh * xs1) * (z1 * sigmoidf(z1));
                    const float v2 = (acc[pt][lt][4 * a + 2] + Dh * xs2) * (z2 * sigmoidf(z2)), v3 = (acc[pt][lt][4 * a + 3] + Dh * xs3) * (z3 * sigmoidf(z3));
                    ss += (v0 * v0 + v1 * v1) + (v2 * v2 + v3 * v3);
                    *(uint2*)(z + t * 1024 + col) = make_uint2(pk2bf(v0, v1), pk2bf(v2, v3));
                }
            ss += __shfl_xor(ss, 32);
            if (hi == 0) ssq2p[t * 16 + h] = ss;
        }
    }
}

struct EpiKc {
    bf16* dst; bool tr; __device__ __forceinline__ void operator()(int m, int c, float v) const { const int hk = m & 3, n = (m >> 2) & 255, b = m >> 10; const bf16 o = (n == 255) ? (bf16)0 : f2bf(v);
        if (tr) dst[((size_t)(b * 4 + hk) * 64 + c) * 256 + n] = o; else dst[((size_t)(b * 4 + hk) * 256 + n) * 64 + c] = o; } };
__device__ __forceinline__ void ph_kc_rope(const Params& p, int wv) {
    PH_IDS(); unsigned char* ws = p.ws; bf16* kc = (bf16*)(ws + OFF_KC); const float* rc = (const float*)(ws + OFF_ROPE); const float* rs = rc + 4096 * 32;
    for (int i = gtid; i < 16 * 256 * 32; i += gn) {
        const int j = i & 31, n = (i >> 5) & 255, bh = i >> 13; const int pos = 16 * n + 31; if (n == 255) continue;
        const float c = rc[pos * 32 + j], s = rs[pos * 32 + j];
        bf16* pp = kc + ((size_t)bh * 256 + n) * 64 + j; const float x1 = bf2f(pp[0]), x2 = bf2f(pp[32]);
        pp[0] = f2bf(x1 * c - x2 * s); pp[32] = f2bf(x1 * s + x2 * c);
    }
}


__device__ __forceinline__ void ph_vt_prep(const Params& p, int wv) {
    PH_IDS(); unsigned char* ws = p.ws; const bf16* kvs = (const bf16*)(ws + OFF_KVS);
    const int bide = bid, nbe = nb;
    for (int unit = bide; unit < 2 * 16 * 64; unit += nbe) {
        const int br = unit & 1, tl = (unit >> 1) & 63, bh = unit >> 7, b = bh >> 2, hk = bh & 3;
        const int d = tid & 63, grp = tid >> 6; const int l0 = tl * 64 + grp * 8;
        const bf16* src = kvs + ((size_t)b * L + l0) * 1536 + (br ? 1280 : 768) + hk * 64 + d;
        unsigned w[4];
#pragma unroll
        for (int i = 0; i < 4; ++i) w[i] = (unsigned)src[(size_t)(2 * i) * 1536] | ((unsigned)src[(size_t)(2 * i + 1) * 1536] << 16);
        bf16* dst = (bf16*)(ws + (br ? OFF_VWT : OFF_VST)) + ((size_t)bh * 64 + d) * L + l0;
        *(uint4*)dst = make_uint4(w[0], w[1], w[2], w[3]);
    }
}

__device__ __forceinline__ float max3f(float a, float b, float c) { float r; asm("v_max3_f32 %0, %1, %2, %3" : "=v"(r) : "v"(a), "v"(b), "v"(c)); return r; }
__device__ __forceinline__ int crow(int r, int hi) { return (r & 3) + 8 * (r >> 2) + 4 * hi; }
constexpr int NSA_KROW = 144, NSA_VROW = 136, NSA_KBUF = 64 * NSA_KROW, NSA_VBUF = 64 * NSA_VROW;
constexpr int NSA_OFF_K = 0, NSA_OFF_V = 4 * NSA_KBUF;
constexpr int NSA_OFF_STASH = 73728;
constexpr int NSA_OFF_IMPA = NSA_OFF_STASH, NSA_IMPS = 65, NSA_OFF_IMPB = NSA_OFF_IMPA + 64 * NSA_IMPS * 4;
constexpr int NSA_OFF_SEL = NSA_OFF_STASH + 65536;
static_assert(NSA_OFF_V + 4 * NSA_VBUF <= NSA_OFF_STASH && NSA_OFF_IMPB + 64 * NSA_IMPS * 4 <= NSA_OFF_SEL && NSA_OFF_SEL + 1024 <= LDS_BYTES - 64, "NSA LDS map");
struct NsaSrc { const bf16* K; size_t kstride; const bf16* VT; size_t ldv; };
__device__ __forceinline__ void nsa_gload(const NsaSrc& s, int k0, int tid, uint4& kr, uint4& vr) {
    const int row = tid >> 3, ch = tid & 7;
    kr = *(const uint4*)(s.K + (size_t)(k0 + row) * s.kstride + ch * 8);
    vr = *(const uint4*)(s.VT + (size_t)row * s.ldv + k0 + ch * 8);
}
__device__ __forceinline__ void nsa_lstore(unsigned char* kb, unsigned char* vb, int tid, const uint4& kr, const uint4& vr) {
    const int row = tid >> 3, ch = tid & 7;
    *(uint4*)(kb + row * NSA_KROW + ch * 16) = kr;
    uint2* vp = (uint2*)(vb + row * NSA_VROW + ch * 16); vp[0] = make_uint2(vr.x, vr.y); vp[1] = make_uint2(vr.z, vr.w);
}
__device__ __forceinline__ void nsa_qk(const unsigned char* kb, const bf16x8 (&qf)[4], int rr, int hi, f32x16& p0, f32x16& p1) {
#pragma unroll
    for (int i = 0; i < 16; ++i) { p0[i] = 0.f; p1[i] = 0.f; }
    __builtin_amdgcn_s_setprio(1);
#pragma unroll
    for (int ds = 0; ds < 4; ++ds) {
        const bf16x8 a0 = *(const bf16x8*)(kb + rr * NSA_KROW + ds * 32 + hi * 16), a1 = *(const bf16x8*)(kb + (rr + 32) * NSA_KROW + ds * 32 + hi * 16);
        p0 = __builtin_amdgcn_mfma_f32_32x32x16_bf16(a0, qf[ds], p0, 0, 0, 0); p1 = __builtin_amdgcn_mfma_f32_32x32x16_bf16(a1, qf[ds], p1, 0, 0, 0);
    }
    __builtin_amdgcn_s_setprio(0);
}
__device__ __forceinline__ void nsa_pv(const unsigned char* vb, int rr, int hi, const f32x16& p0, const f32x16& p1, f32x16 (&O)[2]) {
    __builtin_amdgcn_s_setprio(1);
#pragma unroll
    for (int s = 0; s < 4; ++s) {
        const int eb = 8 * (s & 1), kbase = 32 * (s >> 1) + 16 * (s & 1);
        union { uint4 u; bf16x8 v; } pf;
        if (s < 2) pf.u = make_uint4(pk2bf(p0[eb], p0[eb + 1]), pk2bf(p0[eb + 2], p0[eb + 3]), pk2bf(p0[eb + 4], p0[eb + 5]), pk2bf(p0[eb + 6], p0[eb + 7]));
        else       pf.u = make_uint4(pk2bf(p1[eb], p1[eb + 1]), pk2bf(p1[eb + 2], p1[eb + 3]), pk2bf(p1[eb + 4], p1[eb + 5]), pk2bf(p1[eb + 6], p1[eb + 7]));
#pragma unroll
        for (int dsub = 0; dsub < 2; ++dsub) {
            const unsigned char* vp = vb + (dsub * 32 + rr) * NSA_VROW + (kbase + 4 * hi) * 2;
            const uint2 lo = *(const uint2*)vp, hh = *(const uint2*)(vp + 16);
            union { uint4 u; bf16x8 v; } vf; vf.u = make_uint4(lo.x, lo.y, hh.x, hh.y);
            O[dsub] = __builtin_amdgcn_mfma_f32_32x32x16_bf16(vf.v, pf.v, O[dsub], 0, 0, 0);
        }
    }
    __builtin_amdgcn_s_setprio(0);
}
template <int MODE>
__device__ __forceinline__ void nsa_tile(unsigned char* lds, const unsigned char* kb, const unsigned char* vb, int jt, int rr, int hi, const bf16x8 (&qf)[4], int lpos, int qi, int tokblk,
                                         u64 selm, float& m, float& lsum, float inv_l, f32x16 (&O)[2]) {
    float* impA = (float*)(lds + NSA_OFF_IMPA); float* impB = (float*)(lds + NSA_OFF_IMPB);
    f32x16 p0, p1; nsa_qk(kb, qf, rr, hi, p0, p1);
    asm volatile("s_nop 15\n\ts_nop 7" : "+v"(p0), "+v"(p1));
    const int k0 = jt * 64;
    const bool tile_on = (MODE != 2) || ((selm >> jt) & 1ull);
    bool full;
    if (MODE <= 1) full = (16 * (k0 + 63) + 31 <= qi * 64); else if (MODE == 2) full = (jt < qi); else full = (jt > qi - 8) && (jt < qi);
    float mx = NEG_INF, mx2 = NEG_INF;
    if (full) {
#pragma unroll
        for (int e = 0; e < 16; e += 2) { mx = max3f(mx, p0[e], p1[e]); mx2 = max3f(mx2, p0[e + 1], p1[e + 1]); }
        if (MODE == 2 && !tile_on) { mx = NEG_INF; mx2 = NEG_INF; }
    } else {
        const int lim = (MODE <= 1) ? (lpos - 31 - 16 * k0 - 64 * hi) : (lpos - k0 - 4 * hi);
#pragma unroll
        for (int e = 0; e < 16; ++e) {
            const int ca = (e & 3) + 8 * (e >> 2), cb = ca + 32; bool oa, ob;
            if (MODE <= 1) { oa = (16 * ca <= lim); ob = (16 * cb <= lim); }
            else if (MODE == 2) { oa = (ca <= lim); ob = (cb <= lim); }
            else { oa = (ca <= lim) && (ca > lim - 512); ob = (cb <= lim) && (cb > lim - 512); }
            p0[e] = oa ? p0[e] : NEG_INF; p1[e] = ob ? p1[e] : NEG_INF; if (e & 1) mx2 = max3f(mx2, p0[e], p1[e]); else mx = max3f(mx, p0[e], p1[e]);
        }
    }
    if (MODE != 1) {
        mx = max3f(mx, mx2, NEG_INF); mx = max3f(mx, __shfl_xor(mx, 32), NEG_INF);
        const float mnew = fmaxf(m, mx);
        if (__any((mnew - m) > 6.0f)) {
            const float alpha = __builtin_amdgcn_exp2f(m - mnew); m = mnew; lsum *= alpha;
            if (MODE != 0) {
#pragma unroll
                for (int e = 0; e < 16; ++e) { O[0][e] *= alpha; O[1][e] *= alpha; }
            }
        }
        const float meff = (MODE == 2 && full && !tile_on) ? BIG : ((m > 0.5f * NEG_INF) ? m : BIG);
        float rs = 0.f;
#pragma unroll
        for (int e = 0; e < 16; ++e) { p0[e] = __builtin_amdgcn_exp2f(p0[e] - meff); p1[e] = __builtin_amdgcn_exp2f(p1[e] - meff); rs += p0[e] + p1[e]; }
        lsum += rs;
        if (MODE != 0) nsa_pv(vb, rr, hi, p0, p1, O);
    } else {
#pragma unroll
        for (int e = 0; e < 16; ++e) { p0[e] = __builtin_amdgcn_exp2f(p0[e] - m) * inv_l; p1[e] = __builtin_amdgcn_exp2f(p1[e] - m) * inv_l; }
        nsa_pv(vb, rr, hi, p0, p1, O);
#pragma unroll
        for (int sub = 0; sub < 2; ++sub)
#pragma unroll
            for (int a = 0; a < 4; ++a) {
                float G, last;
                if (sub == 0) { G = (p0[4 * a] + p0[4 * a + 1]) + (p0[4 * a + 2] + p0[4 * a + 3]); last = p0[4 * a + 3]; } else { G = (p1[4 * a] + p1[4 * a + 1]) + (p1[4 * a + 2] + p1[4 * a + 3]); last = p1[4 * a + 3]; }
                G += __shfl_xor(G, 1); G += __shfl_xor(G, 2); last += __shfl_xor(last, 1); last += __shfl_xor(last, 2);
                const int jj = (k0 >> 2) + 8 * sub + 2 * a + hi;
                if ((rr & 3) == 0) { impA[tokblk * NSA_IMPS + jj] = G; if (jj + 1 < 64) impB[tokblk * NSA_IMPS + jj + 1] = last; }
            }
    }
}
template <int MODE>
__device__ __forceinline__ void nsa_branch(unsigned char* lds, const NsaSrc& src, int jt0, int jt1, int tid, int rr, int hi, const bf16x8 (&qf)[4], int lpos, int qi, int tokblk,
                                           u64 selm, u64 wsel, float& m, float& lsum, float inv_l, f32x16 (&O)[2]) {
    if (jt0 >= jt1) return;
    asm volatile("" : "+v"(tid), "+v"(rr));
    uint4 krA, vrA, krB, vrB;
    nsa_gload(src, jt0 * 64, tid, krA, vrA);
    if (jt0 + 1 < jt1) nsa_gload(src, (jt0 + 1) * 64, tid, krB, vrB);
    nsa_lstore(lds + NSA_OFF_K, lds + NSA_OFF_V, tid, krA, vrA);
    if (jt0 + 1 < jt1) nsa_lstore(lds + NSA_OFF_K + NSA_KBUF, lds + NSA_OFF_V + NSA_VBUF, tid, krB, vrB);
    __syncthreads();
    int par = 0;
    for (int jt = jt0; jt < jt1; jt += 2, par ^= 1) {
        const bool hasB = (jt + 1 < jt1), more = (jt + 2 < jt1), moreB = (jt + 3 < jt1);
        if (more) nsa_gload(src, (jt + 2) * 64, tid, krA, vrA);
        if (moreB) nsa_gload(src, (jt + 3) * 64, tid, krB, vrB);
        const unsigned char* kb = lds + NSA_OFF_K + (par * 2) * NSA_KBUF; const unsigned char* vb = lds + NSA_OFF_V + (par * 2) * NSA_VBUF;
        if ((MODE != 2) || ((wsel >> jt) & 1ull)) nsa_tile<MODE>(lds, kb, vb, jt, rr, hi, qf, lpos, qi, tokblk, selm, m, lsum, inv_l, O);
        if (hasB && ((MODE != 2) || ((wsel >> (jt + 1)) & 1ull))) nsa_tile<MODE>(lds, kb + NSA_KBUF, vb + NSA_VBUF, jt + 1, rr, hi, qf, lpos, qi, tokblk, selm, m, lsum, inv_l, O);
        if (more) nsa_lstore(lds + NSA_OFF_K + ((par ^ 1) * 2) * NSA_KBUF, lds + NSA_OFF_V + ((par ^ 1) * 2) * NSA_VBUF, tid, krA, vrA);
        if (moreB) nsa_lstore(lds + NSA_OFF_K + ((par ^ 1) * 2 + 1) * NSA_KBUF, lds + NSA_OFF_V + ((par ^ 1) * 2 + 1) * NSA_VBUF, tid, krB, vrB);
        __syncthreads();
    }
}
__device__ __forceinline__ void ph_nsa(const Params& p, int wv, unsigned char* lds) {
    PH_IDS(); unsigned char* ws = p.ws; const int wave = wv, rr = lane & 31, hi = lane >> 5;
    bf16* q = (bf16*)(ws + OFF_Q); const bf16* kvs = (const bf16*)(ws + OFF_KVS);
    const float* gate = (const float*)(ws + OFF_GATE); float* ssq = (float*)(ws + OFF_SSQ);
    float* impA = (float*)(lds + NSA_OFF_IMPA); float* impB = (float*)(lds + NSA_OFF_IMPB); u64* selw = (u64*)(lds + NSA_OFF_SEL);
    unsigned* qctr = (unsigned*)(ws + OFF_BAR + 14336) + 64 * (bid & 7); volatile int* ucur = (volatile int*)(lds + NSA_OFF_SEL + 512);
    for (;;) {
        if (tid == 0) *ucur = (int)__hip_atomic_fetch_add(qctr, 1u, __ATOMIC_RELAXED, __HIP_MEMORY_SCOPE_AGENT);
        __syncthreads();
        const int u = *ucur;
        if (u >= 128) break;
        const int bh = (bid & 7) + 8 * (u & 1), qi = 63 - (u >> 1);
        const int b = bh >> 2, hk = bh & 3; const int tokblk = wave * 8 + (rr >> 2), g = rr & 3; const int lpos = qi * 64 + tokblk; const size_t t = (size_t)b * L + lpos;
        bf16* qrow = q + t * 1024 + (hk * 4 + g) * 64;
        bf16x8 qf[4];
#pragma unroll
        for (int ds = 0; ds < 4; ++ds) qf[ds] = *(const bf16x8*)(qrow + ds * 16 + hi * 8);
        for (int i = tid; i < 64 * NSA_IMPS; i += NTHREADS) { impA[i] = 0.f; impB[i] = 0.f; }
        __syncthreads();
        f32x16 O[2]; float* stash = (float*)(lds + NSA_OFF_STASH) + tid;
        const float g0 = gate[t * 48 + (hk * 4 + g) * 3 + 0], g1 = gate[t * 48 + (hk * 4 + g) * 3 + 1], g2 = gate[t * 48 + (hk * 4 + g) * 3 + 2];
        {
            NsaSrc s{(const bf16*)(ws + OFF_KC) + (size_t)bh * 256 * 64, 64, (const bf16*)(ws + OFF_VCT) + (size_t)bh * 64 * 256, 256};
            const int nct = (4 * qi + 3 + 63) >> 6;
            float m = NEG_INF, lsum = 0.f;
            nsa_branch<0>(lds, s, 0, nct, tid, rr, hi, qf, lpos, qi, tokblk, 0ull, 0ull, m, lsum, 0.f, O);
            lsum += __shfl_xor(lsum, 32);
            const float inv_l = lsum > 0.f ? 1.0f / lsum : 0.f;
#pragma unroll
            for (int e = 0; e < 16; ++e) { O[0][e] = 0.f; O[1][e] = 0.f; }
            nsa_branch<1>(lds, s, 0, nct, tid, rr, hi, qf, lpos, qi, tokblk, 0ull, 0ull, m, lsum, inv_l, O);
        }
        f32x16 Oc[2];
#pragma unroll
        for (int e = 0; e < 16; ++e) { Oc[0][e] = g0 * O[0][e]; Oc[1][e] = g0 * O[1][e]; }
        {
            const int tk = tid >> 3, jg = tid & 7; float v[8];
#pragma unroll
            for (int i = 0; i < 8; ++i) { const int j = jg * 8 + i; const float raw = impA[tk * NSA_IMPS + j] + impB[tk * NSA_IMPS + j];
                const bool causal = (j <= qi), forced = (j == 0) || (j == qi) || (j == qi - 1); v[i] = causal ? (forced ? BIG : raw) : NEG_INF; }
            __syncthreads();
#pragma unroll
            for (int i = 0; i < 8; ++i) impA[tk * NSA_IMPS + jg * 8 + i] = v[i];
            __syncthreads();
            int rank[8];
#pragma unroll
            for (int i = 0; i < 8; ++i) rank[i] = 0;
            for (int jj = 0; jj < 64; ++jj) { const float x = impA[tk * NSA_IMPS + jj];
#pragma unroll
                for (int i = 0; i < 8; ++i) rank[i] += (x > v[i] || (x == v[i] && jj < jg * 8 + i)) ? 1 : 0; }
            unsigned b8 = 0u;
#pragma unroll
            for (int i = 0; i < 8; ++i) b8 |= (rank[i] < 16 && jg * 8 + i <= qi) ? (1u << i) : 0u;
            const u64 full = (u64)b8 << (jg * 8); unsigned blo = (unsigned)full, bhi = (unsigned)(full >> 32);
            blo |= __shfl_xor(blo, 1); bhi |= __shfl_xor(bhi, 1); blo |= __shfl_xor(blo, 2); bhi |= __shfl_xor(bhi, 2); blo |= __shfl_xor(blo, 4); bhi |= __shfl_xor(bhi, 4);
            if (jg == 0) selw[tk] = (u64)blo | ((u64)bhi << 32);
            __syncthreads();
        }
        const u64 selm = selw[tokblk];
        __syncthreads();
#pragma unroll
        for (int e = 0; e < 16; ++e) { stash[e * 512] = Oc[0][e]; stash[(16 + e) * 512] = Oc[1][e]; }
        u64 wsel = selm;
        { unsigned lo = (unsigned)wsel, h2 = (unsigned)(wsel >> 32);
          lo |= __shfl_xor(lo, 4); h2 |= __shfl_xor(h2, 4); lo |= __shfl_xor(lo, 8); h2 |= __shfl_xor(h2, 8); lo |= __shfl_xor(lo, 16); h2 |= __shfl_xor(h2, 16);
          wsel = (u64)lo | ((u64)h2 << 32); }
        {
            NsaSrc s{kvs + (size_t)b * L * 1536 + 512 + hk * 64, 1536, (const bf16*)(ws + OFF_VST) + (size_t)bh * 64 * L, (size_t)L};
            float m = NEG_INF, lsum = 0.f;
#pragma unroll
            for (int e = 0; e < 16; ++e) { O[0][e] = 0.f; O[1][e] = 0.f; }
            nsa_branch<2>(lds, s, 0, qi + 1, tid, rr, hi, qf, lpos, qi, tokblk, selm, wsel, m, lsum, 0.f, O);
            lsum += __shfl_xor(lsum, 32); const float sc = g1 / lsum;
#pragma unroll
            for (int e = 0; e < 16; ++e) { stash[e * 512] += sc * O[0][e]; stash[(16 + e) * 512] += sc * O[1][e]; }
        }
        {
            NsaSrc s{kvs + (size_t)b * L * 1536 + 1024 + hk * 64, 1536, (const bf16*)(ws + OFF_VWT) + (size_t)bh * 64 * L, (size_t)L};
            float m = NEG_INF, lsum = 0.f;
#pragma unroll
            for (int e = 0; e < 16; ++e) { O[0][e] = 0.f; O[1][e] = 0.f; }
            nsa_branch<3>(lds, s, qi >= 8 ? qi - 8 : 0, qi + 1, tid, rr, hi, qf, lpos, qi, tokblk, 0ull, 0ull, m, lsum, 0.f, O);
            lsum += __shfl_xor(lsum, 32); const float sc = g2 / lsum;
#pragma unroll
            for (int e = 0; e < 16; ++e) { O[0][e] = stash[e * 512] + sc * O[0][e]; O[1][e] = stash[(16 + e) * 512] + sc * O[1][e]; }
        }
        float ss = 0.f;
#pragma unroll
        for (int dsub = 0; dsub < 2; ++dsub)
#pragma unroll
            for (int a = 0; a < 4; ++a) {
                const float v0 = O[dsub][4 * a], v1 = O[dsub][4 * a + 1], v2 = O[dsub][4 * a + 2], v3 = O[dsub][4 * a + 3];
                ss += (v0 * v0 + v1 * v1) + (v2 * v2 + v3 * v3);
                *(uint2*)(qrow + dsub * 32 + 8 * a + 4 * hi) = make_uint2(pk2bf(v0, v1), pk2bf(v2, v3));
            }
        ss += __shfl_xor(ss, 32); ss += __shfl_xor(ss, 1); ss += __shfl_xor(ss, 2);
        if (hi == 0 && g == 0) ssq[t * 4 + hk] = ss;
        __syncthreads();
    }
}

constexpr size_t OFF_SU = 640 * 1024, OFF_SV = 704 * 1024, OFF_SX = 768 * 1024, OFF_SC = 832 * 1024;
constexpr size_t OFF_COEFQ = 218 * MiB, OFF_H1Q = 220 * MiB;
__device__ __forceinline__ unsigned pack4i8(float a, float b, float c, float d) {
    const int ia = (int)rintf(a), ib = (int)rintf(b), ic = (int)rintf(c), id = (int)rintf(d);
    return (unsigned)(ia & 0xff) | ((unsigned)(ib & 0xff) << 8) | ((unsigned)(ic & 0xff) << 16) | ((unsigned)(id & 0xff) << 24);
}
__device__ __forceinline__ void ph_ln1(const Params& p, int wv) {
    PH_IDS(); unsigned char* ws = p.ws; bf16* h1b = (bf16*)(ws + OFF_H1B); unsigned char* h1q = ws + OFF_H1Q; float* sx = (float*)(ws + OFF_SX);
    for (int t = gwave; t < T; t += nwaves) {
        float v[16]; float s = 0.f; float* row = p.out + (size_t)t * 1024 + lane * 16;
#pragma unroll
        for (int i = 0; i < 4; ++i) { const float4 a = *(const float4*)(row + 4 * i); v[4 * i] = a.x; v[4 * i + 1] = a.y; v[4 * i + 2] = a.z; v[4 * i + 3] = a.w; s += (a.x + a.y) + (a.z + a.w); }
        const float mu = wave_sum(s) * (1.0f / 1024.0f); float s2 = 0.f;
#pragma unroll
        for (int i = 0; i < 16; ++i) { v[i] -= mu; s2 += v[i] * v[i]; }
        const float rstd = rsqrtf(wave_sum(s2) * (1.0f / 1024.0f) + LN_EPS); float amax = 0.f;
#pragma unroll
        for (int i = 0; i < 4; ++i) { const int c = lane * 16 + 4 * i; const float4 ga = *(const float4*)(p.ln1_g + c), ba = *(const float4*)(p.ln1_b + c);
            v[4 * i] = v[4 * i] * rstd * ga.x + ba.x; v[4 * i + 1] = v[4 * i + 1] * rstd * ga.y + ba.y; v[4 * i + 2] = v[4 * i + 2] * rstd * ga.z + ba.z; v[4 * i + 3] = v[4 * i + 3] * rstd * ga.w + ba.w;
            *(float4*)(row + 4 * i) = make_float4(v[4 * i], v[4 * i + 1], v[4 * i + 2], v[4 * i + 3]); }
#pragma unroll
        for (int i = 0; i < 16; ++i) amax = fmaxf(amax, fabsf(v[i]));
        amax = fmaxf(wave_max(amax), 1e-20f); const float inv = 127.0f / amax;
        *(uint4*)(h1b + (size_t)t * 1024 + lane * 16) = pack8(v); *(uint4*)(h1b + (size_t)t * 1024 + lane * 16 + 8) = pack8(v + 8);
        *(uint4*)(h1q + (size_t)t * 1024 + lane * 16) = make_uint4(pack4i8(v[0] * inv, v[1] * inv, v[2] * inv, v[3] * inv), pack4i8(v[4] * inv, v[5] * inv, v[6] * inv, v[7] * inv),
                                                                 pack4i8(v[8] * inv, v[9] * inv, v[10] * inv, v[11] * inv), pack4i8(v[12] * inv, v[13] * inv, v[14] * inv, v[15] * inv));
        if (lane == 0) sx[t] = amax * (1.0f / 127.0f);
    }
}

__device__ __forceinline__ unsigned umaxu(unsigned a, unsigned b) { return a > b ? a : b; }
__device__ __forceinline__ unsigned uminu(unsigned a, unsigned b) { return a < b ? a : b; }
__device__ __forceinline__ unsigned f2mono(float f) { const unsigned u = __float_as_uint(f); return (u & 0x80000000u) ? ~u : (u | 0x80000000u); }
__device__ __forceinline__ float mono2f(unsigned m) { return __uint_as_float((m & 0x80000000u) ? (m & 0x7fffffffu) : ~m); }
template <int N> __device__ __forceinline__ void bitonic_sort_desc(unsigned (&a)[N]) {
#pragma unroll
    for (int k = 2; k <= N; k <<= 1)
#pragma unroll
        for (int j = k >> 1; j > 0; j >>= 1)
#pragma unroll
            for (int i = 0; i < N; ++i) { const int l = i ^ j; if (l > i) { const bool desc = ((i & k) == 0); const unsigned x = a[i], y = a[l], mx = umaxu(x, y), mn = uminu(x, y); a[i] = desc ? mx : mn; a[l] = desc ? mn : mx; } }
}
__device__ __forceinline__ void merge_top16(unsigned (&a)[16], const unsigned (&b)[16]) {
#pragma unroll
    for (int i = 0; i < 16; ++i) a[i] = umaxu(a[i], b[15 - i]);
#pragma unroll
    for (int j = 8; j > 0; j >>= 1)
#pragma unroll
        for (int i = 0; i < 16; ++i) { const int l = i ^ j; if (l > i) { const unsigned x = a[i], y = a[l]; a[i] = umaxu(x, y); a[l] = uminu(x, y); } }
}
constexpr int PK_KROW = 272;
__device__ __forceinline__ void peer_stage1(const bf16* qrow, const unsigned char* krow, int hi, unsigned (&run)[16]) {
    bf16x8 qf[8];
#pragma unroll
    for (int ks = 0; ks < 8; ++ks) qf[ks] = *(const bf16x8*)(qrow + ks * 16);
#pragma unroll 1
    for (int kt = 0; kt < 4; ++kt) {
        f32x16 acc;
#pragma unroll
        for (int e = 0; e < 16; ++e) acc[e] = 0.f;
        const unsigned char* kr = krow + kt * 32 * PK_KROW;
#pragma unroll
        for (int ks = 0; ks < 8; ++ks) acc = __builtin_amdgcn_mfma_f32_32x32x16_bf16(*(const bf16x8*)(kr + ks * 32), qf[ks], acc, 0, 0, 0);
        unsigned grp[16]; const unsigned ib = (unsigned)(127 - kt * 32 - 4 * hi);
#pragma unroll
        for (int e = 0; e < 16; ++e) grp[e] = (f2mono(acc[e]) & ~0x7fu) | (ib - (unsigned)((e & 3) + 8 * (e >> 2)));
        bitonic_sort_desc<16>(grp);
        if (kt == 0) {
#pragma unroll
            for (int i = 0; i < 16; ++i) run[i] = grp[i];
        } else merge_top16(run, grp);
    }
    unsigned oth[16];
#pragma unroll
    for (int i = 0; i < 16; ++i) oth[i] = __shfl_xor(run[i], 32);
    merge_top16(run, oth);
}
__device__ __forceinline__ void ph_peer_topk(const Params& p, int wv, unsigned char* lds) {
    PH_IDS(); unsigned char* ws = p.ws; const int rr = lane & 31, hi = lane >> 5;
    unsigned char* kimg = lds; int* exl = (int*)(lds + 2 * 128 * PK_KROW + wv * 6400);
    const bf16* qp = (const bf16*)(ws + OFF_QP); const bf16* keys = (const bf16*)(ws + OFF_KEYS);
    int* eidx = (int*)(ws + OFF_EIDX); float* gw = (float*)(ws + OFF_GW);
    const int h = bid & 7;
    for (int i = tid; i < 256 * 16; i += NTHREADS) { const int row = i >> 4, ch = i & 15; *(uint4*)(kimg + row * PK_KROW + ch * 16) = *(const uint4*)(keys + ((size_t)h * 256 + row) * 128 + ch * 8); }
    __syncthreads();
    for (int tt = (bid >> 3) * NWAVES + wv; tt < 512; tt += (nb >> 3) * NWAVES) {
        const int t0 = tt * 32;
        unsigned top[2][16];
        peer_stage1(qp + (size_t)(t0 + rr) * 2048 + h * 256 + 8 * hi, kimg + rr * PK_KROW + 16 * hi, hi, top[0]);
        peer_stage1(qp + (size_t)(t0 + rr) * 2048 + h * 256 + 128 + 8 * hi, kimg + (128 + rr) * PK_KROW + 16 * hi, hi, top[1]);
        unsigned g4[4][16];
#pragma unroll
        for (int k = 0; k < 4; ++k)
#pragma unroll
            for (int i = 0; i < 16; ++i) g4[k][i] = 0u;
#pragma unroll
        for (int i = 0; i < 16; ++i) {
            int off = 0;
#pragma unroll
            for (int k = 0; k < 16; ++k) if (k < i) off += 16 / (k + 1);
            const float s0 = mono2f(top[0][i] & ~0x7fu); const int e0 = (int)(127u - (top[0][i] & 0x7fu)) * 128;
#pragma unroll
            for (int j = 0; j < 16; ++j) if ((i + 1) * (j + 1) <= 16) {
                const int nc = off + j;
                const float sum = s0 + mono2f(top[1][j] & ~0x7fu);
                g4[nc >> 4][nc & 15] = (f2mono(sum) & ~0x3fu) | (unsigned)(63 - nc);
                if (hi == 0) exl[nc * 32 + rr] = e0 + (int)(127u - (top[1][j] & 0x7fu));
            }
        }
#pragma unroll
        for (int k = 0; k < 4; ++k) bitonic_sort_desc<16>(g4[k]);
        merge_top16(g4[0], g4[1]); merge_top16(g4[2], g4[3]); merge_top16(g4[0], g4[2]);
        float e16[16]; float den = 0.f; const float gmax = mono2f(g4[0][0] & ~0x3fu);
#pragma unroll
        for (int r = 0; r < 16; ++r) { e16[r] = __expf(mono2f(g4[0][r] & ~0x3fu) - gmax); den += e16[r]; }
        const float inv = 1.0f / den; const size_t ob = (size_t)(t0 + rr) * 128 + h * 16 + hi * 8;
        float wo[8]; int eo[8];
#pragma unroll
        for (int k = 0; k < 8; ++k) { const unsigned key = hi ? g4[0][8 + k] : g4[0][k]; wo[k] = (hi ? e16[8 + k] : e16[k]) * inv; eo[k] = exl[(63 - (int)(key & 0x3fu)) * 32 + rr]; }
        *(float4*)(gw + ob) = make_float4(wo[0], wo[1], wo[2], wo[3]); *(float4*)(gw + ob + 4) = make_float4(wo[4], wo[5], wo[6], wo[7]);
        *(int4*)(eidx + ob) = make_int4(eo[0], eo[1], eo[2], eo[3]); *(int4*)(eidx + ob + 4) = make_int4(eo[4], eo[5], eo[6], eo[7]);
    }
}
__device__ __forceinline__ void ph_peer_cvt(const Params& p, int wv) {
    PH_IDS(); unsigned char* ws = p.ws;
    for (int r = gwave; r < 2 * 16384; r += nwaves) {
        const bool isv = r >= 16384; const int e = isv ? r - 16384 : r;
        const float* src = (isv ? p.peer_v : p.peer_u) + (size_t)e * 1024 + lane * 16; float v[16]; float amax = 0.f;
#pragma unroll
        for (int i = 0; i < 4; ++i) { const float4 a = *(const float4*)(src + 4 * i); v[4 * i] = a.x; v[4 * i + 1] = a.y; v[4 * i + 2] = a.z; v[4 * i + 3] = a.w; }
#pragma unroll
        for (int i = 0; i < 16; ++i) amax = fmaxf(amax, fabsf(v[i]));
        amax = fmaxf(wave_max(amax), 1e-30f); const float inv = 127.0f / amax;
        *(uint4*)(ws + (isv ? OFF_PV : OFF_PU) + (size_t)e * 1024 + lane * 16) = make_uint4(pack4i8(v[0] * inv, v[1] * inv, v[2] * inv, v[3] * inv), pack4i8(v[4] * inv, v[5] * inv, v[6] * inv, v[7] * inv),
                                                                                            pack4i8(v[8] * inv, v[9] * inv, v[10] * inv, v[11] * inv), pack4i8(v[12] * inv, v[13] * inv, v[14] * inv, v[15] * inv));
        if (lane == 0) ((float*)(ws + (isv ? OFF_SV : OFF_SU)))[e] = amax * (1.0f / 127.0f);
    }
}
constexpr size_t OFF_PART = 26 * MiB;
constexpr size_t OFF_Y = 26 * MiB;
static_assert(OFF_PART + 64 * MiB <= OFF_H1B && OFF_PV + 16 * MiB <= OFF_XSBC && OFF_VWT + 8 * MiB <= OFF_PU, "PEER scratch map");
#define PU_ISSUE16(W, ELO, EHI) do { _Pragma("unroll") for (int k = 0; k < 8; ++k) { const int e0 = __shfl(ELO, k * 8 + g), e1 = __shfl(EHI, k * 8 + g); \
        W[k] = *(const uint4*)(PU + (size_t)e0 * 1024 + 128 * s + 16 * j); W[8 + k] = *(const uint4*)(PU + (size_t)e1 * 1024 + 128 * s + 16 * j); } } while (0)
#define PU_DOT16(W, X) __builtin_amdgcn_sdot4((int)(W).w, (int)(X).w, __builtin_amdgcn_sdot4((int)(W).z, (int)(X).z, __builtin_amdgcn_sdot4((int)(W).y, (int)(X).y, __builtin_amdgcn_sdot4((int)(W).x, (int)(X).x, 0, false), false), false), false)
#define PU_REDUCE8(W, O, XQ, PROW, B) do { int d[8], a4[4], a2[2], a1; \
        _Pragma("unroll") for (int k = 0; k < 8; ++k) d[k] = PU_DOT16(W[(O) + k], XQ); \
        _Pragma("unroll") for (int k = 0; k < 4; ++k) { const int give = b2 ? d[k] : d[4 + k]; a4[k] = (b2 ? d[4 + k] : d[k]) + __shfl_xor(give, 4); } \
        _Pragma("unroll") for (int k = 0; k < 2; ++k) { const int give = b1 ? a4[k] : a4[2 + k]; a2[k] = (b1 ? a4[2 + k] : a4[k]) + __shfl_xor(give, 2); } \
        { const int give = b0 ? a2[0] : a2[1]; a1 = (b0 ? a2[1] : a2[0]) + __shfl_xor(give, 1); } \
        (PROW)[(B) * 64 + kk * 8 + g] = a1; } while (0)
#define PU_META(T_, XQ, ELO, EHI) do { const int tq_ = (T_) < T ? (T_) : tlast; XQ = *(const uint4*)(h1q + (size_t)tq_ * 1024 + 128 * s + 16 * j); \
        ELO = eidx[(size_t)tq_ * 128 + lane]; EHI = eidx[(size_t)tq_ * 128 + 64 + lane]; } while (0)
#define PU_TOKEN(W, T_, XQ) do { int* prow = part + ((size_t)s * T + (T_)) * 128; PU_REDUCE8(W, 0, XQ, prow, 0); PU_REDUCE8(W, 8, XQ, prow, 1); } while (0)
__device__ __forceinline__ void ph_peer_u(const Params& p, int wv) {
    PH_IDS(); unsigned char* ws = p.ws; const int s = bid & 7, cu = bid >> 3, ncu = nb >> 3, g = lane >> 3, j = lane & 7;
    const unsigned char* h1q = ws + OFF_H1Q; const int* eidx = (const int*)(ws + OFF_EIDX); const unsigned char* PU = ws + OFF_PU; int* part = (int*)(ws + OFF_PART);
    const bool b2 = (lane & 4) != 0, b1 = (lane & 2) != 0, b0 = (lane & 1) != 0; const int kk = (b2 ? 4 : 0) + (b1 ? 2 : 0) + (b0 ? 1 : 0);
    const int tstep = ncu * NWAVES; int t = cu * NWAVES + wv;
    if (t >= T) return;
    const int tlast = t;
    uint4 xq0, xq1; int el0, eh0, el1, eh1;
    PU_META(t, xq0, el0, eh0); PU_META(t + tstep, xq1, el1, eh1);
    uint4 wA[16], wB[16];
    PU_ISSUE16(wA, el0, eh0);
    for (;;) {
        { const uint4 cx = xq0; PU_META(t + 2 * tstep, xq0, el0, eh0); PU_ISSUE16(wB, el1, eh1); PU_TOKEN(wA, t, cx); }
        t += tstep; if (t >= T) break;
        { const uint4 cx = xq1; PU_META(t + 2 * tstep, xq1, el1, eh1); PU_ISSUE16(wA, el0, eh0); PU_TOKEN(wB, t, cx); }
        t += tstep; if (t >= T) break;
    }
}
__device__ __forceinline__ void ph_peer_c(const Params& p, int wv) {
    PH_IDS(); unsigned char* ws = p.ws; const int* part = (const int*)(ws + OFF_PART); const float* gw = (const float*)(ws + OFF_GW); const int* eidx = (const int*)(ws + OFF_EIDX);
    const float* su = (const float*)(ws + OFF_SU); const float* sv = (const float*)(ws + OFF_SV); const float* sx = (const float*)(ws + OFF_SX); float* sc = (float*)(ws + OFF_SC); unsigned* coefq = (unsigned*)(ws + OFF_COEFQ);
    for (int t = gwave; t < T; t += nwaves) {
        float cp[2];
#pragma unroll
        for (int b = 0; b < 2; ++b) { const size_t i = (size_t)t * 128 + b * 64 + lane; int acc = 0;
#pragma unroll
            for (int s = 0; s < 8; ++s) acc += part[(size_t)s * T * 128 + i];
            const int e = eidx[i]; cp[b] = gw[i] * gelu_exact((float)acc * su[e] * sx[t]) * sv[e]; }
        const float amax = fmaxf(wave_max(fmaxf(fabsf(cp[0]), fabsf(cp[1]))), 1e-30f), inv = 127.0f / amax;
        const int q0 = (int)rintf(cp[0] * inv) & 0xff, q1 = (int)rintf(cp[1] * inv) & 0xff;
        const int gg = lane & 7, kq = (lane >> 3) & 1;
        unsigned w0 = 0u, w1 = 0u;
#pragma unroll
        for (int i = 0; i < 4; ++i) { const int srcl = (4 * kq + i) * 8 + gg; w0 |= (unsigned)__shfl(q0, srcl) << (8 * i); w1 |= (unsigned)__shfl(q1, srcl) << (8 * i); }
        if (lane < 16) { coefq[(size_t)t * 32 + lane] = w0; coefq[(size_t)t * 32 + 16 + lane] = w1; }
        if (lane == 0) sc[t] = amax * (1.0f / 127.0f);
    }
}
#define PV_ISSUE16(W, ELO, EHI) do { _Pragma("unroll") for (int k = 0; k < 8; ++k) { const int e0 = __shfl(ELO, k * 8 + g), e1 = __shfl(EHI, k * 8 + g); \
        W[k] = *(const uint4*)(PV + (size_t)e0 * 1024 + 128 * s + 16 * j); W[8 + k] = *(const uint4*)(PV + (size_t)e1 * 1024 + 128 * s + 16 * j); } } while (0)
#define PV_META(T_, ELO, EHI, CQ) do { const int tq_ = (T_) < T ? (T_) : tlast; ELO = eidx[(size_t)tq_ * 128 + lane]; EHI = eidx[(size_t)tq_ * 128 + 64 + lane]; \
        CQ[0] = coefq[(size_t)tq_ * 32 + g]; CQ[1] = coefq[(size_t)tq_ * 32 + 8 + g]; CQ[2] = coefq[(size_t)tq_ * 32 + 16 + g]; CQ[3] = coefq[(size_t)tq_ * 32 + 24 + g]; } while (0)
#define PV_BLK(W0, W1, W2, W3, CQW, A0, A1, A2, A3) do { \
        const unsigned l01 = __builtin_amdgcn_perm(W1, W0, 0x05010400u), h01 = __builtin_amdgcn_perm(W1, W0, 0x07030602u), l23 = __builtin_amdgcn_perm(W3, W2, 0x05010400u), h23 = __builtin_amdgcn_perm(W3, W2, 0x07030602u); \
        A0 = __builtin_amdgcn_sdot4((int)__builtin_amdgcn_perm(l23, l01, 0x05040100u), (int)(CQW), A0, false); A1 = __builtin_amdgcn_sdot4((int)__builtin_amdgcn_perm(l23, l01, 0x07060302u), (int)(CQW), A1, false); \
        A2 = __builtin_amdgcn_sdot4((int)__builtin_amdgcn_perm(h23, h01, 0x05040100u), (int)(CQW), A2, false); A3 = __builtin_amdgcn_sdot4((int)__builtin_amdgcn_perm(h23, h01, 0x07060302u), (int)(CQW), A3, false); } while (0)
#define PV_QUAD(W, O, CQW) do { PV_BLK(W[(O)].x, W[(O) + 1].x, W[(O) + 2].x, W[(O) + 3].x, CQW, acc[0], acc[1], acc[2], acc[3]); PV_BLK(W[(O)].y, W[(O) + 1].y, W[(O) + 2].y, W[(O) + 3].y, CQW, acc[4], acc[5], acc[6], acc[7]); \
        PV_BLK(W[(O)].z, W[(O) + 1].z, W[(O) + 2].z, W[(O) + 3].z, CQW, acc[8], acc[9], acc[10], acc[11]); PV_BLK(W[(O)].w, W[(O) + 1].w, W[(O) + 2].w, W[(O) + 3].w, CQW, acc[12], acc[13], acc[14], acc[15]); } while (0)
#define PV_TOKEN(W, CQ, T_) do { int acc[16]; _Pragma("unroll") for (int i = 0; i < 16; ++i) acc[i] = 0; \
        PV_QUAD(W, 0, CQ[0]); PV_QUAD(W, 4, CQ[1]); PV_QUAD(W, 8, CQ[2]); PV_QUAD(W, 12, CQ[3]); \
        int y8[8], y4[4], y2[2]; \
        _Pragma("unroll") for (int i = 0; i < 8; ++i) { const int give = b5 ? acc[i] : acc[8 + i]; y8[i] = (b5 ? acc[8 + i] : acc[i]) + __shfl_xor(give, 32); } \
        _Pragma("unroll") for (int i = 0; i < 4; ++i) { const int give = b4 ? y8[i] : y8[4 + i]; y4[i] = (b4 ? y8[4 + i] : y8[i]) + __shfl_xor(give, 16); } \
        _Pragma("unroll") for (int i = 0; i < 2; ++i) { const int give = b3 ? y4[i] : y4[2 + i]; y2[i] = (b3 ? y4[2 + i] : y4[i]) + __shfl_xor(give, 8); } \
        const float sct = sc[(T_)]; *(float2*)(Y + (size_t)(T_) * 1024 + 128 * s + 16 * j + c0) = make_float2((float)y2[0] * sct, (float)y2[1] * sct); } while (0)
__device__ __forceinline__ void ph_peer_v(const Params& p, int wv) {
    PH_IDS(); unsigned char* ws = p.ws; const int s = bid & 7, cu = bid >> 3, ncu = nb >> 3, g = lane >> 3, j = lane & 7;
    const int* eidx = (const int*)(ws + OFF_EIDX); const unsigned* coefq = (const unsigned*)(ws + OFF_COEFQ); const float* sc = (const float*)(ws + OFF_SC); const unsigned char* PV = ws + OFF_PV; float* Y = (float*)(ws + OFF_Y);
    const bool b5 = (lane & 32) != 0, b4 = (lane & 16) != 0, b3 = (lane & 8) != 0; const int c0 = (b5 ? 8 : 0) + (b4 ? 4 : 0) + (b3 ? 2 : 0);
    const int tstep = ncu * NWAVES; int t = cu * NWAVES + wv;
    if (t >= T) return;
    const int tlast = t;
    int el0, eh0, el1, eh1; unsigned cq0[4], cq1[4];
    PV_META(t, el0, eh0, cq0); PV_META(t + tstep, el1, eh1, cq1);
    uint4 wA[16], wB[16];
    PV_ISSUE16(wA, el0, eh0);
    for (;;) {
        { unsigned cc[4] = {cq0[0], cq0[1], cq0[2], cq0[3]}; PV_META(t + 2 * tstep, el0, eh0, cq0); PV_ISSUE16(wB, el1, eh1); PV_TOKEN(wA, cc, t); }
        t += tstep; if (t >= T) break;
        { unsigned cc[4] = {cq1[0], cq1[1], cq1[2], cq1[3]}; PV_META(t + 2 * tstep, el1, eh1, cq1); PV_ISSUE16(wA, el0, eh0); PV_TOKEN(wB, cc, t); }
        t += tstep; if (t >= T) break;
    }
}
__device__ __forceinline__ void ph_peer_ln2(const Params& p, int wv) {
    PH_IDS(); unsigned char* ws = p.ws; const float* Y = (const float*)(ws + OFF_Y);
    int t = gwave; if (t >= T) return;
    float4 ha[4], ya[4];
#pragma unroll
    for (int i = 0; i < 4; ++i) { ha[i] = *(const float4*)(p.out + (size_t)t * 1024 + lane * 16 + 4 * i); ya[i] = *(const float4*)(Y + (size_t)t * 1024 + lane * 16 + 4 * i); }
    for (;;) {
        const int tn = t + nwaves; const int tq = tn < T ? tn : t;
        float4 hb[4], yb[4];
#pragma unroll
        for (int i = 0; i < 4; ++i) { hb[i] = *(const float4*)(p.out + (size_t)tq * 1024 + lane * 16 + 4 * i); yb[i] = *(const float4*)(Y + (size_t)tq * 1024 + lane * 16 + 4 * i); }
        float y[16]; float s1 = 0.f, s2 = 0.f;
#pragma unroll
        for (int i = 0; i < 4; ++i) { y[4 * i] = ya[i].x + DN_ALPHA * ha[i].x; y[4 * i + 1] = ya[i].y + DN_ALPHA * ha[i].y; y[4 * i + 2] = ya[i].z + DN_ALPHA * ha[i].z; y[4 * i + 3] = ya[i].w + DN_ALPHA * ha[i].w; }
#pragma unroll
        for (int i = 0; i < 16; ++i) { s1 += y[i]; s2 += y[i] * y[i]; }
#pragma unroll
        for (int o = 1; o < 64; o <<= 1) { s1 += __shfl_xor(s1, o); s2 += __shfl_xor(s2, o); }
        const float mu = s1 * (1.0f / 1024.0f); const float var = fmaxf(s2 * (1.0f / 1024.0f) - mu * mu, 0.f); const float rstd = rsqrtf(var + LN_EPS);
        float* row = p.out + (size_t)t * 1024 + lane * 16;
#pragma unroll
        for (int i = 0; i < 4; ++i) { const int c = lane * 16 + 4 * i; const float4 ga = *(const float4*)(p.ln2_g + c), ba = *(const float4*)(p.ln2_b + c);
            float4 o; o.x = (y[4 * i] - mu) * rstd * ga.x + ba.x; o.y = (y[4 * i + 1] - mu) * rstd * ga.y + ba.y; o.z = (y[4 * i + 2] - mu) * rstd * ga.z + ba.z; o.w = (y[4 * i + 3] - mu) * rstd * ga.w + ba.w;
            *(float4*)(row + 4 * i) = o; }
        if (tn >= T) break;
        t = tn;
#pragma unroll
        for (int i = 0; i < 4; ++i) { ha[i] = hb[i]; ya[i] = yb[i]; }
    }
}

#define LAS __attribute__((address_space(3)))
#define XB_TMO      128
#define XB_XCNT(j)  (256  + 64 * (j))
#define XB_XSUB(j)  (1280 + 64 * (j))
#define XB_XGEN(j)  (2304 + 64 * (j))
#define XB_TOP      3328
#define XB_TOPGEN   3392
#define XCD_BAR_WORDS 3456
#define XB_SPIN_CAP (1u << 18)

__device__ __forceinline__ unsigned xb_ld(unsigned* p)              { return __hip_atomic_load(p, __ATOMIC_RELAXED, __HIP_MEMORY_SCOPE_AGENT); }
__device__ __forceinline__ unsigned xb_add(unsigned* p, unsigned v) { return __hip_atomic_fetch_add(p, v, __ATOMIC_RELAXED, __HIP_MEMORY_SCOPE_AGENT); }
__device__ __forceinline__ unsigned xb_xcc_id() { return (unsigned)__builtin_amdgcn_s_getreg((3 << 11) | 20) & 0xFu; }
#define XB_SPIN(cond, bar) do { unsigned _sp = 0; while (cond) { __builtin_amdgcn_s_sleep(1); \
    if ((++_sp & 255u) == 0u) { if (xb_ld(&(bar)[XB_TMO])) break; if (_sp > XB_SPIN_CAP) { atomicAdd(&(bar)[XB_TMO], 1u); break; } } } } while (0)

struct XcdBarrier {
    unsigned* bar; unsigned x;
    volatile LAS unsigned* st;
};

__device__ __forceinline__ XcdBarrier xcd_barrier_post(unsigned* bar, volatile LAS unsigned* st, bool leader) {
    XcdBarrier b; b.bar = bar; b.x = xb_xcc_id(); b.st = st;
    if (leader) (void)xb_add(&bar[XB_XCNT(b.x)], 1u);
    return b;
}
__device__ __forceinline__ void xcd_barrier_complete(unsigned* bar, unsigned x, unsigned& nloc, unsigned& nx) {
    const unsigned G = gridDim.x * gridDim.y * gridDim.z;
    unsigned sum, cnt, mine, sp = 0u;
    for (;;) {
        sum = 0u; cnt = 0u; mine = 0u;
#pragma unroll
        for (unsigned j = 0; j < 16; ++j) { const unsigned c = xb_ld(&bar[XB_XCNT(j)]); sum += c; cnt += (c > 0u) ? 1u : 0u; mine = (j == x) ? c : mine; }
        if (sum == G) break;
        __builtin_amdgcn_s_sleep(1);
        if ((++sp & 255u) == 0u) { if (xb_ld(&bar[XB_TMO])) break; if (sp > XB_SPIN_CAP) { atomicAdd(&bar[XB_TMO], 1u); break; } }
    }
    nloc = mine > 0u ? mine : 1u; nx = cnt > 0u ? cnt : 1u;
}

__device__ __forceinline__ void xcd_barrier(const XcdBarrier& b, bool leader) {
    asm volatile("s_waitcnt vmcnt(0)" ::: "memory");
    __syncthreads();
    if (leader) {
        unsigned* bar = b.bar;
        __builtin_amdgcn_s_waitcnt(0);
        unsigned nloc = b.st[0], nx = b.st[1];
        if (nloc == 0u) { xcd_barrier_complete(bar, b.x, nloc, nx); b.st[0] = nloc; b.st[1] = nx; }
        const unsigned old = xb_add(&bar[XB_XSUB(b.x)], 1u);
        const unsigned gen = old / nloc;
        if (old + 1u == (gen + 1u) * nloc) {
            __builtin_amdgcn_fence(__ATOMIC_RELEASE, "agent");
            asm volatile("s_waitcnt vmcnt(0)" ::: "memory");
            const unsigned og = xb_add(&bar[XB_TOP], 1u);
            const unsigned tg = og / nx;
            if (og + 1u == (tg + 1u) * nx) xb_add(&bar[XB_TOPGEN], 1u);
            else XB_SPIN(xb_ld(&bar[XB_TOPGEN]) == tg, bar);
            __builtin_amdgcn_fence(__ATOMIC_ACQUIRE, "agent");
            xb_add(&bar[XB_XGEN(b.x)], 1u);
            asm volatile("s_waitcnt vmcnt(0)" ::: "memory");
        } else {
            XB_SPIN(xb_ld(&bar[XB_XGEN(b.x)]) == gen, bar);
            __builtin_amdgcn_fence(__ATOMIC_ACQUIRE, "agent");
            asm volatile("s_waitcnt vmcnt(0)" ::: "memory");
        }
    }
    __syncthreads();
}

#ifndef TIMING_BOUNDARY
#define TIMING_BOUNDARY -1
#endif
#define TPROBE(k) do { if (TIMING_BOUNDARY == (k)) { const unsigned long long t1_ = __builtin_amdgcn_s_memrealtime(); while (__builtin_amdgcn_s_memrealtime() - t1_ < t1_ - tstart_) __builtin_amdgcn_s_sleep(8); } } while (0)
__global__ void __launch_bounds__(NTHREADS) fwd_megakernel(Params p) {
    extern __shared__ __attribute__((aligned(16))) unsigned char lds[];
    cg::grid_group grid = cg::this_grid();
    const int nb = gridDim.x, bid = blockIdx.x;
    const int wv = __builtin_amdgcn_readfirstlane(threadIdx.x >> 6);
    unsigned char* ws = p.ws;
    const unsigned long long tstart_ = (TIMING_BOUNDARY >= 0) ? __builtin_amdgcn_s_memrealtime() : 0ull; (void)tstart_;
    PG8_LAS unsigned char* ldsp = (PG8_LAS unsigned char*)lds;
    const bool leader = (wv == 0) && (lane_id() == 0);
    volatile LAS unsigned* bst = (volatile LAS unsigned*)(ldsp + LDS_BYTES - 64);
    if (leader) { bst[0] = 0u; bst[1] = 0u; }
    __syncthreads();
    const XcdBarrier xbar = xcd_barrier_post((unsigned*)(ws + OFF_BAR), bst, leader);

    ph_prep(p, wv, lds);
    if (p.ws == nullptr) grid.sync();
    xcd_barrier(xbar, leader);
    TPROBE(0);
    {
        pg8::Gemm g{(const bf16*)(ws + OFF_XB), (const bf16*)(ws + OFF_WIN), T, NPROJ_PAD, 1024, 1024, 0, 1 << 30, 0l};
        pg8::StaticOrder S; S.init(T, NPROJ_PAD, nb, bid);
        pg8::EpiInProjPg E{(bf16*)(ws + OFF_Z), (bf16*)(ws + OFF_XBC), (bf16*)(ws + OFF_Q), (bf16*)(ws + OFF_KVS), (bf16*)(ws + OFF_DTG)};
        pg8::gemm_phase<pg8::EpiInProjPg, pg8::StaticOrder, pg8::NoMid, true, true>(wv, ldsp, g, S, E, pg8::NoMid{});
    }
    xcd_barrier(xbar, leader);
    TPROBE(1);
    if (bid < 32) {
        const bool isv = bid >= 16;
        pg8::Gemm g{(const bf16*)(ws + OFF_KVS) + (isv ? 256 : 0), (const bf16*)(ws + (isv ? OFF_W1V : OFF_W1K)), 4096, 256, 2048, 0, 1, 1 << 30, 0l};
        pg8::StaticOrder S; S.init(4096, 256, 16, isv ? bid - 16 : bid);
        pg8::EpiBf16<1> E{(bf16*)(ws + OFF_HID + (isv ? 2 * MiB : 0)), 256, (const float*)(ws + (isv ? OFF_B1V : OFF_B1K)), 0, 0, 1.f};
        pg8::gemm_phase<pg8::EpiBf16<1>, pg8::StaticOrder, pg8::NoMid, true, true>(wv, ldsp, g, S, E, pg8::NoMid{});
    }
    else ph_tokprep(p, wv);
    xcd_barrier(xbar, leader);
    TPROBE(2);
    ph_ssd_prep2(p, wv, lds);
    ph_vt_prep(p, wv);
    xcd_barrier(xbar, leader);
    TPROBE(3);
    {
        RowMajorBf16 ak{(const bf16*)(ws + OFF_HID), 256}, av{(const bf16*)(ws + OFF_HID + 2 * MiB), 256};
        RowMajorBf16 bk{(const bf16*)(ws + OFF_W2K), 256}, bv{(const bf16*)(ws + OFF_W2V), 256};
        EpiKc ek{(bf16*)(ws + OFF_KC), false}, ev{(bf16*)(ws + OFF_VCT), true};
        gemm_wave32(wv, 4096 / 32, 64 / 32, 256, ak, bk, ek);
        gemm_wave32(wv, 4096 / 32, 64 / 32, 256, av, bv, ev);
    }
    ph_ssd_states(p, wv);
    xcd_barrier(xbar, leader);
    TPROBE(4);
    ph_kc_rope(p, wv);
    ph_ssd_scan(p, wv);
    ph_peer_cvt(p, wv);
    xcd_barrier(xbar, leader);
    TPROBE(5);
    ph_ssd_out(p, wv, lds);
    ph_nsa(p, wv, lds);
    xcd_barrier(xbar, leader);
    TPROBE(6);
    {
        pg8::Gemm g{(const bf16*)(ws + OFF_Q), (const bf16*)(ws + OFF_WOUT), T, 1024, 2048, 1024, 0, 16, (long)OFF_Z - (long)OFF_Q - 16l * 128l};
        pg8::StaticOrder S; S.init(T, 1024, nb, bid);
        pg8::RmsFactors rf{(const float*)(ws + OFF_SSQ), (const float*)(ws + OFF_HID), RMS_EPS};
        pg8::EpiOutProj E{p.x, p.out, DN_ALPHA, rf}; pg8::MidRmsScale MH{rf};
        pg8::gemm_phase<pg8::EpiOutProj, pg8::StaticOrder, pg8::MidRmsScale, true, true>(wv, ldsp, g, S, E, MH);
    }
    xcd_barrier(xbar, leader);
    TPROBE(7);
    ph_ln1(p, wv);
    xcd_barrier(xbar, leader);
    TPROBE(8);
    {
        pg8::Gemm g{(const bf16*)(ws + OFF_H1B), (const bf16*)(ws + OFF_WQ), T, 2048, 1024, 1024, 0, 1 << 30, 0l};
        pg8::StaticOrder S; S.init(T, 2048, nb, bid);
        pg8::EpiBf16<0> E{(bf16*)(ws + OFF_QP), 2048, nullptr, 0, 0, 1.f};
        pg8::gemm_phase<pg8::EpiBf16<0>, pg8::StaticOrder, pg8::NoMid, true, true>(wv, ldsp, g, S, E, pg8::NoMid{});
    }
    xcd_barrier(xbar, leader);
    TPROBE(9);
    ph_peer_topk(p, wv, lds);
    xcd_barrier(xbar, leader);
    TPROBE(10);
    ph_peer_u(p, wv);
    xcd_barrier(xbar, leader);
    TPROBE(11);
    ph_peer_c(p, wv);
    xcd_barrier(xbar, leader);
    TPROBE(12);
    ph_peer_v(p, wv);
    xcd_barrier(xbar, leader);
    TPROBE(13);
    ph_peer_ln2(p, wv);
}

extern "C" void kernel_launch(void* const* d_in, const int* in_sizes, int n_in, void* d_out, int out_size, void* d_ws, size_t ws_size, hipStream_t stream) {
    static int grid_blocks = 0;
    if (!grid_blocks) {
        int dev = 0, cus = 0, per_cu = 0;
        hipGetDevice(&dev);
        hipDeviceGetAttribute(&cus, hipDeviceAttributeMultiprocessorCount, dev);
        hipFuncSetAttribute((const void*)fwd_megakernel, hipFuncAttributeMaxDynamicSharedMemorySize, LDS_BYTES);
        hipOccupancyMaxActiveBlocksPerMultiprocessor(&per_cu, fwd_megakernel, NTHREADS, LDS_BYTES);
        if (per_cu < 1) per_cu = 1;
        if (per_cu > 1) per_cu = 1;
        grid_blocks = cus * per_cu;
        if (ws_size < 244 * MiB) fprintf(stderr, "kernel_launch: workspace too small: %zu\n", ws_size);
    }
    Params p{};
    const float** pp = (const float**)&p;
    for (int i = 0; i < 24; ++i) pp[i] = (const float*)d_in[i];
    p.out = (float*)d_out; p.ws = (unsigned char*)d_ws;
    (void)hipMemsetAsync((unsigned char*)d_ws + OFF_BAR, 0, BAR_BYTES, stream);
    void* args[] = {&p};
    hipError_t e = hipLaunchCooperativeKernel((void*)fwd_megakernel, dim3(grid_blocks), dim3(NTHREADS), args, LDS_BYTES, stream);
    if (e != hipSuccess) fprintf(stderr, "cooperative launch failed: %s (grid %d)\n", hipGetErrorString(e), grid_blocks);
}
```

```cpp
#include <hip/hip_runtime.h>
#include <hip/hip_cooperative_groups.h>
#include <cstdio>
#include <cstdint>
namespace cg = cooperative_groups;

typedef unsigned short bf16;
typedef short bf16x8 __attribute__((ext_vector_type(8)));
typedef float f32x4 __attribute__((ext_vector_type(4)));
typedef float f32x16 __attribute__((ext_vector_type(16)));
typedef unsigned long long u64;

constexpr int T = 16384, L = 4096, NBATCH = 4, D = 1024;
constexpr int NPROJ = 5184, NPROJ_PAD = 5376;
constexpr int NTHREADS = 512, NWAVES = 8;
constexpr float LN_EPS = 1e-5f, RMS_EPS = 1e-5f;
constexpr float DN_ALPHA = 1.189207115002721f;
constexpr float NEG_INF = -1e30f, BIG = 1e30f;

constexpr size_t MiB = 1u << 20;
constexpr size_t OFF_SSQ = 0, OFF_BAR = 512 * 1024, BAR_BYTES = 16384;
constexpr size_t OFF_WOUT = 1 * MiB, OFF_WQ = 5 * MiB, OFF_W1K = 9 * MiB, OFF_W1V = 10 * MiB;
constexpr size_t OFF_W2K = 11 * MiB, OFF_W2V = 11 * MiB + 65536, OFF_B1K = 11 * MiB + 131072, OFF_B1V = 11 * MiB + 131072 + 4096;
constexpr size_t OFF_KEYS = 12 * MiB, OFF_ROPE = 13 * MiB, OFF_DT = 14 * MiB, OFF_ACS = 15 * MiB, OFF_GATE = 16 * MiB;
constexpr size_t OFF_HID = 20 * MiB, OFF_KC = 24 * MiB;
constexpr size_t OFF_Z = 26 * MiB, OFF_Q = 58 * MiB, OFF_KVS = 90 * MiB, OFF_XBC = 138 * MiB, OFF_XSBC = 186 * MiB, OFF_BT = 234 * MiB, OFF_DTG = 242 * MiB;
constexpr size_t OFF_VST = 138 * MiB, OFF_VWT = 146 * MiB, OFF_VCT = 19 * MiB;
constexpr size_t OFF_XB = 186 * MiB, OFF_WIN = 218 * MiB;
constexpr size_t OFF_H1B = 90 * MiB, OFF_QP = 26 * MiB, OFF_EIDX = 202 * MiB, OFF_GW = 210 * MiB;
constexpr size_t OFF_PU = 154 * MiB, OFF_PV = 170 * MiB;
constexpr int LDS_BYTES = 147456;

struct Params {
    const float *x, *w_in, *conv_w, *conv_b, *dt_bias, *a_log, *d_skip, *ssd_norm_w;
    const float *cmp_pos_k, *cmp_w1_k, *cmp_w2_k, *cmp_pos_v, *cmp_w1_v, *cmp_w2_v;
    const float *attn_norm_w, *w_out, *ln1_g, *ln1_b, *peer_wq, *peer_keys, *peer_u, *peer_v, *ln2_g, *ln2_b;
    float* out; unsigned char* ws;
};

__device__ __forceinline__ float bf2f(bf16 v) { return __uint_as_float((unsigned)v << 16); }
__device__ __forceinline__ bf16 f2bf(float f) { unsigned u = __float_as_uint(f); return (bf16)((u + 0x7fffu + ((u >> 16) & 1u)) >> 16); }
__device__ __forceinline__ int lane_id() { int l = (int)__builtin_amdgcn_mbcnt_hi(~0u, __builtin_amdgcn_mbcnt_lo(~0u, 0u)); asm volatile("" : "+v"(l)); return l; }
#define PH_IDS() const int lane = lane_id(); const int tid = (wv << 6) | lane; const int bid = blockIdx.x, nb = gridDim.x; const int gtid = bid * NTHREADS + tid, gn = nb * NTHREADS; const int gwave = bid * NWAVES + wv, nwaves = nb * NWAVES; (void)gtid; (void)gn; (void)gwave; (void)nwaves;
typedef float f32x2v __attribute__((ext_vector_type(2)));
typedef __bf16 bf16x2v __attribute__((ext_vector_type(2)));
__device__ __forceinline__ unsigned pk2bf(float lo, float hi) { f32x2v v = {lo, hi}; bf16x2v b = __builtin_convertvector(v, bf16x2v); return __builtin_bit_cast(unsigned, b); }
__device__ __forceinline__ float bflo(unsigned w) { return __uint_as_float(w << 16); }
__device__ __forceinline__ float bfhi(unsigned w) { return __uint_as_float(w & 0xffff0000u); }
__device__ __forceinline__ float wave_sum(float v) {
#pragma unroll
    for (int o = 1; o < 64; o <<= 1) v += __shfl_xor(v, o);
    return v;
}
__device__ __forceinline__ float wave_max(float v) {
#pragma unroll
    for (int o = 1; o < 64; o <<= 1) v = fmaxf(v, __shfl_xor(v, o));
    return v;
}
__device__ __forceinline__ float gelu_exact(float v) { return 0.5f * v * (1.0f + erff(v * 0.7071067811865476f)); }
__device__ __forceinline__ float sigmoidf(float v) { return 1.0f / (1.0f + __expf(-v)); }

template <class AP, class BP, class EP>
__device__ __forceinline__ void gemm_wave32(int wv, int Mt, int Nt, int K, const AP& ap, const BP& bp, const EP& ep) {
    PH_IDS(); const int r = lane & 15, q = lane >> 4;
    for (int tile = gwave; tile < Mt * Nt; tile += nwaves) {
        const int tm = tile / Nt, tn = tile % Nt, row0 = tm * 32, col0 = tn * 32;
        f32x4 acc[2][2];
#pragma unroll
        for (int i = 0; i < 2; ++i)
#pragma unroll
            for (int j = 0; j < 2; ++j) acc[i][j] = (f32x4){0.f, 0.f, 0.f, 0.f};
        for (int k0 = 0; k0 < K; k0 += 32) {
            const bf16x8 a0 = ap(row0 + r, k0 + 8 * q), a1 = ap(row0 + 16 + r, k0 + 8 * q);
            const bf16x8 b0 = bp(col0 + r, k0 + 8 * q), b1 = bp(col0 + 16 + r, k0 + 8 * q);
            acc[0][0] = __builtin_amdgcn_mfma_f32_16x16x32_bf16(a0, b0, acc[0][0], 0, 0, 0);
            acc[0][1] = __builtin_amdgcn_mfma_f32_16x16x32_bf16(a0, b1, acc[0][1], 0, 0, 0);
            acc[1][0] = __builtin_amdgcn_mfma_f32_16x16x32_bf16(a1, b0, acc[1][0], 0, 0, 0);
            acc[1][1] = __builtin_amdgcn_mfma_f32_16x16x32_bf16(a1, b1, acc[1][1], 0, 0, 0);
        }
#pragma unroll
        for (int i = 0; i < 2; ++i)
#pragma unroll
            for (int j = 0; j < 2; ++j)
#pragma unroll
                for (int e = 0; e < 4; ++e) ep(row0 + 16 * i + 4 * q + e, col0 + 16 * j + r, acc[i][j][e]);
    }
}
struct RowMajorBf16 { const bf16* p; int ld; __device__ __forceinline__ bf16x8 operator()(int row, int k) const { return *(const bf16x8*)(p + (size_t)row * ld + k); } };

namespace pg8 {
#define PG8_LAS __attribute__((address_space(3)))
typedef unsigned short bf16_t;
typedef short bf16x8 __attribute__((ext_vector_type(8)));
typedef float f32x4 __attribute__((ext_vector_type(4)));
typedef unsigned u32x4 __attribute__((ext_vector_type(4)));
constexpr int BM = 256, BK = 64, HALF = 128, HTB = HALF * BK * 2  , STAGE_BYTES = 8 * HTB, NXCD = 8, WGM = 8;

__host__ __device__ __forceinline__ int lds_byte(int r, int c) { const int st = (r >> 4) * 2 + (c >> 5), rr = r & 15, cc = c & 31, ob = rr * 64 + cc * 2; return st * 1024 + (ob ^ (((ob >> 9) & 1) << 5)); }
__host__ __device__ __forceinline__ void stage_rc(int b, int& R, int& C) { const int st = b / 1024, sb = b % 1024, swz = sb ^ (((sb >> 9) & 1) << 5); R = (st >> 1) * 16 + swz / 64; C = (st & 1) * 32 + (swz % 64) / 2; }
__host__ __device__ __forceinline__ int perm32(int rho) { const int n = rho >> 4, i = rho & 15; return 8 * (i >> 2) + 4 * n + (i & 3); }

struct Unit { int pm, pn; };
struct Gemm { const bf16_t* A; const bf16_t* Bt; int M, N, K; int lda; int amode; int ksplit; long kdelta; };

struct StaticOrder {
    int nM, nN, nwg, G, c;
    __host__ __device__ void init(int M, int N, int G_, int c_) { nM = M / BM; nN = N / BM; nwg = nM * nN; G = G_; c = c_; }
    __host__ __device__ bool next(int i, Unit& u) const {
        const long L = (long)i * G + c; if (L >= nwg) return false;
        int wgid = (int)L; { const int q = nwg / NXCD, r = nwg % NXCD, xcd = wgid % NXCD, off = wgid / NXCD; wgid = (xcd < r ? xcd * (q + 1) : r * (q + 1) + (xcd - r) * q) + off; }
        const int nig = WGM * nN, gid = wgid / nig, fm = gid * WGM, gsz = (nM - fm) < WGM ? (nM - fm) : WGM;
        u.pm = fm + ((wgid % nig) % gsz); u.pn = (wgid % nig) / gsz; return true;
    }
    __device__ __forceinline__ void a_ready(const Unit&) const {}
    __device__ __forceinline__ void done(const Unit&) const {}
};


__device__ __forceinline__ unsigned cvt_pk_bf16(float lo, float hi) { unsigned r; asm volatile("v_cvt_pk_bf16_f32 %0, %1, %2" : "=v"(r) : "v"(lo), "v"(hi)); return r; }
typedef float f32x2 __attribute__((ext_vector_type(2)));
__device__ __forceinline__ f32x2 gelu_pk(f32x2 v) {
    const f32x2 av = __builtin_elementwise_abs(v), d = av * 0.2316418882f + 1.0f;
    f32x2 t; t.x = __builtin_amdgcn_rcpf(d.x); t.y = __builtin_amdgcn_rcpf(d.y);
    f32x2 q = t * 0.5307027145f + (-0.7265760135f); q = q * t + 0.7107068705f; q = q * t + (-0.142248368f); q = q * t + 0.127414796f; q = q * t;
    const f32x2 s = (v * v) * (-0.72134752044f);
    f32x2 e; e.x = __builtin_amdgcn_exp2f(s.x); e.y = __builtin_amdgcn_exp2f(s.y);
    const f32x2 m = v * (q * e), r = v - m;
    f32x2 o; o.x = v.x < 0.f ? m.x : r.x; o.y = v.y < 0.f ? m.y : r.y; return o;
}

template <int ACT  > struct EpiBf16 {
    static constexpr bool PERM = true, AFTER_DRAIN = false; static_assert(ACT == 0 || ACT == 1, "EpiBf16: ACT is 0 (none) or 1 (gelu_pk)");
    bf16_t* O; int ldc; const float* bias; int split_cols; size_t split_stride; float scale0;
    __device__ __forceinline__ void operator()(const f32x4 (&acc)[2][2][4][2], const Unit& u, int wr, int wc, int fr, int fq) const {
        const int row0 = u.pm * BM + wr * 64 + fr; int colt = u.pn * BM; bf16_t* base = O;
        float sc = 1.f; if (split_cols) { const int t = colt / split_cols; base += (size_t)t * split_stride; colt -= t * split_cols; if (t == 0) sc = scale0; }
        const int col0 = colt + wc * 32 + 8 * fq, bcol0 = u.pn * BM + wc * 32 + 8 * fq;
        f32x4 bv[2][2];
#pragma unroll
        for (int bj = 0; bj < 2; ++bj)
#pragma unroll
            for (int n = 0; n < 2; ++n) bv[bj][n] = bias ? *(const f32x4*)(bias + bcol0 + bj * HALF + 4 * n) : (f32x4){0.f, 0.f, 0.f, 0.f};
#pragma unroll
        for (int ai = 0; ai < 2; ++ai)
#pragma unroll
            for (int m = 0; m < 4; ++m) { bf16_t* rowp = base + (size_t)(row0 + ai * HALF + m * 16) * ldc + col0;
#pragma unroll
                for (int bj = 0; bj < 2; ++bj) { f32x4 v0 = acc[ai][bj][m][0] + bv[bj][0], v1 = acc[ai][bj][m][1] + bv[bj][1];
                    if (ACT == 1) { f32x2 a = gelu_pk((f32x2){v0[0], v0[1]}), b = gelu_pk((f32x2){v0[2], v0[3]}), c = gelu_pk((f32x2){v1[0], v1[1]}), d = gelu_pk((f32x2){v1[2], v1[3]});
                        v0 = (f32x4){a.x, a.y, b.x, b.y}; v1 = (f32x4){c.x, c.y, d.x, d.y}; }
                    v0 = v0 * sc; v1 = v1 * sc; u32x4 w; w.x = cvt_pk_bf16(v0[0], v0[1]); w.y = cvt_pk_bf16(v0[2], v0[3]); w.z = cvt_pk_bf16(v1[0], v1[1]); w.w = cvt_pk_bf16(v1[2], v1[3]);
                    *(u32x4*)(rowp + bj * HALF) = w; } }
    }
};

struct EpiInProjPg { static constexpr bool PERM = true, AFTER_DRAIN = false;
    bf16_t *z, *xbc, *q, *kvs, *dtg;
    __device__ __forceinline__ void operator()(const f32x4 (&acc)[2][2][4][2], const Unit& u, int wr, int wc, int fr, int fq) const {
        bf16_t* base; int ldc, colt; const int pn = u.pn;
        if (pn < 4) { base = z; ldc = 1024; colt = pn * 256; } else if (pn < 10) { base = xbc; ldc = 1536; colt = (pn - 4) * 256; }
        else if (pn < 14) { base = q; ldc = 1024; colt = (pn - 10) * 256; } else if (pn < 20) { base = kvs; ldc = 1536; colt = (pn - 14) * 256; }
        else { base = dtg; ldc = 64; colt = 0; }
        const int row0 = u.pm * BM + wr * 64 + fr, col0 = colt + wc * 32 + 8 * fq;
#pragma unroll
        for (int ai = 0; ai < 2; ++ai)
#pragma unroll
            for (int m = 0; m < 4; ++m) { bf16_t* rowp = base + (size_t)(row0 + ai * HALF + m * 16) * ldc + col0;
#pragma unroll
                for (int bj = 0; bj < 2; ++bj) { const f32x4 v0 = acc[ai][bj][m][0], v1 = acc[ai][bj][m][1];
                    u32x4 w; w.x = cvt_pk_bf16(v0[0], v0[1]); w.y = cvt_pk_bf16(v0[2], v0[3]); w.z = cvt_pk_bf16(v1[0], v1[1]); w.w = cvt_pk_bf16(v1[2], v1[3]);
                    if (pn < 20 || (bj == 0 && wc < 2)) *(u32x4*)(rowp + bj * HALF) = w; } }
    }
};
struct RmsFactors { const float* ssqp; const float* ssq2p; float eps;
    __device__ __forceinline__ void get(int row, float& ra, float& r0, float& r1) const {
        const f32x4 a = *(const f32x4*)(ssqp + 4 * row); const f32x4 b0 = *(const f32x4*)(ssq2p + 16 * row), b1 = *(const f32x4*)(ssq2p + 16 * row + 4), b2 = *(const f32x4*)(ssq2p + 16 * row + 8), b3 = *(const f32x4*)(ssq2p + 16 * row + 12);
        ra = rsqrtf(((a[0] + a[1]) + (a[2] + a[3])) * (1.0f / 1024.0f) + eps);
        r0 = rsqrtf((((b0[0] + b0[1]) + (b0[2] + b0[3])) + ((b1[0] + b1[1]) + (b1[2] + b1[3]))) * (1.0f / 512.0f) + eps);
        r1 = rsqrtf((((b2[0] + b2[1]) + (b2[2] + b2[3])) + ((b3[0] + b3[1]) + (b3[2] + b3[3]))) * (1.0f / 512.0f) + eps); } };
struct EpiOutProj { static constexpr bool PERM = false, AFTER_DRAIN = false;
    const float* x; float* out; float alpha; RmsFactors rf;
    __device__ __forceinline__ void operator()(const f32x4 (&acc)[2][2][4][2], const Unit& u, int wr, int wc, int fr, int fq) const {
        const int col0 = u.pn * BM + wc * 32 + 4 * fq;
#pragma unroll
        for (int ai = 0; ai < 2; ++ai)
#pragma unroll
            for (int m = 0; m < 4; ++m) { const int row = u.pm * BM + ai * HALF + wr * 64 + m * 16 + fr; const size_t off = (size_t)row * 1024 + col0;
                float ra, r0, r1; rf.get(row, ra, r0, r1);
#pragma unroll
                for (int bj = 0; bj < 2; ++bj)
#pragma unroll
                    for (int n = 0; n < 2; ++n) { const size_t o = off + bj * HALF + n * 16; const f32x4 xv = *(const f32x4*)(x + o); *(f32x4*)(out + o) = xv * alpha + acc[ai][bj][m][n] * r1; } }
    }
};
struct MidRmsScale { static constexpr bool ENABLED = true; RmsFactors rf;
    __device__ __forceinline__ void operator()(f32x4 (&acc)[2][2][4][2], const Unit& u, int t, int wr, int wc, int fr, int fq) const {
        if (t != 16 && t != 24) return;
        int rowb = u.pm * BM + wr * 64 + fr; asm volatile("" : "+v"(rowb));
#pragma unroll
        for (int ai = 0; ai < 2; ++ai)
#pragma unroll
            for (int m = 0; m < 4; ++m) { float ra, r0, r1; rf.get(rowb + ai * HALF + m * 16, ra, r0, r1);
                const float sc = (t == 16) ? ra / r0 : r0 / r1;
#pragma unroll
                for (int bj = 0; bj < 2; ++bj)
#pragma unroll
                    for (int n = 0; n < 2; ++n) acc[ai][bj][m][n] = acc[ai][bj][m][n] * sc; }
    }
};
struct NoMid { static constexpr bool ENABLED = false; template <class ACC> __device__ __forceinline__ void operator()(ACC&, const Unit&, int, int, int, int, int) const {} };
template <class Epi, class Sched, class Mid, bool ALIGN_EPI = false, bool SP2 = false>
__device__ __forceinline__ void gemm_phase(int wv, PG8_LAS unsigned char* lds, const Gemm g, const Sched& S, const Epi& E, const Mid& MH) {
    int lane_ = (int)__builtin_amdgcn_mbcnt_hi(~0u, __builtin_amdgcn_mbcnt_lo(~0u, 0u)); asm volatile("" : "+v"(lane_));
    const int lane = lane_, wid = wv, tid = (wv << 6) | lane, wr = wid >> 2, wc = wid & 3, fr = lane & 15, fq = lane >> 4;
    const int K = g.K, nt = K / BK;
    unsigned voffA[2], voffB[2];
#pragma unroll
    for (int i = 0; i < 2; ++i) { int R, C; stage_rc(tid * 16 + i * 8192, R, C); const int Rb = Epi::PERM ? ((R & ~31) + perm32(R & 31)) : R;
        voffA[i] = g.amode == 0 ? (unsigned)(R * g.lda + C) * 2u : (unsigned)((R >> 2) * 49152 + (R & 3) * 128 + C * 2); voffB[i] = (unsigned)(Rb * K + C) * 2u; }
    const size_t kstep = (size_t)(BK * 2);
    const size_t hstep = (size_t)HALF * K * 2;
    const size_t tstep = 2 * hstep;
    const size_t kstepA = g.amode == 0 ? (size_t)(BK * 2) : (size_t)3072;
    const size_t hstepA = g.amode == 0 ? (size_t)HALF * g.lda * 2 : (size_t)32 * 49152;
    const size_t tstepA = 2 * hstepA;
#define PG8_AK(base, t) ((base) + (size_t)(t) * kstepA + (((t) >= g.ksplit) ? g.kdelta : 0l))
    const unsigned ldsw = (unsigned)wid * 1024u;
    const int aoff = lds_byte(wr * 64 + fr, fq * 8), boff = lds_byte(wc * 32 + fr, fq * 8);
#define PG8_SA(b, h) (((b) * 2 + (h)) * HTB)
#define PG8_SB(b, h) ((4 + (b) * 2 + (h)) * HTB)
#define PG8_STAGE(bufoff, gbase, voff) do { _Pragma("unroll") for (int _i = 0; _i < 2; ++_i) \
        __builtin_amdgcn_global_load_lds((const unsigned*)((const char*)(gbase) + (voff)[_i]), (PG8_LAS unsigned*)(lds + (bufoff) + ldsw + _i * 8192), 16, 0, 0); } while (0)
#define PG8_LDA(dst, b, h) do { _Pragma("unroll") for (int m = 0; m < 4; ++m) _Pragma("unroll") for (int k = 0; k < 2; ++k) dst[m][k] = *(const PG8_LAS bf16x8*)(lds + PG8_SA(b, h) + aoff + m * 2048 + k * 1024); } while (0)
#define PG8_LDB(dst, b, h) do { _Pragma("unroll") for (int n = 0; n < 2; ++n) _Pragma("unroll") for (int k = 0; k < 2; ++k) dst[n][k] = *(const PG8_LAS bf16x8*)(lds + PG8_SB(b, h) + boff + n * 2048 + k * 1024); } while (0)
#define PG8_MMA(ai, bj, At, Bt) do { __builtin_amdgcn_s_setprio(1); _Pragma("unroll") for (int m = 0; m < 4; ++m) _Pragma("unroll") for (int n = 0; n < 2; ++n) _Pragma("unroll") for (int k = 0; k < 2; ++k) \
        acc[ai][bj][m][n] = __builtin_amdgcn_mfma_f32_16x16x32_bf16(Bt[n][k], At[m][k], acc[ai][bj][m][n], 0, 0, 0); __builtin_amdgcn_s_setprio(0); } while (0)
#define PG8_WAIT_V(n) asm volatile("s_waitcnt vmcnt(" #n ")" ::: "memory")
#define PG8_WAIT_L(n) asm volatile("s_waitcnt lgkmcnt(" #n ")" ::: "memory")
#define PG8_BAR __builtin_amdgcn_s_barrier()
#define PG8_SCHED __builtin_amdgcn_sched_barrier(0)
    Unit cur, nxt; int ui = 0;
    if (!S.next(0, cur)) return;
    f32x4 acc[2][2][4][2];
#pragma unroll
    for (int a = 0; a < 2; ++a)
#pragma unroll
        for (int b = 0; b < 2; ++b)
#pragma unroll
            for (int m = 0; m < 4; ++m)
#pragma unroll
                for (int n = 0; n < 2; ++n) acc[a][b][m][n] = (f32x4){0.f, 0.f, 0.f, 0.f};
    bf16x8 At[4][2], B0[2][2], B1[2][2];
    const char* cA = (const char*)g.A + (size_t)cur.pm * tstepA; const char* cB = (const char*)g.Bt + (size_t)cur.pn * tstep;
    S.a_ready(cur);
    if constexpr (SP2) {
        PG8_STAGE(PG8_SB(0, 0), cB, voffB); PG8_STAGE(PG8_SB(0, 1), cB + hstep, voffB); PG8_STAGE(PG8_SA(0, 0), cA, voffA); PG8_STAGE(PG8_SA(0, 1), cA + hstepA, voffA);
        if (wr == 1) PG8_BAR;
        PG8_WAIT_V(2); PG8_BAR;
        PG8_STAGE(PG8_SB(1, 0), cB + kstep, voffB); PG8_STAGE(PG8_SA(1, 0), PG8_AK(cA, 1), voffA); PG8_STAGE(PG8_SB(1, 1), cB + hstep + kstep, voffB);
        PG8_WAIT_V(6); PG8_BAR;
    } else {
        PG8_STAGE(PG8_SB(0, 0), cB, voffB); PG8_STAGE(PG8_SA(0, 0), cA, voffA); PG8_STAGE(PG8_SB(0, 1), cB + hstep, voffB); PG8_STAGE(PG8_SA(0, 1), cA + hstepA, voffA);
        if (wr == 1) PG8_BAR;
        PG8_WAIT_V(4); PG8_BAR;
        PG8_STAGE(PG8_SB(1, 0), cB + kstep, voffB); PG8_STAGE(PG8_SA(1, 0), PG8_AK(cA, 1), voffA); PG8_STAGE(PG8_SB(1, 1), cB + hstep + kstep, voffB);
        PG8_WAIT_V(6); PG8_BAR;
    }
    for (;;) {
        const bool has_next = S.next(ui + 1, nxt);
        const char* nA = has_next ? (const char*)g.A + (size_t)nxt.pm * tstepA : cA; const char* nB = has_next ? (const char*)g.Bt + (size_t)nxt.pn * tstep : cB;
        for (int t = 0; t < nt; t += 2) {
            const bool last = (t == nt - 2);
            if (Mid::ENABLED) MH(acc, cur, t, wr, wc, fr, fq);
            const char* a1 = PG8_AK(cA, t + 1);
            const char* a2 = last ? nA : PG8_AK(cA, t + 2); const char* b2 = last ? nB : cB + (size_t)(t + 2) * kstep;
            const char* a3 = a2 + kstepA; const char* b3 = b2 + kstep;
            if (last && has_next) S.a_ready(nxt);
            if constexpr (SP2) {
            PG8_LDB(B0, 0, 0); PG8_LDB(B1, 0, 1); PG8_SCHED; PG8_LDA(At, 0, 0); PG8_STAGE(PG8_SA(1, 1), a1 + hstepA, voffA);
            PG8_WAIT_V(8); PG8_WAIT_L(0); PG8_BAR; PG8_MMA(0, 0, At, B0); PG8_MMA(0, 1, At, B1); PG8_BAR; PG8_SCHED;
            PG8_LDA(At, 0, 1); PG8_STAGE(PG8_SB(0, 0), b2, voffB); PG8_STAGE(PG8_SB(0, 1), b2 + hstep, voffB); PG8_STAGE(PG8_SA(0, 0), a2, voffA);
            PG8_WAIT_V(8); PG8_WAIT_L(0); PG8_BAR; PG8_MMA(1, 0, At, B0); PG8_MMA(1, 1, At, B1); PG8_BAR; PG8_SCHED;
            PG8_LDB(B0, 1, 0); PG8_LDB(B1, 1, 1); PG8_SCHED; PG8_LDA(At, 1, 0); PG8_STAGE(PG8_SA(0, 1), a2 + hstepA, voffA);
            PG8_WAIT_V(8); PG8_WAIT_L(0); PG8_BAR; PG8_MMA(0, 0, At, B0); PG8_MMA(0, 1, At, B1); PG8_BAR; PG8_SCHED;
            PG8_LDA(At, 1, 1); PG8_STAGE(PG8_SB(1, 0), b3, voffB); PG8_STAGE(PG8_SB(1, 1), b3 + hstep, voffB); PG8_STAGE(PG8_SA(1, 0), a3, voffA);
            PG8_WAIT_V(8); PG8_WAIT_L(0); PG8_BAR; PG8_MMA(1, 0, At, B0); PG8_MMA(1, 1, At, B1); PG8_BAR; PG8_SCHED;
            } else {
            PG8_LDB(B0, 0, 0); PG8_SCHED; PG8_LDA(At, 0, 0); PG8_STAGE(PG8_SA(1, 1), a1 + hstepA, voffA);
            PG8_WAIT_L(8); PG8_BAR; PG8_WAIT_L(0); PG8_MMA(0, 0, At, B0); PG8_BAR; PG8_SCHED;
            PG8_LDB(B1, 0, 1); PG8_STAGE(PG8_SB(0, 0), b2, voffB);
            PG8_BAR; PG8_WAIT_L(0); PG8_MMA(0, 1, At, B1); PG8_BAR;
            PG8_LDA(At, 0, 1); PG8_STAGE(PG8_SA(0, 0), a2, voffA);
            PG8_BAR; PG8_WAIT_L(0); PG8_MMA(1, 0, At, B0); PG8_BAR; PG8_SCHED;
            PG8_STAGE(PG8_SB(0, 1), b2 + hstep, voffB);
            PG8_WAIT_V(6); PG8_BAR; PG8_MMA(1, 1, At, B1); PG8_BAR;
            PG8_LDB(B0, 1, 0); PG8_SCHED; PG8_LDA(At, 1, 0); PG8_STAGE(PG8_SA(0, 1), a2 + hstepA, voffA);
            PG8_WAIT_L(8); PG8_BAR; PG8_WAIT_L(0); PG8_MMA(0, 0, At, B0); PG8_BAR; PG8_SCHED;
            PG8_LDB(B1, 1, 1); PG8_STAGE(PG8_SB(1, 0), b3, voffB);
            PG8_BAR; PG8_WAIT_L(0); PG8_MMA(0, 1, At, B1); PG8_BAR;
            PG8_LDA(At, 1, 1); PG8_STAGE(PG8_SA(1, 0), a3, voffA);
            PG8_BAR; PG8_WAIT_L(0); PG8_MMA(1, 0, At, B0); PG8_BAR; PG8_SCHED;
            PG8_STAGE(PG8_SB(1, 1), b3 + hstep, voffB);
            PG8_WAIT_V(6); PG8_BAR; PG8_MMA(1, 1, At, B1); PG8_BAR;
            }
        }
        if constexpr (ALIGN_EPI) { if (wr == 0) PG8_BAR; }
        if constexpr (!Epi::AFTER_DRAIN) { E(acc, cur, wr, wc, fr, fq); S.done(cur); }
        if (!has_next) break;
#pragma unroll
        for (int a = 0; a < 2; ++a)
#pragma unroll
            for (int b = 0; b < 2; ++b)
#pragma unroll
                for (int m = 0; m < 4; ++m)
#pragma unroll
                    for (int n = 0; n < 2; ++n) acc[a][b][m][n] = (f32x4){0.f, 0.f, 0.f, 0.f};
        cur = nxt; cA = nA; cB = nB; ++ui;
        if constexpr (ALIGN_EPI) { if (wr == 1) PG8_BAR; }
    }
    PG8_WAIT_V(0);
    if constexpr (!ALIGN_EPI) { if (wr == 0) PG8_BAR; }
    PG8_BAR;
    if constexpr (Epi::AFTER_DRAIN) { E.fused(acc, cur, wr, wc, fr, fq, lds, wid, lane); S.done(cur); }
#undef PG8_AK
#undef PG8_SA
#undef PG8_SB
#undef PG8_STAGE
#undef PG8_LDA
#undef PG8_LDB
#undef PG8_MMA
#undef PG8_WAIT_V
#undef PG8_WAIT_L
#undef PG8_BAR
#undef PG8_SCHED
}
}

__device__ __forceinline__ int winmap(int n) { return n < 2560 ? n : (n < 5120 ? n + 16 : (n < 5136 ? 2560 + (n - 5120) : n)); }
template <class Map>
__device__ __forceinline__ void transpose_item(const float* W, int ldw, bf16* WT, int K, int item, int nblk, float* scr, int lane, const Map& mp) {
    const int kb = item / nblk, nbk = item % nblk, k0 = 64 * kb, n0 = 32 * nbk;
    const int col = mp.scol(n0 + (lane & 31));
#pragma unroll 8
    for (int i = 0; i < 32; ++i) { const int kk = 2 * i + (lane >> 5); scr[kk * 33 + (lane & 31)] = col >= 0 ? W[(size_t)mp.srow(k0 + kk) * ldw + col] * mp.scale(k0 + kk) : 0.f; }
    const int c = lane & 7;
#pragma unroll
    for (int j = 0; j < 4; ++j) { const int n = (lane >> 3) + 8 * j; const float* s = scr + (8 * c) * 33 + n;
        *(uint4*)(WT + (size_t)(n0 + n) * K + k0 + 8 * c) = make_uint4(pk2bf(s[0], s[33]), pk2bf(s[66], s[99]), pk2bf(s[132], s[165]), pk2bf(s[198], s[231])); }
}
struct MapPlain { __device__ __forceinline__ int srow(int k) const { return k; } __device__ __forceinline__ int scol(int n) const { return n; } __device__ __forceinline__ float scale(int) const { return 1.f; } };
struct MapWin { __device__ __forceinline__ int srow(int k) const { return k; } __device__ __forceinline__ int scol(int n) const { return n < NPROJ ? winmap(n) : -1; } __device__ __forceinline__ float scale(int) const { return 1.f; } };
struct MapWout { const float* an; const float* sn;
    __device__ __forceinline__ int srow(int k) const { return (k + 1024) & 2047; } __device__ __forceinline__ int scol(int n) const { return n; } __device__ __forceinline__ float scale(int k) const { return k < 1024 ? an[k] : sn[k - 1024]; } };
__device__ __forceinline__ void ph_prep(const Params& p, int wv, unsigned char* lds) {
    PH_IDS(); unsigned char* ws = p.ws;
    bf16* xb = (bf16*)(ws + OFF_XB);
    for (size_t i = gtid; i < (size_t)T * D / 8; i += gn) { const float4 v = ((const float4*)p.x)[2 * i], w = ((const float4*)p.x)[2 * i + 1]; ((uint4*)xb)[i] = make_uint4(pk2bf(v.x, v.y), pk2bf(v.z, v.w), pk2bf(w.x, w.y), pk2bf(w.z, w.w)); }
    {
        float* scr = (float*)(lds + wv * 8448);
        constexpr int I_WIN = 16 * 168, I_WOUT = 32 * 32, I_WQ = 16 * 64, I_W1 = 32 * 8, I_W2 = 4 * 2;
        constexpr int NIT = I_WIN + I_WOUT + I_WQ + 2 * I_W1 + 2 * I_W2;
        for (int it = gwave; it < NIT; it += nwaves) {
            int r = it;
            if (r < I_WIN) { transpose_item(p.w_in, NPROJ, (bf16*)(ws + OFF_WIN), 1024, r, 168, scr, lane, MapWin{}); continue; } r -= I_WIN;
            if (r < I_WOUT) { transpose_item(p.w_out, 1024, (bf16*)(ws + OFF_WOUT), 2048, r, 32, scr, lane, MapWout{p.attn_norm_w, p.ssd_norm_w}); continue; } r -= I_WOUT;
            if (r < I_WQ) { transpose_item(p.peer_wq, 2048, (bf16*)(ws + OFF_WQ), 1024, r, 64, scr, lane, MapPlain{}); continue; } r -= I_WQ;
            if (r < I_W1) { transpose_item(p.cmp_w1_k, 256, (bf16*)(ws + OFF_W1K), 2048, r, 8, scr, lane, MapPlain{}); continue; } r -= I_W1;
            if (r < I_W1) { transpose_item(p.cmp_w1_v, 256, (bf16*)(ws + OFF_W1V), 2048, r, 8, scr, lane, MapPlain{}); continue; } r -= I_W1;
            if (r < I_W2) { transpose_item(p.cmp_w2_k, 64, (bf16*)(ws + OFF_W2K), 256, r, 2, scr, lane, MapPlain{}); continue; } r -= I_W2;
            transpose_item(p.cmp_w2_v, 64, (bf16*)(ws + OFF_W2V), 256, r, 2, scr, lane, MapPlain{});
        }
    }
    bf16* keys = (bf16*)(ws + OFF_KEYS);
    for (int i = gtid; i < 8 * 2 * 128 * 128; i += gn) keys[i] = f2bf(p.peer_keys[i]);
    float* rc = (float*)(ws + OFF_ROPE); float* rs = rc + 4096 * 32;
    for (int i = gtid; i < 4096 * 32; i += gn) {
        const int pos = i >> 5, j = i & 31;
        const float inv = powf(10000.0f, -(float)(2 * j) / 64.0f); const float angf = (float)pos * inv;
        double xr = (double)angf * 0.15915494309189535; xr -= rint(xr); const double rr = xr * 6.283185307179586, r2 = rr * rr;
        double s = -1.0 / 10888869450418352160768000000.0, c = 1.0 / 403291461126605635584000000.0;
        s = s * r2 + 1.0 / 15511210043330985984000000.0;  c = c * r2 - 1.0 / 620448401733239439360000.0;
        s = s * r2 - 1.0 / 25852016738884976640000.0;     c = c * r2 + 1.0 / 1124000727777607680000.0;
        s = s * r2 + 1.0 / 51090942171709440000.0;        c = c * r2 - 1.0 / 2432902008176640000.0;
        s = s * r2 - 1.0 / 121645100408832000.0;          c = c * r2 + 1.0 / 6402373705728000.0;
        s = s * r2 + 1.0 / 355687428096000.0;             c = c * r2 - 1.0 / 20922789888000.0;
        s = s * r2 - 1.0 / 1307674368000.0;               c = c * r2 + 1.0 / 87178291200.0;
        s = s * r2 + 1.0 / 6227020800.0;                  c = c * r2 - 1.0 / 479001600.0;
        s = s * r2 - 1.0 / 39916800.0;                    c = c * r2 + 1.0 / 3628800.0;
        s = s * r2 + 1.0 / 362880.0;                      c = c * r2 - 1.0 / 40320.0;
        s = s * r2 - 1.0 / 5040.0;                        c = c * r2 + 1.0 / 720.0;
        s = s * r2 + 1.0 / 120.0;                         c = c * r2 - 1.0 / 24.0;
        s = s * r2 - 1.0 / 6.0;                           c = c * r2 + 0.5;
        s = s * r2 + 1.0;                                 c = c * r2 - 1.0;
        s = s * rr; c = -c;
        rc[i] = (float)c; rs[i] = (float)s;
    }
    float* b1p = (float*)(ws + OFF_HID);
    for (int o = gwave; o < 64; o += nwaves) {
        const int mat = o >> 5, kc = o & 31; const float* pos = mat ? p.cmp_pos_v : p.cmp_pos_k; const float* w1 = mat ? p.cmp_w1_v : p.cmp_w1_k;
        float4 acc = make_float4(0.f, 0.f, 0.f, 0.f);
#pragma unroll 8
        for (int k = kc * 64; k < kc * 64 + 64; ++k) { const float pk = pos[k]; const float4 w = *(const float4*)(w1 + (size_t)k * 256 + 4 * lane); acc.x += pk * w.x; acc.y += pk * w.y; acc.z += pk * w.z; acc.w += pk * w.w; }
        *(float4*)(b1p + (size_t)o * 256 + 4 * lane) = acc;
    }
}

__device__ __forceinline__ void unpack8(const uint4& w, float* f) { f[0] = __uint_as_float(w.x << 16); f[1] = __uint_as_float(w.x & 0xffff0000u); f[2] = __uint_as_float(w.y << 16); f[3] = __uint_as_float(w.y & 0xffff0000u);
    f[4] = __uint_as_float(w.z << 16); f[5] = __uint_as_float(w.z & 0xffff0000u); f[6] = __uint_as_float(w.w << 16); f[7] = __uint_as_float(w.w & 0xffff0000u); }
__device__ __forceinline__ uint4 pack8(const float* f) { return make_uint4(pk2bf(f[0], f[1]), pk2bf(f[2], f[3]), pk2bf(f[4], f[5]), pk2bf(f[6], f[7])); }
__device__ __forceinline__ void ph_tokprep(const Params& p, int wv) {
    PH_IDS(); unsigned char* ws = p.ws;
    const int gtid_ = (nb > 64 ? bid - 32 : bid) * NTHREADS + tid, gn_ = (nb > 64 ? nb - 32 : nb) * NTHREADS;
    const bf16* xbc = (const bf16*)(ws + OFF_XBC); bf16* xsbc = (bf16*)(ws + OFF_XSBC);
    for (int it = gtid_; it < (T / 16) * 192; it += gn_) {
        const int cg = it % 192, tg = it / 192, ch = cg * 8, t0 = tg * 16, l0 = t0 & (L - 1);
        float w[4][8], bias[8];
#pragma unroll
        for (int j = 0; j < 4; ++j) { const float4 a = *(const float4*)(p.conv_w + j * 1536 + ch), b2 = *(const float4*)(p.conv_w + j * 1536 + ch + 4); w[j][0] = a.x; w[j][1] = a.y; w[j][2] = a.z; w[j][3] = a.w; w[j][4] = b2.x; w[j][5] = b2.y; w[j][6] = b2.z; w[j][7] = b2.w; }
        { const float4 a = *(const float4*)(p.conv_b + ch), b2 = *(const float4*)(p.conv_b + ch + 4); bias[0] = a.x; bias[1] = a.y; bias[2] = a.z; bias[3] = a.w; bias[4] = b2.x; bias[5] = b2.y; bias[6] = b2.z; bias[7] = b2.w; }
        float x0[8], x1[8], x2[8], x3[8];
        { uint4 h0 = make_uint4(0u, 0u, 0u, 0u), h1 = h0, h2 = h0;
          if (l0 != 0) { h0 = *(const uint4*)(xbc + (size_t)(t0 - 3) * 1536 + ch); h1 = *(const uint4*)(xbc + (size_t)(t0 - 2) * 1536 + ch); h2 = *(const uint4*)(xbc + (size_t)(t0 - 1) * 1536 + ch); }
          unpack8(h0, x0); unpack8(h1, x1); unpack8(h2, x2); }
#pragma unroll
        for (int u = 0; u < 16; ++u) {
            unpack8(*(const uint4*)(xbc + (size_t)(t0 + u) * 1536 + ch), x3);
            float y[8];
#pragma unroll
            for (int i = 0; i < 8; ++i) { const float v = bias[i] + w[0][i] * x0[i] + w[1][i] * x1[i] + w[2][i] * x2[i] + w[3][i] * x3[i]; y[i] = v * sigmoidf(v); x0[i] = x1[i]; x1[i] = x2[i]; x2[i] = x3[i]; }
            *(uint4*)(xsbc + (size_t)(t0 + u) * 1536 + ch) = pack8(y);
        }
    }
    const bf16* dtg = (const bf16*)(ws + OFF_DTG); float* dt = (float*)(ws + OFF_DT); float* gate = (float*)(ws + OFF_GATE);
    for (int i = gtid_; i < T * 64; i += gn_) {
        const int t = i >> 6, c = i & 63; const float v = bf2f(dtg[i]);
        if (c < 16) { const float xx = v + p.dt_bias[c]; dt[t * 16 + c] = xx > 20.f ? xx : log1pf(__expf(xx)); }
        else gate[t * 48 + (c - 16)] = sigmoidf(v);
    }
    const float* rc = (const float*)(ws + OFF_ROPE); const float* rs = rc + 4096 * 32;
    bf16* q = (bf16*)(ws + OFF_Q); bf16* kvs = (bf16*)(ws + OFF_KVS);
    for (int it = gtid_; it < T * 24 * 4; it += gn_) {
        const int j0 = (it & 3) * 8, hh = (it >> 2) % 24, t = it / 96, l = t & (L - 1);
        bf16* pp; float sc;
        if (hh < 16) { pp = q + (size_t)t * 1024 + hh * 64 + j0; sc = 0.125f * 1.4426950408889634f; } else if (hh < 20) { pp = kvs + (size_t)t * 1536 + 512 + (hh - 16) * 64 + j0; sc = 1.f; } else { pp = kvs + (size_t)t * 1536 + 1024 + (hh - 20) * 64 + j0; sc = 1.f; }
        float x1[8], x2[8], c[8], s[8], o1[8], o2[8];
        unpack8(*(const uint4*)pp, x1); unpack8(*(const uint4*)(pp + 32), x2);
        { const float4 a = *(const float4*)(rc + l * 32 + j0), b2 = *(const float4*)(rc + l * 32 + j0 + 4), d = *(const float4*)(rs + l * 32 + j0), e = *(const float4*)(rs + l * 32 + j0 + 4);
          c[0] = a.x; c[1] = a.y; c[2] = a.z; c[3] = a.w; c[4] = b2.x; c[5] = b2.y; c[6] = b2.z; c[7] = b2.w; s[0] = d.x; s[1] = d.y; s[2] = d.z; s[3] = d.w; s[4] = e.x; s[5] = e.y; s[6] = e.z; s[7] = e.w; }
#pragma unroll
        for (int i = 0; i < 8; ++i) { o1[i] = (x1[i] * c[i] - x2[i] * s[i]) * sc; o2[i] = (x1[i] * s[i] + x2[i] * c[i]) * sc; }
        *(uint4*)pp = pack8(o1); *(uint4*)(pp + 32) = pack8(o2);
    }
}

__device__ __forceinline__ void ph_ssd_prep2(const Params& p, int wv, unsigned char* lds) {
    PH_IDS(); unsigned char* ws = p.ws;
    const bf16* xsbc = (const bf16*)(ws + OFF_XSBC); const float* dt = (const float*)(ws + OFF_DT);
    bf16* XdT = (bf16*)p.out; bf16* BT = (bf16*)(ws + OFF_BT); float* acsT = (float*)(ws + OFF_ACS);
    float* sdt = (float*)lds; float* swave = sdt + 128;
    const int bide = bid, nbe = nb;
    for (int unit = bide; unit < 2048 + 256; unit += nbe) {
        __syncthreads();
        if (unit < 2048) {
            const int h = unit & 15, bc = unit >> 4; const size_t t0 = (size_t)bc * 128;
            const float A = -__expf(p.a_log[h]);
            if (tid < 128) { const float dv = dt[(t0 + tid) * 16 + h]; sdt[tid] = dv; float a = dv * A;
#pragma unroll
                for (int o = 1; o < 64; o <<= 1) { const float v = __shfl_up(a, o); if (lane >= o) a += v; }
                if (lane == 63) swave[tid >> 6] = a;
                sdt[128 + 8 + tid] = a; }
            __syncthreads();
            if (tid < 128) { float a = sdt[128 + 8 + tid]; if (tid >= 64) a += swave[0]; acsT[(size_t)unit * 128 + tid] = a; }
            const int pp = tid & 63, lg = tid >> 6; const bf16* src = xsbc + (t0 + lg * 16) * 1536 + h * 64 + pp;
            unsigned w[8];
#pragma unroll
            for (int i = 0; i < 8; ++i) { const float v0 = bf2f(src[(size_t)(2 * i) * 1536]) * sdt[lg * 16 + 2 * i], v1 = bf2f(src[(size_t)(2 * i + 1) * 1536]) * sdt[lg * 16 + 2 * i + 1]; w[i] = (unsigned)f2bf(v0) | ((unsigned)f2bf(v1) << 16); }
            uint4* dst = (uint4*)(XdT + (size_t)unit * 8192 + pp * 128 + lg * 16);
            dst[0] = make_uint4(w[0], w[1], w[2], w[3]); dst[1] = make_uint4(w[4], w[5], w[6], w[7]);
        } else {
            const int u2 = unit - 2048, g = u2 & 1, bc = u2 >> 1; const size_t t0 = (size_t)bc * 128;
            const int n = tid & 127, lg = tid >> 7; const bf16* src = xsbc + (t0 + lg * 32) * 1536 + 1024 + g * 128 + n;
            uint4* dst = (uint4*)(BT + (size_t)u2 * 16384 + n * 128 + lg * 32);
#pragma unroll
            for (int k = 0; k < 4; ++k) { unsigned w[4];
#pragma unroll
                for (int i = 0; i < 4; ++i) w[i] = (unsigned)src[(size_t)(8 * k + 2 * i) * 1536] | ((unsigned)src[(size_t)(8 * k + 2 * i + 1) * 1536] << 16);
                dst[k] = make_uint4(w[0], w[1], w[2], w[3]); }
        }
    }
}
__device__ __forceinline__ void ph_ssd_states(const Params& p, int wv) {
    PH_IDS(); unsigned char* ws = p.ws; const int rr = lane & 31, hi = lane >> 5;
    const bf16* XdT = (const bf16*)p.out; bf16* S = (bf16*)((unsigned char*)p.out + 32 * MiB); const bf16* BT = (const bf16*)(ws + OFF_BT); const float* acsT = (const float*)(ws + OFF_ACS);
    for (int unit = gwave; unit < 2048; unit += nwaves) {
        const int h = unit & 15, bc = unit >> 4, g = h >> 3;
        const float* ac = acsT + (size_t)unit * 128; const float alast = ac[127];
        const bf16* xrow = XdT + (size_t)unit * 8192 + rr * 128 + 8 * hi; const bf16* bt = BT + (size_t)(bc * 2 + g) * 16384 + rr * 128 + 8 * hi;
        f32x16 acc[4][2];
#pragma unroll
        for (int nt = 0; nt < 4; ++nt)
#pragma unroll
            for (int pt = 0; pt < 2; ++pt)
#pragma unroll
                for (int e = 0; e < 16; ++e) acc[nt][pt][e] = 0.f;
#pragma unroll 2
        for (int ks = 0; ks < 8; ++ks) {
            const int l0 = ks * 16 + 8 * hi; float dec[8];
            { const f32x4 a0 = *(const f32x4*)(ac + l0), a1 = *(const f32x4*)(ac + l0 + 4);
#pragma unroll
              for (int jx = 0; jx < 8; ++jx) dec[jx] = __expf(alast - (jx < 4 ? a0[jx] : a1[jx - 4])); }
            bf16x8 xf[2];
#pragma unroll
            for (int pt = 0; pt < 2; ++pt) { float f[8]; unpack8(*(const uint4*)(xrow + (size_t)pt * 4096 + ks * 16), f);
#pragma unroll
                for (int jx = 0; jx < 8; ++jx) f[jx] *= dec[jx];
                union { uint4 u; bf16x8 v; } cvu; cvu.u = pack8(f); xf[pt] = cvu.v; }
#pragma unroll
            for (int nt = 0; nt < 4; ++nt) { const bf16x8 bf_ = *(const bf16x8*)(bt + (size_t)nt * 4096 + ks * 16);
#pragma unroll
                for (int pt = 0; pt < 2; ++pt) acc[nt][pt] = __builtin_amdgcn_mfma_f32_32x32x16_bf16(bf_, xf[pt], acc[nt][pt], 0, 0, 0); }
        }
#pragma unroll
        for (int pt = 0; pt < 2; ++pt) { bf16* so = S + (size_t)unit * 8192 + (pt * 32 + rr) * 128 + 4 * hi;
#pragma unroll
            for (int nt = 0; nt < 4; ++nt)
#pragma unroll
                for (int a = 0; a < 4; ++a) *(uint2*)(so + nt * 32 + 8 * a) = make_uint2(pk2bf(acc[nt][pt][4 * a], acc[nt][pt][4 * a + 1]), pk2bf(acc[nt][pt][4 * a + 2], acc[nt][pt][4 * a + 3])); }
    }
}
__device__ __forceinline__ void ph_ssd_scan(const Params& p, int wv) {
    PH_IDS();
    unsigned* S = (unsigned*)((unsigned char*)p.out + 32 * MiB); const float* acsT = (const float*)(p.ws + OFF_ACS);
    for (int e = gtid; e < NBATCH * 16 * 4096; e += gn) {
        const int pn = e & 4095, h = (e >> 12) & 15, b = e >> 16; float r0 = 0.f, r1 = 0.f;
        for (int c = 0; c < 32; c += 4) {
            unsigned v[4]; float d[4];
#pragma unroll
            for (int u = 0; u < 4; ++u) { const int unit = (b * 32 + c + u) * 16 + h; v[u] = S[(size_t)unit * 4096 + pn]; d[u] = __expf(acsT[(size_t)unit * 128 + 127]); }
#pragma unroll
            for (int u = 0; u < 4; ++u) { const int unit = (b * 32 + c + u) * 16 + h; S[(size_t)unit * 4096 + pn] = (unsigned)f2bf(r0) | ((unsigned)f2bf(r1) << 16);
                r0 = r0 * d[u] + bf2f((bf16)(v[u] & 0xffffu)); r1 = r1 * d[u] + bf2f((bf16)(v[u] >> 16)); }
        }
    }
}
constexpr int SO_CBROW = 136;
__device__ __forceinline__ void ph_ssd_out(const Params& p, int wv, unsigned char* lds) {
    PH_IDS(); unsigned char* ws = p.ws; const int rr = lane & 31, hi = lane >> 5;
    const bf16* XdT = (const bf16*)p.out; const bf16* S = (const bf16*)((unsigned char*)p.out + 32 * MiB); const bf16* xsbc = (const bf16*)(ws + OFF_XSBC);
    const float* acsT = (const float*)(ws + OFF_ACS); bf16* z = (bf16*)(ws + OFF_Z); float* ssq2p = (float*)(ws + OFF_HID);
    bf16* CBl = (bf16*)lds;
    for (int unit = bid; unit < 256; unit += nb) {
        const int g = unit & 1, bc = unit >> 1; const size_t t0 = (size_t)bc * 128;
        __syncthreads();
        for (int ti = wv; ti < 10; ti += NWAVES) {
            int lt = 0, st = ti; if (st > 0) { st -= 1; lt = 1; if (st > 1) { st -= 2; lt = 2; if (st > 2) { st -= 3; lt = 3; } } }
            f32x16 acc;
#pragma unroll
            for (int e = 0; e < 16; ++e) acc[e] = 0.f;
            const bf16* arow = xsbc + (t0 + st * 32 + rr) * 1536 + 1024 + g * 128 + 8 * hi; const bf16* brow = xsbc + (t0 + lt * 32 + rr) * 1536 + 1280 + g * 128 + 8 * hi;
#pragma unroll
            for (int ks = 0; ks < 8; ++ks) acc = __builtin_amdgcn_mfma_f32_32x32x16_bf16(*(const bf16x8*)(arow + ks * 16), *(const bf16x8*)(brow + ks * 16), acc, 0, 0, 0);
            bf16* dst = CBl + (lt * 32 + rr) * SO_CBROW + st * 32 + 4 * hi;
#pragma unroll
            for (int a = 0; a < 4; ++a) *(uint2*)(dst + 8 * a) = make_uint2(pk2bf(acc[4 * a], acc[4 * a + 1]), pk2bf(acc[4 * a + 2], acc[4 * a + 3]));
        }
        __syncthreads();
        const int h = g * 8 + wv, uh = bc * 16 + h; const float* ac = acsT + (size_t)uh * 128; const float Dh = p.d_skip[h];
        const bf16* xd = XdT + (size_t)uh * 8192 + rr * 128 + 8 * hi; const bf16* sin = S + (size_t)uh * 8192 + rr * 128 + 8 * hi;
        f32x16 acc[2][4];
#pragma unroll
        for (int pt = 0; pt < 2; ++pt)
#pragma unroll
            for (int lt = 0; lt < 4; ++lt)
#pragma unroll
                for (int e = 0; e < 16; ++e) acc[pt][lt][e] = 0.f;
#pragma unroll
        for (int lt = 0; lt < 4; ++lt) {
            const int l = lt * 32 + rr; const float acl = ac[l]; const float eal = __expf(acl);
#pragma unroll
            for (int ks = 0; ks < 2 * lt + 2; ++ks) {
                const int s0 = ks * 16 + 8 * hi; float cb[8]; unpack8(*(const uint4*)(CBl + l * SO_CBROW + s0), cb);
                const f32x4 a0 = *(const f32x4*)(ac + s0), a1 = *(const f32x4*)(ac + s0 + 4);
#pragma unroll
                for (int jx = 0; jx < 8; ++jx) { const float as = jx < 4 ? a0[jx] : a1[jx - 4]; cb[jx] = (s0 + jx <= l) ? cb[jx] * __expf(acl - as) : 0.f; }
                union { uint4 u; bf16x8 v; } mf; mf.u = pack8(cb);
#pragma unroll
                for (int pt = 0; pt < 2; ++pt) acc[pt][lt] = __builtin_amdgcn_mfma_f32_32x32x16_bf16(*(const bf16x8*)(xd + (size_t)pt * 4096 + ks * 16), mf.v, acc[pt][lt], 0, 0, 0);
            }
            const bf16* crow_ = xsbc + (t0 + l) * 1536 + 1280 + g * 128 + 8 * hi;
#pragma unroll
            for (int ks = 0; ks < 8; ++ks) {
                float cf[8]; unpack8(*(const uint4*)(crow_ + ks * 16), cf);
#pragma unroll
                for (int jx = 0; jx < 8; ++jx) cf[jx] *= eal;
                union { uint4 u; bf16x8 v; } bf_; bf_.u = pack8(cf);
#pragma unroll
                for (int pt = 0; pt < 2; ++pt) acc[pt][lt] = __builtin_amdgcn_mfma_f32_32x32x16_bf16(*(const bf16x8*)(sin + (size_t)pt * 4096 + ks * 16), bf_.v, acc[pt][lt], 0, 0, 0);
            }
            const size_t t = t0 + l; float ss = 0.f;
#pragma unroll
            for (int pt = 0; pt < 2; ++pt)
#pragma unroll
                for (int a = 0; a < 4; ++a) {
                    const int col = h * 64 + pt * 32 + 8 * a + 4 * hi;
                    const uint2 xw = *(const uint2*)(xsbc + t * 1536 + col), zw = *(const uint2*)(z + t * 1024 + col);
                    const float xs0 = bflo(xw.x), xs1 = bfhi(xw.x), xs2 = bflo(xw.y), xs3 = bfhi(xw.y), z0 = bflo(zw.x), z1 = bfhi(zw.x), z2 = bflo(zw.y), z3 = bfhi(zw.y);
                    const float v0 = (acc[pt][lt][4 * a] + Dh * xs0) * (z0 * sigmoidf(z0)), v1 = (acc[pt][lt][4 * a + 1] + Dh * xs1) * (z1 * sigmoidf(z1));
                    const float v2 = (acc[pt][lt][4 * a + 2] + Dh * xs2) * (z2 * sigmoidf(z2)), v3 = (acc[pt][lt][4 * a + 3] + Dh * xs3) * (z3 * sigmoidf(z3));
                    ss += (v0 * v0 + v1 * v1) + (v2 * v2 + v3 * v3);
                    *(uint2*)(z + t * 1024 + col) = make_uint2(pk2bf(v0, v1), pk2bf(v2, v3));
                }
            ss += __shfl_xor(ss, 32);
            if (hi == 0) ssq2p[t * 16 + h] = ss;
        }
    }
}

struct EpiKc {
    bf16* dst; bool tr; __device__ __forceinline__ void operator()(int m, int c, float v) const { const int hk = m & 3, n = (m >> 2) & 255, b = m >> 10; const bf16 o = (n == 255) ? (bf16)0 : f2bf(v);
        if (tr) dst[((size_t)(b * 4 + hk) * 64 + c) * 256 + n] = o; else dst[((size_t)(b * 4 + hk) * 256 + n) * 64 + c] = o; } };
__device__ __forceinline__ void ph_kc_rope(const Params& p, int wv) {
    PH_IDS(); unsigned char* ws = p.ws; bf16* kc = (bf16*)(ws + OFF_KC); const float* rc = (const float*)(ws + OFF_ROPE); const float* rs = rc + 4096 * 32;
    for (int i = gtid; i < 16 * 256 * 32; i += gn) {
        const int j = i & 31, n = (i >> 5) & 255, bh = i >> 13; const int pos = 16 * n + 31; if (n == 255) continue;
        const float c = rc[pos * 32 + j], s = rs[pos * 32 + j];
        bf16* pp = kc + ((size_t)bh * 256 + n) * 64 + j; const float x1 = bf2f(pp[0]), x2 = bf2f(pp[32]);
        pp[0] = f2bf(x1 * c - x2 * s); pp[32] = f2bf(x1 * s + x2 * c);
    }
}


__device__ __forceinline__ void ph_vt_prep(const Params& p, int wv) {
    PH_IDS(); unsigned char* ws = p.ws; const bf16* kvs = (const bf16*)(ws + OFF_KVS);
    const int bide = bid, nbe = nb;
    for (int unit = bide; unit < 2 * 16 * 64; unit += nbe) {
        const int br = unit & 1, tl = (unit >> 1) & 63, bh = unit >> 7, b = bh >> 2, hk = bh & 3;
        const int d = tid & 63, grp = tid >> 6; const int l0 = tl * 64 + grp * 8;
        const bf16* src = kvs + ((size_t)b * L + l0) * 1536 + (br ? 1280 : 768) + hk * 64 + d;
        unsigned w[4];
#pragma unroll
        for (int i = 0; i < 4; ++i) w[i] = (unsigned)src[(size_t)(2 * i) * 1536] | ((unsigned)src[(size_t)(2 * i + 1) * 1536] << 16);
        bf16* dst = (bf16*)(ws + (br ? OFF_VWT : OFF_VST)) + ((size_t)bh * 64 + d) * L + l0;
        *(uint4*)dst = make_uint4(w[0], w[1], w[2], w[3]);
    }
}

__device__ __forceinline__ float max3f(float a, float b, float c) { float r; asm("v_max3_f32 %0, %1, %2, %3" : "=v"(r) : "v"(a), "v"(b), "v"(c)); return r; }
__device__ __forceinline__ int crow(int r, int hi) { return (r & 3) + 8 * (r >> 2) + 4 * hi; }
constexpr int NSA_KROW = 144, NSA_VROW = 144, NSA_KBUF = 64 * NSA_KROW, NSA_VBUF = 64 * NSA_VROW;
constexpr int NSA_OFF_K = 0, NSA_OFF_V = 4 * NSA_KBUF;
constexpr int NSA_OFF_STASH = 73728;
constexpr int NSA_OFF_IMPA = NSA_OFF_STASH, NSA_IMPS = 65, NSA_OFF_IMPB = NSA_OFF_IMPA + 64 * NSA_IMPS * 4;
constexpr int NSA_OFF_SEL = NSA_OFF_STASH + 65536;
static_assert(NSA_OFF_V + 4 * NSA_VBUF <= NSA_OFF_STASH && NSA_OFF_IMPB + 64 * NSA_IMPS * 4 <= NSA_OFF_SEL && NSA_OFF_SEL + 1024 <= LDS_BYTES - 64, "NSA LDS map");
struct NsaSrc { const bf16* K; size_t kstride; const bf16* VT; size_t ldv; };
__device__ __forceinline__ void nsa_gload(const NsaSrc& s, int k0, int tid, uint4& kr, uint4& vr) {
    const int row = tid >> 3, ch = tid & 7;
    kr = *(const uint4*)(s.K + (size_t)(k0 + row) * s.kstride + ch * 8);
    vr = *(const uint4*)(s.VT + (size_t)row * s.ldv + k0 + ch * 8);
}
__device__ __forceinline__ void nsa_lstore(unsigned char* kb, unsigned char* vb, int tid, const uint4& kr, const uint4& vr) {
    const int row = tid >> 3, ch = tid & 7;
    *(uint4*)(kb + row * NSA_KROW + ch * 16) = kr;
    uint2* vp = (uint2*)(vb + row * NSA_VROW + (ch >> 1) * 32 + (ch & 1) * 8); vp[0] = make_uint2(vr.x, vr.y); vp[2] = make_uint2(vr.z, vr.w);
}
__device__ __forceinline__ void nsa_qk(const unsigned char* kb, const bf16x8 (&qf)[4], int rr, int hi, f32x16& p0, f32x16& p1) {
#pragma unroll
    for (int i = 0; i < 16; ++i) { p0[i] = 0.f; p1[i] = 0.f; }
    __builtin_amdgcn_s_setprio(1);
#pragma unroll
    for (int ds = 0; ds < 4; ++ds) {
        const bf16x8 a0 = *(const bf16x8*)(kb + rr * NSA_KROW + ds * 32 + hi * 16), a1 = *(const bf16x8*)(kb + (rr + 32) * NSA_KROW + ds * 32 + hi * 16);
        p0 = __builtin_amdgcn_mfma_f32_32x32x16_bf16(a0, qf[ds], p0, 0, 0, 0); p1 = __builtin_amdgcn_mfma_f32_32x32x16_bf16(a1, qf[ds], p1, 0, 0, 0);
    }
    __builtin_amdgcn_s_setprio(0);
}
__device__ __forceinline__ void nsa_pv(const unsigned char* vb, int rr, int hi, const f32x16& p0, const f32x16& p1, f32x16 (&O)[2]) {
    __builtin_amdgcn_s_setprio(1);
#pragma unroll
    for (int s = 0; s < 4; ++s) {
        const int eb = 8 * (s & 1), kbase = 32 * (s >> 1) + 16 * (s & 1);
        union { uint4 u; bf16x8 v; } pf;
        if (s < 2) pf.u = make_uint4(pk2bf(p0[eb], p0[eb + 1]), pk2bf(p0[eb + 2], p0[eb + 3]), pk2bf(p0[eb + 4], p0[eb + 5]), pk2bf(p0[eb + 6], p0[eb + 7]));
        else       pf.u = make_uint4(pk2bf(p1[eb], p1[eb + 1]), pk2bf(p1[eb + 2], p1[eb + 3]), pk2bf(p1[eb + 4], p1[eb + 5]), pk2bf(p1[eb + 6], p1[eb + 7]));
#pragma unroll
        for (int dsub = 0; dsub < 2; ++dsub) {
            const bf16x8 vfv = *(const bf16x8*)(vb + (dsub * 32 + rr) * NSA_VROW + s * 32 + hi * 16);
            O[dsub] = __builtin_amdgcn_mfma_f32_32x32x16_bf16(vfv, pf.v, O[dsub], 0, 0, 0);
        }
    }
    __builtin_amdgcn_s_setprio(0);
}
template <int MODE>
__device__ __forceinline__ void nsa_tile(unsigned char* lds, const unsigned char* kb, const unsigned char* vb, int jt, int rr, int hi, const bf16x8 (&qf)[4], int lpos, int qi, int tokblk,
                                         u64 selm, float& m, float& lsum, float inv_l, f32x16 (&O)[2]) {
    float* impA = (float*)(lds + NSA_OFF_IMPA); float* impB = (float*)(lds + NSA_OFF_IMPB);
    f32x16 p0, p1; nsa_qk(kb, qf, rr, hi, p0, p1);
    asm volatile("s_nop 15\n\ts_nop 7" : "+v"(p0), "+v"(p1));
    const int k0 = jt * 64;
    const bool tile_on = (MODE != 2) || ((selm >> jt) & 1ull);
    bool full;
    if (MODE <= 1) full = (16 * (k0 + 63) + 31 <= qi * 64); else if (MODE == 2) full = (jt < qi); else full = (jt > qi - 8) && (jt < qi);
    float mx = NEG_INF, mx2 = NEG_INF;
    if (full) {
#pragma unroll
        for (int e = 0; e < 16; e += 2) { mx = max3f(mx, p0[e], p1[e]); mx2 = max3f(mx2, p0[e + 1], p1[e + 1]); }
        if (MODE == 2 && !tile_on) { mx = NEG_INF; mx2 = NEG_INF; }
    } else {
        const int lim = (MODE <= 1) ? (lpos - 31 - 16 * k0 - 64 * hi) : (lpos - k0 - 4 * hi);
#pragma unroll
        for (int e = 0; e < 16; ++e) {
            const int ca = (e & 3) + 8 * (e >> 2), cb = ca + 32; bool oa, ob;
            if (MODE <= 1) { oa = (16 * ca <= lim); ob = (16 * cb <= lim); }
            else if (MODE == 2) { oa = (ca <= lim); ob = (cb <= lim); }
            else { oa = (ca <= lim) && (ca > lim - 512); ob = (cb <= lim) && (cb > lim - 512); }
            p0[e] = oa ? p0[e] : NEG_INF; p1[e] = ob ? p1[e] : NEG_INF; if (e & 1) mx2 = max3f(mx2, p0[e], p1[e]); else mx = max3f(mx, p0[e], p1[e]);
        }
    }
    if (MODE != 1) {
        mx = max3f(mx, mx2, NEG_INF); mx = max3f(mx, __shfl_xor(mx, 32), NEG_INF);
        const float mnew = fmaxf(m, mx);
        if (__any((mnew - m) > 6.0f)) {
            const float alpha = __builtin_amdgcn_exp2f(m - mnew); m = mnew; lsum *= alpha;
            if (MODE != 0) {
#pragma unroll
                for (int e = 0; e < 16; ++e) { O[0][e] *= alpha; O[1][e] *= alpha; }
            }
        }
        const float meff = (MODE == 2 && full && !tile_on) ? BIG : ((m > 0.5f * NEG_INF) ? m : BIG);
        float rs = 0.f;
#pragma unroll
        for (int e = 0; e < 16; ++e) { p0[e] = __builtin_amdgcn_exp2f(p0[e] - meff); p1[e] = __builtin_amdgcn_exp2f(p1[e] - meff); rs += p0[e] + p1[e]; }
        lsum += rs;
        if (MODE != 0) nsa_pv(vb, rr, hi, p0, p1, O);
    } else {
#pragma unroll
        for (int e = 0; e < 16; ++e) { p0[e] = __builtin_amdgcn_exp2f(p0[e] - m) * inv_l; p1[e] = __builtin_amdgcn_exp2f(p1[e] - m) * inv_l; }
        nsa_pv(vb, rr, hi, p0, p1, O);
#pragma unroll
        for (int sub = 0; sub < 2; ++sub)
#pragma unroll
            for (int a = 0; a < 4; ++a) {
                float G, last;
                if (sub == 0) { G = (p0[4 * a] + p0[4 * a + 1]) + (p0[4 * a + 2] + p0[4 * a + 3]); last = p0[4 * a + 3]; } else { G = (p1[4 * a] + p1[4 * a + 1]) + (p1[4 * a + 2] + p1[4 * a + 3]); last = p1[4 * a + 3]; }
                G += __shfl_xor(G, 1); G += __shfl_xor(G, 2); last += __shfl_xor(last, 1); last += __shfl_xor(last, 2);
                const int jj = (k0 >> 2) + 8 * sub + 2 * a + hi;
                if ((rr & 3) == 0) { impA[tokblk * NSA_IMPS + jj] = G; if (jj + 1 < 64) impB[tokblk * NSA_IMPS + jj + 1] = last; }
            }
    }
}
template <int MODE>
__device__ __forceinline__ void nsa_branch(unsigned char* lds, const NsaSrc& src, int jt0, int jt1, int tid, int rr, int hi, const bf16x8 (&qf)[4], int lpos, int qi, int tokblk,
                                           u64 selm, u64 wsel, float& m, float& lsum, float inv_l, f32x16 (&O)[2]) {
    if (jt0 >= jt1) return;
    asm volatile("" : "+v"(tid), "+v"(rr));
    uint4 krA, vrA, krB, vrB;
    nsa_gload(src, jt0 * 64, tid, krA, vrA);
    if (jt0 + 1 < jt1) nsa_gload(src, (jt0 + 1) * 64, tid, krB, vrB);
    nsa_lstore(lds + NSA_OFF_K, lds + NSA_OFF_V, tid, krA, vrA);
    if (jt0 + 1 < jt1) nsa_lstore(lds + NSA_OFF_K + NSA_KBUF, lds + NSA_OFF_V + NSA_VBUF, tid, krB, vrB);
    __syncthreads();
    int par = 0;
    for (int jt = jt0; jt < jt1; jt += 2, par ^= 1) {
        const bool hasB = (jt + 1 < jt1), more = (jt + 2 < jt1), moreB = (jt + 3 < jt1);
        if (more) nsa_gload(src, (jt + 2) * 64, tid, krA, vrA);
        if (moreB) nsa_gload(src, (jt + 3) * 64, tid, krB, vrB);
        const unsigned char* kb = lds + NSA_OFF_K + (par * 2) * NSA_KBUF; const unsigned char* vb = lds + NSA_OFF_V + (par * 2) * NSA_VBUF;
        if ((MODE != 2) || ((wsel >> jt) & 1ull)) nsa_tile<MODE>(lds, kb, vb, jt, rr, hi, qf, lpos, qi, tokblk, selm, m, lsum, inv_l, O);
        if (hasB && ((MODE != 2) || ((wsel >> (jt + 1)) & 1ull))) nsa_tile<MODE>(lds, kb + NSA_KBUF, vb + NSA_VBUF, jt + 1, rr, hi, qf, lpos, qi, tokblk, selm, m, lsum, inv_l, O);
        if (more) nsa_lstore(lds + NSA_OFF_K + ((par ^ 1) * 2) * NSA_KBUF, lds + NSA_OFF_V + ((par ^ 1) * 2) * NSA_VBUF, tid, krA, vrA);
        if (moreB) nsa_lstore(lds + NSA_OFF_K + ((par ^ 1) * 2 + 1) * NSA_KBUF, lds + NSA_OFF_V + ((par ^ 1) * 2 + 1) * NSA_VBUF, tid, krB, vrB);
        __syncthreads();
    }
}
__device__ __forceinline__ void ph_nsa(const Params& p, int wv, unsigned char* lds) {
    PH_IDS(); unsigned char* ws = p.ws; const int wave = wv, rr = lane & 31, hi = lane >> 5;
    bf16* q = (bf16*)(ws + OFF_Q); const bf16* kvs = (const bf16*)(ws + OFF_KVS);
    const float* gate = (const float*)(ws + OFF_GATE); float* ssq = (float*)(ws + OFF_SSQ);
    float* impA = (float*)(lds + NSA_OFF_IMPA); float* impB = (float*)(lds + NSA_OFF_IMPB); u64* selw = (u64*)(lds + NSA_OFF_SEL);
    unsigned* qctr = (unsigned*)(ws + OFF_BAR + 14336) + 64 * (bid & 7); volatile int* ucur = (volatile int*)(lds + NSA_OFF_SEL + 512);
    for (;;) {
        if (tid == 0) *ucur = (int)__hip_atomic_fetch_add(qctr, 1u, __ATOMIC_RELAXED, __HIP_MEMORY_SCOPE_AGENT);
        __syncthreads();
        const int u = *ucur;
        if (u >= 128) break;
        const int bh = (bid & 7) + 8 * (u & 1), qi = 63 - (u >> 1);
        const int b = bh >> 2, hk = bh & 3; const int tokblk = wave * 8 + (rr >> 2), g = rr & 3; const int lpos = qi * 64 + tokblk; const size_t t = (size_t)b * L + lpos;
        bf16* qrow = q + t * 1024 + (hk * 4 + g) * 64;
        bf16x8 qf[4];
#pragma unroll
        for (int ds = 0; ds < 4; ++ds) qf[ds] = *(const bf16x8*)(qrow + ds * 16 + hi * 8);
        for (int i = tid; i < 64 * NSA_IMPS; i += NTHREADS) { impA[i] = 0.f; impB[i] = 0.f; }
        __syncthreads();
        f32x16 O[2]; float* stash = (float*)(lds + NSA_OFF_STASH) + tid;
        const float g0 = gate[t * 48 + (hk * 4 + g) * 3 + 0], g1 = gate[t * 48 + (hk * 4 + g) * 3 + 1], g2 = gate[t * 48 + (hk * 4 + g) * 3 + 2];
        {
            NsaSrc s{(const bf16*)(ws + OFF_KC) + (size_t)bh * 256 * 64, 64, (const bf16*)(ws + OFF_VCT) + (size_t)bh * 64 * 256, 256};
            const int nct = (4 * qi + 3 + 63) >> 6;
            float m = NEG_INF, lsum = 0.f;
            nsa_branch<0>(lds, s, 0, nct, tid, rr, hi, qf, lpos, qi, tokblk, 0ull, 0ull, m, lsum, 0.f, O);
            lsum += __shfl_xor(lsum, 32);
            const float inv_l = lsum > 0.f ? 1.0f / lsum : 0.f;
#pragma unroll
            for (int e = 0; e < 16; ++e) { O[0][e] = 0.f; O[1][e] = 0.f; }
            nsa_branch<1>(lds, s, 0, nct, tid, rr, hi, qf, lpos, qi, tokblk, 0ull, 0ull, m, lsum, inv_l, O);
        }
        f32x16 Oc[2];
#pragma unroll
        for (int e = 0; e < 16; ++e) { Oc[0][e] = g0 * O[0][e]; Oc[1][e] = g0 * O[1][e]; }
        {
            const int tk = tid >> 3, jg = tid & 7; float v[8];
#pragma unroll
            for (int i = 0; i < 8; ++i) { const int j = jg * 8 + i; const float raw = impA[tk * NSA_IMPS + j] + impB[tk * NSA_IMPS + j];
                const bool causal = (j <= qi), forced = (j == 0) || (j == qi) || (j == qi - 1); v[i] = causal ? (forced ? BIG : raw) : NEG_INF; }
            __syncthreads();
#pragma unroll
            for (int i = 0; i < 8; ++i) impA[tk * NSA_IMPS + jg * 8 + i] = v[i];
            __syncthreads();
            int rank[8];
#pragma unroll
            for (int i = 0; i < 8; ++i) rank[i] = 0;
            for (int jj = 0; jj < 64; ++jj) { const float x = impA[tk * NSA_IMPS + jj];
#pragma unroll
                for (int i = 0; i < 8; ++i) rank[i] += (x > v[i] || (x == v[i] && jj < jg * 8 + i)) ? 1 : 0; }
            unsigned b8 = 0u;
#pragma unroll
            for (int i = 0; i < 8; ++i) b8 |= (rank[i] < 16 && jg * 8 + i <= qi) ? (1u << i) : 0u;
            const u64 full = (u64)b8 << (jg * 8); unsigned blo = (unsigned)full, bhi = (unsigned)(full >> 32);
            blo |= __shfl_xor(blo, 1); bhi |= __shfl_xor(bhi, 1); blo |= __shfl_xor(blo, 2); bhi |= __shfl_xor(bhi, 2); blo |= __shfl_xor(blo, 4); bhi |= __shfl_xor(bhi, 4);
            if (jg == 0) selw[tk] = (u64)blo | ((u64)bhi << 32);
            __syncthreads();
        }
        const u64 selm = selw[tokblk];
        __syncthreads();
#pragma unroll
        for (int e = 0; e < 16; ++e) { stash[e * 512] = Oc[0][e]; stash[(16 + e) * 512] = Oc[1][e]; }
        u64 wsel = selm;
        { unsigned lo = (unsigned)wsel, h2 = (unsigned)(wsel >> 32);
          lo |= __shfl_xor(lo, 4); h2 |= __shfl_xor(h2, 4); lo |= __shfl_xor(lo, 8); h2 |= __shfl_xor(h2, 8); lo |= __shfl_xor(lo, 16); h2 |= __shfl_xor(h2, 16);
          wsel = (u64)lo | ((u64)h2 << 32); }
        {
            NsaSrc s{kvs + (size_t)b * L * 1536 + 512 + hk * 64, 1536, (const bf16*)(ws + OFF_VST) + (size_t)bh * 64 * L, (size_t)L};
            float m = NEG_INF, lsum = 0.f;
#pragma unroll
            for (int e = 0; e < 16; ++e) { O[0][e] = 0.f; O[1][e] = 0.f; }
            nsa_branch<2>(lds, s, 0, qi + 1, tid, rr, hi, qf, lpos, qi, tokblk, selm, wsel, m, lsum, 0.f, O);
            lsum += __shfl_xor(lsum, 32); const float sc = g1 / lsum;
#pragma unroll
            for (int e = 0; e < 16; ++e) { stash[e * 512] += sc * O[0][e]; stash[(16 + e) * 512] += sc * O[1][e]; }
        }
        {
            NsaSrc s{kvs + (size_t)b * L * 1536 + 1024 + hk * 64, 1536, (const bf16*)(ws + OFF_VWT) + (size_t)bh * 64 * L, (size_t)L};
            float m = NEG_INF, lsum = 0.f;
#pragma unroll
            for (int e = 0; e < 16; ++e) { O[0][e] = 0.f; O[1][e] = 0.f; }
            nsa_branch<3>(lds, s, qi >= 8 ? qi - 8 : 0, qi + 1, tid, rr, hi, qf, lpos, qi, tokblk, 0ull, 0ull, m, lsum, 0.f, O);
            lsum += __shfl_xor(lsum, 32); const float sc = g2 / lsum;
#pragma unroll
            for (int e = 0; e < 16; ++e) { O[0][e] = stash[e * 512] + sc * O[0][e]; O[1][e] = stash[(16 + e) * 512] + sc * O[1][e]; }
        }
        float ss = 0.f;
#pragma unroll
        for (int dsub = 0; dsub < 2; ++dsub)
#pragma unroll
            for (int a = 0; a < 4; ++a) {
                const float v0 = O[dsub][4 * a], v1 = O[dsub][4 * a + 1], v2 = O[dsub][4 * a + 2], v3 = O[dsub][4 * a + 3];
                ss += (v0 * v0 + v1 * v1) + (v2 * v2 + v3 * v3);
                *(uint2*)(qrow + dsub * 32 + 8 * a + 4 * hi) = make_uint2(pk2bf(v0, v1), pk2bf(v2, v3));
            }
        ss += __shfl_xor(ss, 32); ss += __shfl_xor(ss, 1); ss += __shfl_xor(ss, 2);
        if (hi == 0 && g == 0) ssq[t * 4 + hk] = ss;
        __syncthreads();
    }
}

constexpr size_t OFF_SU = 640 * 1024, OFF_SV = 704 * 1024, OFF_SX = 768 * 1024, OFF_SC = 832 * 1024;
constexpr size_t OFF_COEFQ = 218 * MiB, OFF_H1Q = 220 * MiB;
__device__ __forceinline__ unsigned pack4i8(float a, float b, float c, float d) {
    const int ia = (int)rintf(a), ib = (int)rintf(b), ic = (int)rintf(c), id = (int)rintf(d);
    return (unsigned)(ia & 0xff) | ((unsigned)(ib & 0xff) << 8) | ((unsigned)(ic & 0xff) << 16) | ((unsigned)(id & 0xff) << 24);
}
__device__ __forceinline__ void ph_ln1(const Params& p, int wv) {
    PH_IDS(); unsigned char* ws = p.ws; bf16* h1b = (bf16*)(ws + OFF_H1B); unsigned char* h1q = ws + OFF_H1Q; float* sx = (float*)(ws + OFF_SX);
    for (int t = gwave; t < T; t += nwaves) {
        float v[16]; float s = 0.f; float* row = p.out + (size_t)t * 1024 + lane * 16;
#pragma unroll
        for (int i = 0; i < 4; ++i) { const float4 a = *(const float4*)(row + 4 * i); v[4 * i] = a.x; v[4 * i + 1] = a.y; v[4 * i + 2] = a.z; v[4 * i + 3] = a.w; s += (a.x + a.y) + (a.z + a.w); }
        const float mu = wave_sum(s) * (1.0f / 1024.0f); float s2 = 0.f;
#pragma unroll
        for (int i = 0; i < 16; ++i) { v[i] -= mu; s2 += v[i] * v[i]; }
        const float rstd = rsqrtf(wave_sum(s2) * (1.0f / 1024.0f) + LN_EPS); float amax = 0.f;
#pragma unroll
        for (int i = 0; i < 4; ++i) { const int c = lane * 16 + 4 * i; const float4 ga = *(const float4*)(p.ln1_g + c), ba = *(const float4*)(p.ln1_b + c);
            v[4 * i] = v[4 * i] * rstd * ga.x + ba.x; v[4 * i + 1] = v[4 * i + 1] * rstd * ga.y + ba.y; v[4 * i + 2] = v[4 * i + 2] * rstd * ga.z + ba.z; v[4 * i + 3] = v[4 * i + 3] * rstd * ga.w + ba.w;
            *(float4*)(row + 4 * i) = make_float4(v[4 * i], v[4 * i + 1], v[4 * i + 2], v[4 * i + 3]); }
#pragma unroll
        for (int i = 0; i < 16; ++i) amax = fmaxf(amax, fabsf(v[i]));
        amax = fmaxf(wave_max(amax), 1e-20f); const float inv = 127.0f / amax;
        *(uint4*)(h1b + (size_t)t * 1024 + lane * 16) = pack8(v); *(uint4*)(h1b + (size_t)t * 1024 + lane * 16 + 8) = pack8(v + 8);
        *(uint4*)(h1q + (size_t)t * 1024 + lane * 16) = make_uint4(pack4i8(v[0] * inv, v[1] * inv, v[2] * inv, v[3] * inv), pack4i8(v[4] * inv, v[5] * inv, v[6] * inv, v[7] * inv),
                                                                 pack4i8(v[8] * inv, v[9] * inv, v[10] * inv, v[11] * inv), pack4i8(v[12] * inv, v[13] * inv, v[14] * inv, v[15] * inv));
        if (lane == 0) sx[t] = amax * (1.0f / 127.0f);
    }
}

__device__ __forceinline__ unsigned umaxu(unsigned a, unsigned b) { return a > b ? a : b; }
__device__ __forceinline__ unsigned uminu(unsigned a, unsigned b) { return a < b ? a : b; }
__device__ __forceinline__ unsigned f2mono(float f) { const unsigned u = __float_as_uint(f); return (u & 0x80000000u) ? ~u : (u | 0x80000000u); }
__device__ __forceinline__ float mono2f(unsigned m) { return __uint_as_float((m & 0x80000000u) ? (m & 0x7fffffffu) : ~m); }
template <int N> __device__ __forceinline__ void bitonic_sort_desc(unsigned (&a)[N]) {
#pragma unroll
    for (int k = 2; k <= N; k <<= 1)
#pragma unroll
        for (int j = k >> 1; j > 0; j >>= 1)
#pragma unroll
            for (int i = 0; i < N; ++i) { const int l = i ^ j; if (l > i) { const bool desc = ((i & k) == 0); const unsigned x = a[i], y = a[l], mx = umaxu(x, y), mn = uminu(x, y); a[i] = desc ? mx : mn; a[l] = desc ? mn : mx; } }
}
__device__ __forceinline__ void merge_top16(unsigned (&a)[16], const unsigned (&b)[16]) {
#pragma unroll
    for (int i = 0; i < 16; ++i) a[i] = umaxu(a[i], b[15 - i]);
#pragma unroll
    for (int j = 8; j > 0; j >>= 1)
#pragma unroll
        for (int i = 0; i < 16; ++i) { const int l = i ^ j; if (l > i) { const unsigned x = a[i], y = a[l]; a[i] = umaxu(x, y); a[l] = uminu(x, y); } }
}
constexpr int PK_KROW = 272;
__device__ __forceinline__ void peer_stage1(const bf16* qrow, const unsigned char* krow, int hi, unsigned (&run)[16]) {
    bf16x8 qf[8];
#pragma unroll
    for (int ks = 0; ks < 8; ++ks) qf[ks] = *(const bf16x8*)(qrow + ks * 16);
#pragma unroll 1
    for (int kt = 0; kt < 4; ++kt) {
        f32x16 acc;
#pragma unroll
        for (int e = 0; e < 16; ++e) acc[e] = 0.f;
        const unsigned char* kr = krow + kt * 32 * PK_KROW;
#pragma unroll
        for (int ks = 0; ks < 8; ++ks) acc = __builtin_amdgcn_mfma_f32_32x32x16_bf16(*(const bf16x8*)(kr + ks * 32), qf[ks], acc, 0, 0, 0);
        unsigned grp[16]; const unsigned ib = (unsigned)(127 - kt * 32 - 4 * hi);
#pragma unroll
        for (int e = 0; e < 16; ++e) grp[e] = (f2mono(acc[e]) & ~0x7fu) | (ib - (unsigned)((e & 3) + 8 * (e >> 2)));
        bitonic_sort_desc<16>(grp);
        if (kt == 0) {
#pragma unroll
            for (int i = 0; i < 16; ++i) run[i] = grp[i];
        } else merge_top16(run, grp);
    }
    unsigned oth[16];
#pragma unroll
    for (int i = 0; i < 16; ++i) oth[i] = __shfl_xor(run[i], 32);
    merge_top16(run, oth);
}
__device__ __forceinline__ void ph_peer_topk(const Params& p, int wv, unsigned char* lds) {
    PH_IDS(); unsigned char* ws = p.ws; const int rr = lane & 31, hi = lane >> 5;
    unsigned char* kimg = lds; int* exl = (int*)(lds + 2 * 128 * PK_KROW + wv * 6400);
    const bf16* qp = (const bf16*)(ws + OFF_QP); const bf16* keys = (const bf16*)(ws + OFF_KEYS);
    int* eidx = (int*)(ws + OFF_EIDX); float* gw = (float*)(ws + OFF_GW);
    const int h = bid & 7;
    for (int i = tid; i < 256 * 16; i += NTHREADS) { const int row = i >> 4, ch = i & 15; *(uint4*)(kimg + row * PK_KROW + ch * 16) = *(const uint4*)(keys + ((size_t)h * 256 + row) * 128 + ch * 8); }
    __syncthreads();
    for (int tt = (bid >> 3) * NWAVES + wv; tt < 512; tt += (nb >> 3) * NWAVES) {
        const int t0 = tt * 32;
        unsigned top[2][16];
        peer_stage1(qp + (size_t)(t0 + rr) * 2048 + h * 256 + 8 * hi, kimg + rr * PK_KROW + 16 * hi, hi, top[0]);
        peer_stage1(qp + (size_t)(t0 + rr) * 2048 + h * 256 + 128 + 8 * hi, kimg + (128 + rr) * PK_KROW + 16 * hi, hi, top[1]);
        unsigned g4[4][16];
#pragma unroll
        for (int k = 0; k < 4; ++k)
#pragma unroll
            for (int i = 0; i < 16; ++i) g4[k][i] = 0u;
#pragma unroll
        for (int i = 0; i < 16; ++i) {
            int off = 0;
#pragma unroll
            for (int k = 0; k < 16; ++k) if (k < i) off += 16 / (k + 1);
            const float s0 = mono2f(top[0][i] & ~0x7fu); const int e0 = (int)(127u - (top[0][i] & 0x7fu)) * 128;
#pragma unroll
            for (int j = 0; j < 16; ++j) if ((i + 1) * (j + 1) <= 16) {
                const int nc = off + j;
                const float sum = s0 + mono2f(top[1][j] & ~0x7fu);
                g4[nc >> 4][nc & 15] = (f2mono(sum) & ~0x3fu) | (unsigned)(63 - nc);
                if (hi == 0) exl[nc * 32 + rr] = e0 + (int)(127u - (top[1][j] & 0x7fu));
            }
        }
#pragma unroll
        for (int k = 0; k < 4; ++k) bitonic_sort_desc<16>(g4[k]);
        merge_top16(g4[0], g4[1]); merge_top16(g4[2], g4[3]); merge_top16(g4[0], g4[2]);
        float e16[16]; float den = 0.f; const float gmax = mono2f(g4[0][0] & ~0x3fu);
#pragma unroll
        for (int r = 0; r < 16; ++r) { e16[r] = __expf(mono2f(g4[0][r] & ~0x3fu) - gmax); den += e16[r]; }
        const float inv = 1.0f / den; const size_t ob = (size_t)(t0 + rr) * 128 + h * 16 + hi * 8;
        float wo[8]; int eo[8];
#pragma unroll
        for (int k = 0; k < 8; ++k) { const unsigned key = hi ? g4[0][8 + k] : g4[0][k]; wo[k] = (hi ? e16[8 + k] : e16[k]) * inv; eo[k] = exl[(63 - (int)(key & 0x3fu)) * 32 + rr]; }
        *(float4*)(gw + ob) = make_float4(wo[0], wo[1], wo[2], wo[3]); *(float4*)(gw + ob + 4) = make_float4(wo[4], wo[5], wo[6], wo[7]);
        *(int4*)(eidx + ob) = make_int4(eo[0], eo[1], eo[2], eo[3]); *(int4*)(eidx + ob + 4) = make_int4(eo[4], eo[5], eo[6], eo[7]);
    }
}
__device__ __forceinline__ void ph_peer_cvt(const Params& p, int wv) {
    PH_IDS(); unsigned char* ws = p.ws;
    for (int r = gwave; r < 2 * 16384; r += nwaves) {
        const bool isv = r >= 16384; const int e = isv ? r - 16384 : r;
        const float* src = (isv ? p.peer_v : p.peer_u) + (size_t)e * 1024 + lane * 16; float v[16]; float amax = 0.f;
#pragma unroll
        for (int i = 0; i < 4; ++i) { const float4 a = *(const float4*)(src + 4 * i); v[4 * i] = a.x; v[4 * i + 1] = a.y; v[4 * i + 2] = a.z; v[4 * i + 3] = a.w; }
#pragma unroll
        for (int i = 0; i < 16; ++i) amax = fmaxf(amax, fabsf(v[i]));
        amax = fmaxf(wave_max(amax), 1e-30f); const float inv = 127.0f / amax;
        *(uint4*)(ws + (isv ? OFF_PV : OFF_PU) + (size_t)e * 1024 + lane * 16) = make_uint4(pack4i8(v[0] * inv, v[1] * inv, v[2] * inv, v[3] * inv), pack4i8(v[4] * inv, v[5] * inv, v[6] * inv, v[7] * inv),
                                                                                            pack4i8(v[8] * inv, v[9] * inv, v[10] * inv, v[11] * inv), pack4i8(v[12] * inv, v[13] * inv, v[14] * inv, v[15] * inv));
        if (lane == 0) ((float*)(ws + (isv ? OFF_SV : OFF_SU)))[e] = amax * (1.0f / 127.0f);
    }
}
constexpr size_t OFF_PART = 26 * MiB;
constexpr size_t OFF_Y = 26 * MiB;
static_assert(OFF_PART + 64 * MiB <= OFF_H1B && OFF_PV + 16 * MiB <= OFF_XSBC && OFF_VWT + 8 * MiB <= OFF_PU, "PEER scratch map");
#define PU_ISSUE16(W, ELO, EHI) do { _Pragma("unroll") for (int k = 0; k < 8; ++k) { const int e0 = __shfl(ELO, k * 8 + g), e1 = __shfl(EHI, k * 8 + g); \
        W[k] = *(const uint4*)(PU + (size_t)e0 * 1024 + 128 * s + 16 * j); W[8 + k] = *(const uint4*)(PU + (size_t)e1 * 1024 + 128 * s + 16 * j); } } while (0)
#define PU_DOT16(W, X) __builtin_amdgcn_sdot4((int)(W).w, (int)(X).w, __builtin_amdgcn_sdot4((int)(W).z, (int)(X).z, __builtin_amdgcn_sdot4((int)(W).y, (int)(X).y, __builtin_amdgcn_sdot4((int)(W).x, (int)(X).x, 0, false), false), false), false)
#define PU_REDUCE8(W, O, XQ, PROW, B) do { int d[8], a4[4], a2[2], a1; \
        _Pragma("unroll") for (int k = 0; k < 8; ++k) d[k] = PU_DOT16(W[(O) + k], XQ); \
        _Pragma("unroll") for (int k = 0; k < 4; ++k) { const int give = b2 ? d[k] : d[4 + k]; a4[k] = (b2 ? d[4 + k] : d[k]) + __shfl_xor(give, 4); } \
        _Pragma("unroll") for (int k = 0; k < 2; ++k) { const int give = b1 ? a4[k] : a4[2 + k]; a2[k] = (b1 ? a4[2 + k] : a4[k]) + __shfl_xor(give, 2); } \
        { const int give = b0 ? a2[0] : a2[1]; a1 = (b0 ? a2[1] : a2[0]) + __shfl_xor(give, 1); } \
        (PROW)[(B) * 64 + kk * 8 + g] = a1; } while (0)
#define PU_META(T_, XQ, ELO, EHI) do { const int tq_ = (T_) < T ? (T_) : tlast; XQ = *(const uint4*)(h1q + (size_t)tq_ * 1024 + 128 * s + 16 * j); \
        ELO = eidx[(size_t)tq_ * 128 + lane]; EHI = eidx[(size_t)tq_ * 128 + 64 + lane]; } while (0)
#define PU_TOKEN(W, T_, XQ) do { int* prow = part + ((size_t)s * T + (T_)) * 128; PU_REDUCE8(W, 0, XQ, prow, 0); PU_REDUCE8(W, 8, XQ, prow, 1); } while (0)
__device__ __forceinline__ void ph_peer_u(const Params& p, int wv) {
    PH_IDS(); unsigned char* ws = p.ws; const int s = bid & 7, cu = bid >> 3, ncu = nb >> 3, g = lane >> 3, j = lane & 7;
    const unsigned char* h1q = ws + OFF_H1Q; const int* eidx = (const int*)(ws + OFF_EIDX); const unsigned char* PU = ws + OFF_PU; int* part = (int*)(ws + OFF_PART);
    const bool b2 = (lane & 4) != 0, b1 = (lane & 2) != 0, b0 = (lane & 1) != 0; const int kk = (b2 ? 4 : 0) + (b1 ? 2 : 0) + (b0 ? 1 : 0);
    const int tstep = ncu * NWAVES; int t = cu * NWAVES + wv;
    if (t >= T) return;
    const int tlast = t;
    uint4 xq0, xq1; int el0, eh0, el1, eh1;
    PU_META(t, xq0, el0, eh0); PU_META(t + tstep, xq1, el1, eh1);
    uint4 wA[16], wB[16];
    PU_ISSUE16(wA, el0, eh0);
    for (;;) {
        { const uint4 cx = xq0; PU_META(t + 2 * tstep, xq0, el0, eh0); PU_ISSUE16(wB, el1, eh1); PU_TOKEN(wA, t, cx); }
        t += tstep; if (t >= T) break;
        { const uint4 cx = xq1; PU_META(t + 2 * tstep, xq1, el1, eh1); PU_ISSUE16(wA, el0, eh0); PU_TOKEN(wB, t, cx); }
        t += tstep; if (t >= T) break;
    }
}
__device__ __forceinline__ void ph_peer_c(const Params& p, int wv) {
    PH_IDS(); unsigned char* ws = p.ws; const int* part = (const int*)(ws + OFF_PART); const float* gw = (const float*)(ws + OFF_GW); const int* eidx = (const int*)(ws + OFF_EIDX);
    const float* su = (const float*)(ws + OFF_SU); const float* sv = (const float*)(ws + OFF_SV); const float* sx = (const float*)(ws + OFF_SX); float* sc = (float*)(ws + OFF_SC); unsigned* coefq = (unsigned*)(ws + OFF_COEFQ);
    for (int t = gwave; t < T; t += nwaves) {
        float cp[2];
#pragma unroll
        for (int b = 0; b < 2; ++b) { const size_t i = (size_t)t * 128 + b * 64 + lane; int acc = 0;
#pragma unroll
            for (int s = 0; s < 8; ++s) acc += part[(size_t)s * T * 128 + i];
            const int e = eidx[i]; cp[b] = gw[i] * gelu_exact((float)acc * su[e] * sx[t]) * sv[e]; }
        const float amax = fmaxf(wave_max(fmaxf(fabsf(cp[0]), fabsf(cp[1]))), 1e-30f), inv = 127.0f / amax;
        const int q0 = (int)rintf(cp[0] * inv) & 0xff, q1 = (int)rintf(cp[1] * inv) & 0xff;
        const int gg = lane & 7, kq = (lane >> 3) & 1;
        unsigned w0 = 0u, w1 = 0u;
#pragma unroll
        for (int i = 0; i < 4; ++i) { const int srcl = (4 * kq + i) * 8 + gg; w0 |= (unsigned)__shfl(q0, srcl) << (8 * i); w1 |= (unsigned)__shfl(q1, srcl) << (8 * i); }
        if (lane < 16) { coefq[(size_t)t * 32 + lane] = w0; coefq[(size_t)t * 32 + 16 + lane] = w1; }
        if (lane == 0) sc[t] = amax * (1.0f / 127.0f);
    }
}
#define PV_ISSUE16(W, ELO, EHI) do { _Pragma("unroll") for (int k = 0; k < 8; ++k) { const int e0 = __shfl(ELO, k * 8 + g), e1 = __shfl(EHI, k * 8 + g); \
        W[k] = *(const uint4*)(PV + (size_t)e0 * 1024 + 128 * s + 16 * j); W[8 + k] = *(const uint4*)(PV + (size_t)e1 * 1024 + 128 * s + 16 * j); } } while (0)
#define PV_META(T_, ELO, EHI, CQ) do { const int tq_ = (T_) < T ? (T_) : tlast; ELO = eidx[(size_t)tq_ * 128 + lane]; EHI = eidx[(size_t)tq_ * 128 + 64 + lane]; \
        CQ[0] = coefq[(size_t)tq_ * 32 + g]; CQ[1] = coefq[(size_t)tq_ * 32 + 8 + g]; CQ[2] = coefq[(size_t)tq_ * 32 + 16 + g]; CQ[3] = coefq[(size_t)tq_ * 32 + 24 + g]; } while (0)
#define PV_BLK(W0, W1, W2, W3, CQW, A0, A1, A2, A3) do { \
        const unsigned l01 = __builtin_amdgcn_perm(W1, W0, 0x05010400u), h01 = __builtin_amdgcn_perm(W1, W0, 0x07030602u), l23 = __builtin_amdgcn_perm(W3, W2, 0x05010400u), h23 = __builtin_amdgcn_perm(W3, W2, 0x07030602u); \
        A0 = __builtin_amdgcn_sdot4((int)__builtin_amdgcn_perm(l23, l01, 0x05040100u), (int)(CQW), A0, false); A1 = __builtin_amdgcn_sdot4((int)__builtin_amdgcn_perm(l23, l01, 0x07060302u), (int)(CQW), A1, false); \
        A2 = __builtin_amdgcn_sdot4((int)__builtin_amdgcn_perm(h23, h01, 0x05040100u), (int)(CQW), A2, false); A3 = __builtin_amdgcn_sdot4((int)__builtin_amdgcn_perm(h23, h01, 0x07060302u), (int)(CQW), A3, false); } while (0)
#define PV_QUAD(W, O, CQW) do { PV_BLK(W[(O)].x, W[(O) + 1].x, W[(O) + 2].x, W[(O) + 3].x, CQW, acc[0], acc[1], acc[2], acc[3]); PV_BLK(W[(O)].y, W[(O) + 1].y, W[(O) + 2].y, W[(O) + 3].y, CQW, acc[4], acc[5], acc[6], acc[7]); \
        PV_BLK(W[(O)].z, W[(O) + 1].z, W[(O) + 2].z, W[(O) + 3].z, CQW, acc[8], acc[9], acc[10], acc[11]); PV_BLK(W[(O)].w, W[(O) + 1].w, W[(O) + 2].w, W[(O) + 3].w, CQW, acc[12], acc[13], acc[14], acc[15]); } while (0)
#define PV_TOKEN(W, CQ, T_) do { int acc[16]; _Pragma("unroll") for (int i = 0; i < 16; ++i) acc[i] = 0; \
        PV_QUAD(W, 0, CQ[0]); PV_QUAD(W, 4, CQ[1]); PV_QUAD(W, 8, CQ[2]); PV_QUAD(W, 12, CQ[3]); \
        int y8[8], y4[4], y2[2]; \
        _Pragma("unroll") for (int i = 0; i < 8; ++i) { const int give = b5 ? acc[i] : acc[8 + i]; y8[i] = (b5 ? acc[8 + i] : acc[i]) + __shfl_xor(give, 32); } \
        _Pragma("unroll") for (int i = 0; i < 4; ++i) { const int give = b4 ? y8[i] : y8[4 + i]; y4[i] = (b4 ? y8[4 + i] : y8[i]) + __shfl_xor(give, 16); } \
        _Pragma("unroll") for (int i = 0; i < 2; ++i) { const int give = b3 ? y4[i] : y4[2 + i]; y2[i] = (b3 ? y4[2 + i] : y4[i]) + __shfl_xor(give, 8); } \
        const float sct = sc[(T_)]; *(float2*)(Y + (size_t)(T_) * 1024 + 128 * s + 16 * j + c0) = make_float2((float)y2[0] * sct, (float)y2[1] * sct); } while (0)
__device__ __forceinline__ void ph_peer_v(const Params& p, int wv) {
    PH_IDS(); unsigned char* ws = p.ws; const int s = bid & 7, cu = bid >> 3, ncu = nb >> 3, g = lane >> 3, j = lane & 7;
    const int* eidx = (const int*)(ws + OFF_EIDX); const unsigned* coefq = (const unsigned*)(ws + OFF_COEFQ); const float* sc = (const float*)(ws + OFF_SC); const unsigned char* PV = ws + OFF_PV; float* Y = (float*)(ws + OFF_Y);
    const bool b5 = (lane & 32) != 0, b4 = (lane & 16) != 0, b3 = (lane & 8) != 0; const int c0 = (b5 ? 8 : 0) + (b4 ? 4 : 0) + (b3 ? 2 : 0);
    const int tstep = ncu * NWAVES; int t = cu * NWAVES + wv;
    if (t >= T) return;
    const int tlast = t;
    int el0, eh0, el1, eh1; unsigned cq0[4], cq1[4];
    PV_META(t, el0, eh0, cq0); PV_META(t + tstep, el1, eh1, cq1);
    uint4 wA[16], wB[16];
    PV_ISSUE16(wA, el0, eh0);
    for (;;) {
        { unsigned cc[4] = {cq0[0], cq0[1], cq0[2], cq0[3]}; PV_META(t + 2 * tstep, el0, eh0, cq0); PV_ISSUE16(wB, el1, eh1); PV_TOKEN(wA, cc, t); }
        t += tstep; if (t >= T) break;
        { unsigned cc[4] = {cq1[0], cq1[1], cq1[2], cq1[3]}; PV_META(t + 2 * tstep, el1, eh1, cq1); PV_ISSUE16(wA, el0, eh0); PV_TOKEN(wB, cc, t); }
        t += tstep; if (t >= T) break;
    }
}
__device__ __forceinline__ void ph_peer_ln2(const Params& p, int wv) {
    PH_IDS(); unsigned char* ws = p.ws; const float* Y = (const float*)(ws + OFF_Y);
    int t = gwave; if (t >= T) return;
    float4 ha[4], ya[4];
#pragma unroll
    for (int i = 0; i < 4; ++i) { ha[i] = *(const float4*)(p.out + (size_t)t * 1024 + lane * 16 + 4 * i); ya[i] = *(const float4*)(Y + (size_t)t * 1024 + lane * 16 + 4 * i); }
    for (;;) {
        const int tn = t + nwaves; const int tq = tn < T ? tn : t;
        float4 hb[4], yb[4];
#pragma unroll
        for (int i = 0; i < 4; ++i) { hb[i] = *(const float4*)(p.out + (size_t)tq * 1024 + lane * 16 + 4 * i); yb[i] = *(const float4*)(Y + (size_t)tq * 1024 + lane * 16 + 4 * i); }
        float y[16]; float s1 = 0.f, s2 = 0.f;
#pragma unroll
        for (int i = 0; i < 4; ++i) { y[4 * i] = ya[i].x + DN_ALPHA * ha[i].x; y[4 * i + 1] = ya[i].y + DN_ALPHA * ha[i].y; y[4 * i + 2] = ya[i].z + DN_ALPHA * ha[i].z; y[4 * i + 3] = ya[i].w + DN_ALPHA * ha[i].w; }
#pragma unroll
        for (int i = 0; i < 16; ++i) { s1 += y[i]; s2 += y[i] * y[i]; }
#pragma unroll
        for (int o = 1; o < 64; o <<= 1) { s1 += __shfl_xor(s1, o); s2 += __shfl_xor(s2, o); }
        const float mu = s1 * (1.0f / 1024.0f); const float var = fmaxf(s2 * (1.0f / 1024.0f) - mu * mu, 0.f); const float rstd = rsqrtf(var + LN_EPS);
        float* row = p.out + (size_t)t * 1024 + lane * 16;
#pragma unroll
        for (int i = 0; i < 4; ++i) { const int c = lane * 16 + 4 * i; const float4 ga = *(const float4*)(p.ln2_g + c), ba = *(const float4*)(p.ln2_b + c);
            float4 o; o.x = (y[4 * i] - mu) * rstd * ga.x + ba.x; o.y = (y[4 * i + 1] - mu) * rstd * ga.y + ba.y; o.z = (y[4 * i + 2] - mu) * rstd * ga.z + ba.z; o.w = (y[4 * i + 3] - mu) * rstd * ga.w + ba.w;
            *(float4*)(row + 4 * i) = o; }
        if (tn >= T) break;
        t = tn;
#pragma unroll
        for (int i = 0; i < 4; ++i) { ha[i] = hb[i]; ya[i] = yb[i]; }
    }
}

#define LAS __attribute__((address_space(3)))
#define XB_TMO      128
#define XB_XCNT(j)  (256  + 64 * (j))
#define XB_XSUB(j)  (1280 + 64 * (j))
#define XB_XGEN(j)  (2304 + 64 * (j))
#define XB_TOP      3328
#define XB_TOPGEN   3392
#define XCD_BAR_WORDS 3456
#define XB_SPIN_CAP (1u << 18)

__device__ __forceinline__ unsigned xb_ld(unsigned* p)              { return __hip_atomic_load(p, __ATOMIC_RELAXED, __HIP_MEMORY_SCOPE_AGENT); }
__device__ __forceinline__ unsigned xb_add(unsigned* p, unsigned v) { return __hip_atomic_fetch_add(p, v, __ATOMIC_RELAXED, __HIP_MEMORY_SCOPE_AGENT); }
__device__ __forceinline__ unsigned xb_xcc_id() { return (unsigned)__builtin_amdgcn_s_getreg((3 << 11) | 20) & 0xFu; }
#define XB_SPIN(cond, bar) do { unsigned _sp = 0; while (cond) { __builtin_amdgcn_s_sleep(1); \
    if ((++_sp & 255u) == 0u) { if (xb_ld(&(bar)[XB_TMO])) break; if (_sp > XB_SPIN_CAP) { atomicAdd(&(bar)[XB_TMO], 1u); break; } } } } while (0)

struct XcdBarrier {
    unsigned* bar; unsigned x;
    volatile LAS unsigned* st;
};

__device__ __forceinline__ XcdBarrier xcd_barrier_post(unsigned* bar, volatile LAS unsigned* st, bool leader) {
    XcdBarrier b; b.bar = bar; b.x = xb_xcc_id(); b.st = st;
    if (leader) (void)xb_add(&bar[XB_XCNT(b.x)], 1u);
    return b;
}
__device__ __forceinline__ void xcd_barrier_complete(unsigned* bar, unsigned x, unsigned& nloc, unsigned& nx) {
    const unsigned G = gridDim.x * gridDim.y * gridDim.z;
    unsigned sum, cnt, mine, sp = 0u;
    for (;;) {
        sum = 0u; cnt = 0u; mine = 0u;
#pragma unroll
        for (unsigned j = 0; j < 16; ++j) { const unsigned c = xb_ld(&bar[XB_XCNT(j)]); sum += c; cnt += (c > 0u) ? 1u : 0u; mine = (j == x) ? c : mine; }
        if (sum == G) break;
        __builtin_amdgcn_s_sleep(1);
        if ((++sp & 255u) == 0u) { if (xb_ld(&bar[XB_TMO])) break; if (sp > XB_SPIN_CAP) { atomicAdd(&bar[XB_TMO], 1u); break; } }
    }
    nloc = mine > 0u ? mine : 1u; nx = cnt > 0u ? cnt : 1u;
}

__device__ __forceinline__ void xcd_barrier(const XcdBarrier& b, bool leader) {
    asm volatile("s_waitcnt vmcnt(0)" ::: "memory");
    __syncthreads();
    if (leader) {
        unsigned* bar = b.bar;
        __builtin_amdgcn_s_waitcnt(0);
        unsigned nloc = b.st[0], nx = b.st[1];
        if (nloc == 0u) { xcd_barrier_complete(bar, b.x, nloc, nx); b.st[0] = nloc; b.st[1] = nx; }
        const unsigned old = xb_add(&bar[XB_XSUB(b.x)], 1u);
        const unsigned gen = old / nloc;
        if (old + 1u == (gen + 1u) * nloc) {
            __builtin_amdgcn_fence(__ATOMIC_RELEASE, "agent");
            asm volatile("s_waitcnt vmcnt(0)" ::: "memory");
            const unsigned og = xb_add(&bar[XB_TOP], 1u);
            const unsigned tg = og / nx;
            if (og + 1u == (tg + 1u) * nx) xb_add(&bar[XB_TOPGEN], 1u);
            else XB_SPIN(xb_ld(&bar[XB_TOPGEN]) == tg, bar);
            __builtin_amdgcn_fence(__ATOMIC_ACQUIRE, "agent");
            xb_add(&bar[XB_XGEN(b.x)], 1u);
            asm volatile("s_waitcnt vmcnt(0)" ::: "memory");
        } else {
            XB_SPIN(xb_ld(&bar[XB_XGEN(b.x)]) == gen, bar);
            __builtin_amdgcn_fence(__ATOMIC_ACQUIRE, "agent");
            asm volatile("s_waitcnt vmcnt(0)" ::: "memory");
        }
    }
    __syncthreads();
}

#ifndef TIMING_BOUNDARY
#define TIMING_BOUNDARY -1
#endif
#define TPROBE(k) do { if (TIMING_BOUNDARY == (k)) { const unsigned long long t1_ = __builtin_amdgcn_s_memrealtime(); while (__builtin_amdgcn_s_memrealtime() - t1_ < t1_ - tstart_) __builtin_amdgcn_s_sleep(8); } } while (0)
__global__ void __launch_bounds__(NTHREADS) fwd_megakernel(Params p) {
    extern __shared__ __attribute__((aligned(16))) unsigned char lds[];
    cg::grid_group grid = cg::this_grid();
    const int nb = gridDim.x, bid = blockIdx.x;
    const int wv = __builtin_amdgcn_readfirstlane(threadIdx.x >> 6);
    unsigned char* ws = p.ws;
    const unsigned long long tstart_ = (TIMING_BOUNDARY >= 0) ? __builtin_amdgcn_s_memrealtime() : 0ull; (void)tstart_;
    PG8_LAS unsigned char* ldsp = (PG8_LAS unsigned char*)lds;
    const bool leader = (wv == 0) && (lane_id() == 0);
    volatile LAS unsigned* bst = (volatile LAS unsigned*)(ldsp + LDS_BYTES - 64);
    if (leader) { bst[0] = 0u; bst[1] = 0u; }
    __syncthreads();
    const XcdBarrier xbar = xcd_barrier_post((unsigned*)(ws + OFF_BAR), bst, leader);

    ph_prep(p, wv, lds);
    if (p.ws == nullptr) grid.sync();
    xcd_barrier(xbar, leader);
    TPROBE(0);
    if (bid == 0) {
        const int o = (wv << 6) | lane_id(); const float* b1p = (const float*)(ws + OFF_HID) + (size_t)(o >> 8) * 32 * 256 + (o & 255); float s = 0.f;
        for (int kc = 0; kc < 32; ++kc) s += b1p[kc * 256];
        ((float*)(ws + (o < 256 ? OFF_B1K : OFF_B1V)))[o & 255] = s;
    }
    {
        pg8::Gemm g{(const bf16*)(ws + OFF_XB), (const bf16*)(ws + OFF_WIN), T, NPROJ_PAD, 1024, 1024, 0, 1 << 30, 0l};
        pg8::StaticOrder S; S.init(T, NPROJ_PAD, nb, bid);
        pg8::EpiInProjPg E{(bf16*)(ws + OFF_Z), (bf16*)(ws + OFF_XBC), (bf16*)(ws + OFF_Q), (bf16*)(ws + OFF_KVS), (bf16*)(ws + OFF_DTG)};
        pg8::gemm_phase<pg8::EpiInProjPg, pg8::StaticOrder, pg8::NoMid, true, true>(wv, ldsp, g, S, E, pg8::NoMid{});
    }
    xcd_barrier(xbar, leader);
    TPROBE(1);
    if (bid < 32) {
        const bool isv = bid >= 16;
        pg8::Gemm g{(const bf16*)(ws + OFF_KVS) + (isv ? 256 : 0), (const bf16*)(ws + (isv ? OFF_W1V : OFF_W1K)), 4096, 256, 2048, 0, 1, 1 << 30, 0l};
        pg8::StaticOrder S; S.init(4096, 256, 16, isv ? bid - 16 : bid);
        pg8::EpiBf16<1> E{(bf16*)(ws + OFF_HID + (isv ? 2 * MiB : 0)), 256, (const float*)(ws + (isv ? OFF_B1V : OFF_B1K)), 0, 0, 1.f};
        pg8::gemm_phase<pg8::EpiBf16<1>, pg8::StaticOrder, pg8::NoMid, true, true>(wv, ldsp, g, S, E, pg8::NoMid{});
    }
    else ph_tokprep(p, wv);
    xcd_barrier(xbar, leader);
    TPROBE(2);
    ph_ssd_prep2(p, wv, lds);
    ph_vt_prep(p, wv);
    xcd_barrier(xbar, leader);
    TPROBE(3);
    {
        RowMajorBf16 ak{(const bf16*)(ws + OFF_HID), 256}, av{(const bf16*)(ws + OFF_HID + 2 * MiB), 256};
        RowMajorBf16 bk{(const bf16*)(ws + OFF_W2K), 256}, bv{(const bf16*)(ws + OFF_W2V), 256};
        EpiKc ek{(bf16*)(ws + OFF_KC), false}, ev{(bf16*)(ws + OFF_VCT), true};
        gemm_wave32(wv, 4096 / 32, 64 / 32, 256, ak, bk, ek);
        gemm_wave32(wv, 4096 / 32, 64 / 32, 256, av, bv, ev);
    }
    ph_ssd_states(p, wv);
    xcd_barrier(xbar, leader);
    TPROBE(4);
    ph_kc_rope(p, wv);
    ph_ssd_scan(p, wv);
    ph_peer_cvt(p, wv);
    xcd_barrier(xbar, leader);
    TPROBE(5);
    ph_ssd_out(p, wv, lds);
    ph_nsa(p, wv, lds);
    xcd_barrier(xbar, leader);
    TPROBE(6);
    {
        pg8::Gemm g{(const bf16*)(ws + OFF_Q), (const bf16*)(ws + OFF_WOUT), T, 1024, 2048, 1024, 0, 16, (long)OFF_Z - (long)OFF_Q - 16l * 128l};
        pg8::StaticOrder S; S.init(T, 1024, nb, bid);
        pg8::RmsFactors rf{(const float*)(ws + OFF_SSQ), (const float*)(ws + OFF_HID), RMS_EPS};
        pg8::EpiOutProj E{p.x, p.out, DN_ALPHA, rf}; pg8::MidRmsScale MH{rf};
        pg8::gemm_phase<pg8::EpiOutProj, pg8::StaticOrder, pg8::MidRmsScale, true, true>(wv, ldsp, g, S, E, MH);
    }
    xcd_barrier(xbar, leader);
    TPROBE(7);
    ph_ln1(p, wv);
    xcd_barrier(xbar, leader);
    TPROBE(8);
    {
        pg8::Gemm g{(const bf16*)(ws + OFF_H1B), (const bf16*)(ws + OFF_WQ), T, 2048, 1024, 1024, 0, 1 << 30, 0l};
        pg8::StaticOrder S; S.init(T, 2048, nb, bid);
        pg8::EpiBf16<0> E{(bf16*)(ws + OFF_QP), 2048, nullptr, 0, 0, 1.f};
        pg8::gemm_phase<pg8::EpiBf16<0>, pg8::StaticOrder, pg8::NoMid, true, true>(wv, ldsp, g, S, E, pg8::NoMid{});
    }
    xcd_barrier(xbar, leader);
    TPROBE(9);
    ph_peer_topk(p, wv, lds);
    xcd_barrier(xbar, leader);
    TPROBE(10);
    ph_peer_u(p, wv);
    xcd_barrier(xbar, leader);
    TPROBE(11);
    ph_peer_c(p, wv);
    xcd_barrier(xbar, leader);
    TPROBE(12);
    ph_peer_v(p, wv);
    xcd_barrier(xbar, leader);
    TPROBE(13);
    ph_peer_ln2(p, wv);
}

extern "C" void kernel_launch(void* const* d_in, const int* in_sizes, int n_in, void* d_out, int out_size, void* d_ws, size_t ws_size, hipStream_t stream) {
    static int grid_blocks = 0;
    if (!grid_blocks) {
        int dev = 0, cus = 0, per_cu = 0;
        hipGetDevice(&dev);
        hipDeviceGetAttribute(&cus, hipDeviceAttributeMultiprocessorCount, dev);
        hipFuncSetAttribute((const void*)fwd_megakernel, hipFuncAttributeMaxDynamicSharedMemorySize, LDS_BYTES);
        hipOccupancyMaxActiveBlocksPerMultiprocessor(&per_cu, fwd_megakernel, NTHREADS, LDS_BYTES);
        if (per_cu < 1) per_cu = 1;
        if (per_cu > 1) per_cu = 1;
        grid_blocks = cus * per_cu;
        if (ws_size < 244 * MiB) fprintf(stderr, "kernel_launch: workspace too small: %zu\n", ws_size);
    }
    Params p{};
    const float** pp = (const float**)&p;
    for (int i = 0; i < 24; ++i) pp[i] = (const float*)d_in[i];
    p.out = (float*)d_out; p.ws = (unsigned char*)d_ws;
    (void)hipMemsetAsync((unsigned char*)d_ws + OFF_BAR, 0, BAR_BYTES, stream);
    void* args[] = {&p};
    hipError_t e = hipLaunchCooperativeKernel((void*)fwd_megakernel, dim3(grid_blocks), dim3(NTHREADS), args, LDS_BYTES, stream);
    if (e != hipSuccess) fprintf(stderr, "cooperative launch failed: %s (grid %d)\n", hipGetErrorString(e), grid_blocks);
}
```

```cpp
#include <hip/hip_runtime.h>
#include <hip/hip_cooperative_groups.h>
#include <cstdio>
#include <cstdint>
namespace cg = cooperative_groups;

typedef unsigned short bf16;
typedef short bf16x8 __attribute__((ext_vector_type(8)));
typedef float f32x4 __attribute__((ext_vector_type(4)));
typedef float f32x16 __attribute__((ext_vector_type(16)));
typedef unsigned long long u64;

constexpr int T = 16384, L = 4096, NBATCH = 4, D = 1024;
constexpr int NPROJ = 5184, NPROJ_PAD = 5376;
constexpr int NTHREADS = 512, NWAVES = 8;
constexpr float LN_EPS = 1e-5f, RMS_EPS = 1e-5f;
constexpr float DN_ALPHA = 1.189207115002721f;
constexpr float NEG_INF = -1e30f, BIG = 1e30f;

constexpr size_t MiB = 1u << 20;
constexpr size_t OFF_SSQ = 0, OFF_BAR = 512 * 1024, BAR_BYTES = 16384;
constexpr size_t OFF_WOUT = 1 * MiB, OFF_WQ = 5 * MiB, OFF_W1K = 9 * MiB, OFF_W1V = 10 * MiB;
constexpr size_t OFF_W2K = 11 * MiB, OFF_W2V = 11 * MiB + 65536, OFF_B1K = 11 * MiB + 131072, OFF_B1V = 11 * MiB + 131072 + 4096;
constexpr size_t OFF_KEYS = 12 * MiB, OFF_ROPE = 13 * MiB, OFF_DT = 14 * MiB, OFF_ACS = 15 * MiB, OFF_GATE = 16 * MiB;
constexpr size_t OFF_HID = 20 * MiB, OFF_KC = 24 * MiB;
constexpr size_t OFF_Z = 26 * MiB, OFF_Q = 58 * MiB, OFF_KVS = 90 * MiB, OFF_XBC = 138 * MiB, OFF_XSBC = 186 * MiB, OFF_BT = 234 * MiB, OFF_DTG = 242 * MiB;
constexpr size_t OFF_VST = 138 * MiB, OFF_VWT = 146 * MiB, OFF_VCT = 19 * MiB;
constexpr size_t OFF_XB = 186 * MiB, OFF_WIN = 218 * MiB;
constexpr size_t OFF_H1B = 90 * MiB, OFF_QP = 26 * MiB, OFF_EIDX = 202 * MiB, OFF_GW = 210 * MiB;
constexpr size_t OFF_PU = 154 * MiB, OFF_PV = 170 * MiB;
constexpr int LDS_BYTES = 147456;

struct Params {
    const float *x, *w_in, *conv_w, *conv_b, *dt_bias, *a_log, *d_skip, *ssd_norm_w;
    const float *cmp_pos_k, *cmp_w1_k, *cmp_w2_k, *cmp_pos_v, *cmp_w1_v, *cmp_w2_v;
    const float *attn_norm_w, *w_out, *ln1_g, *ln1_b, *peer_wq, *peer_keys, *peer_u, *peer_v, *ln2_g, *ln2_b;
    float* out; unsigned char* ws;
};

__device__ __forceinline__ float bf2f(bf16 v) { return __uint_as_float((unsigned)v << 16); }
__device__ __forceinline__ bf16 f2bf(float f) { unsigned u = __float_as_uint(f); return (bf16)((u + 0x7fffu + ((u >> 16) & 1u)) >> 16); }
__device__ __forceinline__ int lane_id() { int l = (int)__builtin_amdgcn_mbcnt_hi(~0u, __builtin_amdgcn_mbcnt_lo(~0u, 0u)); asm volatile("" : "+v"(l)); return l; }
#define PH_IDS() const int lane = lane_id(); const int tid = (wv << 6) | lane; const int bid = blockIdx.x, nb = gridDim.x; const int gtid = bid * NTHREADS + tid, gn = nb * NTHREADS; const int gwave = bid * NWAVES + wv, nwaves = nb * NWAVES; (void)gtid; (void)gn; (void)gwave; (void)nwaves;
typedef float f32x2v __attribute__((ext_vector_type(2)));
typedef __bf16 bf16x2v __attribute__((ext_vector_type(2)));
__device__ __forceinline__ unsigned pk2bf(float lo, float hi) { f32x2v v = {lo, hi}; bf16x2v b = __builtin_convertvector(v, bf16x2v); return __builtin_bit_cast(unsigned, b); }
__device__ __forceinline__ float bflo(unsigned w) { return __uint_as_float(w << 16); }
__device__ __forceinline__ float bfhi(unsigned w) { return __uint_as_float(w & 0xffff0000u); }
__device__ __forceinline__ float wave_sum(float v) {
#pragma unroll
    for (int o = 1; o < 64; o <<= 1) v += __shfl_xor(v, o);
    return v;
}
__device__ __forceinline__ float wave_max(float v) {
#pragma unroll
    for (int o = 1; o < 64; o <<= 1) v = fmaxf(v, __shfl_xor(v, o));
    return v;
}
__device__ __forceinline__ float gelu_exact(float v) { return 0.5f * v * (1.0f + erff(v * 0.7071067811865476f)); }
__device__ __forceinline__ float sigmoidf(float v) { return 1.0f / (1.0f + __expf(-v)); }

template <class AP, class BP, class EP>
__device__ __forceinline__ void gemm_wave32(int wv, int Mt, int Nt, int K, const AP& ap, const BP& bp, const EP& ep) {
    PH_IDS(); const int r = lane & 15, q = lane >> 4;
    for (int tile = gwave; tile < Mt * Nt; tile += nwaves) {
        const int tm = tile / Nt, tn = tile % Nt, row0 = tm * 32, col0 = tn * 32;
        f32x4 acc[2][2];
#pragma unroll
        for (int i = 0; i < 2; ++i)
#pragma unroll
            for (int j = 0; j < 2; ++j) acc[i][j] = (f32x4){0.f, 0.f, 0.f, 0.f};
        for (int k0 = 0; k0 < K; k0 += 32) {
            const bf16x8 a0 = ap(row0 + r, k0 + 8 * q), a1 = ap(row0 + 16 + r, k0 + 8 * q);
            const bf16x8 b0 = bp(col0 + r, k0 + 8 * q), b1 = bp(col0 + 16 + r, k0 + 8 * q);
            acc[0][0] = __builtin_amdgcn_mfma_f32_16x16x32_bf16(a0, b0, acc[0][0], 0, 0, 0);
            acc[0][1] = __builtin_amdgcn_mfma_f32_16x16x32_bf16(a0, b1, acc[0][1], 0, 0, 0);
            acc[1][0] = __builtin_amdgcn_mfma_f32_16x16x32_bf16(a1, b0, acc[1][0], 0, 0, 0);
            acc[1][1] = __builtin_amdgcn_mfma_f32_16x16x32_bf16(a1, b1, acc[1][1], 0, 0, 0);
        }
#pragma unroll
        for (int i = 0; i < 2; ++i)
#pragma unroll
            for (int j = 0; j < 2; ++j)
#pragma unroll
                for (int e = 0; e < 4; ++e) ep(row0 + 16 * i + 4 * q + e, col0 + 16 * j + r, acc[i][j][e]);
    }
}
template <class AP, class BP, class EP>
__device__ __forceinline__ void gemm_wave16(int wv, int Mt, int Nt, int K, const AP& ap, const BP& bp, const EP& ep, int task0, int ntask_total) {
    PH_IDS(); const int r = lane & 15, q = lane >> 4;
    for (int task = gwave; task < ntask_total; task += nwaves) {
        const int tile = task - task0; if (tile < 0 || tile >= Mt * Nt) continue;
        const int tm = tile / Nt, tn = tile % Nt, row0 = tm * 16, col0 = tn * 16;
        f32x4 acc = (f32x4){0.f, 0.f, 0.f, 0.f};
#pragma unroll 4
        for (int k0 = 0; k0 < K; k0 += 32) acc = __builtin_amdgcn_mfma_f32_16x16x32_bf16(ap(row0 + r, k0 + 8 * q), bp(col0 + r, k0 + 8 * q), acc, 0, 0, 0);
#pragma unroll
        for (int e = 0; e < 4; ++e) ep(row0 + 4 * q + e, col0 + r, acc[e]);
    }
}
struct RowMajorBf16 { const bf16* p; int ld; __device__ __forceinline__ bf16x8 operator()(int row, int k) const { return *(const bf16x8*)(p + (size_t)row * ld + k); } };

namespace pg8 {
#define PG8_LAS __attribute__((address_space(3)))
typedef unsigned short bf16_t;
typedef short bf16x8 __attribute__((ext_vector_type(8)));
typedef float f32x4 __attribute__((ext_vector_type(4)));
typedef unsigned u32x4 __attribute__((ext_vector_type(4)));
constexpr int BM = 256, BK = 64, HALF = 128, HTB = HALF * BK * 2  , STAGE_BYTES = 8 * HTB, NXCD = 8, WGM = 8;

__host__ __device__ __forceinline__ int lds_byte(int r, int c) { const int st = (r >> 4) * 2 + (c >> 5), rr = r & 15, cc = c & 31, ob = rr * 64 + cc * 2; return st * 1024 + (ob ^ (((ob >> 9) & 1) << 5)); }
__host__ __device__ __forceinline__ void stage_rc(int b, int& R, int& C) { const int st = b / 1024, sb = b % 1024, swz = sb ^ (((sb >> 9) & 1) << 5); R = (st >> 1) * 16 + swz / 64; C = (st & 1) * 32 + (swz % 64) / 2; }
__host__ __device__ __forceinline__ int perm32(int rho) { const int n = rho >> 4, i = rho & 15; return 8 * (i >> 2) + 4 * n + (i & 3); }

struct Unit { int pm, pn; };
struct Gemm { const bf16_t* A; const bf16_t* Bt; int M, N, K; int lda; int amode; int ksplit; long kdelta; };

struct StaticOrder {
    int nM, nN, nwg, G, c;
    __host__ __device__ void init(int M, int N, int G_, int c_) { nM = M / BM; nN = N / BM; nwg = nM * nN; G = G_; c = c_; }
    __host__ __device__ bool next(int i, Unit& u) const {
        const long L = (long)i * G + c; if (L >= nwg) return false;
        int wgid = (int)L; { const int q = nwg / NXCD, r = nwg % NXCD, xcd = wgid % NXCD, off = wgid / NXCD; wgid = (xcd < r ? xcd * (q + 1) : r * (q + 1) + (xcd - r) * q) + off; }
        const int nig = WGM * nN, gid = wgid / nig, fm = gid * WGM, gsz = (nM - fm) < WGM ? (nM - fm) : WGM;
        u.pm = fm + ((wgid % nig) % gsz); u.pn = (wgid % nig) / gsz; return true;
    }
    __device__ __forceinline__ void a_ready(const Unit&) const {}
    __device__ __forceinline__ void done(const Unit&) const {}
};


__device__ __forceinline__ unsigned cvt_pk_bf16(float lo, float hi) { unsigned r; asm volatile("v_cvt_pk_bf16_f32 %0, %1, %2" : "=v"(r) : "v"(lo), "v"(hi)); return r; }
typedef float f32x2 __attribute__((ext_vector_type(2)));
__device__ __forceinline__ f32x2 gelu_pk(f32x2 v) {
    const f32x2 av = __builtin_elementwise_abs(v), d = av * 0.2316418882f + 1.0f;
    f32x2 t; t.x = __builtin_amdgcn_rcpf(d.x); t.y = __builtin_amdgcn_rcpf(d.y);
    f32x2 q = t * 0.5307027145f + (-0.7265760135f); q = q * t + 0.7107068705f; q = q * t + (-0.142248368f); q = q * t + 0.127414796f; q = q * t;
    const f32x2 s = (v * v) * (-0.72134752044f);
    f32x2 e; e.x = __builtin_amdgcn_exp2f(s.x); e.y = __builtin_amdgcn_exp2f(s.y);
    const f32x2 m = v * (q * e), r = v - m;
    f32x2 o; o.x = v.x < 0.f ? m.x : r.x; o.y = v.y < 0.f ? m.y : r.y; return o;
}

template <int ACT  > struct EpiBf16 {
    static constexpr bool PERM = true, AFTER_DRAIN = false; static_assert(ACT == 0 || ACT == 1, "EpiBf16: ACT is 0 (none) or 1 (gelu_pk)");
    bf16_t* O; int ldc; const float* bias; int split_cols; size_t split_stride; float scale0;
    __device__ __forceinline__ void operator()(const f32x4 (&acc)[2][2][4][2], const Unit& u, int wr, int wc, int fr, int fq) const {
        const int row0 = u.pm * BM + wr * 64 + fr; int colt = u.pn * BM; bf16_t* base = O;
        float sc = 1.f; if (split_cols) { const int t = colt / split_cols; base += (size_t)t * split_stride; colt -= t * split_cols; if (t == 0) sc = scale0; }
        const int col0 = colt + wc * 32 + 8 * fq, bcol0 = u.pn * BM + wc * 32 + 8 * fq;
        f32x4 bv[2][2];
#pragma unroll
        for (int bj = 0; bj < 2; ++bj)
#pragma unroll
            for (int n = 0; n < 2; ++n) bv[bj][n] = bias ? *(const f32x4*)(bias + bcol0 + bj * HALF + 4 * n) : (f32x4){0.f, 0.f, 0.f, 0.f};
#pragma unroll
        for (int ai = 0; ai < 2; ++ai)
#pragma unroll
            for (int m = 0; m < 4; ++m) { bf16_t* rowp = base + (size_t)(row0 + ai * HALF + m * 16) * ldc + col0;
#pragma unroll
                for (int bj = 0; bj < 2; ++bj) { f32x4 v0 = acc[ai][bj][m][0] + bv[bj][0], v1 = acc[ai][bj][m][1] + bv[bj][1];
                    if (ACT == 1) { f32x2 a = gelu_pk((f32x2){v0[0], v0[1]}), b = gelu_pk((f32x2){v0[2], v0[3]}), c = gelu_pk((f32x2){v1[0], v1[1]}), d = gelu_pk((f32x2){v1[2], v1[3]});
                        v0 = (f32x4){a.x, a.y, b.x, b.y}; v1 = (f32x4){c.x, c.y, d.x, d.y}; }
                    v0 = v0 * sc; v1 = v1 * sc; u32x4 w; w.x = cvt_pk_bf16(v0[0], v0[1]); w.y = cvt_pk_bf16(v0[2], v0[3]); w.z = cvt_pk_bf16(v1[0], v1[1]); w.w = cvt_pk_bf16(v1[2], v1[3]);
                    *(u32x4*)(rowp + bj * HALF) = w; } }
    }
};

struct EpiInProjPg { static constexpr bool PERM = true, AFTER_DRAIN = false;
    bf16_t *z, *xbc, *q, *kvs, *dtg;
    __device__ __forceinline__ void operator()(const f32x4 (&acc)[2][2][4][2], const Unit& u, int wr, int wc, int fr, int fq) const {
        bf16_t* base; int ldc, colt; const int pn = u.pn;
        if (pn < 4) { base = z; ldc = 1024; colt = pn * 256; } else if (pn < 10) { base = xbc; ldc = 1536; colt = (pn - 4) * 256; }
        else if (pn < 14) { base = q; ldc = 1024; colt = (pn - 10) * 256; } else if (pn < 20) { base = kvs; ldc = 1536; colt = (pn - 14) * 256; }
        else { base = dtg; ldc = 64; colt = 0; }
        const int row0 = u.pm * BM + wr * 64 + fr, col0 = colt + wc * 32 + 8 * fq;
#pragma unroll
        for (int ai = 0; ai < 2; ++ai)
#pragma unroll
            for (int m = 0; m < 4; ++m) { bf16_t* rowp = base + (size_t)(row0 + ai * HALF + m * 16) * ldc + col0;
#pragma unroll
                for (int bj = 0; bj < 2; ++bj) { const f32x4 v0 = acc[ai][bj][m][0], v1 = acc[ai][bj][m][1];
                    u32x4 w; w.x = cvt_pk_bf16(v0[0], v0[1]); w.y = cvt_pk_bf16(v0[2], v0[3]); w.z = cvt_pk_bf16(v1[0], v1[1]); w.w = cvt_pk_bf16(v1[2], v1[3]);
                    if (pn < 20 || (bj == 0 && wc < 2)) *(u32x4*)(rowp + bj * HALF) = w; } }
    }
};
struct RmsFactors { const float* ssqp; const float* ssq2p; float eps;
    __device__ __forceinline__ void get(int row, float& ra, float& r0, float& r1) const {
        const f32x4 a = *(const f32x4*)(ssqp + 4 * row); const f32x4 b0 = *(const f32x4*)(ssq2p + 16 * row), b1 = *(const f32x4*)(ssq2p + 16 * row + 4), b2 = *(const f32x4*)(ssq2p + 16 * row + 8), b3 = *(const f32x4*)(ssq2p + 16 * row + 12);
        ra = rsqrtf(((a[0] + a[1]) + (a[2] + a[3])) * (1.0f / 1024.0f) + eps);
        r0 = rsqrtf((((b0[0] + b0[1]) + (b0[2] + b0[3])) + ((b1[0] + b1[1]) + (b1[2] + b1[3]))) * (1.0f / 512.0f) + eps);
        r1 = rsqrtf((((b2[0] + b2[1]) + (b2[2] + b2[3])) + ((b3[0] + b3[1]) + (b3[2] + b3[3]))) * (1.0f / 512.0f) + eps); } };
struct EpiOutProj { static constexpr bool PERM = false, AFTER_DRAIN = false;
    const float* x; float* out; float alpha; RmsFactors rf;
    __device__ __forceinline__ void operator()(const f32x4 (&acc)[2][2][4][2], const Unit& u, int wr, int wc, int fr, int fq) const {
        const int col0 = u.pn * BM + wc * 32 + 4 * fq;
#pragma unroll
        for (int ai = 0; ai < 2; ++ai)
#pragma unroll
            for (int m = 0; m < 4; ++m) { const int row = u.pm * BM + ai * HALF + wr * 64 + m * 16 + fr; const size_t off = (size_t)row * 1024 + col0;
                float ra, r0, r1; rf.get(row, ra, r0, r1);
#pragma unroll
                for (int bj = 0; bj < 2; ++bj)
#pragma unroll
                    for (int n = 0; n < 2; ++n) { const size_t o = off + bj * HALF + n * 16; const f32x4 xv = *(const f32x4*)(x + o); *(f32x4*)(out + o) = xv * alpha + acc[ai][bj][m][n] * r1; } }
    }
};
struct MidRmsScale { static constexpr bool ENABLED = true; RmsFactors rf;
    __device__ __forceinline__ void operator()(f32x4 (&acc)[2][2][4][2], const Unit& u, int t, int wr, int wc, int fr, int fq) const {
        if (t != 16 && t != 24) return;
        int rowb = u.pm * BM + wr * 64 + fr; asm volatile("" : "+v"(rowb));
#pragma unroll
        for (int ai = 0; ai < 2; ++ai)
#pragma unroll
            for (int m = 0; m < 4; ++m) { float ra, r0, r1; rf.get(rowb + ai * HALF + m * 16, ra, r0, r1);
                const float sc = (t == 16) ? ra / r0 : r0 / r1;
#pragma unroll
                for (int bj = 0; bj < 2; ++bj)
#pragma unroll
                    for (int n = 0; n < 2; ++n) acc[ai][bj][m][n] = acc[ai][bj][m][n] * sc; }
    }
};
struct NoMid { static constexpr bool ENABLED = false; template <class ACC> __device__ __forceinline__ void operator()(ACC&, const Unit&, int, int, int, int, int) const {} };
template <class Epi, class Sched, class Mid, bool ALIGN_EPI = false, bool SP2 = false>
__device__ __forceinline__ void gemm_phase(int wv, PG8_LAS unsigned char* lds, const Gemm g, const Sched& S, const Epi& E, const Mid& MH) {
    int lane_ = (int)__builtin_amdgcn_mbcnt_hi(~0u, __builtin_amdgcn_mbcnt_lo(~0u, 0u)); asm volatile("" : "+v"(lane_));
    const int lane = lane_, wid = wv, tid = (wv << 6) | lane, wr = wid >> 2, wc = wid & 3, fr = lane & 15, fq = lane >> 4;
    const int K = g.K, nt = K / BK;
    unsigned voffA[2], voffB[2];
#pragma unroll
    for (int i = 0; i < 2; ++i) { int R, C; stage_rc(tid * 16 + i * 8192, R, C); const int Rb = Epi::PERM ? ((R & ~31) + perm32(R & 31)) : R;
        voffA[i] = g.amode == 0 ? (unsigned)(R * g.lda + C) * 2u : (unsigned)((R >> 2) * 49152 + (R & 3) * 128 + C * 2); voffB[i] = (unsigned)(Rb * K + C) * 2u; }
    const size_t kstep = (size_t)(BK * 2);
    const size_t hstep = (size_t)HALF * K * 2;
    const size_t tstep = 2 * hstep;
    const size_t kstepA = g.amode == 0 ? (size_t)(BK * 2) : (size_t)3072;
    const size_t hstepA = g.amode == 0 ? (size_t)HALF * g.lda * 2 : (size_t)32 * 49152;
    const size_t tstepA = 2 * hstepA;
#define PG8_AK(base, t) ((base) + (size_t)(t) * kstepA + (((t) >= g.ksplit) ? g.kdelta : 0l))
    const unsigned ldsw = (unsigned)wid * 1024u;
    const int aoff = lds_byte(wr * 64 + fr, fq * 8), boff = lds_byte(wc * 32 + fr, fq * 8);
#define PG8_SA(b, h) (((b) * 2 + (h)) * HTB)
#define PG8_SB(b, h) ((4 + (b) * 2 + (h)) * HTB)
#define PG8_STAGE(bufoff, gbase, voff) do { _Pragma("unroll") for (int _i = 0; _i < 2; ++_i) \
        __builtin_amdgcn_global_load_lds((const unsigned*)((const char*)(gbase) + (voff)[_i]), (PG8_LAS unsigned*)(lds + (bufoff) + ldsw + _i * 8192), 16, 0, 0); } while (0)
#define PG8_LDA(dst, b, h) do { _Pragma("unroll") for (int m = 0; m < 4; ++m) _Pragma("unroll") for (int k = 0; k < 2; ++k) dst[m][k] = *(const PG8_LAS bf16x8*)(lds + PG8_SA(b, h) + aoff + m * 2048 + k * 1024); } while (0)
#define PG8_LDB(dst, b, h) do { _Pragma("unroll") for (int n = 0; n < 2; ++n) _Pragma("unroll") for (int k = 0; k < 2; ++k) dst[n][k] = *(const PG8_LAS bf16x8*)(lds + PG8_SB(b, h) + boff + n * 2048 + k * 1024); } while (0)
#define PG8_MMA(ai, bj, At, Bt) do { __builtin_amdgcn_s_setprio(1); _Pragma("unroll") for (int m = 0; m < 4; ++m) _Pragma("unroll") for (int n = 0; n < 2; ++n) _Pragma("unroll") for (int k = 0; k < 2; ++k) \
        acc[ai][bj][m][n] = __builtin_amdgcn_mfma_f32_16x16x32_bf16(Bt[n][k], At[m][k], acc[ai][bj][m][n], 0, 0, 0); __builtin_amdgcn_s_setprio(0); } while (0)
#define PG8_WAIT_V(n) asm volatile("s_waitcnt vmcnt(" #n ")" ::: "memory")
#define PG8_WAIT_L(n) asm volatile("s_waitcnt lgkmcnt(" #n ")" ::: "memory")
#define PG8_BAR __builtin_amdgcn_s_barrier()
#define PG8_SCHED __builtin_amdgcn_sched_barrier(0)
    Unit cur, nxt; int ui = 0;
    if (!S.next(0, cur)) return;
    f32x4 acc[2][2][4][2];
#pragma unroll
    for (int a = 0; a < 2; ++a)
#pragma unroll
        for (int b = 0; b < 2; ++b)
#pragma unroll
            for (int m = 0; m < 4; ++m)
#pragma unroll
                for (int n = 0; n < 2; ++n) acc[a][b][m][n] = (f32x4){0.f, 0.f, 0.f, 0.f};
    bf16x8 At[4][2], B0[2][2], B1[2][2];
    const char* cA = (const char*)g.A + (size_t)cur.pm * tstepA; const char* cB = (const char*)g.Bt + (size_t)cur.pn * tstep;
    S.a_ready(cur);
    if constexpr (SP2) {
        PG8_STAGE(PG8_SB(0, 0), cB, voffB); PG8_STAGE(PG8_SB(0, 1), cB + hstep, voffB); PG8_STAGE(PG8_SA(0, 0), cA, voffA); PG8_STAGE(PG8_SA(0, 1), cA + hstepA, voffA);
        if (wr == 1) PG8_BAR;
        PG8_WAIT_V(2); PG8_BAR;
        PG8_STAGE(PG8_SB(1, 0), cB + kstep, voffB); PG8_STAGE(PG8_SA(1, 0), PG8_AK(cA, 1), voffA); PG8_STAGE(PG8_SB(1, 1), cB + hstep + kstep, voffB);
        PG8_WAIT_V(6); PG8_BAR;
    } else {
        PG8_STAGE(PG8_SB(0, 0), cB, voffB); PG8_STAGE(PG8_SA(0, 0), cA, voffA); PG8_STAGE(PG8_SB(0, 1), cB + hstep, voffB); PG8_STAGE(PG8_SA(0, 1), cA + hstepA, voffA);
        if (wr == 1) PG8_BAR;
        PG8_WAIT_V(4); PG8_BAR;
        PG8_STAGE(PG8_SB(1, 0), cB + kstep, voffB); PG8_STAGE(PG8_SA(1, 0), PG8_AK(cA, 1), voffA); PG8_STAGE(PG8_SB(1, 1), cB + hstep + kstep, voffB);
        PG8_WAIT_V(6); PG8_BAR;
    }
    for (;;) {
        const bool has_next = S.next(ui + 1, nxt);
        const char* nA = has_next ? (const char*)g.A + (size_t)nxt.pm * tstepA : cA; const char* nB = has_next ? (const char*)g.Bt + (size_t)nxt.pn * tstep : cB;
        for (int t = 0; t < nt; t += 2) {
            const bool last = (t == nt - 2);
            if (Mid::ENABLED) MH(acc, cur, t, wr, wc, fr, fq);
            const char* a1 = PG8_AK(cA, t + 1);
            const char* a2 = last ? nA : PG8_AK(cA, t + 2); const char* b2 = last ? nB : cB + (size_t)(t + 2) * kstep;
            const char* a3 = a2 + kstepA; const char* b3 = b2 + kstep;
            if (last && has_next) S.a_ready(nxt);
            if constexpr (SP2) {
            PG8_LDB(B0, 0, 0); PG8_LDB(B1, 0, 1); PG8_SCHED; PG8_LDA(At, 0, 0); PG8_STAGE(PG8_SA(1, 1), a1 + hstepA, voffA);
            PG8_WAIT_V(8); PG8_WAIT_L(0); PG8_BAR; PG8_MMA(0, 0, At, B0); PG8_MMA(0, 1, At, B1); PG8_BAR; PG8_SCHED;
            PG8_LDA(At, 0, 1); PG8_STAGE(PG8_SB(0, 0), b2, voffB); PG8_STAGE(PG8_SB(0, 1), b2 + hstep, voffB); PG8_STAGE(PG8_SA(0, 0), a2, voffA);
            PG8_WAIT_V(8); PG8_WAIT_L(0); PG8_BAR; PG8_MMA(1, 0, At, B0); PG8_MMA(1, 1, At, B1); PG8_BAR; PG8_SCHED;
            PG8_LDB(B0, 1, 0); PG8_LDB(B1, 1, 1); PG8_SCHED; PG8_LDA(At, 1, 0); PG8_STAGE(PG8_SA(0, 1), a2 + hstepA, voffA);
            PG8_WAIT_V(8); PG8_WAIT_L(0); PG8_BAR; PG8_MMA(0, 0, At, B0); PG8_MMA(0, 1, At, B1); PG8_BAR; PG8_SCHED;
            PG8_LDA(At, 1, 1); PG8_STAGE(PG8_SB(1, 0), b3, voffB); PG8_STAGE(PG8_SB(1, 1), b3 + hstep, voffB); PG8_STAGE(PG8_SA(1, 0), a3, voffA);
            PG8_WAIT_V(8); PG8_WAIT_L(0); PG8_BAR; PG8_MMA(1, 0, At, B0); PG8_MMA(1, 1, At, B1); PG8_BAR; PG8_SCHED;
            } else {
            PG8_LDB(B0, 0, 0); PG8_SCHED; PG8_LDA(At, 0, 0); PG8_STAGE(PG8_SA(1, 1), a1 + hstepA, voffA);
            PG8_WAIT_L(8); PG8_BAR; PG8_WAIT_L(0); PG8_MMA(0, 0, At, B0); PG8_BAR; PG8_SCHED;
            PG8_LDB(B1, 0, 1); PG8_STAGE(PG8_SB(0, 0), b2, voffB);
            PG8_BAR; PG8_WAIT_L(0); PG8_MMA(0, 1, At, B1); PG8_BAR;
            PG8_LDA(At, 0, 1); PG8_STAGE(PG8_SA(0, 0), a2, voffA);
            PG8_BAR; PG8_WAIT_L(0); PG8_MMA(1, 0, At, B0); PG8_BAR; PG8_SCHED;
            PG8_STAGE(PG8_SB(0, 1), b2 + hstep, voffB);
            PG8_WAIT_V(6); PG8_BAR; PG8_MMA(1, 1, At, B1); PG8_BAR;
            PG8_LDB(B0, 1, 0); PG8_SCHED; PG8_LDA(At, 1, 0); PG8_STAGE(PG8_SA(0, 1), a2 + hstepA, voffA);
            PG8_WAIT_L(8); PG8_BAR; PG8_WAIT_L(0); PG8_MMA(0, 0, At, B0); PG8_BAR; PG8_SCHED;
            PG8_LDB(B1, 1, 1); PG8_STAGE(PG8_SB(1, 0), b3, voffB);
            PG8_BAR; PG8_WAIT_L(0); PG8_MMA(0, 1, At, B1); PG8_BAR;
            PG8_LDA(At, 1, 1); PG8_STAGE(PG8_SA(1, 0), a3, voffA);
            PG8_BAR; PG8_WAIT_L(0); PG8_MMA(1, 0, At, B0); PG8_BAR; PG8_SCHED;
            PG8_STAGE(PG8_SB(1, 1), b3 + hstep, voffB);
            PG8_WAIT_V(6); PG8_BAR; PG8_MMA(1, 1, At, B1); PG8_BAR;
            }
        }
        if constexpr (ALIGN_EPI) { if (wr == 0) PG8_BAR; }
        if constexpr (!Epi::AFTER_DRAIN) { E(acc, cur, wr, wc, fr, fq); S.done(cur); }
        if (!has_next) break;
#pragma unroll
        for (int a = 0; a < 2; ++a)
#pragma unroll
            for (int b = 0; b < 2; ++b)
#pragma unroll
                for (int m = 0; m < 4; ++m)
#pragma unroll
                    for (int n = 0; n < 2; ++n) acc[a][b][m][n] = (f32x4){0.f, 0.f, 0.f, 0.f};
        cur = nxt; cA = nA; cB = nB; ++ui;
        if constexpr (ALIGN_EPI) { if (wr == 1) PG8_BAR; }
    }
    PG8_WAIT_V(0);
    if constexpr (!ALIGN_EPI) { if (wr == 0) PG8_BAR; }
    PG8_BAR;
    if constexpr (Epi::AFTER_DRAIN) { E.fused(acc, cur, wr, wc, fr, fq, lds, wid, lane); S.done(cur); }
#undef PG8_AK
#undef PG8_SA
#undef PG8_SB
#undef PG8_STAGE
#undef PG8_LDA
#undef PG8_LDB
#undef PG8_MMA
#undef PG8_WAIT_V
#undef PG8_WAIT_L
#undef PG8_BAR
#undef PG8_SCHED
}
}

__device__ __forceinline__ int winmap(int n) { return n < 2560 ? n : (n < 5120 ? n + 16 : (n < 5136 ? 2560 + (n - 5120) : n)); }
template <class Map>
__device__ __forceinline__ void transpose_item(const float* W, int ldw, bf16* WT, int K, int item, int nblk, float* scr, int lane, const Map& mp) {
    const int kb = item / nblk, nbk = item % nblk, k0 = 64 * kb, n0 = 32 * nbk;
    const int col = mp.scol(n0 + (lane & 31));
#pragma unroll 8
    for (int i = 0; i < 32; ++i) { const int kk = 2 * i + (lane >> 5); scr[kk * 33 + (lane & 31)] = col >= 0 ? W[(size_t)mp.srow(k0 + kk) * ldw + col] * mp.scale(k0 + kk) : 0.f; }
    const int c = lane & 7;
#pragma unroll
    for (int j = 0; j < 4; ++j) { const int n = (lane >> 3) + 8 * j; const float* s = scr + (8 * c) * 33 + n;
        *(uint4*)(WT + (size_t)(n0 + n) * K + k0 + 8 * c) = make_uint4(pk2bf(s[0], s[33]), pk2bf(s[66], s[99]), pk2bf(s[132], s[165]), pk2bf(s[198], s[231])); }
}
struct MapPlain { __device__ __forceinline__ int srow(int k) const { return k; } __device__ __forceinline__ int scol(int n) const { return n; } __device__ __forceinline__ float scale(int) const { return 1.f; } };
struct MapWin { __device__ __forceinline__ int srow(int k) const { return k; } __device__ __forceinline__ int scol(int n) const { return n < NPROJ ? winmap(n) : -1; } __device__ __forceinline__ float scale(int) const { return 1.f; } };
struct MapWout { const float* an; const float* sn;
    __device__ __forceinline__ int srow(int k) const { return (k + 1024) & 2047; } __device__ __forceinline__ int scol(int n) const { return n; } __device__ __forceinline__ float scale(int k) const { return k < 1024 ? an[k] : sn[k - 1024]; } };
__device__ __forceinline__ void ph_prep(const Params& p, int wv, unsigned char* lds) {
    PH_IDS(); unsigned char* ws = p.ws;
    bf16* xb = (bf16*)(ws + OFF_XB);
    for (size_t i = gtid; i < (size_t)T * D / 8; i += gn) { const float4 v = ((const float4*)p.x)[2 * i], w = ((const float4*)p.x)[2 * i + 1]; ((uint4*)xb)[i] = make_uint4(pk2bf(v.x, v.y), pk2bf(v.z, v.w), pk2bf(w.x, w.y), pk2bf(w.z, w.w)); }
    {
        float* scr = (float*)(lds + wv * 8448);
        constexpr int I_WIN = 16 * 168, I_WOUT = 32 * 32, I_WQ = 16 * 64, I_W1 = 32 * 8, I_W2 = 4 * 2;
        constexpr int NIT = I_WIN + I_WOUT + I_WQ + 2 * I_W1 + 2 * I_W2;
        for (int it = gwave; it < NIT; it += nwaves) {
            int r = it;
            if (r < I_WIN) { transpose_item(p.w_in, NPROJ, (bf16*)(ws + OFF_WIN), 1024, r, 168, scr, lane, MapWin{}); continue; } r -= I_WIN;
            if (r < I_WOUT) { transpose_item(p.w_out, 1024, (bf16*)(ws + OFF_WOUT), 2048, r, 32, scr, lane, MapWout{p.attn_norm_w, p.ssd_norm_w}); continue; } r -= I_WOUT;
            if (r < I_WQ) { transpose_item(p.peer_wq, 2048, (bf16*)(ws + OFF_WQ), 1024, r, 64, scr, lane, MapPlain{}); continue; } r -= I_WQ;
            if (r < I_W1) { transpose_item(p.cmp_w1_k, 256, (bf16*)(ws + OFF_W1K), 2048, r, 8, scr, lane, MapPlain{}); continue; } r -= I_W1;
            if (r < I_W1) { transpose_item(p.cmp_w1_v, 256, (bf16*)(ws + OFF_W1V), 2048, r, 8, scr, lane, MapPlain{}); continue; } r -= I_W1;
            if (r < I_W2) { transpose_item(p.cmp_w2_k, 64, (bf16*)(ws + OFF_W2K), 256, r, 2, scr, lane, MapPlain{}); continue; } r -= I_W2;
            transpose_item(p.cmp_w2_v, 64, (bf16*)(ws + OFF_W2V), 256, r, 2, scr, lane, MapPlain{});
        }
    }
    bf16* keys = (bf16*)(ws + OFF_KEYS);
    for (int i = gtid; i < 8 * 2 * 128 * 128; i += gn) keys[i] = f2bf(p.peer_keys[i]);
    float* rc = (float*)(ws + OFF_ROPE); float* rs = rc + 4096 * 32;
    for (int i = gtid; i < 4096 * 32; i += gn) {
        const int pos = i >> 5, j = i & 31;
        const float inv = powf(10000.0f, -(float)(2 * j) / 64.0f); const float angf = (float)pos * inv;
        double xr = (double)angf * 0.15915494309189535; xr -= rint(xr); const double rr = xr * 6.283185307179586, r2 = rr * rr;
        double s = -1.0 / 10888869450418352160768000000.0, c = 1.0 / 403291461126605635584000000.0;
        s = s * r2 + 1.0 / 15511210043330985984000000.0;  c = c * r2 - 1.0 / 620448401733239439360000.0;
        s = s * r2 - 1.0 / 25852016738884976640000.0;     c = c * r2 + 1.0 / 1124000727777607680000.0;
        s = s * r2 + 1.0 / 51090942171709440000.0;        c = c * r2 - 1.0 / 2432902008176640000.0;
        s = s * r2 - 1.0 / 121645100408832000.0;          c = c * r2 + 1.0 / 6402373705728000.0;
        s = s * r2 + 1.0 / 355687428096000.0;             c = c * r2 - 1.0 / 20922789888000.0;
        s = s * r2 - 1.0 / 1307674368000.0;               c = c * r2 + 1.0 / 87178291200.0;
        s = s * r2 + 1.0 / 6227020800.0;                  c = c * r2 - 1.0 / 479001600.0;
        s = s * r2 - 1.0 / 39916800.0;                    c = c * r2 + 1.0 / 3628800.0;
        s = s * r2 + 1.0 / 362880.0;                      c = c * r2 - 1.0 / 40320.0;
        s = s * r2 - 1.0 / 5040.0;                        c = c * r2 + 1.0 / 720.0;
        s = s * r2 + 1.0 / 120.0;                         c = c * r2 - 1.0 / 24.0;
        s = s * r2 - 1.0 / 6.0;                           c = c * r2 + 0.5;
        s = s * r2 + 1.0;                                 c = c * r2 - 1.0;
        s = s * rr; c = -c;
        rc[i] = (float)c; rs[i] = (float)s;
    }
    float* b1p = (float*)(ws + OFF_HID);
    for (int o = gwave; o < 64; o += nwaves) {
        const int mat = o >> 5, kc = o & 31; const float* pos = mat ? p.cmp_pos_v : p.cmp_pos_k; const float* w1 = mat ? p.cmp_w1_v : p.cmp_w1_k;
        float4 acc = make_float4(0.f, 0.f, 0.f, 0.f);
#pragma unroll 8
        for (int k = kc * 64; k < kc * 64 + 64; ++k) { const float pk = pos[k]; const float4 w = *(const float4*)(w1 + (size_t)k * 256 + 4 * lane); acc.x += pk * w.x; acc.y += pk * w.y; acc.z += pk * w.z; acc.w += pk * w.w; }
        *(float4*)(b1p + (size_t)o * 256 + 4 * lane) = acc;
    }
}

__device__ __forceinline__ void unpack8(const uint4& w, float* f) { f[0] = __uint_as_float(w.x << 16); f[1] = __uint_as_float(w.x & 0xffff0000u); f[2] = __uint_as_float(w.y << 16); f[3] = __uint_as_float(w.y & 0xffff0000u);
    f[4] = __uint_as_float(w.z << 16); f[5] = __uint_as_float(w.z & 0xffff0000u); f[6] = __uint_as_float(w.w << 16); f[7] = __uint_as_float(w.w & 0xffff0000u); }
__device__ __forceinline__ uint4 pack8(const float* f) { return make_uint4(pk2bf(f[0], f[1]), pk2bf(f[2], f[3]), pk2bf(f[4], f[5]), pk2bf(f[6], f[7])); }
__device__ __forceinline__ void ph_tokprep(const Params& p, int wv) {
    PH_IDS(); unsigned char* ws = p.ws;
    const int gtid_ = (nb > 64 ? bid - 32 : bid) * NTHREADS + tid, gn_ = (nb > 64 ? nb - 32 : nb) * NTHREADS;
    const bf16* xbc = (const bf16*)(ws + OFF_XBC); bf16* xsbc = (bf16*)(ws + OFF_XSBC);
    for (int it = gtid_; it < (T / 16) * 192; it += gn_) {
        const int cg = it % 192, tg = it / 192, ch = cg * 8, t0 = tg * 16, l0 = t0 & (L - 1);
        float w[4][8], bias[8];
#pragma unroll
        for (int j = 0; j < 4; ++j) { const float4 a = *(const float4*)(p.conv_w + j * 1536 + ch), b2 = *(const float4*)(p.conv_w + j * 1536 + ch + 4); w[j][0] = a.x; w[j][1] = a.y; w[j][2] = a.z; w[j][3] = a.w; w[j][4] = b2.x; w[j][5] = b2.y; w[j][6] = b2.z; w[j][7] = b2.w; }
        { const float4 a = *(const float4*)(p.conv_b + ch), b2 = *(const float4*)(p.conv_b + ch + 4); bias[0] = a.x; bias[1] = a.y; bias[2] = a.z; bias[3] = a.w; bias[4] = b2.x; bias[5] = b2.y; bias[6] = b2.z; bias[7] = b2.w; }
        float x0[8], x1[8], x2[8], x3[8];
        { uint4 h0 = make_uint4(0u, 0u, 0u, 0u), h1 = h0, h2 = h0;
          if (l0 != 0) { h0 = *(const uint4*)(xbc + (size_t)(t0 - 3) * 1536 + ch); h1 = *(const uint4*)(xbc + (size_t)(t0 - 2) * 1536 + ch); h2 = *(const uint4*)(xbc + (size_t)(t0 - 1) * 1536 + ch); }
          unpack8(h0, x0); unpack8(h1, x1); unpack8(h2, x2); }
#pragma unroll
        for (int u = 0; u < 16; ++u) {
            unpack8(*(const uint4*)(xbc + (size_t)(t0 + u) * 1536 + ch), x3);
            float y[8];
#pragma unroll
            for (int i = 0; i < 8; ++i) { const float v = bias[i] + w[0][i] * x0[i] + w[1][i] * x1[i] + w[2][i] * x2[i] + w[3][i] * x3[i]; y[i] = v * sigmoidf(v); x0[i] = x1[i]; x1[i] = x2[i]; x2[i] = x3[i]; }
            *(uint4*)(xsbc + (size_t)(t0 + u) * 1536 + ch) = pack8(y);
        }
    }
    const bf16* dtg = (const bf16*)(ws + OFF_DTG); float* dt = (float*)(ws + OFF_DT); float* gate = (float*)(ws + OFF_GATE);
    for (int i = gtid_; i < T * 64; i += gn_) {
        const int t = i >> 6, c = i & 63; const float v = bf2f(dtg[i]);
        if (c < 16) { const float xx = v + p.dt_bias[c]; dt[t * 16 + c] = xx > 20.f ? xx : log1pf(__expf(xx)); }
        else gate[t * 48 + (c - 16)] = sigmoidf(v);
    }
    const float* rc = (const float*)(ws + OFF_ROPE); const float* rs = rc + 4096 * 32;
    bf16* q = (bf16*)(ws + OFF_Q); bf16* kvs = (bf16*)(ws + OFF_KVS);
    for (int it = gtid_; it < T * 24 * 4; it += gn_) {
        const int j0 = (it & 3) * 8, hh = (it >> 2) % 24, t = it / 96, l = t & (L - 1);
        bf16* pp; float sc;
        if (hh < 16) { pp = q + (size_t)t * 1024 + hh * 64 + j0; sc = 0.125f * 1.4426950408889634f; } else if (hh < 20) { pp = kvs + (size_t)t * 1536 + 512 + (hh - 16) * 64 + j0; sc = 1.f; } else { pp = kvs + (size_t)t * 1536 + 1024 + (hh - 20) * 64 + j0; sc = 1.f; }
        float x1[8], x2[8], c[8], s[8], o1[8], o2[8];
        unpack8(*(const uint4*)pp, x1); unpack8(*(const uint4*)(pp + 32), x2);
        { const float4 a = *(const float4*)(rc + l * 32 + j0), b2 = *(const float4*)(rc + l * 32 + j0 + 4), d = *(const float4*)(rs + l * 32 + j0), e = *(const float4*)(rs + l * 32 + j0 + 4);
          c[0] = a.x; c[1] = a.y; c[2] = a.z; c[3] = a.w; c[4] = b2.x; c[5] = b2.y; c[6] = b2.z; c[7] = b2.w; s[0] = d.x; s[1] = d.y; s[2] = d.z; s[3] = d.w; s[4] = e.x; s[5] = e.y; s[6] = e.z; s[7] = e.w; }
#pragma unroll
        for (int i = 0; i < 8; ++i) { o1[i] = (x1[i] * c[i] - x2[i] * s[i]) * sc; o2[i] = (x1[i] * s[i] + x2[i] * c[i]) * sc; }
        *(uint4*)pp = pack8(o1); *(uint4*)(pp + 32) = pack8(o2);
    }
}

__device__ __forceinline__ void ph_ssd_prep2(const Params& p, int wv, unsigned char* lds) {
    PH_IDS(); unsigned char* ws = p.ws;
    const bf16* xsbc = (const bf16*)(ws + OFF_XSBC); const float* dt = (const float*)(ws + OFF_DT);
    bf16* XdT = (bf16*)p.out; bf16* BT = (bf16*)(ws + OFF_BT); float* acsT = (float*)(ws + OFF_ACS);
    float* sdt = (float*)lds; float* swave = sdt + 128;
    const int bide = bid, nbe = nb;
    for (int unit = bide; unit < 2048 + 256; unit += nbe) {
        __syncthreads();
        if (unit < 2048) {
            const int h = unit & 15, bc = unit >> 4; const size_t t0 = (size_t)bc * 128;
            const float A = -__expf(p.a_log[h]);
            if (tid < 128) { const float dv = dt[(t0 + tid) * 16 + h]; sdt[tid] = dv; float a = dv * A;
#pragma unroll
                for (int o = 1; o < 64; o <<= 1) { const float v = __shfl_up(a, o); if (lane >= o) a += v; }
                if (lane == 63) swave[tid >> 6] = a;
                sdt[128 + 8 + tid] = a; }
            __syncthreads();
            if (tid < 128) { float a = sdt[128 + 8 + tid]; if (tid >= 64) a += swave[0]; acsT[(size_t)unit * 128 + tid] = a; }
            const int pp = tid & 63, lg = tid >> 6; const bf16* src = xsbc + (t0 + lg * 16) * 1536 + h * 64 + pp;
            unsigned w[8];
#pragma unroll
            for (int i = 0; i < 8; ++i) { const float v0 = bf2f(src[(size_t)(2 * i) * 1536]) * sdt[lg * 16 + 2 * i], v1 = bf2f(src[(size_t)(2 * i + 1) * 1536]) * sdt[lg * 16 + 2 * i + 1]; w[i] = (unsigned)f2bf(v0) | ((unsigned)f2bf(v1) << 16); }
            uint4* dst = (uint4*)(XdT + (size_t)unit * 8192 + pp * 128 + lg * 16);
            dst[0] = make_uint4(w[0], w[1], w[2], w[3]); dst[1] = make_uint4(w[4], w[5], w[6], w[7]);
        } else {
            const int u2 = unit - 2048, g = u2 & 1, bc = u2 >> 1; const size_t t0 = (size_t)bc * 128;
            const int n = tid & 127, lg = tid >> 7; const bf16* src = xsbc + (t0 + lg * 32) * 1536 + 1024 + g * 128 + n;
            uint4* dst = (uint4*)(BT + (size_t)u2 * 16384 + n * 128 + lg * 32);
#pragma unroll
            for (int k = 0; k < 4; ++k) { unsigned w[4];
#pragma unroll
                for (int i = 0; i < 4; ++i) w[i] = (unsigned)src[(size_t)(8 * k + 2 * i) * 1536] | ((unsigned)src[(size_t)(8 * k + 2 * i + 1) * 1536] << 16);
                dst[k] = make_uint4(w[0], w[1], w[2], w[3]); }
        }
    }
}
__device__ __forceinline__ void ph_ssd_states(const Params& p, int wv) {
    PH_IDS(); unsigned char* ws = p.ws; const int rr = lane & 31, hi = lane >> 5;
    const bf16* XdT = (const bf16*)p.out; bf16* S = (bf16*)((unsigned char*)p.out + 32 * MiB); const bf16* BT = (const bf16*)(ws + OFF_BT); const float* acsT = (const float*)(ws + OFF_ACS);
    for (int unit = gwave; unit < 2048; unit += nwaves) {
        const int h = unit & 15, bc = unit >> 4, g = h >> 3;
        const float* ac = acsT + (size_t)unit * 128; const float alast = ac[127];
        const bf16* xrow = XdT + (size_t)unit * 8192 + rr * 128 + 8 * hi; const bf16* bt = BT + (size_t)(bc * 2 + g) * 16384 + rr * 128 + 8 * hi;
        f32x16 acc[4][2];
#pragma unroll
        for (int nt = 0; nt < 4; ++nt)
#pragma unroll
            for (int pt = 0; pt < 2; ++pt)
#pragma unroll
                for (int e = 0; e < 16; ++e) acc[nt][pt][e] = 0.f;
#pragma unroll 2
        for (int ks = 0; ks < 8; ++ks) {
            const int l0 = ks * 16 + 8 * hi; float dec[8];
            { const f32x4 a0 = *(const f32x4*)(ac + l0), a1 = *(const f32x4*)(ac + l0 + 4);
#pragma unroll
              for (int jx = 0; jx < 8; ++jx) dec[jx] = __expf(alast - (jx < 4 ? a0[jx] : a1[jx - 4])); }
            bf16x8 xf[2];
#pragma unroll
            for (int pt = 0; pt < 2; ++pt) { float f[8]; unpack8(*(const uint4*)(xrow + (size_t)pt * 4096 + ks * 16), f);
#pragma unroll
                for (int jx = 0; jx < 8; ++jx) f[jx] *= dec[jx];
                union { uint4 u; bf16x8 v; } cvu; cvu.u = pack8(f); xf[pt] = cvu.v; }
#pragma unroll
            for (int nt = 0; nt < 4; ++nt) { const bf16x8 bf_ = *(const bf16x8*)(bt + (size_t)nt * 4096 + ks * 16);
#pragma unroll
                for (int pt = 0; pt < 2; ++pt) acc[nt][pt] = __builtin_amdgcn_mfma_f32_32x32x16_bf16(bf_, xf[pt], acc[nt][pt], 0, 0, 0); }
        }
#pragma unroll
        for (int pt = 0; pt < 2; ++pt) { bf16* so = S + (size_t)unit * 8192 + (pt * 32 + rr) * 128 + 4 * hi;
#pragma unroll
            for (int nt = 0; nt < 4; ++nt)
#pragma unroll
                for (int a = 0; a < 4; ++a) *(uint2*)(so + nt * 32 + 8 * a) = make_uint2(pk2bf(acc[nt][pt][4 * a], acc[nt][pt][4 * a + 1]), pk2bf(acc[nt][pt][4 * a + 2], acc[nt][pt][4 * a + 3])); }
    }
}
__device__ __forceinline__ void ph_ssd_scan(const Params& p, int wv) {
    PH_IDS();
    unsigned* S = (unsigned*)((unsigned char*)p.out + 32 * MiB); const float* acsT = (const float*)(p.ws + OFF_ACS);
    for (int e = gtid; e < NBATCH * 16 * 4096; e += gn) {
        const int pn = e & 4095, h = (e >> 12) & 15, b = e >> 16; float r0 = 0.f, r1 = 0.f;
        for (int c = 0; c < 32; c += 4) {
            unsigned v[4]; float d[4];
#pragma unroll
            for (int u = 0; u < 4; ++u) { const int unit = (b * 32 + c + u) * 16 + h; v[u] = S[(size_t)unit * 4096 + pn]; d[u] = __expf(acsT[(size_t)unit * 128 + 127]); }
#pragma unroll
            for (int u = 0; u < 4; ++u) { const int unit = (b * 32 + c + u) * 16 + h; S[(size_t)unit * 4096 + pn] = (unsigned)f2bf(r0) | ((unsigned)f2bf(r1) << 16);
                r0 = r0 * d[u] + bf2f((bf16)(v[u] & 0xffffu)); r1 = r1 * d[u] + bf2f((bf16)(v[u] >> 16)); }
        }
    }
}
constexpr int SO_CBROW = 136;
__device__ __forceinline__ void ph_ssd_out(const Params& p, int wv, unsigned char* lds) {
    PH_IDS(); unsigned char* ws = p.ws; const int rr = lane & 31, hi = lane >> 5;
    const bf16* XdT = (const bf16*)p.out; const bf16* S = (const bf16*)((unsigned char*)p.out + 32 * MiB); const bf16* xsbc = (const bf16*)(ws + OFF_XSBC);
    const float* acsT = (const float*)(ws + OFF_ACS); bf16* z = (bf16*)(ws + OFF_Z); float* ssq2p = (float*)(ws + OFF_HID);
    bf16* CBl = (bf16*)lds;
    for (int unit = bid; unit < 256; unit += nb) {
        const int g = unit & 1, bc = unit >> 1; const size_t t0 = (size_t)bc * 128;
        __syncthreads();
        for (int ti = wv; ti < 10; ti += NWAVES) {
            int lt = 0, st = ti; if (st > 0) { st -= 1; lt = 1; if (st > 1) { st -= 2; lt = 2; if (st > 2) { st -= 3; lt = 3; } } }
            f32x16 acc;
#pragma unroll
            for (int e = 0; e < 16; ++e) acc[e] = 0.f;
            const bf16* arow = xsbc + (t0 + st * 32 + rr) * 1536 + 1024 + g * 128 + 8 * hi; const bf16* brow = xsbc + (t0 + lt * 32 + rr) * 1536 + 1280 + g * 128 + 8 * hi;
#pragma unroll
            for (int ks = 0; ks < 8; ++ks) acc = __builtin_amdgcn_mfma_f32_32x32x16_bf16(*(const bf16x8*)(arow + ks * 16), *(const bf16x8*)(brow + ks * 16), acc, 0, 0, 0);
            bf16* dst = CBl + (lt * 32 + rr) * SO_CBROW + st * 32 + 4 * hi;
#pragma unroll
            for (int a = 0; a < 4; ++a) *(uint2*)(dst + 8 * a) = make_uint2(pk2bf(acc[4 * a], acc[4 * a + 1]), pk2bf(acc[4 * a + 2], acc[4 * a + 3]));
        }
        __syncthreads();
        const int h = g * 8 + wv, uh = bc * 16 + h; const float* ac = acsT + (size_t)uh * 128; const float Dh = p.d_skip[h];
        const bf16* xd = XdT + (size_t)uh * 8192 + rr * 128 + 8 * hi; const bf16* sin = S + (size_t)uh * 8192 + rr * 128 + 8 * hi;
        f32x16 acc[2][4];
#pragma unroll
        for (int pt = 0; pt < 2; ++pt)
#pragma unroll
            for (int lt = 0; lt < 4; ++lt)
#pragma unroll
                for (int e = 0; e < 16; ++e) acc[pt][lt][e] = 0.f;
#pragma unroll
        for (int lt = 0; lt < 4; ++lt) {
            const int l = lt * 32 + rr; const float acl = ac[l]; const float eal = __expf(acl);
#pragma unroll
            for (int ks = 0; ks < 2 * lt + 2; ++ks) {
                const int s0 = ks * 16 + 8 * hi; float cb[8]; unpack8(*(const uint4*)(CBl + l * SO_CBROW + s0), cb);
                const f32x4 a0 = *(const f32x4*)(ac + s0), a1 = *(const f32x4*)(ac + s0 + 4);
#pragma unroll
                for (int jx = 0; jx < 8; ++jx) { const float as = jx < 4 ? a0[jx] : a1[jx - 4]; cb[jx] = (s0 + jx <= l) ? cb[jx] * __expf(acl - as) : 0.f; }
                union { uint4 u; bf16x8 v; } mf; mf.u = pack8(cb);
#pragma unroll
                for (int pt = 0; pt < 2; ++pt) acc[pt][lt] = __builtin_amdgcn_mfma_f32_32x32x16_bf16(*(const bf16x8*)(xd + (size_t)pt * 4096 + ks * 16), mf.v, acc[pt][lt], 0, 0, 0);
            }
            const bf16* crow_ = xsbc + (t0 + l) * 1536 + 1280 + g * 128 + 8 * hi;
#pragma unroll
            for (int ks = 0; ks < 8; ++ks) {
                float cf[8]; unpack8(*(const uint4*)(crow_ + ks * 16), cf);
#pragma unroll
                for (int jx = 0; jx < 8; ++jx) cf[jx] *= eal;
                union { uint4 u; bf16x8 v; } bf_; bf_.u = pack8(cf);
#pragma unroll
                for (int pt = 0; pt < 2; ++pt) acc[pt][lt] = __builtin_amdgcn_mfma_f32_32x32x16_bf16(*(const bf16x8*)(sin + (size_t)pt * 4096 + ks * 16), bf_.v, acc[pt][lt], 0, 0, 0);
            }
            const size_t t = t0 + l; float ss = 0.f;
#pragma unroll
            for (int pt = 0; pt < 2; ++pt)
#pragma unroll
                for (int a = 0; a < 4; ++a) {
                    const int col = h * 64 + pt * 32 + 8 * a + 4 * hi;
                    const uint2 xw = *(const uint2*)(xsbc + t * 1536 + col), zw = *(const uint2*)(z + t * 1024 + col);
                    const float xs0 = bflo(xw.x), xs1 = bfhi(xw.x), xs2 = bflo(xw.y), xs3 = bfhi(xw.y), z0 = bflo(zw.x), z1 = bfhi(zw.x), z2 = bflo(zw.y), z3 = bfhi(zw.y);
                    const float v0 = (acc[pt][lt][4 * a] + Dh * xs0) * (z0 * sigmoidf(z0)), v1 = (acc[pt][lt][4 * a + 1] + Dh * xs1) * (z1 * sigmoidf(z1));
                    const float v2 = (acc[pt][lt][4 * a + 2] + Dh * xs2) * (z2 * sigmoidf(z2)), v3 = (acc[pt][lt][4 * a + 3] + Dh * xs3) * (z3 * sigmoidf(z3));
                    ss += (v0 * v0 + v1 * v1) + (v2 * v2 + v3 * v3);
                    *(uint2*)(z + t * 1024 + col) = make_uint2(pk2bf(v0, v1), pk2bf(v2, v3));
                }
            ss += __shfl_xor(ss, 32);
            if (hi == 0) ssq2p[t * 16 + h] = ss;
        }
    }
}

struct EpiKc {
    bf16* dst; bool tr; __device__ __forceinline__ void operator()(int m, int c, float v) const { const int hk = m & 3, n = (m >> 2) & 255, b = m >> 10; const bf16 o = (n == 255) ? (bf16)0 : f2bf(v);
        if (tr) dst[((size_t)(b * 4 + hk) * 64 + c) * 256 + n] = o; else dst[((size_t)(b * 4 + hk) * 256 + n) * 64 + c] = o; } };
__device__ __forceinline__ void ph_kc_rope(const Params& p, int wv) {
    PH_IDS(); unsigned char* ws = p.ws; bf16* kc = (bf16*)(ws + OFF_KC); const float* rc = (const float*)(ws + OFF_ROPE); const float* rs = rc + 4096 * 32;
    for (int i = gtid; i < 16 * 256 * 32; i += gn) {
        const int j = i & 31, n = (i >> 5) & 255, bh = i >> 13; const int pos = 16 * n + 31; if (n == 255) continue;
        const float c = rc[pos * 32 + j], s = rs[pos * 32 + j];
        bf16* pp = kc + ((size_t)bh * 256 + n) * 64 + j; const float x1 = bf2f(pp[0]), x2 = bf2f(pp[32]);
        pp[0] = f2bf(x1 * c - x2 * s); pp[32] = f2bf(x1 * s + x2 * c);
    }
}


__device__ __forceinline__ void ph_vt_prep(const Params& p, int wv) {
    PH_IDS(); unsigned char* ws = p.ws; const bf16* kvs = (const bf16*)(ws + OFF_KVS);
    const int bide = bid, nbe = nb;
    for (int unit = bide; unit < 2 * 16 * 64; unit += nbe) {
        const int br = unit & 1, tl = (unit >> 1) & 63, bh = unit >> 7, b = bh >> 2, hk = bh & 3;
        const int d = tid & 63, grp = tid >> 6; const int l0 = tl * 64 + grp * 8;
        const bf16* src = kvs + ((size_t)b * L + l0) * 1536 + (br ? 1280 : 768) + hk * 64 + d;
        unsigned w[4];
#pragma unroll
        for (int i = 0; i < 4; ++i) w[i] = (unsigned)src[(size_t)(2 * i) * 1536] | ((unsigned)src[(size_t)(2 * i + 1) * 1536] << 16);
        bf16* dst = (bf16*)(ws + (br ? OFF_VWT : OFF_VST)) + ((size_t)bh * 64 + d) * L + l0;
        *(uint4*)dst = make_uint4(w[0], w[1], w[2], w[3]);
    }
}

__device__ __forceinline__ float max3f(float a, float b, float c) { float r; asm("v_max3_f32 %0, %1, %2, %3" : "=v"(r) : "v"(a), "v"(b), "v"(c)); return r; }
__device__ __forceinline__ int crow(int r, int hi) { return (r & 3) + 8 * (r >> 2) + 4 * hi; }
constexpr int NSA_KROW = 144, NSA_VROW = 144, NSA_KBUF = 64 * NSA_KROW, NSA_VBUF = 64 * NSA_VROW;
constexpr int NSA_OFF_K = 0, NSA_OFF_V = 4 * NSA_KBUF;
constexpr int NSA_OFF_STASH = 73728;
constexpr int NSA_OFF_IMPA = NSA_OFF_STASH, NSA_IMPS = 65, NSA_OFF_IMPB = NSA_OFF_IMPA + 64 * NSA_IMPS * 4;
constexpr int NSA_OFF_SEL = NSA_OFF_STASH + 65536;
static_assert(NSA_OFF_V + 4 * NSA_VBUF <= NSA_OFF_STASH && NSA_OFF_IMPB + 64 * NSA_IMPS * 4 <= NSA_OFF_SEL && NSA_OFF_SEL + 1024 <= LDS_BYTES - 64, "NSA LDS map");
struct NsaSrc { const bf16* K; size_t kstride; const bf16* VT; size_t ldv; };
__device__ __forceinline__ void nsa_gload(const NsaSrc& s, int k0, int tid, uint4& kr, uint4& vr) {
    const int row = tid >> 3, ch = tid & 7;
    kr = *(const uint4*)(s.K + (size_t)(k0 + row) * s.kstride + ch * 8);
    vr = *(const uint4*)(s.VT + (size_t)row * s.ldv + k0 + ch * 8);
}
__device__ __forceinline__ void nsa_lstore(unsigned char* kb, unsigned char* vb, int tid, const uint4& kr, const uint4& vr) {
    const int row = tid >> 3, ch = tid & 7;
    *(uint4*)(kb + row * NSA_KROW + ch * 16) = kr;
    uint2* vp = (uint2*)(vb + row * NSA_VROW + (ch >> 1) * 32 + (ch & 1) * 8); vp[0] = make_uint2(vr.x, vr.y); vp[2] = make_uint2(vr.z, vr.w);
}
__device__ __forceinline__ void nsa_qk(const unsigned char* kb, const bf16x8 (&qf)[4], int rr, int hi, f32x16& p0, f32x16& p1) {
#pragma unroll
    for (int i = 0; i < 16; ++i) { p0[i] = 0.f; p1[i] = 0.f; }
    __builtin_amdgcn_s_setprio(1);
#pragma unroll
    for (int ds = 0; ds < 4; ++ds) {
        const bf16x8 a0 = *(const bf16x8*)(kb + rr * NSA_KROW + ds * 32 + hi * 16), a1 = *(const bf16x8*)(kb + (rr + 32) * NSA_KROW + ds * 32 + hi * 16);
        p0 = __builtin_amdgcn_mfma_f32_32x32x16_bf16(a0, qf[ds], p0, 0, 0, 0); p1 = __builtin_amdgcn_mfma_f32_32x32x16_bf16(a1, qf[ds], p1, 0, 0, 0);
    }
    __builtin_amdgcn_s_setprio(0);
}
__device__ __forceinline__ void nsa_pv(const unsigned char* vb, int rr, int hi, const f32x16& p0, const f32x16& p1, f32x16 (&O)[2]) {
    __builtin_amdgcn_s_setprio(1);
#pragma unroll
    for (int s = 0; s < 4; ++s) {
        const int eb = 8 * (s & 1), kbase = 32 * (s >> 1) + 16 * (s & 1);
        union { uint4 u; bf16x8 v; } pf;
        if (s < 2) pf.u = make_uint4(pk2bf(p0[eb], p0[eb + 1]), pk2bf(p0[eb + 2], p0[eb + 3]), pk2bf(p0[eb + 4], p0[eb + 5]), pk2bf(p0[eb + 6], p0[eb + 7]));
        else       pf.u = make_uint4(pk2bf(p1[eb], p1[eb + 1]), pk2bf(p1[eb + 2], p1[eb + 3]), pk2bf(p1[eb + 4], p1[eb + 5]), pk2bf(p1[eb + 6], p1[eb + 7]));
#pragma unroll
        for (int dsub = 0; dsub < 2; ++dsub) {
            const bf16x8 vfv = *(const bf16x8*)(vb + (dsub * 32 + rr) * NSA_VROW + s * 32 + hi * 16);
            O[dsub] = __builtin_amdgcn_mfma_f32_32x32x16_bf16(vfv, pf.v, O[dsub], 0, 0, 0);
        }
    }
    __builtin_amdgcn_s_setprio(0);
}
template <int MODE>
__device__ __forceinline__ void nsa_tile(unsigned char* lds, const unsigned char* kb, const unsigned char* vb, int jt, int rr, int hi, const bf16x8 (&qf)[4], int lpos, int qi, int tokblk,
                                         u64 selm, float& m, float& lsum, float inv_l, f32x16 (&O)[2]) {
    float* impA = (float*)(lds + NSA_OFF_IMPA); float* impB = (float*)(lds + NSA_OFF_IMPB);
    f32x16 p0, p1; nsa_qk(kb, qf, rr, hi, p0, p1);
    asm volatile("s_nop 15\n\ts_nop 7" : "+v"(p0), "+v"(p1));
    const int k0 = jt * 64;
    const bool tile_on = (MODE != 2) || ((selm >> jt) & 1ull);
    bool full;
    if (MODE <= 1) full = (16 * (k0 + 63) + 31 <= qi * 64); else if (MODE == 2) full = (jt < qi); else full = (jt > qi - 8) && (jt < qi);
    float mx = NEG_INF, mx2 = NEG_INF;
    if (full) {
#pragma unroll
        for (int e = 0; e < 16; e += 2) { mx = max3f(mx, p0[e], p1[e]); mx2 = max3f(mx2, p0[e + 1], p1[e + 1]); }
        if (MODE == 2 && !tile_on) { mx = NEG_INF; mx2 = NEG_INF; }
    } else {
        const int lim = (MODE <= 1) ? (lpos - 31 - 16 * k0 - 64 * hi) : (lpos - k0 - 4 * hi);
#pragma unroll
        for (int e = 0; e < 16; ++e) {
            const int ca = (e & 3) + 8 * (e >> 2), cb = ca + 32; bool oa, ob;
            if (MODE <= 1) { oa = (16 * ca <= lim); ob = (16 * cb <= lim); }
            else if (MODE == 2) { oa = (ca <= lim); ob = (cb <= lim); }
            else { oa = (ca <= lim) && (ca > lim - 512); ob = (cb <= lim) && (cb > lim - 512); }
            p0[e] = oa ? p0[e] : NEG_INF; p1[e] = ob ? p1[e] : NEG_INF; if (e & 1) mx2 = max3f(mx2, p0[e], p1[e]); else mx = max3f(mx, p0[e], p1[e]);
        }
    }
    if (MODE != 1) {
        mx = max3f(mx, mx2, NEG_INF); mx = max3f(mx, __shfl_xor(mx, 32), NEG_INF);
        const float mnew = fmaxf(m, mx);
        if (__any((mnew - m) > 6.0f)) {
            const float alpha = __builtin_amdgcn_exp2f(m - mnew); m = mnew; lsum *= alpha;
            if (MODE != 0) {
#pragma unroll
                for (int e = 0; e < 16; ++e) { O[0][e] *= alpha; O[1][e] *= alpha; }
            }
        }
        const float meff = (MODE == 2 && full && !tile_on) ? BIG : ((m > 0.5f * NEG_INF) ? m : BIG);
        float rs = 0.f;
#pragma unroll
        for (int e = 0; e < 16; ++e) { p0[e] = __builtin_amdgcn_exp2f(p0[e] - meff); p1[e] = __builtin_amdgcn_exp2f(p1[e] - meff); rs += p0[e] + p1[e]; }
        lsum += rs;
        if (MODE != 0) nsa_pv(vb, rr, hi, p0, p1, O);
    } else {
#pragma unroll
        for (int e = 0; e < 16; ++e) { p0[e] = __builtin_amdgcn_exp2f(p0[e] - m) * inv_l; p1[e] = __builtin_amdgcn_exp2f(p1[e] - m) * inv_l; }
        nsa_pv(vb, rr, hi, p0, p1, O);
#pragma unroll
        for (int sub = 0; sub < 2; ++sub)
#pragma unroll
            for (int a = 0; a < 4; ++a) {
                float G, last;
                if (sub == 0) { G = (p0[4 * a] + p0[4 * a + 1]) + (p0[4 * a + 2] + p0[4 * a + 3]); last = p0[4 * a + 3]; } else { G = (p1[4 * a] + p1[4 * a + 1]) + (p1[4 * a + 2] + p1[4 * a + 3]); last = p1[4 * a + 3]; }
                G += __shfl_xor(G, 1); G += __shfl_xor(G, 2); last += __shfl_xor(last, 1); last += __shfl_xor(last, 2);
                const int jj = (k0 >> 2) + 8 * sub + 2 * a + hi;
                if ((rr & 3) == 0) { impA[tokblk * NSA_IMPS + jj] = G; if (jj + 1 < 64) impB[tokblk * NSA_IMPS + jj + 1] = last; }
            }
    }
}
template <int MODE>
__device__ __forceinline__ void nsa_branch(unsigned char* lds, const NsaSrc& src, int jt0, int jt1, int tid, int rr, int hi, const bf16x8 (&qf)[4], int lpos, int qi, int tokblk,
                                           u64 selm, u64 wsel, float& m, float& lsum, float inv_l, f32x16 (&O)[2]) {
    if (jt0 >= jt1) return;
    asm volatile("" : "+v"(tid), "+v"(rr));
    uint4 krA, vrA, krB, vrB;
    nsa_gload(src, jt0 * 64, tid, krA, vrA);
    if (jt0 + 1 < jt1) nsa_gload(src, (jt0 + 1) * 64, tid, krB, vrB);
    nsa_lstore(lds + NSA_OFF_K, lds + NSA_OFF_V, tid, krA, vrA);
    if (jt0 + 1 < jt1) nsa_lstore(lds + NSA_OFF_K + NSA_KBUF, lds + NSA_OFF_V + NSA_VBUF, tid, krB, vrB);
    __syncthreads();
    int par = 0;
    for (int jt = jt0; jt < jt1; jt += 2, par ^= 1) {
        const bool hasB = (jt + 1 < jt1), more = (jt + 2 < jt1), moreB = (jt + 3 < jt1);
        if (more) nsa_gload(src, (jt + 2) * 64, tid, krA, vrA);
        if (moreB) nsa_gload(src, (jt + 3) * 64, tid, krB, vrB);
        const unsigned char* kb = lds + NSA_OFF_K + (par * 2) * NSA_KBUF; const unsigned char* vb = lds + NSA_OFF_V + (par * 2) * NSA_VBUF;
        if ((MODE != 2) || ((wsel >> jt) & 1ull)) nsa_tile<MODE>(lds, kb, vb, jt, rr, hi, qf, lpos, qi, tokblk, selm, m, lsum, inv_l, O);
        if (hasB && ((MODE != 2) || ((wsel >> (jt + 1)) & 1ull))) nsa_tile<MODE>(lds, kb + NSA_KBUF, vb + NSA_VBUF, jt + 1, rr, hi, qf, lpos, qi, tokblk, selm, m, lsum, inv_l, O);
        if (more) nsa_lstore(lds + NSA_OFF_K + ((par ^ 1) * 2) * NSA_KBUF, lds + NSA_OFF_V + ((par ^ 1) * 2) * NSA_VBUF, tid, krA, vrA);
        if (moreB) nsa_lstore(lds + NSA_OFF_K + ((par ^ 1) * 2 + 1) * NSA_KBUF, lds + NSA_OFF_V + ((par ^ 1) * 2 + 1) * NSA_VBUF, tid, krB, vrB);
        __syncthreads();
    }
}
__device__ __forceinline__ void ph_nsa(const Params& p, int wv, unsigned char* lds) {
    PH_IDS(); unsigned char* ws = p.ws; const int wave = wv, rr = lane & 31, hi = lane >> 5;
    bf16* q = (bf16*)(ws + OFF_Q); const bf16* kvs = (const bf16*)(ws + OFF_KVS);
    const float* gate = (const float*)(ws + OFF_GATE); float* ssq = (float*)(ws + OFF_SSQ);
    float* impA = (float*)(lds + NSA_OFF_IMPA); float* impB = (float*)(lds + NSA_OFF_IMPB); u64* selw = (u64*)(lds + NSA_OFF_SEL);
    unsigned* qctr = (unsigned*)(ws + OFF_BAR + 14336) + 64 * (bid & 7); volatile int* ucur = (volatile int*)(lds + NSA_OFF_SEL + 512);
    for (;;) {
        if (tid == 0) *ucur = (int)__hip_atomic_fetch_add(qctr, 1u, __ATOMIC_RELAXED, __HIP_MEMORY_SCOPE_AGENT);
        __syncthreads();
        const int u = *ucur;
        if (u >= 128) break;
        const int bh = (bid & 7) + 8 * (u & 1), qi = 63 - (u >> 1);
        const int b = bh >> 2, hk = bh & 3; const int tokblk = wave * 8 + (rr >> 2), g = rr & 3; const int lpos = qi * 64 + tokblk; const size_t t = (size_t)b * L + lpos;
        bf16* qrow = q + t * 1024 + (hk * 4 + g) * 64;
        bf16x8 qf[4];
#pragma unroll
        for (int ds = 0; ds < 4; ++ds) qf[ds] = *(const bf16x8*)(qrow + ds * 16 + hi * 8);
        for (int i = tid; i < 64 * NSA_IMPS; i += NTHREADS) { impA[i] = 0.f; impB[i] = 0.f; }
        __syncthreads();
        f32x16 O[2]; float* stash = (float*)(lds + NSA_OFF_STASH) + tid;
        const float g0 = gate[t * 48 + (hk * 4 + g) * 3 + 0], g1 = gate[t * 48 + (hk * 4 + g) * 3 + 1], g2 = gate[t * 48 + (hk * 4 + g) * 3 + 2];
        {
            NsaSrc s{(const bf16*)(ws + OFF_KC) + (size_t)bh * 256 * 64, 64, (const bf16*)(ws + OFF_VCT) + (size_t)bh * 64 * 256, 256};
            const int nct = (4 * qi + 3 + 63) >> 6;
            float m = NEG_INF, lsum = 0.f;
            nsa_branch<0>(lds, s, 0, nct, tid, rr, hi, qf, lpos, qi, tokblk, 0ull, 0ull, m, lsum, 0.f, O);
            lsum += __shfl_xor(lsum, 32);
            const float inv_l = lsum > 0.f ? 1.0f / lsum : 0.f;
#pragma unroll
            for (int e = 0; e < 16; ++e) { O[0][e] = 0.f; O[1][e] = 0.f; }
            nsa_branch<1>(lds, s, 0, nct, tid, rr, hi, qf, lpos, qi, tokblk, 0ull, 0ull, m, lsum, inv_l, O);
        }
        f32x16 Oc[2];
#pragma unroll
        for (int e = 0; e < 16; ++e) { Oc[0][e] = g0 * O[0][e]; Oc[1][e] = g0 * O[1][e]; }
        {
            const int tk = tid >> 3, jg = tid & 7; float v[8];
#pragma unroll
            for (int i = 0; i < 8; ++i) { const int j = jg * 8 + i; const float raw = impA[tk * NSA_IMPS + j] + impB[tk * NSA_IMPS + j];
                const bool causal = (j <= qi), forced = (j == 0) || (j == qi) || (j == qi - 1); v[i] = causal ? (forced ? BIG : raw) : NEG_INF; }
            __syncthreads();
#pragma unroll
            for (int i = 0; i < 8; ++i) impA[tk * NSA_IMPS + jg * 8 + i] = v[i];
            __syncthreads();
            int rank[8];
#pragma unroll
            for (int i = 0; i < 8; ++i) rank[i] = 0;
            for (int jj = 0; jj < 64; ++jj) { const float x = impA[tk * NSA_IMPS + jj];
#pragma unroll
                for (int i = 0; i < 8; ++i) rank[i] += (x > v[i] || (x == v[i] && jj < jg * 8 + i)) ? 1 : 0; }
            unsigned b8 = 0u;
#pragma unroll
            for (int i = 0; i < 8; ++i) b8 |= (rank[i] < 16 && jg * 8 + i <= qi) ? (1u << i) : 0u;
            const u64 full = (u64)b8 << (jg * 8); unsigned blo = (unsigned)full, bhi = (unsigned)(full >> 32);
            blo |= __shfl_xor(blo, 1); bhi |= __shfl_xor(bhi, 1); blo |= __shfl_xor(blo, 2); bhi |= __shfl_xor(bhi, 2); blo |= __shfl_xor(blo, 4); bhi |= __shfl_xor(bhi, 4);
            if (jg == 0) selw[tk] = (u64)blo | ((u64)bhi << 32);
            __syncthreads();
        }
        const u64 selm = selw[tokblk];
        __syncthreads();
#pragma unroll
        for (int e = 0; e < 16; ++e) { stash[e * 512] = Oc[0][e]; stash[(16 + e) * 512] = Oc[1][e]; }
        u64 wsel = selm;
        { unsigned lo = (unsigned)wsel, h2 = (unsigned)(wsel >> 32);
          lo |= __shfl_xor(lo, 4); h2 |= __shfl_xor(h2, 4); lo |= __shfl_xor(lo, 8); h2 |= __shfl_xor(h2, 8); lo |= __shfl_xor(lo, 16); h2 |= __shfl_xor(h2, 16);
          wsel = (u64)lo | ((u64)h2 << 32); }
        {
            NsaSrc s{kvs + (size_t)b * L * 1536 + 512 + hk * 64, 1536, (const bf16*)(ws + OFF_VST) + (size_t)bh * 64 * L, (size_t)L};
            float m = NEG_INF, lsum = 0.f;
#pragma unroll
            for (int e = 0; e < 16; ++e) { O[0][e] = 0.f; O[1][e] = 0.f; }
            nsa_branch<2>(lds, s, 0, qi + 1, tid, rr, hi, qf, lpos, qi, tokblk, selm, wsel, m, lsum, 0.f, O);
            lsum += __shfl_xor(lsum, 32); const float sc = g1 / lsum;
#pragma unroll
            for (int e = 0; e < 16; ++e) { stash[e * 512] += sc * O[0][e]; stash[(16 + e) * 512] += sc * O[1][e]; }
        }
        {
            NsaSrc s{kvs + (size_t)b * L * 1536 + 1024 + hk * 64, 1536, (const bf16*)(ws + OFF_VWT) + (size_t)bh * 64 * L, (size_t)L};
            float m = NEG_INF, lsum = 0.f;
#pragma unroll
            for (int e = 0; e < 16; ++e) { O[0][e] = 0.f; O[1][e] = 0.f; }
            nsa_branch<3>(lds, s, qi >= 8 ? qi - 8 : 0, qi + 1, tid, rr, hi, qf, lpos, qi, tokblk, 0ull, 0ull, m, lsum, 0.f, O);
            lsum += __shfl_xor(lsum, 32); const float sc = g2 / lsum;
#pragma unroll
            for (int e = 0; e < 16; ++e) { O[0][e] = stash[e * 512] + sc * O[0][e]; O[1][e] = stash[(16 + e) * 512] + sc * O[1][e]; }
        }
        float ss = 0.f;
#pragma unroll
        for (int dsub = 0; dsub < 2; ++dsub)
#pragma unroll
            for (int a = 0; a < 4; ++a) {
                const float v0 = O[dsub][4 * a], v1 = O[dsub][4 * a + 1], v2 = O[dsub][4 * a + 2], v3 = O[dsub][4 * a + 3];
                ss += (v0 * v0 + v1 * v1) + (v2 * v2 + v3 * v3);
                *(uint2*)(qrow + dsub * 32 + 8 * a + 4 * hi) = make_uint2(pk2bf(v0, v1), pk2bf(v2, v3));
            }
        ss += __shfl_xor(ss, 32); ss += __shfl_xor(ss, 1); ss += __shfl_xor(ss, 2);
        if (hi == 0 && g == 0) ssq[t * 4 + hk] = ss;
        __syncthreads();
    }
}

constexpr size_t OFF_SU = 640 * 1024, OFF_SV = 704 * 1024, OFF_SX = 768 * 1024, OFF_SC = 832 * 1024;
constexpr size_t OFF_COEFQ = 218 * MiB, OFF_H1Q = 220 * MiB;
__device__ __forceinline__ unsigned pack4i8(float a, float b, float c, float d) {
    const int ia = (int)rintf(a), ib = (int)rintf(b), ic = (int)rintf(c), id = (int)rintf(d);
    return (unsigned)(ia & 0xff) | ((unsigned)(ib & 0xff) << 8) | ((unsigned)(ic & 0xff) << 16) | ((unsigned)(id & 0xff) << 24);
}
__device__ __forceinline__ void ph_ln1(const Params& p, int wv) {
    PH_IDS(); unsigned char* ws = p.ws; bf16* h1b = (bf16*)(ws + OFF_H1B); unsigned char* h1q = ws + OFF_H1Q; float* sx = (float*)(ws + OFF_SX);
    for (int t = gwave; t < T; t += nwaves) {
        float v[16]; float s = 0.f; float* row = p.out + (size_t)t * 1024 + lane * 16;
#pragma unroll
        for (int i = 0; i < 4; ++i) { const float4 a = *(const float4*)(row + 4 * i); v[4 * i] = a.x; v[4 * i + 1] = a.y; v[4 * i + 2] = a.z; v[4 * i + 3] = a.w; s += (a.x + a.y) + (a.z + a.w); }
        const float mu = wave_sum(s) * (1.0f / 1024.0f); float s2 = 0.f;
#pragma unroll
        for (int i = 0; i < 16; ++i) { v[i] -= mu; s2 += v[i] * v[i]; }
        const float rstd = rsqrtf(wave_sum(s2) * (1.0f / 1024.0f) + LN_EPS); float amax = 0.f;
#pragma unroll
        for (int i = 0; i < 4; ++i) { const int c = lane * 16 + 4 * i; const float4 ga = *(const float4*)(p.ln1_g + c), ba = *(const float4*)(p.ln1_b + c);
            v[4 * i] = v[4 * i] * rstd * ga.x + ba.x; v[4 * i + 1] = v[4 * i + 1] * rstd * ga.y + ba.y; v[4 * i + 2] = v[4 * i + 2] * rstd * ga.z + ba.z; v[4 * i + 3] = v[4 * i + 3] * rstd * ga.w + ba.w;
            *(float4*)(row + 4 * i) = make_float4(v[4 * i], v[4 * i + 1], v[4 * i + 2], v[4 * i + 3]); }
#pragma unroll
        for (int i = 0; i < 16; ++i) amax = fmaxf(amax, fabsf(v[i]));
        amax = fmaxf(wave_max(amax), 1e-20f); const float inv = 127.0f / amax;
        *(uint4*)(h1b + (size_t)t * 1024 + lane * 16) = pack8(v); *(uint4*)(h1b + (size_t)t * 1024 + lane * 16 + 8) = pack8(v + 8);
        *(uint4*)(h1q + (size_t)t * 1024 + lane * 16) = make_uint4(pack4i8(v[0] * inv, v[1] * inv, v[2] * inv, v[3] * inv), pack4i8(v[4] * inv, v[5] * inv, v[6] * inv, v[7] * inv),
                                                                 pack4i8(v[8] * inv, v[9] * inv, v[10] * inv, v[11] * inv), pack4i8(v[12] * inv, v[13] * inv, v[14] * inv, v[15] * inv));
        if (lane == 0) sx[t] = amax * (1.0f / 127.0f);
    }
}

__device__ __forceinline__ unsigned umaxu(unsigned a, unsigned b) { return a > b ? a : b; }
__device__ __forceinline__ unsigned uminu(unsigned a, unsigned b) { return a < b ? a : b; }
__device__ __forceinline__ unsigned f2mono(float f) { const unsigned u = __float_as_uint(f); return (u & 0x80000000u) ? ~u : (u | 0x80000000u); }
__device__ __forceinline__ float mono2f(unsigned m) { return __uint_as_float((m & 0x80000000u) ? (m & 0x7fffffffu) : ~m); }
template <int N> __device__ __forceinline__ void bitonic_sort_desc(unsigned (&a)[N]) {
#pragma unroll
    for (int k = 2; k <= N; k <<= 1)
#pragma unroll
        for (int j = k >> 1; j > 0; j >>= 1)
#pragma unroll
            for (int i = 0; i < N; ++i) { const int l = i ^ j; if (l > i) { const bool desc = ((i & k) == 0); const unsigned x = a[i], y = a[l], mx = umaxu(x, y), mn = uminu(x, y); a[i] = desc ? mx : mn; a[l] = desc ? mn : mx; } }
}
__device__ __forceinline__ void merge_top16(unsigned (&a)[16], const unsigned (&b)[16]) {
#pragma unroll
    for (int i = 0; i < 16; ++i) a[i] = umaxu(a[i], b[15 - i]);
#pragma unroll
    for (int j = 8; j > 0; j >>= 1)
#pragma unroll
        for (int i = 0; i < 16; ++i) { const int l = i ^ j; if (l > i) { const unsigned x = a[i], y = a[l]; a[i] = umaxu(x, y); a[l] = uminu(x, y); } }
}
constexpr int PK_KROW = 272;
__device__ __forceinline__ void peer_stage1(const bf16* qrow, const unsigned char* krow, int hi, unsigned (&run)[16]) {
    bf16x8 qf[8];
#pragma unroll
    for (int ks = 0; ks < 8; ++ks) qf[ks] = *(const bf16x8*)(qrow + ks * 16);
#pragma unroll 1
    for (int kt = 0; kt < 4; ++kt) {
        f32x16 acc;
#pragma unroll
        for (int e = 0; e < 16; ++e) acc[e] = 0.f;
        const unsigned char* kr = krow + kt * 32 * PK_KROW;
#pragma unroll
        for (int ks = 0; ks < 8; ++ks) acc = __builtin_amdgcn_mfma_f32_32x32x16_bf16(*(const bf16x8*)(kr + ks * 32), qf[ks], acc, 0, 0, 0);
        unsigned grp[16]; const unsigned ib = (unsigned)(127 - kt * 32 - 4 * hi);
#pragma unroll
        for (int e = 0; e < 16; ++e) grp[e] = (f2mono(acc[e]) & ~0x7fu) | (ib - (unsigned)((e & 3) + 8 * (e >> 2)));
        bitonic_sort_desc<16>(grp);
        if (kt == 0) {
#pragma unroll
            for (int i = 0; i < 16; ++i) run[i] = grp[i];
        } else merge_top16(run, grp);
    }
    unsigned oth[16];
#pragma unroll
    for (int i = 0; i < 16; ++i) oth[i] = __shfl_xor(run[i], 32);
    merge_top16(run, oth);
}
__device__ __forceinline__ void ph_peer_topk(const Params& p, int wv, unsigned char* lds) {
    PH_IDS(); unsigned char* ws = p.ws; const int rr = lane & 31, hi = lane >> 5;
    unsigned char* kimg = lds; int* exl = (int*)(lds + 2 * 128 * PK_KROW + wv * 6400);
    const bf16* qp = (const bf16*)(ws + OFF_QP); const bf16* keys = (const bf16*)(ws + OFF_KEYS);
    int* eidx = (int*)(ws + OFF_EIDX); float* gw = (float*)(ws + OFF_GW);
    const int h = bid & 7;
    for (int i = tid; i < 256 * 16; i += NTHREADS) { const int row = i >> 4, ch = i & 15; *(uint4*)(kimg + row * PK_KROW + ch * 16) = *(const uint4*)(keys + ((size_t)h * 256 + row) * 128 + ch * 8); }
    __syncthreads();
    for (int tt = (bid >> 3) * NWAVES + wv; tt < 512; tt += (nb >> 3) * NWAVES) {
        const int t0 = tt * 32;
        unsigned top[2][16];
        peer_stage1(qp + (size_t)(t0 + rr) * 2048 + h * 256 + 8 * hi, kimg + rr * PK_KROW + 16 * hi, hi, top[0]);
        peer_stage1(qp + (size_t)(t0 + rr) * 2048 + h * 256 + 128 + 8 * hi, kimg + (128 + rr) * PK_KROW + 16 * hi, hi, top[1]);
        unsigned g4[4][16];
#pragma unroll
        for (int k = 0; k < 4; ++k)
#pragma unroll
            for (int i = 0; i < 16; ++i) g4[k][i] = 0u;
#pragma unroll
        for (int i = 0; i < 16; ++i) {
            int off = 0;
#pragma unroll
            for (int k = 0; k < 16; ++k) if (k < i) off += 16 / (k + 1);
            const float s0 = mono2f(top[0][i] & ~0x7fu); const int e0 = (int)(127u - (top[0][i] & 0x7fu)) * 128;
#pragma unroll
            for (int j = 0; j < 16; ++j) if ((i + 1) * (j + 1) <= 16) {
                const int nc = off + j;
                const float sum = s0 + mono2f(top[1][j] & ~0x7fu);
                g4[nc >> 4][nc & 15] = (f2mono(sum) & ~0x3fu) | (unsigned)(63 - nc);
                if (hi == 0) exl[nc * 32 + rr] = e0 + (int)(127u - (top[1][j] & 0x7fu));
            }
        }
#pragma unroll
        for (int k = 0; k < 4; ++k) bitonic_sort_desc<16>(g4[k]);
        merge_top16(g4[0], g4[1]); merge_top16(g4[2], g4[3]); merge_top16(g4[0], g4[2]);
        float e16[16]; float den = 0.f; const float gmax = mono2f(g4[0][0] & ~0x3fu);
#pragma unroll
        for (int r = 0; r < 16; ++r) { e16[r] = __expf(mono2f(g4[0][r] & ~0x3fu) - gmax); den += e16[r]; }
        const float inv = 1.0f / den; const size_t ob = (size_t)(t0 + rr) * 128 + h * 16 + hi * 8;
        float wo[8]; int eo[8];
#pragma unroll
        for (int k = 0; k < 8; ++k) { const unsigned key = hi ? g4[0][8 + k] : g4[0][k]; wo[k] = (hi ? e16[8 + k] : e16[k]) * inv; eo[k] = exl[(63 - (int)(key & 0x3fu)) * 32 + rr]; }
        *(float4*)(gw + ob) = make_float4(wo[0], wo[1], wo[2], wo[3]); *(float4*)(gw + ob + 4) = make_float4(wo[4], wo[5], wo[6], wo[7]);
        *(int4*)(eidx + ob) = make_int4(eo[0], eo[1], eo[2], eo[3]); *(int4*)(eidx + ob + 4) = make_int4(eo[4], eo[5], eo[6], eo[7]);
    }
}
__device__ __forceinline__ void ph_peer_cvt(const Params& p, int wv) {
    PH_IDS(); unsigned char* ws = p.ws;
    for (int r = gwave; r < 2 * 16384; r += nwaves) {
        const bool isv = r >= 16384; const int e = isv ? r - 16384 : r;
        const float* src = (isv ? p.peer_v : p.peer_u) + (size_t)e * 1024 + lane * 16; float v[16]; float amax = 0.f;
#pragma unroll
        for (int i = 0; i < 4; ++i) { const float4 a = *(const float4*)(src + 4 * i); v[4 * i] = a.x; v[4 * i + 1] = a.y; v[4 * i + 2] = a.z; v[4 * i + 3] = a.w; }
#pragma unroll
        for (int i = 0; i < 16; ++i) amax = fmaxf(amax, fabsf(v[i]));
        amax = fmaxf(wave_max(amax), 1e-30f); const float inv = 127.0f / amax;
        *(uint4*)(ws + (isv ? OFF_PV : OFF_PU) + (size_t)e * 1024 + lane * 16) = make_uint4(pack4i8(v[0] * inv, v[1] * inv, v[2] * inv, v[3] * inv), pack4i8(v[4] * inv, v[5] * inv, v[6] * inv, v[7] * inv),
                                                                                            pack4i8(v[8] * inv, v[9] * inv, v[10] * inv, v[11] * inv), pack4i8(v[12] * inv, v[13] * inv, v[14] * inv, v[15] * inv));
        if (lane == 0) ((float*)(ws + (isv ? OFF_SV : OFF_SU)))[e] = amax * (1.0f / 127.0f);
    }
}
constexpr size_t OFF_PART = 26 * MiB;
constexpr size_t OFF_Y = 26 * MiB;
static_assert(OFF_PART + 64 * MiB <= OFF_H1B && OFF_PV + 16 * MiB <= OFF_XSBC && OFF_VWT + 8 * MiB <= OFF_PU, "PEER scratch map");
#define PU_ISSUE16(W, ELO, EHI) do { _Pragma("unroll") for (int k = 0; k < 8; ++k) { const int e0 = __shfl(ELO, k * 8 + g), e1 = __shfl(EHI, k * 8 + g); \
        W[k] = *(const uint4*)(PU + (size_t)e0 * 1024 + 128 * s + 16 * j); W[8 + k] = *(const uint4*)(PU + (size_t)e1 * 1024 + 128 * s + 16 * j); } } while (0)
#define PU_DOT16(W, X) __builtin_amdgcn_sdot4((int)(W).w, (int)(X).w, __builtin_amdgcn_sdot4((int)(W).z, (int)(X).z, __builtin_amdgcn_sdot4((int)(W).y, (int)(X).y, __builtin_amdgcn_sdot4((int)(W).x, (int)(X).x, 0, false), false), false), false)
#define PU_REDUCE8(W, O, XQ, PROW, B) do { int d[8], a4[4], a2[2], a1; \
        _Pragma("unroll") for (int k = 0; k < 8; ++k) d[k] = PU_DOT16(W[(O) + k], XQ); \
        _Pragma("unroll") for (int k = 0; k < 4; ++k) { const int give = b2 ? d[k] : d[4 + k]; a4[k] = (b2 ? d[4 + k] : d[k]) + __shfl_xor(give, 4); } \
        _Pragma("unroll") for (int k = 0; k < 2; ++k) { const int give = b1 ? a4[k] : a4[2 + k]; a2[k] = (b1 ? a4[2 + k] : a4[k]) + __shfl_xor(give, 2); } \
        { const int give = b0 ? a2[0] : a2[1]; a1 = (b0 ? a2[1] : a2[0]) + __shfl_xor(give, 1); } \
        (PROW)[(B) * 64 + kk * 8 + g] = a1; } while (0)
#define PU_META(T_, XQ, ELO, EHI) do { const int tq_ = (T_) < T ? (T_) : tlast; XQ = *(const uint4*)(h1q + (size_t)tq_ * 1024 + 128 * s + 16 * j); \
        ELO = eidx[(size_t)tq_ * 128 + lane]; EHI = eidx[(size_t)tq_ * 128 + 64 + lane]; } while (0)
#define PU_TOKEN(W, T_, XQ) do { int* prow = part + ((size_t)s * T + (T_)) * 128; PU_REDUCE8(W, 0, XQ, prow, 0); PU_REDUCE8(W, 8, XQ, prow, 1); } while (0)
__device__ __forceinline__ void ph_peer_u(const Params& p, int wv) {
    PH_IDS(); unsigned char* ws = p.ws; const int s = bid & 7, cu = bid >> 3, ncu = nb >> 3, g = lane >> 3, j = lane & 7;
    const unsigned char* h1q = ws + OFF_H1Q; const int* eidx = (const int*)(ws + OFF_EIDX); const unsigned char* PU = ws + OFF_PU; int* part = (int*)(ws + OFF_PART);
    const bool b2 = (lane & 4) != 0, b1 = (lane & 2) != 0, b0 = (lane & 1) != 0; const int kk = (b2 ? 4 : 0) + (b1 ? 2 : 0) + (b0 ? 1 : 0);
    const int tstep = ncu * NWAVES; int t = cu * NWAVES + wv;
    if (t >= T) return;
    const int tlast = t;
    uint4 xq0, xq1; int el0, eh0, el1, eh1;
    PU_META(t, xq0, el0, eh0); PU_META(t + tstep, xq1, el1, eh1);
    uint4 wA[16], wB[16];
    PU_ISSUE16(wA, el0, eh0);
    for (;;) {
        { const uint4 cx = xq0; PU_META(t + 2 * tstep, xq0, el0, eh0); PU_ISSUE16(wB, el1, eh1); PU_TOKEN(wA, t, cx); }
        t += tstep; if (t >= T) break;
        { const uint4 cx = xq1; PU_META(t + 2 * tstep, xq1, el1, eh1); PU_ISSUE16(wA, el0, eh0); PU_TOKEN(wB, t, cx); }
        t += tstep; if (t >= T) break;
    }
}
__device__ __forceinline__ void ph_peer_c(const Params& p, int wv) {
    PH_IDS(); unsigned char* ws = p.ws; const int* part = (const int*)(ws + OFF_PART); const float* gw = (const float*)(ws + OFF_GW); const int* eidx = (const int*)(ws + OFF_EIDX);
    const float* su = (const float*)(ws + OFF_SU); const float* sv = (const float*)(ws + OFF_SV); const float* sx = (const float*)(ws + OFF_SX); float* sc = (float*)(ws + OFF_SC); unsigned* coefq = (unsigned*)(ws + OFF_COEFQ);
    for (int t = gwave; t < T; t += nwaves) {
        float cp[2];
#pragma unroll
        for (int b = 0; b < 2; ++b) { const size_t i = (size_t)t * 128 + b * 64 + lane; int acc = 0;
#pragma unroll
            for (int s = 0; s < 8; ++s) acc += part[(size_t)s * T * 128 + i];
            const int e = eidx[i]; cp[b] = gw[i] * gelu_exact((float)acc * su[e] * sx[t]) * sv[e]; }
        const float amax = fmaxf(wave_max(fmaxf(fabsf(cp[0]), fabsf(cp[1]))), 1e-30f), inv = 127.0f / amax;
        const int q0 = (int)rintf(cp[0] * inv) & 0xff, q1 = (int)rintf(cp[1] * inv) & 0xff;
        const int gg = lane & 7, kq = (lane >> 3) & 1;
        unsigned w0 = 0u, w1 = 0u;
#pragma unroll
        for (int i = 0; i < 4; ++i) { const int srcl = (4 * kq + i) * 8 + gg; w0 |= (unsigned)__shfl(q0, srcl) << (8 * i); w1 |= (unsigned)__shfl(q1, srcl) << (8 * i); }
        if (lane < 16) { coefq[(size_t)t * 32 + lane] = w0; coefq[(size_t)t * 32 + 16 + lane] = w1; }
        if (lane == 0) sc[t] = amax * (1.0f / 127.0f);
    }
}
#define PV_ISSUE16(W, ELO, EHI) do { _Pragma("unroll") for (int k = 0; k < 8; ++k) { const int e0 = __shfl(ELO, k * 8 + g), e1 = __shfl(EHI, k * 8 + g); \
        W[k] = *(const uint4*)(PV + (size_t)e0 * 1024 + 128 * s + 16 * j); W[8 + k] = *(const uint4*)(PV + (size_t)e1 * 1024 + 128 * s + 16 * j); } } while (0)
#define PV_META(T_, ELO, EHI, CQ) do { const int tq_ = (T_) < T ? (T_) : tlast; ELO = eidx[(size_t)tq_ * 128 + lane]; EHI = eidx[(size_t)tq_ * 128 + 64 + lane]; \
        CQ[0] = coefq[(size_t)tq_ * 32 + g]; CQ[1] = coefq[(size_t)tq_ * 32 + 8 + g]; CQ[2] = coefq[(size_t)tq_ * 32 + 16 + g]; CQ[3] = coefq[(size_t)tq_ * 32 + 24 + g]; } while (0)
#define PV_BLK(W0, W1, W2, W3, CQW, A0, A1, A2, A3) do { \
        const unsigned l01 = __builtin_amdgcn_perm(W1, W0, 0x05010400u), h01 = __builtin_amdgcn_perm(W1, W0, 0x07030602u), l23 = __builtin_amdgcn_perm(W3, W2, 0x05010400u), h23 = __builtin_amdgcn_perm(W3, W2, 0x07030602u); \
        A0 = __builtin_amdgcn_sdot4((int)__builtin_amdgcn_perm(l23, l01, 0x05040100u), (int)(CQW), A0, false); A1 = __builtin_amdgcn_sdot4((int)__builtin_amdgcn_perm(l23, l01, 0x07060302u), (int)(CQW), A1, false); \
        A2 = __builtin_amdgcn_sdot4((int)__builtin_amdgcn_perm(h23, h01, 0x05040100u), (int)(CQW), A2, false); A3 = __builtin_amdgcn_sdot4((int)__builtin_amdgcn_perm(h23, h01, 0x07060302u), (int)(CQW), A3, false); } while (0)
#define PV_QUAD(W, O, CQW) do { PV_BLK(W[(O)].x, W[(O) + 1].x, W[(O) + 2].x, W[(O) + 3].x, CQW, acc[0], acc[1], acc[2], acc[3]); PV_BLK(W[(O)].y, W[(O) + 1].y, W[(O) + 2].y, W[(O) + 3].y, CQW, acc[4], acc[5], acc[6], acc[7]); \
        PV_BLK(W[(O)].z, W[(O) + 1].z, W[(O) + 2].z, W[(O) + 3].z, CQW, acc[8], acc[9], acc[10], acc[11]); PV_BLK(W[(O)].w, W[(O) + 1].w, W[(O) + 2].w, W[(O) + 3].w, CQW, acc[12], acc[13], acc[14], acc[15]); } while (0)
#define PV_TOKEN(W, CQ, T_) do { int acc[16]; _Pragma("unroll") for (int i = 0; i < 16; ++i) acc[i] = 0; \
        PV_QUAD(W, 0, CQ[0]); PV_QUAD(W, 4, CQ[1]); PV_QUAD(W, 8, CQ[2]); PV_QUAD(W, 12, CQ[3]); \
        int y8[8], y4[4], y2[2]; \
        _Pragma("unroll") for (int i = 0; i < 8; ++i) { const int give = b5 ? acc[i] : acc[8 + i]; y8[i] = (b5 ? acc[8 + i] : acc[i]) + __shfl_xor(give, 32); } \
        _Pragma("unroll") for (int i = 0; i < 4; ++i) { const int give = b4 ? y8[i] : y8[4 + i]; y4[i] = (b4 ? y8[4 + i] : y8[i]) + __shfl_xor(give, 16); } \
        _Pragma("unroll") for (int i = 0; i < 2; ++i) { const int give = b3 ? y4[i] : y4[2 + i]; y2[i] = (b3 ? y4[2 + i] : y4[i]) + __shfl_xor(give, 8); } \
        const float sct = sc[(T_)]; *(float2*)(Y + (size_t)(T_) * 1024 + 128 * s + 16 * j + c0) = make_float2((float)y2[0] * sct, (float)y2[1] * sct); } while (0)
__device__ __forceinline__ void ph_peer_v(const Params& p, int wv) {
    PH_IDS(); unsigned char* ws = p.ws; const int s = bid & 7, cu = bid >> 3, ncu = nb >> 3, g = lane >> 3, j = lane & 7;
    const int* eidx = (const int*)(ws + OFF_EIDX); const unsigned* coefq = (const unsigned*)(ws + OFF_COEFQ); const float* sc = (const float*)(ws + OFF_SC); const unsigned char* PV = ws + OFF_PV; float* Y = (float*)(ws + OFF_Y);
    const bool b5 = (lane & 32) != 0, b4 = (lane & 16) != 0, b3 = (lane & 8) != 0; const int c0 = (b5 ? 8 : 0) + (b4 ? 4 : 0) + (b3 ? 2 : 0);
    const int tstep = ncu * NWAVES; int t = cu * NWAVES + wv;
    if (t >= T) return;
    const int tlast = t;
    int el0, eh0, el1, eh1; unsigned cq0[4], cq1[4];
    PV_META(t, el0, eh0, cq0); PV_META(t + tstep, el1, eh1, cq1);
    uint4 wA[16], wB[16];
    PV_ISSUE16(wA, el0, eh0);
    for (;;) {
        { unsigned cc[4] = {cq0[0], cq0[1], cq0[2], cq0[3]}; PV_META(t + 2 * tstep, el0, eh0, cq0); PV_ISSUE16(wB, el1, eh1); PV_TOKEN(wA, cc, t); }
        t += tstep; if (t >= T) break;
        { unsigned cc[4] = {cq1[0], cq1[1], cq1[2], cq1[3]}; PV_META(t + 2 * tstep, el1, eh1, cq1); PV_ISSUE16(wA, el0, eh0); PV_TOKEN(wB, cc, t); }
        t += tstep; if (t >= T) break;
    }
}
__device__ __forceinline__ void ph_peer_ln2(const Params& p, int wv) {
    PH_IDS(); unsigned char* ws = p.ws; const float* Y = (const float*)(ws + OFF_Y);
    int t = gwave; if (t >= T) return;
    float4 ha[4], ya[4];
#pragma unroll
    for (int i = 0; i < 4; ++i) { ha[i] = *(const float4*)(p.out + (size_t)t * 1024 + lane * 16 + 4 * i); ya[i] = *(const float4*)(Y + (size_t)t * 1024 + lane * 16 + 4 * i); }
    for (;;) {
        const int tn = t + nwaves; const int tq = tn < T ? tn : t;
        float4 hb[4], yb[4];
#pragma unroll
        for (int i = 0; i < 4; ++i) { hb[i] = *(const float4*)(p.out + (size_t)tq * 1024 + lane * 16 + 4 * i); yb[i] = *(const float4*)(Y + (size_t)tq * 1024 + lane * 16 + 4 * i); }
        float y[16]; float s1 = 0.f, s2 = 0.f;
#pragma unroll
        for (int i = 0; i < 4; ++i) { y[4 * i] = ya[i].x + DN_ALPHA * ha[i].x; y[4 * i + 1] = ya[i].y + DN_ALPHA * ha[i].y; y[4 * i + 2] = ya[i].z + DN_ALPHA * ha[i].z; y[4 * i + 3] = ya[i].w + DN_ALPHA * ha[i].w; }
#pragma unroll
        for (int i = 0; i < 16; ++i) { s1 += y[i]; s2 += y[i] * y[i]; }
#pragma unroll
        for (int o = 1; o < 64; o <<= 1) { s1 += __shfl_xor(s1, o); s2 += __shfl_xor(s2, o); }
        const float mu = s1 * (1.0f / 1024.0f); const float var = fmaxf(s2 * (1.0f / 1024.0f) - mu * mu, 0.f); const float rstd = rsqrtf(var + LN_EPS);
        float* row = p.out + (size_t)t * 1024 + lane * 16;
#pragma unroll
        for (int i = 0; i < 4; ++i) { const int c = lane * 16 + 4 * i; const float4 ga = *(const float4*)(p.ln2_g + c), ba = *(const float4*)(p.ln2_b + c);
            float4 o; o.x = (y[4 * i] - mu) * rstd * ga.x + ba.x; o.y = (y[4 * i + 1] - mu) * rstd * ga.y + ba.y; o.z = (y[4 * i + 2] - mu) * rstd * ga.z + ba.z; o.w = (y[4 * i + 3] - mu) * rstd * ga.w + ba.w;
            *(float4*)(row + 4 * i) = o; }
        if (tn >= T) break;
        t = tn;
#pragma unroll
        for (int i = 0; i < 4; ++i) { ha[i] = hb[i]; ya[i] = yb[i]; }
    }
}

#define LAS __attribute__((address_space(3)))
#define XB_TMO      128
#define XB_XCNT(j)  (256  + 64 * (j))
#define XB_XSUB(j)  (1280 + 64 * (j))
#define XB_XGEN(j)  (2304 + 64 * (j))
#define XB_TOP      3328
#define XB_TOPGEN   3392
#define XCD_BAR_WORDS 3456
#define XB_SPIN_CAP (1u << 18)

__device__ __forceinline__ unsigned xb_ld(unsigned* p)              { return __hip_atomic_load(p, __ATOMIC_RELAXED, __HIP_MEMORY_SCOPE_AGENT); }
__device__ __forceinline__ unsigned xb_add(unsigned* p, unsigned v) { return __hip_atomic_fetch_add(p, v, __ATOMIC_RELAXED, __HIP_MEMORY_SCOPE_AGENT); }
__device__ __forceinline__ unsigned xb_xcc_id() { return (unsigned)__builtin_amdgcn_s_getreg((3 << 11) | 20) & 0xFu; }
#define XB_SPIN(cond, bar) do { unsigned _sp = 0; while (cond) { __builtin_amdgcn_s_sleep(1); \
    if ((++_sp & 255u) == 0u) { if (xb_ld(&(bar)[XB_TMO])) break; if (_sp > XB_SPIN_CAP) { atomicAdd(&(bar)[XB_TMO], 1u); break; } } } } while (0)

struct XcdBarrier {
    unsigned* bar; unsigned x;
    volatile LAS unsigned* st;
};

__device__ __forceinline__ XcdBarrier xcd_barrier_post(unsigned* bar, volatile LAS unsigned* st, bool leader) {
    XcdBarrier b; b.bar = bar; b.x = xb_xcc_id(); b.st = st;
    if (leader) (void)xb_add(&bar[XB_XCNT(b.x)], 1u);
    return b;
}
__device__ __forceinline__ void xcd_barrier_complete(unsigned* bar, unsigned x, unsigned& nloc, unsigned& nx) {
    const unsigned G = gridDim.x * gridDim.y * gridDim.z;
    unsigned sum, cnt, mine, sp = 0u;
    for (;;) {
        sum = 0u; cnt = 0u; mine = 0u;
#pragma unroll
        for (unsigned j = 0; j < 16; ++j) { const unsigned c = xb_ld(&bar[XB_XCNT(j)]); sum += c; cnt += (c > 0u) ? 1u : 0u; mine = (j == x) ? c : mine; }
        if (sum == G) break;
        __builtin_amdgcn_s_sleep(1);
        if ((++sp & 255u) == 0u) { if (xb_ld(&bar[XB_TMO])) break; if (sp > XB_SPIN_CAP) { atomicAdd(&bar[XB_TMO], 1u); break; } }
    }
    nloc = mine > 0u ? mine : 1u; nx = cnt > 0u ? cnt : 1u;
}

__device__ __forceinline__ void xcd_barrier(const XcdBarrier& b, bool leader) {
    asm volatile("s_waitcnt vmcnt(0)" ::: "memory");
    __syncthreads();
    if (leader) {
        unsigned* bar = b.bar;
        __builtin_amdgcn_s_waitcnt(0);
        unsigned nloc = b.st[0], nx = b.st[1];
        if (nloc == 0u) { xcd_barrier_complete(bar, b.x, nloc, nx); b.st[0] = nloc; b.st[1] = nx; }
        const unsigned old = xb_add(&bar[XB_XSUB(b.x)], 1u);
        const unsigned gen = old / nloc;
        if (old + 1u == (gen + 1u) * nloc) {
            __builtin_amdgcn_fence(__ATOMIC_RELEASE, "agent");
            asm volatile("s_waitcnt vmcnt(0)" ::: "memory");
            const unsigned og = xb_add(&bar[XB_TOP], 1u);
            const unsigned tg = og / nx;
            if (og + 1u == (tg + 1u) * nx) xb_add(&bar[XB_TOPGEN], 1u);
            else XB_SPIN(xb_ld(&bar[XB_TOPGEN]) == tg, bar);
            __builtin_amdgcn_fence(__ATOMIC_ACQUIRE, "agent");
            xb_add(&bar[XB_XGEN(b.x)], 1u);
            asm volatile("s_waitcnt vmcnt(0)" ::: "memory");
        } else {
            XB_SPIN(xb_ld(&bar[XB_XGEN(b.x)]) == gen, bar);
            __builtin_amdgcn_fence(__ATOMIC_ACQUIRE, "agent");
            asm volatile("s_waitcnt vmcnt(0)" ::: "memory");
        }
    }
    __syncthreads();
}

#ifndef TIMING_BOUNDARY
#define TIMING_BOUNDARY -1
#endif
#define TPROBE(k) do { if (TIMING_BOUNDARY == (k)) { const unsigned long long t1_ = __builtin_amdgcn_s_memrealtime(); while (__builtin_amdgcn_s_memrealtime() - t1_ < t1_ - tstart_) __builtin_amdgcn_s_sleep(8); } } while (0)
__global__ void __launch_bounds__(NTHREADS) fwd_megakernel(Params p) {
    extern __shared__ __attribute__((aligned(16))) unsigned char lds[];
    cg::grid_group grid = cg::this_grid();
    const int nb = gridDim.x, bid = blockIdx.x;
    const int wv = __builtin_amdgcn_readfirstlane(threadIdx.x >> 6);
    unsigned char* ws = p.ws;
    const unsigned long long tstart_ = (TIMING_BOUNDARY >= 0) ? __builtin_amdgcn_s_memrealtime() : 0ull; (void)tstart_;
    PG8_LAS unsigned char* ldsp = (PG8_LAS unsigned char*)lds;
    const bool leader = (wv == 0) && (lane_id() == 0);
    volatile LAS unsigned* bst = (volatile LAS unsigned*)(ldsp + LDS_BYTES - 64);
    if (leader) { bst[0] = 0u; bst[1] = 0u; }
    __syncthreads();
    const XcdBarrier xbar = xcd_barrier_post((unsigned*)(ws + OFF_BAR), bst, leader);

    ph_prep(p, wv, lds);
    if (p.ws == nullptr) grid.sync();
    xcd_barrier(xbar, leader);
    TPROBE(0);
    if (bid == 0) {
        const int o = (wv << 6) | lane_id(); const float* b1p = (const float*)(ws + OFF_HID) + (size_t)(o >> 8) * 32 * 256 + (o & 255); float s = 0.f;
        for (int kc = 0; kc < 32; ++kc) s += b1p[kc * 256];
        ((float*)(ws + (o < 256 ? OFF_B1K : OFF_B1V)))[o & 255] = s;
    }
    {
        pg8::Gemm g{(const bf16*)(ws + OFF_XB), (const bf16*)(ws + OFF_WIN), T, NPROJ_PAD, 1024, 1024, 0, 1 << 30, 0l};
        pg8::StaticOrder S; S.init(T, NPROJ_PAD, nb, bid);
        pg8::EpiInProjPg E{(bf16*)(ws + OFF_Z), (bf16*)(ws + OFF_XBC), (bf16*)(ws + OFF_Q), (bf16*)(ws + OFF_KVS), (bf16*)(ws + OFF_DTG)};
        pg8::gemm_phase<pg8::EpiInProjPg, pg8::StaticOrder, pg8::NoMid, true, true>(wv, ldsp, g, S, E, pg8::NoMid{});
    }
    xcd_barrier(xbar, leader);
    TPROBE(1);
    if (bid < 32) {
        const bool isv = bid >= 16;
        pg8::Gemm g{(const bf16*)(ws + OFF_KVS) + (isv ? 256 : 0), (const bf16*)(ws + (isv ? OFF_W1V : OFF_W1K)), 4096, 256, 2048, 0, 1, 1 << 30, 0l};
        pg8::StaticOrder S; S.init(4096, 256, 16, isv ? bid - 16 : bid);
        pg8::EpiBf16<1> E{(bf16*)(ws + OFF_HID + (isv ? 2 * MiB : 0)), 256, (const float*)(ws + (isv ? OFF_B1V : OFF_B1K)), 0, 0, 1.f};
        pg8::gemm_phase<pg8::EpiBf16<1>, pg8::StaticOrder, pg8::NoMid, true, true>(wv, ldsp, g, S, E, pg8::NoMid{});
    }
    else ph_tokprep(p, wv);
    xcd_barrier(xbar, leader);
    TPROBE(2);
    ph_ssd_prep2(p, wv, lds);
    ph_vt_prep(p, wv);
    xcd_barrier(xbar, leader);
    TPROBE(3);
    {
        RowMajorBf16 ak{(const bf16*)(ws + OFF_HID), 256}, av{(const bf16*)(ws + OFF_HID + 2 * MiB), 256};
        RowMajorBf16 bk{(const bf16*)(ws + OFF_W2K), 256}, bv{(const bf16*)(ws + OFF_W2V), 256};
        EpiKc ek{(bf16*)(ws + OFF_KC), false}, ev{(bf16*)(ws + OFF_VCT), true};
        gemm_wave16(wv, 4096 / 16, 64 / 16, 256, ak, bk, ek, 0, 2048);
        gemm_wave16(wv, 4096 / 16, 64 / 16, 256, av, bv, ev, 1024, 2048);
    }
    ph_ssd_states(p, wv);
    xcd_barrier(xbar, leader);
    TPROBE(4);
    ph_kc_rope(p, wv);
    ph_ssd_scan(p, wv);
    ph_peer_cvt(p, wv);
    xcd_barrier(xbar, leader);
    TPROBE(5);
    ph_ssd_out(p, wv, lds);
    ph_nsa(p, wv, lds);
    xcd_barrier(xbar, leader);
    TPROBE(6);
    {
        pg8::Gemm g{(const bf16*)(ws + OFF_Q), (const bf16*)(ws + OFF_WOUT), T, 1024, 2048, 1024, 0, 16, (long)OFF_Z - (long)OFF_Q - 16l * 128l};
        pg8::StaticOrder S; S.init(T, 1024, nb, bid);
        pg8::RmsFactors rf{(const float*)(ws + OFF_SSQ), (const float*)(ws + OFF_HID), RMS_EPS};
        pg8::EpiOutProj E{p.x, p.out, DN_ALPHA, rf}; pg8::MidRmsScale MH{rf};
        pg8::gemm_phase<pg8::EpiOutProj, pg8::StaticOrder, pg8::MidRmsScale, true, true>(wv, ldsp, g, S, E, MH);
    }
    xcd_barrier(xbar, leader);
    TPROBE(7);
    ph_ln1(p, wv);
    xcd_barrier(xbar, leader);
    TPROBE(8);
    {
        pg8::Gemm g{(const bf16*)(ws + OFF_H1B), (const bf16*)(ws + OFF_WQ), T, 2048, 1024, 1024, 0, 1 << 30, 0l};
        pg8::StaticOrder S; S.init(T, 2048, nb, bid);
        pg8::EpiBf16<0> E{(bf16*)(ws + OFF_QP), 2048, nullptr, 0, 0, 1.f};
        pg8::gemm_phase<pg8::EpiBf16<0>, pg8::StaticOrder, pg8::NoMid, true, true>(wv, ldsp, g, S, E, pg8::NoMid{});
    }
    xcd_barrier(xbar, leader);
    TPROBE(9);
    ph_peer_topk(p, wv, lds);
    xcd_barrier(xbar, leader);
    TPROBE(10);
    ph_peer_u(p, wv);
    xcd_barrier(xbar, leader);
    TPROBE(11);
    ph_peer_c(p, wv);
    xcd_barrier(xbar, leader);
    TPROBE(12);
    ph_peer_v(p, wv);
    xcd_barrier(xbar, leader);
    TPROBE(13);
    ph_peer_ln2(p, wv);
}

extern "C" void kernel_launch(void* const* d_in, const int* in_sizes, int n_in, void* d_out, int out_size, void* d_ws, size_t ws_size, hipStream_t stream) {
    static int grid_blocks = 0;
    if (!grid_blocks) {
        int dev = 0, cus = 0, per_cu = 0;
        hipGetDevice(&dev);
        hipDeviceGetAttribute(&cus, hipDeviceAttributeMultiprocessorCount, dev);
        hipFuncSetAttribute((const void*)fwd_megakernel, hipFuncAttributeMaxDynamicSharedMemorySize, LDS_BYTES);
        hipOccupancyMaxActiveBlocksPerMultiprocessor(&per_cu, fwd_megakernel, NTHREADS, LDS_BYTES);
        if (per_cu < 1) per_cu = 1;
        if (per_cu > 1) per_cu = 1;
        grid_blocks = cus * per_cu;
        if (ws_size < 244 * MiB) fprintf(stderr, "kernel_launch: workspace too small: %zu\n", ws_size);
    }
    Params p{};
    const float** pp = (const float**)&p;
    for (int i = 0; i < 24; ++i) pp[i] = (const float*)d_in[i];
    p.out = (float*)d_out; p.ws = (unsigned char*)d_ws;
    (void)hipMemsetAsync((unsigned char*)d_ws + OFF_BAR, 0, BAR_BYTES, stream);
    void* args[] = {&p};
    hipError_t e = hipLaunchCooperativeKernel((void*)fwd_megakernel, dim3(grid_blocks), dim3(NTHREADS), args, LDS_BYTES, stream);
    if (e != hipSuccess) fprintf(stderr, "cooperative launch failed: %s (grid %d)\n", hipGetErrorString(e), grid_blocks);
}
```

```cpp
#include <hip/hip_runtime.h>
#include <hip/hip_cooperative_groups.h>
#include <cstdio>
#include <cstdint>
namespace cg = cooperative_groups;

typedef unsigned short bf16;
typedef short bf16x8 __attribute__((ext_vector_type(8)));
typedef float f32x4 __attribute__((ext_vector_type(4)));
typedef float f32x16 __attribute__((ext_vector_type(16)));
typedef unsigned long long u64;

constexpr int T = 16384, L = 4096, NBATCH = 4, D = 1024;
constexpr int NPROJ = 5184, NPROJ_PAD = 5376;
constexpr int NTHREADS = 512, NWAVES = 8;
constexpr float LN_EPS = 1e-5f, RMS_EPS = 1e-5f;
constexpr float DN_ALPHA = 1.189207115002721f;
constexpr float NEG_INF = -1e30f, BIG = 1e30f;

constexpr size_t MiB = 1u << 20;
constexpr size_t OFF_SSQ = 0, OFF_BAR = 512 * 1024, BAR_BYTES = 16384;
constexpr size_t OFF_WOUT = 1 * MiB, OFF_WQ = 5 * MiB, OFF_W1K = 9 * MiB, OFF_W1V = 10 * MiB;
constexpr size_t OFF_W2K = 11 * MiB, OFF_W2V = 11 * MiB + 65536, OFF_B1K = 11 * MiB + 131072, OFF_B1V = 11 * MiB + 131072 + 4096;
constexpr size_t OFF_KEYS = 12 * MiB, OFF_ROPE = 13 * MiB, OFF_DT = 14 * MiB, OFF_ACS = 15 * MiB, OFF_GATE = 16 * MiB;
constexpr size_t OFF_HID = 20 * MiB, OFF_KC = 24 * MiB;
constexpr size_t OFF_Z = 26 * MiB, OFF_Q = 58 * MiB, OFF_KVS = 90 * MiB, OFF_XBC = 138 * MiB, OFF_XSBC = 186 * MiB, OFF_BT = 234 * MiB, OFF_DTG = 242 * MiB;
constexpr size_t OFF_VST = 138 * MiB, OFF_VWT = 146 * MiB, OFF_VCT = 19 * MiB;
constexpr size_t OFF_XB = 186 * MiB, OFF_WIN = 218 * MiB;
constexpr size_t OFF_H1B = 90 * MiB, OFF_QP = 26 * MiB, OFF_EIDX = 202 * MiB, OFF_GW = 210 * MiB;
constexpr size_t OFF_PU = 154 * MiB, OFF_PV = 170 * MiB;
constexpr int LDS_BYTES = 147456;

struct Params {
    const float *x, *w_in, *conv_w, *conv_b, *dt_bias, *a_log, *d_skip, *ssd_norm_w;
    const float *cmp_pos_k, *cmp_w1_k, *cmp_w2_k, *cmp_pos_v, *cmp_w1_v, *cmp_w2_v;
    const float *attn_norm_w, *w_out, *ln1_g, *ln1_b, *peer_wq, *peer_keys, *peer_u, *peer_v, *ln2_g, *ln2_b;
    float* out; unsigned char* ws;
};

__device__ __forceinline__ float bf2f(bf16 v) { return __uint_as_float((unsigned)v << 16); }
__device__ __forceinline__ bf16 f2bf(float f) { unsigned u = __float_as_uint(f); return (bf16)((u + 0x7fffu + ((u >> 16) & 1u)) >> 16); }
__device__ __forceinline__ int lane_id() { int l = (int)__builtin_amdgcn_mbcnt_hi(~0u, __builtin_amdgcn_mbcnt_lo(~0u, 0u)); asm volatile("" : "+v"(l)); return l; }
#define PH_IDS() const int lane = lane_id(); const int tid = (wv << 6) | lane; const int bid = blockIdx.x, nb = gridDim.x; const int gtid = bid * NTHREADS + tid, gn = nb * NTHREADS; const int gwave = bid * NWAVES + wv, nwaves = nb * NWAVES; (void)gtid; (void)gn; (void)gwave; (void)nwaves;
typedef float f32x2v __attribute__((ext_vector_type(2)));
typedef __bf16 bf16x2v __attribute__((ext_vector_type(2)));
__device__ __forceinline__ unsigned pk2bf(float lo, float hi) { f32x2v v = {lo, hi}; bf16x2v b = __builtin_convertvector(v, bf16x2v); return __builtin_bit_cast(unsigned, b); }
__device__ __forceinline__ float bflo(unsigned w) { return __uint_as_float(w << 16); }
__device__ __forceinline__ float bfhi(unsigned w) { return __uint_as_float(w & 0xffff0000u); }
__device__ __forceinline__ float wave_sum(float v) {
#pragma unroll
    for (int o = 1; o < 64; o <<= 1) v += __shfl_xor(v, o);
    return v;
}
__device__ __forceinline__ float wave_max(float v) {
#pragma unroll
    for (int o = 1; o < 64; o <<= 1) v = fmaxf(v, __shfl_xor(v, o));
    return v;
}
__device__ __forceinline__ float gelu_exact(float v) { return 0.5f * v * (1.0f + erff(v * 0.7071067811865476f)); }
__device__ __forceinline__ float sigmoidf(float v) { return 1.0f / (1.0f + __expf(-v)); }

template <class AP, class BP, class EP>
__device__ __forceinline__ void gemm_wave32(int wv, int Mt, int Nt, int K, const AP& ap, const BP& bp, const EP& ep) {
    PH_IDS(); const int r = lane & 15, q = lane >> 4;
    for (int tile = gwave; tile < Mt * Nt; tile += nwaves) {
        const int tm = tile / Nt, tn = tile % Nt, row0 = tm * 32, col0 = tn * 32;
        f32x4 acc[2][2];
#pragma unroll
        for (int i = 0; i < 2; ++i)
#pragma unroll
            for (int j = 0; j < 2; ++j) acc[i][j] = (f32x4){0.f, 0.f, 0.f, 0.f};
        for (int k0 = 0; k0 < K; k0 += 32) {
            const bf16x8 a0 = ap(row0 + r, k0 + 8 * q), a1 = ap(row0 + 16 + r, k0 + 8 * q);
            const bf16x8 b0 = bp(col0 + r, k0 + 8 * q), b1 = bp(col0 + 16 + r, k0 + 8 * q);
            acc[0][0] = __builtin_amdgcn_mfma_f32_16x16x32_bf16(a0, b0, acc[0][0], 0, 0, 0);
            acc[0][1] = __builtin_amdgcn_mfma_f32_16x16x32_bf16(a0, b1, acc[0][1], 0, 0, 0);
            acc[1][0] = __builtin_amdgcn_mfma_f32_16x16x32_bf16(a1, b0, acc[1][0], 0, 0, 0);
            acc[1][1] = __builtin_amdgcn_mfma_f32_16x16x32_bf16(a1, b1, acc[1][1], 0, 0, 0);
        }
#pragma unroll
        for (int i = 0; i < 2; ++i)
#pragma unroll
            for (int j = 0; j < 2; ++j)
#pragma unroll
                for (int e = 0; e < 4; ++e) ep(row0 + 16 * i + 4 * q + e, col0 + 16 * j + r, acc[i][j][e]);
    }
}
template <class AP, class BP, class EP>
__device__ __forceinline__ void gemm_wave16(int wv, int Mt, int Nt, int K, const AP& ap, const BP& bp, const EP& ep, int task0, int ntask_total) {
    PH_IDS(); const int r = lane & 15, q = lane >> 4;
    for (int task = gwave; task < ntask_total; task += nwaves) {
        const int tile = task - task0; if (tile < 0 || tile >= Mt * Nt) continue;
        const int tm = tile / Nt, tn = tile % Nt, row0 = tm * 16, col0 = tn * 16;
        f32x4 acc = (f32x4){0.f, 0.f, 0.f, 0.f};
#pragma unroll 4
        for (int k0 = 0; k0 < K; k0 += 32) acc = __builtin_amdgcn_mfma_f32_16x16x32_bf16(ap(row0 + r, k0 + 8 * q), bp(col0 + r, k0 + 8 * q), acc, 0, 0, 0);
#pragma unroll
        for (int e = 0; e < 4; ++e) ep(row0 + 4 * q + e, col0 + r, acc[e]);
    }
}
struct RowMajorBf16 { const bf16* p; int ld; __device__ __forceinline__ bf16x8 operator()(int row, int k) const { return *(const bf16x8*)(p + (size_t)row * ld + k); } };

namespace pg8 {
#define PG8_LAS __attribute__((address_space(3)))
typedef unsigned short bf16_t;
typedef short bf16x8 __attribute__((ext_vector_type(8)));
typedef float f32x4 __attribute__((ext_vector_type(4)));
typedef unsigned u32x4 __attribute__((ext_vector_type(4)));
constexpr int BM = 256, BK = 64, HALF = 128, HTB = HALF * BK * 2  , STAGE_BYTES = 8 * HTB, NXCD = 8, WGM = 8;

__host__ __device__ __forceinline__ int lds_byte(int r, int c) { const int st = (r >> 4) * 2 + (c >> 5), rr = r & 15, cc = c & 31, ob = rr * 64 + cc * 2; return st * 1024 + (ob ^ (((ob >> 9) & 1) << 5)); }
__host__ __device__ __forceinline__ void stage_rc(int b, int& R, int& C) { const int st = b / 1024, sb = b % 1024, swz = sb ^ (((sb >> 9) & 1) << 5); R = (st >> 1) * 16 + swz / 64; C = (st & 1) * 32 + (swz % 64) / 2; }
__host__ __device__ __forceinline__ int perm32(int rho) { const int n = rho >> 4, i = rho & 15; return 8 * (i >> 2) + 4 * n + (i & 3); }

struct Unit { int pm, pn; };
struct Gemm { const bf16_t* A; const bf16_t* Bt; int M, N, K; int lda; int amode; int ksplit; long kdelta; };

struct StaticOrder {
    int nM, nN, nwg, G, c;
    __host__ __device__ void init(int M, int N, int G_, int c_) { nM = M / BM; nN = N / BM; nwg = nM * nN; G = G_; c = c_; }
    __host__ __device__ bool next(int i, Unit& u) const {
        const long L = (long)i * G + c; if (L >= nwg) return false;
        int wgid = (int)L; { const int q = nwg / NXCD, r = nwg % NXCD, xcd = wgid % NXCD, off = wgid / NXCD; wgid = (xcd < r ? xcd * (q + 1) : r * (q + 1) + (xcd - r) * q) + off; }
        const int nig = WGM * nN, gid = wgid / nig, fm = gid * WGM, gsz = (nM - fm) < WGM ? (nM - fm) : WGM;
        u.pm = fm + ((wgid % nig) % gsz); u.pn = (wgid % nig) / gsz; return true;
    }
    __device__ __forceinline__ void a_ready(const Unit&) const {}
    __device__ __forceinline__ void done(const Unit&) const {}
};


__device__ __forceinline__ unsigned cvt_pk_bf16(float lo, float hi) { unsigned r; asm volatile("v_cvt_pk_bf16_f32 %0, %1, %2" : "=v"(r) : "v"(lo), "v"(hi)); return r; }
typedef float f32x2 __attribute__((ext_vector_type(2)));
__device__ __forceinline__ f32x2 gelu_pk(f32x2 v) {
    const f32x2 av = __builtin_elementwise_abs(v), d = av * 0.2316418882f + 1.0f;
    f32x2 t; t.x = __builtin_amdgcn_rcpf(d.x); t.y = __builtin_amdgcn_rcpf(d.y);
    f32x2 q = t * 0.5307027145f + (-0.7265760135f); q = q * t + 0.7107068705f; q = q * t + (-0.142248368f); q = q * t + 0.127414796f; q = q * t;
    const f32x2 s = (v * v) * (-0.72134752044f);
    f32x2 e; e.x = __builtin_amdgcn_exp2f(s.x); e.y = __builtin_amdgcn_exp2f(s.y);
    const f32x2 m = v * (q * e), r = v - m;
    f32x2 o; o.x = v.x < 0.f ? m.x : r.x; o.y = v.y < 0.f ? m.y : r.y; return o;
}

template <int ACT  > struct EpiBf16 {
    static constexpr bool PERM = true, AFTER_DRAIN = false; static_assert(ACT == 0 || ACT == 1, "EpiBf16: ACT is 0 (none) or 1 (gelu_pk)");
    bf16_t* O; int ldc; const float* bias; int split_cols; size_t split_stride; float scale0;
    __device__ __forceinline__ void operator()(const f32x4 (&acc)[2][2][4][2], const Unit& u, int wr, int wc, int fr, int fq) const {
        const int row0 = u.pm * BM + wr * 64 + fr; int colt = u.pn * BM; bf16_t* base = O;
        float sc = 1.f; if (split_cols) { const int t = colt / split_cols; base += (size_t)t * split_stride; colt -= t * split_cols; if (t == 0) sc = scale0; }
        const int col0 = colt + wc * 32 + 8 * fq, bcol0 = u.pn * BM + wc * 32 + 8 * fq;
        f32x4 bv[2][2];
#pragma unroll
        for (int bj = 0; bj < 2; ++bj)
#pragma unroll
            for (int n = 0; n < 2; ++n) bv[bj][n] = bias ? *(const f32x4*)(bias + bcol0 + bj * HALF + 4 * n) : (f32x4){0.f, 0.f, 0.f, 0.f};
#pragma unroll
        for (int ai = 0; ai < 2; ++ai)
#pragma unroll
            for (int m = 0; m < 4; ++m) { bf16_t* rowp = base + (size_t)(row0 + ai * HALF + m * 16) * ldc + col0;
#pragma unroll
                for (int bj = 0; bj < 2; ++bj) { f32x4 v0 = acc[ai][bj][m][0] + bv[bj][0], v1 = acc[ai][bj][m][1] + bv[bj][1];
                    if (ACT == 1) { f32x2 a = gelu_pk((f32x2){v0[0], v0[1]}), b = gelu_pk((f32x2){v0[2], v0[3]}), c = gelu_pk((f32x2){v1[0], v1[1]}), d = gelu_pk((f32x2){v1[2], v1[3]});
                        v0 = (f32x4){a.x, a.y, b.x, b.y}; v1 = (f32x4){c.x, c.y, d.x, d.y}; }
                    v0 = v0 * sc; v1 = v1 * sc; u32x4 w; w.x = cvt_pk_bf16(v0[0], v0[1]); w.y = cvt_pk_bf16(v0[2], v0[3]); w.z = cvt_pk_bf16(v1[0], v1[1]); w.w = cvt_pk_bf16(v1[2], v1[3]);
                    *(u32x4*)(rowp + bj * HALF) = w; } }
    }
};

struct EpiInProjPg { static constexpr bool PERM = true, AFTER_DRAIN = false;
    bf16_t *z, *xbc, *q, *kvs, *dtg;
    __device__ __forceinline__ void operator()(const f32x4 (&acc)[2][2][4][2], const Unit& u, int wr, int wc, int fr, int fq) const {
        bf16_t* base; int ldc, colt; const int pn = u.pn;
        if (pn < 4) { base = z; ldc = 1024; colt = pn * 256; } else if (pn < 10) { base = xbc; ldc = 1536; colt = (pn - 4) * 256; }
        else if (pn < 14) { base = q; ldc = 1024; colt = (pn - 10) * 256; } else if (pn < 20) { base = kvs; ldc = 1536; colt = (pn - 14) * 256; }
        else { base = dtg; ldc = 64; colt = 0; }
        const int row0 = u.pm * BM + wr * 64 + fr, col0 = colt + wc * 32 + 8 * fq;
#pragma unroll
        for (int ai = 0; ai < 2; ++ai)
#pragma unroll
            for (int m = 0; m < 4; ++m) { bf16_t* rowp = base + (size_t)(row0 + ai * HALF + m * 16) * ldc + col0;
#pragma unroll
                for (int bj = 0; bj < 2; ++bj) { const f32x4 v0 = acc[ai][bj][m][0], v1 = acc[ai][bj][m][1];
                    u32x4 w; w.x = cvt_pk_bf16(v0[0], v0[1]); w.y = cvt_pk_bf16(v0[2], v0[3]); w.z = cvt_pk_bf16(v1[0], v1[1]); w.w = cvt_pk_bf16(v1[2], v1[3]);
                    if (pn < 20 || (bj == 0 && wc < 2)) *(u32x4*)(rowp + bj * HALF) = w; } }
    }
};
struct RmsFactors { const float* ssqp; const float* ssq2p; float eps;
    __device__ __forceinline__ void get(int row, float& ra, float& r0, float& r1) const {
        const f32x4 a = *(const f32x4*)(ssqp + 4 * row); const f32x4 b0 = *(const f32x4*)(ssq2p + 16 * row), b1 = *(const f32x4*)(ssq2p + 16 * row + 4), b2 = *(const f32x4*)(ssq2p + 16 * row + 8), b3 = *(const f32x4*)(ssq2p + 16 * row + 12);
        ra = rsqrtf(((a[0] + a[1]) + (a[2] + a[3])) * (1.0f / 1024.0f) + eps);
        r0 = rsqrtf((((b0[0] + b0[1]) + (b0[2] + b0[3])) + ((b1[0] + b1[1]) + (b1[2] + b1[3]))) * (1.0f / 512.0f) + eps);
        r1 = rsqrtf((((b2[0] + b2[1]) + (b2[2] + b2[3])) + ((b3[0] + b3[1]) + (b3[2] + b3[3]))) * (1.0f / 512.0f) + eps); } };
struct EpiOutProj { static constexpr bool PERM = false, AFTER_DRAIN = false;
    const float* x; float* out; float alpha; RmsFactors rf;
    __device__ __forceinline__ void operator()(const f32x4 (&acc)[2][2][4][2], const Unit& u, int wr, int wc, int fr, int fq) const {
        const int col0 = u.pn * BM + wc * 32 + 4 * fq;
#pragma unroll
        for (int ai = 0; ai < 2; ++ai)
#pragma unroll
            for (int m = 0; m < 4; ++m) { const int row = u.pm * BM + ai * HALF + wr * 64 + m * 16 + fr; const size_t off = (size_t)row * 1024 + col0;
                float ra, r0, r1; rf.get(row, ra, r0, r1);
#pragma unroll
                for (int bj = 0; bj < 2; ++bj)
#pragma unroll
                    for (int n = 0; n < 2; ++n) { const size_t o = off + bj * HALF + n * 16; const f32x4 xv = *(const f32x4*)(x + o); *(f32x4*)(out + o) = xv * alpha + acc[ai][bj][m][n] * r1; } }
    }
};
struct MidRmsScale { static constexpr bool ENABLED = true; RmsFactors rf;
    __device__ __forceinline__ void operator()(f32x4 (&acc)[2][2][4][2], const Unit& u, int t, int wr, int wc, int fr, int fq) const {
        if (t != 16 && t != 24) return;
        int rowb = u.pm * BM + wr * 64 + fr; asm volatile("" : "+v"(rowb));
#pragma unroll
        for (int ai = 0; ai < 2; ++ai)
#pragma unroll
            for (int m = 0; m < 4; ++m) { float ra, r0, r1; rf.get(rowb + ai * HALF + m * 16, ra, r0, r1);
                const float sc = (t == 16) ? ra / r0 : r0 / r1;
#pragma unroll
                for (int bj = 0; bj < 2; ++bj)
#pragma unroll
                    for (int n = 0; n < 2; ++n) acc[ai][bj][m][n] = acc[ai][bj][m][n] * sc; }
    }
};
struct NoMid { static constexpr bool ENABLED = false; template <class ACC> __device__ __forceinline__ void operator()(ACC&, const Unit&, int, int, int, int, int) const {} };
template <class Epi, class Sched, class Mid, bool ALIGN_EPI = false, bool SP2 = false>
__device__ __forceinline__ void gemm_phase(int wv, PG8_LAS unsigned char* lds, const Gemm g, const Sched& S, const Epi& E, const Mid& MH) {
    int lane_ = (int)__builtin_amdgcn_mbcnt_hi(~0u, __builtin_amdgcn_mbcnt_lo(~0u, 0u)); asm volatile("" : "+v"(lane_));
    const int lane = lane_, wid = wv, tid = (wv << 6) | lane, wr = wid >> 2, wc = wid & 3, fr = lane & 15, fq = lane >> 4;
    const int K = g.K, nt = K / BK;
    unsigned voffA[2], voffB[2];
#pragma unroll
    for (int i = 0; i < 2; ++i) { int R, C; stage_rc(tid * 16 + i * 8192, R, C); const int Rb = Epi::PERM ? ((R & ~31) + perm32(R & 31)) : R;
        voffA[i] = g.amode == 0 ? (unsigned)(R * g.lda + C) * 2u : (unsigned)((R >> 2) * 49152 + (R & 3) * 128 + C * 2); voffB[i] = (unsigned)(Rb * K + C) * 2u; }
    const size_t kstep = (size_t)(BK * 2);
    const size_t hstep = (size_t)HALF * K * 2;
    const size_t tstep = 2 * hstep;
    const size_t kstepA = g.amode == 0 ? (size_t)(BK * 2) : (size_t)3072;
    const size_t hstepA = g.amode == 0 ? (size_t)HALF * g.lda * 2 : (size_t)32 * 49152;
    const size_t tstepA = 2 * hstepA;
#define PG8_AK(base, t) ((base) + (size_t)(t) * kstepA + (((t) >= g.ksplit) ? g.kdelta : 0l))
    const unsigned ldsw = (unsigned)wid * 1024u;
    const int aoff = lds_byte(wr * 64 + fr, fq * 8), boff = lds_byte(wc * 32 + fr, fq * 8);
#define PG8_SA(b, h) (((b) * 2 + (h)) * HTB)
#define PG8_SB(b, h) ((4 + (b) * 2 + (h)) * HTB)
#define PG8_STAGE(bufoff, gbase, voff) do { _Pragma("unroll") for (int _i = 0; _i < 2; ++_i) \
        __builtin_amdgcn_global_load_lds((const unsigned*)((const char*)(gbase) + (voff)[_i]), (PG8_LAS unsigned*)(lds + (bufoff) + ldsw + _i * 8192), 16, 0, 0); } while (0)
#define PG8_LDA(dst, b, h) do { _Pragma("unroll") for (int m = 0; m < 4; ++m) _Pragma("unroll") for (int k = 0; k < 2; ++k) dst[m][k] = *(const PG8_LAS bf16x8*)(lds + PG8_SA(b, h) + aoff + m * 2048 + k * 1024); } while (0)
#define PG8_LDB(dst, b, h) do { _Pragma("unroll") for (int n = 0; n < 2; ++n) _Pragma("unroll") for (int k = 0; k < 2; ++k) dst[n][k] = *(const PG8_LAS bf16x8*)(lds + PG8_SB(b, h) + boff + n * 2048 + k * 1024); } while (0)
#define PG8_MMA(ai, bj, At, Bt) do { __builtin_amdgcn_s_setprio(1); _Pragma("unroll") for (int m = 0; m < 4; ++m) _Pragma("unroll") for (int n = 0; n < 2; ++n) _Pragma("unroll") for (int k = 0; k < 2; ++k) \
        acc[ai][bj][m][n] = __builtin_amdgcn_mfma_f32_16x16x32_bf16(Bt[n][k], At[m][k], acc[ai][bj][m][n], 0, 0, 0); __builtin_amdgcn_s_setprio(0); } while (0)
#define PG8_WAIT_V(n) asm volatile("s_waitcnt vmcnt(" #n ")" ::: "memory")
#define PG8_WAIT_L(n) asm volatile("s_waitcnt lgkmcnt(" #n ")" ::: "memory")
#define PG8_BAR __builtin_amdgcn_s_barrier()
#define PG8_SCHED __builtin_amdgcn_sched_barrier(0)
    Unit cur, nxt; int ui = 0;
    if (!S.next(0, cur)) return;
    f32x4 acc[2][2][4][2];
#pragma unroll
    for (int a = 0; a < 2; ++a)
#pragma unroll
        for (int b = 0; b < 2; ++b)
#pragma unroll
            for (int m = 0; m < 4; ++m)
#pragma unroll
                for (int n = 0; n < 2; ++n) acc[a][b][m][n] = (f32x4){0.f, 0.f, 0.f, 0.f};
    bf16x8 At[4][2], B0[2][2], B1[2][2];
    const char* cA = (const char*)g.A + (size_t)cur.pm * tstepA; const char* cB = (const char*)g.Bt + (size_t)cur.pn * tstep;
    S.a_ready(cur);
    if constexpr (SP2) {
        PG8_STAGE(PG8_SB(0, 0), cB, voffB); PG8_STAGE(PG8_SB(0, 1), cB + hstep, voffB); PG8_STAGE(PG8_SA(0, 0), cA, voffA); PG8_STAGE(PG8_SA(0, 1), cA + hstepA, voffA);
        if (wr == 1) PG8_BAR;
        PG8_WAIT_V(2); PG8_BAR;
        PG8_STAGE(PG8_SB(1, 0), cB + kstep, voffB); PG8_STAGE(PG8_SA(1, 0), PG8_AK(cA, 1), voffA); PG8_STAGE(PG8_SB(1, 1), cB + hstep + kstep, voffB);
        PG8_WAIT_V(6); PG8_BAR;
    } else {
        PG8_STAGE(PG8_SB(0, 0), cB, voffB); PG8_STAGE(PG8_SA(0, 0), cA, voffA); PG8_STAGE(PG8_SB(0, 1), cB + hstep, voffB); PG8_STAGE(PG8_SA(0, 1), cA + hstepA, voffA);
        if (wr == 1) PG8_BAR;
        PG8_WAIT_V(4); PG8_BAR;
        PG8_STAGE(PG8_SB(1, 0), cB + kstep, voffB); PG8_STAGE(PG8_SA(1, 0), PG8_AK(cA, 1), voffA); PG8_STAGE(PG8_SB(1, 1), cB + hstep + kstep, voffB);
        PG8_WAIT_V(6); PG8_BAR;
    }
    for (;;) {
        const bool has_next = S.next(ui + 1, nxt);
        const char* nA = has_next ? (const char*)g.A + (size_t)nxt.pm * tstepA : cA; const char* nB = has_next ? (const char*)g.Bt + (size_t)nxt.pn * tstep : cB;
        for (int t = 0; t < nt; t += 2) {
            const bool last = (t == nt - 2);
            if (Mid::ENABLED) MH(acc, cur, t, wr, wc, fr, fq);
            const char* a1 = PG8_AK(cA, t + 1);
            const char* a2 = last ? nA : PG8_AK(cA, t + 2); const char* b2 = last ? nB : cB + (size_t)(t + 2) * kstep;
            const char* a3 = a2 + kstepA; const char* b3 = b2 + kstep;
            if (last && has_next) S.a_ready(nxt);
            if constexpr (SP2) {
            PG8_LDB(B0, 0, 0); PG8_LDB(B1, 0, 1); PG8_SCHED; PG8_LDA(At, 0, 0); PG8_STAGE(PG8_SA(1, 1), a1 + hstepA, voffA);
            PG8_WAIT_V(8); PG8_WAIT_L(0); PG8_BAR; PG8_MMA(0, 0, At, B0); PG8_MMA(0, 1, At, B1); PG8_BAR; PG8_SCHED;
            PG8_LDA(At, 0, 1); PG8_STAGE(PG8_SB(0, 0), b2, voffB); PG8_STAGE(PG8_SB(0, 1), b2 + hstep, voffB); PG8_STAGE(PG8_SA(0, 0), a2, voffA);
            PG8_WAIT_V(8); PG8_WAIT_L(0); PG8_BAR; PG8_MMA(1, 0, At, B0); PG8_MMA(1, 1, At, B1); PG8_BAR; PG8_SCHED;
            PG8_LDB(B0, 1, 0); PG8_LDB(B1, 1, 1); PG8_SCHED; PG8_LDA(At, 1, 0); PG8_STAGE(PG8_SA(0, 1), a2 + hstepA, voffA);
            PG8_WAIT_V(8); PG8_WAIT_L(0); PG8_BAR; PG8_MMA(0, 0, At, B0); PG8_MMA(0, 1, At, B1); PG8_BAR; PG8_SCHED;
            PG8_LDA(At, 1, 1); PG8_STAGE(PG8_SB(1, 0), b3, voffB); PG8_STAGE(PG8_SB(1, 1), b3 + hstep, voffB); PG8_STAGE(PG8_SA(1, 0), a3, voffA);
            PG8_WAIT_V(8); PG8_WAIT_L(0); PG8_BAR; PG8_MMA(1, 0, At, B0); PG8_MMA(1, 1, At, B1); PG8_BAR; PG8_SCHED;
            } else {
            PG8_LDB(B0, 0, 0); PG8_SCHED; PG8_LDA(At, 0, 0); PG8_STAGE(PG8_SA(1, 1), a1 + hstepA, voffA);
            PG8_WAIT_L(8); PG8_BAR; PG8_WAIT_L(0); PG8_MMA(0, 0, At, B0); PG8_BAR; PG8_SCHED;
            PG8_LDB(B1, 0, 1); PG8_STAGE(PG8_SB(0, 0), b2, voffB);
            PG8_BAR; PG8_WAIT_L(0); PG8_MMA(0, 1, At, B1); PG8_BAR;
            PG8_LDA(At, 0, 1); PG8_STAGE(PG8_SA(0, 0), a2, voffA);
            PG8_BAR; PG8_WAIT_L(0); PG8_MMA(1, 0, At, B0); PG8_BAR; PG8_SCHED;
            PG8_STAGE(PG8_SB(0, 1), b2 + hstep, voffB);
            PG8_WAIT_V(6); PG8_BAR; PG8_MMA(1, 1, At, B1); PG8_BAR;
            PG8_LDB(B0, 1, 0); PG8_SCHED; PG8_LDA(At, 1, 0); PG8_STAGE(PG8_SA(0, 1), a2 + hstepA, voffA);
            PG8_WAIT_L(8); PG8_BAR; PG8_WAIT_L(0); PG8_MMA(0, 0, At, B0); PG8_BAR; PG8_SCHED;
            PG8_LDB(B1, 1, 1); PG8_STAGE(PG8_SB(1, 0), b3, voffB);
            PG8_BAR; PG8_WAIT_L(0); PG8_MMA(0, 1, At, B1); PG8_BAR;
            PG8_LDA(At, 1, 1); PG8_STAGE(PG8_SA(1, 0), a3, voffA);
            PG8_BAR; PG8_WAIT_L(0); PG8_MMA(1, 0, At, B0); PG8_BAR; PG8_SCHED;
            PG8_STAGE(PG8_SB(1, 1), b3 + hstep, voffB);
            PG8_WAIT_V(6); PG8_BAR; PG8_MMA(1, 1, At, B1); PG8_BAR;
            }
        }
        if constexpr (ALIGN_EPI) { if (wr == 0) PG8_BAR; }
        if constexpr (!Epi::AFTER_DRAIN) { E(acc, cur, wr, wc, fr, fq); S.done(cur); }
        if (!has_next) break;
#pragma unroll
        for (int a = 0; a < 2; ++a)
#pragma unroll
            for (int b = 0; b < 2; ++b)
#pragma unroll
                for (int m = 0; m < 4; ++m)
#pragma unroll
                    for (int n = 0; n < 2; ++n) acc[a][b][m][n] = (f32x4){0.f, 0.f, 0.f, 0.f};
        cur = nxt; cA = nA; cB = nB; ++ui;
        if constexpr (ALIGN_EPI) { if (wr == 1) PG8_BAR; }
    }
    PG8_WAIT_V(0);
    if constexpr (!ALIGN_EPI) { if (wr == 0) PG8_BAR; }
    PG8_BAR;
    if constexpr (Epi::AFTER_DRAIN) { E.fused(acc, cur, wr, wc, fr, fq, lds, wid, lane); S.done(cur); }
#undef PG8_AK
#undef PG8_SA
#undef PG8_SB
#undef PG8_STAGE
#undef PG8_LDA
#undef PG8_LDB
#undef PG8_MMA
#undef PG8_WAIT_V
#undef PG8_WAIT_L
#undef PG8_BAR
#undef PG8_SCHED
}
}

__device__ __forceinline__ int winmap(int n) { return n < 2560 ? n : (n < 5120 ? n + 16 : (n < 5136 ? 2560 + (n - 5120) : n)); }
template <class Map>
__device__ __forceinline__ void transpose_item(const float* W, int ldw, bf16* WT, int K, int item, int nblk, float* scr, int lane, const Map& mp) {
    const int kb = item / nblk, nbk = item % nblk, k0 = 64 * kb, n0 = 32 * nbk;
    const int col = mp.scol(n0 + (lane & 31));
#pragma unroll 8
    for (int i = 0; i < 32; ++i) { const int kk = 2 * i + (lane >> 5); scr[kk * 33 + (lane & 31)] = col >= 0 ? W[(size_t)mp.srow(k0 + kk) * ldw + col] * mp.scale(k0 + kk) : 0.f; }
    const int c = lane & 7;
#pragma unroll
    for (int j = 0; j < 4; ++j) { const int n = (lane >> 3) + 8 * j; const float* s = scr + (8 * c) * 33 + n;
        *(uint4*)(WT + (size_t)(n0 + n) * K + k0 + 8 * c) = make_uint4(pk2bf(s[0], s[33]), pk2bf(s[66], s[99]), pk2bf(s[132], s[165]), pk2bf(s[198], s[231])); }
}
struct MapPlain { __device__ __forceinline__ int srow(int k) const { return k; } __device__ __forceinline__ int scol(int n) const { return n; } __device__ __forceinline__ float scale(int) const { return 1.f; } };
struct MapWin { __device__ __forceinline__ int srow(int k) const { return k; } __device__ __forceinline__ int scol(int n) const { return n < NPROJ ? winmap(n) : -1; } __device__ __forceinline__ float scale(int) const { return 1.f; } };
struct MapWout { const float* an; const float* sn;
    __device__ __forceinline__ int srow(int k) const { return (k + 1024) & 2047; } __device__ __forceinline__ int scol(int n) const { return n; } __device__ __forceinline__ float scale(int k) const { return k < 1024 ? an[k] : sn[k - 1024]; } };
__device__ __forceinline__ void ph_prep(const Params& p, int wv, unsigned char* lds) {
    PH_IDS(); unsigned char* ws = p.ws;
    bf16* xb = (bf16*)(ws + OFF_XB);
    for (size_t i = gtid; i < (size_t)T * D / 8; i += gn) { const float4 v = ((const float4*)p.x)[2 * i], w = ((const float4*)p.x)[2 * i + 1]; ((uint4*)xb)[i] = make_uint4(pk2bf(v.x, v.y), pk2bf(v.z, v.w), pk2bf(w.x, w.y), pk2bf(w.z, w.w)); }
    {
        float* scr = (float*)(lds + wv * 8448);
        constexpr int I_WIN = 16 * 168, I_WOUT = 32 * 32, I_WQ = 16 * 64, I_W1 = 32 * 8, I_W2 = 4 * 2;
        constexpr int NIT = I_WIN + I_WOUT + I_WQ + 2 * I_W1 + 2 * I_W2;
        for (int it = gwave; it < NIT; it += nwaves) {
            int r = it;
            if (r < I_WIN) { transpose_item(p.w_in, NPROJ, (bf16*)(ws + OFF_WIN), 1024, r, 168, scr, lane, MapWin{}); continue; } r -= I_WIN;
            if (r < I_WOUT) { transpose_item(p.w_out, 1024, (bf16*)(ws + OFF_WOUT), 2048, r, 32, scr, lane, MapWout{p.attn_norm_w, p.ssd_norm_w}); continue; } r -= I_WOUT;
            if (r < I_WQ) { transpose_item(p.peer_wq, 2048, (bf16*)(ws + OFF_WQ), 1024, r, 64, scr, lane, MapPlain{}); continue; } r -= I_WQ;
            if (r < I_W1) { transpose_item(p.cmp_w1_k, 256, (bf16*)(ws + OFF_W1K), 2048, r, 8, scr, lane, MapPlain{}); continue; } r -= I_W1;
            if (r < I_W1) { transpose_item(p.cmp_w1_v, 256, (bf16*)(ws + OFF_W1V), 2048, r, 8, scr, lane, MapPlain{}); continue; } r -= I_W1;
            if (r < I_W2) { transpose_item(p.cmp_w2_k, 64, (bf16*)(ws + OFF_W2K), 256, r, 2, scr, lane, MapPlain{}); continue; } r -= I_W2;
            transpose_item(p.cmp_w2_v, 64, (bf16*)(ws + OFF_W2V), 256, r, 2, scr, lane, MapPlain{});
        }
    }
    bf16* keys = (bf16*)(ws + OFF_KEYS);
    for (int i = gtid; i < 8 * 2 * 128 * 128; i += gn) keys[i] = f2bf(p.peer_keys[i]);
    float* rc = (float*)(ws + OFF_ROPE); float* rs = rc + 4096 * 32;
    for (int i = gtid; i < 4096 * 32; i += gn) {
        const int pos = i >> 5, j = i & 31;
        const float inv = powf(10000.0f, -(float)(2 * j) / 64.0f); const float angf = (float)pos * inv;
        double xr = (double)angf * 0.15915494309189535; xr -= rint(xr); const double rr = xr * 6.283185307179586, r2 = rr * rr;
        double s = -1.0 / 10888869450418352160768000000.0, c = 1.0 / 403291461126605635584000000.0;
        s = s * r2 + 1.0 / 15511210043330985984000000.0;  c = c * r2 - 1.0 / 620448401733239439360000.0;
        s = s * r2 - 1.0 / 25852016738884976640000.0;     c = c * r2 + 1.0 / 1124000727777607680000.0;
        s = s * r2 + 1.0 / 51090942171709440000.0;        c = c * r2 - 1.0 / 2432902008176640000.0;
        s = s * r2 - 1.0 / 121645100408832000.0;          c = c * r2 + 1.0 / 6402373705728000.0;
        s = s * r2 + 1.0 / 355687428096000.0;             c = c * r2 - 1.0 / 20922789888000.0;
        s = s * r2 - 1.0 / 1307674368000.0;               c = c * r2 + 1.0 / 87178291200.0;
        s = s * r2 + 1.0 / 6227020800.0;                  c = c * r2 - 1.0 / 479001600.0;
        s = s * r2 - 1.0 / 39916800.0;                    c = c * r2 + 1.0 / 3628800.0;
        s = s * r2 + 1.0 / 362880.0;                      c = c * r2 - 1.0 / 40320.0;
        s = s * r2 - 1.0 / 5040.0;                        c = c * r2 + 1.0 / 720.0;
        s = s * r2 + 1.0 / 120.0;                         c = c * r2 - 1.0 / 24.0;
        s = s * r2 - 1.0 / 6.0;                           c = c * r2 + 0.5;
        s = s * r2 + 1.0;                                 c = c * r2 - 1.0;
        s = s * rr; c = -c;
        rc[i] = (float)c; rs[i] = (float)s;
    }
    float* b1p = (float*)(ws + OFF_HID);
    for (int o = gwave; o < 64; o += nwaves) {
        const int mat = o >> 5, kc = o & 31; const float* pos = mat ? p.cmp_pos_v : p.cmp_pos_k; const float* w1 = mat ? p.cmp_w1_v : p.cmp_w1_k;
        float4 acc = make_float4(0.f, 0.f, 0.f, 0.f);
#pragma unroll 8
        for (int k = kc * 64; k < kc * 64 + 64; ++k) { const float pk = pos[k]; const float4 w = *(const float4*)(w1 + (size_t)k * 256 + 4 * lane); acc.x += pk * w.x; acc.y += pk * w.y; acc.z += pk * w.z; acc.w += pk * w.w; }
        *(float4*)(b1p + (size_t)o * 256 + 4 * lane) = acc;
    }
}

__device__ __forceinline__ void unpack8(const uint4& w, float* f) { f[0] = __uint_as_float(w.x << 16); f[1] = __uint_as_float(w.x & 0xffff0000u); f[2] = __uint_as_float(w.y << 16); f[3] = __uint_as_float(w.y & 0xffff0000u);
    f[4] = __uint_as_float(w.z << 16); f[5] = __uint_as_float(w.z & 0xffff0000u); f[6] = __uint_as_float(w.w << 16); f[7] = __uint_as_float(w.w & 0xffff0000u); }
__device__ __forceinline__ uint4 pack8(const float* f) { return make_uint4(pk2bf(f[0], f[1]), pk2bf(f[2], f[3]), pk2bf(f[4], f[5]), pk2bf(f[6], f[7])); }
__device__ __forceinline__ void ph_tokprep(const Params& p, int wv) {
    PH_IDS(); unsigned char* ws = p.ws;
    const int gtid_ = (nb > 64 ? bid - 32 : bid) * NTHREADS + tid, gn_ = (nb > 64 ? nb - 32 : nb) * NTHREADS;
    const bf16* xbc = (const bf16*)(ws + OFF_XBC); bf16* xsbc = (bf16*)(ws + OFF_XSBC);
    for (int it = gtid_; it < (T / 16) * 192; it += gn_) {
        const int cg = it % 192, tg = it / 192, ch = cg * 8, t0 = tg * 16, l0 = t0 & (L - 1);
        float w[4][8], bias[8];
#pragma unroll
        for (int j = 0; j < 4; ++j) { const float4 a = *(const float4*)(p.conv_w + j * 1536 + ch), b2 = *(const float4*)(p.conv_w + j * 1536 + ch + 4); w[j][0] = a.x; w[j][1] = a.y; w[j][2] = a.z; w[j][3] = a.w; w[j][4] = b2.x; w[j][5] = b2.y; w[j][6] = b2.z; w[j][7] = b2.w; }
        { const float4 a = *(const float4*)(p.conv_b + ch), b2 = *(const float4*)(p.conv_b + ch + 4); bias[0] = a.x; bias[1] = a.y; bias[2] = a.z; bias[3] = a.w; bias[4] = b2.x; bias[5] = b2.y; bias[6] = b2.z; bias[7] = b2.w; }
        float x0[8], x1[8], x2[8], x3[8];
        { uint4 h0 = make_uint4(0u, 0u, 0u, 0u), h1 = h0, h2 = h0;
          if (l0 != 0) { h0 = *(const uint4*)(xbc + (size_t)(t0 - 3) * 1536 + ch); h1 = *(const uint4*)(xbc + (size_t)(t0 - 2) * 1536 + ch); h2 = *(const uint4*)(xbc + (size_t)(t0 - 1) * 1536 + ch); }
          unpack8(h0, x0); unpack8(h1, x1); unpack8(h2, x2); }
#pragma unroll
        for (int u = 0; u < 16; ++u) {
            unpack8(*(const uint4*)(xbc + (size_t)(t0 + u) * 1536 + ch), x3);
            float y[8];
#pragma unroll
            for (int i = 0; i < 8; ++i) { const float v = bias[i] + w[0][i] * x0[i] + w[1][i] * x1[i] + w[2][i] * x2[i] + w[3][i] * x3[i]; y[i] = v * sigmoidf(v); x0[i] = x1[i]; x1[i] = x2[i]; x2[i] = x3[i]; }
            *(uint4*)(xsbc + (size_t)(t0 + u) * 1536 + ch) = pack8(y);
        }
    }
    const bf16* dtg = (const bf16*)(ws + OFF_DTG); float* dt = (float*)(ws + OFF_DT); float* gate = (float*)(ws + OFF_GATE);
    for (int i = gtid_; i < T * 64; i += gn_) {
        const int t = i >> 6, c = i & 63; const float v = bf2f(dtg[i]);
        if (c < 16) { const float xx = v + p.dt_bias[c]; dt[t * 16 + c] = xx > 20.f ? xx : log1pf(__expf(xx)); }
        else gate[t * 48 + (c - 16)] = sigmoidf(v);
    }
    const float* rc = (const float*)(ws + OFF_ROPE); const float* rs = rc + 4096 * 32;
    bf16* q = (bf16*)(ws + OFF_Q); bf16* kvs = (bf16*)(ws + OFF_KVS);
    for (int it = gtid_; it < T * 24 * 4; it += gn_) {
        const int j0 = (it & 3) * 8, hh = (it >> 2) % 24, t = it / 96, l = t & (L - 1);
        bf16* pp; float sc;
        if (hh < 16) { pp = q + (size_t)t * 1024 + hh * 64 + j0; sc = 0.125f * 1.4426950408889634f; } else if (hh < 20) { pp = kvs + (size_t)t * 1536 + 512 + (hh - 16) * 64 + j0; sc = 1.f; } else { pp = kvs + (size_t)t * 1536 + 1024 + (hh - 20) * 64 + j0; sc = 1.f; }
        float x1[8], x2[8], c[8], s[8], o1[8], o2[8];
        unpack8(*(const uint4*)pp, x1); unpack8(*(const uint4*)(pp + 32), x2);
        { const float4 a = *(const float4*)(rc + l * 32 + j0), b2 = *(const float4*)(rc + l * 32 + j0 + 4), d = *(const float4*)(rs + l * 32 + j0), e = *(const float4*)(rs + l * 32 + j0 + 4);
          c[0] = a.x; c[1] = a.y; c[2] = a.z; c[3] = a.w; c[4] = b2.x; c[5] = b2.y; c[6] = b2.z; c[7] = b2.w; s[0] = d.x; s[1] = d.y; s[2] = d.z; s[3] = d.w; s[4] = e.x; s[5] = e.y; s[6] = e.z; s[7] = e.w; }
#pragma unroll
        for (int i = 0; i < 8; ++i) { o1[i] = (x1[i] * c[i] - x2[i] * s[i]) * sc; o2[i] = (x1[i] * s[i] + x2[i] * c[i]) * sc; }
        *(uint4*)pp = pack8(o1); *(uint4*)(pp + 32) = pack8(o2);
    }
}

__device__ __forceinline__ void ph_ssd_prep2(const Params& p, int wv, unsigned char* lds) {
    PH_IDS(); unsigned char* ws = p.ws;
    const bf16* xsbc = (const bf16*)(ws + OFF_XSBC); const float* dt = (const float*)(ws + OFF_DT);
    bf16* XdT = (bf16*)p.out; bf16* BT = (bf16*)(ws + OFF_BT); float* acsT = (float*)(ws + OFF_ACS);
    float* sdt = (float*)lds; float* swave = sdt + 128;
    const int bide = bid, nbe = nb;
    for (int unit = bide; unit < 2048 + 256; unit += nbe) {
        __syncthreads();
        if (unit < 2048) {
            const int h = unit & 15, bc = unit >> 4; const size_t t0 = (size_t)bc * 128;
            const float A = -__expf(p.a_log[h]);
            if (tid < 128) { const float dv = dt[(t0 + tid) * 16 + h]; sdt[tid] = dv; float a = dv * A;
#pragma unroll
                for (int o = 1; o < 64; o <<= 1) { const float v = __shfl_up(a, o); if (lane >= o) a += v; }
                if (lane == 63) swave[tid >> 6] = a;
                sdt[128 + 8 + tid] = a; }
            __syncthreads();
            if (tid < 128) { float a = sdt[128 + 8 + tid]; if (tid >= 64) a += swave[0]; acsT[(size_t)unit * 128 + tid] = a; }
            const int pp = tid & 63, lg = tid >> 6; const bf16* src = xsbc + (t0 + lg * 16) * 1536 + h * 64 + pp;
            unsigned w[8];
#pragma unroll
            for (int i = 0; i < 8; ++i) { const float v0 = bf2f(src[(size_t)(2 * i) * 1536]) * sdt[lg * 16 + 2 * i], v1 = bf2f(src[(size_t)(2 * i + 1) * 1536]) * sdt[lg * 16 + 2 * i + 1]; w[i] = (unsigned)f2bf(v0) | ((unsigned)f2bf(v1) << 16); }
            uint4* dst = (uint4*)(XdT + (size_t)unit * 8192 + pp * 128 + lg * 16);
            dst[0] = make_uint4(w[0], w[1], w[2], w[3]); dst[1] = make_uint4(w[4], w[5], w[6], w[7]);
        } else {
            const int u2 = unit - 2048, g = u2 & 1, bc = u2 >> 1; const size_t t0 = (size_t)bc * 128;
            const int n = tid & 127, lg = tid >> 7; const bf16* src = xsbc + (t0 + lg * 32) * 1536 + 1024 + g * 128 + n;
            uint4* dst = (uint4*)(BT + (size_t)u2 * 16384 + n * 128 + lg * 32);
#pragma unroll
            for (int k = 0; k < 4; ++k) { unsigned w[4];
#pragma unroll
                for (int i = 0; i < 4; ++i) w[i] = (unsigned)src[(size_t)(8 * k + 2 * i) * 1536] | ((unsigned)src[(size_t)(8 * k + 2 * i + 1) * 1536] << 16);
                dst[k] = make_uint4(w[0], w[1], w[2], w[3]); }
        }
    }
}
__device__ __forceinline__ void ph_ssd_states(const Params& p, int wv) {
    PH_IDS(); unsigned char* ws = p.ws; const int rr = lane & 31, hi = lane >> 5;
    const bf16* XdT = (const bf16*)p.out; bf16* S = (bf16*)((unsigned char*)p.out + 32 * MiB); const bf16* BT = (const bf16*)(ws + OFF_BT); const float* acsT = (const float*)(ws + OFF_ACS);
    for (int unit = gwave; unit < 2048; unit += nwaves) {
        const int h = unit & 15, bc = unit >> 4, g = h >> 3;
        const float* ac = acsT + (size_t)unit * 128; const float alast = ac[127];
        const bf16* xrow = XdT + (size_t)unit * 8192 + rr * 128 + 8 * hi; const bf16* bt = BT + (size_t)(bc * 2 + g) * 16384 + rr * 128 + 8 * hi;
        f32x16 acc[4][2];
#pragma unroll
        for (int nt = 0; nt < 4; ++nt)
#pragma unroll
            for (int pt = 0; pt < 2; ++pt)
#pragma unroll
                for (int e = 0; e < 16; ++e) acc[nt][pt][e] = 0.f;
#pragma unroll 2
        for (int ks = 0; ks < 8; ++ks) {
            const int l0 = ks * 16 + 8 * hi; float dec[8];
            { const f32x4 a0 = *(const f32x4*)(ac + l0), a1 = *(const f32x4*)(ac + l0 + 4);
#pragma unroll
              for (int jx = 0; jx < 8; ++jx) dec[jx] = __expf(alast - (jx < 4 ? a0[jx] : a1[jx - 4])); }
            bf16x8 xf[2];
#pragma unroll
            for (int pt = 0; pt < 2; ++pt) { float f[8]; unpack8(*(const uint4*)(xrow + (size_t)pt * 4096 + ks * 16), f);
#pragma unroll
                for (int jx = 0; jx < 8; ++jx) f[jx] *= dec[jx];
                union { uint4 u; bf16x8 v; } cvu; cvu.u = pack8(f); xf[pt] = cvu.v; }
#pragma unroll
            for (int nt = 0; nt < 4; ++nt) { const bf16x8 bf_ = *(const bf16x8*)(bt + (size_t)nt * 4096 + ks * 16);
#pragma unroll
                for (int pt = 0; pt < 2; ++pt) acc[nt][pt] = __builtin_amdgcn_mfma_f32_32x32x16_bf16(bf_, xf[pt], acc[nt][pt], 0, 0, 0); }
        }
#pragma unroll
        for (int pt = 0; pt < 2; ++pt) { bf16* so = S + (size_t)unit * 8192 + (pt * 32 + rr) * 128 + 4 * hi;
#pragma unroll
            for (int nt = 0; nt < 4; ++nt)
#pragma unroll
                for (int a = 0; a < 4; ++a) *(uint2*)(so + nt * 32 + 8 * a) = make_uint2(pk2bf(acc[nt][pt][4 * a], acc[nt][pt][4 * a + 1]), pk2bf(acc[nt][pt][4 * a + 2], acc[nt][pt][4 * a + 3])); }
    }
}
__device__ __forceinline__ void ph_ssd_scan(const Params& p, int wv) {
    PH_IDS();
    unsigned* S = (unsigned*)((unsigned char*)p.out + 32 * MiB); const float* acsT = (const float*)(p.ws + OFF_ACS);
    for (int e = gtid; e < NBATCH * 16 * 4096; e += gn) {
        const int pn = e & 4095, h = (e >> 12) & 15, b = e >> 16; float r0 = 0.f, r1 = 0.f;
        for (int c = 0; c < 32; c += 4) {
            unsigned v[4]; float d[4];
#pragma unroll
            for (int u = 0; u < 4; ++u) { const int unit = (b * 32 + c + u) * 16 + h; v[u] = S[(size_t)unit * 4096 + pn]; d[u] = __expf(acsT[(size_t)unit * 128 + 127]); }
#pragma unroll
            for (int u = 0; u < 4; ++u) { const int unit = (b * 32 + c + u) * 16 + h; S[(size_t)unit * 4096 + pn] = (unsigned)f2bf(r0) | ((unsigned)f2bf(r1) << 16);
                r0 = r0 * d[u] + bf2f((bf16)(v[u] & 0xffffu)); r1 = r1 * d[u] + bf2f((bf16)(v[u] >> 16)); }
        }
    }
}
constexpr int SO_CBROW = 136;
__device__ __forceinline__ void ph_ssd_out(const Params& p, int wv, unsigned char* lds) {
    PH_IDS(); unsigned char* ws = p.ws; const int rr = lane & 31, hi = lane >> 5;
    const bf16* XdT = (const bf16*)p.out; const bf16* S = (const bf16*)((unsigned char*)p.out + 32 * MiB); const bf16* xsbc = (const bf16*)(ws + OFF_XSBC);
    const float* acsT = (const float*)(ws + OFF_ACS); bf16* z = (bf16*)(ws + OFF_Z); float* ssq2p = (float*)(ws + OFF_HID);
    bf16* CBl = (bf16*)lds;
    for (int unit = bid; unit < 256; unit += nb) {
        const int g = unit & 1, bc = unit >> 1; const size_t t0 = (size_t)bc * 128;
        __syncthreads();
        for (int ti = wv; ti < 10; ti += NWAVES) {
            int lt = 0, st = ti; if (st > 0) { st -= 1; lt = 1; if (st > 1) { st -= 2; lt = 2; if (st > 2) { st -= 3; lt = 3; } } }
            f32x16 acc;
#pragma unroll
            for (int e = 0; e < 16; ++e) acc[e] = 0.f;
            const bf16* arow = xsbc + (t0 + st * 32 + rr) * 1536 + 1024 + g * 128 + 8 * hi; const bf16* brow = xsbc + (t0 + lt * 32 + rr) * 1536 + 1280 + g * 128 + 8 * hi;
#pragma unroll
            for (int ks = 0; ks < 8; ++ks) acc = __builtin_amdgcn_mfma_f32_32x32x16_bf16(*(const bf16x8*)(arow + ks * 16), *(const bf16x8*)(brow + ks * 16), acc, 0, 0, 0);
            bf16* dst = CBl + (lt * 32 + rr) * SO_CBROW + st * 32 + 4 * hi;
#pragma unroll
            for (int a = 0; a < 4; ++a) *(uint2*)(dst + 8 * a) = make_uint2(pk2bf(acc[4 * a], acc[4 * a + 1]), pk2bf(acc[4 * a + 2], acc[4 * a + 3]));
        }
        __syncthreads();
        const int h = g * 8 + wv, uh = bc * 16 + h; const float* ac = acsT + (size_t)uh * 128; const float Dh = p.d_skip[h];
        const bf16* xd = XdT + (size_t)uh * 8192 + rr * 128 + 8 * hi; const bf16* sin = S + (size_t)uh * 8192 + rr * 128 + 8 * hi;
        f32x16 acc[2][4];
#pragma unroll
        for (int pt = 0; pt < 2; ++pt)
#pragma unroll
            for (int lt = 0; lt < 4; ++lt)
#pragma unroll
                for (int e = 0; e < 16; ++e) acc[pt][lt][e] = 0.f;
#pragma unroll
        for (int lt = 0; lt < 4; ++lt) {
            const int l = lt * 32 + rr; const float acl = ac[l]; const float eal = __expf(acl);
#pragma unroll
            for (int ks = 0; ks < 2 * lt + 2; ++ks) {
                const int s0 = ks * 16 + 8 * hi; float cb[8]; unpack8(*(const uint4*)(CBl + l * SO_CBROW + s0), cb);
                const f32x4 a0 = *(const f32x4*)(ac + s0), a1 = *(const f32x4*)(ac + s0 + 4);
#pragma unroll
                for (int jx = 0; jx < 8; ++jx) { const float as = jx < 4 ? a0[jx] : a1[jx - 4]; cb[jx] = (s0 + jx <= l) ? cb[jx] * __expf(acl - as) : 0.f; }
                union { uint4 u; bf16x8 v; } mf; mf.u = pack8(cb);
#pragma unroll
                for (int pt = 0; pt < 2; ++pt) acc[pt][lt] = __builtin_amdgcn_mfma_f32_32x32x16_bf16(*(const bf16x8*)(xd + (size_t)pt * 4096 + ks * 16), mf.v, acc[pt][lt], 0, 0, 0);
            }
            const bf16* crow_ = xsbc + (t0 + l) * 1536 + 1280 + g * 128 + 8 * hi;
#pragma unroll
            for (int ks = 0; ks < 8; ++ks) {
                float cf[8]; unpack8(*(const uint4*)(crow_ + ks * 16), cf);
#pragma unroll
                for (int jx = 0; jx < 8; ++jx) cf[jx] *= eal;
                union { uint4 u; bf16x8 v; } bf_; bf_.u = pack8(cf);
#pragma unroll
                for (int pt = 0; pt < 2; ++pt) acc[pt][lt] = __builtin_amdgcn_mfma_f32_32x32x16_bf16(*(const bf16x8*)(sin + (size_t)pt * 4096 + ks * 16), bf_.v, acc[pt][lt], 0, 0, 0);
            }
            const size_t t = t0 + l; float ss = 0.f;
#pragma unroll
            for (int pt = 0; pt < 2; ++pt)
#pragma unroll
                for (int a = 0; a < 4; ++a) {
                    const int col = h * 64 + pt * 32 + 8 * a + 4 * hi;
                    const uint2 xw = *(const uint2*)(xsbc + t * 1536 + col), zw = *(const uint2*)(z + t * 1024 + col);
                    const float xs0 = bflo(xw.x), xs1 = bfhi(xw.x), xs2 = bflo(xw.y), xs3 = bfhi(xw.y), z0 = bflo(zw.x), z1 = bfhi(zw.x), z2 = bflo(zw.y), z3 = bfhi(zw.y);
                    const float v0 = (acc[pt][lt][4 * a] + Dh * xs0) * (z0 * sigmoidf(z0)), v1 = (acc[pt][lt][4 * a + 1] + Dh * xs1) * (z1 * sigmoidf(z1));
                    const float v2 = (acc[pt][lt][4 * a + 2] + Dh * xs2) * (z2 * sigmoidf(z2)), v3 = (acc[pt][lt][4 * a + 3] + Dh * xs3) * (z3 * sigmoidf(z3));
                    ss += (v0 * v0 + v1 * v1) + (v2 * v2 + v3 * v3);
                    *(uint2*)(z + t * 1024 + col) = make_uint2(pk2bf(v0, v1), pk2bf(v2, v3));
                }
            ss += __shfl_xor(ss, 32);
            if (hi == 0) ssq2p[t * 16 + h] = ss;
        }
    }
}

struct EpiKc {
    bf16* dst; bool tr; __device__ __forceinline__ void operator()(int m, int c, float v) const { const int hk = m & 3, n = (m >> 2) & 255, b = m >> 10; const bf16 o = (n == 255) ? (bf16)0 : f2bf(v);
        if (tr) dst[((size_t)(b * 4 + hk) * 64 + c) * 256 + ((n & ~12) | ((n & 4) << 1) | ((n & 8) >> 1))] = o; else dst[((size_t)(b * 4 + hk) * 256 + n) * 64 + c] = o; } };
__device__ __forceinline__ void ph_kc_rope(const Params& p, int wv) {
    PH_IDS(); unsigned char* ws = p.ws; bf16* kc = (bf16*)(ws + OFF_KC); const float* rc = (const float*)(ws + OFF_ROPE); const float* rs = rc + 4096 * 32;
    for (int i = gtid; i < 16 * 256 * 32; i += gn) {
        const int j = i & 31, n = (i >> 5) & 255, bh = i >> 13; const int pos = 16 * n + 31; if (n == 255) continue;
        const float c = rc[pos * 32 + j], s = rs[pos * 32 + j];
        bf16* pp = kc + ((size_t)bh * 256 + n) * 64 + j; const float x1 = bf2f(pp[0]), x2 = bf2f(pp[32]);
        pp[0] = f2bf(x1 * c - x2 * s); pp[32] = f2bf(x1 * s + x2 * c);
    }
}


__device__ __forceinline__ void ph_vt_prep(const Params& p, int wv) {
    PH_IDS(); unsigned char* ws = p.ws; const bf16* kvs = (const bf16*)(ws + OFF_KVS);
    const int bide = bid, nbe = nb;
    for (int unit = bide; unit < 2 * 16 * 64; unit += nbe) {
        const int br = unit & 1, tl = (unit >> 1) & 63, bh = unit >> 7, b = bh >> 2, hk = bh & 3;
        const int d = tid & 63, grp = tid >> 6; const int l0 = tl * 64 + grp * 8;
        const bf16* src = kvs + ((size_t)b * L + l0) * 1536 + (br ? 1280 : 768) + hk * 64 + d;
        unsigned w[4];
#pragma unroll
        for (int i = 0; i < 4; ++i) w[i] = (unsigned)src[(size_t)(2 * i) * 1536] | ((unsigned)src[(size_t)(2 * i + 1) * 1536] << 16);
        bf16* dst = (bf16*)(ws + (br ? OFF_VWT : OFF_VST)) + ((size_t)bh * 64 + d) * L + (l0 & ~15) + 4 * ((l0 >> 3) & 1);
        *(uint2*)dst = make_uint2(w[0], w[1]); *(uint2*)(dst + 8) = make_uint2(w[2], w[3]);
    }
}

__device__ __forceinline__ float max3f(float a, float b, float c) { float r; asm("v_max3_f32 %0, %1, %2, %3" : "=v"(r) : "v"(a), "v"(b), "v"(c)); return r; }
__device__ __forceinline__ int crow(int r, int hi) { return (r & 3) + 8 * (r >> 2) + 4 * hi; }
constexpr int NSA_KBUF = 8192, NSA_VBUF = 8192;
constexpr int NSA_OFF_K = 0, NSA_OFF_V = 4 * NSA_KBUF;
constexpr int NSA_OFF_STASH = 73728;
constexpr int NSA_OFF_IMPA = NSA_OFF_STASH, NSA_IMPS = 65, NSA_OFF_IMPB = NSA_OFF_IMPA + 64 * NSA_IMPS * 4;
constexpr int NSA_OFF_SEL = NSA_OFF_STASH + 65536;
static_assert(NSA_OFF_V + 4 * NSA_VBUF <= NSA_OFF_STASH && NSA_OFF_IMPB + 64 * NSA_IMPS * 4 <= NSA_OFF_SEL && NSA_OFF_SEL + 1024 <= LDS_BYTES - 64, "NSA LDS map");
struct NsaSrc { const bf16* K; size_t kstride; const bf16* VT; size_t ldv; };
__device__ __forceinline__ void nsa_dma(const bf16* kp, const bf16* vp, unsigned char* kb, unsigned char* vb) {
    __builtin_amdgcn_global_load_lds((const unsigned*)kp, (PG8_LAS unsigned*)kb, 16, 0, 0);
    __builtin_amdgcn_global_load_lds((const unsigned*)vp, (PG8_LAS unsigned*)vb, 16, 0, 0);
}
__device__ __forceinline__ void nsa_qk(const unsigned char* kb, const bf16x8 (&qf)[4], int fo0, f32x16& p0, f32x16& p1) {
#pragma unroll
    for (int i = 0; i < 16; ++i) { p0[i] = 0.f; p1[i] = 0.f; }
    __builtin_amdgcn_s_setprio(1);
#pragma unroll
    for (int ds = 0; ds < 4; ++ds) {
        const bf16x8 a0 = *(const bf16x8*)(kb + (fo0 ^ (32 * ds))), a1 = *(const bf16x8*)(kb + (fo0 ^ (32 * ds)) + 4096);
        p0 = __builtin_amdgcn_mfma_f32_32x32x16_bf16(a0, qf[ds], p0, 0, 0, 0); p1 = __builtin_amdgcn_mfma_f32_32x32x16_bf16(a1, qf[ds], p1, 0, 0, 0);
    }
    __builtin_amdgcn_s_setprio(0);
}
__device__ __forceinline__ void nsa_pv(const unsigned char* vb, int fo0, const f32x16& p0, const f32x16& p1, f32x16 (&O)[2]) {
    __builtin_amdgcn_s_setprio(1);
#pragma unroll
    for (int s = 0; s < 4; ++s) {
        const int eb = 8 * (s & 1), kbase = 32 * (s >> 1) + 16 * (s & 1);
        union { uint4 u; bf16x8 v; } pf;
        if (s < 2) pf.u = make_uint4(pk2bf(p0[eb], p0[eb + 1]), pk2bf(p0[eb + 2], p0[eb + 3]), pk2bf(p0[eb + 4], p0[eb + 5]), pk2bf(p0[eb + 6], p0[eb + 7]));
        else       pf.u = make_uint4(pk2bf(p1[eb], p1[eb + 1]), pk2bf(p1[eb + 2], p1[eb + 3]), pk2bf(p1[eb + 4], p1[eb + 5]), pk2bf(p1[eb + 6], p1[eb + 7]));
#pragma unroll
        for (int dsub = 0; dsub < 2; ++dsub) {
            const bf16x8 vfv = *(const bf16x8*)(vb + (fo0 ^ (32 * s)) + dsub * 4096);
            O[dsub] = __builtin_amdgcn_mfma_f32_32x32x16_bf16(vfv, pf.v, O[dsub], 0, 0, 0);
        }
    }
    __builtin_amdgcn_s_setprio(0);
}
template <int MODE>
__device__ __forceinline__ void nsa_tile(unsigned char* lds, const unsigned char* kb, const unsigned char* vb, int jt, int rr, int hi, int fo0, const bf16x8 (&qf)[4], int lpos, int qi, int tokblk,
                                         u64 selm, float& m, float& lsum, float inv_l, f32x16 (&O)[2]) {
    float* impA = (float*)(lds + NSA_OFF_IMPA); float* impB = (float*)(lds + NSA_OFF_IMPB);
    f32x16 p0, p1; nsa_qk(kb, qf, fo0, p0, p1);
    asm volatile("s_nop 15\n\ts_nop 7" : "+v"(p0), "+v"(p1));
    const int k0 = jt * 64;
    const bool tile_on = (MODE != 2) || ((selm >> jt) & 1ull);
    bool full;
    if (MODE <= 1) full = (16 * (k0 + 63) + 31 <= qi * 64); else if (MODE == 2) full = (jt < qi); else full = (jt > qi - 8) && (jt < qi);
    float mx = NEG_INF, mx2 = NEG_INF;
    if (full) {
#pragma unroll
        for (int e = 0; e < 16; e += 2) { mx = max3f(mx, p0[e], p1[e]); mx2 = max3f(mx2, p0[e + 1], p1[e + 1]); }
        if (MODE == 2 && !tile_on) { mx = NEG_INF; mx2 = NEG_INF; }
    } else {
        const int lim = (MODE <= 1) ? (lpos - 31 - 16 * k0 - 64 * hi) : (lpos - k0 - 4 * hi);
#pragma unroll
        for (int e = 0; e < 16; ++e) {
            const int ca = (e & 3) + 8 * (e >> 2), cb = ca + 32; bool oa, ob;
            if (MODE <= 1) { oa = (16 * ca <= lim); ob = (16 * cb <= lim); }
            else if (MODE == 2) { oa = (ca <= lim); ob = (cb <= lim); }
            else { oa = (ca <= lim) && (ca > lim - 512); ob = (cb <= lim) && (cb > lim - 512); }
            p0[e] = oa ? p0[e] : NEG_INF; p1[e] = ob ? p1[e] : NEG_INF; if (e & 1) mx2 = max3f(mx2, p0[e], p1[e]); else mx = max3f(mx, p0[e], p1[e]);
        }
    }
    if (MODE != 1) {
        mx = max3f(mx, mx2, NEG_INF); mx = max3f(mx, __shfl_xor(mx, 32), NEG_INF);
        const float mnew = fmaxf(m, mx);
        if (__any((mnew - m) > 6.0f)) {
            const float alpha = __builtin_amdgcn_exp2f(m - mnew); m = mnew; lsum *= alpha;
            if (MODE != 0) {
#pragma unroll
                for (int e = 0; e < 16; ++e) { O[0][e] *= alpha; O[1][e] *= alpha; }
            }
        }
        const float meff = (MODE == 2 && full && !tile_on) ? BIG : ((m > 0.5f * NEG_INF) ? m : BIG);
        float rs = 0.f;
#pragma unroll
        for (int e = 0; e < 16; ++e) { p0[e] = __builtin_amdgcn_exp2f(p0[e] - meff); p1[e] = __builtin_amdgcn_exp2f(p1[e] - meff); rs += p0[e] + p1[e]; }
        lsum += rs;
        if (MODE != 0) nsa_pv(vb, fo0, p0, p1, O);
    } else {
#pragma unroll
        for (int e = 0; e < 16; ++e) { p0[e] = __builtin_amdgcn_exp2f(p0[e] - m) * inv_l; p1[e] = __builtin_amdgcn_exp2f(p1[e] - m) * inv_l; }
        nsa_pv(vb, fo0, p0, p1, O);
#pragma unroll
        for (int sub = 0; sub < 2; ++sub)
#pragma unroll
            for (int a = 0; a < 4; ++a) {
                float G, last;
                if (sub == 0) { G = (p0[4 * a] + p0[4 * a + 1]) + (p0[4 * a + 2] + p0[4 * a + 3]); last = p0[4 * a + 3]; } else { G = (p1[4 * a] + p1[4 * a + 1]) + (p1[4 * a + 2] + p1[4 * a + 3]); last = p1[4 * a + 3]; }
                G += __shfl_xor(G, 1); G += __shfl_xor(G, 2); last += __shfl_xor(last, 1); last += __shfl_xor(last, 2);
                const int jj = (k0 >> 2) + 8 * sub + 2 * a + hi;
                if ((rr & 3) == 0) { impA[tokblk * NSA_IMPS + jj] = G; if (jj + 1 < 64) impB[tokblk * NSA_IMPS + jj + 1] = last; }
            }
    }
}
template <int MODE>
__device__ __forceinline__ void nsa_branch(unsigned char* lds, const NsaSrc& src, int jt0, int jt1, int wv, int lane, int rr, int hi, const bf16x8 (&qf)[4], int lpos, int qi, int tokblk,
                                           u64 selm, u64 wsel, float& m, float& lsum, float inv_l, f32x16 (&O)[2]) {
    if (jt0 >= jt1) return;
    asm volatile("" : "+v"(lane), "+v"(rr));
    const int srow = wv * 8 + (lane >> 3), sch = ((lane & 7) ^ ((srow >> 1) & 7)) * 8;
    const bf16* kp = src.K + (size_t)srow * src.kstride + sch + (size_t)(jt0 * 64) * src.kstride;
    const bf16* vp = src.VT + (size_t)srow * src.ldv + sch + jt0 * 64;
    const size_t kstep = 64 * src.kstride;
    const int fo0 = rr * 128 + ((hi ^ ((rr >> 1) & 7)) << 4);
    unsigned char* lw = lds + wv * 1024;
    nsa_dma(kp, vp, lw + NSA_OFF_K, lw + NSA_OFF_V);
    if (jt0 + 1 < jt1) nsa_dma(kp + kstep, vp + 64, lw + NSA_OFF_K + NSA_KBUF, lw + NSA_OFF_V + NSA_VBUF);
    kp += 2 * kstep; vp += 128;
    asm volatile("s_waitcnt vmcnt(0)" ::: "memory");
    __syncthreads();
    int par = 0;
    for (int jt = jt0; jt < jt1; jt += 2, par ^= 1) {
        const bool hasB = (jt + 1 < jt1), more = (jt + 2 < jt1), moreB = (jt + 3 < jt1);
        if (more) nsa_dma(kp, vp, lw + NSA_OFF_K + ((par ^ 1) * 2) * NSA_KBUF, lw + NSA_OFF_V + ((par ^ 1) * 2) * NSA_VBUF);
        if (moreB) nsa_dma(kp + kstep, vp + 64, lw + NSA_OFF_K + ((par ^ 1) * 2 + 1) * NSA_KBUF, lw + NSA_OFF_V + ((par ^ 1) * 2 + 1) * NSA_VBUF);
        kp += 2 * kstep; vp += 128;
        const unsigned char* kb = lds + NSA_OFF_K + (par * 2) * NSA_KBUF; const unsigned char* vb = lds + NSA_OFF_V + (par * 2) * NSA_VBUF;
        if ((MODE != 2) || ((wsel >> jt) & 1ull)) nsa_tile<MODE>(lds, kb, vb, jt, rr, hi, fo0, qf, lpos, qi, tokblk, selm, m, lsum, inv_l, O);
        if (hasB && ((MODE != 2) || ((wsel >> (jt + 1)) & 1ull))) nsa_tile<MODE>(lds, kb + NSA_KBUF, vb + NSA_VBUF, jt + 1, rr, hi, fo0, qf, lpos, qi, tokblk, selm, m, lsum, inv_l, O);
        asm volatile("s_waitcnt vmcnt(0)" ::: "memory");
        __syncthreads();
    }
}
__device__ __forceinline__ void ph_nsa(const Params& p, int wv, unsigned char* lds) {
    PH_IDS(); unsigned char* ws = p.ws; const int wave = wv, rr = lane & 31, hi = lane >> 5;
    bf16* q = (bf16*)(ws + OFF_Q); const bf16* kvs = (const bf16*)(ws + OFF_KVS);
    const float* gate = (const float*)(ws + OFF_GATE); float* ssq = (float*)(ws + OFF_SSQ);
    float* impA = (float*)(lds + NSA_OFF_IMPA); float* impB = (float*)(lds + NSA_OFF_IMPB); u64* selw = (u64*)(lds + NSA_OFF_SEL);
    unsigned* qctr = (unsigned*)(ws + OFF_BAR + 14336) + 64 * (bid & 7); volatile int* ucur = (volatile int*)(lds + NSA_OFF_SEL + 512);
    for (;;) {
        if (tid == 0) *ucur = (int)__hip_atomic_fetch_add(qctr, 1u, __ATOMIC_RELAXED, __HIP_MEMORY_SCOPE_AGENT);
        __syncthreads();
        const int u = *ucur;
        if (u >= 128) break;
        const int bh = (bid & 7) + 8 * (u & 1), qi = 63 - (u >> 1);
        const int b = bh >> 2, hk = bh & 3; const int tokblk = wave * 8 + (rr >> 2), g = rr & 3; const int lpos = qi * 64 + tokblk; const size_t t = (size_t)b * L + lpos;
        bf16* qrow = q + t * 1024 + (hk * 4 + g) * 64;
        bf16x8 qf[4];
#pragma unroll
        for (int ds = 0; ds < 4; ++ds) qf[ds] = *(const bf16x8*)(qrow + ds * 16 + hi * 8);
        for (int i = tid; i < 64 * NSA_IMPS; i += NTHREADS) { impA[i] = 0.f; impB[i] = 0.f; }
        __syncthreads();
        f32x16 O[2]; float* stash = (float*)(lds + NSA_OFF_STASH) + tid;
        const float g0 = gate[t * 48 + (hk * 4 + g) * 3 + 0], g1 = gate[t * 48 + (hk * 4 + g) * 3 + 1], g2 = gate[t * 48 + (hk * 4 + g) * 3 + 2];
        {
            NsaSrc s{(const bf16*)(ws + OFF_KC) + (size_t)bh * 256 * 64, 64, (const bf16*)(ws + OFF_VCT) + (size_t)bh * 64 * 256, 256};
            const int nct = (4 * qi + 3 + 63) >> 6;
            float m = NEG_INF, lsum = 0.f;
            nsa_branch<0>(lds, s, 0, nct, wv, lane, rr, hi, qf, lpos, qi, tokblk, 0ull, 0ull, m, lsum, 0.f, O);
            lsum += __shfl_xor(lsum, 32);
            const float inv_l = lsum > 0.f ? 1.0f / lsum : 0.f;
#pragma unroll
            for (int e = 0; e < 16; ++e) { O[0][e] = 0.f; O[1][e] = 0.f; }
            nsa_branch<1>(lds, s, 0, nct, wv, lane, rr, hi, qf, lpos, qi, tokblk, 0ull, 0ull, m, lsum, inv_l, O);
        }
        f32x16 Oc[2];
#pragma unroll
        for (int e = 0; e < 16; ++e) { Oc[0][e] = g0 * O[0][e]; Oc[1][e] = g0 * O[1][e]; }
        {
            const int tk = tid >> 3, jg = tid & 7; float v[8];
#pragma unroll
            for (int i = 0; i < 8; ++i) { const int j = jg * 8 + i; const float raw = impA[tk * NSA_IMPS + j] + impB[tk * NSA_IMPS + j];
                const bool causal = (j <= qi), forced = (j == 0) || (j == qi) || (j == qi - 1); v[i] = causal ? (forced ? BIG : raw) : NEG_INF; }
            __syncthreads();
#pragma unroll
            for (int i = 0; i < 8; ++i) impA[tk * NSA_IMPS + jg * 8 + i] = v[i];
            __syncthreads();
            int rank[8];
#pragma unroll
            for (int i = 0; i < 8; ++i) rank[i] = 0;
            for (int jj = 0; jj < 64; ++jj) { const float x = impA[tk * NSA_IMPS + jj];
#pragma unroll
                for (int i = 0; i < 8; ++i) rank[i] += (x > v[i] || (x == v[i] && jj < jg * 8 + i)) ? 1 : 0; }
            unsigned b8 = 0u;
#pragma unroll
            for (int i = 0; i < 8; ++i) b8 |= (rank[i] < 16 && jg * 8 + i <= qi) ? (1u << i) : 0u;
            const u64 full = (u64)b8 << (jg * 8); unsigned blo = (unsigned)full, bhi = (unsigned)(full >> 32);
            blo |= __shfl_xor(blo, 1); bhi |= __shfl_xor(bhi, 1); blo |= __shfl_xor(blo, 2); bhi |= __shfl_xor(bhi, 2); blo |= __shfl_xor(blo, 4); bhi |= __shfl_xor(bhi, 4);
            if (jg == 0) selw[tk] = (u64)blo | ((u64)bhi << 32);
            __syncthreads();
        }
        const u64 selm = selw[tokblk];
        __syncthreads();
#pragma unroll
        for (int e = 0; e < 16; ++e) { stash[e * 512] = Oc[0][e]; stash[(16 + e) * 512] = Oc[1][e]; }
        u64 wsel = selm;
        { unsigned lo = (unsigned)wsel, h2 = (unsigned)(wsel >> 32);
          lo |= __shfl_xor(lo, 4); h2 |= __shfl_xor(h2, 4); lo |= __shfl_xor(lo, 8); h2 |= __shfl_xor(h2, 8); lo |= __shfl_xor(lo, 16); h2 |= __shfl_xor(h2, 16);
          wsel = (u64)lo | ((u64)h2 << 32); }
        {
            NsaSrc s{kvs + (size_t)b * L * 1536 + 512 + hk * 64, 1536, (const bf16*)(ws + OFF_VST) + (size_t)bh * 64 * L, (size_t)L};
            float m = NEG_INF, lsum = 0.f;
#pragma unroll
            for (int e = 0; e < 16; ++e) { O[0][e] = 0.f; O[1][e] = 0.f; }
            nsa_branch<2>(lds, s, 0, qi + 1, wv, lane, rr, hi, qf, lpos, qi, tokblk, selm, wsel, m, lsum, 0.f, O);
            lsum += __shfl_xor(lsum, 32); const float sc = g1 / lsum;
#pragma unroll
            for (int e = 0; e < 16; ++e) { stash[e * 512] += sc * O[0][e]; stash[(16 + e) * 512] += sc * O[1][e]; }
        }
        {
            NsaSrc s{kvs + (size_t)b * L * 1536 + 1024 + hk * 64, 1536, (const bf16*)(ws + OFF_VWT) + (size_t)bh * 64 * L, (size_t)L};
            float m = NEG_INF, lsum = 0.f;
#pragma unroll
            for (int e = 0; e < 16; ++e) { O[0][e] = 0.f; O[1][e] = 0.f; }
            nsa_branch<3>(lds, s, qi >= 8 ? qi - 8 : 0, qi + 1, wv, lane, rr, hi, qf, lpos, qi, tokblk, 0ull, 0ull, m, lsum, 0.f, O);
            lsum += __shfl_xor(lsum, 32); const float sc = g2 / lsum;
#pragma unroll
            for (int e = 0; e < 16; ++e) { O[0][e] = stash[e * 512] + sc * O[0][e]; O[1][e] = stash[(16 + e) * 512] + sc * O[1][e]; }
        }
        float ss = 0.f;
#pragma unroll
        for (int dsub = 0; dsub < 2; ++dsub)
#pragma unroll
            for (int a = 0; a < 4; ++a) {
                const float v0 = O[dsub][4 * a], v1 = O[dsub][4 * a + 1], v2 = O[dsub][4 * a + 2], v3 = O[dsub][4 * a + 3];
                ss += (v0 * v0 + v1 * v1) + (v2 * v2 + v3 * v3);
                *(uint2*)(qrow + dsub * 32 + 8 * a + 4 * hi) = make_uint2(pk2bf(v0, v1), pk2bf(v2, v3));
            }
        ss += __shfl_xor(ss, 32); ss += __shfl_xor(ss, 1); ss += __shfl_xor(ss, 2);
        if (hi == 0 && g == 0) ssq[t * 4 + hk] = ss;
        __syncthreads();
    }
}

constexpr size_t OFF_SU = 640 * 1024, OFF_SV = 704 * 1024, OFF_SX = 768 * 1024, OFF_SC = 832 * 1024;
constexpr size_t OFF_COEFQ = 218 * MiB, OFF_H1Q = 220 * MiB;
__device__ __forceinline__ unsigned pack4i8(float a, float b, float c, float d) {
    const int ia = (int)rintf(a), ib = (int)rintf(b), ic = (int)rintf(c), id = (int)rintf(d);
    return (unsigned)(ia & 0xff) | ((unsigned)(ib & 0xff) << 8) | ((unsigned)(ic & 0xff) << 16) | ((unsigned)(id & 0xff) << 24);
}
__device__ __forceinline__ void ph_ln1(const Params& p, int wv) {
    PH_IDS(); unsigned char* ws = p.ws; bf16* h1b = (bf16*)(ws + OFF_H1B); unsigned char* h1q = ws + OFF_H1Q; float* sx = (float*)(ws + OFF_SX);
    for (int t = gwave; t < T; t += nwaves) {
        float v[16]; float s = 0.f; float* row = p.out + (size_t)t * 1024 + lane * 16;
#pragma unroll
        for (int i = 0; i < 4; ++i) { const float4 a = *(const float4*)(row + 4 * i); v[4 * i] = a.x; v[4 * i + 1] = a.y; v[4 * i + 2] = a.z; v[4 * i + 3] = a.w; s += (a.x + a.y) + (a.z + a.w); }
        const float mu = wave_sum(s) * (1.0f / 1024.0f); float s2 = 0.f;
#pragma unroll
        for (int i = 0; i < 16; ++i) { v[i] -= mu; s2 += v[i] * v[i]; }
        const float rstd = rsqrtf(wave_sum(s2) * (1.0f / 1024.0f) + LN_EPS); float amax = 0.f;
#pragma unroll
        for (int i = 0; i < 4; ++i) { const int c = lane * 16 + 4 * i; const float4 ga = *(const float4*)(p.ln1_g + c), ba = *(const float4*)(p.ln1_b + c);
            v[4 * i] = v[4 * i] * rstd * ga.x + ba.x; v[4 * i + 1] = v[4 * i + 1] * rstd * ga.y + ba.y; v[4 * i + 2] = v[4 * i + 2] * rstd * ga.z + ba.z; v[4 * i + 3] = v[4 * i + 3] * rstd * ga.w + ba.w;
            *(float4*)(row + 4 * i) = make_float4(v[4 * i], v[4 * i + 1], v[4 * i + 2], v[4 * i + 3]); }
#pragma unroll
        for (int i = 0; i < 16; ++i) amax = fmaxf(amax, fabsf(v[i]));
        amax = fmaxf(wave_max(amax), 1e-20f); const float inv = 127.0f / amax;
        *(uint4*)(h1b + (size_t)t * 1024 + lane * 16) = pack8(v); *(uint4*)(h1b + (size_t)t * 1024 + lane * 16 + 8) = pack8(v + 8);
        *(uint4*)(h1q + (size_t)t * 1024 + lane * 16) = make_uint4(pack4i8(v[0] * inv, v[1] * inv, v[2] * inv, v[3] * inv), pack4i8(v[4] * inv, v[5] * inv, v[6] * inv, v[7] * inv),
                                                                 pack4i8(v[8] * inv, v[9] * inv, v[10] * inv, v[11] * inv), pack4i8(v[12] * inv, v[13] * inv, v[14] * inv, v[15] * inv));
        if (lane == 0) sx[t] = amax * (1.0f / 127.0f);
    }
}

__device__ __forceinline__ unsigned umaxu(unsigned a, unsigned b) { return a > b ? a : b; }
__device__ __forceinline__ unsigned uminu(unsigned a, unsigned b) { return a < b ? a : b; }
__device__ __forceinline__ unsigned f2mono(float f) { const unsigned u = __float_as_uint(f); return (u & 0x80000000u) ? ~u : (u | 0x80000000u); }
__device__ __forceinline__ float mono2f(unsigned m) { return __uint_as_float((m & 0x80000000u) ? (m & 0x7fffffffu) : ~m); }
template <int N> __device__ __forceinline__ void bitonic_sort_desc(unsigned (&a)[N]) {
#pragma unroll
    for (int k = 2; k <= N; k <<= 1)
#pragma unroll
        for (int j = k >> 1; j > 0; j >>= 1)
#pragma unroll
            for (int i = 0; i < N; ++i) { const int l = i ^ j; if (l > i) { const bool desc = ((i & k) == 0); const unsigned x = a[i], y = a[l], mx = umaxu(x, y), mn = uminu(x, y); a[i] = desc ? mx : mn; a[l] = desc ? mn : mx; } }
}
__device__ __forceinline__ void merge_top16(unsigned (&a)[16], const unsigned (&b)[16]) {
#pragma unroll
    for (int i = 0; i < 16; ++i) a[i] = umaxu(a[i], b[15 - i]);
#pragma unroll
    for (int j = 8; j > 0; j >>= 1)
#pragma unroll
        for (int i = 0; i < 16; ++i) { const int l = i ^ j; if (l > i) { const unsigned x = a[i], y = a[l]; a[i] = umaxu(x, y); a[l] = uminu(x, y); } }
}
constexpr int PK_KROW = 272;
__device__ __forceinline__ void peer_stage1(const bf16* qrow, const unsigned char* krow, int hi, unsigned (&run)[16]) {
    bf16x8 qf[8];
#pragma unroll
    for (int ks = 0; ks < 8; ++ks) qf[ks] = *(const bf16x8*)(qrow + ks * 16);
#pragma unroll 1
    for (int kt = 0; kt < 4; ++kt) {
        f32x16 acc;
#pragma unroll
        for (int e = 0; e < 16; ++e) acc[e] = 0.f;
        const unsigned char* kr = krow + kt * 32 * PK_KROW;
#pragma unroll
        for (int ks = 0; ks < 8; ++ks) acc = __builtin_amdgcn_mfma_f32_32x32x16_bf16(*(const bf16x8*)(kr + ks * 32), qf[ks], acc, 0, 0, 0);
        unsigned grp[16]; const unsigned ib = (unsigned)(127 - kt * 32 - 4 * hi);
#pragma unroll
        for (int e = 0; e < 16; ++e) grp[e] = (f2mono(acc[e]) & ~0x7fu) | (ib - (unsigned)((e & 3) + 8 * (e >> 2)));
        bitonic_sort_desc<16>(grp);
        if (kt == 0) {
#pragma unroll
            for (int i = 0; i < 16; ++i) run[i] = grp[i];
        } else merge_top16(run, grp);
    }
    unsigned oth[16];
#pragma unroll
    for (int i = 0; i < 16; ++i) oth[i] = __shfl_xor(run[i], 32);
    merge_top16(run, oth);
}
__device__ __forceinline__ void ph_peer_topk(const Params& p, int wv, unsigned char* lds) {
    PH_IDS(); unsigned char* ws = p.ws; const int rr = lane & 31, hi = lane >> 5;
    unsigned char* kimg = lds; int* exl = (int*)(lds + 2 * 128 * PK_KROW + wv * 6400);
    const bf16* qp = (const bf16*)(ws + OFF_QP); const bf16* keys = (const bf16*)(ws + OFF_KEYS);
    int* eidx = (int*)(ws + OFF_EIDX); float* gw = (float*)(ws + OFF_GW);
    const int h = bid & 7;
    for (int i = tid; i < 256 * 16; i += NTHREADS) { const int row = i >> 4, ch = i & 15; *(uint4*)(kimg + row * PK_KROW + ch * 16) = *(const uint4*)(keys + ((size_t)h * 256 + row) * 128 + ch * 8); }
    __syncthreads();
    for (int tt = (bid >> 3) * NWAVES + wv; tt < 512; tt += (nb >> 3) * NWAVES) {
        const int t0 = tt * 32;
        unsigned top[2][16];
        peer_stage1(qp + (size_t)(t0 + rr) * 2048 + h * 256 + 8 * hi, kimg + rr * PK_KROW + 16 * hi, hi, top[0]);
        peer_stage1(qp + (size_t)(t0 + rr) * 2048 + h * 256 + 128 + 8 * hi, kimg + (128 + rr) * PK_KROW + 16 * hi, hi, top[1]);
        unsigned g4[4][16];
#pragma unroll
        for (int k = 0; k < 4; ++k)
#pragma unroll
            for (int i = 0; i < 16; ++i) g4[k][i] = 0u;
#pragma unroll
        for (int i = 0; i < 16; ++i) {
            int off = 0;
#pragma unroll
            for (int k = 0; k < 16; ++k) if (k < i) off += 16 / (k + 1);
            const float s0 = mono2f(top[0][i] & ~0x7fu); const int e0 = (int)(127u - (top[0][i] & 0x7fu)) * 128;
#pragma unroll
            for (int j = 0; j < 16; ++j) if ((i + 1) * (j + 1) <= 16) {
                const int nc = off + j;
                const float sum = s0 + mono2f(top[1][j] & ~0x7fu);
                g4[nc >> 4][nc & 15] = (f2mono(sum) & ~0x3fu) | (unsigned)(63 - nc);
                if (hi == 0) exl[nc * 32 + rr] = e0 + (int)(127u - (top[1][j] & 0x7fu));
            }
        }
#pragma unroll
        for (int k = 0; k < 4; ++k) bitonic_sort_desc<16>(g4[k]);
        merge_top16(g4[0], g4[1]); merge_top16(g4[2], g4[3]); merge_top16(g4[0], g4[2]);
        float e16[16]; float den = 0.f; const float gmax = mono2f(g4[0][0] & ~0x3fu);
#pragma unroll
        for (int r = 0; r < 16; ++r) { e16[r] = __expf(mono2f(g4[0][r] & ~0x3fu) - gmax); den += e16[r]; }
        const float inv = 1.0f / den; const size_t ob = (size_t)(t0 + rr) * 128 + h * 16 + hi * 8;
        float wo[8]; int eo[8];
#pragma unroll
        for (int k = 0; k < 8; ++k) { const unsigned key = hi ? g4[0][8 + k] : g4[0][k]; wo[k] = (hi ? e16[8 + k] : e16[k]) * inv; eo[k] = exl[(63 - (int)(key & 0x3fu)) * 32 + rr]; }
        *(float4*)(gw + ob) = make_float4(wo[0], wo[1], wo[2], wo[3]); *(float4*)(gw + ob + 4) = make_float4(wo[4], wo[5], wo[6], wo[7]);
        *(int4*)(eidx + ob) = make_int4(eo[0], eo[1], eo[2], eo[3]); *(int4*)(eidx + ob + 4) = make_int4(eo[4], eo[5], eo[6], eo[7]);
    }
}
__device__ __forceinline__ void ph_peer_cvt(const Params& p, int wv) {
    PH_IDS(); unsigned char* ws = p.ws;
    for (int r = gwave; r < 2 * 16384; r += nwaves) {
        const bool isv = r >= 16384; const int e = isv ? r - 16384 : r;
        const float* src = (isv ? p.peer_v : p.peer_u) + (size_t)e * 1024 + lane * 16; float v[16]; float amax = 0.f;
#pragma unroll
        for (int i = 0; i < 4; ++i) { const float4 a = *(const float4*)(src + 4 * i); v[4 * i] = a.x; v[4 * i + 1] = a.y; v[4 * i + 2] = a.z; v[4 * i + 3] = a.w; }
#pragma unroll
        for (int i = 0; i < 16; ++i) amax = fmaxf(amax, fabsf(v[i]));
        amax = fmaxf(wave_max(amax), 1e-30f); const float inv = 127.0f / amax;
        *(uint4*)(ws + (isv ? OFF_PV : OFF_PU) + (size_t)e * 1024 + lane * 16) = make_uint4(pack4i8(v[0] * inv, v[1] * inv, v[2] * inv, v[3] * inv), pack4i8(v[4] * inv, v[5] * inv, v[6] * inv, v[7] * inv),
                                                                                            pack4i8(v[8] * inv, v[9] * inv, v[10] * inv, v[11] * inv), pack4i8(v[12] * inv, v[13] * inv, v[14] * inv, v[15] * inv));
        if (lane == 0) ((float*)(ws + (isv ? OFF_SV : OFF_SU)))[e] = amax * (1.0f / 127.0f);
    }
}
constexpr size_t OFF_PART = 26 * MiB;
constexpr size_t OFF_Y = 26 * MiB;
static_assert(OFF_PART + 64 * MiB <= OFF_H1B && OFF_PV + 16 * MiB <= OFF_XSBC && OFF_VWT + 8 * MiB <= OFF_PU, "PEER scratch map");
#define PU_ISSUE16(W, ELO, EHI) do { _Pragma("unroll") for (int k = 0; k < 8; ++k) { const int e0 = __shfl(ELO, k * 8 + g), e1 = __shfl(EHI, k * 8 + g); \
        W[k] = *(const uint4*)(PU + (size_t)e0 * 1024 + 128 * s + 16 * j); W[8 + k] = *(const uint4*)(PU + (size_t)e1 * 1024 + 128 * s + 16 * j); } } while (0)
#define PU_DOT16(W, X) __builtin_amdgcn_sdot4((int)(W).w, (int)(X).w, __builtin_amdgcn_sdot4((int)(W).z, (int)(X).z, __builtin_amdgcn_sdot4((int)(W).y, (int)(X).y, __builtin_amdgcn_sdot4((int)(W).x, (int)(X).x, 0, false), false), false), false)
#define PU_REDUCE8(W, O, XQ, PROW, B) do { int d[8], a4[4], a2[2], a1; \
        _Pragma("unroll") for (int k = 0; k < 8; ++k) d[k] = PU_DOT16(W[(O) + k], XQ); \
        _Pragma("unroll") for (int k = 0; k < 4; ++k) { const int give = b2 ? d[k] : d[4 + k]; a4[k] = (b2 ? d[4 + k] : d[k]) + __shfl_xor(give, 4); } \
        _Pragma("unroll") for (int k = 0; k < 2; ++k) { const int give = b1 ? a4[k] : a4[2 + k]; a2[k] = (b1 ? a4[2 + k] : a4[k]) + __shfl_xor(give, 2); } \
        { const int give = b0 ? a2[0] : a2[1]; a1 = (b0 ? a2[1] : a2[0]) + __shfl_xor(give, 1); } \
        (PROW)[(B) * 64 + kk * 8 + g] = a1; } while (0)
#define PU_META(T_, XQ, ELO, EHI) do { const int tq_ = (T_) < T ? (T_) : tlast; XQ = *(const uint4*)(h1q + (size_t)tq_ * 1024 + 128 * s + 16 * j); \
        ELO = eidx[(size_t)tq_ * 128 + lane]; EHI = eidx[(size_t)tq_ * 128 + 64 + lane]; } while (0)
#define PU_TOKEN(W, T_, XQ) do { int* prow = part + ((size_t)s * T + (T_)) * 128; PU_REDUCE8(W, 0, XQ, prow, 0); PU_REDUCE8(W, 8, XQ, prow, 1); } while (0)
__device__ __forceinline__ void ph_peer_u(const Params& p, int wv) {
    PH_IDS(); unsigned char* ws = p.ws; const int s = bid & 7, cu = bid >> 3, ncu = nb >> 3, g = lane >> 3, j = lane & 7;
    const unsigned char* h1q = ws + OFF_H1Q; const int* eidx = (const int*)(ws + OFF_EIDX); const unsigned char* PU = ws + OFF_PU; int* part = (int*)(ws + OFF_PART);
    const bool b2 = (lane & 4) != 0, b1 = (lane & 2) != 0, b0 = (lane & 1) != 0; const int kk = (b2 ? 4 : 0) + (b1 ? 2 : 0) + (b0 ? 1 : 0);
    const int tstep = ncu * NWAVES; int t = cu * NWAVES + wv;
    if (t >= T) return;
    const int tlast = t;
    uint4 xq0, xq1; int el0, eh0, el1, eh1;
    PU_META(t, xq0, el0, eh0); PU_META(t + tstep, xq1, el1, eh1);
    uint4 wA[16], wB[16];
    PU_ISSUE16(wA, el0, eh0);
    for (;;) {
        { const uint4 cx = xq0; PU_META(t + 2 * tstep, xq0, el0, eh0); PU_ISSUE16(wB, el1, eh1); PU_TOKEN(wA, t, cx); }
        t += tstep; if (t >= T) break;
        { const uint4 cx = xq1; PU_META(t + 2 * tstep, xq1, el1, eh1); PU_ISSUE16(wA, el0, eh0); PU_TOKEN(wB, t, cx); }
        t += tstep; if (t >= T) break;
    }
}
__device__ __forceinline__ void ph_peer_c(const Params& p, int wv) {
    PH_IDS(); unsigned char* ws = p.ws; const int* part = (const int*)(ws + OFF_PART); const float* gw = (const float*)(ws + OFF_GW); const int* eidx = (const int*)(ws + OFF_EIDX);
    const float* su = (const float*)(ws + OFF_SU); const float* sv = (const float*)(ws + OFF_SV); const float* sx = (const float*)(ws + OFF_SX); float* sc = (float*)(ws + OFF_SC); unsigned* coefq = (unsigned*)(ws + OFF_COEFQ);
    for (int t = gwave; t < T; t += nwaves) {
        float cp[2];
#pragma unroll
        for (int b = 0; b < 2; ++b) { const size_t i = (size_t)t * 128 + b * 64 + lane; int acc = 0;
#pragma unroll
            for (int s = 0; s < 8; ++s) acc += part[(size_t)s * T * 128 + i];
            const int e = eidx[i]; cp[b] = gw[i] * gelu_exact((float)acc * su[e] * sx[t]) * sv[e]; }
        const float amax = fmaxf(wave_max(fmaxf(fabsf(cp[0]), fabsf(cp[1]))), 1e-30f), inv = 127.0f / amax;
        const int q0 = (int)rintf(cp[0] * inv) & 0xff, q1 = (int)rintf(cp[1] * inv) & 0xff;
        const int gg = lane & 7, kq = (lane >> 3) & 1;
        unsigned w0 = 0u, w1 = 0u;
#pragma unroll
        for (int i = 0; i < 4; ++i) { const int srcl = (4 * kq + i) * 8 + gg; w0 |= (unsigned)__shfl(q0, srcl) << (8 * i); w1 |= (unsigned)__shfl(q1, srcl) << (8 * i); }
        if (lane < 16) { coefq[(size_t)t * 32 + lane] = w0; coefq[(size_t)t * 32 + 16 + lane] = w1; }
        if (lane == 0) sc[t] = amax * (1.0f / 127.0f);
    }
}
#define PV_ISSUE16(W, ELO, EHI) do { _Pragma("unroll") for (int k = 0; k < 8; ++k) { const int e0 = __shfl(ELO, k * 8 + g), e1 = __shfl(EHI, k * 8 + g); \
        W[k] = *(const uint4*)(PV + (size_t)e0 * 1024 + 128 * s + 16 * j); W[8 + k] = *(const uint4*)(PV + (size_t)e1 * 1024 + 128 * s + 16 * j); } } while (0)
#define PV_META(T_, ELO, EHI, CQ) do { const int tq_ = (T_) < T ? (T_) : tlast; ELO = eidx[(size_t)tq_ * 128 + lane]; EHI = eidx[(size_t)tq_ * 128 + 64 + lane]; \
        CQ[0] = coefq[(size_t)tq_ * 32 + g]; CQ[1] = coefq[(size_t)tq_ * 32 + 8 + g]; CQ[2] = coefq[(size_t)tq_ * 32 + 16 + g]; CQ[3] = coefq[(size_t)tq_ * 32 + 24 + g]; } while (0)
#define PV_BLK(W0, W1, W2, W3, CQW, A0, A1, A2, A3) do { \
        const unsigned l01 = __builtin_amdgcn_perm(W1, W0, 0x05010400u), h01 = __builtin_amdgcn_perm(W1, W0, 0x07030602u), l23 = __builtin_amdgcn_perm(W3, W2, 0x05010400u), h23 = __builtin_amdgcn_perm(W3, W2, 0x07030602u); \
        A0 = __builtin_amdgcn_sdot4((int)__builtin_amdgcn_perm(l23, l01, 0x05040100u), (int)(CQW), A0, false); A1 = __builtin_amdgcn_sdot4((int)__builtin_amdgcn_perm(l23, l01, 0x07060302u), (int)(CQW), A1, false); \
        A2 = __builtin_amdgcn_sdot4((int)__builtin_amdgcn_perm(h23, h01, 0x05040100u), (int)(CQW), A2, false); A3 = __builtin_amdgcn_sdot4((int)__builtin_amdgcn_perm(h23, h01, 0x07060302u), (int)(CQW), A3, false); } while (0)
#define PV_QUAD(W, O, CQW) do { PV_BLK(W[(O)].x, W[(O) + 1].x, W[(O) + 2].x, W[(O) + 3].x, CQW, acc[0], acc[1], acc[2], acc[3]); PV_BLK(W[(O)].y, W[(O) + 1].y, W[(O) + 2].y, W[(O) + 3].y, CQW, acc[4], acc[5], acc[6], acc[7]); \
        PV_BLK(W[(O)].z, W[(O) + 1].z, W[(O) + 2].z, W[(O) + 3].z, CQW, acc[8], acc[9], acc[10], acc[11]); PV_BLK(W[(O)].w, W[(O) + 1].w, W[(O) + 2].w, W[(O) + 3].w, CQW, acc[12], acc[13], acc[14], acc[15]); } while (0)
#define PV_TOKEN(W, CQ, T_) do { int acc[16]; _Pragma("unroll") for (int i = 0; i < 16; ++i) acc[i] = 0; \
        PV_QUAD(W, 0, CQ[0]); PV_QUAD(W, 4, CQ[1]); PV_QUAD(W, 8, CQ[2]); PV_QUAD(W, 12, CQ[3]); \
        int y8[8], y4[4], y2[2]; \
        _Pragma("unroll") for (int i = 0; i < 8; ++i) { const int give = b5 ? acc[i] : acc[8 + i]; y8[i] = (b5 ? acc[8 + i] : acc[i]) + __shfl_xor(give, 32); } \
        _Pragma("unroll") for (int i = 0; i < 4; ++i) { const int give = b4 ? y8[i] : y8[4 + i]; y4[i] = (b4 ? y8[4 + i] : y8[i]) + __shfl_xor(give, 16); } \
        _Pragma("unroll") for (int i = 0; i < 2; ++i) { const int give = b3 ? y4[i] : y4[2 + i]; y2[i] = (b3 ? y4[2 + i] : y4[i]) + __shfl_xor(give, 8); } \
        const float sct = sc[(T_)]; *(float2*)(Y + (size_t)(T_) * 1024 + 128 * s + 16 * j + c0) = make_float2((float)y2[0] * sct, (float)y2[1] * sct); } while (0)
__device__ __forceinline__ void ph_peer_v(const Params& p, int wv) {
    PH_IDS(); unsigned char* ws = p.ws; const int s = bid & 7, cu = bid >> 3, ncu = nb >> 3, g = lane >> 3, j = lane & 7;
    const int* eidx = (const int*)(ws + OFF_EIDX); const unsigned* coefq = (const unsigned*)(ws + OFF_COEFQ); const float* sc = (const float*)(ws + OFF_SC); const unsigned char* PV = ws + OFF_PV; float* Y = (float*)(ws + OFF_Y);
    const bool b5 = (lane & 32) != 0, b4 = (lane & 16) != 0, b3 = (lane & 8) != 0; const int c0 = (b5 ? 8 : 0) + (b4 ? 4 : 0) + (b3 ? 2 : 0);
    const int tstep = ncu * NWAVES; int t = cu * NWAVES + wv;
    if (t >= T) return;
    const int tlast = t;
    int el0, eh0, el1, eh1; unsigned cq0[4], cq1[4];
    PV_META(t, el0, eh0, cq0); PV_META(t + tstep, el1, eh1, cq1);
    uint4 wA[16], wB[16];
    PV_ISSUE16(wA, el0, eh0);
    for (;;) {
        { unsigned cc[4] = {cq0[0], cq0[1], cq0[2], cq0[3]}; PV_META(t + 2 * tstep, el0, eh0, cq0); PV_ISSUE16(wB, el1, eh1); PV_TOKEN(wA, cc, t); }
        t += tstep; if (t >= T) break;
        { unsigned cc[4] = {cq1[0], cq1[1], cq1[2], cq1[3]}; PV_META(t + 2 * tstep, el1, eh1, cq1); PV_ISSUE16(wA, el0, eh0); PV_TOKEN(wB, cc, t); }
        t += tstep; if (t >= T) break;
    }
}
__device__ __forceinline__ void ph_peer_ln2(const Params& p, int wv) {
    PH_IDS(); unsigned char* ws = p.ws; const float* Y = (const float*)(ws + OFF_Y);
    int t = gwave; if (t >= T) return;
    float4 ha[4], ya[4];
#pragma unroll
    for (int i = 0; i < 4; ++i) { ha[i] = *(const float4*)(p.out + (size_t)t * 1024 + lane * 16 + 4 * i); ya[i] = *(const float4*)(Y + (size_t)t * 1024 + lane * 16 + 4 * i); }
    for (;;) {
        const int tn = t + nwaves; const int tq = tn < T ? tn : t;
        float4 hb[4], yb[4];
#pragma unroll
        for (int i = 0; i < 4; ++i) { hb[i] = *(const float4*)(p.out + (size_t)tq * 1024 + lane * 16 + 4 * i); yb[i] = *(const float4*)(Y + (size_t)tq * 1024 + lane * 16 + 4 * i); }
        float y[16]; float s1 = 0.f, s2 = 0.f;
#pragma unroll
        for (int i = 0; i < 4; ++i) { y[4 * i] = ya[i].x + DN_ALPHA * ha[i].x; y[4 * i + 1] = ya[i].y + DN_ALPHA * ha[i].y; y[4 * i + 2] = ya[i].z + DN_ALPHA * ha[i].z; y[4 * i + 3] = ya[i].w + DN_ALPHA * ha[i].w; }
#pragma unroll
        for (int i = 0; i < 16; ++i) { s1 += y[i]; s2 += y[i] * y[i]; }
#pragma unroll
        for (int o = 1; o < 64; o <<= 1) { s1 += __shfl_xor(s1, o); s2 += __shfl_xor(s2, o); }
        const float mu = s1 * (1.0f / 1024.0f); const float var = fmaxf(s2 * (1.0f / 1024.0f) - mu * mu, 0.f); const float rstd = rsqrtf(var + LN_EPS);
        float* row = p.out + (size_t)t * 1024 + lane * 16;
#pragma unroll
        for (int i = 0; i < 4; ++i) { const int c = lane * 16 + 4 * i; const float4 ga = *(const float4*)(p.ln2_g + c), ba = *(const float4*)(p.ln2_b + c);
            float4 o; o.x = (y[4 * i] - mu) * rstd * ga.x + ba.x; o.y = (y[4 * i + 1] - mu) * rstd * ga.y + ba.y; o.z = (y[4 * i + 2] - mu) * rstd * ga.z + ba.z; o.w = (y[4 * i + 3] - mu) * rstd * ga.w + ba.w;
            *(float4*)(row + 4 * i) = o; }
        if (tn >= T) break;
        t = tn;
#pragma unroll
        for (int i = 0; i < 4; ++i) { ha[i] = hb[i]; ya[i] = yb[i]; }
    }
}

#define LAS __attribute__((address_space(3)))
#define XB_TMO      128
#define XB_XCNT(j)  (256  + 64 * (j))
#define XB_XSUB(j)  (1280 + 64 * (j))
#define XB_XGEN(j)  (2304 + 64 * (j))
#define XB_TOP      3328
#define XB_TOPGEN   3392
#define XCD_BAR_WORDS 3456
#define XB_SPIN_CAP (1u << 18)

__device__ __forceinline__ unsigned xb_ld(unsigned* p)              { return __hip_atomic_load(p, __ATOMIC_RELAXED, __HIP_MEMORY_SCOPE_AGENT); }
__device__ __forceinline__ unsigned xb_add(unsigned* p, unsigned v) { return __hip_atomic_fetch_add(p, v, __ATOMIC_RELAXED, __HIP_MEMORY_SCOPE_AGENT); }
__device__ __forceinline__ unsigned xb_xcc_id() { return (unsigned)__builtin_amdgcn_s_getreg((3 << 11) | 20) & 0xFu; }
#define XB_SPIN(cond, bar) do { unsigned _sp = 0; while (cond) { __builtin_amdgcn_s_sleep(1); \
    if ((++_sp & 255u) == 0u) { if (xb_ld(&(bar)[XB_TMO])) break; if (_sp > XB_SPIN_CAP) { atomicAdd(&(bar)[XB_TMO], 1u); break; } } } } while (0)

struct XcdBarrier {
    unsigned* bar; unsigned x;
    volatile LAS unsigned* st;
};

__device__ __forceinline__ XcdBarrier xcd_barrier_post(unsigned* bar, volatile LAS unsigned* st, bool leader) {
    XcdBarrier b; b.bar = bar; b.x = xb_xcc_id(); b.st = st;
    if (leader) (void)xb_add(&bar[XB_XCNT(b.x)], 1u);
    return b;
}
__device__ __forceinline__ void xcd_barrier_complete(unsigned* bar, unsigned x, unsigned& nloc, unsigned& nx) {
    const unsigned G = gridDim.x * gridDim.y * gridDim.z;
    unsigned sum, cnt, mine, sp = 0u;
    for (;;) {
        sum = 0u; cnt = 0u; mine = 0u;
#pragma unroll
        for (unsigned j = 0; j < 16; ++j) { const unsigned c = xb_ld(&bar[XB_XCNT(j)]); sum += c; cnt += (c > 0u) ? 1u : 0u; mine = (j == x) ? c : mine; }
        if (sum == G) break;
        __builtin_amdgcn_s_sleep(1);
        if ((++sp & 255u) == 0u) { if (xb_ld(&bar[XB_TMO])) break; if (sp > XB_SPIN_CAP) { atomicAdd(&bar[XB_TMO], 1u); break; } }
    }
    nloc = mine > 0u ? mine : 1u; nx = cnt > 0u ? cnt : 1u;
}

__device__ __forceinline__ void xcd_barrier(const XcdBarrier& b, bool leader) {
    asm volatile("s_waitcnt vmcnt(0)" ::: "memory");
    __syncthreads();
    if (leader) {
        unsigned* bar = b.bar;
        __builtin_amdgcn_s_waitcnt(0);
        unsigned nloc = b.st[0], nx = b.st[1];
        if (nloc == 0u) { xcd_barrier_complete(bar, b.x, nloc, nx); b.st[0] = nloc; b.st[1] = nx; }
        const unsigned old = xb_add(&bar[XB_XSUB(b.x)], 1u);
        const unsigned gen = old / nloc;
        if (old + 1u == (gen + 1u) * nloc) {
            __builtin_amdgcn_fence(__ATOMIC_RELEASE, "agent");
            asm volatile("s_waitcnt vmcnt(0)" ::: "memory");
            const unsigned og = xb_add(&bar[XB_TOP], 1u);
            const unsigned tg = og / nx;
            if (og + 1u == (tg + 1u) * nx) xb_add(&bar[XB_TOPGEN], 1u);
            else XB_SPIN(xb_ld(&bar[XB_TOPGEN]) == tg, bar);
            __builtin_amdgcn_fence(__ATOMIC_ACQUIRE, "agent");
            xb_add(&bar[XB_XGEN(b.x)], 1u);
            asm volatile("s_waitcnt vmcnt(0)" ::: "memory");
        } else {
            XB_SPIN(xb_ld(&bar[XB_XGEN(b.x)]) == gen, bar);
            __builtin_amdgcn_fence(__ATOMIC_ACQUIRE, "agent");
            asm volatile("s_waitcnt vmcnt(0)" ::: "memory");
        }
    }
    __syncthreads();
}

#ifndef TIMING_BOUNDARY
#define TIMING_BOUNDARY -1
#endif
#define TPROBE(k) do { if (TIMING_BOUNDARY == (k)) { const unsigned long long t1_ = __builtin_amdgcn_s_memrealtime(); while (__builtin_amdgcn_s_memrealtime() - t1_ < t1_ - tstart_) __builtin_amdgcn_s_sleep(8); } } while (0)
__global__ void __launch_bounds__(NTHREADS) fwd_megakernel(Params p) {
    extern __shared__ __attribute__((aligned(16))) unsigned char lds[];
    cg::grid_group grid = cg::this_grid();
    const int nb = gridDim.x, bid = blockIdx.x;
    const int wv = __builtin_amdgcn_readfirstlane(threadIdx.x >> 6);
    unsigned char* ws = p.ws;
    const unsigned long long tstart_ = (TIMING_BOUNDARY >= 0) ? __builtin_amdgcn_s_memrealtime() : 0ull; (void)tstart_;
    PG8_LAS unsigned char* ldsp = (PG8_LAS unsigned char*)lds;
    const bool leader = (wv == 0) && (lane_id() == 0);
    volatile LAS unsigned* bst = (volatile LAS unsigned*)(ldsp + LDS_BYTES - 64);
    if (leader) { bst[0] = 0u; bst[1] = 0u; }
    __syncthreads();
    const XcdBarrier xbar = xcd_barrier_post((unsigned*)(ws + OFF_BAR), bst, leader);

    ph_prep(p, wv, lds);
    if (p.ws == nullptr) grid.sync();
    xcd_barrier(xbar, leader);
    TPROBE(0);
    if (bid == 0) {
        const int o = (wv << 6) | lane_id(); const float* b1p = (const float*)(ws + OFF_HID) + (size_t)(o >> 8) * 32 * 256 + (o & 255); float s = 0.f;
        for (int kc = 0; kc < 32; ++kc) s += b1p[kc * 256];
        ((float*)(ws + (o < 256 ? OFF_B1K : OFF_B1V)))[o & 255] = s;
    }
    {
        pg8::Gemm g{(const bf16*)(ws + OFF_XB), (const bf16*)(ws + OFF_WIN), T, NPROJ_PAD, 1024, 1024, 0, 1 << 30, 0l};
        pg8::StaticOrder S; S.init(T, NPROJ_PAD, nb, bid);
        pg8::EpiInProjPg E{(bf16*)(ws + OFF_Z), (bf16*)(ws + OFF_XBC), (bf16*)(ws + OFF_Q), (bf16*)(ws + OFF_KVS), (bf16*)(ws + OFF_DTG)};
        pg8::gemm_phase<pg8::EpiInProjPg, pg8::StaticOrder, pg8::NoMid, true, true>(wv, ldsp, g, S, E, pg8::NoMid{});
    }
    xcd_barrier(xbar, leader);
    TPROBE(1);
    if (bid < 32) {
        const bool isv = bid >= 16;
        pg8::Gemm g{(const bf16*)(ws + OFF_KVS) + (isv ? 256 : 0), (const bf16*)(ws + (isv ? OFF_W1V : OFF_W1K)), 4096, 256, 2048, 0, 1, 1 << 30, 0l};
        pg8::StaticOrder S; S.init(4096, 256, 16, isv ? bid - 16 : bid);
        pg8::EpiBf16<1> E{(bf16*)(ws + OFF_HID + (isv ? 2 * MiB : 0)), 256, (const float*)(ws + (isv ? OFF_B1V : OFF_B1K)), 0, 0, 1.f};
        pg8::gemm_phase<pg8::EpiBf16<1>, pg8::StaticOrder, pg8::NoMid, true, true>(wv, ldsp, g, S, E, pg8::NoMid{});
    }
    else ph_tokprep(p, wv);
    xcd_barrier(xbar, leader);
    TPROBE(2);
    ph_ssd_prep2(p, wv, lds);
    ph_vt_prep(p, wv);
    xcd_barrier(xbar, leader);
    TPROBE(3);
    {
        RowMajorBf16 ak{(const bf16*)(ws + OFF_HID), 256}, av{(const bf16*)(ws + OFF_HID + 2 * MiB), 256};
        RowMajorBf16 bk{(const bf16*)(ws + OFF_W2K), 256}, bv{(const bf16*)(ws + OFF_W2V), 256};
        EpiKc ek{(bf16*)(ws + OFF_KC), false}, ev{(bf16*)(ws + OFF_VCT), true};
        gemm_wave16(wv, 4096 / 16, 64 / 16, 256, ak, bk, ek, 0, 2048);
        gemm_wave16(wv, 4096 / 16, 64 / 16, 256, av, bv, ev, 1024, 2048);
    }
    ph_ssd_states(p, wv);
    xcd_barrier(xbar, leader);
    TPROBE(4);
    ph_kc_rope(p, wv);
    ph_ssd_scan(p, wv);
    ph_peer_cvt(p, wv);
    xcd_barrier(xbar, leader);
    TPROBE(5);
    ph_ssd_out(p, wv, lds);
    ph_nsa(p, wv, lds);
    xcd_barrier(xbar, leader);
    TPROBE(6);
    {
        pg8::Gemm g{(const bf16*)(ws + OFF_Q), (const bf16*)(ws + OFF_WOUT), T, 1024, 2048, 1024, 0, 16, (long)OFF_Z - (long)OFF_Q - 16l * 128l};
        pg8::StaticOrder S; S.init(T, 1024, nb, bid);
        pg8::RmsFactors rf{(const float*)(ws + OFF_SSQ), (const float*)(ws + OFF_HID), RMS_EPS};
        pg8::EpiOutProj E{p.x, p.out, DN_ALPHA, rf}; pg8::MidRmsScale MH{rf};
        pg8::gemm_phase<pg8::EpiOutProj, pg8::StaticOrder, pg8::MidRmsScale, true, true>(wv, ldsp, g, S, E, MH);
    }
    xcd_barrier(xbar, leader);
    TPROBE(7);
    ph_ln1(p, wv);
    xcd_barrier(xbar, leader);
    TPROBE(8);
    {
        pg8::Gemm g{(const bf16*)(ws + OFF_H1B), (const bf16*)(ws + OFF_WQ), T, 2048, 1024, 1024, 0, 1 << 30, 0l};
        pg8::StaticOrder S; S.init(T, 2048, nb, bid);
        pg8::EpiBf16<0> E{(bf16*)(ws + OFF_QP), 2048, nullptr, 0, 0, 1.f};
        pg8::gemm_phase<pg8::EpiBf16<0>, pg8::StaticOrder, pg8::NoMid, true, true>(wv, ldsp, g, S, E, pg8::NoMid{});
    }
    xcd_barrier(xbar, leader);
    TPROBE(9);
    ph_peer_topk(p, wv, lds);
    xcd_barrier(xbar, leader);
    TPROBE(10);
    ph_peer_u(p, wv);
    xcd_barrier(xbar, leader);
    TPROBE(11);
    ph_peer_c(p, wv);
    xcd_barrier(xbar, leader);
    TPROBE(12);
    ph_peer_v(p, wv);
    xcd_barrier(xbar, leader);
    TPROBE(13);
    ph_peer_ln2(p, wv);
}

extern "C" void kernel_launch(void* const* d_in, const int* in_sizes, int n_in, void* d_out, int out_size, void* d_ws, size_t ws_size, hipStream_t stream) {
    static int grid_blocks = 0;
    if (!grid_blocks) {
        int dev = 0, cus = 0, per_cu = 0;
        hipGetDevice(&dev);
        hipDeviceGetAttribute(&cus, hipDeviceAttributeMultiprocessorCount, dev);
        hipFuncSetAttribute((const void*)fwd_megakernel, hipFuncAttributeMaxDynamicSharedMemorySize, LDS_BYTES);
        hipOccupancyMaxActiveBlocksPerMultiprocessor(&per_cu, fwd_megakernel, NTHREADS, LDS_BYTES);
        if (per_cu < 1) per_cu = 1;
        if (per_cu > 1) per_cu = 1;
        grid_blocks = cus * per_cu;
        if (ws_size < 244 * MiB) fprintf(stderr, "kernel_launch: workspace too small: %zu\n", ws_size);
    }
    Params p{};
    const float** pp = (const float**)&p;
    for (int i = 0; i < 24; ++i) pp[i] = (const float*)d_in[i];
    p.out = (float*)d_out; p.ws = (unsigned char*)d_ws;
    (void)hipMemsetAsync((unsigned char*)d_ws + OFF_BAR, 0, BAR_BYTES, stream);
    void* args[] = {&p};
    hipError_t e = hipLaunchCooperativeKernel((void*)fwd_megakernel, dim3(grid_blocks), dim3(NTHREADS), args, LDS_BYTES, stream);
    if (e != hipSuccess) fprintf(stderr, "cooperative launch failed: %s (grid %d)\n", hipGetErrorString(e), grid_blocks);
}
```

```cpp
#include <hip/hip_runtime.h>
#include <hip/hip_cooperative_groups.h>
#include <cstdio>
#include <cstdint>
namespace cg = cooperative_groups;

typedef unsigned short bf16;
typedef short bf16x8 __attribute__((ext_vector_type(8)));
typedef float f32x4 __attribute__((ext_vector_type(4)));
typedef float f32x16 __attribute__((ext_vector_type(16)));
typedef unsigned long long u64;

constexpr int T = 16384, L = 4096, NBATCH = 4, D = 1024;
constexpr int NPROJ = 5184, NPROJ_PAD = 5376;
constexpr int NTHREADS = 512, NWAVES = 8;
constexpr float LN_EPS = 1e-5f, RMS_EPS = 1e-5f;
constexpr float DN_ALPHA = 1.189207115002721f;
constexpr float NEG_INF = -1e30f, BIG = 1e30f;

constexpr size_t MiB = 1u << 20;
constexpr size_t OFF_SSQ = 0, OFF_BAR = 512 * 1024, BAR_BYTES = 16384;
constexpr size_t OFF_WOUT = 1 * MiB, OFF_WQ = 5 * MiB, OFF_W1K = 9 * MiB, OFF_W1V = 10 * MiB;
constexpr size_t OFF_W2K = 11 * MiB, OFF_W2V = 11 * MiB + 65536, OFF_B1K = 11 * MiB + 131072, OFF_B1V = 11 * MiB + 131072 + 4096;
constexpr size_t OFF_KEYS = 12 * MiB, OFF_ROPE = 13 * MiB, OFF_DT = 14 * MiB, OFF_ACS = 15 * MiB, OFF_GATE = 16 * MiB;
constexpr size_t OFF_HID = 20 * MiB, OFF_KC = 24 * MiB;
constexpr size_t OFF_Z = 26 * MiB, OFF_Q = 58 * MiB, OFF_KVS = 90 * MiB, OFF_XSBC = 186 * MiB, OFF_BT = 234 * MiB, OFF_DTG = 242 * MiB;
constexpr size_t OFF_VST = 138 * MiB, OFF_VWT = 146 * MiB, OFF_VCT = 19 * MiB;
constexpr size_t OFF_XB = 186 * MiB, OFF_WIN = 218 * MiB;
constexpr size_t OFF_H1B = 90 * MiB, OFF_QP = 26 * MiB, OFF_EIDX = 202 * MiB, OFF_GW = 210 * MiB;
constexpr size_t OFF_PU = 154 * MiB, OFF_PV = 170 * MiB;
constexpr int LDS_BYTES = 147456;

struct Params {
    const float *x, *w_in, *conv_w, *conv_b, *dt_bias, *a_log, *d_skip, *ssd_norm_w;
    const float *cmp_pos_k, *cmp_w1_k, *cmp_w2_k, *cmp_pos_v, *cmp_w1_v, *cmp_w2_v;
    const float *attn_norm_w, *w_out, *ln1_g, *ln1_b, *peer_wq, *peer_keys, *peer_u, *peer_v, *ln2_g, *ln2_b;
    float* out; unsigned char* ws;
};

__device__ __forceinline__ float bf2f(bf16 v) { return __uint_as_float((unsigned)v << 16); }
__device__ __forceinline__ bf16 f2bf(float f) { unsigned u = __float_as_uint(f); return (bf16)((u + 0x7fffu + ((u >> 16) & 1u)) >> 16); }
__device__ __forceinline__ int lane_id() { int l = (int)__builtin_amdgcn_mbcnt_hi(~0u, __builtin_amdgcn_mbcnt_lo(~0u, 0u)); asm volatile("" : "+v"(l)); return l; }
#define PH_IDS() const int lane = lane_id(); const int tid = (wv << 6) | lane; const int bid = blockIdx.x, nb = gridDim.x; const int gtid = bid * NTHREADS + tid, gn = nb * NTHREADS; const int gwave = bid * NWAVES + wv, nwaves = nb * NWAVES; (void)gtid; (void)gn; (void)gwave; (void)nwaves;
typedef float f32x2v __attribute__((ext_vector_type(2)));
typedef __bf16 bf16x2v __attribute__((ext_vector_type(2)));
__device__ __forceinline__ unsigned pk2bf(float lo, float hi) { f32x2v v = {lo, hi}; bf16x2v b = __builtin_convertvector(v, bf16x2v); return __builtin_bit_cast(unsigned, b); }
__device__ __forceinline__ float bflo(unsigned w) { return __uint_as_float(w << 16); }
__device__ __forceinline__ float bfhi(unsigned w) { return __uint_as_float(w & 0xffff0000u); }
__device__ __forceinline__ float wave_sum(float v) {
#pragma unroll
    for (int o = 1; o < 64; o <<= 1) v += __shfl_xor(v, o);
    return v;
}
__device__ __forceinline__ float wave_max(float v) {
#pragma unroll
    for (int o = 1; o < 64; o <<= 1) v = fmaxf(v, __shfl_xor(v, o));
    return v;
}
__device__ __forceinline__ float gelu_exact(float v) { return 0.5f * v * (1.0f + erff(v * 0.7071067811865476f)); }
__device__ __forceinline__ float sigmoidf(float v) { return 1.0f / (1.0f + __expf(-v)); }

template <class AP, class BP, class EP>
__device__ __forceinline__ void gemm_wave32(int wv, int Mt, int Nt, int K, const AP& ap, const BP& bp, const EP& ep) {
    PH_IDS(); const int r = lane & 15, q = lane >> 4;
    for (int tile = gwave; tile < Mt * Nt; tile += nwaves) {
        const int tm = tile / Nt, tn = tile % Nt, row0 = tm * 32, col0 = tn * 32;
        f32x4 acc[2][2];
#pragma unroll
        for (int i = 0; i < 2; ++i)
#pragma unroll
            for (int j = 0; j < 2; ++j) acc[i][j] = (f32x4){0.f, 0.f, 0.f, 0.f};
        for (int k0 = 0; k0 < K; k0 += 32) {
            const bf16x8 a0 = ap(row0 + r, k0 + 8 * q), a1 = ap(row0 + 16 + r, k0 + 8 * q);
            const bf16x8 b0 = bp(col0 + r, k0 + 8 * q), b1 = bp(col0 + 16 + r, k0 + 8 * q);
            acc[0][0] = __builtin_amdgcn_mfma_f32_16x16x32_bf16(a0, b0, acc[0][0], 0, 0, 0);
            acc[0][1] = __builtin_amdgcn_mfma_f32_16x16x32_bf16(a0, b1, acc[0][1], 0, 0, 0);
            acc[1][0] = __builtin_amdgcn_mfma_f32_16x16x32_bf16(a1, b0, acc[1][0], 0, 0, 0);
            acc[1][1] = __builtin_amdgcn_mfma_f32_16x16x32_bf16(a1, b1, acc[1][1], 0, 0, 0);
        }
#pragma unroll
        for (int i = 0; i < 2; ++i)
#pragma unroll
            for (int j = 0; j < 2; ++j)
#pragma unroll
                for (int e = 0; e < 4; ++e) ep(row0 + 16 * i + 4 * q + e, col0 + 16 * j + r, acc[i][j][e]);
    }
}
template <class AP, class BP, class EP>
__device__ __forceinline__ void gemm_wave16(int wv, int Mt, int Nt, int K, const AP& ap, const BP& bp, const EP& ep, int task0, int ntask_total) {
    PH_IDS(); const int r = lane & 15, q = lane >> 4;
    for (int task = gwave; task < ntask_total; task += nwaves) {
        const int tile = task - task0; if (tile < 0 || tile >= Mt * Nt) continue;
        const int tm = tile / Nt, tn = tile % Nt, row0 = tm * 16, col0 = tn * 16;
        f32x4 acc = (f32x4){0.f, 0.f, 0.f, 0.f};
#pragma unroll 4
        for (int k0 = 0; k0 < K; k0 += 32) acc = __builtin_amdgcn_mfma_f32_16x16x32_bf16(ap(row0 + r, k0 + 8 * q), bp(col0 + r, k0 + 8 * q), acc, 0, 0, 0);
#pragma unroll
        for (int e = 0; e < 4; ++e) ep(row0 + 4 * q + e, col0 + r, acc[e]);
    }
}
struct RowMajorBf16 { const bf16* p; int ld; __device__ __forceinline__ bf16x8 operator()(int row, int k) const { return *(const bf16x8*)(p + (size_t)row * ld + k); } };

namespace pg8 {
#define PG8_LAS __attribute__((address_space(3)))
typedef unsigned short bf16_t;
typedef short bf16x8 __attribute__((ext_vector_type(8)));
typedef float f32x4 __attribute__((ext_vector_type(4)));
typedef unsigned u32x4 __attribute__((ext_vector_type(4)));
constexpr int BM = 256, BK = 64, HALF = 128, HTB = HALF * BK * 2  , STAGE_BYTES = 8 * HTB, NXCD = 8, WGM = 8;

__host__ __device__ __forceinline__ int lds_byte(int r, int c) { const int st = (r >> 4) * 2 + (c >> 5), rr = r & 15, cc = c & 31, ob = rr * 64 + cc * 2; return st * 1024 + (ob ^ (((ob >> 9) & 1) << 5)); }
__host__ __device__ __forceinline__ void stage_rc(int b, int& R, int& C) { const int st = b / 1024, sb = b % 1024, swz = sb ^ (((sb >> 9) & 1) << 5); R = (st >> 1) * 16 + swz / 64; C = (st & 1) * 32 + (swz % 64) / 2; }
__host__ __device__ __forceinline__ int perm32(int rho) { const int n = rho >> 4, i = rho & 15; return 8 * (i >> 2) + 4 * n + (i & 3); }

struct Unit { int pm, pn; };
struct Gemm { const bf16_t* A; const bf16_t* Bt; int M, N, K; int lda; int amode; int ksplit; long kdelta; };

struct StaticOrder {
    int nM, nN, nwg, G, c;
    __host__ __device__ void init(int M, int N, int G_, int c_) { nM = M / BM; nN = N / BM; nwg = nM * nN; G = G_; c = c_; }
    __host__ __device__ bool next(int i, Unit& u) const {
        const long L = (long)i * G + c; if (L >= nwg) return false;
        int wgid = (int)L; { const int q = nwg / NXCD, r = nwg % NXCD, xcd = wgid % NXCD, off = wgid / NXCD; wgid = (xcd < r ? xcd * (q + 1) : r * (q + 1) + (xcd - r) * q) + off; }
        const int nig = WGM * nN, gid = wgid / nig, fm = gid * WGM, gsz = (nM - fm) < WGM ? (nM - fm) : WGM;
        u.pm = fm + ((wgid % nig) % gsz); u.pn = (wgid % nig) / gsz; return true;
    }
    __device__ __forceinline__ void a_ready(const Unit&) const {}
    __device__ __forceinline__ void done(const Unit&) const {}
};


__device__ __forceinline__ unsigned cvt_pk_bf16(float lo, float hi) { unsigned r; asm volatile("v_cvt_pk_bf16_f32 %0, %1, %2" : "=v"(r) : "v"(lo), "v"(hi)); return r; }
typedef float f32x2 __attribute__((ext_vector_type(2)));
__device__ __forceinline__ f32x2 gelu_pk(f32x2 v) {
    const f32x2 av = __builtin_elementwise_abs(v), d = av * 0.2316418882f + 1.0f;
    f32x2 t; t.x = __builtin_amdgcn_rcpf(d.x); t.y = __builtin_amdgcn_rcpf(d.y);
    f32x2 q = t * 0.5307027145f + (-0.7265760135f); q = q * t + 0.7107068705f; q = q * t + (-0.142248368f); q = q * t + 0.127414796f; q = q * t;
    const f32x2 s = (v * v) * (-0.72134752044f);
    f32x2 e; e.x = __builtin_amdgcn_exp2f(s.x); e.y = __builtin_amdgcn_exp2f(s.y);
    const f32x2 m = v * (q * e), r = v - m;
    f32x2 o; o.x = v.x < 0.f ? m.x : r.x; o.y = v.y < 0.f ? m.y : r.y; return o;
}

template <int ACT  > struct EpiBf16 {
    static constexpr bool PERM = true, AFTER_DRAIN = false; static_assert(ACT == 0 || ACT == 1, "EpiBf16: ACT is 0 (none) or 1 (gelu_pk)");
    bf16_t* O; int ldc; const float* bias; int split_cols; size_t split_stride; float scale0;
    __device__ __forceinline__ void operator()(const f32x4 (&acc)[2][2][4][2], const Unit& u, int wr, int wc, int fr, int fq) const {
        const int row0 = u.pm * BM + wr * 64 + fr; int colt = u.pn * BM; bf16_t* base = O;
        float sc = 1.f; if (split_cols) { const int t = colt / split_cols; base += (size_t)t * split_stride; colt -= t * split_cols; if (t == 0) sc = scale0; }
        const int col0 = colt + wc * 32 + 8 * fq, bcol0 = u.pn * BM + wc * 32 + 8 * fq;
        f32x4 bv[2][2];
#pragma unroll
        for (int bj = 0; bj < 2; ++bj)
#pragma unroll
            for (int n = 0; n < 2; ++n) bv[bj][n] = bias ? *(const f32x4*)(bias + bcol0 + bj * HALF + 4 * n) : (f32x4){0.f, 0.f, 0.f, 0.f};
#pragma unroll
        for (int ai = 0; ai < 2; ++ai)
#pragma unroll
            for (int m = 0; m < 4; ++m) { bf16_t* rowp = base + (size_t)(row0 + ai * HALF + m * 16) * ldc + col0;
#pragma unroll
                for (int bj = 0; bj < 2; ++bj) { f32x4 v0 = acc[ai][bj][m][0] + bv[bj][0], v1 = acc[ai][bj][m][1] + bv[bj][1];
                    if (ACT == 1) { f32x2 a = gelu_pk((f32x2){v0[0], v0[1]}), b = gelu_pk((f32x2){v0[2], v0[3]}), c = gelu_pk((f32x2){v1[0], v1[1]}), d = gelu_pk((f32x2){v1[2], v1[3]});
                        v0 = (f32x4){a.x, a.y, b.x, b.y}; v1 = (f32x4){c.x, c.y, d.x, d.y}; }
                    v0 = v0 * sc; v1 = v1 * sc; u32x4 w; w.x = cvt_pk_bf16(v0[0], v0[1]); w.y = cvt_pk_bf16(v0[2], v0[3]); w.z = cvt_pk_bf16(v1[0], v1[1]); w.w = cvt_pk_bf16(v1[2], v1[3]);
                    *(u32x4*)(rowp + bj * HALF) = w; } }
    }
};

struct EpiInProjPg { static constexpr bool PERM = true, AFTER_DRAIN = false;
    bf16_t *z, *xbc, *q, *kvs, *dtg;
    __device__ __forceinline__ void operator()(const f32x4 (&acc)[2][2][4][2], const Unit& u, int wr, int wc, int fr, int fq) const {
        bf16_t* base; int ldc, colt; const int pn = u.pn;
        if (pn < 4) { base = z; ldc = 1024; colt = pn * 256; } else if (pn < 10) { base = xbc; ldc = 1536; colt = (pn - 4) * 256; }
        else if (pn < 14) { base = q; ldc = 1024; colt = (pn - 10) * 256; } else if (pn < 20) { base = kvs; ldc = 1536; colt = (pn - 14) * 256; }
        else { base = dtg; ldc = 64; colt = 0; }
        const int row0 = u.pm * BM + wr * 64 + fr, col0 = colt + wc * 32 + 8 * fq;
#pragma unroll
        for (int ai = 0; ai < 2; ++ai)
#pragma unroll
            for (int m = 0; m < 4; ++m) { bf16_t* rowp = base + (size_t)(row0 + ai * HALF + m * 16) * ldc + col0;
#pragma unroll
                for (int bj = 0; bj < 2; ++bj) { const f32x4 v0 = acc[ai][bj][m][0], v1 = acc[ai][bj][m][1];
                    u32x4 w; w.x = cvt_pk_bf16(v0[0], v0[1]); w.y = cvt_pk_bf16(v0[2], v0[3]); w.z = cvt_pk_bf16(v1[0], v1[1]); w.w = cvt_pk_bf16(v1[2], v1[3]);
                    if (pn < 20 || (bj == 0 && wc < 2)) *(u32x4*)(rowp + bj * HALF) = w; } }
    }
};
struct RmsFactors { const float* ssqp; const float* ssq2p; float eps;
    __device__ __forceinline__ void get(int row, float& ra, float& r0, float& r1) const {
        const f32x4 a = *(const f32x4*)(ssqp + 4 * row); const f32x4 b0 = *(const f32x4*)(ssq2p + 16 * row), b1 = *(const f32x4*)(ssq2p + 16 * row + 4), b2 = *(const f32x4*)(ssq2p + 16 * row + 8), b3 = *(const f32x4*)(ssq2p + 16 * row + 12);
        ra = rsqrtf(((a[0] + a[1]) + (a[2] + a[3])) * (1.0f / 1024.0f) + eps);
        r0 = rsqrtf((((b0[0] + b0[1]) + (b0[2] + b0[3])) + ((b1[0] + b1[1]) + (b1[2] + b1[3]))) * (1.0f / 512.0f) + eps);
        r1 = rsqrtf((((b2[0] + b2[1]) + (b2[2] + b2[3])) + ((b3[0] + b3[1]) + (b3[2] + b3[3]))) * (1.0f / 512.0f) + eps); } };
struct EpiOutProj { static constexpr bool PERM = false, AFTER_DRAIN = false;
    const float* x; float* out; float alpha; RmsFactors rf;
    __device__ __forceinline__ void operator()(const f32x4 (&acc)[2][2][4][2], const Unit& u, int wr, int wc, int fr, int fq) const {
        const int col0 = u.pn * BM + wc * 32 + 4 * fq;
#pragma unroll
        for (int ai = 0; ai < 2; ++ai)
#pragma unroll
            for (int m = 0; m < 4; ++m) { const int row = u.pm * BM + ai * HALF + wr * 64 + m * 16 + fr; const size_t off = (size_t)row * 1024 + col0;
                float ra, r0, r1; rf.get(row, ra, r0, r1);
#pragma unroll
                for (int bj = 0; bj < 2; ++bj)
#pragma unroll
                    for (int n = 0; n < 2; ++n) { const size_t o = off + bj * HALF + n * 16; const f32x4 xv = *(const f32x4*)(x + o); *(f32x4*)(out + o) = xv * alpha + acc[ai][bj][m][n] * r1; } }
    }
};
struct MidRmsScale { static constexpr bool ENABLED = true; RmsFactors rf;
    __device__ __forceinline__ void operator()(f32x4 (&acc)[2][2][4][2], const Unit& u, int t, int wr, int wc, int fr, int fq) const {
        if (t != 16 && t != 24) return;
        int rowb = u.pm * BM + wr * 64 + fr; asm volatile("" : "+v"(rowb));
#pragma unroll
        for (int ai = 0; ai < 2; ++ai)
#pragma unroll
            for (int m = 0; m < 4; ++m) { float ra, r0, r1; rf.get(rowb + ai * HALF + m * 16, ra, r0, r1);
                const float sc = (t == 16) ? ra / r0 : r0 / r1;
#pragma unroll
                for (int bj = 0; bj < 2; ++bj)
#pragma unroll
                    for (int n = 0; n < 2; ++n) acc[ai][bj][m][n] = acc[ai][bj][m][n] * sc; }
    }
};
struct NoMid { static constexpr bool ENABLED = false; template <class ACC> __device__ __forceinline__ void operator()(ACC&, const Unit&, int, int, int, int, int) const {} };
template <class Epi, class Sched, class Mid, bool ALIGN_EPI = false, bool SP2 = false>
__device__ __forceinline__ void gemm_phase(int wv, PG8_LAS unsigned char* lds, const Gemm g, const Sched& S, const Epi& E, const Mid& MH) {
    int lane_ = (int)__builtin_amdgcn_mbcnt_hi(~0u, __builtin_amdgcn_mbcnt_lo(~0u, 0u)); asm volatile("" : "+v"(lane_));
    const int lane = lane_, wid = wv, tid = (wv << 6) | lane, wr = wid >> 2, wc = wid & 3, fr = lane & 15, fq = lane >> 4;
    const int K = g.K, nt = K / BK;
    unsigned voffA[2], voffB[2];
#pragma unroll
    for (int i = 0; i < 2; ++i) { int R, C; stage_rc(tid * 16 + i * 8192, R, C); const int Rb = Epi::PERM ? ((R & ~31) + perm32(R & 31)) : R;
        voffA[i] = g.amode == 0 ? (unsigned)(R * g.lda + C) * 2u : (unsigned)((R >> 2) * 49152 + (R & 3) * 128 + C * 2); voffB[i] = (unsigned)(Rb * K + C) * 2u; }
    const size_t kstep = (size_t)(BK * 2);
    const size_t hstep = (size_t)HALF * K * 2;
    const size_t tstep = 2 * hstep;
    const size_t kstepA = g.amode == 0 ? (size_t)(BK * 2) : (size_t)3072;
    const size_t hstepA = g.amode == 0 ? (size_t)HALF * g.lda * 2 : (size_t)32 * 49152;
    const size_t tstepA = 2 * hstepA;
#define PG8_AK(base, t) ((base) + (size_t)(t) * kstepA + (((t) >= g.ksplit) ? g.kdelta : 0l))
    const unsigned ldsw = (unsigned)wid * 1024u;
    const int aoff = lds_byte(wr * 64 + fr, fq * 8), boff = lds_byte(wc * 32 + fr, fq * 8);
#define PG8_SA(b, h) (((b) * 2 + (h)) * HTB)
#define PG8_SB(b, h) ((4 + (b) * 2 + (h)) * HTB)
#define PG8_STAGE(bufoff, gbase, voff) do { _Pragma("unroll") for (int _i = 0; _i < 2; ++_i) \
        __builtin_amdgcn_global_load_lds((const unsigned*)((const char*)(gbase) + (voff)[_i]), (PG8_LAS unsigned*)(lds + (bufoff) + ldsw + _i * 8192), 16, 0, 0); } while (0)
#define PG8_LDA(dst, b, h) do { _Pragma("unroll") for (int m = 0; m < 4; ++m) _Pragma("unroll") for (int k = 0; k < 2; ++k) dst[m][k] = *(const PG8_LAS bf16x8*)(lds + PG8_SA(b, h) + aoff + m * 2048 + k * 1024); } while (0)
#define PG8_LDB(dst, b, h) do { _Pragma("unroll") for (int n = 0; n < 2; ++n) _Pragma("unroll") for (int k = 0; k < 2; ++k) dst[n][k] = *(const PG8_LAS bf16x8*)(lds + PG8_SB(b, h) + boff + n * 2048 + k * 1024); } while (0)
#define PG8_MMA(ai, bj, At, Bt) do { __builtin_amdgcn_s_setprio(1); _Pragma("unroll") for (int m = 0; m < 4; ++m) _Pragma("unroll") for (int n = 0; n < 2; ++n) _Pragma("unroll") for (int k = 0; k < 2; ++k) \
        acc[ai][bj][m][n] = __builtin_amdgcn_mfma_f32_16x16x32_bf16(Bt[n][k], At[m][k], acc[ai][bj][m][n], 0, 0, 0); __builtin_amdgcn_s_setprio(0); } while (0)
#define PG8_WAIT_V(n) asm volatile("s_waitcnt vmcnt(" #n ")" ::: "memory")
#define PG8_WAIT_L(n) asm volatile("s_waitcnt lgkmcnt(" #n ")" ::: "memory")
#define PG8_BAR __builtin_amdgcn_s_barrier()
#define PG8_SCHED __builtin_amdgcn_sched_barrier(0)
    Unit cur, nxt; int ui = 0;
    if (!S.next(0, cur)) return;
    f32x4 acc[2][2][4][2];
#pragma unroll
    for (int a = 0; a < 2; ++a)
#pragma unroll
        for (int b = 0; b < 2; ++b)
#pragma unroll
            for (int m = 0; m < 4; ++m)
#pragma unroll
                for (int n = 0; n < 2; ++n) acc[a][b][m][n] = (f32x4){0.f, 0.f, 0.f, 0.f};
    bf16x8 At[4][2], B0[2][2], B1[2][2];
    const char* cA = (const char*)g.A + (size_t)cur.pm * tstepA; const char* cB = (const char*)g.Bt + (size_t)cur.pn * tstep;
    S.a_ready(cur);
    if constexpr (SP2) {
        PG8_STAGE(PG8_SB(0, 0), cB, voffB); PG8_STAGE(PG8_SB(0, 1), cB + hstep, voffB); PG8_STAGE(PG8_SA(0, 0), cA, voffA); PG8_STAGE(PG8_SA(0, 1), cA + hstepA, voffA);
        if (wr == 1) PG8_BAR;
        PG8_WAIT_V(2); PG8_BAR;
        PG8_STAGE(PG8_SB(1, 0), cB + kstep, voffB); PG8_STAGE(PG8_SA(1, 0), PG8_AK(cA, 1), voffA); PG8_STAGE(PG8_SB(1, 1), cB + hstep + kstep, voffB);
        PG8_WAIT_V(6); PG8_BAR;
    } else {
        PG8_STAGE(PG8_SB(0, 0), cB, voffB); PG8_STAGE(PG8_SA(0, 0), cA, voffA); PG8_STAGE(PG8_SB(0, 1), cB + hstep, voffB); PG8_STAGE(PG8_SA(0, 1), cA + hstepA, voffA);
        if (wr == 1) PG8_BAR;
        PG8_WAIT_V(4); PG8_BAR;
        PG8_STAGE(PG8_SB(1, 0), cB + kstep, voffB); PG8_STAGE(PG8_SA(1, 0), PG8_AK(cA, 1), voffA); PG8_STAGE(PG8_SB(1, 1), cB + hstep + kstep, voffB);
        PG8_WAIT_V(6); PG8_BAR;
    }
    for (;;) {
        const bool has_next = S.next(ui + 1, nxt);
        const char* nA = has_next ? (const char*)g.A + (size_t)nxt.pm * tstepA : cA; const char* nB = has_next ? (const char*)g.Bt + (size_t)nxt.pn * tstep : cB;
        for (int t = 0; t < nt; t += 2) {
            const bool last = (t == nt - 2);
            if (Mid::ENABLED) MH(acc, cur, t, wr, wc, fr, fq);
            const char* a1 = PG8_AK(cA, t + 1);
            const char* a2 = last ? nA : PG8_AK(cA, t + 2); const char* b2 = last ? nB : cB + (size_t)(t + 2) * kstep;
            const char* a3 = a2 + kstepA; const char* b3 = b2 + kstep;
            if (last && has_next) S.a_ready(nxt);
            if constexpr (SP2) {
            PG8_LDB(B0, 0, 0); PG8_LDB(B1, 0, 1); PG8_SCHED; PG8_LDA(At, 0, 0); PG8_STAGE(PG8_SA(1, 1), a1 + hstepA, voffA);
            PG8_WAIT_V(8); PG8_WAIT_L(0); PG8_BAR; PG8_MMA(0, 0, At, B0); PG8_MMA(0, 1, At, B1); PG8_BAR; PG8_SCHED;
            PG8_LDA(At, 0, 1); PG8_STAGE(PG8_SB(0, 0), b2, voffB); PG8_STAGE(PG8_SB(0, 1), b2 + hstep, voffB); PG8_STAGE(PG8_SA(0, 0), a2, voffA);
            PG8_WAIT_V(8); PG8_WAIT_L(0); PG8_BAR; PG8_MMA(1, 0, At, B0); PG8_MMA(1, 1, At, B1); PG8_BAR; PG8_SCHED;
            PG8_LDB(B0, 1, 0); PG8_LDB(B1, 1, 1); PG8_SCHED; PG8_LDA(At, 1, 0); PG8_STAGE(PG8_SA(0, 1), a2 + hstepA, voffA);
            PG8_WAIT_V(8); PG8_WAIT_L(0); PG8_BAR; PG8_MMA(0, 0, At, B0); PG8_MMA(0, 1, At, B1); PG8_BAR; PG8_SCHED;
            PG8_LDA(At, 1, 1); PG8_STAGE(PG8_SB(1, 0), b3, voffB); PG8_STAGE(PG8_SB(1, 1), b3 + hstep, voffB); PG8_STAGE(PG8_SA(1, 0), a3, voffA);
            PG8_WAIT_V(8); PG8_WAIT_L(0); PG8_BAR; PG8_MMA(1, 0, At, B0); PG8_MMA(1, 1, At, B1); PG8_BAR; PG8_SCHED;
            } else {
            PG8_LDB(B0, 0, 0); PG8_SCHED; PG8_LDA(At, 0, 0); PG8_STAGE(PG8_SA(1, 1), a1 + hstepA, voffA);
            PG8_WAIT_L(8); PG8_BAR; PG8_WAIT_L(0); PG8_MMA(0, 0, At, B0); PG8_BAR; PG8_SCHED;
            PG8_LDB(B1, 0, 1); PG8_STAGE(PG8_SB(0, 0), b2, voffB);
            PG8_BAR; PG8_WAIT_L(0); PG8_MMA(0, 1, At, B1); PG8_BAR;
            PG8_LDA(At, 0, 1); PG8_STAGE(PG8_SA(0, 0), a2, voffA);
            PG8_BAR; PG8_WAIT_L(0); PG8_MMA(1, 0, At, B0); PG8_BAR; PG8_SCHED;
            PG8_STAGE(PG8_SB(0, 1), b2 + hstep, voffB);
            PG8_WAIT_V(6); PG8_BAR; PG8_MMA(1, 1, At, B1); PG8_BAR;
            PG8_LDB(B0, 1, 0); PG8_SCHED; PG8_LDA(At, 1, 0); PG8_STAGE(PG8_SA(0, 1), a2 + hstepA, voffA);
            PG8_WAIT_L(8); PG8_BAR; PG8_WAIT_L(0); PG8_MMA(0, 0, At, B0); PG8_BAR; PG8_SCHED;
            PG8_LDB(B1, 1, 1); PG8_STAGE(PG8_SB(1, 0), b3, voffB);
            PG8_BAR; PG8_WAIT_L(0); PG8_MMA(0, 1, At, B1); PG8_BAR;
            PG8_LDA(At, 1, 1); PG8_STAGE(PG8_SA(1, 0), a3, voffA);
            PG8_BAR; PG8_WAIT_L(0); PG8_MMA(1, 0, At, B0); PG8_BAR; PG8_SCHED;
            PG8_STAGE(PG8_SB(1, 1), b3 + hstep, voffB);
            PG8_WAIT_V(6); PG8_BAR; PG8_MMA(1, 1, At, B1); PG8_BAR;
            }
        }
        if constexpr (ALIGN_EPI) { if (wr == 0) PG8_BAR; }
        if constexpr (!Epi::AFTER_DRAIN) { E(acc, cur, wr, wc, fr, fq); S.done(cur); }
        if (!has_next) break;
#pragma unroll
        for (int a = 0; a < 2; ++a)
#pragma unroll
            for (int b = 0; b < 2; ++b)
#pragma unroll
                for (int m = 0; m < 4; ++m)
#pragma unroll
                    for (int n = 0; n < 2; ++n) acc[a][b][m][n] = (f32x4){0.f, 0.f, 0.f, 0.f};
        cur = nxt; cA = nA; cB = nB; ++ui;
        if constexpr (ALIGN_EPI) { if (wr == 1) PG8_BAR; }
    }
    PG8_WAIT_V(0);
    if constexpr (!ALIGN_EPI) { if (wr == 0) PG8_BAR; }
    PG8_BAR;
    if constexpr (Epi::AFTER_DRAIN) { E.fused(acc, cur, wr, wc, fr, fq, lds, wid, lane); S.done(cur); }
#undef PG8_AK
#undef PG8_SA
#undef PG8_SB
#undef PG8_STAGE
#undef PG8_LDA
#undef PG8_LDB
#undef PG8_MMA
#undef PG8_WAIT_V
#undef PG8_WAIT_L
#undef PG8_BAR
#undef PG8_SCHED
}
}

__device__ __forceinline__ int winmap(int n) { return n < 2560 ? n : (n < 5120 ? n + 16 : (n < 5136 ? 2560 + (n - 5120) : n)); }
template <class Map>
__device__ __forceinline__ void transpose_item(const float* W, int ldw, bf16* WT, int K, int item, int nblk, float* scr, int lane, const Map& mp) {
    const int kb = item / nblk, nbk = item % nblk, k0 = 64 * kb, n0 = 32 * nbk;
    const int col = mp.scol(n0 + (lane & 31));
#pragma unroll 8
    for (int i = 0; i < 32; ++i) { const int kk = 2 * i + (lane >> 5); scr[kk * 33 + (lane & 31)] = col >= 0 ? W[(size_t)mp.srow(k0 + kk) * ldw + col] * mp.scale(k0 + kk) : 0.f; }
    const int c = lane & 7;
#pragma unroll
    for (int j = 0; j < 4; ++j) { const int n = (lane >> 3) + 8 * j; const float* s = scr + (8 * c) * 33 + n;
        *(uint4*)(WT + (size_t)(n0 + n) * K + k0 + 8 * c) = make_uint4(pk2bf(s[0], s[33]), pk2bf(s[66], s[99]), pk2bf(s[132], s[165]), pk2bf(s[198], s[231])); }
}
struct MapPlain { __device__ __forceinline__ int srow(int k) const { return k; } __device__ __forceinline__ int scol(int n) const { return n; } __device__ __forceinline__ float scale(int) const { return 1.f; } };
struct MapWin { __device__ __forceinline__ int srow(int k) const { return k; } __device__ __forceinline__ int scol(int n) const { return n < NPROJ ? winmap(n) : -1; } __device__ __forceinline__ float scale(int) const { return 1.f; } };
struct MapWout { const float* an; const float* sn;
    __device__ __forceinline__ int srow(int k) const { return (k + 1024) & 2047; } __device__ __forceinline__ int scol(int n) const { return n; } __device__ __forceinline__ float scale(int k) const { return k < 1024 ? an[k] : sn[k - 1024]; } };
__device__ __forceinline__ void ph_prep(const Params& p, int wv, unsigned char* lds) {
    PH_IDS(); unsigned char* ws = p.ws;
    bf16* xb = (bf16*)(ws + OFF_XB);
    for (size_t i = gtid; i < (size_t)T * D / 8; i += gn) { const float4 v = ((const float4*)p.x)[2 * i], w = ((const float4*)p.x)[2 * i + 1]; ((uint4*)xb)[i] = make_uint4(pk2bf(v.x, v.y), pk2bf(v.z, v.w), pk2bf(w.x, w.y), pk2bf(w.z, w.w)); }
    {
        float* scr = (float*)(lds + wv * 8448);
        constexpr int I_WIN = 16 * 168, I_WOUT = 32 * 32, I_WQ = 16 * 64, I_W1 = 32 * 8, I_W2 = 4 * 2;
        constexpr int NIT = I_WIN + I_WOUT + I_WQ + 2 * I_W1 + 2 * I_W2;
        for (int it = gwave; it < NIT; it += nwaves) {
            int r = it;
            if (r < I_WIN) { transpose_item(p.w_in, NPROJ, (bf16*)(ws + OFF_WIN), 1024, r, 168, scr, lane, MapWin{}); continue; } r -= I_WIN;
            if (r < I_WOUT) { transpose_item(p.w_out, 1024, (bf16*)(ws + OFF_WOUT), 2048, r, 32, scr, lane, MapWout{p.attn_norm_w, p.ssd_norm_w}); continue; } r -= I_WOUT;
            if (r < I_WQ) { transpose_item(p.peer_wq, 2048, (bf16*)(ws + OFF_WQ), 1024, r, 64, scr, lane, MapPlain{}); continue; } r -= I_WQ;
            if (r < I_W1) { transpose_item(p.cmp_w1_k, 256, (bf16*)(ws + OFF_W1K), 2048, r, 8, scr, lane, MapPlain{}); continue; } r -= I_W1;
            if (r < I_W1) { transpose_item(p.cmp_w1_v, 256, (bf16*)(ws + OFF_W1V), 2048, r, 8, scr, lane, MapPlain{}); continue; } r -= I_W1;
            if (r < I_W2) { transpose_item(p.cmp_w2_k, 64, (bf16*)(ws + OFF_W2K), 256, r, 2, scr, lane, MapPlain{}); continue; } r -= I_W2;
            transpose_item(p.cmp_w2_v, 64, (bf16*)(ws + OFF_W2V), 256, r, 2, scr, lane, MapPlain{});
        }
    }
    bf16* keys = (bf16*)(ws + OFF_KEYS);
    for (int i = gtid; i < 8 * 2 * 128 * 128; i += gn) keys[i] = f2bf(p.peer_keys[i]);
    float* rc = (float*)(ws + OFF_ROPE); float* rs = rc + 4096 * 32;
    for (int i = gtid; i < 4096 * 32; i += gn) {
        const int pos = i >> 5, j = i & 31;
        const float inv = powf(10000.0f, -(float)(2 * j) / 64.0f); const float angf = (float)pos * inv;
        double xr = (double)angf * 0.15915494309189535; xr -= rint(xr); const double rr = xr * 6.283185307179586, r2 = rr * rr;
        double s = -1.0 / 10888869450418352160768000000.0, c = 1.0 / 403291461126605635584000000.0;
        s = s * r2 + 1.0 / 15511210043330985984000000.0;  c = c * r2 - 1.0 / 620448401733239439360000.0;
        s = s * r2 - 1.0 / 25852016738884976640000.0;     c = c * r2 + 1.0 / 1124000727777607680000.0;
        s = s * r2 + 1.0 / 51090942171709440000.0;        c = c * r2 - 1.0 / 2432902008176640000.0;
        s = s * r2 - 1.0 / 121645100408832000.0;          c = c * r2 + 1.0 / 6402373705728000.0;
        s = s * r2 + 1.0 / 355687428096000.0;             c = c * r2 - 1.0 / 20922789888000.0;
        s = s * r2 - 1.0 / 1307674368000.0;               c = c * r2 + 1.0 / 87178291200.0;
        s = s * r2 + 1.0 / 6227020800.0;                  c = c * r2 - 1.0 / 479001600.0;
        s = s * r2 - 1.0 / 39916800.0;                    c = c * r2 + 1.0 / 3628800.0;
        s = s * r2 + 1.0 / 362880.0;                      c = c * r2 - 1.0 / 40320.0;
        s = s * r2 - 1.0 / 5040.0;                        c = c * r2 + 1.0 / 720.0;
        s = s * r2 + 1.0 / 120.0;                         c = c * r2 - 1.0 / 24.0;
        s = s * r2 - 1.0 / 6.0;                           c = c * r2 + 0.5;
        s = s * r2 + 1.0;                                 c = c * r2 - 1.0;
        s = s * rr; c = -c;
        rc[i] = (float)c; rs[i] = (float)s;
    }
    float* b1p = (float*)(ws + OFF_HID);
    for (int o = gwave; o < 64; o += nwaves) {
        const int mat = o >> 5, kc = o & 31; const float* pos = mat ? p.cmp_pos_v : p.cmp_pos_k; const float* w1 = mat ? p.cmp_w1_v : p.cmp_w1_k;
        float4 acc = make_float4(0.f, 0.f, 0.f, 0.f);
#pragma unroll 8
        for (int k = kc * 64; k < kc * 64 + 64; ++k) { const float pk = pos[k]; const float4 w = *(const float4*)(w1 + (size_t)k * 256 + 4 * lane); acc.x += pk * w.x; acc.y += pk * w.y; acc.z += pk * w.z; acc.w += pk * w.w; }
        *(float4*)(b1p + (size_t)o * 256 + 4 * lane) = acc;
    }
}

__device__ __forceinline__ void unpack8(const uint4& w, float* f) { f[0] = __uint_as_float(w.x << 16); f[1] = __uint_as_float(w.x & 0xffff0000u); f[2] = __uint_as_float(w.y << 16); f[3] = __uint_as_float(w.y & 0xffff0000u);
    f[4] = __uint_as_float(w.z << 16); f[5] = __uint_as_float(w.z & 0xffff0000u); f[6] = __uint_as_float(w.w << 16); f[7] = __uint_as_float(w.w & 0xffff0000u); }
__device__ __forceinline__ uint4 pack8(const float* f) { return make_uint4(pk2bf(f[0], f[1]), pk2bf(f[2], f[3]), pk2bf(f[4], f[5]), pk2bf(f[6], f[7])); }
__device__ __forceinline__ void ph_tokprep(const Params& p, int wv) {
    PH_IDS(); unsigned char* ws = p.ws;
    const int gtid_ = (nb > 64 ? bid - 32 : bid) * NTHREADS + tid, gn_ = (nb > 64 ? nb - 32 : nb) * NTHREADS;
    const bf16* xbc = (const bf16*)p.out; bf16* xsbc = (bf16*)(ws + OFF_XSBC);
    for (int it = gtid_; it < (T / 16) * 192; it += gn_) {
        const int cg = it % 192, tg = it / 192, ch = cg * 8, t0 = tg * 16, l0 = t0 & (L - 1);
        float w[4][8], bias[8];
#pragma unroll
        for (int j = 0; j < 4; ++j) { const float4 a = *(const float4*)(p.conv_w + j * 1536 + ch), b2 = *(const float4*)(p.conv_w + j * 1536 + ch + 4); w[j][0] = a.x; w[j][1] = a.y; w[j][2] = a.z; w[j][3] = a.w; w[j][4] = b2.x; w[j][5] = b2.y; w[j][6] = b2.z; w[j][7] = b2.w; }
        { const float4 a = *(const float4*)(p.conv_b + ch), b2 = *(const float4*)(p.conv_b + ch + 4); bias[0] = a.x; bias[1] = a.y; bias[2] = a.z; bias[3] = a.w; bias[4] = b2.x; bias[5] = b2.y; bias[6] = b2.z; bias[7] = b2.w; }
        float x0[8], x1[8], x2[8], x3[8];
        { uint4 h0 = make_uint4(0u, 0u, 0u, 0u), h1 = h0, h2 = h0;
          if (l0 != 0) { h0 = *(const uint4*)(xbc + (size_t)(t0 - 3) * 1536 + ch); h1 = *(const uint4*)(xbc + (size_t)(t0 - 2) * 1536 + ch); h2 = *(const uint4*)(xbc + (size_t)(t0 - 1) * 1536 + ch); }
          unpack8(h0, x0); unpack8(h1, x1); unpack8(h2, x2); }
#pragma unroll
        for (int u = 0; u < 16; ++u) {
            unpack8(*(const uint4*)(xbc + (size_t)(t0 + u) * 1536 + ch), x3);
            float y[8];
#pragma unroll
            for (int i = 0; i < 8; ++i) { const float v = bias[i] + w[0][i] * x0[i] + w[1][i] * x1[i] + w[2][i] * x2[i] + w[3][i] * x3[i]; y[i] = v * sigmoidf(v); x0[i] = x1[i]; x1[i] = x2[i]; x2[i] = x3[i]; }
            *(uint4*)(xsbc + (size_t)(t0 + u) * 1536 + ch) = pack8(y);
        }
    }
    const bf16* dtg = (const bf16*)(ws + OFF_DTG); float* dt = (float*)(ws + OFF_DT); float* gate = (float*)(ws + OFF_GATE);
    for (int i = gtid_; i < T * 64; i += gn_) {
        const int t = i >> 6, c = i & 63; const float v = bf2f(dtg[i]);
        if (c < 16) { const float xx = v + p.dt_bias[c]; dt[t * 16 + c] = xx > 20.f ? xx : log1pf(__expf(xx)); }
        else gate[t * 48 + (c - 16)] = sigmoidf(v);
    }
    const float* rc = (const float*)(ws + OFF_ROPE); const float* rs = rc + 4096 * 32;
    bf16* q = (bf16*)(ws + OFF_Q); bf16* kvs = (bf16*)(ws + OFF_KVS);
    for (int it = gtid_; it < T * 24 * 4; it += gn_) {
        const int j0 = (it & 3) * 8, hh = (it >> 2) % 24, t = it / 96, l = t & (L - 1);
        bf16* pp; float sc;
        if (hh < 16) { pp = q + (size_t)t * 1024 + hh * 64 + j0; sc = 0.125f * 1.4426950408889634f; } else if (hh < 20) { pp = kvs + (size_t)t * 1536 + 512 + (hh - 16) * 64 + j0; sc = 1.f; } else { pp = kvs + (size_t)t * 1536 + 1024 + (hh - 20) * 64 + j0; sc = 1.f; }
        float x1[8], x2[8], c[8], s[8], o1[8], o2[8];
        unpack8(*(const uint4*)pp, x1); unpack8(*(const uint4*)(pp + 32), x2);
        { const float4 a = *(const float4*)(rc + l * 32 + j0), b2 = *(const float4*)(rc + l * 32 + j0 + 4), d = *(const float4*)(rs + l * 32 + j0), e = *(const float4*)(rs + l * 32 + j0 + 4);
          c[0] = a.x; c[1] = a.y; c[2] = a.z; c[3] = a.w; c[4] = b2.x; c[5] = b2.y; c[6] = b2.z; c[7] = b2.w; s[0] = d.x; s[1] = d.y; s[2] = d.z; s[3] = d.w; s[4] = e.x; s[5] = e.y; s[6] = e.z; s[7] = e.w; }
#pragma unroll
        for (int i = 0; i < 8; ++i) { o1[i] = (x1[i] * c[i] - x2[i] * s[i]) * sc; o2[i] = (x1[i] * s[i] + x2[i] * c[i]) * sc; }
        *(uint4*)pp = pack8(o1); *(uint4*)(pp + 32) = pack8(o2);
    }
}

__device__ __forceinline__ void ph_ssd_prep2(const Params& p, int wv, unsigned char* lds) {
    PH_IDS(); unsigned char* ws = p.ws;
    const bf16* xsbc = (const bf16*)(ws + OFF_XSBC); const float* dt = (const float*)(ws + OFF_DT);
    bf16* XdT = (bf16*)p.out; bf16* BT = (bf16*)(ws + OFF_BT); float* acsT = (float*)(ws + OFF_ACS);
    float* sdt = (float*)lds; float* swave = sdt + 128;
    const int bide = bid, nbe = nb;
    for (int unit = bide; unit < 2048 + 256; unit += nbe) {
        __syncthreads();
        if (unit < 2048) {
            const int h = unit & 15, bc = unit >> 4; const size_t t0 = (size_t)bc * 128;
            const float A = -__expf(p.a_log[h]);
            if (tid < 128) { const float dv = dt[(t0 + tid) * 16 + h]; sdt[tid] = dv; float a = dv * A;
#pragma unroll
                for (int o = 1; o < 64; o <<= 1) { const float v = __shfl_up(a, o); if (lane >= o) a += v; }
                if (lane == 63) swave[tid >> 6] = a;
                sdt[128 + 8 + tid] = a; }
            __syncthreads();
            if (tid < 128) { float a = sdt[128 + 8 + tid]; if (tid >= 64) a += swave[0]; acsT[(size_t)unit * 128 + tid] = a; }
            const int pp = tid & 63, lg = tid >> 6; const bf16* src = xsbc + (t0 + lg * 16) * 1536 + h * 64 + pp;
            unsigned w[8];
#pragma unroll
            for (int i = 0; i < 8; ++i) { const float v0 = bf2f(src[(size_t)(2 * i) * 1536]) * sdt[lg * 16 + 2 * i], v1 = bf2f(src[(size_t)(2 * i + 1) * 1536]) * sdt[lg * 16 + 2 * i + 1]; w[i] = (unsigned)f2bf(v0) | ((unsigned)f2bf(v1) << 16); }
            uint4* dst = (uint4*)(XdT + (size_t)unit * 8192 + pp * 128 + lg * 16);
            dst[0] = make_uint4(w[0], w[1], w[2], w[3]); dst[1] = make_uint4(w[4], w[5], w[6], w[7]);
        } else {
            const int u2 = unit - 2048, g = u2 & 1, bc = u2 >> 1; const size_t t0 = (size_t)bc * 128;
            const int n = tid & 127, lg = tid >> 7; const bf16* src = xsbc + (t0 + lg * 32) * 1536 + 1024 + g * 128 + n;
            uint4* dst = (uint4*)(BT + (size_t)u2 * 16384 + n * 128 + lg * 32);
#pragma unroll
            for (int k = 0; k < 4; ++k) { unsigned w[4];
#pragma unroll
                for (int i = 0; i < 4; ++i) w[i] = (unsigned)src[(size_t)(8 * k + 2 * i) * 1536] | ((unsigned)src[(size_t)(8 * k + 2 * i + 1) * 1536] << 16);
                dst[k] = make_uint4(w[0], w[1], w[2], w[3]); }
        }
    }
}
__device__ __forceinline__ void ph_ssd_states(const Params& p, int wv) {
    PH_IDS(); unsigned char* ws = p.ws; const int rr = lane & 31, hi = lane >> 5;
    const bf16* XdT = (const bf16*)p.out; bf16* S = (bf16*)((unsigned char*)p.out + 32 * MiB); const bf16* BT = (const bf16*)(ws + OFF_BT); const float* acsT = (const float*)(ws + OFF_ACS);
    for (int unit = gwave; unit < 2048; unit += nwaves) {
        const int h = unit & 15, bc = unit >> 4, g = h >> 3;
        const float* ac = acsT + (size_t)unit * 128; const float alast = ac[127];
        const bf16* xrow = XdT + (size_t)unit * 8192 + rr * 128 + 8 * hi; const bf16* bt = BT + (size_t)(bc * 2 + g) * 16384 + rr * 128 + 8 * hi;
        f32x16 acc[4][2];
#pragma unroll
        for (int nt = 0; nt < 4; ++nt)
#pragma unroll
            for (int pt = 0; pt < 2; ++pt)
#pragma unroll
                for (int e = 0; e < 16; ++e) acc[nt][pt][e] = 0.f;
#pragma unroll 2
        for (int ks = 0; ks < 8; ++ks) {
            const int l0 = ks * 16 + 8 * hi; float dec[8];
            { const f32x4 a0 = *(const f32x4*)(ac + l0), a1 = *(const f32x4*)(ac + l0 + 4);
#pragma unroll
              for (int jx = 0; jx < 8; ++jx) dec[jx] = __expf(alast - (jx < 4 ? a0[jx] : a1[jx - 4])); }
            bf16x8 xf[2];
#pragma unroll
            for (int pt = 0; pt < 2; ++pt) { float f[8]; unpack8(*(const uint4*)(xrow + (size_t)pt * 4096 + ks * 16), f);
#pragma unroll
                for (int jx = 0; jx < 8; ++jx) f[jx] *= dec[jx];
                union { uint4 u; bf16x8 v; } cvu; cvu.u = pack8(f); xf[pt] = cvu.v; }
#pragma unroll
            for (int nt = 0; nt < 4; ++nt) { const bf16x8 bf_ = *(const bf16x8*)(bt + (size_t)nt * 4096 + ks * 16);
#pragma unroll
                for (int pt = 0; pt < 2; ++pt) acc[nt][pt] = __builtin_amdgcn_mfma_f32_32x32x16_bf16(bf_, xf[pt], acc[nt][pt], 0, 0, 0); }
        }
#pragma unroll
        for (int pt = 0; pt < 2; ++pt) { bf16* so = S + (size_t)unit * 8192 + (pt * 32 + rr) * 128 + 4 * hi;
#pragma unroll
            for (int nt = 0; nt < 4; ++nt)
#pragma unroll
                for (int a = 0; a < 4; ++a) *(uint2*)(so + nt * 32 + 8 * a) = make_uint2(pk2bf(acc[nt][pt][4 * a], acc[nt][pt][4 * a + 1]), pk2bf(acc[nt][pt][4 * a + 2], acc[nt][pt][4 * a + 3])); }
    }
}
__device__ __forceinline__ void ph_ssd_scan(const Params& p, int wv) {
    PH_IDS();
    unsigned* S = (unsigned*)((unsigned char*)p.out + 32 * MiB); const float* acsT = (const float*)(p.ws + OFF_ACS);
    for (int e = gtid; e < NBATCH * 16 * 4096; e += gn) {
        const int pn = e & 4095, h = (e >> 12) & 15, b = e >> 16; float r0 = 0.f, r1 = 0.f;
        for (int c = 0; c < 32; c += 4) {
            unsigned v[4]; float d[4];
#pragma unroll
            for (int u = 0; u < 4; ++u) { const int unit = (b * 32 + c + u) * 16 + h; v[u] = S[(size_t)unit * 4096 + pn]; d[u] = __expf(acsT[(size_t)unit * 128 + 127]); }
#pragma unroll
            for (int u = 0; u < 4; ++u) { const int unit = (b * 32 + c + u) * 16 + h; S[(size_t)unit * 4096 + pn] = (unsigned)f2bf(r0) | ((unsigned)f2bf(r1) << 16);
                r0 = r0 * d[u] + bf2f((bf16)(v[u] & 0xffffu)); r1 = r1 * d[u] + bf2f((bf16)(v[u] >> 16)); }
        }
    }
}
constexpr int SO_CBROW = 136;
__device__ __forceinline__ void ph_ssd_out(const Params& p, int wv, unsigned char* lds) {
    PH_IDS(); unsigned char* ws = p.ws; const int rr = lane & 31, hi = lane >> 5;
    const bf16* XdT = (const bf16*)p.out; const bf16* S = (const bf16*)((unsigned char*)p.out + 32 * MiB); const bf16* xsbc = (const bf16*)(ws + OFF_XSBC);
    const float* acsT = (const float*)(ws + OFF_ACS); bf16* z = (bf16*)(ws + OFF_Z); float* ssq2p = (float*)(ws + OFF_HID);
    bf16* CBl = (bf16*)lds;
    for (int unit = bid; unit < 256; unit += nb) {
        const int g = unit & 1, bc = unit >> 1; const size_t t0 = (size_t)bc * 128;
        __syncthreads();
        for (int ti = wv; ti < 10; ti += NWAVES) {
            int lt = 0, st = ti; if (st > 0) { st -= 1; lt = 1; if (st > 1) { st -= 2; lt = 2; if (st > 2) { st -= 3; lt = 3; } } }
            f32x16 acc;
#pragma unroll
            for (int e = 0; e < 16; ++e) acc[e] = 0.f;
            const bf16* arow = xsbc + (t0 + st * 32 + rr) * 1536 + 1024 + g * 128 + 8 * hi; const bf16* brow = xsbc + (t0 + lt * 32 + rr) * 1536 + 1280 + g * 128 + 8 * hi;
#pragma unroll
            for (int ks = 0; ks < 8; ++ks) acc = __builtin_amdgcn_mfma_f32_32x32x16_bf16(*(const bf16x8*)(arow + ks * 16), *(const bf16x8*)(brow + ks * 16), acc, 0, 0, 0);
            bf16* dst = CBl + (lt * 32 + rr) * SO_CBROW + st * 32 + 4 * hi;
#pragma unroll
            for (int a = 0; a < 4; ++a) *(uint2*)(dst + 8 * a) = make_uint2(pk2bf(acc[4 * a], acc[4 * a + 1]), pk2bf(acc[4 * a + 2], acc[4 * a + 3]));
        }
        __syncthreads();
        const int h = g * 8 + wv, uh = bc * 16 + h; const float* ac = acsT + (size_t)uh * 128; const float Dh = p.d_skip[h];
        const bf16* xd = XdT + (size_t)uh * 8192 + rr * 128 + 8 * hi; const bf16* sin = S + (size_t)uh * 8192 + rr * 128 + 8 * hi;
        f32x16 acc[2][4];
#pragma unroll
        for (int pt = 0; pt < 2; ++pt)
#pragma unroll
            for (int lt = 0; lt < 4; ++lt)
#pragma unroll
                for (int e = 0; e < 16; ++e) acc[pt][lt][e] = 0.f;
#pragma unroll
        for (int lt = 0; lt < 4; ++lt) {
            const int l = lt * 32 + rr; const float acl = ac[l]; const float eal = __expf(acl);
#pragma unroll
            for (int ks = 0; ks < 2 * lt + 2; ++ks) {
                const int s0 = ks * 16 + 8 * hi; float cb[8]; unpack8(*(const uint4*)(CBl + l * SO_CBROW + s0), cb);
                const f32x4 a0 = *(const f32x4*)(ac + s0), a1 = *(const f32x4*)(ac + s0 + 4);
#pragma unroll
                for (int jx = 0; jx < 8; ++jx) { const float as = jx < 4 ? a0[jx] : a1[jx - 4]; cb[jx] = (s0 + jx <= l) ? cb[jx] * __expf(acl - as) : 0.f; }
                union { uint4 u; bf16x8 v; } mf; mf.u = pack8(cb);
#pragma unroll
                for (int pt = 0; pt < 2; ++pt) acc[pt][lt] = __builtin_amdgcn_mfma_f32_32x32x16_bf16(*(const bf16x8*)(xd + (size_t)pt * 4096 + ks * 16), mf.v, acc[pt][lt], 0, 0, 0);
            }
            const bf16* crow_ = xsbc + (t0 + l) * 1536 + 1280 + g * 128 + 8 * hi;
#pragma unroll
            for (int ks = 0; ks < 8; ++ks) {
                float cf[8]; unpack8(*(const uint4*)(crow_ + ks * 16), cf);
#pragma unroll
                for (int jx = 0; jx < 8; ++jx) cf[jx] *= eal;
                union { uint4 u; bf16x8 v; } bf_; bf_.u = pack8(cf);
#pragma unroll
                for (int pt = 0; pt < 2; ++pt) acc[pt][lt] = __builtin_amdgcn_mfma_f32_32x32x16_bf16(*(const bf16x8*)(sin + (size_t)pt * 4096 + ks * 16), bf_.v, acc[pt][lt], 0, 0, 0);
            }
            const size_t t = t0 + l; float ss = 0.f;
#pragma unroll
            for (int pt = 0; pt < 2; ++pt)
#pragma unroll
                for (int a = 0; a < 4; ++a) {
                    const int col = h * 64 + pt * 32 + 8 * a + 4 * hi;
                    const uint2 xw = *(const uint2*)(xsbc + t * 1536 + col), zw = *(const uint2*)(z + t * 1024 + col);
                    const float xs0 = bflo(xw.x), xs1 = bfhi(xw.x), xs2 = bflo(xw.y), xs3 = bfhi(xw.y), z0 = bflo(zw.x), z1 = bfhi(zw.x), z2 = bflo(zw.y), z3 = bfhi(zw.y);
                    const float v0 = (acc[pt][lt][4 * a] + Dh * xs0) * (z0 * sigmoidf(z0)), v1 = (acc[pt][lt][4 * a + 1] + Dh * xs1) * (z1 * sigmoidf(z1));
                    const float v2 = (acc[pt][lt][4 * a + 2] + Dh * xs2) * (z2 * sigmoidf(z2)), v3 = (acc[pt][lt][4 * a + 3] + Dh * xs3) * (z3 * sigmoidf(z3));
                    ss += (v0 * v0 + v1 * v1) + (v2 * v2 + v3 * v3);
                    *(uint2*)(z + t * 1024 + col) = make_uint2(pk2bf(v0, v1), pk2bf(v2, v3));
                }
            ss += __shfl_xor(ss, 32);
            if (hi == 0) ssq2p[t * 16 + h] = ss;
        }
    }
}

struct EpiKc {
    bf16* dst; bool tr; __device__ __forceinline__ void operator()(int m, int c, float v) const { const int hk = m & 3, n = (m >> 2) & 255, b = m >> 10; const bf16 o = (n == 255) ? (bf16)0 : f2bf(v);
        if (tr) dst[((size_t)(b * 4 + hk) * 64 + c) * 256 + ((n & ~12) | ((n & 4) << 1) | ((n & 8) >> 1))] = o; else dst[((size_t)(b * 4 + hk) * 256 + n) * 64 + c] = o; } };
__device__ __forceinline__ void ph_kc_rope(const Params& p, int wv) {
    PH_IDS(); unsigned char* ws = p.ws; bf16* kc = (bf16*)(ws + OFF_KC); const float* rc = (const float*)(ws + OFF_ROPE); const float* rs = rc + 4096 * 32;
    for (int i = gtid; i < 16 * 256 * 32; i += gn) {
        const int j = i & 31, n = (i >> 5) & 255, bh = i >> 13; const int pos = 16 * n + 31; if (n == 255) continue;
        const float c = rc[pos * 32 + j], s = rs[pos * 32 + j];
        bf16* pp = kc + ((size_t)bh * 256 + n) * 64 + j; const float x1 = bf2f(pp[0]), x2 = bf2f(pp[32]);
        pp[0] = f2bf(x1 * c - x2 * s); pp[32] = f2bf(x1 * s + x2 * c);
    }
}


__device__ __forceinline__ void ph_vt_prep(const Params& p, int wv) {
    PH_IDS(); unsigned char* ws = p.ws; const bf16* kvs = (const bf16*)(ws + OFF_KVS);
    const int bide = bid, nbe = nb;
    for (int unit = bide; unit < 2 * 16 * 64; unit += nbe) {
        const int br = unit & 1, tl = (unit >> 1) & 63, bh = unit >> 7, b = bh >> 2, hk = bh & 3;
        const int d = tid & 63, grp = tid >> 6; const int l0 = tl * 64 + grp * 8;
        const bf16* src = kvs + ((size_t)b * L + l0) * 1536 + (br ? 1280 : 768) + hk * 64 + d;
        unsigned w[4];
#pragma unroll
        for (int i = 0; i < 4; ++i) w[i] = (unsigned)src[(size_t)(2 * i) * 1536] | ((unsigned)src[(size_t)(2 * i + 1) * 1536] << 16);
        bf16* dst = (bf16*)(ws + (br ? OFF_VWT : OFF_VST)) + ((size_t)bh * 64 + d) * L + (l0 & ~15) + 4 * ((l0 >> 3) & 1);
        *(uint2*)dst = make_uint2(w[0], w[1]); *(uint2*)(dst + 8) = make_uint2(w[2], w[3]);
    }
}

__device__ __forceinline__ float max3f(float a, float b, float c) { float r; asm("v_max3_f32 %0, %1, %2, %3" : "=v"(r) : "v"(a), "v"(b), "v"(c)); return r; }
__device__ __forceinline__ int crow(int r, int hi) { return (r & 3) + 8 * (r >> 2) + 4 * hi; }
constexpr int NSA_KBUF = 8192, NSA_VBUF = 8192;
constexpr int NSA_OFF_K = 0, NSA_OFF_V = 4 * NSA_KBUF;
constexpr int NSA_OFF_STASH = 73728;
constexpr int NSA_OFF_IMPA = NSA_OFF_STASH, NSA_IMPS = 65, NSA_OFF_IMPB = NSA_OFF_IMPA + 64 * NSA_IMPS * 4;
constexpr int NSA_OFF_SEL = NSA_OFF_STASH + 65536;
static_assert(NSA_OFF_V + 4 * NSA_VBUF <= NSA_OFF_STASH && NSA_OFF_IMPB + 64 * NSA_IMPS * 4 <= NSA_OFF_SEL && NSA_OFF_SEL + 1024 <= LDS_BYTES - 64, "NSA LDS map");
struct NsaSrc { const bf16* K; size_t kstride; const bf16* VT; size_t ldv; };
__device__ __forceinline__ void nsa_dma(const bf16* kp, const bf16* vp, unsigned char* kb, unsigned char* vb) {
    __builtin_amdgcn_global_load_lds((const unsigned*)kp, (PG8_LAS unsigned*)kb, 16, 0, 0);
    __builtin_amdgcn_global_load_lds((const unsigned*)vp, (PG8_LAS unsigned*)vb, 16, 0, 0);
}
__device__ __forceinline__ void nsa_qk(const unsigned char* kb, const bf16x8 (&qf)[4], int fo0, f32x16& p0, f32x16& p1) {
#pragma unroll
    for (int i = 0; i < 16; ++i) { p0[i] = 0.f; p1[i] = 0.f; }
    __builtin_amdgcn_s_setprio(1);
#pragma unroll
    for (int ds = 0; ds < 4; ++ds) {
        const bf16x8 a0 = *(const bf16x8*)(kb + (fo0 ^ (32 * ds))), a1 = *(const bf16x8*)(kb + (fo0 ^ (32 * ds)) + 4096);
        p0 = __builtin_amdgcn_mfma_f32_32x32x16_bf16(a0, qf[ds], p0, 0, 0, 0); p1 = __builtin_amdgcn_mfma_f32_32x32x16_bf16(a1, qf[ds], p1, 0, 0, 0);
    }
    __builtin_amdgcn_s_setprio(0);
}
__device__ __forceinline__ void nsa_pv(const unsigned char* vb, int fo0, const f32x16& p0, const f32x16& p1, f32x16 (&O)[2]) {
    __builtin_amdgcn_s_setprio(1);
#pragma unroll
    for (int s = 0; s < 4; ++s) {
        const int eb = 8 * (s & 1), kbase = 32 * (s >> 1) + 16 * (s & 1);
        union { uint4 u; bf16x8 v; } pf;
        if (s < 2) pf.u = make_uint4(pk2bf(p0[eb], p0[eb + 1]), pk2bf(p0[eb + 2], p0[eb + 3]), pk2bf(p0[eb + 4], p0[eb + 5]), pk2bf(p0[eb + 6], p0[eb + 7]));
        else       pf.u = make_uint4(pk2bf(p1[eb], p1[eb + 1]), pk2bf(p1[eb + 2], p1[eb + 3]), pk2bf(p1[eb + 4], p1[eb + 5]), pk2bf(p1[eb + 6], p1[eb + 7]));
#pragma unroll
        for (int dsub = 0; dsub < 2; ++dsub) {
            const bf16x8 vfv = *(const bf16x8*)(vb + (fo0 ^ (32 * s)) + dsub * 4096);
            O[dsub] = __builtin_amdgcn_mfma_f32_32x32x16_bf16(vfv, pf.v, O[dsub], 0, 0, 0);
        }
    }
    __builtin_amdgcn_s_setprio(0);
}
template <int MODE>
__device__ __forceinline__ void nsa_tile(unsigned char* lds, const unsigned char* kb, const unsigned char* vb, int jt, int rr, int hi, int fo0, const bf16x8 (&qf)[4], int lpos, int qi, int tokblk,
                                         u64 selm, float& m, float& lsum, float inv_l, f32x16 (&O)[2]) {
    float* impA = (float*)(lds + NSA_OFF_IMPA); float* impB = (float*)(lds + NSA_OFF_IMPB);
    f32x16 p0, p1; nsa_qk(kb, qf, fo0, p0, p1);
    asm volatile("s_nop 15\n\ts_nop 7" : "+v"(p0), "+v"(p1));
    const int k0 = jt * 64;
    const bool tile_on = (MODE != 2) || ((selm >> jt) & 1ull);
    bool full;
    if (MODE <= 1) full = (16 * (k0 + 63) + 31 <= qi * 64); else if (MODE == 2) full = (jt < qi); else full = (jt > qi - 8) && (jt < qi);
    float mx = NEG_INF, mx2 = NEG_INF;
    if (full) {
#pragma unroll
        for (int e = 0; e < 16; e += 2) { mx = max3f(mx, p0[e], p1[e]); mx2 = max3f(mx2, p0[e + 1], p1[e + 1]); }
        if (MODE == 2 && !tile_on) { mx = NEG_INF; mx2 = NEG_INF; }
    } else {
        const int lim = (MODE <= 1) ? (lpos - 31 - 16 * k0 - 64 * hi) : (lpos - k0 - 4 * hi);
#pragma unroll
        for (int e = 0; e < 16; ++e) {
            const int ca = (e & 3) + 8 * (e >> 2), cb = ca + 32; bool oa, ob;
            if (MODE <= 1) { oa = (16 * ca <= lim); ob = (16 * cb <= lim); }
            else if (MODE == 2) { oa = (ca <= lim); ob = (cb <= lim); }
            else { oa = (ca <= lim) && (ca > lim - 512); ob = (cb <= lim) && (cb > lim - 512); }
            p0[e] = oa ? p0[e] : NEG_INF; p1[e] = ob ? p1[e] : NEG_INF; if (e & 1) mx2 = max3f(mx2, p0[e], p1[e]); else mx = max3f(mx, p0[e], p1[e]);
        }
    }
    if (MODE != 1) {
        mx = max3f(mx, mx2, NEG_INF); mx = max3f(mx, __shfl_xor(mx, 32), NEG_INF);
        const float mnew = fmaxf(m, mx);
        if (__any((mnew - m) > 6.0f)) {
            const float alpha = __builtin_amdgcn_exp2f(m - mnew); m = mnew; lsum *= alpha;
            if (MODE != 0) {
#pragma unroll
                for (int e = 0; e < 16; ++e) { O[0][e] *= alpha; O[1][e] *= alpha; }
            }
        }
        const float meff = (MODE == 2 && full && !tile_on) ? BIG : ((m > 0.5f * NEG_INF) ? m : BIG);
        float rs = 0.f;
#pragma unroll
        for (int e = 0; e < 16; ++e) { p0[e] = __builtin_amdgcn_exp2f(p0[e] - meff); p1[e] = __builtin_amdgcn_exp2f(p1[e] - meff); rs += p0[e] + p1[e]; }
        lsum += rs;
        if (MODE != 0) nsa_pv(vb, fo0, p0, p1, O);
    } else {
#pragma unroll
        for (int e = 0; e < 16; ++e) { p0[e] = __builtin_amdgcn_exp2f(p0[e] - m) * inv_l; p1[e] = __builtin_amdgcn_exp2f(p1[e] - m) * inv_l; }
        nsa_pv(vb, fo0, p0, p1, O);
#pragma unroll
        for (int sub = 0; sub < 2; ++sub)
#pragma unroll
            for (int a = 0; a < 4; ++a) {
                float G, last;
                if (sub == 0) { G = (p0[4 * a] + p0[4 * a + 1]) + (p0[4 * a + 2] + p0[4 * a + 3]); last = p0[4 * a + 3]; } else { G = (p1[4 * a] + p1[4 * a + 1]) + (p1[4 * a + 2] + p1[4 * a + 3]); last = p1[4 * a + 3]; }
                G += __shfl_xor(G, 1); G += __shfl_xor(G, 2); last += __shfl_xor(last, 1); last += __shfl_xor(last, 2);
                const int jj = (k0 >> 2) + 8 * sub + 2 * a + hi;
                if ((rr & 3) == 0) { impA[tokblk * NSA_IMPS + jj] = G; if (jj + 1 < 64) impB[tokblk * NSA_IMPS + jj + 1] = last; }
            }
    }
}
template <int MODE>
__device__ __forceinline__ void nsa_branch(unsigned char* lds, const NsaSrc& src, int jt0, int jt1, int wv, int lane, int rr, int hi, const bf16x8 (&qf)[4], int lpos, int qi, int tokblk,
                                           u64 selm, u64 wsel, float& m, float& lsum, float inv_l, f32x16 (&O)[2]) {
    if (jt0 >= jt1) return;
    asm volatile("" : "+v"(lane), "+v"(rr));
    const int srow = wv * 8 + (lane >> 3), sch = ((lane & 7) ^ ((srow >> 1) & 7)) * 8;
    const bf16* kp = src.K + (size_t)srow * src.kstride + sch + (size_t)(jt0 * 64) * src.kstride;
    const bf16* vp = src.VT + (size_t)srow * src.ldv + sch + jt0 * 64;
    const size_t kstep = 64 * src.kstride;
    const int fo0 = rr * 128 + ((hi ^ ((rr >> 1) & 7)) << 4);
    unsigned char* lw = lds + wv * 1024;
    nsa_dma(kp, vp, lw + NSA_OFF_K, lw + NSA_OFF_V);
    if (jt0 + 1 < jt1) nsa_dma(kp + kstep, vp + 64, lw + NSA_OFF_K + NSA_KBUF, lw + NSA_OFF_V + NSA_VBUF);
    kp += 2 * kstep; vp += 128;
    asm volatile("s_waitcnt vmcnt(0)" ::: "memory");
    __syncthreads();
    int par = 0;
    for (int jt = jt0; jt < jt1; jt += 2, par ^= 1) {
        const bool hasB = (jt + 1 < jt1), more = (jt + 2 < jt1), moreB = (jt + 3 < jt1);
        if (more) nsa_dma(kp, vp, lw + NSA_OFF_K + ((par ^ 1) * 2) * NSA_KBUF, lw + NSA_OFF_V + ((par ^ 1) * 2) * NSA_VBUF);
        if (moreB) nsa_dma(kp + kstep, vp + 64, lw + NSA_OFF_K + ((par ^ 1) * 2 + 1) * NSA_KBUF, lw + NSA_OFF_V + ((par ^ 1) * 2 + 1) * NSA_VBUF);
        kp += 2 * kstep; vp += 128;
        const unsigned char* kb = lds + NSA_OFF_K + (par * 2) * NSA_KBUF; const unsigned char* vb = lds + NSA_OFF_V + (par * 2) * NSA_VBUF;
        if ((MODE != 2) || ((wsel >> jt) & 1ull)) nsa_tile<MODE>(lds, kb, vb, jt, rr, hi, fo0, qf, lpos, qi, tokblk, selm, m, lsum, inv_l, O);
        if (hasB && ((MODE != 2) || ((wsel >> (jt + 1)) & 1ull))) nsa_tile<MODE>(lds, kb + NSA_KBUF, vb + NSA_VBUF, jt + 1, rr, hi, fo0, qf, lpos, qi, tokblk, selm, m, lsum, inv_l, O);
        asm volatile("s_waitcnt vmcnt(0)" ::: "memory");
        __syncthreads();
    }
}
__device__ __forceinline__ void ph_nsa(const Params& p, int wv, unsigned char* lds) {
    PH_IDS(); unsigned char* ws = p.ws; const int wave = wv, rr = lane & 31, hi = lane >> 5;
    bf16* q = (bf16*)(ws + OFF_Q); const bf16* kvs = (const bf16*)(ws + OFF_KVS);
    const float* gate = (const float*)(ws + OFF_GATE); float* ssq = (float*)(ws + OFF_SSQ);
    float* impA = (float*)(lds + NSA_OFF_IMPA); float* impB = (float*)(lds + NSA_OFF_IMPB); u64* selw = (u64*)(lds + NSA_OFF_SEL);
    unsigned* qctr = (unsigned*)(ws + OFF_BAR + 14336) + 64 * (bid & 7); volatile int* ucur = (volatile int*)(lds + NSA_OFF_SEL + 512);
    for (;;) {
        if (tid == 0) *ucur = (int)__hip_atomic_fetch_add(qctr, 1u, __ATOMIC_RELAXED, __HIP_MEMORY_SCOPE_AGENT);
        __syncthreads();
        const int u = *ucur;
        if (u >= 128) break;
        const int bh = (bid & 7) + 8 * (u & 1), qi = 63 - (u >> 1);
        const int b = bh >> 2, hk = bh & 3; const int tokblk = wave * 8 + (rr >> 2), g = rr & 3; const int lpos = qi * 64 + tokblk; const size_t t = (size_t)b * L + lpos;
        bf16* qrow = q + t * 1024 + (hk * 4 + g) * 64;
        bf16x8 qf[4];
#pragma unroll
        for (int ds = 0; ds < 4; ++ds) qf[ds] = *(const bf16x8*)(qrow + ds * 16 + hi * 8);
        for (int i = tid; i < 64 * NSA_IMPS; i += NTHREADS) { impA[i] = 0.f; impB[i] = 0.f; }
        __syncthreads();
        f32x16 O[2]; float* stash = (float*)(lds + NSA_OFF_STASH) + tid;
        const float g0 = gate[t * 48 + (hk * 4 + g) * 3 + 0], g1 = gate[t * 48 + (hk * 4 + g) * 3 + 1], g2 = gate[t * 48 + (hk * 4 + g) * 3 + 2];
        {
            NsaSrc s{(const bf16*)(ws + OFF_KC) + (size_t)bh * 256 * 64, 64, (const bf16*)(ws + OFF_VCT) + (size_t)bh * 64 * 256, 256};
            const int nct = (4 * qi + 3 + 63) >> 6;
            float m = NEG_INF, lsum = 0.f;
            nsa_branch<0>(lds, s, 0, nct, wv, lane, rr, hi, qf, lpos, qi, tokblk, 0ull, 0ull, m, lsum, 0.f, O);
            lsum += __shfl_xor(lsum, 32);
            const float inv_l = lsum > 0.f ? 1.0f / lsum : 0.f;
#pragma unroll
            for (int e = 0; e < 16; ++e) { O[0][e] = 0.f; O[1][e] = 0.f; }
            nsa_branch<1>(lds, s, 0, nct, wv, lane, rr, hi, qf, lpos, qi, tokblk, 0ull, 0ull, m, lsum, inv_l, O);
        }
        f32x16 Oc[2];
#pragma unroll
        for (int e = 0; e < 16; ++e) { Oc[0][e] = g0 * O[0][e]; Oc[1][e] = g0 * O[1][e]; }
        {
            const int tk = tid >> 3, jg = tid & 7; float v[8];
#pragma unroll
            for (int i = 0; i < 8; ++i) { const int j = jg * 8 + i; const float raw = impA[tk * NSA_IMPS + j] + impB[tk * NSA_IMPS + j];
                const bool causal = (j <= qi), forced = (j == 0) || (j == qi) || (j == qi - 1); v[i] = causal ? (forced ? BIG : raw) : NEG_INF; }
            __syncthreads();
#pragma unroll
            for (int i = 0; i < 8; ++i) impA[tk * NSA_IMPS + jg * 8 + i] = v[i];
            __syncthreads();
            int rank[8];
#pragma unroll
            for (int i = 0; i < 8; ++i) rank[i] = 0;
            for (int jj = 0; jj < 64; ++jj) { const float x = impA[tk * NSA_IMPS + jj];
#pragma unroll
                for (int i = 0; i < 8; ++i) rank[i] += (x > v[i] || (x == v[i] && jj < jg * 8 + i)) ? 1 : 0; }
            unsigned b8 = 0u;
#pragma unroll
            for (int i = 0; i < 8; ++i) b8 |= (rank[i] < 16 && jg * 8 + i <= qi) ? (1u << i) : 0u;
            const u64 full = (u64)b8 << (jg * 8); unsigned blo = (unsigned)full, bhi = (unsigned)(full >> 32);
            blo |= __shfl_xor(blo, 1); bhi |= __shfl_xor(bhi, 1); blo |= __shfl_xor(blo, 2); bhi |= __shfl_xor(bhi, 2); blo |= __shfl_xor(blo, 4); bhi |= __shfl_xor(bhi, 4);
            if (jg == 0) selw[tk] = (u64)blo | ((u64)bhi << 32);
            __syncthreads();
        }
        const u64 selm = selw[tokblk];
        __syncthreads();
#pragma unroll
        for (int e = 0; e < 16; ++e) { stash[e * 512] = Oc[0][e]; stash[(16 + e) * 512] = Oc[1][e]; }
        u64 wsel = selm;
        { unsigned lo = (unsigned)wsel, h2 = (unsigned)(wsel >> 32);
          lo |= __shfl_xor(lo, 4); h2 |= __shfl_xor(h2, 4); lo |= __shfl_xor(lo, 8); h2 |= __shfl_xor(h2, 8); lo |= __shfl_xor(lo, 16); h2 |= __shfl_xor(h2, 16);
          wsel = (u64)lo | ((u64)h2 << 32); }
        {
            NsaSrc s{kvs + (size_t)b * L * 1536 + 512 + hk * 64, 1536, (const bf16*)(ws + OFF_VST) + (size_t)bh * 64 * L, (size_t)L};
            float m = NEG_INF, lsum = 0.f;
#pragma unroll
            for (int e = 0; e < 16; ++e) { O[0][e] = 0.f; O[1][e] = 0.f; }
            nsa_branch<2>(lds, s, 0, qi + 1, wv, lane, rr, hi, qf, lpos, qi, tokblk, selm, wsel, m, lsum, 0.f, O);
            lsum += __shfl_xor(lsum, 32); const float sc = g1 / lsum;
#pragma unroll
            for (int e = 0; e < 16; ++e) { stash[e * 512] += sc * O[0][e]; stash[(16 + e) * 512] += sc * O[1][e]; }
        }
        {
            NsaSrc s{kvs + (size_t)b * L * 1536 + 1024 + hk * 64, 1536, (const bf16*)(ws + OFF_VWT) + (size_t)bh * 64 * L, (size_t)L};
            float m = NEG_INF, lsum = 0.f;
#pragma unroll
            for (int e = 0; e < 16; ++e) { O[0][e] = 0.f; O[1][e] = 0.f; }
            nsa_branch<3>(lds, s, qi >= 8 ? qi - 8 : 0, qi + 1, wv, lane, rr, hi, qf, lpos, qi, tokblk, 0ull, 0ull, m, lsum, 0.f, O);
            lsum += __shfl_xor(lsum, 32); const float sc = g2 / lsum;
#pragma unroll
            for (int e = 0; e < 16; ++e) { O[0][e] = stash[e * 512] + sc * O[0][e]; O[1][e] = stash[(16 + e) * 512] + sc * O[1][e]; }
        }
        float ss = 0.f;
#pragma unroll
        for (int dsub = 0; dsub < 2; ++dsub)
#pragma unroll
            for (int a = 0; a < 4; ++a) {
                const float v0 = O[dsub][4 * a], v1 = O[dsub][4 * a + 1], v2 = O[dsub][4 * a + 2], v3 = O[dsub][4 * a + 3];
                ss += (v0 * v0 + v1 * v1) + (v2 * v2 + v3 * v3);
                *(uint2*)(qrow + dsub * 32 + 8 * a + 4 * hi) = make_uint2(pk2bf(v0, v1), pk2bf(v2, v3));
            }
        ss += __shfl_xor(ss, 32); ss += __shfl_xor(ss, 1); ss += __shfl_xor(ss, 2);
        if (hi == 0 && g == 0) ssq[t * 4 + hk] = ss;
        __syncthreads();
    }
}

constexpr size_t OFF_SU = 640 * 1024, OFF_SV = 704 * 1024, OFF_SX = 768 * 1024, OFF_SC = 832 * 1024;
constexpr size_t OFF_COEFQ = 218 * MiB, OFF_H1Q = 220 * MiB;
__device__ __forceinline__ unsigned pack4i8(float a, float b, float c, float d) {
    const int ia = (int)rintf(a), ib = (int)rintf(b), ic = (int)rintf(c), id = (int)rintf(d);
    return (unsigned)(ia & 0xff) | ((unsigned)(ib & 0xff) << 8) | ((unsigned)(ic & 0xff) << 16) | ((unsigned)(id & 0xff) << 24);
}
__device__ __forceinline__ void ph_ln1(const Params& p, int wv) {
    PH_IDS(); unsigned char* ws = p.ws; bf16* h1b = (bf16*)(ws + OFF_H1B); unsigned char* h1q = ws + OFF_H1Q; float* sx = (float*)(ws + OFF_SX);
    for (int t = gwave; t < T; t += nwaves) {
        float v[16]; float s = 0.f; float* row = p.out + (size_t)t * 1024 + lane * 16;
#pragma unroll
        for (int i = 0; i < 4; ++i) { const float4 a = *(const float4*)(row + 4 * i); v[4 * i] = a.x; v[4 * i + 1] = a.y; v[4 * i + 2] = a.z; v[4 * i + 3] = a.w; s += (a.x + a.y) + (a.z + a.w); }
        const float mu = wave_sum(s) * (1.0f / 1024.0f); float s2 = 0.f;
#pragma unroll
        for (int i = 0; i < 16; ++i) { v[i] -= mu; s2 += v[i] * v[i]; }
        const float rstd = rsqrtf(wave_sum(s2) * (1.0f / 1024.0f) + LN_EPS); float amax = 0.f;
#pragma unroll
        for (int i = 0; i < 4; ++i) { const int c = lane * 16 + 4 * i; const float4 ga = *(const float4*)(p.ln1_g + c), ba = *(const float4*)(p.ln1_b + c);
            v[4 * i] = v[4 * i] * rstd * ga.x + ba.x; v[4 * i + 1] = v[4 * i + 1] * rstd * ga.y + ba.y; v[4 * i + 2] = v[4 * i + 2] * rstd * ga.z + ba.z; v[4 * i + 3] = v[4 * i + 3] * rstd * ga.w + ba.w;
            *(float4*)(row + 4 * i) = make_float4(v[4 * i], v[4 * i + 1], v[4 * i + 2], v[4 * i + 3]); }
#pragma unroll
        for (int i = 0; i < 16; ++i) amax = fmaxf(amax, fabsf(v[i]));
        amax = fmaxf(wave_max(amax), 1e-20f); const float inv = 127.0f / amax;
        *(uint4*)(h1b + (size_t)t * 1024 + lane * 16) = pack8(v); *(uint4*)(h1b + (size_t)t * 1024 + lane * 16 + 8) = pack8(v + 8);
        *(uint4*)(h1q + (size_t)t * 1024 + lane * 16) = make_uint4(pack4i8(v[0] * inv, v[1] * inv, v[2] * inv, v[3] * inv), pack4i8(v[4] * inv, v[5] * inv, v[6] * inv, v[7] * inv),
                                                                 pack4i8(v[8] * inv, v[9] * inv, v[10] * inv, v[11] * inv), pack4i8(v[12] * inv, v[13] * inv, v[14] * inv, v[15] * inv));
        if (lane == 0) sx[t] = amax * (1.0f / 127.0f);
    }
}

__device__ __forceinline__ unsigned umaxu(unsigned a, unsigned b) { return a > b ? a : b; }
__device__ __forceinline__ unsigned uminu(unsigned a, unsigned b) { return a < b ? a : b; }
__device__ __forceinline__ unsigned f2mono(float f) { const unsigned u = __float_as_uint(f); return (u & 0x80000000u) ? ~u : (u | 0x80000000u); }
__device__ __forceinline__ float mono2f(unsigned m) { return __uint_as_float((m & 0x80000000u) ? (m & 0x7fffffffu) : ~m); }
template <int N> __device__ __forceinline__ void bitonic_sort_desc(unsigned (&a)[N]) {
#pragma unroll
    for (int k = 2; k <= N; k <<= 1)
#pragma unroll
        for (int j = k >> 1; j > 0; j >>= 1)
#pragma unroll
            for (int i = 0; i < N; ++i) { const int l = i ^ j; if (l > i) { const bool desc = ((i & k) == 0); const unsigned x = a[i], y = a[l], mx = umaxu(x, y), mn = uminu(x, y); a[i] = desc ? mx : mn; a[l] = desc ? mn : mx; } }
}
__device__ __forceinline__ void merge_top16(unsigned (&a)[16], const unsigned (&b)[16]) {
#pragma unroll
    for (int i = 0; i < 16; ++i) a[i] = umaxu(a[i], b[15 - i]);
#pragma unroll
    for (int j = 8; j > 0; j >>= 1)
#pragma unroll
        for (int i = 0; i < 16; ++i) { const int l = i ^ j; if (l > i) { const unsigned x = a[i], y = a[l]; a[i] = umaxu(x, y); a[l] = uminu(x, y); } }
}
constexpr int PK_KROW = 272;
__device__ __forceinline__ void peer_stage1(const bf16* qrow, const unsigned char* krow, int hi, unsigned (&run)[16]) {
    bf16x8 qf[8];
#pragma unroll
    for (int ks = 0; ks < 8; ++ks) qf[ks] = *(const bf16x8*)(qrow + ks * 16);
#pragma unroll 1
    for (int kt = 0; kt < 4; ++kt) {
        f32x16 acc;
#pragma unroll
        for (int e = 0; e < 16; ++e) acc[e] = 0.f;
        const unsigned char* kr = krow + kt * 32 * PK_KROW;
#pragma unroll
        for (int ks = 0; ks < 8; ++ks) acc = __builtin_amdgcn_mfma_f32_32x32x16_bf16(*(const bf16x8*)(kr + ks * 32), qf[ks], acc, 0, 0, 0);
        unsigned grp[16]; const unsigned ib = (unsigned)(127 - kt * 32 - 4 * hi);
#pragma unroll
        for (int e = 0; e < 16; ++e) grp[e] = (f2mono(acc[e]) & ~0x7fu) | (ib - (unsigned)((e & 3) + 8 * (e >> 2)));
        bitonic_sort_desc<16>(grp);
        if (kt == 0) {
#pragma unroll
            for (int i = 0; i < 16; ++i) run[i] = grp[i];
        } else merge_top16(run, grp);
    }
    unsigned oth[16];
#pragma unroll
    for (int i = 0; i < 16; ++i) oth[i] = __shfl_xor(run[i], 32);
    merge_top16(run, oth);
}
__device__ __forceinline__ void ph_peer_topk(const Params& p, int wv, unsigned char* lds) {
    PH_IDS(); unsigned char* ws = p.ws; const int rr = lane & 31, hi = lane >> 5;
    unsigned char* kimg = lds; int* exl = (int*)(lds + 2 * 128 * PK_KROW + wv * 6400);
    const bf16* qp = (const bf16*)(ws + OFF_QP); const bf16* keys = (const bf16*)(ws + OFF_KEYS);
    int* eidx = (int*)(ws + OFF_EIDX); float* gw = (float*)(ws + OFF_GW);
    const int h = bid & 7;
    for (int i = tid; i < 256 * 16; i += NTHREADS) { const int row = i >> 4, ch = i & 15; *(uint4*)(kimg + row * PK_KROW + ch * 16) = *(const uint4*)(keys + ((size_t)h * 256 + row) * 128 + ch * 8); }
    __syncthreads();
    for (int tt = (bid >> 3) * NWAVES + wv; tt < 512; tt += (nb >> 3) * NWAVES) {
        const int t0 = tt * 32;
        unsigned top[2][16];
        peer_stage1(qp + (size_t)(t0 + rr) * 2048 + h * 256 + 8 * hi, kimg + rr * PK_KROW + 16 * hi, hi, top[0]);
        peer_stage1(qp + (size_t)(t0 + rr) * 2048 + h * 256 + 128 + 8 * hi, kimg + (128 + rr) * PK_KROW + 16 * hi, hi, top[1]);
        unsigned g4[4][16];
#pragma unroll
        for (int k = 0; k < 4; ++k)
#pragma unroll
            for (int i = 0; i < 16; ++i) g4[k][i] = 0u;
#pragma unroll
        for (int i = 0; i < 16; ++i) {
            int off = 0;
#pragma unroll
            for (int k = 0; k < 16; ++k) if (k < i) off += 16 / (k + 1);
            const float s0 = mono2f(top[0][i] & ~0x7fu); const int e0 = (int)(127u - (top[0][i] & 0x7fu)) * 128;
#pragma unroll
            for (int j = 0; j < 16; ++j) if ((i + 1) * (j + 1) <= 16) {
                const int nc = off + j;
                const float sum = s0 + mono2f(top[1][j] & ~0x7fu);
                g4[nc >> 4][nc & 15] = (f2mono(sum) & ~0x3fu) | (unsigned)(63 - nc);
                if (hi == 0) exl[nc * 32 + rr] = e0 + (int)(127u - (top[1][j] & 0x7fu));
            }
        }
#pragma unroll
        for (int k = 0; k < 4; ++k) bitonic_sort_desc<16>(g4[k]);
        merge_top16(g4[0], g4[1]); merge_top16(g4[2], g4[3]); merge_top16(g4[0], g4[2]);
        float e16[16]; float den = 0.f; const float gmax = mono2f(g4[0][0] & ~0x3fu);
#pragma unroll
        for (int r = 0; r < 16; ++r) { e16[r] = __expf(mono2f(g4[0][r] & ~0x3fu) - gmax); den += e16[r]; }
        const float inv = 1.0f / den; const size_t ob = (size_t)(t0 + rr) * 128 + h * 16 + hi * 8;
        float wo[8]; int eo[8];
#pragma unroll
        for (int k = 0; k < 8; ++k) { const unsigned key = hi ? g4[0][8 + k] : g4[0][k]; wo[k] = (hi ? e16[8 + k] : e16[k]) * inv; eo[k] = exl[(63 - (int)(key & 0x3fu)) * 32 + rr]; }
        *(float4*)(gw + ob) = make_float4(wo[0], wo[1], wo[2], wo[3]); *(float4*)(gw + ob + 4) = make_float4(wo[4], wo[5], wo[6], wo[7]);
        *(int4*)(eidx + ob) = make_int4(eo[0], eo[1], eo[2], eo[3]); *(int4*)(eidx + ob + 4) = make_int4(eo[4], eo[5], eo[6], eo[7]);
    }
}
constexpr int CVT_SPLIT = 24576;
__device__ __forceinline__ void ph_peer_cvt(const Params& p, int wv, int r0, int r1, int w0, int nw) {
    PH_IDS(); unsigned char* ws = p.ws;
    for (int r = r0 + w0; r < r1; r += nw) {
        const bool isv = r >= 16384; const int e = isv ? r - 16384 : r;
        const float* src = (isv ? p.peer_v : p.peer_u) + (size_t)e * 1024 + lane * 16; float v[16]; float amax = 0.f;
#pragma unroll
        for (int i = 0; i < 4; ++i) { const float4 a = *(const float4*)(src + 4 * i); v[4 * i] = a.x; v[4 * i + 1] = a.y; v[4 * i + 2] = a.z; v[4 * i + 3] = a.w; }
#pragma unroll
        for (int i = 0; i < 16; ++i) amax = fmaxf(amax, fabsf(v[i]));
        amax = fmaxf(wave_max(amax), 1e-30f); const float inv = 127.0f / amax;
        *(uint4*)(ws + (isv ? OFF_PV : OFF_PU) + (size_t)e * 1024 + lane * 16) = make_uint4(pack4i8(v[0] * inv, v[1] * inv, v[2] * inv, v[3] * inv), pack4i8(v[4] * inv, v[5] * inv, v[6] * inv, v[7] * inv),
                                                                                            pack4i8(v[8] * inv, v[9] * inv, v[10] * inv, v[11] * inv), pack4i8(v[12] * inv, v[13] * inv, v[14] * inv, v[15] * inv));
        if (lane == 0) ((float*)(ws + (isv ? OFF_SV : OFF_SU)))[e] = amax * (1.0f / 127.0f);
    }
}
constexpr size_t OFF_PART = 26 * MiB;
constexpr size_t OFF_Y = 26 * MiB;
static_assert(OFF_PART + 64 * MiB <= OFF_H1B && OFF_PV + 16 * MiB <= OFF_XSBC && OFF_VWT + 8 * MiB <= OFF_PU, "PEER scratch map");
#define PU_ISSUE16(W, ELO, EHI) do { _Pragma("unroll") for (int k = 0; k < 8; ++k) { const int e0 = __shfl(ELO, k * 8 + g), e1 = __shfl(EHI, k * 8 + g); \
        W[k] = *(const uint4*)(PU + (size_t)e0 * 1024 + 128 * s + 16 * j); W[8 + k] = *(const uint4*)(PU + (size_t)e1 * 1024 + 128 * s + 16 * j); } } while (0)
#define PU_DOT16(W, X) __builtin_amdgcn_sdot4((int)(W).w, (int)(X).w, __builtin_amdgcn_sdot4((int)(W).z, (int)(X).z, __builtin_amdgcn_sdot4((int)(W).y, (int)(X).y, __builtin_amdgcn_sdot4((int)(W).x, (int)(X).x, 0, false), false), false), false)
#define PU_REDUCE8(W, O, XQ, PROW, B) do { int d[8], a4[4], a2[2], a1; \
        _Pragma("unroll") for (int k = 0; k < 8; ++k) d[k] = PU_DOT16(W[(O) + k], XQ); \
        _Pragma("unroll") for (int k = 0; k < 4; ++k) { const int give = b2 ? d[k] : d[4 + k]; a4[k] = (b2 ? d[4 + k] : d[k]) + __shfl_xor(give, 4); } \
        _Pragma("unroll") for (int k = 0; k < 2; ++k) { const int give = b1 ? a4[k] : a4[2 + k]; a2[k] = (b1 ? a4[2 + k] : a4[k]) + __shfl_xor(give, 2); } \
        { const int give = b0 ? a2[0] : a2[1]; a1 = (b0 ? a2[1] : a2[0]) + __shfl_xor(give, 1); } \
        (PROW)[(B) * 64 + kk * 8 + g] = a1; } while (0)
#define PU_META(T_, XQ, ELO, EHI) do { const int tq_ = (T_) < T ? (T_) : tlast; XQ = *(const uint4*)(h1q + (size_t)tq_ * 1024 + 128 * s + 16 * j); \
        ELO = eidx[(size_t)tq_ * 128 + lane]; EHI = eidx[(size_t)tq_ * 128 + 64 + lane]; } while (0)
#define PU_TOKEN(W, T_, XQ) do { int* prow = part + ((size_t)s * T + (T_)) * 128; PU_REDUCE8(W, 0, XQ, prow, 0); PU_REDUCE8(W, 8, XQ, prow, 1); } while (0)
__device__ __forceinline__ void ph_peer_u(const Params& p, int wv) {
    PH_IDS(); unsigned char* ws = p.ws; const int s = bid & 7, cu = bid >> 3, ncu = nb >> 3, g = lane >> 3, j = lane & 7;
    const unsigned char* h1q = ws + OFF_H1Q; const int* eidx = (const int*)(ws + OFF_EIDX); const unsigned char* PU = ws + OFF_PU; int* part = (int*)(ws + OFF_PART);
    const bool b2 = (lane & 4) != 0, b1 = (lane & 2) != 0, b0 = (lane & 1) != 0; const int kk = (b2 ? 4 : 0) + (b1 ? 2 : 0) + (b0 ? 1 : 0);
    const int tstep = ncu * NWAVES; int t = cu * NWAVES + wv;
    if (t >= T) return;
    const int tlast = t;
    uint4 xq0, xq1; int el0, eh0, el1, eh1;
    PU_META(t, xq0, el0, eh0); PU_META(t + tstep, xq1, el1, eh1);
    uint4 wA[16], wB[16];
    PU_ISSUE16(wA, el0, eh0);
    for (;;) {
        { const uint4 cx = xq0; PU_META(t + 2 * tstep, xq0, el0, eh0); PU_ISSUE16(wB, el1, eh1); PU_TOKEN(wA, t, cx); }
        t += tstep; if (t >= T) break;
        { const uint4 cx = xq1; PU_META(t + 2 * tstep, xq1, el1, eh1); PU_ISSUE16(wA, el0, eh0); PU_TOKEN(wB, t, cx); }
        t += tstep; if (t >= T) break;
    }
}
__device__ __forceinline__ void ph_peer_c(const Params& p, int wv) {
    PH_IDS(); unsigned char* ws = p.ws; const int* part = (const int*)(ws + OFF_PART); const float* gw = (const float*)(ws + OFF_GW); const int* eidx = (const int*)(ws + OFF_EIDX);
    const float* su = (const float*)(ws + OFF_SU); const float* sv = (const float*)(ws + OFF_SV); const float* sx = (const float*)(ws + OFF_SX); float* sc = (float*)(ws + OFF_SC); unsigned* coefq = (unsigned*)(ws + OFF_COEFQ);
    for (int t = gwave; t < T; t += nwaves) {
        float cp[2];
#pragma unroll
        for (int b = 0; b < 2; ++b) { const size_t i = (size_t)t * 128 + b * 64 + lane; int acc = 0;
#pragma unroll
            for (int s = 0; s < 8; ++s) acc += part[(size_t)s * T * 128 + i];
            const int e = eidx[i]; cp[b] = gw[i] * gelu_exact((float)acc * su[e] * sx[t]) * sv[e]; }
        const float amax = fmaxf(wave_max(fmaxf(fabsf(cp[0]), fabsf(cp[1]))), 1e-30f), inv = 127.0f / amax;
        const int q0 = (int)rintf(cp[0] * inv) & 0xff, q1 = (int)rintf(cp[1] * inv) & 0xff;
        const int gg = lane & 7, kq = (lane >> 3) & 1;
        unsigned w0 = 0u, w1 = 0u;
#pragma unroll
        for (int i = 0; i < 4; ++i) { const int srcl = (4 * kq + i) * 8 + gg; w0 |= (unsigned)__shfl(q0, srcl) << (8 * i); w1 |= (unsigned)__shfl(q1, srcl) << (8 * i); }
        if (lane < 16) { coefq[(size_t)t * 32 + lane] = w0; coefq[(size_t)t * 32 + 16 + lane] = w1; }
        if (lane == 0) sc[t] = amax * (1.0f / 127.0f);
    }
}
#define PV_ISSUE16(W, ELO, EHI) do { _Pragma("unroll") for (int k = 0; k < 8; ++k) { const int e0 = __shfl(ELO, k * 8 + g), e1 = __shfl(EHI, k * 8 + g); \
        W[k] = *(const uint4*)(PV + (size_t)e0 * 1024 + 128 * s + 16 * j); W[8 + k] = *(const uint4*)(PV + (size_t)e1 * 1024 + 128 * s + 16 * j); } } while (0)
#define PV_META(T_, ELO, EHI, CQ) do { const int tq_ = (T_) < T ? (T_) : tlast; ELO = eidx[(size_t)tq_ * 128 + lane]; EHI = eidx[(size_t)tq_ * 128 + 64 + lane]; \
        CQ[0] = coefq[(size_t)tq_ * 32 + g]; CQ[1] = coefq[(size_t)tq_ * 32 + 8 + g]; CQ[2] = coefq[(size_t)tq_ * 32 + 16 + g]; CQ[3] = coefq[(size_t)tq_ * 32 + 24 + g]; } while (0)
#define PV_BLK(W0, W1, W2, W3, CQW, A0, A1, A2, A3) do { \
        const unsigned l01 = __builtin_amdgcn_perm(W1, W0, 0x05010400u), h01 = __builtin_amdgcn_perm(W1, W0, 0x07030602u), l23 = __builtin_amdgcn_perm(W3, W2, 0x05010400u), h23 = __builtin_amdgcn_perm(W3, W2, 0x07030602u); \
        A0 = __builtin_amdgcn_sdot4((int)__builtin_amdgcn_perm(l23, l01, 0x05040100u), (int)(CQW), A0, false); A1 = __builtin_amdgcn_sdot4((int)__builtin_amdgcn_perm(l23, l01, 0x07060302u), (int)(CQW), A1, false); \
        A2 = __builtin_amdgcn_sdot4((int)__builtin_amdgcn_perm(h23, h01, 0x05040100u), (int)(CQW), A2, false); A3 = __builtin_amdgcn_sdot4((int)__builtin_amdgcn_perm(h23, h01, 0x07060302u), (int)(CQW), A3, false); } while (0)
#define PV_QUAD(W, O, CQW) do { PV_BLK(W[(O)].x, W[(O) + 1].x, W[(O) + 2].x, W[(O) + 3].x, CQW, acc[0], acc[1], acc[2], acc[3]); PV_BLK(W[(O)].y, W[(O) + 1].y, W[(O) + 2].y, W[(O) + 3].y, CQW, acc[4], acc[5], acc[6], acc[7]); \
        PV_BLK(W[(O)].z, W[(O) + 1].z, W[(O) + 2].z, W[(O) + 3].z, CQW, acc[8], acc[9], acc[10], acc[11]); PV_BLK(W[(O)].w, W[(O) + 1].w, W[(O) + 2].w, W[(O) + 3].w, CQW, acc[12], acc[13], acc[14], acc[15]); } while (0)
#define PV_TOKEN(W, CQ, T_) do { int acc[16]; _Pragma("unroll") for (int i = 0; i < 16; ++i) acc[i] = 0; \
        PV_QUAD(W, 0, CQ[0]); PV_QUAD(W, 4, CQ[1]); PV_QUAD(W, 8, CQ[2]); PV_QUAD(W, 12, CQ[3]); \
        int y8[8], y4[4], y2[2]; \
        _Pragma("unroll") for (int i = 0; i < 8; ++i) { const int give = b5 ? acc[i] : acc[8 + i]; y8[i] = (b5 ? acc[8 + i] : acc[i]) + __shfl_xor(give, 32); } \
        _Pragma("unroll") for (int i = 0; i < 4; ++i) { const int give = b4 ? y8[i] : y8[4 + i]; y4[i] = (b4 ? y8[4 + i] : y8[i]) + __shfl_xor(give, 16); } \
        _Pragma("unroll") for (int i = 0; i < 2; ++i) { const int give = b3 ? y4[i] : y4[2 + i]; y2[i] = (b3 ? y4[2 + i] : y4[i]) + __shfl_xor(give, 8); } \
        const float sct = sc[(T_)]; *(float2*)(Y + (size_t)(T_) * 1024 + 128 * s + 16 * j + c0) = make_float2((float)y2[0] * sct, (float)y2[1] * sct); } while (0)
__device__ __forceinline__ void ph_peer_v(const Params& p, int wv) {
    PH_IDS(); unsigned char* ws = p.ws; const int s = bid & 7, cu = bid >> 3, ncu = nb >> 3, g = lane >> 3, j = lane & 7;
    const int* eidx = (const int*)(ws + OFF_EIDX); const unsigned* coefq = (const unsigned*)(ws + OFF_COEFQ); const float* sc = (const float*)(ws + OFF_SC); const unsigned char* PV = ws + OFF_PV; float* Y = (float*)(ws + OFF_Y);
    const bool b5 = (lane & 32) != 0, b4 = (lane & 16) != 0, b3 = (lane & 8) != 0; const int c0 = (b5 ? 8 : 0) + (b4 ? 4 : 0) + (b3 ? 2 : 0);
    const int tstep = ncu * NWAVES; int t = cu * NWAVES + wv;
    if (t >= T) return;
    const int tlast = t;
    int el0, eh0, el1, eh1; unsigned cq0[4], cq1[4];
    PV_META(t, el0, eh0, cq0); PV_META(t + tstep, el1, eh1, cq1);
    uint4 wA[16], wB[16];
    PV_ISSUE16(wA, el0, eh0);
    for (;;) {
        { unsigned cc[4] = {cq0[0], cq0[1], cq0[2], cq0[3]}; PV_META(t + 2 * tstep, el0, eh0, cq0); PV_ISSUE16(wB, el1, eh1); PV_TOKEN(wA, cc, t); }
        t += tstep; if (t >= T) break;
        { unsigned cc[4] = {cq1[0], cq1[1], cq1[2], cq1[3]}; PV_META(t + 2 * tstep, el1, eh1, cq1); PV_ISSUE16(wA, el0, eh0); PV_TOKEN(wB, cc, t); }
        t += tstep; if (t >= T) break;
    }
}
__device__ __forceinline__ void ph_peer_ln2(const Params& p, int wv) {
    PH_IDS(); unsigned char* ws = p.ws; const float* Y = (const float*)(ws + OFF_Y);
    int t = gwave; if (t >= T) return;
    float4 ha[4], ya[4];
#pragma unroll
    for (int i = 0; i < 4; ++i) { ha[i] = *(const float4*)(p.out + (size_t)t * 1024 + lane * 16 + 4 * i); ya[i] = *(const float4*)(Y + (size_t)t * 1024 + lane * 16 + 4 * i); }
    for (;;) {
        const int tn = t + nwaves; const int tq = tn < T ? tn : t;
        float4 hb[4], yb[4];
#pragma unroll
        for (int i = 0; i < 4; ++i) { hb[i] = *(const float4*)(p.out + (size_t)tq * 1024 + lane * 16 + 4 * i); yb[i] = *(const float4*)(Y + (size_t)tq * 1024 + lane * 16 + 4 * i); }
        float y[16]; float s1 = 0.f, s2 = 0.f;
#pragma unroll
        for (int i = 0; i < 4; ++i) { y[4 * i] = ya[i].x + DN_ALPHA * ha[i].x; y[4 * i + 1] = ya[i].y + DN_ALPHA * ha[i].y; y[4 * i + 2] = ya[i].z + DN_ALPHA * ha[i].z; y[4 * i + 3] = ya[i].w + DN_ALPHA * ha[i].w; }
#pragma unroll
        for (int i = 0; i < 16; ++i) { s1 += y[i]; s2 += y[i] * y[i]; }
#pragma unroll
        for (int o = 1; o < 64; o <<= 1) { s1 += __shfl_xor(s1, o); s2 += __shfl_xor(s2, o); }
        const float mu = s1 * (1.0f / 1024.0f); const float var = fmaxf(s2 * (1.0f / 1024.0f) - mu * mu, 0.f); const float rstd = rsqrtf(var + LN_EPS);
        float* row = p.out + (size_t)t * 1024 + lane * 16;
#pragma unroll
        for (int i = 0; i < 4; ++i) { const int c = lane * 16 + 4 * i; const float4 ga = *(const float4*)(p.ln2_g + c), ba = *(const float4*)(p.ln2_b + c);
            float4 o; o.x = (y[4 * i] - mu) * rstd * ga.x + ba.x; o.y = (y[4 * i + 1] - mu) * rstd * ga.y + ba.y; o.z = (y[4 * i + 2] - mu) * rstd * ga.z + ba.z; o.w = (y[4 * i + 3] - mu) * rstd * ga.w + ba.w;
            *(float4*)(row + 4 * i) = o; }
        if (tn >= T) break;
        t = tn;
#pragma unroll
        for (int i = 0; i < 4; ++i) { ha[i] = hb[i]; ya[i] = yb[i]; }
    }
}

#define LAS __attribute__((address_space(3)))
#define XB_TMO      128
#define XB_XCNT(j)  (256  + 64 * (j))
#define XB_XSUB(j)  (1280 + 64 * (j))
#define XB_XGEN(j)  (2304 + 64 * (j))
#define XB_TOP      3328
#define XB_TOPGEN   3392
#define XCD_BAR_WORDS 3456
#define XB_SPIN_CAP (1u << 18)

__device__ __forceinline__ unsigned xb_ld(unsigned* p)              { return __hip_atomic_load(p, __ATOMIC_RELAXED, __HIP_MEMORY_SCOPE_AGENT); }
__device__ __forceinline__ unsigned xb_add(unsigned* p, unsigned v) { return __hip_atomic_fetch_add(p, v, __ATOMIC_RELAXED, __HIP_MEMORY_SCOPE_AGENT); }
__device__ __forceinline__ unsigned xb_xcc_id() { return (unsigned)__builtin_amdgcn_s_getreg((3 << 11) | 20) & 0xFu; }
#define XB_SPIN(cond, bar) do { unsigned _sp = 0; while (cond) { __builtin_amdgcn_s_sleep(1); \
    if ((++_sp & 255u) == 0u) { if (xb_ld(&(bar)[XB_TMO])) break; if (_sp > XB_SPIN_CAP) { atomicAdd(&(bar)[XB_TMO], 1u); break; } } } } while (0)

struct XcdBarrier {
    unsigned* bar; unsigned x;
    volatile LAS unsigned* st;
};

__device__ __forceinline__ XcdBarrier xcd_barrier_post(unsigned* bar, volatile LAS unsigned* st, bool leader) {
    XcdBarrier b; b.bar = bar; b.x = xb_xcc_id(); b.st = st;
    if (leader) (void)xb_add(&bar[XB_XCNT(b.x)], 1u);
    return b;
}
__device__ __forceinline__ void xcd_barrier_complete(unsigned* bar, unsigned x, unsigned& nloc, unsigned& nx) {
    const unsigned G = gridDim.x * gridDim.y * gridDim.z;
    unsigned sum, cnt, mine, sp = 0u;
    for (;;) {
        sum = 0u; cnt = 0u; mine = 0u;
#pragma unroll
        for (unsigned j = 0; j < 16; ++j) { const unsigned c = xb_ld(&bar[XB_XCNT(j)]); sum += c; cnt += (c > 0u) ? 1u : 0u; mine = (j == x) ? c : mine; }
        if (sum == G) break;
        __builtin_amdgcn_s_sleep(1);
        if ((++sp & 255u) == 0u) { if (xb_ld(&bar[XB_TMO])) break; if (sp > XB_SPIN_CAP) { atomicAdd(&bar[XB_TMO], 1u); break; } }
    }
    nloc = mine > 0u ? mine : 1u; nx = cnt > 0u ? cnt : 1u;
}

__device__ __forceinline__ void xcd_barrier(const XcdBarrier& b, bool leader) {
    asm volatile("s_waitcnt vmcnt(0)" ::: "memory");
    __syncthreads();
    if (leader) {
        unsigned* bar = b.bar;
        __builtin_amdgcn_s_waitcnt(0);
        unsigned nloc = b.st[0], nx = b.st[1];
        if (nloc == 0u) { xcd_barrier_complete(bar, b.x, nloc, nx); b.st[0] = nloc; b.st[1] = nx; }
        const unsigned old = xb_add(&bar[XB_XSUB(b.x)], 1u);
        const unsigned gen = old / nloc;
        if (old + 1u == (gen + 1u) * nloc) {
            __builtin_amdgcn_fence(__ATOMIC_RELEASE, "agent");
            asm volatile("s_waitcnt vmcnt(0)" ::: "memory");
            const unsigned og = xb_add(&bar[XB_TOP], 1u);
            const unsigned tg = og / nx;
            if (og + 1u == (tg + 1u) * nx) xb_add(&bar[XB_TOPGEN], 1u);
            else XB_SPIN(xb_ld(&bar[XB_TOPGEN]) == tg, bar);
            __builtin_amdgcn_fence(__ATOMIC_ACQUIRE, "agent");
            xb_add(&bar[XB_XGEN(b.x)], 1u);
            asm volatile("s_waitcnt vmcnt(0)" ::: "memory");
        } else {
            XB_SPIN(xb_ld(&bar[XB_XGEN(b.x)]) == gen, bar);
            __builtin_amdgcn_fence(__ATOMIC_ACQUIRE, "agent");
            asm volatile("s_waitcnt vmcnt(0)" ::: "memory");
        }
    }
    __syncthreads();
}

#ifndef TIMING_BOUNDARY
#define TIMING_BOUNDARY -1
#endif
#define TPROBE(k) do { if (TIMING_BOUNDARY == (k)) { const unsigned long long t1_ = __builtin_amdgcn_s_memrealtime(); while (__builtin_amdgcn_s_memrealtime() - t1_ < t1_ - tstart_) __builtin_amdgcn_s_sleep(8); } } while (0)
__global__ void __launch_bounds__(NTHREADS) fwd_megakernel(Params p) {
    extern __shared__ __attribute__((aligned(16))) unsigned char lds[];
    cg::grid_group grid = cg::this_grid();
    const int nb = gridDim.x, bid = blockIdx.x;
    const int wv = __builtin_amdgcn_readfirstlane(threadIdx.x >> 6);
    unsigned char* ws = p.ws;
    const unsigned long long tstart_ = (TIMING_BOUNDARY >= 0) ? __builtin_amdgcn_s_memrealtime() : 0ull; (void)tstart_;
    PG8_LAS unsigned char* ldsp = (PG8_LAS unsigned char*)lds;
    const bool leader = (wv == 0) && (lane_id() == 0);
    volatile LAS unsigned* bst = (volatile LAS unsigned*)(ldsp + LDS_BYTES - 64);
    if (leader) { bst[0] = 0u; bst[1] = 0u; }
    __syncthreads();
    const XcdBarrier xbar = xcd_barrier_post((unsigned*)(ws + OFF_BAR), bst, leader);

    ph_prep(p, wv, lds);
    if (p.ws == nullptr) grid.sync();
    xcd_barrier(xbar, leader);
    TPROBE(0);
    if (bid == 0) {
        const int o = (wv << 6) | lane_id(); const float* b1p = (const float*)(ws + OFF_HID) + (size_t)(o >> 8) * 32 * 256 + (o & 255); float s = 0.f;
        for (int kc = 0; kc < 32; ++kc) s += b1p[kc * 256];
        ((float*)(ws + (o < 256 ? OFF_B1K : OFF_B1V)))[o & 255] = s;
    }
    {
        pg8::Gemm g{(const bf16*)(ws + OFF_XB), (const bf16*)(ws + OFF_WIN), T, NPROJ_PAD, 1024, 1024, 0, 1 << 30, 0l};
        pg8::StaticOrder S; S.init(T, NPROJ_PAD, nb, bid);
        pg8::EpiInProjPg E{(bf16*)(ws + OFF_Z), (bf16*)p.out, (bf16*)(ws + OFF_Q), (bf16*)(ws + OFF_KVS), (bf16*)(ws + OFF_DTG)};
        pg8::gemm_phase<pg8::EpiInProjPg, pg8::StaticOrder, pg8::NoMid, true, true>(wv, ldsp, g, S, E, pg8::NoMid{});
    }
    const int nheavy = (T / 256 * (NPROJ_PAD / 256)) % nb, cvt_split = (nheavy > 0 && nheavy < nb) ? CVT_SPLIT : 0;
    if (bid >= nheavy && cvt_split) ph_peer_cvt(p, wv, 0, cvt_split, (bid - nheavy) * NWAVES + wv, (nb - nheavy) * NWAVES);
    xcd_barrier(xbar, leader);
    TPROBE(1);
    if (bid < 32) {
        const bool isv = bid >= 16;
        pg8::Gemm g{(const bf16*)(ws + OFF_KVS) + (isv ? 256 : 0), (const bf16*)(ws + (isv ? OFF_W1V : OFF_W1K)), 4096, 256, 2048, 0, 1, 1 << 30, 0l};
        pg8::StaticOrder S; S.init(4096, 256, 16, isv ? bid - 16 : bid);
        pg8::EpiBf16<1> E{(bf16*)(ws + OFF_HID + (isv ? 2 * MiB : 0)), 256, (const float*)(ws + (isv ? OFF_B1V : OFF_B1K)), 0, 0, 1.f};
        pg8::gemm_phase<pg8::EpiBf16<1>, pg8::StaticOrder, pg8::NoMid, true, true>(wv, ldsp, g, S, E, pg8::NoMid{});
    }
    else ph_tokprep(p, wv);
    xcd_barrier(xbar, leader);
    TPROBE(2);
    ph_ssd_prep2(p, wv, lds);
    ph_vt_prep(p, wv);
    xcd_barrier(xbar, leader);
    TPROBE(3);
    {
        RowMajorBf16 ak{(const bf16*)(ws + OFF_HID), 256}, av{(const bf16*)(ws + OFF_HID + 2 * MiB), 256};
        RowMajorBf16 bk{(const bf16*)(ws + OFF_W2K), 256}, bv{(const bf16*)(ws + OFF_W2V), 256};
        EpiKc ek{(bf16*)(ws + OFF_KC), false}, ev{(bf16*)(ws + OFF_VCT), true};
        gemm_wave16(wv, 4096 / 16, 64 / 16, 256, ak, bk, ek, 0, 2048);
        gemm_wave16(wv, 4096 / 16, 64 / 16, 256, av, bv, ev, 1024, 2048);
    }
    ph_ssd_states(p, wv);
    xcd_barrier(xbar, leader);
    TPROBE(4);
    ph_kc_rope(p, wv);
    ph_ssd_scan(p, wv);
    ph_peer_cvt(p, wv, cvt_split, 2 * 16384, bid * NWAVES + wv, nb * NWAVES);
    xcd_barrier(xbar, leader);
    TPROBE(5);
    ph_ssd_out(p, wv, lds);
    ph_nsa(p, wv, lds);
    xcd_barrier(xbar, leader);
    TPROBE(6);
    {
        pg8::Gemm g{(const bf16*)(ws + OFF_Q), (const bf16*)(ws + OFF_WOUT), T, 1024, 2048, 1024, 0, 16, (long)OFF_Z - (long)OFF_Q - 16l * 128l};
        pg8::StaticOrder S; S.init(T, 1024, nb, bid);
        pg8::RmsFactors rf{(const float*)(ws + OFF_SSQ), (const float*)(ws + OFF_HID), RMS_EPS};
        pg8::EpiOutProj E{p.x, p.out, DN_ALPHA, rf}; pg8::MidRmsScale MH{rf};
        pg8::gemm_phase<pg8::EpiOutProj, pg8::StaticOrder, pg8::MidRmsScale, true, true>(wv, ldsp, g, S, E, MH);
    }
    xcd_barrier(xbar, leader);
    TPROBE(7);
    ph_ln1(p, wv);
    xcd_barrier(xbar, leader);
    TPROBE(8);
    {
        pg8::Gemm g{(const bf16*)(ws + OFF_H1B), (const bf16*)(ws + OFF_WQ), T, 2048, 1024, 1024, 0, 1 << 30, 0l};
        pg8::StaticOrder S; S.init(T, 2048, nb, bid);
        pg8::EpiBf16<0> E{(bf16*)(ws + OFF_QP), 2048, nullptr, 0, 0, 1.f};
        pg8::gemm_phase<pg8::EpiBf16<0>, pg8::StaticOrder, pg8::NoMid, true, true>(wv, ldsp, g, S, E, pg8::NoMid{});
    }
    xcd_barrier(xbar, leader);
    TPROBE(9);
    ph_peer_topk(p, wv, lds);
    xcd_barrier(xbar, leader);
    TPROBE(10);
    ph_peer_u(p, wv);
    xcd_barrier(xbar, leader);
    TPROBE(11);
    ph_peer_c(p, wv);
    xcd_barrier(xbar, leader);
    TPROBE(12);
    ph_peer_v(p, wv);
    xcd_barrier(xbar, leader);
    TPROBE(13);
    ph_peer_ln2(p, wv);
}

extern "C" void kernel_launch(void* const* d_in, const int* in_sizes, int n_in, void* d_out, int out_size, void* d_ws, size_t ws_size, hipStream_t stream) {
    static int grid_blocks = 0;
    if (!grid_blocks) {
        int dev = 0, cus = 0, per_cu = 0;
        hipGetDevice(&dev);
        hipDeviceGetAttribute(&cus, hipDeviceAttributeMultiprocessorCount, dev);
        hipFuncSetAttribute((const void*)fwd_megakernel, hipFuncAttributeMaxDynamicSharedMemorySize, LDS_BYTES);
        hipOccupancyMaxActiveBlocksPerMultiprocessor(&per_cu, fwd_megakernel, NTHREADS, LDS_BYTES);
        if (per_cu < 1) per_cu = 1;
        if (per_cu > 1) per_cu = 1;
        grid_blocks = cus * per_cu;
        if (ws_size < 244 * MiB) fprintf(stderr, "kernel_launch: workspace too small: %zu\n", ws_size);
    }
    Params p{};
    const float** pp = (const float**)&p;
    for (int i = 0; i < 24; ++i) pp[i] = (const float*)d_in[i];
    p.out = (float*)d_out; p.ws = (unsigned char*)d_ws;
    (void)hipMemsetAsync((unsigned char*)d_ws + OFF_BAR, 0, BAR_BYTES, stream);
    void* args[] = {&p};
    hipError_t e = hipLaunchCooperativeKernel((void*)fwd_megakernel, dim3(grid_blocks), dim3(NTHREADS), args, LDS_BYTES, stream);
    if (e != hipSuccess) fprintf(stderr, "cooperative launch failed: %s (grid %d)\n", hipGetErrorString(e), grid_blocks);
}
```

```cpp
#include <hip/hip_runtime.h>
#include <hip/hip_cooperative_groups.h>
#include <cstdio>
#include <cstdint>
namespace cg = cooperative_groups;

typedef unsigned short bf16;
typedef short bf16x8 __attribute__((ext_vector_type(8)));
typedef float f32x4 __attribute__((ext_vector_type(4)));
typedef float f32x16 __attribute__((ext_vector_type(16)));
typedef unsigned long long u64;

constexpr int T = 16384, L = 4096, NBATCH = 4, D = 1024;
constexpr int NPROJ = 5184, NPROJ_PAD = 5376;
constexpr int NTHREADS = 512, NWAVES = 8;
constexpr float LN_EPS = 1e-5f, RMS_EPS = 1e-5f;
constexpr float DN_ALPHA = 1.189207115002721f;
constexpr float NEG_INF = -1e30f, BIG = 1e30f;

constexpr size_t MiB = 1u << 20;
constexpr size_t OFF_SSQ = 0, OFF_BAR = 512 * 1024, BAR_BYTES = 16384;
constexpr size_t OFF_WOUT = 1 * MiB, OFF_WQ = 5 * MiB, OFF_W1K = 9 * MiB, OFF_W1V = 10 * MiB;
constexpr size_t OFF_W2K = 11 * MiB, OFF_W2V = 11 * MiB + 65536, OFF_B1K = 11 * MiB + 131072, OFF_B1V = 11 * MiB + 131072 + 4096;
constexpr size_t OFF_KEYS = 12 * MiB, OFF_ROPE = 13 * MiB, OFF_DT = 14 * MiB, OFF_ACS = 15 * MiB, OFF_GATE = 16 * MiB;
constexpr size_t OFF_HID = 20 * MiB, OFF_KC = 24 * MiB;
constexpr size_t OFF_Z = 26 * MiB, OFF_Q = 58 * MiB, OFF_KVS = 90 * MiB, OFF_XBC = 138 * MiB, OFF_XSBC = 186 * MiB, OFF_BT = 234 * MiB, OFF_DTG = 242 * MiB;
constexpr size_t OFF_VST = 138 * MiB, OFF_VWT = 146 * MiB, OFF_VCT = 19 * MiB;
constexpr size_t OFF_XB = 186 * MiB, OFF_WIN = 218 * MiB;
constexpr size_t OFF_H1B = 90 * MiB, OFF_QP = 26 * MiB, OFF_EIDX = 202 * MiB, OFF_GW = 210 * MiB;
constexpr size_t OFF_PU = 154 * MiB, OFF_PV = 170 * MiB;
constexpr int LDS_BYTES = 147456;

struct Params {
    const float *x, *w_in, *conv_w, *conv_b, *dt_bias, *a_log, *d_skip, *ssd_norm_w;
    const float *cmp_pos_k, *cmp_w1_k, *cmp_w2_k, *cmp_pos_v, *cmp_w1_v, *cmp_w2_v;
    const float *attn_norm_w, *w_out, *ln1_g, *ln1_b, *peer_wq, *peer_keys, *peer_u, *peer_v, *ln2_g, *ln2_b;
    float* out; unsigned char* ws;
};

__device__ __forceinline__ float bf2f(bf16 v) { return __uint_as_float((unsigned)v << 16); }
__device__ __forceinline__ bf16 f2bf(float f) { unsigned u = __float_as_uint(f); return (bf16)((u + 0x7fffu + ((u >> 16) & 1u)) >> 16); }
__device__ __forceinline__ int lane_id() { int l = (int)__builtin_amdgcn_mbcnt_hi(~0u, __builtin_amdgcn_mbcnt_lo(~0u, 0u)); asm volatile("" : "+v"(l)); return l; }
#define PH_IDS() const int lane = lane_id(); const int tid = (wv << 6) | lane; const int bid = blockIdx.x, nb = gridDim.x; const int gtid = bid * NTHREADS + tid, gn = nb * NTHREADS; const int gwave = bid * NWAVES + wv, nwaves = nb * NWAVES; (void)gtid; (void)gn; (void)gwave; (void)nwaves;
typedef float f32x2v __attribute__((ext_vector_type(2)));
typedef __bf16 bf16x2v __attribute__((ext_vector_type(2)));
__device__ __forceinline__ unsigned pk2bf(float lo, float hi) { f32x2v v = {lo, hi}; bf16x2v b = __builtin_convertvector(v, bf16x2v); return __builtin_bit_cast(unsigned, b); }
__device__ __forceinline__ float bflo(unsigned w) { return __uint_as_float(w << 16); }
__device__ __forceinline__ float bfhi(unsigned w) { return __uint_as_float(w & 0xffff0000u); }
__device__ __forceinline__ float wave_sum(float v) {
#pragma unroll
    for (int o = 1; o < 64; o <<= 1) v += __shfl_xor(v, o);
    return v;
}
__device__ __forceinline__ float wave_max(float v) {
#pragma unroll
    for (int o = 1; o < 64; o <<= 1) v = fmaxf(v, __shfl_xor(v, o));
    return v;
}
__device__ __forceinline__ float gelu_exact(float v) { return 0.5f * v * (1.0f + erff(v * 0.7071067811865476f)); }
__device__ __forceinline__ float sigmoidf(float v) { return 1.0f / (1.0f + __expf(-v)); }

template <class AP, class BP, class EP>
__device__ __forceinline__ void gemm_wave32(int wv, int Mt, int Nt, int K, const AP& ap, const BP& bp, const EP& ep) {
    PH_IDS(); const int r = lane & 15, q = lane >> 4;
    for (int tile = gwave; tile < Mt * Nt; tile += nwaves) {
        const int tm = tile / Nt, tn = tile % Nt, row0 = tm * 32, col0 = tn * 32;
        f32x4 acc[2][2];
#pragma unroll
        for (int i = 0; i < 2; ++i)
#pragma unroll
            for (int j = 0; j < 2; ++j) acc[i][j] = (f32x4){0.f, 0.f, 0.f, 0.f};
        for (int k0 = 0; k0 < K; k0 += 32) {
            const bf16x8 a0 = ap(row0 + r, k0 + 8 * q), a1 = ap(row0 + 16 + r, k0 + 8 * q);
            const bf16x8 b0 = bp(col0 + r, k0 + 8 * q), b1 = bp(col0 + 16 + r, k0 + 8 * q);
            acc[0][0] = __builtin_amdgcn_mfma_f32_16x16x32_bf16(a0, b0, acc[0][0], 0, 0, 0);
            acc[0][1] = __builtin_amdgcn_mfma_f32_16x16x32_bf16(a0, b1, acc[0][1], 0, 0, 0);
            acc[1][0] = __builtin_amdgcn_mfma_f32_16x16x32_bf16(a1, b0, acc[1][0], 0, 0, 0);
            acc[1][1] = __builtin_amdgcn_mfma_f32_16x16x32_bf16(a1, b1, acc[1][1], 0, 0, 0);
        }
#pragma unroll
        for (int i = 0; i < 2; ++i)
#pragma unroll
            for (int j = 0; j < 2; ++j)
#pragma unroll
                for (int e = 0; e < 4; ++e) ep(row0 + 16 * i + 4 * q + e, col0 + 16 * j + r, acc[i][j][e]);
    }
}
template <class AP, class BP, class EP>
__device__ __forceinline__ void gemm_wave16(int wv, int Mt, int Nt, int K, const AP& ap, const BP& bp, const EP& ep, int task0, int ntask_total) {
    PH_IDS(); const int r = lane & 15, q = lane >> 4;
    for (int task = gwave; task < ntask_total; task += nwaves) {
        const int tile = task - task0; if (tile < 0 || tile >= Mt * Nt) continue;
        const int tm = tile / Nt, tn = tile % Nt, row0 = tm * 16, col0 = tn * 16;
        f32x4 acc = (f32x4){0.f, 0.f, 0.f, 0.f};
#pragma unroll 4
        for (int k0 = 0; k0 < K; k0 += 32) acc = __builtin_amdgcn_mfma_f32_16x16x32_bf16(ap(row0 + r, k0 + 8 * q), bp(col0 + r, k0 + 8 * q), acc, 0, 0, 0);
#pragma unroll
        for (int e = 0; e < 4; ++e) ep(row0 + 4 * q + e, col0 + r, acc[e]);
    }
}
struct RowMajorBf16 { const bf16* p; int ld; __device__ __forceinline__ bf16x8 operator()(int row, int k) const { return *(const bf16x8*)(p + (size_t)row * ld + k); } };

namespace pg8 {
#define PG8_LAS __attribute__((address_space(3)))
typedef unsigned short bf16_t;
typedef short bf16x8 __attribute__((ext_vector_type(8)));
typedef float f32x4 __attribute__((ext_vector_type(4)));
typedef unsigned u32x4 __attribute__((ext_vector_type(4)));
constexpr int BM = 256, BK = 64, HALF = 128, HTB = HALF * BK * 2  , STAGE_BYTES = 8 * HTB, NXCD = 8, WGM = 8;

__host__ __device__ __forceinline__ int lds_byte(int r, int c) { const int st = (r >> 4) * 2 + (c >> 5), rr = r & 15, cc = c & 31, ob = rr * 64 + cc * 2; return st * 1024 + (ob ^ (((ob >> 9) & 1) << 5)); }
__host__ __device__ __forceinline__ void stage_rc(int b, int& R, int& C) { const int st = b / 1024, sb = b % 1024, swz = sb ^ (((sb >> 9) & 1) << 5); R = (st >> 1) * 16 + swz / 64; C = (st & 1) * 32 + (swz % 64) / 2; }
__host__ __device__ __forceinline__ int perm32(int rho) { const int n = rho >> 4, i = rho & 15; return 8 * (i >> 2) + 4 * n + (i & 3); }

struct Unit { int pm, pn; };
struct Gemm { const bf16_t* A; const bf16_t* Bt; int M, N, K; int lda; int amode; int ksplit; long kdelta; };

struct StaticOrder {
    int nM, nN, nwg, G, c;
    __host__ __device__ void init(int M, int N, int G_, int c_) { nM = M / BM; nN = N / BM; nwg = nM * nN; G = G_; c = c_; }
    __host__ __device__ bool next(int i, Unit& u) const {
        const long L = (long)i * G + c; if (L >= nwg) return false;
        int wgid = (int)L; { const int q = nwg / NXCD, r = nwg % NXCD, xcd = wgid % NXCD, off = wgid / NXCD; wgid = (xcd < r ? xcd * (q + 1) : r * (q + 1) + (xcd - r) * q) + off; }
        const int nig = WGM * nN, gid = wgid / nig, fm = gid * WGM, gsz = (nM - fm) < WGM ? (nM - fm) : WGM;
        u.pm = fm + ((wgid % nig) % gsz); u.pn = (wgid % nig) / gsz; return true;
    }
    __device__ __forceinline__ void a_ready(const Unit&) const {}
    __device__ __forceinline__ void done(const Unit&) const {}
};


__device__ __forceinline__ unsigned cvt_pk_bf16(float lo, float hi) { unsigned r; asm volatile("v_cvt_pk_bf16_f32 %0, %1, %2" : "=v"(r) : "v"(lo), "v"(hi)); return r; }
typedef float f32x2 __attribute__((ext_vector_type(2)));
__device__ __forceinline__ f32x2 gelu_pk(f32x2 v) {
    const f32x2 av = __builtin_elementwise_abs(v), d = av * 0.2316418882f + 1.0f;
    f32x2 t; t.x = __builtin_amdgcn_rcpf(d.x); t.y = __builtin_amdgcn_rcpf(d.y);
    f32x2 q = t * 0.5307027145f + (-0.7265760135f); q = q * t + 0.7107068705f; q = q * t + (-0.142248368f); q = q * t + 0.127414796f; q = q * t;
    const f32x2 s = (v * v) * (-0.72134752044f);
    f32x2 e; e.x = __builtin_amdgcn_exp2f(s.x); e.y = __builtin_amdgcn_exp2f(s.y);
    const f32x2 m = v * (q * e), r = v - m;
    f32x2 o; o.x = v.x < 0.f ? m.x : r.x; o.y = v.y < 0.f ? m.y : r.y; return o;
}

template <int ACT  > struct EpiBf16 {
    static constexpr bool PERM = true, AFTER_DRAIN = false; static_assert(ACT == 0 || ACT == 1, "EpiBf16: ACT is 0 (none) or 1 (gelu_pk)");
    bf16_t* O; int ldc; const float* bias; int split_cols; size_t split_stride; float scale0;
    __device__ __forceinline__ void operator()(const f32x4 (&acc)[2][2][4][2], const Unit& u, int wr, int wc, int fr, int fq) const {
        const int row0 = u.pm * BM + wr * 64 + fr; int colt = u.pn * BM; bf16_t* base = O;
        float sc = 1.f; if (split_cols) { const int t = colt / split_cols; base += (size_t)t * split_stride; colt -= t * split_cols; if (t == 0) sc = scale0; }
        const int col0 = colt + wc * 32 + 8 * fq, bcol0 = u.pn * BM + wc * 32 + 8 * fq;
        f32x4 bv[2][2];
#pragma unroll
        for (int bj = 0; bj < 2; ++bj)
#pragma unroll
            for (int n = 0; n < 2; ++n) bv[bj][n] = bias ? *(const f32x4*)(bias + bcol0 + bj * HALF + 4 * n) : (f32x4){0.f, 0.f, 0.f, 0.f};
#pragma unroll
        for (int ai = 0; ai < 2; ++ai)
#pragma unroll
            for (int m = 0; m < 4; ++m) { bf16_t* rowp = base + (size_t)(row0 + ai * HALF + m * 16) * ldc + col0;
#pragma unroll
                for (int bj = 0; bj < 2; ++bj) { f32x4 v0 = acc[ai][bj][m][0] + bv[bj][0], v1 = acc[ai][bj][m][1] + bv[bj][1];
                    if (ACT == 1) { f32x2 a = gelu_pk((f32x2){v0[0], v0[1]}), b = gelu_pk((f32x2){v0[2], v0[3]}), c = gelu_pk((f32x2){v1[0], v1[1]}), d = gelu_pk((f32x2){v1[2], v1[3]});
                        v0 = (f32x4){a.x, a.y, b.x, b.y}; v1 = (f32x4){c.x, c.y, d.x, d.y}; }
                    v0 = v0 * sc; v1 = v1 * sc; u32x4 w; w.x = cvt_pk_bf16(v0[0], v0[1]); w.y = cvt_pk_bf16(v0[2], v0[3]); w.z = cvt_pk_bf16(v1[0], v1[1]); w.w = cvt_pk_bf16(v1[2], v1[3]);
                    *(u32x4*)(rowp + bj * HALF) = w; } }
    }
};

struct EpiInProjPg { static constexpr bool PERM = true, AFTER_DRAIN = false;
    bf16_t *z, *xbc, *q, *kvs, *dtg;
    __device__ __forceinline__ void operator()(const f32x4 (&acc)[2][2][4][2], const Unit& u, int wr, int wc, int fr, int fq) const {
        bf16_t* base; int ldc, colt; const int pn = u.pn;
        if (pn < 4) { base = z; ldc = 1024; colt = pn * 256; } else if (pn < 10) { base = xbc; ldc = 1536; colt = (pn - 4) * 256; }
        else if (pn < 14) { base = q; ldc = 1024; colt = (pn - 10) * 256; } else if (pn < 20) { base = kvs; ldc = 1536; colt = (pn - 14) * 256; }
        else { base = dtg; ldc = 64; colt = 0; }
        const int row0 = u.pm * BM + wr * 64 + fr, col0 = colt + wc * 32 + 8 * fq;
#pragma unroll
        for (int ai = 0; ai < 2; ++ai)
#pragma unroll
            for (int m = 0; m < 4; ++m) { bf16_t* rowp = base + (size_t)(row0 + ai * HALF + m * 16) * ldc + col0;
#pragma unroll
                for (int bj = 0; bj < 2; ++bj) { const f32x4 v0 = acc[ai][bj][m][0], v1 = acc[ai][bj][m][1];
                    u32x4 w; w.x = cvt_pk_bf16(v0[0], v0[1]); w.y = cvt_pk_bf16(v0[2], v0[3]); w.z = cvt_pk_bf16(v1[0], v1[1]); w.w = cvt_pk_bf16(v1[2], v1[3]);
                    if (pn < 20 || (bj == 0 && wc < 2)) *(u32x4*)(rowp + bj * HALF) = w; } }
    }
};
struct RmsFactors { const float* ssqp; const float* ssq2p; float eps;
    __device__ __forceinline__ void get(int row, float& ra, float& r0, float& r1) const {
        const f32x4 a = *(const f32x4*)(ssqp + 4 * row); const f32x4 b0 = *(const f32x4*)(ssq2p + 16 * row), b1 = *(const f32x4*)(ssq2p + 16 * row + 4), b2 = *(const f32x4*)(ssq2p + 16 * row + 8), b3 = *(const f32x4*)(ssq2p + 16 * row + 12);
        ra = rsqrtf(((a[0] + a[1]) + (a[2] + a[3])) * (1.0f / 1024.0f) + eps);
        r0 = rsqrtf((((b0[0] + b0[1]) + (b0[2] + b0[3])) + ((b1[0] + b1[1]) + (b1[2] + b1[3]))) * (1.0f / 512.0f) + eps);
        r1 = rsqrtf((((b2[0] + b2[1]) + (b2[2] + b2[3])) + ((b3[0] + b3[1]) + (b3[2] + b3[3]))) * (1.0f / 512.0f) + eps); } };
struct EpiOutProj { static constexpr bool PERM = false, AFTER_DRAIN = false;
    const float* x; float* out; float alpha; RmsFactors rf;
    __device__ __forceinline__ void operator()(const f32x4 (&acc)[2][2][4][2], const Unit& u, int wr, int wc, int fr, int fq) const {
        const int col0 = u.pn * BM + wc * 32 + 4 * fq;
#pragma unroll
        for (int ai = 0; ai < 2; ++ai)
#pragma unroll
            for (int m = 0; m < 4; ++m) { const int row = u.pm * BM + ai * HALF + wr * 64 + m * 16 + fr; const size_t off = (size_t)row * 1024 + col0;
                float ra, r0, r1; rf.get(row, ra, r0, r1);
#pragma unroll
                for (int bj = 0; bj < 2; ++bj)
#pragma unroll
                    for (int n = 0; n < 2; ++n) { const size_t o = off + bj * HALF + n * 16; const f32x4 xv = *(const f32x4*)(x + o); *(f32x4*)(out + o) = xv * alpha + acc[ai][bj][m][n] * r1; } }
    }
};
struct MidRmsScale { static constexpr bool ENABLED = true; RmsFactors rf;
    __device__ __forceinline__ void operator()(f32x4 (&acc)[2][2][4][2], const Unit& u, int t, int wr, int wc, int fr, int fq) const {
        if (t != 16 && t != 24) return;
        int rowb = u.pm * BM + wr * 64 + fr; asm volatile("" : "+v"(rowb));
#pragma unroll
        for (int ai = 0; ai < 2; ++ai)
#pragma unroll
            for (int m = 0; m < 4; ++m) { float ra, r0, r1; rf.get(rowb + ai * HALF + m * 16, ra, r0, r1);
                const float sc = (t == 16) ? ra / r0 : r0 / r1;
#pragma unroll
                for (int bj = 0; bj < 2; ++bj)
#pragma unroll
                    for (int n = 0; n < 2; ++n) acc[ai][bj][m][n] = acc[ai][bj][m][n] * sc; }
    }
};
struct NoMid { static constexpr bool ENABLED = false; template <class ACC> __device__ __forceinline__ void operator()(ACC&, const Unit&, int, int, int, int, int) const {} };
template <class Epi, class Sched, class Mid, bool ALIGN_EPI = false, bool SP2 = false>
__device__ __forceinline__ void gemm_phase(int wv, PG8_LAS unsigned char* lds, const Gemm g, const Sched& S, const Epi& E, const Mid& MH) {
    int lane_ = (int)__builtin_amdgcn_mbcnt_hi(~0u, __builtin_amdgcn_mbcnt_lo(~0u, 0u)); asm volatile("" : "+v"(lane_));
    const int lane = lane_, wid = wv, tid = (wv << 6) | lane, wr = wid >> 2, wc = wid & 3, fr = lane & 15, fq = lane >> 4;
    const int K = g.K, nt = K / BK;
    unsigned voffA[2], voffB[2];
#pragma unroll
    for (int i = 0; i < 2; ++i) { int R, C; stage_rc(tid * 16 + i * 8192, R, C); const int Rb = Epi::PERM ? ((R & ~31) + perm32(R & 31)) : R;
        voffA[i] = g.amode == 0 ? (unsigned)(R * g.lda + C) * 2u : (unsigned)((R >> 2) * 49152 + (R & 3) * 128 + C * 2); voffB[i] = (unsigned)(Rb * K + C) * 2u; }
    const size_t kstep = (size_t)(BK * 2);
    const size_t hstep = (size_t)HALF * K * 2;
    const size_t tstep = 2 * hstep;
    const size_t kstepA = g.amode == 0 ? (size_t)(BK * 2) : (size_t)3072;
    const size_t hstepA = g.amode == 0 ? (size_t)HALF * g.lda * 2 : (size_t)32 * 49152;
    const size_t tstepA = 2 * hstepA;
#define PG8_AK(base, t) ((base) + (size_t)(t) * kstepA + (((t) >= g.ksplit) ? g.kdelta : 0l))
    const unsigned ldsw = (unsigned)wid * 1024u;
    const int aoff = lds_byte(wr * 64 + fr, fq * 8), boff = lds_byte(wc * 32 + fr, fq * 8);
#define PG8_SA(b, h) (((b) * 2 + (h)) * HTB)
#define PG8_SB(b, h) ((4 + (b) * 2 + (h)) * HTB)
#define PG8_STAGE(bufoff, gbase, voff) do { _Pragma("unroll") for (int _i = 0; _i < 2; ++_i) \
        __builtin_amdgcn_global_load_lds((const unsigned*)((const char*)(gbase) + (voff)[_i]), (PG8_LAS unsigned*)(lds + (bufoff) + ldsw + _i * 8192), 16, 0, 0); } while (0)
#define PG8_LDA(dst, b, h) do { _Pragma("unroll") for (int m = 0; m < 4; ++m) _Pragma("unroll") for (int k = 0; k < 2; ++k) dst[m][k] = *(const PG8_LAS bf16x8*)(lds + PG8_SA(b, h) + aoff + m * 2048 + k * 1024); } while (0)
#define PG8_LDB(dst, b, h) do { _Pragma("unroll") for (int n = 0; n < 2; ++n) _Pragma("unroll") for (int k = 0; k < 2; ++k) dst[n][k] = *(const PG8_LAS bf16x8*)(lds + PG8_SB(b, h) + boff + n * 2048 + k * 1024); } while (0)
#define PG8_MMA(ai, bj, At, Bt) do { __builtin_amdgcn_s_setprio(1); _Pragma("unroll") for (int m = 0; m < 4; ++m) _Pragma("unroll") for (int n = 0; n < 2; ++n) _Pragma("unroll") for (int k = 0; k < 2; ++k) \
        acc[ai][bj][m][n] = __builtin_amdgcn_mfma_f32_16x16x32_bf16(Bt[n][k], At[m][k], acc[ai][bj][m][n], 0, 0, 0); __builtin_amdgcn_s_setprio(0); } while (0)
#define PG8_WAIT_V(n) asm volatile("s_waitcnt vmcnt(" #n ")" ::: "memory")
#define PG8_WAIT_L(n) asm volatile("s_waitcnt lgkmcnt(" #n ")" ::: "memory")
#define PG8_BAR __builtin_amdgcn_s_barrier()
#define PG8_SCHED __builtin_amdgcn_sched_barrier(0)
    Unit cur, nxt; int ui = 0;
    if (!S.next(0, cur)) return;
    f32x4 acc[2][2][4][2];
#pragma unroll
    for (int a = 0; a < 2; ++a)
#pragma unroll
        for (int b = 0; b < 2; ++b)
#pragma unroll
            for (int m = 0; m < 4; ++m)
#pragma unroll
                for (int n = 0; n < 2; ++n) acc[a][b][m][n] = (f32x4){0.f, 0.f, 0.f, 0.f};
    bf16x8 At[4][2], B0[2][2], B1[2][2];
    const char* cA = (const char*)g.A + (size_t)cur.pm * tstepA; const char* cB = (const char*)g.Bt + (size_t)cur.pn * tstep;
    S.a_ready(cur);
    if constexpr (SP2) {
        PG8_STAGE(PG8_SB(0, 0), cB, voffB); PG8_STAGE(PG8_SB(0, 1), cB + hstep, voffB); PG8_STAGE(PG8_SA(0, 0), cA, voffA); PG8_STAGE(PG8_SA(0, 1), cA + hstepA, voffA);
        if (wr == 1) PG8_BAR;
        PG8_WAIT_V(2); PG8_BAR;
        PG8_STAGE(PG8_SB(1, 0), cB + kstep, voffB); PG8_STAGE(PG8_SA(1, 0), PG8_AK(cA, 1), voffA); PG8_STAGE(PG8_SB(1, 1), cB + hstep + kstep, voffB);
        PG8_WAIT_V(6); PG8_BAR;
    } else {
        PG8_STAGE(PG8_SB(0, 0), cB, voffB); PG8_STAGE(PG8_SA(0, 0), cA, voffA); PG8_STAGE(PG8_SB(0, 1), cB + hstep, voffB); PG8_STAGE(PG8_SA(0, 1), cA + hstepA, voffA);
        if (wr == 1) PG8_BAR;
        PG8_WAIT_V(4); PG8_BAR;
        PG8_STAGE(PG8_SB(1, 0), cB + kstep, voffB); PG8_STAGE(PG8_SA(1, 0), PG8_AK(cA, 1), voffA); PG8_STAGE(PG8_SB(1, 1), cB + hstep + kstep, voffB);
        PG8_WAIT_V(6); PG8_BAR;
    }
    for (;;) {
        const bool has_next = S.next(ui + 1, nxt);
        const char* nA = has_next ? (const char*)g.A + (size_t)nxt.pm * tstepA : cA; const char* nB = has_next ? (const char*)g.Bt + (size_t)nxt.pn * tstep : cB;
        for (int t = 0; t < nt; t += 2) {
            const bool last = (t == nt - 2);
            if (Mid::ENABLED) MH(acc, cur, t, wr, wc, fr, fq);
            const char* a1 = PG8_AK(cA, t + 1);
            const char* a2 = last ? nA : PG8_AK(cA, t + 2); const char* b2 = last ? nB : cB + (size_t)(t + 2) * kstep;
            const char* a3 = a2 + kstepA; const char* b3 = b2 + kstep;
            if (last && has_next) S.a_ready(nxt);
            if constexpr (SP2) {
            PG8_LDB(B0, 0, 0); PG8_LDB(B1, 0, 1); PG8_SCHED; PG8_LDA(At, 0, 0); PG8_STAGE(PG8_SA(1, 1), a1 + hstepA, voffA);
            PG8_WAIT_V(8); PG8_WAIT_L(0); PG8_BAR; PG8_MMA(0, 0, At, B0); PG8_MMA(0, 1, At, B1); PG8_BAR; PG8_SCHED;
            PG8_LDA(At, 0, 1); PG8_STAGE(PG8_SB(0, 0), b2, voffB); PG8_STAGE(PG8_SB(0, 1), b2 + hstep, voffB); PG8_STAGE(PG8_SA(0, 0), a2, voffA);
            PG8_WAIT_V(8); PG8_WAIT_L(0); PG8_BAR; PG8_MMA(1, 0, At, B0); PG8_MMA(1, 1, At, B1); PG8_BAR; PG8_SCHED;
            PG8_LDB(B0, 1, 0); PG8_LDB(B1, 1, 1); PG8_SCHED; PG8_LDA(At, 1, 0); PG8_STAGE(PG8_SA(0, 1), a2 + hstepA, voffA);
            PG8_WAIT_V(8); PG8_WAIT_L(0); PG8_BAR; PG8_MMA(0, 0, At, B0); PG8_MMA(0, 1, At, B1); PG8_BAR; PG8_SCHED;
            PG8_LDA(At, 1, 1); PG8_STAGE(PG8_SB(1, 0), b3, voffB); PG8_STAGE(PG8_SB(1, 1), b3 + hstep, voffB); PG8_STAGE(PG8_SA(1, 0), a3, voffA);
            PG8_WAIT_V(8); PG8_WAIT_L(0); PG8_BAR; PG8_MMA(1, 0, At, B0); PG8_MMA(1, 1, At, B1); PG8_BAR; PG8_SCHED;
            } else {
            PG8_LDB(B0, 0, 0); PG8_SCHED; PG8_LDA(At, 0, 0); PG8_STAGE(PG8_SA(1, 1), a1 + hstepA, voffA);
            PG8_WAIT_L(8); PG8_BAR; PG8_WAIT_L(0); PG8_MMA(0, 0, At, B0); PG8_BAR; PG8_SCHED;
            PG8_LDB(B1, 0, 1); PG8_STAGE(PG8_SB(0, 0), b2, voffB);
            PG8_BAR; PG8_WAIT_L(0); PG8_MMA(0, 1, At, B1); PG8_BAR;
            PG8_LDA(At, 0, 1); PG8_STAGE(PG8_SA(0, 0), a2, voffA);
            PG8_BAR; PG8_WAIT_L(0); PG8_MMA(1, 0, At, B0); PG8_BAR; PG8_SCHED;
            PG8_STAGE(PG8_SB(0, 1), b2 + hstep, voffB);
            PG8_WAIT_V(6); PG8_BAR; PG8_MMA(1, 1, At, B1); PG8_BAR;
            PG8_LDB(B0, 1, 0); PG8_SCHED; PG8_LDA(At, 1, 0); PG8_STAGE(PG8_SA(0, 1), a2 + hstepA, voffA);
            PG8_WAIT_L(8); PG8_BAR; PG8_WAIT_L(0); PG8_MMA(0, 0, At, B0); PG8_BAR; PG8_SCHED;
            PG8_LDB(B1, 1, 1); PG8_STAGE(PG8_SB(1, 0), b3, voffB);
            PG8_BAR; PG8_WAIT_L(0); PG8_MMA(0, 1, At, B1); PG8_BAR;
            PG8_LDA(At, 1, 1); PG8_STAGE(PG8_SA(1, 0), a3, voffA);
            PG8_BAR; PG8_WAIT_L(0); PG8_MMA(1, 0, At, B0); PG8_BAR; PG8_SCHED;
            PG8_STAGE(PG8_SB(1, 1), b3 + hstep, voffB);
            PG8_WAIT_V(6); PG8_BAR; PG8_MMA(1, 1, At, B1); PG8_BAR;
            }
        }
        if constexpr (ALIGN_EPI) { if (wr == 0) PG8_BAR; }
        if constexpr (!Epi::AFTER_DRAIN) { E(acc, cur, wr, wc, fr, fq); S.done(cur); }
        if (!has_next) break;
#pragma unroll
        for (int a = 0; a < 2; ++a)
#pragma unroll
            for (int b = 0; b < 2; ++b)
#pragma unroll
                for (int m = 0; m < 4; ++m)
#pragma unroll
                    for (int n = 0; n < 2; ++n) acc[a][b][m][n] = (f32x4){0.f, 0.f, 0.f, 0.f};
        cur = nxt; cA = nA; cB = nB; ++ui;
        if constexpr (ALIGN_EPI) { if (wr == 1) PG8_BAR; }
    }
    PG8_WAIT_V(0);
    if constexpr (!ALIGN_EPI) { if (wr == 0) PG8_BAR; }
    PG8_BAR;
    if constexpr (Epi::AFTER_DRAIN) { E.fused(acc, cur, wr, wc, fr, fq, lds, wid, lane); S.done(cur); }
#undef PG8_AK
#undef PG8_SA
#undef PG8_SB
#undef PG8_STAGE
#undef PG8_LDA
#undef PG8_LDB
#undef PG8_MMA
#undef PG8_WAIT_V
#undef PG8_WAIT_L
#undef PG8_BAR
#undef PG8_SCHED
}
}

__device__ __forceinline__ int winmap(int n) { return n < 2560 ? n : (n < 5120 ? n + 16 : (n < 5136 ? 2560 + (n - 5120) : n)); }
template <class Map>
__device__ __forceinline__ void transpose_item(const float* W, int ldw, bf16* WT, int K, int item, int nblk, float* scr, int lane, const Map& mp) {
    const int kb = item / nblk, nbk = item % nblk, k0 = 64 * kb, n0 = 32 * nbk;
    const int col = mp.scol(n0 + (lane & 31));
#pragma unroll 8
    for (int i = 0; i < 32; ++i) { const int kk = 2 * i + (lane >> 5); scr[kk * 33 + (lane & 31)] = col >= 0 ? W[(size_t)mp.srow(k0 + kk) * ldw + col] * mp.scale(k0 + kk) : 0.f; }
    const int c = lane & 7;
#pragma unroll
    for (int j = 0; j < 4; ++j) { const int n = (lane >> 3) + 8 * j; const float* s = scr + (8 * c) * 33 + n;
        *(uint4*)(WT + (size_t)(n0 + n) * K + k0 + 8 * c) = make_uint4(pk2bf(s[0], s[33]), pk2bf(s[66], s[99]), pk2bf(s[132], s[165]), pk2bf(s[198], s[231])); }
}
struct MapPlain { __device__ __forceinline__ int srow(int k) const { return k; } __device__ __forceinline__ int scol(int n) const { return n; } __device__ __forceinline__ float scale(int) const { return 1.f; } };
struct MapWin { __device__ __forceinline__ int srow(int k) const { return k; } __device__ __forceinline__ int scol(int n) const { return n < NPROJ ? winmap(n) : -1; } __device__ __forceinline__ float scale(int) const { return 1.f; } };
struct MapWout { const float* an; const float* sn;
    __device__ __forceinline__ int srow(int k) const { return (k + 1024) & 2047; } __device__ __forceinline__ int scol(int n) const { return n; } __device__ __forceinline__ float scale(int k) const { return k < 1024 ? an[k] : sn[k - 1024]; } };
__device__ __forceinline__ void ph_prep(const Params& p, int wv, unsigned char* lds) {
    PH_IDS(); unsigned char* ws = p.ws;
    bf16* xb = (bf16*)(ws + OFF_XB);
    for (size_t i = gtid; i < (size_t)T * D / 8; i += gn) { const float4 v = ((const float4*)p.x)[2 * i], w = ((const float4*)p.x)[2 * i + 1]; ((uint4*)xb)[i] = make_uint4(pk2bf(v.x, v.y), pk2bf(v.z, v.w), pk2bf(w.x, w.y), pk2bf(w.z, w.w)); }
    {
        float* scr = (float*)(lds + wv * 8448);
        constexpr int I_WIN = 16 * 168, I_WOUT = 32 * 32, I_WQ = 16 * 64, I_W1 = 32 * 8, I_W2 = 4 * 2;
        constexpr int NIT = I_WIN + I_WOUT + I_WQ + 2 * I_W1 + 2 * I_W2;
        for (int it = gwave; it < NIT; it += nwaves) {
            int r = it;
            if (r < I_WIN) { transpose_item(p.w_in, NPROJ, (bf16*)(ws + OFF_WIN), 1024, r, 168, scr, lane, MapWin{}); continue; } r -= I_WIN;
            if (r < I_WOUT) { transpose_item(p.w_out, 1024, (bf16*)(ws + OFF_WOUT), 2048, r, 32, scr, lane, MapWout{p.attn_norm_w, p.ssd_norm_w}); continue; } r -= I_WOUT;
            if (r < I_WQ) { transpose_item(p.peer_wq, 2048, (bf16*)(ws + OFF_WQ), 1024, r, 64, scr, lane, MapPlain{}); continue; } r -= I_WQ;
            if (r < I_W1) { transpose_item(p.cmp_w1_k, 256, (bf16*)(ws + OFF_W1K), 2048, r, 8, scr, lane, MapPlain{}); continue; } r -= I_W1;
            if (r < I_W1) { transpose_item(p.cmp_w1_v, 256, (bf16*)(ws + OFF_W1V), 2048, r, 8, scr, lane, MapPlain{}); continue; } r -= I_W1;
            if (r < I_W2) { transpose_item(p.cmp_w2_k, 64, (bf16*)(ws + OFF_W2K), 256, r, 2, scr, lane, MapPlain{}); continue; } r -= I_W2;
            transpose_item(p.cmp_w2_v, 64, (bf16*)(ws + OFF_W2V), 256, r, 2, scr, lane, MapPlain{});
        }
    }
    bf16* keys = (bf16*)(ws + OFF_KEYS);
    for (int i = gtid; i < 8 * 2 * 128 * 128; i += gn) keys[i] = f2bf(p.peer_keys[i]);
    float* rc = (float*)(ws + OFF_ROPE); float* rs = rc + 4096 * 32;
    for (int i = gtid; i < 4096 * 32; i += gn) {
        const int pos = i >> 5, j = i & 31;
        const float inv = powf(10000.0f, -(float)(2 * j) / 64.0f); const float angf = (float)pos * inv;
        double xr = (double)angf * 0.15915494309189535; xr -= rint(xr); const double rr = xr * 6.283185307179586, r2 = rr * rr;
        double s = -1.0 / 10888869450418352160768000000.0, c = 1.0 / 403291461126605635584000000.0;
        s = s * r2 + 1.0 / 15511210043330985984000000.0;  c = c * r2 - 1.0 / 620448401733239439360000.0;
        s = s * r2 - 1.0 / 25852016738884976640000.0;     c = c * r2 + 1.0 / 1124000727777607680000.0;
        s = s * r2 + 1.0 / 51090942171709440000.0;        c = c * r2 - 1.0 / 2432902008176640000.0;
        s = s * r2 - 1.0 / 121645100408832000.0;          c = c * r2 + 1.0 / 6402373705728000.0;
        s = s * r2 + 1.0 / 355687428096000.0;             c = c * r2 - 1.0 / 20922789888000.0;
        s = s * r2 - 1.0 / 1307674368000.0;               c = c * r2 + 1.0 / 87178291200.0;
        s = s * r2 + 1.0 / 6227020800.0;                  c = c * r2 - 1.0 / 479001600.0;
        s = s * r2 - 1.0 / 39916800.0;                    c = c * r2 + 1.0 / 3628800.0;
        s = s * r2 + 1.0 / 362880.0;                      c = c * r2 - 1.0 / 40320.0;
        s = s * r2 - 1.0 / 5040.0;                        c = c * r2 + 1.0 / 720.0;
        s = s * r2 + 1.0 / 120.0;                         c = c * r2 - 1.0 / 24.0;
        s = s * r2 - 1.0 / 6.0;                           c = c * r2 + 0.5;
        s = s * r2 + 1.0;                                 c = c * r2 - 1.0;
        s = s * rr; c = -c;
        rc[i] = (float)c; rs[i] = (float)s;
    }
    float* b1p = (float*)(ws + OFF_HID);
    for (int o = gwave; o < 64; o += nwaves) {
        const int mat = o >> 5, kc = o & 31; const float* pos = mat ? p.cmp_pos_v : p.cmp_pos_k; const float* w1 = mat ? p.cmp_w1_v : p.cmp_w1_k;
        float4 acc = make_float4(0.f, 0.f, 0.f, 0.f);
#pragma unroll 8
        for (int k = kc * 64; k < kc * 64 + 64; ++k) { const float pk = pos[k]; const float4 w = *(const float4*)(w1 + (size_t)k * 256 + 4 * lane); acc.x += pk * w.x; acc.y += pk * w.y; acc.z += pk * w.z; acc.w += pk * w.w; }
        *(float4*)(b1p + (size_t)o * 256 + 4 * lane) = acc;
    }
}

__device__ __forceinline__ void unpack8(const uint4& w, float* f) { f[0] = __uint_as_float(w.x << 16); f[1] = __uint_as_float(w.x & 0xffff0000u); f[2] = __uint_as_float(w.y << 16); f[3] = __uint_as_float(w.y & 0xffff0000u);
    f[4] = __uint_as_float(w.z << 16); f[5] = __uint_as_float(w.z & 0xffff0000u); f[6] = __uint_as_float(w.w << 16); f[7] = __uint_as_float(w.w & 0xffff0000u); }
__device__ __forceinline__ uint4 pack8(const float* f) { return make_uint4(pk2bf(f[0], f[1]), pk2bf(f[2], f[3]), pk2bf(f[4], f[5]), pk2bf(f[6], f[7])); }
__device__ __forceinline__ void ph_tokprep(const Params& p, int wv) {
    PH_IDS(); unsigned char* ws = p.ws;
    const int gtid_ = (nb > 64 ? bid - 32 : bid) * NTHREADS + tid, gn_ = (nb > 64 ? nb - 32 : nb) * NTHREADS;
    const bf16* xbc = (const bf16*)(ws + OFF_XBC); bf16* xsbc = (bf16*)(ws + OFF_XSBC);
    for (int it = gtid_; it < (T / 16) * 192; it += gn_) {
        const int cg = it % 192, tg = it / 192, ch = cg * 8, t0 = tg * 16, l0 = t0 & (L - 1);
        float w[4][8], bias[8];
#pragma unroll
        for (int j = 0; j < 4; ++j) { const float4 a = *(const float4*)(p.conv_w + j * 1536 + ch), b2 = *(const float4*)(p.conv_w + j * 1536 + ch + 4); w[j][0] = a.x; w[j][1] = a.y; w[j][2] = a.z; w[j][3] = a.w; w[j][4] = b2.x; w[j][5] = b2.y; w[j][6] = b2.z; w[j][7] = b2.w; }
        { const float4 a = *(const float4*)(p.conv_b + ch), b2 = *(const float4*)(p.conv_b + ch + 4); bias[0] = a.x; bias[1] = a.y; bias[2] = a.z; bias[3] = a.w; bias[4] = b2.x; bias[5] = b2.y; bias[6] = b2.z; bias[7] = b2.w; }
        float x0[8], x1[8], x2[8], x3[8];
        { uint4 h0 = make_uint4(0u, 0u, 0u, 0u), h1 = h0, h2 = h0;
          if (l0 != 0) { h0 = *(const uint4*)(xbc + (size_t)(t0 - 3) * 1536 + ch); h1 = *(const uint4*)(xbc + (size_t)(t0 - 2) * 1536 + ch); h2 = *(const uint4*)(xbc + (size_t)(t0 - 1) * 1536 + ch); }
          unpack8(h0, x0); unpack8(h1, x1); unpack8(h2, x2); }
#pragma unroll
        for (int u = 0; u < 16; ++u) {
            unpack8(*(const uint4*)(xbc + (size_t)(t0 + u) * 1536 + ch), x3);
            float y[8];
#pragma unroll
            for (int i = 0; i < 8; ++i) { const float v = bias[i] + w[0][i] * x0[i] + w[1][i] * x1[i] + w[2][i] * x2[i] + w[3][i] * x3[i]; y[i] = v * sigmoidf(v); x0[i] = x1[i]; x1[i] = x2[i]; x2[i] = x3[i]; }
            *(uint4*)(xsbc + (size_t)(t0 + u) * 1536 + ch) = pack8(y);
        }
    }
    const bf16* dtg = (const bf16*)(ws + OFF_DTG); float* dt = (float*)(ws + OFF_DT); float* gate = (float*)(ws + OFF_GATE);
    for (int i = gtid_; i < T * 64; i += gn_) {
        const int t = i >> 6, c = i & 63; const float v = bf2f(dtg[i]);
        if (c < 16) { const float xx = v + p.dt_bias[c]; dt[t * 16 + c] = xx > 20.f ? xx : log1pf(__expf(xx)); }
        else gate[t * 48 + (c - 16)] = sigmoidf(v);
    }
    const float* rc = (const float*)(ws + OFF_ROPE); const float* rs = rc + 4096 * 32;
    bf16* q = (bf16*)(ws + OFF_Q); bf16* kvs = (bf16*)(ws + OFF_KVS);
    for (int it = gtid_; it < T * 24 * 4; it += gn_) {
        const int j0 = (it & 3) * 8, hh = (it >> 2) % 24, t = it / 96, l = t & (L - 1);
        bf16* pp; float sc;
        if (hh < 16) { pp = q + (size_t)t * 1024 + hh * 64 + j0; sc = 0.125f * 1.4426950408889634f; } else if (hh < 20) { pp = kvs + (size_t)t * 1536 + 512 + (hh - 16) * 64 + j0; sc = 1.f; } else { pp = kvs + (size_t)t * 1536 + 1024 + (hh - 20) * 64 + j0; sc = 1.f; }
        float x1[8], x2[8], c[8], s[8], o1[8], o2[8];
        unpack8(*(const uint4*)pp, x1); unpack8(*(const uint4*)(pp + 32), x2);
        { const float4 a = *(const float4*)(rc + l * 32 + j0), b2 = *(const float4*)(rc + l * 32 + j0 + 4), d = *(const float4*)(rs + l * 32 + j0), e = *(const float4*)(rs + l * 32 + j0 + 4);
          c[0] = a.x; c[1] = a.y; c[2] = a.z; c[3] = a.w; c[4] = b2.x; c[5] = b2.y; c[6] = b2.z; c[7] = b2.w; s[0] = d.x; s[1] = d.y; s[2] = d.z; s[3] = d.w; s[4] = e.x; s[5] = e.y; s[6] = e.z; s[7] = e.w; }
#pragma unroll
        for (int i = 0; i < 8; ++i) { o1[i] = (x1[i] * c[i] - x2[i] * s[i]) * sc; o2[i] = (x1[i] * s[i] + x2[i] * c[i]) * sc; }
        *(uint4*)pp = pack8(o1); *(uint4*)(pp + 32) = pack8(o2);
    }
}

__device__ __forceinline__ void ph_ssd_prep2(const Params& p, int wv, unsigned char* lds) {
    PH_IDS(); unsigned char* ws = p.ws;
    const bf16* xsbc = (const bf16*)(ws + OFF_XSBC); const float* dt = (const float*)(ws + OFF_DT);
    bf16* XdT = (bf16*)p.out; bf16* BT = (bf16*)(ws + OFF_BT); float* acsT = (float*)(ws + OFF_ACS);
    float* sdt = (float*)lds; float* swave = sdt + 128;
    const int bide = bid, nbe = nb;
    for (int unit = bide; unit < 2048 + 256; unit += nbe) {
        __syncthreads();
        if (unit < 2048) {
            const int h = unit & 15, bc = unit >> 4; const size_t t0 = (size_t)bc * 128;
            const float A = -__expf(p.a_log[h]);
            if (tid < 128) { const float dv = dt[(t0 + tid) * 16 + h]; sdt[tid] = dv; float a = dv * A;
#pragma unroll
                for (int o = 1; o < 64; o <<= 1) { const float v = __shfl_up(a, o); if (lane >= o) a += v; }
                if (lane == 63) swave[tid >> 6] = a;
                sdt[128 + 8 + tid] = a; }
            __syncthreads();
            if (tid < 128) { float a = sdt[128 + 8 + tid]; if (tid >= 64) a += swave[0]; acsT[(size_t)unit * 128 + tid] = a; }
            const int pp = tid & 63, lg = tid >> 6; const bf16* src = xsbc + (t0 + lg * 16) * 1536 + h * 64 + pp;
            unsigned w[8];
#pragma unroll
            for (int i = 0; i < 8; ++i) { const float v0 = bf2f(src[(size_t)(2 * i) * 1536]) * sdt[lg * 16 + 2 * i], v1 = bf2f(src[(size_t)(2 * i + 1) * 1536]) * sdt[lg * 16 + 2 * i + 1]; w[i] = (unsigned)f2bf(v0) | ((unsigned)f2bf(v1) << 16); }
            uint4* dst = (uint4*)(XdT + (size_t)unit * 8192 + pp * 128 + lg * 16);
            dst[0] = make_uint4(w[0], w[1], w[2], w[3]); dst[1] = make_uint4(w[4], w[5], w[6], w[7]);
        } else {
            const int u2 = unit - 2048, g = u2 & 1, bc = u2 >> 1; const size_t t0 = (size_t)bc * 128;
            const int n = tid & 127, lg = tid >> 7; const bf16* src = xsbc + (t0 + lg * 32) * 1536 + 1024 + g * 128 + n;
            uint4* dst = (uint4*)(BT + (size_t)u2 * 16384 + n * 128 + lg * 32);
#pragma unroll
            for (int k = 0; k < 4; ++k) { unsigned w[4];
#pragma unroll
                for (int i = 0; i < 4; ++i) w[i] = (unsigned)src[(size_t)(8 * k + 2 * i) * 1536] | ((unsigned)src[(size_t)(8 * k + 2 * i + 1) * 1536] << 16);
                dst[k] = make_uint4(w[0], w[1], w[2], w[3]); }
        }
    }
}
__device__ __forceinline__ void ph_ssd_states(const Params& p, int wv) {
    PH_IDS(); unsigned char* ws = p.ws; const int rr = lane & 31, hi = lane >> 5;
    const bf16* XdT = (const bf16*)p.out; bf16* S = (bf16*)((unsigned char*)p.out + 32 * MiB); const bf16* BT = (const bf16*)(ws + OFF_BT); const float* acsT = (const float*)(ws + OFF_ACS);
    for (int unit = gwave; unit < 2048; unit += nwaves) {
        const int h = unit & 15, bc = unit >> 4, g = h >> 3;
        const float* ac = acsT + (size_t)unit * 128; const float alast = ac[127];
        const bf16* xrow = XdT + (size_t)unit * 8192 + rr * 128 + 8 * hi; const bf16* bt = BT + (size_t)(bc * 2 + g) * 16384 + rr * 128 + 8 * hi;
        f32x16 acc[4][2];
#pragma unroll
        for (int nt = 0; nt < 4; ++nt)
#pragma unroll
            for (int pt = 0; pt < 2; ++pt)
#pragma unroll
                for (int e = 0; e < 16; ++e) acc[nt][pt][e] = 0.f;
#pragma unroll 2
        for (int ks = 0; ks < 8; ++ks) {
            const int l0 = ks * 16 + 8 * hi; float dec[8];
            { const f32x4 a0 = *(const f32x4*)(ac + l0), a1 = *(const f32x4*)(ac + l0 + 4);
#pragma unroll
              for (int jx = 0; jx < 8; ++jx) dec[jx] = __expf(alast - (jx < 4 ? a0[jx] : a1[jx - 4])); }
            bf16x8 xf[2];
#pragma unroll
            for (int pt = 0; pt < 2; ++pt) { float f[8]; unpack8(*(const uint4*)(xrow + (size_t)pt * 4096 + ks * 16), f);
#pragma unroll
                for (int jx = 0; jx < 8; ++jx) f[jx] *= dec[jx];
                union { uint4 u; bf16x8 v; } cvu; cvu.u = pack8(f); xf[pt] = cvu.v; }
#pragma unroll
            for (int nt = 0; nt < 4; ++nt) { const bf16x8 bf_ = *(const bf16x8*)(bt + (size_t)nt * 4096 + ks * 16);
#pragma unroll
                for (int pt = 0; pt < 2; ++pt) acc[nt][pt] = __builtin_amdgcn_mfma_f32_32x32x16_bf16(bf_, xf[pt], acc[nt][pt], 0, 0, 0); }
        }
#pragma unroll
        for (int pt = 0; pt < 2; ++pt) { bf16* so = S + (size_t)unit * 8192 + (pt * 32 + rr) * 128 + 4 * hi;
#pragma unroll
            for (int nt = 0; nt < 4; ++nt)
#pragma unroll
                for (int a = 0; a < 4; ++a) *(uint2*)(so + nt * 32 + 8 * a) = make_uint2(pk2bf(acc[nt][pt][4 * a], acc[nt][pt][4 * a + 1]), pk2bf(acc[nt][pt][4 * a + 2], acc[nt][pt][4 * a + 3])); }
    }
}
__device__ __forceinline__ void ph_ssd_scan(const Params& p, int wv) {
    PH_IDS();
    unsigned* S = (unsigned*)((unsigned char*)p.out + 32 * MiB); const float* acsT = (const float*)(p.ws + OFF_ACS);
    for (int e = gtid; e < NBATCH * 16 * 4096; e += gn) {
        const int pn = e & 4095, h = (e >> 12) & 15, b = e >> 16; float r0 = 0.f, r1 = 0.f;
        for (int c = 0; c < 32; c += 4) {
            unsigned v[4]; float d[4];
#pragma unroll
            for (int u = 0; u < 4; ++u) { const int unit = (b * 32 + c + u) * 16 + h; v[u] = S[(size_t)unit * 4096 + pn]; d[u] = __expf(acsT[(size_t)unit * 128 + 127]); }
#pragma unroll
            for (int u = 0; u < 4; ++u) { const int unit = (b * 32 + c + u) * 16 + h; S[(size_t)unit * 4096 + pn] = (unsigned)f2bf(r0) | ((unsigned)f2bf(r1) << 16);
                r0 = r0 * d[u] + bf2f((bf16)(v[u] & 0xffffu)); r1 = r1 * d[u] + bf2f((bf16)(v[u] >> 16)); }
        }
    }
}
constexpr int SO_CBROW = 136;
__device__ __forceinline__ void ph_ssd_out(const Params& p, int wv, unsigned char* lds) {
    PH_IDS(); unsigned char* ws = p.ws; const int rr = lane & 31, hi = lane >> 5;
    const bf16* XdT = (const bf16*)p.out; const bf16* S = (const bf16*)((unsigned char*)p.out + 32 * MiB); const bf16* xsbc = (const bf16*)(ws + OFF_XSBC);
    const float* acsT = (const float*)(ws + OFF_ACS); bf16* z = (bf16*)(ws + OFF_Z); float* ssq2p = (float*)(ws + OFF_HID);
    bf16* CBl = (bf16*)lds;
    for (int unit = bid; unit < 256; unit += nb) {
        const int g = unit & 1, bc = unit >> 1; const size_t t0 = (size_t)bc * 128;
        __syncthreads();
        for (int ti = wv; ti < 10; ti += NWAVES) {
            int lt = 0, st = ti; if (st > 0) { st -= 1; lt = 1; if (st > 1) { st -= 2; lt = 2; if (st > 2) { st -= 3; lt = 3; } } }
            f32x16 acc;
#pragma unroll
            for (int e = 0; e < 16; ++e) acc[e] = 0.f;
            const bf16* arow = xsbc + (t0 + st * 32 + rr) * 1536 + 1024 + g * 128 + 8 * hi; const bf16* brow = xsbc + (t0 + lt * 32 + rr) * 1536 + 1280 + g * 128 + 8 * hi;
#pragma unroll
            for (int ks = 0; ks < 8; ++ks) acc = __builtin_amdgcn_mfma_f32_32x32x16_bf16(*(const bf16x8*)(arow + ks * 16), *(const bf16x8*)(brow + ks * 16), acc, 0, 0, 0);
            bf16* dst = CBl + (lt * 32 + rr) * SO_CBROW + st * 32 + 4 * hi;
#pragma unroll
            for (int a = 0; a < 4; ++a) *(uint2*)(dst + 8 * a) = make_uint2(pk2bf(acc[4 * a], acc[4 * a + 1]), pk2bf(acc[4 * a + 2], acc[4 * a + 3]));
        }
        __syncthreads();
        const int h = g * 8 + wv, uh = bc * 16 + h; const float* ac = acsT + (size_t)uh * 128; const float Dh = p.d_skip[h];
        const bf16* xd = XdT + (size_t)uh * 8192 + rr * 128 + 8 * hi; const bf16* sin = S + (size_t)uh * 8192 + rr * 128 + 8 * hi;
        f32x16 acc[2][4];
#pragma unroll
        for (int pt = 0; pt < 2; ++pt)
#pragma unroll
            for (int lt = 0; lt < 4; ++lt)
#pragma unroll
                for (int e = 0; e < 16; ++e) acc[pt][lt][e] = 0.f;
#pragma unroll
        for (int lt = 0; lt < 4; ++lt) {
            const int l = lt * 32 + rr; const float acl = ac[l]; const float eal = __expf(acl);
#pragma unroll
            for (int ks = 0; ks < 2 * lt + 2; ++ks) {
                const int s0 = ks * 16 + 8 * hi; float cb[8]; unpack8(*(const uint4*)(CBl + l * SO_CBROW + s0), cb);
                const f32x4 a0 = *(const f32x4*)(ac + s0), a1 = *(const f32x4*)(ac + s0 + 4);
#pragma unroll
                for (int jx = 0; jx < 8; ++jx) { const float as = jx < 4 ? a0[jx] : a1[jx - 4]; cb[jx] = (s0 + jx <= l) ? cb[jx] * __expf(acl - as) : 0.f; }
                union { uint4 u; bf16x8 v; } mf; mf.u = pack8(cb);
#pragma unroll
                for (int pt = 0; pt < 2; ++pt) acc[pt][lt] = __builtin_amdgcn_mfma_f32_32x32x16_bf16(*(const bf16x8*)(xd + (size_t)pt * 4096 + ks * 16), mf.v, acc[pt][lt], 0, 0, 0);
            }
            const bf16* crow_ = xsbc + (t0 + l) * 1536 + 1280 + g * 128 + 8 * hi;
#pragma unroll
            for (int ks = 0; ks < 8; ++ks) {
                float cf[8]; unpack8(*(const uint4*)(crow_ + ks * 16), cf);
#pragma unroll
                for (int jx = 0; jx < 8; ++jx) cf[jx] *= eal;
                union { uint4 u; bf16x8 v; } bf_; bf_.u = pack8(cf);
#pragma unroll
                for (int pt = 0; pt < 2; ++pt) acc[pt][lt] = __builtin_amdgcn_mfma_f32_32x32x16_bf16(*(const bf16x8*)(sin + (size_t)pt * 4096 + ks * 16), bf_.v, acc[pt][lt], 0, 0, 0);
            }
            const size_t t = t0 + l; float ss = 0.f;
#pragma unroll
            for (int pt = 0; pt < 2; ++pt)
#pragma unroll
                for (int a = 0; a < 4; ++a) {
                    const int col = h * 64 + pt * 32 + 8 * a + 4 * hi;
                    const uint2 xw = *(const uint2*)(xsbc + t * 1536 + col), zw = *(const uint2*)(z + t * 1024 + col);
                    const float xs0 = bflo(xw.x), xs1 = bfhi(xw.x), xs2 = bflo(xw.y), xs3 = bfhi(xw.y), z0 = bflo(zw.x), z1 = bfhi(zw.x), z2 = bflo(zw.y), z3 = bfhi(zw.y);
                    const float v0 = (acc[pt][lt][4 * a] + Dh * xs0) * (z0 * sigmoidf(z0)), v1 = (acc[pt][lt][4 * a + 1] + Dh * xs1) * (z1 * sigmoidf(z1));
                    const float v2 = (acc[pt][lt][4 * a + 2] + Dh * xs2) * (z2 * sigmoidf(z2)), v3 = (acc[pt][lt][4 * a + 3] + Dh * xs3) * (z3 * sigmoidf(z3));
                    ss += (v0 * v0 + v1 * v1) + (v2 * v2 + v3 * v3);
                    *(uint2*)(z + t * 1024 + col) = make_uint2(pk2bf(v0, v1), pk2bf(v2, v3));
                }
            ss += __shfl_xor(ss, 32);
            if (hi == 0) ssq2p[t * 16 + h] = ss;
        }
    }
}

struct EpiKc {
    bf16* dst; bool tr; __device__ __forceinline__ void operator()(int m, int c, float v) const { const int hk = m & 3, n = (m >> 2) & 255, b = m >> 10; const bf16 o = (n == 255) ? (bf16)0 : f2bf(v);
        if (tr) dst[((size_t)(b * 4 + hk) * 64 + c) * 256 + ((n & ~12) | ((n & 4) << 1) | ((n & 8) >> 1))] = o; else dst[((size_t)(b * 4 + hk) * 256 + n) * 64 + c] = o; } };
__device__ __forceinline__ void ph_kc_rope(const Params& p, int wv) {
    PH_IDS(); unsigned char* ws = p.ws; bf16* kc = (bf16*)(ws + OFF_KC); const float* rc = (const float*)(ws + OFF_ROPE); const float* rs = rc + 4096 * 32;
    for (int i = gtid; i < 16 * 256 * 32; i += gn) {
        const int j = i & 31, n = (i >> 5) & 255, bh = i >> 13; const int pos = 16 * n + 31; if (n == 255) continue;
        const float c = rc[pos * 32 + j], s = rs[pos * 32 + j];
        bf16* pp = kc + ((size_t)bh * 256 + n) * 64 + j; const float x1 = bf2f(pp[0]), x2 = bf2f(pp[32]);
        pp[0] = f2bf(x1 * c - x2 * s); pp[32] = f2bf(x1 * s + x2 * c);
    }
}


__device__ __forceinline__ void ph_vt_prep(const Params& p, int wv) {
    PH_IDS(); unsigned char* ws = p.ws; const bf16* kvs = (const bf16*)(ws + OFF_KVS);
    const int bide = bid, nbe = nb;
    for (int unit = bide; unit < 2 * 16 * 64; unit += nbe) {
        const int br = unit & 1, tl = (unit >> 1) & 63, bh = unit >> 7, b = bh >> 2, hk = bh & 3;
        const int d = tid & 63, grp = tid >> 6; const int l0 = tl * 64 + grp * 8;
        const bf16* src = kvs + ((size_t)b * L + l0) * 1536 + (br ? 1280 : 768) + hk * 64 + d;
        unsigned w[4];
#pragma unroll
        for (int i = 0; i < 4; ++i) w[i] = (unsigned)src[(size_t)(2 * i) * 1536] | ((unsigned)src[(size_t)(2 * i + 1) * 1536] << 16);
        bf16* dst = (bf16*)(ws + (br ? OFF_VWT : OFF_VST)) + ((size_t)bh * 64 + d) * L + (l0 & ~15) + 4 * ((l0 >> 3) & 1);
        *(uint2*)dst = make_uint2(w[0], w[1]); *(uint2*)(dst + 8) = make_uint2(w[2], w[3]);
    }
}

__device__ __forceinline__ float max3f(float a, float b, float c) { float r; asm("v_max3_f32 %0, %1, %2, %3" : "=v"(r) : "v"(a), "v"(b), "v"(c)); return r; }
__device__ __forceinline__ int crow(int r, int hi) { return (r & 3) + 8 * (r >> 2) + 4 * hi; }
constexpr int NSA_KBUF = 8192, NSA_VBUF = 8192;
constexpr int NSA_OFF_K = 0, NSA_OFF_V = 4 * NSA_KBUF;
constexpr int NSA_OFF_STASH = 73728;
constexpr int NSA_OFF_IMPA = NSA_OFF_STASH, NSA_IMPS = 65, NSA_OFF_IMPB = NSA_OFF_IMPA + 64 * NSA_IMPS * 4;
constexpr int NSA_OFF_SEL = NSA_OFF_STASH + 65536;
static_assert(NSA_OFF_V + 4 * NSA_VBUF <= NSA_OFF_STASH && NSA_OFF_IMPB + 64 * NSA_IMPS * 4 <= NSA_OFF_SEL && NSA_OFF_SEL + 1024 <= LDS_BYTES - 64, "NSA LDS map");
struct NsaSrc { const bf16* K; size_t kstride; const bf16* VT; size_t ldv; };
__device__ __forceinline__ void nsa_dma(const bf16* kp, const bf16* vp, unsigned char* kb, unsigned char* vb) {
    __builtin_amdgcn_global_load_lds((const unsigned*)kp, (PG8_LAS unsigned*)kb, 16, 0, 0);
    __builtin_amdgcn_global_load_lds((const unsigned*)vp, (PG8_LAS unsigned*)vb, 16, 0, 0);
}
__device__ __forceinline__ void nsa_qk(const unsigned char* kb, const bf16x8 (&qf)[4], int fo0, f32x16& p0, f32x16& p1) {
#pragma unroll
    for (int i = 0; i < 16; ++i) { p0[i] = 0.f; p1[i] = 0.f; }
    __builtin_amdgcn_s_setprio(1);
#pragma unroll
    for (int ds = 0; ds < 4; ++ds) {
        const bf16x8 a0 = *(const bf16x8*)(kb + (fo0 ^ (32 * ds))), a1 = *(const bf16x8*)(kb + (fo0 ^ (32 * ds)) + 4096);
        p0 = __builtin_amdgcn_mfma_f32_32x32x16_bf16(a0, qf[ds], p0, 0, 0, 0); p1 = __builtin_amdgcn_mfma_f32_32x32x16_bf16(a1, qf[ds], p1, 0, 0, 0);
    }
    __builtin_amdgcn_s_setprio(0);
}
__device__ __forceinline__ void nsa_pv(const unsigned char* vb, int fo0, const f32x16& p0, const f32x16& p1, f32x16 (&O)[2]) {
    __builtin_amdgcn_s_setprio(1);
#pragma unroll
    for (int s = 0; s < 4; ++s) {
        const int eb = 8 * (s & 1), kbase = 32 * (s >> 1) + 16 * (s & 1);
        union { uint4 u; bf16x8 v; } pf;
        if (s < 2) pf.u = make_uint4(pk2bf(p0[eb], p0[eb + 1]), pk2bf(p0[eb + 2], p0[eb + 3]), pk2bf(p0[eb + 4], p0[eb + 5]), pk2bf(p0[eb + 6], p0[eb + 7]));
        else       pf.u = make_uint4(pk2bf(p1[eb], p1[eb + 1]), pk2bf(p1[eb + 2], p1[eb + 3]), pk2bf(p1[eb + 4], p1[eb + 5]), pk2bf(p1[eb + 6], p1[eb + 7]));
#pragma unroll
        for (int dsub = 0; dsub < 2; ++dsub) {
            const bf16x8 vfv = *(const bf16x8*)(vb + (fo0 ^ (32 * s)) + dsub * 4096);
            O[dsub] = __builtin_amdgcn_mfma_f32_32x32x16_bf16(vfv, pf.v, O[dsub], 0, 0, 0);
        }
    }
    __builtin_amdgcn_s_setprio(0);
}
template <int MODE>
__device__ __forceinline__ void nsa_tile(unsigned char* lds, const unsigned char* kb, const unsigned char* vb, int jt, int rr, int hi, int fo0, const bf16x8 (&qf)[4], int lpos, int qi, int tokblk,
                                         u64 selm, float& m, float& lsum, float inv_l, f32x16 (&O)[2]) {
    float* impA = (float*)(lds + NSA_OFF_IMPA); float* impB = (float*)(lds + NSA_OFF_IMPB);
    f32x16 p0, p1; nsa_qk(kb, qf, fo0, p0, p1);
    asm volatile("s_nop 15\n\ts_nop 7" : "+v"(p0), "+v"(p1));
    const int k0 = jt * 64;
    const bool tile_on = (MODE != 2) || ((selm >> jt) & 1ull);
    bool full;
    if (MODE <= 1) full = (16 * (k0 + 63) + 31 <= qi * 64); else if (MODE == 2) full = (jt < qi); else full = (jt > qi - 8) && (jt < qi);
    float mx = NEG_INF, mx2 = NEG_INF;
    if (full) {
#pragma unroll
        for (int e = 0; e < 16; e += 2) { mx = max3f(mx, p0[e], p1[e]); mx2 = max3f(mx2, p0[e + 1], p1[e + 1]); }
        if (MODE == 2 && !tile_on) { mx = NEG_INF; mx2 = NEG_INF; }
    } else {
        const int lim = (MODE <= 1) ? (lpos - 31 - 16 * k0 - 64 * hi) : (lpos - k0 - 4 * hi);
#pragma unroll
        for (int e = 0; e < 16; ++e) {
            const int ca = (e & 3) + 8 * (e >> 2), cb = ca + 32; bool oa, ob;
            if (MODE <= 1) { oa = (16 * ca <= lim); ob = (16 * cb <= lim); }
            else if (MODE == 2) { oa = (ca <= lim); ob = (cb <= lim); }
            else { oa = (ca <= lim) && (ca > lim - 512); ob = (cb <= lim) && (cb > lim - 512); }
            p0[e] = oa ? p0[e] : NEG_INF; p1[e] = ob ? p1[e] : NEG_INF; if (e & 1) mx2 = max3f(mx2, p0[e], p1[e]); else mx = max3f(mx, p0[e], p1[e]);
        }
    }
    if (MODE != 1) {
        mx = max3f(mx, mx2, NEG_INF); mx = max3f(mx, __shfl_xor(mx, 32), NEG_INF);
        const float mnew = fmaxf(m, mx);
        if (__any((mnew - m) > 6.0f)) {
            const float alpha = __builtin_amdgcn_exp2f(m - mnew); m = mnew; lsum *= alpha;
            if (MODE != 0) {
#pragma unroll
                for (int e = 0; e < 16; ++e) { O[0][e] *= alpha; O[1][e] *= alpha; }
            }
        }
        const float meff = (MODE == 2 && full && !tile_on) ? BIG : ((m > 0.5f * NEG_INF) ? m : BIG);
        float rs = 0.f;
#pragma unroll
        for (int e = 0; e < 16; ++e) { p0[e] = __builtin_amdgcn_exp2f(p0[e] - meff); p1[e] = __builtin_amdgcn_exp2f(p1[e] - meff); rs += p0[e] + p1[e]; }
        lsum += rs;
        if (MODE != 0) nsa_pv(vb, fo0, p0, p1, O);
    } else {
#pragma unroll
        for (int e = 0; e < 16; ++e) { p0[e] = __builtin_amdgcn_exp2f(p0[e] - m) * inv_l; p1[e] = __builtin_amdgcn_exp2f(p1[e] - m) * inv_l; }
        nsa_pv(vb, fo0, p0, p1, O);
#pragma unroll
        for (int sub = 0; sub < 2; ++sub)
#pragma unroll
            for (int a = 0; a < 4; ++a) {
                float G, last;
                if (sub == 0) { G = (p0[4 * a] + p0[4 * a + 1]) + (p0[4 * a + 2] + p0[4 * a + 3]); last = p0[4 * a + 3]; } else { G = (p1[4 * a] + p1[4 * a + 1]) + (p1[4 * a + 2] + p1[4 * a + 3]); last = p1[4 * a + 3]; }
                G += __shfl_xor(G, 1); G += __shfl_xor(G, 2); last += __shfl_xor(last, 1); last += __shfl_xor(last, 2);
                const int jj = (k0 >> 2) + 8 * sub + 2 * a + hi;
                if ((rr & 3) == 0) { impA[tokblk * NSA_IMPS + jj] = G; if (jj + 1 < 64) impB[tokblk * NSA_IMPS + jj + 1] = last; }
            }
    }
}
__device__ __forceinline__ void nsa_issue_pair(unsigned char* lds, const NsaSrc& src, int jt, int jt1, int bufpar, int wv, int lane) {
    const int srow = wv * 8 + (lane >> 3), sch = ((lane & 7) ^ ((srow >> 1) & 7)) * 8;
    const bf16* kp = src.K + (size_t)srow * src.kstride + sch + (size_t)(jt * 64) * src.kstride;
    const bf16* vp = src.VT + (size_t)srow * src.ldv + sch + jt * 64;
    unsigned char* lw = lds + wv * 1024;
    nsa_dma(kp, vp, lw + NSA_OFF_K + (bufpar * 2) * NSA_KBUF, lw + NSA_OFF_V + (bufpar * 2) * NSA_VBUF);
    if (jt + 1 < jt1) nsa_dma(kp + 64 * src.kstride, vp + 64, lw + NSA_OFF_K + (bufpar * 2 + 1) * NSA_KBUF, lw + NSA_OFF_V + (bufpar * 2 + 1) * NSA_VBUF);
}
template <int MODE>
__device__ __forceinline__ void nsa_branch(unsigned char* lds, const NsaSrc& src, int jt0, int jt1, const NsaSrc& nxt, int njt0, int njt1, int& par, int wv, int lane, int rr, int hi,
                                           const bf16x8 (&qf)[4], int lpos, int qi, int tokblk, u64 selm, u64 wsel, float& m, float& lsum, float inv_l, f32x16 (&O)[2]) {
    asm volatile("" : "+v"(lane), "+v"(rr));
    const int fo0 = rr * 128 + ((hi ^ ((rr >> 1) & 7)) << 4);
    for (int jt = jt0; jt < jt1; jt += 2, par ^= 1) {
        const bool hasB = (jt + 1 < jt1);
        if (jt + 2 < jt1) nsa_issue_pair(lds, src, jt + 2, jt1, par ^ 1, wv, lane);
        else if (njt0 < njt1) nsa_issue_pair(lds, nxt, njt0, njt1, par ^ 1, wv, lane);
        const unsigned char* kb = lds + NSA_OFF_K + (par * 2) * NSA_KBUF; const unsigned char* vb = lds + NSA_OFF_V + (par * 2) * NSA_VBUF;
        if ((MODE != 2) || ((wsel >> jt) & 1ull)) nsa_tile<MODE>(lds, kb, vb, jt, rr, hi, fo0, qf, lpos, qi, tokblk, selm, m, lsum, inv_l, O);
        if (hasB && ((MODE != 2) || ((wsel >> (jt + 1)) & 1ull))) nsa_tile<MODE>(lds, kb + NSA_KBUF, vb + NSA_VBUF, jt + 1, rr, hi, fo0, qf, lpos, qi, tokblk, selm, m, lsum, inv_l, O);
        asm volatile("s_waitcnt vmcnt(0)" ::: "memory");
        __syncthreads();
    }
}
__device__ __forceinline__ void ph_nsa(const Params& p, int wv, unsigned char* lds) {
    PH_IDS(); unsigned char* ws = p.ws; const int wave = wv, rr = lane & 31, hi = lane >> 5;
    bf16* q = (bf16*)(ws + OFF_Q); const bf16* kvs = (const bf16*)(ws + OFF_KVS);
    const float* gate = (const float*)(ws + OFF_GATE); float* ssq = (float*)(ws + OFF_SSQ);
    float* impA = (float*)(lds + NSA_OFF_IMPA); float* impB = (float*)(lds + NSA_OFF_IMPB); u64* selw = (u64*)(lds + NSA_OFF_SEL);
    unsigned* qctr = (unsigned*)(ws + OFF_BAR + 14336) + 64 * (bid & 7); volatile int* ucur = (volatile int*)(lds + NSA_OFF_SEL + 512);
    int par = 0;
    for (;;) {
        if (tid == 0) *ucur = (int)__hip_atomic_fetch_add(qctr, 1u, __ATOMIC_RELAXED, __HIP_MEMORY_SCOPE_AGENT);
        __syncthreads();
        const int u = *ucur;
        if (u >= 128) break;
        const int bh = (bid & 7) + 8 * (u & 1), qi = 63 - (u >> 1);
        const int b = bh >> 2, hk = bh & 3; const int tokblk = wave * 8 + (rr >> 2), g = rr & 3; const int lpos = qi * 64 + tokblk; const size_t t = (size_t)b * L + lpos;
        bf16* qrow = q + t * 1024 + (hk * 4 + g) * 64;
        const NsaSrc sc_{(const bf16*)(ws + OFF_KC) + (size_t)bh * 256 * 64, 64, (const bf16*)(ws + OFF_VCT) + (size_t)bh * 64 * 256, 256};
        const NsaSrc ss_{kvs + (size_t)b * L * 1536 + 512 + hk * 64, 1536, (const bf16*)(ws + OFF_VST) + (size_t)bh * 64 * L, (size_t)L};
        const NsaSrc sw_{kvs + (size_t)b * L * 1536 + 1024 + hk * 64, 1536, (const bf16*)(ws + OFF_VWT) + (size_t)bh * 64 * L, (size_t)L};
        const int nct = (4 * qi + 3 + 63) >> 6, wj0 = qi >= 8 ? qi - 8 : 0;
        nsa_issue_pair(lds, sc_, 0, nct, par, wv, lane);
        bf16x8 qf[4];
#pragma unroll
        for (int ds = 0; ds < 4; ++ds) qf[ds] = *(const bf16x8*)(qrow + ds * 16 + hi * 8);
        for (int i = tid; i < 64 * NSA_IMPS; i += NTHREADS) { impA[i] = 0.f; impB[i] = 0.f; }
        asm volatile("s_waitcnt vmcnt(0)" ::: "memory");
        __syncthreads();
        f32x16 O[2]; float* stash = (float*)(lds + NSA_OFF_STASH) + tid;
        const float g0 = gate[t * 48 + (hk * 4 + g) * 3 + 0], g1 = gate[t * 48 + (hk * 4 + g) * 3 + 1], g2 = gate[t * 48 + (hk * 4 + g) * 3 + 2];
        {
            float m = NEG_INF, lsum = 0.f;
            nsa_branch<0>(lds, sc_, 0, nct, sc_, 0, nct, par, wv, lane, rr, hi, qf, lpos, qi, tokblk, 0ull, 0ull, m, lsum, 0.f, O);
            lsum += __shfl_xor(lsum, 32);
            const float inv_l = lsum > 0.f ? 1.0f / lsum : 0.f;
#pragma unroll
            for (int e = 0; e < 16; ++e) { O[0][e] = 0.f; O[1][e] = 0.f; }
            nsa_branch<1>(lds, sc_, 0, nct, ss_, 0, qi + 1, par, wv, lane, rr, hi, qf, lpos, qi, tokblk, 0ull, 0ull, m, lsum, inv_l, O);
        }
        f32x16 Oc[2];
#pragma unroll
        for (int e = 0; e < 16; ++e) { Oc[0][e] = g0 * O[0][e]; Oc[1][e] = g0 * O[1][e]; }
        {
            const int tk = tid >> 3, jg = tid & 7; float v[8];
#pragma unroll
            for (int i = 0; i < 8; ++i) { const int j = jg * 8 + i; const float raw = impA[tk * NSA_IMPS + j] + impB[tk * NSA_IMPS + j];
                const bool causal = (j <= qi), forced = (j == 0) || (j == qi) || (j == qi - 1); v[i] = causal ? (forced ? BIG : raw) : NEG_INF; }
            __syncthreads();
#pragma unroll
            for (int i = 0; i < 8; ++i) impA[tk * NSA_IMPS + jg * 8 + i] = v[i];
            __syncthreads();
            int rank[8];
#pragma unroll
            for (int i = 0; i < 8; ++i) rank[i] = 0;
            for (int jj = 0; jj < 64; ++jj) { const float x = impA[tk * NSA_IMPS + jj];
#pragma unroll
                for (int i = 0; i < 8; ++i) rank[i] += (x > v[i] || (x == v[i] && jj < jg * 8 + i)) ? 1 : 0; }
            unsigned b8 = 0u;
#pragma unroll
            for (int i = 0; i < 8; ++i) b8 |= (rank[i] < 16 && jg * 8 + i <= qi) ? (1u << i) : 0u;
            const u64 full = (u64)b8 << (jg * 8); unsigned blo = (unsigned)full, bhi = (unsigned)(full >> 32);
            blo |= __shfl_xor(blo, 1); bhi |= __shfl_xor(bhi, 1); blo |= __shfl_xor(blo, 2); bhi |= __shfl_xor(bhi, 2); blo |= __shfl_xor(blo, 4); bhi |= __shfl_xor(bhi, 4);
            if (jg == 0) selw[tk] = (u64)blo | ((u64)bhi << 32);
            __syncthreads();
        }
        const u64 selm = selw[tokblk];
        __syncthreads();
#pragma unroll
        for (int e = 0; e < 16; ++e) { stash[e * 512] = Oc[0][e]; stash[(16 + e) * 512] = Oc[1][e]; }
        u64 wsel = selm;
        { unsigned lo = (unsigned)wsel, h2 = (unsigned)(wsel >> 32);
          lo |= __shfl_xor(lo, 4); h2 |= __shfl_xor(h2, 4); lo |= __shfl_xor(lo, 8); h2 |= __shfl_xor(h2, 8); lo |= __shfl_xor(lo, 16); h2 |= __shfl_xor(h2, 16);
          wsel = (u64)lo | ((u64)h2 << 32); }
        {
            float m = NEG_INF, lsum = 0.f;
#pragma unroll
            for (int e = 0; e < 16; ++e) { O[0][e] = 0.f; O[1][e] = 0.f; }
            nsa_branch<2>(lds, ss_, 0, qi + 1, sw_, wj0, qi + 1, par, wv, lane, rr, hi, qf, lpos, qi, tokblk, selm, wsel, m, lsum, 0.f, O);
            lsum += __shfl_xor(lsum, 32); const float sc = g1 / lsum;
#pragma unroll
            for (int e = 0; e < 16; ++e) { stash[e * 512] += sc * O[0][e]; stash[(16 + e) * 512] += sc * O[1][e]; }
        }
        {
            float m = NEG_INF, lsum = 0.f;
#pragma unroll
            for (int e = 0; e < 16; ++e) { O[0][e] = 0.f; O[1][e] = 0.f; }
            nsa_branch<3>(lds, sw_, wj0, qi + 1, sw_, 0, 0, par, wv, lane, rr, hi, qf, lpos, qi, tokblk, 0ull, 0ull, m, lsum, 0.f, O);
            lsum += __shfl_xor(lsum, 32); const float sc = g2 / lsum;
#pragma unroll
            for (int e = 0; e < 16; ++e) { O[0][e] = stash[e * 512] + sc * O[0][e]; O[1][e] = stash[(16 + e) * 512] + sc * O[1][e]; }
        }
        float ss = 0.f;
#pragma unroll
        for (int dsub = 0; dsub < 2; ++dsub)
#pragma unroll
            for (int a = 0; a < 4; ++a) {
                const float v0 = O[dsub][4 * a], v1 = O[dsub][4 * a + 1], v2 = O[dsub][4 * a + 2], v3 = O[dsub][4 * a + 3];
                ss += (v0 * v0 + v1 * v1) + (v2 * v2 + v3 * v3);
                *(uint2*)(qrow + dsub * 32 + 8 * a + 4 * hi) = make_uint2(pk2bf(v0, v1), pk2bf(v2, v3));
            }
        ss += __shfl_xor(ss, 32); ss += __shfl_xor(ss, 1); ss += __shfl_xor(ss, 2);
        if (hi == 0 && g == 0) ssq[t * 4 + hk] = ss;
        __syncthreads();
    }
}

constexpr size_t OFF_SU = 640 * 1024, OFF_SV = 704 * 1024, OFF_SX = 768 * 1024, OFF_SC = 832 * 1024;
constexpr size_t OFF_COEFQ = 218 * MiB, OFF_H1Q = 220 * MiB;
__device__ __forceinline__ unsigned pack4i8(float a, float b, float c, float d) {
    const int ia = (int)rintf(a), ib = (int)rintf(b), ic = (int)rintf(c), id = (int)rintf(d);
    return (unsigned)(ia & 0xff) | ((unsigned)(ib & 0xff) << 8) | ((unsigned)(ic & 0xff) << 16) | ((unsigned)(id & 0xff) << 24);
}
__device__ __forceinline__ void ph_ln1(const Params& p, int wv) {
    PH_IDS(); unsigned char* ws = p.ws; bf16* h1b = (bf16*)(ws + OFF_H1B); unsigned char* h1q = ws + OFF_H1Q; float* sx = (float*)(ws + OFF_SX);
    for (int t = gwave; t < T; t += nwaves) {
        float v[16]; float s = 0.f; float* row = p.out + (size_t)t * 1024 + lane * 16;
#pragma unroll
        for (int i = 0; i < 4; ++i) { const float4 a = *(const float4*)(row + 4 * i); v[4 * i] = a.x; v[4 * i + 1] = a.y; v[4 * i + 2] = a.z; v[4 * i + 3] = a.w; s += (a.x + a.y) + (a.z + a.w); }
        const float mu = wave_sum(s) * (1.0f / 1024.0f); float s2 = 0.f;
#pragma unroll
        for (int i = 0; i < 16; ++i) { v[i] -= mu; s2 += v[i] * v[i]; }
        const float rstd = rsqrtf(wave_sum(s2) * (1.0f / 1024.0f) + LN_EPS); float amax = 0.f;
#pragma unroll
        for (int i = 0; i < 4; ++i) { const int c = lane * 16 + 4 * i; const float4 ga = *(const float4*)(p.ln1_g + c), ba = *(const float4*)(p.ln1_b + c);
            v[4 * i] = v[4 * i] * rstd * ga.x + ba.x; v[4 * i + 1] = v[4 * i + 1] * rstd * ga.y + ba.y; v[4 * i + 2] = v[4 * i + 2] * rstd * ga.z + ba.z; v[4 * i + 3] = v[4 * i + 3] * rstd * ga.w + ba.w;
            *(float4*)(row + 4 * i) = make_float4(v[4 * i], v[4 * i + 1], v[4 * i + 2], v[4 * i + 3]); }
#pragma unroll
        for (int i = 0; i < 16; ++i) amax = fmaxf(amax, fabsf(v[i]));
        amax = fmaxf(wave_max(amax), 1e-20f); const float inv = 127.0f / amax;
        *(uint4*)(h1b + (size_t)t * 1024 + lane * 16) = pack8(v); *(uint4*)(h1b + (size_t)t * 1024 + lane * 16 + 8) = pack8(v + 8);
        *(uint4*)(h1q + (size_t)t * 1024 + lane * 16) = make_uint4(pack4i8(v[0] * inv, v[1] * inv, v[2] * inv, v[3] * inv), pack4i8(v[4] * inv, v[5] * inv, v[6] * inv, v[7] * inv),
                                                                 pack4i8(v[8] * inv, v[9] * inv, v[10] * inv, v[11] * inv), pack4i8(v[12] * inv, v[13] * inv, v[14] * inv, v[15] * inv));
        if (lane == 0) sx[t] = amax * (1.0f / 127.0f);
    }
}

__device__ __forceinline__ unsigned umaxu(unsigned a, unsigned b) { return a > b ? a : b; }
__device__ __forceinline__ unsigned uminu(unsigned a, unsigned b) { return a < b ? a : b; }
__device__ __forceinline__ unsigned f2mono(float f) { const unsigned u = __float_as_uint(f); return (u & 0x80000000u) ? ~u : (u | 0x80000000u); }
__device__ __forceinline__ float mono2f(unsigned m) { return __uint_as_float((m & 0x80000000u) ? (m & 0x7fffffffu) : ~m); }
template <int N> __device__ __forceinline__ void bitonic_sort_desc(unsigned (&a)[N]) {
#pragma unroll
    for (int k = 2; k <= N; k <<= 1)
#pragma unroll
        for (int j = k >> 1; j > 0; j >>= 1)
#pragma unroll
            for (int i = 0; i < N; ++i) { const int l = i ^ j; if (l > i) { const bool desc = ((i & k) == 0); const unsigned x = a[i], y = a[l], mx = umaxu(x, y), mn = uminu(x, y); a[i] = desc ? mx : mn; a[l] = desc ? mn : mx; } }
}
__device__ __forceinline__ void merge_top16(unsigned (&a)[16], const unsigned (&b)[16]) {
#pragma unroll
    for (int i = 0; i < 16; ++i) a[i] = umaxu(a[i], b[15 - i]);
#pragma unroll
    for (int j = 8; j > 0; j >>= 1)
#pragma unroll
        for (int i = 0; i < 16; ++i) { const int l = i ^ j; if (l > i) { const unsigned x = a[i], y = a[l]; a[i] = umaxu(x, y); a[l] = uminu(x, y); } }
}
constexpr int PK_KROW = 272;
__device__ __forceinline__ void peer_stage1(const bf16* qrow, const unsigned char* krow, int hi, unsigned (&run)[16]) {
    bf16x8 qf[8];
#pragma unroll
    for (int ks = 0; ks < 8; ++ks) qf[ks] = *(const bf16x8*)(qrow + ks * 16);
#pragma unroll 1
    for (int kt = 0; kt < 4; ++kt) {
        f32x16 acc;
#pragma unroll
        for (int e = 0; e < 16; ++e) acc[e] = 0.f;
        const unsigned char* kr = krow + kt * 32 * PK_KROW;
#pragma unroll
        for (int ks = 0; ks < 8; ++ks) acc = __builtin_amdgcn_mfma_f32_32x32x16_bf16(*(const bf16x8*)(kr + ks * 32), qf[ks], acc, 0, 0, 0);
        unsigned grp[16]; const unsigned ib = (unsigned)(127 - kt * 32 - 4 * hi);
#pragma unroll
        for (int e = 0; e < 16; ++e) grp[e] = (f2mono(acc[e]) & ~0x7fu) | (ib - (unsigned)((e & 3) + 8 * (e >> 2)));
        bitonic_sort_desc<16>(grp);
        if (kt == 0) {
#pragma unroll
            for (int i = 0; i < 16; ++i) run[i] = grp[i];
        } else merge_top16(run, grp);
    }
    unsigned oth[16];
#pragma unroll
    for (int i = 0; i < 16; ++i) oth[i] = __shfl_xor(run[i], 32);
    merge_top16(run, oth);
}
__device__ __forceinline__ void ph_peer_topk(const Params& p, int wv, unsigned char* lds) {
    PH_IDS(); unsigned char* ws = p.ws; const int rr = lane & 31, hi = lane >> 5;
    unsigned char* kimg = lds; int* exl = (int*)(lds + 2 * 128 * PK_KROW + wv * 6400);
    const bf16* qp = (const bf16*)(ws + OFF_QP); const bf16* keys = (const bf16*)(ws + OFF_KEYS);
    int* eidx = (int*)(ws + OFF_EIDX); float* gw = (float*)(ws + OFF_GW);
    const int h = bid & 7;
    for (int i = tid; i < 256 * 16; i += NTHREADS) { const int row = i >> 4, ch = i & 15; *(uint4*)(kimg + row * PK_KROW + ch * 16) = *(const uint4*)(keys + ((size_t)h * 256 + row) * 128 + ch * 8); }
    __syncthreads();
    for (int tt = (bid >> 3) * NWAVES + wv; tt < 512; tt += (nb >> 3) * NWAVES) {
        const int t0 = tt * 32;
        unsigned top[2][16];
        peer_stage1(qp + (size_t)(t0 + rr) * 2048 + h * 256 + 8 * hi, kimg + rr * PK_KROW + 16 * hi, hi, top[0]);
        peer_stage1(qp + (size_t)(t0 + rr) * 2048 + h * 256 + 128 + 8 * hi, kimg + (128 + rr) * PK_KROW + 16 * hi, hi, top[1]);
        unsigned g4[4][16];
#pragma unroll
        for (int k = 0; k < 4; ++k)
#pragma unroll
            for (int i = 0; i < 16; ++i) g4[k][i] = 0u;
#pragma unroll
        for (int i = 0; i < 16; ++i) {
            int off = 0;
#pragma unroll
            for (int k = 0; k < 16; ++k) if (k < i) off += 16 / (k + 1);
            const float s0 = mono2f(top[0][i] & ~0x7fu); const int e0 = (int)(127u - (top[0][i] & 0x7fu)) * 128;
#pragma unroll
            for (int j = 0; j < 16; ++j) if ((i + 1) * (j + 1) <= 16) {
                const int nc = off + j;
                const float sum = s0 + mono2f(top[1][j] & ~0x7fu);
                g4[nc >> 4][nc & 15] = (f2mono(sum) & ~0x3fu) | (unsigned)(63 - nc);
                if (hi == 0) exl[nc * 32 + rr] = e0 + (int)(127u - (top[1][j] & 0x7fu));
            }
        }
#pragma unroll
        for (int k = 0; k < 4; ++k) bitonic_sort_desc<16>(g4[k]);
        merge_top16(g4[0], g4[1]); merge_top16(g4[2], g4[3]); merge_top16(g4[0], g4[2]);
        float e16[16]; float den = 0.f; const float gmax = mono2f(g4[0][0] & ~0x3fu);
#pragma unroll
        for (int r = 0; r < 16; ++r) { e16[r] = __expf(mono2f(g4[0][r] & ~0x3fu) - gmax); den += e16[r]; }
        const float inv = 1.0f / den; const size_t ob = (size_t)(t0 + rr) * 128 + h * 16 + hi * 8;
        float wo[8]; int eo[8];
#pragma unroll
        for (int k = 0; k < 8; ++k) { const unsigned key = hi ? g4[0][8 + k] : g4[0][k]; wo[k] = (hi ? e16[8 + k] : e16[k]) * inv; eo[k] = exl[(63 - (int)(key & 0x3fu)) * 32 + rr]; }
        *(float4*)(gw + ob) = make_float4(wo[0], wo[1], wo[2], wo[3]); *(float4*)(gw + ob + 4) = make_float4(wo[4], wo[5], wo[6], wo[7]);
        *(int4*)(eidx + ob) = make_int4(eo[0], eo[1], eo[2], eo[3]); *(int4*)(eidx + ob + 4) = make_int4(eo[4], eo[5], eo[6], eo[7]);
    }
}
__device__ __forceinline__ void ph_peer_cvt(const Params& p, int wv) {
    PH_IDS(); unsigned char* ws = p.ws;
    for (int r = gwave; r < 2 * 16384; r += nwaves) {
        const bool isv = r >= 16384; const int e = isv ? r - 16384 : r;
        const float* src = (isv ? p.peer_v : p.peer_u) + (size_t)e * 1024 + lane * 16; float v[16]; float amax = 0.f;
#pragma unroll
        for (int i = 0; i < 4; ++i) { const float4 a = *(const float4*)(src + 4 * i); v[4 * i] = a.x; v[4 * i + 1] = a.y; v[4 * i + 2] = a.z; v[4 * i + 3] = a.w; }
#pragma unroll
        for (int i = 0; i < 16; ++i) amax = fmaxf(amax, fabsf(v[i]));
        amax = fmaxf(wave_max(amax), 1e-30f); const float inv = 127.0f / amax;
        *(uint4*)(ws + (isv ? OFF_PV : OFF_PU) + (size_t)e * 1024 + lane * 16) = make_uint4(pack4i8(v[0] * inv, v[1] * inv, v[2] * inv, v[3] * inv), pack4i8(v[4] * inv, v[5] * inv, v[6] * inv, v[7] * inv),
                                                                                            pack4i8(v[8] * inv, v[9] * inv, v[10] * inv, v[11] * inv), pack4i8(v[12] * inv, v[13] * inv, v[14] * inv, v[15] * inv));
        if (lane == 0) ((float*)(ws + (isv ? OFF_SV : OFF_SU)))[e] = amax * (1.0f / 127.0f);
    }
}
constexpr size_t OFF_PART = 26 * MiB;
constexpr size_t OFF_Y = 26 * MiB;
static_assert(OFF_PART + 64 * MiB <= OFF_H1B && OFF_PV + 16 * MiB <= OFF_XSBC && OFF_VWT + 8 * MiB <= OFF_PU, "PEER scratch map");
#define PU_ISSUE16(W, ELO, EHI) do { _Pragma("unroll") for (int k = 0; k < 8; ++k) { const int e0 = __shfl(ELO, k * 8 + g), e1 = __shfl(EHI, k * 8 + g); \
        W[k] = *(const uint4*)(PU + (size_t)e0 * 1024 + 128 * s + 16 * j); W[8 + k] = *(const uint4*)(PU + (size_t)e1 * 1024 + 128 * s + 16 * j); } } while (0)
#define PU_DOT16(W, X) __builtin_amdgcn_sdot4((int)(W).w, (int)(X).w, __builtin_amdgcn_sdot4((int)(W).z, (int)(X).z, __builtin_amdgcn_sdot4((int)(W).y, (int)(X).y, __builtin_amdgcn_sdot4((int)(W).x, (int)(X).x, 0, false), false), false), false)
#define PU_REDUCE8(W, O, XQ, PROW, B) do { int d[8], a4[4], a2[2], a1; \
        _Pragma("unroll") for (int k = 0; k < 8; ++k) d[k] = PU_DOT16(W[(O) + k], XQ); \
        _Pragma("unroll") for (int k = 0; k < 4; ++k) { const int give = b2 ? d[k] : d[4 + k]; a4[k] = (b2 ? d[4 + k] : d[k]) + __shfl_xor(give, 4); } \
        _Pragma("unroll") for (int k = 0; k < 2; ++k) { const int give = b1 ? a4[k] : a4[2 + k]; a2[k] = (b1 ? a4[2 + k] : a4[k]) + __shfl_xor(give, 2); } \
        { const int give = b0 ? a2[0] : a2[1]; a1 = (b0 ? a2[1] : a2[0]) + __shfl_xor(give, 1); } \
        (PROW)[(B) * 64 + kk * 8 + g] = a1; } while (0)
#define PU_META(T_, XQ, ELO, EHI) do { const int tq_ = (T_) < T ? (T_) : tlast; XQ = *(const uint4*)(h1q + (size_t)tq_ * 1024 + 128 * s + 16 * j); \
        ELO = eidx[(size_t)tq_ * 128 + lane]; EHI = eidx[(size_t)tq_ * 128 + 64 + lane]; } while (0)
#define PU_TOKEN(W, T_, XQ) do { int* prow = part + ((size_t)s * T + (T_)) * 128; PU_REDUCE8(W, 0, XQ, prow, 0); PU_REDUCE8(W, 8, XQ, prow, 1); } while (0)
__device__ __forceinline__ void ph_peer_u(const Params& p, int wv) {
    PH_IDS(); unsigned char* ws = p.ws; const int s = bid & 7, cu = bid >> 3, ncu = nb >> 3, g = lane >> 3, j = lane & 7;
    const unsigned char* h1q = ws + OFF_H1Q; const int* eidx = (const int*)(ws + OFF_EIDX); const unsigned char* PU = ws + OFF_PU; int* part = (int*)(ws + OFF_PART);
    const bool b2 = (lane & 4) != 0, b1 = (lane & 2) != 0, b0 = (lane & 1) != 0; const int kk = (b2 ? 4 : 0) + (b1 ? 2 : 0) + (b0 ? 1 : 0);
    const int tstep = ncu * NWAVES; int t = cu * NWAVES + wv;
    if (t >= T) return;
    const int tlast = t;
    uint4 xq0, xq1; int el0, eh0, el1, eh1;
    PU_META(t, xq0, el0, eh0); PU_META(t + tstep, xq1, el1, eh1);
    uint4 wA[16], wB[16];
    PU_ISSUE16(wA, el0, eh0);
    for (;;) {
        { const uint4 cx = xq0; PU_META(t + 2 * tstep, xq0, el0, eh0); PU_ISSUE16(wB, el1, eh1); PU_TOKEN(wA, t, cx); }
        t += tstep; if (t >= T) break;
        { const uint4 cx = xq1; PU_META(t + 2 * tstep, xq1, el1, eh1); PU_ISSUE16(wA, el0, eh0); PU_TOKEN(wB, t, cx); }
        t += tstep; if (t >= T) break;
    }
}
__device__ __forceinline__ void ph_peer_c(const Params& p, int wv) {
    PH_IDS(); unsigned char* ws = p.ws; const int* part = (const int*)(ws + OFF_PART); const float* gw = (const float*)(ws + OFF_GW); const int* eidx = (const int*)(ws + OFF_EIDX);
    const float* su = (const float*)(ws + OFF_SU); const float* sv = (const float*)(ws + OFF_SV); const float* sx = (const float*)(ws + OFF_SX); float* sc = (float*)(ws + OFF_SC); unsigned* coefq = (unsigned*)(ws + OFF_COEFQ);
    for (int t = gwave; t < T; t += nwaves) {
        float cp[2];
#pragma unroll
        for (int b = 0; b < 2; ++b) { const size_t i = (size_t)t * 128 + b * 64 + lane; int acc = 0;
#pragma unroll
            for (int s = 0; s < 8; ++s) acc += part[(size_t)s * T * 128 + i];
            const int e = eidx[i]; cp[b] = gw[i] * gelu_exact((float)acc * su[e] * sx[t]) * sv[e]; }
        const float amax = fmaxf(wave_max(fmaxf(fabsf(cp[0]), fabsf(cp[1]))), 1e-30f), inv = 127.0f / amax;
        const int q0 = (int)rintf(cp[0] * inv) & 0xff, q1 = (int)rintf(cp[1] * inv) & 0xff;
        const int gg = lane & 7, kq = (lane >> 3) & 1;
        unsigned w0 = 0u, w1 = 0u;
#pragma unroll
        for (int i = 0; i < 4; ++i) { const int srcl = (4 * kq + i) * 8 + gg; w0 |= (unsigned)__shfl(q0, srcl) << (8 * i); w1 |= (unsigned)__shfl(q1, srcl) << (8 * i); }
        if (lane < 16) { coefq[(size_t)t * 32 + lane] = w0; coefq[(size_t)t * 32 + 16 + lane] = w1; }
        if (lane == 0) sc[t] = amax * (1.0f / 127.0f);
    }
}
#define PV_ISSUE16(W, ELO, EHI) do { _Pragma("unroll") for (int k = 0; k < 8; ++k) { const int e0 = __shfl(ELO, k * 8 + g), e1 = __shfl(EHI, k * 8 + g); \
        W[k] = *(const uint4*)(PV + (size_t)e0 * 1024 + 128 * s + 16 * j); W[8 + k] = *(const uint4*)(PV + (size_t)e1 * 1024 + 128 * s + 16 * j); } } while (0)
#define PV_META(T_, ELO, EHI, CQ) do { const int tq_ = (T_) < T ? (T_) : tlast; ELO = eidx[(size_t)tq_ * 128 + lane]; EHI = eidx[(size_t)tq_ * 128 + 64 + lane]; \
        CQ[0] = coefq[(size_t)tq_ * 32 + g]; CQ[1] = coefq[(size_t)tq_ * 32 + 8 + g]; CQ[2] = coefq[(size_t)tq_ * 32 + 16 + g]; CQ[3] = coefq[(size_t)tq_ * 32 + 24 + g]; } while (0)
#define PV_BLK(W0, W1, W2, W3, CQW, A0, A1, A2, A3) do { \
        const unsigned l01 = __builtin_amdgcn_perm(W1, W0, 0x05010400u), h01 = __builtin_amdgcn_perm(W1, W0, 0x07030602u), l23 = __builtin_amdgcn_perm(W3, W2, 0x05010400u), h23 = __builtin_amdgcn_perm(W3, W2, 0x07030602u); \
        A0 = __builtin_amdgcn_sdot4((int)__builtin_amdgcn_perm(l23, l01, 0x05040100u), (int)(CQW), A0, false); A1 = __builtin_amdgcn_sdot4((int)__builtin_amdgcn_perm(l23, l01, 0x07060302u), (int)(CQW), A1, false); \
        A2 = __builtin_amdgcn_sdot4((int)__builtin_amdgcn_perm(h23, h01, 0x05040100u), (int)(CQW), A2, false); A3 = __builtin_amdgcn_sdot4((int)__builtin_amdgcn_perm(h23, h01, 0x07060302u), (int)(CQW), A3, false); } while (0)
#define PV_QUAD(W, O, CQW) do { PV_BLK(W[(O)].x, W[(O) + 1].x, W[(O) + 2].x, W[(O) + 3].x, CQW, acc[0], acc[1], acc[2], acc[3]); PV_BLK(W[(O)].y, W[(O) + 1].y, W[(O) + 2].y, W[(O) + 3].y, CQW, acc[4], acc[5], acc[6], acc[7]); \
        PV_BLK(W[(O)].z, W[(O) + 1].z, W[(O) + 2].z, W[(O) + 3].z, CQW, acc[8], acc[9], acc[10], acc[11]); PV_BLK(W[(O)].w, W[(O) + 1].w, W[(O) + 2].w, W[(O) + 3].w, CQW, acc[12], acc[13], acc[14], acc[15]); } while (0)
#define PV_TOKEN(W, CQ, T_) do { int acc[16]; _Pragma("unroll") for (int i = 0; i < 16; ++i) acc[i] = 0; \
        PV_QUAD(W, 0, CQ[0]); PV_QUAD(W, 4, CQ[1]); PV_QUAD(W, 8, CQ[2]); PV_QUAD(W, 12, CQ[3]); \
        int y8[8], y4[4], y2[2]; \
        _Pragma("unroll") for (int i = 0; i < 8; ++i) { const int give = b5 ? acc[i] : acc[8 + i]; y8[i] = (b5 ? acc[8 + i] : acc[i]) + __shfl_xor(give, 32); } \
        _Pragma("unroll") for (int i = 0; i < 4; ++i) { const int give = b4 ? y8[i] : y8[4 + i]; y4[i] = (b4 ? y8[4 + i] : y8[i]) + __shfl_xor(give, 16); } \
        _Pragma("unroll") for (int i = 0; i < 2; ++i) { const int give = b3 ? y4[i] : y4[2 + i]; y2[i] = (b3 ? y4[2 + i] : y4[i]) + __shfl_xor(give, 8); } \
        const float sct = sc[(T_)]; *(float2*)(Y + (size_t)(T_) * 1024 + 128 * s + 16 * j + c0) = make_float2((float)y2[0] * sct, (float)y2[1] * sct); } while (0)
__device__ __forceinline__ void ph_peer_v(const Params& p, int wv) {
    PH_IDS(); unsigned char* ws = p.ws; const int s = bid & 7, cu = bid >> 3, ncu = nb >> 3, g = lane >> 3, j = lane & 7;
    const int* eidx = (const int*)(ws + OFF_EIDX); const unsigned* coefq = (const unsigned*)(ws + OFF_COEFQ); const float* sc = (const float*)(ws + OFF_SC); const unsigned char* PV = ws + OFF_PV; float* Y = (float*)(ws + OFF_Y);
    const bool b5 = (lane & 32) != 0, b4 = (lane & 16) != 0, b3 = (lane & 8) != 0; const int c0 = (b5 ? 8 : 0) + (b4 ? 4 : 0) + (b3 ? 2 : 0);
    const int tstep = ncu * NWAVES; int t = cu * NWAVES + wv;
    if (t >= T) return;
    const int tlast = t;
    int el0, eh0, el1, eh1; unsigned cq0[4], cq1[4];
    PV_META(t, el0, eh0, cq0); PV_META(t + tstep, el1, eh1, cq1);
    uint4 wA[16], wB[16];
    PV_ISSUE16(wA, el0, eh0);
    for (;;) {
        { unsigned cc[4] = {cq0[0], cq0[1], cq0[2], cq0[3]}; PV_META(t + 2 * tstep, el0, eh0, cq0); PV_ISSUE16(wB, el1, eh1); PV_TOKEN(wA, cc, t); }
        t += tstep; if (t >= T) break;
        { unsigned cc[4] = {cq1[0], cq1[1], cq1[2], cq1[3]}; PV_META(t + 2 * tstep, el1, eh1, cq1); PV_ISSUE16(wA, el0, eh0); PV_TOKEN(wB, cc, t); }
        t += tstep; if (t >= T) break;
    }
}
__device__ __forceinline__ void ph_peer_ln2(const Params& p, int wv) {
    PH_IDS(); unsigned char* ws = p.ws; const float* Y = (const float*)(ws + OFF_Y);
    int t = gwave; if (t >= T) return;
    float4 ha[4], ya[4];
#pragma unroll
    for (int i = 0; i < 4; ++i) { ha[i] = *(const float4*)(p.out + (size_t)t * 1024 + lane * 16 + 4 * i); ya[i] = *(const float4*)(Y + (size_t)t * 1024 + lane * 16 + 4 * i); }
    for (;;) {
        const int tn = t + nwaves; const int tq = tn < T ? tn : t;
        float4 hb[4], yb[4];
#pragma unroll
        for (int i = 0; i < 4; ++i) { hb[i] = *(const float4*)(p.out + (size_t)tq * 1024 + lane * 16 + 4 * i); yb[i] = *(const float4*)(Y + (size_t)tq * 1024 + lane * 16 + 4 * i); }
        float y[16]; float s1 = 0.f, s2 = 0.f;
#pragma unroll
        for (int i = 0; i < 4; ++i) { y[4 * i] = ya[i].x + DN_ALPHA * ha[i].x; y[4 * i + 1] = ya[i].y + DN_ALPHA * ha[i].y; y[4 * i + 2] = ya[i].z + DN_ALPHA * ha[i].z; y[4 * i + 3] = ya[i].w + DN_ALPHA * ha[i].w; }
#pragma unroll
        for (int i = 0; i < 16; ++i) { s1 += y[i]; s2 += y[i] * y[i]; }
#pragma unroll
        for (int o = 1; o < 64; o <<= 1) { s1 += __shfl_xor(s1, o); s2 += __shfl_xor(s2, o); }
        const float mu = s1 * (1.0f / 1024.0f); const float var = fmaxf(s2 * (1.0f / 1024.0f) - mu * mu, 0.f); const float rstd = rsqrtf(var + LN_EPS);
        float* row = p.out + (size_t)t * 1024 + lane * 16;
#pragma unroll
        for (int i = 0; i < 4; ++i) { const int c = lane * 16 + 4 * i; const float4 ga = *(const float4*)(p.ln2_g + c), ba = *(const float4*)(p.ln2_b + c);
            float4 o; o.x = (y[4 * i] - mu) * rstd * ga.x + ba.x; o.y = (y[4 * i + 1] - mu) * rstd * ga.y + ba.y; o.z = (y[4 * i + 2] - mu) * rstd * ga.z + ba.z; o.w = (y[4 * i + 3] - mu) * rstd * ga.w + ba.w;
            *(float4*)(row + 4 * i) = o; }
        if (tn >= T) break;
        t = tn;
#pragma unroll
        for (int i = 0; i < 4; ++i) { ha[i] = hb[i]; ya[i] = yb[i]; }
    }
}

#define LAS __attribute__((address_space(3)))
#define XB_TMO      128
#define XB_XCNT(j)  (256  + 64 * (j))
#define XB_XSUB(j)  (1280 + 64 * (j))
#define XB_XGEN(j)  (2304 + 64 * (j))
#define XB_TOP      3328
#define XB_TOPGEN   3392
#define XCD_BAR_WORDS 3456
#define XB_SPIN_CAP (1u << 18)

__device__ __forceinline__ unsigned xb_ld(unsigned* p)              { return __hip_atomic_load(p, __ATOMIC_RELAXED, __HIP_MEMORY_SCOPE_AGENT); }
__device__ __forceinline__ unsigned xb_add(unsigned* p, unsigned v) { return __hip_atomic_fetch_add(p, v, __ATOMIC_RELAXED, __HIP_MEMORY_SCOPE_AGENT); }
__device__ __forceinline__ unsigned xb_xcc_id() { return (unsigned)__builtin_amdgcn_s_getreg((3 << 11) | 20) & 0xFu; }
#define XB_SPIN(cond, bar) do { unsigned _sp = 0; while (cond) { __builtin_amdgcn_s_sleep(1); \
    if ((++_sp & 255u) == 0u) { if (xb_ld(&(bar)[XB_TMO])) break; if (_sp > XB_SPIN_CAP) { atomicAdd(&(bar)[XB_TMO], 1u); break; } } } } while (0)

struct XcdBarrier {
    unsigned* bar; unsigned x;
    volatile LAS unsigned* st;
};

__device__ __forceinline__ XcdBarrier xcd_barrier_post(unsigned* bar, volatile LAS unsigned* st, bool leader) {
    XcdBarrier b; b.bar = bar; b.x = xb_xcc_id(); b.st = st;
    if (leader) (void)xb_add(&bar[XB_XCNT(b.x)], 1u);
    return b;
}
__device__ __forceinline__ void xcd_barrier_complete(unsigned* bar, unsigned x, unsigned& nloc, unsigned& nx) {
    const unsigned G = gridDim.x * gridDim.y * gridDim.z;
    unsigned sum, cnt, mine, sp = 0u;
    for (;;) {
        sum = 0u; cnt = 0u; mine = 0u;
#pragma unroll
        for (unsigned j = 0; j < 16; ++j) { const unsigned c = xb_ld(&bar[XB_XCNT(j)]); sum += c; cnt += (c > 0u) ? 1u : 0u; mine = (j == x) ? c : mine; }
        if (sum == G) break;
        __builtin_amdgcn_s_sleep(1);
        if ((++sp & 255u) == 0u) { if (xb_ld(&bar[XB_TMO])) break; if (sp > XB_SPIN_CAP) { atomicAdd(&bar[XB_TMO], 1u); break; } }
    }
    nloc = mine > 0u ? mine : 1u; nx = cnt > 0u ? cnt : 1u;
}

__device__ __forceinline__ void xcd_barrier(const XcdBarrier& b, bool leader) {
    asm volatile("s_waitcnt vmcnt(0)" ::: "memory");
    __syncthreads();
    if (leader) {
        unsigned* bar = b.bar;
        __builtin_amdgcn_s_waitcnt(0);
        unsigned nloc = b.st[0], nx = b.st[1];
        if (nloc == 0u) { xcd_barrier_complete(bar, b.x, nloc, nx); b.st[0] = nloc; b.st[1] = nx; }
        const unsigned old = xb_add(&bar[XB_XSUB(b.x)], 1u);
        const unsigned gen = old / nloc;
        if (old + 1u == (gen + 1u) * nloc) {
            __builtin_amdgcn_fence(__ATOMIC_RELEASE, "agent");
            asm volatile("s_waitcnt vmcnt(0)" ::: "memory");
            const unsigned og = xb_add(&bar[XB_TOP], 1u);
            const unsigned tg = og / nx;
            if (og + 1u == (tg + 1u) * nx) xb_add(&bar[XB_TOPGEN], 1u);
            else XB_SPIN(xb_ld(&bar[XB_TOPGEN]) == tg, bar);
            __builtin_amdgcn_fence(__ATOMIC_ACQUIRE, "agent");
            xb_add(&bar[XB_XGEN(b.x)], 1u);
            asm volatile("s_waitcnt vmcnt(0)" ::: "memory");
        } else {
            XB_SPIN(xb_ld(&bar[XB_XGEN(b.x)]) == gen, bar);
            __builtin_amdgcn_fence(__ATOMIC_ACQUIRE, "agent");
            asm volatile("s_waitcnt vmcnt(0)" ::: "memory");
        }
    }
    __syncthreads();
}

#ifndef TIMING_BOUNDARY
#define TIMING_BOUNDARY -1
#endif
#define TPROBE(k) do { if (TIMING_BOUNDARY == (k)) { const unsigned long long t1_ = __builtin_amdgcn_s_memrealtime(); while (__builtin_amdgcn_s_memrealtime() - t1_ < t1_ - tstart_) __builtin_amdgcn_s_sleep(8); } } while (0)
__global__ void __launch_bounds__(NTHREADS) fwd_megakernel(Params p) {
    extern __shared__ __attribute__((aligned(16))) unsigned char lds[];
    cg::grid_group grid = cg::this_grid();
    const int nb = gridDim.x, bid = blockIdx.x;
    const int wv = __builtin_amdgcn_readfirstlane(threadIdx.x >> 6);
    unsigned char* ws = p.ws;
    const unsigned long long tstart_ = (TIMING_BOUNDARY >= 0) ? __builtin_amdgcn_s_memrealtime() : 0ull; (void)tstart_;
    PG8_LAS unsigned char* ldsp = (PG8_LAS unsigned char*)lds;
    const bool leader = (wv == 0) && (lane_id() == 0);
    volatile LAS unsigned* bst = (volatile LAS unsigned*)(ldsp + LDS_BYTES - 64);
    if (leader) { bst[0] = 0u; bst[1] = 0u; }
    __syncthreads();
    const XcdBarrier xbar = xcd_barrier_post((unsigned*)(ws + OFF_BAR), bst, leader);

    ph_prep(p, wv, lds);
    if (p.ws == nullptr) grid.sync();
    xcd_barrier(xbar, leader);
    TPROBE(0);
    if (bid == 0) {
        const int o = (wv << 6) | lane_id(); const float* b1p = (const float*)(ws + OFF_HID) + (size_t)(o >> 8) * 32 * 256 + (o & 255); float s = 0.f;
        for (int kc = 0; kc < 32; ++kc) s += b1p[kc * 256];
        ((float*)(ws + (o < 256 ? OFF_B1K : OFF_B1V)))[o & 255] = s;
    }
    {
        pg8::Gemm g{(const bf16*)(ws + OFF_XB), (const bf16*)(ws + OFF_WIN), T, NPROJ_PAD, 1024, 1024, 0, 1 << 30, 0l};
        pg8::StaticOrder S; S.init(T, NPROJ_PAD, nb, bid);
        pg8::EpiInProjPg E{(bf16*)(ws + OFF_Z), (bf16*)(ws + OFF_XBC), (bf16*)(ws + OFF_Q), (bf16*)(ws + OFF_KVS), (bf16*)(ws + OFF_DTG)};
        pg8::gemm_phase<pg8::EpiInProjPg, pg8::StaticOrder, pg8::NoMid, true, true>(wv, ldsp, g, S, E, pg8::NoMid{});
    }
    xcd_barrier(xbar, leader);
    TPROBE(1);
    if (bid < 32) {
        const bool isv = bid >= 16;
        pg8::Gemm g{(const bf16*)(ws + OFF_KVS) + (isv ? 256 : 0), (const bf16*)(ws + (isv ? OFF_W1V : OFF_W1K)), 4096, 256, 2048, 0, 1, 1 << 30, 0l};
        pg8::StaticOrder S; S.init(4096, 256, 16, isv ? bid - 16 : bid);
        pg8::EpiBf16<1> E{(bf16*)(ws + OFF_HID + (isv ? 2 * MiB : 0)), 256, (const float*)(ws + (isv ? OFF_B1V : OFF_B1K)), 0, 0, 1.f};
        pg8::gemm_phase<pg8::EpiBf16<1>, pg8::StaticOrder, pg8::NoMid, true, true>(wv, ldsp, g, S, E, pg8::NoMid{});
    }
    else ph_tokprep(p, wv);
    xcd_barrier(xbar, leader);
    TPROBE(2);
    ph_ssd_prep2(p, wv, lds);
    ph_vt_prep(p, wv);
    xcd_barrier(xbar, leader);
    TPROBE(3);
    {
        RowMajorBf16 ak{(const bf16*)(ws + OFF_HID), 256}, av{(const bf16*)(ws + OFF_HID + 2 * MiB), 256};
        RowMajorBf16 bk{(const bf16*)(ws + OFF_W2K), 256}, bv{(const bf16*)(ws + OFF_W2V), 256};
        EpiKc ek{(bf16*)(ws + OFF_KC), false}, ev{(bf16*)(ws + OFF_VCT), true};
        gemm_wave16(wv, 4096 / 16, 64 / 16, 256, ak, bk, ek, 0, 2048);
        gemm_wave16(wv, 4096 / 16, 64 / 16, 256, av, bv, ev, 1024, 2048);
    }
    ph_ssd_states(p, wv);
    xcd_barrier(xbar, leader);
    TPROBE(4);
    ph_kc_rope(p, wv);
    ph_ssd_scan(p, wv);
    ph_peer_cvt(p, wv);
    xcd_barrier(xbar, leader);
    TPROBE(5);
    ph_ssd_out(p, wv, lds);
    ph_nsa(p, wv, lds);
    xcd_barrier(xbar, leader);
    TPROBE(6);
    {
        pg8::Gemm g{(const bf16*)(ws + OFF_Q), (const bf16*)(ws + OFF_WOUT), T, 1024, 2048, 1024, 0, 16, (long)OFF_Z - (long)OFF_Q - 16l * 128l};
        pg8::StaticOrder S; S.init(T, 1024, nb, bid);
        pg8::RmsFactors rf{(const float*)(ws + OFF_SSQ), (const float*)(ws + OFF_HID), RMS_EPS};
        pg8::EpiOutProj E{p.x, p.out, DN_ALPHA, rf}; pg8::MidRmsScale MH{rf};
        pg8::gemm_phase<pg8::EpiOutProj, pg8::StaticOrder, pg8::MidRmsScale, true, true>(wv, ldsp, g, S, E, MH);
    }
    xcd_barrier(xbar, leader);
    TPROBE(7);
    ph_ln1(p, wv);
    xcd_barrier(xbar, leader);
    TPROBE(8);
    {
        pg8::Gemm g{(const bf16*)(ws + OFF_H1B), (const bf16*)(ws + OFF_WQ), T, 2048, 1024, 1024, 0, 1 << 30, 0l};
        pg8::StaticOrder S; S.init(T, 2048, nb, bid);
        pg8::EpiBf16<0> E{(bf16*)(ws + OFF_QP), 2048, nullptr, 0, 0, 1.f};
        pg8::gemm_phase<pg8::EpiBf16<0>, pg8::StaticOrder, pg8::NoMid, true, true>(wv, ldsp, g, S, E, pg8::NoMid{});
    }
    xcd_barrier(xbar, leader);
    TPROBE(9);
    ph_peer_topk(p, wv, lds);
    xcd_barrier(xbar, leader);
    TPROBE(10);
    ph_peer_u(p, wv);
    xcd_barrier(xbar, leader);
    TPROBE(11);
    ph_peer_c(p, wv);
    xcd_barrier(xbar, leader);
    TPROBE(12);
    ph_peer_v(p, wv);
    xcd_barrier(xbar, leader);
    TPROBE(13);
    ph_peer_ln2(p, wv);
}

extern "C" void kernel_launch(void* const* d_in, const int* in_sizes, int n_in, void* d_out, int out_size, void* d_ws, size_t ws_size, hipStream_t stream) {
    static int grid_blocks = 0;
    if (!grid_blocks) {
        int dev = 0, cus = 0, per_cu = 0;
        hipGetDevice(&dev);
        hipDeviceGetAttribute(&cus, hipDeviceAttributeMultiprocessorCount, dev);
        hipFuncSetAttribute((const void*)fwd_megakernel, hipFuncAttributeMaxDynamicSharedMemorySize, LDS_BYTES);
        hipOccupancyMaxActiveBlocksPerMultiprocessor(&per_cu, fwd_megakernel, NTHREADS, LDS_BYTES);
        if (per_cu < 1) per_cu = 1;
        if (per_cu > 1) per_cu = 1;
        grid_blocks = cus * per_cu;
        if (ws_size < 244 * MiB) fprintf(stderr, "kernel_launch: workspace too small: %zu\n", ws_size);
    }
    Params p{};
    const float** pp = (const float**)&p;
    for (int i = 0; i < 24; ++i) pp[i] = (const float*)d_in[i];
    p.out = (float*)d_out; p.ws = (unsigned char*)d_ws;
    (void)hipMemsetAsync((unsigned char*)d_ws + OFF_BAR, 0, BAR_BYTES, stream);
    void* args[] = {&p};
    hipError_t e = hipLaunchCooperativeKernel((void*)fwd_megakernel, dim3(grid_blocks), dim3(NTHREADS), args, LDS_BYTES, stream);
    if (e != hipSuccess) fprintf(stderr, "cooperative launch failed: %s (grid %d)\n", hipGetErrorString(e), grid_blocks);
}
```

```cpp
#include <hip/hip_runtime.h>
#include <hip/hip_cooperative_groups.h>
#include <cstdio>
#include <cstdint>
namespace cg = cooperative_groups;

typedef unsigned short bf16;
typedef short bf16x8 __attribute__((ext_vector_type(8)));
typedef float f32x4 __attribute__((ext_vector_type(4)));
typedef float f32x16 __attribute__((ext_vector_type(16)));
typedef unsigned long long u64;

constexpr int T = 16384, L = 4096, NBATCH = 4, D = 1024;
constexpr int NPROJ = 5184, NPROJ_PAD = 5376;
constexpr int NTHREADS = 512, NWAVES = 8;
constexpr float LN_EPS = 1e-5f, RMS_EPS = 1e-5f;
constexpr float DN_ALPHA = 1.189207115002721f;
constexpr float NEG_INF = -1e30f, BIG = 1e30f;

constexpr size_t MiB = 1u << 20;
constexpr size_t OFF_SSQ = 0, OFF_BAR = 512 * 1024, BAR_BYTES = 16384;
constexpr size_t OFF_WOUT = 1 * MiB, OFF_WQ = 5 * MiB, OFF_W1K = 9 * MiB, OFF_W1V = 10 * MiB;
constexpr size_t OFF_W2K = 11 * MiB, OFF_W2V = 11 * MiB + 65536, OFF_B1K = 11 * MiB + 131072, OFF_B1V = 11 * MiB + 131072 + 4096;
constexpr size_t OFF_KEYS = 12 * MiB, OFF_ROPE = 13 * MiB, OFF_DT = 14 * MiB, OFF_ACS = 15 * MiB, OFF_GATE = 16 * MiB;
constexpr size_t OFF_HID = 20 * MiB, OFF_KC = 24 * MiB;
constexpr size_t OFF_ROPEB = 252 * MiB;
constexpr size_t OFF_Z = 26 * MiB, OFF_Q = 58 * MiB, OFF_KVS = 90 * MiB, OFF_XBC = 138 * MiB, OFF_XSBC = 186 * MiB, OFF_BT = 234 * MiB, OFF_DTG = 242 * MiB;
constexpr size_t OFF_VCT = 19 * MiB;
constexpr size_t OFF_XB = 186 * MiB, OFF_WIN = 218 * MiB;
constexpr size_t OFF_H1B = 90 * MiB, OFF_QP = 26 * MiB, OFF_EIDX = 202 * MiB, OFF_GW = 210 * MiB;
constexpr size_t OFF_PU = 154 * MiB, OFF_PV = 170 * MiB;
constexpr int LDS_BYTES = 147456;

struct Params {
    const float *x, *w_in, *conv_w, *conv_b, *dt_bias, *a_log, *d_skip, *ssd_norm_w;
    const float *cmp_pos_k, *cmp_w1_k, *cmp_w2_k, *cmp_pos_v, *cmp_w1_v, *cmp_w2_v;
    const float *attn_norm_w, *w_out, *ln1_g, *ln1_b, *peer_wq, *peer_keys, *peer_u, *peer_v, *ln2_g, *ln2_b;
    float* out; unsigned char* ws;
};

__device__ __forceinline__ float bf2f(bf16 v) { return __uint_as_float((unsigned)v << 16); }
__device__ __forceinline__ bf16 f2bf(float f) { unsigned u = __float_as_uint(f); return (bf16)((u + 0x7fffu + ((u >> 16) & 1u)) >> 16); }
__device__ __forceinline__ int lane_id() { int l = (int)__builtin_amdgcn_mbcnt_hi(~0u, __builtin_amdgcn_mbcnt_lo(~0u, 0u)); asm volatile("" : "+v"(l)); return l; }
#define PH_IDS() const int lane = lane_id(); const int tid = (wv << 6) | lane; const int bid = blockIdx.x, nb = gridDim.x; const int gtid = bid * NTHREADS + tid, gn = nb * NTHREADS; const int gwave = bid * NWAVES + wv, nwaves = nb * NWAVES; (void)gtid; (void)gn; (void)gwave; (void)nwaves;
typedef float f32x2v __attribute__((ext_vector_type(2)));
typedef __bf16 bf16x2v __attribute__((ext_vector_type(2)));
__device__ __forceinline__ unsigned pk2bf(float lo, float hi) { f32x2v v = {lo, hi}; bf16x2v b = __builtin_convertvector(v, bf16x2v); return __builtin_bit_cast(unsigned, b); }
__device__ __forceinline__ float bflo(unsigned w) { return __uint_as_float(w << 16); }
__device__ __forceinline__ float bfhi(unsigned w) { return __uint_as_float(w & 0xffff0000u); }
__device__ __forceinline__ int shx_i(int v, int o) {
    if (o == 1) return __builtin_amdgcn_update_dpp(v, v, 0xB1  , 0xF, 0xF, false);
    if (o == 2) return __builtin_amdgcn_update_dpp(v, v, 0x4E  , 0xF, 0xF, false);
    if (o == 4) { const int r = __builtin_amdgcn_update_dpp(v, v, 0x104  , 0xF, 0x5, false); return __builtin_amdgcn_update_dpp(r, v, 0x114  , 0xF, 0xA, false); }
    if (o == 8) return __builtin_amdgcn_update_dpp(v, v, 0x128  , 0xF, 0xF, false);
    const int l = (int)__builtin_amdgcn_mbcnt_hi(~0u, __builtin_amdgcn_mbcnt_lo(~0u, 0u));
    if (o == 16) { const auto r = __builtin_amdgcn_permlane16_swap((unsigned)v, (unsigned)v, false, false); return (l & 16) ? (int)r[0] : (int)r[1]; }
    const auto r = __builtin_amdgcn_permlane32_swap((unsigned)v, (unsigned)v, false, false); return (l & 32) ? (int)r[0] : (int)r[1];
}
__device__ __forceinline__ int shx(int v, int o) { return shx_i(v, o); }
__device__ __forceinline__ unsigned shx(unsigned v, int o) { return (unsigned)shx_i((int)v, o); }
__device__ __forceinline__ float shx(float v, int o) { return __int_as_float(shx_i(__float_as_int(v), o)); }
__device__ __forceinline__ float wave_sum(float v) {
#pragma unroll
    for (int o = 1; o < 64; o <<= 1) v += shx(v, o);
    return v;
}
__device__ __forceinline__ float wave_max(float v) {
#pragma unroll
    for (int o = 1; o < 64; o <<= 1) v = fmaxf(v, shx(v, o));
    return v;
}
__device__ __forceinline__ float gelu_exact(float v) { return 0.5f * v * (1.0f + erff(v * 0.7071067811865476f)); }
__device__ __forceinline__ float sigmoidf(float v) { return 1.0f / (1.0f + __expf(-v)); }

template <class AP, class BP, class EP>
__device__ __forceinline__ void gemm_wave32(int wv, int Mt, int Nt, int K, const AP& ap, const BP& bp, const EP& ep) {
    PH_IDS(); const int r = lane & 15, q = lane >> 4;
    for (int tile = gwave; tile < Mt * Nt; tile += nwaves) {
        const int tm = tile / Nt, tn = tile % Nt, row0 = tm * 32, col0 = tn * 32;
        f32x4 acc[2][2];
#pragma unroll
        for (int i = 0; i < 2; ++i)
#pragma unroll
            for (int j = 0; j < 2; ++j) acc[i][j] = (f32x4){0.f, 0.f, 0.f, 0.f};
        for (int k0 = 0; k0 < K; k0 += 32) {
            const bf16x8 a0 = ap(row0 + r, k0 + 8 * q), a1 = ap(row0 + 16 + r, k0 + 8 * q);
            const bf16x8 b0 = bp(col0 + r, k0 + 8 * q), b1 = bp(col0 + 16 + r, k0 + 8 * q);
            acc[0][0] = __builtin_amdgcn_mfma_f32_16x16x32_bf16(a0, b0, acc[0][0], 0, 0, 0);
            acc[0][1] = __builtin_amdgcn_mfma_f32_16x16x32_bf16(a0, b1, acc[0][1], 0, 0, 0);
            acc[1][0] = __builtin_amdgcn_mfma_f32_16x16x32_bf16(a1, b0, acc[1][0], 0, 0, 0);
            acc[1][1] = __builtin_amdgcn_mfma_f32_16x16x32_bf16(a1, b1, acc[1][1], 0, 0, 0);
        }
#pragma unroll
        for (int i = 0; i < 2; ++i)
#pragma unroll
            for (int j = 0; j < 2; ++j)
#pragma unroll
                for (int e = 0; e < 4; ++e) ep(row0 + 16 * i + 4 * q + e, col0 + 16 * j + r, acc[i][j][e]);
    }
}
template <class AP, class BP, class EP>
__device__ __forceinline__ void gemm_wave16(int wv, int Mt, int Nt, int K, const AP& ap, const BP& bp, const EP& ep, int task0, int ntask_total) {
    PH_IDS(); const int r = lane & 15, q = lane >> 4;
    for (int task = gwave; task < ntask_total; task += nwaves) {
        const int tile = task - task0; if (tile < 0 || tile >= Mt * Nt) continue;
        const int tm = tile / Nt, tn = tile % Nt, row0 = tm * 16, col0 = tn * 16;
        f32x4 acc = (f32x4){0.f, 0.f, 0.f, 0.f};
#pragma unroll 4
        for (int k0 = 0; k0 < K; k0 += 32) acc = __builtin_amdgcn_mfma_f32_16x16x32_bf16(ap(row0 + r, k0 + 8 * q), bp(col0 + r, k0 + 8 * q), acc, 0, 0, 0);
#pragma unroll
        for (int e = 0; e < 4; ++e) ep(row0 + 4 * q + e, col0 + r, acc[e]);
    }
}
struct RowMajorBf16 { const bf16* p; int ld; __device__ __forceinline__ bf16x8 operator()(int row, int k) const { return *(const bf16x8*)(p + (size_t)row * ld + k); } };

namespace pg8 {
#define PG8_LAS __attribute__((address_space(3)))
typedef unsigned short bf16_t;
typedef short bf16x8 __attribute__((ext_vector_type(8)));
typedef float f32x4 __attribute__((ext_vector_type(4)));
typedef unsigned u32x4 __attribute__((ext_vector_type(4)));
constexpr int BM = 256, BK = 64, HALF = 128, HTB = HALF * BK * 2  , STAGE_BYTES = 8 * HTB, NXCD = 8, WGM = 8;

__host__ __device__ __forceinline__ int lds_byte(int r, int c) { const int st = (r >> 4) * 2 + (c >> 5), rr = r & 15, cc = c & 31, ob = rr * 64 + cc * 2; return st * 1024 + (ob ^ (((ob >> 9) & 1) << 5)); }
__host__ __device__ __forceinline__ void stage_rc(int b, int& R, int& C) { const int st = b / 1024, sb = b % 1024, swz = sb ^ (((sb >> 9) & 1) << 5); R = (st >> 1) * 16 + swz / 64; C = (st & 1) * 32 + (swz % 64) / 2; }
__host__ __device__ __forceinline__ int perm32(int rho) { const int n = rho >> 4, i = rho & 15; return 8 * (i >> 2) + 4 * n + (i & 3); }

struct Unit { int pm, pn; };
struct Gemm { const bf16_t* A; const bf16_t* Bt; int M, N, K; int lda; int amode; int ksplit; long kdelta; int ldb; };

struct StaticOrder {
    int nM, nN, nwg, G, c;
    __host__ __device__ void init(int M, int N, int G_, int c_) { nM = M / BM; nN = N / BM; nwg = nM * nN; G = G_; c = c_; }
    __host__ __device__ bool next(int i, Unit& u) const {
        const long L = (long)i * G + c; if (L >= nwg) return false;
        int wgid = (int)L; { const int q = nwg / NXCD, r = nwg % NXCD, xcd = wgid % NXCD, off = wgid / NXCD; wgid = (xcd < r ? xcd * (q + 1) : r * (q + 1) + (xcd - r) * q) + off; }
        const int nig = WGM * nN, gid = wgid / nig, fm = gid * WGM, gsz = (nM - fm) < WGM ? (nM - fm) : WGM;
        u.pm = fm + ((wgid % nig) % gsz); u.pn = (wgid % nig) / gsz; return true;
    }
    __device__ __forceinline__ void a_ready(const Unit&) const {}
    __device__ __forceinline__ void done(const Unit&) const {}
};


__device__ __forceinline__ unsigned cvt_pk_bf16(float lo, float hi) { unsigned r; asm volatile("v_cvt_pk_bf16_f32 %0, %1, %2" : "=v"(r) : "v"(lo), "v"(hi)); return r; }
typedef float f32x2 __attribute__((ext_vector_type(2)));
__device__ __forceinline__ f32x2 gelu_pk(f32x2 v) {
    const f32x2 av = __builtin_elementwise_abs(v), d = av * 0.2316418882f + 1.0f;
    f32x2 t; t.x = __builtin_amdgcn_rcpf(d.x); t.y = __builtin_amdgcn_rcpf(d.y);
    f32x2 q = t * 0.5307027145f + (-0.7265760135f); q = q * t + 0.7107068705f; q = q * t + (-0.142248368f); q = q * t + 0.127414796f; q = q * t;
    const f32x2 s = (v * v) * (-0.72134752044f);
    f32x2 e; e.x = __builtin_amdgcn_exp2f(s.x); e.y = __builtin_amdgcn_exp2f(s.y);
    const f32x2 m = v * (q * e), r = v - m;
    f32x2 o; o.x = v.x < 0.f ? m.x : r.x; o.y = v.y < 0.f ? m.y : r.y; return o;
}

template <int ACT  > struct EpiBf16 {
    static constexpr bool PERM = true, AFTER_DRAIN = false; static_assert(ACT == 0 || ACT == 1, "EpiBf16: ACT is 0 (none) or 1 (gelu_pk)");
    bf16_t* O; int ldc; const float* bias; int split_cols; size_t split_stride; float scale0;
    __device__ __forceinline__ void operator()(const f32x4 (&acc)[2][2][4][2], const Unit& u, int wr, int wc, int fr, int fq) const {
        const int row0 = u.pm * BM + wr * 64 + fr; int colt = u.pn * BM; bf16_t* base = O;
        float sc = 1.f; if (split_cols) { const int t = colt / split_cols; base += (size_t)t * split_stride; colt -= t * split_cols; if (t == 0) sc = scale0; }
        const int col0 = colt + wc * 32 + 8 * fq, bcol0 = u.pn * BM + wc * 32 + 8 * fq;
        f32x4 bv[2][2];
#pragma unroll
        for (int bj = 0; bj < 2; ++bj)
#pragma unroll
            for (int n = 0; n < 2; ++n) bv[bj][n] = bias ? *(const f32x4*)(bias + bcol0 + bj * HALF + 4 * n) : (f32x4){0.f, 0.f, 0.f, 0.f};
#pragma unroll
        for (int ai = 0; ai < 2; ++ai)
#pragma unroll
            for (int m = 0; m < 4; ++m) { bf16_t* rowp = base + (size_t)(row0 + ai * HALF + m * 16) * ldc + col0;
#pragma unroll
                for (int bj = 0; bj < 2; ++bj) { f32x4 v0 = acc[ai][bj][m][0] + bv[bj][0], v1 = acc[ai][bj][m][1] + bv[bj][1];
                    if (ACT == 1) { f32x2 a = gelu_pk((f32x2){v0[0], v0[1]}), b = gelu_pk((f32x2){v0[2], v0[3]}), c = gelu_pk((f32x2){v1[0], v1[1]}), d = gelu_pk((f32x2){v1[2], v1[3]});
                        v0 = (f32x4){a.x, a.y, b.x, b.y}; v1 = (f32x4){c.x, c.y, d.x, d.y}; }
                    v0 = v0 * sc; v1 = v1 * sc; u32x4 w; w.x = cvt_pk_bf16(v0[0], v0[1]); w.y = cvt_pk_bf16(v0[2], v0[3]); w.z = cvt_pk_bf16(v1[0], v1[1]); w.w = cvt_pk_bf16(v1[2], v1[3]);
                    *(u32x4*)(rowp + bj * HALF) = w; } }
    }
};

struct EpiInProjPg { static constexpr bool PERM = true, AFTER_DRAIN = false;
    bf16_t *z, *xbc, *q, *kvs, *dtg;
    __device__ __forceinline__ void operator()(const f32x4 (&acc)[2][2][4][2], const Unit& u, int wr, int wc, int fr, int fq) const {
        bf16_t* base; int ldc, colt; const int pn = u.pn;
        if (pn < 4) { base = z; ldc = 1024; colt = pn * 256; } else if (pn < 10) { base = xbc; ldc = 1536; colt = (pn - 4) * 256; }
        else if (pn < 14) { base = q; ldc = 1024; colt = (pn - 10) * 256; } else if (pn < 20) { base = kvs; ldc = 1536; colt = (pn - 14) * 256; }
        else { base = dtg; ldc = 64; colt = 0; }
        const int row0 = u.pm * BM + wr * 64 + fr, col0 = colt + wc * 32 + 8 * fq;
#pragma unroll
        for (int ai = 0; ai < 2; ++ai)
#pragma unroll
            for (int m = 0; m < 4; ++m) { bf16_t* rowp = base + (size_t)(row0 + ai * HALF + m * 16) * ldc + col0;
#pragma unroll
                for (int bj = 0; bj < 2; ++bj) { const f32x4 v0 = acc[ai][bj][m][0], v1 = acc[ai][bj][m][1];
                    u32x4 w; w.x = cvt_pk_bf16(v0[0], v0[1]); w.y = cvt_pk_bf16(v0[2], v0[3]); w.z = cvt_pk_bf16(v1[0], v1[1]); w.w = cvt_pk_bf16(v1[2], v1[3]);
                    if (pn < 20 || (bj == 0 && wc < 2)) *(u32x4*)(rowp + bj * HALF) = w; } }
    }
};
struct RmsFactors { const float* ssqp; const float* ssq2p; float eps;
    __device__ __forceinline__ void get(int row, float& ra, float& r0, float& r1) const {
        const f32x4 a = *(const f32x4*)(ssqp + 4 * row); const f32x4 b0 = *(const f32x4*)(ssq2p + 16 * row), b1 = *(const f32x4*)(ssq2p + 16 * row + 4), b2 = *(const f32x4*)(ssq2p + 16 * row + 8), b3 = *(const f32x4*)(ssq2p + 16 * row + 12);
        ra = rsqrtf(((a[0] + a[1]) + (a[2] + a[3])) * (1.0f / 1024.0f) + eps);
        r0 = rsqrtf((((b0[0] + b0[1]) + (b0[2] + b0[3])) + ((b1[0] + b1[1]) + (b1[2] + b1[3]))) * (1.0f / 512.0f) + eps);
        r1 = rsqrtf((((b2[0] + b2[1]) + (b2[2] + b2[3])) + ((b3[0] + b3[1]) + (b3[2] + b3[3]))) * (1.0f / 512.0f) + eps); } };
struct EpiOutProj { static constexpr bool PERM = true, AFTER_DRAIN = false;
    const float* x; bf16* out; float alpha; const float* fl;
    __device__ __forceinline__ void operator()(const f32x4 (&acc)[2][2][4][2], const Unit& u, int wr, int wc, int fr, int fq) const {
        const int col0 = u.pn * BM + wc * 32 + 8 * fq;
#pragma unroll
        for (int ai = 0; ai < 2; ++ai)
#pragma unroll
            for (int m = 0; m < 4; ++m) { const int row = u.pm * BM + ai * HALF + wr * 64 + m * 16 + fr; const size_t off = (size_t)row * 1024 + col0;
                const float r1 = fl[(ai * HALF + wr * 64 + m * 16 + fr) * 4 + 2];
#pragma unroll
                for (int bj = 0; bj < 2; ++bj) { const size_t o = off + bj * HALF; const f32x4 x0 = *(const f32x4*)(x + o), x1 = *(const f32x4*)(x + o + 4);
                    const f32x4 v0 = x0 * alpha + acc[ai][bj][m][0] * r1, v1 = x1 * alpha + acc[ai][bj][m][1] * r1;
                    *(uint4*)(out + o) = make_uint4(pk2bf(v0[0], v0[1]), pk2bf(v0[2], v0[3]), pk2bf(v1[0], v1[1]), pk2bf(v1[2], v1[3])); } }
    }
};
struct MidRmsScale { static constexpr bool ENABLED = true; RmsFactors rf; float* fl;
    __device__ __forceinline__ void begin(const Unit& u, int wr, int wc, int fr, int fq) const {
        const int idx = (((wr * 4 + wc) * 4 + fq) << 4) + fr;
        if (idx < BM) { float ra, r0, r1; rf.get(u.pm * BM + idx, ra, r0, r1); *(f32x4*)(fl + idx * 4) = (f32x4){ra / r0, r0 / r1, r1, 0.f}; }
    }
    __device__ __forceinline__ void operator()(f32x4 (&acc)[2][2][4][2], const Unit& u, int t, int wr, int wc, int fr, int fq) const {
        if (t != 16 && t != 24) return;
        int rowb = wr * 64 + fr; asm volatile("" : "+v"(rowb));
#pragma unroll
        for (int ai = 0; ai < 2; ++ai)
#pragma unroll
            for (int m = 0; m < 4; ++m) { const float sc = fl[(rowb + ai * HALF + m * 16) * 4 + (t == 16 ? 0 : 1)];
#pragma unroll
                for (int bj = 0; bj < 2; ++bj)
#pragma unroll
                    for (int n = 0; n < 2; ++n) acc[ai][bj][m][n] = acc[ai][bj][m][n] * sc; }
    }
};
struct NoMid { static constexpr bool ENABLED = false; template <class ACC> __device__ __forceinline__ void operator()(ACC&, const Unit&, int, int, int, int, int) const {} };
template <class Epi, class Sched, class Mid, bool ALIGN_EPI = false, bool SP2 = false>
__device__ __forceinline__ void gemm_phase(int wv, PG8_LAS unsigned char* lds, const Gemm g, const Sched& S, const Epi& E, const Mid& MH) {
    int lane_ = (int)__builtin_amdgcn_mbcnt_hi(~0u, __builtin_amdgcn_mbcnt_lo(~0u, 0u)); asm volatile("" : "+v"(lane_));
    const int lane = lane_, wid = wv, tid = (wv << 6) | lane, wr = wid >> 2, wc = wid & 3, fr = lane & 15, fq = lane >> 4;
    const int K = g.K, nt = K / BK, ldb = g.ldb ? g.ldb : K;
    unsigned voffA[2], voffB[2];
#pragma unroll
    for (int i = 0; i < 2; ++i) { int R, C; stage_rc(tid * 16 + i * 8192, R, C); const int Rb = Epi::PERM ? ((R & ~31) + perm32(R & 31)) : R;
        voffA[i] = g.amode == 0 ? (unsigned)(R * g.lda + C) * 2u : (unsigned)((R >> 2) * 49152 + (R & 3) * 128 + C * 2); voffB[i] = (unsigned)(Rb * ldb + C) * 2u; }
    const size_t kstep = (size_t)(BK * 2);
    const size_t hstep = (size_t)HALF * ldb * 2;
    const size_t tstep = 2 * hstep;
    const size_t kstepA = g.amode == 0 ? (size_t)(BK * 2) : (size_t)3072;
    const size_t hstepA = g.amode == 0 ? (size_t)HALF * g.lda * 2 : (size_t)32 * 49152;
    const size_t tstepA = 2 * hstepA;
#define PG8_AK(base, t) ((base) + (size_t)(t) * kstepA + (((t) >= g.ksplit) ? g.kdelta : 0l))
    const unsigned ldsw = (unsigned)wid * 1024u;
    const int aoff = lds_byte(wr * 64 + fr, fq * 8), boff = lds_byte(wc * 32 + fr, fq * 8);
#define PG8_SA(b, h) (((b) * 2 + (h)) * HTB)
#define PG8_SB(b, h) ((4 + (b) * 2 + (h)) * HTB)
#define PG8_STAGE(bufoff, gbase, voff) do { _Pragma("unroll") for (int _i = 0; _i < 2; ++_i) \
        __builtin_amdgcn_global_load_lds((const unsigned*)((const char*)(gbase) + (voff)[_i]), (PG8_LAS unsigned*)(lds + (bufoff) + ldsw + _i * 8192), 16, 0, 0); } while (0)
#define PG8_LDA(dst, b, h) do { _Pragma("unroll") for (int m = 0; m < 4; ++m) _Pragma("unroll") for (int k = 0; k < 2; ++k) dst[m][k] = *(const PG8_LAS bf16x8*)(lds + PG8_SA(b, h) + aoff + m * 2048 + k * 1024); } while (0)
#define PG8_LDB(dst, b, h) do { _Pragma("unroll") for (int n = 0; n < 2; ++n) _Pragma("unroll") for (int k = 0; k < 2; ++k) dst[n][k] = *(const PG8_LAS bf16x8*)(lds + PG8_SB(b, h) + boff + n * 2048 + k * 1024); } while (0)
#define PG8_MMA(ai, bj, At, Bt) do { __builtin_amdgcn_s_setprio(1); _Pragma("unroll") for (int m = 0; m < 4; ++m) _Pragma("unroll") for (int n = 0; n < 2; ++n) _Pragma("unroll") for (int k = 0; k < 2; ++k) \
        acc[ai][bj][m][n] = __builtin_amdgcn_mfma_f32_16x16x32_bf16(Bt[n][k], At[m][k], acc[ai][bj][m][n], 0, 0, 0); __builtin_amdgcn_s_setprio(0); } while (0)
#define PG8_WAIT_V(n) asm volatile("s_waitcnt vmcnt(" #n ")" ::: "memory")
#define PG8_WAIT_L(n) asm volatile("s_waitcnt lgkmcnt(" #n ")" ::: "memory")
#define PG8_BAR __builtin_amdgcn_s_barrier()
#define PG8_SCHED __builtin_amdgcn_sched_barrier(0)
    Unit cur, nxt; int ui = 0;
    if (!S.next(0, cur)) return;
    f32x4 acc[2][2][4][2];
#pragma unroll
    for (int a = 0; a < 2; ++a)
#pragma unroll
        for (int b = 0; b < 2; ++b)
#pragma unroll
            for (int m = 0; m < 4; ++m)
#pragma unroll
                for (int n = 0; n < 2; ++n) acc[a][b][m][n] = (f32x4){0.f, 0.f, 0.f, 0.f};
    bf16x8 At[4][2], B0[2][2], B1[2][2];
    const char* cA = (const char*)g.A + (size_t)cur.pm * tstepA; const char* cB = (const char*)g.Bt + (size_t)cur.pn * tstep;
    S.a_ready(cur);
    if constexpr (SP2) {
        PG8_STAGE(PG8_SB(0, 0), cB, voffB); PG8_STAGE(PG8_SB(0, 1), cB + hstep, voffB); PG8_STAGE(PG8_SA(0, 0), cA, voffA); PG8_STAGE(PG8_SA(0, 1), cA + hstepA, voffA);
        if (wr == 1) PG8_BAR;
        PG8_WAIT_V(2); PG8_BAR;
        PG8_STAGE(PG8_SB(1, 0), cB + kstep, voffB); PG8_STAGE(PG8_SA(1, 0), PG8_AK(cA, 1), voffA); PG8_STAGE(PG8_SB(1, 1), cB + hstep + kstep, voffB);
        PG8_WAIT_V(6); PG8_BAR;
    } else {
        PG8_STAGE(PG8_SB(0, 0), cB, voffB); PG8_STAGE(PG8_SA(0, 0), cA, voffA); PG8_STAGE(PG8_SB(0, 1), cB + hstep, voffB); PG8_STAGE(PG8_SA(0, 1), cA + hstepA, voffA);
        if (wr == 1) PG8_BAR;
        PG8_WAIT_V(4); PG8_BAR;
        PG8_STAGE(PG8_SB(1, 0), cB + kstep, voffB); PG8_STAGE(PG8_SA(1, 0), PG8_AK(cA, 1), voffA); PG8_STAGE(PG8_SB(1, 1), cB + hstep + kstep, voffB);
        PG8_WAIT_V(6); PG8_BAR;
    }
    for (;;) {
        const bool has_next = S.next(ui + 1, nxt);
        const char* nA = has_next ? (const char*)g.A + (size_t)nxt.pm * tstepA : cA; const char* nB = has_next ? (const char*)g.Bt + (size_t)nxt.pn * tstep : cB;
        if constexpr (Mid::ENABLED) MH.begin(cur, wr, wc, fr, fq);
        for (int t = 0; t < nt; t += 2) {
            const bool last = (t == nt - 2);
            if (Mid::ENABLED) MH(acc, cur, t, wr, wc, fr, fq);
            const char* a1 = PG8_AK(cA, t + 1);
            const char* a2 = last ? nA : PG8_AK(cA, t + 2); const char* b2 = last ? nB : cB + (size_t)(t + 2) * kstep;
            const char* a3 = a2 + kstepA; const char* b3 = b2 + kstep;
            if (last && has_next) S.a_ready(nxt);
            if constexpr (SP2) {
            PG8_LDB(B0, 0, 0); PG8_LDB(B1, 0, 1); PG8_SCHED; PG8_LDA(At, 0, 0); PG8_STAGE(PG8_SA(1, 1), a1 + hstepA, voffA);
            PG8_WAIT_V(8); PG8_WAIT_L(0); PG8_BAR; PG8_MMA(0, 0, At, B0); PG8_MMA(0, 1, At, B1); PG8_BAR; PG8_SCHED;
            PG8_LDA(At, 0, 1); PG8_STAGE(PG8_SB(0, 0), b2, voffB); PG8_STAGE(PG8_SB(0, 1), b2 + hstep, voffB); PG8_STAGE(PG8_SA(0, 0), a2, voffA);
            PG8_WAIT_V(8); PG8_WAIT_L(0); PG8_BAR; PG8_MMA(1, 0, At, B0); PG8_MMA(1, 1, At, B1); PG8_BAR; PG8_SCHED;
            PG8_LDB(B0, 1, 0); PG8_LDB(B1, 1, 1); PG8_SCHED; PG8_LDA(At, 1, 0); PG8_STAGE(PG8_SA(0, 1), a2 + hstepA, voffA);
            PG8_WAIT_V(8); PG8_WAIT_L(0); PG8_BAR; PG8_MMA(0, 0, At, B0); PG8_MMA(0, 1, At, B1); PG8_BAR; PG8_SCHED;
            PG8_LDA(At, 1, 1); PG8_STAGE(PG8_SB(1, 0), b3, voffB); PG8_STAGE(PG8_SB(1, 1), b3 + hstep, voffB); PG8_STAGE(PG8_SA(1, 0), a3, voffA);
            PG8_WAIT_V(8); PG8_WAIT_L(0); PG8_BAR; PG8_MMA(1, 0, At, B0); PG8_MMA(1, 1, At, B1); PG8_BAR; PG8_SCHED;
            } else {
            PG8_LDB(B0, 0, 0); PG8_SCHED; PG8_LDA(At, 0, 0); PG8_STAGE(PG8_SA(1, 1), a1 + hstepA, voffA);
            PG8_WAIT_L(8); PG8_BAR; PG8_WAIT_L(0); PG8_MMA(0, 0, At, B0); PG8_BAR; PG8_SCHED;
            PG8_LDB(B1, 0, 1); PG8_STAGE(PG8_SB(0, 0), b2, voffB);
            PG8_BAR; PG8_WAIT_L(0); PG8_MMA(0, 1, At, B1); PG8_BAR;
            PG8_LDA(At, 0, 1); PG8_STAGE(PG8_SA(0, 0), a2, voffA);
            PG8_BAR; PG8_WAIT_L(0); PG8_MMA(1, 0, At, B0); PG8_BAR; PG8_SCHED;
            PG8_STAGE(PG8_SB(0, 1), b2 + hstep, voffB);
            PG8_WAIT_V(6); PG8_BAR; PG8_MMA(1, 1, At, B1); PG8_BAR;
            PG8_LDB(B0, 1, 0); PG8_SCHED; PG8_LDA(At, 1, 0); PG8_STAGE(PG8_SA(0, 1), a2 + hstepA, voffA);
            PG8_WAIT_L(8); PG8_BAR; PG8_WAIT_L(0); PG8_MMA(0, 0, At, B0); PG8_BAR; PG8_SCHED;
            PG8_LDB(B1, 1, 1); PG8_STAGE(PG8_SB(1, 0), b3, voffB);
            PG8_BAR; PG8_WAIT_L(0); PG8_MMA(0, 1, At, B1); PG8_BAR;
            PG8_LDA(At, 1, 1); PG8_STAGE(PG8_SA(1, 0), a3, voffA);
            PG8_BAR; PG8_WAIT_L(0); PG8_MMA(1, 0, At, B0); PG8_BAR; PG8_SCHED;
            PG8_STAGE(PG8_SB(1, 1), b3 + hstep, voffB);
            PG8_WAIT_V(6); PG8_BAR; PG8_MMA(1, 1, At, B1); PG8_BAR;
            }
        }
        if constexpr (ALIGN_EPI) { if (wr == 0) PG8_BAR; }
        if constexpr (!Epi::AFTER_DRAIN) { E(acc, cur, wr, wc, fr, fq); S.done(cur); }
        if (!has_next) break;
#pragma unroll
        for (int a = 0; a < 2; ++a)
#pragma unroll
            for (int b = 0; b < 2; ++b)
#pragma unroll
                for (int m = 0; m < 4; ++m)
#pragma unroll
                    for (int n = 0; n < 2; ++n) acc[a][b][m][n] = (f32x4){0.f, 0.f, 0.f, 0.f};
        cur = nxt; cA = nA; cB = nB; ++ui;
        if constexpr (ALIGN_EPI) { if (wr == 1) PG8_BAR; }
    }
    PG8_WAIT_V(0);
    if constexpr (!ALIGN_EPI) { if (wr == 0) PG8_BAR; }
    PG8_BAR;
    if constexpr (Epi::AFTER_DRAIN) { E.fused(acc, cur, wr, wc, fr, fq, lds, wid, lane); S.done(cur); }
#undef PG8_AK
#undef PG8_SA
#undef PG8_SB
#undef PG8_STAGE
#undef PG8_LDA
#undef PG8_LDB
#undef PG8_MMA
#undef PG8_WAIT_V
#undef PG8_WAIT_L
#undef PG8_BAR
#undef PG8_SCHED
}
}

__device__ __forceinline__ int winmap(int n) { return n < 2560 ? n : (n < 5120 ? n + 16 : (n < 5136 ? 2560 + (n - 5120) : n)); }
template <class Map>
__device__ __forceinline__ void transpose_item(const float* W, int ldw, bf16* WT, int K, int item, int nblk, float* scr, int lane, const Map& mp) {
    const int kb = item / nblk, nbk = item % nblk, k0 = 64 * kb, n0 = 32 * nbk;
    const int cq = lane & 7, rsub = lane >> 3; const int col = mp.scol(n0 + 4 * cq);
#pragma unroll
    for (int i = 0; i < 8; ++i) { const int kk = 8 * i + rsub; float4 v = make_float4(0.f, 0.f, 0.f, 0.f);
        if (col >= 0) v = *(const float4*)(W + (size_t)mp.srow(k0 + kk) * ldw + col);
        const float sc = mp.scale(k0 + kk); float* d = scr + kk * 33 + 4 * cq; d[0] = v.x * sc; d[1] = v.y * sc; d[2] = v.z * sc; d[3] = v.w * sc; }
    const int c = lane & 7;
#pragma unroll
    for (int j = 0; j < 4; ++j) { const int n = (lane >> 3) + 8 * j; const float* s = scr + (8 * c) * 33 + n;
        *(uint4*)(WT + (size_t)(n0 + n) * K + k0 + 8 * c) = make_uint4(pk2bf(s[0], s[33]), pk2bf(s[66], s[99]), pk2bf(s[132], s[165]), pk2bf(s[198], s[231])); }
}
struct MapPlain { __device__ __forceinline__ int srow(int k) const { return k; } __device__ __forceinline__ int scol(int n) const { return n; } __device__ __forceinline__ float scale(int) const { return 1.f; } };
struct MapWin { __device__ __forceinline__ int srow(int k) const { return k; } __device__ __forceinline__ int scol(int n) const { return n < NPROJ ? winmap(n) : -1; } __device__ __forceinline__ float scale(int) const { return 1.f; } };
struct MapWout { const float* an; const float* sn;
    __device__ __forceinline__ int srow(int k) const { return (k + 1024) & 2047; } __device__ __forceinline__ int scol(int n) const { return n; } __device__ __forceinline__ float scale(int k) const { return k < 1024 ? an[k] : sn[k - 1024]; } };
__device__ __forceinline__ void ph_prep(const Params& p, int wv, unsigned char* lds) {
    PH_IDS(); unsigned char* ws = p.ws;
    bf16* xb = (bf16*)(ws + OFF_XB);
    for (size_t i = gtid; i < (size_t)T * D / 8; i += gn) { const float4 v = ((const float4*)p.x)[2 * i], w = ((const float4*)p.x)[2 * i + 1]; ((uint4*)xb)[i] = make_uint4(pk2bf(v.x, v.y), pk2bf(v.z, v.w), pk2bf(w.x, w.y), pk2bf(w.z, w.w)); }
    {
        float* scr = (float*)(lds + wv * 8448);
        constexpr int I_WIN = 16 * 168, I_WOUT = 32 * 32, I_WQ = 16 * 64, I_W1 = 32 * 8, I_W2 = 4 * 2;
        constexpr int NIT = I_WIN + I_WOUT + I_WQ + 2 * I_W1 + 2 * I_W2;
        for (int it = gwave; it < NIT; it += nwaves) {
            int r = it;
            if (r < I_WIN) { transpose_item(p.w_in, NPROJ, (bf16*)(ws + OFF_WIN), 1024, r, 168, scr, lane, MapWin{}); continue; } r -= I_WIN;
            if (r < I_WOUT) { transpose_item(p.w_out, 1024, (bf16*)(ws + OFF_WOUT), 2048, r, 32, scr, lane, MapWout{p.attn_norm_w, p.ssd_norm_w}); continue; } r -= I_WOUT;
            if (r < I_WQ) { transpose_item(p.peer_wq, 2048, (bf16*)(ws + OFF_WQ), 1024, r, 64, scr, lane, MapPlain{}); continue; } r -= I_WQ;
            if (r < I_W1) { transpose_item(p.cmp_w1_k, 256, (bf16*)(ws + OFF_W1K), 2048, r, 8, scr, lane, MapPlain{}); continue; } r -= I_W1;
            if (r < I_W1) { transpose_item(p.cmp_w1_v, 256, (bf16*)(ws + OFF_W1V), 2048, r, 8, scr, lane, MapPlain{}); continue; } r -= I_W1;
            if (r < I_W2) { transpose_item(p.cmp_w2_k, 64, (bf16*)(ws + OFF_W2K), 256, r, 2, scr, lane, MapPlain{}); continue; } r -= I_W2;
            transpose_item(p.cmp_w2_v, 64, (bf16*)(ws + OFF_W2V), 256, r, 2, scr, lane, MapPlain{});
        }
    }
    bf16* keys = (bf16*)(ws + OFF_KEYS);
    for (int i = gtid; i < 8 * 2 * 128 * 128 / 8; i += gn) { const float4 a = ((const float4*)p.peer_keys)[2 * i], b = ((const float4*)p.peer_keys)[2 * i + 1]; ((uint4*)keys)[i] = make_uint4(pk2bf(a.x, a.y), pk2bf(a.z, a.w), pk2bf(b.x, b.y), pk2bf(b.z, b.w)); }
    float* rc = (float*)(ws + OFF_ROPE); float* rs = rc + 4096 * 32;
    for (int i = gtid; i < 4096 * 32; i += gn) {
        const int pos = i >> 5, j = i & 31;
        const float inv = powf(10000.0f, -(float)(2 * j) / 64.0f); const float angf = (float)pos * inv;
        double xr = (double)angf * 0.15915494309189535; xr -= rint(xr); const double rr = xr * 6.283185307179586, r2 = rr * rr;
        double s = -1.0 / 10888869450418352160768000000.0, c = 1.0 / 403291461126605635584000000.0;
        s = s * r2 + 1.0 / 15511210043330985984000000.0;  c = c * r2 - 1.0 / 620448401733239439360000.0;
        s = s * r2 - 1.0 / 25852016738884976640000.0;     c = c * r2 + 1.0 / 1124000727777607680000.0;
        s = s * r2 + 1.0 / 51090942171709440000.0;        c = c * r2 - 1.0 / 2432902008176640000.0;
        s = s * r2 - 1.0 / 121645100408832000.0;          c = c * r2 + 1.0 / 6402373705728000.0;
        s = s * r2 + 1.0 / 355687428096000.0;             c = c * r2 - 1.0 / 20922789888000.0;
        s = s * r2 - 1.0 / 1307674368000.0;               c = c * r2 + 1.0 / 87178291200.0;
        s = s * r2 + 1.0 / 6227020800.0;                  c = c * r2 - 1.0 / 479001600.0;
        s = s * r2 - 1.0 / 39916800.0;                    c = c * r2 + 1.0 / 3628800.0;
        s = s * r2 + 1.0 / 362880.0;                      c = c * r2 - 1.0 / 40320.0;
        s = s * r2 - 1.0 / 5040.0;                        c = c * r2 + 1.0 / 720.0;
        s = s * r2 + 1.0 / 120.0;                         c = c * r2 - 1.0 / 24.0;
        s = s * r2 - 1.0 / 6.0;                           c = c * r2 + 0.5;
        s = s * r2 + 1.0;                                 c = c * r2 - 1.0;
        s = s * rr; c = -c;
        rc[i] = (float)c; rs[i] = (float)s;
        { bf16* rb = (bf16*)(ws + OFF_ROPEB); rb[pos * 64 + j] = f2bf((float)c); rb[pos * 64 + 32 + j] = f2bf((float)s); }
    }
    float* b1p = (float*)(ws + OFF_HID);
    for (int o = gwave; o < 64; o += nwaves) {
        const int mat = o >> 5, kc = o & 31; const float* pos = mat ? p.cmp_pos_v : p.cmp_pos_k; const float* w1 = mat ? p.cmp_w1_v : p.cmp_w1_k;
        float4 acc = make_float4(0.f, 0.f, 0.f, 0.f);
#pragma unroll 8
        for (int k = kc * 64; k < kc * 64 + 64; ++k) { const float pk = pos[k]; const float4 w = *(const float4*)(w1 + (size_t)k * 256 + 4 * lane); acc.x += pk * w.x; acc.y += pk * w.y; acc.z += pk * w.z; acc.w += pk * w.w; }
        *(float4*)(b1p + (size_t)o * 256 + 4 * lane) = acc;
    }
}

__device__ __forceinline__ void unpack8(const uint4& w, float* f) { f[0] = __uint_as_float(w.x << 16); f[1] = __uint_as_float(w.x & 0xffff0000u); f[2] = __uint_as_float(w.y << 16); f[3] = __uint_as_float(w.y & 0xffff0000u);
    f[4] = __uint_as_float(w.z << 16); f[5] = __uint_as_float(w.z & 0xffff0000u); f[6] = __uint_as_float(w.w << 16); f[7] = __uint_as_float(w.w & 0xffff0000u); }
__device__ __forceinline__ uint4 pack8(const float* f) { return make_uint4(pk2bf(f[0], f[1]), pk2bf(f[2], f[3]), pk2bf(f[4], f[5]), pk2bf(f[6], f[7])); }
__device__ __forceinline__ void ph_tokprep(const Params& p, int wv) {
    PH_IDS(); unsigned char* ws = p.ws;
    const int gtid_ = (nb > 128 ? bid - 64 : bid) * NTHREADS + tid, gn_ = (nb > 128 ? nb - 64 : nb) * NTHREADS;
    const bf16* xbc = (const bf16*)(ws + OFF_XBC); bf16* xsbc = (bf16*)(ws + OFF_XSBC);
    for (int it = gtid_; it < (T / 16) * 192; it += gn_) {
        const int cg = it % 192, tg = it / 192, ch = cg * 8, t0 = tg * 16, l0 = t0 & (L - 1);
        float w[4][8], bias[8];
#pragma unroll
        for (int j = 0; j < 4; ++j) { const float4 a = *(const float4*)(p.conv_w + j * 1536 + ch), b2 = *(const float4*)(p.conv_w + j * 1536 + ch + 4); w[j][0] = a.x; w[j][1] = a.y; w[j][2] = a.z; w[j][3] = a.w; w[j][4] = b2.x; w[j][5] = b2.y; w[j][6] = b2.z; w[j][7] = b2.w; }
        { const float4 a = *(const float4*)(p.conv_b + ch), b2 = *(const float4*)(p.conv_b + ch + 4); bias[0] = a.x; bias[1] = a.y; bias[2] = a.z; bias[3] = a.w; bias[4] = b2.x; bias[5] = b2.y; bias[6] = b2.z; bias[7] = b2.w; }
        float x0[8], x1[8], x2[8], x3[8];
        { uint4 h0 = make_uint4(0u, 0u, 0u, 0u), h1 = h0, h2 = h0;
          if (l0 != 0) { h0 = *(const uint4*)(xbc + (size_t)(t0 - 3) * 1536 + ch); h1 = *(const uint4*)(xbc + (size_t)(t0 - 2) * 1536 + ch); h2 = *(const uint4*)(xbc + (size_t)(t0 - 1) * 1536 + ch); }
          unpack8(h0, x0); unpack8(h1, x1); unpack8(h2, x2); }
#pragma unroll
        for (int u = 0; u < 16; ++u) {
            unpack8(*(const uint4*)(xbc + (size_t)(t0 + u) * 1536 + ch), x3);
            float y[8];
#pragma unroll
            for (int i = 0; i < 8; ++i) { const float v = bias[i] + w[0][i] * x0[i] + w[1][i] * x1[i] + w[2][i] * x2[i] + w[3][i] * x3[i]; y[i] = v * sigmoidf(v); x0[i] = x1[i]; x1[i] = x2[i]; x2[i] = x3[i]; }
            *(uint4*)(xsbc + (size_t)(t0 + u) * 1536 + ch) = pack8(y);
        }
    }
    const bf16* dtg = (const bf16*)(ws + OFF_DTG); float* dt = (float*)(ws + OFF_DT); float* gate = (float*)(ws + OFF_GATE);
    for (int i = gtid_; i < T * 8; i += gn_) {
        const int t = i >> 3, c0 = (i & 7) * 8; float v[8], o[8]; unpack8(*(const uint4*)(dtg + (size_t)t * 64 + c0), v);
        if (c0 < 16) {
#pragma unroll
            for (int k = 0; k < 8; ++k) { const float xx = v[k] + p.dt_bias[c0 + k]; o[k] = xx > 20.f ? xx : log1pf(__expf(xx)); }
            float* d = dt + t * 16 + c0; *(float4*)d = make_float4(o[0], o[1], o[2], o[3]); *(float4*)(d + 4) = make_float4(o[4], o[5], o[6], o[7]);
        } else {
#pragma unroll
            for (int k = 0; k < 8; ++k) o[k] = sigmoidf(v[k]);
            float* d = gate + t * 48 + (c0 - 16); *(float4*)d = make_float4(o[0], o[1], o[2], o[3]); *(float4*)(d + 4) = make_float4(o[4], o[5], o[6], o[7]);
        }
    }
    const float* rc = (const float*)(ws + OFF_ROPE); const float* rs = rc + 4096 * 32;
    bf16* q = (bf16*)(ws + OFF_Q); bf16* kvs = (bf16*)(ws + OFF_KVS);
    for (int it = gtid_; it < T * 8 * 4; it += gn_) {
        const int j0 = (it & 3) * 8, hh = 16 + ((it >> 2) & 7), t = it >> 5, l = t & (L - 1);
        bf16* pp; float sc;
        if (hh < 16) { pp = q + (size_t)t * 1024 + hh * 64 + j0; sc = 0.125f * 1.4426950408889634f; } else if (hh < 20) { pp = kvs + (size_t)t * 1536 + 512 + (hh - 16) * 64 + j0; sc = 1.f; } else { pp = kvs + (size_t)t * 1536 + 1024 + (hh - 20) * 64 + j0; sc = 1.f; }
        float x1[8], x2[8], c[8], s[8], o1[8], o2[8];
        unpack8(*(const uint4*)pp, x1); unpack8(*(const uint4*)(pp + 32), x2);
        { const float4 a = *(const float4*)(rc + l * 32 + j0), b2 = *(const float4*)(rc + l * 32 + j0 + 4), d = *(const float4*)(rs + l * 32 + j0), e = *(const float4*)(rs + l * 32 + j0 + 4);
          c[0] = a.x; c[1] = a.y; c[2] = a.z; c[3] = a.w; c[4] = b2.x; c[5] = b2.y; c[6] = b2.z; c[7] = b2.w; s[0] = d.x; s[1] = d.y; s[2] = d.z; s[3] = d.w; s[4] = e.x; s[5] = e.y; s[6] = e.z; s[7] = e.w; }
#pragma unroll
        for (int i = 0; i < 8; ++i) { o1[i] = (x1[i] * c[i] - x2[i] * s[i]) * sc; o2[i] = (x1[i] * s[i] + x2[i] * c[i]) * sc; }
        *(uint4*)pp = pack8(o1); *(uint4*)(pp + 32) = pack8(o2);
    }
}

__device__ __forceinline__ void swap16(unsigned& a, unsigned& b) { const auto r = __builtin_amdgcn_permlane16_swap(a, b, false, false); a = r[0]; b = r[1]; }
__device__ __forceinline__ void swap32(unsigned& a, unsigned& b) { const auto r = __builtin_amdgcn_permlane32_swap(a, b, false, false); a = r[0]; b = r[1]; }
__device__ __forceinline__ void ph_ssd_prep2(const Params& p, int wv, unsigned char* lds) {
    PH_IDS(); unsigned char* ws = p.ws;
    const bf16* xsbc = (const bf16*)(ws + OFF_XSBC); const float* dt = (const float*)(ws + OFF_DT);
    bf16* XdT = (bf16*)p.out; bf16* BT = (bf16*)(ws + OFF_BT); float* acsT = (float*)(ws + OFF_ACS);
    float* sdt = (float*)lds; float* swave = sdt + 128;
    unsigned* XT = (unsigned*)(lds + 2048); constexpr int XTS = 96;
    const int bide = bid, nbe = nb;
    for (int unit = bide; unit < 2048 + 256; unit += nbe) {
        __syncthreads();
        if (unit < 2048) {
            const int h = unit & 15, bc = unit >> 4; const size_t t0 = (size_t)bc * 128;
            const float A = -__expf(p.a_log[h]);
            const int sp = tid & 63, ch = tid >> 6;
            const uint4 r0 = *(const uint4*)(xsbc + (t0 + 2 * sp) * 1536 + h * 64 + 8 * ch), r1 = *(const uint4*)(xsbc + (t0 + 2 * sp + 1) * 1536 + h * 64 + 8 * ch);
            if (tid < 128) { const float dv = dt[(t0 + tid) * 16 + h]; sdt[tid] = dv; float a = dv * A;
#pragma unroll
                for (int o = 1; o < 64; o <<= 1) { const float v = __shfl_up(a, o); if (lane >= o) a += v; }
                if (lane == 63) swave[tid >> 6] = a;
                sdt[128 + 8 + tid] = a; }
            __syncthreads();
            if (tid < 128) { float a = sdt[128 + 8 + tid]; if (tid >= 64) a += swave[0]; acsT[(size_t)unit * 128 + tid] = a; }
            { float v0[8], v1[8]; unpack8(r0, v0); unpack8(r1, v1); const float d0 = sdt[2 * sp], d1 = sdt[2 * sp + 1];
#pragma unroll
              for (int k = 0; k < 8; ++k) XT[(8 * ch + k) * XTS + sp] = pk2bf(v0[k] * d0, v1[k] * d1); }
            __syncthreads();
#pragma unroll
            for (int rep = 0; rep < 2; ++rep) { const int pp = tid >> 3, sc = (tid & 7) + 8 * rep;
                *(uint4*)(XdT + (size_t)unit * 8192 + ((sc >> 1) * 64 + pp) * 16 + 8 * (sc & 1)) = *(const uint4*)(XT + pp * XTS + 4 * sc); }
        } else {
            const int u2 = unit - 2048, g = u2 & 1, bc = u2 >> 1; const size_t t0 = (size_t)bc * 128;
            const int sp = tid & 63, ch = tid >> 6;
#pragma unroll
            for (int half = 0; half < 2; ++half) {
                const int cc = ch + 8 * half;
                const uint4 r0 = *(const uint4*)(xsbc + (t0 + 2 * sp) * 1536 + 1024 + g * 128 + 8 * cc), r1 = *(const uint4*)(xsbc + (t0 + 2 * sp + 1) * 1536 + 1024 + g * 128 + 8 * cc);
#pragma unroll
                for (int k = 0; k < 4; ++k) { const unsigned a = (&r0.x)[k], b2 = (&r1.x)[k];
                    XT[(8 * cc + 2 * k) * XTS + sp] = (a & 0xffffu) | (b2 << 16); XT[(8 * cc + 2 * k + 1) * XTS + sp] = (a >> 16) | (b2 & 0xffff0000u); }
            }
            __syncthreads();
#pragma unroll
            for (int rep = 0; rep < 4; ++rep) { const int n = (tid >> 3) + 64 * (rep >> 1), sc = (tid & 7) + 8 * (rep & 1);
                *(uint4*)(BT + (size_t)u2 * 16384 + ((sc >> 1) * 128 + n) * 16 + 8 * (sc & 1)) = *(const uint4*)(XT + n * XTS + 4 * sc); }
        }
    }
}
__device__ __forceinline__ void ph_ssd_states(const Params& p, int wv) {
    PH_IDS(); unsigned char* ws = p.ws; const int rr = lane & 31, hi = lane >> 5;
    const bf16* XdT = (const bf16*)p.out; bf16* S = (bf16*)((unsigned char*)p.out + 32 * MiB); const bf16* BT = (const bf16*)(ws + OFF_BT); const float* acsT = (const float*)(ws + OFF_ACS);
    for (int unit = gwave; unit < 2048; unit += nwaves) {
        const int h = unit & 15, bc = unit >> 4, g = h >> 3;
        const float* ac = acsT + (size_t)unit * 128; const float alast = ac[127];
        const bf16* xrow = XdT + (size_t)unit * 8192 + rr * 16 + 8 * hi; const bf16* bt = BT + (size_t)(bc * 2 + g) * 16384 + rr * 16 + 8 * hi;
        f32x16 acc[4][2];
#pragma unroll
        for (int nt = 0; nt < 4; ++nt)
#pragma unroll
            for (int pt = 0; pt < 2; ++pt)
#pragma unroll
                for (int e = 0; e < 16; ++e) acc[nt][pt][e] = 0.f;
#pragma unroll 2
        for (int ks = 0; ks < 8; ++ks) {
            const int l0 = ks * 16 + 8 * hi; float dec[8];
            { const f32x4 a0 = *(const f32x4*)(ac + l0), a1 = *(const f32x4*)(ac + l0 + 4);
#pragma unroll
              for (int jx = 0; jx < 8; ++jx) dec[jx] = __expf(alast - (jx < 4 ? a0[jx] : a1[jx - 4])); }
            bf16x8 xf[2];
#pragma unroll
            for (int pt = 0; pt < 2; ++pt) { float f[8]; unpack8(*(const uint4*)(xrow + pt * 512 + ks * 1024), f);
#pragma unroll
                for (int jx = 0; jx < 8; ++jx) f[jx] *= dec[jx];
                union { uint4 u; bf16x8 v; } cvu; cvu.u = pack8(f); xf[pt] = cvu.v; }
#pragma unroll
            for (int nt = 0; nt < 4; ++nt) { const bf16x8 bf_ = *(const bf16x8*)(bt + nt * 512 + ks * 2048);
#pragma unroll
                for (int pt = 0; pt < 2; ++pt) acc[nt][pt] = __builtin_amdgcn_mfma_f32_32x32x16_bf16(bf_, xf[pt], acc[nt][pt], 0, 0, 0); }
        }
#pragma unroll
        for (int pt = 0; pt < 2; ++pt) { bf16* so0 = S + (size_t)unit * 8192 + (pt * 32 + rr) * 16;
#pragma unroll
            for (int nt = 0; nt < 4; ++nt)
#pragma unroll
                for (int kp = 0; kp < 2; ++kp) {
                    unsigned w0 = pk2bf(acc[nt][pt][8 * kp], acc[nt][pt][8 * kp + 1]), w1 = pk2bf(acc[nt][pt][8 * kp + 2], acc[nt][pt][8 * kp + 3]);
                    unsigned w2 = pk2bf(acc[nt][pt][8 * kp + 4], acc[nt][pt][8 * kp + 5]), w3 = pk2bf(acc[nt][pt][8 * kp + 6], acc[nt][pt][8 * kp + 7]);
                    swap32(w0, w2); swap32(w1, w3);
                    *(uint4*)(so0 + ((2 * nt + kp) * 64) * 16 + 8 * hi) = make_uint4(w0, w1, w2, w3); } }
    }
}
__device__ __forceinline__ void ph_ssd_scan(const Params& p, int wv) {
    PH_IDS();
    uint4* S = (uint4*)((unsigned char*)p.out + 32 * MiB); const float* acsT = (const float*)(p.ws + OFF_ACS);
    for (int e = gtid; e < NBATCH * 16 * 1024; e += gn) {
        const int q4 = e & 1023, h = (e >> 10) & 15, b = e >> 14; float r[8];
#pragma unroll
        for (int i = 0; i < 8; ++i) r[i] = 0.f;
        for (int c = 0; c < 32; c += 4) {
            uint4 v[4]; float d[4];
#pragma unroll
            for (int u = 0; u < 4; ++u) { const int unit = (b * 32 + c + u) * 16 + h; v[u] = S[(size_t)unit * 1024 + q4]; d[u] = __expf(acsT[(size_t)unit * 128 + 127]); }
#pragma unroll
            for (int u = 0; u < 4; ++u) { const int unit = (b * 32 + c + u) * 16 + h;
                S[(size_t)unit * 1024 + q4] = make_uint4(pk2bf(r[0], r[1]), pk2bf(r[2], r[3]), pk2bf(r[4], r[5]), pk2bf(r[6], r[7]));
                float f[8]; unpack8(v[u], f);
#pragma unroll
                for (int i = 0; i < 8; ++i) r[i] = r[i] * d[u] + f[i]; }
        }
    }
}
constexpr int SO_CBROW = 136;
constexpr int SO_OFF_C = 128 * SO_CBROW * 2, SO_OFF_ACS = SO_OFF_C + 32768;
__device__ __forceinline__ void ssd_out_unit(const Params& p, int wv, unsigned char* lds, int unit) {
    PH_IDS(); unsigned char* ws = p.ws; const int rr = lane & 31, hi = lane >> 5;
    const bf16* XdT = (const bf16*)p.out; const bf16* S = (const bf16*)((unsigned char*)p.out + 32 * MiB); const bf16* xsbc = (const bf16*)(ws + OFF_XSBC);
    const float* acsT = (const float*)(ws + OFF_ACS); bf16* z = (bf16*)(ws + OFF_Z); float* ssq2p = (float*)(ws + OFF_HID);
    bf16* CBl = (bf16*)lds; unsigned char* Cimg = lds + SO_OFF_C; float* acl_ = (float*)(lds + SO_OFF_ACS) + wv * 128;
    {
        const int g = unit & 1, bc = unit >> 1; const size_t t0 = (size_t)bc * 128;
        const int h = g * 8 + wv, uh = bc * 16 + h; const float* ac = acsT + (size_t)uh * 128; const float Dh = p.d_skip[h];
        __syncthreads();
#pragma unroll
        for (int i = 0; i < 4; ++i) {
            const int row = (wv * 4 + i) * 4 + (lane >> 4), ch = (lane & 15) ^ (row & 15);
            __builtin_amdgcn_global_load_lds((const unsigned*)(xsbc + (t0 + row) * 1536 + 1280 + g * 128 + ch * 8), (PG8_LAS unsigned*)(Cimg + (wv * 4 + i) * 1024), 16, 0, 0);
        }
        const float ac0 = ac[lane], ac1 = ac[lane + 64];
        bf16x8 xa[8], sa[8]; uint2 xw[2][4], zw[2][4];
        auto load_epi = [&](int pt, int lt, int rr) {
#pragma unroll
            for (int kp = 0; kp < 2; ++kp) {
                const size_t t = t0 + lt * 32 + rr; const int col = h * 64 + pt * 32 + 16 * kp + 8 * hi;
                uint4 xq = *(const uint4*)(xsbc + t * 1536 + col), zq = *(const uint4*)(z + t * 1024 + col);
                swap32(xq.x, xq.z); swap32(xq.y, xq.w); swap32(zq.x, zq.z); swap32(zq.y, zq.w);
                xw[lt & 1][2 * kp] = make_uint2(xq.x, xq.y); xw[lt & 1][2 * kp + 1] = make_uint2(xq.z, xq.w);
                zw[lt & 1][2 * kp] = make_uint2(zq.x, zq.y); zw[lt & 1][2 * kp + 1] = make_uint2(zq.z, zq.w);
            }
        };
        auto load_half = [&](int pt, int rr) {
            const bf16* xd = XdT + (size_t)uh * 8192 + (pt * 32 + rr) * 16 + 8 * hi; const bf16* sin = S + (size_t)uh * 8192 + (pt * 32 + rr) * 16 + 8 * hi;
#pragma unroll
            for (int ks = 0; ks < 8; ++ks) { xa[ks] = *(const bf16x8*)(xd + ks * 1024); sa[ks] = *(const bf16x8*)(sin + ks * 1024); }
            load_epi(pt, 0, rr); load_epi(pt, 1, rr);
        };
        load_half(0, rr);
        acl_[lane] = ac0; acl_[lane + 64] = ac1;
        asm volatile("s_waitcnt vmcnt(0)" ::: "memory");
        __syncthreads();
        for (int ti = wv; ti < 10; ti += NWAVES) {
            int lt = 0, st = ti; if (st > 0) { st -= 1; lt = 1; if (st > 1) { st -= 2; lt = 2; if (st > 2) { st -= 3; lt = 3; } } }
            f32x16 acc;
#pragma unroll
            for (int e = 0; e < 16; ++e) acc[e] = 0.f;
            bf16x8 bfr[8]; const bf16* arow = xsbc + (t0 + st * 32 + rr) * 1536 + 1024 + g * 128 + 8 * hi;
#pragma unroll
            for (int ks = 0; ks < 8; ++ks) bfr[ks] = *(const bf16x8*)(arow + ks * 16);
            const int crow0 = lt * 32 + rr; const unsigned char* cl = Cimg + crow0 * 256;
#pragma unroll
            for (int ks = 0; ks < 8; ++ks) acc = __builtin_amdgcn_mfma_f32_32x32x16_bf16(bfr[ks], *(const bf16x8*)(cl + (((2 * ks + hi) ^ (crow0 & 15)) << 4)), acc, 0, 0, 0);
            bf16* dst = CBl + (lt * 32 + rr) * SO_CBROW + st * 32 + 4 * hi;
#pragma unroll
            for (int a = 0; a < 4; ++a) *(uint2*)(dst + 8 * a) = make_uint2(pk2bf(acc[4 * a], acc[4 * a + 1]), pk2bf(acc[4 * a + 2], acc[4 * a + 3]));
        }
        __syncthreads();
#pragma unroll 1
        for (int pt = 0; pt < 2; ++pt) {
            int rq = rr; asm volatile("" : "+v"(rq));
            if (pt == 1) load_half(1, rq);
#pragma unroll
            for (int lt = 0; lt < 4; ++lt) {
                asm volatile("" ::: "memory");
                const int l = lt * 32 + rq; const float acl = acl_[l]; const float eal = __expf(acl);
                f32x16 acc;
#pragma unroll
                for (int e = 0; e < 16; ++e) acc[e] = 0.f;
#pragma unroll
                for (int ks = 0; ks < 2 * lt + 2; ++ks) {
                    const int s0 = ks * 16 + 8 * hi; float cb[8]; unpack8(*(const uint4*)(CBl + l * SO_CBROW + s0), cb);
                    const f32x4 a0 = *(const f32x4*)(acl_ + s0), a1 = *(const f32x4*)(acl_ + s0 + 4);
#pragma unroll
                    for (int jx = 0; jx < 8; ++jx) { const float as = jx < 4 ? a0[jx] : a1[jx - 4]; cb[jx] = (s0 + jx <= l) ? cb[jx] * __expf(acl - as) : 0.f; }
                    union { uint4 u; bf16x8 v; } mf; mf.u = pack8(cb);
                    acc = __builtin_amdgcn_mfma_f32_32x32x16_bf16(xa[ks], mf.v, acc, 0, 0, 0);
                }
                const unsigned char* cl = Cimg + l * 256;
#pragma unroll
                for (int ks = 0; ks < 8; ++ks) {
                    float cf[8]; unpack8(*(const uint4*)(cl + (((2 * ks + hi) ^ (l & 15)) << 4)), cf);
#pragma unroll
                    for (int jx = 0; jx < 8; ++jx) cf[jx] *= eal;
                    union { uint4 u; bf16x8 v; } bf_; bf_.u = pack8(cf);
                    acc = __builtin_amdgcn_mfma_f32_32x32x16_bf16(sa[ks], bf_.v, acc, 0, 0, 0);
                }
                const size_t t = t0 + l; float ss = 0.f;
#pragma unroll
                for (int kp = 0; kp < 2; ++kp) {
                    unsigned w[2][2];
#pragma unroll
                    for (int u = 0; u < 2; ++u) { const int a = 2 * kp + u;
                        const uint2 xv = xw[lt & 1][a], zv = zw[lt & 1][a];
                        const float xs0 = bflo(xv.x), xs1 = bfhi(xv.x), xs2 = bflo(xv.y), xs3 = bfhi(xv.y), z0 = bflo(zv.x), z1 = bfhi(zv.x), z2 = bflo(zv.y), z3 = bfhi(zv.y);
                        const float v0 = (acc[4 * a] + Dh * xs0) * (z0 * sigmoidf(z0)), v1 = (acc[4 * a + 1] + Dh * xs1) * (z1 * sigmoidf(z1));
                        const float v2 = (acc[4 * a + 2] + Dh * xs2) * (z2 * sigmoidf(z2)), v3 = (acc[4 * a + 3] + Dh * xs3) * (z3 * sigmoidf(z3));
                        ss += (v0 * v0 + v1 * v1) + (v2 * v2 + v3 * v3);
                        w[u][0] = pk2bf(v0, v1); w[u][1] = pk2bf(v2, v3); }
                    swap32(w[0][0], w[1][0]); swap32(w[0][1], w[1][1]);
                    *(uint4*)(z + t * 1024 + h * 64 + pt * 32 + 16 * kp + 8 * hi) = make_uint4(w[0][0], w[0][1], w[1][0], w[1][1]);
                }
                ss += shx(ss, 32);
                if (hi == 0) { if (pt == 0) ssq2p[t * 16 + h] = ss; else ssq2p[t * 16 + h] += ss; }
                if (lt < 2) load_epi(pt, lt + 2, rq);
            }
        }
    }
}

struct EpiKc {
    bf16* dst; bool tr; __device__ __forceinline__ void operator()(int m, int c, float v) const { const int hk = m & 3, n = (m >> 2) & 255, b = m >> 10; const bf16 o = (n == 255) ? (bf16)0 : f2bf(v);
        if (tr) dst[((size_t)(b * 4 + hk) * 64 + c) * 256 + ((n & ~12) | ((n & 4) << 1) | ((n & 8) >> 1))] = o; else dst[((size_t)(b * 4 + hk) * 256 + n) * 64 + c] = o; } };
__device__ __forceinline__ void ph_kc_rope(const Params& p, int wv) {
    PH_IDS(); unsigned char* ws = p.ws; bf16* kc = (bf16*)(ws + OFF_KC); const float* rc = (const float*)(ws + OFF_ROPE); const float* rs = rc + 4096 * 32;
    for (int i = gtid; i < 16 * 256 * 32; i += gn) {
        const int j = i & 31, n = (i >> 5) & 255, bh = i >> 13; const int pos = 16 * n + 31; if (n == 255) continue;
        const float c = rc[pos * 32 + j], s = rs[pos * 32 + j];
        bf16* pp = kc + ((size_t)bh * 256 + n) * 64 + j; const float x1 = bf2f(pp[0]), x2 = bf2f(pp[32]);
        pp[0] = f2bf(x1 * c - x2 * s); pp[32] = f2bf(x1 * s + x2 * c);
    }
}


constexpr size_t OFF_SU = 640 * 1024, OFF_SV = 704 * 1024, OFF_SX = 768 * 1024, OFF_SC = 832 * 1024;
__device__ __forceinline__ unsigned pack4i8(float a, float b, float c, float d) {
    const int ia = (int)rintf(a), ib = (int)rintf(b), ic = (int)rintf(c), id = (int)rintf(d);
    return (unsigned)(ia & 0xff) | ((unsigned)(ib & 0xff) << 8) | ((unsigned)(ic & 0xff) << 16) | ((unsigned)(id & 0xff) << 24);
}
__device__ __forceinline__ void peer_cvt_unit(const Params& p, int wv, int unit) {
    PH_IDS(); unsigned char* ws = p.ws;
    const int r0 = unit * 128 + wv * 16;
#pragma unroll 1
    for (int rb = 0; rb < 16; rb += 4) {
        float4 a[4][4];
#pragma unroll
        for (int j = 0; j < 4; ++j) {
            const int r = r0 + rb + j; const bool isv = r >= 16384; const int e = isv ? r - 16384 : r;
            const float* src = (isv ? p.peer_v : p.peer_u) + (size_t)e * 1024 + lane * 16;
#pragma unroll
            for (int i = 0; i < 4; ++i) a[j][i] = *(const float4*)(src + 4 * i);
        }
#pragma unroll
        for (int j = 0; j < 4; ++j) {
            const int r = r0 + rb + j; const bool isv = r >= 16384; const int e = isv ? r - 16384 : r;
            float amax = 0.f;
#pragma unroll
            for (int i = 0; i < 4; ++i) amax = fmaxf(fmaxf(amax, fmaxf(fabsf(a[j][i].x), fabsf(a[j][i].y))), fmaxf(fabsf(a[j][i].z), fabsf(a[j][i].w)));
            amax = fmaxf(wave_max(amax), 1e-30f); const float inv = 127.0f / amax;
            *(uint4*)(ws + (isv ? OFF_PV : OFF_PU) + (size_t)e * 1024 + lane * 16) = make_uint4(pack4i8(a[j][0].x * inv, a[j][0].y * inv, a[j][0].z * inv, a[j][0].w * inv), pack4i8(a[j][1].x * inv, a[j][1].y * inv, a[j][1].z * inv, a[j][1].w * inv),
                                                                                                pack4i8(a[j][2].x * inv, a[j][2].y * inv, a[j][2].z * inv, a[j][2].w * inv), pack4i8(a[j][3].x * inv, a[j][3].y * inv, a[j][3].z * inv, a[j][3].w * inv));
            if (lane == 0) ((float*)(ws + (isv ? OFF_SV : OFF_SU)))[e] = amax * (1.0f / 127.0f);
        }
    }
}

__device__ __forceinline__ float max3f(float a, float b, float c) { float r; asm("v_max3_f32 %0, %1, %2, %3" : "=v"(r) : "v"(a), "v"(b), "v"(c)); return r; }
__device__ __forceinline__ int crow(int r, int hi) { return (r & 3) + 8 * (r >> 2) + 4 * hi; }
constexpr int NSA_KBUF = 8192, NSA_VBUF = 8192;
constexpr int NSA_OFF_K = 0, NSA_OFF_V = 4 * NSA_KBUF;
constexpr int NSA_OFF_STASH = 73728;
constexpr int NSA_OFF_IMPA = NSA_OFF_STASH, NSA_IMPS = 65, NSA_OFF_IMPB = NSA_OFF_IMPA + 64 * NSA_IMPS * 4;
constexpr int NSA_OFF_SEL = NSA_OFF_STASH + 65536;
constexpr int NSA_OFF_KEYS = NSA_OFF_IMPB + 64 * NSA_IMPS * 4, NSA_KEYS = 68;
static_assert(NSA_OFF_KEYS % 16 == 0 && NSA_OFF_KEYS + 64 * NSA_KEYS * 4 <= NSA_OFF_SEL, "NSA key table");
static_assert(NSA_OFF_V + 4 * NSA_VBUF <= NSA_OFF_STASH && NSA_OFF_IMPB + 64 * NSA_IMPS * 4 <= NSA_OFF_SEL && NSA_OFF_SEL + 1024 <= LDS_BYTES - 64, "NSA LDS map");
#ifndef NSA_TP
#define NSA_TP -1
#endif
#define TPB(k) do { if (NSA_TP == (k)) t0_ = __builtin_amdgcn_s_memrealtime(); } while (0)
#define TPE(k) do { if (NSA_TP == (k)) tacc_ += __builtin_amdgcn_s_memrealtime() - t0_; } while (0)
struct NsaSrc { const bf16* K; size_t kstride; const bf16* V; size_t vstride; };
__device__ __forceinline__ void nsa_dma(const bf16* kp, const bf16* vp, unsigned char* kb, unsigned char* vb) {
    __builtin_amdgcn_global_load_lds((const unsigned*)kp, (PG8_LAS unsigned*)kb, 16, 0, 0);
    __builtin_amdgcn_global_load_lds((const unsigned*)vp, (PG8_LAS unsigned*)vb, 16, 0, 0);
}
__device__ __forceinline__ void nsa_qk(const unsigned char* kb, const bf16x8 (&qf)[4], int fo0, f32x16& p0, f32x16& p1) {
#pragma unroll
    for (int i = 0; i < 16; ++i) { p0[i] = 0.f; p1[i] = 0.f; }
#pragma unroll
    for (int ds = 0; ds < 4; ++ds) {
        const bf16x8 a0 = *(const bf16x8*)(kb + (fo0 ^ (32 * ds))), a1 = *(const bf16x8*)(kb + (fo0 ^ (32 * ds)) + 4096);
        p0 = __builtin_amdgcn_mfma_f32_32x32x16_bf16(a0, qf[ds], p0, 0, 0, 0); p1 = __builtin_amdgcn_mfma_f32_32x32x16_bf16(a1, qf[ds], p1, 0, 0, 0);
    }
}
typedef unsigned short u16x4v __attribute__((ext_vector_type(4)));
struct PvPre { unsigned ad[4][2]; u16x4v r[2][2][2][2]; };
#define NSA_TR_ISSUE(S, KH) asm volatile("ds_read_b64_tr_b16 %0, %8\n\tds_read_b64_tr_b16 %1, %9\n\tds_read_b64_tr_b16 %2, %10\n\tds_read_b64_tr_b16 %3, %11\n\t" \
                     "ds_read_b64_tr_b16 %4, %8 offset:4096\n\tds_read_b64_tr_b16 %5, %9 offset:4096\n\tds_read_b64_tr_b16 %6, %10 offset:4096\n\tds_read_b64_tr_b16 %7, %11 offset:4096" \
                     : "=&v"(S.r[KH][0][0][0]), "=&v"(S.r[KH][0][0][1]), "=&v"(S.r[KH][0][1][0]), "=&v"(S.r[KH][0][1][1]), "=&v"(S.r[KH][1][0][0]), "=&v"(S.r[KH][1][0][1]), "=&v"(S.r[KH][1][1][0]), "=&v"(S.r[KH][1][1][1]) \
                     : "v"(S.ad[2 * KH][0]), "v"(S.ad[2 * KH][1]), "v"(S.ad[2 * KH + 1][0]), "v"(S.ad[2 * KH + 1][1]) : "memory")
#define NSA_TR_WAIT(S, KH) asm volatile("s_waitcnt lgkmcnt(0)" : "+v"(S.r[KH][0][0][0]), "+v"(S.r[KH][0][0][1]), "+v"(S.r[KH][0][1][0]), "+v"(S.r[KH][0][1][1]), "+v"(S.r[KH][1][0][0]), "+v"(S.r[KH][1][0][1]), "+v"(S.r[KH][1][1][0]), "+v"(S.r[KH][1][1][1]), "+v"(O[0]), "+v"(O[1]) :: "memory")
__device__ __forceinline__ void nsa_pv_begin(const unsigned char* vb, int lane, PvPre& S) {
    const unsigned h = lane >> 5, blk = (lane >> 4) & 1, q = (lane & 15) >> 2, pp = lane & 3;
    const unsigned vbase = (unsigned)(size_t)vb;
#pragma unroll
    for (int c = 0; c < 4; ++c)
#pragma unroll
        for (int t = 0; t < 2; ++t) { const unsigned row = 4 * h + 8 * t + q, ch = 4 * c + 2 * blk + (pp >> 1);
            S.ad[c][t] = vbase + 256u * row + 16u * (ch ^ (((row & 3) << 2) | ((row >> 2) & 3))) + 8u * (pp & 1); }
    NSA_TR_ISSUE(S, 0);
}
__device__ __forceinline__ void nsa_pv(PvPre& S, const f32x16& p0, const f32x16& p1, f32x16 (&O)[2]) {
    __builtin_amdgcn_s_setprio(1);
    union PF { uint4 u; bf16x8 v; };
    PF pf0[2], pf1[2];
#pragma unroll
    for (int ks = 0; ks < 2; ++ks) { const int eb = 8 * ks; pf0[ks].u = make_uint4(pk2bf(p0[eb], p0[eb + 1]), pk2bf(p0[eb + 2], p0[eb + 3]), pk2bf(p0[eb + 4], p0[eb + 5]), pk2bf(p0[eb + 6], p0[eb + 7])); }
    NSA_TR_WAIT(S, 0);
    NSA_TR_ISSUE(S, 1);
#pragma unroll
    for (int ks = 0; ks < 2; ++ks)
#pragma unroll
        for (int dsub = 0; dsub < 2; ++dsub) { union { u16x4v h2[2]; bf16x8 v; } vf; vf.h2[0] = S.r[0][ks][dsub][0]; vf.h2[1] = S.r[0][ks][dsub][1];
            O[dsub] = __builtin_amdgcn_mfma_f32_32x32x16_bf16(vf.v, pf0[ks].v, O[dsub], 0, 0, 0); }
#pragma unroll
    for (int ks = 0; ks < 2; ++ks) { const int eb = 8 * ks; pf1[ks].u = make_uint4(pk2bf(p1[eb], p1[eb + 1]), pk2bf(p1[eb + 2], p1[eb + 3]), pk2bf(p1[eb + 4], p1[eb + 5]), pk2bf(p1[eb + 6], p1[eb + 7])); }
    NSA_TR_WAIT(S, 1);
#pragma unroll
    for (int ks = 0; ks < 2; ++ks)
#pragma unroll
        for (int dsub = 0; dsub < 2; ++dsub) { union { u16x4v h2[2]; bf16x8 v; } vf; vf.h2[0] = S.r[1][ks][dsub][0]; vf.h2[1] = S.r[1][ks][dsub][1];
            O[dsub] = __builtin_amdgcn_mfma_f32_32x32x16_bf16(vf.v, pf1[ks].v, O[dsub], 0, 0, 0); }
    __builtin_amdgcn_s_setprio(0);
}
#undef NSA_TR_ISSUE
#undef NSA_TR_WAIT
template <int MODE>
__device__ __forceinline__ void nsa_tile(unsigned char* lds, const unsigned char* kb, const unsigned char* vb, int jt, int rr, int hi, int fo0, const bf16x8 (&qf)[4], int lpos, int qi, int tokblk,
                                         u64 selm, float& m, float& lsum, float inv_l, f32x16 (&O)[2]) {
    float* impA = (float*)(lds + NSA_OFF_IMPA); float* impB = (float*)(lds + NSA_OFF_IMPB);
    f32x16 p0, p1; nsa_qk(kb, qf, fo0, p0, p1);
    PvPre pvs; if (MODE != 0) nsa_pv_begin(vb, rr + 32 * hi, pvs);
    asm volatile("s_nop 15\n\ts_nop 7" : "+v"(p0), "+v"(p1));
    const int k0 = jt * 64;
    const bool tile_on = (MODE != 2) || ((selm >> jt) & 1ull);
    bool full;
    if (MODE <= 1) full = (16 * (k0 + 63) + 31 <= qi * 64); else if (MODE == 2) full = (jt < qi); else full = (jt > qi - 8) && (jt < qi);
    float mx = NEG_INF, mx2 = NEG_INF;
    if (full) {
#pragma unroll
        for (int e = 0; e < 16; e += 2) { mx = max3f(mx, p0[e], p1[e]); mx2 = max3f(mx2, p0[e + 1], p1[e + 1]); }
        if (MODE == 2 && !tile_on) { mx = NEG_INF; mx2 = NEG_INF; }
    } else {
        const int lim = (MODE <= 1) ? (lpos - 31 - 16 * k0 - 64 * hi) : (lpos - k0 - 4 * hi);
#pragma unroll
        for (int e = 0; e < 16; ++e) {
            const int ca = (e & 3) + 8 * (e >> 2), cb = ca + 32; bool oa, ob;
            if (MODE <= 1) { oa = (16 * ca <= lim); ob = (16 * cb <= lim); }
            else if (MODE == 2) { oa = (ca <= lim); ob = (cb <= lim); }
            else { oa = (ca <= lim) && (ca > lim - 512); ob = (cb <= lim) && (cb > lim - 512); }
            p0[e] = oa ? p0[e] : NEG_INF; p1[e] = ob ? p1[e] : NEG_INF; if (e & 1) mx2 = max3f(mx2, p0[e], p1[e]); else mx = max3f(mx, p0[e], p1[e]);
        }
    }
    if (MODE != 1) {
        mx = max3f(mx, mx2, NEG_INF); mx = max3f(mx, shx(mx, 32), NEG_INF);
        const float mnew = fmaxf(m, mx);
        if (__any((mnew - m) > 6.0f)) {
            const float alpha = __builtin_amdgcn_exp2f(m - mnew); m = mnew; lsum *= alpha;
            if (MODE != 0) {
#pragma unroll
                for (int e = 0; e < 16; ++e) { O[0][e] *= alpha; O[1][e] *= alpha; }
            }
        }
        const float meff = (MODE == 2 && full && !tile_on) ? BIG : ((m > 0.5f * NEG_INF) ? m : BIG);
        float rs = 0.f;
#pragma unroll
        for (int e = 0; e < 16; ++e) { p0[e] = __builtin_amdgcn_exp2f(p0[e] - meff); p1[e] = __builtin_amdgcn_exp2f(p1[e] - meff); rs += p0[e] + p1[e]; }
        lsum += rs;
        if (MODE != 0) nsa_pv(pvs, p0, p1, O);
    } else {
#pragma unroll
        for (int e = 0; e < 16; ++e) { p0[e] = __builtin_amdgcn_exp2f(p0[e] - m) * inv_l; p1[e] = __builtin_amdgcn_exp2f(p1[e] - m) * inv_l; }
        nsa_pv(pvs, p0, p1, O);
#pragma unroll
        for (int sub = 0; sub < 2; ++sub)
#pragma unroll
            for (int a = 0; a < 4; ++a) {
                float G, last;
                if (sub == 0) { G = (p0[4 * a] + p0[4 * a + 1]) + (p0[4 * a + 2] + p0[4 * a + 3]); last = p0[4 * a + 3]; } else { G = (p1[4 * a] + p1[4 * a + 1]) + (p1[4 * a + 2] + p1[4 * a + 3]); last = p1[4 * a + 3]; }
                G += shx(G, 1); G += shx(G, 2); last += shx(last, 1); last += shx(last, 2);
                const int jj = (k0 >> 2) + 8 * sub + 2 * a + hi;
                if ((rr & 3) == 0) { impA[tokblk * NSA_IMPS + jj] = G; if (jj + 1 < 64) impB[tokblk * NSA_IMPS + jj + 1] = last; }
            }
    }
}
__device__ __forceinline__ void nsa_issue_pair(unsigned char* lds, const NsaSrc& src, int jt, int jt1, int bufpar, int wv, int lane) {
    const int srow = wv * 8 + (lane >> 3), sch = ((lane & 7) ^ ((srow >> 1) & 7)) * 8;
    const bf16* kp = src.K + (size_t)srow * src.kstride + sch + (size_t)(jt * 64) * src.kstride;
    const int P = wv * 64 + lane, vrow = P >> 4, vch = (P & 15) ^ (((vrow & 3) << 2) | ((vrow >> 2) & 3)), vkey = vrow + 32 * (vch >> 3);
    const bf16* vp = src.V + (size_t)(jt * 64 + vkey) * src.vstride + (vch & 7) * 8;
    unsigned char* lw = lds + wv * 1024;
    nsa_dma(kp, vp, lw + NSA_OFF_K + (bufpar * 2) * NSA_KBUF, lw + NSA_OFF_V + (bufpar * 2) * NSA_VBUF);
    if (jt + 1 < jt1) nsa_dma(kp + 64 * src.kstride, vp + 64 * src.vstride, lw + NSA_OFF_K + (bufpar * 2 + 1) * NSA_KBUF, lw + NSA_OFF_V + (bufpar * 2 + 1) * NSA_VBUF);
}
template <int MODE>
__device__ __forceinline__ void nsa_branch(unsigned char* lds, const NsaSrc& src, int jt0, int jt1, const NsaSrc& nxt, int njt0, int njt1, int& par, int wv, int lane, int rr, int hi,
                                           const bf16x8 (&qf)[4], int lpos, int qi, int tokblk, u64 selm, u64 wsel, float& m, float& lsum, float inv_l, f32x16 (&O)[2]) {
    asm volatile("" : "+v"(lane), "+v"(rr), "+v"(hi), "+v"(lpos), "+v"(tokblk));
    const int fo0 = rr * 128 + ((hi ^ ((rr >> 1) & 7)) << 4);
    for (int jt = jt0; jt < jt1; jt += 2, par ^= 1) {
        const bool hasB = (jt + 1 < jt1);
        if (jt + 2 < jt1) nsa_issue_pair(lds, src, jt + 2, jt1, par ^ 1, wv, lane);
        else if (njt0 < njt1) nsa_issue_pair(lds, nxt, njt0, njt1, par ^ 1, wv, lane);
        const unsigned char* kb = lds + NSA_OFF_K + (par * 2) * NSA_KBUF; const unsigned char* vb = lds + NSA_OFF_V + (par * 2) * NSA_VBUF;
        if ((MODE != 2) || ((wsel >> jt) & 1ull)) nsa_tile<MODE>(lds, kb, vb, jt, rr, hi, fo0, qf, lpos, qi, tokblk, selm, m, lsum, inv_l, O);
        if (hasB && ((MODE != 2) || ((wsel >> (jt + 1)) & 1ull))) nsa_tile<MODE>(lds, kb + NSA_KBUF, vb + NSA_VBUF, jt + 1, rr, hi, fo0, qf, lpos, qi, tokblk, selm, m, lsum, inv_l, O);
        asm volatile("s_waitcnt vmcnt(0)" ::: "memory");
        __syncthreads();
    }
}
__device__ __forceinline__ void ph_nsa(const Params& p, int wv, unsigned char* lds) {
    PH_IDS(); unsigned char* ws = p.ws; const int wave = wv; const int lane0 = lane, tid0 = tid;
    bf16* q = (bf16*)(ws + OFF_Q); const bf16* kvs = (const bf16*)(ws + OFF_KVS);
    const float* gate = (const float*)(ws + OFF_GATE); float* ssq = (float*)(ws + OFF_SSQ);
    float* impA = (float*)(lds + NSA_OFF_IMPA); float* impB = (float*)(lds + NSA_OFF_IMPB); u64* selw = (u64*)(lds + NSA_OFF_SEL);
    unsigned* qctr0 = (unsigned*)(ws + OFF_BAR + 14336); volatile int* ucur = (volatile int*)(lds + NSA_OFF_SEL + 512);
    int xq = bid & 7, nempty = 0;
    int par = 0; unsigned long long t0_ = 0ull, tacc_ = 0ull; (void)t0_;
    for (;;) {
        TPB(5);
        if (tid0 == 0) {
            int got = -1, qx = xq;
            if (!nempty) { const unsigned u0 = __hip_atomic_fetch_add(qctr0 + 64 * xq, 1u, __ATOMIC_RELAXED, __HIP_MEMORY_SCOPE_AGENT); if (u0 < 192u) got = (int)u0; }
            if (got < 0) {
                unsigned c[8];
#pragma unroll
                for (int k = 0; k < 8; ++k) c[k] = __hip_atomic_load(qctr0 + 64 * k, __ATOMIC_RELAXED, __HIP_MEMORY_SCOPE_AGENT);
#pragma unroll
                for (int k = 0; k < 8; ++k) if (got < 0 && c[k] < 192u) { const unsigned u1 = __hip_atomic_fetch_add(qctr0 + 64 * k, 1u, __ATOMIC_RELAXED, __HIP_MEMORY_SCOPE_AGENT); if (u1 < 192u) { got = (int)u1; qx = k; } }
            }
            ucur[0] = got; ucur[1] = qx;
        }
        __syncthreads();
        int lane = lane0; asm volatile("" : "+v"(lane));
        const int tid = (wv << 6) | lane, rr = lane & 31, hi = lane >> 5;
        const int uq = __builtin_amdgcn_readfirstlane(ucur[0]);
        { const int qn = __builtin_amdgcn_readfirstlane(ucur[1]); if (qn != xq || uq < 0) nempty = 1; xq = qn; }
        __syncthreads();
        if (uq < 0) break;
        if (uq < 128 && (uq & 3) == 2) { TPB(8); ssd_out_unit(p, wv, lds, xq + 8 * (uq >> 2)); TPE(8); continue; }
        if (uq < 128 && (uq & 3) == 3) { TPB(9); peer_cvt_unit(p, wv, xq + 8 * (uq >> 2)); TPE(9); continue; }
        const int u = uq < 128 ? 2 * (uq >> 2) + (uq & 3) : uq - 64;
        const int bh = xq + 8 * (u & 1), qi = 63 - (u >> 1);
        const int b = bh >> 2, hk = bh & 3; const int tokblk = wave * 8 + (rr >> 2), g = rr & 3; const int lpos = qi * 64 + tokblk; const size_t t = (size_t)b * L + lpos;
        bf16* qrow = q + t * 1024 + (hk * 4 + g) * 64;
        const NsaSrc sc_{(const bf16*)(ws + OFF_KC) + (size_t)bh * 256 * 64, 64, (const bf16*)(ws + OFF_VCT) + (size_t)bh * 256 * 64, 64};
        const NsaSrc ss_{kvs + (size_t)b * L * 1536 + 512 + hk * 64, 1536, kvs + (size_t)b * L * 1536 + 768 + hk * 64, 1536};
        const NsaSrc sw_{kvs + (size_t)b * L * 1536 + 1024 + hk * 64, 1536, kvs + (size_t)b * L * 1536 + 1280 + hk * 64, 1536};
        const int nct = (4 * qi + 3 + 63) >> 6, wj0 = qi >= 8 ? qi - 8 : 0;
        nsa_issue_pair(lds, sc_, 0, nct, par, wv, lane);
        bf16x8 qf[4];
#pragma unroll
        for (int ds = 0; ds < 4; ++ds) qf[ds] = *(const bf16x8*)(qrow + ds * 16 + hi * 8);
        {
            const float* rc = (const float*)(ws + OFF_ROPE); const float* rs = rc + 4096 * 32; const float sc = 0.125f * 1.4426950408889634f;
#pragma unroll
            for (int ds = 0; ds < 2; ++ds) {
                const int j0 = ds * 16 + hi * 8; float c[8], sn[8], x1[8], x2[8], o1[8], o2[8];
                { const bf16* rt = (const bf16*)(ws + OFF_ROPEB) + (size_t)lpos * 64 + j0;
                  unpack8(*(const uint4*)rt, c); unpack8(*(const uint4*)(rt + 32), sn); }
                union { bf16x8 v; uint4 u; } f1, f2; f1.v = qf[ds]; f2.v = qf[ds + 2];
                unpack8(f1.u, x1); unpack8(f2.u, x2);
#pragma unroll
                for (int i = 0; i < 8; ++i) { o1[i] = (x1[i] * c[i] - x2[i] * sn[i]) * sc; o2[i] = (x1[i] * sn[i] + x2[i] * c[i]) * sc; }
                f1.u = pack8(o1); f2.u = pack8(o2); qf[ds] = f1.v; qf[ds + 2] = f2.v;
            }
        }
        for (int i = tid; i < 64 * NSA_IMPS; i += NTHREADS) { impA[i] = 0.f; impB[i] = 0.f; }
        asm volatile("s_waitcnt vmcnt(0)" ::: "memory");
        __syncthreads();
        TPE(5);
        f32x16 O[2]; float* stash = (float*)(lds + NSA_OFF_STASH) + tid;
        const float g0 = gate[t * 48 + (hk * 4 + g) * 3 + 0], g1 = gate[t * 48 + (hk * 4 + g) * 3 + 1], g2 = gate[t * 48 + (hk * 4 + g) * 3 + 2];
        {
            float m = NEG_INF, lsum = 0.f;
            TPB(1);
            nsa_branch<0>(lds, sc_, 0, nct, sc_, 0, nct, par, wv, lane, rr, hi, qf, lpos, qi, tokblk, 0ull, 0ull, m, lsum, 0.f, O);
            lsum += shx(lsum, 32);
            const float inv_l = lsum > 0.f ? 1.0f / lsum : 0.f;
#pragma unroll
            for (int e = 0; e < 16; ++e) { O[0][e] = 0.f; O[1][e] = 0.f; }
            nsa_branch<1>(lds, sc_, 0, nct, ss_, 0, qi + 1, par, wv, lane, rr, hi, qf, lpos, qi, tokblk, 0ull, 0ull, m, lsum, inv_l, O);
        }
        TPE(1);
        f32x16 Oc[2];
        TPB(2);
#pragma unroll
        for (int e = 0; e < 16; ++e) { Oc[0][e] = g0 * O[0][e]; Oc[1][e] = g0 * O[1][e]; }
        {
            int tids = tid; asm volatile("" : "+v"(tids));
            const int tk = tids >> 3, jg = tids & 7; unsigned v[8]; unsigned* keys = (unsigned*)(lds + NSA_OFF_KEYS);
#pragma unroll
            for (int i = 0; i < 8; ++i) { const int j = jg * 8 + i; const float raw = impA[tk * NSA_IMPS + j] + impB[tk * NSA_IMPS + j];
                const bool causal = (j <= qi), forced = (j == 0) || (j == qi) || (j == qi - 1); v[i] = causal ? (forced ? 0x7f000000u : __float_as_uint(raw)) : 0u; }
            *(uint4*)(keys + tk * NSA_KEYS + jg * 8) = make_uint4(v[0], v[1], v[2], v[3]); *(uint4*)(keys + tk * NSA_KEYS + jg * 8 + 4) = make_uint4(v[4], v[5], v[6], v[7]);
            __syncthreads();
            int rank[8];
#pragma unroll
            for (int i = 0; i < 8; ++i) { rank[i] = 0;
#pragma unroll
                for (int k = 0; k < 8; ++k) if (k != i) rank[i] += ((k < i) ? (v[k] >= v[i]) : (v[k] > v[i])) ? 1 : 0; }
#pragma unroll
            for (int go = 1; go < 8; ++go) {
                const int og = (jg + go) & 7; const unsigned bias = og < jg ? 1u : 0u;
                const uint4 x0 = *(const uint4*)(keys + tk * NSA_KEYS + og * 8), x1 = *(const uint4*)(keys + tk * NSA_KEYS + og * 8 + 4);
                const unsigned xs[8] = {x0.x + bias, x0.y + bias, x0.z + bias, x0.w + bias, x1.x + bias, x1.y + bias, x1.z + bias, x1.w + bias};
#pragma unroll
                for (int k = 0; k < 8; ++k)
#pragma unroll
                    for (int i = 0; i < 8; ++i) rank[i] += (xs[k] > v[i]) ? 1 : 0;
            }
            unsigned b8 = 0u;
#pragma unroll
            for (int i = 0; i < 8; ++i) b8 |= (rank[i] < 16 && jg * 8 + i <= qi) ? (1u << i) : 0u;
            const u64 full = (u64)b8 << (jg * 8); unsigned blo = (unsigned)full, bhi = (unsigned)(full >> 32);
            blo |= shx(blo, 1); bhi |= shx(bhi, 1); blo |= shx(blo, 2); bhi |= shx(bhi, 2); blo |= shx(blo, 4); bhi |= shx(bhi, 4);
            if (jg == 0) selw[tk] = (u64)blo | ((u64)bhi << 32);
            __syncthreads();
        }
        const u64 selm = selw[tokblk];
        __syncthreads();
#pragma unroll
        for (int e = 0; e < 16; ++e) { stash[e * 512] = Oc[0][e]; stash[(16 + e) * 512] = Oc[1][e]; }
        u64 wsel = selm;
        { unsigned lo = (unsigned)wsel, h2 = (unsigned)(wsel >> 32);
          lo |= shx(lo, 4); h2 |= shx(h2, 4); lo |= shx(lo, 8); h2 |= shx(h2, 8); lo |= shx(lo, 16); h2 |= shx(h2, 16);
          wsel = (u64)lo | ((u64)h2 << 32); }
        TPE(2);
        TPB(3);
        {
            float m = NEG_INF, lsum = 0.f;
#pragma unroll
            for (int e = 0; e < 16; ++e) { O[0][e] = 0.f; O[1][e] = 0.f; }
            nsa_branch<2>(lds, ss_, 0, qi + 1, sw_, wj0, qi + 1, par, wv, lane, rr, hi, qf, lpos, qi, tokblk, selm, wsel, m, lsum, 0.f, O);
            lsum += shx(lsum, 32); const float sc = g1 / lsum;
#pragma unroll
            for (int e = 0; e < 16; ++e) { stash[e * 512] += sc * O[0][e]; stash[(16 + e) * 512] += sc * O[1][e]; }
        }
        TPE(3);
        TPB(4);
        {
            float m = NEG_INF, lsum = 0.f;
#pragma unroll
            for (int e = 0; e < 16; ++e) { O[0][e] = 0.f; O[1][e] = 0.f; }
            nsa_branch<3>(lds, sw_, wj0, qi + 1, sw_, 0, 0, par, wv, lane, rr, hi, qf, lpos, qi, tokblk, 0ull, 0ull, m, lsum, 0.f, O);
            lsum += shx(lsum, 32); const float sc = g2 / lsum;
#pragma unroll
            for (int e = 0; e < 16; ++e) { O[0][e] = stash[e * 512] + sc * O[0][e]; O[1][e] = stash[(16 + e) * 512] + sc * O[1][e]; }
        }
        TPE(4);
        TPB(6);
        float ss = 0.f;
#pragma unroll
        for (int dsub = 0; dsub < 2; ++dsub)
#pragma unroll
            for (int kp = 0; kp < 2; ++kp) {
                unsigned w[2][2];
#pragma unroll
                for (int u = 0; u < 2; ++u) { const int a = 2 * kp + u; const float v0 = O[dsub][4 * a], v1 = O[dsub][4 * a + 1], v2 = O[dsub][4 * a + 2], v3 = O[dsub][4 * a + 3];
                    ss += (v0 * v0 + v1 * v1) + (v2 * v2 + v3 * v3); w[u][0] = pk2bf(v0, v1); w[u][1] = pk2bf(v2, v3); }
                swap32(w[0][0], w[1][0]); swap32(w[0][1], w[1][1]);
                *(uint4*)(qrow + dsub * 32 + 16 * kp + 8 * hi) = make_uint4(w[0][0], w[0][1], w[1][0], w[1][1]);
            }
        ss += shx(ss, 32); ss += shx(ss, 1); ss += shx(ss, 2);
        if (hi == 0 && g == 0) ssq[t * 4 + hk] = ss;
        __syncthreads();
        TPE(6);
    }
    if (NSA_TP >= 0 && NSA_TP != 0 && tid0 == 0) atomicAdd((unsigned long long*)(ws + OFF_BAR + 14336 + 128), tacc_);
}

constexpr size_t OFF_COEFQ = 218 * MiB, OFF_H1Q = 220 * MiB;
__device__ __forceinline__ void ph_ln1(const Params& p, int wv) {
    PH_IDS(); unsigned char* ws = p.ws; bf16* h1b = (bf16*)(ws + OFF_H1B); unsigned char* h1q = ws + OFF_H1Q; float* sx = (float*)(ws + OFF_SX);
    float4 g1[4], b1[4];
#pragma unroll
    for (int i = 0; i < 4; ++i) { g1[i] = *(const float4*)(p.ln1_g + lane * 16 + 4 * i); b1[i] = *(const float4*)(p.ln1_b + lane * 16 + 4 * i); }
    for (int t = gwave; t < T; t += nwaves) {
        float v[16]; float s = 0.f; const bf16* row = (const bf16*)p.out + (size_t)t * 1024 + lane * 16;
        unpack8(*(const uint4*)row, v); unpack8(*(const uint4*)(row + 8), v + 8);
#pragma unroll
        for (int i = 0; i < 16; i += 4) s += (v[i] + v[i + 1]) + (v[i + 2] + v[i + 3]);
        const float mu = wave_sum(s) * (1.0f / 1024.0f); float s2 = 0.f;
#pragma unroll
        for (int i = 0; i < 16; ++i) { v[i] -= mu; s2 += v[i] * v[i]; }
        const float rstd = rsqrtf(wave_sum(s2) * (1.0f / 1024.0f) + LN_EPS); float amax = 0.f;
#pragma unroll
        for (int i = 0; i < 4; ++i) { const float4 ga = g1[i], ba = b1[i];
            v[4 * i] = v[4 * i] * rstd * ga.x + ba.x; v[4 * i + 1] = v[4 * i + 1] * rstd * ga.y + ba.y; v[4 * i + 2] = v[4 * i + 2] * rstd * ga.z + ba.z; v[4 * i + 3] = v[4 * i + 3] * rstd * ga.w + ba.w;
 }
#pragma unroll
        for (int i = 0; i < 16; ++i) amax = fmaxf(amax, fabsf(v[i]));
        amax = fmaxf(wave_max(amax), 1e-20f); const float inv = 127.0f / amax;
        *(uint4*)(h1b + (size_t)t * 1024 + lane * 16) = pack8(v); *(uint4*)(h1b + (size_t)t * 1024 + lane * 16 + 8) = pack8(v + 8);
        *(uint4*)(h1q + (size_t)t * 1024 + lane * 16) = make_uint4(pack4i8(v[0] * inv, v[1] * inv, v[2] * inv, v[3] * inv), pack4i8(v[4] * inv, v[5] * inv, v[6] * inv, v[7] * inv),
                                                                 pack4i8(v[8] * inv, v[9] * inv, v[10] * inv, v[11] * inv), pack4i8(v[12] * inv, v[13] * inv, v[14] * inv, v[15] * inv));
        if (lane == 0) sx[t] = amax * (1.0f / 127.0f);
    }
}

__device__ __forceinline__ unsigned umaxu(unsigned a, unsigned b) { return a > b ? a : b; }
__device__ __forceinline__ unsigned uminu(unsigned a, unsigned b) { return a < b ? a : b; }
__device__ __forceinline__ unsigned f2mono(float f) { const unsigned u = __float_as_uint(f); return (u & 0x80000000u) ? ~u : (u | 0x80000000u); }
__device__ __forceinline__ float mono2f(unsigned m) { return __uint_as_float((m & 0x80000000u) ? (m & 0x7fffffffu) : ~m); }
template <int N> __device__ __forceinline__ void bitonic_sort_desc(unsigned (&a)[N]) {
#pragma unroll
    for (int k = 2; k <= N; k <<= 1)
#pragma unroll
        for (int j = k >> 1; j > 0; j >>= 1)
#pragma unroll
            for (int i = 0; i < N; ++i) { const int l = i ^ j; if (l > i) { const bool desc = ((i & k) == 0); const unsigned x = a[i], y = a[l], mx = umaxu(x, y), mn = uminu(x, y); a[i] = desc ? mx : mn; a[l] = desc ? mn : mx; } }
}
__device__ __forceinline__ void merge_top16(unsigned (&a)[16], const unsigned (&b)[16]) {
#pragma unroll
    for (int i = 0; i < 16; ++i) a[i] = umaxu(a[i], b[15 - i]);
#pragma unroll
    for (int j = 8; j > 0; j >>= 1)
#pragma unroll
        for (int i = 0; i < 16; ++i) { const int l = i ^ j; if (l > i) { const unsigned x = a[i], y = a[l]; a[i] = umaxu(x, y); a[l] = uminu(x, y); } }
}
constexpr int PK_KROW = 272;
__device__ __forceinline__ void peer_stage1(const bf16* qrow, const unsigned char* krow, int hi, unsigned (&run)[16]) {
    bf16x8 qf[8];
#pragma unroll
    for (int ks = 0; ks < 8; ++ks) qf[ks] = *(const bf16x8*)(qrow + ks * 16);
#pragma unroll 1
    for (int kt = 0; kt < 4; ++kt) {
        f32x16 acc;
#pragma unroll
        for (int e = 0; e < 16; ++e) acc[e] = 0.f;
        const unsigned char* kr = krow + kt * 32 * PK_KROW;
#pragma unroll
        for (int ks = 0; ks < 8; ++ks) acc = __builtin_amdgcn_mfma_f32_32x32x16_bf16(*(const bf16x8*)(kr + ks * 32), qf[ks], acc, 0, 0, 0);
        unsigned grp[16]; const unsigned ib = (unsigned)(127 - kt * 32 - 4 * hi);
#pragma unroll
        for (int e = 0; e < 16; ++e) grp[e] = (f2mono(acc[e]) & ~0x7fu) | (ib - (unsigned)((e & 3) + 8 * (e >> 2)));
        bitonic_sort_desc<16>(grp);
        if (kt == 0) {
#pragma unroll
            for (int i = 0; i < 16; ++i) run[i] = grp[i];
        } else merge_top16(run, grp);
    }
    unsigned oth[16];
#pragma unroll
    for (int i = 0; i < 16; ++i) oth[i] = shx(run[i], 32);
    merge_top16(run, oth);
}
__device__ __forceinline__ void ph_peer_topk(const Params& p, int wv, unsigned char* lds) {
    PH_IDS(); unsigned char* ws = p.ws; const int rr = lane & 31, hi = lane >> 5;
    unsigned char* kimg = lds; int* exl = (int*)(lds + 2 * 128 * PK_KROW + wv * 6400);
    const bf16* qp = (const bf16*)(ws + OFF_QP); const bf16* keys = (const bf16*)(ws + OFF_KEYS);
    int* eidx = (int*)(ws + OFF_EIDX); float* gw = (float*)(ws + OFF_GW);
    const int h = bid & 7;
    for (int i = tid; i < 256 * 16; i += NTHREADS) { const int row = i >> 4, ch = i & 15; *(uint4*)(kimg + row * PK_KROW + ch * 16) = *(const uint4*)(keys + ((size_t)h * 256 + row) * 128 + ch * 8); }
    __syncthreads();
    for (int tt = (bid >> 3) * NWAVES + wv; tt < 512; tt += (nb >> 3) * NWAVES) {
        const int t0 = tt * 32;
        unsigned top[2][16];
        peer_stage1(qp + (size_t)(t0 + rr) * 2048 + h * 256 + 8 * hi, kimg + rr * PK_KROW + 16 * hi, hi, top[0]);
        peer_stage1(qp + (size_t)(t0 + rr) * 2048 + h * 256 + 128 + 8 * hi, kimg + (128 + rr) * PK_KROW + 16 * hi, hi, top[1]);
        unsigned g4[4][16];
#pragma unroll
        for (int k = 0; k < 4; ++k)
#pragma unroll
            for (int i = 0; i < 16; ++i) g4[k][i] = 0u;
#pragma unroll
        for (int i = 0; i < 16; ++i) {
            int off = 0;
#pragma unroll
            for (int k = 0; k < 16; ++k) if (k < i) off += 16 / (k + 1);
            const float s0 = mono2f(top[0][i] & ~0x7fu); const int e0 = (int)(127u - (top[0][i] & 0x7fu)) * 128;
#pragma unroll
            for (int j = 0; j < 16; ++j) if ((i + 1) * (j + 1) <= 16) {
                const int nc = off + j;
                const float sum = s0 + mono2f(top[1][j] & ~0x7fu);
                g4[nc >> 4][nc & 15] = (f2mono(sum) & ~0x3fu) | (unsigned)(63 - nc);
                if (hi == 0) exl[nc * 32 + rr] = e0 + (int)(127u - (top[1][j] & 0x7fu));
            }
        }
#pragma unroll
        for (int k = 0; k < 4; ++k) bitonic_sort_desc<16>(g4[k]);
        merge_top16(g4[0], g4[1]); merge_top16(g4[2], g4[3]); merge_top16(g4[0], g4[2]);
        float e16[16]; float den = 0.f; const float gmax = mono2f(g4[0][0] & ~0x3fu);
#pragma unroll
        for (int r = 0; r < 16; ++r) { e16[r] = __expf(mono2f(g4[0][r] & ~0x3fu) - gmax); den += e16[r]; }
        const float inv = 1.0f / den; const size_t ob = (size_t)(t0 + rr) * 128 + h * 16 + hi * 8;
        float wo[8]; int eo[8];
#pragma unroll
        for (int k = 0; k < 8; ++k) { const unsigned key = hi ? g4[0][8 + k] : g4[0][k]; wo[k] = (hi ? e16[8 + k] : e16[k]) * inv; eo[k] = exl[(63 - (int)(key & 0x3fu)) * 32 + rr]; }
        *(float4*)(gw + ob) = make_float4(wo[0], wo[1], wo[2], wo[3]); *(float4*)(gw + ob + 4) = make_float4(wo[4], wo[5], wo[6], wo[7]);
        *(int4*)(eidx + ob) = make_int4(eo[0], eo[1], eo[2], eo[3]); *(int4*)(eidx + ob + 4) = make_int4(eo[4], eo[5], eo[6], eo[7]);
    }
}
constexpr size_t OFF_PART = 26 * MiB;
constexpr size_t OFF_Y = 26 * MiB;
static_assert(OFF_PART + 64 * MiB <= OFF_H1B && OFF_PV + 16 * MiB <= OFF_XSBC, "PEER scratch map");
typedef unsigned u32x4v __attribute__((ext_vector_type(4)));
__device__ __forceinline__ uint4 bufld16(__amdgpu_buffer_rsrc_t r, int voff) { const u32x4v v = __builtin_amdgcn_raw_buffer_load_b128(r, voff, 0, 0); return make_uint4(v.x, v.y, v.z, v.w); }
#define PU_ISSUE16(W, ELO, EHI) do { _Pragma("unroll") for (int k = 0; k < 8; ++k) { const int e0 = __shfl(ELO, k * 8 + g), e1 = __shfl(EHI, k * 8 + g); \
        W[k] = bufld16(rsrc_, e0 * 1024 + sj_); W[8 + k] = bufld16(rsrc_, e1 * 1024 + sj_); } } while (0)
#define PU_DOT16(W, X) __builtin_amdgcn_sdot4((int)(W).w, (int)(X).w, __builtin_amdgcn_sdot4((int)(W).z, (int)(X).z, __builtin_amdgcn_sdot4((int)(W).y, (int)(X).y, __builtin_amdgcn_sdot4((int)(W).x, (int)(X).x, 0, false), false), false), false)
#define PU_REDUCE8(W, O, XQ, PROW, B) do { int d[8], a4[4], a2[2], a1; \
        _Pragma("unroll") for (int k = 0; k < 8; ++k) d[k] = PU_DOT16(W[(O) + k], XQ); \
        _Pragma("unroll") for (int k = 0; k < 4; ++k) { const int give = b2 ? d[k] : d[4 + k]; a4[k] = (b2 ? d[4 + k] : d[k]) + shx(give, 4); } \
        _Pragma("unroll") for (int k = 0; k < 2; ++k) { const int give = b1 ? a4[k] : a4[2 + k]; a2[k] = (b1 ? a4[2 + k] : a4[k]) + shx(give, 2); } \
        { const int give = b0 ? a2[0] : a2[1]; a1 = (b0 ? a2[1] : a2[0]) + shx(give, 1); } \
        (B) = a1; } while (0)
#define PU_META(T_, XQ, ELO, EHI) do { const int tq_ = (T_) < T ? (T_) : tlast; XQ = *(const uint4*)(h1q + (size_t)tq_ * 1024 + 128 * s + 16 * j); \
        ELO = eidx[(size_t)tq_ * 128 + lane]; EHI = eidx[(size_t)tq_ * 128 + 64 + lane]; } while (0)
#define PU_TOKEN(W, T_, XQ) do { unsigned* prow = (unsigned*)(part + ((size_t)s * T + (T_)) * 128); int d0_, d1_; PU_REDUCE8(W, 0, XQ, prow, d0_); PU_REDUCE8(W, 8, XQ, prow, d1_); \
        prow[kk * 8 + g] = pk2bf((float)d0_, (float)d1_); } while (0)
__device__ __forceinline__ void ph_peer_u(const Params& p, int wv) {
    PH_IDS(); unsigned char* ws = p.ws; const int s = bid & 7, cu = bid >> 3, ncu = nb >> 3, g = lane >> 3, j = lane & 7;
    const __amdgpu_buffer_rsrc_t rsrc_ = __builtin_amdgcn_make_buffer_rsrc((void*)(ws + OFF_PU), 0, 16 * 1024 * 1024, 0x00020000); const int sj_ = 128 * s + 16 * j;
    const unsigned char* h1q = ws + OFF_H1Q; const int* eidx = (const int*)(ws + OFF_EIDX); const unsigned char* PU = ws + OFF_PU; bf16* part = (bf16*)(ws + OFF_PART);
    const bool b2 = (lane & 4) != 0, b1 = (lane & 2) != 0, b0 = (lane & 1) != 0; const int kk = (b2 ? 4 : 0) + (b1 ? 2 : 0) + (b0 ? 1 : 0);
    const int tstep = ncu * NWAVES; int t = cu * NWAVES + wv;
    if (t >= T) return;
    const int tlast = t;
    uint4 xq0, xq1; int el0, eh0, el1, eh1;
    PU_META(t, xq0, el0, eh0); PU_META(t + tstep, xq1, el1, eh1);
    uint4 wA[16], wB[16];
    PU_ISSUE16(wA, el0, eh0);
    for (;;) {
        { const uint4 cx = xq0; PU_META(t + 2 * tstep, xq0, el0, eh0); PU_ISSUE16(wB, el1, eh1); PU_TOKEN(wA, t, cx); }
        t += tstep; if (t >= T) break;
        { const uint4 cx = xq1; PU_META(t + 2 * tstep, xq1, el1, eh1); PU_ISSUE16(wA, el0, eh0); PU_TOKEN(wB, t, cx); }
        t += tstep; if (t >= T) break;
    }
}
__device__ __forceinline__ void ph_peer_c(const Params& p, int wv) {
    PH_IDS(); unsigned char* ws = p.ws; const bf16* part = (const bf16*)(ws + OFF_PART); const float* gw = (const float*)(ws + OFF_GW); const int* eidx = (const int*)(ws + OFF_EIDX);
    const float* su = (const float*)(ws + OFF_SU); const float* sv = (const float*)(ws + OFF_SV); const float* sx = (const float*)(ws + OFF_SX); float* sc = (float*)(ws + OFF_SC); unsigned* coefq = (unsigned*)(ws + OFF_COEFQ);
    for (int t = gwave; t < T; t += nwaves) {
        float cp[2];
        float accp[2] = {0.f, 0.f};
#pragma unroll
        for (int s = 0; s < 8; ++s) { const unsigned w = ((const unsigned*)part)[((size_t)s * T + t) * 64 + lane]; accp[0] += bflo(w); accp[1] += bfhi(w); }
#pragma unroll
        for (int b = 0; b < 2; ++b) { const size_t i = (size_t)t * 128 + b * 64 + lane;
            const int e = eidx[i]; cp[b] = gw[i] * gelu_exact(accp[b] * su[e] * sx[t]) * sv[e]; }
        const float amax = fmaxf(wave_max(fmaxf(fabsf(cp[0]), fabsf(cp[1]))), 1e-30f), inv = 127.0f / amax;
        const int q0 = (int)rintf(cp[0] * inv) & 0xff, q1 = (int)rintf(cp[1] * inv) & 0xff;
        const int gg = lane & 7, kq = (lane >> 3) & 1;
        unsigned w0 = 0u, w1 = 0u;
#pragma unroll
        for (int i = 0; i < 4; ++i) { const int srcl = (4 * kq + i) * 8 + gg; w0 |= (unsigned)__shfl(q0, srcl) << (8 * i); w1 |= (unsigned)__shfl(q1, srcl) << (8 * i); }
        if (lane < 16) { coefq[(size_t)t * 32 + lane] = w0; coefq[(size_t)t * 32 + 16 + lane] = w1; }
        if (lane == 0) sc[t] = amax * (1.0f / 127.0f);
    }
}
#define PV_ISSUE16(W, ELO, EHI) do { _Pragma("unroll") for (int k = 0; k < 8; ++k) { const int e0 = __shfl(ELO, k * 8 + g), e1 = __shfl(EHI, k * 8 + g); \
        W[k] = bufld16(rsrc_, e0 * 1024 + sj_); W[8 + k] = bufld16(rsrc_, e1 * 1024 + sj_); } } while (0)
#define PV_META(T_, ELO, EHI, CQ) do { const int tq_ = (T_) < T ? (T_) : tlast; ELO = eidx[(size_t)tq_ * 128 + lane]; EHI = eidx[(size_t)tq_ * 128 + 64 + lane]; \
        CQ[0] = coefq[(size_t)tq_ * 32 + g]; CQ[1] = coefq[(size_t)tq_ * 32 + 8 + g]; CQ[2] = coefq[(size_t)tq_ * 32 + 16 + g]; CQ[3] = coefq[(size_t)tq_ * 32 + 24 + g]; } while (0)
#define PV_BLK(W0, W1, W2, W3, CQW, A0, A1, A2, A3) do { \
        const unsigned l01 = __builtin_amdgcn_perm(W1, W0, 0x05010400u), h01 = __builtin_amdgcn_perm(W1, W0, 0x07030602u), l23 = __builtin_amdgcn_perm(W3, W2, 0x05010400u), h23 = __builtin_amdgcn_perm(W3, W2, 0x07030602u); \
        A0 = __builtin_amdgcn_sdot4((int)__builtin_amdgcn_perm(l23, l01, 0x05040100u), (int)(CQW), A0, false); A1 = __builtin_amdgcn_sdot4((int)__builtin_amdgcn_perm(l23, l01, 0x07060302u), (int)(CQW), A1, false); \
        A2 = __builtin_amdgcn_sdot4((int)__builtin_amdgcn_perm(h23, h01, 0x05040100u), (int)(CQW), A2, false); A3 = __builtin_amdgcn_sdot4((int)__builtin_amdgcn_perm(h23, h01, 0x07060302u), (int)(CQW), A3, false); } while (0)
#define PV_QUAD(W, O, CQW) do { PV_BLK(W[(O)].x, W[(O) + 1].x, W[(O) + 2].x, W[(O) + 3].x, CQW, acc[0], acc[1], acc[2], acc[3]); PV_BLK(W[(O)].y, W[(O) + 1].y, W[(O) + 2].y, W[(O) + 3].y, CQW, acc[4], acc[5], acc[6], acc[7]); \
        PV_BLK(W[(O)].z, W[(O) + 1].z, W[(O) + 2].z, W[(O) + 3].z, CQW, acc[8], acc[9], acc[10], acc[11]); PV_BLK(W[(O)].w, W[(O) + 1].w, W[(O) + 2].w, W[(O) + 3].w, CQW, acc[12], acc[13], acc[14], acc[15]); } while (0)
#define PV_TOKEN(W, CQ, T_) do { int acc[16]; _Pragma("unroll") for (int i = 0; i < 16; ++i) acc[i] = 0; \
        PV_QUAD(W, 0, CQ[0]); PV_QUAD(W, 4, CQ[1]); PV_QUAD(W, 8, CQ[2]); PV_QUAD(W, 12, CQ[3]); \
        int y8[8], y4[4], y2[2]; \
        _Pragma("unroll") for (int i = 0; i < 8; ++i) { unsigned a_ = (unsigned)acc[i], b_ = (unsigned)acc[8 + i]; swap32(a_, b_); y8[i] = (int)a_ + (int)b_; }     \
        _Pragma("unroll") for (int i = 0; i < 4; ++i) { unsigned a_ = (unsigned)y8[i], b_ = (unsigned)y8[4 + i]; swap16(a_, b_); y4[i] = (int)a_ + (int)b_; } \
        _Pragma("unroll") for (int i = 0; i < 2; ++i) { const int give = b3 ? y4[i] : y4[2 + i]; y2[i] = (b3 ? y4[2 + i] : y4[i]) + shx(give, 8); } \
        const float sct = sc[(T_)]; *(unsigned*)(Y + (size_t)(T_) * 1024 + 128 * s + 16 * j + c0) = pk2bf((float)y2[0] * sct, (float)y2[1] * sct); } while (0)
__device__ __forceinline__ void ph_peer_v(const Params& p, int wv) {
    PH_IDS(); unsigned char* ws = p.ws; const int s = bid & 7, cu = bid >> 3, ncu = nb >> 3, g = lane >> 3, j = lane & 7;
    const __amdgpu_buffer_rsrc_t rsrc_ = __builtin_amdgcn_make_buffer_rsrc((void*)(ws + OFF_PV), 0, 16 * 1024 * 1024, 0x00020000); const int sj_ = 128 * s + 16 * j;
    const int* eidx = (const int*)(ws + OFF_EIDX); const unsigned* coefq = (const unsigned*)(ws + OFF_COEFQ); const float* sc = (const float*)(ws + OFF_SC); const unsigned char* PV = ws + OFF_PV; bf16* Y = (bf16*)(ws + OFF_Y);
    const bool b5 = (lane & 32) != 0, b4 = (lane & 16) != 0, b3 = (lane & 8) != 0; const int c0 = (b5 ? 8 : 0) + (b4 ? 4 : 0) + (b3 ? 2 : 0);
    const int tstep = ncu * NWAVES; int t = cu * NWAVES + wv;
    if (t >= T) return;
    const int tlast = t;
    int el0, eh0, el1, eh1; unsigned cq0[4], cq1[4];
    PV_META(t, el0, eh0, cq0); PV_META(t + tstep, el1, eh1, cq1);
    uint4 wA[16], wB[16];
    PV_ISSUE16(wA, el0, eh0);
    for (;;) {
        { unsigned cc[4] = {cq0[0], cq0[1], cq0[2], cq0[3]}; PV_META(t + 2 * tstep, el0, eh0, cq0); PV_ISSUE16(wB, el1, eh1); PV_TOKEN(wA, cc, t); }
        t += tstep; if (t >= T) break;
        { unsigned cc[4] = {cq1[0], cq1[1], cq1[2], cq1[3]}; PV_META(t + 2 * tstep, el1, eh1, cq1); PV_ISSUE16(wA, el0, eh0); PV_TOKEN(wB, cc, t); }
        t += tstep; if (t >= T) break;
    }
}
__device__ __forceinline__ void ph_peer_ln2(const Params& p, int wv) {
    PH_IDS(); unsigned char* ws = p.ws; const bf16* Y = (const bf16*)(ws + OFF_Y); const bf16* h1b = (const bf16*)(ws + OFF_H1B);
    int t = gwave; if (t >= T) return;
    float4 g2[4], b2[4];
#pragma unroll
    for (int i = 0; i < 4; ++i) { g2[i] = *(const float4*)(p.ln2_g + lane * 16 + 4 * i); b2[i] = *(const float4*)(p.ln2_b + lane * 16 + 4 * i); }
    uint4 ha[2], ya[2];
#pragma unroll
    for (int i = 0; i < 2; ++i) { ha[i] = *(const uint4*)(h1b + (size_t)t * 1024 + lane * 16 + 8 * i); ya[i] = *(const uint4*)(Y + (size_t)t * 1024 + lane * 16 + 8 * i); }
    for (;;) {
        const int tn = t + nwaves; const int tq = tn < T ? tn : t;
        uint4 hb[2], yb[2];
#pragma unroll
        for (int i = 0; i < 2; ++i) { hb[i] = *(const uint4*)(h1b + (size_t)tq * 1024 + lane * 16 + 8 * i); yb[i] = *(const uint4*)(Y + (size_t)tq * 1024 + lane * 16 + 8 * i); }
        float y[16], hf[16]; float s1 = 0.f, s2 = 0.f;
        unpack8(ya[0], y); unpack8(ya[1], y + 8); unpack8(ha[0], hf); unpack8(ha[1], hf + 8);
#pragma unroll
        for (int i = 0; i < 16; ++i) { y[i] += DN_ALPHA * hf[i]; s1 += y[i]; s2 += y[i] * y[i]; }
#pragma unroll
        for (int o = 1; o < 64; o <<= 1) { s1 += shx(s1, o); s2 += shx(s2, o); }
        const float mu = s1 * (1.0f / 1024.0f); const float var = fmaxf(s2 * (1.0f / 1024.0f) - mu * mu, 0.f); const float rstd = rsqrtf(var + LN_EPS);
        float* row = p.out + (size_t)t * 1024 + lane * 16;
#pragma unroll
        for (int i = 0; i < 4; ++i) { const float4 ga = g2[i], ba = b2[i];
            float4 o; o.x = (y[4 * i] - mu) * rstd * ga.x + ba.x; o.y = (y[4 * i + 1] - mu) * rstd * ga.y + ba.y; o.z = (y[4 * i + 2] - mu) * rstd * ga.z + ba.z; o.w = (y[4 * i + 3] - mu) * rstd * ga.w + ba.w;
            *(float4*)(row + 4 * i) = o; }
        if (tn >= T) break;
        t = tn;
#pragma unroll
        for (int i = 0; i < 2; ++i) { ha[i] = hb[i]; ya[i] = yb[i]; }
    }
}

#define LAS __attribute__((address_space(3)))
#define XB_TMO      128
#define XB_XCNT(j)  (256  + 64 * (j))
#define XB_XSUB(j)  (1280 + 64 * (j))
#define XB_XGEN(j)  (2304 + 64 * (j))
#define XB_TOP      3328
#define XB_TOPGEN   3392
#define XCD_BAR_WORDS 3456
#define XB_SPIN_CAP (1u << 18)

__device__ __forceinline__ unsigned xb_ld(unsigned* p)              { return __hip_atomic_load(p, __ATOMIC_RELAXED, __HIP_MEMORY_SCOPE_AGENT); }
__device__ __forceinline__ unsigned xb_add(unsigned* p, unsigned v) { return __hip_atomic_fetch_add(p, v, __ATOMIC_RELAXED, __HIP_MEMORY_SCOPE_AGENT); }
__device__ __forceinline__ unsigned xb_xcc_id() { return (unsigned)__builtin_amdgcn_s_getreg((3 << 11) | 20) & 0xFu; }
#define XB_SPIN(cond, bar) do { unsigned _sp = 0; while (cond) { __builtin_amdgcn_s_sleep(1); \
    if ((++_sp & 255u) == 0u) { if (xb_ld(&(bar)[XB_TMO])) break; if (_sp > XB_SPIN_CAP) { atomicAdd(&(bar)[XB_TMO], 1u); break; } } } } while (0)

struct XcdBarrier {
    unsigned* bar; unsigned x;
    volatile LAS unsigned* st;
};

__device__ __forceinline__ XcdBarrier xcd_barrier_post(unsigned* bar, volatile LAS unsigned* st, bool leader) {
    XcdBarrier b; b.bar = bar; b.x = xb_xcc_id(); b.st = st;
    if (leader) (void)xb_add(&bar[XB_XCNT(b.x)], 1u);
    return b;
}
__device__ __forceinline__ void xcd_barrier_complete(unsigned* bar, unsigned x, unsigned& nloc, unsigned& nx) {
    const unsigned G = gridDim.x * gridDim.y * gridDim.z;
    unsigned sum, cnt, mine, sp = 0u;
    for (;;) {
        sum = 0u; cnt = 0u; mine = 0u;
#pragma unroll
        for (unsigned j = 0; j < 16; ++j) { const unsigned c = xb_ld(&bar[XB_XCNT(j)]); sum += c; cnt += (c > 0u) ? 1u : 0u; mine = (j == x) ? c : mine; }
        if (sum == G) break;
        __builtin_amdgcn_s_sleep(1);
        if ((++sp & 255u) == 0u) { if (xb_ld(&bar[XB_TMO])) break; if (sp > XB_SPIN_CAP) { atomicAdd(&bar[XB_TMO], 1u); break; } }
    }
    nloc = mine > 0u ? mine : 1u; nx = cnt > 0u ? cnt : 1u;
}

__device__ __forceinline__ void xcd_barrier(const XcdBarrier& b, bool leader) {
    asm volatile("s_waitcnt vmcnt(0)" ::: "memory");
    __syncthreads();
    if (leader) {
        unsigned* bar = b.bar;
        __builtin_amdgcn_s_waitcnt(0);
        unsigned nloc = b.st[0], nx = b.st[1];
        if (nloc == 0u) { xcd_barrier_complete(bar, b.x, nloc, nx); b.st[0] = nloc; b.st[1] = nx; }
        const unsigned old = xb_add(&bar[XB_XSUB(b.x)], 1u);
        const unsigned gen = old / nloc;
        if (old + 1u == (gen + 1u) * nloc) {
            __builtin_amdgcn_fence(__ATOMIC_RELEASE, "agent");
            asm volatile("s_waitcnt vmcnt(0)" ::: "memory");
            const unsigned og = xb_add(&bar[XB_TOP], 1u);
            const unsigned tg = og / nx;
            if (og + 1u == (tg + 1u) * nx) xb_add(&bar[XB_TOPGEN], 1u);
            else XB_SPIN(xb_ld(&bar[XB_TOPGEN]) == tg, bar);
            __builtin_amdgcn_fence(__ATOMIC_ACQUIRE, "agent");
            xb_add(&bar[XB_XGEN(b.x)], 1u);
            asm volatile("s_waitcnt vmcnt(0)" ::: "memory");
        } else {
            XB_SPIN(xb_ld(&bar[XB_XGEN(b.x)]) == gen, bar);
            __builtin_amdgcn_fence(__ATOMIC_ACQUIRE, "agent");
            asm volatile("s_waitcnt vmcnt(0)" ::: "memory");
        }
    }
    __syncthreads();
}

constexpr size_t OFF_HPART = 244 * MiB;
struct HidFromParts { const bf16* p0; const bf16* p1; const float* bias;
    __device__ __forceinline__ bf16x8 operator()(int row, int k) const {
        float a[8], b[8], o[8]; unpack8(*(const uint4*)(p0 + (size_t)row * 256 + k), a); unpack8(*(const uint4*)(p1 + (size_t)row * 256 + k), b);
        const float4 b0 = *(const float4*)(bias + k), b1 = *(const float4*)(bias + k + 4); const float bb[8] = {b0.x, b0.y, b0.z, b0.w, b1.x, b1.y, b1.z, b1.w};
#pragma unroll
        for (int i = 0; i < 8; ++i) o[i] = gelu_exact(a[i] + b[i] + bb[i]);
        union { uint4 u; bf16x8 v; } r; r.u = pack8(o); return r.v; } };
template <bool ISK, class AP>
__device__ __forceinline__ void gemm2_rowtile(const Params& p, int wv, const AP& ap, int tm0, int tmstep) {
    PH_IDS(); unsigned char* ws = p.ws; const int r = lane & 15, q = lane >> 4;
    const bf16* w2 = (const bf16*)(ws + (ISK ? OFF_W2K : OFF_W2V)); bf16* outp = (bf16*)(ws + (ISK ? OFF_KC : OFF_VCT));
    const float* rc = (const float*)(ws + OFF_ROPE); const float* rs = rc + 4096 * 32;
    for (int tm = tm0; tm < 256; tm += tmstep) {
        const int row0 = tm * 16;
        f32x4 acc[4];
#pragma unroll
        for (int ct = 0; ct < 4; ++ct) acc[ct] = (f32x4){0.f, 0.f, 0.f, 0.f};
#pragma unroll 2
        for (int ks = 0; ks < 8; ++ks) {
            const bf16x8 a = ap(row0 + r, ks * 32 + 8 * q);
#pragma unroll
            for (int ct = 0; ct < 4; ++ct) acc[ct] = __builtin_amdgcn_mfma_f32_16x16x32_bf16(a, *(const bf16x8*)(w2 + (size_t)(ct * 16 + r) * 256 + ks * 32 + 8 * q), acc[ct], 0, 0, 0);
        }
#pragma unroll
        for (int e = 0; e < 4; ++e) {
            const int m = row0 + 4 * q + e, hk = m & 3, n = (m >> 2) & 255, b = m >> 10; const int pos = 16 * n + 31;
            bf16* dst = outp + ((size_t)(b * 4 + hk) * 256 + n) * 64;
            if (ISK) {
#pragma unroll
                for (int ct = 0; ct < 2; ++ct) {
                    const int j = ct * 16 + r; const float c = rc[pos * 32 + j], sn = rs[pos * 32 + j]; const float x1 = acc[ct][e], x2 = acc[ct + 2][e];
                    dst[j] = (n == 255) ? (bf16)0 : f2bf(x1 * c - x2 * sn); dst[j + 32] = (n == 255) ? (bf16)0 : f2bf(x1 * sn + x2 * c);
                }
            } else {
#pragma unroll
                for (int ct = 0; ct < 4; ++ct) dst[ct * 16 + r] = (n == 255) ? (bf16)0 : f2bf(acc[ct][e]);
            }
        }
    }
}
#ifndef TIMING_BOUNDARY
#define TIMING_BOUNDARY -1
#endif
#define TPROBE(k) do { if (TIMING_BOUNDARY == (k)) { const unsigned long long t1_ = __builtin_amdgcn_s_memrealtime(); while (__builtin_amdgcn_s_memrealtime() - t1_ < t1_ - tstart_) __builtin_amdgcn_s_sleep(8); } } while (0)
__global__ void __launch_bounds__(NTHREADS) fwd_megakernel(Params p) {
    extern __shared__ __attribute__((aligned(16))) unsigned char lds[];
    cg::grid_group grid = cg::this_grid();
    const int nb = gridDim.x, bid = blockIdx.x;
    const int wv = __builtin_amdgcn_readfirstlane(threadIdx.x >> 6);
    unsigned char* ws = p.ws;
    const unsigned long long tstart_ = (TIMING_BOUNDARY >= 0) ? __builtin_amdgcn_s_memrealtime() : 0ull; (void)tstart_;
    PG8_LAS unsigned char* ldsp = (PG8_LAS unsigned char*)lds;
    const bool leader = (wv == 0) && (lane_id() == 0);
    volatile LAS unsigned* bst = (volatile LAS unsigned*)(ldsp + LDS_BYTES - 64);
    if (leader) { bst[0] = 0u; bst[1] = 0u; }
    __syncthreads();
    const XcdBarrier xbar = xcd_barrier_post((unsigned*)(ws + OFF_BAR), bst, leader);

    ph_prep(p, wv, lds);
    if (p.ws == nullptr) grid.sync();
    xcd_barrier(xbar, leader);
    TPROBE(0);
    if (bid == nb - 1) {
        const int o = (wv << 6) | lane_id(); const float* b1p = (const float*)(ws + OFF_HID) + (size_t)(o >> 8) * 32 * 256 + (o & 255); float s = 0.f;
        for (int kc = 0; kc < 32; ++kc) s += b1p[kc * 256];
        ((float*)(ws + (o < 256 ? OFF_B1K : OFF_B1V)))[o & 255] = s;
    }
    {
        pg8::Gemm g{(const bf16*)(ws + OFF_XB), (const bf16*)(ws + OFF_WIN), T, NPROJ_PAD, 1024, 1024, 0, 1 << 30, 0l};
        pg8::StaticOrder S; S.init(T, NPROJ_PAD, nb, bid);
        pg8::EpiInProjPg E{(bf16*)(ws + OFF_Z), (bf16*)(ws + OFF_XBC), (bf16*)(ws + OFF_Q), (bf16*)(ws + OFF_KVS), (bf16*)(ws + OFF_DTG)};
        pg8::gemm_phase<pg8::EpiInProjPg, pg8::StaticOrder, pg8::NoMid, true, true>(wv, ldsp, g, S, E, pg8::NoMid{});
    }
    xcd_barrier(xbar, leader);
    TPROBE(1);
    if (bid < 64) {
        const int kh = bid >> 5, isv = (bid >> 4) & 1;
        pg8::Gemm g{(const bf16*)(ws + OFF_KVS) + (isv ? 256 : 0) + (size_t)kh * 16 * 1536, (const bf16*)(ws + (isv ? OFF_W1V : OFF_W1K)) + kh * 1024, 4096, 256, 1024, 0, 1, 1 << 30, 0l, 2048};
        pg8::StaticOrder S; S.init(4096, 256, 16, bid & 15);
        pg8::EpiBf16<0> E{(bf16*)(ws + OFF_HPART) + (size_t)(kh * 2 + isv) * 4096 * 256, 256, nullptr, 0, 0, 1.f};
        pg8::gemm_phase<pg8::EpiBf16<0>, pg8::StaticOrder, pg8::NoMid, true, true>(wv, ldsp, g, S, E, pg8::NoMid{});
    }
    else ph_tokprep(p, wv);
    xcd_barrier(xbar, leader);
    TPROBE(2);
    ph_ssd_prep2(p, wv, lds);
    xcd_barrier(xbar, leader);
    TPROBE(3);
    {
        const bf16* hp = (const bf16*)(ws + OFF_HPART);
        HidFromParts ak{hp, hp + (size_t)2 * 4096 * 256, (const float*)(ws + OFF_B1K)}, av{hp + (size_t)4096 * 256, hp + (size_t)3 * 4096 * 256, (const float*)(ws + OFF_B1V)};
        if (wv == 0) gemm2_rowtile<true>(p, wv, ak, bid, nb);
        if (wv == 1) gemm2_rowtile<false>(p, wv, av, bid, nb);
    }
    ph_ssd_states(p, wv);
    xcd_barrier(xbar, leader);
    TPROBE(4);
    ph_ssd_scan(p, wv);
    xcd_barrier(xbar, leader);
    TPROBE(5);
    ph_nsa(p, wv, lds);
    { const unsigned long long tb_ = (NSA_TP == 0) ? __builtin_amdgcn_s_memrealtime() : 0ull;
      xcd_barrier(xbar, leader);
      if (NSA_TP >= 0) {
          unsigned long long* acc_ = (unsigned long long*)(ws + OFF_BAR + 14336 + 128);
          if (NSA_TP == 0) { if (wv == 0 && lane_id() == 0) atomicAdd(acc_, __builtin_amdgcn_s_memrealtime() - tb_); xcd_barrier(xbar, leader); }
          const unsigned long long mean_ = __hip_atomic_load(acc_, __ATOMIC_RELAXED, __HIP_MEMORY_SCOPE_AGENT) / (unsigned long long)nb;
          const unsigned long long t1_ = __builtin_amdgcn_s_memrealtime(); while (__builtin_amdgcn_s_memrealtime() - t1_ < mean_) __builtin_amdgcn_s_sleep(2);
      } }
    TPROBE(6);
    {
        pg8::Gemm g{(const bf16*)(ws + OFF_Q), (const bf16*)(ws + OFF_WOUT), T, 1024, 2048, 1024, 0, 16, (long)OFF_Z - (long)OFF_Q - 16l * 128l};
        pg8::StaticOrder S; S.init(T, 1024, nb, bid);
        pg8::RmsFactors rf{(const float*)(ws + OFF_SSQ), (const float*)(ws + OFF_HID), RMS_EPS};
        float* fl = (float*)(lds + pg8::STAGE_BYTES);
        pg8::EpiOutProj E{p.x, (bf16*)p.out, DN_ALPHA, fl}; pg8::MidRmsScale MH{rf, fl};
        pg8::gemm_phase<pg8::EpiOutProj, pg8::StaticOrder, pg8::MidRmsScale, true, true>(wv, ldsp, g, S, E, MH);
    }
    xcd_barrier(xbar, leader);
    TPROBE(7);
    ph_ln1(p, wv);
    xcd_barrier(xbar, leader);
    TPROBE(8);
    {
        pg8::Gemm g{(const bf16*)(ws + OFF_H1B), (const bf16*)(ws + OFF_WQ), T, 2048, 1024, 1024, 0, 1 << 30, 0l};
        pg8::StaticOrder S; S.init(T, 2048, nb, bid);
        pg8::EpiBf16<0> E{(bf16*)(ws + OFF_QP), 2048, nullptr, 0, 0, 1.f};
        pg8::gemm_phase<pg8::EpiBf16<0>, pg8::StaticOrder, pg8::NoMid, true, true>(wv, ldsp, g, S, E, pg8::NoMid{});
    }
    xcd_barrier(xbar, leader);
    TPROBE(9);
    ph_peer_topk(p, wv, lds);
    xcd_barrier(xbar, leader);
    TPROBE(10);
    ph_peer_u(p, wv);
    xcd_barrier(xbar, leader);
    TPROBE(11);
    ph_peer_c(p, wv);
    xcd_barrier(xbar, leader);
    TPROBE(12);
    ph_peer_v(p, wv);
    xcd_barrier(xbar, leader);
    TPROBE(13);
    ph_peer_ln2(p, wv);
}

extern "C" void kernel_launch(void* const* d_in, const int* in_sizes, int n_in, void* d_out, int out_size, void* d_ws, size_t ws_size, hipStream_t stream) {
    static int grid_blocks = 0;
    if (!grid_blocks) {
        int dev = 0, cus = 0, per_cu = 0;
        hipGetDevice(&dev);
        hipDeviceGetAttribute(&cus, hipDeviceAttributeMultiprocessorCount, dev);
        hipFuncSetAttribute((const void*)fwd_megakernel, hipFuncAttributeMaxDynamicSharedMemorySize, LDS_BYTES);
        hipOccupancyMaxActiveBlocksPerMultiprocessor(&per_cu, fwd_megakernel, NTHREADS, LDS_BYTES);
        if (per_cu < 1) per_cu = 1;
        if (per_cu > 1) per_cu = 1;
        grid_blocks = cus * per_cu;
        if (ws_size < 244 * MiB) fprintf(stderr, "kernel_launch: workspace too small: %zu\n", ws_size);
    }
    Params p{};
    const float** pp = (const float**)&p;
    for (int i = 0; i < 24; ++i) pp[i] = (const float*)d_in[i];
    p.out = (float*)d_out; p.ws = (unsigned char*)d_ws;
    (void)hipMemsetAsync((unsigned char*)d_ws + OFF_BAR, 0, BAR_BYTES, stream);
    void* args[] = {&p};
    hipError_t e = hipLaunchCooperativeKernel((void*)fwd_megakernel, dim3(grid_blocks), dim3(NTHREADS), args, LDS_BYTES, stream);
    if (e != hipSuccess) fprintf(stderr, "cooperative launch failed: %s (grid %d)\n", hipGetErrorString(e), grid_blocks);
}
```
